# Optimizing an MI355X kernel written in HIP

```python
import math
import jax
import jax.numpy as jnp
from jax import lax
import numpy as np

D_MODEL = 1024
BATCH = 8
SEQ = 2048
DEPTH = 2

GRID_W = 64
CTX_LEN = 256
N_BRANCH = 4
BRANCH_W = 256
NORM_EPS = 1e-6
ROPE_BASE = 10000.0
Q_BLOCK = 128
ADA_CHUNKS = 6
ADA_INIT = 0.3

MLA_HEADS = 4
MLA_NOPE = 64
MLA_ROPE = 32
MLA_QK = MLA_NOPE + MLA_ROPE
MLA_V = 64
Q_LORA = 256
KV_LORA = 128

FNET_GROUPS = 4
FNET_GW = BRANCH_W // FNET_GROUPS

S5_GROUP_CH = 16
S5_GROUPS = BRANCH_W // S5_GROUP_CH
S5_STATE = 64
S5_DT_MIN = 0.001
S5_DT_MAX = 0.1

RET_HEADS = 4
RET_HD = BRANCH_W // RET_HEADS
RET_CHUNK = 128

D_FF = 4 * D_MODEL

STATE_SIZES = (KV_LORA, MLA_ROPE, BRANCH_W, BRANCH_W, BRANCH_W)
MAIN_SIZES = (Q_LORA, BRANCH_W, BRANCH_W, BRANCH_W, N_BRANCH * D_MODEL)
STATE_COLS = sum(STATE_SIZES)
IN_COLS = STATE_COLS + sum(MAIN_SIZES)

kernel_name = 'hybrid_mla_fnet_s5_retention_dit_block'


def split_cols(z, sizes):
    return jnp.split(z, np.cumsum(sizes)[:-1].tolist(), axis=-1)


def rms_norm(x, w):
    xf = x.astype(jnp.float32)
    y = xf * lax.rsqrt(jnp.mean(xf * xf, axis=-1, keepdims=True) + NORM_EPS)
    return (y * w.astype(jnp.float32)).astype(x.dtype)


def ada_rms(x, w, shift, scale):
    return rms_norm(x, w) * (1.0 + scale) + shift


def rotary(x, pos):
    half = x.shape[-1] // 2
    freqs = ROPE_BASE ** (-jnp.arange(half, dtype=jnp.float32) / half)
    ang = pos.astype(jnp.float32)[:, None] * freqs
    cos = jnp.cos(ang)[:, None, :]
    sin = jnp.sin(ang)[:, None, :]
    xf = x.astype(jnp.float32)
    x1, x2 = xf[..., :half], xf[..., half:]
    return jnp.concatenate([x1 * cos - x2 * sin, x1 * sin + x2 * cos], axis=-1).astype(x.dtype)


def axial_rotary(x, rows, cols):
    h = x.shape[-1] // 2
    return jnp.concatenate([rotary(x[..., :h], rows), rotary(x[..., h:], cols)], axis=-1)


def mla_keys(kv_c, k_r, kv_norm, w_ukv, qk_k, rows, cols):
    B, L, _ = kv_c.shape
    kv = (rms_norm(kv_c, kv_norm) @ w_ukv).reshape(B, L, MLA_HEADS, MLA_NOPE + MLA_V)
    k_nope, v = kv[..., :MLA_NOPE], kv[..., MLA_NOPE:]
    k_r = jnp.broadcast_to(k_r[:, :, None, :], (B, L, MLA_HEADS, MLA_ROPE))
    k = rms_norm(jnp.concatenate([k_nope, k_r], axis=-1), qk_k)
    if rows is not None:
        k = jnp.concatenate([k[..., :MLA_NOPE], axial_rotary(k[..., MLA_NOPE:], rows, cols)], axis=-1)
    return k, v


def mla_queries(q_c, q_norm, w_uq, qk_q, rows, cols):
    B, L, _ = q_c.shape
    q = (rms_norm(q_c, q_norm) @ w_uq).reshape(B, L, MLA_HEADS, MLA_QK)
    q = rms_norm(q, qk_q)
    if rows is None:
        return q
    return jnp.concatenate([q[..., :MLA_NOPE], axial_rotary(q[..., MLA_NOPE:], rows, cols)], axis=-1)


def block_softmax_attention(q, k, v):
    B, Lq, H, dk = q.shape
    dv = v.shape[-1]
    nb = Lq // Q_BLOCK
    scale = dk ** -0.5
    qb = q.reshape(B, nb, Q_BLOCK, H, dk).swapaxes(0, 1)

    def attend(qi):
        s = jnp.einsum('bqhd,bkhd->bhqk', qi, k).astype(jnp.float32) * scale
        p = jax.nn.softmax(s, axis=-1).astype(v.dtype)
        return jnp.einsum('bhqk,bkhd->bqhd', p, v)

    o = lax.map(attend, qb)
    return o.swapaxes(0, 1).reshape(B, Lq, H * dv)


def fourier_mix(u):
    B, L, _ = u.shape
    ug = u.astype(jnp.float32).reshape(B, L, FNET_GROUPS, FNET_GW)
    y = jnp.fft.fft2(ug, axes=(1, 3), norm='ortho').real
    return y.reshape(B, L, BRANCH_W).astype(u.dtype)


def s5_discretise(lam_re, lam_im, log_step, b_re, b_im):
    lam = lax.complex(lam_re.astype(jnp.float32), lam_im.astype(jnp.float32))
    step = jnp.exp(log_step.astype(jnp.float32))[:, None]
    lam_bar = jnp.exp(lam * step)
    b = lax.complex(b_re.astype(jnp.float32), b_im.astype(jnp.float32))
    b_bar = ((lam_bar - 1.0) / lam)[..., None] * b
    return lam_bar, b_bar


def linear_recurrence_op(left, right):
    a_l, b_l = left
    a_r, b_r = right
    return a_l * a_r, a_r * b_l + b_r


def s5_scan(u, lam_bar, b_bar, x0, reverse):
    B, L, _ = u.shape
    ug = u.astype(jnp.float32).reshape(B, L, S5_GROUPS, S5_GROUP_CH).astype(jnp.complex64)
    bu = jnp.einsum('blgh,gph->blgp', ug, b_bar)
    if reverse:
        bu = jnp.flip(bu, axis=1)
    if x0 is not None:
        bu = bu.at[:, 0].add(lam_bar * x0)
    a = jnp.broadcast_to(lam_bar, bu.shape)
    _, xs = lax.associative_scan(linear_recurrence_op, (a, bu), axis=1)
    return jnp.flip(xs, axis=1) if reverse else xs


def s5_readout(u, xs_f, xs_b, c_f, c_b, d, w_glu):
    B, L, _ = u.shape
    y = (jnp.einsum('blgp,ghp->blgh', xs_f, c_f).real
         + jnp.einsum('blgp,ghp->blgh', xs_b, c_b).real)
    y = y.reshape(B, L, BRANCH_W).astype(u.dtype) + d * u
    y = jax.nn.gelu(y)
    val, gate = jnp.split(y @ w_glu, 2, axis=-1)
    return val * jax.nn.sigmoid(gate)


def retention_heads(t, pos):
    B, L, _ = t.shape
    t = t.reshape(B, L, RET_HEADS, RET_HD)
    if pos is not None:
        t = rotary(t, pos)
    return t.transpose(0, 2, 1, 3)


def retention_chunkwise(q, k, v, log_g, s0):
    B, H, L, dk = q.shape
    n = L // RET_CHUNK
    idx = jnp.arange(RET_CHUNK, dtype=jnp.float32)
    diff = idx[:, None] - idx[None, :]
    intra = jnp.where(diff >= 0, jnp.exp(log_g[:, None, None] * jnp.maximum(diff, 0.0)), 0.0)
    q_dec = jnp.exp(log_g[:, None] * (idx + 1.0))
    k_dec = jnp.exp(log_g[:, None] * (RET_CHUNK - 1.0 - idx))
    chunk_dec = jnp.exp(log_g * RET_CHUNK)

    def blocks(t):
        return t.astype(jnp.float32).reshape(B, H, n, RET_CHUNK, t.shape[-1]).transpose(2, 0, 1, 3, 4)

    def step(s, qkv):
        qi, ki, vi = qkv
        att = jnp.einsum('bhqd,bhkd->bhqk', qi, ki) * intra
        o = (jnp.einsum('bhqk,bhkv->bhqv', att, vi)
             + jnp.einsum('bhqd,bhdv->bhqv', qi * q_dec[..., None], s))
        s = s * chunk_dec[:, None, None] + jnp.einsum('bhkd,bhkv->bhdv', ki * k_dec[..., None], vi)
        return s, o

    s, o = lax.scan(step, s0, (blocks(q), blocks(k), blocks(v)))
    return o.transpose(1, 2, 0, 3, 4).reshape(B, H, L, -1), s


def retention_final_state(k, v, log_g):
    L = k.shape[2]
    w = jnp.exp(log_g[:, None] * (L - 1.0 - jnp.arange(L, dtype=jnp.float32)))
    return jnp.einsum('bhld,bhlv,hl->bhdv', k.astype(jnp.float32), v.astype(jnp.float32), w)


def retention_bidir(q, k, v, log_g_f, log_g_b, s0_f, s0_b):
    o_f, s_f = retention_chunkwise(q, k, v, log_g_f, s0_f)
    o_b, s_b = retention_chunkwise(jnp.flip(q, 2), jnp.flip(k, 2), jnp.flip(v, 2), log_g_b, s0_b)
    return o_f + jnp.flip(o_b, 2), s_f, s_b


def retention_output(o, g, gn_w):
    B, H, L, dv = o.shape
    of = o.astype(jnp.float32).transpose(0, 2, 1, 3)
    mu = jnp.mean(of, axis=-1, keepdims=True)
    var = jnp.mean(jnp.square(of - mu), axis=-1, keepdims=True)
    y = ((of - mu) * lax.rsqrt(var + NORM_EPS)).reshape(B, L, H * dv) * gn_w.astype(jnp.float32)
    return (jax.nn.silu(g.astype(jnp.float32)) * y).astype(g.dtype)


def merge_branches(o_a, o_b, o_c, o_d, gates, w_branch, w_out):
    B, L, _ = gates.shape
    o = jnp.stack([o_a.astype(gates.dtype), o_b.astype(gates.dtype),
                   o_c.astype(gates.dtype), o_d.astype(gates.dtype)], axis=2)
    y = jnp.einsum('blnw,nwd->blnd', o, w_branch)
    g = jax.nn.sigmoid(gates.reshape(B, L, N_BRANCH, D_MODEL).astype(jnp.float32)).astype(y.dtype)
    return jnp.sum(g * y, axis=2) @ w_out


def sq_relu_mlp(h, w1, w2):
    return jnp.square(jax.nn.relu(h @ w1)) @ w2


def setup_inputs(seed: int = 0) -> dict:
    key = jax.random.key(seed)
    ks = jax.random.split(key, 30)
    f32 = jnp.float32

    def nrm(i, shape, scale):
        return jax.random.normal(ks[i], shape, f32) * scale

    def gain(i, shape):
        return 1.0 + 0.01 * jax.random.normal(ks[i], shape, f32)

    Ld = DEPTH
    n_idx = jnp.arange(S5_STATE, dtype=f32)
    gamma0 = 1.0 - 2.0 ** (-5.0 - np.arange(RET_HEADS))
    logit0 = jnp.asarray(np.log(gamma0 / (1.0 - gamma0)), dtype=f32)
    s5_shape = (Ld, 2, S5_GROUPS, S5_STATE)
    return {
        'x': nrm(0, (BATCH, SEQ, D_MODEL), 1.0),
        'c': nrm(1, (BATCH, D_MODEL), 1.0),
        'ctx': nrm(2, (BATCH, CTX_LEN, D_MODEL), 1.0),
        'c_ctx': nrm(3, (D_MODEL,), 1.0),
        'ada_w': nrm(4, (Ld, D_MODEL, ADA_CHUNKS * D_MODEL), ADA_INIT * D_MODEL ** -0.5),
        'ada_b': nrm(5, (Ld, ADA_CHUNKS * D_MODEL), 0.01),
        'norm_mix_w': gain(6, (Ld, D_MODEL)),
        'norm_ffn_w': gain(7, (Ld, D_MODEL)),
        'w_in': nrm(8, (Ld, D_MODEL, IN_COLS), D_MODEL ** -0.5),
        'mla_q_norm': gain(9, (Ld, Q_LORA)),
        'mla_w_uq': nrm(10, (Ld, Q_LORA, MLA_HEADS * MLA_QK), Q_LORA ** -0.5),
        'mla_kv_norm': gain(11, (Ld, KV_LORA)),
        'mla_w_ukv': nrm(12, (Ld, KV_LORA, MLA_HEADS * (MLA_NOPE + MLA_V)), KV_LORA ** -0.5),
        'mla_qk_norm_q': gain(13, (Ld, MLA_QK)),
        'mla_qk_norm_k': gain(14, (Ld, MLA_QK)),
        's5_lam_re': -0.5 + nrm(15, s5_shape, 0.01),
        's5_lam_im': math.pi * n_idx + nrm(16, s5_shape, 0.01),
        's5_log_step': jax.random.uniform(ks[17], (Ld, 2, S5_GROUPS), f32,
                                          math.log(S5_DT_MIN), math.log(S5_DT_MAX)),
        's5_b_re': nrm(18, (Ld, 2, S5_GROUPS, S5_STATE, S5_GROUP_CH), (2 * S5_GROUP_CH) ** -0.5),
        's5_b_im': nrm(19, (Ld, 2, S5_GROUPS, S5_STATE, S5_GROUP_CH), (2 * S5_GROUP_CH) ** -0.5),
        's5_c_re': nrm(20, (Ld, 2, S5_GROUPS, S5_GROUP_CH, S5_STATE), (2 * S5_STATE) ** -0.5),
        's5_c_im': nrm(21, (Ld, 2, S5_GROUPS, S5_GROUP_CH, S5_STATE), (2 * S5_STATE) ** -0.5),
        's5_d': nrm(22, (Ld, BRANCH_W), 1.0),
        's5_w_glu': nrm(23, (Ld, BRANCH_W, 2 * BRANCH_W), BRANCH_W ** -0.5),
        'ret_decay_logit': logit0 + nrm(24, (Ld, 2, RET_HEADS), 0.01),
        'ret_gn_w': gain(25, (Ld, BRANCH_W)),
        'w_branch': nrm(26, (Ld, N_BRANCH, BRANCH_W, D_MODEL), BRANCH_W ** -0.5),
        'w_out': nrm(27, (Ld, D_MODEL, D_MODEL), D_MODEL ** -0.5),
        'ffn_w1': nrm(28, (Ld, D_MODEL, D_FF), D_MODEL ** -0.5),
        'ffn_w2': nrm(29, (Ld, D_FF, D_MODEL), D_FF ** -0.5),
    }


def reference(x, c, ctx, c_ctx, ada_w, ada_b, norm_mix_w, norm_ffn_w, w_in,
              mla_q_norm, mla_w_uq, mla_kv_norm, mla_w_ukv, mla_qk_norm_q, mla_qk_norm_k,
              s5_lam_re, s5_lam_im, s5_log_step, s5_b_re, s5_b_im, s5_c_re, s5_c_im,
              s5_d, s5_w_glu, ret_decay_logit, ret_gn_w, w_branch, w_out, ffn_w1, ffn_w2):
    f32 = jnp.float32
    B, L, _ = x.shape
    ROWS = L // GRID_W
    rows = jnp.repeat(jnp.arange(ROWS, dtype=f32), GRID_W)
    cols = jnp.tile(jnp.arange(GRID_W, dtype=f32), ROWS)
    pos = jnp.arange(L, dtype=f32)
    ret_scale = RET_HD ** -0.5
    zero_ret = jnp.zeros((B, RET_HEADS, RET_HD, RET_HD), f32)
    full_sizes = STATE_SIZES + MAIN_SIZES

    xl, xc = x, ctx
    for l in range(DEPTH):
        last = l == DEPTH - 1
        mod_l = (jax.nn.silu(c) @ ada_w[l] + ada_b[l])[:, None, :]
        mod_c = (jax.nn.silu(c_ctx) @ ada_w[l] + ada_b[l])[None, None, :]
        sh1, sc1, g1, sh2, sc2, g2 = jnp.split(mod_l, ADA_CHUNKS, axis=-1)
        csh1, csc1, cg1, csh2, csc2, cg2 = jnp.split(mod_c, ADA_CHUNKS, axis=-1)

        lam_f, bbar_f = s5_discretise(s5_lam_re[l, 0], s5_lam_im[l, 0], s5_log_step[l, 0],
                                      s5_b_re[l, 0], s5_b_im[l, 0])
        lam_b, bbar_b = s5_discretise(s5_lam_re[l, 1], s5_lam_im[l, 1], s5_log_step[l, 1],
                                      s5_b_re[l, 1], s5_b_im[l, 1])
        cmat_f = lax.complex(s5_c_re[l, 0].astype(f32), s5_c_im[l, 0].astype(f32))
        cmat_b = lax.complex(s5_c_re[l, 1].astype(f32), s5_c_im[l, 1].astype(f32))
        log_g_f = jax.nn.log_sigmoid(ret_decay_logit[l, 0].astype(f32))
        log_g_b = jax.nn.log_sigmoid(ret_decay_logit[l, 1].astype(f32))

        hc = ada_rms(xc, norm_mix_w[l], csh1, csc1)
        if last:
            zc = split_cols(hc @ w_in[l][:, :STATE_COLS], STATE_SIZES)
        else:
            zc = split_cols(hc @ w_in[l], full_sizes)
        k_ctx, v_ctx = mla_keys(zc[0], zc[1], mla_kv_norm[l], mla_w_ukv[l], mla_qk_norm_k[l], None, None)
        xs_cf = s5_scan(zc[2], lam_f, bbar_f, None, False)
        xs_cb = s5_scan(zc[2], lam_b, bbar_b, None, True)
        rk_c = retention_heads(zc[3], None) * ret_scale
        rv_c = retention_heads(zc[4], None)
        if last:
            s_f = retention_final_state(rk_c, rv_c, log_g_f)
            s_b = retention_final_state(jnp.flip(rk_c, 2), jnp.flip(rv_c, 2), log_g_b)
        else:
            rq_c = retention_heads(zc[7], None)
            o_ret_c, s_f, s_b = retention_bidir(rq_c, rk_c, rv_c, log_g_f, log_g_b, zero_ret, zero_ret)

        hl = ada_rms(xl, norm_mix_w[l], sh1, sc1)
        zl = split_cols(hl @ w_in[l], full_sizes)
        k_l, v_l = mla_keys(zl[0], zl[1], mla_kv_norm[l], mla_w_ukv[l], mla_qk_norm_k[l], rows, cols)
        q_l = mla_queries(zl[5], mla_q_norm[l], mla_w_uq[l], mla_qk_norm_q[l], rows, cols)
        o_a = block_softmax_attention(q_l, jnp.concatenate([k_ctx, k_l], axis=1),
                                      jnp.concatenate([v_ctx, v_l], axis=1))
        o_b = fourier_mix(zl[6])
        xs_f = s5_scan(zl[2], lam_f, bbar_f, xs_cf[:, -1], False)
        xs_b = s5_scan(zl[2], lam_b, bbar_b, xs_cb[:, 0], True)
        o_c = s5_readout(zl[2], xs_f, xs_b, cmat_f, cmat_b, s5_d[l], s5_w_glu[l])
        rq = retention_heads(zl[7], pos)
        rk = retention_heads(zl[3], pos) * ret_scale
        rv = retention_heads(zl[4], None)
        o_ret, _, _ = retention_bidir(rq, rk, rv, log_g_f, log_g_b, s_f, s_b)
        o_d = retention_output(o_ret, zl[8], ret_gn_w[l])
        xl_new = xl + g1 * merge_branches(o_a, o_b, o_c, o_d, zl[9], w_branch[l], w_out[l])
        xl_new = xl_new + g2 * sq_relu_mlp(ada_rms(xl_new, norm_ffn_w[l], sh2, sc2), ffn_w1[l], ffn_w2[l])

        if not last:
            q_cx = mla_queries(zc[5], mla_q_norm[l], mla_w_uq[l], mla_qk_norm_q[l], None, None)
            oc_a = block_softmax_attention(q_cx, k_ctx, v_ctx)
            oc_b = fourier_mix(zc[6])
            oc_c = s5_readout(zc[2], xs_cf, xs_cb, cmat_f, cmat_b, s5_d[l], s5_w_glu[l])
            oc_d = retention_output(o_ret_c, zc[8], ret_gn_w[l])
            xc = xc + cg1 * merge_branches(oc_a, oc_b, oc_c, oc_d, zc[9], w_branch[l], w_out[l])
            xc = xc + cg2 * sq_relu_mlp(ada_rms(xc, norm_ffn_w[l], csh2, csc2), ffn_w1[l], ffn_w2[l])
        xl = xl_new
    return xl
```

```cpp
#include <hip/hip_runtime.h>
#include <cstdint>
#include <cstring>
#include <cstdio>

typedef unsigned short bf16_t;
typedef short bf16x8 __attribute__((ext_vector_type(8)));
typedef float f32x4 __attribute__((ext_vector_type(4)));

constexpr int DM = 1024, NB = 8, SEQ = 2048, CTX = 256, DEPTH = 2;
constexpr int RL = NB * SEQ;
constexpr int RC = NB * CTX;
constexpr int RT = RL + RC;
constexpr int INC = 6048;
constexpr int ZW = 2048;
constexpr int C_KVC = 0, C_KR = 128, C_S5 = 160, C_RK = 416, C_RV = 672, C_QC = 928, C_FU = 1184, C_RQ = 1440, C_RG = 1696, C_GATE = 1952;
constexpr int DFF = 4096;
constexpr int TCH = 64;
constexpr int NCH = RT / TCH;
constexpr float EPS = 1e-6f;
#define PI_D 3.14159265358979323846

__device__ __forceinline__ float bf2f(bf16_t v) { return __uint_as_float(((unsigned)v) << 16); }
__device__ __forceinline__ bf16_t f2bf(float f) { unsigned u = __float_as_uint(f); return (bf16_t)((u + 0x7fffu + ((u >> 16) & 1u)) >> 16); }
__device__ __forceinline__ float sigmoidf_(float x) { return 1.f / (1.f + __expf(-x)); }
__device__ __forceinline__ float siluf_(float x) { return x * sigmoidf_(x); }
__device__ __forceinline__ float geluf_(float x) { return 0.5f * x * (1.f + tanhf(0.7978845608028654f * (x + 0.044715f * x * x * x))); }
__device__ __forceinline__ int row_batch(int row) { return row < RL ? (row >> 11) : ((row - RL) >> 8); }
__device__ __forceinline__ int row_modidx(int row) { return row < RL ? (row >> 11) : 8; }

constexpr size_t MiB = 1ull << 20;
constexpr size_t WS_MOD = 0;
constexpr size_t WS_RS = 1 * MiB;
constexpr size_t WS_TRIG = WS_RS + 256 * 1024;
constexpr size_t WS_LAMT = WS_TRIG + 32 * 1024;
constexpr size_t WS_LP = 2 * MiB;
constexpr size_t WS_BB = 5 * MiB;
constexpr size_t WS_XN = 8 * MiB;
constexpr size_t WS_Z = 44 * MiB;
constexpr size_t WS_QKV = 116 * MiB;
constexpr size_t WS_F1 = 152 * MiB;
constexpr size_t WS_TZ = 170 * MiB;
constexpr size_t WS_MS = 172 * MiB;
constexpr size_t WS_QO = 188 * MiB;
constexpr size_t WS_SLOC = 204 * MiB;
constexpr size_t WS_XP = 209 * MiB;
constexpr size_t WS_XC = 214 * MiB;
constexpr size_t WS_RAW = 222 * MiB;
constexpr size_t WS_YG = WS_RAW;
constexpr size_t WS_GL = WS_RAW + 9 * MiB;
constexpr size_t WS_STASH = WS_QKV;
constexpr size_t WS_MM = WS_F1;
constexpr size_t WS_H = WS_Z;
constexpr size_t WS_END = 256 * MiB;

template <bool MFMA, class AF, class BF, class EF>
__global__ void __launch_bounds__(256) gemm_kernel(AF A, BF B, EF E, int nbatch, int M, int N, int K) {
    __shared__ __attribute__((aligned(16))) bf16_t sA[64][40];
    __shared__ __attribute__((aligned(16))) bf16_t sB[64][40];
    const int tid = threadIdx.x;
    const int tm = (M + 63) >> 6, tn = (N + 63) >> 6, total = nbatch * tm * tn;
    for (int it = blockIdx.x; it < total; it += gridDim.x) {
        const int b = it / (tm * tn), r = it % (tm * tn), m0 = (r / tn) * 64, n0 = (r % tn) * 64;
        float accf[4][4];
        f32x4 accm[2][2];
#pragma unroll
        for (int i = 0; i < 4; ++i)
#pragma unroll
            for (int j = 0; j < 4; ++j) accf[i][j] = 0.f;
#pragma unroll
        for (int i = 0; i < 2; ++i)
#pragma unroll
            for (int j = 0; j < 2; ++j) accm[i][j] = (f32x4){0.f, 0.f, 0.f, 0.f};
        for (int k0 = 0; k0 < K; k0 += 32) {
            __syncthreads();
#pragma unroll
            for (int i = 0; i < 8; ++i) {
                const int e = tid + i * 256;
                { const int m = e >> 5, k = e & 31; float v = 0.f; if (m0 + m < M && k0 + k < K) v = A(b, m0 + m, k0 + k); sA[m][k] = f2bf(v); }
                { const int k = e >> 6, n = e & 63; float v = 0.f; if (n0 + n < N && k0 + k < K) v = B(b, k0 + k, n0 + n); sB[n][k] = f2bf(v); }
            }
            __syncthreads();
            if (MFMA) {
                const int w = tid >> 6, lane = tid & 63, wm = (w >> 1) * 32, wn = (w & 1) * 32, fr = lane & 15, fq = lane >> 4;
                bf16x8 af[2], bfr[2];
#pragma unroll
                for (int i = 0; i < 2; ++i) { af[i] = *(const bf16x8*)&sA[wm + i * 16 + fr][fq * 8]; bfr[i] = *(const bf16x8*)&sB[wn + i * 16 + fr][fq * 8]; }
#pragma unroll
                for (int i = 0; i < 2; ++i)
#pragma unroll
                    for (int j = 0; j < 2; ++j) accm[i][j] = __builtin_amdgcn_mfma_f32_16x16x32_bf16(af[i], bfr[j], accm[i][j], 0, 0, 0);
            } else {
                const int tx = tid & 15, ty = tid >> 4;
#pragma unroll 8
                for (int k = 0; k < 32; ++k) {
                    float a[4], bb[4];
#pragma unroll
                    for (int i = 0; i < 4; ++i) { a[i] = bf2f(sA[ty * 4 + i][k]); bb[i] = bf2f(sB[tx * 4 + i][k]); }
#pragma unroll
                    for (int i = 0; i < 4; ++i)
#pragma unroll
                        for (int j = 0; j < 4; ++j) accf[i][j] += a[i] * bb[j];
                }
            }
        }
        if (MFMA) {
            const int w = tid >> 6, lane = tid & 63, wm = (w >> 1) * 32, wn = (w & 1) * 32, fr = lane & 15, fq = lane >> 4;
#pragma unroll
            for (int i = 0; i < 2; ++i)
#pragma unroll
                for (int j = 0; j < 2; ++j)
#pragma unroll
                    for (int rr = 0; rr < 4; ++rr) {
                        const int m = m0 + wm + i * 16 + fq * 4 + rr, n = n0 + wn + j * 16 + fr;
                        if (m < M && n < N) E(b, m, n, accm[i][j][rr]);
                    }
        } else {
            const int tx = tid & 15, ty = tid >> 4;
#pragma unroll
            for (int i = 0; i < 4; ++i)
#pragma unroll
                for (int j = 0; j < 4; ++j) { const int m = m0 + ty * 4 + i, n = n0 + tx * 4 + j; if (m < M && n < N) E(b, m, n, accf[i][j]); }
        }
    }
}
#ifndef GEMM_MFMA
#define GEMM_MFMA false
#endif
template <class T> static T zeroed() { T t; memset((void*)&t, 0, sizeof(T)); return t; }
template <class AF, class BF, class EF>
static void launch_gemm(hipStream_t s, const AF& A, const BF& B, const EF& E, int nbatch, int M, int N, int K) {
    const int total = nbatch * ((M + 63) / 64) * ((N + 63) / 64);
    const int grid = total < 4096 ? total : 4096;
    hipLaunchKernelGGL((gemm_kernel<GEMM_MFMA, AF, BF, EF>), dim3(grid), dim3(256), 0, s, A, B, E, nbatch, M, N, K);
}

struct A_bf16 { const bf16_t* p; long long ld; long long coff;
    __device__ float operator()(int, int m, int k) const { return bf2f(p[(size_t)m * ld + coff + k]); } };
struct A_bf16_scaled { const bf16_t* p; long long ld; long long coff; const float* rs; long long rsi; const float* w;
    __device__ float operator()(int, int m, int k) const { return bf2f(p[(size_t)m * ld + coff + k]) * rs[(size_t)m * 2 + rsi] * w[k]; } };
struct B_f32 { const float* p; long long ld; long long coff;
    __device__ float operator()(int, int k, int n) const { return p[(size_t)k * ld + coff + n]; } };
struct E_bf16 { bf16_t* p; long long ld; long long coff;
    __device__ void operator()(int, int m, int n, float v) const { p[(size_t)m * ld + coff + n] = f2bf(v); } };

__global__ void __launch_bounds__(256) k_mod(const float* c, const float* c_ctx, const float* ada_w, const float* ada_b, float* mod) {
    __shared__ float sl[9][1024];
    for (int e = threadIdx.x; e < 9 * 1024; e += 256) { const int j = e >> 10, k = e & 1023; const float v = j < 8 ? c[j * 1024 + k] : c_ctx[k]; sl[j][k] = siluf_(v); }
    __syncthreads();
    const int gi = blockIdx.x * 256 + threadIdx.x;
    if (gi >= 2 * 6144) return;
    const int l = gi / 6144, n = gi % 6144;
    float acc[9];
#pragma unroll
    for (int j = 0; j < 9; ++j) acc[j] = 0.f;
    const float* w = ada_w + (size_t)l * 1024 * 6144 + n;
    for (int k = 0; k < 1024; ++k) { const float wv = w[(size_t)k * 6144];
#pragma unroll
        for (int j = 0; j < 9; ++j) acc[j] += sl[j][k] * wv; }
    const float bb = ada_b[l * 6144 + n];
#pragma unroll
    for (int j = 0; j < 9; ++j) mod[((size_t)l * 9 + j) * 6144 + n] = acc[j] + bb;
}
__global__ void k_trig(float* trig) { const int i = blockIdx.x * 256 + threadIdx.x; if (i < 2048) { const double a = 2.0 * PI_D * i / 2048.0; trig[i] = (float)cos(a); trig[2048 + i] = (float)sin(a); } }

__global__ void k_s5_lp(int l, const float* lam_re, const float* lam_im, const float* log_step, const float* b_re, const float* b_im, double2* LP, double2* BB, float* lamT) {
    const int i = blockIdx.x * 256 + threadIdx.x;
    if (i >= 2 * 16 * 64) return;
    const int d = i / 1024, g = (i / 64) % 16, p = i % 64;
    const size_t li = ((size_t)(l * 2 + d) * 16 + g) * 64 + p;
    const double re = lam_re[li], im = lam_im[li], dt = exp((double)log_step[(l * 2 + d) * 16 + g]);
    for (int k = 0; k <= 64; ++k) { const double m = exp(re * dt * k), a = im * dt * k; LP[(size_t)i * 65 + k] = make_double2(m * cos(a), m * sin(a)); }
    const double m1 = exp(re * dt), lbr = m1 * cos(im * dt), lbi = m1 * sin(im * dt);
    const double nr = lbr - 1.0, ni = lbi, den = re * re + im * im;
    const double fr = (nr * re + ni * im) / den, fi = (ni * re - nr * im) / den;
    for (int h = 0; h < 16; ++h) { const double br = b_re[li * 16 + h], bi = b_im[li * 16 + h]; BB[(size_t)i * 16 + h] = make_double2(fr * br - fi * bi, fr * bi + fi * br); }
    const double2 lt = LP[(size_t)i * 65 + 64];
    lamT[((size_t)(g * 2 + d) * 64 + p) * 2 + 0] = (float)lt.x; lamT[((size_t)(g * 2 + d) * 64 + p) * 2 + 1] = (float)lt.y;
}
__global__ void k_s5_tz(int l, const double2* LP, const double2* BB, const float* c_re, const float* c_im, const float* s5_d, float* TZ) {
    const int i = blockIdx.x * 256 + threadIdx.x;
    if (i >= 16 * 127 * 256) return;
    const int g = i / (127 * 256), dd = (i / 256) % 127, hp = (i / 16) % 16, h = i % 16;
    const int delta = dd - 63;
    double acc = 0.0;
    for (int d = 0; d < 2; ++d) {
        if ((d == 0 && delta < 0) || (d == 1 && delta > 0)) continue;
        const int tau = delta < 0 ? -delta : delta;
        for (int p = 0; p < 64; ++p) {
            const size_t ci = (((size_t)(l * 2 + d) * 16 + g) * 16 + h) * 64 + p;
            const double cr = c_re[ci], cim = c_im[ci];
            const size_t gi = ((size_t)d * 16 + g) * 64 + p;
            const double2 lp = LP[gi * 65 + tau], bb = BB[gi * 16 + hp];
            const double xr = lp.x * bb.x - lp.y * bb.y, xi = lp.x * bb.y + lp.y * bb.x;
            acc += cr * xr - cim * xi;
        }
    }
    if (delta == 0 && h == hp) acc += (double)s5_d[l * 256 + g * 16 + h];
    TZ[i] = (float)acc;
}
__global__ void k_s5_ms(const double2* LP, const double2* BB, float* MS) {
    const int i = blockIdx.x * 256 + threadIdx.x;
    if (i >= 16 * 1024 * 128) return;
    const int g = i / (1024 * 128), sh = (i / 128) % 1024, dp = i % 128, d = dp / 64, p = dp % 64, s = sh / 16, hp = sh % 16;
    const size_t gi = ((size_t)d * 16 + g) * 64 + p;
    const double2 lp = LP[gi * 65 + (d == 0 ? 63 - s : s)], bb = BB[gi * 16 + hp];
    float* o = MS + ((size_t)g * 1024 + sh) * 256 + d * 128;
    o[p] = (float)(lp.x * bb.x - lp.y * bb.y); o[64 + p] = (float)(lp.x * bb.y + lp.y * bb.x);
}
__global__ void k_s5_qo(int l, const double2* LP, const float* c_re, const float* c_im, float* QO) {
    const int i = blockIdx.x * 256 + threadIdx.x;
    if (i >= 16 * 128 * 1024) return;
    const int g = i / (128 * 1024), dp = (i / 1024) % 128, th = i % 1024, d = dp / 64, p = dp % 64, t = th / 16, h = th % 16;
    const size_t ci = (((size_t)(l * 2 + d) * 16 + g) * 16 + h) * 64 + p;
    const double cr = c_re[ci], cim = c_im[ci];
    const double2 lp = LP[(((size_t)d * 16 + g) * 64 + p) * 65 + (d == 0 ? t + 1 : 64 - t)];
    float* o = QO + ((size_t)g * 256 + d * 128) * 1024 + th;
    o[(size_t)p * 1024] = (float)(cr * lp.x - cim * lp.y); o[(size_t)(64 + p) * 1024] = (float)(-(cr * lp.y + cim * lp.x));
}

__global__ void __launch_bounds__(256) k_adarms(const float* xlat, const float* xctx, const float* w, const float* mod  , int sh_chunk, int sc_chunk, bf16_t* out) {
    const int wave = (blockIdx.x * 256 + threadIdx.x) >> 6, lane = threadIdx.x & 63, nw = (gridDim.x * 256) >> 6;
    for (int row = wave; row < RT; row += nw) {
        const float* x = row < RL ? xlat + (size_t)row * DM : xctx + (size_t)(row - RL) * DM;
        float v[16]; float ss = 0.f;
#pragma unroll
        for (int j = 0; j < 4; ++j) { const f32x4 t = *(const f32x4*)(x + j * 256 + lane * 4); v[j * 4] = t[0]; v[j * 4 + 1] = t[1]; v[j * 4 + 2] = t[2]; v[j * 4 + 3] = t[3]; ss += t[0] * t[0] + t[1] * t[1] + t[2] * t[2] + t[3] * t[3]; }
#pragma unroll
        for (int o = 1; o < 64; o <<= 1) ss += __shfl_xor(ss, o);
        const float rstd = rsqrtf(ss * (1.f / DM) + EPS);
        const float* mrow = mod + (size_t)row_modidx(row) * 6144;
#pragma unroll
        for (int j = 0; j < 4; ++j)
#pragma unroll
            for (int q = 0; q < 4; ++q) { const int cidx = j * 256 + lane * 4 + q; const float y = v[j * 4 + q] * rstd * w[cidx] * (1.f + mrow[sc_chunk * 1024 + cidx]) + mrow[sh_chunk * 1024 + cidx]; out[(size_t)row * DM + cidx] = f2bf(y); }
    }
}
__global__ void __launch_bounds__(256) k_mla_stats(const bf16_t* Z, float* rs) {
    const int wave = (blockIdx.x * 256 + threadIdx.x) >> 6, lane = threadIdx.x & 63, nw = (gridDim.x * 256) >> 6;
    for (int row = wave; row < RT; row += nw) {
        const bf16_t* z = Z + (size_t)row * ZW; float sq = 0.f, sk = 0.f;
#pragma unroll
        for (int j = 0; j < 4; ++j) { const float v = bf2f(z[C_QC + j * 64 + lane]); sq += v * v; }
#pragma unroll
        for (int j = 0; j < 2; ++j) { const float v = bf2f(z[C_KVC + j * 64 + lane]); sk += v * v; }
#pragma unroll
        for (int o = 1; o < 64; o <<= 1) { sq += __shfl_xor(sq, o); sk += __shfl_xor(sk, o); }
        if (lane == 0) { rs[(size_t)row * 2] = rsqrtf(sq * (1.f / 256) + EPS); rs[(size_t)row * 2 + 1] = rsqrtf(sk * (1.f / 128) + EPS); }
    }
}
__global__ void __launch_bounds__(256) k_mla_post(const bf16_t* Z, const bf16_t* qraw, const bf16_t* kvraw, const float* qkq, const float* qkk, bf16_t* Q, bf16_t* Kb, bf16_t* Vb) {
    const int gi = blockIdx.x * 256 + threadIdx.x;
    if (gi >= RT * 4) return;
    const int row = gi >> 2, h = gi & 3;
    const bool lat = row < RL; const int b = row_batch(row), t = lat ? (row & 2047) : ((row - RL) & 255);
    const int qi = lat ? t : 2048 + t, ki = lat ? 256 + t : t;
    float q[96], k[96];
    float sq = 0.f, sk = 0.f;
#pragma unroll
    for (int i = 0; i < 96; ++i) { q[i] = bf2f(qraw[(size_t)row * 384 + h * 96 + i]); sq += q[i] * q[i]; }
#pragma unroll
    for (int i = 0; i < 64; ++i) { k[i] = bf2f(kvraw[(size_t)row * 512 + h * 128 + i]); }
#pragma unroll
    for (int i = 0; i < 32; ++i) { k[64 + i] = bf2f(Z[(size_t)row * ZW + C_KR + i]); }
#pragma unroll
    for (int i = 0; i < 96; ++i) sk += k[i] * k[i];
    const float rq = rsqrtf(sq * (1.f / 96) + EPS), rk = rsqrtf(sk * (1.f / 96) + EPS);
#pragma unroll
    for (int i = 0; i < 96; ++i) { q[i] = q[i] * rq * qkq[i]; k[i] = k[i] * rk * qkk[i]; }
    if (lat) {
        const float prow = (float)(t >> 6), pcol = (float)(t & 63);
#pragma unroll
        for (int part = 0; part < 2; ++part) { const float pos = part ? pcol : prow; const int base = 64 + part * 16;
#pragma unroll
            for (int j = 0; j < 8; ++j) { const float fr = exp2f(-(float)j * (13.287712379549449f / 8.f)), a = pos * fr, cs = __cosf(a), sn = __sinf(a);
                { const float x1 = q[base + j], x2 = q[base + 8 + j]; q[base + j] = x1 * cs - x2 * sn; q[base + 8 + j] = x1 * sn + x2 * cs; }
                { const float x1 = k[base + j], x2 = k[base + 8 + j]; k[base + j] = x1 * cs - x2 * sn; k[base + 8 + j] = x1 * sn + x2 * cs; } } }
    }
    bf16_t* qo = Q + ((size_t)(b * 4 + h) * 2304 + qi) * 96; bf16_t* ko = Kb + ((size_t)(b * 4 + h) * 2304 + ki) * 96; bf16_t* vo = Vb + ((size_t)(b * 4 + h) * 2304 + ki) * 64;
#pragma unroll
    for (int i = 0; i < 96; ++i) { qo[i] = f2bf(q[i]); ko[i] = f2bf(k[i]); }
    for (int i = 0; i < 64; ++i) vo[i] = kvraw[(size_t)row * 512 + h * 128 + 64 + i];
}
__global__ void __launch_bounds__(256) k_attn(const bf16_t* Q, const bf16_t* Kb, const bf16_t* Vb, bf16_t* Z  , int with_ctx) {
    __shared__ float sK[32][96]; __shared__ float sV[32][64];
    const int nunits = 32 * (8 + (with_ctx ? 1 : 0));
    for (int u = blockIdx.x; u < nunits; u += gridDim.x) {
        const int bh = u % 32, qb = u / 32;
        const int qi = qb * 256 + threadIdx.x, nkeys = qb < 8 ? 2304 : 256;
        float q[96], o[64];
        const bf16_t* qp = Q + ((size_t)bh * 2304 + qi) * 96;
#pragma unroll
        for (int i = 0; i < 96; ++i) q[i] = bf2f(qp[i]) * 0.10206207261596577f;
#pragma unroll
        for (int i = 0; i < 64; ++i) o[i] = 0.f;
        float mx = -1e30f, l = 0.f;
        for (int k0 = 0; k0 < nkeys; k0 += 32) {
            __syncthreads();
            for (int e = threadIdx.x; e < 32 * 96; e += 256) sK[e / 96][e % 96] = bf2f(Kb[((size_t)bh * 2304 + k0) * 96 + e]);
            for (int e = threadIdx.x; e < 32 * 64; e += 256) sV[e / 64][e % 64] = bf2f(Vb[((size_t)bh * 2304 + k0) * 64 + e]);
            __syncthreads();
#pragma unroll 2
            for (int j = 0; j < 32; ++j) { float a = 0.f;
#pragma unroll
                for (int i = 0; i < 96; ++i) a += q[i] * sK[j][i];
                if (a > mx) { const float corr = __expf(mx - a); mx = a; l *= corr;
#pragma unroll
                    for (int i = 0; i < 64; ++i) o[i] *= corr; }
                const float p = __expf(a - mx); l += p;
#pragma unroll
                for (int i = 0; i < 64; ++i) o[i] += p * sV[j][i]; }
        }
        const int b = bh >> 2, h = bh & 3;
        const int row = qb < 8 ? b * 2048 + qi : RL + b * 256 + (qi - 2048);
        const float inv = 1.f / l;
#pragma unroll
        for (int i = 0; i < 64; ++i) Z[(size_t)row * ZW + C_QC + h * 64 + i] = f2bf(o[i] * inv);
    }
}
__global__ void __launch_bounds__(256) k_f1(const bf16_t* Z, const float* trig, bf16_t* F1lat, bf16_t* F1ctx) {
    const int gi = blockIdx.x * 256 + threadIdx.x;
    if (gi >= RT * 256) return;
    const int row = gi >> 8, gm = gi & 255, g = gm >> 6, m = gm & 63;
    float a = 0.f, bsum = 0.f;
    const bf16_t* u = Z + (size_t)row * ZW + C_FU + g * 64;
    for (int c = 0; c < 64; ++c) { const float v = bf2f(u[c]); const int idx = ((m * c) & 63) * 32; a += v * trig[idx]; bsum += v * trig[2048 + idx]; }
    if (row < RL) { const int b = row >> 11, t = row & 2047; bf16_t* o = F1lat + ((size_t)(b * 256 + gm) * 2) * 2048; o[t] = f2bf(a); o[2048 + t] = f2bf(bsum); }
    else { const int r = row - RL, b = r >> 8, t = r & 255; bf16_t* o = F1ctx + ((size_t)(b * 256 + gm) * 2) * 256; o[t] = f2bf(a); o[256 + t] = f2bf(bsum); }
}
struct A_dft { const float* trig; long long L; long long mul;
    __device__ float operator()(int, int k, int kk) const { const int part = kk >= (int)L, t = part ? kk - (int)L : kk; const int idx = (int)(((long long)k * t) & (L - 1)) * (int)mul; return part ? -trig[2048 + idx] : trig[idx]; } };
struct B_f1t { const bf16_t* p; long long L;
    __device__ float operator()(int b, int kk, int n) const { return bf2f(p[((size_t)(b * 256 + n)) * 2 * L + kk]); } };
struct E_fourier { bf16_t* Z; long long rowbase; long long L; double scale;
    __device__ void operator()(int b, int m, int n, float v) const { Z[((size_t)rowbase + (size_t)b * L + m) * ZW + C_FU + n] = f2bf(v * (float)scale); } };

struct A_s5u { const bf16_t* Z;
    __device__ float operator()(int g, int rc, int k) const { return bf2f(Z[((size_t)rc * 64 + (k >> 4)) * ZW + C_S5 + g * 16 + (k & 15)]); } };
struct B_ms { const float* MS; __device__ float operator()(int g, int k, int n) const { return MS[((size_t)g * 1024 + k) * 256 + n]; } };
struct E_sloc { float* S; __device__ void operator()(int g, int rc, int n, float v) const { S[((size_t)rc * 16 + g) * 256 + n] = v; } };
__global__ void __launch_bounds__(256) k_s5_scan(const float* SLOC, const float* lamT, float* XP) {
    const int i = blockIdx.x * 256 + threadIdx.x;
    if (i >= 8 * 16 * 2 * 64) return;
    const int b = i / 2048, g = (i / 128) % 16, d = (i / 64) % 2, p = i % 64;
    const float lr = lamT[((size_t)(g * 2 + d) * 64 + p) * 2], li = lamT[((size_t)(g * 2 + d) * 64 + p) * 2 + 1];
    float xr = 0.f, xi = 0.f;
    for (int step = 0; step < 36; ++step) {
        int rc;
        if (d == 0) rc = step < 4 ? 256 + b * 4 + step : b * 32 + (step - 4);
        else rc = step < 4 ? 256 + b * 4 + (3 - step) : b * 32 + (31 - (step - 4));
        const size_t o = ((size_t)rc * 16 + g) * 256 + d * 128;
        XP[o + p] = xr; XP[o + 64 + p] = xi;
        const float sr = SLOC[o + p], si = SLOC[o + 64 + p];
        const float nr = lr * xr - li * xi + sr, ni = lr * xi + li * xr + si; xr = nr; xi = ni;
    }
}
struct A_s5out { const bf16_t* Z; const float* XP;
    __device__ float operator()(int g, int rc, int k) const { return k < 1024 ? bf2f(Z[((size_t)rc * 64 + (k >> 4)) * ZW + C_S5 + g * 16 + (k & 15)]) : XP[((size_t)rc * 16 + g) * 256 + (k - 1024)]; } };
struct B_s5out { const float* TZ; const float* QO;
    __device__ float operator()(int g, int k, int n) const { if (k < 1024) { const int s = k >> 4, hp = k & 15, t = n >> 4, h = n & 15; return TZ[(((size_t)g * 127 + (t - s + 63)) * 16 + hp) * 16 + h]; } return QO[((size_t)g * 256 + (k - 1024)) * 1024 + n]; } };
struct E_s5out { bf16_t* YG; __device__ void operator()(int g, int rc, int n, float v) const { YG[((size_t)rc * 64 + (n >> 4)) * 256 + g * 16 + (n & 15)] = f2bf(geluf_(v)); } };
__global__ void __launch_bounds__(256) k_glu(const bf16_t* GL, bf16_t* Z) {
    const int gi = blockIdx.x * 256 + threadIdx.x; if (gi >= RT * 256) return;
    const int row = gi >> 8, j = gi & 255;
    const float val = bf2f(GL[(size_t)row * 512 + j]), gate = bf2f(GL[(size_t)row * 512 + 256 + j]);
    Z[(size_t)row * ZW + C_S5 + j] = f2bf(val * sigmoidf_(gate));
}

__global__ void __launch_bounds__(256) k_ret_prep(bf16_t* Z) {
    const int gi = blockIdx.x * 256 + threadIdx.x; if (gi >= RT * 4 * 32) return;
    const int row = gi >> 7, h = (gi >> 5) & 3, j = gi & 31;
    bf16_t* z = Z + (size_t)row * ZW;
    if (row < RL) {
        const int t = row & 2047; const float fr = exp2f(-(float)j * (13.287712379549449f / 32.f)), a = (float)t * fr, cs = cosf(a), sn = sinf(a);
        { const float x1 = bf2f(z[C_RQ + h * 64 + j]), x2 = bf2f(z[C_RQ + h * 64 + 32 + j]); z[C_RQ + h * 64 + j] = f2bf(x1 * cs - x2 * sn); z[C_RQ + h * 64 + 32 + j] = f2bf(x1 * sn + x2 * cs); }
        { const float x1 = bf2f(z[C_RK + h * 64 + j]), x2 = bf2f(z[C_RK + h * 64 + 32 + j]); z[C_RK + h * 64 + j] = f2bf((x1 * cs - x2 * sn) * 0.125f); z[C_RK + h * 64 + 32 + j] = f2bf((x1 * sn + x2 * cs) * 0.125f); }
    } else {
        z[C_RK + h * 64 + j] = f2bf(bf2f(z[C_RK + h * 64 + j]) * 0.125f); z[C_RK + h * 64 + 32 + j] = f2bf(bf2f(z[C_RK + h * 64 + 32 + j]) * 0.125f);
    }
}
__global__ void __launch_bounds__(256) k_ret(bf16_t* Z, const float* decay_logit  , const float* gn_w  , int with_ctx) {
    __shared__ float sK[32][64]; __shared__ float sV[32][64];
    const int nunits = 32 * (8 + (with_ctx ? 1 : 0));
    for (int u = blockIdx.x; u < nunits; u += gridDim.x) {
        const int bh = u % 32, qb = u / 32, b = bh >> 2, h = bh & 3;
        const bool lat = qb < 8;
        const int qpos = lat ? qb * 256 + threadIdx.x : threadIdx.x;
        const int qrow = lat ? b * 2048 + qpos : RL + b * 256 + qpos;
        const float lgf = -log1pf(__expf(-decay_logit[h])) * 1.4426950408889634f, lgb = -log1pf(__expf(-decay_logit[4 + h])) * 1.4426950408889634f;
        float q[64], o[64];
#pragma unroll
        for (int i = 0; i < 64; ++i) { q[i] = bf2f(Z[(size_t)qrow * ZW + C_RQ + h * 64 + i]); o[i] = 0.f; }
        const int nkeys = lat ? 2560 : 256;
        for (int k0 = 0; k0 < nkeys; k0 += 32) {
            int krow0, kpos0;
            if (lat) { if (k0 < 256) { krow0 = RL + b * 256 + k0; kpos0 = k0 - 256; } else if (k0 < 2304) { krow0 = b * 2048 + (k0 - 256); kpos0 = k0 - 256; } else { krow0 = RL + b * 256 + (k0 - 2304); kpos0 = 2048 + (k0 - 2304); } }
            else { krow0 = RL + b * 256 + k0; kpos0 = k0; }
            __syncthreads();
            for (int e = threadIdx.x; e < 32 * 64; e += 256) { const int j = e >> 6, i = e & 63; sK[j][i] = bf2f(Z[(size_t)(krow0 + j) * ZW + C_RK + h * 64 + i]); sV[j][i] = bf2f(Z[(size_t)(krow0 + j) * ZW + C_RV + h * 64 + i]); }
            __syncthreads();
#pragma unroll 2
            for (int j = 0; j < 32; ++j) { float a = 0.f;
#pragma unroll
                for (int i = 0; i < 64; ++i) a += q[i] * sK[j][i];
                const int dpos = qpos - (kpos0 + j);
                const float dec = dpos > 0 ? exp2f(lgf * (float)dpos) : (dpos < 0 ? exp2f(lgb * (float)(-dpos)) : 2.f);
                a *= dec;
#pragma unroll
                for (int i = 0; i < 64; ++i) o[i] += a * sV[j][i]; }
        }
        __syncthreads();
        float mu = 0.f;
#pragma unroll
        for (int i = 0; i < 64; ++i) mu += o[i];
        mu *= (1.f / 64);
        float var = 0.f;
#pragma unroll
        for (int i = 0; i < 64; ++i) { const float d = o[i] - mu; var += d * d; }
        var *= (1.f / 64);
        const float rstd = rsqrtf(var + EPS);
#pragma unroll
        for (int i = 0; i < 64; ++i) { const float gte = bf2f(Z[(size_t)qrow * ZW + C_RG + h * 64 + i]); const float y = (o[i] - mu) * rstd * gn_w[h * 64 + i];
            Z[(size_t)qrow * ZW + C_RQ + h * 64 + i] = f2bf(siluf_(gte) * y); }
    }
}

struct E_merge { const bf16_t* stash; bf16_t* MMp; long long first;
    __device__ void operator()(int, int m, int n, float v) const { const size_t i = (size_t)m * DM + n; const float t = sigmoidf_(v) * bf2f(stash[i]); MMp[i] = f2bf(first ? t : bf2f(MMp[i]) + t); } };
struct E_resid { const float* xlat; const float* xctx; float* olat; float* octx; const float* mod; long long gchunk;
    __device__ void operator()(int, int m, int n, float v) const {
        const float g = mod[(size_t)row_modidx(m) * 6144 + gchunk * 1024 + n];
        if (m < RL) olat[(size_t)m * DM + n] = xlat[(size_t)m * DM + n] + g * v; else octx[(size_t)(m - RL) * DM + n] = xctx[(size_t)(m - RL) * DM + n] + g * v; } };
struct E_relu2 { bf16_t* H; __device__ void operator()(int, int m, int n, float v) const { const float r = fmaxf(v, 0.f); H[(size_t)m * DFF + n] = f2bf(r * r); } };

extern "C" void kernel_launch(void* const* d_in, const int* in_sizes, int n_in, void* d_out, int out_size, void* d_ws, size_t ws_size, hipStream_t stream) {
    if (n_in != 30 || ws_size < WS_END) { fprintf(stderr, "kernel_launch: unexpected n_in %d / ws_size %zu\n", n_in, ws_size); return; }
    const float* x = (const float*)d_in[0]; const float* c = (const float*)d_in[1]; const float* ctx = (const float*)d_in[2]; const float* c_ctx = (const float*)d_in[3];
    const float* ada_w = (const float*)d_in[4]; const float* ada_b = (const float*)d_in[5]; const float* norm_mix_w = (const float*)d_in[6]; const float* norm_ffn_w = (const float*)d_in[7];
    const float* w_in = (const float*)d_in[8]; const float* mla_q_norm = (const float*)d_in[9]; const float* mla_w_uq = (const float*)d_in[10]; const float* mla_kv_norm = (const float*)d_in[11];
    const float* mla_w_ukv = (const float*)d_in[12]; const float* qk_q = (const float*)d_in[13]; const float* qk_k = (const float*)d_in[14];
    const float* s5_lam_re = (const float*)d_in[15]; const float* s5_lam_im = (const float*)d_in[16]; const float* s5_log_step = (const float*)d_in[17];
    const float* s5_b_re = (const float*)d_in[18]; const float* s5_b_im = (const float*)d_in[19]; const float* s5_c_re = (const float*)d_in[20]; const float* s5_c_im = (const float*)d_in[21];
    const float* s5_d = (const float*)d_in[22]; const float* s5_w_glu = (const float*)d_in[23]; const float* ret_decay = (const float*)d_in[24]; const float* ret_gn_w = (const float*)d_in[25];
    const float* w_branch = (const float*)d_in[26]; const float* w_out = (const float*)d_in[27]; const float* ffn_w1 = (const float*)d_in[28]; const float* ffn_w2 = (const float*)d_in[29];
    char* ws = (char*)d_ws; float* out = (float*)d_out;
    float* MOD = (float*)(ws + WS_MOD); float* RS = (float*)(ws + WS_RS); float* TRIG = (float*)(ws + WS_TRIG); float* LAMT = (float*)(ws + WS_LAMT);
    double2* LP = (double2*)(ws + WS_LP); double2* BBt = (double2*)(ws + WS_BB);
    bf16_t* XN = (bf16_t*)(ws + WS_XN); bf16_t* Z = (bf16_t*)(ws + WS_Z);
    bf16_t* Q = (bf16_t*)(ws + WS_QKV); bf16_t* Kb = Q + (size_t)32 * 2304 * 96; bf16_t* Vb = Kb + (size_t)32 * 2304 * 96;
    bf16_t* F1lat = (bf16_t*)(ws + WS_F1); bf16_t* F1ctx = F1lat + (size_t)8 * 256 * 2 * 2048;
    float* TZ = (float*)(ws + WS_TZ); float* MS = (float*)(ws + WS_MS); float* QO = (float*)(ws + WS_QO); float* SLOC = (float*)(ws + WS_SLOC); float* XP = (float*)(ws + WS_XP);
    float* XC = (float*)(ws + WS_XC); bf16_t* QRAW = (bf16_t*)(ws + WS_RAW); bf16_t* KVRAW = QRAW + (size_t)RT * 384;
    bf16_t* YG = (bf16_t*)(ws + WS_YG); bf16_t* GL = (bf16_t*)(ws + WS_GL); bf16_t* STASH = (bf16_t*)(ws + WS_STASH); bf16_t* MM = (bf16_t*)(ws + WS_MM); bf16_t* H = (bf16_t*)(ws + WS_H);

    hipLaunchKernelGGL(k_mod, dim3(48), dim3(256), 0, stream, c, c_ctx, ada_w, ada_b, MOD);
    hipLaunchKernelGGL(k_trig, dim3(8), dim3(256), 0, stream, TRIG);

    for (int l = 0; l < DEPTH; ++l) {
        const float* modl = MOD + (size_t)l * 9 * 6144;
        const float* xlat = l == 0 ? x : out; const float* xctx = l == 0 ? ctx : XC;
        const float* win = w_in + (size_t)l * DM * INC;
        hipLaunchKernelGGL(k_s5_lp, dim3(8), dim3(256), 0, stream, l, s5_lam_re, s5_lam_im, s5_log_step, s5_b_re, s5_b_im, LP, BBt, LAMT);
        hipLaunchKernelGGL(k_s5_tz, dim3(16 * 127), dim3(256), 0, stream, l, LP, BBt, s5_c_re, s5_c_im, s5_d, TZ);
        hipLaunchKernelGGL(k_s5_ms, dim3(16 * 1024 * 128 / 256), dim3(256), 0, stream, LP, BBt, MS);
        hipLaunchKernelGGL(k_s5_qo, dim3(16 * 128 * 1024 / 256), dim3(256), 0, stream, l, LP, s5_c_re, s5_c_im, QO);
        hipLaunchKernelGGL(k_adarms, dim3(1024), dim3(256), 0, stream, xlat, xctx, norm_mix_w + l * DM, modl, 0, 1, XN);
        { A_bf16 A = zeroed<A_bf16>(); A.p = XN; A.ld = DM; A.coff = 0; B_f32 B = zeroed<B_f32>(); B.p = win; B.ld = INC; B.coff = 0; E_bf16 E = zeroed<E_bf16>(); E.p = Z; E.ld = ZW; E.coff = 0;
          launch_gemm(stream, A, B, E, 1, RT, C_GATE, DM); }
        hipLaunchKernelGGL(k_mla_stats, dim3(1024), dim3(256), 0, stream, Z, RS);
        { A_bf16_scaled A = zeroed<A_bf16_scaled>(); A.p = Z; A.ld = ZW; A.coff = C_QC; A.rs = RS; A.rsi = 0; A.w = mla_q_norm + l * 256;
          B_f32 B = zeroed<B_f32>(); B.p = mla_w_uq + (size_t)l * 256 * 384; B.ld = 384; B.coff = 0; E_bf16 E = zeroed<E_bf16>(); E.p = QRAW; E.ld = 384; E.coff = 0;
          launch_gemm(stream, A, B, E, 1, RT, 384, 256); }
        { A_bf16_scaled A = zeroed<A_bf16_scaled>(); A.p = Z; A.ld = ZW; A.coff = C_KVC; A.rs = RS; A.rsi = 1; A.w = mla_kv_norm + l * 128;
          B_f32 B = zeroed<B_f32>(); B.p = mla_w_ukv + (size_t)l * 128 * 512; B.ld = 512; B.coff = 0; E_bf16 E = zeroed<E_bf16>(); E.p = KVRAW; E.ld = 512; E.coff = 0;
          launch_gemm(stream, A, B, E, 1, RT, 512, 128); }
        hipLaunchKernelGGL(k_mla_post, dim3(RT * 4 / 256), dim3(256), 0, stream, Z, QRAW, KVRAW, qk_q + l * 96, qk_k + l * 96, Q, Kb, Vb);
        hipLaunchKernelGGL(k_attn, dim3(288), dim3(256), 0, stream, Q, Kb, Vb, Z, 1);
        hipLaunchKernelGGL(k_f1, dim3(RT), dim3(256), 0, stream, Z, TRIG, F1lat, F1ctx);
        { A_dft A = zeroed<A_dft>(); A.trig = TRIG; A.L = 2048; A.mul = 1; B_f1t B = zeroed<B_f1t>(); B.p = F1lat; B.L = 2048;
          E_fourier E = zeroed<E_fourier>(); E.Z = Z; E.rowbase = 0; E.L = 2048; E.scale = 1.0 / sqrt(2048.0 * 64.0);
          launch_gemm(stream, A, B, E, 8, 2048, 256, 4096); }
        { A_dft A = zeroed<A_dft>(); A.trig = TRIG; A.L = 256; A.mul = 8; B_f1t B = zeroed<B_f1t>(); B.p = F1ctx; B.L = 256;
          E_fourier E = zeroed<E_fourier>(); E.Z = Z; E.rowbase = RL; E.L = 256; E.scale = 1.0 / sqrt(256.0 * 64.0);
          launch_gemm(stream, A, B, E, 8, 256, 256, 512); }
        { A_s5u A = zeroed<A_s5u>(); A.Z = Z; B_ms B = zeroed<B_ms>(); B.MS = MS; E_sloc E = zeroed<E_sloc>(); E.S = SLOC; launch_gemm(stream, A, B, E, 16, NCH, 256, 1024); }
        hipLaunchKernelGGL(k_s5_scan, dim3(64), dim3(256), 0, stream, SLOC, LAMT, XP);
        { A_s5out A = zeroed<A_s5out>(); A.Z = Z; A.XP = XP; B_s5out B = zeroed<B_s5out>(); B.TZ = TZ; B.QO = QO; E_s5out E = zeroed<E_s5out>(); E.YG = YG; launch_gemm(stream, A, B, E, 16, NCH, 1024, 1280); }
        { A_bf16 A = zeroed<A_bf16>(); A.p = YG; A.ld = 256; A.coff = 0; B_f32 B = zeroed<B_f32>(); B.p = s5_w_glu + (size_t)l * 256 * 512; B.ld = 512; B.coff = 0; E_bf16 E = zeroed<E_bf16>(); E.p = GL; E.ld = 512; E.coff = 0;
          launch_gemm(stream, A, B, E, 1, RT, 512, 256); }
        hipLaunchKernelGGL(k_glu, dim3(RT), dim3(256), 0, stream, GL, Z);
        hipLaunchKernelGGL(k_ret_prep, dim3(RT * 128 / 256), dim3(256), 0, stream, Z);
        hipLaunchKernelGGL(k_ret, dim3(288), dim3(256), 0, stream, Z, ret_decay + l * 8, ret_gn_w + l * 256, 1);
        const int bcol[4] = {C_QC, C_FU, C_S5, C_RQ};
        for (int n = 0; n < 4; ++n) {
            { A_bf16 A = zeroed<A_bf16>(); A.p = Z; A.ld = ZW; A.coff = bcol[n]; B_f32 B = zeroed<B_f32>(); B.p = w_branch + ((size_t)l * 4 + n) * 256 * DM; B.ld = DM; B.coff = 0;
              E_bf16 E = zeroed<E_bf16>(); E.p = STASH; E.ld = DM; E.coff = 0; launch_gemm(stream, A, B, E, 1, RT, DM, 256); }
            { A_bf16 A = zeroed<A_bf16>(); A.p = XN; A.ld = DM; A.coff = 0; B_f32 B = zeroed<B_f32>(); B.p = win; B.ld = INC; B.coff = C_GATE + n * DM;
              E_merge E = zeroed<E_merge>(); E.stash = STASH; E.MMp = MM; E.first = (n == 0); launch_gemm(stream, A, B, E, 1, RT, DM, DM); }
        }
        { A_bf16 A = zeroed<A_bf16>(); A.p = MM; A.ld = DM; A.coff = 0; B_f32 B = zeroed<B_f32>(); B.p = w_out + (size_t)l * DM * DM; B.ld = DM; B.coff = 0;
          E_resid E = zeroed<E_resid>(); E.xlat = xlat; E.xctx = xctx; E.olat = out; E.octx = XC; E.mod = modl; E.gchunk = 2; launch_gemm(stream, A, B, E, 1, RT, DM, DM); }
        hipLaunchKernelGGL(k_adarms, dim3(1024), dim3(256), 0, stream, (const float*)out, (const float*)XC, norm_ffn_w + l * DM, modl, 3, 4, XN);
        { A_bf16 A = zeroed<A_bf16>(); A.p = XN; A.ld = DM; A.coff = 0; B_f32 B = zeroed<B_f32>(); B.p = ffn_w1 + (size_t)l * DM * DFF; B.ld = DFF; B.coff = 0; E_relu2 E = zeroed<E_relu2>(); E.H = H;
          launch_gemm(stream, A, B, E, 1, RT, DFF, DM); }
        { A_bf16 A = zeroed<A_bf16>(); A.p = H; A.ld = DFF; A.coff = 0; B_f32 B = zeroed<B_f32>(); B.p = ffn_w2 + (size_t)l * DFF * DM; B.ld = DM; B.coff = 0;
          E_resid E = zeroed<E_resid>(); E.xlat = out; E.xctx = XC; E.olat = out; E.octx = XC; E.mod = modl; E.gchunk = 5; launch_gemm(stream, A, B, E, 1, RT, DM, DFF); }
    }
}
```

```cpp
#include <hip/hip_runtime.h>
#include <cstdint>
#include <cstring>
#include <cstdio>

typedef unsigned short bf16_t;
typedef short bf16x8 __attribute__((ext_vector_type(8)));
typedef float f32x4 __attribute__((ext_vector_type(4)));

constexpr int DM = 1024, NB = 8, SEQ = 2048, CTX = 256, DEPTH = 2;
constexpr int RL = NB * SEQ;
constexpr int RC = NB * CTX;
constexpr int RT = RL + RC;
constexpr int INC = 6048;
constexpr int ZW = 2048;
constexpr int C_KVC = 0, C_KR = 128, C_S5 = 160, C_RK = 416, C_RV = 672, C_QC = 928, C_FU = 1184, C_RQ = 1440, C_RG = 1696, C_GATE = 1952;
constexpr int DFF = 4096;
constexpr int TCH = 64;
constexpr int NCH = RT / TCH;
constexpr float EPS = 1e-6f;
#define PI_D 3.14159265358979323846

__device__ __forceinline__ float bf2f(bf16_t v) { return __uint_as_float(((unsigned)v) << 16); }
__device__ __forceinline__ bf16_t f2bf(float f) { unsigned u = __float_as_uint(f); return (bf16_t)((u + 0x7fffu + ((u >> 16) & 1u)) >> 16); }
__device__ __forceinline__ float sigmoidf_(float x) { return 1.f / (1.f + __expf(-x)); }
__device__ __forceinline__ float siluf_(float x) { return x * sigmoidf_(x); }
__device__ __forceinline__ float geluf_(float x) { return 0.5f * x * (1.f + tanhf(0.7978845608028654f * (x + 0.044715f * x * x * x))); }
__device__ __forceinline__ int row_batch(int row) { return row < RL ? (row >> 11) : ((row - RL) >> 8); }
__device__ __forceinline__ int row_modidx(int row) { return row < RL ? (row >> 11) : 8; }

constexpr size_t MiB = 1ull << 20;
constexpr size_t WS_MOD = 0;
constexpr size_t WS_RS = 1 * MiB;
constexpr size_t WS_TRIG = WS_RS + 256 * 1024;
constexpr size_t WS_LAMT = WS_TRIG + 32 * 1024;
constexpr size_t WS_LP = 2 * MiB;
constexpr size_t WS_BB = 5 * MiB;
constexpr size_t WS_XN = 8 * MiB;
constexpr size_t WS_Z = 44 * MiB;
constexpr size_t WS_QKV = 116 * MiB;
constexpr size_t WS_F1 = 152 * MiB;
constexpr size_t WS_TZ = 170 * MiB;
constexpr size_t WS_MS = 172 * MiB;
constexpr size_t WS_QO = 188 * MiB;
constexpr size_t WS_SLOC = 204 * MiB;
constexpr size_t WS_XP = 209 * MiB;
constexpr size_t WS_XC = 214 * MiB;
constexpr size_t WS_RAW = 222 * MiB;
constexpr size_t WS_YG = WS_RAW;
constexpr size_t WS_GL = WS_RAW + 9 * MiB;
constexpr size_t WS_STASH = WS_QKV;
constexpr size_t WS_MM = WS_F1;
constexpr size_t WS_H = WS_Z;
constexpr size_t WS_END = 256 * MiB;


#define LAS __attribute__((address_space(3)))
#define NT 512
__device__ __forceinline__ int l_tid() { int t = threadIdx.x; asm volatile("" : "+v"(t)); return t; }
__device__ __forceinline__ int l_bid() { int b = blockIdx.x; asm volatile("" : "+s"(b)); return b; }
__device__ __forceinline__ int l_grid() { int g = gridDim.x; asm volatile("" : "+s"(g)); return g; }
#define PH_IDS const int tid_ = l_tid(), bid_ = l_bid(), G_ = l_grid(); (void)tid_; (void)bid_; (void)G_
template <class AF, class BF, class EF>
__device__ __forceinline__ void gemm_tile(const AF& A, const BF& B, const EF& E, bool valid, int b, int m0, int n0, int M, int N, int K, bf16_t (*sA)[40], bf16_t (*sB)[40], int ht) {
    f32x4 accm[2][2];
#pragma unroll
    for (int i = 0; i < 2; ++i)
#pragma unroll
        for (int j = 0; j < 2; ++j) accm[i][j] = (f32x4){0.f, 0.f, 0.f, 0.f};
    const int w = ht >> 6, lane = ht & 63, wm = (w >> 1) * 32, wn = (w & 1) * 32, fr = lane & 15, fq = lane >> 4;
    for (int k0 = 0; k0 < K; k0 += 32) {
        __syncthreads();
#pragma unroll
        for (int i = 0; i < 8; ++i) {
            const int e = ht + i * 256;
            { const int m = e >> 5, k = e & 31; float v = 0.f; if (valid && m0 + m < M && k0 + k < K) v = A(b, m0 + m, k0 + k); sA[m][k] = f2bf(v); }
            { const int k = e >> 6, n = e & 63; float v = 0.f; if (valid && n0 + n < N && k0 + k < K) v = B(b, k0 + k, n0 + n); sB[n][k] = f2bf(v); }
        }
        __syncthreads();
        bf16x8 af[2], bfr[2];
#pragma unroll
        for (int i = 0; i < 2; ++i) { af[i] = *(const bf16x8*)&sA[wm + i * 16 + fr][fq * 8]; bfr[i] = *(const bf16x8*)&sB[wn + i * 16 + fr][fq * 8]; }
#pragma unroll
        for (int i = 0; i < 2; ++i)
#pragma unroll
            for (int j = 0; j < 2; ++j) accm[i][j] = __builtin_amdgcn_mfma_f32_16x16x32_bf16(af[i], bfr[j], accm[i][j], 0, 0, 0);
    }
    if (valid) {
#pragma unroll
        for (int i = 0; i < 2; ++i)
#pragma unroll
            for (int j = 0; j < 2; ++j)
#pragma unroll
                for (int rr = 0; rr < 4; ++rr) {
                    const int m = m0 + wm + i * 16 + fq * 4 + rr, n = n0 + wn + j * 16 + fr;
                    if (m < M && n < N) E(b, m, n, accm[i][j][rr]);
                }
    }
}
template <class AF, class BF, class EF>
__device__ __forceinline__ void gemm_phase(unsigned char* lds, const AF& A, const BF& B, const EF& E, int nbatch, int M, int N, int K) {
    PH_IDS; const int tid = tid_, half = tid >> 8, ht = tid & 255;
    bf16_t (*sA)[40] = (bf16_t (*)[40])(lds + half * 10240);
    bf16_t (*sB)[40] = (bf16_t (*)[40])(lds + half * 10240 + 5120);
    const int tm = (M + 63) >> 6, tn = (N + 63) >> 6, total = nbatch * tm * tn;
    for (int it0 = bid_ * 2; it0 < total; it0 += G_ * 2) {
        const int it = it0 + half; const bool valid = it < total;
        const int itc = valid ? it : 0;
        const int b = itc / (tm * tn), r = itc % (tm * tn), m0 = (r / tn) * 64, n0 = (r % tn) * 64;
        gemm_tile(A, B, E, valid, b, m0, n0, M, N, K, sA, sB, ht);
    }
    __syncthreads();
}
template <class T> static T zeroed() { T t; memset((void*)&t, 0, sizeof(T)); return t; }

struct A_bf16 { const bf16_t* p; long long ld; long long coff;
    __device__ float operator()(int, int m, int k) const { return bf2f(p[(size_t)m * ld + coff + k]); } };
struct A_bf16_scaled { const bf16_t* p; long long ld; long long coff; const float* rs; long long rsi; const float* w;
    __device__ float operator()(int, int m, int k) const { return bf2f(p[(size_t)m * ld + coff + k]) * rs[(size_t)m * 2 + rsi] * w[k]; } };
struct B_f32 { const float* p; long long ld; long long coff;
    __device__ float operator()(int, int k, int n) const { return p[(size_t)k * ld + coff + n]; } };
struct E_bf16 { bf16_t* p; long long ld; long long coff;
    __device__ void operator()(int, int m, int n, float v) const { p[(size_t)m * ld + coff + n] = f2bf(v); } };

#define XB_TMO      128
#define XB_XCNT(j)  (256  + 64 * (j))
#define XB_XSUB(j)  (1280 + 64 * (j))
#define XB_XGEN(j)  (2304 + 64 * (j))
#define XB_TOP      3328
#define XB_TOPGEN   3392
#define XCD_BAR_WORDS 3456
#define XB_SPIN_CAP (1u << 18)
__device__ __forceinline__ unsigned xb_ld(unsigned* p)              { return __hip_atomic_load(p, __ATOMIC_RELAXED, __HIP_MEMORY_SCOPE_AGENT); }
__device__ __forceinline__ unsigned xb_add(unsigned* p, unsigned v) { return __hip_atomic_fetch_add(p, v, __ATOMIC_RELAXED, __HIP_MEMORY_SCOPE_AGENT); }
__device__ __forceinline__ unsigned xb_xcc_id() { return (unsigned)__builtin_amdgcn_s_getreg((3 << 11) | 20) & 0xFu; }
#define XB_SPIN(cond, bar) do { unsigned _sp = 0; while (cond) { __builtin_amdgcn_s_sleep(1); \
    if ((++_sp & 255u) == 0u) { if (xb_ld(&(bar)[XB_TMO])) break; if (_sp > XB_SPIN_CAP) { atomicAdd(&(bar)[XB_TMO], 1u); break; } } } } while (0)
struct XcdBarrier { unsigned* bar; unsigned x; volatile LAS unsigned* st; };
__device__ __forceinline__ XcdBarrier xcd_barrier_post(unsigned* bar, volatile LAS unsigned* st) {
    XcdBarrier b; b.bar = bar; b.x = xb_xcc_id(); b.st = st;
    if (threadIdx.x == 0) (void)xb_add(&bar[XB_XCNT(b.x)], 1u);
    return b;
}
__device__ __forceinline__ void xcd_barrier_complete(unsigned* bar, unsigned x, unsigned& nloc, unsigned& nx) {
    const unsigned G = gridDim.x * gridDim.y * gridDim.z;
    unsigned sum, cnt, mine, sp = 0u;
    for (;;) {
        sum = 0u; cnt = 0u; mine = 0u;
#pragma unroll
        for (unsigned j = 0; j < 16; ++j) { const unsigned c = xb_ld(&bar[XB_XCNT(j)]); sum += c; cnt += (c > 0u) ? 1u : 0u; mine = (j == x) ? c : mine; }
        if (sum == G) break;
        __builtin_amdgcn_s_sleep(1);
        if ((++sp & 255u) == 0u) { if (xb_ld(&bar[XB_TMO])) break; if (sp > XB_SPIN_CAP) { atomicAdd(&bar[XB_TMO], 1u); break; } }
    }
    nloc = mine > 0u ? mine : 1u; nx = cnt > 0u ? cnt : 1u;
}
__device__ __forceinline__ void xcd_barrier(const XcdBarrier& b) {
    asm volatile("s_waitcnt vmcnt(0)" ::: "memory");
    __syncthreads();
    if (threadIdx.x == 0) {
        unsigned* bar = b.bar;
        __builtin_amdgcn_s_waitcnt(0);
        unsigned nloc = b.st[0], nx = b.st[1];
        if (nloc == 0u) { xcd_barrier_complete(bar, b.x, nloc, nx); b.st[0] = nloc; b.st[1] = nx; }
        const unsigned old = xb_add(&bar[XB_XSUB(b.x)], 1u);
        const unsigned gen = old / nloc;
        if (old + 1u == (gen + 1u) * nloc) {
            __builtin_amdgcn_fence(__ATOMIC_RELEASE, "agent");
            asm volatile("s_waitcnt vmcnt(0)" ::: "memory");
            const unsigned og = xb_add(&bar[XB_TOP], 1u);
            const unsigned tg = og / nx;
            if (og + 1u == (tg + 1u) * nx) xb_add(&bar[XB_TOPGEN], 1u);
            else XB_SPIN(xb_ld(&bar[XB_TOPGEN]) == tg, bar);
            __builtin_amdgcn_fence(__ATOMIC_ACQUIRE, "agent");
            xb_add(&bar[XB_XGEN(b.x)], 1u);
            asm volatile("s_waitcnt vmcnt(0)" ::: "memory");
        } else {
            XB_SPIN(xb_ld(&bar[XB_XGEN(b.x)]) == gen, bar);
            __builtin_amdgcn_fence(__ATOMIC_ACQUIRE, "agent");
            asm volatile("s_waitcnt vmcnt(0)" ::: "memory");
        }
    }
    __syncthreads();
}

#define GSTRIDE(gi, total) for (int gi = bid_ * NT + tid_; gi < (total); gi += G_ * NT)
__device__ __forceinline__ void ph_mod(unsigned char* lds, const float* c, const float* c_ctx, const float* ada_w, const float* ada_b, float* mod) { PH_IDS;
    float (*sl)[1024] = (float (*)[1024])lds;
    for (int e = tid_; e < 9 * 1024; e += NT) { const int j = e >> 10, k = e & 1023; const float v = j < 8 ? c[j * 1024 + k] : c_ctx[k]; sl[j][k] = siluf_(v); }
    __syncthreads();
    GSTRIDE(gi, 2 * 6144) {
        const int l = gi / 6144, n = gi % 6144;
        float acc[9];
#pragma unroll
        for (int j = 0; j < 9; ++j) acc[j] = 0.f;
        const float* w = ada_w + (size_t)l * 1024 * 6144 + n;
        for (int k = 0; k < 1024; ++k) { const float wv = w[(size_t)k * 6144];
#pragma unroll
            for (int j = 0; j < 9; ++j) acc[j] += sl[j][k] * wv; }
        const float bb = ada_b[l * 6144 + n];
#pragma unroll
        for (int j = 0; j < 9; ++j) mod[((size_t)l * 9 + j) * 6144 + n] = acc[j] + bb;
    }
    __syncthreads();
}
__device__ __forceinline__ void ph_trig(float* trig) { PH_IDS; GSTRIDE(i, 2048) { const float xx = (float)i * (1.f / 1024.f); trig[i] = cospif(xx); trig[2048 + i] = sinpif(xx); } }
__device__ __forceinline__ double2 lam_pow(double re, double im, double dt, int k) {
    const double m = (double)__expf((float)(re * dt * k));
    double xx = im * dt * (double)k * 0.318309886183790671538;
    xx -= 2.0 * rint(xx * 0.5);
    const float xf = (float)xx;
    return make_double2(m * (double)cospif(xf), m * (double)sinpif(xf));
}
__device__ __forceinline__ void ph_s5_lp(int l, const float* lam_re, const float* lam_im, const float* log_step, const float* b_re, const float* b_im, double2* LP, double2* BB, float* lamT) { PH_IDS;
    GSTRIDE(i, 2 * 16 * 64) {
        const int d = i / 1024, g = (i / 64) % 16, p = i % 64;
        const size_t li = ((size_t)(l * 2 + d) * 16 + g) * 64 + p;
        const double re = lam_re[li], im = lam_im[li], dt = (double)expf(log_step[(l * 2 + d) * 16 + g]);
        for (int k = 0; k <= 64; ++k) LP[(size_t)i * 65 + k] = lam_pow(re, im, dt, k);
        const double2 l1 = lam_pow(re, im, dt, 1);
        const double nr = l1.x - 1.0, ni = l1.y, den = re * re + im * im;
        const double fr = (nr * re + ni * im) / den, fi = (ni * re - nr * im) / den;
        for (int h = 0; h < 16; ++h) { const double br = b_re[li * 16 + h], bi = b_im[li * 16 + h]; BB[(size_t)i * 16 + h] = make_double2(fr * br - fi * bi, fr * bi + fi * br); }
        const double2 l64 = lam_pow(re, im, dt, 64);
        lamT[((size_t)(g * 2 + d) * 64 + p) * 2 + 0] = (float)l64.x; lamT[((size_t)(g * 2 + d) * 64 + p) * 2 + 1] = (float)l64.y;
    }
}
__device__ __forceinline__ void ph_s5_tz(int l, const double2* LP, const double2* BB, const float* c_re, const float* c_im, const float* s5_d, float* TZ) { PH_IDS;
    GSTRIDE(i, 16 * 127 * 256) {
        const int g = i / (127 * 256), dd = (i / 256) % 127, hp = (i / 16) % 16, h = i % 16;
        const int delta = dd - 63;
        double acc = 0.0;
        for (int d = 0; d < 2; ++d) {
            if ((d == 0 && delta < 0) || (d == 1 && delta > 0)) continue;
            const int tau = delta < 0 ? -delta : delta;
            for (int p = 0; p < 64; ++p) {
                const size_t ci = (((size_t)(l * 2 + d) * 16 + g) * 16 + h) * 64 + p;
                const double cr = c_re[ci], cim = c_im[ci];
                const size_t gi = ((size_t)d * 16 + g) * 64 + p;
                const double2 lp = LP[gi * 65 + tau], bb = BB[gi * 16 + hp];
                const double xr = lp.x * bb.x - lp.y * bb.y, xi = lp.x * bb.y + lp.y * bb.x;
                acc += cr * xr - cim * xi;
            }
        }
        if (delta == 0 && h == hp) acc += (double)s5_d[l * 256 + g * 16 + h];
        TZ[i] = (float)acc;
    }
}
__device__ __forceinline__ void ph_s5_ms(const double2* LP, const double2* BB, float* MS) { PH_IDS;
    GSTRIDE(i, 16 * 1024 * 128) {
        const int g = i / (1024 * 128), sh = (i / 128) % 1024, dp = i % 128, d = dp / 64, p = dp % 64, s = sh / 16, hp = sh % 16;
        const size_t gi = ((size_t)d * 16 + g) * 64 + p;
        const double2 lp = LP[gi * 65 + (d == 0 ? 63 - s : s)], bb = BB[gi * 16 + hp];
        float* o = MS + ((size_t)g * 1024 + sh) * 256 + d * 128;
        o[p] = (float)(lp.x * bb.x - lp.y * bb.y); o[64 + p] = (float)(lp.x * bb.y + lp.y * bb.x);
    }
}
__device__ __forceinline__ void ph_s5_qo(int l, const double2* LP, const float* c_re, const float* c_im, float* QO) { PH_IDS;
    GSTRIDE(i, 16 * 128 * 1024) {
        const int g = i / (128 * 1024), dp = (i / 1024) % 128, th = i % 1024, d = dp / 64, p = dp % 64, t = th / 16, h = th % 16;
        const size_t ci = (((size_t)(l * 2 + d) * 16 + g) * 16 + h) * 64 + p;
        const double cr = c_re[ci], cim = c_im[ci];
        const double2 lp = LP[(((size_t)d * 16 + g) * 64 + p) * 65 + (d == 0 ? t + 1 : 64 - t)];
        float* o = QO + ((size_t)g * 256 + d * 128) * 1024 + th;
        o[(size_t)p * 1024] = (float)(cr * lp.x - cim * lp.y); o[(size_t)(64 + p) * 1024] = (float)(-(cr * lp.y + cim * lp.x));
    }
}
__device__ __forceinline__ void ph_adarms(const float* xlat, const float* xctx, const float* w, const float* mod, int sh_chunk, int sc_chunk, bf16_t* out) { PH_IDS;
    const int wave = (bid_ * NT + tid_) >> 6, lane = tid_ & 63, nw = (G_ * NT) >> 6;
    for (int row = wave; row < RT; row += nw) {
        const float* x = row < RL ? xlat + (size_t)row * DM : xctx + (size_t)(row - RL) * DM;
        float v[16]; float ss = 0.f;
#pragma unroll
        for (int j = 0; j < 4; ++j) { const f32x4 t = *(const f32x4*)(x + j * 256 + lane * 4); v[j * 4] = t[0]; v[j * 4 + 1] = t[1]; v[j * 4 + 2] = t[2]; v[j * 4 + 3] = t[3]; ss += t[0] * t[0] + t[1] * t[1] + t[2] * t[2] + t[3] * t[3]; }
#pragma unroll
        for (int o = 1; o < 64; o <<= 1) ss += __shfl_xor(ss, o);
        const float rstd = rsqrtf(ss * (1.f / DM) + EPS);
        const float* mrow = mod + (size_t)row_modidx(row) * 6144;
#pragma unroll
        for (int j = 0; j < 4; ++j)
#pragma unroll
            for (int q = 0; q < 4; ++q) { const int cidx = j * 256 + lane * 4 + q; const float y = v[j * 4 + q] * rstd * w[cidx] * (1.f + mrow[sc_chunk * 1024 + cidx]) + mrow[sh_chunk * 1024 + cidx]; out[(size_t)row * DM + cidx] = f2bf(y); }
    }
}
__device__ __forceinline__ void ph_mla_stats(const bf16_t* Z, float* rs) { PH_IDS;
    const int wave = (bid_ * NT + tid_) >> 6, lane = tid_ & 63, nw = (G_ * NT) >> 6;
    for (int row = wave; row < RT; row += nw) {
        const bf16_t* z = Z + (size_t)row * ZW; float sq = 0.f, sk = 0.f;
#pragma unroll
        for (int j = 0; j < 4; ++j) { const float v = bf2f(z[C_QC + j * 64 + lane]); sq += v * v; }
#pragma unroll
        for (int j = 0; j < 2; ++j) { const float v = bf2f(z[C_KVC + j * 64 + lane]); sk += v * v; }
#pragma unroll
        for (int o = 1; o < 64; o <<= 1) { sq += __shfl_xor(sq, o); sk += __shfl_xor(sk, o); }
        if (lane == 0) { rs[(size_t)row * 2] = rsqrtf(sq * (1.f / 256) + EPS); rs[(size_t)row * 2 + 1] = rsqrtf(sk * (1.f / 128) + EPS); }
    }
}
__device__ __forceinline__ void ph_mla_post(const bf16_t* Z, const bf16_t* qraw, const bf16_t* kvraw, const float* qkq, const float* qkk, bf16_t* Q, bf16_t* Kb, bf16_t* Vb) { PH_IDS;
    GSTRIDE(gi, RT * 8) {
        const int row = gi >> 3, h = (gi >> 1) & 3, isk = gi & 1;
        const bool lat = row < RL; const int b = row_batch(row), t = lat ? (row & 2047) : ((row - RL) & 255);
        const int qi = lat ? t : 2048 + t, ki = lat ? 256 + t : t;
        float v[96];
        float ss = 0.f;
        if (!isk) {
#pragma unroll
            for (int i = 0; i < 96; ++i) v[i] = bf2f(qraw[(size_t)row * 384 + h * 96 + i]);
        } else {
#pragma unroll
            for (int i = 0; i < 64; ++i) v[i] = bf2f(kvraw[(size_t)row * 512 + h * 128 + i]);
#pragma unroll
            for (int i = 0; i < 32; ++i) v[64 + i] = bf2f(Z[(size_t)row * ZW + C_KR + i]);
        }
#pragma unroll
        for (int i = 0; i < 96; ++i) ss += v[i] * v[i];
        const float rr = rsqrtf(ss * (1.f / 96) + EPS);
        const float* wv = isk ? qkk : qkq;
#pragma unroll
        for (int i = 0; i < 96; ++i) v[i] = v[i] * rr * wv[i];
        if (lat) {
            const float prow = (float)(t >> 6), pcol = (float)(t & 63);
#pragma unroll
            for (int part = 0; part < 2; ++part) { const float pos = part ? pcol : prow; const int base = 64 + part * 16;
#pragma unroll
                for (int j = 0; j < 8; ++j) { const float fr = exp2f(-(float)j * (13.287712379549449f / 8.f)), a = pos * fr, cs = __cosf(a), sn = __sinf(a);
                    const float x1 = v[base + j], x2 = v[base + 8 + j]; v[base + j] = x1 * cs - x2 * sn; v[base + 8 + j] = x1 * sn + x2 * cs; } }
        }
        bf16_t* o = isk ? Kb + ((size_t)(b * 4 + h) * 2304 + ki) * 96 : Q + ((size_t)(b * 4 + h) * 2304 + qi) * 96;
#pragma unroll
        for (int i = 0; i < 96; ++i) o[i] = f2bf(v[i]);
        if (isk) { bf16_t* vo = Vb + ((size_t)(b * 4 + h) * 2304 + ki) * 64; for (int i = 0; i < 64; ++i) vo[i] = kvraw[(size_t)row * 512 + h * 128 + 64 + i]; }
    }
}
__device__ __forceinline__ void ph_attn(unsigned char* lds, const bf16_t* Q, const bf16_t* Kb, const bf16_t* Vb, bf16_t* Z, int with_ctx) { PH_IDS;
    float (*sK)[96] = (float (*)[96])lds; float (*sV)[64] = (float (*)[64])(lds + 32 * 96 * 4);
    const int nunits = 32 * (8 + (with_ctx ? 1 : 0));
    const int qt = tid_ & 255, dh = (tid_ >> 8) * 32;
    for (int u = bid_; u < nunits; u += G_) {
        const int bh = u % 32, qb = u / 32;
        const bool lat = qb < 8;
        const int qi = qb * 256 + qt, nkeys = lat ? 2304 : 256;
        float q[96], o[32];
        const bf16_t* qp = Q + ((size_t)bh * 2304 + qi) * 96;
#pragma unroll
        for (int i = 0; i < 96; ++i) q[i] = bf2f(qp[i]) * 0.10206207261596577f;
#pragma unroll
        for (int i = 0; i < 32; ++i) o[i] = 0.f;
        float mx = -1e30f, l = 0.f;
        for (int k0 = 0; k0 < nkeys; k0 += 32) {
            __syncthreads();
            for (int e = tid_; e < 32 * 96; e += NT) sK[e / 96][e % 96] = bf2f(Kb[((size_t)bh * 2304 + k0) * 96 + e]);
            for (int e = tid_; e < 32 * 64; e += NT) sV[e / 64][e % 64] = bf2f(Vb[((size_t)bh * 2304 + k0) * 64 + e]);
            __syncthreads();
#pragma unroll 1
            for (int j = 0; j < 32; ++j) { float a = 0.f;
#pragma unroll
                for (int i = 0; i < 96; ++i) a += q[i] * sK[j][i];
                if (a > mx) { const float corr = __expf(mx - a); mx = a; l *= corr;
#pragma unroll
                    for (int i = 0; i < 32; ++i) o[i] *= corr; }
                const float p = __expf(a - mx); l += p;
#pragma unroll
                for (int i = 0; i < 32; ++i) o[i] += p * sV[j][dh + i]; }
        }
        const int b = bh >> 2, h = bh & 3;
        const int row = lat ? b * 2048 + qi : RL + b * 256 + (qi - 2048);
        const float inv = 1.f / l;
#pragma unroll
        for (int i = 0; i < 32; ++i) Z[(size_t)row * ZW + C_QC + h * 64 + dh + i] = f2bf(o[i] * inv);
    }
    __syncthreads();
}
__device__ __forceinline__ void ph_f1(const bf16_t* Z, const float* trig, bf16_t* F1lat, bf16_t* F1ctx) { PH_IDS;
    GSTRIDE(gi, RT * 256) {
        const int row = gi >> 8, gm = gi & 255, g = gm >> 6, m = gm & 63;
        float a = 0.f, bsum = 0.f;
        const bf16_t* u = Z + (size_t)row * ZW + C_FU + g * 64;
        for (int c = 0; c < 64; ++c) { const float v = bf2f(u[c]); const int idx = ((m * c) & 63) * 32; a += v * trig[idx]; bsum += v * trig[2048 + idx]; }
        if (row < RL) { const int b = row >> 11, t = row & 2047; bf16_t* o = F1lat + ((size_t)(b * 256 + gm) * 2) * 2048; o[t] = f2bf(a); o[2048 + t] = f2bf(bsum); }
        else { const int r = row - RL, b = r >> 8, t = r & 255; bf16_t* o = F1ctx + ((size_t)(b * 256 + gm) * 2) * 256; o[t] = f2bf(a); o[256 + t] = f2bf(bsum); }
    }
}
struct A_dft { const float* trig; long long L; long long mul;
    __device__ float operator()(int, int k, int kk) const { const int part = kk >= (int)L, t = part ? kk - (int)L : kk; const int idx = (int)(((long long)k * t) & (L - 1)) * (int)mul; return part ? -trig[2048 + idx] : trig[idx]; } };
struct B_f1t { const bf16_t* p; long long L;
    __device__ float operator()(int b, int kk, int n) const { return bf2f(p[((size_t)(b * 256 + n)) * 2 * L + kk]); } };
struct E_fourier { bf16_t* Z; long long rowbase; long long L; double scale;
    __device__ void operator()(int b, int m, int n, float v) const { Z[((size_t)rowbase + (size_t)b * L + m) * ZW + C_FU + n] = f2bf(v * (float)scale); } };

struct A_s5u { const bf16_t* Z;
    __device__ float operator()(int g, int rc, int k) const { return bf2f(Z[((size_t)rc * 64 + (k >> 4)) * ZW + C_S5 + g * 16 + (k & 15)]); } };
struct B_ms { const float* MS; __device__ float operator()(int g, int k, int n) const { return MS[((size_t)g * 1024 + k) * 256 + n]; } };
struct E_sloc { float* S; __device__ void operator()(int g, int rc, int n, float v) const { S[((size_t)rc * 16 + g) * 256 + n] = v; } };
__device__ __forceinline__ void ph_s5_scan(const float* SLOC, const float* lamT, float* XP) { PH_IDS;
    GSTRIDE(i, 8 * 16 * 2 * 64) {
        const int b = i / 2048, g = (i / 128) % 16, d = (i / 64) % 2, p = i % 64;
        const float lr = lamT[((size_t)(g * 2 + d) * 64 + p) * 2], li = lamT[((size_t)(g * 2 + d) * 64 + p) * 2 + 1];
        float xr = 0.f, xi = 0.f;
        for (int step = 0; step < 36; ++step) {
            int rc;
            if (d == 0) rc = step < 4 ? 256 + b * 4 + step : b * 32 + (step - 4);
            else rc = step < 4 ? 256 + b * 4 + (3 - step) : b * 32 + (31 - (step - 4));
            const size_t o = ((size_t)rc * 16 + g) * 256 + d * 128;
            XP[o + p] = xr; XP[o + 64 + p] = xi;
            const float sr = SLOC[o + p], si = SLOC[o + 64 + p];
            const float nr = lr * xr - li * xi + sr, ni = lr * xi + li * xr + si; xr = nr; xi = ni;
        }
    }
}
struct A_s5out { const bf16_t* Z; const float* XP;
    __device__ float operator()(int g, int rc, int k) const { return k < 1024 ? bf2f(Z[((size_t)rc * 64 + (k >> 4)) * ZW + C_S5 + g * 16 + (k & 15)]) : XP[((size_t)rc * 16 + g) * 256 + (k - 1024)]; } };
struct B_s5out { const float* TZ; const float* QO;
    __device__ float operator()(int g, int k, int n) const { if (k < 1024) { const int s = k >> 4, hp = k & 15, t = n >> 4, h = n & 15; return TZ[(((size_t)g * 127 + (t - s + 63)) * 16 + hp) * 16 + h]; } return QO[((size_t)g * 256 + (k - 1024)) * 1024 + n]; } };
struct E_s5out { bf16_t* YG; __device__ void operator()(int g, int rc, int n, float v) const { YG[((size_t)rc * 64 + (n >> 4)) * 256 + g * 16 + (n & 15)] = f2bf(geluf_(v)); } };
__device__ __forceinline__ void ph_glu(const bf16_t* GL, bf16_t* Z) { PH_IDS;
    GSTRIDE(gi, RT * 256) {
        const int row = gi >> 8, j = gi & 255;
        const float val = bf2f(GL[(size_t)row * 512 + j]), gate = bf2f(GL[(size_t)row * 512 + 256 + j]);
        Z[(size_t)row * ZW + C_S5 + j] = f2bf(val * sigmoidf_(gate));
    }
}
__device__ __forceinline__ void ph_ret_prep(bf16_t* Z) { PH_IDS;
    GSTRIDE(gi, RT * 4 * 32) {
        const int row = gi >> 7, h = (gi >> 5) & 3, j = gi & 31;
        bf16_t* z = Z + (size_t)row * ZW;
        if (row < RL) {
            const int t = row & 2047; const float fr = exp2f(-(float)j * (13.287712379549449f / 32.f)), a = (float)t * fr, cs = cosf(a), sn = sinf(a);
            { const float x1 = bf2f(z[C_RQ + h * 64 + j]), x2 = bf2f(z[C_RQ + h * 64 + 32 + j]); z[C_RQ + h * 64 + j] = f2bf(x1 * cs - x2 * sn); z[C_RQ + h * 64 + 32 + j] = f2bf(x1 * sn + x2 * cs); }
            { const float x1 = bf2f(z[C_RK + h * 64 + j]), x2 = bf2f(z[C_RK + h * 64 + 32 + j]); z[C_RK + h * 64 + j] = f2bf((x1 * cs - x2 * sn) * 0.125f); z[C_RK + h * 64 + 32 + j] = f2bf((x1 * sn + x2 * cs) * 0.125f); }
        } else {
            z[C_RK + h * 64 + j] = f2bf(bf2f(z[C_RK + h * 64 + j]) * 0.125f); z[C_RK + h * 64 + 32 + j] = f2bf(bf2f(z[C_RK + h * 64 + 32 + j]) * 0.125f);
        }
    }
}
__device__ __forceinline__ void ph_ret(unsigned char* lds, bf16_t* Z, const float* decay_logit, const float* gn_w, int with_ctx) { PH_IDS;
    float (*sK)[64] = (float (*)[64])lds; float (*sV)[64] = (float (*)[64])(lds + 32 * 64 * 4);
    float* sred = (float*)(lds + 2 * 32 * 64 * 4);
    const int nunits = 32 * (8 + (with_ctx ? 1 : 0));
    const int qt = tid_ & 255, hh = tid_ >> 8, dh = hh * 32;
    for (int u = bid_; u < nunits; u += G_) {
        const int bh = u % 32, qb = u / 32, b = bh >> 2, h = bh & 3;
        const bool lat = qb < 8;
        const int qpos = lat ? qb * 256 + qt : qt;
        const int qrow = lat ? b * 2048 + qpos : RL + b * 256 + qpos;
        const float lgf = -log1pf(__expf(-decay_logit[h])) * 1.4426950408889634f, lgb = -log1pf(__expf(-decay_logit[4 + h])) * 1.4426950408889634f;
        float q[64], o[32];
#pragma unroll
        for (int i = 0; i < 64; ++i) q[i] = bf2f(Z[(size_t)qrow * ZW + C_RQ + h * 64 + i]);
#pragma unroll
        for (int i = 0; i < 32; ++i) o[i] = 0.f;
        const int nkeys = lat ? 2560 : 256;
        for (int k0 = 0; k0 < nkeys; k0 += 32) {
            int krow0, kpos0;
            if (lat) { if (k0 < 256) { krow0 = RL + b * 256 + k0; kpos0 = k0 - 256; } else if (k0 < 2304) { krow0 = b * 2048 + (k0 - 256); kpos0 = k0 - 256; } else { krow0 = RL + b * 256 + (k0 - 2304); kpos0 = 2048 + (k0 - 2304); } }
            else { krow0 = RL + b * 256 + k0; kpos0 = k0; }
            __syncthreads();
            for (int e = tid_; e < 32 * 64; e += NT) { const int j = e >> 6, i = e & 63; sK[j][i] = bf2f(Z[(size_t)(krow0 + j) * ZW + C_RK + h * 64 + i]); sV[j][i] = bf2f(Z[(size_t)(krow0 + j) * ZW + C_RV + h * 64 + i]); }
            __syncthreads();
#pragma unroll 1
            for (int j = 0; j < 32; ++j) { float a = 0.f;
#pragma unroll
                for (int i = 0; i < 64; ++i) a += q[i] * sK[j][i];
                const int dpos = qpos - (kpos0 + j);
                const float dec = dpos > 0 ? exp2f(lgf * (float)dpos) : (dpos < 0 ? exp2f(lgb * (float)(-dpos)) : 2.f);
                a *= dec;
#pragma unroll
                for (int i = 0; i < 32; ++i) o[i] += a * sV[j][dh + i]; }
        }
        float s1 = 0.f;
#pragma unroll
        for (int i = 0; i < 32; ++i) s1 += o[i];
        __syncthreads();
        sred[hh * 256 + qt] = s1;
        __syncthreads();
        const float mu = (sred[qt] + sred[256 + qt]) * (1.f / 64);
        float s2 = 0.f;
#pragma unroll
        for (int i = 0; i < 32; ++i) { const float d = o[i] - mu; s2 += d * d; }
        __syncthreads();
        sred[hh * 256 + qt] = s2;
        __syncthreads();
        const float rstd = rsqrtf((sred[qt] + sred[256 + qt]) * (1.f / 64) + EPS);
#pragma unroll
        for (int i = 0; i < 32; ++i) { const float gte = bf2f(Z[(size_t)qrow * ZW + C_RG + h * 64 + dh + i]); const float y = (o[i] - mu) * rstd * gn_w[h * 64 + dh + i];
            Z[(size_t)qrow * ZW + C_RQ + h * 64 + dh + i] = f2bf(siluf_(gte) * y); }
    }
    __syncthreads();
}
struct E_merge { const bf16_t* stash; bf16_t* MMp; long long first;
    __device__ void operator()(int, int m, int n, float v) const { const size_t i = (size_t)m * DM + n; const float t = sigmoidf_(v) * bf2f(stash[i]); MMp[i] = f2bf(first ? t : bf2f(MMp[i]) + t); } };
struct E_resid { const float* xlat; const float* xctx; float* olat; float* octx; const float* mod; long long gchunk;
    __device__ void operator()(int, int m, int n, float v) const {
        const float g = mod[(size_t)row_modidx(m) * 6144 + gchunk * 1024 + n];
        if (m < RL) olat[(size_t)m * DM + n] = xlat[(size_t)m * DM + n] + g * v; else octx[(size_t)(m - RL) * DM + n] = xctx[(size_t)(m - RL) * DM + n] + g * v; } };
struct E_relu2 { bf16_t* H; __device__ void operator()(int, int m, int n, float v) const { const float r = fmaxf(v, 0.f); H[(size_t)m * DFF + n] = f2bf(r * r); } };

constexpr size_t WS_BAR = 7 * MiB;
constexpr int LDS_BYTES = 147456;
struct Args { const float* in[30]; float* out; unsigned char* ws; };
typedef const __attribute__((address_space(4))) Args* CArgs;
__device__ __forceinline__ CArgs kargs() { CArgs p = (CArgs)__builtin_amdgcn_kernarg_segment_ptr(); asm volatile("" : "+s"(p)); return p; }
#define IN(i) (kargs()->in[i])
#define WSB(T, off) ((T*)(kargs()->ws + (off)))
#define OUTP (kargs()->out)
enum { I_X = 0, I_C, I_CTX, I_CCTX, I_ADAW, I_ADAB, I_NMIX, I_NFFN, I_WIN, I_QNORM, I_WUQ, I_KVNORM, I_WUKV, I_QKQ, I_QKK, I_LRE, I_LIM, I_LSTEP, I_BRE, I_BIM, I_CRE, I_CIM, I_S5D, I_WGLU, I_RDEC, I_RGN, I_WBR, I_WOUT, I_W1, I_W2 };
__global__ void __launch_bounds__(NT, 2) mega(Args a_unused) {
    extern __shared__ __attribute__((aligned(16))) unsigned char lds[];
    volatile LAS unsigned* bst = (volatile LAS unsigned*)((LAS unsigned char*)lds + LDS_BYTES - 16);
    if (threadIdx.x < 4) bst[threadIdx.x] = 0u;
    __syncthreads();
    XcdBarrier bar = xcd_barrier_post(WSB(unsigned, WS_BAR), bst);
#define GRID_BAR() do { bar.bar = WSB(unsigned, WS_BAR); xcd_barrier(bar); } while (0)

    ph_mod(lds, IN(I_C), IN(I_CCTX), IN(I_ADAW), IN(I_ADAB), WSB(float, WS_MOD));
    ph_trig(WSB(float, WS_TRIG));
    GRID_BAR();
#pragma nounroll
    for (int l = 0; l < DEPTH; ++l) {
#define MODL (WSB(float, WS_MOD) + (size_t)l * 9 * 6144)
#define XLAT (l == 0 ? IN(I_X) : (const float*)OUTP)
#define XCTX (l == 0 ? IN(I_CTX) : (const float*)WSB(float, WS_XC))
#define WINL (IN(I_WIN) + (size_t)l * DM * INC)
#define ZP WSB(bf16_t, WS_Z)
#define XNP WSB(bf16_t, WS_XN)
#define QP WSB(bf16_t, WS_QKV)
#define KP (WSB(bf16_t, WS_QKV) + (size_t)32 * 2304 * 96)
#define VP (WSB(bf16_t, WS_QKV) + (size_t)2 * 32 * 2304 * 96)
#define F1LAT WSB(bf16_t, WS_F1)
#define F1CTX (WSB(bf16_t, WS_F1) + (size_t)8 * 256 * 2 * 2048)
#define QRAWP WSB(bf16_t, WS_RAW)
#define KVRAWP (WSB(bf16_t, WS_RAW) + (size_t)RT * 384)
        ph_s5_lp(l, IN(I_LRE), IN(I_LIM), IN(I_LSTEP), IN(I_BRE), IN(I_BIM), WSB(double2, WS_LP), WSB(double2, WS_BB), WSB(float, WS_LAMT));
        ph_adarms(XLAT, XCTX, IN(I_NMIX) + l * DM, MODL, 0, 1, XNP);
        GRID_BAR();
        ph_s5_tz(l, WSB(double2, WS_LP), WSB(double2, WS_BB), IN(I_CRE), IN(I_CIM), IN(I_S5D), WSB(float, WS_TZ));
        ph_s5_ms(WSB(double2, WS_LP), WSB(double2, WS_BB), WSB(float, WS_MS));
        ph_s5_qo(l, WSB(double2, WS_LP), IN(I_CRE), IN(I_CIM), WSB(float, WS_QO));
        { A_bf16 A; A.p = XNP; A.ld = DM; A.coff = 0; B_f32 B; B.p = WINL; B.ld = INC; B.coff = 0; E_bf16 E; E.p = ZP; E.ld = ZW; E.coff = 0;
          gemm_phase(lds, A, B, E, 1, RT, C_GATE, DM); }
        GRID_BAR();
        ph_mla_stats(ZP, WSB(float, WS_RS));
        ph_f1(ZP, WSB(float, WS_TRIG), F1LAT, F1CTX);
        ph_ret_prep(ZP);
        { A_s5u A; A.Z = ZP; B_ms B; B.MS = WSB(float, WS_MS); E_sloc E; E.S = WSB(float, WS_SLOC); gemm_phase(lds, A, B, E, 16, NCH, 256, 1024); }
        GRID_BAR();
        { A_bf16_scaled A; A.p = ZP; A.ld = ZW; A.coff = C_QC; A.rs = WSB(float, WS_RS); A.rsi = 0; A.w = IN(I_QNORM) + l * 256;
          B_f32 B; B.p = IN(I_WUQ) + (size_t)l * 256 * 384; B.ld = 384; B.coff = 0; E_bf16 E; E.p = QRAWP; E.ld = 384; E.coff = 0;
          gemm_phase(lds, A, B, E, 1, RT, 384, 256); }
        { A_bf16_scaled A; A.p = ZP; A.ld = ZW; A.coff = C_KVC; A.rs = WSB(float, WS_RS); A.rsi = 1; A.w = IN(I_KVNORM) + l * 128;
          B_f32 B; B.p = IN(I_WUKV) + (size_t)l * 128 * 512; B.ld = 512; B.coff = 0; E_bf16 E; E.p = KVRAWP; E.ld = 512; E.coff = 0;
          gemm_phase(lds, A, B, E, 1, RT, 512, 128); }
        ph_s5_scan(WSB(float, WS_SLOC), WSB(float, WS_LAMT), WSB(float, WS_XP));
        { A_dft A; A.trig = WSB(float, WS_TRIG); A.L = 2048; A.mul = 1; B_f1t B; B.p = F1LAT; B.L = 2048;
          E_fourier E; E.Z = ZP; E.rowbase = 0; E.L = 2048; E.scale = 1.0 / sqrt(2048.0 * 64.0);
          gemm_phase(lds, A, B, E, 8, 2048, 256, 4096); }
        { A_dft A; A.trig = WSB(float, WS_TRIG); A.L = 256; A.mul = 8; B_f1t B; B.p = F1CTX; B.L = 256;
          E_fourier E; E.Z = ZP; E.rowbase = RL; E.L = 256; E.scale = 1.0 / sqrt(256.0 * 64.0);
          gemm_phase(lds, A, B, E, 8, 256, 256, 512); }
        ph_ret(lds, ZP, IN(I_RDEC) + l * 8, IN(I_RGN) + l * 256, 1);
        GRID_BAR();
        ph_mla_post(ZP, QRAWP, KVRAWP, IN(I_QKQ) + l * 96, IN(I_QKK) + l * 96, QP, KP, VP);
        GRID_BAR();
        ph_attn(lds, QP, KP, VP, ZP, 1);
        { A_s5out A; A.Z = ZP; A.XP = WSB(float, WS_XP); B_s5out B; B.TZ = WSB(float, WS_TZ); B.QO = WSB(float, WS_QO); E_s5out E; E.YG = WSB(bf16_t, WS_YG); gemm_phase(lds, A, B, E, 16, NCH, 1024, 1280); }
        GRID_BAR();
        { A_bf16 A; A.p = WSB(bf16_t, WS_YG); A.ld = 256; A.coff = 0; B_f32 B; B.p = IN(I_WGLU) + (size_t)l * 256 * 512; B.ld = 512; B.coff = 0; E_bf16 E; E.p = WSB(bf16_t, WS_GL); E.ld = 512; E.coff = 0;
          gemm_phase(lds, A, B, E, 1, RT, 512, 256); }
        GRID_BAR();
        ph_glu(WSB(bf16_t, WS_GL), ZP);
        GRID_BAR();
        {
            PH_IDS; const int tid = tid_, half = tid >> 8, ht = tid & 255;
            bf16_t (*sA)[40] = (bf16_t (*)[40])(lds + half * 10240);
            bf16_t (*sB)[40] = (bf16_t (*)[40])(lds + half * 10240 + 5120);
            const int tm = RT / 64, tn = DM / 64, total = tm * tn;
            for (int it0 = bid_ * 2; it0 < total; it0 += G_ * 2) {
                const int it = it0 + half; const bool valid = it < total; const int itc = valid ? it : 0;
                const int m0 = (itc / tn) * 64, n0 = (itc % tn) * 64;
#pragma unroll 1
                for (int n = 0; n < 4; ++n) {
                    const int bcol = n == 0 ? C_QC : (n == 1 ? C_FU : (n == 2 ? C_S5 : C_RQ));
                    { A_bf16 A; A.p = ZP; A.ld = ZW; A.coff = bcol; B_f32 B; B.p = IN(I_WBR) + ((size_t)l * 4 + n) * 256 * DM; B.ld = DM; B.coff = 0;
                      E_bf16 E; E.p = WSB(bf16_t, WS_STASH); E.ld = DM; E.coff = 0; gemm_tile(A, B, E, valid, 0, m0, n0, RT, DM, 256, sA, sB, ht); }
                    { A_bf16 A; A.p = XNP; A.ld = DM; A.coff = 0; B_f32 B; B.p = WINL; B.ld = INC; B.coff = C_GATE + n * DM;
                      E_merge E; E.stash = WSB(bf16_t, WS_STASH); E.MMp = WSB(bf16_t, WS_MM); E.first = (n == 0); gemm_tile(A, B, E, valid, 0, m0, n0, RT, DM, DM, sA, sB, ht); }
                }
            }
            __syncthreads();
        }
        GRID_BAR();
        { A_bf16 A; A.p = WSB(bf16_t, WS_MM); A.ld = DM; A.coff = 0; B_f32 B; B.p = IN(I_WOUT) + (size_t)l * DM * DM; B.ld = DM; B.coff = 0;
          E_resid E; E.xlat = XLAT; E.xctx = XCTX; E.olat = OUTP; E.octx = WSB(float, WS_XC); E.mod = MODL; E.gchunk = 2; gemm_phase(lds, A, B, E, 1, RT, DM, DM); }
        GRID_BAR();
        ph_adarms(OUTP, WSB(float, WS_XC), IN(I_NFFN) + l * DM, MODL, 3, 4, XNP);
        GRID_BAR();
        { A_bf16 A; A.p = XNP; A.ld = DM; A.coff = 0; B_f32 B; B.p = IN(I_W1) + (size_t)l * DM * DFF; B.ld = DFF; B.coff = 0; E_relu2 E; E.H = WSB(bf16_t, WS_H);
          gemm_phase(lds, A, B, E, 1, RT, DFF, DM); }
        GRID_BAR();
        { A_bf16 A; A.p = WSB(bf16_t, WS_H); A.ld = DFF; A.coff = 0; B_f32 B; B.p = IN(I_W2) + (size_t)l * DFF * DM; B.ld = DM; B.coff = 0;
          E_resid E; E.xlat = OUTP; E.xctx = WSB(float, WS_XC); E.olat = OUTP; E.octx = WSB(float, WS_XC); E.mod = MODL; E.gchunk = 5; gemm_phase(lds, A, B, E, 1, RT, DM, DFF); }
        if (l + 1 < DEPTH) GRID_BAR();
    }
}

extern "C" void kernel_launch(void* const* d_in, const int* in_sizes, int n_in, void* d_out, int out_size, void* d_ws, size_t ws_size, hipStream_t stream) {
    static int grid = 0;
    if (grid == 0) {
        if (n_in != 30 || ws_size < WS_END) { fprintf(stderr, "kernel_launch: unexpected n_in %d / ws_size %zu\n", n_in, ws_size); grid = -1; return; }
        int dev = 0, cus = 0, per_cu = 0;
        if (hipGetDevice(&dev) != hipSuccess || hipDeviceGetAttribute(&cus, hipDeviceAttributeMultiprocessorCount, dev) != hipSuccess) { grid = -1; return; }
        if (hipFuncSetAttribute((const void*)mega, hipFuncAttributeMaxDynamicSharedMemorySize, LDS_BYTES) != hipSuccess) { fprintf(stderr, "kernel_launch: hipFuncSetAttribute failed\n"); grid = -1; return; }
        if (hipOccupancyMaxActiveBlocksPerMultiprocessor(&per_cu, (const void*)mega, NT, LDS_BYTES) != hipSuccess || per_cu < 1) fprintf(stderr, "kernel_launch: occupancy query says %d\n", per_cu);
        (void)hipGetLastError();
        grid = cus;
    }
    if (grid < 0) return;
    (void)hipMemsetAsync((char*)d_ws + WS_BAR, 0, XCD_BAR_WORDS * 4, stream);
    Args a; memset((void*)&a, 0, sizeof(a));
    for (int i = 0; i < 30; ++i) a.in[i] = (const float*)d_in[i];
    a.out = (float*)d_out; a.ws = (unsigned char*)d_ws;
    hipLaunchKernelGGL(mega, dim3(grid), dim3(NT), LDS_BYTES, stream, a);
}
```

```cpp
#include <hip/hip_runtime.h>
#include <cstdint>
#include <cstring>
#include <cstdio>

typedef unsigned short bf16_t;
typedef short bf16x8 __attribute__((ext_vector_type(8)));
typedef float f32x4 __attribute__((ext_vector_type(4)));

constexpr int DM = 1024, NB = 8, SEQ = 2048, CTX = 256, DEPTH = 2;
constexpr int RL = NB * SEQ;
constexpr int RC = NB * CTX;
constexpr int RT = RL + RC;
constexpr int INC = 6048;
constexpr int ZW = 2048;
constexpr int C_KVC = 0, C_KR = 128, C_S5 = 160, C_RK = 416, C_RV = 672, C_QC = 928, C_FU = 1184, C_RQ = 1440, C_RG = 1696, C_GATE = 1952;
constexpr int DFF = 4096;
constexpr int TCH = 64;
constexpr int NCH = RT / TCH;
constexpr float EPS = 1e-6f;
#define PI_D 3.14159265358979323846

__device__ __forceinline__ float bf2f(bf16_t v) { return __uint_as_float(((unsigned)v) << 16); }
__device__ __forceinline__ bf16_t f2bf(float f) { unsigned u = __float_as_uint(f); return (bf16_t)((u + 0x7fffu + ((u >> 16) & 1u)) >> 16); }
__device__ __forceinline__ float sigmoidf_(float x) { return 1.f / (1.f + __expf(-x)); }
__device__ __forceinline__ float siluf_(float x) { return x * sigmoidf_(x); }
__device__ __forceinline__ float geluf_(float x) { return 0.5f * x * (1.f + tanhf(0.7978845608028654f * (x + 0.044715f * x * x * x))); }
__device__ __forceinline__ int row_batch(int row) { return row < RL ? (row >> 11) : ((row - RL) >> 8); }
__device__ __forceinline__ int row_modidx(int row) { return row < RL ? (row >> 11) : 8; }

constexpr size_t MiB = 1ull << 20;
constexpr size_t WS_MOD = 0;
constexpr size_t WS_RS = 1 * MiB;
constexpr size_t WS_TRIG = WS_RS + 256 * 1024;
constexpr size_t WS_LAMT = WS_TRIG + 32 * 1024;
constexpr size_t WS_LP = 2 * MiB;
constexpr size_t WS_BB = 5 * MiB;
constexpr size_t WS_W = 8 * MiB;
constexpr size_t WS_WIN = WS_W, WS_W1 = WS_W + 12 * MiB, WS_W2 = WS_W + 20 * MiB, WS_WOUT = WS_W + 28 * MiB, WS_WBR = WS_W + 30 * MiB;
constexpr size_t WS_XN = 40 * MiB;
constexpr size_t WS_RAW = WS_XN;
constexpr size_t WS_YG = WS_XN;
constexpr size_t WS_Z = 76 * MiB;
constexpr size_t WS_QKV = 148 * MiB;
constexpr size_t WS_F1 = 184 * MiB;
constexpr size_t WS_GL = WS_F1;
constexpr size_t WS_TZ = 202 * MiB;
constexpr size_t WS_MS = 204 * MiB;
constexpr size_t WS_QO = 212 * MiB;
constexpr size_t WS_SLOC = 220 * MiB;
constexpr size_t WS_XP = 225 * MiB;
constexpr size_t WS_XC = 230 * MiB;
constexpr size_t WS_MM = WS_QKV;
constexpr size_t WS_STASH = WS_F1;
constexpr size_t WS_H = WS_Z;
constexpr size_t WS_END = 256 * MiB;


#define LAS __attribute__((address_space(3)))
#define NT 512
__device__ __forceinline__ int l_tid() { int t = threadIdx.x; asm volatile("" : "+v"(t)); return t; }
__device__ __forceinline__ int l_bid() { int b = blockIdx.x; asm volatile("" : "+s"(b)); return b; }
__device__ __forceinline__ int l_grid() { int g = gridDim.x; asm volatile("" : "+s"(g)); return g; }
#define PH_IDS const int tid_ = l_tid(), bid_ = l_bid(), G_ = l_grid(); (void)tid_; (void)bid_; (void)G_
template <class AF, class BF, class EF>
__device__ __forceinline__ void gemm_tile(const AF& A, const BF& B, const EF& E, bool valid, int b, int m0, int n0, int M, int N, int K, bf16_t (*sA)[40], bf16_t (*sB)[40], int ht) {
    f32x4 accm[2][2];
#pragma unroll
    for (int i = 0; i < 2; ++i)
#pragma unroll
        for (int j = 0; j < 2; ++j) accm[i][j] = (f32x4){0.f, 0.f, 0.f, 0.f};
    const int w = ht >> 6, lane = ht & 63, wm = (w >> 1) * 32, wn = (w & 1) * 32, fr = lane & 15, fq = lane >> 4;
    for (int k0 = 0; k0 < K; k0 += 32) {
        __syncthreads();
#pragma unroll
        for (int i = 0; i < 8; ++i) {
            const int e = ht + i * 256;
            { const int m = e >> 5, k = e & 31; float v = 0.f; if (valid && m0 + m < M && k0 + k < K) v = A(b, m0 + m, k0 + k); sA[m][k] = f2bf(v); }
            { const int k = e >> 6, n = e & 63; float v = 0.f; if (valid && n0 + n < N && k0 + k < K) v = B(b, k0 + k, n0 + n); sB[n][k] = f2bf(v); }
        }
        __syncthreads();
        bf16x8 af[2], bfr[2];
#pragma unroll
        for (int i = 0; i < 2; ++i) { af[i] = *(const bf16x8*)&sA[wm + i * 16 + fr][fq * 8]; bfr[i] = *(const bf16x8*)&sB[wn + i * 16 + fr][fq * 8]; }
#pragma unroll
        for (int i = 0; i < 2; ++i)
#pragma unroll
            for (int j = 0; j < 2; ++j) accm[i][j] = __builtin_amdgcn_mfma_f32_16x16x32_bf16(af[i], bfr[j], accm[i][j], 0, 0, 0);
    }
    if (valid) {
#pragma unroll
        for (int i = 0; i < 2; ++i)
#pragma unroll
            for (int j = 0; j < 2; ++j)
#pragma unroll
                for (int rr = 0; rr < 4; ++rr) {
                    const int m = m0 + wm + i * 16 + fq * 4 + rr, n = n0 + wn + j * 16 + fr;
                    if (m < M && n < N) E(b, m, n, accm[i][j][rr]);
                }
    }
}
template <class AF, class BF, class EF>
__device__ __forceinline__ void gemm_phase(unsigned char* lds, const AF& A, const BF& B, const EF& E, int nbatch, int M, int N, int K) {
    PH_IDS; const int tid = tid_, half = tid >> 8, ht = tid & 255;
    bf16_t (*sA)[40] = (bf16_t (*)[40])(lds + half * 10240);
    bf16_t (*sB)[40] = (bf16_t (*)[40])(lds + half * 10240 + 5120);
    const int tm = (M + 63) >> 6, tn = (N + 63) >> 6, total = nbatch * tm * tn;
    for (int it0 = bid_ * 2; it0 < total; it0 += G_ * 2) {
        const int it = it0 + half; const bool valid = it < total;
        const int itc = valid ? it : 0;
        const int b = itc / (tm * tn), r = itc % (tm * tn), m0 = (r / tn) * 64, n0 = (r % tn) * 64;
        gemm_tile(A, B, E, valid, b, m0, n0, M, N, K, sA, sB, ht);
    }
    __syncthreads();
}
template <class T> static T zeroed() { T t; memset((void*)&t, 0, sizeof(T)); return t; }

struct A_bf16 { const bf16_t* p; long long ld; long long coff;
    __device__ float operator()(int, int m, int k) const { return bf2f(p[(size_t)m * ld + coff + k]); } };
struct A_bf16_scaled { const bf16_t* p; long long ld; long long coff; const float* rs; long long rsi; const float* w;
    __device__ float operator()(int, int m, int k) const { return bf2f(p[(size_t)m * ld + coff + k]) * rs[(size_t)m * 2 + rsi] * w[k]; } };
struct B_f32 { const float* p; long long ld; long long coff;
    __device__ float operator()(int, int k, int n) const { return p[(size_t)k * ld + coff + n]; } };
struct E_bf16 { bf16_t* p; long long ld; long long coff;
    __device__ void operator()(int, int m, int n, float v) const { p[(size_t)m * ld + coff + n] = f2bf(v); } };

#define XB_TMO      128
#define XB_XCNT(j)  (256  + 64 * (j))
#define XB_XSUB(j)  (1280 + 64 * (j))
#define XB_XGEN(j)  (2304 + 64 * (j))
#define XB_TOP      3328
#define XB_TOPGEN   3392
#define XCD_BAR_WORDS 3456
#define XB_SPIN_CAP (1u << 18)
__device__ __forceinline__ unsigned xb_ld(unsigned* p)              { return __hip_atomic_load(p, __ATOMIC_RELAXED, __HIP_MEMORY_SCOPE_AGENT); }
__device__ __forceinline__ unsigned xb_add(unsigned* p, unsigned v) { return __hip_atomic_fetch_add(p, v, __ATOMIC_RELAXED, __HIP_MEMORY_SCOPE_AGENT); }
__device__ __forceinline__ unsigned xb_xcc_id() { return (unsigned)__builtin_amdgcn_s_getreg((3 << 11) | 20) & 0xFu; }
#define XB_SPIN(cond, bar) do { unsigned _sp = 0; while (cond) { __builtin_amdgcn_s_sleep(1); \
    if ((++_sp & 255u) == 0u) { if (xb_ld(&(bar)[XB_TMO])) break; if (_sp > XB_SPIN_CAP) { atomicAdd(&(bar)[XB_TMO], 1u); break; } } } } while (0)
struct XcdBarrier { unsigned* bar; unsigned x; volatile LAS unsigned* st; };
__device__ __forceinline__ XcdBarrier xcd_barrier_post(unsigned* bar, volatile LAS unsigned* st) {
    XcdBarrier b; b.bar = bar; b.x = xb_xcc_id(); b.st = st;
    if (threadIdx.x == 0) (void)xb_add(&bar[XB_XCNT(b.x)], 1u);
    return b;
}
__device__ __forceinline__ void xcd_barrier_complete(unsigned* bar, unsigned x, unsigned& nloc, unsigned& nx) {
    const unsigned G = gridDim.x * gridDim.y * gridDim.z;
    unsigned sum, cnt, mine, sp = 0u;
    for (;;) {
        sum = 0u; cnt = 0u; mine = 0u;
#pragma unroll
        for (unsigned j = 0; j < 16; ++j) { const unsigned c = xb_ld(&bar[XB_XCNT(j)]); sum += c; cnt += (c > 0u) ? 1u : 0u; mine = (j == x) ? c : mine; }
        if (sum == G) break;
        __builtin_amdgcn_s_sleep(1);
        if ((++sp & 255u) == 0u) { if (xb_ld(&bar[XB_TMO])) break; if (sp > XB_SPIN_CAP) { atomicAdd(&bar[XB_TMO], 1u); break; } }
    }
    nloc = mine > 0u ? mine : 1u; nx = cnt > 0u ? cnt : 1u;
}
__device__ __forceinline__ void xcd_barrier(const XcdBarrier& b) {
    asm volatile("s_waitcnt vmcnt(0)" ::: "memory");
    __syncthreads();
    if (threadIdx.x == 0) {
        unsigned* bar = b.bar;
        __builtin_amdgcn_s_waitcnt(0);
        unsigned nloc = b.st[0], nx = b.st[1];
        if (nloc == 0u) { xcd_barrier_complete(bar, b.x, nloc, nx); b.st[0] = nloc; b.st[1] = nx; }
        const unsigned old = xb_add(&bar[XB_XSUB(b.x)], 1u);
        const unsigned gen = old / nloc;
        if (old + 1u == (gen + 1u) * nloc) {
            __builtin_amdgcn_fence(__ATOMIC_RELEASE, "agent");
            asm volatile("s_waitcnt vmcnt(0)" ::: "memory");
            const unsigned og = xb_add(&bar[XB_TOP], 1u);
            const unsigned tg = og / nx;
            if (og + 1u == (tg + 1u) * nx) xb_add(&bar[XB_TOPGEN], 1u);
            else XB_SPIN(xb_ld(&bar[XB_TOPGEN]) == tg, bar);
            __builtin_amdgcn_fence(__ATOMIC_ACQUIRE, "agent");
            xb_add(&bar[XB_XGEN(b.x)], 1u);
            asm volatile("s_waitcnt vmcnt(0)" ::: "memory");
        } else {
            XB_SPIN(xb_ld(&bar[XB_XGEN(b.x)]) == gen, bar);
            __builtin_amdgcn_fence(__ATOMIC_ACQUIRE, "agent");
            asm volatile("s_waitcnt vmcnt(0)" ::: "memory");
        }
    }
    __syncthreads();
}

namespace pg8 {
typedef unsigned u32x4 __attribute__((ext_vector_type(4)));
constexpr int BM = 256, BK = 64, HALF = 128, HTB = HALF * BK * 2, STAGE_BYTES = 8 * HTB, NXCD = 8, WGM = 8;
__device__ __forceinline__ int lds_byte(int r, int c) { const int st = (r >> 4) * 2 + (c >> 5), rr = r & 15, cc = c & 31, ob = rr * 64 + cc * 2; return st * 1024 + (ob ^ (((ob >> 9) & 1) << 5)); }
__device__ __forceinline__ void stage_rc(int b, int& R, int& C) { const int st = b / 1024, sb = b % 1024, swz = sb ^ (((sb >> 9) & 1) << 5); R = (st >> 1) * 16 + swz / 64; C = (st & 1) * 32 + (swz % 64) / 2; }
__device__ __forceinline__ int perm32(int rho) { const int n = rho >> 4, i = rho & 15; return 8 * (i >> 2) + 4 * n + (i & 3); }
struct Unit { const char* A; const char* B; unsigned lda, ldb; int nt, pm, pn, kind, aux; };
__device__ __forceinline__ unsigned cvt_pk_bf16(float lo, float hi) { unsigned r; asm volatile("v_cvt_pk_bf16_f32 %0, %1, %2" : "=v"(r) : "v"(lo), "v"(hi)); return r; }
__device__ __forceinline__ bool static_tile(int nM, int nN, int G, int c, int i, int& pm, int& pn) {
    const int nwg = nM * nN; const long L = (long)i * G + c; if (L >= nwg) return false;
    int wgid = (int)L; { const int q = nwg / NXCD, r = nwg % NXCD, xcd = wgid % NXCD, off = wgid / NXCD; wgid = (xcd < r ? xcd * (q + 1) : r * (q + 1) + (xcd - r) * q) + off; }
    const int nig = WGM * nN, gid = wgid / nig, fm = gid * WGM, gsz = (nM - fm) < WGM ? (nM - fm) : WGM;
    pm = fm + ((wgid % nig) % gsz); pn = (wgid % nig) / gsz; return true;
}
template <class Epi, class Sched>
__device__ __forceinline__ void gemm_phase(LAS unsigned char* lds, const Sched& S, const Epi& E) {
    const int tid = l_tid(), wid = __builtin_amdgcn_readfirstlane(tid >> 6), lane = tid & 63, wr = wid >> 2, wc = wid & 3, fr = lane & 15, fq = lane >> 4;
    int sR[2], sRb[2], sC2[2];
#pragma unroll
    for (int i = 0; i < 2; ++i) { int R, C; stage_rc(tid * 16 + i * 8192, R, C); sR[i] = R; sRb[i] = (R & ~31) + perm32(R & 31); sC2[i] = C * 2; }
    const size_t kstep = (size_t)(BK * 2);
    const unsigned ldsw = (unsigned)wid * 1024u;
    const int aoff = lds_byte(wr * 64 + fr, fq * 8), boff = lds_byte(wc * 32 + fr, fq * 8);
#define PG8_SA(b, h) (((b) * 2 + (h)) * HTB)
#define PG8_SB(b, h) ((4 + (b) * 2 + (h)) * HTB)
#define PG8_STAGE_A(bufoff, gbase, ld) do { \
        __builtin_amdgcn_global_load_lds((const unsigned*)((const char*)(gbase) + (unsigned)(sR[0] * (ld) + sC2[0])), (LAS unsigned*)(lds + (bufoff) + ldsw), 16, 0, 0); \
        __builtin_amdgcn_global_load_lds((const unsigned*)((const char*)(gbase) + (unsigned)(sR[1] * (ld) + sC2[1])), (LAS unsigned*)(lds + (bufoff) + ldsw + 8192), 16, 0, 0); } while (0)
#define PG8_STAGE_B(bufoff, gbase, ld) do { \
        __builtin_amdgcn_global_load_lds((const unsigned*)((const char*)(gbase) + (unsigned)(sRb[0] * (ld) + sC2[0])), (LAS unsigned*)(lds + (bufoff) + ldsw), 16, 0, 0); \
        __builtin_amdgcn_global_load_lds((const unsigned*)((const char*)(gbase) + (unsigned)(sRb[1] * (ld) + sC2[1])), (LAS unsigned*)(lds + (bufoff) + ldsw + 8192), 16, 0, 0); } while (0)
#define PG8_LDA(dst, b, h) do { _Pragma("unroll") for (int m = 0; m < 4; ++m) _Pragma("unroll") for (int k = 0; k < 2; ++k) dst[m][k] = *(const LAS bf16x8*)(lds + PG8_SA(b, h) + aoff + m * 2048 + k * 1024); } while (0)
#define PG8_LDB(dst, b, h) do { _Pragma("unroll") for (int n = 0; n < 2; ++n) _Pragma("unroll") for (int k = 0; k < 2; ++k) dst[n][k] = *(const LAS bf16x8*)(lds + PG8_SB(b, h) + boff + n * 2048 + k * 1024); } while (0)
#define PG8_MMA(ai, bj, At, Bt) do { __builtin_amdgcn_s_setprio(1); _Pragma("unroll") for (int m = 0; m < 4; ++m) _Pragma("unroll") for (int n = 0; n < 2; ++n) _Pragma("unroll") for (int k = 0; k < 2; ++k) \
        acc[ai][bj][m][n] = __builtin_amdgcn_mfma_f32_16x16x32_bf16(Bt[n][k], At[m][k], acc[ai][bj][m][n], 0, 0, 0); __builtin_amdgcn_s_setprio(0); } while (0)
#define PG8_WAIT_V(n) asm volatile("s_waitcnt vmcnt(" #n ")" ::: "memory")
#define PG8_WAIT_L(n) asm volatile("s_waitcnt lgkmcnt(" #n ")" ::: "memory")
#define PG8_BAR __builtin_amdgcn_s_barrier()
#define PG8_SCHED __builtin_amdgcn_sched_barrier(0)
    Unit cur, nxt; int ui = 0;
    if (!S.next(0, cur)) return;
    f32x4 acc[2][2][4][2];
#pragma unroll
    for (int a = 0; a < 2; ++a)
#pragma unroll
        for (int b = 0; b < 2; ++b)
#pragma unroll
            for (int m = 0; m < 4; ++m)
#pragma unroll
                for (int n = 0; n < 2; ++n) acc[a][b][m][n] = (f32x4){0.f, 0.f, 0.f, 0.f};
    bf16x8 At[4][2], B0[2][2], B1[2][2];
    const char* cA = cur.A; const char* cB = cur.B;
    int clda = cur.lda, cldb = cur.ldb;
    PG8_STAGE_B(PG8_SB(0, 0), cB, cldb); PG8_STAGE_B(PG8_SB(0, 1), cB + (size_t)HALF * cldb, cldb); PG8_STAGE_A(PG8_SA(0, 0), cA, clda); PG8_STAGE_A(PG8_SA(0, 1), cA + (size_t)HALF * clda, clda);
    if (wr == 1) PG8_BAR;
    PG8_WAIT_V(2); PG8_BAR;
    PG8_STAGE_B(PG8_SB(1, 0), cB + kstep, cldb); PG8_STAGE_A(PG8_SA(1, 0), cA + kstep, clda); PG8_STAGE_B(PG8_SB(1, 1), cB + (size_t)HALF * cldb + kstep, cldb);
    PG8_WAIT_V(6); PG8_BAR;
    for (;;) {
        const bool has_next = S.next(ui + 1, nxt);
        const char* nA = has_next ? nxt.A : cA; const char* nB = has_next ? nxt.B : cB;
        const int nlda = has_next ? (int)nxt.lda : clda, nldb = has_next ? (int)nxt.ldb : cldb;
        const int nt = cur.nt;
        for (int t = 0; t < nt; t += 2) {
            const bool last = (t == nt - 2);
            const char* a1 = cA + (size_t)(t + 1) * kstep;
            const char* a2 = last ? nA : cA + (size_t)(t + 2) * kstep; const char* b2 = last ? nB : cB + (size_t)(t + 2) * kstep;
            const char* a3 = a2 + kstep; const char* b3 = b2 + kstep;
            const int lda2 = last ? nlda : clda, ldb2 = last ? nldb : cldb;
            PG8_LDB(B0, 0, 0); PG8_LDB(B1, 0, 1); PG8_SCHED; PG8_LDA(At, 0, 0); PG8_STAGE_A(PG8_SA(1, 1), a1 + (size_t)HALF * clda, clda);
            PG8_WAIT_V(8); PG8_WAIT_L(0); PG8_BAR; PG8_MMA(0, 0, At, B0); PG8_MMA(0, 1, At, B1); PG8_BAR; PG8_SCHED;
            PG8_LDA(At, 0, 1); PG8_STAGE_B(PG8_SB(0, 0), b2, ldb2); PG8_STAGE_B(PG8_SB(0, 1), b2 + (size_t)HALF * ldb2, ldb2); PG8_STAGE_A(PG8_SA(0, 0), a2, lda2);
            PG8_WAIT_V(8); PG8_WAIT_L(0); PG8_BAR; PG8_MMA(1, 0, At, B0); PG8_MMA(1, 1, At, B1); PG8_BAR; PG8_SCHED;
            PG8_LDB(B0, 1, 0); PG8_LDB(B1, 1, 1); PG8_SCHED; PG8_LDA(At, 1, 0); PG8_STAGE_A(PG8_SA(0, 1), a2 + (size_t)HALF * lda2, lda2);
            PG8_WAIT_V(8); PG8_WAIT_L(0); PG8_BAR; PG8_MMA(0, 0, At, B0); PG8_MMA(0, 1, At, B1); PG8_BAR; PG8_SCHED;
            PG8_LDA(At, 1, 1); PG8_STAGE_B(PG8_SB(1, 0), b3, ldb2); PG8_STAGE_B(PG8_SB(1, 1), b3 + (size_t)HALF * ldb2, ldb2); PG8_STAGE_A(PG8_SA(1, 0), a3, lda2);
            PG8_WAIT_V(8); PG8_WAIT_L(0); PG8_BAR; PG8_MMA(1, 0, At, B0); PG8_MMA(1, 1, At, B1); PG8_BAR; PG8_SCHED;
        }
        if (wr == 0) PG8_BAR;
        E(acc, cur, wr, wc, fr, fq);
        if (!has_next) break;
#pragma unroll
        for (int a = 0; a < 2; ++a)
#pragma unroll
            for (int b = 0; b < 2; ++b)
#pragma unroll
                for (int m = 0; m < 4; ++m)
#pragma unroll
                    for (int n = 0; n < 2; ++n) acc[a][b][m][n] = (f32x4){0.f, 0.f, 0.f, 0.f};
        cur = nxt; cA = nA; cB = nB; clda = nlda; cldb = nldb; ++ui;
        if (wr == 1) PG8_BAR;
    }
    PG8_WAIT_V(0);
    PG8_BAR;
#undef PG8_SA
#undef PG8_SB
#undef PG8_STAGE_A
#undef PG8_STAGE_B
#undef PG8_LDA
#undef PG8_LDB
#undef PG8_MMA
#undef PG8_WAIT_V
#undef PG8_WAIT_L
#undef PG8_BAR
#undef PG8_SCHED
}
}

#define GSTRIDE(gi, total) for (int gi = bid_ * NT + tid_; gi < (total); gi += G_ * NT)
__device__ __forceinline__ void ph_mod(unsigned char* lds, const float* c, const float* c_ctx, const float* ada_w, const float* ada_b, float* mod) { PH_IDS;
    float (*sl)[1024] = (float (*)[1024])lds;
    for (int e = tid_; e < 9 * 1024; e += NT) { const int j = e >> 10, k = e & 1023; const float v = j < 8 ? c[j * 1024 + k] : c_ctx[k]; sl[j][k] = siluf_(v); }
    __syncthreads();
    GSTRIDE(gi, 2 * 6144) {
        const int l = gi / 6144, n = gi % 6144;
        float acc[9];
#pragma unroll
        for (int j = 0; j < 9; ++j) acc[j] = 0.f;
        const float* w = ada_w + (size_t)l * 1024 * 6144 + n;
        for (int k = 0; k < 1024; ++k) { const float wv = w[(size_t)k * 6144];
#pragma unroll
            for (int j = 0; j < 9; ++j) acc[j] += sl[j][k] * wv; }
        const float bb = ada_b[l * 6144 + n];
#pragma unroll
        for (int j = 0; j < 9; ++j) mod[((size_t)l * 9 + j) * 6144 + n] = acc[j] + bb;
    }
    __syncthreads();
}
__device__ __forceinline__ void ph_trig(float* trig) { PH_IDS; GSTRIDE(i, 2048) { const float xx = (float)i * (1.f / 1024.f); trig[i] = cospif(xx); trig[2048 + i] = sinpif(xx); } }
__device__ __forceinline__ double2 lam_pow(double re, double im, double dt, int k) {
    const double m = (double)__expf((float)(re * dt * k));
    double xx = im * dt * (double)k * 0.318309886183790671538;
    xx -= 2.0 * rint(xx * 0.5);
    const float xf = (float)xx;
    return make_double2(m * (double)cospif(xf), m * (double)sinpif(xf));
}
__device__ __forceinline__ void ph_s5_lp(int l, const float* lam_re, const float* lam_im, const float* log_step, const float* b_re, const float* b_im, double2* LP, double2* BB, float* lamT) { PH_IDS;
    GSTRIDE(i, 2 * 16 * 64) {
        const int d = i / 1024, g = (i / 64) % 16, p = i % 64;
        const size_t li = ((size_t)(l * 2 + d) * 16 + g) * 64 + p;
        const double re = lam_re[li], im = lam_im[li], dt = (double)expf(log_step[(l * 2 + d) * 16 + g]);
        for (int k = 0; k <= 64; ++k) LP[(size_t)i * 65 + k] = lam_pow(re, im, dt, k);
        const double2 l1 = lam_pow(re, im, dt, 1);
        const double nr = l1.x - 1.0, ni = l1.y, den = re * re + im * im;
        const double fr = (nr * re + ni * im) / den, fi = (ni * re - nr * im) / den;
        for (int h = 0; h < 16; ++h) { const double br = b_re[li * 16 + h], bi = b_im[li * 16 + h]; BB[(size_t)i * 16 + h] = make_double2(fr * br - fi * bi, fr * bi + fi * br); }
        const double2 l64 = lam_pow(re, im, dt, 64);
        lamT[((size_t)(g * 2 + d) * 64 + p) * 2 + 0] = (float)l64.x; lamT[((size_t)(g * 2 + d) * 64 + p) * 2 + 1] = (float)l64.y;
    }
}
__device__ __forceinline__ void ph_s5_tz(int l, const double2* LP, const double2* BB, const float* c_re, const float* c_im, const float* s5_d, float* TZ) { PH_IDS;
    GSTRIDE(i, 16 * 127 * 256) {
        const int g = i / (127 * 256), dd = (i / 256) % 127, hp = (i / 16) % 16, h = i % 16;
        const int delta = dd - 63;
        double acc = 0.0;
        for (int d = 0; d < 2; ++d) {
            if ((d == 0 && delta < 0) || (d == 1 && delta > 0)) continue;
            const int tau = delta < 0 ? -delta : delta;
            for (int p = 0; p < 64; ++p) {
                const size_t ci = (((size_t)(l * 2 + d) * 16 + g) * 16 + h) * 64 + p;
                const double cr = c_re[ci], cim = c_im[ci];
                const size_t gi = ((size_t)d * 16 + g) * 64 + p;
                const double2 lp = LP[gi * 65 + tau], bb = BB[gi * 16 + hp];
                const double xr = lp.x * bb.x - lp.y * bb.y, xi = lp.x * bb.y + lp.y * bb.x;
                acc += cr * xr - cim * xi;
            }
        }
        if (delta == 0 && h == hp) acc += (double)s5_d[l * 256 + g * 16 + h];
        TZ[i] = (float)acc;
    }
}
__device__ __forceinline__ void ph_s5_ms(const double2* LP, const double2* BB, bf16_t* MS) { PH_IDS;
    GSTRIDE(i, 16 * 1024 * 128) {
        const int g = i / (1024 * 128), sh = (i / 128) % 1024, dp = i % 128, d = dp / 64, p = dp % 64, s = sh / 16, hp = sh % 16;
        const size_t gi = ((size_t)d * 16 + g) * 64 + p;
        const double2 lp = LP[gi * 65 + (d == 0 ? 63 - s : s)], bb = BB[gi * 16 + hp];
        bf16_t* o = MS + ((size_t)g * 1024 + sh) * 256 + d * 128;
        o[p] = f2bf((float)(lp.x * bb.x - lp.y * bb.y)); o[64 + p] = f2bf((float)(lp.x * bb.y + lp.y * bb.x));
    }
}
__device__ __forceinline__ void ph_s5_qo(int l, const double2* LP, const float* c_re, const float* c_im, bf16_t* QO) { PH_IDS;
    GSTRIDE(i, 16 * 128 * 1024) {
        const int g = i / (128 * 1024), dp = (i / 1024) % 128, th = i % 1024, d = dp / 64, p = dp % 64, t = th / 16, h = th % 16;
        const size_t ci = (((size_t)(l * 2 + d) * 16 + g) * 16 + h) * 64 + p;
        const double cr = c_re[ci], cim = c_im[ci];
        const double2 lp = LP[(((size_t)d * 16 + g) * 64 + p) * 65 + (d == 0 ? t + 1 : 64 - t)];
        bf16_t* o = QO + ((size_t)g * 256 + d * 128) * 1024 + th;
        o[(size_t)p * 1024] = f2bf((float)(cr * lp.x - cim * lp.y)); o[(size_t)(64 + p) * 1024] = f2bf((float)(-(cr * lp.y + cim * lp.x)));
    }
}
__device__ __forceinline__ void ph_adarms(const float* xlat, const float* xctx, const float* w, const float* mod, int sh_chunk, int sc_chunk, bf16_t* out) { PH_IDS;
    const int wave = (bid_ * NT + tid_) >> 6, lane = tid_ & 63, nw = (G_ * NT) >> 6;
    for (int row = wave; row < RT; row += nw) {
        const float* x = row < RL ? xlat + (size_t)row * DM : xctx + (size_t)(row - RL) * DM;
        float v[16]; float ss = 0.f;
#pragma unroll
        for (int j = 0; j < 4; ++j) { const f32x4 t = *(const f32x4*)(x + j * 256 + lane * 4); v[j * 4] = t[0]; v[j * 4 + 1] = t[1]; v[j * 4 + 2] = t[2]; v[j * 4 + 3] = t[3]; ss += t[0] * t[0] + t[1] * t[1] + t[2] * t[2] + t[3] * t[3]; }
#pragma unroll
        for (int o = 1; o < 64; o <<= 1) ss += __shfl_xor(ss, o);
        const float rstd = rsqrtf(ss * (1.f / DM) + EPS);
        const float* mrow = mod + (size_t)row_modidx(row) * 6144;
#pragma unroll
        for (int j = 0; j < 4; ++j)
#pragma unroll
            for (int q = 0; q < 4; ++q) { const int cidx = j * 256 + lane * 4 + q; const float y = v[j * 4 + q] * rstd * w[cidx] * (1.f + mrow[sc_chunk * 1024 + cidx]) + mrow[sh_chunk * 1024 + cidx]; out[(size_t)row * DM + cidx] = f2bf(y); }
    }
}
__device__ __forceinline__ void ph_mla_stats(const bf16_t* Z, float* rs) { PH_IDS;
    const int wave = (bid_ * NT + tid_) >> 6, lane = tid_ & 63, nw = (G_ * NT) >> 6;
    for (int row = wave; row < RT; row += nw) {
        const bf16_t* z = Z + (size_t)row * ZW; float sq = 0.f, sk = 0.f;
#pragma unroll
        for (int j = 0; j < 4; ++j) { const float v = bf2f(z[C_QC + j * 64 + lane]); sq += v * v; }
#pragma unroll
        for (int j = 0; j < 2; ++j) { const float v = bf2f(z[C_KVC + j * 64 + lane]); sk += v * v; }
#pragma unroll
        for (int o = 1; o < 64; o <<= 1) { sq += __shfl_xor(sq, o); sk += __shfl_xor(sk, o); }
        if (lane == 0) { rs[(size_t)row * 2] = rsqrtf(sq * (1.f / 256) + EPS); rs[(size_t)row * 2 + 1] = rsqrtf(sk * (1.f / 128) + EPS); }
    }
}
__device__ __forceinline__ void ph_mla_post(const bf16_t* Z, const bf16_t* qraw, const bf16_t* kvraw, const float* qkq, const float* qkk, bf16_t* Q, bf16_t* Kb, bf16_t* Vb) { PH_IDS;
    GSTRIDE(gi, RT * 8) {
        const int row = gi >> 3, h = (gi >> 1) & 3, isk = gi & 1;
        const bool lat = row < RL; const int b = row_batch(row), t = lat ? (row & 2047) : ((row - RL) & 255);
        const int qi = lat ? t : 2048 + t, ki = lat ? 256 + t : t;
        float v[96];
        float ss = 0.f;
        if (!isk) {
#pragma unroll
            for (int i = 0; i < 96; ++i) v[i] = bf2f(qraw[(size_t)row * 384 + h * 96 + i]);
        } else {
#pragma unroll
            for (int i = 0; i < 64; ++i) v[i] = bf2f(kvraw[(size_t)row * 512 + h * 128 + i]);
#pragma unroll
            for (int i = 0; i < 32; ++i) v[64 + i] = bf2f(Z[(size_t)row * ZW + C_KR + i]);
        }
#pragma unroll
        for (int i = 0; i < 96; ++i) ss += v[i] * v[i];
        const float rr = rsqrtf(ss * (1.f / 96) + EPS) * (isk ? 1.f : 0.14724727430627066f);
        const float* wv = isk ? qkk : qkq;
#pragma unroll
        for (int i = 0; i < 96; ++i) v[i] = v[i] * rr * wv[i];
        if (lat) {
            const float prow = (float)(t >> 6), pcol = (float)(t & 63);
#pragma unroll
            for (int part = 0; part < 2; ++part) { const float pos = part ? pcol : prow; const int base = 64 + part * 16;
#pragma unroll
                for (int j = 0; j < 8; ++j) { const float fr = exp2f(-(float)j * (13.287712379549449f / 8.f)), a = pos * fr, cs = __cosf(a), sn = __sinf(a);
                    const float x1 = v[base + j], x2 = v[base + 8 + j]; v[base + j] = x1 * cs - x2 * sn; v[base + 8 + j] = x1 * sn + x2 * cs; } }
        }
        bf16_t* o = isk ? Kb + ((size_t)(b * 4 + h) * 2304 + ki) * 96 : Q + ((size_t)(b * 4 + h) * 2304 + qi) * 96;
#pragma unroll
        for (int i = 0; i < 96; ++i) o[i] = f2bf(v[i]);
        if (isk) { bf16_t* vo = Vb + ((size_t)(b * 4 + h) * 2304 + ki) * 64; for (int i = 0; i < 64; ++i) vo[i] = kvraw[(size_t)row * 512 + h * 128 + 64 + i]; }
    }
}
__device__ __forceinline__ void ph_attn(unsigned char* lds, const bf16_t* Q, const bf16_t* Kb, const bf16_t* Vb, bf16_t* Z, int with_ctx) { PH_IDS;
    float (*sK)[96] = (float (*)[96])lds; float (*sV)[64] = (float (*)[64])(lds + 32 * 96 * 4);
    const int nunits = 32 * (8 + (with_ctx ? 1 : 0));
    const int qt = tid_ & 255, dh = (tid_ >> 8) * 32;
    for (int u = bid_; u < nunits; u += G_) {
        const int bh = u % 32, qb = u / 32;
        const bool lat = qb < 8;
        const int qi = qb * 256 + qt, nkeys = lat ? 2304 : 256;
        float q[96], o[32];
        const bf16_t* qp = Q + ((size_t)bh * 2304 + qi) * 96;
#pragma unroll
        for (int i = 0; i < 96; ++i) q[i] = bf2f(qp[i]) * 0.10206207261596577f;
#pragma unroll
        for (int i = 0; i < 32; ++i) o[i] = 0.f;
        float mx = -1e30f, l = 0.f;
        for (int k0 = 0; k0 < nkeys; k0 += 32) {
            __syncthreads();
            for (int e = tid_; e < 32 * 96; e += NT) sK[e / 96][e % 96] = bf2f(Kb[((size_t)bh * 2304 + k0) * 96 + e]);
            for (int e = tid_; e < 32 * 64; e += NT) sV[e / 64][e % 64] = bf2f(Vb[((size_t)bh * 2304 + k0) * 64 + e]);
            __syncthreads();
#pragma unroll 1
            for (int j = 0; j < 32; ++j) { float a = 0.f;
#pragma unroll
                for (int i = 0; i < 96; ++i) a += q[i] * sK[j][i];
                if (a > mx) { const float corr = __expf(mx - a); mx = a; l *= corr;
#pragma unroll
                    for (int i = 0; i < 32; ++i) o[i] *= corr; }
                const float p = __expf(a - mx); l += p;
#pragma unroll
                for (int i = 0; i < 32; ++i) o[i] += p * sV[j][dh + i]; }
        }
        const int b = bh >> 2, h = bh & 3;
        const int row = lat ? b * 2048 + qi : RL + b * 256 + (qi - 2048);
        const float inv = 1.f / l;
#pragma unroll
        for (int i = 0; i < 32; ++i) Z[(size_t)row * ZW + C_QC + h * 64 + dh + i] = f2bf(o[i] * inv);
    }
    __syncthreads();
}
__device__ __forceinline__ void ph_f1(const bf16_t* Z, const float* trig, bf16_t* F1lat, bf16_t* F1ctx) { PH_IDS;
    GSTRIDE(gi, RT * 256) {
        const int row = gi >> 8, gm = gi & 255, g = gm >> 6, m = gm & 63;
        float a = 0.f, bsum = 0.f;
        const bf16_t* u = Z + (size_t)row * ZW + C_FU + g * 64;
        for (int c = 0; c < 64; ++c) { const float v = bf2f(u[c]); const int idx = ((m * c) & 63) * 32; a += v * trig[idx]; bsum += v * trig[2048 + idx]; }
        if (row < RL) { const int b = row >> 11, t = row & 2047; bf16_t* o = F1lat + ((size_t)(b * 256 + gm) * 2) * 2048; o[t] = f2bf(a); o[2048 + t] = f2bf(bsum); }
        else { const int r = row - RL, b = r >> 8, t = r & 255; bf16_t* o = F1ctx + ((size_t)(b * 256 + gm) * 2) * 256; o[t] = f2bf(a); o[256 + t] = f2bf(bsum); }
    }
}
struct A_dft { const float* trig; long long L; long long mul;
    __device__ float operator()(int, int k, int kk) const { const int part = kk >= (int)L, t = part ? kk - (int)L : kk; const int idx = (int)(((long long)k * t) & (L - 1)) * (int)mul; return part ? -trig[2048 + idx] : trig[idx]; } };
struct B_f1t { const bf16_t* p; long long L;
    __device__ float operator()(int b, int kk, int n) const { return bf2f(p[((size_t)(b * 256 + n)) * 2 * L + kk]); } };
struct E_fourier { bf16_t* Z; long long rowbase; long long L; double scale;
    __device__ void operator()(int b, int m, int n, float v) const { Z[((size_t)rowbase + (size_t)b * L + m) * ZW + C_FU + n] = f2bf(v * (float)scale); } };

struct A_s5u { const bf16_t* Z;
    __device__ float operator()(int g, int rc, int k) const { return bf2f(Z[((size_t)rc * 64 + (k >> 4)) * ZW + C_S5 + g * 16 + (k & 15)]); } };
struct B_ms { const bf16_t* MS; __device__ float operator()(int g, int k, int n) const { return bf2f(MS[((size_t)g * 1024 + k) * 256 + n]); } };
struct E_sloc { float* S; __device__ void operator()(int g, int rc, int n, float v) const { S[((size_t)rc * 16 + g) * 256 + n] = v; } };
__device__ __forceinline__ void ph_s5_scan(const float* SLOC, const float* lamT, float* XP) { PH_IDS;
    GSTRIDE(i, 8 * 16 * 2 * 64) {
        const int b = i / 2048, g = (i / 128) % 16, d = (i / 64) % 2, p = i % 64;
        const float lr = lamT[((size_t)(g * 2 + d) * 64 + p) * 2], li = lamT[((size_t)(g * 2 + d) * 64 + p) * 2 + 1];
        float xr = 0.f, xi = 0.f;
        for (int step = 0; step < 36; ++step) {
            int rc;
            if (d == 0) rc = step < 4 ? 256 + b * 4 + step : b * 32 + (step - 4);
            else rc = step < 4 ? 256 + b * 4 + (3 - step) : b * 32 + (31 - (step - 4));
            const size_t o = ((size_t)rc * 16 + g) * 256 + d * 128;
            XP[o + p] = xr; XP[o + 64 + p] = xi;
            const float sr = SLOC[o + p], si = SLOC[o + 64 + p];
            const float nr = lr * xr - li * xi + sr, ni = lr * xi + li * xr + si; xr = nr; xi = ni;
        }
    }
}
struct A_s5out { const bf16_t* Z; const float* XP;
    __device__ float operator()(int g, int rc, int k) const { return k < 1024 ? bf2f(Z[((size_t)rc * 64 + (k >> 4)) * ZW + C_S5 + g * 16 + (k & 15)]) : XP[((size_t)rc * 16 + g) * 256 + (k - 1024)]; } };
struct B_s5out { const float* TZ; const bf16_t* QO;
    __device__ float operator()(int g, int k, int n) const { if (k < 1024) { const int s = k >> 4, hp = k & 15, t = n >> 4, h = n & 15; return TZ[(((size_t)g * 127 + (t - s + 63)) * 16 + hp) * 16 + h]; } return bf2f(QO[((size_t)g * 256 + (k - 1024)) * 1024 + n]); } };
struct E_s5out { bf16_t* YG; __device__ void operator()(int g, int rc, int n, float v) const { YG[((size_t)rc * 64 + (n >> 4)) * 256 + g * 16 + (n & 15)] = f2bf(geluf_(v)); } };
__device__ __forceinline__ void ph_glu(const bf16_t* GL, bf16_t* Z) { PH_IDS;
    GSTRIDE(gi, RT * 256) {
        const int row = gi >> 8, j = gi & 255;
        const float val = bf2f(GL[(size_t)row * 512 + j]), gate = bf2f(GL[(size_t)row * 512 + 256 + j]);
        Z[(size_t)row * ZW + C_S5 + j] = f2bf(val * sigmoidf_(gate));
    }
}
__device__ __forceinline__ void ph_ret_prep(bf16_t* Z) { PH_IDS;
    GSTRIDE(gi, RT * 4 * 32) {
        const int row = gi >> 7, h = (gi >> 5) & 3, j = gi & 31;
        bf16_t* z = Z + (size_t)row * ZW;
        if (row < RL) {
            const int t = row & 2047; const float fr = exp2f(-(float)j * (13.287712379549449f / 32.f)), a = (float)t * fr, cs = cosf(a), sn = sinf(a);
            { const float x1 = bf2f(z[C_RQ + h * 64 + j]), x2 = bf2f(z[C_RQ + h * 64 + 32 + j]); z[C_RQ + h * 64 + j] = f2bf(x1 * cs - x2 * sn); z[C_RQ + h * 64 + 32 + j] = f2bf(x1 * sn + x2 * cs); }
            { const float x1 = bf2f(z[C_RK + h * 64 + j]), x2 = bf2f(z[C_RK + h * 64 + 32 + j]); z[C_RK + h * 64 + j] = f2bf((x1 * cs - x2 * sn) * 0.125f); z[C_RK + h * 64 + 32 + j] = f2bf((x1 * sn + x2 * cs) * 0.125f); }
        } else {
            z[C_RK + h * 64 + j] = f2bf(bf2f(z[C_RK + h * 64 + j]) * 0.125f); z[C_RK + h * 64 + 32 + j] = f2bf(bf2f(z[C_RK + h * 64 + 32 + j]) * 0.125f);
        }
    }
}
__device__ __forceinline__ void ph_ret(unsigned char* lds, bf16_t* Z, const float* decay_logit, const float* gn_w, int with_ctx) { PH_IDS;
    float (*sK)[64] = (float (*)[64])lds; float (*sV)[64] = (float (*)[64])(lds + 32 * 64 * 4);
    float* sred = (float*)(lds + 2 * 32 * 64 * 4);
    const int nunits = 32 * (8 + (with_ctx ? 1 : 0));
    const int qt = tid_ & 255, hh = tid_ >> 8, dh = hh * 32;
    for (int u = bid_; u < nunits; u += G_) {
        const int bh = u % 32, qb = u / 32, b = bh >> 2, h = bh & 3;
        const bool lat = qb < 8;
        const int qpos = lat ? qb * 256 + qt : qt;
        const int qrow = lat ? b * 2048 + qpos : RL + b * 256 + qpos;
        const float lgf = -log1pf(__expf(-decay_logit[h])) * 1.4426950408889634f, lgb = -log1pf(__expf(-decay_logit[4 + h])) * 1.4426950408889634f;
        float q[64], o[32];
#pragma unroll
        for (int i = 0; i < 64; ++i) q[i] = bf2f(Z[(size_t)qrow * ZW + C_RQ + h * 64 + i]);
#pragma unroll
        for (int i = 0; i < 32; ++i) o[i] = 0.f;
        const int nkeys = lat ? 2560 : 256;
        for (int k0 = 0; k0 < nkeys; k0 += 32) {
            int krow0, kpos0;
            if (lat) { if (k0 < 256) { krow0 = RL + b * 256 + k0; kpos0 = k0 - 256; } else if (k0 < 2304) { krow0 = b * 2048 + (k0 - 256); kpos0 = k0 - 256; } else { krow0 = RL + b * 256 + (k0 - 2304); kpos0 = 2048 + (k0 - 2304); } }
            else { krow0 = RL + b * 256 + k0; kpos0 = k0; }
            __syncthreads();
            for (int e = tid_; e < 32 * 64; e += NT) { const int j = e >> 6, i = e & 63; sK[j][i] = bf2f(Z[(size_t)(krow0 + j) * ZW + C_RK + h * 64 + i]); sV[j][i] = bf2f(Z[(size_t)(krow0 + j) * ZW + C_RV + h * 64 + i]); }
            __syncthreads();
#pragma unroll 1
            for (int j = 0; j < 32; ++j) { float a = 0.f;
#pragma unroll
                for (int i = 0; i < 64; ++i) a += q[i] * sK[j][i];
                const int dpos = qpos - (kpos0 + j);
                const float dec = dpos > 0 ? exp2f(lgf * (float)dpos) : (dpos < 0 ? exp2f(lgb * (float)(-dpos)) : 2.f);
                a *= dec;
#pragma unroll
                for (int i = 0; i < 32; ++i) o[i] += a * sV[j][dh + i]; }
        }
        float s1 = 0.f;
#pragma unroll
        for (int i = 0; i < 32; ++i) s1 += o[i];
        __syncthreads();
        sred[hh * 256 + qt] = s1;
        __syncthreads();
        const float mu = (sred[qt] + sred[256 + qt]) * (1.f / 64);
        float s2 = 0.f;
#pragma unroll
        for (int i = 0; i < 32; ++i) { const float d = o[i] - mu; s2 += d * d; }
        __syncthreads();
        sred[hh * 256 + qt] = s2;
        __syncthreads();
        const float rstd = rsqrtf((sred[qt] + sred[256 + qt]) * (1.f / 64) + EPS);
#pragma unroll
        for (int i = 0; i < 32; ++i) { const float gte = bf2f(Z[(size_t)qrow * ZW + C_RG + h * 64 + dh + i]); const float y = (o[i] - mu) * rstd * gn_w[h * 64 + dh + i];
            Z[(size_t)qrow * ZW + C_RQ + h * 64 + dh + i] = f2bf(siluf_(gte) * y); }
    }
    __syncthreads();
}
struct E_merge { const bf16_t* stash; bf16_t* MMp; long long first;
    __device__ void operator()(int, int m, int n, float v) const { const size_t i = (size_t)m * DM + n; const float t = sigmoidf_(v) * bf2f(stash[i]); MMp[i] = f2bf(first ? t : bf2f(MMp[i]) + t); } };
struct E_resid { const float* xlat; const float* xctx; float* olat; float* octx; const float* mod; long long gchunk;
    __device__ void operator()(int, int m, int n, float v) const {
        const float g = mod[(size_t)row_modidx(m) * 6144 + gchunk * 1024 + n];
        if (m < RL) olat[(size_t)m * DM + n] = xlat[(size_t)m * DM + n] + g * v; else octx[(size_t)(m - RL) * DM + n] = xctx[(size_t)(m - RL) * DM + n] + g * v; } };
struct E_relu2 { bf16_t* H; __device__ void operator()(int, int m, int n, float v) const { const float r = fmaxf(v, 0.f); H[(size_t)m * DFF + n] = f2bf(r * r); } };

namespace fa {
typedef float f32x16 __attribute__((ext_vector_type(16)));
typedef short s16x4 __attribute__((ext_vector_type(4)));
typedef unsigned u32x4 __attribute__((ext_vector_type(4)));
typedef unsigned u32x2 __attribute__((ext_vector_type(2)));
__device__ __forceinline__ s16x4 vtr(const LAS char* p) { return __builtin_bit_cast(s16x4, __builtin_amdgcn_ds_read_tr16_b64_v4i16((LAS s16x4*)p)); }
__device__ __forceinline__ unsigned pk2(float lo, float hi) { unsigned r; asm volatile("v_cvt_pk_bf16_f32 %0, %1, %2" : "=v"(r) : "v"(lo), "v"(hi)); return r; }
__device__ __forceinline__ bf16x8 pack_p(const f32x16& p, int base) { u32x4 w; w.x = pk2(p[base], p[base + 1]); w.y = pk2(p[base + 2], p[base + 3]); w.z = pk2(p[base + 4], p[base + 5]); w.w = pk2(p[base + 6], p[base + 7]); return __builtin_bit_cast(bf16x8, w); }
__device__ __forceinline__ int crow(int r, int hi) { return (r & 3) + 8 * (r >> 2) + 4 * hi; }
__device__ __forceinline__ void pv_tile(f32x16& o0, f32x16& o1, const LAS char* vb, const bf16x8 (&pf)[4]) {
#pragma unroll
    for (int ks = 0; ks < 4; ++ks) {
        const s16x4 a0 = vtr(vb + ks * 1024), a1 = vtr(vb + ks * 1024 + 512), b0 = vtr(vb + 4096 + ks * 1024), b1 = vtr(vb + 4096 + ks * 1024 + 512);
        const bf16x8 v0 = (bf16x8){a0[0], a0[1], a0[2], a0[3], a1[0], a1[1], a1[2], a1[3]}, v1 = (bf16x8){b0[0], b0[1], b0[2], b0[3], b1[0], b1[1], b1[2], b1[3]};
        o0 = __builtin_amdgcn_mfma_f32_32x32x16_bf16(v0, pf[ks], o0, 0, 0, 0);
        o1 = __builtin_amdgcn_mfma_f32_32x32x16_bf16(v1, pf[ks], o1, 0, 0, 0);
    }
}
constexpr int KP_A = 208, KT_A = 64 * KP_A, VT = 8192, BUF_A = KT_A + VT;
constexpr int KP_R = 144, KT_R = 64 * KP_R, BUF_R = KT_R + VT;
}

__device__ __forceinline__ void ph_attn_mfma(unsigned char* lds_, const bf16_t* Q, const bf16_t* Kb, const bf16_t* Vb, bf16_t* Z, int with_ctx) { PH_IDS;
    using namespace fa;
    LAS char* sm = (LAS char*)lds_;
    const int lane = tid_ & 63, wid = __builtin_amdgcn_readfirstlane(tid_ >> 6), r32 = lane & 31, hi = lane >> 5;
    const int nunits = 256 + (with_ctx ? 32 : 0);
    const int vcu = (bid_ % 8) * (G_ / 8) + bid_ / 8;
    const int koff0 = (tid_ / 12) * KP_A + (tid_ % 12) * 16, koff1 = ((tid_ + 512) / 12) * KP_A + ((tid_ + 512) % 12) * 16;
    const int voff = KT_A + ((tid_ & 7) >> 2) * 4096 + (tid_ >> 3) * 64 + (tid_ & 3) * 16;
    const int vrd = KT_A + ((lane >> 4) & 1) * 32 + (lane & 3) * 8 + (4 * hi + ((lane & 15) >> 2)) * 64;
    for (int u = vcu; u < nunits; u += G_) {
        const bool lat = u < 256; const int bh = lat ? (u >> 3) : (u - 256), qb = lat ? (u & 7) : 8;
        const int ntile = lat ? 36 : 4;
        const char* Kg = (const char*)(Kb + (size_t)bh * 2304 * 96); const char* Vg = (const char*)(Vb + (size_t)bh * 2304 * 64);
        const bf16_t* Qg = Q + ((size_t)bh * 2304 + qb * 256 + wid * 32 + r32) * 96;
        bf16x8 qf[6];
#pragma unroll
        for (int st = 0; st < 6; ++st) qf[st] = *(const bf16x8*)(Qg + 16 * st + 8 * hi);
        f32x16 o0, o1;
#pragma unroll
        for (int r = 0; r < 16; ++r) { o0[r] = 0.f; o1[r] = 0.f; }
        float mrun = -1e30f, lsum = 0.f;
        u32x4 kr0, kr1, vr;
        kr0 = *(const u32x4*)(Kg + tid_ * 16); kr1 = tid_ < 256 ? *(const u32x4*)(Kg + (tid_ + 512) * 16) : (u32x4){0u, 0u, 0u, 0u}; vr = *(const u32x4*)(Vg + tid_ * 16);
        __syncthreads();
        *(LAS u32x4*)(sm + koff0) = kr0; if (tid_ < 256) *(LAS u32x4*)(sm + koff1) = kr1; *(LAS u32x4*)(sm + voff) = vr;
        __syncthreads();
        for (int t = 0; t < ntile; ++t) {
            const int buf = (t & 1) * BUF_A;
            if (t + 1 < ntile) { const char* kg = Kg + (size_t)(t + 1) * 12288; const char* vg = Vg + (size_t)(t + 1) * 8192;
                kr0 = *(const u32x4*)(kg + tid_ * 16); if (tid_ < 256) kr1 = *(const u32x4*)(kg + (tid_ + 512) * 16); vr = *(const u32x4*)(vg + tid_ * 16); }
            const LAS char* kb = sm + buf + r32 * KP_A + 16 * hi;
            f32x16 p0, p1;
#pragma unroll
            for (int r = 0; r < 16; ++r) { p0[r] = 0.f; p1[r] = 0.f; }
#pragma unroll
            for (int st = 0; st < 6; ++st) {
                const bf16x8 k0 = *(const LAS bf16x8*)(kb + 32 * st), k1 = *(const LAS bf16x8*)(kb + 32 * KP_A + 32 * st);
                p0 = __builtin_amdgcn_mfma_f32_32x32x16_bf16(k0, qf[st], p0, 0, 0, 0);
                p1 = __builtin_amdgcn_mfma_f32_32x32x16_bf16(k1, qf[st], p1, 0, 0, 0);
            }
            float tm = fmaxf(p0[0], p1[0]);
#pragma unroll
            for (int r = 1; r < 16; ++r) tm = fmaxf(tm, fmaxf(p0[r], p1[r]));
            tm = fmaxf(tm, __shfl_xor(tm, 32));
            const float mn = fmaxf(mrun, tm), alpha = __builtin_amdgcn_exp2f(mrun - mn); mrun = mn;
            float ps = 0.f;
#pragma unroll
            for (int r = 0; r < 16; ++r) { p0[r] = __builtin_amdgcn_exp2f(p0[r] - mn); p1[r] = __builtin_amdgcn_exp2f(p1[r] - mn); ps += p0[r] + p1[r]; }
            lsum = lsum * alpha + ps;
#pragma unroll
            for (int r = 0; r < 16; ++r) { o0[r] *= alpha; o1[r] *= alpha; }
            bf16x8 pf[4]; pf[0] = pack_p(p0, 0); pf[1] = pack_p(p0, 8); pf[2] = pack_p(p1, 0); pf[3] = pack_p(p1, 8);
            pv_tile(o0, o1, sm + buf + vrd, pf);
            if (t + 1 < ntile) { const int nb = ((t + 1) & 1) * BUF_A; *(LAS u32x4*)(sm + nb + koff0) = kr0; if (tid_ < 256) *(LAS u32x4*)(sm + nb + koff1) = kr1; *(LAS u32x4*)(sm + nb + voff) = vr; }
            __syncthreads();
        }
        lsum += __shfl_xor(lsum, 32);
        const float inv = 1.f / lsum;
        const int b = bh >> 2, h = bh & 3;
        const int row = (lat ? b * 2048 + qb * 256 : RL + b * 256) + wid * 32 + r32;
        bf16_t* op = Z + (size_t)row * ZW + C_QC + h * 64 + 4 * hi;
#pragma unroll
        for (int g = 0; g < 4; ++g) {
            u32x2 w0, w1; w0.x = pk2(o0[4 * g] * inv, o0[4 * g + 1] * inv); w0.y = pk2(o0[4 * g + 2] * inv, o0[4 * g + 3] * inv);
            w1.x = pk2(o1[4 * g] * inv, o1[4 * g + 1] * inv); w1.y = pk2(o1[4 * g + 2] * inv, o1[4 * g + 3] * inv);
            *(u32x2*)(op + 8 * g) = w0; *(u32x2*)(op + 32 + 8 * g) = w1;
        }
    }
    __syncthreads();
}

__device__ __forceinline__ void ph_ret_mfma(unsigned char* lds_, bf16_t* Z, const float* decay_logit, const float* gn_w, int with_ctx) { PH_IDS;
    using namespace fa;
    LAS char* sm = (LAS char*)lds_;
    const int lane = tid_ & 63, wid = __builtin_amdgcn_readfirstlane(tid_ >> 6), r32 = lane & 31, hi = lane >> 5;
    const int nunits = 256 + (with_ctx ? 32 : 0);
    const int vcu = (bid_ % 8) * (G_ / 8) + bid_ / 8;
    const int prow = tid_ >> 3, pc = tid_ & 7;
    const int koff = prow * KP_R + pc * 16;
    const int voff = KT_R + (pc >> 2) * 4096 + prow * 64 + (pc & 3) * 16;
    const int vrd = KT_R + ((lane >> 4) & 1) * 32 + (lane & 3) * 8 + (4 * hi + ((lane & 15) >> 2)) * 64;
    for (int u = vcu; u < nunits; u += G_) {
        const bool lat = u < 256; const int bh = lat ? (u >> 3) : (u - 256), qb = lat ? (u & 7) : 0, b = bh >> 2, h = bh & 3;
        const int ntile = lat ? 40 : 4;
        const float lgf = -log1pf(__expf(-decay_logit[h])) * 1.4426950408889634f, lgb = -log1pf(__expf(-decay_logit[4 + h])) * 1.4426950408889634f;
        const int qpos = qb * 256 + wid * 32 + r32;
        const int qrow = (lat ? b * 2048 : RL + b * 256) + qpos;
        bf16_t* zq = Z + (size_t)qrow * ZW;
        bf16x8 qf[4];
#pragma unroll
        for (int st = 0; st < 4; ++st) qf[st] = *(const bf16x8*)(zq + C_RQ + h * 64 + 16 * st + 8 * hi);
        f32x16 o0, o1;
#pragma unroll
        for (int r = 0; r < 16; ++r) { o0[r] = 0.f; o1[r] = 0.f; }
        const int ctx0 = RL + b * 256, lat0 = b * 2048;
#define RET_TILE_ROW(t) (lat ? ((t) < 4 ? ctx0 + 64 * (t) : ((t) < 36 ? lat0 + 64 * ((t) - 4) : ctx0 + 64 * ((t) - 36))) : ctx0 + 64 * (t))
#define RET_TILE_POS(t) (lat ? 64 * (t) - 256 : 64 * (t))
        u32x4 kr, vr;
        { const bf16_t* zr = Z + (size_t)(RET_TILE_ROW(0) + prow) * ZW + h * 64 + pc * 8; kr = *(const u32x4*)(zr + C_RK); vr = *(const u32x4*)(zr + C_RV); }
        __syncthreads();
        *(LAS u32x4*)(sm + koff) = kr; *(LAS u32x4*)(sm + voff) = vr;
        __syncthreads();
        for (int t = 0; t < ntile; ++t) {
            const int buf = (t & 1) * BUF_R;
            if (t + 1 < ntile) { const bf16_t* zr = Z + (size_t)(RET_TILE_ROW(t + 1) + prow) * ZW + h * 64 + pc * 8; kr = *(const u32x4*)(zr + C_RK); vr = *(const u32x4*)(zr + C_RV); }
            const LAS char* kb = sm + buf + r32 * KP_R + 16 * hi;
            f32x16 p0, p1;
#pragma unroll
            for (int r = 0; r < 16; ++r) { p0[r] = 0.f; p1[r] = 0.f; }
#pragma unroll
            for (int st = 0; st < 4; ++st) {
                const bf16x8 k0 = *(const LAS bf16x8*)(kb + 32 * st), k1 = *(const LAS bf16x8*)(kb + 32 * KP_R + 32 * st);
                p0 = __builtin_amdgcn_mfma_f32_32x32x16_bf16(k0, qf[st], p0, 0, 0, 0);
                p1 = __builtin_amdgcn_mfma_f32_32x32x16_bf16(k1, qf[st], p1, 0, 0, 0);
            }
            const int d0 = qpos - RET_TILE_POS(t) - 4 * hi;
#pragma unroll
            for (int r = 0; r < 16; ++r) {
                const int dp0 = d0 - ((r & 3) + 8 * (r >> 2)), dp1 = dp0 - 32;
                const float w0 = dp0 > 0 ? __builtin_amdgcn_exp2f(lgf * (float)dp0) : (dp0 < 0 ? __builtin_amdgcn_exp2f(-lgb * (float)dp0) : 2.f);
                const float w1 = dp1 > 0 ? __builtin_amdgcn_exp2f(lgf * (float)dp1) : (dp1 < 0 ? __builtin_amdgcn_exp2f(-lgb * (float)dp1) : 2.f);
                p0[r] *= w0; p1[r] *= w1;
            }
            bf16x8 pf[4]; pf[0] = pack_p(p0, 0); pf[1] = pack_p(p0, 8); pf[2] = pack_p(p1, 0); pf[3] = pack_p(p1, 8);
            pv_tile(o0, o1, sm + buf + vrd, pf);
            if (t + 1 < ntile) { const int nb = ((t + 1) & 1) * BUF_R; *(LAS u32x4*)(sm + nb + koff) = kr; *(LAS u32x4*)(sm + nb + voff) = vr; }
            __syncthreads();
        }
#undef RET_TILE_ROW
#undef RET_TILE_POS
        float s1 = 0.f;
#pragma unroll
        for (int r = 0; r < 16; ++r) s1 += o0[r] + o1[r];
        s1 += __shfl_xor(s1, 32);
        const float mu = s1 * (1.f / 64);
        float s2 = 0.f;
#pragma unroll
        for (int r = 0; r < 16; ++r) { const float a = o0[r] - mu, c = o1[r] - mu; s2 += a * a + c * c; }
        s2 += __shfl_xor(s2, 32);
        const float rstd = rsqrtf(s2 * (1.f / 64) + EPS);
#pragma unroll
        for (int g = 0; g < 4; ++g)
#pragma unroll
            for (int blk = 0; blk < 2; ++blk) {
                const int d = blk * 32 + 8 * g + 4 * hi;
                const u32x2 gt = *(const u32x2*)(zq + C_RG + h * 64 + d);
                const f32x4 gw = *(const f32x4*)(gn_w + h * 64 + d);
                float y[4];
#pragma unroll
                for (int q = 0; q < 4; ++q) { const float ov = blk ? o1[4 * g + q] : o0[4 * g + q]; const unsigned gb = q < 2 ? gt.x : gt.y; const float gv = __uint_as_float((q & 1) ? (gb & 0xffff0000u) : (gb << 16));
                    y[q] = siluf_(gv) * ((ov - mu) * rstd * gw[q]); }
                u32x2 w; w.x = pk2(y[0], y[1]); w.y = pk2(y[2], y[3]);
                *(u32x2*)(zq + C_RQ + h * 64 + d) = w;
            }
    }
    __syncthreads();
}

struct SchedGrid {
    const char* A; const char* B; unsigned lda, ldb; int nt, nM, nN, G, c, kind, aux;
    __device__ __forceinline__ bool next(int i, pg8::Unit& u) const {
        int pm, pn; if (!pg8::static_tile(nM, nN, G, c, i, pm, pn)) return false;
        u.A = A + (size_t)pm * 256 * lda; u.B = B + (size_t)pn * 256 * ldb; u.lda = lda; u.ldb = ldb; u.nt = nt; u.pm = pm; u.pn = pn; u.kind = kind; u.aux = aux; return true; }
};
struct SchedMerge {
    const char* Z; const char* XN; const char* WBR; const char* WING; int njobs, G, vcu;
    __device__ __forceinline__ bool next(int i, pg8::Unit& u) const {
        const int job = (i >> 3) * G + vcu; if (job >= njobs) return false;
        const int sub = i & 7, n = sub >> 1, pm = job >> 2, pn = job & 3;
        u.pm = pm; u.pn = pn; u.aux = n;
        if (!(sub & 1)) { const int bcol = n == 0 ? C_QC : (n == 1 ? C_FU : (n == 2 ? C_S5 : C_RQ));
            u.A = Z + ((size_t)pm * 256 * ZW + bcol) * 2; u.lda = ZW * 2; u.B = WBR + ((size_t)n * 1024 + pn * 256) * 512; u.ldb = 512; u.nt = 4; u.kind = 0; }
        else { u.A = XN + (size_t)pm * 256 * 2048; u.lda = 2048; u.B = WING + ((size_t)n * 1024 + pn * 256) * 2048; u.ldb = 2048; u.nt = 16; u.kind = 1; }
        return true; }
};
#define EPI_FOREACH(...) _Pragma("unroll") for (int ai = 0; ai < 2; ++ai) _Pragma("unroll") for (int m = 0; m < 4; ++m) _Pragma("unroll") for (int bj = 0; bj < 2; ++bj) { \
        const int row = u.pm * 256 + ai * 128 + wr * 64 + m * 16 + fr, col = u.pn * 256 + bj * 128 + wc * 32 + 8 * fq; const f32x4 v0 = acc[ai][bj][m][0], v1 = acc[ai][bj][m][1]; (void)row; (void)col; __VA_ARGS__ }
__device__ __forceinline__ pg8::u32x4 pack8(const f32x4 a, const f32x4 b) { pg8::u32x4 w; w.x = pg8::cvt_pk_bf16(a[0], a[1]); w.y = pg8::cvt_pk_bf16(a[2], a[3]); w.z = pg8::cvt_pk_bf16(b[0], b[1]); w.w = pg8::cvt_pk_bf16(b[2], b[3]); return w; }
__device__ __forceinline__ void unpack8(const pg8::u32x4 w, f32x4& a, f32x4& b) {
    a[0] = __uint_as_float(w.x << 16); a[1] = __uint_as_float(w.x & 0xffff0000u); a[2] = __uint_as_float(w.y << 16); a[3] = __uint_as_float(w.y & 0xffff0000u);
    b[0] = __uint_as_float(w.z << 16); b[1] = __uint_as_float(w.z & 0xffff0000u); b[2] = __uint_as_float(w.w << 16); b[3] = __uint_as_float(w.w & 0xffff0000u); }
struct EpiStore {
    bf16_t* O; int ld; int act;
    __device__ __forceinline__ void operator()(const f32x4 (&acc)[2][2][4][2], const pg8::Unit& u, int wr, int wc, int fr, int fq) const {
        EPI_FOREACH( f32x4 a = v0, b = v1; if (act == 1) { _Pragma("unroll") for (int q = 0; q < 4; ++q) { const float ra = fmaxf(a[q], 0.f), rb = fmaxf(b[q], 0.f); a[q] = ra * ra; b[q] = rb * rb; } }
            *(pg8::u32x4*)(O + (size_t)row * ld + col) = pack8(a, b); )
    }
};
struct EpiResid {
    const float* xlat; const float* xctx; float* olat; float* octx; const float* mod; int gch;
    __device__ __forceinline__ void operator()(const f32x4 (&acc)[2][2][4][2], const pg8::Unit& u, int wr, int wc, int fr, int fq) const {
        const bool lat = u.pm < 64; const float* xb = lat ? xlat : xctx - (size_t)RL * DM; float* ob = lat ? olat : octx - (size_t)RL * DM;
        const float* g = mod + (size_t)(lat ? (u.pm >> 3) : 8) * 6144 + gch * 1024;
        EPI_FOREACH( const f32x4 g0 = *(const f32x4*)(g + col), g1 = *(const f32x4*)(g + col + 4); const size_t o = (size_t)row * DM + col;
            const f32x4 x0 = *(const f32x4*)(xb + o), x1 = *(const f32x4*)(xb + o + 4); *(f32x4*)(ob + o) = x0 + g0 * v0; *(f32x4*)(ob + o + 4) = x1 + g1 * v1; if (bj) asm volatile("" ::: "memory"); )
    }
};
struct EpiMerge {
    pg8::u32x4* stash; bf16_t* MMp;
    __device__ __forceinline__ void operator()(const f32x4 (&acc)[2][2][4][2], const pg8::Unit& u, int wr, int wc, int fr, int fq) const {
        int tid = threadIdx.x; asm volatile("" : "+v"(tid));
        if (u.kind == 0) { EPI_FOREACH( stash[((ai * 4 + m) * 2 + bj) * NT + tid] = pack8(v0, v1); if (bj) asm volatile("" ::: "memory"); ) }
        else { EPI_FOREACH( f32x4 y0, y1; unpack8(stash[((ai * 4 + m) * 2 + bj) * NT + tid], y0, y1); f32x4 t0, t1;
                _Pragma("unroll") for (int q = 0; q < 4; ++q) { t0[q] = sigmoidf_(v0[q]) * y0[q]; t1[q] = sigmoidf_(v1[q]) * y1[q]; }
                pg8::u32x4* mp = (pg8::u32x4*)(MMp + (size_t)row * DM + col);
                if (u.aux != 0) { f32x4 p0, p1; unpack8(*mp, p0, p1); t0 += p0; t1 += p1; }
                *mp = pack8(t0, t1); asm volatile("" ::: "memory"); ) }
    }
};
__device__ __forceinline__ void transpose_item(const float* W, int K, int N, bf16_t* WT, int row_off, LAS float* scr, int item, int lane) {
    const int nblk = N / 32, kb = item / nblk, nb = item % nblk, k0 = 64 * kb, n0 = 32 * nb;
#pragma unroll 8
    for (int i = 0; i < 32; ++i) { const int kk = 2 * i + (lane >> 5); scr[kk * 33 + (lane & 31)] = W[(size_t)(k0 + kk) * N + n0 + (lane & 31)]; }
    asm volatile("s_waitcnt lgkmcnt(0)" ::: "memory");
    const int c = lane & 7;
#pragma unroll
    for (int j = 0; j < 4; ++j) { const int n = (lane >> 3) + 8 * j; const LAS float* sp = scr + (8 * c) * 33 + n;
        pg8::u32x4 o; o.x = pg8::cvt_pk_bf16(sp[0 * 33], sp[1 * 33]); o.y = pg8::cvt_pk_bf16(sp[2 * 33], sp[3 * 33]); o.z = pg8::cvt_pk_bf16(sp[4 * 33], sp[5 * 33]); o.w = pg8::cvt_pk_bf16(sp[6 * 33], sp[7 * 33]);
        *(pg8::u32x4*)(WT + (size_t)(row_off + n0 + n) * K + k0 + 8 * c) = o; }
    asm volatile("s_waitcnt lgkmcnt(0)" ::: "memory");
}
__device__ __forceinline__ void ph_convert_weights(unsigned char* lds, int l, const float* w_in, const float* w1, const float* w2, const float* w_out, const float* w_br, unsigned char* ws) { PH_IDS;
    const int wave = __builtin_amdgcn_readfirstlane(tid_ >> 6), lane = tid_ & 63;
    LAS float* scr = (LAS float*)((LAS unsigned char*)lds + wave * 16384);
    const int gw = bid_ * 8 + wave, NGW = G_ * 8;
    constexpr int I_IN = 16 * 189, I_1 = 16 * 128, I_2 = 64 * 32, I_O = 16 * 32, I_B = 4 * 32;
    constexpr int NITEMS = I_IN + I_1 + I_2 + I_O + 4 * I_B;
    bf16_t* WIN_T = (bf16_t*)(ws + WS_WIN); bf16_t* W1_T = (bf16_t*)(ws + WS_W1); bf16_t* W2_T = (bf16_t*)(ws + WS_W2); bf16_t* WOUT_T = (bf16_t*)(ws + WS_WOUT); bf16_t* WBR_T = (bf16_t*)(ws + WS_WBR);
    for (int it = gw; it < NITEMS; it += NGW) {
        int r = it;
        if (r < I_IN) { const int nb = r % 189; transpose_item(w_in + (size_t)l * DM * INC, DM, INC, WIN_T, nb >= 61 ? 96 : 0, scr, r, lane); continue; } r -= I_IN;
        if (r < I_1) { transpose_item(w1 + (size_t)l * DM * DFF, DM, DFF, W1_T, 0, scr, r, lane); continue; } r -= I_1;
        if (r < I_2) { transpose_item(w2 + (size_t)l * DFF * DM, DFF, DM, W2_T, 0, scr, r, lane); continue; } r -= I_2;
        if (r < I_O) { transpose_item(w_out + (size_t)l * DM * DM, DM, DM, WOUT_T, 0, scr, r, lane); continue; } r -= I_O;
        { const int n = r / I_B; transpose_item(w_br + ((size_t)l * 4 + n) * 256 * DM, 256, DM, WBR_T + (size_t)n * 1024 * 256, 0, scr, r % I_B, lane); }
    }
    GSTRIDE(gi, 96 * 1024 / 8) { *(pg8::u32x4*)(WIN_T + (size_t)1952 * 1024 + (size_t)gi * 8) = (pg8::u32x4){0u, 0u, 0u, 0u}; }
    __syncthreads();
}

constexpr size_t WS_BAR = 7 * MiB;
constexpr int LDS_BYTES = 147456;
struct Args { const float* in[30]; float* out; unsigned char* ws; };
typedef const __attribute__((address_space(4))) Args* CArgs;
__device__ __forceinline__ CArgs kargs() { CArgs p = (CArgs)__builtin_amdgcn_kernarg_segment_ptr(); asm volatile("" : "+s"(p)); return p; }
#define IN(i) (kargs()->in[i])
#define WSB(T, off) ((T*)(kargs()->ws + (off)))
#define OUTP (kargs()->out)
enum { I_X = 0, I_C, I_CTX, I_CCTX, I_ADAW, I_ADAB, I_NMIX, I_NFFN, I_WIN, I_QNORM, I_WUQ, I_KVNORM, I_WUKV, I_QKQ, I_QKK, I_LRE, I_LIM, I_LSTEP, I_BRE, I_BIM, I_CRE, I_CIM, I_S5D, I_WGLU, I_RDEC, I_RGN, I_WBR, I_WOUT, I_W1, I_W2 };
#define GRID_BAR() do { bar.bar = WSB(unsigned, WS_BAR); { unsigned x_ = bar.x; asm volatile("" : "+s"(x_)); bar.x = x_; } xcd_barrier(bar); } while (0)
template <int L> __device__ __forceinline__ void layer_body(unsigned char* lds, XcdBarrier& bar) {
    constexpr int l = L;

#define MODL (WSB(float, WS_MOD) + (size_t)l * 9 * 6144)
#define XLAT (l == 0 ? IN(I_X) : (const float*)OUTP)
#define XCTX (l == 0 ? IN(I_CTX) : (const float*)WSB(float, WS_XC))
#define WINL (IN(I_WIN) + (size_t)l * DM * INC)
#define ZP WSB(bf16_t, WS_Z)
#define XNP WSB(bf16_t, WS_XN)
#define QP WSB(bf16_t, WS_QKV)
#define KP (WSB(bf16_t, WS_QKV) + (size_t)32 * 2304 * 96)
#define VP (WSB(bf16_t, WS_QKV) + (size_t)2 * 32 * 2304 * 96)
#define F1LAT WSB(bf16_t, WS_F1)
#define F1CTX (WSB(bf16_t, WS_F1) + (size_t)8 * 256 * 2 * 2048)
#define QRAWP WSB(bf16_t, WS_RAW)
#define KVRAWP (WSB(bf16_t, WS_RAW) + (size_t)RT * 384)
        ph_s5_lp(l, IN(I_LRE), IN(I_LIM), IN(I_LSTEP), IN(I_BRE), IN(I_BIM), WSB(double2, WS_LP), WSB(double2, WS_BB), WSB(float, WS_LAMT));
        ph_adarms(XLAT, XCTX, IN(I_NMIX) + l * DM, MODL, 0, 1, XNP);
        ph_convert_weights(lds, l, IN(I_WIN), IN(I_W1), IN(I_W2), IN(I_WOUT), IN(I_WBR), kargs()->ws);
        GRID_BAR();
        ph_s5_tz(l, WSB(double2, WS_LP), WSB(double2, WS_BB), IN(I_CRE), IN(I_CIM), IN(I_S5D), WSB(float, WS_TZ));
        ph_s5_ms(WSB(double2, WS_LP), WSB(double2, WS_BB), WSB(bf16_t, WS_MS));
        ph_s5_qo(l, WSB(double2, WS_LP), IN(I_CRE), IN(I_CIM), WSB(bf16_t, WS_QO));
        { SchedGrid S; S.A = (const char*)XNP; S.B = (const char*)WSB(bf16_t, WS_WIN); S.lda = 2048; S.ldb = 2048; S.nt = 16; S.nM = RT / 256; S.nN = 8; S.G = l_grid(); S.c = l_bid(); S.kind = 0; S.aux = 0;
          EpiStore E; E.O = ZP; E.ld = ZW; E.act = 0; pg8::gemm_phase((LAS unsigned char*)lds, S, E); }
        GRID_BAR();
        ph_mla_stats(ZP, WSB(float, WS_RS));
        ph_f1(ZP, WSB(float, WS_TRIG), F1LAT, F1CTX);
        ph_ret_prep(ZP);
        { A_s5u A; A.Z = ZP; B_ms B; B.MS = WSB(bf16_t, WS_MS); E_sloc E; E.S = WSB(float, WS_SLOC); gemm_phase(lds, A, B, E, 16, NCH, 256, 1024); }
        GRID_BAR();
        { A_bf16_scaled A; A.p = ZP; A.ld = ZW; A.coff = C_QC; A.rs = WSB(float, WS_RS); A.rsi = 0; A.w = IN(I_QNORM) + l * 256;
          B_f32 B; B.p = IN(I_WUQ) + (size_t)l * 256 * 384; B.ld = 384; B.coff = 0; E_bf16 E; E.p = QRAWP; E.ld = 384; E.coff = 0;
          gemm_phase(lds, A, B, E, 1, RT, 384, 256); }
        { A_bf16_scaled A; A.p = ZP; A.ld = ZW; A.coff = C_KVC; A.rs = WSB(float, WS_RS); A.rsi = 1; A.w = IN(I_KVNORM) + l * 128;
          B_f32 B; B.p = IN(I_WUKV) + (size_t)l * 128 * 512; B.ld = 512; B.coff = 0; E_bf16 E; E.p = KVRAWP; E.ld = 512; E.coff = 0;
          gemm_phase(lds, A, B, E, 1, RT, 512, 128); }
        ph_s5_scan(WSB(float, WS_SLOC), WSB(float, WS_LAMT), WSB(float, WS_XP));
        { A_dft A; A.trig = WSB(float, WS_TRIG); A.L = 2048; A.mul = 1; B_f1t B; B.p = F1LAT; B.L = 2048;
          E_fourier E; E.Z = ZP; E.rowbase = 0; E.L = 2048; E.scale = 1.0 / sqrt(2048.0 * 64.0);
          gemm_phase(lds, A, B, E, 8, 2048, 256, 4096); }
        { A_dft A; A.trig = WSB(float, WS_TRIG); A.L = 256; A.mul = 8; B_f1t B; B.p = F1CTX; B.L = 256;
          E_fourier E; E.Z = ZP; E.rowbase = RL; E.L = 256; E.scale = 1.0 / sqrt(256.0 * 64.0);
          gemm_phase(lds, A, B, E, 8, 256, 256, 512); }
        ph_ret_mfma(lds, ZP, IN(I_RDEC) + l * 8, IN(I_RGN) + l * 256, 1);
        GRID_BAR();
        ph_mla_post(ZP, QRAWP, KVRAWP, IN(I_QKQ) + l * 96, IN(I_QKK) + l * 96, QP, KP, VP);
        GRID_BAR();
        ph_attn_mfma(lds, QP, KP, VP, ZP, 1);
        { A_s5out A; A.Z = ZP; A.XP = WSB(float, WS_XP); B_s5out B; B.TZ = WSB(float, WS_TZ); B.QO = WSB(bf16_t, WS_QO); E_s5out E; E.YG = WSB(bf16_t, WS_YG); gemm_phase(lds, A, B, E, 16, NCH, 1024, 1280); }
        GRID_BAR();
        { A_bf16 A; A.p = WSB(bf16_t, WS_YG); A.ld = 256; A.coff = 0; B_f32 B; B.p = IN(I_WGLU) + (size_t)l * 256 * 512; B.ld = 512; B.coff = 0; E_bf16 E; E.p = WSB(bf16_t, WS_GL); E.ld = 512; E.coff = 0;
          gemm_phase(lds, A, B, E, 1, RT, 512, 256); }
        GRID_BAR();
        ph_glu(WSB(bf16_t, WS_GL), ZP);
        ph_adarms(XLAT, XCTX, IN(I_NMIX) + l * DM, MODL, 0, 1, XNP);
        GRID_BAR();
        { SchedMerge S; S.Z = (const char*)ZP; S.XN = (const char*)XNP; S.WBR = (const char*)WSB(bf16_t, WS_WBR); S.WING = (const char*)(WSB(bf16_t, WS_WIN) + (size_t)2048 * 1024);
          S.njobs = (RT / 256) * 4; S.G = l_grid(); { const int bx = l_bid(); S.vcu = (bx % 8) * (S.G / 8) + bx / 8; }
          EpiMerge E; E.stash = WSB(pg8::u32x4, WS_STASH) + (size_t)l_bid() * 8192; E.MMp = WSB(bf16_t, WS_MM); pg8::gemm_phase((LAS unsigned char*)lds, S, E); }
        GRID_BAR();
        { SchedGrid S; S.A = (const char*)WSB(bf16_t, WS_MM); S.B = (const char*)WSB(bf16_t, WS_WOUT); S.lda = 2048; S.ldb = 2048; S.nt = 16; S.nM = RT / 256; S.nN = 4; S.G = l_grid(); S.c = l_bid(); S.kind = 0; S.aux = 0;
          EpiResid E; E.xlat = XLAT; E.xctx = XCTX; E.olat = OUTP; E.octx = WSB(float, WS_XC); E.mod = MODL; E.gch = 2; pg8::gemm_phase((LAS unsigned char*)lds, S, E); }
        GRID_BAR();
        ph_adarms(OUTP, WSB(float, WS_XC), IN(I_NFFN) + l * DM, MODL, 3, 4, XNP);
        GRID_BAR();
        { SchedGrid S; S.A = (const char*)XNP; S.B = (const char*)WSB(bf16_t, WS_W1); S.lda = 2048; S.ldb = 2048; S.nt = 16; S.nM = RT / 256; S.nN = 16; S.G = l_grid(); S.c = l_bid(); S.kind = 0; S.aux = 0;
          EpiStore E; E.O = WSB(bf16_t, WS_H); E.ld = DFF; E.act = 1; pg8::gemm_phase((LAS unsigned char*)lds, S, E); }
        GRID_BAR();
        { SchedGrid S; S.A = (const char*)WSB(bf16_t, WS_H); S.B = (const char*)WSB(bf16_t, WS_W2); S.lda = 8192; S.ldb = 8192; S.nt = 64; S.nM = RT / 256; S.nN = 4; S.G = l_grid(); S.c = l_bid(); S.kind = 0; S.aux = 0;
          EpiResid E; E.xlat = OUTP; E.xctx = WSB(float, WS_XC); E.olat = OUTP; E.octx = WSB(float, WS_XC); E.mod = MODL; E.gch = 5; pg8::gemm_phase((LAS unsigned char*)lds, S, E); }
        if (l + 1 < DEPTH) GRID_BAR();
}
__global__ void __launch_bounds__(NT, 2) mega(Args a_unused) {
    extern __shared__ __attribute__((aligned(16))) unsigned char lds[];
    volatile LAS unsigned* bst = (volatile LAS unsigned*)((LAS unsigned char*)lds + LDS_BYTES - 16);
    if (threadIdx.x < 4) bst[threadIdx.x] = 0u;
    __syncthreads();
    XcdBarrier bar = xcd_barrier_post(WSB(unsigned, WS_BAR), bst);

    ph_mod(lds, IN(I_C), IN(I_CCTX), IN(I_ADAW), IN(I_ADAB), WSB(float, WS_MOD));
    ph_trig(WSB(float, WS_TRIG));
    GRID_BAR();
    layer_body<0>(lds, bar);
    layer_body<1>(lds, bar);
}

extern "C" void kernel_launch(void* const* d_in, const int* in_sizes, int n_in, void* d_out, int out_size, void* d_ws, size_t ws_size, hipStream_t stream) {
    static int grid = 0;
    if (grid == 0) {
        if (n_in != 30 || ws_size < WS_END) { fprintf(stderr, "kernel_launch: unexpected n_in %d / ws_size %zu\n", n_in, ws_size); grid = -1; return; }
        int dev = 0, cus = 0, per_cu = 0;
        if (hipGetDevice(&dev) != hipSuccess || hipDeviceGetAttribute(&cus, hipDeviceAttributeMultiprocessorCount, dev) != hipSuccess) { grid = -1; return; }
        if (hipFuncSetAttribute((const void*)mega, hipFuncAttributeMaxDynamicSharedMemorySize, LDS_BYTES) != hipSuccess) { fprintf(stderr, "kernel_launch: hipFuncSetAttribute failed\n"); grid = -1; return; }
        if (hipOccupancyMaxActiveBlocksPerMultiprocessor(&per_cu, (const void*)mega, NT, LDS_BYTES) != hipSuccess || per_cu < 1) fprintf(stderr, "kernel_launch: occupancy query says %d\n", per_cu);
        (void)hipGetLastError();
        grid = cus;
    }
    if (grid < 0) return;
    (void)hipMemsetAsync((char*)d_ws + WS_BAR, 0, XCD_BAR_WORDS * 4, stream);
    Args a; memset((void*)&a, 0, sizeof(a));
    for (int i = 0; i < 30; ++i) a.in[i] = (const float*)d_in[i];
    a.out = (float*)d_out; a.ws = (unsigned char*)d_ws;
    hipLaunchKernelGGL(mega, dim3(grid), dim3(NT), LDS_BYTES, stream, a);
}
```

```cpp
#include <hip/hip_runtime.h>
#include <cstdint>
#include <cstring>
#include <cstdio>

typedef unsigned short bf16_t;
typedef short bf16x8 __attribute__((ext_vector_type(8)));
typedef float f32x4 __attribute__((ext_vector_type(4)));

constexpr int DM = 1024, NB = 8, SEQ = 2048, CTX = 256, DEPTH = 2;
constexpr int RL = NB * SEQ;
constexpr int RC = NB * CTX;
constexpr int RT = RL + RC;
constexpr int INC = 6048;
constexpr int ZW = 2048;
constexpr int C_KVC = 0, C_KR = 128, C_S5 = 160, C_RK = 416, C_RV = 672, C_QC = 928, C_FU = 1184, C_RQ = 1440, C_RG = 1696, C_GATE = 1952;
constexpr int DFF = 4096;
constexpr int TCH = 64;
constexpr int NCH = RT / TCH;
constexpr float EPS = 1e-6f;
#define PI_D 3.14159265358979323846

__device__ __forceinline__ float bf2f(bf16_t v) { return __uint_as_float(((unsigned)v) << 16); }
__device__ __forceinline__ bf16_t f2bf(float f) { unsigned u = __float_as_uint(f); return (bf16_t)((u + 0x7fffu + ((u >> 16) & 1u)) >> 16); }
__device__ __forceinline__ float sigmoidf_(float x) { return 1.f / (1.f + __expf(-x)); }
__device__ __forceinline__ float siluf_(float x) { return x * sigmoidf_(x); }
__device__ __forceinline__ float geluf_(float x) { return 0.5f * x * (1.f + tanhf(0.7978845608028654f * (x + 0.044715f * x * x * x))); }
__device__ __forceinline__ int row_batch(int row) { return row < RL ? (row >> 11) : ((row - RL) >> 8); }
__device__ __forceinline__ int row_modidx(int row) { return row < RL ? (row >> 11) : 8; }

constexpr size_t MiB = 1ull << 20;
constexpr size_t WS_MOD = 0;
constexpr size_t WS_RS = 1 * MiB;
constexpr size_t WS_TRIG = WS_RS + 256 * 1024;
constexpr size_t WS_LAMT = WS_TRIG + 32 * 1024;
constexpr size_t WS_LP = 2 * MiB;
constexpr size_t WS_BB = 5 * MiB;
constexpr size_t WS_W = 8 * MiB;
constexpr size_t WS_WIN = WS_W, WS_W1 = WS_W + 12 * MiB, WS_W2 = WS_W + 20 * MiB, WS_WOUT = WS_W + 28 * MiB, WS_WBR = WS_W + 30 * MiB;
constexpr size_t WS_XN = 40 * MiB;
constexpr size_t WS_RAW = WS_XN;
constexpr size_t WS_YG = WS_XN;
constexpr size_t WS_Z = 76 * MiB;
constexpr size_t WS_QKV = 148 * MiB;
constexpr size_t WS_F1 = 184 * MiB;
constexpr size_t WS_GL = WS_F1;
constexpr size_t WS_TZ = 202 * MiB;
constexpr size_t WS_MS = 204 * MiB;
constexpr size_t WS_QO = 212 * MiB;
constexpr size_t WS_SLOC = 220 * MiB;
constexpr size_t WS_XP = 225 * MiB;
constexpr size_t WS_XC = 230 * MiB;
constexpr size_t WS_MM = WS_QKV;
constexpr size_t WS_STASH = WS_F1;
constexpr size_t WS_H = WS_Z;
constexpr size_t WS_WGLU = 6 * MiB;
constexpr size_t WS_DFTL = 238 * MiB;
constexpr size_t WS_DFTC = 254 * MiB;
constexpr size_t WS_END = 256 * MiB;


#define LAS __attribute__((address_space(3)))
#define NT 512
__device__ __forceinline__ int l_tid() { int t = threadIdx.x; asm volatile("" : "+v"(t)); return t; }
__device__ __forceinline__ int l_bid() { int b = blockIdx.x; asm volatile("" : "+s"(b)); return b; }
__device__ __forceinline__ int l_grid() { int g = gridDim.x; asm volatile("" : "+s"(g)); return g; }
#define PH_IDS const int tid_ = l_tid(), bid_ = l_bid(), G_ = l_grid(); (void)tid_; (void)bid_; (void)G_
template <class AF, class BF, class EF>
__device__ __forceinline__ void gemm_tile(const AF& A, const BF& B, const EF& E, bool valid, int b, int m0, int n0, int M, int N, int K, bf16_t (*sA)[40], bf16_t (*sB)[40], int ht) {
    f32x4 accm[2][2];
#pragma unroll
    for (int i = 0; i < 2; ++i)
#pragma unroll
        for (int j = 0; j < 2; ++j) accm[i][j] = (f32x4){0.f, 0.f, 0.f, 0.f};
    const int w = ht >> 6, lane = ht & 63, wm = (w >> 1) * 32, wn = (w & 1) * 32, fr = lane & 15, fq = lane >> 4;
    for (int k0 = 0; k0 < K; k0 += 32) {
        __syncthreads();
#pragma unroll
        for (int i = 0; i < 8; ++i) {
            const int e = ht + i * 256;
            { const int m = e >> 5, k = e & 31; float v = 0.f; if (valid && m0 + m < M && k0 + k < K) v = A(b, m0 + m, k0 + k); sA[m][k] = f2bf(v); }
            { const int k = e >> 6, n = e & 63; float v = 0.f; if (valid && n0 + n < N && k0 + k < K) v = B(b, k0 + k, n0 + n); sB[n][k] = f2bf(v); }
        }
        __syncthreads();
        bf16x8 af[2], bfr[2];
#pragma unroll
        for (int i = 0; i < 2; ++i) { af[i] = *(const bf16x8*)&sA[wm + i * 16 + fr][fq * 8]; bfr[i] = *(const bf16x8*)&sB[wn + i * 16 + fr][fq * 8]; }
#pragma unroll
        for (int i = 0; i < 2; ++i)
#pragma unroll
            for (int j = 0; j < 2; ++j) accm[i][j] = __builtin_amdgcn_mfma_f32_16x16x32_bf16(af[i], bfr[j], accm[i][j], 0, 0, 0);
    }
    if (valid) {
#pragma unroll
        for (int i = 0; i < 2; ++i)
#pragma unroll
            for (int j = 0; j < 2; ++j)
#pragma unroll
                for (int rr = 0; rr < 4; ++rr) {
                    const int m = m0 + wm + i * 16 + fq * 4 + rr, n = n0 + wn + j * 16 + fr;
                    if (m < M && n < N) E(b, m, n, accm[i][j][rr]);
                }
    }
}
template <class AF, class BF, class EF>
__device__ __forceinline__ void gemm_phase(unsigned char* lds, const AF& A, const BF& B, const EF& E, int nbatch, int M, int N, int K) {
    PH_IDS; const int tid = tid_, half = tid >> 8, ht = tid & 255;
    bf16_t (*sA)[40] = (bf16_t (*)[40])(lds + half * 10240);
    bf16_t (*sB)[40] = (bf16_t (*)[40])(lds + half * 10240 + 5120);
    const int tm = (M + 63) >> 6, tn = (N + 63) >> 6, total = nbatch * tm * tn;
    for (int it0 = bid_ * 2; it0 < total; it0 += G_ * 2) {
        const int it = it0 + half; const bool valid = it < total;
        const int itc = valid ? it : 0;
        const int b = itc / (tm * tn), r = itc % (tm * tn), m0 = (r / tn) * 64, n0 = (r % tn) * 64;
        gemm_tile(A, B, E, valid, b, m0, n0, M, N, K, sA, sB, ht);
    }
    __syncthreads();
}
template <class T> static T zeroed() { T t; memset((void*)&t, 0, sizeof(T)); return t; }

struct A_bf16 { const bf16_t* p; long long ld; long long coff;
    __device__ float operator()(int, int m, int k) const { return bf2f(p[(size_t)m * ld + coff + k]); } };
struct A_bf16_scaled { const bf16_t* p; long long ld; long long coff; const float* rs; long long rsi; const float* w;
    __device__ float operator()(int, int m, int k) const { return bf2f(p[(size_t)m * ld + coff + k]) * rs[(size_t)m * 2 + rsi] * w[k]; } };
struct B_f32 { const float* p; long long ld; long long coff;
    __device__ float operator()(int, int k, int n) const { return p[(size_t)k * ld + coff + n]; } };
struct E_bf16 { bf16_t* p; long long ld; long long coff;
    __device__ void operator()(int, int m, int n, float v) const { p[(size_t)m * ld + coff + n] = f2bf(v); } };

#define XB_TMO      128
#define XB_XCNT(j)  (256  + 64 * (j))
#define XB_XSUB(j)  (1280 + 64 * (j))
#define XB_XGEN(j)  (2304 + 64 * (j))
#define XB_TOP      3328
#define XB_TOPGEN   3392
#define XCD_BAR_WORDS 3456
#define XB_SPIN_CAP (1u << 18)
__device__ __forceinline__ unsigned xb_ld(unsigned* p)              { return __hip_atomic_load(p, __ATOMIC_RELAXED, __HIP_MEMORY_SCOPE_AGENT); }
__device__ __forceinline__ unsigned xb_add(unsigned* p, unsigned v) { return __hip_atomic_fetch_add(p, v, __ATOMIC_RELAXED, __HIP_MEMORY_SCOPE_AGENT); }
__device__ __forceinline__ unsigned xb_xcc_id() { return (unsigned)__builtin_amdgcn_s_getreg((3 << 11) | 20) & 0xFu; }
#define XB_SPIN(cond, bar) do { unsigned _sp = 0; while (cond) { __builtin_amdgcn_s_sleep(1); \
    if ((++_sp & 255u) == 0u) { if (xb_ld(&(bar)[XB_TMO])) break; if (_sp > XB_SPIN_CAP) { atomicAdd(&(bar)[XB_TMO], 1u); break; } } } } while (0)
struct XcdBarrier { unsigned* bar; unsigned x; volatile LAS unsigned* st; };
__device__ __forceinline__ XcdBarrier xcd_barrier_post(unsigned* bar, volatile LAS unsigned* st) {
    XcdBarrier b; b.bar = bar; b.x = xb_xcc_id(); b.st = st;
    if (threadIdx.x == 0) (void)xb_add(&bar[XB_XCNT(b.x)], 1u);
    return b;
}
__device__ __forceinline__ void xcd_barrier_complete(unsigned* bar, unsigned x, unsigned& nloc, unsigned& nx) {
    const unsigned G = gridDim.x * gridDim.y * gridDim.z;
    unsigned sum, cnt, mine, sp = 0u;
    for (;;) {
        sum = 0u; cnt = 0u; mine = 0u;
#pragma unroll
        for (unsigned j = 0; j < 16; ++j) { const unsigned c = xb_ld(&bar[XB_XCNT(j)]); sum += c; cnt += (c > 0u) ? 1u : 0u; mine = (j == x) ? c : mine; }
        if (sum == G) break;
        __builtin_amdgcn_s_sleep(1);
        if ((++sp & 255u) == 0u) { if (xb_ld(&bar[XB_TMO])) break; if (sp > XB_SPIN_CAP) { atomicAdd(&bar[XB_TMO], 1u); break; } }
    }
    nloc = mine > 0u ? mine : 1u; nx = cnt > 0u ? cnt : 1u;
}
__device__ __forceinline__ void xcd_barrier(const XcdBarrier& b) {
    asm volatile("s_waitcnt vmcnt(0)" ::: "memory");
    __syncthreads();
    if (threadIdx.x == 0) {
        unsigned* bar = b.bar;
        __builtin_amdgcn_s_waitcnt(0);
        unsigned nloc = b.st[0], nx = b.st[1];
        if (nloc == 0u) { xcd_barrier_complete(bar, b.x, nloc, nx); b.st[0] = nloc; b.st[1] = nx; }
        const unsigned old = xb_add(&bar[XB_XSUB(b.x)], 1u);
        const unsigned gen = old / nloc;
        if (old + 1u == (gen + 1u) * nloc) {
            __builtin_amdgcn_fence(__ATOMIC_RELEASE, "agent");
            asm volatile("s_waitcnt vmcnt(0)" ::: "memory");
            const unsigned og = xb_add(&bar[XB_TOP], 1u);
            const unsigned tg = og / nx;
            if (og + 1u == (tg + 1u) * nx) xb_add(&bar[XB_TOPGEN], 1u);
            else XB_SPIN(xb_ld(&bar[XB_TOPGEN]) == tg, bar);
            __builtin_amdgcn_fence(__ATOMIC_ACQUIRE, "agent");
            xb_add(&bar[XB_XGEN(b.x)], 1u);
            asm volatile("s_waitcnt vmcnt(0)" ::: "memory");
        } else {
            XB_SPIN(xb_ld(&bar[XB_XGEN(b.x)]) == gen, bar);
            __builtin_amdgcn_fence(__ATOMIC_ACQUIRE, "agent");
            asm volatile("s_waitcnt vmcnt(0)" ::: "memory");
        }
    }
    __syncthreads();
}

namespace pg8 {
typedef unsigned u32x4 __attribute__((ext_vector_type(4)));
constexpr int BM = 256, BK = 64, HALF = 128, HTB = HALF * BK * 2, STAGE_BYTES = 8 * HTB, NXCD = 8, WGM = 8;
__device__ __forceinline__ int lds_byte(int r, int c) { const int st = (r >> 4) * 2 + (c >> 5), rr = r & 15, cc = c & 31, ob = rr * 64 + cc * 2; return st * 1024 + (ob ^ (((ob >> 9) & 1) << 5)); }
__device__ __forceinline__ void stage_rc(int b, int& R, int& C) { const int st = b / 1024, sb = b % 1024, swz = sb ^ (((sb >> 9) & 1) << 5); R = (st >> 1) * 16 + swz / 64; C = (st & 1) * 32 + (swz % 64) / 2; }
__device__ __forceinline__ int perm32(int rho) { const int n = rho >> 4, i = rho & 15; return 8 * (i >> 2) + 4 * n + (i & 3); }
struct Unit { const char* A; const char* B; unsigned lda, ldb; int nt, pm, pn, kind, aux; };
__device__ __forceinline__ unsigned cvt_pk_bf16(float lo, float hi) { unsigned r; asm volatile("v_cvt_pk_bf16_f32 %0, %1, %2" : "=v"(r) : "v"(lo), "v"(hi)); return r; }
__device__ __forceinline__ bool static_tile(int nM, int nN, int G, int c, int i, int& pm, int& pn) {
    const int nwg = nM * nN; const long L = (long)i * G + c; if (L >= nwg) return false;
    int wgid = (int)L; { const int q = nwg / NXCD, r = nwg % NXCD, xcd = wgid % NXCD, off = wgid / NXCD; wgid = (xcd < r ? xcd * (q + 1) : r * (q + 1) + (xcd - r) * q) + off; }
    const int nig = WGM * nN, gid = wgid / nig, fm = gid * WGM, gsz = (nM - fm) < WGM ? (nM - fm) : WGM;
    pm = fm + ((wgid % nig) % gsz); pn = (wgid % nig) / gsz; return true;
}
template <class Epi, class Sched>
__device__ __forceinline__ void gemm_phase(LAS unsigned char* lds, const Sched& S, const Epi& E) {
    const int tid = l_tid(), wid = __builtin_amdgcn_readfirstlane(tid >> 6), lane = tid & 63, wr = wid >> 2, wc = wid & 3, fr = lane & 15, fq = lane >> 4;
    int sR[2], sRb[2], sC2[2];
#pragma unroll
    for (int i = 0; i < 2; ++i) { int R, C; stage_rc(tid * 16 + i * 8192, R, C); sR[i] = R; sRb[i] = (R & ~31) + perm32(R & 31); sC2[i] = C * 2; }
    const size_t kstep = (size_t)(BK * 2);
    const unsigned ldsw = (unsigned)wid * 1024u;
    const int aoff = lds_byte(wr * 64 + fr, fq * 8), boff = lds_byte(wc * 32 + fr, fq * 8);
#define PG8_SA(b, h) (((b) * 2 + (h)) * HTB)
#define PG8_SB(b, h) ((4 + (b) * 2 + (h)) * HTB)
#define PG8_STAGE_A(bufoff, gbase, ld) do { \
        __builtin_amdgcn_global_load_lds((const unsigned*)((const char*)(gbase) + (unsigned)(sR[0] * (ld) + sC2[0])), (LAS unsigned*)(lds + (bufoff) + ldsw), 16, 0, 0); \
        __builtin_amdgcn_global_load_lds((const unsigned*)((const char*)(gbase) + (unsigned)(sR[1] * (ld) + sC2[1])), (LAS unsigned*)(lds + (bufoff) + ldsw + 8192), 16, 0, 0); } while (0)
#define PG8_STAGE_B(bufoff, gbase, ld) do { \
        __builtin_amdgcn_global_load_lds((const unsigned*)((const char*)(gbase) + (unsigned)(sRb[0] * (ld) + sC2[0])), (LAS unsigned*)(lds + (bufoff) + ldsw), 16, 0, 0); \
        __builtin_amdgcn_global_load_lds((const unsigned*)((const char*)(gbase) + (unsigned)(sRb[1] * (ld) + sC2[1])), (LAS unsigned*)(lds + (bufoff) + ldsw + 8192), 16, 0, 0); } while (0)
#define PG8_LDA(dst, b, h) do { _Pragma("unroll") for (int m = 0; m < 4; ++m) _Pragma("unroll") for (int k = 0; k < 2; ++k) dst[m][k] = *(const LAS bf16x8*)(lds + PG8_SA(b, h) + aoff + m * 2048 + k * 1024); } while (0)
#define PG8_LDB(dst, b, h) do { _Pragma("unroll") for (int n = 0; n < 2; ++n) _Pragma("unroll") for (int k = 0; k < 2; ++k) dst[n][k] = *(const LAS bf16x8*)(lds + PG8_SB(b, h) + boff + n * 2048 + k * 1024); } while (0)
#define PG8_MMA(ai, bj, At, Bt) do { __builtin_amdgcn_s_setprio(1); _Pragma("unroll") for (int m = 0; m < 4; ++m) _Pragma("unroll") for (int n = 0; n < 2; ++n) _Pragma("unroll") for (int k = 0; k < 2; ++k) \
        acc[ai][bj][m][n] = __builtin_amdgcn_mfma_f32_16x16x32_bf16(Bt[n][k], At[m][k], acc[ai][bj][m][n], 0, 0, 0); __builtin_amdgcn_s_setprio(0); } while (0)
#define PG8_WAIT_V(n) asm volatile("s_waitcnt vmcnt(" #n ")" ::: "memory")
#define PG8_WAIT_L(n) asm volatile("s_waitcnt lgkmcnt(" #n ")" ::: "memory")
#define PG8_BAR __builtin_amdgcn_s_barrier()
#define PG8_SCHED __builtin_amdgcn_sched_barrier(0)
    Unit cur, nxt; int ui = 0;
    if (!S.next(0, cur)) return;
    f32x4 acc[2][2][4][2];
#pragma unroll
    for (int a = 0; a < 2; ++a)
#pragma unroll
        for (int b = 0; b < 2; ++b)
#pragma unroll
            for (int m = 0; m < 4; ++m)
#pragma unroll
                for (int n = 0; n < 2; ++n) acc[a][b][m][n] = (f32x4){0.f, 0.f, 0.f, 0.f};
    bf16x8 At[4][2], B0[2][2], B1[2][2];
    const char* cA = cur.A; const char* cB = cur.B;
    int clda = cur.lda, cldb = cur.ldb;
    PG8_STAGE_B(PG8_SB(0, 0), cB, cldb); PG8_STAGE_B(PG8_SB(0, 1), cB + (size_t)HALF * cldb, cldb); PG8_STAGE_A(PG8_SA(0, 0), cA, clda); PG8_STAGE_A(PG8_SA(0, 1), cA + (size_t)HALF * clda, clda);
    if (wr == 1) PG8_BAR;
    PG8_WAIT_V(2); PG8_BAR;
    PG8_STAGE_B(PG8_SB(1, 0), cB + kstep, cldb); PG8_STAGE_A(PG8_SA(1, 0), cA + kstep, clda); PG8_STAGE_B(PG8_SB(1, 1), cB + (size_t)HALF * cldb + kstep, cldb);
    PG8_WAIT_V(6); PG8_BAR;
    for (;;) {
        const bool has_next = S.next(ui + 1, nxt);
        const char* nA = has_next ? nxt.A : cA; const char* nB = has_next ? nxt.B : cB;
        const int nlda = has_next ? (int)nxt.lda : clda, nldb = has_next ? (int)nxt.ldb : cldb;
        const int nt = cur.nt;
        for (int t = 0; t < nt; t += 2) {
            const bool last = (t == nt - 2);
            const char* a1 = cA + (size_t)(t + 1) * kstep;
            const char* a2 = last ? nA : cA + (size_t)(t + 2) * kstep; const char* b2 = last ? nB : cB + (size_t)(t + 2) * kstep;
            const char* a3 = a2 + kstep; const char* b3 = b2 + kstep;
            const int lda2 = last ? nlda : clda, ldb2 = last ? nldb : cldb;
            PG8_LDB(B0, 0, 0); PG8_LDB(B1, 0, 1); PG8_SCHED; PG8_LDA(At, 0, 0); PG8_STAGE_A(PG8_SA(1, 1), a1 + (size_t)HALF * clda, clda);
            PG8_WAIT_V(8); PG8_WAIT_L(0); PG8_BAR; PG8_MMA(0, 0, At, B0); PG8_MMA(0, 1, At, B1); PG8_BAR; PG8_SCHED;
            PG8_LDA(At, 0, 1); PG8_STAGE_B(PG8_SB(0, 0), b2, ldb2); PG8_STAGE_B(PG8_SB(0, 1), b2 + (size_t)HALF * ldb2, ldb2); PG8_STAGE_A(PG8_SA(0, 0), a2, lda2);
            PG8_WAIT_V(8); PG8_WAIT_L(0); PG8_BAR; PG8_MMA(1, 0, At, B0); PG8_MMA(1, 1, At, B1); PG8_BAR; PG8_SCHED;
            PG8_LDB(B0, 1, 0); PG8_LDB(B1, 1, 1); PG8_SCHED; PG8_LDA(At, 1, 0); PG8_STAGE_A(PG8_SA(0, 1), a2 + (size_t)HALF * lda2, lda2);
            PG8_WAIT_V(8); PG8_WAIT_L(0); PG8_BAR; PG8_MMA(0, 0, At, B0); PG8_MMA(0, 1, At, B1); PG8_BAR; PG8_SCHED;
            PG8_LDA(At, 1, 1); PG8_STAGE_B(PG8_SB(1, 0), b3, ldb2); PG8_STAGE_B(PG8_SB(1, 1), b3 + (size_t)HALF * ldb2, ldb2); PG8_STAGE_A(PG8_SA(1, 0), a3, lda2);
            PG8_WAIT_V(8); PG8_WAIT_L(0); PG8_BAR; PG8_MMA(1, 0, At, B0); PG8_MMA(1, 1, At, B1); PG8_BAR; PG8_SCHED;
        }
        if (wr == 0) PG8_BAR;
        E(acc, cur, wr, wc, fr, fq);
        if (!has_next) break;
#pragma unroll
        for (int a = 0; a < 2; ++a)
#pragma unroll
            for (int b = 0; b < 2; ++b)
#pragma unroll
                for (int m = 0; m < 4; ++m)
#pragma unroll
                    for (int n = 0; n < 2; ++n) acc[a][b][m][n] = (f32x4){0.f, 0.f, 0.f, 0.f};
        cur = nxt; cA = nA; cB = nB; clda = nlda; cldb = nldb; ++ui;
        if (wr == 1) PG8_BAR;
    }
    PG8_WAIT_V(0);
    PG8_BAR;
#undef PG8_SA
#undef PG8_SB
#undef PG8_STAGE_A
#undef PG8_STAGE_B
#undef PG8_LDA
#undef PG8_LDB
#undef PG8_MMA
#undef PG8_WAIT_V
#undef PG8_WAIT_L
#undef PG8_BAR
#undef PG8_SCHED
}
}

#define GSTRIDE(gi, total) for (int gi = bid_ * NT + tid_; gi < (total); gi += G_ * NT)
__device__ __forceinline__ void ph_mod(unsigned char* lds, const float* c, const float* c_ctx, const float* ada_w, const float* ada_b, float* mod) { PH_IDS;
    float (*sl)[1024] = (float (*)[1024])lds;
    for (int e = tid_; e < 9 * 1024; e += NT) { const int j = e >> 10, k = e & 1023; const float v = j < 8 ? c[j * 1024 + k] : c_ctx[k]; sl[j][k] = siluf_(v); }
    __syncthreads();
    GSTRIDE(gi, 2 * 6144) {
        const int l = gi / 6144, n = gi % 6144;
        float acc[9];
#pragma unroll
        for (int j = 0; j < 9; ++j) acc[j] = 0.f;
        const float* w = ada_w + (size_t)l * 1024 * 6144 + n;
        for (int k = 0; k < 1024; ++k) { const float wv = w[(size_t)k * 6144];
#pragma unroll
            for (int j = 0; j < 9; ++j) acc[j] += sl[j][k] * wv; }
        const float bb = ada_b[l * 6144 + n];
#pragma unroll
        for (int j = 0; j < 9; ++j) mod[((size_t)l * 9 + j) * 6144 + n] = acc[j] + bb;
    }
    __syncthreads();
}
__device__ __forceinline__ void ph_trig(float* trig) { PH_IDS; GSTRIDE(i, 2048) { const float xx = (float)i * (1.f / 1024.f); trig[i] = cospif(xx); trig[2048 + i] = sinpif(xx); } }
__device__ __forceinline__ double2 lam_pow(double re, double im, double dt, int k) {
    const double m = (double)__expf((float)(re * dt * k));
    double xx = im * dt * (double)k * 0.318309886183790671538;
    xx -= 2.0 * rint(xx * 0.5);
    const float xf = (float)xx;
    return make_double2(m * (double)cospif(xf), m * (double)sinpif(xf));
}
__device__ __forceinline__ void ph_s5_lp(int l, const float* lam_re, const float* lam_im, const float* log_step, const float* b_re, const float* b_im, double2* LP, double2* BB, float* lamT) { PH_IDS;
    GSTRIDE(i, 2 * 16 * 64) {
        const int d = i / 1024, g = (i / 64) % 16, p = i % 64;
        const size_t li = ((size_t)(l * 2 + d) * 16 + g) * 64 + p;
        const double re = lam_re[li], im = lam_im[li], dt = (double)expf(log_step[(l * 2 + d) * 16 + g]);
        for (int k = 0; k <= 64; ++k) LP[(size_t)i * 65 + k] = lam_pow(re, im, dt, k);
        const double2 l1 = lam_pow(re, im, dt, 1);
        const double nr = l1.x - 1.0, ni = l1.y, den = re * re + im * im;
        const double fr = (nr * re + ni * im) / den, fi = (ni * re - nr * im) / den;
        for (int h = 0; h < 16; ++h) { const double br = b_re[li * 16 + h], bi = b_im[li * 16 + h]; BB[(size_t)i * 16 + h] = make_double2(fr * br - fi * bi, fr * bi + fi * br); }
        const double2 l64 = lam_pow(re, im, dt, 64);
        lamT[((size_t)(g * 2 + d) * 64 + p) * 2 + 0] = (float)l64.x; lamT[((size_t)(g * 2 + d) * 64 + p) * 2 + 1] = (float)l64.y;
    }
}
__device__ __forceinline__ void ph_s5_tz(int l, const double2* LP, const double2* BB, const float* c_re, const float* c_im, const float* s5_d, bf16_t* TZT) { PH_IDS;
    GSTRIDE(i, 16 * 127 * 256) {
        const int g = i / (127 * 256), dd = (i / 256) % 127, h = (i / 16) % 16, hp = i % 16;
        const int delta = dd - 63;
        double acc = 0.0;
        for (int d = 0; d < 2; ++d) {
            if ((d == 0 && delta < 0) || (d == 1 && delta > 0)) continue;
            const int tau = delta < 0 ? -delta : delta;
            for (int p = 0; p < 64; ++p) {
                const size_t ci = (((size_t)(l * 2 + d) * 16 + g) * 16 + h) * 64 + p;
                const double cr = c_re[ci], cim = c_im[ci];
                const size_t gi = ((size_t)d * 16 + g) * 64 + p;
                const double2 lp = LP[gi * 65 + tau], bb = BB[gi * 16 + hp];
                const double xr = lp.x * bb.x - lp.y * bb.y, xi = lp.x * bb.y + lp.y * bb.x;
                acc += cr * xr - cim * xi;
            }
        }
        if (delta == 0 && h == hp) acc += (double)s5_d[l * 256 + g * 16 + h];
        TZT[i] = f2bf((float)acc);
    }
}
__device__ __forceinline__ void ph_s5_ms(const double2* LP, const double2* BB, bf16_t* MST) { PH_IDS;
    GSTRIDE(i, 16 * 128 * 1024) {
        const int g = i / (128 * 1024), dp = (i / 1024) % 128, sh = i % 1024, d = dp / 64, p = dp % 64, s = sh / 16, hp = sh % 16;
        const size_t gi = ((size_t)d * 16 + g) * 64 + p;
        const double2 lp = LP[gi * 65 + (d == 0 ? 63 - s : s)], bb = BB[gi * 16 + hp];
        bf16_t* o = MST + ((size_t)g * 256 + d * 128 + p) * 1024 + sh;
        o[0] = f2bf((float)(lp.x * bb.x - lp.y * bb.y)); o[(size_t)64 * 1024] = f2bf((float)(lp.x * bb.y + lp.y * bb.x));
    }
}
__device__ __forceinline__ void ph_s5_qo(int l, const double2* LP, const float* c_re, const float* c_im, bf16_t* QOT) { PH_IDS;
    GSTRIDE(i, 16 * 1024 * 128) {
        const int g = i / (128 * 1024), th = (i / 128) % 1024, dp = i % 128, d = dp / 64, p = dp % 64, t = th / 16, h = th % 16;
        const size_t ci = (((size_t)(l * 2 + d) * 16 + g) * 16 + h) * 64 + p;
        const double cr = c_re[ci], cim = c_im[ci];
        const double2 lp = LP[(((size_t)d * 16 + g) * 64 + p) * 65 + (d == 0 ? t + 1 : 64 - t)];
        bf16_t* o = QOT + ((size_t)g * 1024 + th) * 256 + d * 128 + p;
        o[0] = f2bf((float)(cr * lp.x - cim * lp.y)); o[64] = f2bf((float)(-(cr * lp.y + cim * lp.x)));
    }
}
__device__ __forceinline__ void ph_adarms(const float* xlat, const float* xctx, const float* w, const float* mod, int sh_chunk, int sc_chunk, bf16_t* out, int nrows) { PH_IDS;
    const int wave = (bid_ * NT + tid_) >> 6, lane = tid_ & 63, nw = (G_ * NT) >> 6;
    for (int row = wave; row < nrows; row += nw) {
        const float* x = row < RL ? xlat + (size_t)row * DM : xctx + (size_t)(row - RL) * DM;
        float v[16]; float ss = 0.f;
#pragma unroll
        for (int j = 0; j < 4; ++j) { const f32x4 t = *(const f32x4*)(x + j * 256 + lane * 4); v[j * 4] = t[0]; v[j * 4 + 1] = t[1]; v[j * 4 + 2] = t[2]; v[j * 4 + 3] = t[3]; ss += t[0] * t[0] + t[1] * t[1] + t[2] * t[2] + t[3] * t[3]; }
#pragma unroll
        for (int o = 1; o < 64; o <<= 1) ss += __shfl_xor(ss, o);
        const float rstd = rsqrtf(ss * (1.f / DM) + EPS);
        const float* mrow = mod + (size_t)row_modidx(row) * 6144;
#pragma unroll
        for (int j = 0; j < 4; ++j)
#pragma unroll
            for (int q = 0; q < 4; ++q) { const int cidx = j * 256 + lane * 4 + q; const float y = v[j * 4 + q] * rstd * w[cidx] * (1.f + mrow[sc_chunk * 1024 + cidx]) + mrow[sh_chunk * 1024 + cidx]; out[(size_t)row * DM + cidx] = f2bf(y); }
    }
}
__device__ __forceinline__ void ph_mla_stats(const bf16_t* Z, float* rs) { PH_IDS;
    const int wave = (bid_ * NT + tid_) >> 6, lane = tid_ & 63, nw = (G_ * NT) >> 6;
    for (int row = wave; row < RT; row += nw) {
        const bf16_t* z = Z + (size_t)row * ZW; float sq = 0.f, sk = 0.f;
#pragma unroll
        for (int j = 0; j < 4; ++j) { const float v = bf2f(z[C_QC + j * 64 + lane]); sq += v * v; }
#pragma unroll
        for (int j = 0; j < 2; ++j) { const float v = bf2f(z[C_KVC + j * 64 + lane]); sk += v * v; }
#pragma unroll
        for (int o = 1; o < 64; o <<= 1) { sq += __shfl_xor(sq, o); sk += __shfl_xor(sk, o); }
        if (lane == 0) { rs[(size_t)row * 2] = rsqrtf(sq * (1.f / 256) + EPS); rs[(size_t)row * 2 + 1] = rsqrtf(sk * (1.f / 128) + EPS); }
    }
}
__device__ __forceinline__ void ph_mla_post(const bf16_t* Z, const bf16_t* qraw, const bf16_t* kvraw, const float* qkq, const float* qkk, bf16_t* Q, bf16_t* Kb, bf16_t* Vb) { PH_IDS;
    GSTRIDE(gi, RT * 8) {
        const int row = gi >> 3, h = (gi >> 1) & 3, isk = gi & 1;
        const bool lat = row < RL; const int b = row_batch(row), t = lat ? (row & 2047) : ((row - RL) & 255);
        const int qi = lat ? t : 2048 + t, ki = lat ? 256 + t : t;
        float v[96];
        float ss = 0.f;
        if (!isk) {
#pragma unroll
            for (int i = 0; i < 96; ++i) v[i] = bf2f(qraw[(size_t)row * 384 + h * 96 + i]);
        } else {
#pragma unroll
            for (int i = 0; i < 64; ++i) v[i] = bf2f(kvraw[(size_t)row * 512 + h * 128 + i]);
#pragma unroll
            for (int i = 0; i < 32; ++i) v[64 + i] = bf2f(Z[(size_t)row * ZW + C_KR + i]);
        }
#pragma unroll
        for (int i = 0; i < 96; ++i) ss += v[i] * v[i];
        const float rr = rsqrtf(ss * (1.f / 96) + EPS) * (isk ? 1.f : 0.14724727430627066f);
        const float* wv = isk ? qkk : qkq;
#pragma unroll
        for (int i = 0; i < 96; ++i) v[i] = v[i] * rr * wv[i];
        if (lat) {
            const float prow = (float)(t >> 6), pcol = (float)(t & 63);
#pragma unroll
            for (int part = 0; part < 2; ++part) { const float pos = part ? pcol : prow; const int base = 64 + part * 16;
#pragma unroll
                for (int j = 0; j < 8; ++j) { const float fr = exp2f(-(float)j * (13.287712379549449f / 8.f)), a = pos * fr, cs = __cosf(a), sn = __sinf(a);
                    const float x1 = v[base + j], x2 = v[base + 8 + j]; v[base + j] = x1 * cs - x2 * sn; v[base + 8 + j] = x1 * sn + x2 * cs; } }
        }
        bf16_t* o = isk ? Kb + ((size_t)(b * 4 + h) * 2304 + ki) * 96 : Q + ((size_t)(b * 4 + h) * 2304 + qi) * 96;
#pragma unroll
        for (int i = 0; i < 96; ++i) o[i] = f2bf(v[i]);
        if (isk) { bf16_t* vo = Vb + ((size_t)(b * 4 + h) * 2304 + ki) * 64; for (int i = 0; i < 64; ++i) vo[i] = kvraw[(size_t)row * 512 + h * 128 + 64 + i]; }
    }
}
__device__ __forceinline__ void ph_attn(unsigned char* lds, const bf16_t* Q, const bf16_t* Kb, const bf16_t* Vb, bf16_t* Z, int with_ctx) { PH_IDS;
    float (*sK)[96] = (float (*)[96])lds; float (*sV)[64] = (float (*)[64])(lds + 32 * 96 * 4);
    const int nunits = 32 * (8 + (with_ctx ? 1 : 0));
    const int qt = tid_ & 255, dh = (tid_ >> 8) * 32;
    for (int u = bid_; u < nunits; u += G_) {
        const int bh = u % 32, qb = u / 32;
        const bool lat = qb < 8;
        const int qi = qb * 256 + qt, nkeys = lat ? 2304 : 256;
        float q[96], o[32];
        const bf16_t* qp = Q + ((size_t)bh * 2304 + qi) * 96;
#pragma unroll
        for (int i = 0; i < 96; ++i) q[i] = bf2f(qp[i]) * 0.10206207261596577f;
#pragma unroll
        for (int i = 0; i < 32; ++i) o[i] = 0.f;
        float mx = -1e30f, l = 0.f;
        for (int k0 = 0; k0 < nkeys; k0 += 32) {
            __syncthreads();
            for (int e = tid_; e < 32 * 96; e += NT) sK[e / 96][e % 96] = bf2f(Kb[((size_t)bh * 2304 + k0) * 96 + e]);
            for (int e = tid_; e < 32 * 64; e += NT) sV[e / 64][e % 64] = bf2f(Vb[((size_t)bh * 2304 + k0) * 64 + e]);
            __syncthreads();
#pragma unroll 1
            for (int j = 0; j < 32; ++j) { float a = 0.f;
#pragma unroll
                for (int i = 0; i < 96; ++i) a += q[i] * sK[j][i];
                if (a > mx) { const float corr = __expf(mx - a); mx = a; l *= corr;
#pragma unroll
                    for (int i = 0; i < 32; ++i) o[i] *= corr; }
                const float p = __expf(a - mx); l += p;
#pragma unroll
                for (int i = 0; i < 32; ++i) o[i] += p * sV[j][dh + i]; }
        }
        const int b = bh >> 2, h = bh & 3;
        const int row = lat ? b * 2048 + qi : RL + b * 256 + (qi - 2048);
        const float inv = 1.f / l;
#pragma unroll
        for (int i = 0; i < 32; ++i) Z[(size_t)row * ZW + C_QC + h * 64 + dh + i] = f2bf(o[i] * inv);
    }
    __syncthreads();
}
__device__ __forceinline__ void ph_f1(const bf16_t* Z, const float* trig, bf16_t* F1lat, bf16_t* F1ctx) { PH_IDS;
    GSTRIDE(gi, RT * 256) {
        const int row = gi >> 8, gm = gi & 255, g = gm >> 6, m = gm & 63;
        float a = 0.f, bsum = 0.f;
        const bf16_t* u = Z + (size_t)row * ZW + C_FU + g * 64;
        for (int c = 0; c < 64; ++c) { const float v = bf2f(u[c]); const int idx = ((m * c) & 63) * 32; a += v * trig[idx]; bsum += v * trig[2048 + idx]; }
        if (row < RL) { const int b = row >> 11, t = row & 2047; bf16_t* o = F1lat + ((size_t)(b * 256 + gm) * 2) * 2048; o[t] = f2bf(a); o[2048 + t] = f2bf(bsum); }
        else { const int r = row - RL, b = r >> 8, t = r & 255; bf16_t* o = F1ctx + ((size_t)(b * 256 + gm) * 2) * 256; o[t] = f2bf(a); o[256 + t] = f2bf(bsum); }
    }
}
struct A_dft { const float* trig; long long L; long long mul;
    __device__ float operator()(int, int k, int kk) const { const int part = kk >= (int)L, t = part ? kk - (int)L : kk; const int idx = (int)(((long long)k * t) & (L - 1)) * (int)mul; return part ? -trig[2048 + idx] : trig[idx]; } };
struct B_f1t { const bf16_t* p; long long L;
    __device__ float operator()(int b, int kk, int n) const { return bf2f(p[((size_t)(b * 256 + n)) * 2 * L + kk]); } };
struct E_fourier { bf16_t* Z; long long rowbase; long long L; double scale;
    __device__ void operator()(int b, int m, int n, float v) const { Z[((size_t)rowbase + (size_t)b * L + m) * ZW + C_FU + n] = f2bf(v * (float)scale); } };

struct A_s5u { const bf16_t* Z;
    __device__ float operator()(int g, int rc, int k) const { return bf2f(Z[((size_t)rc * 64 + (k >> 4)) * ZW + C_S5 + g * 16 + (k & 15)]); } };
struct B_ms { const bf16_t* MS; __device__ float operator()(int g, int k, int n) const { return bf2f(MS[((size_t)g * 1024 + k) * 256 + n]); } };
struct E_sloc { float* S; __device__ void operator()(int g, int rc, int n, float v) const { S[((size_t)rc * 16 + g) * 256 + n] = v; } };
__device__ __forceinline__ void ph_s5_scan(const float* SLOC, const float* lamT, float* XP) { PH_IDS;
    GSTRIDE(i, 8 * 16 * 2 * 64) {
        const int b = i / 2048, g = (i / 128) % 16, d = (i / 64) % 2, p = i % 64;
        const float lr = lamT[((size_t)(g * 2 + d) * 64 + p) * 2], li = lamT[((size_t)(g * 2 + d) * 64 + p) * 2 + 1];
        float xr = 0.f, xi = 0.f;
        for (int step = 0; step < 36; ++step) {
            int rc;
            if (d == 0) rc = step < 4 ? 256 + b * 4 + step : b * 32 + (step - 4);
            else rc = step < 4 ? 256 + b * 4 + (3 - step) : b * 32 + (31 - (step - 4));
            const size_t o = ((size_t)rc * 16 + g) * 256 + d * 128;
            XP[o + p] = xr; XP[o + 64 + p] = xi;
            const float sr = SLOC[o + p], si = SLOC[o + 64 + p];
            const float nr = lr * xr - li * xi + sr, ni = lr * xi + li * xr + si; xr = nr; xi = ni;
        }
    }
}
struct A_s5out { const bf16_t* Z; const float* XP;
    __device__ float operator()(int g, int rc, int k) const { return k < 1024 ? bf2f(Z[((size_t)rc * 64 + (k >> 4)) * ZW + C_S5 + g * 16 + (k & 15)]) : XP[((size_t)rc * 16 + g) * 256 + (k - 1024)]; } };
struct B_s5out { const float* TZ; const bf16_t* QO;
    __device__ float operator()(int g, int k, int n) const { if (k < 1024) { const int s = k >> 4, hp = k & 15, t = n >> 4, h = n & 15; return TZ[(((size_t)g * 127 + (t - s + 63)) * 16 + hp) * 16 + h]; } return bf2f(QO[((size_t)g * 256 + (k - 1024)) * 1024 + n]); } };
struct E_s5out { bf16_t* YG; __device__ void operator()(int g, int rc, int n, float v) const { YG[((size_t)rc * 64 + (n >> 4)) * 256 + g * 16 + (n & 15)] = f2bf(geluf_(v)); } };
__device__ __forceinline__ void ph_glu(const bf16_t* GL, bf16_t* Z) { PH_IDS;
    GSTRIDE(gi, RT * 256) {
        const int row = gi >> 8, j = gi & 255;
        const float val = bf2f(GL[(size_t)row * 512 + j]), gate = bf2f(GL[(size_t)row * 512 + 256 + j]);
        Z[(size_t)row * ZW + C_S5 + j] = f2bf(val * sigmoidf_(gate));
    }
}
__device__ __forceinline__ void ph_ret_prep(bf16_t* Z) { PH_IDS;
    GSTRIDE(gi, RT * 4 * 32) {
        const int row = gi >> 7, h = (gi >> 5) & 3, j = gi & 31;
        bf16_t* z = Z + (size_t)row * ZW;
        if (row < RL) {
            const int t = row & 2047; const float fr = exp2f(-(float)j * (13.287712379549449f / 32.f)), a = (float)t * fr, cs = cosf(a), sn = sinf(a);
            { const float x1 = bf2f(z[C_RQ + h * 64 + j]), x2 = bf2f(z[C_RQ + h * 64 + 32 + j]); z[C_RQ + h * 64 + j] = f2bf(x1 * cs - x2 * sn); z[C_RQ + h * 64 + 32 + j] = f2bf(x1 * sn + x2 * cs); }
            { const float x1 = bf2f(z[C_RK + h * 64 + j]), x2 = bf2f(z[C_RK + h * 64 + 32 + j]); z[C_RK + h * 64 + j] = f2bf((x1 * cs - x2 * sn) * 0.125f); z[C_RK + h * 64 + 32 + j] = f2bf((x1 * sn + x2 * cs) * 0.125f); }
        } else {
            z[C_RK + h * 64 + j] = f2bf(bf2f(z[C_RK + h * 64 + j]) * 0.125f); z[C_RK + h * 64 + 32 + j] = f2bf(bf2f(z[C_RK + h * 64 + 32 + j]) * 0.125f);
        }
    }
}
__device__ __forceinline__ void ph_ret(unsigned char* lds, bf16_t* Z, const float* decay_logit, const float* gn_w, int with_ctx) { PH_IDS;
    float (*sK)[64] = (float (*)[64])lds; float (*sV)[64] = (float (*)[64])(lds + 32 * 64 * 4);
    float* sred = (float*)(lds + 2 * 32 * 64 * 4);
    const int nunits = 32 * (8 + (with_ctx ? 1 : 0));
    const int qt = tid_ & 255, hh = tid_ >> 8, dh = hh * 32;
    for (int u = bid_; u < nunits; u += G_) {
        const int bh = u % 32, qb = u / 32, b = bh >> 2, h = bh & 3;
        const bool lat = qb < 8;
        const int qpos = lat ? qb * 256 + qt : qt;
        const int qrow = lat ? b * 2048 + qpos : RL + b * 256 + qpos;
        const float lgf = -log1pf(__expf(-decay_logit[h])) * 1.4426950408889634f, lgb = -log1pf(__expf(-decay_logit[4 + h])) * 1.4426950408889634f;
        float q[64], o[32];
#pragma unroll
        for (int i = 0; i < 64; ++i) q[i] = bf2f(Z[(size_t)qrow * ZW + C_RQ + h * 64 + i]);
#pragma unroll
        for (int i = 0; i < 32; ++i) o[i] = 0.f;
        const int nkeys = lat ? 2560 : 256;
        for (int k0 = 0; k0 < nkeys; k0 += 32) {
            int krow0, kpos0;
            if (lat) { if (k0 < 256) { krow0 = RL + b * 256 + k0; kpos0 = k0 - 256; } else if (k0 < 2304) { krow0 = b * 2048 + (k0 - 256); kpos0 = k0 - 256; } else { krow0 = RL + b * 256 + (k0 - 2304); kpos0 = 2048 + (k0 - 2304); } }
            else { krow0 = RL + b * 256 + k0; kpos0 = k0; }
            __syncthreads();
            for (int e = tid_; e < 32 * 64; e += NT) { const int j = e >> 6, i = e & 63; sK[j][i] = bf2f(Z[(size_t)(krow0 + j) * ZW + C_RK + h * 64 + i]); sV[j][i] = bf2f(Z[(size_t)(krow0 + j) * ZW + C_RV + h * 64 + i]); }
            __syncthreads();
#pragma unroll 1
            for (int j = 0; j < 32; ++j) { float a = 0.f;
#pragma unroll
                for (int i = 0; i < 64; ++i) a += q[i] * sK[j][i];
                const int dpos = qpos - (kpos0 + j);
                const float dec = dpos > 0 ? exp2f(lgf * (float)dpos) : (dpos < 0 ? exp2f(lgb * (float)(-dpos)) : 2.f);
                a *= dec;
#pragma unroll
                for (int i = 0; i < 32; ++i) o[i] += a * sV[j][dh + i]; }
        }
        float s1 = 0.f;
#pragma unroll
        for (int i = 0; i < 32; ++i) s1 += o[i];
        __syncthreads();
        sred[hh * 256 + qt] = s1;
        __syncthreads();
        const float mu = (sred[qt] + sred[256 + qt]) * (1.f / 64);
        float s2 = 0.f;
#pragma unroll
        for (int i = 0; i < 32; ++i) { const float d = o[i] - mu; s2 += d * d; }
        __syncthreads();
        sred[hh * 256 + qt] = s2;
        __syncthreads();
        const float rstd = rsqrtf((sred[qt] + sred[256 + qt]) * (1.f / 64) + EPS);
#pragma unroll
        for (int i = 0; i < 32; ++i) { const float gte = bf2f(Z[(size_t)qrow * ZW + C_RG + h * 64 + dh + i]); const float y = (o[i] - mu) * rstd * gn_w[h * 64 + dh + i];
            Z[(size_t)qrow * ZW + C_RQ + h * 64 + dh + i] = f2bf(siluf_(gte) * y); }
    }
    __syncthreads();
}
struct E_merge { const bf16_t* stash; bf16_t* MMp; long long first;
    __device__ void operator()(int, int m, int n, float v) const { const size_t i = (size_t)m * DM + n; const float t = sigmoidf_(v) * bf2f(stash[i]); MMp[i] = f2bf(first ? t : bf2f(MMp[i]) + t); } };
struct E_resid { const float* xlat; const float* xctx; float* olat; float* octx; const float* mod; long long gchunk;
    __device__ void operator()(int, int m, int n, float v) const {
        const float g = mod[(size_t)row_modidx(m) * 6144 + gchunk * 1024 + n];
        if (m < RL) olat[(size_t)m * DM + n] = xlat[(size_t)m * DM + n] + g * v; else octx[(size_t)(m - RL) * DM + n] = xctx[(size_t)(m - RL) * DM + n] + g * v; } };
struct E_relu2 { bf16_t* H; __device__ void operator()(int, int m, int n, float v) const { const float r = fmaxf(v, 0.f); H[(size_t)m * DFF + n] = f2bf(r * r); } };

namespace fa {
typedef float f32x16 __attribute__((ext_vector_type(16)));
typedef short s16x4 __attribute__((ext_vector_type(4)));
typedef unsigned u32x4 __attribute__((ext_vector_type(4)));
typedef unsigned u32x2 __attribute__((ext_vector_type(2)));
__device__ __forceinline__ s16x4 vtr(const LAS char* p) { return __builtin_bit_cast(s16x4, __builtin_amdgcn_ds_read_tr16_b64_v4i16((LAS s16x4*)p)); }
__device__ __forceinline__ unsigned pk2(float lo, float hi) { unsigned r; asm volatile("v_cvt_pk_bf16_f32 %0, %1, %2" : "=v"(r) : "v"(lo), "v"(hi)); return r; }
__device__ __forceinline__ bf16x8 pack_p(const f32x16& p, int base) { u32x4 w; w.x = pk2(p[base], p[base + 1]); w.y = pk2(p[base + 2], p[base + 3]); w.z = pk2(p[base + 4], p[base + 5]); w.w = pk2(p[base + 6], p[base + 7]); return __builtin_bit_cast(bf16x8, w); }
__device__ __forceinline__ int crow(int r, int hi) { return (r & 3) + 8 * (r >> 2) + 4 * hi; }
__device__ __forceinline__ void pv_tile(f32x16& o0, f32x16& o1, const LAS char* vb, const bf16x8 (&pf)[4]) {
#pragma unroll
    for (int ks = 0; ks < 4; ++ks) {
        const s16x4 a0 = vtr(vb + ks * 1024), a1 = vtr(vb + ks * 1024 + 512), b0 = vtr(vb + 4096 + ks * 1024), b1 = vtr(vb + 4096 + ks * 1024 + 512);
        const bf16x8 v0 = (bf16x8){a0[0], a0[1], a0[2], a0[3], a1[0], a1[1], a1[2], a1[3]}, v1 = (bf16x8){b0[0], b0[1], b0[2], b0[3], b1[0], b1[1], b1[2], b1[3]};
        o0 = __builtin_amdgcn_mfma_f32_32x32x16_bf16(v0, pf[ks], o0, 0, 0, 0);
        o1 = __builtin_amdgcn_mfma_f32_32x32x16_bf16(v1, pf[ks], o1, 0, 0, 0);
    }
}
constexpr int KP_A = 208, KT_A = 64 * KP_A, VT = 8192, BUF_A = KT_A + VT;
constexpr int KP_R = 144, KT_R = 64 * KP_R, BUF_R = KT_R + VT;
}

__device__ __forceinline__ void ph_s5_sloc(const bf16_t* Z, const bf16_t* MST, float* SLOC) { PH_IDS;
    const int lane = tid_ & 63, wid = __builtin_amdgcn_readfirstlane(tid_ >> 6), c16 = lane & 15, kq = lane >> 4;
    for (int u = bid_; u < 16 * 18; u += G_) {
        const int g = u / 18, rcbase = (u % 18) * 16;
        const bf16_t* up = Z + ((size_t)(rcbase + c16) * 64 + (kq >> 1)) * ZW + C_S5 + g * 16 + 8 * (kq & 1);
        const bf16_t* mp0 = MST + ((size_t)g * 256 + wid * 32 + c16) * 1024 + 8 * kq;
        f32x4 acc0 = (f32x4){0.f, 0.f, 0.f, 0.f}, acc1 = acc0;
#pragma unroll 8
        for (int ks = 0; ks < 32; ++ks) {
            const bf16x8 bfrag = *(const bf16x8*)(up + (size_t)(2 * ks) * ZW);
            const bf16x8 a0 = *(const bf16x8*)(mp0 + 32 * ks), a1 = *(const bf16x8*)(mp0 + 16 * 1024 + 32 * ks);
            acc0 = __builtin_amdgcn_mfma_f32_16x16x32_bf16(a0, bfrag, acc0, 0, 0, 0);
            acc1 = __builtin_amdgcn_mfma_f32_16x16x32_bf16(a1, bfrag, acc1, 0, 0, 0);
        }
        float* op = SLOC + ((size_t)(rcbase + c16) * 16 + g) * 256 + wid * 32 + 4 * kq;
        *(f32x4*)op = acc0; *(f32x4*)(op + 16) = acc1;
    }
}
__device__ __forceinline__ void ph_s5_out(unsigned char* lds_, const bf16_t* Z, const bf16_t* TZT, const bf16_t* QOT, const float* SLOC, const float* lamT, bf16_t* YG, int nrct) { PH_IDS;
    LAS char* sm = (LAS char*)lds_;
    constexpr int O_TZ = 0, O_XP = 65536, O_U = 73728, UP = 2064, O_SL = O_U + 16 * UP;
    const int lane = tid_ & 63, wid = __builtin_amdgcn_readfirstlane(tid_ >> 6), c16 = lane & 15, kq = lane >> 4;
    for (int u = bid_; u < 16 * nrct; u += G_) {
        const int g = u / nrct, rct = u % nrct, rcbase = rct * 16;
        const bool lat = rct < 16; const int b = rcbase >> 5, c0 = rcbase & 31;
        __syncthreads();
        for (int e = tid_; e < 65024 / 16; e += NT) *(LAS fa::u32x4*)(sm + O_TZ + e * 16) = *(const fa::u32x4*)((const char*)(TZT + (size_t)g * 127 * 256) + e * 16);
        for (int e = tid_; e < 16 * 128; e += NT) { const int rc = e >> 7, s = (e >> 1) & 63, hh = e & 1;
            *(LAS fa::u32x4*)(sm + O_U + rc * UP + s * 32 + hh * 16) = *(const fa::u32x4*)(Z + ((size_t)(rcbase + rc) * 64 + s) * ZW + C_S5 + g * 16 + hh * 8); }
        const int nsl = lat ? 36 : 16;
        for (int e = tid_; e < nsl * 64; e += NT) { const int r = e >> 6, q4 = e & 63; const int rc = lat ? (r < 4 ? 256 + b * 4 + r : b * 32 + (r - 4)) : rcbase + r;
            *(LAS f32x4*)(sm + O_SL + r * 1024 + q4 * 16) = *(const f32x4*)(SLOC + ((size_t)rc * 16 + g) * 256 + q4 * 4); }
        __syncthreads();
        if (tid_ < 128) {
            const int d = tid_ >> 6, p = tid_ & 63;
            const float lr = lamT[((size_t)(g * 2 + d) * 64 + p) * 2], li = lamT[((size_t)(g * 2 + d) * 64 + p) * 2 + 1];
            const LAS float* sl = (const LAS float*)(sm + O_SL) + d * 128 + p;
            LAS bf16_t* xp = (LAS bf16_t*)(sm + O_XP) + d * 128 + p;
            float xr = 0.f, xi = 0.f;
#define S5_STEP(r) do { const float sr = sl[(r) * 256], si = sl[(r) * 256 + 64]; const float nr = lr * xr - li * xi + sr, ni = lr * xi + li * xr + si; xr = nr; xi = ni; } while (0)
            if (lat) {
                if (d == 0) { for (int r = 0; r < 4 + c0; ++r) S5_STEP(r);
                    for (int r = 0; r < 16; ++r) { xp[r * 256] = f2bf(xr); xp[r * 256 + 64] = f2bf(xi); S5_STEP(4 + c0 + r); } }
                else { for (int r = 3; r >= 0; --r) S5_STEP(r);
                    for (int c = 31; c >= c0 + 16; --c) S5_STEP(4 + c);
                    for (int r = 15; r >= 0; --r) { xp[r * 256] = f2bf(xr); xp[r * 256 + 64] = f2bf(xi); S5_STEP(4 + c0 + r); } }
            } else {
                if (d == 0) { for (int r = 0; r < 16; ++r) { if ((r & 3) == 0) { xr = 0.f; xi = 0.f; } xp[r * 256] = f2bf(xr); xp[r * 256 + 64] = f2bf(xi); S5_STEP(r); } }
                else { for (int r = 15; r >= 0; --r) { if ((r & 3) == 3) { xr = 0.f; xi = 0.f; } xp[r * 256] = f2bf(xr); xp[r * 256 + 64] = f2bf(xi); S5_STEP(r); } }
            }
#undef S5_STEP
        }
        __syncthreads();
        const LAS char* ub = sm + O_U + c16 * UP + kq * 16;
        const LAS char* xb = sm + O_XP + c16 * 512 + kq * 16;
#pragma unroll 1
        for (int i = 0; i < 8; ++i) {
            const int t = wid * 8 + i;
            f32x4 acc = (f32x4){0.f, 0.f, 0.f, 0.f};
            const LAS char* tz = sm + O_TZ + ((t + 63 - (kq >> 1)) * 16 + c16) * 32 + (kq & 1) * 16;
#pragma unroll 8
            for (int ks = 0; ks < 32; ++ks) {
                const bf16x8 a = *(const LAS bf16x8*)(tz - ks * 1024), bq = *(const LAS bf16x8*)(ub + ks * 64);
                acc = __builtin_amdgcn_mfma_f32_16x16x32_bf16(a, bq, acc, 0, 0, 0);
            }
            const bf16_t* qo = QOT + ((size_t)g * 1024 + t * 16 + c16) * 256 + 8 * kq;
#pragma unroll
            for (int ks = 0; ks < 8; ++ks) {
                const bf16x8 a = *(const bf16x8*)(qo + 32 * ks), bq = *(const LAS bf16x8*)(xb + ks * 64);
                acc = __builtin_amdgcn_mfma_f32_16x16x32_bf16(a, bq, acc, 0, 0, 0);
            }
            fa::u32x2 w; w.x = fa::pk2(geluf_(acc[0]), geluf_(acc[1])); w.y = fa::pk2(geluf_(acc[2]), geluf_(acc[3]));
            *(fa::u32x2*)(YG + ((size_t)(rcbase + c16) * 64 + t) * 256 + g * 16 + 4 * kq) = w;
        }
    }
    __syncthreads();
}
__device__ __forceinline__ void ph_attn_mfma(unsigned char* lds_, const bf16_t* Q, const bf16_t* Kb, const bf16_t* Vb, bf16_t* Z, int with_ctx) { PH_IDS;
    using namespace fa;
    LAS char* sm = (LAS char*)lds_;
    const int lane = tid_ & 63, wid = __builtin_amdgcn_readfirstlane(tid_ >> 6), r32 = lane & 31, hi = lane >> 5;
    const int nunits = 256 + (with_ctx ? 32 : 0);
    const int vcu = (bid_ % 8) * (G_ / 8) + bid_ / 8;
    const int koff0 = (tid_ / 12) * KP_A + (tid_ % 12) * 16, koff1 = ((tid_ + 512) / 12) * KP_A + ((tid_ + 512) % 12) * 16;
    const int voff = KT_A + ((tid_ & 7) >> 2) * 4096 + (tid_ >> 3) * 64 + (tid_ & 3) * 16;
    const int vrd = KT_A + ((lane >> 4) & 1) * 32 + (lane & 3) * 8 + (4 * hi + ((lane & 15) >> 2)) * 64;
    for (int u = vcu; u < nunits; u += G_) {
        const bool lat = u < 256; const int bh = lat ? (u >> 3) : (u - 256), qb = lat ? (u & 7) : 8;
        const int ntile = lat ? 36 : 4;
        const char* Kg = (const char*)(Kb + (size_t)bh * 2304 * 96); const char* Vg = (const char*)(Vb + (size_t)bh * 2304 * 64);
        const bf16_t* Qg = Q + ((size_t)bh * 2304 + qb * 256 + wid * 32 + r32) * 96;
        bf16x8 qf[6];
#pragma unroll
        for (int st = 0; st < 6; ++st) qf[st] = *(const bf16x8*)(Qg + 16 * st + 8 * hi);
        f32x16 o0, o1;
#pragma unroll
        for (int r = 0; r < 16; ++r) { o0[r] = 0.f; o1[r] = 0.f; }
        float mrun = -1e30f, lsum = 0.f;
        u32x4 kr0, kr1, vr;
        kr0 = *(const u32x4*)(Kg + tid_ * 16); kr1 = tid_ < 256 ? *(const u32x4*)(Kg + (tid_ + 512) * 16) : (u32x4){0u, 0u, 0u, 0u}; vr = *(const u32x4*)(Vg + tid_ * 16);
        __syncthreads();
        *(LAS u32x4*)(sm + koff0) = kr0; if (tid_ < 256) *(LAS u32x4*)(sm + koff1) = kr1; *(LAS u32x4*)(sm + voff) = vr;
        __syncthreads();
        for (int t = 0; t < ntile; ++t) {
            const int buf = (t & 1) * BUF_A;
            if (t + 1 < ntile) { const char* kg = Kg + (size_t)(t + 1) * 12288; const char* vg = Vg + (size_t)(t + 1) * 8192;
                kr0 = *(const u32x4*)(kg + tid_ * 16); if (tid_ < 256) kr1 = *(const u32x4*)(kg + (tid_ + 512) * 16); vr = *(const u32x4*)(vg + tid_ * 16); }
            const LAS char* kb = sm + buf + r32 * KP_A + 16 * hi;
            f32x16 p0, p1;
#pragma unroll
            for (int r = 0; r < 16; ++r) { p0[r] = 0.f; p1[r] = 0.f; }
#pragma unroll
            for (int st = 0; st < 6; ++st) {
                const bf16x8 k0 = *(const LAS bf16x8*)(kb + 32 * st), k1 = *(const LAS bf16x8*)(kb + 32 * KP_A + 32 * st);
                p0 = __builtin_amdgcn_mfma_f32_32x32x16_bf16(k0, qf[st], p0, 0, 0, 0);
                p1 = __builtin_amdgcn_mfma_f32_32x32x16_bf16(k1, qf[st], p1, 0, 0, 0);
            }
            float tm = fmaxf(p0[0], p1[0]);
#pragma unroll
            for (int r = 1; r < 16; ++r) tm = fmaxf(tm, fmaxf(p0[r], p1[r]));
            tm = fmaxf(tm, __shfl_xor(tm, 32));
            const float mn = fmaxf(mrun, tm), alpha = __builtin_amdgcn_exp2f(mrun - mn); mrun = mn;
            float ps = 0.f;
#pragma unroll
            for (int r = 0; r < 16; ++r) { p0[r] = __builtin_amdgcn_exp2f(p0[r] - mn); p1[r] = __builtin_amdgcn_exp2f(p1[r] - mn); ps += p0[r] + p1[r]; }
            lsum = lsum * alpha + ps;
#pragma unroll
            for (int r = 0; r < 16; ++r) { o0[r] *= alpha; o1[r] *= alpha; }
            bf16x8 pf[4]; pf[0] = pack_p(p0, 0); pf[1] = pack_p(p0, 8); pf[2] = pack_p(p1, 0); pf[3] = pack_p(p1, 8);
            pv_tile(o0, o1, sm + buf + vrd, pf);
            if (t + 1 < ntile) { const int nb = ((t + 1) & 1) * BUF_A; *(LAS u32x4*)(sm + nb + koff0) = kr0; if (tid_ < 256) *(LAS u32x4*)(sm + nb + koff1) = kr1; *(LAS u32x4*)(sm + nb + voff) = vr; }
            __syncthreads();
        }
        lsum += __shfl_xor(lsum, 32);
        const float inv = 1.f / lsum;
        const int b = bh >> 2, h = bh & 3;
        const int row = (lat ? b * 2048 + qb * 256 : RL + b * 256) + wid * 32 + r32;
        bf16_t* op = Z + (size_t)row * ZW + C_QC + h * 64 + 4 * hi;
#pragma unroll
        for (int g = 0; g < 4; ++g) {
            u32x2 w0, w1; w0.x = pk2(o0[4 * g] * inv, o0[4 * g + 1] * inv); w0.y = pk2(o0[4 * g + 2] * inv, o0[4 * g + 3] * inv);
            w1.x = pk2(o1[4 * g] * inv, o1[4 * g + 1] * inv); w1.y = pk2(o1[4 * g + 2] * inv, o1[4 * g + 3] * inv);
            *(u32x2*)(op + 8 * g) = w0; *(u32x2*)(op + 32 + 8 * g) = w1;
        }
    }
    __syncthreads();
}

__device__ __forceinline__ void ph_ret_mfma(unsigned char* lds_, bf16_t* Z, const float* decay_logit, const float* gn_w, int with_ctx) { PH_IDS;
    using namespace fa;
    LAS char* sm = (LAS char*)lds_;
    const int lane = tid_ & 63, wid = __builtin_amdgcn_readfirstlane(tid_ >> 6), r32 = lane & 31, hi = lane >> 5;
    const int nunits = 256 + (with_ctx ? 32 : 0);
    const int vcu = (bid_ % 8) * (G_ / 8) + bid_ / 8;
    const int prow = tid_ >> 3, pc = tid_ & 7;
    const int koff = prow * KP_R + pc * 16;
    const int voff = KT_R + (pc >> 2) * 4096 + prow * 64 + (pc & 3) * 16;
    const int vrd = KT_R + ((lane >> 4) & 1) * 32 + (lane & 3) * 8 + (4 * hi + ((lane & 15) >> 2)) * 64;
    for (int u = vcu; u < nunits; u += G_) {
        const bool lat = u < 256; const int bh = lat ? (u >> 3) : (u - 256), qb = lat ? (u & 7) : 0, b = bh >> 2, h = bh & 3;
        const int ntile = lat ? 40 : 4;
        const float lgf = -log1pf(__expf(-decay_logit[h])) * 1.4426950408889634f, lgb = -log1pf(__expf(-decay_logit[4 + h])) * 1.4426950408889634f;
        const int qpos = qb * 256 + wid * 32 + r32;
        const int qrow = (lat ? b * 2048 : RL + b * 256) + qpos;
        bf16_t* zq = Z + (size_t)qrow * ZW;
        bf16x8 qf[4];
#pragma unroll
        for (int st = 0; st < 4; ++st) qf[st] = *(const bf16x8*)(zq + C_RQ + h * 64 + 16 * st + 8 * hi);
        f32x16 o0, o1;
#pragma unroll
        for (int r = 0; r < 16; ++r) { o0[r] = 0.f; o1[r] = 0.f; }
        const int ctx0 = RL + b * 256, lat0 = b * 2048;
#define RET_TILE_ROW(t) (lat ? ((t) < 4 ? ctx0 + 64 * (t) : ((t) < 36 ? lat0 + 64 * ((t) - 4) : ctx0 + 64 * ((t) - 36))) : ctx0 + 64 * (t))
#define RET_TILE_POS(t) (lat ? 64 * (t) - 256 : 64 * (t))
        u32x4 kr, vr;
        { const bf16_t* zr = Z + (size_t)(RET_TILE_ROW(0) + prow) * ZW + h * 64 + pc * 8; kr = *(const u32x4*)(zr + C_RK); vr = *(const u32x4*)(zr + C_RV); }
        __syncthreads();
        *(LAS u32x4*)(sm + koff) = kr; *(LAS u32x4*)(sm + voff) = vr;
        __syncthreads();
        for (int t = 0; t < ntile; ++t) {
            const int buf = (t & 1) * BUF_R;
            if (t + 1 < ntile) { const bf16_t* zr = Z + (size_t)(RET_TILE_ROW(t + 1) + prow) * ZW + h * 64 + pc * 8; kr = *(const u32x4*)(zr + C_RK); vr = *(const u32x4*)(zr + C_RV); }
            const LAS char* kb = sm + buf + r32 * KP_R + 16 * hi;
            f32x16 p0, p1;
#pragma unroll
            for (int r = 0; r < 16; ++r) { p0[r] = 0.f; p1[r] = 0.f; }
#pragma unroll
            for (int st = 0; st < 4; ++st) {
                const bf16x8 k0 = *(const LAS bf16x8*)(kb + 32 * st), k1 = *(const LAS bf16x8*)(kb + 32 * KP_R + 32 * st);
                p0 = __builtin_amdgcn_mfma_f32_32x32x16_bf16(k0, qf[st], p0, 0, 0, 0);
                p1 = __builtin_amdgcn_mfma_f32_32x32x16_bf16(k1, qf[st], p1, 0, 0, 0);
            }
            const int d0 = qpos - RET_TILE_POS(t) - 4 * hi;
#pragma unroll
            for (int r = 0; r < 16; ++r) {
                const int dp0 = d0 - ((r & 3) + 8 * (r >> 2)), dp1 = dp0 - 32;
                const float w0 = dp0 > 0 ? __builtin_amdgcn_exp2f(lgf * (float)dp0) : (dp0 < 0 ? __builtin_amdgcn_exp2f(-lgb * (float)dp0) : 2.f);
                const float w1 = dp1 > 0 ? __builtin_amdgcn_exp2f(lgf * (float)dp1) : (dp1 < 0 ? __builtin_amdgcn_exp2f(-lgb * (float)dp1) : 2.f);
                p0[r] *= w0; p1[r] *= w1;
            }
            bf16x8 pf[4]; pf[0] = pack_p(p0, 0); pf[1] = pack_p(p0, 8); pf[2] = pack_p(p1, 0); pf[3] = pack_p(p1, 8);
            pv_tile(o0, o1, sm + buf + vrd, pf);
            if (t + 1 < ntile) { const int nb = ((t + 1) & 1) * BUF_R; *(LAS u32x4*)(sm + nb + koff) = kr; *(LAS u32x4*)(sm + nb + voff) = vr; }
            __syncthreads();
        }
#undef RET_TILE_ROW
#undef RET_TILE_POS
        float s1 = 0.f;
#pragma unroll
        for (int r = 0; r < 16; ++r) s1 += o0[r] + o1[r];
        s1 += __shfl_xor(s1, 32);
        const float mu = s1 * (1.f / 64);
        float s2 = 0.f;
#pragma unroll
        for (int r = 0; r < 16; ++r) { const float a = o0[r] - mu, c = o1[r] - mu; s2 += a * a + c * c; }
        s2 += __shfl_xor(s2, 32);
        const float rstd = rsqrtf(s2 * (1.f / 64) + EPS);
#pragma unroll
        for (int g = 0; g < 4; ++g)
#pragma unroll
            for (int blk = 0; blk < 2; ++blk) {
                const int d = blk * 32 + 8 * g + 4 * hi;
                const u32x2 gt = *(const u32x2*)(zq + C_RG + h * 64 + d);
                const f32x4 gw = *(const f32x4*)(gn_w + h * 64 + d);
                float y[4];
#pragma unroll
                for (int q = 0; q < 4; ++q) { const float ov = blk ? o1[4 * g + q] : o0[4 * g + q]; const unsigned gb = q < 2 ? gt.x : gt.y; const float gv = __uint_as_float((q & 1) ? (gb & 0xffff0000u) : (gb << 16));
                    y[q] = siluf_(gv) * ((ov - mu) * rstd * gw[q]); }
                u32x2 w; w.x = pk2(y[0], y[1]); w.y = pk2(y[2], y[3]);
                *(u32x2*)(zq + C_RQ + h * 64 + d) = w;
            }
    }
    __syncthreads();
}

struct SchedGrid {
    const char* A; const char* B; unsigned lda, ldb; int nt, nM, nN, G, c, kind, aux;
    __device__ __forceinline__ bool next(int i, pg8::Unit& u) const {
        int pm, pn; if (!pg8::static_tile(nM, nN, G, c, i, pm, pn)) return false;
        u.A = A + (size_t)pm * 256 * lda; u.B = B + (size_t)pn * 256 * ldb; u.lda = lda; u.ldb = ldb; u.nt = nt; u.pm = pm; u.pn = pn; u.kind = kind; u.aux = aux; return true; }
};
struct SchedP1 {
    const char* A; const char* B; int G, c, last;
    __device__ __forceinline__ bool next(int i, pg8::Unit& u) const {
        int pm, pn;
        if (!last) { if (!pg8::static_tile(RT / 256, 8, G, c, i, pm, pn)) return false; }
        else { if (!pg8::static_tile(RL / 256, 8, G, c, i, pm, pn)) { const int j = i * G + c - (RL / 256) * 8; if (j < 0 || j >= 32) return false; pm = RL / 256 + (j >> 2); pn = j & 3; } }
        u.A = A + (size_t)pm * 256 * 2048; u.B = B + (size_t)pn * 256 * 2048; u.lda = 2048; u.ldb = 2048; u.nt = 16; u.pm = pm; u.pn = pn; u.kind = 0; u.aux = 0; return true; }
};
struct SchedMerge {
    const char* Z; const char* XN; const char* WBR; const char* WING; int njobs, G, vcu;
    __device__ __forceinline__ bool next(int i, pg8::Unit& u) const {
        const int job = (i >> 3) * G + vcu; if (job >= njobs) return false;
        const int sub = i & 7, n = sub >> 1, pm = job >> 2, pn = job & 3;
        u.pm = pm; u.pn = pn; u.aux = n;
        if (!(sub & 1)) { const int bcol = n == 0 ? C_QC : (n == 1 ? C_FU : (n == 2 ? C_S5 : C_RQ));
            u.A = Z + ((size_t)pm * 256 * ZW + bcol) * 2; u.lda = ZW * 2; u.B = WBR + ((size_t)n * 1024 + pn * 256) * 512; u.ldb = 512; u.nt = 4; u.kind = 0; }
        else { u.A = XN + (size_t)pm * 256 * 2048; u.lda = 2048; u.B = WING + ((size_t)n * 1024 + pn * 256) * 2048; u.ldb = 2048; u.nt = 16; u.kind = 1; }
        return true; }
};
#define EPI_FOREACH(...) _Pragma("unroll") for (int ai = 0; ai < 2; ++ai) _Pragma("unroll") for (int m = 0; m < 4; ++m) _Pragma("unroll") for (int bj = 0; bj < 2; ++bj) { \
        const int row = u.pm * 256 + ai * 128 + wr * 64 + m * 16 + fr, col = u.pn * 256 + bj * 128 + wc * 32 + 8 * fq; const f32x4 v0 = acc[ai][bj][m][0], v1 = acc[ai][bj][m][1]; (void)row; (void)col; __VA_ARGS__ }
__device__ __forceinline__ pg8::u32x4 pack8(const f32x4 a, const f32x4 b) { pg8::u32x4 w; w.x = pg8::cvt_pk_bf16(a[0], a[1]); w.y = pg8::cvt_pk_bf16(a[2], a[3]); w.z = pg8::cvt_pk_bf16(b[0], b[1]); w.w = pg8::cvt_pk_bf16(b[2], b[3]); return w; }
__device__ __forceinline__ void unpack8(const pg8::u32x4 w, f32x4& a, f32x4& b) {
    a[0] = __uint_as_float(w.x << 16); a[1] = __uint_as_float(w.x & 0xffff0000u); a[2] = __uint_as_float(w.y << 16); a[3] = __uint_as_float(w.y & 0xffff0000u);
    b[0] = __uint_as_float(w.z << 16); b[1] = __uint_as_float(w.z & 0xffff0000u); b[2] = __uint_as_float(w.w << 16); b[3] = __uint_as_float(w.w & 0xffff0000u); }
struct EpiStore {
    bf16_t* O; int ld; int act;
    __device__ __forceinline__ void operator()(const f32x4 (&acc)[2][2][4][2], const pg8::Unit& u, int wr, int wc, int fr, int fq) const {
        EPI_FOREACH( f32x4 a = v0, b = v1; if (act == 1) { _Pragma("unroll") for (int q = 0; q < 4; ++q) { const float ra = fmaxf(a[q], 0.f), rb = fmaxf(b[q], 0.f); a[q] = ra * ra; b[q] = rb * rb; } }
            *(pg8::u32x4*)(O + (size_t)row * ld + col) = pack8(a, b); )
    }
};
struct EpiResid {
    const float* xlat; const float* xctx; float* olat; float* octx; const float* mod; int gch;
    __device__ __forceinline__ void operator()(const f32x4 (&acc)[2][2][4][2], const pg8::Unit& u, int wr, int wc, int fr, int fq) const {
        const bool lat = u.pm < 64; const float* xb = lat ? xlat : xctx - (size_t)RL * DM; float* ob = lat ? olat : octx - (size_t)RL * DM;
        const float* g = mod + (size_t)(lat ? (u.pm >> 3) : 8) * 6144 + gch * 1024;
        EPI_FOREACH( const f32x4 g0 = *(const f32x4*)(g + col), g1 = *(const f32x4*)(g + col + 4); const size_t o = (size_t)row * DM + col;
            const f32x4 x0 = *(const f32x4*)(xb + o), x1 = *(const f32x4*)(xb + o + 4); *(f32x4*)(ob + o) = x0 + g0 * v0; *(f32x4*)(ob + o + 4) = x1 + g1 * v1; if (bj) asm volatile("" ::: "memory"); )
    }
};
struct EpiMerge {
    pg8::u32x4* stash; bf16_t* MMp;
    __device__ __forceinline__ void operator()(const f32x4 (&acc)[2][2][4][2], const pg8::Unit& u, int wr, int wc, int fr, int fq) const {
        int tid = threadIdx.x; asm volatile("" : "+v"(tid));
        if (u.kind == 0) { EPI_FOREACH( stash[((ai * 4 + m) * 2 + bj) * NT + tid] = pack8(v0, v1); if (bj) asm volatile("" ::: "memory"); ) }
        else { EPI_FOREACH( f32x4 y0, y1; unpack8(stash[((ai * 4 + m) * 2 + bj) * NT + tid], y0, y1); f32x4 t0, t1;
                _Pragma("unroll") for (int q = 0; q < 4; ++q) { t0[q] = sigmoidf_(v0[q]) * y0[q]; t1[q] = sigmoidf_(v1[q]) * y1[q]; }
                pg8::u32x4* mp = (pg8::u32x4*)(MMp + (size_t)row * DM + col);
                if (u.aux != 0) { f32x4 p0, p1; unpack8(*mp, p0, p1); t0 += p0; t1 += p1; }
                *mp = pack8(t0, t1); asm volatile("" ::: "memory"); ) }
    }
};
__device__ __forceinline__ void transpose_item(const float* W, int K, int N, bf16_t* WT, int row_off, LAS float* scr, int item, int lane) {
    const int nblk = N / 32, kb = item / nblk, nb = item % nblk, k0 = 64 * kb, n0 = 32 * nb;
#pragma unroll 8
    for (int i = 0; i < 32; ++i) { const int kk = 2 * i + (lane >> 5); scr[kk * 33 + (lane & 31)] = W[(size_t)(k0 + kk) * N + n0 + (lane & 31)]; }
    asm volatile("s_waitcnt lgkmcnt(0)" ::: "memory");
    const int c = lane & 7;
#pragma unroll
    for (int j = 0; j < 4; ++j) { const int n = (lane >> 3) + 8 * j; const LAS float* sp = scr + (8 * c) * 33 + n;
        pg8::u32x4 o; o.x = pg8::cvt_pk_bf16(sp[0 * 33], sp[1 * 33]); o.y = pg8::cvt_pk_bf16(sp[2 * 33], sp[3 * 33]); o.z = pg8::cvt_pk_bf16(sp[4 * 33], sp[5 * 33]); o.w = pg8::cvt_pk_bf16(sp[6 * 33], sp[7 * 33]);
        *(pg8::u32x4*)(WT + (size_t)(row_off + n0 + n) * K + k0 + 8 * c) = o; }
    asm volatile("s_waitcnt lgkmcnt(0)" ::: "memory");
}
__device__ __forceinline__ void ph_convert_weights(unsigned char* lds, int l, const float* w_in, const float* w1, const float* w2, const float* w_out, const float* w_br, const float* w_glu, unsigned char* ws) { PH_IDS;
    const int wave = __builtin_amdgcn_readfirstlane(tid_ >> 6), lane = tid_ & 63;
    LAS float* scr = (LAS float*)((LAS unsigned char*)lds + wave * 16384);
    const int gw = bid_ * 8 + wave, NGW = G_ * 8;
    constexpr int I_IN = 16 * 189, I_1 = 16 * 128, I_2 = 64 * 32, I_O = 16 * 32, I_B = 4 * 32;
    constexpr int I_G = 4 * 16;
    constexpr int NITEMS = I_IN + I_1 + I_2 + I_O + 4 * I_B + I_G;
    bf16_t* WIN_T = (bf16_t*)(ws + WS_WIN); bf16_t* W1_T = (bf16_t*)(ws + WS_W1); bf16_t* W2_T = (bf16_t*)(ws + WS_W2); bf16_t* WOUT_T = (bf16_t*)(ws + WS_WOUT); bf16_t* WBR_T = (bf16_t*)(ws + WS_WBR);
    for (int it = gw; it < NITEMS; it += NGW) {
        int r = it;
        if (r < I_IN) { const int nb = r % 189; transpose_item(w_in + (size_t)l * DM * INC, DM, INC, WIN_T, nb >= 61 ? 96 : 0, scr, r, lane); continue; } r -= I_IN;
        if (r < I_1) { transpose_item(w1 + (size_t)l * DM * DFF, DM, DFF, W1_T, 0, scr, r, lane); continue; } r -= I_1;
        if (r < I_2) { transpose_item(w2 + (size_t)l * DFF * DM, DFF, DM, W2_T, 0, scr, r, lane); continue; } r -= I_2;
        if (r < I_O) { transpose_item(w_out + (size_t)l * DM * DM, DM, DM, WOUT_T, 0, scr, r, lane); continue; } r -= I_O;
        if (r < 4 * I_B) { const int n = r / I_B; transpose_item(w_br + ((size_t)l * 4 + n) * 256 * DM, 256, DM, WBR_T + (size_t)n * 1024 * 256, 0, scr, r % I_B, lane); continue; } r -= 4 * I_B;
        { const int n0 = (r % 16) * 32; const int off = n0 < 128 ? 0 : (n0 < 256 ? 128 : (n0 < 384 ? -128 : 0));
          transpose_item(w_glu + (size_t)l * 256 * 512, 256, 512, (bf16_t*)(ws + WS_WGLU), off, scr, r, lane); }
    }
    GSTRIDE(gi, 96 * 1024 / 8) { *(pg8::u32x4*)(WIN_T + (size_t)1952 * 1024 + (size_t)gi * 8) = (pg8::u32x4){0u, 0u, 0u, 0u}; }
    __syncthreads();
}

struct EpiFourier {
    bf16_t* Zp; int rowbase, L; float scale;
    __device__ __forceinline__ void operator()(const f32x4 (&acc)[2][2][4][2], const pg8::Unit& u, int wr, int wc, int fr, int fq) const {
        EPI_FOREACH( *(pg8::u32x4*)(Zp + ((size_t)rowbase + (size_t)u.pn * L + row) * ZW + C_FU + (col - u.pn * 256)) = pack8(v0 * scale, v1 * scale); )
    }
};
struct EpiGlu {
    bf16_t* Zp;
    __device__ __forceinline__ void operator()(const f32x4 (&acc)[2][2][4][2], const pg8::Unit& u, int wr, int wc, int fr, int fq) const {
#pragma unroll
        for (int ai = 0; ai < 2; ++ai)
#pragma unroll
            for (int m = 0; m < 4; ++m) {
                const int row = u.pm * 256 + ai * 128 + wr * 64 + m * 16 + fr, col = u.pn * 128 + wc * 32 + 8 * fq;
                f32x4 a, b;
#pragma unroll
                for (int q = 0; q < 4; ++q) { a[q] = acc[ai][0][m][0][q] * sigmoidf_(acc[ai][1][m][0][q]); b[q] = acc[ai][0][m][1][q] * sigmoidf_(acc[ai][1][m][1][q]); }
                *(pg8::u32x4*)(Zp + (size_t)row * ZW + C_S5 + col) = pack8(a, b);
            }
    }
};
__device__ __forceinline__ void ph_dft_gen(const float* trig, bf16_t* DL, bf16_t* DC) { PH_IDS;
    GSTRIDE(gi, 2048 * 4096 / 8) {
        const int k = gi >> 9, kk0 = (gi & 511) * 8; pg8::u32x4 w; unsigned pr[4];
#pragma unroll
        for (int q = 0; q < 4; ++q) { float v[2];
#pragma unroll
            for (int e = 0; e < 2; ++e) { const int kk = kk0 + 2 * q + e, part = kk >> 11, t = kk & 2047, idx = (k * t) & 2047; v[e] = part ? -trig[2048 + idx] : trig[idx]; }
            pr[q] = pg8::cvt_pk_bf16(v[0], v[1]); }
        w.x = pr[0]; w.y = pr[1]; w.z = pr[2]; w.w = pr[3];
        *(pg8::u32x4*)(DL + (size_t)k * 4096 + kk0) = w;
    }
    GSTRIDE(gi, 256 * 512 / 8) {
        const int k = gi >> 6, kk0 = (gi & 63) * 8; pg8::u32x4 w; unsigned pr[4];
#pragma unroll
        for (int q = 0; q < 4; ++q) { float v[2];
#pragma unroll
            for (int e = 0; e < 2; ++e) { const int kk = kk0 + 2 * q + e, part = kk >> 8, t = kk & 255, idx = ((k * t) & 255) * 8; v[e] = part ? -trig[2048 + idx] : trig[idx]; }
            pr[q] = pg8::cvt_pk_bf16(v[0], v[1]); }
        w.x = pr[0]; w.y = pr[1]; w.z = pr[2]; w.w = pr[3];
        *(pg8::u32x4*)(DC + (size_t)k * 512 + kk0) = w;
    }
}

constexpr size_t WS_BAR = 7 * MiB;
constexpr int LDS_BYTES = 147456;
struct Args { const float* in[30]; float* out; unsigned char* ws; };
typedef const __attribute__((address_space(4))) Args* CArgs;
__device__ __forceinline__ CArgs kargs() { CArgs p = (CArgs)__builtin_amdgcn_kernarg_segment_ptr(); asm volatile("" : "+s"(p)); return p; }
#define IN(i) (kargs()->in[i])
#define WSB(T, off) ((T*)(kargs()->ws + (off)))
#define OUTP (kargs()->out)
enum { I_X = 0, I_C, I_CTX, I_CCTX, I_ADAW, I_ADAB, I_NMIX, I_NFFN, I_WIN, I_QNORM, I_WUQ, I_KVNORM, I_WUKV, I_QKQ, I_QKK, I_LRE, I_LIM, I_LSTEP, I_BRE, I_BIM, I_CRE, I_CIM, I_S5D, I_WGLU, I_RDEC, I_RGN, I_WBR, I_WOUT, I_W1, I_W2 };
#define GRID_BAR() do { bar.bar = WSB(unsigned, WS_BAR); { unsigned x_ = bar.x; asm volatile("" : "+s"(x_)); bar.x = x_; } xcd_barrier(bar); } while (0)
template <int L> __device__ __forceinline__ void layer_body(unsigned char* lds, XcdBarrier& bar) {
    constexpr int l = L;
    constexpr bool LASTL = (L == DEPTH - 1);
    constexpr int NMT = LASTL ? RL / 256 : RT / 256;
    constexpr int WCTX = LASTL ? 0 : 1;

#define MODL (WSB(float, WS_MOD) + (size_t)l * 9 * 6144)
#define XLAT (l == 0 ? IN(I_X) : (const float*)OUTP)
#define XCTX (l == 0 ? IN(I_CTX) : (const float*)WSB(float, WS_XC))
#define WINL (IN(I_WIN) + (size_t)l * DM * INC)
#define ZP WSB(bf16_t, WS_Z)
#define XNP WSB(bf16_t, WS_XN)
#define QP WSB(bf16_t, WS_QKV)
#define KP (WSB(bf16_t, WS_QKV) + (size_t)32 * 2304 * 96)
#define VP (WSB(bf16_t, WS_QKV) + (size_t)2 * 32 * 2304 * 96)
#define F1LAT WSB(bf16_t, WS_F1)
#define F1CTX (WSB(bf16_t, WS_F1) + (size_t)8 * 256 * 2 * 2048)
#define QRAWP WSB(bf16_t, WS_RAW)
#define KVRAWP (WSB(bf16_t, WS_RAW) + (size_t)RT * 384)
        ph_s5_lp(l, IN(I_LRE), IN(I_LIM), IN(I_LSTEP), IN(I_BRE), IN(I_BIM), WSB(double2, WS_LP), WSB(double2, WS_BB), WSB(float, WS_LAMT));
        ph_adarms(XLAT, XCTX, IN(I_NMIX) + l * DM, MODL, 0, 1, XNP, RT);
        ph_convert_weights(lds, l, IN(I_WIN), IN(I_W1), IN(I_W2), IN(I_WOUT), IN(I_WBR), IN(I_WGLU), kargs()->ws);
        if (l == 0) ph_dft_gen(WSB(float, WS_TRIG), WSB(bf16_t, WS_DFTL), WSB(bf16_t, WS_DFTC));
        GRID_BAR();
        ph_s5_tz(l, WSB(double2, WS_LP), WSB(double2, WS_BB), IN(I_CRE), IN(I_CIM), IN(I_S5D), WSB(bf16_t, WS_TZ));
        ph_s5_ms(WSB(double2, WS_LP), WSB(double2, WS_BB), WSB(bf16_t, WS_MS));
        ph_s5_qo(l, WSB(double2, WS_LP), IN(I_CRE), IN(I_CIM), WSB(bf16_t, WS_QO));
        { SchedP1 S; S.A = (const char*)XNP; S.B = (const char*)WSB(bf16_t, WS_WIN); S.G = l_grid(); S.c = l_bid(); S.last = LASTL ? 1 : 0;
          EpiStore E; E.O = ZP; E.ld = ZW; E.act = 0; pg8::gemm_phase((LAS unsigned char*)lds, S, E); }
        GRID_BAR();
        ph_mla_stats(ZP, WSB(float, WS_RS));
        ph_f1(ZP, WSB(float, WS_TRIG), F1LAT, F1CTX);
        ph_ret_prep(ZP);
        ph_s5_sloc(ZP, WSB(bf16_t, WS_MS), WSB(float, WS_SLOC));
        GRID_BAR();
        { A_bf16_scaled A; A.p = ZP; A.ld = ZW; A.coff = C_QC; A.rs = WSB(float, WS_RS); A.rsi = 0; A.w = IN(I_QNORM) + l * 256;
          B_f32 B; B.p = IN(I_WUQ) + (size_t)l * 256 * 384; B.ld = 384; B.coff = 0; E_bf16 E; E.p = QRAWP; E.ld = 384; E.coff = 0;
          gemm_phase(lds, A, B, E, 1, RT, 384, 256); }
        { A_bf16_scaled A; A.p = ZP; A.ld = ZW; A.coff = C_KVC; A.rs = WSB(float, WS_RS); A.rsi = 1; A.w = IN(I_KVNORM) + l * 128;
          B_f32 B; B.p = IN(I_WUKV) + (size_t)l * 128 * 512; B.ld = 512; B.coff = 0; E_bf16 E; E.p = KVRAWP; E.ld = 512; E.coff = 0;
          gemm_phase(lds, A, B, E, 1, RT, 512, 128); }
        { SchedGrid S; S.A = (const char*)WSB(bf16_t, WS_DFTL); S.B = (const char*)F1LAT; S.lda = 8192; S.ldb = 8192; S.nt = 64; S.nM = 8; S.nN = 8; S.G = l_grid(); S.c = l_bid(); S.kind = 0; S.aux = 0;
          EpiFourier E; E.Zp = ZP; E.rowbase = 0; E.L = 2048; E.scale = 0.0027621358640099515f; pg8::gemm_phase((LAS unsigned char*)lds, S, E); }
        if (!LASTL) { SchedGrid S; S.A = (const char*)WSB(bf16_t, WS_DFTC); S.B = (const char*)F1CTX; S.lda = 1024; S.ldb = 1024; S.nt = 8; S.nM = 1; S.nN = 8; S.G = l_grid(); S.c = l_bid(); S.kind = 0; S.aux = 0;
          EpiFourier E; E.Zp = ZP; E.rowbase = RL; E.L = 256; E.scale = 0.0078125f; pg8::gemm_phase((LAS unsigned char*)lds, S, E); }
        ph_ret_mfma(lds, ZP, IN(I_RDEC) + l * 8, IN(I_RGN) + l * 256, WCTX);
        GRID_BAR();
        ph_mla_post(ZP, QRAWP, KVRAWP, IN(I_QKQ) + l * 96, IN(I_QKK) + l * 96, QP, KP, VP);
        GRID_BAR();
        ph_attn_mfma(lds, QP, KP, VP, ZP, WCTX);
        ph_s5_out(lds, ZP, WSB(bf16_t, WS_TZ), WSB(bf16_t, WS_QO), WSB(float, WS_SLOC), WSB(float, WS_LAMT), WSB(bf16_t, WS_YG), LASTL ? 16 : 18);
        GRID_BAR();
        { SchedGrid S; S.A = (const char*)WSB(bf16_t, WS_YG); S.B = (const char*)WSB(bf16_t, WS_WGLU); S.lda = 512; S.ldb = 512; S.nt = 4; S.nM = NMT; S.nN = 2; S.G = l_grid(); S.c = l_bid(); S.kind = 0; S.aux = 0;
          EpiGlu E; E.Zp = ZP; pg8::gemm_phase((LAS unsigned char*)lds, S, E); }
        GRID_BAR();
        ph_adarms(XLAT, XCTX, IN(I_NMIX) + l * DM, MODL, 0, 1, XNP, NMT * 256);
        GRID_BAR();
        { SchedMerge S; S.Z = (const char*)ZP; S.XN = (const char*)XNP; S.WBR = (const char*)WSB(bf16_t, WS_WBR); S.WING = (const char*)(WSB(bf16_t, WS_WIN) + (size_t)2048 * 1024);
          S.njobs = NMT * 4; S.G = l_grid(); { const int bx = l_bid(); S.vcu = (bx % 8) * (S.G / 8) + bx / 8; }
          EpiMerge E; E.stash = WSB(pg8::u32x4, WS_STASH) + (size_t)l_bid() * 8192; E.MMp = WSB(bf16_t, WS_MM); pg8::gemm_phase((LAS unsigned char*)lds, S, E); }
        GRID_BAR();
        { SchedGrid S; S.A = (const char*)WSB(bf16_t, WS_MM); S.B = (const char*)WSB(bf16_t, WS_WOUT); S.lda = 2048; S.ldb = 2048; S.nt = 16; S.nM = NMT; S.nN = 4; S.G = l_grid(); S.c = l_bid(); S.kind = 0; S.aux = 0;
          EpiResid E; E.xlat = XLAT; E.xctx = XCTX; E.olat = OUTP; E.octx = WSB(float, WS_XC); E.mod = MODL; E.gch = 2; pg8::gemm_phase((LAS unsigned char*)lds, S, E); }
        GRID_BAR();
        ph_adarms(OUTP, WSB(float, WS_XC), IN(I_NFFN) + l * DM, MODL, 3, 4, XNP, NMT * 256);
        GRID_BAR();
        { SchedGrid S; S.A = (const char*)XNP; S.B = (const char*)WSB(bf16_t, WS_W1); S.lda = 2048; S.ldb = 2048; S.nt = 16; S.nM = NMT; S.nN = 16; S.G = l_grid(); S.c = l_bid(); S.kind = 0; S.aux = 0;
          EpiStore E; E.O = WSB(bf16_t, WS_H); E.ld = DFF; E.act = 1; pg8::gemm_phase((LAS unsigned char*)lds, S, E); }
        GRID_BAR();
        { SchedGrid S; S.A = (const char*)WSB(bf16_t, WS_H); S.B = (const char*)WSB(bf16_t, WS_W2); S.lda = 8192; S.ldb = 8192; S.nt = 64; S.nM = NMT; S.nN = 4; S.G = l_grid(); S.c = l_bid(); S.kind = 0; S.aux = 0;
          EpiResid E; E.xlat = OUTP; E.xctx = WSB(float, WS_XC); E.olat = OUTP; E.octx = WSB(float, WS_XC); E.mod = MODL; E.gch = 5; pg8::gemm_phase((LAS unsigned char*)lds, S, E); }
        if (l + 1 < DEPTH) GRID_BAR();
}
__global__ void __launch_bounds__(NT, 2) mega(Args a_unused) {
    extern __shared__ __attribute__((aligned(16))) unsigned char lds[];
    volatile LAS unsigned* bst = (volatile LAS unsigned*)((LAS unsigned char*)lds + LDS_BYTES - 16);
    if (threadIdx.x < 4) bst[threadIdx.x] = 0u;
    __syncthreads();
    XcdBarrier bar = xcd_barrier_post(WSB(unsigned, WS_BAR), bst);

    ph_mod(lds, IN(I_C), IN(I_CCTX), IN(I_ADAW), IN(I_ADAB), WSB(float, WS_MOD));
    ph_trig(WSB(float, WS_TRIG));
    GRID_BAR();
    layer_body<0>(lds, bar);
    layer_body<1>(lds, bar);
}

extern "C" void kernel_launch(void* const* d_in, const int* in_sizes, int n_in, void* d_out, int out_size, void* d_ws, size_t ws_size, hipStream_t stream) {
    static int grid = 0;
    if (grid == 0) {
        if (n_in != 30 || ws_size < WS_END) { fprintf(stderr, "kernel_launch: unexpected n_in %d / ws_size %zu\n", n_in, ws_size); grid = -1; return; }
        int dev = 0, cus = 0, per_cu = 0;
        if (hipGetDevice(&dev) != hipSuccess || hipDeviceGetAttribute(&cus, hipDeviceAttributeMultiprocessorCount, dev) != hipSuccess) { grid = -1; return; }
        if (hipFuncSetAttribute((const void*)mega, hipFuncAttributeMaxDynamicSharedMemorySize, LDS_BYTES) != hipSuccess) { fprintf(stderr, "kernel_launch: hipFuncSetAttribute failed\n"); grid = -1; return; }
        if (hipOccupancyMaxActiveBlocksPerMultiprocessor(&per_cu, (const void*)mega, NT, LDS_BYTES) != hipSuccess || per_cu < 1) fprintf(stderr, "kernel_launch: occupancy query says %d\n", per_cu);
        (void)hipGetLastError();
        grid = cus;
    }
    if (grid < 0) return;
    (void)hipMemsetAsync((char*)d_ws + WS_BAR, 0, XCD_BAR_WORDS * 4, stream);
    Args a; memset((void*)&a, 0, sizeof(a));
    for (int i = 0; i < 30; ++i) a.in[i] = (const float*)d_in[i];
    a.out = (float*)d_out; a.ws = (unsigned char*)d_ws;
    hipLaunchKernelGGL(mega, dim3(grid), dim3(NT), LDS_BYTES, stream, a);
}
```

```cpp
#include <hip/hip_runtime.h>
#include <cstdint>
#include <cstring>
#include <cstdio>

typedef unsigned short bf16_t;
typedef short bf16x8 __attribute__((ext_vector_type(8)));
typedef float f32x4 __attribute__((ext_vector_type(4)));

constexpr int DM = 1024, NB = 8, SEQ = 2048, CTX = 256, DEPTH = 2;
constexpr int RL = NB * SEQ;
constexpr int RC = NB * CTX;
constexpr int RT = RL + RC;
constexpr int INC = 6048;
constexpr int ZW = 2048;
constexpr int C_KVC = 0, C_KR = 128, C_S5 = 160, C_RK = 416, C_RV = 672, C_QC = 928, C_FU = 1184, C_RQ = 1440, C_RG = 1696, C_GATE = 1952;
constexpr int C_OC = C_RK;
constexpr int DFF = 4096;
constexpr int TCH = 64;
constexpr int NCH = RT / TCH;
constexpr float EPS = 1e-6f;
#define PI_D 3.14159265358979323846

__device__ __forceinline__ float bf2f(bf16_t v) { return __uint_as_float(((unsigned)v) << 16); }
__device__ __forceinline__ bf16_t f2bf(float f) { unsigned u = __float_as_uint(f); return (bf16_t)((u + 0x7fffu + ((u >> 16) & 1u)) >> 16); }
__device__ __forceinline__ float sigmoidf_(float x) { return 1.f / (1.f + __expf(-x)); }
__device__ __forceinline__ float siluf_(float x) { return x * sigmoidf_(x); }
__device__ __forceinline__ float geluf_(float x) { return 0.5f * x * (1.f + tanhf(0.7978845608028654f * (x + 0.044715f * x * x * x))); }
__device__ __forceinline__ int row_batch(int row) { return row < RL ? (row >> 11) : ((row - RL) >> 8); }
__device__ __forceinline__ int row_modidx(int row) { return row < RL ? (row >> 11) : 8; }

constexpr size_t MiB = 1ull << 20;
constexpr size_t WS_MOD = 0;
constexpr size_t WS_RS = 1 * MiB;
constexpr size_t WS_TRIG = WS_RS + 256 * 1024;
constexpr size_t WS_LAMT = WS_TRIG + 32 * 1024;
constexpr size_t WS_LP = 2 * MiB;
constexpr size_t WS_BB = 5 * MiB;
constexpr size_t WS_W = 8 * MiB;
constexpr size_t WS_WIN = WS_W, WS_W1 = WS_W + 12 * MiB, WS_W2 = WS_W + 20 * MiB, WS_WOUT = WS_W + 28 * MiB, WS_WBR = WS_W + 30 * MiB;
constexpr size_t WS_XN = 40 * MiB;
constexpr size_t WS_RAW = WS_XN;
constexpr size_t WS_YG = WS_XN;
constexpr size_t WS_Z = 76 * MiB;
constexpr size_t WS_QKV = 148 * MiB;
constexpr size_t WS_F1 = 184 * MiB;
constexpr size_t WS_GL = WS_F1;
constexpr size_t WS_TZ = 202 * MiB;
constexpr size_t WS_MS = 204 * MiB;
constexpr size_t WS_QO = 212 * MiB;
constexpr size_t WS_SLOC = 220 * MiB;
constexpr size_t WS_XP = 225 * MiB;
constexpr size_t WS_XC = 230 * MiB;
constexpr size_t WS_MM = WS_QKV;
constexpr size_t WS_STASH = WS_F1;
constexpr size_t WS_H = WS_Z;
constexpr size_t WS_WUQ = 6 * MiB + 256 * 1024;
constexpr size_t WS_WUKV = 6 * MiB + 512 * 1024;
constexpr size_t WS_D64 = 6 * MiB + 768 * 1024;
constexpr size_t WS_WGLU = 6 * MiB;
constexpr size_t WS_DFTL = 238 * MiB;
constexpr size_t WS_DFTC = 254 * MiB;
constexpr size_t WS_END = 256 * MiB;


#define LAS __attribute__((address_space(3)))
#define NT 512
__device__ __forceinline__ int l_tid() { int t = threadIdx.x; asm volatile("" : "+v"(t)); return t; }
__device__ __forceinline__ int l_bid() { int b = blockIdx.x; asm volatile("" : "+s"(b)); return b; }
__device__ __forceinline__ int l_grid() { int g = gridDim.x; asm volatile("" : "+s"(g)); return g; }
#define PH_IDS const int tid_ = l_tid(), bid_ = l_bid(), G_ = l_grid(); (void)tid_; (void)bid_; (void)G_
template <class AF, class BF, class EF>
__device__ __forceinline__ void gemm_tile(const AF& A, const BF& B, const EF& E, bool valid, int b, int m0, int n0, int M, int N, int K, bf16_t (*sA)[40], bf16_t (*sB)[40], int ht) {
    f32x4 accm[2][2];
#pragma unroll
    for (int i = 0; i < 2; ++i)
#pragma unroll
        for (int j = 0; j < 2; ++j) accm[i][j] = (f32x4){0.f, 0.f, 0.f, 0.f};
    const int w = ht >> 6, lane = ht & 63, wm = (w >> 1) * 32, wn = (w & 1) * 32, fr = lane & 15, fq = lane >> 4;
    for (int k0 = 0; k0 < K; k0 += 32) {
        __syncthreads();
#pragma unroll
        for (int i = 0; i < 8; ++i) {
            const int e = ht + i * 256;
            { const int m = e >> 5, k = e & 31; float v = 0.f; if (valid && m0 + m < M && k0 + k < K) v = A(b, m0 + m, k0 + k); sA[m][k] = f2bf(v); }
            { const int k = e >> 6, n = e & 63; float v = 0.f; if (valid && n0 + n < N && k0 + k < K) v = B(b, k0 + k, n0 + n); sB[n][k] = f2bf(v); }
        }
        __syncthreads();
        bf16x8 af[2], bfr[2];
#pragma unroll
        for (int i = 0; i < 2; ++i) { af[i] = *(const bf16x8*)&sA[wm + i * 16 + fr][fq * 8]; bfr[i] = *(const bf16x8*)&sB[wn + i * 16 + fr][fq * 8]; }
#pragma unroll
        for (int i = 0; i < 2; ++i)
#pragma unroll
            for (int j = 0; j < 2; ++j) accm[i][j] = __builtin_amdgcn_mfma_f32_16x16x32_bf16(af[i], bfr[j], accm[i][j], 0, 0, 0);
    }
    if (valid) {
#pragma unroll
        for (int i = 0; i < 2; ++i)
#pragma unroll
            for (int j = 0; j < 2; ++j)
#pragma unroll
                for (int rr = 0; rr < 4; ++rr) {
                    const int m = m0 + wm + i * 16 + fq * 4 + rr, n = n0 + wn + j * 16 + fr;
                    if (m < M && n < N) E(b, m, n, accm[i][j][rr]);
                }
    }
}
template <class AF, class BF, class EF>
__device__ __forceinline__ void gemm_phase(unsigned char* lds, const AF& A, const BF& B, const EF& E, int nbatch, int M, int N, int K) {
    PH_IDS; const int tid = tid_, half = tid >> 8, ht = tid & 255;
    bf16_t (*sA)[40] = (bf16_t (*)[40])(lds + half * 10240);
    bf16_t (*sB)[40] = (bf16_t (*)[40])(lds + half * 10240 + 5120);
    const int tm = (M + 63) >> 6, tn = (N + 63) >> 6, total = nbatch * tm * tn;
    for (int it0 = bid_ * 2; it0 < total; it0 += G_ * 2) {
        const int it = it0 + half; const bool valid = it < total;
        const int itc = valid ? it : 0;
        const int b = itc / (tm * tn), r = itc % (tm * tn), m0 = (r / tn) * 64, n0 = (r % tn) * 64;
        gemm_tile(A, B, E, valid, b, m0, n0, M, N, K, sA, sB, ht);
    }
    __syncthreads();
}
template <class T> static T zeroed() { T t; memset((void*)&t, 0, sizeof(T)); return t; }

struct A_bf16 { const bf16_t* p; long long ld; long long coff;
    __device__ float operator()(int, int m, int k) const { return bf2f(p[(size_t)m * ld + coff + k]); } };
struct A_bf16_scaled { const bf16_t* p; long long ld; long long coff; const float* rs; long long rsi; const float* w;
    __device__ float operator()(int, int m, int k) const { return bf2f(p[(size_t)m * ld + coff + k]) * rs[(size_t)m * 2 + rsi] * w[k]; } };
struct B_f32 { const float* p; long long ld; long long coff;
    __device__ float operator()(int, int k, int n) const { return p[(size_t)k * ld + coff + n]; } };
struct E_bf16 { bf16_t* p; long long ld; long long coff;
    __device__ void operator()(int, int m, int n, float v) const { p[(size_t)m * ld + coff + n] = f2bf(v); } };

#define XB_TMO      128
#define XB_XCNT(j)  (256  + 64 * (j))
#define XB_XSUB(j)  (1280 + 64 * (j))
#define XB_XGEN(j)  (2304 + 64 * (j))
#define XB_TOP      3328
#define XB_TOPGEN   3392
#define XCD_BAR_WORDS 3456
#define XB_SPIN_CAP (1u << 18)
__device__ __forceinline__ unsigned xb_ld(unsigned* p)              { return __hip_atomic_load(p, __ATOMIC_RELAXED, __HIP_MEMORY_SCOPE_AGENT); }
__device__ __forceinline__ unsigned xb_add(unsigned* p, unsigned v) { return __hip_atomic_fetch_add(p, v, __ATOMIC_RELAXED, __HIP_MEMORY_SCOPE_AGENT); }
__device__ __forceinline__ unsigned xb_xcc_id() { return (unsigned)__builtin_amdgcn_s_getreg((3 << 11) | 20) & 0xFu; }
#define XB_SPIN(cond, bar) do { unsigned _sp = 0; while (cond) { __builtin_amdgcn_s_sleep(1); \
    if ((++_sp & 255u) == 0u) { if (xb_ld(&(bar)[XB_TMO])) break; if (_sp > XB_SPIN_CAP) { atomicAdd(&(bar)[XB_TMO], 1u); break; } } } } while (0)
struct XcdBarrier { unsigned* bar; unsigned x; volatile LAS unsigned* st; };
__device__ __forceinline__ XcdBarrier xcd_barrier_post(unsigned* bar, volatile LAS unsigned* st) {
    XcdBarrier b; b.bar = bar; b.x = xb_xcc_id(); b.st = st;
    if (threadIdx.x == 0) (void)xb_add(&bar[XB_XCNT(b.x)], 1u);
    return b;
}
__device__ __forceinline__ void xcd_barrier_complete(unsigned* bar, unsigned x, unsigned& nloc, unsigned& nx) {
    const unsigned G = gridDim.x * gridDim.y * gridDim.z;
    unsigned sum, cnt, mine, sp = 0u;
    for (;;) {
        sum = 0u; cnt = 0u; mine = 0u;
#pragma unroll
        for (unsigned j = 0; j < 16; ++j) { const unsigned c = xb_ld(&bar[XB_XCNT(j)]); sum += c; cnt += (c > 0u) ? 1u : 0u; mine = (j == x) ? c : mine; }
        if (sum == G) break;
        __builtin_amdgcn_s_sleep(1);
        if ((++sp & 255u) == 0u) { if (xb_ld(&bar[XB_TMO])) break; if (sp > XB_SPIN_CAP) { atomicAdd(&bar[XB_TMO], 1u); break; } }
    }
    nloc = mine > 0u ? mine : 1u; nx = cnt > 0u ? cnt : 1u;
}
__device__ __forceinline__ void xcd_barrier(const XcdBarrier& b) {
    asm volatile("s_waitcnt vmcnt(0)" ::: "memory");
    __syncthreads();
    if (threadIdx.x == 0) {
        unsigned* bar = b.bar;
        __builtin_amdgcn_s_waitcnt(0);
        unsigned nloc = b.st[0], nx = b.st[1];
        if (nloc == 0u) { xcd_barrier_complete(bar, b.x, nloc, nx); b.st[0] = nloc; b.st[1] = nx; }
        const unsigned old = xb_add(&bar[XB_XSUB(b.x)], 1u);
        const unsigned gen = old / nloc;
        if (old + 1u == (gen + 1u) * nloc) {
            __builtin_amdgcn_fence(__ATOMIC_RELEASE, "agent");
            asm volatile("s_waitcnt vmcnt(0)" ::: "memory");
            const unsigned og = xb_add(&bar[XB_TOP], 1u);
            const unsigned tg = og / nx;
            if (og + 1u == (tg + 1u) * nx) xb_add(&bar[XB_TOPGEN], 1u);
            else XB_SPIN(xb_ld(&bar[XB_TOPGEN]) == tg, bar);
            __builtin_amdgcn_fence(__ATOMIC_ACQUIRE, "agent");
            xb_add(&bar[XB_XGEN(b.x)], 1u);
            asm volatile("s_waitcnt vmcnt(0)" ::: "memory");
        } else {
            XB_SPIN(xb_ld(&bar[XB_XGEN(b.x)]) == gen, bar);
            __builtin_amdgcn_fence(__ATOMIC_ACQUIRE, "agent");
            asm volatile("s_waitcnt vmcnt(0)" ::: "memory");
        }
    }
    __syncthreads();
}

namespace pg8 {
typedef unsigned u32x4 __attribute__((ext_vector_type(4)));
constexpr int BM = 256, BK = 64, HALF = 128, HTB = HALF * BK * 2, STAGE_BYTES = 8 * HTB, NXCD = 8, WGM = 8;
__device__ __forceinline__ int lds_byte(int r, int c) { const int st = (r >> 4) * 2 + (c >> 5), rr = r & 15, cc = c & 31, ob = rr * 64 + cc * 2; return st * 1024 + (ob ^ (((ob >> 9) & 1) << 5)); }
__device__ __forceinline__ void stage_rc(int b, int& R, int& C) { const int st = b / 1024, sb = b % 1024, swz = sb ^ (((sb >> 9) & 1) << 5); R = (st >> 1) * 16 + swz / 64; C = (st & 1) * 32 + (swz % 64) / 2; }
__device__ __forceinline__ int perm32(int rho) { const int n = rho >> 4, i = rho & 15; return 8 * (i >> 2) + 4 * n + (i & 3); }
struct Unit { const char* A; const char* B; unsigned lda, ldb; int nt, pm, pn, kind, aux; };
__device__ __forceinline__ unsigned cvt_pk_bf16(float lo, float hi) { unsigned r; asm volatile("v_cvt_pk_bf16_f32 %0, %1, %2" : "=v"(r) : "v"(lo), "v"(hi)); return r; }
__device__ __forceinline__ bool static_tile(int nM, int nN, int G, int c, int i, int& pm, int& pn) {
    const int nwg = nM * nN; const long L = (long)i * G + c; if (L >= nwg) return false;
    int wgid = (int)L; { const int q = nwg / NXCD, r = nwg % NXCD, xcd = wgid % NXCD, off = wgid / NXCD; wgid = (xcd < r ? xcd * (q + 1) : r * (q + 1) + (xcd - r) * q) + off; }
    const int nig = WGM * nN, gid = wgid / nig, fm = gid * WGM, gsz = (nM - fm) < WGM ? (nM - fm) : WGM;
    pm = fm + ((wgid % nig) % gsz); pn = (wgid % nig) / gsz; return true;
}
template <class Epi, class Sched>
__device__ __forceinline__ void gemm_phase(LAS unsigned char* lds, const Sched& S, const Epi& E) {
    const int tid = l_tid(), wid = __builtin_amdgcn_readfirstlane(tid >> 6), lane = tid & 63, wr = wid >> 2, wc = wid & 3, fr = lane & 15, fq = lane >> 4;
    int sR[2], sRb[2], sC2[2];
#pragma unroll
    for (int i = 0; i < 2; ++i) { int R, C; stage_rc(tid * 16 + i * 8192, R, C); sR[i] = R; sRb[i] = (R & ~31) + perm32(R & 31); sC2[i] = C * 2; }
    const size_t kstep = (size_t)(BK * 2);
    const unsigned ldsw = (unsigned)wid * 1024u;
    const int aoff = lds_byte(wr * 64 + fr, fq * 8), boff = lds_byte(wc * 32 + fr, fq * 8);
#define PG8_SA(b, h) (((b) * 2 + (h)) * HTB)
#define PG8_SB(b, h) ((4 + (b) * 2 + (h)) * HTB)
#define PG8_STAGE_A(bufoff, gbase, ld) do { \
        __builtin_amdgcn_global_load_lds((const unsigned*)((const char*)(gbase) + (unsigned)(sR[0] * (ld) + sC2[0])), (LAS unsigned*)(lds + (bufoff) + ldsw), 16, 0, 0); \
        __builtin_amdgcn_global_load_lds((const unsigned*)((const char*)(gbase) + (unsigned)(sR[1] * (ld) + sC2[1])), (LAS unsigned*)(lds + (bufoff) + ldsw + 8192), 16, 0, 0); } while (0)
#define PG8_STAGE_B(bufoff, gbase, ld) do { \
        __builtin_amdgcn_global_load_lds((const unsigned*)((const char*)(gbase) + (unsigned)(sRb[0] * (ld) + sC2[0])), (LAS unsigned*)(lds + (bufoff) + ldsw), 16, 0, 0); \
        __builtin_amdgcn_global_load_lds((const unsigned*)((const char*)(gbase) + (unsigned)(sRb[1] * (ld) + sC2[1])), (LAS unsigned*)(lds + (bufoff) + ldsw + 8192), 16, 0, 0); } while (0)
#define PG8_LDA(dst, b, h) do { _Pragma("unroll") for (int m = 0; m < 4; ++m) _Pragma("unroll") for (int k = 0; k < 2; ++k) dst[m][k] = *(const LAS bf16x8*)(lds + PG8_SA(b, h) + aoff + m * 2048 + k * 1024); } while (0)
#define PG8_LDB(dst, b, h) do { _Pragma("unroll") for (int n = 0; n < 2; ++n) _Pragma("unroll") for (int k = 0; k < 2; ++k) dst[n][k] = *(const LAS bf16x8*)(lds + PG8_SB(b, h) + boff + n * 2048 + k * 1024); } while (0)
#define PG8_MMA(ai, bj, At, Bt) do { __builtin_amdgcn_s_setprio(1); _Pragma("unroll") for (int m = 0; m < 4; ++m) _Pragma("unroll") for (int n = 0; n < 2; ++n) _Pragma("unroll") for (int k = 0; k < 2; ++k) \
        acc[ai][bj][m][n] = __builtin_amdgcn_mfma_f32_16x16x32_bf16(Bt[n][k], At[m][k], acc[ai][bj][m][n], 0, 0, 0); __builtin_amdgcn_s_setprio(0); } while (0)
#define PG8_WAIT_V(n) asm volatile("s_waitcnt vmcnt(" #n ")" ::: "memory")
#define PG8_WAIT_L(n) asm volatile("s_waitcnt lgkmcnt(" #n ")" ::: "memory")
#define PG8_BAR __builtin_amdgcn_s_barrier()
#define PG8_SCHED __builtin_amdgcn_sched_barrier(0)
    Unit cur, nxt; int ui = 0;
    if (!S.next(0, cur)) return;
    f32x4 acc[2][2][4][2];
#pragma unroll
    for (int a = 0; a < 2; ++a)
#pragma unroll
        for (int b = 0; b < 2; ++b)
#pragma unroll
            for (int m = 0; m < 4; ++m)
#pragma unroll
                for (int n = 0; n < 2; ++n) acc[a][b][m][n] = (f32x4){0.f, 0.f, 0.f, 0.f};
    bf16x8 At[4][2], B0[2][2], B1[2][2];
    const char* cA = cur.A; const char* cB = cur.B;
    int clda = cur.lda, cldb = cur.ldb;
    PG8_STAGE_B(PG8_SB(0, 0), cB, cldb); PG8_STAGE_B(PG8_SB(0, 1), cB + (size_t)HALF * cldb, cldb); PG8_STAGE_A(PG8_SA(0, 0), cA, clda); PG8_STAGE_A(PG8_SA(0, 1), cA + (size_t)HALF * clda, clda);
    if (wr == 1) PG8_BAR;
    PG8_WAIT_V(2); PG8_BAR;
    PG8_STAGE_B(PG8_SB(1, 0), cB + kstep, cldb); PG8_STAGE_A(PG8_SA(1, 0), cA + kstep, clda); PG8_STAGE_B(PG8_SB(1, 1), cB + (size_t)HALF * cldb + kstep, cldb);
    PG8_WAIT_V(6); PG8_BAR;
    for (;;) {
        const bool has_next = S.next(ui + 1, nxt);
        const char* nA = has_next ? nxt.A : cA; const char* nB = has_next ? nxt.B : cB;
        const int nlda = has_next ? (int)nxt.lda : clda, nldb = has_next ? (int)nxt.ldb : cldb;
        const int nt = cur.nt;
        for (int t = 0; t < nt; t += 2) {
            const bool last = (t == nt - 2);
            const char* a1 = cA + (size_t)(t + 1) * kstep;
            const char* a2 = last ? nA : cA + (size_t)(t + 2) * kstep; const char* b2 = last ? nB : cB + (size_t)(t + 2) * kstep;
            const char* a3 = a2 + kstep; const char* b3 = b2 + kstep;
            const int lda2 = last ? nlda : clda, ldb2 = last ? nldb : cldb;
            PG8_LDB(B0, 0, 0); PG8_LDB(B1, 0, 1); PG8_SCHED; PG8_LDA(At, 0, 0); PG8_STAGE_A(PG8_SA(1, 1), a1 + (size_t)HALF * clda, clda);
            PG8_WAIT_V(8); PG8_WAIT_L(0); PG8_BAR; PG8_MMA(0, 0, At, B0); PG8_MMA(0, 1, At, B1); PG8_BAR; PG8_SCHED;
            PG8_LDA(At, 0, 1); PG8_STAGE_B(PG8_SB(0, 0), b2, ldb2); PG8_STAGE_B(PG8_SB(0, 1), b2 + (size_t)HALF * ldb2, ldb2); PG8_STAGE_A(PG8_SA(0, 0), a2, lda2);
            PG8_WAIT_V(8); PG8_WAIT_L(0); PG8_BAR; PG8_MMA(1, 0, At, B0); PG8_MMA(1, 1, At, B1); PG8_BAR; PG8_SCHED;
            PG8_LDB(B0, 1, 0); PG8_LDB(B1, 1, 1); PG8_SCHED; PG8_LDA(At, 1, 0); PG8_STAGE_A(PG8_SA(0, 1), a2 + (size_t)HALF * lda2, lda2);
            PG8_WAIT_V(8); PG8_WAIT_L(0); PG8_BAR; PG8_MMA(0, 0, At, B0); PG8_MMA(0, 1, At, B1); PG8_BAR; PG8_SCHED;
            PG8_LDA(At, 1, 1); PG8_STAGE_B(PG8_SB(1, 0), b3, ldb2); PG8_STAGE_B(PG8_SB(1, 1), b3 + (size_t)HALF * ldb2, ldb2); PG8_STAGE_A(PG8_SA(1, 0), a3, lda2);
            PG8_WAIT_V(8); PG8_WAIT_L(0); PG8_BAR; PG8_MMA(1, 0, At, B0); PG8_MMA(1, 1, At, B1); PG8_BAR; PG8_SCHED;
        }
        if (wr == 0) PG8_BAR;
        E(acc, cur, wr, wc, fr, fq);
        if (!has_next) break;
#pragma unroll
        for (int a = 0; a < 2; ++a)
#pragma unroll
            for (int b = 0; b < 2; ++b)
#pragma unroll
                for (int m = 0; m < 4; ++m)
#pragma unroll
                    for (int n = 0; n < 2; ++n) acc[a][b][m][n] = (f32x4){0.f, 0.f, 0.f, 0.f};
        cur = nxt; cA = nA; cB = nB; clda = nlda; cldb = nldb; ++ui;
        if (wr == 1) PG8_BAR;
    }
    PG8_WAIT_V(0);
    PG8_BAR;
#undef PG8_SA
#undef PG8_SB
#undef PG8_STAGE_A
#undef PG8_STAGE_B
#undef PG8_LDA
#undef PG8_LDB
#undef PG8_MMA
#undef PG8_WAIT_V
#undef PG8_WAIT_L
#undef PG8_BAR
#undef PG8_SCHED
}
}

__device__ __forceinline__ pg8::u32x4 pack8(const f32x4 a, const f32x4 b) { pg8::u32x4 w; w.x = pg8::cvt_pk_bf16(a[0], a[1]); w.y = pg8::cvt_pk_bf16(a[2], a[3]); w.z = pg8::cvt_pk_bf16(b[0], b[1]); w.w = pg8::cvt_pk_bf16(b[2], b[3]); return w; }
__device__ __forceinline__ void unpack8(const pg8::u32x4 w, f32x4& a, f32x4& b) {
    a[0] = __uint_as_float(w.x << 16); a[1] = __uint_as_float(w.x & 0xffff0000u); a[2] = __uint_as_float(w.y << 16); a[3] = __uint_as_float(w.y & 0xffff0000u);
    b[0] = __uint_as_float(w.z << 16); b[1] = __uint_as_float(w.z & 0xffff0000u); b[2] = __uint_as_float(w.w << 16); b[3] = __uint_as_float(w.w & 0xffff0000u); }
#define GSTRIDE(gi, total) for (int gi = bid_ * NT + tid_; gi < (total); gi += G_ * NT)
__device__ __forceinline__ void ph_mod(unsigned char* lds, const float* c, const float* c_ctx, const float* ada_w, const float* ada_b, float* mod) { PH_IDS;
    float (*sl)[1024] = (float (*)[1024])lds;
    for (int e = tid_; e < 9 * 1024; e += NT) { const int j = e >> 10, k = e & 1023; const float v = j < 8 ? c[j * 1024 + k] : c_ctx[k]; sl[j][k] = siluf_(v); }
    __syncthreads();
    GSTRIDE(gi, 2 * 6144) {
        const int l = gi / 6144, n = gi % 6144;
        float acc[9];
#pragma unroll
        for (int j = 0; j < 9; ++j) acc[j] = 0.f;
        const float* w = ada_w + (size_t)l * 1024 * 6144 + n;
        for (int k = 0; k < 1024; ++k) { const float wv = w[(size_t)k * 6144];
#pragma unroll
            for (int j = 0; j < 9; ++j) acc[j] += sl[j][k] * wv; }
        const float bb = ada_b[l * 6144 + n];
#pragma unroll
        for (int j = 0; j < 9; ++j) mod[((size_t)l * 9 + j) * 6144 + n] = acc[j] + bb;
    }
    __syncthreads();
}
__device__ __forceinline__ void ph_trig(float* trig, bf16_t* d64) { PH_IDS; GSTRIDE(i, 2048) { const float xx = (float)i * (1.f / 1024.f); trig[i] = cospif(xx); trig[2048 + i] = sinpif(xx); }
    GSTRIDE(i, 128 * 64) { const int n = i >> 6, c = i & 63, m = n & 63; const float xx = (float)((m * c) & 63) * (1.f / 32.f); d64[i] = f2bf(n < 64 ? cospif(xx) : sinpif(xx)); } }
__device__ __forceinline__ double2 lam_pow(double re, double im, double dt, int k) {
    const double m = (double)__expf((float)(re * dt * k));
    double xx = im * dt * (double)k * 0.318309886183790671538;
    xx -= 2.0 * rint(xx * 0.5);
    const float xf = (float)xx;
    return make_double2(m * (double)cospif(xf), m * (double)sinpif(xf));
}
__device__ __forceinline__ void ph_s5_lp(int l, const float* lam_re, const float* lam_im, const float* log_step, const float* b_re, const float* b_im, double2* LP, double2* BB, float* lamT) { PH_IDS;
    GSTRIDE(i, 2 * 16 * 64) {
        const int d = i / 1024, g = (i / 64) % 16, p = i % 64;
        const size_t li = ((size_t)(l * 2 + d) * 16 + g) * 64 + p;
        const double re = lam_re[li], im = lam_im[li], dt = (double)expf(log_step[(l * 2 + d) * 16 + g]);
        for (int k = 0; k <= 64; ++k) LP[(size_t)i * 65 + k] = lam_pow(re, im, dt, k);
        const double2 l1 = lam_pow(re, im, dt, 1);
        const double nr = l1.x - 1.0, ni = l1.y, den = re * re + im * im;
        const double fr = (nr * re + ni * im) / den, fi = (ni * re - nr * im) / den;
        for (int h = 0; h < 16; ++h) { const double br = b_re[li * 16 + h], bi = b_im[li * 16 + h]; BB[(size_t)i * 16 + h] = make_double2(fr * br - fi * bi, fr * bi + fi * br); }
        const double2 l64 = lam_pow(re, im, dt, 64);
        lamT[((size_t)(g * 2 + d) * 64 + p) * 2 + 0] = (float)l64.x; lamT[((size_t)(g * 2 + d) * 64 + p) * 2 + 1] = (float)l64.y;
    }
}
__device__ __forceinline__ void ph_s5_tz(int l, const double2* LP, const double2* BB, const float* c_re, const float* c_im, const float* s5_d, bf16_t* TZT) { PH_IDS;
    GSTRIDE(i, 16 * 127 * 256) {
        const int g = i / (127 * 256), dd = (i / 256) % 127, h = (i / 16) % 16, hp = i % 16;
        const int delta = dd - 63;
        double acc = 0.0;
        for (int d = 0; d < 2; ++d) {
            if ((d == 0 && delta < 0) || (d == 1 && delta > 0)) continue;
            const int tau = delta < 0 ? -delta : delta;
            for (int p = 0; p < 64; ++p) {
                const size_t ci = (((size_t)(l * 2 + d) * 16 + g) * 16 + h) * 64 + p;
                const double cr = c_re[ci], cim = c_im[ci];
                const size_t gi = ((size_t)d * 16 + g) * 64 + p;
                const double2 lp = LP[gi * 65 + tau], bb = BB[gi * 16 + hp];
                const double xr = lp.x * bb.x - lp.y * bb.y, xi = lp.x * bb.y + lp.y * bb.x;
                acc += cr * xr - cim * xi;
            }
        }
        if (delta == 0 && h == hp) acc += (double)s5_d[l * 256 + g * 16 + h];
        TZT[i] = f2bf((float)acc);
    }
}
__device__ __forceinline__ void ph_s5_ms(const double2* LP, const double2* BB, bf16_t* MST) { PH_IDS;
    GSTRIDE(i, 16 * 128 * 1024) {
        const int g = i / (128 * 1024), dp = (i / 1024) % 128, sh = i % 1024, d = dp / 64, p = dp % 64, s = sh / 16, hp = sh % 16;
        const size_t gi = ((size_t)d * 16 + g) * 64 + p;
        const double2 lp = LP[gi * 65 + (d == 0 ? 63 - s : s)], bb = BB[gi * 16 + hp];
        bf16_t* o = MST + ((size_t)g * 256 + d * 128 + p) * 1024 + sh;
        o[0] = f2bf((float)(lp.x * bb.x - lp.y * bb.y)); o[(size_t)64 * 1024] = f2bf((float)(lp.x * bb.y + lp.y * bb.x));
    }
}
__device__ __forceinline__ void ph_s5_qo(int l, const double2* LP, const float* c_re, const float* c_im, bf16_t* QOT) { PH_IDS;
    GSTRIDE(i, 16 * 1024 * 128) {
        const int g = i / (128 * 1024), th = (i / 128) % 1024, dp = i % 128, d = dp / 64, p = dp % 64, t = th / 16, h = th % 16;
        const size_t ci = (((size_t)(l * 2 + d) * 16 + g) * 16 + h) * 64 + p;
        const double cr = c_re[ci], cim = c_im[ci];
        const double2 lp = LP[(((size_t)d * 16 + g) * 64 + p) * 65 + (d == 0 ? t + 1 : 64 - t)];
        bf16_t* o = QOT + ((size_t)g * 1024 + th) * 256 + d * 128 + p;
        o[0] = f2bf((float)(cr * lp.x - cim * lp.y)); o[64] = f2bf((float)(-(cr * lp.y + cim * lp.x)));
    }
}
__device__ __forceinline__ void ph_adarms(const float* xlat, const float* xctx, const float* w, const float* mod, int sh_chunk, int sc_chunk, bf16_t* out, int nrows) { PH_IDS;
    const int wave = (bid_ * NT + tid_) >> 6, lane = tid_ & 63, nw = (G_ * NT) >> 6;
    for (int row = wave; row < nrows; row += nw) {
        const float* x = row < RL ? xlat + (size_t)row * DM : xctx + (size_t)(row - RL) * DM;
        float v[16]; float ss = 0.f;
#pragma unroll
        for (int j = 0; j < 4; ++j) { const f32x4 t = *(const f32x4*)(x + j * 256 + lane * 4); v[j * 4] = t[0]; v[j * 4 + 1] = t[1]; v[j * 4 + 2] = t[2]; v[j * 4 + 3] = t[3]; ss += t[0] * t[0] + t[1] * t[1] + t[2] * t[2] + t[3] * t[3]; }
#pragma unroll
        for (int o = 1; o < 64; o <<= 1) ss += __shfl_xor(ss, o);
        const float rstd = rsqrtf(ss * (1.f / DM) + EPS);
        const float* mrow = mod + (size_t)row_modidx(row) * 6144;
#pragma unroll
        for (int j = 0; j < 4; ++j)
#pragma unroll
            for (int q = 0; q < 4; ++q) { const int cidx = j * 256 + lane * 4 + q; const float y = v[j * 4 + q] * rstd * w[cidx] * (1.f + mrow[sc_chunk * 1024 + cidx]) + mrow[sh_chunk * 1024 + cidx]; out[(size_t)row * DM + cidx] = f2bf(y); }
    }
}
__device__ __forceinline__ void ph_mla_stats(const bf16_t* Z, float* rs) { PH_IDS;
    const int wave = (bid_ * NT + tid_) >> 6, lane = tid_ & 63, nw = (G_ * NT) >> 6;
    for (int row = wave; row < RT; row += nw) {
        const bf16_t* z = Z + (size_t)row * ZW; float sq = 0.f, sk = 0.f;
#pragma unroll
        for (int j = 0; j < 4; ++j) { const float v = bf2f(z[C_QC + j * 64 + lane]); sq += v * v; }
#pragma unroll
        for (int j = 0; j < 2; ++j) { const float v = bf2f(z[C_KVC + j * 64 + lane]); sk += v * v; }
#pragma unroll
        for (int o = 1; o < 64; o <<= 1) { sq += __shfl_xor(sq, o); sk += __shfl_xor(sk, o); }
        if (lane == 0) { rs[(size_t)row * 2] = rsqrtf(sq * (1.f / 256) + EPS); rs[(size_t)row * 2 + 1] = rsqrtf(sk * (1.f / 128) + EPS); }
    }
}
__device__ __forceinline__ void ph_mla_post(const bf16_t* Z, const bf16_t* qraw, const bf16_t* kvraw, const float* qkq, const float* qkk, bf16_t* Q, bf16_t* Kb, bf16_t* Vb) { PH_IDS;
    GSTRIDE(gi, RT * 8) {
        const int row = gi >> 3, h = (gi >> 1) & 3, isk = gi & 1;
        const bool lat = row < RL; const int b = row_batch(row), t = lat ? (row & 2047) : ((row - RL) & 255);
        const int qi = lat ? t : 2048 + t, ki = lat ? 256 + t : t;
        float v[96];
        float ss = 0.f;
        if (!isk) {
#pragma unroll
            for (int i = 0; i < 96; ++i) v[i] = bf2f(qraw[(size_t)row * 384 + h * 96 + i]);
        } else {
#pragma unroll
            for (int i = 0; i < 64; ++i) v[i] = bf2f(kvraw[(size_t)row * 512 + h * 128 + i]);
#pragma unroll
            for (int i = 0; i < 32; ++i) v[64 + i] = bf2f(Z[(size_t)row * ZW + C_KR + i]);
        }
#pragma unroll
        for (int i = 0; i < 96; ++i) ss += v[i] * v[i];
        const float rr = rsqrtf(ss * (1.f / 96) + EPS) * (isk ? 1.f : 0.14724727430627066f);
        const float* wv = isk ? qkk : qkq;
#pragma unroll
        for (int i = 0; i < 96; ++i) v[i] = v[i] * rr * wv[i];
        if (lat) {
            const float prow = (float)(t >> 6), pcol = (float)(t & 63);
#pragma unroll
            for (int part = 0; part < 2; ++part) { const float pos = part ? pcol : prow; const int base = 64 + part * 16;
#pragma unroll
                for (int j = 0; j < 8; ++j) { const float fr = exp2f(-(float)j * (13.287712379549449f / 8.f)), a = pos * fr, cs = __cosf(a), sn = __sinf(a);
                    const float x1 = v[base + j], x2 = v[base + 8 + j]; v[base + j] = x1 * cs - x2 * sn; v[base + 8 + j] = x1 * sn + x2 * cs; } }
        }
        bf16_t* o = isk ? Kb + ((size_t)(b * 4 + h) * 2304 + ki) * 96 : Q + ((size_t)(b * 4 + h) * 2304 + qi) * 96;
#pragma unroll
        for (int i = 0; i < 96; ++i) o[i] = f2bf(v[i]);
        if (isk) { bf16_t* vo = Vb + ((size_t)(b * 4 + h) * 2304 + ki) * 64; for (int i = 0; i < 64; ++i) vo[i] = kvraw[(size_t)row * 512 + h * 128 + 64 + i]; }
    }
}
__device__ __forceinline__ void ph_attn(unsigned char* lds, const bf16_t* Q, const bf16_t* Kb, const bf16_t* Vb, bf16_t* Z, int with_ctx) { PH_IDS;
    float (*sK)[96] = (float (*)[96])lds; float (*sV)[64] = (float (*)[64])(lds + 32 * 96 * 4);
    const int nunits = 32 * (8 + (with_ctx ? 1 : 0));
    const int qt = tid_ & 255, dh = (tid_ >> 8) * 32;
    for (int u = bid_; u < nunits; u += G_) {
        const int bh = u % 32, qb = u / 32;
        const bool lat = qb < 8;
        const int qi = qb * 256 + qt, nkeys = lat ? 2304 : 256;
        float q[96], o[32];
        const bf16_t* qp = Q + ((size_t)bh * 2304 + qi) * 96;
#pragma unroll
        for (int i = 0; i < 96; ++i) q[i] = bf2f(qp[i]) * 0.10206207261596577f;
#pragma unroll
        for (int i = 0; i < 32; ++i) o[i] = 0.f;
        float mx = -1e30f, l = 0.f;
        for (int k0 = 0; k0 < nkeys; k0 += 32) {
            __syncthreads();
            for (int e = tid_; e < 32 * 96; e += NT) sK[e / 96][e % 96] = bf2f(Kb[((size_t)bh * 2304 + k0) * 96 + e]);
            for (int e = tid_; e < 32 * 64; e += NT) sV[e / 64][e % 64] = bf2f(Vb[((size_t)bh * 2304 + k0) * 64 + e]);
            __syncthreads();
#pragma unroll 1
            for (int j = 0; j < 32; ++j) { float a = 0.f;
#pragma unroll
                for (int i = 0; i < 96; ++i) a += q[i] * sK[j][i];
                if (a > mx) { const float corr = __expf(mx - a); mx = a; l *= corr;
#pragma unroll
                    for (int i = 0; i < 32; ++i) o[i] *= corr; }
                const float p = __expf(a - mx); l += p;
#pragma unroll
                for (int i = 0; i < 32; ++i) o[i] += p * sV[j][dh + i]; }
        }
        const int b = bh >> 2, h = bh & 3;
        const int row = lat ? b * 2048 + qi : RL + b * 256 + (qi - 2048);
        const float inv = 1.f / l;
#pragma unroll
        for (int i = 0; i < 32; ++i) Z[(size_t)row * ZW + C_QC + h * 64 + dh + i] = f2bf(o[i] * inv);
    }
    __syncthreads();
}
__device__ __forceinline__ void ph_f1(const bf16_t* Z, const float* trig, bf16_t* F1lat, bf16_t* F1ctx) { PH_IDS;
    GSTRIDE(gi, RT * 256) {
        const int row = gi >> 8, gm = gi & 255, g = gm >> 6, m = gm & 63;
        float a = 0.f, bsum = 0.f;
        const bf16_t* u = Z + (size_t)row * ZW + C_FU + g * 64;
        for (int c = 0; c < 64; ++c) { const float v = bf2f(u[c]); const int idx = ((m * c) & 63) * 32; a += v * trig[idx]; bsum += v * trig[2048 + idx]; }
        if (row < RL) { const int b = row >> 11, t = row & 2047; bf16_t* o = F1lat + ((size_t)(b * 256 + gm) * 2) * 2048; o[t] = f2bf(a); o[2048 + t] = f2bf(bsum); }
        else { const int r = row - RL, b = r >> 8, t = r & 255; bf16_t* o = F1ctx + ((size_t)(b * 256 + gm) * 2) * 256; o[t] = f2bf(a); o[256 + t] = f2bf(bsum); }
    }
}
struct A_dft { const float* trig; long long L; long long mul;
    __device__ float operator()(int, int k, int kk) const { const int part = kk >= (int)L, t = part ? kk - (int)L : kk; const int idx = (int)(((long long)k * t) & (L - 1)) * (int)mul; return part ? -trig[2048 + idx] : trig[idx]; } };
struct B_f1t { const bf16_t* p; long long L;
    __device__ float operator()(int b, int kk, int n) const { return bf2f(p[((size_t)(b * 256 + n)) * 2 * L + kk]); } };
struct E_fourier { bf16_t* Z; long long rowbase; long long L; double scale;
    __device__ void operator()(int b, int m, int n, float v) const { Z[((size_t)rowbase + (size_t)b * L + m) * ZW + C_FU + n] = f2bf(v * (float)scale); } };

struct A_s5u { const bf16_t* Z;
    __device__ float operator()(int g, int rc, int k) const { return bf2f(Z[((size_t)rc * 64 + (k >> 4)) * ZW + C_S5 + g * 16 + (k & 15)]); } };
struct B_ms { const bf16_t* MS; __device__ float operator()(int g, int k, int n) const { return bf2f(MS[((size_t)g * 1024 + k) * 256 + n]); } };
struct E_sloc { float* S; __device__ void operator()(int g, int rc, int n, float v) const { S[((size_t)rc * 16 + g) * 256 + n] = v; } };
__device__ __forceinline__ void ph_s5_scan(const float* SLOC, const float* lamT, float* XP) { PH_IDS;
    GSTRIDE(i, 8 * 16 * 2 * 64) {
        const int b = i / 2048, g = (i / 128) % 16, d = (i / 64) % 2, p = i % 64;
        const float lr = lamT[((size_t)(g * 2 + d) * 64 + p) * 2], li = lamT[((size_t)(g * 2 + d) * 64 + p) * 2 + 1];
        float xr = 0.f, xi = 0.f;
        for (int step = 0; step < 36; ++step) {
            int rc;
            if (d == 0) rc = step < 4 ? 256 + b * 4 + step : b * 32 + (step - 4);
            else rc = step < 4 ? 256 + b * 4 + (3 - step) : b * 32 + (31 - (step - 4));
            const size_t o = ((size_t)rc * 16 + g) * 256 + d * 128;
            XP[o + p] = xr; XP[o + 64 + p] = xi;
            const float sr = SLOC[o + p], si = SLOC[o + 64 + p];
            const float nr = lr * xr - li * xi + sr, ni = lr * xi + li * xr + si; xr = nr; xi = ni;
        }
    }
}
struct A_s5out { const bf16_t* Z; const float* XP;
    __device__ float operator()(int g, int rc, int k) const { return k < 1024 ? bf2f(Z[((size_t)rc * 64 + (k >> 4)) * ZW + C_S5 + g * 16 + (k & 15)]) : XP[((size_t)rc * 16 + g) * 256 + (k - 1024)]; } };
struct B_s5out { const float* TZ; const bf16_t* QO;
    __device__ float operator()(int g, int k, int n) const { if (k < 1024) { const int s = k >> 4, hp = k & 15, t = n >> 4, h = n & 15; return TZ[(((size_t)g * 127 + (t - s + 63)) * 16 + hp) * 16 + h]; } return bf2f(QO[((size_t)g * 256 + (k - 1024)) * 1024 + n]); } };
struct E_s5out { bf16_t* YG; __device__ void operator()(int g, int rc, int n, float v) const { YG[((size_t)rc * 64 + (n >> 4)) * 256 + g * 16 + (n & 15)] = f2bf(geluf_(v)); } };
__device__ __forceinline__ void ph_glu(const bf16_t* GL, bf16_t* Z) { PH_IDS;
    GSTRIDE(gi, RT * 256) {
        const int row = gi >> 8, j = gi & 255;
        const float val = bf2f(GL[(size_t)row * 512 + j]), gate = bf2f(GL[(size_t)row * 512 + 256 + j]);
        Z[(size_t)row * ZW + C_S5 + j] = f2bf(val * sigmoidf_(gate));
    }
}
__device__ __forceinline__ void ph_ret_prep(bf16_t* Z) { PH_IDS;
    GSTRIDE(gi, RT * 4 * 32) {
        const int row = gi >> 7, h = (gi >> 5) & 3, j = gi & 31;
        bf16_t* z = Z + (size_t)row * ZW;
        if (row < RL) {
            const int t = row & 2047; const float fr = exp2f(-(float)j * (13.287712379549449f / 32.f)), a = (float)t * fr, cs = cosf(a), sn = sinf(a);
            { const float x1 = bf2f(z[C_RQ + h * 64 + j]), x2 = bf2f(z[C_RQ + h * 64 + 32 + j]); z[C_RQ + h * 64 + j] = f2bf(x1 * cs - x2 * sn); z[C_RQ + h * 64 + 32 + j] = f2bf(x1 * sn + x2 * cs); }
            { const float x1 = bf2f(z[C_RK + h * 64 + j]), x2 = bf2f(z[C_RK + h * 64 + 32 + j]); z[C_RK + h * 64 + j] = f2bf((x1 * cs - x2 * sn) * 0.125f); z[C_RK + h * 64 + 32 + j] = f2bf((x1 * sn + x2 * cs) * 0.125f); }
        } else {
            z[C_RK + h * 64 + j] = f2bf(bf2f(z[C_RK + h * 64 + j]) * 0.125f); z[C_RK + h * 64 + 32 + j] = f2bf(bf2f(z[C_RK + h * 64 + 32 + j]) * 0.125f);
        }
    }
}
__device__ __forceinline__ void ph_ret(unsigned char* lds, bf16_t* Z, const float* decay_logit, const float* gn_w, int with_ctx) { PH_IDS;
    float (*sK)[64] = (float (*)[64])lds; float (*sV)[64] = (float (*)[64])(lds + 32 * 64 * 4);
    float* sred = (float*)(lds + 2 * 32 * 64 * 4);
    const int nunits = 32 * (8 + (with_ctx ? 1 : 0));
    const int qt = tid_ & 255, hh = tid_ >> 8, dh = hh * 32;
    for (int u = bid_; u < nunits; u += G_) {
        const int bh = u % 32, qb = u / 32, b = bh >> 2, h = bh & 3;
        const bool lat = qb < 8;
        const int qpos = lat ? qb * 256 + qt : qt;
        const int qrow = lat ? b * 2048 + qpos : RL + b * 256 + qpos;
        const float lgf = -log1pf(__expf(-decay_logit[h])) * 1.4426950408889634f, lgb = -log1pf(__expf(-decay_logit[4 + h])) * 1.4426950408889634f;
        float q[64], o[32];
#pragma unroll
        for (int i = 0; i < 64; ++i) q[i] = bf2f(Z[(size_t)qrow * ZW + C_RQ + h * 64 + i]);
#pragma unroll
        for (int i = 0; i < 32; ++i) o[i] = 0.f;
        const int nkeys = lat ? 2560 : 256;
        for (int k0 = 0; k0 < nkeys; k0 += 32) {
            int krow0, kpos0;
            if (lat) { if (k0 < 256) { krow0 = RL + b * 256 + k0; kpos0 = k0 - 256; } else if (k0 < 2304) { krow0 = b * 2048 + (k0 - 256); kpos0 = k0 - 256; } else { krow0 = RL + b * 256 + (k0 - 2304); kpos0 = 2048 + (k0 - 2304); } }
            else { krow0 = RL + b * 256 + k0; kpos0 = k0; }
            __syncthreads();
            for (int e = tid_; e < 32 * 64; e += NT) { const int j = e >> 6, i = e & 63; sK[j][i] = bf2f(Z[(size_t)(krow0 + j) * ZW + C_RK + h * 64 + i]); sV[j][i] = bf2f(Z[(size_t)(krow0 + j) * ZW + C_RV + h * 64 + i]); }
            __syncthreads();
#pragma unroll 1
            for (int j = 0; j < 32; ++j) { float a = 0.f;
#pragma unroll
                for (int i = 0; i < 64; ++i) a += q[i] * sK[j][i];
                const int dpos = qpos - (kpos0 + j);
                const float dec = dpos > 0 ? exp2f(lgf * (float)dpos) : (dpos < 0 ? exp2f(lgb * (float)(-dpos)) : 2.f);
                a *= dec;
#pragma unroll
                for (int i = 0; i < 32; ++i) o[i] += a * sV[j][dh + i]; }
        }
        float s1 = 0.f;
#pragma unroll
        for (int i = 0; i < 32; ++i) s1 += o[i];
        __syncthreads();
        sred[hh * 256 + qt] = s1;
        __syncthreads();
        const float mu = (sred[qt] + sred[256 + qt]) * (1.f / 64);
        float s2 = 0.f;
#pragma unroll
        for (int i = 0; i < 32; ++i) { const float d = o[i] - mu; s2 += d * d; }
        __syncthreads();
        sred[hh * 256 + qt] = s2;
        __syncthreads();
        const float rstd = rsqrtf((sred[qt] + sred[256 + qt]) * (1.f / 64) + EPS);
#pragma unroll
        for (int i = 0; i < 32; ++i) { const float gte = bf2f(Z[(size_t)qrow * ZW + C_RG + h * 64 + dh + i]); const float y = (o[i] - mu) * rstd * gn_w[h * 64 + dh + i];
            Z[(size_t)qrow * ZW + C_RQ + h * 64 + dh + i] = f2bf(siluf_(gte) * y); }
    }
    __syncthreads();
}
struct E_merge { const bf16_t* stash; bf16_t* MMp; long long first;
    __device__ void operator()(int, int m, int n, float v) const { const size_t i = (size_t)m * DM + n; const float t = sigmoidf_(v) * bf2f(stash[i]); MMp[i] = f2bf(first ? t : bf2f(MMp[i]) + t); } };
struct E_resid { const float* xlat; const float* xctx; float* olat; float* octx; const float* mod; long long gchunk;
    __device__ void operator()(int, int m, int n, float v) const {
        const float g = mod[(size_t)row_modidx(m) * 6144 + gchunk * 1024 + n];
        if (m < RL) olat[(size_t)m * DM + n] = xlat[(size_t)m * DM + n] + g * v; else octx[(size_t)(m - RL) * DM + n] = xctx[(size_t)(m - RL) * DM + n] + g * v; } };
struct E_relu2 { bf16_t* H; __device__ void operator()(int, int m, int n, float v) const { const float r = fmaxf(v, 0.f); H[(size_t)m * DFF + n] = f2bf(r * r); } };

namespace fa {
typedef float f32x16 __attribute__((ext_vector_type(16)));
typedef short s16x4 __attribute__((ext_vector_type(4)));
typedef unsigned u32x4 __attribute__((ext_vector_type(4)));
typedef unsigned u32x2 __attribute__((ext_vector_type(2)));
__device__ __forceinline__ s16x4 vtr(const LAS char* p) { return __builtin_bit_cast(s16x4, __builtin_amdgcn_ds_read_tr16_b64_v4i16((LAS s16x4*)p)); }
__device__ __forceinline__ unsigned pk2(float lo, float hi) { unsigned r; asm volatile("v_cvt_pk_bf16_f32 %0, %1, %2" : "=v"(r) : "v"(lo), "v"(hi)); return r; }
__device__ __forceinline__ bf16x8 pack_p(const f32x16& p, int base) { u32x4 w; w.x = pk2(p[base], p[base + 1]); w.y = pk2(p[base + 2], p[base + 3]); w.z = pk2(p[base + 4], p[base + 5]); w.w = pk2(p[base + 6], p[base + 7]); return __builtin_bit_cast(bf16x8, w); }
__device__ __forceinline__ int crow(int r, int hi) { return (r & 3) + 8 * (r >> 2) + 4 * hi; }
__device__ __forceinline__ void pv_tile(f32x16& o0, f32x16& o1, const LAS char* vb, const bf16x8 (&pf)[4]) {
#pragma unroll
    for (int ks = 0; ks < 4; ++ks) {
        const s16x4 a0 = vtr(vb + ks * 1024), a1 = vtr(vb + ks * 1024 + 512), b0 = vtr(vb + 4096 + ks * 1024), b1 = vtr(vb + 4096 + ks * 1024 + 512);
        const bf16x8 v0 = (bf16x8){a0[0], a0[1], a0[2], a0[3], a1[0], a1[1], a1[2], a1[3]}, v1 = (bf16x8){b0[0], b0[1], b0[2], b0[3], b1[0], b1[1], b1[2], b1[3]};
        o0 = __builtin_amdgcn_mfma_f32_32x32x16_bf16(v0, pf[ks], o0, 0, 0, 0);
        o1 = __builtin_amdgcn_mfma_f32_32x32x16_bf16(v1, pf[ks], o1, 0, 0, 0);
    }
}
constexpr int KP_A = 208, KT_A = 64 * KP_A, VT = 8192, BUF_A = KT_A + VT;
constexpr int KP_R = 144, KT_R = 64 * KP_R, BUF_R = KT_R + VT;
}

__device__ __forceinline__ void ph_s5_sloc(const bf16_t* Z, const bf16_t* MST, float* SLOC) { PH_IDS;
    const int lane = tid_ & 63, wid = __builtin_amdgcn_readfirstlane(tid_ >> 6), c16 = lane & 15, kq = lane >> 4;
    for (int u = bid_; u < 16 * 18; u += G_) {
        const int g = u / 18, rcbase = (u % 18) * 16;
        const bf16_t* up = Z + ((size_t)(rcbase + c16) * 64 + (kq >> 1)) * ZW + C_S5 + g * 16 + 8 * (kq & 1);
        const bf16_t* mp0 = MST + ((size_t)g * 256 + wid * 32 + c16) * 1024 + 8 * kq;
        f32x4 acc0 = (f32x4){0.f, 0.f, 0.f, 0.f}, acc1 = acc0;
#pragma unroll 8
        for (int ks = 0; ks < 32; ++ks) {
            const bf16x8 bfrag = *(const bf16x8*)(up + (size_t)(2 * ks) * ZW);
            const bf16x8 a0 = *(const bf16x8*)(mp0 + 32 * ks), a1 = *(const bf16x8*)(mp0 + 16 * 1024 + 32 * ks);
            acc0 = __builtin_amdgcn_mfma_f32_16x16x32_bf16(a0, bfrag, acc0, 0, 0, 0);
            acc1 = __builtin_amdgcn_mfma_f32_16x16x32_bf16(a1, bfrag, acc1, 0, 0, 0);
        }
        float* op = SLOC + ((size_t)(rcbase + c16) * 16 + g) * 256 + wid * 32 + 4 * kq;
        *(f32x4*)op = acc0; *(f32x4*)(op + 16) = acc1;
    }
}
__device__ __forceinline__ void ph_s5_out(unsigned char* lds_, const bf16_t* Z, const bf16_t* TZT, const bf16_t* QOT, const float* SLOC, const float* lamT, bf16_t* YG, int nrct) { PH_IDS;
    LAS char* sm = (LAS char*)lds_;
    constexpr int O_TZ = 0, O_XP = 65536, O_U = 73728, UP = 2064, O_SL = O_U + 16 * UP;
    const int lane = tid_ & 63, wid = __builtin_amdgcn_readfirstlane(tid_ >> 6), c16 = lane & 15, kq = lane >> 4;
    for (int u = bid_; u < 16 * nrct; u += G_) {
        const int g = u / nrct, rct = u % nrct, rcbase = rct * 16;
        const bool lat = rct < 16; const int b = rcbase >> 5, c0 = rcbase & 31;
        __syncthreads();
        for (int e = tid_; e < 65024 / 16; e += NT) *(LAS fa::u32x4*)(sm + O_TZ + e * 16) = *(const fa::u32x4*)((const char*)(TZT + (size_t)g * 127 * 256) + e * 16);
        for (int e = tid_; e < 16 * 128; e += NT) { const int rc = e >> 7, s = (e >> 1) & 63, hh = e & 1;
            *(LAS fa::u32x4*)(sm + O_U + rc * UP + s * 32 + hh * 16) = *(const fa::u32x4*)(Z + ((size_t)(rcbase + rc) * 64 + s) * ZW + C_S5 + g * 16 + hh * 8); }
        const int nsl = lat ? 36 : 16;
        for (int e = tid_; e < nsl * 64; e += NT) { const int r = e >> 6, q4 = e & 63; const int rc = lat ? (r < 4 ? 256 + b * 4 + r : b * 32 + (r - 4)) : rcbase + r;
            *(LAS f32x4*)(sm + O_SL + r * 1024 + q4 * 16) = *(const f32x4*)(SLOC + ((size_t)rc * 16 + g) * 256 + q4 * 4); }
        __syncthreads();
        if (tid_ < 128) {
            const int d = tid_ >> 6, p = tid_ & 63;
            const float lr = lamT[((size_t)(g * 2 + d) * 64 + p) * 2], li = lamT[((size_t)(g * 2 + d) * 64 + p) * 2 + 1];
            const LAS float* sl = (const LAS float*)(sm + O_SL) + d * 128 + p;
            LAS bf16_t* xp = (LAS bf16_t*)(sm + O_XP) + d * 128 + p;
            float xr = 0.f, xi = 0.f;
#define S5_STEP(r) do { const float sr = sl[(r) * 256], si = sl[(r) * 256 + 64]; const float nr = lr * xr - li * xi + sr, ni = lr * xi + li * xr + si; xr = nr; xi = ni; } while (0)
            if (lat) {
                if (d == 0) { for (int r = 0; r < 4 + c0; ++r) S5_STEP(r);
                    for (int r = 0; r < 16; ++r) { xp[r * 256] = f2bf(xr); xp[r * 256 + 64] = f2bf(xi); S5_STEP(4 + c0 + r); } }
                else { for (int r = 3; r >= 0; --r) S5_STEP(r);
                    for (int c = 31; c >= c0 + 16; --c) S5_STEP(4 + c);
                    for (int r = 15; r >= 0; --r) { xp[r * 256] = f2bf(xr); xp[r * 256 + 64] = f2bf(xi); S5_STEP(4 + c0 + r); } }
            } else {
                if (d == 0) { for (int r = 0; r < 16; ++r) { if ((r & 3) == 0) { xr = 0.f; xi = 0.f; } xp[r * 256] = f2bf(xr); xp[r * 256 + 64] = f2bf(xi); S5_STEP(r); } }
                else { for (int r = 15; r >= 0; --r) { if ((r & 3) == 3) { xr = 0.f; xi = 0.f; } xp[r * 256] = f2bf(xr); xp[r * 256 + 64] = f2bf(xi); S5_STEP(r); } }
            }
#undef S5_STEP
        }
        __syncthreads();
        const LAS char* ub = sm + O_U + c16 * UP + kq * 16;
        const LAS char* xb = sm + O_XP + c16 * 512 + kq * 16;
#pragma unroll 1
        for (int i = 0; i < 8; ++i) {
            const int t = wid * 8 + i;
            f32x4 acc = (f32x4){0.f, 0.f, 0.f, 0.f};
            const LAS char* tz = sm + O_TZ + ((t + 63 - (kq >> 1)) * 16 + c16) * 32 + (kq & 1) * 16;
#pragma unroll 8
            for (int ks = 0; ks < 32; ++ks) {
                const bf16x8 a = *(const LAS bf16x8*)(tz - ks * 1024), bq = *(const LAS bf16x8*)(ub + ks * 64);
                acc = __builtin_amdgcn_mfma_f32_16x16x32_bf16(a, bq, acc, 0, 0, 0);
            }
            const bf16_t* qo = QOT + ((size_t)g * 1024 + t * 16 + c16) * 256 + 8 * kq;
#pragma unroll
            for (int ks = 0; ks < 8; ++ks) {
                const bf16x8 a = *(const bf16x8*)(qo + 32 * ks), bq = *(const LAS bf16x8*)(xb + ks * 64);
                acc = __builtin_amdgcn_mfma_f32_16x16x32_bf16(a, bq, acc, 0, 0, 0);
            }
            fa::u32x2 w; w.x = fa::pk2(geluf_(acc[0]), geluf_(acc[1])); w.y = fa::pk2(geluf_(acc[2]), geluf_(acc[3]));
            *(fa::u32x2*)(YG + ((size_t)(rcbase + c16) * 64 + t) * ZW + C_S5 + g * 16 + 4 * kq) = w;
        }
    }
    __syncthreads();
}
__device__ __forceinline__ void rope16(float (&v)[4], int kq, float pos, bool on) {
#pragma unroll
    for (int r = 0; r < 4; ++r) {
        const int j = (4 * kq + r) & 7;
        const float ang = pos * exp2f(-(float)j * (13.287712379549449f / 8.f)), cs = __cosf(ang), sn = __sinf(ang);
        const float other = __shfl_xor(v[r], 32);
        const float rot = kq < 2 ? v[r] * cs - other * sn : other * sn + v[r] * cs;
        v[r] = on ? rot : v[r];
    }
}
__device__ __forceinline__ void ph_prep(bf16_t* Z, const bf16_t* WUQ, const bf16_t* WUKV, const bf16_t* D64, const float* qkq, const float* qkk,
                                        bf16_t* Q, bf16_t* Kb, bf16_t* Vb, bf16_t* F1lat, bf16_t* F1ctx) { PH_IDS;
    const int lane = tid_ & 63, wid = __builtin_amdgcn_readfirstlane(tid_ >> 6), c16 = lane & 15, kq = lane >> 4;
    for (int blk = bid_; blk < RT / 72; blk += G_) {
        const int row0 = blk * 72;
#pragma unroll 1
      for (int pass3 = 0; pass3 < 2; ++pass3) {
        int rowc[3]; bool valid[3];
#pragma unroll
        for (int tt = 0; tt < 3; ++tt) { const int o = 16 * (3 * pass3 + tt) + c16; valid[tt] = o < 72; rowc[tt] = row0 + (valid[tt] ? o : 71); }
        if (wid < 4) {
            const int h = wid;
            f32x4 acc[6][3]; float ssq[3];
#pragma unroll
            for (int tt = 0; tt < 3; ++tt) { ssq[tt] = 0.f;
#pragma unroll
                for (int nt = 0; nt < 6; ++nt) acc[nt][tt] = (f32x4){0.f, 0.f, 0.f, 0.f}; }
#pragma unroll 1
            for (int ks = 0; ks < 8; ++ks) {
                bf16x8 bq[3], aw[6];
#pragma unroll
                for (int tt = 0; tt < 3; ++tt) { bq[tt] = *(const bf16x8*)(Z + (size_t)rowc[tt] * ZW + C_QC + 32 * ks + 8 * kq);
#pragma unroll
                    for (int e = 0; e < 8; ++e) { const float f = bf2f((bf16_t)bq[tt][e]); ssq[tt] += f * f; } }
#pragma unroll
                for (int nt = 0; nt < 6; ++nt) aw[nt] = *(const bf16x8*)(WUQ + (size_t)(h * 96 + 16 * nt + c16) * 256 + 32 * ks + 8 * kq);
#pragma unroll
                for (int nt = 0; nt < 6; ++nt)
#pragma unroll
                    for (int tt = 0; tt < 3; ++tt) acc[nt][tt] = __builtin_amdgcn_mfma_f32_16x16x32_bf16(aw[nt], bq[tt], acc[nt][tt], 0, 0, 0);
            }
#pragma unroll
            for (int tt = 0; tt < 3; ++tt) {
                float s1 = ssq[tt]; s1 += __shfl_xor(s1, 16); s1 += __shfl_xor(s1, 32);
                const float rstd = rsqrtf(s1 * (1.f / 256) + EPS);
                float ss = 0.f;
#pragma unroll
                for (int nt = 0; nt < 6; ++nt)
#pragma unroll
                    for (int r = 0; r < 4; ++r) ss += acc[nt][tt][r] * acc[nt][tt][r];
                ss += __shfl_xor(ss, 16); ss += __shfl_xor(ss, 32);
                const float fac = rstd * rsqrtf(rstd * rstd * ss * (1.f / 96) + EPS) * 0.14724727430627066f;
                const int row = rowc[tt]; const bool lat = row < RL; const int b = row_batch(row), t = lat ? (row & 2047) : ((row - RL) & 255), qi = lat ? t : 2048 + t;
                bf16_t* qo = Q + ((size_t)(b * 4 + h) * 2304 + qi) * 96 + 4 * kq;
#pragma unroll
                for (int nt = 0; nt < 6; ++nt) {
                    const f32x4 w = *(const f32x4*)(qkq + 16 * nt + 4 * kq);
                    float v[4];
#pragma unroll
                    for (int r = 0; r < 4; ++r) v[r] = acc[nt][tt][r] * fac * w[r];
                    if (nt >= 4) rope16(v, kq, nt == 4 ? (float)(t >> 6) : (float)(t & 63), lat);
                    fa::u32x2 o; o.x = fa::pk2(v[0], v[1]); o.y = fa::pk2(v[2], v[3]);
                    if (valid[tt]) *(fa::u32x2*)(qo + 16 * nt) = o;
                }
            }
        } else {
            const int h = wid - 4;
            float ssq[3], rstd[3];
#pragma unroll
            for (int tt = 0; tt < 3; ++tt) ssq[tt] = 0.f;
#pragma unroll 1
            for (int pass = 0; pass < 2; ++pass) {
                f32x4 acc[4][3];
#pragma unroll
                for (int tt = 0; tt < 3; ++tt)
#pragma unroll
                    for (int nt = 0; nt < 4; ++nt) acc[nt][tt] = (f32x4){0.f, 0.f, 0.f, 0.f};
#pragma unroll 1
                for (int ks = 0; ks < 4; ++ks) {
                    bf16x8 bq[3], aw[4];
#pragma unroll
                    for (int tt = 0; tt < 3; ++tt) { bq[tt] = *(const bf16x8*)(Z + (size_t)rowc[tt] * ZW + C_KVC + 32 * ks + 8 * kq);
                        if (pass == 0) {
#pragma unroll
                            for (int e = 0; e < 8; ++e) { const float f = bf2f((bf16_t)bq[tt][e]); ssq[tt] += f * f; } } }
#pragma unroll
                    for (int nt = 0; nt < 4; ++nt) aw[nt] = *(const bf16x8*)(WUKV + (size_t)(h * 128 + pass * 64 + 16 * nt + c16) * 128 + 32 * ks + 8 * kq);
#pragma unroll
                    for (int nt = 0; nt < 4; ++nt)
#pragma unroll
                        for (int tt = 0; tt < 3; ++tt) acc[nt][tt] = __builtin_amdgcn_mfma_f32_16x16x32_bf16(aw[nt], bq[tt], acc[nt][tt], 0, 0, 0);
                }
#pragma unroll
                for (int tt = 0; tt < 3; ++tt) {
                    const int row = rowc[tt]; const bool lat = row < RL; const int b = row_batch(row), t = lat ? (row & 2047) : ((row - RL) & 255), ki = lat ? 256 + t : t;
                    if (pass == 0) {
                        float s1 = ssq[tt]; s1 += __shfl_xor(s1, 16); s1 += __shfl_xor(s1, 32);
                        rstd[tt] = rsqrtf(s1 * (1.f / 128) + EPS);
                        float kr[2][4];
#pragma unroll
                        for (int e = 0; e < 2; ++e) { const fa::u32x2 w = *(const fa::u32x2*)(Z + (size_t)row * ZW + C_KR + 16 * e + 4 * kq);
                            kr[e][0] = __uint_as_float(w.x << 16); kr[e][1] = __uint_as_float(w.x & 0xffff0000u); kr[e][2] = __uint_as_float(w.y << 16); kr[e][3] = __uint_as_float(w.y & 0xffff0000u); }
                        float ss = 0.f;
#pragma unroll
                        for (int nt = 0; nt < 4; ++nt)
#pragma unroll
                            for (int r = 0; r < 4; ++r) { acc[nt][tt][r] *= rstd[tt]; ss += acc[nt][tt][r] * acc[nt][tt][r]; }
#pragma unroll
                        for (int e = 0; e < 2; ++e)
#pragma unroll
                            for (int r = 0; r < 4; ++r) ss += kr[e][r] * kr[e][r];
                        ss += __shfl_xor(ss, 16); ss += __shfl_xor(ss, 32);
                        const float fac = rsqrtf(ss * (1.f / 96) + EPS);
                        bf16_t* ko = Kb + ((size_t)(b * 4 + h) * 2304 + ki) * 96 + 4 * kq;
#pragma unroll
                        for (int nt = 0; nt < 6; ++nt) {
                            const f32x4 w = *(const f32x4*)(qkk + 16 * nt + 4 * kq);
                            float v[4];
#pragma unroll
                            for (int r = 0; r < 4; ++r) v[r] = (nt < 4 ? acc[nt < 4 ? nt : 0][tt][r] : kr[nt < 4 ? 0 : nt - 4][r]) * fac * w[r];
                            if (nt >= 4) rope16(v, kq, nt == 4 ? (float)(t >> 6) : (float)(t & 63), lat);
                            fa::u32x2 o; o.x = fa::pk2(v[0], v[1]); o.y = fa::pk2(v[2], v[3]);
                            if (valid[tt]) *(fa::u32x2*)(ko + 16 * nt) = o;
                        }
                    } else {
                        bf16_t* vo = Vb + ((size_t)(b * 4 + h) * 2304 + ki) * 64 + 4 * kq;
#pragma unroll
                        for (int nt = 0; nt < 4; ++nt) { fa::u32x2 o; o.x = fa::pk2(acc[nt][tt][0] * rstd[tt], acc[nt][tt][1] * rstd[tt]); o.y = fa::pk2(acc[nt][tt][2] * rstd[tt], acc[nt][tt][3] * rstd[tt]);
                            if (valid[tt]) *(fa::u32x2*)(vo + 16 * nt) = o; }
                    }
                }
            }
        }
        {
            const int g = wid >> 1, part = wid & 1;
            f32x4 acc[4][3];
#pragma unroll
            for (int tt = 0; tt < 3; ++tt)
#pragma unroll
                for (int nt = 0; nt < 4; ++nt) acc[nt][tt] = (f32x4){0.f, 0.f, 0.f, 0.f};
#pragma unroll
            for (int ks = 0; ks < 2; ++ks) {
                bf16x8 au[3], bd[4];
#pragma unroll
                for (int tt = 0; tt < 3; ++tt) au[tt] = *(const bf16x8*)(Z + (size_t)rowc[tt] * ZW + C_FU + g * 64 + 32 * ks + 8 * kq);
#pragma unroll
                for (int nt = 0; nt < 4; ++nt) bd[nt] = *(const bf16x8*)(D64 + (size_t)(part * 64 + 16 * nt + c16) * 64 + 32 * ks + 8 * kq);
#pragma unroll
                for (int nt = 0; nt < 4; ++nt)
#pragma unroll
                    for (int tt = 0; tt < 3; ++tt) acc[nt][tt] = __builtin_amdgcn_mfma_f32_16x16x32_bf16(au[tt], bd[nt], acc[nt][tt], 0, 0, 0);
            }
#pragma unroll
            for (int tt = 0; tt < 3; ++tt) {
                const int o4 = 16 * (3 * pass3 + tt) + 4 * kq; const int trow = row0 + o4;
                if (o4 < 72) {
                    const bool lat = trow < RL;
#pragma unroll
                    for (int nt = 0; nt < 4; ++nt) {
                        const int gm = g * 64 + 16 * nt + c16;
                        fa::u32x2 o; o.x = fa::pk2(acc[nt][tt][0], acc[nt][tt][1]); o.y = fa::pk2(acc[nt][tt][2], acc[nt][tt][3]);
                        if (lat) { const int b = trow >> 11, t0 = trow & 2047; *(fa::u32x2*)(F1lat + ((size_t)(b * 256 + gm) * 2 + part) * 2048 + t0) = o; }
                        else { const int rr = trow - RL, b = rr >> 8, t0 = rr & 255; *(fa::u32x2*)(F1ctx + ((size_t)(b * 256 + gm) * 2 + part) * 256 + t0) = o; }
                    }
                }
            }
        }
      }
#pragma unroll 1
        for (int it = tid_; it < 72 * 16; it += NT) {
            const int row = row0 + (it >> 4), h = (it >> 2) & 3, jg = it & 3;
            bf16_t* zq = Z + (size_t)row * ZW + C_RQ + h * 64 + 8 * jg; bf16_t* zk = Z + (size_t)row * ZW + C_RK + h * 64 + 8 * jg;
            const fa::u32x4 k1 = *(const fa::u32x4*)zk, k2 = *(const fa::u32x4*)(zk + 32);
            f32x4 ka, kb, kc, kd; unpack8(k1, ka, kb); unpack8(k2, kc, kd);
            if (row < RL) {
                const fa::u32x4 q1 = *(const fa::u32x4*)zq, q2 = *(const fa::u32x4*)(zq + 32);
                f32x4 qa, qb, qc, qd; unpack8(q1, qa, qb); unpack8(q2, qc, qd);
                const float tpos = (float)(row & 2047);
                float x1q[8] = {qa[0], qa[1], qa[2], qa[3], qb[0], qb[1], qb[2], qb[3]}, x2q[8] = {qc[0], qc[1], qc[2], qc[3], qd[0], qd[1], qd[2], qd[3]};
                float x1k[8] = {ka[0], ka[1], ka[2], ka[3], kb[0], kb[1], kb[2], kb[3]}, x2k[8] = {kc[0], kc[1], kc[2], kc[3], kd[0], kd[1], kd[2], kd[3]};
#pragma unroll
                for (int e = 0; e < 8; ++e) {
                    const float ang = tpos * exp2f(-(float)(8 * jg + e) * (13.287712379549449f / 32.f)), cs = cosf(ang), sn = sinf(ang);
                    const float a = x1q[e], c = x2q[e]; x1q[e] = a * cs - c * sn; x2q[e] = a * sn + c * cs;
                    const float a2 = x1k[e], c2 = x2k[e]; x1k[e] = (a2 * cs - c2 * sn) * 0.125f; x2k[e] = (a2 * sn + c2 * cs) * 0.125f;
                }
                *(fa::u32x4*)zq = pack8((f32x4){x1q[0], x1q[1], x1q[2], x1q[3]}, (f32x4){x1q[4], x1q[5], x1q[6], x1q[7]});
                *(fa::u32x4*)(zq + 32) = pack8((f32x4){x2q[0], x2q[1], x2q[2], x2q[3]}, (f32x4){x2q[4], x2q[5], x2q[6], x2q[7]});
                *(fa::u32x4*)zk = pack8((f32x4){x1k[0], x1k[1], x1k[2], x1k[3]}, (f32x4){x1k[4], x1k[5], x1k[6], x1k[7]});
                *(fa::u32x4*)(zk + 32) = pack8((f32x4){x2k[0], x2k[1], x2k[2], x2k[3]}, (f32x4){x2k[4], x2k[5], x2k[6], x2k[7]});
            } else {
                *(fa::u32x4*)zk = pack8(ka * 0.125f, kb * 0.125f); *(fa::u32x4*)(zk + 32) = pack8(kc * 0.125f, kd * 0.125f);
            }
        }
    }
}

__device__ __forceinline__ void ph_attn_mfma(unsigned char* lds_, const bf16_t* Q, const bf16_t* Kb, const bf16_t* Vb, bf16_t* Z, int with_ctx) { PH_IDS;
    using namespace fa;
    LAS char* sm = (LAS char*)lds_;
    const int lane = tid_ & 63, wid = __builtin_amdgcn_readfirstlane(tid_ >> 6), r32 = lane & 31, hi = lane >> 5;
    const int nunits = 256 + (with_ctx ? 32 : 0);
    const int vcu = (bid_ % 8) * (G_ / 8) + bid_ / 8;
    const int koff0 = (tid_ / 12) * KP_A + (tid_ % 12) * 16, koff1 = ((tid_ + 512) / 12) * KP_A + ((tid_ + 512) % 12) * 16;
    const int voff = KT_A + ((tid_ & 7) >> 2) * 4096 + (tid_ >> 3) * 64 + (tid_ & 3) * 16;
    const int vrd = KT_A + ((lane >> 4) & 1) * 32 + (lane & 3) * 8 + (4 * hi + ((lane & 15) >> 2)) * 64;
    for (int u = vcu; u < nunits; u += G_) {
        const bool lat = u < 256; const int bh = lat ? (u >> 3) : (u - 256), qb = lat ? (u & 7) : 8;
        const int ntile = lat ? 36 : 4;
        const char* Kg = (const char*)(Kb + (size_t)bh * 2304 * 96); const char* Vg = (const char*)(Vb + (size_t)bh * 2304 * 64);
        const bf16_t* Qg = Q + ((size_t)bh * 2304 + qb * 256 + wid * 32 + r32) * 96;
        bf16x8 qf[6];
#pragma unroll
        for (int st = 0; st < 6; ++st) qf[st] = *(const bf16x8*)(Qg + 16 * st + 8 * hi);
        f32x16 o0, o1;
#pragma unroll
        for (int r = 0; r < 16; ++r) { o0[r] = 0.f; o1[r] = 0.f; }
        float mrun = -1e30f, lsum = 0.f;
        u32x4 kr0, kr1, vr;
        kr0 = *(const u32x4*)(Kg + tid_ * 16); kr1 = tid_ < 256 ? *(const u32x4*)(Kg + (tid_ + 512) * 16) : (u32x4){0u, 0u, 0u, 0u}; vr = *(const u32x4*)(Vg + tid_ * 16);
        __syncthreads();
        *(LAS u32x4*)(sm + koff0) = kr0; if (tid_ < 256) *(LAS u32x4*)(sm + koff1) = kr1; *(LAS u32x4*)(sm + voff) = vr;
        __syncthreads();
        for (int t = 0; t < ntile; ++t) {
            const int buf = (t & 1) * BUF_A;
            if (t + 1 < ntile) { const char* kg = Kg + (size_t)(t + 1) * 12288; const char* vg = Vg + (size_t)(t + 1) * 8192;
                kr0 = *(const u32x4*)(kg + tid_ * 16); if (tid_ < 256) kr1 = *(const u32x4*)(kg + (tid_ + 512) * 16); vr = *(const u32x4*)(vg + tid_ * 16); }
            const LAS char* kb = sm + buf + r32 * KP_A + 16 * hi;
            f32x16 p0, p1;
#pragma unroll
            for (int r = 0; r < 16; ++r) { p0[r] = 0.f; p1[r] = 0.f; }
#pragma unroll
            for (int st = 0; st < 6; ++st) {
                const bf16x8 k0 = *(const LAS bf16x8*)(kb + 32 * st), k1 = *(const LAS bf16x8*)(kb + 32 * KP_A + 32 * st);
                p0 = __builtin_amdgcn_mfma_f32_32x32x16_bf16(k0, qf[st], p0, 0, 0, 0);
                p1 = __builtin_amdgcn_mfma_f32_32x32x16_bf16(k1, qf[st], p1, 0, 0, 0);
            }
            float tm = fmaxf(p0[0], p1[0]);
#pragma unroll
            for (int r = 1; r < 16; ++r) tm = fmaxf(tm, fmaxf(p0[r], p1[r]));
            tm = fmaxf(tm, __shfl_xor(tm, 32));
            const float mn = fmaxf(mrun, tm), alpha = __builtin_amdgcn_exp2f(mrun - mn); mrun = mn;
            float ps = 0.f;
#pragma unroll
            for (int r = 0; r < 16; ++r) { p0[r] = __builtin_amdgcn_exp2f(p0[r] - mn); p1[r] = __builtin_amdgcn_exp2f(p1[r] - mn); ps += p0[r] + p1[r]; }
            lsum = lsum * alpha + ps;
#pragma unroll
            for (int r = 0; r < 16; ++r) { o0[r] *= alpha; o1[r] *= alpha; }
            bf16x8 pf[4]; pf[0] = pack_p(p0, 0); pf[1] = pack_p(p0, 8); pf[2] = pack_p(p1, 0); pf[3] = pack_p(p1, 8);
            pv_tile(o0, o1, sm + buf + vrd, pf);
            if (t + 1 < ntile) { const int nb = ((t + 1) & 1) * BUF_A; *(LAS u32x4*)(sm + nb + koff0) = kr0; if (tid_ < 256) *(LAS u32x4*)(sm + nb + koff1) = kr1; *(LAS u32x4*)(sm + nb + voff) = vr; }
            __syncthreads();
        }
        lsum += __shfl_xor(lsum, 32);
        const float inv = 1.f / lsum;
        const int b = bh >> 2, h = bh & 3;
        const int row = (lat ? b * 2048 + qb * 256 : RL + b * 256) + wid * 32 + r32;
        bf16_t* op = Z + (size_t)row * ZW + C_QC + h * 64 + 4 * hi;
#pragma unroll
        for (int g = 0; g < 4; ++g) {
            u32x2 w0, w1; w0.x = pk2(o0[4 * g] * inv, o0[4 * g + 1] * inv); w0.y = pk2(o0[4 * g + 2] * inv, o0[4 * g + 3] * inv);
            w1.x = pk2(o1[4 * g] * inv, o1[4 * g + 1] * inv); w1.y = pk2(o1[4 * g + 2] * inv, o1[4 * g + 3] * inv);
            *(u32x2*)(op + 8 * g) = w0; *(u32x2*)(op + 32 + 8 * g) = w1;
        }
    }
    __syncthreads();
}

__device__ __forceinline__ void ph_ret_mfma(unsigned char* lds_, bf16_t* Z, const float* decay_logit, const float* gn_w, int with_ctx) { PH_IDS;
    using namespace fa;
    LAS char* sm = (LAS char*)lds_;
    const int lane = tid_ & 63, wid = __builtin_amdgcn_readfirstlane(tid_ >> 6), r32 = lane & 31, hi = lane >> 5;
    const int nunits = 256 + (with_ctx ? 32 : 0);
    const int vcu = (bid_ % 8) * (G_ / 8) + bid_ / 8;
    const int prow = tid_ >> 3, pc = tid_ & 7;
    const int koff = prow * KP_R + pc * 16;
    const int voff = KT_R + (pc >> 2) * 4096 + prow * 64 + (pc & 3) * 16;
    const int vrd = KT_R + ((lane >> 4) & 1) * 32 + (lane & 3) * 8 + (4 * hi + ((lane & 15) >> 2)) * 64;
    for (int u = vcu; u < nunits; u += G_) {
        const bool lat = u < 256; const int bh = lat ? (u >> 3) : (u - 256), qb = lat ? (u & 7) : 0, b = bh >> 2, h = bh & 3;
        const int ntile = lat ? 40 : 4;
        const float lgf = -log1pf(__expf(-decay_logit[h])) * 1.4426950408889634f, lgb = -log1pf(__expf(-decay_logit[4 + h])) * 1.4426950408889634f;
        const int qpos = qb * 256 + wid * 32 + r32;
        const int qrow = (lat ? b * 2048 : RL + b * 256) + qpos;
        bf16_t* zq = Z + (size_t)qrow * ZW;
        bf16x8 qf[4];
#pragma unroll
        for (int st = 0; st < 4; ++st) qf[st] = *(const bf16x8*)(zq + C_RQ + h * 64 + 16 * st + 8 * hi);
        f32x16 o0, o1;
#pragma unroll
        for (int r = 0; r < 16; ++r) { o0[r] = 0.f; o1[r] = 0.f; }
        const int ctx0 = RL + b * 256, lat0 = b * 2048;
#define RET_TILE_ROW(t) (lat ? ((t) < 4 ? ctx0 + 64 * (t) : ((t) < 36 ? lat0 + 64 * ((t) - 4) : ctx0 + 64 * ((t) - 36))) : ctx0 + 64 * (t))
#define RET_TILE_POS(t) (lat ? 64 * (t) - 256 : 64 * (t))
        u32x4 kr, vr;
        { const bf16_t* zr = Z + (size_t)(RET_TILE_ROW(0) + prow) * ZW + h * 64 + pc * 8; kr = *(const u32x4*)(zr + C_RK); vr = *(const u32x4*)(zr + C_RV); }
        __syncthreads();
        *(LAS u32x4*)(sm + koff) = kr; *(LAS u32x4*)(sm + voff) = vr;
        __syncthreads();
        for (int t = 0; t < ntile; ++t) {
            const int buf = (t & 1) * BUF_R;
            if (t + 1 < ntile) { const bf16_t* zr = Z + (size_t)(RET_TILE_ROW(t + 1) + prow) * ZW + h * 64 + pc * 8; kr = *(const u32x4*)(zr + C_RK); vr = *(const u32x4*)(zr + C_RV); }
            const LAS char* kb = sm + buf + r32 * KP_R + 16 * hi;
            f32x16 p0, p1;
#pragma unroll
            for (int r = 0; r < 16; ++r) { p0[r] = 0.f; p1[r] = 0.f; }
#pragma unroll
            for (int st = 0; st < 4; ++st) {
                const bf16x8 k0 = *(const LAS bf16x8*)(kb + 32 * st), k1 = *(const LAS bf16x8*)(kb + 32 * KP_R + 32 * st);
                p0 = __builtin_amdgcn_mfma_f32_32x32x16_bf16(k0, qf[st], p0, 0, 0, 0);
                p1 = __builtin_amdgcn_mfma_f32_32x32x16_bf16(k1, qf[st], p1, 0, 0, 0);
            }
            const int d0 = qpos - RET_TILE_POS(t) - 4 * hi;
#pragma unroll
            for (int r = 0; r < 16; ++r) {
                const int dp0 = d0 - ((r & 3) + 8 * (r >> 2)), dp1 = dp0 - 32;
                const float w0 = dp0 > 0 ? __builtin_amdgcn_exp2f(lgf * (float)dp0) : (dp0 < 0 ? __builtin_amdgcn_exp2f(-lgb * (float)dp0) : 2.f);
                const float w1 = dp1 > 0 ? __builtin_amdgcn_exp2f(lgf * (float)dp1) : (dp1 < 0 ? __builtin_amdgcn_exp2f(-lgb * (float)dp1) : 2.f);
                p0[r] *= w0; p1[r] *= w1;
            }
            bf16x8 pf[4]; pf[0] = pack_p(p0, 0); pf[1] = pack_p(p0, 8); pf[2] = pack_p(p1, 0); pf[3] = pack_p(p1, 8);
            pv_tile(o0, o1, sm + buf + vrd, pf);
            if (t + 1 < ntile) { const int nb = ((t + 1) & 1) * BUF_R; *(LAS u32x4*)(sm + nb + koff) = kr; *(LAS u32x4*)(sm + nb + voff) = vr; }
            __syncthreads();
        }
#undef RET_TILE_ROW
#undef RET_TILE_POS
        float s1 = 0.f;
#pragma unroll
        for (int r = 0; r < 16; ++r) s1 += o0[r] + o1[r];
        s1 += __shfl_xor(s1, 32);
        const float mu = s1 * (1.f / 64);
        float s2 = 0.f;
#pragma unroll
        for (int r = 0; r < 16; ++r) { const float a = o0[r] - mu, c = o1[r] - mu; s2 += a * a + c * c; }
        s2 += __shfl_xor(s2, 32);
        const float rstd = rsqrtf(s2 * (1.f / 64) + EPS);
#pragma unroll
        for (int g = 0; g < 4; ++g)
#pragma unroll
            for (int blk = 0; blk < 2; ++blk) {
                const int d = blk * 32 + 8 * g + 4 * hi;
                const u32x2 gt = *(const u32x2*)(zq + C_RG + h * 64 + d);
                const f32x4 gw = *(const f32x4*)(gn_w + h * 64 + d);
                float y[4];
#pragma unroll
                for (int q = 0; q < 4; ++q) { const float ov = blk ? o1[4 * g + q] : o0[4 * g + q]; const unsigned gb = q < 2 ? gt.x : gt.y; const float gv = __uint_as_float((q & 1) ? (gb & 0xffff0000u) : (gb << 16));
                    y[q] = siluf_(gv) * ((ov - mu) * rstd * gw[q]); }
                u32x2 w; w.x = pk2(y[0], y[1]); w.y = pk2(y[2], y[3]);
                *(u32x2*)(zq + C_RQ + h * 64 + d) = w;
            }
    }
    __syncthreads();
}

struct SchedGrid {
    const char* A; const char* B; unsigned lda, ldb; int nt, nM, nN, G, c, kind, aux;
    __device__ __forceinline__ bool next(int i, pg8::Unit& u) const {
        int pm, pn; if (!pg8::static_tile(nM, nN, G, c, i, pm, pn)) return false;
        u.A = A + (size_t)pm * 256 * lda; u.B = B + (size_t)pn * 256 * ldb; u.lda = lda; u.ldb = ldb; u.nt = nt; u.pm = pm; u.pn = pn; u.kind = kind; u.aux = aux; return true; }
};
struct SchedP1 {
    const char* A; const char* B; int G, c, last;
    __device__ __forceinline__ bool next(int i, pg8::Unit& u) const {
        int pm, pn;
        if (!last) { if (!pg8::static_tile(RT / 256, 8, G, c, i, pm, pn)) return false; }
        else { if (!pg8::static_tile(RL / 256, 8, G, c, i, pm, pn)) { const int j = i * G + c - (RL / 256) * 8; if (j < 0 || j >= 32) return false; pm = RL / 256 + (j >> 2); pn = j & 3; } }
        u.A = A + (size_t)pm * 256 * 2048; u.B = B + (size_t)pn * 256 * 2048; u.lda = 2048; u.ldb = 2048; u.nt = 16; u.pm = pm; u.pn = pn; u.kind = 0; u.aux = 0; return true; }
};
struct SchedMerge {
    const char* Z; const char* XN; const char* WBR; const char* WING; int njobs, G, vcu;
    __device__ __forceinline__ bool next(int i, pg8::Unit& u) const {
        const int job = (i >> 3) * G + vcu; if (job >= njobs) return false;
        const int sub = i & 7, n = sub >> 1, pm = job >> 2, pn = job & 3;
        u.pm = pm; u.pn = pn; u.aux = n;
        if (!(sub & 1)) { const int bcol = n == 0 ? C_QC : (n == 1 ? C_FU : (n == 2 ? C_OC : C_RQ));
            u.A = Z + ((size_t)pm * 256 * ZW + bcol) * 2; u.lda = ZW * 2; u.B = WBR + ((size_t)n * 1024 + pn * 256) * 512; u.ldb = 512; u.nt = 4; u.kind = 0; }
        else { u.A = XN + (size_t)pm * 256 * 2048; u.lda = 2048; u.B = WING + ((size_t)n * 1024 + pn * 256) * 2048; u.ldb = 2048; u.nt = 16; u.kind = 1; }
        return true; }
};
#define EPI_FOREACH(...) _Pragma("unroll") for (int ai = 0; ai < 2; ++ai) _Pragma("unroll") for (int m = 0; m < 4; ++m) _Pragma("unroll") for (int bj = 0; bj < 2; ++bj) { \
        const int row = u.pm * 256 + ai * 128 + wr * 64 + m * 16 + fr, col = u.pn * 256 + bj * 128 + wc * 32 + 8 * fq; const f32x4 v0 = acc[ai][bj][m][0], v1 = acc[ai][bj][m][1]; (void)row; (void)col; __VA_ARGS__ }
struct EpiStore {
    bf16_t* O; int ld; int act;
    __device__ __forceinline__ void operator()(const f32x4 (&acc)[2][2][4][2], const pg8::Unit& u, int wr, int wc, int fr, int fq) const {
        EPI_FOREACH( f32x4 a = v0, b = v1; if (act == 1) { _Pragma("unroll") for (int q = 0; q < 4; ++q) { const float ra = fmaxf(a[q], 0.f), rb = fmaxf(b[q], 0.f); a[q] = ra * ra; b[q] = rb * rb; } }
            *(pg8::u32x4*)(O + (size_t)row * ld + col) = pack8(a, b); )
    }
};
struct EpiResid {
    const float* xlat; const float* xctx; float* olat; float* octx; const float* mod; int gch;
    __device__ __forceinline__ void operator()(const f32x4 (&acc)[2][2][4][2], const pg8::Unit& u, int wr, int wc, int fr, int fq) const {
        const bool lat = u.pm < 64; const float* xb = lat ? xlat : xctx - (size_t)RL * DM; float* ob = lat ? olat : octx - (size_t)RL * DM;
        const float* g = mod + (size_t)(lat ? (u.pm >> 3) : 8) * 6144 + gch * 1024;
        EPI_FOREACH( const f32x4 g0 = *(const f32x4*)(g + col), g1 = *(const f32x4*)(g + col + 4); const size_t o = (size_t)row * DM + col;
            const f32x4 x0 = *(const f32x4*)(xb + o), x1 = *(const f32x4*)(xb + o + 4); *(f32x4*)(ob + o) = x0 + g0 * v0; *(f32x4*)(ob + o + 4) = x1 + g1 * v1; if (bj) asm volatile("" ::: "memory"); )
    }
};
struct EpiMerge {
    pg8::u32x4* stash; bf16_t* MMp;
    __device__ __forceinline__ void operator()(const f32x4 (&acc)[2][2][4][2], const pg8::Unit& u, int wr, int wc, int fr, int fq) const {
        int tid = threadIdx.x; asm volatile("" : "+v"(tid));
        if (u.kind == 0) { EPI_FOREACH( stash[((ai * 4 + m) * 2 + bj) * NT + tid] = pack8(v0, v1); if (bj) asm volatile("" ::: "memory"); ) }
        else { EPI_FOREACH( f32x4 y0, y1; unpack8(stash[((ai * 4 + m) * 2 + bj) * NT + tid], y0, y1); f32x4 t0, t1;
                _Pragma("unroll") for (int q = 0; q < 4; ++q) { t0[q] = sigmoidf_(v0[q]) * y0[q]; t1[q] = sigmoidf_(v1[q]) * y1[q]; }
                pg8::u32x4* mp = (pg8::u32x4*)(MMp + (size_t)row * DM + col);
                if (u.aux != 0) { f32x4 p0, p1; unpack8(*mp, p0, p1); t0 += p0; t1 += p1; }
                *mp = pack8(t0, t1); asm volatile("" ::: "memory"); ) }
    }
};
__device__ __forceinline__ void transpose_item(const float* W, int K, int N, bf16_t* WT, int row_off, LAS float* scr, int item, int lane, const float* kscale = nullptr) {
    const int nblk = N / 32, kb = item / nblk, nb = item % nblk, k0 = 64 * kb, n0 = 32 * nb;
#pragma unroll 8
    for (int i = 0; i < 32; ++i) { const int kk = 2 * i + (lane >> 5); float wv = W[(size_t)(k0 + kk) * N + n0 + (lane & 31)]; if (kscale) wv *= kscale[k0 + kk]; scr[kk * 33 + (lane & 31)] = wv; }
    asm volatile("s_waitcnt lgkmcnt(0)" ::: "memory");
    const int c = lane & 7;
#pragma unroll
    for (int j = 0; j < 4; ++j) { const int n = (lane >> 3) + 8 * j; const LAS float* sp = scr + (8 * c) * 33 + n;
        pg8::u32x4 o; o.x = pg8::cvt_pk_bf16(sp[0 * 33], sp[1 * 33]); o.y = pg8::cvt_pk_bf16(sp[2 * 33], sp[3 * 33]); o.z = pg8::cvt_pk_bf16(sp[4 * 33], sp[5 * 33]); o.w = pg8::cvt_pk_bf16(sp[6 * 33], sp[7 * 33]);
        *(pg8::u32x4*)(WT + (size_t)(row_off + n0 + n) * K + k0 + 8 * c) = o; }
    asm volatile("s_waitcnt lgkmcnt(0)" ::: "memory");
}
__device__ __forceinline__ void ph_convert_weights(unsigned char* lds, int l, const float* w_in, const float* w1, const float* w2, const float* w_out, const float* w_br, const float* w_glu,
                                                   const float* w_uq, const float* q_norm, const float* w_ukv, const float* kv_norm, unsigned char* ws) { PH_IDS;
    const int wave = __builtin_amdgcn_readfirstlane(tid_ >> 6), lane = tid_ & 63;
    LAS float* scr = (LAS float*)((LAS unsigned char*)lds + wave * 16384);
    const int gw = bid_ * 8 + wave, NGW = G_ * 8;
    constexpr int I_IN = 16 * 189, I_1 = 16 * 128, I_2 = 64 * 32, I_O = 16 * 32, I_B = 4 * 32;
    constexpr int I_G = 4 * 16;
    constexpr int I_UQ = 4 * 12, I_UKV = 2 * 16;
    constexpr int NITEMS = I_IN + I_1 + I_2 + I_O + 4 * I_B + I_G + I_UQ + I_UKV;
    bf16_t* WIN_T = (bf16_t*)(ws + WS_WIN); bf16_t* W1_T = (bf16_t*)(ws + WS_W1); bf16_t* W2_T = (bf16_t*)(ws + WS_W2); bf16_t* WOUT_T = (bf16_t*)(ws + WS_WOUT); bf16_t* WBR_T = (bf16_t*)(ws + WS_WBR);
    for (int it = gw; it < NITEMS; it += NGW) {
        int r = it;
        if (r < I_IN) { const int nb = r % 189; transpose_item(w_in + (size_t)l * DM * INC, DM, INC, WIN_T, nb >= 61 ? 96 : 0, scr, r, lane); continue; } r -= I_IN;
        if (r < I_1) { transpose_item(w1 + (size_t)l * DM * DFF, DM, DFF, W1_T, 0, scr, r, lane); continue; } r -= I_1;
        if (r < I_2) { transpose_item(w2 + (size_t)l * DFF * DM, DFF, DM, W2_T, 0, scr, r, lane); continue; } r -= I_2;
        if (r < I_O) { transpose_item(w_out + (size_t)l * DM * DM, DM, DM, WOUT_T, 0, scr, r, lane); continue; } r -= I_O;
        if (r < 4 * I_B) { const int n = r / I_B; transpose_item(w_br + ((size_t)l * 4 + n) * 256 * DM, 256, DM, WBR_T + (size_t)n * 1024 * 256, 0, scr, r % I_B, lane); continue; } r -= 4 * I_B;
        { const int n0 = (r % 16) * 32; const int off = n0 < 128 ? 0 : (n0 < 256 ? 128 : (n0 < 384 ? -128 : 0));
          if (r < I_G) { transpose_item(w_glu + (size_t)l * 256 * 512, 256, 512, (bf16_t*)(ws + WS_WGLU), off, scr, r, lane); continue; } }
        r -= I_G;
        if (r < I_UQ) { transpose_item(w_uq + (size_t)l * 256 * 384, 256, 384, (bf16_t*)(ws + WS_WUQ), 0, scr, r, lane, q_norm + l * 256); continue; } r -= I_UQ;
        transpose_item(w_ukv + (size_t)l * 128 * 512, 128, 512, (bf16_t*)(ws + WS_WUKV), 0, scr, r, lane, kv_norm + l * 128);
    }
    GSTRIDE(gi, 96 * 1024 / 8) { *(pg8::u32x4*)(WIN_T + (size_t)1952 * 1024 + (size_t)gi * 8) = (pg8::u32x4){0u, 0u, 0u, 0u}; }
    __syncthreads();
}

struct EpiFourier {
    bf16_t* Zp; int rowbase, L; float scale;
    __device__ __forceinline__ void operator()(const f32x4 (&acc)[2][2][4][2], const pg8::Unit& u, int wr, int wc, int fr, int fq) const {
        EPI_FOREACH( *(pg8::u32x4*)(Zp + ((size_t)rowbase + (size_t)u.pn * L + row) * ZW + C_FU + (col - u.pn * 256)) = pack8(v0 * scale, v1 * scale); )
    }
};
struct EpiGlu {
    bf16_t* Zp;
    __device__ __forceinline__ void operator()(const f32x4 (&acc)[2][2][4][2], const pg8::Unit& u, int wr, int wc, int fr, int fq) const {
#pragma unroll
        for (int ai = 0; ai < 2; ++ai)
#pragma unroll
            for (int m = 0; m < 4; ++m) {
                const int row = u.pm * 256 + ai * 128 + wr * 64 + m * 16 + fr, col = u.pn * 128 + wc * 32 + 8 * fq;
                f32x4 a, b;
#pragma unroll
                for (int q = 0; q < 4; ++q) { a[q] = acc[ai][0][m][0][q] * sigmoidf_(acc[ai][1][m][0][q]); b[q] = acc[ai][0][m][1][q] * sigmoidf_(acc[ai][1][m][1][q]); }
                *(pg8::u32x4*)(Zp + (size_t)row * ZW + C_OC + col) = pack8(a, b);
            }
    }
};
__device__ __forceinline__ void ph_dft_gen(const float* trig, bf16_t* DL, bf16_t* DC) { PH_IDS;
    GSTRIDE(gi, 2048 * 4096 / 8) {
        const int k = gi >> 9, kk0 = (gi & 511) * 8; pg8::u32x4 w; unsigned pr[4];
#pragma unroll
        for (int q = 0; q < 4; ++q) { float v[2];
#pragma unroll
            for (int e = 0; e < 2; ++e) { const int kk = kk0 + 2 * q + e, part = kk >> 11, t = kk & 2047, idx = (k * t) & 2047; v[e] = part ? -trig[2048 + idx] : trig[idx]; }
            pr[q] = pg8::cvt_pk_bf16(v[0], v[1]); }
        w.x = pr[0]; w.y = pr[1]; w.z = pr[2]; w.w = pr[3];
        *(pg8::u32x4*)(DL + (size_t)k * 4096 + kk0) = w;
    }
    GSTRIDE(gi, 256 * 512 / 8) {
        const int k = gi >> 6, kk0 = (gi & 63) * 8; pg8::u32x4 w; unsigned pr[4];
#pragma unroll
        for (int q = 0; q < 4; ++q) { float v[2];
#pragma unroll
            for (int e = 0; e < 2; ++e) { const int kk = kk0 + 2 * q + e, part = kk >> 8, t = kk & 255, idx = ((k * t) & 255) * 8; v[e] = part ? -trig[2048 + idx] : trig[idx]; }
            pr[q] = pg8::cvt_pk_bf16(v[0], v[1]); }
        w.x = pr[0]; w.y = pr[1]; w.z = pr[2]; w.w = pr[3];
        *(pg8::u32x4*)(DC + (size_t)k * 512 + kk0) = w;
    }
}

constexpr size_t WS_BAR = 7 * MiB;
constexpr int LDS_BYTES = 147456;
struct Args { const float* in[30]; float* out; unsigned char* ws; };
typedef const __attribute__((address_space(4))) Args* CArgs;
__device__ __forceinline__ CArgs kargs() { CArgs p = (CArgs)__builtin_amdgcn_kernarg_segment_ptr(); asm volatile("" : "+s"(p)); return p; }
#define IN(i) (kargs()->in[i])
#define WSB(T, off) ((T*)(kargs()->ws + (off)))
#define OUTP (kargs()->out)
enum { I_X = 0, I_C, I_CTX, I_CCTX, I_ADAW, I_ADAB, I_NMIX, I_NFFN, I_WIN, I_QNORM, I_WUQ, I_KVNORM, I_WUKV, I_QKQ, I_QKK, I_LRE, I_LIM, I_LSTEP, I_BRE, I_BIM, I_CRE, I_CIM, I_S5D, I_WGLU, I_RDEC, I_RGN, I_WBR, I_WOUT, I_W1, I_W2 };
#define GRID_BAR() do { bar.bar = WSB(unsigned, WS_BAR); { unsigned x_ = bar.x; asm volatile("" : "+s"(x_)); bar.x = x_; } xcd_barrier(bar); } while (0)
template <int L> __device__ __forceinline__ void layer_body(unsigned char* lds, XcdBarrier& bar) {
    constexpr int l = L;
    constexpr bool LASTL = (L == DEPTH - 1);
    constexpr int NMT = LASTL ? RL / 256 : RT / 256;
    constexpr int WCTX = LASTL ? 0 : 1;

#define MODL (WSB(float, WS_MOD) + (size_t)l * 9 * 6144)
#define XLAT (l == 0 ? IN(I_X) : (const float*)OUTP)
#define XCTX (l == 0 ? IN(I_CTX) : (const float*)WSB(float, WS_XC))
#define WINL (IN(I_WIN) + (size_t)l * DM * INC)
#define ZP WSB(bf16_t, WS_Z)
#define XNP WSB(bf16_t, WS_XN)
#define QP WSB(bf16_t, WS_QKV)
#define KP (WSB(bf16_t, WS_QKV) + (size_t)32 * 2304 * 96)
#define VP (WSB(bf16_t, WS_QKV) + (size_t)2 * 32 * 2304 * 96)
#define F1LAT WSB(bf16_t, WS_F1)
#define F1CTX (WSB(bf16_t, WS_F1) + (size_t)8 * 256 * 2 * 2048)
#define QRAWP WSB(bf16_t, WS_RAW)
#define KVRAWP (WSB(bf16_t, WS_RAW) + (size_t)RT * 384)
        ph_s5_lp(l, IN(I_LRE), IN(I_LIM), IN(I_LSTEP), IN(I_BRE), IN(I_BIM), WSB(double2, WS_LP), WSB(double2, WS_BB), WSB(float, WS_LAMT));
        ph_adarms(XLAT, XCTX, IN(I_NMIX) + l * DM, MODL, 0, 1, XNP, RT);
        ph_convert_weights(lds, l, IN(I_WIN), IN(I_W1), IN(I_W2), IN(I_WOUT), IN(I_WBR), IN(I_WGLU), IN(I_WUQ), IN(I_QNORM), IN(I_WUKV), IN(I_KVNORM), kargs()->ws);
        if (l == 0) ph_dft_gen(WSB(float, WS_TRIG), WSB(bf16_t, WS_DFTL), WSB(bf16_t, WS_DFTC));
        GRID_BAR();
        ph_s5_tz(l, WSB(double2, WS_LP), WSB(double2, WS_BB), IN(I_CRE), IN(I_CIM), IN(I_S5D), WSB(bf16_t, WS_TZ));
        ph_s5_ms(WSB(double2, WS_LP), WSB(double2, WS_BB), WSB(bf16_t, WS_MS));
        ph_s5_qo(l, WSB(double2, WS_LP), IN(I_CRE), IN(I_CIM), WSB(bf16_t, WS_QO));
        { SchedP1 S; S.A = (const char*)XNP; S.B = (const char*)WSB(bf16_t, WS_WIN); S.G = l_grid(); S.c = l_bid(); S.last = LASTL ? 1 : 0;
          EpiStore E; E.O = ZP; E.ld = ZW; E.act = 0; pg8::gemm_phase((LAS unsigned char*)lds, S, E); }
        GRID_BAR();
        ph_prep(ZP, WSB(bf16_t, WS_WUQ), WSB(bf16_t, WS_WUKV), WSB(bf16_t, WS_D64), IN(I_QKQ) + l * 96, IN(I_QKK) + l * 96, QP, KP, VP, F1LAT, F1CTX);
        ph_s5_sloc(ZP, WSB(bf16_t, WS_MS), WSB(float, WS_SLOC));
        GRID_BAR();
        { SchedGrid S; S.A = (const char*)WSB(bf16_t, WS_DFTL); S.B = (const char*)F1LAT; S.lda = 8192; S.ldb = 8192; S.nt = 64; S.nM = 8; S.nN = 8; S.G = l_grid(); S.c = l_bid(); S.kind = 0; S.aux = 0;
          EpiFourier E; E.Zp = ZP; E.rowbase = 0; E.L = 2048; E.scale = 0.0027621358640099515f; pg8::gemm_phase((LAS unsigned char*)lds, S, E); }
        if (!LASTL) { SchedGrid S; S.A = (const char*)WSB(bf16_t, WS_DFTC); S.B = (const char*)F1CTX; S.lda = 1024; S.ldb = 1024; S.nt = 8; S.nM = 1; S.nN = 8; S.G = l_grid(); S.c = l_bid(); S.kind = 0; S.aux = 0;
          EpiFourier E; E.Zp = ZP; E.rowbase = RL; E.L = 256; E.scale = 0.0078125f; pg8::gemm_phase((LAS unsigned char*)lds, S, E); }
        ph_ret_mfma(lds, ZP, IN(I_RDEC) + l * 8, IN(I_RGN) + l * 256, WCTX);
        ph_attn_mfma(lds, QP, KP, VP, ZP, WCTX);
        ph_s5_out(lds, ZP, WSB(bf16_t, WS_TZ), WSB(bf16_t, WS_QO), WSB(float, WS_SLOC), WSB(float, WS_LAMT), ZP, LASTL ? 16 : 18);
        GRID_BAR();
        { SchedGrid S; S.A = (const char*)(ZP + C_S5); S.B = (const char*)WSB(bf16_t, WS_WGLU); S.lda = ZW * 2; S.ldb = 512; S.nt = 4; S.nM = NMT; S.nN = 2; S.G = l_grid(); S.c = l_bid(); S.kind = 0; S.aux = 0;
          EpiGlu E; E.Zp = ZP; pg8::gemm_phase((LAS unsigned char*)lds, S, E); }
        GRID_BAR();
        { SchedMerge S; S.Z = (const char*)ZP; S.XN = (const char*)XNP; S.WBR = (const char*)WSB(bf16_t, WS_WBR); S.WING = (const char*)(WSB(bf16_t, WS_WIN) + (size_t)2048 * 1024);
          S.njobs = NMT * 4; S.G = l_grid(); { const int bx = l_bid(); S.vcu = (bx % 8) * (S.G / 8) + bx / 8; }
          EpiMerge E; E.stash = WSB(pg8::u32x4, WS_STASH) + (size_t)l_bid() * 8192; E.MMp = WSB(bf16_t, WS_MM); pg8::gemm_phase((LAS unsigned char*)lds, S, E); }
        GRID_BAR();
        { SchedGrid S; S.A = (const char*)WSB(bf16_t, WS_MM); S.B = (const char*)WSB(bf16_t, WS_WOUT); S.lda = 2048; S.ldb = 2048; S.nt = 16; S.nM = NMT; S.nN = 4; S.G = l_grid(); S.c = l_bid(); S.kind = 0; S.aux = 0;
          EpiResid E; E.xlat = XLAT; E.xctx = XCTX; E.olat = OUTP; E.octx = WSB(float, WS_XC); E.mod = MODL; E.gch = 2; pg8::gemm_phase((LAS unsigned char*)lds, S, E); }
        GRID_BAR();
        ph_adarms(OUTP, WSB(float, WS_XC), IN(I_NFFN) + l * DM, MODL, 3, 4, XNP, NMT * 256);
        GRID_BAR();
        { SchedGrid S; S.A = (const char*)XNP; S.B = (const char*)WSB(bf16_t, WS_W1); S.lda = 2048; S.ldb = 2048; S.nt = 16; S.nM = NMT; S.nN = 16; S.G = l_grid(); S.c = l_bid(); S.kind = 0; S.aux = 0;
          EpiStore E; E.O = WSB(bf16_t, WS_H); E.ld = DFF; E.act = 1; pg8::gemm_phase((LAS unsigned char*)lds, S, E); }
        GRID_BAR();
        { SchedGrid S; S.A = (const char*)WSB(bf16_t, WS_H); S.B = (const char*)WSB(bf16_t, WS_W2); S.lda = 8192; S.ldb = 8192; S.nt = 64; S.nM = NMT; S.nN = 4; S.G = l_grid(); S.c = l_bid(); S.kind = 0; S.aux = 0;
          EpiResid E; E.xlat = OUTP; E.xctx = WSB(float, WS_XC); E.olat = OUTP; E.octx = WSB(float, WS_XC); E.mod = MODL; E.gch = 5; pg8::gemm_phase((LAS unsigned char*)lds, S, E); }
        if (l + 1 < DEPTH) GRID_BAR();
}
__global__ void __launch_bounds__(NT, 2) mega(Args a_unused) {
    extern __shared__ __attribute__((aligned(16))) unsigned char lds[];
    volatile LAS unsigned* bst = (volatile LAS unsigned*)((LAS unsigned char*)lds + LDS_BYTES - 16);
    if (threadIdx.x < 4) bst[threadIdx.x] = 0u;
    __syncthreads();
    XcdBarrier bar = xcd_barrier_post(WSB(unsigned, WS_BAR), bst);

    ph_mod(lds, IN(I_C), IN(I_CCTX), IN(I_ADAW), IN(I_ADAB), WSB(float, WS_MOD));
    ph_trig(WSB(float, WS_TRIG), WSB(bf16_t, WS_D64));
    GRID_BAR();
    layer_body<0>(lds, bar);
    layer_body<1>(lds, bar);
}

extern "C" void kernel_launch(void* const* d_in, const int* in_sizes, int n_in, void* d_out, int out_size, void* d_ws, size_t ws_size, hipStream_t stream) {
    static int grid = 0;
    if (grid == 0) {
        if (n_in != 30 || ws_size < WS_END) { fprintf(stderr, "kernel_launch: unexpected n_in %d / ws_size %zu\n", n_in, ws_size); grid = -1; return; }
        int dev = 0, cus = 0, per_cu = 0;
        if (hipGetDevice(&dev) != hipSuccess || hipDeviceGetAttribute(&cus, hipDeviceAttributeMultiprocessorCount, dev) != hipSuccess) { grid = -1; return; }
        if (hipFuncSetAttribute((const void*)mega, hipFuncAttributeMaxDynamicSharedMemorySize, LDS_BYTES) != hipSuccess) { fprintf(stderr, "kernel_launch: hipFuncSetAttribute failed\n"); grid = -1; return; }
        if (hipOccupancyMaxActiveBlocksPerMultiprocessor(&per_cu, (const void*)mega, NT, LDS_BYTES) != hipSuccess || per_cu < 1) fprintf(stderr, "kernel_launch: occupancy query says %d\n", per_cu);
        (void)hipGetLastError();
        grid = cus;
    }
    if (grid < 0) return;
    (void)hipMemsetAsync((char*)d_ws + WS_BAR, 0, XCD_BAR_WORDS * 4, stream);
    Args a; memset((void*)&a, 0, sizeof(a));
    for (int i = 0; i < 30; ++i) a.in[i] = (const float*)d_in[i];
    a.out = (float*)d_out; a.ws = (unsigned char*)d_ws;
    hipLaunchKernelGGL(mega, dim3(grid), dim3(NT), LDS_BYTES, stream, a);
}
```

```cpp
#include <hip/hip_runtime.h>
#include <cstdint>
#include <cstring>
#include <cstdio>

typedef unsigned short bf16_t;
typedef short bf16x8 __attribute__((ext_vector_type(8)));
typedef float f32x4 __attribute__((ext_vector_type(4)));

constexpr int DM = 1024, NB = 8, SEQ = 2048, CTX = 256, DEPTH = 2;
constexpr int RL = NB * SEQ;
constexpr int RC = NB * CTX;
constexpr int RT = RL + RC;
constexpr int INC = 6048;
constexpr int ZW = 2048;
constexpr int C_KVC = 0, C_KR = 128, C_S5 = 160, C_RK = 416, C_RV = 672, C_QC = 928, C_FU = 1184, C_RQ = 1440, C_RG = 1696, C_GATE = 1952;
constexpr int C_OC = C_RK;
constexpr int DFF = 4096;
constexpr int TCH = 64;
constexpr int NCH = RT / TCH;
constexpr float EPS = 1e-6f;
#define PI_D 3.14159265358979323846

__device__ __forceinline__ float bf2f(bf16_t v) { return __uint_as_float(((unsigned)v) << 16); }
__device__ __forceinline__ bf16_t f2bf(float f) { unsigned u = __float_as_uint(f); return (bf16_t)((u + 0x7fffu + ((u >> 16) & 1u)) >> 16); }
__device__ __forceinline__ float sigmoidf_(float x) { return 1.f / (1.f + __expf(-x)); }
__device__ __forceinline__ float siluf_(float x) { return x * sigmoidf_(x); }
__device__ __forceinline__ float geluf_(float x) { return 0.5f * x * (1.f + tanhf(0.7978845608028654f * (x + 0.044715f * x * x * x))); }
__device__ __forceinline__ int row_batch(int row) { return row < RL ? (row >> 11) : ((row - RL) >> 8); }
__device__ __forceinline__ int row_modidx(int row) { return row < RL ? (row >> 11) : 8; }

constexpr size_t MiB = 1ull << 20;
constexpr size_t WS_MOD = 0;
constexpr size_t WS_RS = 1 * MiB;
constexpr size_t WS_TRIG = WS_RS + 256 * 1024;
constexpr size_t WS_LAMT = WS_TRIG + 32 * 1024;
constexpr size_t WS_LP = 2 * MiB;
constexpr size_t WS_BB = 5 * MiB;
constexpr size_t WS_W = 8 * MiB;
constexpr size_t WS_WIN = WS_W, WS_W1 = WS_W + 12 * MiB, WS_W2 = WS_W + 20 * MiB, WS_WOUT = WS_W + 28 * MiB, WS_WBR = WS_W + 30 * MiB;
constexpr size_t WS_XN = 40 * MiB;
constexpr size_t WS_RAW = WS_XN;
constexpr size_t WS_YG = WS_XN;
constexpr size_t WS_Z = 76 * MiB;
constexpr size_t WS_QKV = 148 * MiB;
constexpr size_t WS_F1 = 184 * MiB;
constexpr size_t WS_GL = WS_F1;
constexpr size_t WS_TZ = 202 * MiB;
constexpr size_t WS_MS = 204 * MiB;
constexpr size_t WS_QO = 212 * MiB;
constexpr size_t WS_SLOC = 220 * MiB;
constexpr size_t WS_XP = 225 * MiB;
constexpr size_t WS_XC = 230 * MiB;
constexpr size_t WS_MM = WS_QKV;
constexpr size_t WS_STASH = WS_F1;
constexpr size_t WS_H = WS_Z;
constexpr size_t WS_WUQ = 6 * MiB + 256 * 1024;
constexpr size_t WS_WUKV = 6 * MiB + 512 * 1024;
constexpr size_t WS_D64 = 6 * MiB + 768 * 1024;
constexpr size_t WS_WGLU = 6 * MiB;
constexpr size_t WS_DFTL = 238 * MiB;
constexpr size_t WS_DFTC = 254 * MiB;
constexpr size_t WS_END = 256 * MiB;


#define LAS __attribute__((address_space(3)))
#define NT 512
__device__ __forceinline__ int l_tid() { int t = threadIdx.x; asm volatile("" : "+v"(t)); return t; }
__device__ __forceinline__ int l_bid() { int b = blockIdx.x; asm volatile("" : "+s"(b)); return b; }
__device__ __forceinline__ int l_grid() { int g = gridDim.x; asm volatile("" : "+s"(g)); return g; }
#define PH_IDS const int tid_ = l_tid(), bid_ = l_bid(), G_ = l_grid(); (void)tid_; (void)bid_; (void)G_
template <class AF, class BF, class EF>
__device__ __forceinline__ void gemm_tile(const AF& A, const BF& B, const EF& E, bool valid, int b, int m0, int n0, int M, int N, int K, bf16_t (*sA)[40], bf16_t (*sB)[40], int ht) {
    f32x4 accm[2][2];
#pragma unroll
    for (int i = 0; i < 2; ++i)
#pragma unroll
        for (int j = 0; j < 2; ++j) accm[i][j] = (f32x4){0.f, 0.f, 0.f, 0.f};
    const int w = ht >> 6, lane = ht & 63, wm = (w >> 1) * 32, wn = (w & 1) * 32, fr = lane & 15, fq = lane >> 4;
    for (int k0 = 0; k0 < K; k0 += 32) {
        __syncthreads();
#pragma unroll
        for (int i = 0; i < 8; ++i) {
            const int e = ht + i * 256;
            { const int m = e >> 5, k = e & 31; float v = 0.f; if (valid && m0 + m < M && k0 + k < K) v = A(b, m0 + m, k0 + k); sA[m][k] = f2bf(v); }
            { const int k = e >> 6, n = e & 63; float v = 0.f; if (valid && n0 + n < N && k0 + k < K) v = B(b, k0 + k, n0 + n); sB[n][k] = f2bf(v); }
        }
        __syncthreads();
        bf16x8 af[2], bfr[2];
#pragma unroll
        for (int i = 0; i < 2; ++i) { af[i] = *(const bf16x8*)&sA[wm + i * 16 + fr][fq * 8]; bfr[i] = *(const bf16x8*)&sB[wn + i * 16 + fr][fq * 8]; }
#pragma unroll
        for (int i = 0; i < 2; ++i)
#pragma unroll
            for (int j = 0; j < 2; ++j) accm[i][j] = __builtin_amdgcn_mfma_f32_16x16x32_bf16(af[i], bfr[j], accm[i][j], 0, 0, 0);
    }
    if (valid) {
#pragma unroll
        for (int i = 0; i < 2; ++i)
#pragma unroll
            for (int j = 0; j < 2; ++j)
#pragma unroll
                for (int rr = 0; rr < 4; ++rr) {
                    const int m = m0 + wm + i * 16 + fq * 4 + rr, n = n0 + wn + j * 16 + fr;
                    if (m < M && n < N) E(b, m, n, accm[i][j][rr]);
                }
    }
}
template <class AF, class BF, class EF>
__device__ __forceinline__ void gemm_phase(unsigned char* lds, const AF& A, const BF& B, const EF& E, int nbatch, int M, int N, int K) {
    PH_IDS; const int tid = tid_, half = tid >> 8, ht = tid & 255;
    bf16_t (*sA)[40] = (bf16_t (*)[40])(lds + half * 10240);
    bf16_t (*sB)[40] = (bf16_t (*)[40])(lds + half * 10240 + 5120);
    const int tm = (M + 63) >> 6, tn = (N + 63) >> 6, total = nbatch * tm * tn;
    for (int it0 = bid_ * 2; it0 < total; it0 += G_ * 2) {
        const int it = it0 + half; const bool valid = it < total;
        const int itc = valid ? it : 0;
        const int b = itc / (tm * tn), r = itc % (tm * tn), m0 = (r / tn) * 64, n0 = (r % tn) * 64;
        gemm_tile(A, B, E, valid, b, m0, n0, M, N, K, sA, sB, ht);
    }
    __syncthreads();
}
template <class T> static T zeroed() { T t; memset((void*)&t, 0, sizeof(T)); return t; }

struct A_bf16 { const bf16_t* p; long long ld; long long coff;
    __device__ float operator()(int, int m, int k) const { return bf2f(p[(size_t)m * ld + coff + k]); } };
struct A_bf16_scaled { const bf16_t* p; long long ld; long long coff; const float* rs; long long rsi; const float* w;
    __device__ float operator()(int, int m, int k) const { return bf2f(p[(size_t)m * ld + coff + k]) * rs[(size_t)m * 2 + rsi] * w[k]; } };
struct B_f32 { const float* p; long long ld; long long coff;
    __device__ float operator()(int, int k, int n) const { return p[(size_t)k * ld + coff + n]; } };
struct E_bf16 { bf16_t* p; long long ld; long long coff;
    __device__ void operator()(int, int m, int n, float v) const { p[(size_t)m * ld + coff + n] = f2bf(v); } };

#define XB_TMO      128
#define XB_XCNT(j)  (256  + 64 * (j))
#define XB_XSUB(j)  (1280 + 64 * (j))
#define XB_XGEN(j)  (2304 + 64 * (j))
#define XB_TOP      3328
#define XB_TOPGEN   3392
#define XCD_BAR_WORDS 3456
#define XB_SPIN_CAP (1u << 18)
__device__ __forceinline__ unsigned xb_ld(unsigned* p)              { return __hip_atomic_load(p, __ATOMIC_RELAXED, __HIP_MEMORY_SCOPE_AGENT); }
__device__ __forceinline__ unsigned xb_add(unsigned* p, unsigned v) { return __hip_atomic_fetch_add(p, v, __ATOMIC_RELAXED, __HIP_MEMORY_SCOPE_AGENT); }
__device__ __forceinline__ unsigned xb_xcc_id() { return (unsigned)__builtin_amdgcn_s_getreg((3 << 11) | 20) & 0xFu; }
#define XB_SPIN(cond, bar) do { unsigned _sp = 0; while (cond) { __builtin_amdgcn_s_sleep(1); \
    if ((++_sp & 255u) == 0u) { if (xb_ld(&(bar)[XB_TMO])) break; if (_sp > XB_SPIN_CAP) { atomicAdd(&(bar)[XB_TMO], 1u); break; } } } } while (0)
struct XcdBarrier { unsigned* bar; unsigned x; volatile LAS unsigned* st; };
__device__ __forceinline__ XcdBarrier xcd_barrier_post(unsigned* bar, volatile LAS unsigned* st) {
    XcdBarrier b; b.bar = bar; b.x = xb_xcc_id(); b.st = st;
    if (threadIdx.x == 0) (void)xb_add(&bar[XB_XCNT(b.x)], 1u);
    return b;
}
__device__ __forceinline__ void xcd_barrier_complete(unsigned* bar, unsigned x, unsigned& nloc, unsigned& nx) {
    const unsigned G = gridDim.x * gridDim.y * gridDim.z;
    unsigned sum, cnt, mine, sp = 0u;
    for (;;) {
        sum = 0u; cnt = 0u; mine = 0u;
#pragma unroll
        for (unsigned j = 0; j < 16; ++j) { const unsigned c = xb_ld(&bar[XB_XCNT(j)]); sum += c; cnt += (c > 0u) ? 1u : 0u; mine = (j == x) ? c : mine; }
        if (sum == G) break;
        __builtin_amdgcn_s_sleep(1);
        if ((++sp & 255u) == 0u) { if (xb_ld(&bar[XB_TMO])) break; if (sp > XB_SPIN_CAP) { atomicAdd(&bar[XB_TMO], 1u); break; } }
    }
    nloc = mine > 0u ? mine : 1u; nx = cnt > 0u ? cnt : 1u;
}
__device__ __forceinline__ void xcd_barrier(const XcdBarrier& b) {
    asm volatile("s_waitcnt vmcnt(0)" ::: "memory");
    __syncthreads();
    if (threadIdx.x == 0) {
        unsigned* bar = b.bar;
        __builtin_amdgcn_s_waitcnt(0);
        unsigned nloc = b.st[0], nx = b.st[1];
        if (nloc == 0u) { xcd_barrier_complete(bar, b.x, nloc, nx); b.st[0] = nloc; b.st[1] = nx; }
        const unsigned old = xb_add(&bar[XB_XSUB(b.x)], 1u);
        const unsigned gen = old / nloc;
        if (old + 1u == (gen + 1u) * nloc) {
            __builtin_amdgcn_fence(__ATOMIC_RELEASE, "agent");
            asm volatile("s_waitcnt vmcnt(0)" ::: "memory");
            const unsigned og = xb_add(&bar[XB_TOP], 1u);
            const unsigned tg = og / nx;
            if (og + 1u == (tg + 1u) * nx) xb_add(&bar[XB_TOPGEN], 1u);
            else XB_SPIN(xb_ld(&bar[XB_TOPGEN]) == tg, bar);
            __builtin_amdgcn_fence(__ATOMIC_ACQUIRE, "agent");
            xb_add(&bar[XB_XGEN(b.x)], 1u);
            asm volatile("s_waitcnt vmcnt(0)" ::: "memory");
        } else {
            XB_SPIN(xb_ld(&bar[XB_XGEN(b.x)]) == gen, bar);
            __builtin_amdgcn_fence(__ATOMIC_ACQUIRE, "agent");
            asm volatile("s_waitcnt vmcnt(0)" ::: "memory");
        }
    }
    __syncthreads();
}

namespace pg8 {
typedef unsigned u32x4 __attribute__((ext_vector_type(4)));
constexpr int BM = 256, BK = 64, HALF = 128, HTB = HALF * BK * 2, STAGE_BYTES = 8 * HTB, NXCD = 8, WGM = 8;
__device__ __forceinline__ int lds_byte(int r, int c) { const int st = (r >> 4) * 2 + (c >> 5), rr = r & 15, cc = c & 31, ob = rr * 64 + cc * 2; return st * 1024 + (ob ^ (((ob >> 9) & 1) << 5)); }
__device__ __forceinline__ void stage_rc(int b, int& R, int& C) { const int st = b / 1024, sb = b % 1024, swz = sb ^ (((sb >> 9) & 1) << 5); R = (st >> 1) * 16 + swz / 64; C = (st & 1) * 32 + (swz % 64) / 2; }
__device__ __forceinline__ int perm32(int rho) { const int n = rho >> 4, i = rho & 15; return 8 * (i >> 2) + 4 * n + (i & 3); }
struct Unit { const char* A; const char* B; unsigned lda, ldb; int nt, pm, pn, kind, aux; };
__device__ __forceinline__ unsigned cvt_pk_bf16(float lo, float hi) { unsigned r; asm volatile("v_cvt_pk_bf16_f32 %0, %1, %2" : "=v"(r) : "v"(lo), "v"(hi)); return r; }
__device__ __forceinline__ bool static_tile(int nM, int nN, int G, int c, int i, int& pm, int& pn) {
    const int nwg = nM * nN; const long L = (long)i * G + c; if (L >= nwg) return false;
    int wgid = (int)L; { const int q = nwg / NXCD, r = nwg % NXCD, xcd = wgid % NXCD, off = wgid / NXCD; wgid = (xcd < r ? xcd * (q + 1) : r * (q + 1) + (xcd - r) * q) + off; }
    const int nig = WGM * nN, gid = wgid / nig, fm = gid * WGM, gsz = (nM - fm) < WGM ? (nM - fm) : WGM;
    pm = fm + ((wgid % nig) % gsz); pn = (wgid % nig) / gsz; return true;
}
template <class Epi, class Sched>
__device__ __forceinline__ void gemm_phase(LAS unsigned char* lds, const Sched& S, const Epi& E) {
    const int tid = l_tid(), wid = __builtin_amdgcn_readfirstlane(tid >> 6), lane = tid & 63, wr = wid >> 2, wc = wid & 3, fr = lane & 15, fq = lane >> 4;
    int sR[2], sRb[2], sC2[2];
#pragma unroll
    for (int i = 0; i < 2; ++i) { int R, C; stage_rc(tid * 16 + i * 8192, R, C); sR[i] = R; sRb[i] = (R & ~31) + perm32(R & 31); sC2[i] = C * 2; }
    const size_t kstep = (size_t)(BK * 2);
    const unsigned ldsw = (unsigned)wid * 1024u;
    const int aoff = lds_byte(wr * 64 + fr, fq * 8), boff = lds_byte(wc * 32 + fr, fq * 8);
#define PG8_SA(b, h) (((b) * 2 + (h)) * HTB)
#define PG8_SB(b, h) ((4 + (b) * 2 + (h)) * HTB)
#define PG8_STAGE_A(bufoff, gbase, ld) do { \
        __builtin_amdgcn_global_load_lds((const unsigned*)((const char*)(gbase) + (unsigned)(sR[0] * (ld) + sC2[0])), (LAS unsigned*)(lds + (bufoff) + ldsw), 16, 0, 0); \
        __builtin_amdgcn_global_load_lds((const unsigned*)((const char*)(gbase) + (unsigned)(sR[1] * (ld) + sC2[1])), (LAS unsigned*)(lds + (bufoff) + ldsw + 8192), 16, 0, 0); } while (0)
#define PG8_STAGE_B(bufoff, gbase, ld) do { \
        __builtin_amdgcn_global_load_lds((const unsigned*)((const char*)(gbase) + (unsigned)(sRb[0] * (ld) + sC2[0])), (LAS unsigned*)(lds + (bufoff) + ldsw), 16, 0, 0); \
        __builtin_amdgcn_global_load_lds((const unsigned*)((const char*)(gbase) + (unsigned)(sRb[1] * (ld) + sC2[1])), (LAS unsigned*)(lds + (bufoff) + ldsw + 8192), 16, 0, 0); } while (0)
#define PG8_LDA(dst, b, h) do { _Pragma("unroll") for (int m = 0; m < 4; ++m) _Pragma("unroll") for (int k = 0; k < 2; ++k) dst[m][k] = *(const LAS bf16x8*)(lds + PG8_SA(b, h) + aoff + m * 2048 + k * 1024); } while (0)
#define PG8_LDB(dst, b, h) do { _Pragma("unroll") for (int n = 0; n < 2; ++n) _Pragma("unroll") for (int k = 0; k < 2; ++k) dst[n][k] = *(const LAS bf16x8*)(lds + PG8_SB(b, h) + boff + n * 2048 + k * 1024); } while (0)
#define PG8_MMA(ai, bj, At, Bt) do { __builtin_amdgcn_s_setprio(1); _Pragma("unroll") for (int m = 0; m < 4; ++m) _Pragma("unroll") for (int n = 0; n < 2; ++n) _Pragma("unroll") for (int k = 0; k < 2; ++k) \
        acc[ai][bj][m][n] = __builtin_amdgcn_mfma_f32_16x16x32_bf16(Bt[n][k], At[m][k], acc[ai][bj][m][n], 0, 0, 0); __builtin_amdgcn_s_setprio(0); } while (0)
#define PG8_WAIT_V(n) asm volatile("s_waitcnt vmcnt(" #n ")" ::: "memory")
#define PG8_WAIT_L(n) asm volatile("s_waitcnt lgkmcnt(" #n ")" ::: "memory")
#define PG8_BAR __builtin_amdgcn_s_barrier()
#define PG8_SCHED __builtin_amdgcn_sched_barrier(0)
    Unit cur, nxt; int ui = 0;
    if (!S.next(0, cur)) return;
    f32x4 acc[2][2][4][2];
#pragma unroll
    for (int a = 0; a < 2; ++a)
#pragma unroll
        for (int b = 0; b < 2; ++b)
#pragma unroll
            for (int m = 0; m < 4; ++m)
#pragma unroll
                for (int n = 0; n < 2; ++n) acc[a][b][m][n] = (f32x4){0.f, 0.f, 0.f, 0.f};
    bf16x8 At[4][2], B0[2][2], B1[2][2];
    const char* cA = cur.A; const char* cB = cur.B;
    int clda = cur.lda, cldb = cur.ldb;
    PG8_STAGE_B(PG8_SB(0, 0), cB, cldb); PG8_STAGE_B(PG8_SB(0, 1), cB + (size_t)HALF * cldb, cldb); PG8_STAGE_A(PG8_SA(0, 0), cA, clda); PG8_STAGE_A(PG8_SA(0, 1), cA + (size_t)HALF * clda, clda);
    if (wr == 1) PG8_BAR;
    PG8_WAIT_V(2); PG8_BAR;
    PG8_STAGE_B(PG8_SB(1, 0), cB + kstep, cldb); PG8_STAGE_A(PG8_SA(1, 0), cA + kstep, clda); PG8_STAGE_B(PG8_SB(1, 1), cB + (size_t)HALF * cldb + kstep, cldb);
    PG8_WAIT_V(6); PG8_BAR;
    for (;;) {
        const bool has_next = S.next(ui + 1, nxt);
        const char* nA = has_next ? nxt.A : cA; const char* nB = has_next ? nxt.B : cB;
        const int nlda = has_next ? (int)nxt.lda : clda, nldb = has_next ? (int)nxt.ldb : cldb;
        const int nt = cur.nt;
        for (int t = 0; t < nt; t += 2) {
            const bool last = (t == nt - 2);
            const char* a1 = cA + (size_t)(t + 1) * kstep;
            const char* a2 = last ? nA : cA + (size_t)(t + 2) * kstep; const char* b2 = last ? nB : cB + (size_t)(t + 2) * kstep;
            const char* a3 = a2 + kstep; const char* b3 = b2 + kstep;
            const int lda2 = last ? nlda : clda, ldb2 = last ? nldb : cldb;
            PG8_LDB(B0, 0, 0); PG8_LDB(B1, 0, 1); PG8_SCHED; PG8_LDA(At, 0, 0); PG8_STAGE_A(PG8_SA(1, 1), a1 + (size_t)HALF * clda, clda);
            PG8_WAIT_V(8); PG8_WAIT_L(0); PG8_BAR; PG8_MMA(0, 0, At, B0); PG8_MMA(0, 1, At, B1); PG8_BAR; PG8_SCHED;
            PG8_LDA(At, 0, 1); PG8_STAGE_B(PG8_SB(0, 0), b2, ldb2); PG8_STAGE_B(PG8_SB(0, 1), b2 + (size_t)HALF * ldb2, ldb2); PG8_STAGE_A(PG8_SA(0, 0), a2, lda2);
            PG8_WAIT_V(8); PG8_WAIT_L(0); PG8_BAR; PG8_MMA(1, 0, At, B0); PG8_MMA(1, 1, At, B1); PG8_BAR; PG8_SCHED;
            PG8_LDB(B0, 1, 0); PG8_LDB(B1, 1, 1); PG8_SCHED; PG8_LDA(At, 1, 0); PG8_STAGE_A(PG8_SA(0, 1), a2 + (size_t)HALF * lda2, lda2);
            PG8_WAIT_V(8); PG8_WAIT_L(0); PG8_BAR; PG8_MMA(0, 0, At, B0); PG8_MMA(0, 1, At, B1); PG8_BAR; PG8_SCHED;
            PG8_LDA(At, 1, 1); PG8_STAGE_B(PG8_SB(1, 0), b3, ldb2); PG8_STAGE_B(PG8_SB(1, 1), b3 + (size_t)HALF * ldb2, ldb2); PG8_STAGE_A(PG8_SA(1, 0), a3, lda2);
            PG8_WAIT_V(8); PG8_WAIT_L(0); PG8_BAR; PG8_MMA(1, 0, At, B0); PG8_MMA(1, 1, At, B1); PG8_BAR; PG8_SCHED;
        }
        if (wr == 0) PG8_BAR;
        E(acc, cur, wr, wc, fr, fq);
        if (!has_next) break;
#pragma unroll
        for (int a = 0; a < 2; ++a)
#pragma unroll
            for (int b = 0; b < 2; ++b)
#pragma unroll
                for (int m = 0; m < 4; ++m)
#pragma unroll
                    for (int n = 0; n < 2; ++n) acc[a][b][m][n] = (f32x4){0.f, 0.f, 0.f, 0.f};
        cur = nxt; cA = nA; cB = nB; clda = nlda; cldb = nldb; ++ui;
        if (wr == 1) PG8_BAR;
    }
    PG8_WAIT_V(0);
    PG8_BAR;
#undef PG8_SA
#undef PG8_SB
#undef PG8_STAGE_A
#undef PG8_STAGE_B
#undef PG8_LDA
#undef PG8_LDB
#undef PG8_MMA
#undef PG8_WAIT_V
#undef PG8_WAIT_L
#undef PG8_BAR
#undef PG8_SCHED
}
}

__device__ __forceinline__ pg8::u32x4 pack8(const f32x4 a, const f32x4 b) { pg8::u32x4 w; w.x = pg8::cvt_pk_bf16(a[0], a[1]); w.y = pg8::cvt_pk_bf16(a[2], a[3]); w.z = pg8::cvt_pk_bf16(b[0], b[1]); w.w = pg8::cvt_pk_bf16(b[2], b[3]); return w; }
__device__ __forceinline__ void unpack8(const pg8::u32x4 w, f32x4& a, f32x4& b) {
    a[0] = __uint_as_float(w.x << 16); a[1] = __uint_as_float(w.x & 0xffff0000u); a[2] = __uint_as_float(w.y << 16); a[3] = __uint_as_float(w.y & 0xffff0000u);
    b[0] = __uint_as_float(w.z << 16); b[1] = __uint_as_float(w.z & 0xffff0000u); b[2] = __uint_as_float(w.w << 16); b[3] = __uint_as_float(w.w & 0xffff0000u); }
namespace fa {
typedef float f32x16 __attribute__((ext_vector_type(16)));
typedef short s16x4 __attribute__((ext_vector_type(4)));
typedef unsigned u32x4 __attribute__((ext_vector_type(4)));
typedef unsigned u32x2 __attribute__((ext_vector_type(2)));
__device__ __forceinline__ s16x4 vtr(const LAS char* p) { return __builtin_bit_cast(s16x4, __builtin_amdgcn_ds_read_tr16_b64_v4i16((LAS s16x4*)p)); }
__device__ __forceinline__ unsigned pk2(float lo, float hi) { unsigned r; asm volatile("v_cvt_pk_bf16_f32 %0, %1, %2" : "=v"(r) : "v"(lo), "v"(hi)); return r; }
__device__ __forceinline__ bf16x8 pack_p(const f32x16& p, int base) { u32x4 w; w.x = pk2(p[base], p[base + 1]); w.y = pk2(p[base + 2], p[base + 3]); w.z = pk2(p[base + 4], p[base + 5]); w.w = pk2(p[base + 6], p[base + 7]); return __builtin_bit_cast(bf16x8, w); }
__device__ __forceinline__ int crow(int r, int hi) { return (r & 3) + 8 * (r >> 2) + 4 * hi; }
__device__ __forceinline__ void pv_tile(f32x16& o0, f32x16& o1, const LAS char* vb, const bf16x8 (&pf)[4]) {
#pragma unroll
    for (int ks = 0; ks < 4; ++ks) {
        const s16x4 a0 = vtr(vb + ks * 1024), a1 = vtr(vb + ks * 1024 + 512), b0 = vtr(vb + 4096 + ks * 1024), b1 = vtr(vb + 4096 + ks * 1024 + 512);
        const bf16x8 v0 = (bf16x8){a0[0], a0[1], a0[2], a0[3], a1[0], a1[1], a1[2], a1[3]}, v1 = (bf16x8){b0[0], b0[1], b0[2], b0[3], b1[0], b1[1], b1[2], b1[3]};
        o0 = __builtin_amdgcn_mfma_f32_32x32x16_bf16(v0, pf[ks], o0, 0, 0, 0);
        o1 = __builtin_amdgcn_mfma_f32_32x32x16_bf16(v1, pf[ks], o1, 0, 0, 0);
    }
}
constexpr int KP_A = 208, KT_A = 64 * KP_A, VT = 8192, BUF_A = KT_A + VT;
constexpr int KP_R = 144, KT_R = 64 * KP_R, BUF_R = KT_R + VT;
}

#define GSTRIDE(gi, total) for (int gi = bid_ * NT + tid_; gi < (total); gi += G_ * NT)
__device__ __forceinline__ void ph_mod(unsigned char* lds, const float* c, const float* c_ctx, const float* ada_w, const float* ada_b, float* mod) { PH_IDS;
    float (*sl)[1024] = (float (*)[1024])lds;
    float* red = (float*)(lds + 9 * 1024 * 4);
    for (int e = tid_; e < 9 * 1024; e += NT) { const int j = e >> 10, k = e & 1023; const float v = j < 8 ? c[j * 1024 + k] : c_ctx[k]; sl[j][k] = siluf_(v); }
    __syncthreads();
    const int nn = tid_ & 63, ks = tid_ >> 6;
    for (int u = bid_; u < 2 * 96; u += G_) {
        const int l = u / 96, n = (u % 96) * 64 + nn;
        float acc[9];
#pragma unroll
        for (int j = 0; j < 9; ++j) acc[j] = 0.f;
        const float* w = ada_w + ((size_t)l * 1024 + ks * 128) * 6144 + n;
#pragma unroll 4
        for (int k = 0; k < 128; ++k) { const float wv = w[(size_t)k * 6144];
#pragma unroll
            for (int j = 0; j < 9; ++j) acc[j] += sl[j][ks * 128 + k] * wv; }
        __syncthreads();
#pragma unroll
        for (int j = 0; j < 9; ++j) red[(ks * 9 + j) * 64 + nn] = acc[j];
        __syncthreads();
        for (int e = tid_; e < 9 * 64; e += NT) { const int j = e >> 6, q = e & 63; float sum = 0.f;
#pragma unroll
            for (int r = 0; r < 8; ++r) sum += red[(r * 9 + j) * 64 + q];
            const int col = (u % 96) * 64 + q; mod[((size_t)l * 9 + j) * 6144 + col] = sum + ada_b[l * 6144 + col]; }
    }
    __syncthreads();
}
__device__ __forceinline__ void ph_trig(float* trig, bf16_t* d64) { PH_IDS; GSTRIDE(i, 2048) { const float xx = (float)i * (1.f / 1024.f); trig[i] = cospif(xx); trig[2048 + i] = sinpif(xx); }
    GSTRIDE(i, 128 * 64) { const int n = i >> 6, c = i & 63, m = n & 63; const float xx = (float)((m * c) & 63) * (1.f / 32.f); d64[i] = f2bf(n < 64 ? cospif(xx) : sinpif(xx)); } }
__device__ __forceinline__ double2 lam_pow(double re, double im, double dt, int k) {
    const double m = (double)__expf((float)(re * dt * k));
    double xx = im * dt * (double)k * 0.318309886183790671538;
    xx -= 2.0 * rint(xx * 0.5);
    const float xf = (float)xx;
    return make_double2(m * (double)cospif(xf), m * (double)sinpif(xf));
}
__device__ __forceinline__ void ph_s5_lp(int l, const float* lam_re, const float* lam_im, const float* log_step, const float* b_re, const float* b_im, float2* LP, float2* BB, float* lamT) { PH_IDS;
    GSTRIDE(it, 2 * 16 * 64 * 81) {
        const int i = it / 81, k = it % 81;
        const int d = i / 1024, g = (i / 64) % 16, p = i % 64;
        const size_t li = ((size_t)(l * 2 + d) * 16 + g) * 64 + p;
        const double re = lam_re[li], im = lam_im[li], dt = (double)expf(log_step[(l * 2 + d) * 16 + g]);
        if (k <= 64) {
            const double2 v = lam_pow(re, im, dt, k); LP[(size_t)i * 65 + k] = make_float2((float)v.x, (float)v.y);
            if (k == 64) { lamT[((size_t)(g * 2 + d) * 64 + p) * 2 + 0] = (float)v.x; lamT[((size_t)(g * 2 + d) * 64 + p) * 2 + 1] = (float)v.y; }
        } else {
            const int h = k - 65;
            const double2 l1 = lam_pow(re, im, dt, 1);
            const double nr = l1.x - 1.0, ni = l1.y, den = re * re + im * im;
            const double fr = (nr * re + ni * im) / den, fi = (ni * re - nr * im) / den;
            const double br = b_re[li * 16 + h], bi = b_im[li * 16 + h]; BB[(size_t)i * 16 + h] = make_float2((float)(fr * br - fi * bi), (float)(fr * bi + fi * br));
        }
    }
}
__device__ __forceinline__ void ph_s5_tz(unsigned char* lds_, int l, const float2* LP, const float2* BB, const float* c_re, const float* c_im, float* TZD) { PH_IDS;
    float2* sC = (float2*)lds_;
    float2* sL = sC + 16 * 64;
    float2* sB = sL + 64 * 65;
    for (int u = bid_; u < 32; u += G_) {
        const int g = u >> 1, d = u & 1;
        __syncthreads();
        for (int e = tid_; e < 16 * 64; e += NT) { const size_t ci = (((size_t)(l * 2 + d) * 16 + g) * 16) * 64 + e; sC[e] = make_float2(c_re[ci], c_im[ci]); }
        for (int e = tid_; e < 64 * 65; e += NT) sL[e] = LP[((size_t)d * 16 + g) * 64 * 65 + e];
        for (int e = tid_; e < 64 * 16; e += NT) sB[e] = BB[((size_t)d * 16 + g) * 64 * 16 + e];
        __syncthreads();
#pragma unroll 1
        for (int i = 0; i < 2; ++i) {
            const int r = tid_ + NT * i, tau = r >> 4, h = r & 15;
            float acc[16];
#pragma unroll
            for (int q = 0; q < 16; ++q) acc[q] = 0.f;
            for (int p = 0; p < 64; ++p) {
                const float2 c = sC[h * 64 + p], lp = sL[p * 65 + tau];
                const float er = c.x * lp.x - c.y * lp.y, ei = c.x * lp.y + c.y * lp.x;
#pragma unroll
                for (int q = 0; q < 16; ++q) { const float2 bb = sB[p * 16 + q]; acc[q] += er * bb.x - ei * bb.y; }
            }
            float* o = TZD + ((((size_t)d * 16 + g) * 64 + tau) * 16 + h) * 16;
#pragma unroll
            for (int q = 0; q < 4; ++q) *(f32x4*)(o + 4 * q) = (f32x4){acc[4 * q], acc[4 * q + 1], acc[4 * q + 2], acc[4 * q + 3]};
        }
    }
    __syncthreads();
}
__device__ __forceinline__ void ph_s5_ms(const float2* LP, const float2* BB, bf16_t* MST) { PH_IDS;
    GSTRIDE(i, 16 * 256 * 128) {
        const int g = i / (256 * 128), n = (i / 128) % 256, sh0 = (i % 128) * 8, d = n >> 7, p = n & 63, im = (n >> 6) & 1, s = sh0 >> 4, hp0 = sh0 & 15;
        const size_t gi = ((size_t)d * 16 + g) * 64 + p;
        const float2 lp = LP[gi * 65 + (d == 0 ? 63 - s : s)];
        float v[8];
#pragma unroll
        for (int q = 0; q < 8; ++q) { const float2 bb = BB[gi * 16 + hp0 + q]; v[q] = im ? lp.x * bb.y + lp.y * bb.x : lp.x * bb.x - lp.y * bb.y; }
        *(pg8::u32x4*)(MST + ((size_t)g * 256 + n) * 1024 + sh0) = pack8((f32x4){v[0], v[1], v[2], v[3]}, (f32x4){v[4], v[5], v[6], v[7]});
    }
}
__device__ __forceinline__ void ph_s5_qo(int l, const float2* LP, const float* c_re, const float* c_im, bf16_t* QOT) { PH_IDS;
    GSTRIDE(i, 16 * 1024 * 32) {
        const int g = i / (1024 * 32), th = (i / 32) % 1024, j0 = (i % 32) * 8, d = j0 >> 7, im = (j0 >> 6) & 1, p0 = j0 & 63, t = th >> 4, h = th & 15;
        const size_t ci = (((size_t)(l * 2 + d) * 16 + g) * 16 + h) * 64 + p0;
        const int e = d == 0 ? t + 1 : 64 - t;
        float v[8];
#pragma unroll
        for (int q = 0; q < 8; ++q) { const float cr = c_re[ci + q], cim = c_im[ci + q]; const float2 lp = LP[(((size_t)d * 16 + g) * 64 + p0 + q) * 65 + e]; v[q] = im ? -(cr * lp.y + cim * lp.x) : cr * lp.x - cim * lp.y; }
        *(pg8::u32x4*)(QOT + ((size_t)g * 1024 + th) * 256 + j0) = pack8((f32x4){v[0], v[1], v[2], v[3]}, (f32x4){v[4], v[5], v[6], v[7]});
    }
}
__device__ __forceinline__ void ph_adarms(const float* xlat, const float* xctx, const float* w, const float* mod, int sh_chunk, int sc_chunk, bf16_t* out, int nrows) { PH_IDS;
    const int wave = (bid_ * NT + tid_) >> 6, lane = tid_ & 63, nw = (G_ * NT) >> 6;
    for (int row = wave; row < nrows; row += nw) {
        const float* x = row < RL ? xlat + (size_t)row * DM : xctx + (size_t)(row - RL) * DM;
        f32x4 v[4]; float ss = 0.f;
#pragma unroll
        for (int j = 0; j < 4; ++j) { v[j] = *(const f32x4*)(x + j * 256 + lane * 4); ss += v[j][0] * v[j][0] + v[j][1] * v[j][1] + v[j][2] * v[j][2] + v[j][3] * v[j][3]; }
#pragma unroll
        for (int o = 1; o < 64; o <<= 1) ss += __shfl_xor(ss, o);
        const float rstd = rsqrtf(ss * (1.f / DM) + EPS);
        const float* mrow = mod + (size_t)row_modidx(row) * 6144;
#pragma unroll
        for (int j = 0; j < 4; ++j) { const int c0 = j * 256 + lane * 4;
            const f32x4 wv = *(const f32x4*)(w + c0), sc = *(const f32x4*)(mrow + sc_chunk * 1024 + c0), sh = *(const f32x4*)(mrow + sh_chunk * 1024 + c0);
            const f32x4 y = v[j] * rstd * wv * (sc + 1.f) + sh;
            fa::u32x2 o; o.x = fa::pk2(y[0], y[1]); o.y = fa::pk2(y[2], y[3]);
            *(fa::u32x2*)(out + (size_t)row * DM + c0) = o; }
    }
}
__device__ __forceinline__ void ph_mla_stats(const bf16_t* Z, float* rs) { PH_IDS;
    const int wave = (bid_ * NT + tid_) >> 6, lane = tid_ & 63, nw = (G_ * NT) >> 6;
    for (int row = wave; row < RT; row += nw) {
        const bf16_t* z = Z + (size_t)row * ZW; float sq = 0.f, sk = 0.f;
#pragma unroll
        for (int j = 0; j < 4; ++j) { const float v = bf2f(z[C_QC + j * 64 + lane]); sq += v * v; }
#pragma unroll
        for (int j = 0; j < 2; ++j) { const float v = bf2f(z[C_KVC + j * 64 + lane]); sk += v * v; }
#pragma unroll
        for (int o = 1; o < 64; o <<= 1) { sq += __shfl_xor(sq, o); sk += __shfl_xor(sk, o); }
        if (lane == 0) { rs[(size_t)row * 2] = rsqrtf(sq * (1.f / 256) + EPS); rs[(size_t)row * 2 + 1] = rsqrtf(sk * (1.f / 128) + EPS); }
    }
}
__device__ __forceinline__ void ph_mla_post(const bf16_t* Z, const bf16_t* qraw, const bf16_t* kvraw, const float* qkq, const float* qkk, bf16_t* Q, bf16_t* Kb, bf16_t* Vb) { PH_IDS;
    GSTRIDE(gi, RT * 8) {
        const int row = gi >> 3, h = (gi >> 1) & 3, isk = gi & 1;
        const bool lat = row < RL; const int b = row_batch(row), t = lat ? (row & 2047) : ((row - RL) & 255);
        const int qi = lat ? t : 2048 + t, ki = lat ? 256 + t : t;
        float v[96];
        float ss = 0.f;
        if (!isk) {
#pragma unroll
            for (int i = 0; i < 96; ++i) v[i] = bf2f(qraw[(size_t)row * 384 + h * 96 + i]);
        } else {
#pragma unroll
            for (int i = 0; i < 64; ++i) v[i] = bf2f(kvraw[(size_t)row * 512 + h * 128 + i]);
#pragma unroll
            for (int i = 0; i < 32; ++i) v[64 + i] = bf2f(Z[(size_t)row * ZW + C_KR + i]);
        }
#pragma unroll
        for (int i = 0; i < 96; ++i) ss += v[i] * v[i];
        const float rr = rsqrtf(ss * (1.f / 96) + EPS) * (isk ? 1.f : 0.14724727430627066f);
        const float* wv = isk ? qkk : qkq;
#pragma unroll
        for (int i = 0; i < 96; ++i) v[i] = v[i] * rr * wv[i];
        if (lat) {
            const float prow = (float)(t >> 6), pcol = (float)(t & 63);
#pragma unroll
            for (int part = 0; part < 2; ++part) { const float pos = part ? pcol : prow; const int base = 64 + part * 16;
#pragma unroll
                for (int j = 0; j < 8; ++j) { const float fr = exp2f(-(float)j * (13.287712379549449f / 8.f)), a = pos * fr, cs = __cosf(a), sn = __sinf(a);
                    const float x1 = v[base + j], x2 = v[base + 8 + j]; v[base + j] = x1 * cs - x2 * sn; v[base + 8 + j] = x1 * sn + x2 * cs; } }
        }
        bf16_t* o = isk ? Kb + ((size_t)(b * 4 + h) * 2304 + ki) * 96 : Q + ((size_t)(b * 4 + h) * 2304 + qi) * 96;
#pragma unroll
        for (int i = 0; i < 96; ++i) o[i] = f2bf(v[i]);
        if (isk) { bf16_t* vo = Vb + ((size_t)(b * 4 + h) * 2304 + ki) * 64; for (int i = 0; i < 64; ++i) vo[i] = kvraw[(size_t)row * 512 + h * 128 + 64 + i]; }
    }
}
__device__ __forceinline__ void ph_attn(unsigned char* lds, const bf16_t* Q, const bf16_t* Kb, const bf16_t* Vb, bf16_t* Z, int with_ctx) { PH_IDS;
    float (*sK)[96] = (float (*)[96])lds; float (*sV)[64] = (float (*)[64])(lds + 32 * 96 * 4);
    const int nunits = 32 * (8 + (with_ctx ? 1 : 0));
    const int qt = tid_ & 255, dh = (tid_ >> 8) * 32;
    for (int u = bid_; u < nunits; u += G_) {
        const int bh = u % 32, qb = u / 32;
        const bool lat = qb < 8;
        const int qi = qb * 256 + qt, nkeys = lat ? 2304 : 256;
        float q[96], o[32];
        const bf16_t* qp = Q + ((size_t)bh * 2304 + qi) * 96;
#pragma unroll
        for (int i = 0; i < 96; ++i) q[i] = bf2f(qp[i]) * 0.10206207261596577f;
#pragma unroll
        for (int i = 0; i < 32; ++i) o[i] = 0.f;
        float mx = -1e30f, l = 0.f;
        for (int k0 = 0; k0 < nkeys; k0 += 32) {
            __syncthreads();
            for (int e = tid_; e < 32 * 96; e += NT) sK[e / 96][e % 96] = bf2f(Kb[((size_t)bh * 2304 + k0) * 96 + e]);
            for (int e = tid_; e < 32 * 64; e += NT) sV[e / 64][e % 64] = bf2f(Vb[((size_t)bh * 2304 + k0) * 64 + e]);
            __syncthreads();
#pragma unroll 1
            for (int j = 0; j < 32; ++j) { float a = 0.f;
#pragma unroll
                for (int i = 0; i < 96; ++i) a += q[i] * sK[j][i];
                if (a > mx) { const float corr = __expf(mx - a); mx = a; l *= corr;
#pragma unroll
                    for (int i = 0; i < 32; ++i) o[i] *= corr; }
                const float p = __expf(a - mx); l += p;
#pragma unroll
                for (int i = 0; i < 32; ++i) o[i] += p * sV[j][dh + i]; }
        }
        const int b = bh >> 2, h = bh & 3;
        const int row = lat ? b * 2048 + qi : RL + b * 256 + (qi - 2048);
        const float inv = 1.f / l;
#pragma unroll
        for (int i = 0; i < 32; ++i) Z[(size_t)row * ZW + C_QC + h * 64 + dh + i] = f2bf(o[i] * inv);
    }
    __syncthreads();
}
__device__ __forceinline__ void ph_f1(const bf16_t* Z, const float* trig, bf16_t* F1lat, bf16_t* F1ctx) { PH_IDS;
    GSTRIDE(gi, RT * 256) {
        const int row = gi >> 8, gm = gi & 255, g = gm >> 6, m = gm & 63;
        float a = 0.f, bsum = 0.f;
        const bf16_t* u = Z + (size_t)row * ZW + C_FU + g * 64;
        for (int c = 0; c < 64; ++c) { const float v = bf2f(u[c]); const int idx = ((m * c) & 63) * 32; a += v * trig[idx]; bsum += v * trig[2048 + idx]; }
        if (row < RL) { const int b = row >> 11, t = row & 2047; bf16_t* o = F1lat + ((size_t)(b * 256 + gm) * 2) * 2048; o[t] = f2bf(a); o[2048 + t] = f2bf(bsum); }
        else { const int r = row - RL, b = r >> 8, t = r & 255; bf16_t* o = F1ctx + ((size_t)(b * 256 + gm) * 2) * 256; o[t] = f2bf(a); o[256 + t] = f2bf(bsum); }
    }
}
struct A_dft { const float* trig; long long L; long long mul;
    __device__ float operator()(int, int k, int kk) const { const int part = kk >= (int)L, t = part ? kk - (int)L : kk; const int idx = (int)(((long long)k * t) & (L - 1)) * (int)mul; return part ? -trig[2048 + idx] : trig[idx]; } };
struct B_f1t { const bf16_t* p; long long L;
    __device__ float operator()(int b, int kk, int n) const { return bf2f(p[((size_t)(b * 256 + n)) * 2 * L + kk]); } };
struct E_fourier { bf16_t* Z; long long rowbase; long long L; double scale;
    __device__ void operator()(int b, int m, int n, float v) const { Z[((size_t)rowbase + (size_t)b * L + m) * ZW + C_FU + n] = f2bf(v * (float)scale); } };

struct A_s5u { const bf16_t* Z;
    __device__ float operator()(int g, int rc, int k) const { return bf2f(Z[((size_t)rc * 64 + (k >> 4)) * ZW + C_S5 + g * 16 + (k & 15)]); } };
struct B_ms { const bf16_t* MS; __device__ float operator()(int g, int k, int n) const { return bf2f(MS[((size_t)g * 1024 + k) * 256 + n]); } };
struct E_sloc { float* S; __device__ void operator()(int g, int rc, int n, float v) const { S[((size_t)rc * 16 + g) * 256 + n] = v; } };
__device__ __forceinline__ void ph_s5_scan(const float* SLOC, const float* lamT, float* XP) { PH_IDS;
    GSTRIDE(i, 8 * 16 * 2 * 64) {
        const int b = i / 2048, g = (i / 128) % 16, d = (i / 64) % 2, p = i % 64;
        const float lr = lamT[((size_t)(g * 2 + d) * 64 + p) * 2], li = lamT[((size_t)(g * 2 + d) * 64 + p) * 2 + 1];
        float xr = 0.f, xi = 0.f;
        for (int step = 0; step < 36; ++step) {
            int rc;
            if (d == 0) rc = step < 4 ? 256 + b * 4 + step : b * 32 + (step - 4);
            else rc = step < 4 ? 256 + b * 4 + (3 - step) : b * 32 + (31 - (step - 4));
            const size_t o = ((size_t)rc * 16 + g) * 256 + d * 128;
            XP[o + p] = xr; XP[o + 64 + p] = xi;
            const float sr = SLOC[o + p], si = SLOC[o + 64 + p];
            const float nr = lr * xr - li * xi + sr, ni = lr * xi + li * xr + si; xr = nr; xi = ni;
        }
    }
}
struct A_s5out { const bf16_t* Z; const float* XP;
    __device__ float operator()(int g, int rc, int k) const { return k < 1024 ? bf2f(Z[((size_t)rc * 64 + (k >> 4)) * ZW + C_S5 + g * 16 + (k & 15)]) : XP[((size_t)rc * 16 + g) * 256 + (k - 1024)]; } };
struct B_s5out { const float* TZ; const bf16_t* QO;
    __device__ float operator()(int g, int k, int n) const { if (k < 1024) { const int s = k >> 4, hp = k & 15, t = n >> 4, h = n & 15; return TZ[(((size_t)g * 127 + (t - s + 63)) * 16 + hp) * 16 + h]; } return bf2f(QO[((size_t)g * 256 + (k - 1024)) * 1024 + n]); } };
struct E_s5out { bf16_t* YG; __device__ void operator()(int g, int rc, int n, float v) const { YG[((size_t)rc * 64 + (n >> 4)) * 256 + g * 16 + (n & 15)] = f2bf(geluf_(v)); } };
__device__ __forceinline__ void ph_glu(const bf16_t* GL, bf16_t* Z) { PH_IDS;
    GSTRIDE(gi, RT * 256) {
        const int row = gi >> 8, j = gi & 255;
        const float val = bf2f(GL[(size_t)row * 512 + j]), gate = bf2f(GL[(size_t)row * 512 + 256 + j]);
        Z[(size_t)row * ZW + C_S5 + j] = f2bf(val * sigmoidf_(gate));
    }
}
__device__ __forceinline__ void ph_ret_prep(bf16_t* Z) { PH_IDS;
    GSTRIDE(gi, RT * 4 * 32) {
        const int row = gi >> 7, h = (gi >> 5) & 3, j = gi & 31;
        bf16_t* z = Z + (size_t)row * ZW;
        if (row < RL) {
            const int t = row & 2047; const float fr = exp2f(-(float)j * (13.287712379549449f / 32.f)), a = (float)t * fr, cs = cosf(a), sn = sinf(a);
            { const float x1 = bf2f(z[C_RQ + h * 64 + j]), x2 = bf2f(z[C_RQ + h * 64 + 32 + j]); z[C_RQ + h * 64 + j] = f2bf(x1 * cs - x2 * sn); z[C_RQ + h * 64 + 32 + j] = f2bf(x1 * sn + x2 * cs); }
            { const float x1 = bf2f(z[C_RK + h * 64 + j]), x2 = bf2f(z[C_RK + h * 64 + 32 + j]); z[C_RK + h * 64 + j] = f2bf((x1 * cs - x2 * sn) * 0.125f); z[C_RK + h * 64 + 32 + j] = f2bf((x1 * sn + x2 * cs) * 0.125f); }
        } else {
            z[C_RK + h * 64 + j] = f2bf(bf2f(z[C_RK + h * 64 + j]) * 0.125f); z[C_RK + h * 64 + 32 + j] = f2bf(bf2f(z[C_RK + h * 64 + 32 + j]) * 0.125f);
        }
    }
}
__device__ __forceinline__ void ph_ret(unsigned char* lds, bf16_t* Z, const float* decay_logit, const float* gn_w, int with_ctx) { PH_IDS;
    float (*sK)[64] = (float (*)[64])lds; float (*sV)[64] = (float (*)[64])(lds + 32 * 64 * 4);
    float* sred = (float*)(lds + 2 * 32 * 64 * 4);
    const int nunits = 32 * (8 + (with_ctx ? 1 : 0));
    const int qt = tid_ & 255, hh = tid_ >> 8, dh = hh * 32;
    for (int u = bid_; u < nunits; u += G_) {
        const int bh = u % 32, qb = u / 32, b = bh >> 2, h = bh & 3;
        const bool lat = qb < 8;
        const int qpos = lat ? qb * 256 + qt : qt;
        const int qrow = lat ? b * 2048 + qpos : RL + b * 256 + qpos;
        const float lgf = -log1pf(__expf(-decay_logit[h])) * 1.4426950408889634f, lgb = -log1pf(__expf(-decay_logit[4 + h])) * 1.4426950408889634f;
        float q[64], o[32];
#pragma unroll
        for (int i = 0; i < 64; ++i) q[i] = bf2f(Z[(size_t)qrow * ZW + C_RQ + h * 64 + i]);
#pragma unroll
        for (int i = 0; i < 32; ++i) o[i] = 0.f;
        const int nkeys = lat ? 2560 : 256;
        for (int k0 = 0; k0 < nkeys; k0 += 32) {
            int krow0, kpos0;
            if (lat) { if (k0 < 256) { krow0 = RL + b * 256 + k0; kpos0 = k0 - 256; } else if (k0 < 2304) { krow0 = b * 2048 + (k0 - 256); kpos0 = k0 - 256; } else { krow0 = RL + b * 256 + (k0 - 2304); kpos0 = 2048 + (k0 - 2304); } }
            else { krow0 = RL + b * 256 + k0; kpos0 = k0; }
            __syncthreads();
            for (int e = tid_; e < 32 * 64; e += NT) { const int j = e >> 6, i = e & 63; sK[j][i] = bf2f(Z[(size_t)(krow0 + j) * ZW + C_RK + h * 64 + i]); sV[j][i] = bf2f(Z[(size_t)(krow0 + j) * ZW + C_RV + h * 64 + i]); }
            __syncthreads();
#pragma unroll 1
            for (int j = 0; j < 32; ++j) { float a = 0.f;
#pragma unroll
                for (int i = 0; i < 64; ++i) a += q[i] * sK[j][i];
                const int dpos = qpos - (kpos0 + j);
                const float dec = dpos > 0 ? exp2f(lgf * (float)dpos) : (dpos < 0 ? exp2f(lgb * (float)(-dpos)) : 2.f);
                a *= dec;
#pragma unroll
                for (int i = 0; i < 32; ++i) o[i] += a * sV[j][dh + i]; }
        }
        float s1 = 0.f;
#pragma unroll
        for (int i = 0; i < 32; ++i) s1 += o[i];
        __syncthreads();
        sred[hh * 256 + qt] = s1;
        __syncthreads();
        const float mu = (sred[qt] + sred[256 + qt]) * (1.f / 64);
        float s2 = 0.f;
#pragma unroll
        for (int i = 0; i < 32; ++i) { const float d = o[i] - mu; s2 += d * d; }
        __syncthreads();
        sred[hh * 256 + qt] = s2;
        __syncthreads();
        const float rstd = rsqrtf((sred[qt] + sred[256 + qt]) * (1.f / 64) + EPS);
#pragma unroll
        for (int i = 0; i < 32; ++i) { const float gte = bf2f(Z[(size_t)qrow * ZW + C_RG + h * 64 + dh + i]); const float y = (o[i] - mu) * rstd * gn_w[h * 64 + dh + i];
            Z[(size_t)qrow * ZW + C_RQ + h * 64 + dh + i] = f2bf(siluf_(gte) * y); }
    }
    __syncthreads();
}
struct E_merge { const bf16_t* stash; bf16_t* MMp; long long first;
    __device__ void operator()(int, int m, int n, float v) const { const size_t i = (size_t)m * DM + n; const float t = sigmoidf_(v) * bf2f(stash[i]); MMp[i] = f2bf(first ? t : bf2f(MMp[i]) + t); } };
struct E_resid { const float* xlat; const float* xctx; float* olat; float* octx; const float* mod; long long gchunk;
    __device__ void operator()(int, int m, int n, float v) const {
        const float g = mod[(size_t)row_modidx(m) * 6144 + gchunk * 1024 + n];
        if (m < RL) olat[(size_t)m * DM + n] = xlat[(size_t)m * DM + n] + g * v; else octx[(size_t)(m - RL) * DM + n] = xctx[(size_t)(m - RL) * DM + n] + g * v; } };
struct E_relu2 { bf16_t* H; __device__ void operator()(int, int m, int n, float v) const { const float r = fmaxf(v, 0.f); H[(size_t)m * DFF + n] = f2bf(r * r); } };


__device__ __forceinline__ void ph_s5_sloc(const bf16_t* Z, const bf16_t* MST, float* SLOC) { PH_IDS;
    const int lane = tid_ & 63, wid = __builtin_amdgcn_readfirstlane(tid_ >> 6), c16 = lane & 15, kq = lane >> 4;
    for (int u = bid_; u < 16 * 18; u += G_) {
        const int g = u / 18, rcbase = (u % 18) * 16;
        const bf16_t* up = Z + ((size_t)(rcbase + c16) * 64 + (kq >> 1)) * ZW + C_S5 + g * 16 + 8 * (kq & 1);
        const bf16_t* mp0 = MST + ((size_t)g * 256 + wid * 32 + c16) * 1024 + 8 * kq;
        f32x4 acc0 = (f32x4){0.f, 0.f, 0.f, 0.f}, acc1 = acc0;
#pragma unroll 8
        for (int ks = 0; ks < 32; ++ks) {
            const bf16x8 bfrag = *(const bf16x8*)(up + (size_t)(2 * ks) * ZW);
            const bf16x8 a0 = *(const bf16x8*)(mp0 + 32 * ks), a1 = *(const bf16x8*)(mp0 + 16 * 1024 + 32 * ks);
            acc0 = __builtin_amdgcn_mfma_f32_16x16x32_bf16(a0, bfrag, acc0, 0, 0, 0);
            acc1 = __builtin_amdgcn_mfma_f32_16x16x32_bf16(a1, bfrag, acc1, 0, 0, 0);
        }
        float* op = SLOC + ((size_t)(rcbase + c16) * 16 + g) * 256 + wid * 32 + 4 * kq;
        *(f32x4*)op = acc0; *(f32x4*)(op + 16) = acc1;
    }
}
__device__ __forceinline__ void ph_s5_out(unsigned char* lds_, const bf16_t* Z, const float* TZD, const float* s5d, const bf16_t* QOT, const float* SLOC, const float* lamT, bf16_t* YG, int nrct) { PH_IDS;
    LAS char* sm = (LAS char*)lds_;
    constexpr int O_TZ = 0, O_XP = 65536, O_U = 73728, UP = 2064, O_SL = O_U + 16 * UP;
    const int lane = tid_ & 63, wid = __builtin_amdgcn_readfirstlane(tid_ >> 6), c16 = lane & 15, kq = lane >> 4;
    for (int u = bid_; u < 16 * nrct; u += G_) {
        const int g = u / nrct, rct = u % nrct, rcbase = rct * 16;
        const bool lat = rct < 16; const int b = rcbase >> 5, c0 = rcbase & 31;
        __syncthreads();
        for (int e = tid_; e < 127 * 64; e += NT) { const int dd = e >> 6, h = (e >> 2) & 15, q4 = (e & 3) * 4;
            const float* tf = TZD + ((((size_t)0 * 16 + g) * 64 + (dd >= 63 ? dd - 63 : 0)) * 16 + h) * 16 + q4; const float* tb = TZD + ((((size_t)1 * 16 + g) * 64 + (dd <= 63 ? 63 - dd : 0)) * 16 + h) * 16 + q4;
            f32x4 v = (f32x4){0.f, 0.f, 0.f, 0.f};
            if (dd >= 63) v += *(const f32x4*)tf;
            if (dd <= 63) v += *(const f32x4*)tb;
            if (dd == 63 && (h >> 2) == (q4 >> 2)) v[h & 3] += s5d[g * 16 + h];
            fa::u32x2 w; w.x = fa::pk2(v[0], v[1]); w.y = fa::pk2(v[2], v[3]);
            *(LAS fa::u32x2*)(sm + O_TZ + (dd * 16 + h) * 32 + q4 * 2) = w; }
        for (int e = tid_; e < 16 * 128; e += NT) { const int rc = e >> 7, s = (e >> 1) & 63, hh = e & 1;
            *(LAS fa::u32x4*)(sm + O_U + rc * UP + s * 32 + hh * 16) = *(const fa::u32x4*)(Z + ((size_t)(rcbase + rc) * 64 + s) * ZW + C_S5 + g * 16 + hh * 8); }
        const int nsl = lat ? 36 : 16;
        for (int e = tid_; e < nsl * 64; e += NT) { const int r = e >> 6, q4 = e & 63; const int rc = lat ? (r < 4 ? 256 + b * 4 + r : b * 32 + (r - 4)) : rcbase + r;
            *(LAS f32x4*)(sm + O_SL + r * 1024 + q4 * 16) = *(const f32x4*)(SLOC + ((size_t)rc * 16 + g) * 256 + q4 * 4); }
        __syncthreads();
        if (tid_ < 128) {
            const int d = tid_ >> 6, p = tid_ & 63;
            const float lr = lamT[((size_t)(g * 2 + d) * 64 + p) * 2], li = lamT[((size_t)(g * 2 + d) * 64 + p) * 2 + 1];
            const LAS float* sl = (const LAS float*)(sm + O_SL) + d * 128 + p;
            LAS bf16_t* xp = (LAS bf16_t*)(sm + O_XP) + d * 128 + p;
            float xr = 0.f, xi = 0.f;
#define S5_STEP(r) do { const float sr = sl[(r) * 256], si = sl[(r) * 256 + 64]; const float nr = lr * xr - li * xi + sr, ni = lr * xi + li * xr + si; xr = nr; xi = ni; } while (0)
            if (lat) {
                if (d == 0) { for (int r = 0; r < 4 + c0; ++r) S5_STEP(r);
                    for (int r = 0; r < 16; ++r) { xp[r * 256] = f2bf(xr); xp[r * 256 + 64] = f2bf(xi); S5_STEP(4 + c0 + r); } }
                else { for (int r = 3; r >= 0; --r) S5_STEP(r);
                    for (int c = 31; c >= c0 + 16; --c) S5_STEP(4 + c);
                    for (int r = 15; r >= 0; --r) { xp[r * 256] = f2bf(xr); xp[r * 256 + 64] = f2bf(xi); S5_STEP(4 + c0 + r); } }
            } else {
                if (d == 0) { for (int r = 0; r < 16; ++r) { if ((r & 3) == 0) { xr = 0.f; xi = 0.f; } xp[r * 256] = f2bf(xr); xp[r * 256 + 64] = f2bf(xi); S5_STEP(r); } }
                else { for (int r = 15; r >= 0; --r) { if ((r & 3) == 3) { xr = 0.f; xi = 0.f; } xp[r * 256] = f2bf(xr); xp[r * 256 + 64] = f2bf(xi); S5_STEP(r); } }
            }
#undef S5_STEP
        }
        __syncthreads();
        const LAS char* ub = sm + O_U + c16 * UP + kq * 16;
        const LAS char* xb = sm + O_XP + c16 * 512 + kq * 16;
#pragma unroll 1
        for (int i = 0; i < 8; ++i) {
            const int t = wid * 8 + i;
            f32x4 acc = (f32x4){0.f, 0.f, 0.f, 0.f};
            const LAS char* tz = sm + O_TZ + ((t + 63 - (kq >> 1)) * 16 + c16) * 32 + (kq & 1) * 16;
#pragma unroll 8
            for (int ks = 0; ks < 32; ++ks) {
                const bf16x8 a = *(const LAS bf16x8*)(tz - ks * 1024), bq = *(const LAS bf16x8*)(ub + ks * 64);
                acc = __builtin_amdgcn_mfma_f32_16x16x32_bf16(a, bq, acc, 0, 0, 0);
            }
            const bf16_t* qo = QOT + ((size_t)g * 1024 + t * 16 + c16) * 256 + 8 * kq;
#pragma unroll
            for (int ks = 0; ks < 8; ++ks) {
                const bf16x8 a = *(const bf16x8*)(qo + 32 * ks), bq = *(const LAS bf16x8*)(xb + ks * 64);
                acc = __builtin_amdgcn_mfma_f32_16x16x32_bf16(a, bq, acc, 0, 0, 0);
            }
            fa::u32x2 w; w.x = fa::pk2(geluf_(acc[0]), geluf_(acc[1])); w.y = fa::pk2(geluf_(acc[2]), geluf_(acc[3]));
            *(fa::u32x2*)(YG + ((size_t)(rcbase + c16) * 64 + t) * ZW + C_S5 + g * 16 + 4 * kq) = w;
        }
    }
    __syncthreads();
}
__device__ __forceinline__ void rope16(float (&v)[4], int kq, float pos, bool on) {
#pragma unroll
    for (int r = 0; r < 4; ++r) {
        const int j = (4 * kq + r) & 7;
        const float ang = pos * exp2f(-(float)j * (13.287712379549449f / 8.f)), cs = __cosf(ang), sn = __sinf(ang);
        const float other = __shfl_xor(v[r], 32);
        const float rot = kq < 2 ? v[r] * cs - other * sn : other * sn + v[r] * cs;
        v[r] = on ? rot : v[r];
    }
}
__device__ __forceinline__ void ph_prep(bf16_t* Z, const bf16_t* WUQ, const bf16_t* WUKV, const bf16_t* D64, const float* qkq, const float* qkk,
                                        bf16_t* Q, bf16_t* Kb, bf16_t* Vb, bf16_t* F1lat, bf16_t* F1ctx) { PH_IDS;
    const int lane = tid_ & 63, wid = __builtin_amdgcn_readfirstlane(tid_ >> 6), c16 = lane & 15, kq = lane >> 4;
    for (int blk = bid_; blk < RT / 72; blk += G_) {
        const int row0 = blk * 72;
#pragma unroll 1
      for (int pass3 = 0; pass3 < 2; ++pass3) {
        int rowc[3]; bool valid[3];
#pragma unroll
        for (int tt = 0; tt < 3; ++tt) { const int o = 16 * (3 * pass3 + tt) + c16; valid[tt] = o < 72; rowc[tt] = row0 + (valid[tt] ? o : 71); }
        if (wid < 4) {
            const int h = wid;
            f32x4 acc[6][3]; float ssq[3];
#pragma unroll
            for (int tt = 0; tt < 3; ++tt) { ssq[tt] = 0.f;
#pragma unroll
                for (int nt = 0; nt < 6; ++nt) acc[nt][tt] = (f32x4){0.f, 0.f, 0.f, 0.f}; }
#pragma unroll 1
            for (int ks = 0; ks < 8; ++ks) {
                bf16x8 bq[3], aw[6];
#pragma unroll
                for (int tt = 0; tt < 3; ++tt) { bq[tt] = *(const bf16x8*)(Z + (size_t)rowc[tt] * ZW + C_QC + 32 * ks + 8 * kq);
#pragma unroll
                    for (int e = 0; e < 8; ++e) { const float f = bf2f((bf16_t)bq[tt][e]); ssq[tt] += f * f; } }
#pragma unroll
                for (int nt = 0; nt < 6; ++nt) aw[nt] = *(const bf16x8*)(WUQ + (size_t)(h * 96 + 16 * nt + c16) * 256 + 32 * ks + 8 * kq);
#pragma unroll
                for (int nt = 0; nt < 6; ++nt)
#pragma unroll
                    for (int tt = 0; tt < 3; ++tt) acc[nt][tt] = __builtin_amdgcn_mfma_f32_16x16x32_bf16(aw[nt], bq[tt], acc[nt][tt], 0, 0, 0);
            }
#pragma unroll
            for (int tt = 0; tt < 3; ++tt) {
                float s1 = ssq[tt]; s1 += __shfl_xor(s1, 16); s1 += __shfl_xor(s1, 32);
                const float rstd = rsqrtf(s1 * (1.f / 256) + EPS);
                float ss = 0.f;
#pragma unroll
                for (int nt = 0; nt < 6; ++nt)
#pragma unroll
                    for (int r = 0; r < 4; ++r) ss += acc[nt][tt][r] * acc[nt][tt][r];
                ss += __shfl_xor(ss, 16); ss += __shfl_xor(ss, 32);
                const float fac = rstd * rsqrtf(rstd * rstd * ss * (1.f / 96) + EPS) * 0.14724727430627066f;
                const int row = rowc[tt]; const bool lat = row < RL; const int b = row_batch(row), t = lat ? (row & 2047) : ((row - RL) & 255), qi = lat ? t : 2048 + t;
                bf16_t* qo = Q + ((size_t)(b * 4 + h) * 2304 + qi) * 96 + 4 * kq;
#pragma unroll
                for (int nt = 0; nt < 6; ++nt) {
                    const f32x4 w = *(const f32x4*)(qkq + 16 * nt + 4 * kq);
                    float v[4];
#pragma unroll
                    for (int r = 0; r < 4; ++r) v[r] = acc[nt][tt][r] * fac * w[r];
                    if (nt >= 4) rope16(v, kq, nt == 4 ? (float)(t >> 6) : (float)(t & 63), lat);
                    fa::u32x2 o; o.x = fa::pk2(v[0], v[1]); o.y = fa::pk2(v[2], v[3]);
                    if (valid[tt]) *(fa::u32x2*)(qo + 16 * nt) = o;
                }
            }
        } else {
            const int h = wid - 4;
            float ssq[3], rstd[3];
#pragma unroll
            for (int tt = 0; tt < 3; ++tt) ssq[tt] = 0.f;
#pragma unroll 1
            for (int pass = 0; pass < 2; ++pass) {
                f32x4 acc[4][3];
#pragma unroll
                for (int tt = 0; tt < 3; ++tt)
#pragma unroll
                    for (int nt = 0; nt < 4; ++nt) acc[nt][tt] = (f32x4){0.f, 0.f, 0.f, 0.f};
#pragma unroll 1
                for (int ks = 0; ks < 4; ++ks) {
                    bf16x8 bq[3], aw[4];
#pragma unroll
                    for (int tt = 0; tt < 3; ++tt) { bq[tt] = *(const bf16x8*)(Z + (size_t)rowc[tt] * ZW + C_KVC + 32 * ks + 8 * kq);
                        if (pass == 0) {
#pragma unroll
                            for (int e = 0; e < 8; ++e) { const float f = bf2f((bf16_t)bq[tt][e]); ssq[tt] += f * f; } } }
#pragma unroll
                    for (int nt = 0; nt < 4; ++nt) aw[nt] = *(const bf16x8*)(WUKV + (size_t)(h * 128 + pass * 64 + 16 * nt + c16) * 128 + 32 * ks + 8 * kq);
#pragma unroll
                    for (int nt = 0; nt < 4; ++nt)
#pragma unroll
                        for (int tt = 0; tt < 3; ++tt) acc[nt][tt] = __builtin_amdgcn_mfma_f32_16x16x32_bf16(aw[nt], bq[tt], acc[nt][tt], 0, 0, 0);
                }
#pragma unroll
                for (int tt = 0; tt < 3; ++tt) {
                    const int row = rowc[tt]; const bool lat = row < RL; const int b = row_batch(row), t = lat ? (row & 2047) : ((row - RL) & 255), ki = lat ? 256 + t : t;
                    if (pass == 0) {
                        float s1 = ssq[tt]; s1 += __shfl_xor(s1, 16); s1 += __shfl_xor(s1, 32);
                        rstd[tt] = rsqrtf(s1 * (1.f / 128) + EPS);
                        float kr[2][4];
#pragma unroll
                        for (int e = 0; e < 2; ++e) { const fa::u32x2 w = *(const fa::u32x2*)(Z + (size_t)row * ZW + C_KR + 16 * e + 4 * kq);
                            kr[e][0] = __uint_as_float(w.x << 16); kr[e][1] = __uint_as_float(w.x & 0xffff0000u); kr[e][2] = __uint_as_float(w.y << 16); kr[e][3] = __uint_as_float(w.y & 0xffff0000u); }
                        float ss = 0.f;
#pragma unroll
                        for (int nt = 0; nt < 4; ++nt)
#pragma unroll
                            for (int r = 0; r < 4; ++r) { acc[nt][tt][r] *= rstd[tt]; ss += acc[nt][tt][r] * acc[nt][tt][r]; }
#pragma unroll
                        for (int e = 0; e < 2; ++e)
#pragma unroll
                            for (int r = 0; r < 4; ++r) ss += kr[e][r] * kr[e][r];
                        ss += __shfl_xor(ss, 16); ss += __shfl_xor(ss, 32);
                        const float fac = rsqrtf(ss * (1.f / 96) + EPS);
                        bf16_t* ko = Kb + ((size_t)(b * 4 + h) * 2304 + ki) * 96 + 4 * kq;
#pragma unroll
                        for (int nt = 0; nt < 6; ++nt) {
                            const f32x4 w = *(const f32x4*)(qkk + 16 * nt + 4 * kq);
                            float v[4];
#pragma unroll
                            for (int r = 0; r < 4; ++r) v[r] = (nt < 4 ? acc[nt < 4 ? nt : 0][tt][r] : kr[nt < 4 ? 0 : nt - 4][r]) * fac * w[r];
                            if (nt >= 4) rope16(v, kq, nt == 4 ? (float)(t >> 6) : (float)(t & 63), lat);
                            fa::u32x2 o; o.x = fa::pk2(v[0], v[1]); o.y = fa::pk2(v[2], v[3]);
                            if (valid[tt]) *(fa::u32x2*)(ko + 16 * nt) = o;
                        }
                    } else {
                        bf16_t* vo = Vb + ((size_t)(b * 4 + h) * 2304 + ki) * 64 + 4 * kq;
#pragma unroll
                        for (int nt = 0; nt < 4; ++nt) { fa::u32x2 o; o.x = fa::pk2(acc[nt][tt][0] * rstd[tt], acc[nt][tt][1] * rstd[tt]); o.y = fa::pk2(acc[nt][tt][2] * rstd[tt], acc[nt][tt][3] * rstd[tt]);
                            if (valid[tt]) *(fa::u32x2*)(vo + 16 * nt) = o; }
                    }
                }
            }
        }
        {
            const int g = wid >> 1, part = wid & 1;
            f32x4 acc[4][3];
#pragma unroll
            for (int tt = 0; tt < 3; ++tt)
#pragma unroll
                for (int nt = 0; nt < 4; ++nt) acc[nt][tt] = (f32x4){0.f, 0.f, 0.f, 0.f};
#pragma unroll
            for (int ks = 0; ks < 2; ++ks) {
                bf16x8 au[3], bd[4];
#pragma unroll
                for (int tt = 0; tt < 3; ++tt) au[tt] = *(const bf16x8*)(Z + (size_t)rowc[tt] * ZW + C_FU + g * 64 + 32 * ks + 8 * kq);
#pragma unroll
                for (int nt = 0; nt < 4; ++nt) bd[nt] = *(const bf16x8*)(D64 + (size_t)(part * 64 + 16 * nt + c16) * 64 + 32 * ks + 8 * kq);
#pragma unroll
                for (int nt = 0; nt < 4; ++nt)
#pragma unroll
                    for (int tt = 0; tt < 3; ++tt) acc[nt][tt] = __builtin_amdgcn_mfma_f32_16x16x32_bf16(au[tt], bd[nt], acc[nt][tt], 0, 0, 0);
            }
#pragma unroll
            for (int tt = 0; tt < 3; ++tt) {
                const int o4 = 16 * (3 * pass3 + tt) + 4 * kq; const int trow = row0 + o4;
                if (o4 < 72) {
                    const bool lat = trow < RL;
#pragma unroll
                    for (int nt = 0; nt < 4; ++nt) {
                        const int gm = g * 64 + 16 * nt + c16;
                        fa::u32x2 o; o.x = fa::pk2(acc[nt][tt][0], acc[nt][tt][1]); o.y = fa::pk2(acc[nt][tt][2], acc[nt][tt][3]);
                        if (lat) { const int b = trow >> 11, t0 = trow & 2047; *(fa::u32x2*)(F1lat + ((size_t)(b * 256 + gm) * 2 + part) * 2048 + t0) = o; }
                        else { const int rr = trow - RL, b = rr >> 8, t0 = rr & 255; *(fa::u32x2*)(F1ctx + ((size_t)(b * 256 + gm) * 2 + part) * 256 + t0) = o; }
                    }
                }
            }
        }
      }
#pragma unroll 1
        for (int it = tid_; it < 72 * 16; it += NT) {
            const int row = row0 + (it >> 4), h = (it >> 2) & 3, jg = it & 3;
            bf16_t* zq = Z + (size_t)row * ZW + C_RQ + h * 64 + 8 * jg; bf16_t* zk = Z + (size_t)row * ZW + C_RK + h * 64 + 8 * jg;
            const fa::u32x4 k1 = *(const fa::u32x4*)zk, k2 = *(const fa::u32x4*)(zk + 32);
            f32x4 ka, kb, kc, kd; unpack8(k1, ka, kb); unpack8(k2, kc, kd);
            if (row < RL) {
                const fa::u32x4 q1 = *(const fa::u32x4*)zq, q2 = *(const fa::u32x4*)(zq + 32);
                f32x4 qa, qb, qc, qd; unpack8(q1, qa, qb); unpack8(q2, qc, qd);
                const float tpos = (float)(row & 2047);
                float x1q[8] = {qa[0], qa[1], qa[2], qa[3], qb[0], qb[1], qb[2], qb[3]}, x2q[8] = {qc[0], qc[1], qc[2], qc[3], qd[0], qd[1], qd[2], qd[3]};
                float x1k[8] = {ka[0], ka[1], ka[2], ka[3], kb[0], kb[1], kb[2], kb[3]}, x2k[8] = {kc[0], kc[1], kc[2], kc[3], kd[0], kd[1], kd[2], kd[3]};
#pragma unroll
                for (int e = 0; e < 8; ++e) {
                    const float ang = tpos * exp2f(-(float)(8 * jg + e) * (13.287712379549449f / 32.f)), cs = cosf(ang), sn = sinf(ang);
                    const float a = x1q[e], c = x2q[e]; x1q[e] = a * cs - c * sn; x2q[e] = a * sn + c * cs;
                    const float a2 = x1k[e], c2 = x2k[e]; x1k[e] = (a2 * cs - c2 * sn) * 0.125f; x2k[e] = (a2 * sn + c2 * cs) * 0.125f;
                }
                *(fa::u32x4*)zq = pack8((f32x4){x1q[0], x1q[1], x1q[2], x1q[3]}, (f32x4){x1q[4], x1q[5], x1q[6], x1q[7]});
                *(fa::u32x4*)(zq + 32) = pack8((f32x4){x2q[0], x2q[1], x2q[2], x2q[3]}, (f32x4){x2q[4], x2q[5], x2q[6], x2q[7]});
                *(fa::u32x4*)zk = pack8((f32x4){x1k[0], x1k[1], x1k[2], x1k[3]}, (f32x4){x1k[4], x1k[5], x1k[6], x1k[7]});
                *(fa::u32x4*)(zk + 32) = pack8((f32x4){x2k[0], x2k[1], x2k[2], x2k[3]}, (f32x4){x2k[4], x2k[5], x2k[6], x2k[7]});
            } else {
                *(fa::u32x4*)zk = pack8(ka * 0.125f, kb * 0.125f); *(fa::u32x4*)(zk + 32) = pack8(kc * 0.125f, kd * 0.125f);
            }
        }
    }
}

__device__ __forceinline__ void ph_attn_mfma(unsigned char* lds_, const bf16_t* Q, const bf16_t* Kb, const bf16_t* Vb, bf16_t* Z, int with_ctx) { PH_IDS;
    using namespace fa;
    LAS char* sm = (LAS char*)lds_;
    const int lane = tid_ & 63, wid = __builtin_amdgcn_readfirstlane(tid_ >> 6), r32 = lane & 31, hi = lane >> 5;
    const int nunits = 256 + (with_ctx ? 32 : 0);
    const int vcu = (bid_ % 8) * (G_ / 8) + bid_ / 8;
    const int koff0 = (tid_ / 12) * KP_A + (tid_ % 12) * 16, koff1 = ((tid_ + 512) / 12) * KP_A + ((tid_ + 512) % 12) * 16;
    const int voff = KT_A + ((tid_ & 7) >> 2) * 4096 + (tid_ >> 3) * 64 + (tid_ & 3) * 16;
    const int vrd = KT_A + ((lane >> 4) & 1) * 32 + (lane & 3) * 8 + (4 * hi + ((lane & 15) >> 2)) * 64;
    for (int u = vcu; u < nunits; u += G_) {
        const bool lat = u < 256; const int bh = lat ? (u >> 3) : (u - 256), qb = lat ? (u & 7) : 8;
        const int ntile = lat ? 36 : 4;
        const char* Kg = (const char*)(Kb + (size_t)bh * 2304 * 96); const char* Vg = (const char*)(Vb + (size_t)bh * 2304 * 64);
        const bf16_t* Qg = Q + ((size_t)bh * 2304 + qb * 256 + wid * 32 + r32) * 96;
        bf16x8 qf[6];
#pragma unroll
        for (int st = 0; st < 6; ++st) qf[st] = *(const bf16x8*)(Qg + 16 * st + 8 * hi);
        f32x16 o0, o1;
#pragma unroll
        for (int r = 0; r < 16; ++r) { o0[r] = 0.f; o1[r] = 0.f; }
        float mrun = -1e30f, lsum = 0.f;
        u32x4 kr0, kr1, vr;
        kr0 = *(const u32x4*)(Kg + tid_ * 16); kr1 = tid_ < 256 ? *(const u32x4*)(Kg + (tid_ + 512) * 16) : (u32x4){0u, 0u, 0u, 0u}; vr = *(const u32x4*)(Vg + tid_ * 16);
        __syncthreads();
        *(LAS u32x4*)(sm + koff0) = kr0; if (tid_ < 256) *(LAS u32x4*)(sm + koff1) = kr1; *(LAS u32x4*)(sm + voff) = vr;
        __syncthreads();
        for (int t = 0; t < ntile; ++t) {
            const int buf = (t & 1) * BUF_A;
            if (t + 1 < ntile) { const char* kg = Kg + (size_t)(t + 1) * 12288; const char* vg = Vg + (size_t)(t + 1) * 8192;
                kr0 = *(const u32x4*)(kg + tid_ * 16); if (tid_ < 256) kr1 = *(const u32x4*)(kg + (tid_ + 512) * 16); vr = *(const u32x4*)(vg + tid_ * 16); }
            const LAS char* kb = sm + buf + r32 * KP_A + 16 * hi;
            f32x16 p0, p1;
#pragma unroll
            for (int r = 0; r < 16; ++r) { p0[r] = 0.f; p1[r] = 0.f; }
#pragma unroll
            for (int st = 0; st < 6; ++st) {
                const bf16x8 k0 = *(const LAS bf16x8*)(kb + 32 * st), k1 = *(const LAS bf16x8*)(kb + 32 * KP_A + 32 * st);
                p0 = __builtin_amdgcn_mfma_f32_32x32x16_bf16(k0, qf[st], p0, 0, 0, 0);
                p1 = __builtin_amdgcn_mfma_f32_32x32x16_bf16(k1, qf[st], p1, 0, 0, 0);
            }
            float tm = fmaxf(p0[0], p1[0]);
#pragma unroll
            for (int r = 1; r < 16; ++r) tm = fmaxf(tm, fmaxf(p0[r], p1[r]));
            tm = fmaxf(tm, __shfl_xor(tm, 32));
            const float mn = fmaxf(mrun, tm), alpha = __builtin_amdgcn_exp2f(mrun - mn); mrun = mn;
            float ps = 0.f;
#pragma unroll
            for (int r = 0; r < 16; ++r) { p0[r] = __builtin_amdgcn_exp2f(p0[r] - mn); p1[r] = __builtin_amdgcn_exp2f(p1[r] - mn); ps += p0[r] + p1[r]; }
            lsum = lsum * alpha + ps;
#pragma unroll
            for (int r = 0; r < 16; ++r) { o0[r] *= alpha; o1[r] *= alpha; }
            bf16x8 pf[4]; pf[0] = pack_p(p0, 0); pf[1] = pack_p(p0, 8); pf[2] = pack_p(p1, 0); pf[3] = pack_p(p1, 8);
            pv_tile(o0, o1, sm + buf + vrd, pf);
            if (t + 1 < ntile) { const int nb = ((t + 1) & 1) * BUF_A; *(LAS u32x4*)(sm + nb + koff0) = kr0; if (tid_ < 256) *(LAS u32x4*)(sm + nb + koff1) = kr1; *(LAS u32x4*)(sm + nb + voff) = vr; }
            __syncthreads();
        }
        lsum += __shfl_xor(lsum, 32);
        const float inv = 1.f / lsum;
        const int b = bh >> 2, h = bh & 3;
        const int row = (lat ? b * 2048 + qb * 256 : RL + b * 256) + wid * 32 + r32;
        bf16_t* op = Z + (size_t)row * ZW + C_QC + h * 64 + 4 * hi;
#pragma unroll
        for (int g = 0; g < 4; ++g) {
            u32x2 w0, w1; w0.x = pk2(o0[4 * g] * inv, o0[4 * g + 1] * inv); w0.y = pk2(o0[4 * g + 2] * inv, o0[4 * g + 3] * inv);
            w1.x = pk2(o1[4 * g] * inv, o1[4 * g + 1] * inv); w1.y = pk2(o1[4 * g + 2] * inv, o1[4 * g + 3] * inv);
            *(u32x2*)(op + 8 * g) = w0; *(u32x2*)(op + 32 + 8 * g) = w1;
        }
    }
    __syncthreads();
}

__device__ __forceinline__ void ph_ret_mfma(unsigned char* lds_, bf16_t* Z, const float* decay_logit, const float* gn_w, int with_ctx) { PH_IDS;
    using namespace fa;
    LAS char* sm = (LAS char*)lds_;
    const int lane = tid_ & 63, wid = __builtin_amdgcn_readfirstlane(tid_ >> 6), r32 = lane & 31, hi = lane >> 5;
    const int nunits = 256 + (with_ctx ? 32 : 0);
    const int vcu = (bid_ % 8) * (G_ / 8) + bid_ / 8;
    const int prow = tid_ >> 3, pc = tid_ & 7;
    const int koff = prow * KP_R + pc * 16;
    const int voff = KT_R + (pc >> 2) * 4096 + prow * 64 + (pc & 3) * 16;
    const int vrd = KT_R + ((lane >> 4) & 1) * 32 + (lane & 3) * 8 + (4 * hi + ((lane & 15) >> 2)) * 64;
    for (int u = vcu; u < nunits; u += G_) {
        const bool lat = u < 256; const int bh = lat ? (u >> 3) : (u - 256), qb = lat ? (u & 7) : 0, b = bh >> 2, h = bh & 3;
        const int ntile = lat ? 40 : 4;
        const float lgf = -log1pf(__expf(-decay_logit[h])) * 1.4426950408889634f, lgb = -log1pf(__expf(-decay_logit[4 + h])) * 1.4426950408889634f;
        const int qpos = qb * 256 + wid * 32 + r32;
        const int qrow = (lat ? b * 2048 : RL + b * 256) + qpos;
        bf16_t* zq = Z + (size_t)qrow * ZW;
        bf16x8 qf[4];
#pragma unroll
        for (int st = 0; st < 4; ++st) qf[st] = *(const bf16x8*)(zq + C_RQ + h * 64 + 16 * st + 8 * hi);
        f32x16 o0, o1;
#pragma unroll
        for (int r = 0; r < 16; ++r) { o0[r] = 0.f; o1[r] = 0.f; }
        const int ctx0 = RL + b * 256, lat0 = b * 2048;
#define RET_TILE_ROW(t) (lat ? ((t) < 4 ? ctx0 + 64 * (t) : ((t) < 36 ? lat0 + 64 * ((t) - 4) : ctx0 + 64 * ((t) - 36))) : ctx0 + 64 * (t))
#define RET_TILE_POS(t) (lat ? 64 * (t) - 256 : 64 * (t))
        u32x4 kr, vr;
        { const bf16_t* zr = Z + (size_t)(RET_TILE_ROW(0) + prow) * ZW + h * 64 + pc * 8; kr = *(const u32x4*)(zr + C_RK); vr = *(const u32x4*)(zr + C_RV); }
        __syncthreads();
        *(LAS u32x4*)(sm + koff) = kr; *(LAS u32x4*)(sm + voff) = vr;
        __syncthreads();
        for (int t = 0; t < ntile; ++t) {
            const int buf = (t & 1) * BUF_R;
            if (t + 1 < ntile) { const bf16_t* zr = Z + (size_t)(RET_TILE_ROW(t + 1) + prow) * ZW + h * 64 + pc * 8; kr = *(const u32x4*)(zr + C_RK); vr = *(const u32x4*)(zr + C_RV); }
            const LAS char* kb = sm + buf + r32 * KP_R + 16 * hi;
            f32x16 p0, p1;
#pragma unroll
            for (int r = 0; r < 16; ++r) { p0[r] = 0.f; p1[r] = 0.f; }
#pragma unroll
            for (int st = 0; st < 4; ++st) {
                const bf16x8 k0 = *(const LAS bf16x8*)(kb + 32 * st), k1 = *(const LAS bf16x8*)(kb + 32 * KP_R + 32 * st);
                p0 = __builtin_amdgcn_mfma_f32_32x32x16_bf16(k0, qf[st], p0, 0, 0, 0);
                p1 = __builtin_amdgcn_mfma_f32_32x32x16_bf16(k1, qf[st], p1, 0, 0, 0);
            }
            const int d0 = qpos - RET_TILE_POS(t) - 4 * hi;
#pragma unroll
            for (int r = 0; r < 16; ++r) {
                const int dp0 = d0 - ((r & 3) + 8 * (r >> 2)), dp1 = dp0 - 32;
                const float w0 = dp0 > 0 ? __builtin_amdgcn_exp2f(lgf * (float)dp0) : (dp0 < 0 ? __builtin_amdgcn_exp2f(-lgb * (float)dp0) : 2.f);
                const float w1 = dp1 > 0 ? __builtin_amdgcn_exp2f(lgf * (float)dp1) : (dp1 < 0 ? __builtin_amdgcn_exp2f(-lgb * (float)dp1) : 2.f);
                p0[r] *= w0; p1[r] *= w1;
            }
            bf16x8 pf[4]; pf[0] = pack_p(p0, 0); pf[1] = pack_p(p0, 8); pf[2] = pack_p(p1, 0); pf[3] = pack_p(p1, 8);
            pv_tile(o0, o1, sm + buf + vrd, pf);
            if (t + 1 < ntile) { const int nb = ((t + 1) & 1) * BUF_R; *(LAS u32x4*)(sm + nb + koff) = kr; *(LAS u32x4*)(sm + nb + voff) = vr; }
            __syncthreads();
        }
#undef RET_TILE_ROW
#undef RET_TILE_POS
        float s1 = 0.f;
#pragma unroll
        for (int r = 0; r < 16; ++r) s1 += o0[r] + o1[r];
        s1 += __shfl_xor(s1, 32);
        const float mu = s1 * (1.f / 64);
        float s2 = 0.f;
#pragma unroll
        for (int r = 0; r < 16; ++r) { const float a = o0[r] - mu, c = o1[r] - mu; s2 += a * a + c * c; }
        s2 += __shfl_xor(s2, 32);
        const float rstd = rsqrtf(s2 * (1.f / 64) + EPS);
#pragma unroll
        for (int g = 0; g < 4; ++g)
#pragma unroll
            for (int blk = 0; blk < 2; ++blk) {
                const int d = blk * 32 + 8 * g + 4 * hi;
                const u32x2 gt = *(const u32x2*)(zq + C_RG + h * 64 + d);
                const f32x4 gw = *(const f32x4*)(gn_w + h * 64 + d);
                float y[4];
#pragma unroll
                for (int q = 0; q < 4; ++q) { const float ov = blk ? o1[4 * g + q] : o0[4 * g + q]; const unsigned gb = q < 2 ? gt.x : gt.y; const float gv = __uint_as_float((q & 1) ? (gb & 0xffff0000u) : (gb << 16));
                    y[q] = siluf_(gv) * ((ov - mu) * rstd * gw[q]); }
                u32x2 w; w.x = pk2(y[0], y[1]); w.y = pk2(y[2], y[3]);
                *(u32x2*)(zq + C_RQ + h * 64 + d) = w;
            }
    }
    __syncthreads();
}

struct SchedGrid {
    const char* A; const char* B; unsigned lda, ldb; int nt, nM, nN, G, c, kind, aux;
    __device__ __forceinline__ bool next(int i, pg8::Unit& u) const {
        int pm, pn; if (!pg8::static_tile(nM, nN, G, c, i, pm, pn)) return false;
        u.A = A + (size_t)pm * 256 * lda; u.B = B + (size_t)pn * 256 * ldb; u.lda = lda; u.ldb = ldb; u.nt = nt; u.pm = pm; u.pn = pn; u.kind = kind; u.aux = aux; return true; }
};
struct SchedP1 {
    const char* A; const char* B; int G, c, last;
    __device__ __forceinline__ bool next(int i, pg8::Unit& u) const {
        int pm, pn;
        if (!last) { if (!pg8::static_tile(RT / 256, 8, G, c, i, pm, pn)) return false; }
        else { if (!pg8::static_tile(RL / 256, 8, G, c, i, pm, pn)) { const int j = i * G + c - (RL / 256) * 8; if (j < 0 || j >= 32) return false; pm = RL / 256 + (j >> 2); pn = j & 3; } }
        u.A = A + (size_t)pm * 256 * 2048; u.B = B + (size_t)pn * 256 * 2048; u.lda = 2048; u.ldb = 2048; u.nt = 16; u.pm = pm; u.pn = pn; u.kind = 0; u.aux = 0; return true; }
};
struct SchedMerge {
    const char* Z; const char* XN; const char* WBR; const char* WING; int njobs, G, vcu;
    __device__ __forceinline__ bool next(int i, pg8::Unit& u) const {
        const int job = (i >> 3) * G + vcu; if (job >= njobs) return false;
        const int sub = i & 7, n = sub >> 1, pm = job >> 2, pn = job & 3;
        u.pm = pm; u.pn = pn; u.aux = n;
        if (!(sub & 1)) { const int bcol = n == 0 ? C_QC : (n == 1 ? C_FU : (n == 2 ? C_OC : C_RQ));
            u.A = Z + ((size_t)pm * 256 * ZW + bcol) * 2; u.lda = ZW * 2; u.B = WBR + ((size_t)n * 1024 + pn * 256) * 512; u.ldb = 512; u.nt = 4; u.kind = 0; }
        else { u.A = XN + (size_t)pm * 256 * 2048; u.lda = 2048; u.B = WING + ((size_t)n * 1024 + pn * 256) * 2048; u.ldb = 2048; u.nt = 16; u.kind = 1; }
        return true; }
};
#define EPI_FOREACH(...) _Pragma("unroll") for (int ai = 0; ai < 2; ++ai) _Pragma("unroll") for (int m = 0; m < 4; ++m) _Pragma("unroll") for (int bj = 0; bj < 2; ++bj) { \
        const int row = u.pm * 256 + ai * 128 + wr * 64 + m * 16 + fr, col = u.pn * 256 + bj * 128 + wc * 32 + 8 * fq; const f32x4 v0 = acc[ai][bj][m][0], v1 = acc[ai][bj][m][1]; (void)row; (void)col; __VA_ARGS__ }
struct EpiStore {
    bf16_t* O; int ld; int act;
    __device__ __forceinline__ void operator()(const f32x4 (&acc)[2][2][4][2], const pg8::Unit& u, int wr, int wc, int fr, int fq) const {
        EPI_FOREACH( f32x4 a = v0, b = v1; if (act == 1) { _Pragma("unroll") for (int q = 0; q < 4; ++q) { const float ra = fmaxf(a[q], 0.f), rb = fmaxf(b[q], 0.f); a[q] = ra * ra; b[q] = rb * rb; } }
            *(pg8::u32x4*)(O + (size_t)row * ld + col) = pack8(a, b); )
    }
};
struct EpiResid {
    const float* xlat; const float* xctx; float* olat; float* octx; const float* mod; int gch;
    __device__ __forceinline__ void operator()(const f32x4 (&acc)[2][2][4][2], const pg8::Unit& u, int wr, int wc, int fr, int fq) const {
        const bool lat = u.pm < 64; const float* xb = lat ? xlat : xctx - (size_t)RL * DM; float* ob = lat ? olat : octx - (size_t)RL * DM;
        const float* g = mod + (size_t)(lat ? (u.pm >> 3) : 8) * 6144 + gch * 1024;
        EPI_FOREACH( const f32x4 g0 = *(const f32x4*)(g + col), g1 = *(const f32x4*)(g + col + 4); const size_t o = (size_t)row * DM + col;
            const f32x4 x0 = *(const f32x4*)(xb + o), x1 = *(const f32x4*)(xb + o + 4); *(f32x4*)(ob + o) = x0 + g0 * v0; *(f32x4*)(ob + o + 4) = x1 + g1 * v1; if (bj) asm volatile("" ::: "memory"); )
    }
};
struct EpiMerge {
    pg8::u32x4* stash; bf16_t* MMp;
    __device__ __forceinline__ void operator()(const f32x4 (&acc)[2][2][4][2], const pg8::Unit& u, int wr, int wc, int fr, int fq) const {
        int tid = threadIdx.x; asm volatile("" : "+v"(tid));
        if (u.kind == 0) { EPI_FOREACH( stash[((ai * 4 + m) * 2 + bj) * NT + tid] = pack8(v0, v1); if (bj) asm volatile("" ::: "memory"); ) }
        else { EPI_FOREACH( f32x4 y0, y1; unpack8(stash[((ai * 4 + m) * 2 + bj) * NT + tid], y0, y1); f32x4 t0, t1;
                _Pragma("unroll") for (int q = 0; q < 4; ++q) { t0[q] = sigmoidf_(v0[q]) * y0[q]; t1[q] = sigmoidf_(v1[q]) * y1[q]; }
                pg8::u32x4* mp = (pg8::u32x4*)(MMp + (size_t)row * DM + col);
                if (u.aux != 0) { f32x4 p0, p1; unpack8(*mp, p0, p1); t0 += p0; t1 += p1; }
                *mp = pack8(t0, t1); asm volatile("" ::: "memory"); ) }
    }
};
__device__ __forceinline__ void transpose_item(const float* W, int K, int N, bf16_t* WT, int row_off, LAS float* scr, int item, int lane, const float* kscale = nullptr) {
    const int nblk = N / 32, kb = item / nblk, nb = item % nblk, k0 = 64 * kb, n0 = 32 * nb;
#pragma unroll 8
    for (int i = 0; i < 32; ++i) { const int kk = 2 * i + (lane >> 5); float wv = W[(size_t)(k0 + kk) * N + n0 + (lane & 31)]; if (kscale) wv *= kscale[k0 + kk]; scr[kk * 33 + (lane & 31)] = wv; }
    asm volatile("s_waitcnt lgkmcnt(0)" ::: "memory");
    const int c = lane & 7;
#pragma unroll
    for (int j = 0; j < 4; ++j) { const int n = (lane >> 3) + 8 * j; const LAS float* sp = scr + (8 * c) * 33 + n;
        pg8::u32x4 o; o.x = pg8::cvt_pk_bf16(sp[0 * 33], sp[1 * 33]); o.y = pg8::cvt_pk_bf16(sp[2 * 33], sp[3 * 33]); o.z = pg8::cvt_pk_bf16(sp[4 * 33], sp[5 * 33]); o.w = pg8::cvt_pk_bf16(sp[6 * 33], sp[7 * 33]);
        *(pg8::u32x4*)(WT + (size_t)(row_off + n0 + n) * K + k0 + 8 * c) = o; }
    asm volatile("s_waitcnt lgkmcnt(0)" ::: "memory");
}
__device__ __forceinline__ void ph_convert_weights(unsigned char* lds, int l, const float* w_in, const float* w1, const float* w2, const float* w_out, const float* w_br, const float* w_glu,
                                                   const float* w_uq, const float* q_norm, const float* w_ukv, const float* kv_norm, unsigned char* ws) { PH_IDS;
    const int wave = __builtin_amdgcn_readfirstlane(tid_ >> 6), lane = tid_ & 63;
    LAS float* scr = (LAS float*)((LAS unsigned char*)lds + wave * 16384);
    const int gw = bid_ * 8 + wave, NGW = G_ * 8;
    constexpr int I_IN = 16 * 189, I_1 = 16 * 128, I_2 = 64 * 32, I_O = 16 * 32, I_B = 4 * 32;
    constexpr int I_G = 4 * 16;
    constexpr int I_UQ = 4 * 12, I_UKV = 2 * 16;
    constexpr int NITEMS = I_IN + I_1 + I_2 + I_O + 4 * I_B + I_G + I_UQ + I_UKV;
    bf16_t* WIN_T = (bf16_t*)(ws + WS_WIN); bf16_t* W1_T = (bf16_t*)(ws + WS_W1); bf16_t* W2_T = (bf16_t*)(ws + WS_W2); bf16_t* WOUT_T = (bf16_t*)(ws + WS_WOUT); bf16_t* WBR_T = (bf16_t*)(ws + WS_WBR);
    for (int it = gw; it < NITEMS; it += NGW) {
        int r = it;
        if (r < I_IN) { const int nb = r % 189; transpose_item(w_in + (size_t)l * DM * INC, DM, INC, WIN_T, nb >= 61 ? 96 : 0, scr, r, lane); continue; } r -= I_IN;
        if (r < I_1) { transpose_item(w1 + (size_t)l * DM * DFF, DM, DFF, W1_T, 0, scr, r, lane); continue; } r -= I_1;
        if (r < I_2) { transpose_item(w2 + (size_t)l * DFF * DM, DFF, DM, W2_T, 0, scr, r, lane); continue; } r -= I_2;
        if (r < I_O) { transpose_item(w_out + (size_t)l * DM * DM, DM, DM, WOUT_T, 0, scr, r, lane); continue; } r -= I_O;
        if (r < 4 * I_B) { const int n = r / I_B; transpose_item(w_br + ((size_t)l * 4 + n) * 256 * DM, 256, DM, WBR_T + (size_t)n * 1024 * 256, 0, scr, r % I_B, lane); continue; } r -= 4 * I_B;
        { const int n0 = (r % 16) * 32; const int off = n0 < 128 ? 0 : (n0 < 256 ? 128 : (n0 < 384 ? -128 : 0));
          if (r < I_G) { transpose_item(w_glu + (size_t)l * 256 * 512, 256, 512, (bf16_t*)(ws + WS_WGLU), off, scr, r, lane); continue; } }
        r -= I_G;
        if (r < I_UQ) { transpose_item(w_uq + (size_t)l * 256 * 384, 256, 384, (bf16_t*)(ws + WS_WUQ), 0, scr, r, lane, q_norm + l * 256); continue; } r -= I_UQ;
        transpose_item(w_ukv + (size_t)l * 128 * 512, 128, 512, (bf16_t*)(ws + WS_WUKV), 0, scr, r, lane, kv_norm + l * 128);
    }
    GSTRIDE(gi, 96 * 1024 / 8) { *(pg8::u32x4*)(WIN_T + (size_t)1952 * 1024 + (size_t)gi * 8) = (pg8::u32x4){0u, 0u, 0u, 0u}; }
    __syncthreads();
}

struct EpiFourier {
    bf16_t* Zp; int rowbase, L; float scale;
    __device__ __forceinline__ void operator()(const f32x4 (&acc)[2][2][4][2], const pg8::Unit& u, int wr, int wc, int fr, int fq) const {
        EPI_FOREACH( *(pg8::u32x4*)(Zp + ((size_t)rowbase + (size_t)u.pn * L + row) * ZW + C_FU + (col - u.pn * 256)) = pack8(v0 * scale, v1 * scale); )
    }
};
struct EpiGlu {
    bf16_t* Zp;
    __device__ __forceinline__ void operator()(const f32x4 (&acc)[2][2][4][2], const pg8::Unit& u, int wr, int wc, int fr, int fq) const {
#pragma unroll
        for (int ai = 0; ai < 2; ++ai)
#pragma unroll
            for (int m = 0; m < 4; ++m) {
                const int row = u.pm * 256 + ai * 128 + wr * 64 + m * 16 + fr, col = u.pn * 128 + wc * 32 + 8 * fq;
                f32x4 a, b;
#pragma unroll
                for (int q = 0; q < 4; ++q) { a[q] = acc[ai][0][m][0][q] * sigmoidf_(acc[ai][1][m][0][q]); b[q] = acc[ai][0][m][1][q] * sigmoidf_(acc[ai][1][m][1][q]); }
                *(pg8::u32x4*)(Zp + (size_t)row * ZW + C_OC + col) = pack8(a, b);
            }
    }
};
__device__ __forceinline__ void ph_dft_gen(const float* trig, bf16_t* DL, bf16_t* DC) { PH_IDS;
    GSTRIDE(gi, 2048 * 4096 / 8) {
        const int k = gi >> 9, kk0 = (gi & 511) * 8; pg8::u32x4 w; unsigned pr[4];
#pragma unroll
        for (int q = 0; q < 4; ++q) { float v[2];
#pragma unroll
            for (int e = 0; e < 2; ++e) { const int kk = kk0 + 2 * q + e, part = kk >> 11, t = kk & 2047, idx = (k * t) & 2047; v[e] = part ? -trig[2048 + idx] : trig[idx]; }
            pr[q] = pg8::cvt_pk_bf16(v[0], v[1]); }
        w.x = pr[0]; w.y = pr[1]; w.z = pr[2]; w.w = pr[3];
        *(pg8::u32x4*)(DL + (size_t)k * 4096 + kk0) = w;
    }
    GSTRIDE(gi, 256 * 512 / 8) {
        const int k = gi >> 6, kk0 = (gi & 63) * 8; pg8::u32x4 w; unsigned pr[4];
#pragma unroll
        for (int q = 0; q < 4; ++q) { float v[2];
#pragma unroll
            for (int e = 0; e < 2; ++e) { const int kk = kk0 + 2 * q + e, part = kk >> 8, t = kk & 255, idx = ((k * t) & 255) * 8; v[e] = part ? -trig[2048 + idx] : trig[idx]; }
            pr[q] = pg8::cvt_pk_bf16(v[0], v[1]); }
        w.x = pr[0]; w.y = pr[1]; w.z = pr[2]; w.w = pr[3];
        *(pg8::u32x4*)(DC + (size_t)k * 512 + kk0) = w;
    }
}

constexpr size_t WS_BAR = 7 * MiB;
constexpr int LDS_BYTES = 147456;
struct Args { const float* in[30]; float* out; unsigned char* ws; };
typedef const __attribute__((address_space(4))) Args* CArgs;
__device__ __forceinline__ CArgs kargs() { CArgs p = (CArgs)__builtin_amdgcn_kernarg_segment_ptr(); asm volatile("" : "+s"(p)); return p; }
#define IN(i) (kargs()->in[i])
#define WSB(T, off) ((T*)(kargs()->ws + (off)))
#define OUTP (kargs()->out)
enum { I_X = 0, I_C, I_CTX, I_CCTX, I_ADAW, I_ADAB, I_NMIX, I_NFFN, I_WIN, I_QNORM, I_WUQ, I_KVNORM, I_WUKV, I_QKQ, I_QKK, I_LRE, I_LIM, I_LSTEP, I_BRE, I_BIM, I_CRE, I_CIM, I_S5D, I_WGLU, I_RDEC, I_RGN, I_WBR, I_WOUT, I_W1, I_W2 };
#define GRID_BAR() do { bar.bar = WSB(unsigned, WS_BAR); { unsigned x_ = bar.x; asm volatile("" : "+s"(x_)); bar.x = x_; } xcd_barrier(bar); } while (0)
template <int L> __device__ __forceinline__ void layer_body(unsigned char* lds, XcdBarrier& bar) {
    constexpr int l = L;
    constexpr bool LASTL = (L == DEPTH - 1);
    constexpr int NMT = LASTL ? RL / 256 : RT / 256;
    constexpr int WCTX = LASTL ? 0 : 1;

#define MODL (WSB(float, WS_MOD) + (size_t)l * 9 * 6144)
#define XLAT (l == 0 ? IN(I_X) : (const float*)OUTP)
#define XCTX (l == 0 ? IN(I_CTX) : (const float*)WSB(float, WS_XC))
#define WINL (IN(I_WIN) + (size_t)l * DM * INC)
#define ZP WSB(bf16_t, WS_Z)
#define XNP WSB(bf16_t, WS_XN)
#define QP WSB(bf16_t, WS_QKV)
#define KP (WSB(bf16_t, WS_QKV) + (size_t)32 * 2304 * 96)
#define VP (WSB(bf16_t, WS_QKV) + (size_t)2 * 32 * 2304 * 96)
#define F1LAT WSB(bf16_t, WS_F1)
#define F1CTX (WSB(bf16_t, WS_F1) + (size_t)8 * 256 * 2 * 2048)
#define QRAWP WSB(bf16_t, WS_RAW)
#define KVRAWP (WSB(bf16_t, WS_RAW) + (size_t)RT * 384)
        ph_s5_lp(l, IN(I_LRE), IN(I_LIM), IN(I_LSTEP), IN(I_BRE), IN(I_BIM), WSB(float2, WS_LP), WSB(float2, WS_BB), WSB(float, WS_LAMT));
        ph_adarms(XLAT, XCTX, IN(I_NMIX) + l * DM, MODL, 0, 1, XNP, RT);
        ph_convert_weights(lds, l, IN(I_WIN), IN(I_W1), IN(I_W2), IN(I_WOUT), IN(I_WBR), IN(I_WGLU), IN(I_WUQ), IN(I_QNORM), IN(I_WUKV), IN(I_KVNORM), kargs()->ws);
        if (l == 0) ph_dft_gen(WSB(float, WS_TRIG), WSB(bf16_t, WS_DFTL), WSB(bf16_t, WS_DFTC));
        GRID_BAR();
        ph_s5_tz(lds, l, WSB(float2, WS_LP), WSB(float2, WS_BB), IN(I_CRE), IN(I_CIM), WSB(float, WS_TZ));
        ph_s5_ms(WSB(float2, WS_LP), WSB(float2, WS_BB), WSB(bf16_t, WS_MS));
        ph_s5_qo(l, WSB(float2, WS_LP), IN(I_CRE), IN(I_CIM), WSB(bf16_t, WS_QO));
        { SchedP1 S; S.A = (const char*)XNP; S.B = (const char*)WSB(bf16_t, WS_WIN); S.G = l_grid(); S.c = l_bid(); S.last = LASTL ? 1 : 0;
          EpiStore E; E.O = ZP; E.ld = ZW; E.act = 0; pg8::gemm_phase((LAS unsigned char*)lds, S, E); }
        GRID_BAR();
        ph_prep(ZP, WSB(bf16_t, WS_WUQ), WSB(bf16_t, WS_WUKV), WSB(bf16_t, WS_D64), IN(I_QKQ) + l * 96, IN(I_QKK) + l * 96, QP, KP, VP, F1LAT, F1CTX);
        ph_s5_sloc(ZP, WSB(bf16_t, WS_MS), WSB(float, WS_SLOC));
        GRID_BAR();
        { SchedGrid S; S.A = (const char*)WSB(bf16_t, WS_DFTL); S.B = (const char*)F1LAT; S.lda = 8192; S.ldb = 8192; S.nt = 64; S.nM = 8; S.nN = 8; S.G = l_grid(); S.c = l_bid(); S.kind = 0; S.aux = 0;
          EpiFourier E; E.Zp = ZP; E.rowbase = 0; E.L = 2048; E.scale = 0.0027621358640099515f; pg8::gemm_phase((LAS unsigned char*)lds, S, E); }
        if (!LASTL) { SchedGrid S; S.A = (const char*)WSB(bf16_t, WS_DFTC); S.B = (const char*)F1CTX; S.lda = 1024; S.ldb = 1024; S.nt = 8; S.nM = 1; S.nN = 8; S.G = l_grid(); S.c = l_bid(); S.kind = 0; S.aux = 0;
          EpiFourier E; E.Zp = ZP; E.rowbase = RL; E.L = 256; E.scale = 0.0078125f; pg8::gemm_phase((LAS unsigned char*)lds, S, E); }
        ph_ret_mfma(lds, ZP, IN(I_RDEC) + l * 8, IN(I_RGN) + l * 256, WCTX);
        ph_attn_mfma(lds, QP, KP, VP, ZP, WCTX);
        ph_s5_out(lds, ZP, WSB(float, WS_TZ), IN(I_S5D) + l * 256, WSB(bf16_t, WS_QO), WSB(float, WS_SLOC), WSB(float, WS_LAMT), ZP, LASTL ? 16 : 18);
        GRID_BAR();
        { SchedGrid S; S.A = (const char*)(ZP + C_S5); S.B = (const char*)WSB(bf16_t, WS_WGLU); S.lda = ZW * 2; S.ldb = 512; S.nt = 4; S.nM = NMT; S.nN = 2; S.G = l_grid(); S.c = l_bid(); S.kind = 0; S.aux = 0;
          EpiGlu E; E.Zp = ZP; pg8::gemm_phase((LAS unsigned char*)lds, S, E); }
        GRID_BAR();
        { SchedMerge S; S.Z = (const char*)ZP; S.XN = (const char*)XNP; S.WBR = (const char*)WSB(bf16_t, WS_WBR); S.WING = (const char*)(WSB(bf16_t, WS_WIN) + (size_t)2048 * 1024);
          S.njobs = NMT * 4; S.G = l_grid(); { const int bx = l_bid(); S.vcu = (bx % 8) * (S.G / 8) + bx / 8; }
          EpiMerge E; E.stash = WSB(pg8::u32x4, WS_STASH) + (size_t)l_bid() * 8192; E.MMp = WSB(bf16_t, WS_MM); pg8::gemm_phase((LAS unsigned char*)lds, S, E); }
        GRID_BAR();
        { SchedGrid S; S.A = (const char*)WSB(bf16_t, WS_MM); S.B = (const char*)WSB(bf16_t, WS_WOUT); S.lda = 2048; S.ldb = 2048; S.nt = 16; S.nM = NMT; S.nN = 4; S.G = l_grid(); S.c = l_bid(); S.kind = 0; S.aux = 0;
          EpiResid E; E.xlat = XLAT; E.xctx = XCTX; E.olat = OUTP; E.octx = WSB(float, WS_XC); E.mod = MODL; E.gch = 2; pg8::gemm_phase((LAS unsigned char*)lds, S, E); }
        GRID_BAR();
        ph_adarms(OUTP, WSB(float, WS_XC), IN(I_NFFN) + l * DM, MODL, 3, 4, XNP, NMT * 256);
        GRID_BAR();
        { SchedGrid S; S.A = (const char*)XNP; S.B = (const char*)WSB(bf16_t, WS_W1); S.lda = 2048; S.ldb = 2048; S.nt = 16; S.nM = NMT; S.nN = 16; S.G = l_grid(); S.c = l_bid(); S.kind = 0; S.aux = 0;
          EpiStore E; E.O = WSB(bf16_t, WS_H); E.ld = DFF; E.act = 1; pg8::gemm_phase((LAS unsigned char*)lds, S, E); }
        GRID_BAR();
        { SchedGrid S; S.A = (const char*)WSB(bf16_t, WS_H); S.B = (const char*)WSB(bf16_t, WS_W2); S.lda = 8192; S.ldb = 8192; S.nt = 64; S.nM = NMT; S.nN = 4; S.G = l_grid(); S.c = l_bid(); S.kind = 0; S.aux = 0;
          EpiResid E; E.xlat = OUTP; E.xctx = WSB(float, WS_XC); E.olat = OUTP; E.octx = WSB(float, WS_XC); E.mod = MODL; E.gch = 5; pg8::gemm_phase((LAS unsigned char*)lds, S, E); }
        if (l + 1 < DEPTH) GRID_BAR();
}
__global__ void __launch_bounds__(NT, 2) mega(Args a_unused) {
    extern __shared__ __attribute__((aligned(16))) unsigned char lds[];
    volatile LAS unsigned* bst = (volatile LAS unsigned*)((LAS unsigned char*)lds + LDS_BYTES - 16);
    if (threadIdx.x < 4) bst[threadIdx.x] = 0u;
    __syncthreads();
    XcdBarrier bar = xcd_barrier_post(WSB(unsigned, WS_BAR), bst);

    ph_mod(lds, IN(I_C), IN(I_CCTX), IN(I_ADAW), IN(I_ADAB), WSB(float, WS_MOD));
    ph_trig(WSB(float, WS_TRIG), WSB(bf16_t, WS_D64));
    GRID_BAR();
    layer_body<0>(lds, bar);
    layer_body<1>(lds, bar);
}

extern "C" void kernel_launch(void* const* d_in, const int* in_sizes, int n_in, void* d_out, int out_size, void* d_ws, size_t ws_size, hipStream_t stream) {
    static int grid = 0;
    if (grid == 0) {
        if (n_in != 30 || ws_size < WS_END) { fprintf(stderr, "kernel_launch: unexpected n_in %d / ws_size %zu\n", n_in, ws_size); grid = -1; return; }
        int dev = 0, cus = 0, per_cu = 0;
        if (hipGetDevice(&dev) != hipSuccess || hipDeviceGetAttribute(&cus, hipDeviceAttributeMultiprocessorCount, dev) != hipSuccess) { grid = -1; return; }
        if (hipFuncSetAttribute((const void*)mega, hipFuncAttributeMaxDynamicSharedMemorySize, LDS_BYTES) != hipSuccess) { fprintf(stderr, "kernel_launch: hipFuncSetAttribute failed\n"); grid = -1; return; }
        if (hipOccupancyMaxActiveBlocksPerMultiprocessor(&per_cu, (const void*)mega, NT, LDS_BYTES) != hipSuccess || per_cu < 1) fprintf(stderr, "kernel_launch: occupancy query says %d\n", per_cu);
        (void)hipGetLastError();
        grid = cus;
    }
    if (grid < 0) return;
    (void)hipMemsetAsync((char*)d_ws + WS_BAR, 0, XCD_BAR_WORDS * 4, stream);
    Args a; memset((void*)&a, 0, sizeof(a));
    for (int i = 0; i < 30; ++i) a.in[i] = (const float*)d_in[i];
    a.out = (float*)d_out; a.ws = (unsigned char*)d_ws;
    hipLaunchKernelGGL(mega, dim3(grid), dim3(NT), LDS_BYTES, stream, a);
}
```

```cpp
#include <hip/hip_runtime.h>
#include <cstdint>
#include <cstring>
#include <cstdio>

typedef unsigned short bf16_t;
typedef short bf16x8 __attribute__((ext_vector_type(8)));
typedef float f32x4 __attribute__((ext_vector_type(4)));

constexpr int DM = 1024, NB = 8, SEQ = 2048, CTX = 256, DEPTH = 2;
constexpr int RL = NB * SEQ;
constexpr int RC = NB * CTX;
constexpr int RT = RL + RC;
constexpr int INC = 6048;
constexpr int ZW = 2048;
constexpr int C_KVC = 0, C_KR = 128, C_S5 = 160, C_RK = 416, C_RV = 672, C_QC = 928, C_FU = 1184, C_RQ = 1440, C_RG = 1696, C_GATE = 1952;
constexpr int C_OC = C_RK;
constexpr int DFF = 4096;
constexpr int TCH = 64;
constexpr int NCH = RT / TCH;
constexpr float EPS = 1e-6f;
#define PI_D 3.14159265358979323846

__device__ __forceinline__ float bf2f(bf16_t v) { return __uint_as_float(((unsigned)v) << 16); }
__device__ __forceinline__ bf16_t f2bf(float f) { unsigned u = __float_as_uint(f); return (bf16_t)((u + 0x7fffu + ((u >> 16) & 1u)) >> 16); }
__device__ __forceinline__ float sigmoidf_(float x) { return 1.f / (1.f + __expf(-x)); }
__device__ __forceinline__ float siluf_(float x) { return x * sigmoidf_(x); }
__device__ __forceinline__ float geluf_(float x) { return 0.5f * x * (1.f + tanhf(0.7978845608028654f * (x + 0.044715f * x * x * x))); }
__device__ __forceinline__ int row_batch(int row) { return row < RL ? (row >> 11) : ((row - RL) >> 8); }
__device__ __forceinline__ int row_modidx(int row) { return row < RL ? (row >> 11) : 8; }

constexpr size_t MiB = 1ull << 20;
constexpr size_t WS_MOD = 0;
constexpr size_t WS_RS = 1 * MiB;
constexpr size_t WS_TRIG = WS_RS + 256 * 1024;
constexpr size_t WS_LAMT = WS_TRIG + 32 * 1024;
constexpr size_t WS_LP = 2 * MiB;
constexpr size_t WS_BB = 5 * MiB;
constexpr size_t WS_W = 8 * MiB;
constexpr size_t WS_WIN = WS_W, WS_W1 = WS_W + 12 * MiB, WS_W2 = WS_W + 20 * MiB, WS_WOUT = WS_W + 28 * MiB, WS_WBR = WS_W + 30 * MiB;
constexpr size_t WS_XN = 40 * MiB;
constexpr size_t WS_RAW = WS_XN;
constexpr size_t WS_YG = WS_XN;
constexpr size_t WS_Z = 76 * MiB;
constexpr size_t WS_QKV = 148 * MiB;
constexpr size_t WS_F1 = 184 * MiB;
constexpr size_t WS_GL = WS_F1;
constexpr size_t WS_TZ = 202 * MiB;
constexpr size_t WS_MS = 204 * MiB;
constexpr size_t WS_QO = 212 * MiB;
constexpr size_t WS_SLOC = 220 * MiB;
constexpr size_t WS_XP = 225 * MiB;
constexpr size_t WS_XC = 230 * MiB;
constexpr size_t WS_MM = WS_QKV;
constexpr size_t WS_STASH = WS_F1;
constexpr size_t WS_H = WS_Z;
constexpr size_t WS_WUQ = 6 * MiB + 256 * 1024;
constexpr size_t WS_WUKV = 6 * MiB + 512 * 1024;
constexpr size_t WS_D64 = 6 * MiB + 768 * 1024;
constexpr size_t WS_WGLU = 6 * MiB;
constexpr size_t WS_DFTL = 238 * MiB;
constexpr size_t WS_DFTC = 254 * MiB;
constexpr size_t WS_END = 256 * MiB;


#define LAS __attribute__((address_space(3)))
#define NT 512
__device__ __forceinline__ int l_tid() { int t = threadIdx.x; asm volatile("" : "+v"(t)); return t; }
__device__ __forceinline__ int l_bid() { int b = blockIdx.x; asm volatile("" : "+s"(b)); return b; }
__device__ __forceinline__ int l_grid() { int g = gridDim.x; asm volatile("" : "+s"(g)); return g; }
#define PH_IDS const int tid_ = l_tid(), bid_ = l_bid(), G_ = l_grid(); (void)tid_; (void)bid_; (void)G_
template <class AF, class BF, class EF>
__device__ __forceinline__ void gemm_tile(const AF& A, const BF& B, const EF& E, bool valid, int b, int m0, int n0, int M, int N, int K, bf16_t (*sA)[40], bf16_t (*sB)[40], int ht) {
    f32x4 accm[2][2];
#pragma unroll
    for (int i = 0; i < 2; ++i)
#pragma unroll
        for (int j = 0; j < 2; ++j) accm[i][j] = (f32x4){0.f, 0.f, 0.f, 0.f};
    const int w = ht >> 6, lane = ht & 63, wm = (w >> 1) * 32, wn = (w & 1) * 32, fr = lane & 15, fq = lane >> 4;
    for (int k0 = 0; k0 < K; k0 += 32) {
        __syncthreads();
#pragma unroll
        for (int i = 0; i < 8; ++i) {
            const int e = ht + i * 256;
            { const int m = e >> 5, k = e & 31; float v = 0.f; if (valid && m0 + m < M && k0 + k < K) v = A(b, m0 + m, k0 + k); sA[m][k] = f2bf(v); }
            { const int k = e >> 6, n = e & 63; float v = 0.f; if (valid && n0 + n < N && k0 + k < K) v = B(b, k0 + k, n0 + n); sB[n][k] = f2bf(v); }
        }
        __syncthreads();
        bf16x8 af[2], bfr[2];
#pragma unroll
        for (int i = 0; i < 2; ++i) { af[i] = *(const bf16x8*)&sA[wm + i * 16 + fr][fq * 8]; bfr[i] = *(const bf16x8*)&sB[wn + i * 16 + fr][fq * 8]; }
#pragma unroll
        for (int i = 0; i < 2; ++i)
#pragma unroll
            for (int j = 0; j < 2; ++j) accm[i][j] = __builtin_amdgcn_mfma_f32_16x16x32_bf16(af[i], bfr[j], accm[i][j], 0, 0, 0);
    }
    if (valid) {
#pragma unroll
        for (int i = 0; i < 2; ++i)
#pragma unroll
            for (int j = 0; j < 2; ++j)
#pragma unroll
                for (int rr = 0; rr < 4; ++rr) {
                    const int m = m0 + wm + i * 16 + fq * 4 + rr, n = n0 + wn + j * 16 + fr;
                    if (m < M && n < N) E(b, m, n, accm[i][j][rr]);
                }
    }
}
template <class AF, class BF, class EF>
__device__ __forceinline__ void gemm_phase(unsigned char* lds, const AF& A, const BF& B, const EF& E, int nbatch, int M, int N, int K) {
    PH_IDS; const int tid = tid_, half = tid >> 8, ht = tid & 255;
    bf16_t (*sA)[40] = (bf16_t (*)[40])(lds + half * 10240);
    bf16_t (*sB)[40] = (bf16_t (*)[40])(lds + half * 10240 + 5120);
    const int tm = (M + 63) >> 6, tn = (N + 63) >> 6, total = nbatch * tm * tn;
    for (int it0 = bid_ * 2; it0 < total; it0 += G_ * 2) {
        const int it = it0 + half; const bool valid = it < total;
        const int itc = valid ? it : 0;
        const int b = itc / (tm * tn), r = itc % (tm * tn), m0 = (r / tn) * 64, n0 = (r % tn) * 64;
        gemm_tile(A, B, E, valid, b, m0, n0, M, N, K, sA, sB, ht);
    }
    __syncthreads();
}
template <class T> static T zeroed() { T t; memset((void*)&t, 0, sizeof(T)); return t; }

struct A_bf16 { const bf16_t* p; long long ld; long long coff;
    __device__ float operator()(int, int m, int k) const { return bf2f(p[(size_t)m * ld + coff + k]); } };
struct A_bf16_scaled { const bf16_t* p; long long ld; long long coff; const float* rs; long long rsi; const float* w;
    __device__ float operator()(int, int m, int k) const { return bf2f(p[(size_t)m * ld + coff + k]) * rs[(size_t)m * 2 + rsi] * w[k]; } };
struct B_f32 { const float* p; long long ld; long long coff;
    __device__ float operator()(int, int k, int n) const { return p[(size_t)k * ld + coff + n]; } };
struct E_bf16 { bf16_t* p; long long ld; long long coff;
    __device__ void operator()(int, int m, int n, float v) const { p[(size_t)m * ld + coff + n] = f2bf(v); } };

#define XB_TMO      128
#define XB_XCNT(j)  (256  + 64 * (j))
#define XB_XSUB(j)  (1280 + 64 * (j))
#define XB_XGEN(j)  (2304 + 64 * (j))
#define XB_TOP      3328
#define XB_TOPGEN   3392
#define XCD_BAR_WORDS 3456
#define XB_SPIN_CAP (1u << 18)
__device__ __forceinline__ unsigned xb_ld(unsigned* p)              { return __hip_atomic_load(p, __ATOMIC_RELAXED, __HIP_MEMORY_SCOPE_AGENT); }
__device__ __forceinline__ unsigned xb_add(unsigned* p, unsigned v) { return __hip_atomic_fetch_add(p, v, __ATOMIC_RELAXED, __HIP_MEMORY_SCOPE_AGENT); }
__device__ __forceinline__ unsigned xb_xcc_id() { return (unsigned)__builtin_amdgcn_s_getreg((3 << 11) | 20) & 0xFu; }
#define XB_SPIN(cond, bar) do { unsigned _sp = 0; while (cond) { __builtin_amdgcn_s_sleep(1); \
    if ((++_sp & 255u) == 0u) { if (xb_ld(&(bar)[XB_TMO])) break; if (_sp > XB_SPIN_CAP) { atomicAdd(&(bar)[XB_TMO], 1u); break; } } } } while (0)
struct XcdBarrier { unsigned* bar; unsigned x; volatile LAS unsigned* st; };
__device__ __forceinline__ XcdBarrier xcd_barrier_post(unsigned* bar, volatile LAS unsigned* st) {
    XcdBarrier b; b.bar = bar; b.x = xb_xcc_id(); b.st = st;
    if (threadIdx.x == 0) (void)xb_add(&bar[XB_XCNT(b.x)], 1u);
    return b;
}
__device__ __forceinline__ void xcd_barrier_complete(unsigned* bar, unsigned x, unsigned& nloc, unsigned& nx) {
    const unsigned G = gridDim.x * gridDim.y * gridDim.z;
    unsigned sum, cnt, mine, sp = 0u;
    for (;;) {
        sum = 0u; cnt = 0u; mine = 0u;
#pragma unroll
        for (unsigned j = 0; j < 16; ++j) { const unsigned c = xb_ld(&bar[XB_XCNT(j)]); sum += c; cnt += (c > 0u) ? 1u : 0u; mine = (j == x) ? c : mine; }
        if (sum == G) break;
        __builtin_amdgcn_s_sleep(1);
        if ((++sp & 255u) == 0u) { if (xb_ld(&bar[XB_TMO])) break; if (sp > XB_SPIN_CAP) { atomicAdd(&bar[XB_TMO], 1u); break; } }
    }
    nloc = mine > 0u ? mine : 1u; nx = cnt > 0u ? cnt : 1u;
}
__device__ __forceinline__ void xcd_barrier(const XcdBarrier& b) {
    asm volatile("s_waitcnt vmcnt(0)" ::: "memory");
    __syncthreads();
    if (threadIdx.x == 0) {
        unsigned* bar = b.bar;
        __builtin_amdgcn_s_waitcnt(0);
        unsigned nloc = b.st[0], nx = b.st[1];
        if (nloc == 0u) { xcd_barrier_complete(bar, b.x, nloc, nx); b.st[0] = nloc; b.st[1] = nx; }
        const unsigned old = xb_add(&bar[XB_XSUB(b.x)], 1u);
        const unsigned gen = old / nloc;
        if (old + 1u == (gen + 1u) * nloc) {
            __builtin_amdgcn_fence(__ATOMIC_RELEASE, "agent");
            asm volatile("s_waitcnt vmcnt(0)" ::: "memory");
            const unsigned og = xb_add(&bar[XB_TOP], 1u);
            const unsigned tg = og / nx;
            if (og + 1u == (tg + 1u) * nx) xb_add(&bar[XB_TOPGEN], 1u);
            else XB_SPIN(xb_ld(&bar[XB_TOPGEN]) == tg, bar);
            __builtin_amdgcn_fence(__ATOMIC_ACQUIRE, "agent");
            xb_add(&bar[XB_XGEN(b.x)], 1u);
            asm volatile("s_waitcnt vmcnt(0)" ::: "memory");
        } else {
            XB_SPIN(xb_ld(&bar[XB_XGEN(b.x)]) == gen, bar);
            __builtin_amdgcn_fence(__ATOMIC_ACQUIRE, "agent");
            asm volatile("s_waitcnt vmcnt(0)" ::: "memory");
        }
    }
    __syncthreads();
}

namespace pg8 {
typedef unsigned u32x4 __attribute__((ext_vector_type(4)));
constexpr int BM = 256, BK = 64, HALF = 128, HTB = HALF * BK * 2, STAGE_BYTES = 8 * HTB, NXCD = 8, WGM = 8;
__device__ __forceinline__ int lds_byte(int r, int c) { const int st = (r >> 4) * 2 + (c >> 5), rr = r & 15, cc = c & 31, ob = rr * 64 + cc * 2; return st * 1024 + (ob ^ (((ob >> 9) & 1) << 5)); }
__device__ __forceinline__ void stage_rc(int b, int& R, int& C) { const int st = b / 1024, sb = b % 1024, swz = sb ^ (((sb >> 9) & 1) << 5); R = (st >> 1) * 16 + swz / 64; C = (st & 1) * 32 + (swz % 64) / 2; }
__device__ __forceinline__ int perm32(int rho) { const int n = rho >> 4, i = rho & 15; return 8 * (i >> 2) + 4 * n + (i & 3); }
struct Unit { const char* A; const char* B; unsigned lda, ldb; int nt, pm, pn, kind, aux; };
__device__ __forceinline__ unsigned cvt_pk_bf16(float lo, float hi) { unsigned r; asm volatile("v_cvt_pk_bf16_f32 %0, %1, %2" : "=v"(r) : "v"(lo), "v"(hi)); return r; }
__device__ __forceinline__ bool static_tile(int nM, int nN, int G, int c, int i, int& pm, int& pn) {
    const int nwg = nM * nN; const long L = (long)i * G + c; if (L >= nwg) return false;
    int wgid = (int)L; { const int q = nwg / NXCD, r = nwg % NXCD, xcd = wgid % NXCD, off = wgid / NXCD; wgid = (xcd < r ? xcd * (q + 1) : r * (q + 1) + (xcd - r) * q) + off; }
    const int nig = WGM * nN, gid = wgid / nig, fm = gid * WGM, gsz = (nM - fm) < WGM ? (nM - fm) : WGM;
    pm = fm + ((wgid % nig) % gsz); pn = (wgid % nig) / gsz; return true;
}
template <class Epi, class Sched>
__device__ __forceinline__ void gemm_phase(LAS unsigned char* lds, const Sched& S, const Epi& E) {
    const int tid = l_tid(), wid = __builtin_amdgcn_readfirstlane(tid >> 6), lane = tid & 63, wr = wid >> 2, wc = wid & 3, fr = lane & 15, fq = lane >> 4;
    int sR[2], sRb[2], sC2[2];
#pragma unroll
    for (int i = 0; i < 2; ++i) { int R, C; stage_rc(tid * 16 + i * 8192, R, C); sR[i] = R; sRb[i] = (R & ~31) + perm32(R & 31); sC2[i] = C * 2; }
    const size_t kstep = (size_t)(BK * 2);
    const unsigned ldsw = (unsigned)wid * 1024u;
    const int aoff = lds_byte(wr * 64 + fr, fq * 8), boff = lds_byte(wc * 32 + fr, fq * 8);
#define PG8_SA(b, h) (((b) * 2 + (h)) * HTB)
#define PG8_SB(b, h) ((4 + (b) * 2 + (h)) * HTB)
#define PG8_STAGE_A(bufoff, gbase, ld) do { \
        __builtin_amdgcn_global_load_lds((const unsigned*)((const char*)(gbase) + (unsigned)(sR[0] * (ld) + sC2[0])), (LAS unsigned*)(lds + (bufoff) + ldsw), 16, 0, 0); \
        __builtin_amdgcn_global_load_lds((const unsigned*)((const char*)(gbase) + (unsigned)(sR[1] * (ld) + sC2[1])), (LAS unsigned*)(lds + (bufoff) + ldsw + 8192), 16, 0, 0); } while (0)
#define PG8_STAGE_B(bufoff, gbase, ld) do { \
        __builtin_amdgcn_global_load_lds((const unsigned*)((const char*)(gbase) + (unsigned)(sRb[0] * (ld) + sC2[0])), (LAS unsigned*)(lds + (bufoff) + ldsw), 16, 0, 0); \
        __builtin_amdgcn_global_load_lds((const unsigned*)((const char*)(gbase) + (unsigned)(sRb[1] * (ld) + sC2[1])), (LAS unsigned*)(lds + (bufoff) + ldsw + 8192), 16, 0, 0); } while (0)
#define PG8_LDA(dst, b, h) do { _Pragma("unroll") for (int m = 0; m < 4; ++m) _Pragma("unroll") for (int k = 0; k < 2; ++k) dst[m][k] = *(const LAS bf16x8*)(lds + PG8_SA(b, h) + aoff + m * 2048 + k * 1024); } while (0)
#define PG8_LDB(dst, b, h) do { _Pragma("unroll") for (int n = 0; n < 2; ++n) _Pragma("unroll") for (int k = 0; k < 2; ++k) dst[n][k] = *(const LAS bf16x8*)(lds + PG8_SB(b, h) + boff + n * 2048 + k * 1024); } while (0)
#define PG8_MMA(ai, bj, At, Bt) do { __builtin_amdgcn_s_setprio(1); _Pragma("unroll") for (int m = 0; m < 4; ++m) _Pragma("unroll") for (int n = 0; n < 2; ++n) _Pragma("unroll") for (int k = 0; k < 2; ++k) \
        acc[ai][bj][m][n] = __builtin_amdgcn_mfma_f32_16x16x32_bf16(Bt[n][k], At[m][k], acc[ai][bj][m][n], 0, 0, 0); __builtin_amdgcn_s_setprio(0); } while (0)
#define PG8_WAIT_V(n) asm volatile("s_waitcnt vmcnt(" #n ")" ::: "memory")
#define PG8_WAIT_L(n) asm volatile("s_waitcnt lgkmcnt(" #n ")" ::: "memory")
#define PG8_BAR __builtin_amdgcn_s_barrier()
#define PG8_SCHED __builtin_amdgcn_sched_barrier(0)
    Unit cur, nxt; int ui = 0;
    if (!S.next(0, cur)) return;
    f32x4 acc[2][2][4][2];
#pragma unroll
    for (int a = 0; a < 2; ++a)
#pragma unroll
        for (int b = 0; b < 2; ++b)
#pragma unroll
            for (int m = 0; m < 4; ++m)
#pragma unroll
                for (int n = 0; n < 2; ++n) acc[a][b][m][n] = (f32x4){0.f, 0.f, 0.f, 0.f};
    bf16x8 At[4][2], B0[2][2], B1[2][2];
    const char* cA = cur.A; const char* cB = cur.B;
    int clda = cur.lda, cldb = cur.ldb;
    PG8_STAGE_B(PG8_SB(0, 0), cB, cldb); PG8_STAGE_B(PG8_SB(0, 1), cB + (size_t)HALF * cldb, cldb); PG8_STAGE_A(PG8_SA(0, 0), cA, clda); PG8_STAGE_A(PG8_SA(0, 1), cA + (size_t)HALF * clda, clda);
    if (wr == 1) PG8_BAR;
    PG8_WAIT_V(2); PG8_BAR;
    PG8_STAGE_B(PG8_SB(1, 0), cB + kstep, cldb); PG8_STAGE_A(PG8_SA(1, 0), cA + kstep, clda); PG8_STAGE_B(PG8_SB(1, 1), cB + (size_t)HALF * cldb + kstep, cldb);
    PG8_WAIT_V(6); PG8_BAR;
    for (;;) {
        const bool has_next = S.next(ui + 1, nxt);
        const char* nA = has_next ? nxt.A : cA; const char* nB = has_next ? nxt.B : cB;
        const int nlda = has_next ? (int)nxt.lda : clda, nldb = has_next ? (int)nxt.ldb : cldb;
        const int nt = cur.nt;
        for (int t = 0; t < nt; t += 2) {
            const bool last = (t == nt - 2);
            const char* a1 = cA + (size_t)(t + 1) * kstep;
            const char* a2 = last ? nA : cA + (size_t)(t + 2) * kstep; const char* b2 = last ? nB : cB + (size_t)(t + 2) * kstep;
            const char* a3 = a2 + kstep; const char* b3 = b2 + kstep;
            const int lda2 = last ? nlda : clda, ldb2 = last ? nldb : cldb;
            PG8_LDB(B0, 0, 0); PG8_LDB(B1, 0, 1); PG8_SCHED; PG8_LDA(At, 0, 0); PG8_STAGE_A(PG8_SA(1, 1), a1 + (size_t)HALF * clda, clda);
            PG8_WAIT_V(8); PG8_WAIT_L(0); PG8_BAR; PG8_MMA(0, 0, At, B0); PG8_MMA(0, 1, At, B1); PG8_BAR; PG8_SCHED;
            PG8_LDA(At, 0, 1); PG8_STAGE_B(PG8_SB(0, 0), b2, ldb2); PG8_STAGE_B(PG8_SB(0, 1), b2 + (size_t)HALF * ldb2, ldb2); PG8_STAGE_A(PG8_SA(0, 0), a2, lda2);
            PG8_WAIT_V(8); PG8_WAIT_L(0); PG8_BAR; PG8_MMA(1, 0, At, B0); PG8_MMA(1, 1, At, B1); PG8_BAR; PG8_SCHED;
            PG8_LDB(B0, 1, 0); PG8_LDB(B1, 1, 1); PG8_SCHED; PG8_LDA(At, 1, 0); PG8_STAGE_A(PG8_SA(0, 1), a2 + (size_t)HALF * lda2, lda2);
            PG8_WAIT_V(8); PG8_WAIT_L(0); PG8_BAR; PG8_MMA(0, 0, At, B0); PG8_MMA(0, 1, At, B1); PG8_BAR; PG8_SCHED;
            PG8_LDA(At, 1, 1); PG8_STAGE_B(PG8_SB(1, 0), b3, ldb2); PG8_STAGE_B(PG8_SB(1, 1), b3 + (size_t)HALF * ldb2, ldb2); PG8_STAGE_A(PG8_SA(1, 0), a3, lda2);
            PG8_WAIT_V(8); PG8_WAIT_L(0); PG8_BAR; PG8_MMA(1, 0, At, B0); PG8_MMA(1, 1, At, B1); PG8_BAR; PG8_SCHED;
        }
        if (wr == 0) PG8_BAR;
        E(acc, cur, wr, wc, fr, fq);
        if (!has_next) break;
#pragma unroll
        for (int a = 0; a < 2; ++a)
#pragma unroll
            for (int b = 0; b < 2; ++b)
#pragma unroll
                for (int m = 0; m < 4; ++m)
#pragma unroll
                    for (int n = 0; n < 2; ++n) acc[a][b][m][n] = (f32x4){0.f, 0.f, 0.f, 0.f};
        cur = nxt; cA = nA; cB = nB; clda = nlda; cldb = nldb; ++ui;
        if (wr == 1) PG8_BAR;
    }
    PG8_WAIT_V(0);
    PG8_BAR;
#undef PG8_SA
#undef PG8_SB
#undef PG8_STAGE_A
#undef PG8_STAGE_B
#undef PG8_LDA
#undef PG8_LDB
#undef PG8_MMA
#undef PG8_WAIT_V
#undef PG8_WAIT_L
#undef PG8_BAR
#undef PG8_SCHED
}
}

__device__ __forceinline__ pg8::u32x4 pack8(const f32x4 a, const f32x4 b) { pg8::u32x4 w; w.x = pg8::cvt_pk_bf16(a[0], a[1]); w.y = pg8::cvt_pk_bf16(a[2], a[3]); w.z = pg8::cvt_pk_bf16(b[0], b[1]); w.w = pg8::cvt_pk_bf16(b[2], b[3]); return w; }
__device__ __forceinline__ void unpack8(const pg8::u32x4 w, f32x4& a, f32x4& b) {
    a[0] = __uint_as_float(w.x << 16); a[1] = __uint_as_float(w.x & 0xffff0000u); a[2] = __uint_as_float(w.y << 16); a[3] = __uint_as_float(w.y & 0xffff0000u);
    b[0] = __uint_as_float(w.z << 16); b[1] = __uint_as_float(w.z & 0xffff0000u); b[2] = __uint_as_float(w.w << 16); b[3] = __uint_as_float(w.w & 0xffff0000u); }
namespace fa {
typedef float f32x16 __attribute__((ext_vector_type(16)));
typedef short s16x4 __attribute__((ext_vector_type(4)));
typedef unsigned u32x4 __attribute__((ext_vector_type(4)));
typedef unsigned u32x2 __attribute__((ext_vector_type(2)));
__device__ __forceinline__ s16x4 vtr(const LAS char* p) { return __builtin_bit_cast(s16x4, __builtin_amdgcn_ds_read_tr16_b64_v4i16((LAS s16x4*)p)); }
__device__ __forceinline__ unsigned pk2(float lo, float hi) { unsigned r; asm volatile("v_cvt_pk_bf16_f32 %0, %1, %2" : "=v"(r) : "v"(lo), "v"(hi)); return r; }
__device__ __forceinline__ bf16x8 pack_p(const f32x16& p, int base) { u32x4 w; w.x = pk2(p[base], p[base + 1]); w.y = pk2(p[base + 2], p[base + 3]); w.z = pk2(p[base + 4], p[base + 5]); w.w = pk2(p[base + 6], p[base + 7]); return __builtin_bit_cast(bf16x8, w); }
__device__ __forceinline__ int crow(int r, int hi) { return (r & 3) + 8 * (r >> 2) + 4 * hi; }
__device__ __forceinline__ void pv_tile(f32x16& o0, f32x16& o1, const LAS char* vb, const bf16x8 (&pf)[4]) {
#pragma unroll
    for (int ks = 0; ks < 4; ++ks) {
        const s16x4 a0 = vtr(vb + ks * 1024), a1 = vtr(vb + ks * 1024 + 512), b0 = vtr(vb + 4096 + ks * 1024), b1 = vtr(vb + 4096 + ks * 1024 + 512);
        const bf16x8 v0 = (bf16x8){a0[0], a0[1], a0[2], a0[3], a1[0], a1[1], a1[2], a1[3]}, v1 = (bf16x8){b0[0], b0[1], b0[2], b0[3], b1[0], b1[1], b1[2], b1[3]};
        o0 = __builtin_amdgcn_mfma_f32_32x32x16_bf16(v0, pf[ks], o0, 0, 0, 0);
        o1 = __builtin_amdgcn_mfma_f32_32x32x16_bf16(v1, pf[ks], o1, 0, 0, 0);
    }
}
constexpr int KP_A = 208, KT_A = 64 * KP_A, VT = 8192, BUF_A = KT_A + VT;
constexpr int KP_R = 144, KT_R = 64 * KP_R, BUF_R = KT_R + VT;
}

#define GSTRIDE(gi, total) for (int gi = bid_ * NT + tid_; gi < (total); gi += G_ * NT)
__device__ __forceinline__ void ph_mod(unsigned char* lds, const float* c, const float* c_ctx, const float* ada_w, const float* ada_b, float* mod) { PH_IDS;
    float (*sl)[1024] = (float (*)[1024])lds;
    float* red = (float*)(lds + 9 * 1024 * 4);
    for (int e = tid_; e < 9 * 1024; e += NT) { const int j = e >> 10, k = e & 1023; const float v = j < 8 ? c[j * 1024 + k] : c_ctx[k]; sl[j][k] = siluf_(v); }
    __syncthreads();
    const int nn = tid_ & 63, ks = tid_ >> 6;
    for (int u = bid_; u < 2 * 96; u += G_) {
        const int l = u / 96, n = (u % 96) * 64 + nn;
        float acc[9];
#pragma unroll
        for (int j = 0; j < 9; ++j) acc[j] = 0.f;
        const float* w = ada_w + ((size_t)l * 1024 + ks * 128) * 6144 + n;
#pragma unroll 4
        for (int k = 0; k < 128; ++k) { const float wv = w[(size_t)k * 6144];
#pragma unroll
            for (int j = 0; j < 9; ++j) acc[j] += sl[j][ks * 128 + k] * wv; }
        __syncthreads();
#pragma unroll
        for (int j = 0; j < 9; ++j) red[(ks * 9 + j) * 64 + nn] = acc[j];
        __syncthreads();
        for (int e = tid_; e < 9 * 64; e += NT) { const int j = e >> 6, q = e & 63; float sum = 0.f;
#pragma unroll
            for (int r = 0; r < 8; ++r) sum += red[(r * 9 + j) * 64 + q];
            const int col = (u % 96) * 64 + q; mod[((size_t)l * 9 + j) * 6144 + col] = sum + ada_b[l * 6144 + col]; }
    }
    __syncthreads();
}
__device__ __forceinline__ void ph_trig(float* trig, bf16_t* d64) { PH_IDS; GSTRIDE(i, 2048) { const float xx = (float)i * (1.f / 1024.f); trig[i] = cospif(xx); trig[2048 + i] = sinpif(xx); }
    GSTRIDE(i, 128 * 64) { const int n = i >> 6, c = i & 63, m = n & 63; const float xx = (float)((m * c) & 63) * (1.f / 32.f); d64[i] = f2bf(n < 64 ? cospif(xx) : sinpif(xx)); } }
__device__ __forceinline__ double2 lam_pow(double re, double im, double dt, int k) {
    const double m = (double)__expf((float)(re * dt * k));
    double xx = im * dt * (double)k * 0.318309886183790671538;
    xx -= 2.0 * rint(xx * 0.5);
    const float xf = (float)xx;
    return make_double2(m * (double)cospif(xf), m * (double)sinpif(xf));
}
__device__ __forceinline__ void ph_s5_lp(int l, const float* lam_re, const float* lam_im, const float* log_step, const float* b_re, const float* b_im, float2* LP, float2* BB, float* lamT) { PH_IDS;
    GSTRIDE(it, 2 * 16 * 64 * 81) {
        const int i = it / 81, k = it % 81;
        const int d = i / 1024, g = (i / 64) % 16, p = i % 64;
        const size_t li = ((size_t)(l * 2 + d) * 16 + g) * 64 + p;
        const double re = lam_re[li], im = lam_im[li], dt = (double)expf(log_step[(l * 2 + d) * 16 + g]);
        if (k <= 64) {
            const double2 v = lam_pow(re, im, dt, k); LP[(size_t)i * 65 + k] = make_float2((float)v.x, (float)v.y);
            if (k == 64) { lamT[((size_t)(g * 2 + d) * 64 + p) * 2 + 0] = (float)v.x; lamT[((size_t)(g * 2 + d) * 64 + p) * 2 + 1] = (float)v.y; }
        } else {
            const int h = k - 65;
            const double2 l1 = lam_pow(re, im, dt, 1);
            const double nr = l1.x - 1.0, ni = l1.y, den = re * re + im * im;
            const double fr = (nr * re + ni * im) / den, fi = (ni * re - nr * im) / den;
            const double br = b_re[li * 16 + h], bi = b_im[li * 16 + h]; BB[(size_t)i * 16 + h] = make_float2((float)(fr * br - fi * bi), (float)(fr * bi + fi * br));
        }
    }
}
__device__ __forceinline__ void ph_s5_tz(unsigned char* lds_, int l, const float2* LP, const float2* BB, const float* c_re, const float* c_im, float* TZD) { PH_IDS;
    float2* sC = (float2*)lds_;
    float2* sL = sC + 16 * 64;
    float2* sB = sL + 64 * 65;
    for (int u = bid_; u < 32; u += G_) {
        const int g = u >> 1, d = u & 1;
        __syncthreads();
        for (int e = tid_; e < 16 * 64; e += NT) { const size_t ci = (((size_t)(l * 2 + d) * 16 + g) * 16) * 64 + e; sC[e] = make_float2(c_re[ci], c_im[ci]); }
        for (int e = tid_; e < 64 * 65; e += NT) sL[e] = LP[((size_t)d * 16 + g) * 64 * 65 + e];
        for (int e = tid_; e < 64 * 16; e += NT) sB[e] = BB[((size_t)d * 16 + g) * 64 * 16 + e];
        __syncthreads();
#pragma unroll 1
        for (int i = 0; i < 2; ++i) {
            const int r = tid_ + NT * i, tau = r >> 4, h = r & 15;
            float acc[16];
#pragma unroll
            for (int q = 0; q < 16; ++q) acc[q] = 0.f;
            for (int p = 0; p < 64; ++p) {
                const float2 c = sC[h * 64 + p], lp = sL[p * 65 + tau];
                const float er = c.x * lp.x - c.y * lp.y, ei = c.x * lp.y + c.y * lp.x;
#pragma unroll
                for (int q = 0; q < 16; ++q) { const float2 bb = sB[p * 16 + q]; acc[q] += er * bb.x - ei * bb.y; }
            }
            float* o = TZD + ((((size_t)d * 16 + g) * 64 + tau) * 16 + h) * 16;
#pragma unroll
            for (int q = 0; q < 4; ++q) *(f32x4*)(o + 4 * q) = (f32x4){acc[4 * q], acc[4 * q + 1], acc[4 * q + 2], acc[4 * q + 3]};
        }
    }
    __syncthreads();
}
__device__ __forceinline__ void ph_s5_ms(const float2* LP, const float2* BB, bf16_t* MST) { PH_IDS;
    GSTRIDE(i, 16 * 256 * 128) {
        const int g = i / (256 * 128), n = (i / 128) % 256, sh0 = (i % 128) * 8, d = n >> 7, p = n & 63, im = (n >> 6) & 1, s = sh0 >> 4, hp0 = sh0 & 15;
        const size_t gi = ((size_t)d * 16 + g) * 64 + p;
        const float2 lp = LP[gi * 65 + (d == 0 ? 63 - s : s)];
        float v[8];
#pragma unroll
        for (int q = 0; q < 8; ++q) { const float2 bb = BB[gi * 16 + hp0 + q]; v[q] = im ? lp.x * bb.y + lp.y * bb.x : lp.x * bb.x - lp.y * bb.y; }
        *(pg8::u32x4*)(MST + ((size_t)g * 256 + n) * 1024 + sh0) = pack8((f32x4){v[0], v[1], v[2], v[3]}, (f32x4){v[4], v[5], v[6], v[7]});
    }
}
__device__ __forceinline__ void ph_s5_qo(int l, const float2* LP, const float* c_re, const float* c_im, bf16_t* QOT) { PH_IDS;
    GSTRIDE(i, 16 * 1024 * 32) {
        const int g = i / (1024 * 32), th = (i / 32) % 1024, j0 = (i % 32) * 8, d = j0 >> 7, im = (j0 >> 6) & 1, p0 = j0 & 63, t = th >> 4, h = th & 15;
        const size_t ci = (((size_t)(l * 2 + d) * 16 + g) * 16 + h) * 64 + p0;
        const int e = d == 0 ? t + 1 : 64 - t;
        float v[8];
#pragma unroll
        for (int q = 0; q < 8; ++q) { const float cr = c_re[ci + q], cim = c_im[ci + q]; const float2 lp = LP[(((size_t)d * 16 + g) * 64 + p0 + q) * 65 + e]; v[q] = im ? -(cr * lp.y + cim * lp.x) : cr * lp.x - cim * lp.y; }
        *(pg8::u32x4*)(QOT + ((size_t)g * 1024 + th) * 256 + j0) = pack8((f32x4){v[0], v[1], v[2], v[3]}, (f32x4){v[4], v[5], v[6], v[7]});
    }
}
__device__ __forceinline__ void ph_adarms(const float* xlat, const float* xctx, const float* w, const float* mod, int sh_chunk, int sc_chunk, bf16_t* out, int nrows) { PH_IDS;
    const int wave = (bid_ * NT + tid_) >> 6, lane = tid_ & 63, nw = (G_ * NT) >> 6;
    for (int row = wave; row < nrows; row += nw) {
        const float* x = row < RL ? xlat + (size_t)row * DM : xctx + (size_t)(row - RL) * DM;
        f32x4 v[4]; float ss = 0.f;
#pragma unroll
        for (int j = 0; j < 4; ++j) { v[j] = *(const f32x4*)(x + j * 256 + lane * 4); ss += v[j][0] * v[j][0] + v[j][1] * v[j][1] + v[j][2] * v[j][2] + v[j][3] * v[j][3]; }
#pragma unroll
        for (int o = 1; o < 64; o <<= 1) ss += __shfl_xor(ss, o);
        const float rstd = rsqrtf(ss * (1.f / DM) + EPS);
        const float* mrow = mod + (size_t)row_modidx(row) * 6144;
#pragma unroll
        for (int j = 0; j < 4; ++j) { const int c0 = j * 256 + lane * 4;
            const f32x4 wv = *(const f32x4*)(w + c0), sc = *(const f32x4*)(mrow + sc_chunk * 1024 + c0), sh = *(const f32x4*)(mrow + sh_chunk * 1024 + c0);
            const f32x4 y = v[j] * rstd * wv * (sc + 1.f) + sh;
            fa::u32x2 o; o.x = fa::pk2(y[0], y[1]); o.y = fa::pk2(y[2], y[3]);
            *(fa::u32x2*)(out + (size_t)row * DM + c0) = o; }
    }
}
__device__ __forceinline__ void ph_mla_stats(const bf16_t* Z, float* rs) { PH_IDS;
    const int wave = (bid_ * NT + tid_) >> 6, lane = tid_ & 63, nw = (G_ * NT) >> 6;
    for (int row = wave; row < RT; row += nw) {
        const bf16_t* z = Z + (size_t)row * ZW; float sq = 0.f, sk = 0.f;
#pragma unroll
        for (int j = 0; j < 4; ++j) { const float v = bf2f(z[C_QC + j * 64 + lane]); sq += v * v; }
#pragma unroll
        for (int j = 0; j < 2; ++j) { const float v = bf2f(z[C_KVC + j * 64 + lane]); sk += v * v; }
#pragma unroll
        for (int o = 1; o < 64; o <<= 1) { sq += __shfl_xor(sq, o); sk += __shfl_xor(sk, o); }
        if (lane == 0) { rs[(size_t)row * 2] = rsqrtf(sq * (1.f / 256) + EPS); rs[(size_t)row * 2 + 1] = rsqrtf(sk * (1.f / 128) + EPS); }
    }
}
__device__ __forceinline__ void ph_mla_post(const bf16_t* Z, const bf16_t* qraw, const bf16_t* kvraw, const float* qkq, const float* qkk, bf16_t* Q, bf16_t* Kb, bf16_t* Vb) { PH_IDS;
    GSTRIDE(gi, RT * 8) {
        const int row = gi >> 3, h = (gi >> 1) & 3, isk = gi & 1;
        const bool lat = row < RL; const int b = row_batch(row), t = lat ? (row & 2047) : ((row - RL) & 255);
        const int qi = lat ? t : 2048 + t, ki = lat ? 256 + t : t;
        float v[96];
        float ss = 0.f;
        if (!isk) {
#pragma unroll
            for (int i = 0; i < 96; ++i) v[i] = bf2f(qraw[(size_t)row * 384 + h * 96 + i]);
        } else {
#pragma unroll
            for (int i = 0; i < 64; ++i) v[i] = bf2f(kvraw[(size_t)row * 512 + h * 128 + i]);
#pragma unroll
            for (int i = 0; i < 32; ++i) v[64 + i] = bf2f(Z[(size_t)row * ZW + C_KR + i]);
        }
#pragma unroll
        for (int i = 0; i < 96; ++i) ss += v[i] * v[i];
        const float rr = rsqrtf(ss * (1.f / 96) + EPS) * (isk ? 1.f : 0.14724727430627066f);
        const float* wv = isk ? qkk : qkq;
#pragma unroll
        for (int i = 0; i < 96; ++i) v[i] = v[i] * rr * wv[i];
        if (lat) {
            const float prow = (float)(t >> 6), pcol = (float)(t & 63);
#pragma unroll
            for (int part = 0; part < 2; ++part) { const float pos = part ? pcol : prow; const int base = 64 + part * 16;
#pragma unroll
                for (int j = 0; j < 8; ++j) { const float fr = exp2f(-(float)j * (13.287712379549449f / 8.f)), a = pos * fr, cs = __cosf(a), sn = __sinf(a);
                    const float x1 = v[base + j], x2 = v[base + 8 + j]; v[base + j] = x1 * cs - x2 * sn; v[base + 8 + j] = x1 * sn + x2 * cs; } }
        }
        bf16_t* o = isk ? Kb + ((size_t)(b * 4 + h) * 2304 + ki) * 96 : Q + ((size_t)(b * 4 + h) * 2304 + qi) * 96;
#pragma unroll
        for (int i = 0; i < 96; ++i) o[i] = f2bf(v[i]);
        if (isk) { bf16_t* vo = Vb + ((size_t)(b * 4 + h) * 2304 + ki) * 64; for (int i = 0; i < 64; ++i) vo[i] = kvraw[(size_t)row * 512 + h * 128 + 64 + i]; }
    }
}
__device__ __forceinline__ void ph_attn(unsigned char* lds, const bf16_t* Q, const bf16_t* Kb, const bf16_t* Vb, bf16_t* Z, int with_ctx) { PH_IDS;
    float (*sK)[96] = (float (*)[96])lds; float (*sV)[64] = (float (*)[64])(lds + 32 * 96 * 4);
    const int nunits = 32 * (8 + (with_ctx ? 1 : 0));
    const int qt = tid_ & 255, dh = (tid_ >> 8) * 32;
    for (int u = bid_; u < nunits; u += G_) {
        const int bh = u % 32, qb = u / 32;
        const bool lat = qb < 8;
        const int qi = qb * 256 + qt, nkeys = lat ? 2304 : 256;
        float q[96], o[32];
        const bf16_t* qp = Q + ((size_t)bh * 2304 + qi) * 96;
#pragma unroll
        for (int i = 0; i < 96; ++i) q[i] = bf2f(qp[i]) * 0.10206207261596577f;
#pragma unroll
        for (int i = 0; i < 32; ++i) o[i] = 0.f;
        float mx = -1e30f, l = 0.f;
        for (int k0 = 0; k0 < nkeys; k0 += 32) {
            __syncthreads();
            for (int e = tid_; e < 32 * 96; e += NT) sK[e / 96][e % 96] = bf2f(Kb[((size_t)bh * 2304 + k0) * 96 + e]);
            for (int e = tid_; e < 32 * 64; e += NT) sV[e / 64][e % 64] = bf2f(Vb[((size_t)bh * 2304 + k0) * 64 + e]);
            __syncthreads();
#pragma unroll 1
            for (int j = 0; j < 32; ++j) { float a = 0.f;
#pragma unroll
                for (int i = 0; i < 96; ++i) a += q[i] * sK[j][i];
                if (a > mx) { const float corr = __expf(mx - a); mx = a; l *= corr;
#pragma unroll
                    for (int i = 0; i < 32; ++i) o[i] *= corr; }
                const float p = __expf(a - mx); l += p;
#pragma unroll
                for (int i = 0; i < 32; ++i) o[i] += p * sV[j][dh + i]; }
        }
        const int b = bh >> 2, h = bh & 3;
        const int row = lat ? b * 2048 + qi : RL + b * 256 + (qi - 2048);
        const float inv = 1.f / l;
#pragma unroll
        for (int i = 0; i < 32; ++i) Z[(size_t)row * ZW + C_QC + h * 64 + dh + i] = f2bf(o[i] * inv);
    }
    __syncthreads();
}
__device__ __forceinline__ void ph_f1(const bf16_t* Z, const float* trig, bf16_t* F1lat, bf16_t* F1ctx) { PH_IDS;
    GSTRIDE(gi, RT * 256) {
        const int row = gi >> 8, gm = gi & 255, g = gm >> 6, m = gm & 63;
        float a = 0.f, bsum = 0.f;
        const bf16_t* u = Z + (size_t)row * ZW + C_FU + g * 64;
        for (int c = 0; c < 64; ++c) { const float v = bf2f(u[c]); const int idx = ((m * c) & 63) * 32; a += v * trig[idx]; bsum += v * trig[2048 + idx]; }
        if (row < RL) { const int b = row >> 11, t = row & 2047; bf16_t* o = F1lat + ((size_t)(b * 256 + gm) * 2) * 2048; o[t] = f2bf(a); o[2048 + t] = f2bf(bsum); }
        else { const int r = row - RL, b = r >> 8, t = r & 255; bf16_t* o = F1ctx + ((size_t)(b * 256 + gm) * 2) * 256; o[t] = f2bf(a); o[256 + t] = f2bf(bsum); }
    }
}
struct A_dft { const float* trig; long long L; long long mul;
    __device__ float operator()(int, int k, int kk) const { const int part = kk >= (int)L, t = part ? kk - (int)L : kk; const int idx = (int)(((long long)k * t) & (L - 1)) * (int)mul; return part ? -trig[2048 + idx] : trig[idx]; } };
struct B_f1t { const bf16_t* p; long long L;
    __device__ float operator()(int b, int kk, int n) const { return bf2f(p[((size_t)(b * 256 + n)) * 2 * L + kk]); } };
struct E_fourier { bf16_t* Z; long long rowbase; long long L; double scale;
    __device__ void operator()(int b, int m, int n, float v) const { Z[((size_t)rowbase + (size_t)b * L + m) * ZW + C_FU + n] = f2bf(v * (float)scale); } };

struct A_s5u { const bf16_t* Z;
    __device__ float operator()(int g, int rc, int k) const { return bf2f(Z[((size_t)rc * 64 + (k >> 4)) * ZW + C_S5 + g * 16 + (k & 15)]); } };
struct B_ms { const bf16_t* MS; __device__ float operator()(int g, int k, int n) const { return bf2f(MS[((size_t)g * 1024 + k) * 256 + n]); } };
struct E_sloc { float* S; __device__ void operator()(int g, int rc, int n, float v) const { S[((size_t)rc * 16 + g) * 256 + n] = v; } };
__device__ __forceinline__ void ph_s5_scan(const float* SLOC, const float* lamT, float* XP) { PH_IDS;
    GSTRIDE(i, 8 * 16 * 2 * 64) {
        const int b = i / 2048, g = (i / 128) % 16, d = (i / 64) % 2, p = i % 64;
        const float lr = lamT[((size_t)(g * 2 + d) * 64 + p) * 2], li = lamT[((size_t)(g * 2 + d) * 64 + p) * 2 + 1];
        float xr = 0.f, xi = 0.f;
        for (int step = 0; step < 36; ++step) {
            int rc;
            if (d == 0) rc = step < 4 ? 256 + b * 4 + step : b * 32 + (step - 4);
            else rc = step < 4 ? 256 + b * 4 + (3 - step) : b * 32 + (31 - (step - 4));
            const size_t o = ((size_t)rc * 16 + g) * 256 + d * 128;
            XP[o + p] = xr; XP[o + 64 + p] = xi;
            const float sr = SLOC[o + p], si = SLOC[o + 64 + p];
            const float nr = lr * xr - li * xi + sr, ni = lr * xi + li * xr + si; xr = nr; xi = ni;
        }
    }
}
struct A_s5out { const bf16_t* Z; const float* XP;
    __device__ float operator()(int g, int rc, int k) const { return k < 1024 ? bf2f(Z[((size_t)rc * 64 + (k >> 4)) * ZW + C_S5 + g * 16 + (k & 15)]) : XP[((size_t)rc * 16 + g) * 256 + (k - 1024)]; } };
struct B_s5out { const float* TZ; const bf16_t* QO;
    __device__ float operator()(int g, int k, int n) const { if (k < 1024) { const int s = k >> 4, hp = k & 15, t = n >> 4, h = n & 15; return TZ[(((size_t)g * 127 + (t - s + 63)) * 16 + hp) * 16 + h]; } return bf2f(QO[((size_t)g * 256 + (k - 1024)) * 1024 + n]); } };
struct E_s5out { bf16_t* YG; __device__ void operator()(int g, int rc, int n, float v) const { YG[((size_t)rc * 64 + (n >> 4)) * 256 + g * 16 + (n & 15)] = f2bf(geluf_(v)); } };
__device__ __forceinline__ void ph_glu(const bf16_t* GL, bf16_t* Z) { PH_IDS;
    GSTRIDE(gi, RT * 256) {
        const int row = gi >> 8, j = gi & 255;
        const float val = bf2f(GL[(size_t)row * 512 + j]), gate = bf2f(GL[(size_t)row * 512 + 256 + j]);
        Z[(size_t)row * ZW + C_S5 + j] = f2bf(val * sigmoidf_(gate));
    }
}
__device__ __forceinline__ void ph_ret_prep(bf16_t* Z) { PH_IDS;
    GSTRIDE(gi, RT * 4 * 32) {
        const int row = gi >> 7, h = (gi >> 5) & 3, j = gi & 31;
        bf16_t* z = Z + (size_t)row * ZW;
        if (row < RL) {
            const int t = row & 2047; const float fr = exp2f(-(float)j * (13.287712379549449f / 32.f)), a = (float)t * fr, cs = cosf(a), sn = sinf(a);
            { const float x1 = bf2f(z[C_RQ + h * 64 + j]), x2 = bf2f(z[C_RQ + h * 64 + 32 + j]); z[C_RQ + h * 64 + j] = f2bf(x1 * cs - x2 * sn); z[C_RQ + h * 64 + 32 + j] = f2bf(x1 * sn + x2 * cs); }
            { const float x1 = bf2f(z[C_RK + h * 64 + j]), x2 = bf2f(z[C_RK + h * 64 + 32 + j]); z[C_RK + h * 64 + j] = f2bf((x1 * cs - x2 * sn) * 0.125f); z[C_RK + h * 64 + 32 + j] = f2bf((x1 * sn + x2 * cs) * 0.125f); }
        } else {
            z[C_RK + h * 64 + j] = f2bf(bf2f(z[C_RK + h * 64 + j]) * 0.125f); z[C_RK + h * 64 + 32 + j] = f2bf(bf2f(z[C_RK + h * 64 + 32 + j]) * 0.125f);
        }
    }
}
__device__ __forceinline__ void ph_ret(unsigned char* lds, bf16_t* Z, const float* decay_logit, const float* gn_w, int with_ctx) { PH_IDS;
    float (*sK)[64] = (float (*)[64])lds; float (*sV)[64] = (float (*)[64])(lds + 32 * 64 * 4);
    float* sred = (float*)(lds + 2 * 32 * 64 * 4);
    const int nunits = 32 * (8 + (with_ctx ? 1 : 0));
    const int qt = tid_ & 255, hh = tid_ >> 8, dh = hh * 32;
    for (int u = bid_; u < nunits; u += G_) {
        const int bh = u % 32, qb = u / 32, b = bh >> 2, h = bh & 3;
        const bool lat = qb < 8;
        const int qpos = lat ? qb * 256 + qt : qt;
        const int qrow = lat ? b * 2048 + qpos : RL + b * 256 + qpos;
        const float lgf = -log1pf(__expf(-decay_logit[h])) * 1.4426950408889634f, lgb = -log1pf(__expf(-decay_logit[4 + h])) * 1.4426950408889634f;
        float q[64], o[32];
#pragma unroll
        for (int i = 0; i < 64; ++i) q[i] = bf2f(Z[(size_t)qrow * ZW + C_RQ + h * 64 + i]);
#pragma unroll
        for (int i = 0; i < 32; ++i) o[i] = 0.f;
        const int nkeys = lat ? 2560 : 256;
        for (int k0 = 0; k0 < nkeys; k0 += 32) {
            int krow0, kpos0;
            if (lat) { if (k0 < 256) { krow0 = RL + b * 256 + k0; kpos0 = k0 - 256; } else if (k0 < 2304) { krow0 = b * 2048 + (k0 - 256); kpos0 = k0 - 256; } else { krow0 = RL + b * 256 + (k0 - 2304); kpos0 = 2048 + (k0 - 2304); } }
            else { krow0 = RL + b * 256 + k0; kpos0 = k0; }
            __syncthreads();
            for (int e = tid_; e < 32 * 64; e += NT) { const int j = e >> 6, i = e & 63; sK[j][i] = bf2f(Z[(size_t)(krow0 + j) * ZW + C_RK + h * 64 + i]); sV[j][i] = bf2f(Z[(size_t)(krow0 + j) * ZW + C_RV + h * 64 + i]); }
            __syncthreads();
#pragma unroll 1
            for (int j = 0; j < 32; ++j) { float a = 0.f;
#pragma unroll
                for (int i = 0; i < 64; ++i) a += q[i] * sK[j][i];
                const int dpos = qpos - (kpos0 + j);
                const float dec = dpos > 0 ? exp2f(lgf * (float)dpos) : (dpos < 0 ? exp2f(lgb * (float)(-dpos)) : 2.f);
                a *= dec;
#pragma unroll
                for (int i = 0; i < 32; ++i) o[i] += a * sV[j][dh + i]; }
        }
        float s1 = 0.f;
#pragma unroll
        for (int i = 0; i < 32; ++i) s1 += o[i];
        __syncthreads();
        sred[hh * 256 + qt] = s1;
        __syncthreads();
        const float mu = (sred[qt] + sred[256 + qt]) * (1.f / 64);
        float s2 = 0.f;
#pragma unroll
        for (int i = 0; i < 32; ++i) { const float d = o[i] - mu; s2 += d * d; }
        __syncthreads();
        sred[hh * 256 + qt] = s2;
        __syncthreads();
        const float rstd = rsqrtf((sred[qt] + sred[256 + qt]) * (1.f / 64) + EPS);
#pragma unroll
        for (int i = 0; i < 32; ++i) { const float gte = bf2f(Z[(size_t)qrow * ZW + C_RG + h * 64 + dh + i]); const float y = (o[i] - mu) * rstd * gn_w[h * 64 + dh + i];
            Z[(size_t)qrow * ZW + C_RQ + h * 64 + dh + i] = f2bf(siluf_(gte) * y); }
    }
    __syncthreads();
}
struct E_merge { const bf16_t* stash; bf16_t* MMp; long long first;
    __device__ void operator()(int, int m, int n, float v) const { const size_t i = (size_t)m * DM + n; const float t = sigmoidf_(v) * bf2f(stash[i]); MMp[i] = f2bf(first ? t : bf2f(MMp[i]) + t); } };
struct E_resid { const float* xlat; const float* xctx; float* olat; float* octx; const float* mod; long long gchunk;
    __device__ void operator()(int, int m, int n, float v) const {
        const float g = mod[(size_t)row_modidx(m) * 6144 + gchunk * 1024 + n];
        if (m < RL) olat[(size_t)m * DM + n] = xlat[(size_t)m * DM + n] + g * v; else octx[(size_t)(m - RL) * DM + n] = xctx[(size_t)(m - RL) * DM + n] + g * v; } };
struct E_relu2 { bf16_t* H; __device__ void operator()(int, int m, int n, float v) const { const float r = fmaxf(v, 0.f); H[(size_t)m * DFF + n] = f2bf(r * r); } };


__device__ __forceinline__ void ph_s5_sloc(const bf16_t* Z, const bf16_t* MST, float* SLOC) { PH_IDS;
    const int lane = tid_ & 63, wid = __builtin_amdgcn_readfirstlane(tid_ >> 6), c16 = lane & 15, kq = lane >> 4;
    for (int u = bid_; u < 16 * 18; u += G_) {
        const int g = u / 18, rcbase = (u % 18) * 16;
        const bf16_t* up = Z + ((size_t)(rcbase + c16) * 64 + (kq >> 1)) * ZW + C_S5 + g * 16 + 8 * (kq & 1);
        const bf16_t* mp0 = MST + ((size_t)g * 256 + wid * 32 + c16) * 1024 + 8 * kq;
        f32x4 acc0 = (f32x4){0.f, 0.f, 0.f, 0.f}, acc1 = acc0;
#pragma unroll 8
        for (int ks = 0; ks < 32; ++ks) {
            const bf16x8 bfrag = *(const bf16x8*)(up + (size_t)(2 * ks) * ZW);
            const bf16x8 a0 = *(const bf16x8*)(mp0 + 32 * ks), a1 = *(const bf16x8*)(mp0 + 16 * 1024 + 32 * ks);
            acc0 = __builtin_amdgcn_mfma_f32_16x16x32_bf16(a0, bfrag, acc0, 0, 0, 0);
            acc1 = __builtin_amdgcn_mfma_f32_16x16x32_bf16(a1, bfrag, acc1, 0, 0, 0);
        }
        float* op = SLOC + ((size_t)(rcbase + c16) * 16 + g) * 256 + wid * 32 + 4 * kq;
        *(f32x4*)op = acc0; *(f32x4*)(op + 16) = acc1;
    }
}
__device__ __forceinline__ void ph_s5_out(unsigned char* lds_, const bf16_t* Z, const float* TZD, const float* s5d, const bf16_t* QOT, const float* SLOC, const float* lamT, bf16_t* YG, int nrct) { PH_IDS;
    LAS char* sm = (LAS char*)lds_;
    constexpr int O_TZ = 0, O_XP = 65536, O_U = 73728, UP = 2064, O_SL = O_U + 16 * UP;
    const int lane = tid_ & 63, wid = __builtin_amdgcn_readfirstlane(tid_ >> 6), c16 = lane & 15, kq = lane >> 4;
    for (int u = bid_; u < 16 * nrct; u += G_) {
        const int g = u / nrct, rct = u % nrct, rcbase = rct * 16;
        const bool lat = rct < 16; const int b = rcbase >> 5, c0 = rcbase & 31;
        __syncthreads();
        for (int e = tid_; e < 127 * 64; e += NT) { const int dd = e >> 6, h = (e >> 2) & 15, q4 = (e & 3) * 4;
            const float* tf = TZD + ((((size_t)0 * 16 + g) * 64 + (dd >= 63 ? dd - 63 : 0)) * 16 + h) * 16 + q4; const float* tb = TZD + ((((size_t)1 * 16 + g) * 64 + (dd <= 63 ? 63 - dd : 0)) * 16 + h) * 16 + q4;
            f32x4 v = (f32x4){0.f, 0.f, 0.f, 0.f};
            if (dd >= 63) v += *(const f32x4*)tf;
            if (dd <= 63) v += *(const f32x4*)tb;
            if (dd == 63 && (h >> 2) == (q4 >> 2)) v[h & 3] += s5d[g * 16 + h];
            fa::u32x2 w; w.x = fa::pk2(v[0], v[1]); w.y = fa::pk2(v[2], v[3]);
            *(LAS fa::u32x2*)(sm + O_TZ + (dd * 16 + h) * 32 + q4 * 2) = w; }
        for (int e = tid_; e < 16 * 128; e += NT) { const int rc = e >> 7, s = (e >> 1) & 63, hh = e & 1;
            *(LAS fa::u32x4*)(sm + O_U + rc * UP + s * 32 + hh * 16) = *(const fa::u32x4*)(Z + ((size_t)(rcbase + rc) * 64 + s) * ZW + C_S5 + g * 16 + hh * 8); }
        const int nsl = lat ? 36 : 16;
        for (int e = tid_; e < nsl * 64; e += NT) { const int r = e >> 6, q4 = e & 63; const int rc = lat ? (r < 4 ? 256 + b * 4 + r : b * 32 + (r - 4)) : rcbase + r;
            *(LAS f32x4*)(sm + O_SL + r * 1024 + q4 * 16) = *(const f32x4*)(SLOC + ((size_t)rc * 16 + g) * 256 + q4 * 4); }
        __syncthreads();
        if (tid_ < 128) {
            const int d = tid_ >> 6, p = tid_ & 63;
            const float lr = lamT[((size_t)(g * 2 + d) * 64 + p) * 2], li = lamT[((size_t)(g * 2 + d) * 64 + p) * 2 + 1];
            const LAS float* sl = (const LAS float*)(sm + O_SL) + d * 128 + p;
            LAS bf16_t* xp = (LAS bf16_t*)(sm + O_XP) + d * 128 + p;
            float xr = 0.f, xi = 0.f;
#define S5_STEP(r) do { const float sr = sl[(r) * 256], si = sl[(r) * 256 + 64]; const float nr = lr * xr - li * xi + sr, ni = lr * xi + li * xr + si; xr = nr; xi = ni; } while (0)
            if (lat) {
                if (d == 0) { for (int r = 0; r < 4 + c0; ++r) S5_STEP(r);
                    for (int r = 0; r < 16; ++r) { xp[r * 256] = f2bf(xr); xp[r * 256 + 64] = f2bf(xi); S5_STEP(4 + c0 + r); } }
                else { for (int r = 3; r >= 0; --r) S5_STEP(r);
                    for (int c = 31; c >= c0 + 16; --c) S5_STEP(4 + c);
                    for (int r = 15; r >= 0; --r) { xp[r * 256] = f2bf(xr); xp[r * 256 + 64] = f2bf(xi); S5_STEP(4 + c0 + r); } }
            } else {
                if (d == 0) { for (int r = 0; r < 16; ++r) { if ((r & 3) == 0) { xr = 0.f; xi = 0.f; } xp[r * 256] = f2bf(xr); xp[r * 256 + 64] = f2bf(xi); S5_STEP(r); } }
                else { for (int r = 15; r >= 0; --r) { if ((r & 3) == 3) { xr = 0.f; xi = 0.f; } xp[r * 256] = f2bf(xr); xp[r * 256 + 64] = f2bf(xi); S5_STEP(r); } }
            }
#undef S5_STEP
        }
        __syncthreads();
        const LAS char* ub = sm + O_U + c16 * UP + kq * 16;
        const LAS char* xb = sm + O_XP + c16 * 512 + kq * 16;
#pragma unroll 1
        for (int i = 0; i < 8; ++i) {
            const int t = wid * 8 + i;
            f32x4 acc = (f32x4){0.f, 0.f, 0.f, 0.f};
            const LAS char* tz = sm + O_TZ + ((t + 63 - (kq >> 1)) * 16 + c16) * 32 + (kq & 1) * 16;
#pragma unroll 8
            for (int ks = 0; ks < 32; ++ks) {
                const bf16x8 a = *(const LAS bf16x8*)(tz - ks * 1024), bq = *(const LAS bf16x8*)(ub + ks * 64);
                acc = __builtin_amdgcn_mfma_f32_16x16x32_bf16(a, bq, acc, 0, 0, 0);
            }
            const bf16_t* qo = QOT + ((size_t)g * 1024 + t * 16 + c16) * 256 + 8 * kq;
#pragma unroll
            for (int ks = 0; ks < 8; ++ks) {
                const bf16x8 a = *(const bf16x8*)(qo + 32 * ks), bq = *(const LAS bf16x8*)(xb + ks * 64);
                acc = __builtin_amdgcn_mfma_f32_16x16x32_bf16(a, bq, acc, 0, 0, 0);
            }
            fa::u32x2 w; w.x = fa::pk2(geluf_(acc[0]), geluf_(acc[1])); w.y = fa::pk2(geluf_(acc[2]), geluf_(acc[3]));
            *(fa::u32x2*)(YG + ((size_t)(rcbase + c16) * 64 + t) * ZW + C_S5 + g * 16 + 4 * kq) = w;
        }
    }
    __syncthreads();
}
__device__ __forceinline__ void rope16(float (&v)[4], int kq, float pos, bool on) {
#pragma unroll
    for (int r = 0; r < 4; ++r) {
        const int j = (4 * kq + r) & 7;
        const float ang = pos * exp2f(-(float)j * (13.287712379549449f / 8.f)), cs = __cosf(ang), sn = __sinf(ang);
        const float other = __shfl_xor(v[r], 32);
        const float rot = kq < 2 ? v[r] * cs - other * sn : other * sn + v[r] * cs;
        v[r] = on ? rot : v[r];
    }
}
__device__ __forceinline__ void ph_prep(bf16_t* Z, const bf16_t* WUQ, const bf16_t* WUKV, const bf16_t* D64, const float* qkq, const float* qkk,
                                        bf16_t* Q, bf16_t* Kb, bf16_t* Vb, bf16_t* F1lat, bf16_t* F1ctx) { PH_IDS;
    const int lane = tid_ & 63, wid = __builtin_amdgcn_readfirstlane(tid_ >> 6), c16 = lane & 15, kq = lane >> 4;
    for (int blk = bid_; blk < RT / 72; blk += G_) {
        const int row0 = blk * 72;
#pragma unroll 1
      for (int pass3 = 0; pass3 < 2; ++pass3) {
        int rowc[3]; bool valid[3];
#pragma unroll
        for (int tt = 0; tt < 3; ++tt) { const int o = 16 * (3 * pass3 + tt) + c16; valid[tt] = o < 72; rowc[tt] = row0 + (valid[tt] ? o : 71); }
        if (wid < 4) {
            const int h = wid;
            f32x4 acc[6][3]; float ssq[3];
#pragma unroll
            for (int tt = 0; tt < 3; ++tt) { ssq[tt] = 0.f;
#pragma unroll
                for (int nt = 0; nt < 6; ++nt) acc[nt][tt] = (f32x4){0.f, 0.f, 0.f, 0.f}; }
#pragma unroll 1
            for (int ks = 0; ks < 8; ++ks) {
                bf16x8 bq[3], aw[6];
#pragma unroll
                for (int tt = 0; tt < 3; ++tt) { bq[tt] = *(const bf16x8*)(Z + (size_t)rowc[tt] * ZW + C_QC + 32 * ks + 8 * kq);
#pragma unroll
                    for (int e = 0; e < 8; ++e) { const float f = bf2f((bf16_t)bq[tt][e]); ssq[tt] += f * f; } }
#pragma unroll
                for (int nt = 0; nt < 6; ++nt) aw[nt] = *(const bf16x8*)(WUQ + (size_t)(h * 96 + 16 * nt + c16) * 256 + 32 * ks + 8 * kq);
#pragma unroll
                for (int nt = 0; nt < 6; ++nt)
#pragma unroll
                    for (int tt = 0; tt < 3; ++tt) acc[nt][tt] = __builtin_amdgcn_mfma_f32_16x16x32_bf16(aw[nt], bq[tt], acc[nt][tt], 0, 0, 0);
            }
#pragma unroll
            for (int tt = 0; tt < 3; ++tt) {
                float s1 = ssq[tt]; s1 += __shfl_xor(s1, 16); s1 += __shfl_xor(s1, 32);
                const float rstd = rsqrtf(s1 * (1.f / 256) + EPS);
                float ss = 0.f;
#pragma unroll
                for (int nt = 0; nt < 6; ++nt)
#pragma unroll
                    for (int r = 0; r < 4; ++r) ss += acc[nt][tt][r] * acc[nt][tt][r];
                ss += __shfl_xor(ss, 16); ss += __shfl_xor(ss, 32);
                const float fac = rstd * rsqrtf(rstd * rstd * ss * (1.f / 96) + EPS) * 0.14724727430627066f;
                const int row = rowc[tt]; const bool lat = row < RL; const int b = row_batch(row), t = lat ? (row & 2047) : ((row - RL) & 255), qi = lat ? t : 2048 + t;
                bf16_t* qo = Q + ((size_t)(b * 4 + h) * 2304 + qi) * 96 + 4 * kq;
#pragma unroll
                for (int nt = 0; nt < 6; ++nt) {
                    const f32x4 w = *(const f32x4*)(qkq + 16 * nt + 4 * kq);
                    float v[4];
#pragma unroll
                    for (int r = 0; r < 4; ++r) v[r] = acc[nt][tt][r] * fac * w[r];
                    if (nt >= 4) rope16(v, kq, nt == 4 ? (float)(t >> 6) : (float)(t & 63), lat);
                    fa::u32x2 o; o.x = fa::pk2(v[0], v[1]); o.y = fa::pk2(v[2], v[3]);
                    if (valid[tt]) *(fa::u32x2*)(qo + 16 * nt) = o;
                }
            }
        } else {
            const int h = wid - 4;
            float ssq[3], rstd[3];
#pragma unroll
            for (int tt = 0; tt < 3; ++tt) ssq[tt] = 0.f;
#pragma unroll 1
            for (int pass = 0; pass < 2; ++pass) {
                f32x4 acc[4][3];
#pragma unroll
                for (int tt = 0; tt < 3; ++tt)
#pragma unroll
                    for (int nt = 0; nt < 4; ++nt) acc[nt][tt] = (f32x4){0.f, 0.f, 0.f, 0.f};
#pragma unroll 1
                for (int ks = 0; ks < 4; ++ks) {
                    bf16x8 bq[3], aw[4];
#pragma unroll
                    for (int tt = 0; tt < 3; ++tt) { bq[tt] = *(const bf16x8*)(Z + (size_t)rowc[tt] * ZW + C_KVC + 32 * ks + 8 * kq);
                        if (pass == 0) {
#pragma unroll
                            for (int e = 0; e < 8; ++e) { const float f = bf2f((bf16_t)bq[tt][e]); ssq[tt] += f * f; } } }
#pragma unroll
                    for (int nt = 0; nt < 4; ++nt) aw[nt] = *(const bf16x8*)(WUKV + (size_t)(h * 128 + pass * 64 + 16 * nt + c16) * 128 + 32 * ks + 8 * kq);
#pragma unroll
                    for (int nt = 0; nt < 4; ++nt)
#pragma unroll
                        for (int tt = 0; tt < 3; ++tt) acc[nt][tt] = __builtin_amdgcn_mfma_f32_16x16x32_bf16(aw[nt], bq[tt], acc[nt][tt], 0, 0, 0);
                }
#pragma unroll
                for (int tt = 0; tt < 3; ++tt) {
                    const int row = rowc[tt]; const bool lat = row < RL; const int b = row_batch(row), t = lat ? (row & 2047) : ((row - RL) & 255), ki = lat ? 256 + t : t;
                    if (pass == 0) {
                        float s1 = ssq[tt]; s1 += __shfl_xor(s1, 16); s1 += __shfl_xor(s1, 32);
                        rstd[tt] = rsqrtf(s1 * (1.f / 128) + EPS);
                        float kr[2][4];
#pragma unroll
                        for (int e = 0; e < 2; ++e) { const fa::u32x2 w = *(const fa::u32x2*)(Z + (size_t)row * ZW + C_KR + 16 * e + 4 * kq);
                            kr[e][0] = __uint_as_float(w.x << 16); kr[e][1] = __uint_as_float(w.x & 0xffff0000u); kr[e][2] = __uint_as_float(w.y << 16); kr[e][3] = __uint_as_float(w.y & 0xffff0000u); }
                        float ss = 0.f;
#pragma unroll
                        for (int nt = 0; nt < 4; ++nt)
#pragma unroll
                            for (int r = 0; r < 4; ++r) { acc[nt][tt][r] *= rstd[tt]; ss += acc[nt][tt][r] * acc[nt][tt][r]; }
#pragma unroll
                        for (int e = 0; e < 2; ++e)
#pragma unroll
                            for (int r = 0; r < 4; ++r) ss += kr[e][r] * kr[e][r];
                        ss += __shfl_xor(ss, 16); ss += __shfl_xor(ss, 32);
                        const float fac = rsqrtf(ss * (1.f / 96) + EPS);
                        bf16_t* ko = Kb + ((size_t)(b * 4 + h) * 2304 + ki) * 96 + 4 * kq;
#pragma unroll
                        for (int nt = 0; nt < 6; ++nt) {
                            const f32x4 w = *(const f32x4*)(qkk + 16 * nt + 4 * kq);
                            float v[4];
#pragma unroll
                            for (int r = 0; r < 4; ++r) v[r] = (nt < 4 ? acc[nt < 4 ? nt : 0][tt][r] : kr[nt < 4 ? 0 : nt - 4][r]) * fac * w[r];
                            if (nt >= 4) rope16(v, kq, nt == 4 ? (float)(t >> 6) : (float)(t & 63), lat);
                            fa::u32x2 o; o.x = fa::pk2(v[0], v[1]); o.y = fa::pk2(v[2], v[3]);
                            if (valid[tt]) *(fa::u32x2*)(ko + 16 * nt) = o;
                        }
                    } else {
                        bf16_t* vo = Vb + ((size_t)(b * 4 + h) * 2304 + ki) * 64 + 4 * kq;
#pragma unroll
                        for (int nt = 0; nt < 4; ++nt) { fa::u32x2 o; o.x = fa::pk2(acc[nt][tt][0] * rstd[tt], acc[nt][tt][1] * rstd[tt]); o.y = fa::pk2(acc[nt][tt][2] * rstd[tt], acc[nt][tt][3] * rstd[tt]);
                            if (valid[tt]) *(fa::u32x2*)(vo + 16 * nt) = o; }
                    }
                }
            }
        }
        {
            const int g = wid >> 1, part = wid & 1;
            f32x4 acc[4][3];
#pragma unroll
            for (int tt = 0; tt < 3; ++tt)
#pragma unroll
                for (int nt = 0; nt < 4; ++nt) acc[nt][tt] = (f32x4){0.f, 0.f, 0.f, 0.f};
#pragma unroll
            for (int ks = 0; ks < 2; ++ks) {
                bf16x8 au[3], bd[4];
#pragma unroll
                for (int tt = 0; tt < 3; ++tt) au[tt] = *(const bf16x8*)(Z + (size_t)rowc[tt] * ZW + C_FU + g * 64 + 32 * ks + 8 * kq);
#pragma unroll
                for (int nt = 0; nt < 4; ++nt) bd[nt] = *(const bf16x8*)(D64 + (size_t)(part * 64 + 16 * nt + c16) * 64 + 32 * ks + 8 * kq);
#pragma unroll
                for (int nt = 0; nt < 4; ++nt)
#pragma unroll
                    for (int tt = 0; tt < 3; ++tt) acc[nt][tt] = __builtin_amdgcn_mfma_f32_16x16x32_bf16(au[tt], bd[nt], acc[nt][tt], 0, 0, 0);
            }
#pragma unroll
            for (int tt = 0; tt < 3; ++tt) {
                const int o4 = 16 * (3 * pass3 + tt) + 4 * kq; const int trow = row0 + o4;
                if (o4 < 72) {
                    const bool lat = trow < RL;
#pragma unroll
                    for (int nt = 0; nt < 4; ++nt) {
                        const int gm = g * 64 + 16 * nt + c16;
                        fa::u32x2 o; o.x = fa::pk2(acc[nt][tt][0], acc[nt][tt][1]); o.y = fa::pk2(acc[nt][tt][2], acc[nt][tt][3]);
                        if (lat) { const int b = trow >> 11, t0 = trow & 2047; *(fa::u32x2*)(F1lat + ((size_t)(b * 256 + gm) * 2 + part) * 2048 + t0) = o; }
                        else { const int rr = trow - RL, b = rr >> 8, t0 = rr & 255; *(fa::u32x2*)(F1ctx + ((size_t)(b * 256 + gm) * 2 + part) * 256 + t0) = o; }
                    }
                }
            }
        }
      }
#pragma unroll 1
        for (int it = tid_; it < 72 * 16; it += NT) {
            const int row = row0 + (it >> 4), h = (it >> 2) & 3, jg = it & 3;
            bf16_t* zq = Z + (size_t)row * ZW + C_RQ + h * 64 + 8 * jg; bf16_t* zk = Z + (size_t)row * ZW + C_RK + h * 64 + 8 * jg;
            const fa::u32x4 k1 = *(const fa::u32x4*)zk, k2 = *(const fa::u32x4*)(zk + 32);
            f32x4 ka, kb, kc, kd; unpack8(k1, ka, kb); unpack8(k2, kc, kd);
            if (row < RL) {
                const fa::u32x4 q1 = *(const fa::u32x4*)zq, q2 = *(const fa::u32x4*)(zq + 32);
                f32x4 qa, qb, qc, qd; unpack8(q1, qa, qb); unpack8(q2, qc, qd);
                const float tpos = (float)(row & 2047);
                float x1q[8] = {qa[0], qa[1], qa[2], qa[3], qb[0], qb[1], qb[2], qb[3]}, x2q[8] = {qc[0], qc[1], qc[2], qc[3], qd[0], qd[1], qd[2], qd[3]};
                float x1k[8] = {ka[0], ka[1], ka[2], ka[3], kb[0], kb[1], kb[2], kb[3]}, x2k[8] = {kc[0], kc[1], kc[2], kc[3], kd[0], kd[1], kd[2], kd[3]};
#pragma unroll
                for (int e = 0; e < 8; ++e) {
                    const float ang = tpos * exp2f(-(float)(8 * jg + e) * (13.287712379549449f / 32.f)), cs = cosf(ang), sn = sinf(ang);
                    const float a = x1q[e], c = x2q[e]; x1q[e] = a * cs - c * sn; x2q[e] = a * sn + c * cs;
                    const float a2 = x1k[e], c2 = x2k[e]; x1k[e] = (a2 * cs - c2 * sn) * 0.125f; x2k[e] = (a2 * sn + c2 * cs) * 0.125f;
                }
                *(fa::u32x4*)zq = pack8((f32x4){x1q[0], x1q[1], x1q[2], x1q[3]}, (f32x4){x1q[4], x1q[5], x1q[6], x1q[7]});
                *(fa::u32x4*)(zq + 32) = pack8((f32x4){x2q[0], x2q[1], x2q[2], x2q[3]}, (f32x4){x2q[4], x2q[5], x2q[6], x2q[7]});
                *(fa::u32x4*)zk = pack8((f32x4){x1k[0], x1k[1], x1k[2], x1k[3]}, (f32x4){x1k[4], x1k[5], x1k[6], x1k[7]});
                *(fa::u32x4*)(zk + 32) = pack8((f32x4){x2k[0], x2k[1], x2k[2], x2k[3]}, (f32x4){x2k[4], x2k[5], x2k[6], x2k[7]});
            } else {
                *(fa::u32x4*)zk = pack8(ka * 0.125f, kb * 0.125f); *(fa::u32x4*)(zk + 32) = pack8(kc * 0.125f, kd * 0.125f);
            }
        }
    }
}

__device__ __forceinline__ void ph_attn_mfma(unsigned char* lds_, const bf16_t* Q, const bf16_t* Kb, const bf16_t* Vb, bf16_t* Z, int with_ctx) { PH_IDS;
    using namespace fa;
    LAS char* sm = (LAS char*)lds_;
    const int lane = tid_ & 63, wid = __builtin_amdgcn_readfirstlane(tid_ >> 6), r32 = lane & 31, hi = lane >> 5;
    const int nunits = 256 + (with_ctx ? 32 : 0);
    const int vcu = (bid_ % 8) * (G_ / 8) + bid_ / 8;
    const int koff0 = (tid_ / 12) * KP_A + (tid_ % 12) * 16, koff1 = ((tid_ + 512) / 12) * KP_A + ((tid_ + 512) % 12) * 16;
    const int voff = KT_A + ((tid_ & 7) >> 2) * 4096 + (tid_ >> 3) * 64 + (tid_ & 3) * 16;
    const int vrd = KT_A + ((lane >> 4) & 1) * 32 + (lane & 3) * 8 + (4 * hi + ((lane & 15) >> 2)) * 64;
    for (int u = vcu; u < nunits; u += G_) {
        const bool lat = u < 256; const int bh = lat ? (u >> 3) : (u - 256), qb = lat ? (u & 7) : 8;
        const int ntile = lat ? 36 : 4;
        const char* Kg = (const char*)(Kb + (size_t)bh * 2304 * 96); const char* Vg = (const char*)(Vb + (size_t)bh * 2304 * 64);
        const bf16_t* Qg = Q + ((size_t)bh * 2304 + qb * 256 + wid * 32 + r32) * 96;
        bf16x8 qf[6];
#pragma unroll
        for (int st = 0; st < 6; ++st) qf[st] = *(const bf16x8*)(Qg + 16 * st + 8 * hi);
        f32x16 o0, o1;
#pragma unroll
        for (int r = 0; r < 16; ++r) { o0[r] = 0.f; o1[r] = 0.f; }
        float mrun = 0.f, lsum = 0.f;
        f32x16 negm;
#pragma unroll
        for (int r = 0; r < 16; ++r) negm[r] = 0.f;
        u32x4 kr0, kr1, vr;
        kr0 = *(const u32x4*)(Kg + tid_ * 16); kr1 = tid_ < 256 ? *(const u32x4*)(Kg + (tid_ + 512) * 16) : (u32x4){0u, 0u, 0u, 0u}; vr = *(const u32x4*)(Vg + tid_ * 16);
        __syncthreads();
        *(LAS u32x4*)(sm + koff0) = kr0; if (tid_ < 256) *(LAS u32x4*)(sm + koff1) = kr1; *(LAS u32x4*)(sm + voff) = vr;
        __syncthreads();
        for (int t = 0; t < ntile; ++t) {
            const int buf = (t & 1) * BUF_A;
            if (t + 1 < ntile) { const char* kg = Kg + (size_t)(t + 1) * 12288; const char* vg = Vg + (size_t)(t + 1) * 8192;
                kr0 = *(const u32x4*)(kg + tid_ * 16); if (tid_ < 256) kr1 = *(const u32x4*)(kg + (tid_ + 512) * 16); vr = *(const u32x4*)(vg + tid_ * 16); }
            const LAS char* kb = sm + buf + r32 * KP_A + 16 * hi;
            f32x16 p0 = negm, p1 = negm;
#pragma unroll
            for (int st = 0; st < 6; ++st) {
                const bf16x8 k0 = *(const LAS bf16x8*)(kb + 32 * st), k1 = *(const LAS bf16x8*)(kb + 32 * KP_A + 32 * st);
                p0 = __builtin_amdgcn_mfma_f32_32x32x16_bf16(k0, qf[st], p0, 0, 0, 0);
                p1 = __builtin_amdgcn_mfma_f32_32x32x16_bf16(k1, qf[st], p1, 0, 0, 0);
            }
            float ta = fmaxf(fmaxf(p0[0], p0[1]), p1[0]), tb = fmaxf(fmaxf(p0[2], p0[3]), p1[1]);
            ta = fmaxf(fmaxf(ta, p1[2]), p1[3]);
#pragma unroll
            for (int r = 4; r < 16; r += 4) { ta = fmaxf(fmaxf(ta, p0[r]), p0[r + 1]); tb = fmaxf(fmaxf(tb, p0[r + 2]), p0[r + 3]); ta = fmaxf(fmaxf(ta, p1[r]), p1[r + 1]); tb = fmaxf(fmaxf(tb, p1[r + 2]), p1[r + 3]); }
            float tm = fmaxf(ta, tb);
            tm = fmaxf(tm, __shfl_xor(tm, 32));
            if (t == 0 || __any(tm > 0.f)) {
                const float dl = t == 0 ? tm : fmaxf(tm, 0.f), alpha = t == 0 ? 1.f : __builtin_amdgcn_exp2f(-dl);
                mrun += dl; lsum *= alpha;
#pragma unroll
                for (int r = 0; r < 16; ++r) { p0[r] -= dl; p1[r] -= dl; o0[r] *= alpha; o1[r] *= alpha; negm[r] = -mrun; }
            }
            float ps = 0.f, ps2 = 0.f;
#pragma unroll
            for (int r = 0; r < 16; ++r) { p0[r] = __builtin_amdgcn_exp2f(p0[r]); p1[r] = __builtin_amdgcn_exp2f(p1[r]); ps += p0[r]; ps2 += p1[r]; }
            lsum += ps + ps2;
            bf16x8 pf[4]; pf[0] = pack_p(p0, 0); pf[1] = pack_p(p0, 8); pf[2] = pack_p(p1, 0); pf[3] = pack_p(p1, 8);
            pv_tile(o0, o1, sm + buf + vrd, pf);
            if (t + 1 < ntile) { const int nb = ((t + 1) & 1) * BUF_A; *(LAS u32x4*)(sm + nb + koff0) = kr0; if (tid_ < 256) *(LAS u32x4*)(sm + nb + koff1) = kr1; *(LAS u32x4*)(sm + nb + voff) = vr; }
            __syncthreads();
        }
        lsum += __shfl_xor(lsum, 32);
        const float inv = 1.f / lsum;
        const int b = bh >> 2, h = bh & 3;
        const int row = (lat ? b * 2048 + qb * 256 : RL + b * 256) + wid * 32 + r32;
        bf16_t* op = Z + (size_t)row * ZW + C_QC + h * 64 + 4 * hi;
#pragma unroll
        for (int g = 0; g < 4; ++g) {
            u32x2 w0, w1; w0.x = pk2(o0[4 * g] * inv, o0[4 * g + 1] * inv); w0.y = pk2(o0[4 * g + 2] * inv, o0[4 * g + 3] * inv);
            w1.x = pk2(o1[4 * g] * inv, o1[4 * g + 1] * inv); w1.y = pk2(o1[4 * g + 2] * inv, o1[4 * g + 3] * inv);
            *(u32x2*)(op + 8 * g) = w0; *(u32x2*)(op + 32 + 8 * g) = w1;
        }
    }
    __syncthreads();
}

__device__ __forceinline__ void ph_ret_mfma(unsigned char* lds_, bf16_t* Z, const float* decay_logit, const float* gn_w, int with_ctx) { PH_IDS;
    using namespace fa;
    LAS char* sm = (LAS char*)lds_;
    const int lane = tid_ & 63, wid = __builtin_amdgcn_readfirstlane(tid_ >> 6), r32 = lane & 31, hi = lane >> 5;
    const int nunits = 256 + (with_ctx ? 32 : 0);
    const int vcu = (bid_ % 8) * (G_ / 8) + bid_ / 8;
    const int prow = tid_ >> 3, pc = tid_ & 7;
    const int koff = prow * KP_R + pc * 16;
    const int voff = KT_R + (pc >> 2) * 4096 + prow * 64 + (pc & 3) * 16;
    const int vrd = KT_R + ((lane >> 4) & 1) * 32 + (lane & 3) * 8 + (4 * hi + ((lane & 15) >> 2)) * 64;
    for (int u = vcu; u < nunits; u += G_) {
        const bool lat = u < 256; const int bh = lat ? (u >> 3) : (u - 256), qb = lat ? (u & 7) : 0, b = bh >> 2, h = bh & 3;
        const int ntile = lat ? 40 : 4;
        const float lgf = -log1pf(__expf(-decay_logit[h])) * 1.4426950408889634f, lgb = -log1pf(__expf(-decay_logit[4 + h])) * 1.4426950408889634f;
        const int qw0 = qb * 256 + wid * 32, qpos = qw0 + r32;
        const int qrow = (lat ? b * 2048 : RL + b * 256) + qpos;
        float ckf[16], ckb[16];
#pragma unroll
        for (int r = 0; r < 16; ++r) { const float off = (float)crow(r, hi); ckf[r] = __builtin_amdgcn_exp2f(-lgf * off); ckb[r] = __builtin_amdgcn_exp2f(lgb * off); }
        const float cf32 = __builtin_amdgcn_exp2f(-lgf * 32.f), cb32 = __builtin_amdgcn_exp2f(lgb * 32.f);
        bf16_t* zq = Z + (size_t)qrow * ZW;
        bf16x8 qf[4];
#pragma unroll
        for (int st = 0; st < 4; ++st) qf[st] = *(const bf16x8*)(zq + C_RQ + h * 64 + 16 * st + 8 * hi);
        f32x16 o0, o1;
#pragma unroll
        for (int r = 0; r < 16; ++r) { o0[r] = 0.f; o1[r] = 0.f; }
        const int ctx0 = RL + b * 256, lat0 = b * 2048;
#define RET_TILE_ROW(t) (lat ? ((t) < 4 ? ctx0 + 64 * (t) : ((t) < 36 ? lat0 + 64 * ((t) - 4) : ctx0 + 64 * ((t) - 36))) : ctx0 + 64 * (t))
#define RET_TILE_POS(t) (lat ? 64 * (t) - 256 : 64 * (t))
        u32x4 kr, vr;
        { const bf16_t* zr = Z + (size_t)(RET_TILE_ROW(0) + prow) * ZW + h * 64 + pc * 8; kr = *(const u32x4*)(zr + C_RK); vr = *(const u32x4*)(zr + C_RV); }
        __syncthreads();
        *(LAS u32x4*)(sm + koff) = kr; *(LAS u32x4*)(sm + voff) = vr;
        __syncthreads();
        for (int t = 0; t < ntile; ++t) {
            const int buf = (t & 1) * BUF_R;
            if (t + 1 < ntile) { const bf16_t* zr = Z + (size_t)(RET_TILE_ROW(t + 1) + prow) * ZW + h * 64 + pc * 8; kr = *(const u32x4*)(zr + C_RK); vr = *(const u32x4*)(zr + C_RV); }
            const LAS char* kb = sm + buf + r32 * KP_R + 16 * hi;
            f32x16 p0, p1;
#pragma unroll
            for (int r = 0; r < 16; ++r) { p0[r] = 0.f; p1[r] = 0.f; }
#pragma unroll
            for (int st = 0; st < 4; ++st) {
                const bf16x8 k0 = *(const LAS bf16x8*)(kb + 32 * st), k1 = *(const LAS bf16x8*)(kb + 32 * KP_R + 32 * st);
                p0 = __builtin_amdgcn_mfma_f32_32x32x16_bf16(k0, qf[st], p0, 0, 0, 0);
                p1 = __builtin_amdgcn_mfma_f32_32x32x16_bf16(k1, qf[st], p1, 0, 0, 0);
            }
            const int kp0 = RET_TILE_POS(t);
            if (kp0 + 63 < qw0) {
                const float sq = __builtin_amdgcn_exp2f(lgf * (float)(qpos - kp0)), sq1 = sq * cf32;
#pragma unroll
                for (int r = 0; r < 16; ++r) { p0[r] = p0[r] * ckf[r] * sq; p1[r] = p1[r] * ckf[r] * sq1; }
            } else if (kp0 > qw0 + 31) {
                const float sq = __builtin_amdgcn_exp2f(lgb * (float)(kp0 - qpos)), sq1 = sq * cb32;
#pragma unroll
                for (int r = 0; r < 16; ++r) { p0[r] = p0[r] * ckb[r] * sq; p1[r] = p1[r] * ckb[r] * sq1; }
            } else {
                const int d0 = qpos - kp0 - 4 * hi;
#pragma unroll
                for (int r = 0; r < 16; ++r) {
                    const int dp0 = d0 - ((r & 3) + 8 * (r >> 2)), dp1 = dp0 - 32;
                    const float w0 = dp0 > 0 ? __builtin_amdgcn_exp2f(lgf * (float)dp0) : (dp0 < 0 ? __builtin_amdgcn_exp2f(-lgb * (float)dp0) : 2.f);
                    const float w1 = dp1 > 0 ? __builtin_amdgcn_exp2f(lgf * (float)dp1) : (dp1 < 0 ? __builtin_amdgcn_exp2f(-lgb * (float)dp1) : 2.f);
                    p0[r] *= w0; p1[r] *= w1;
                }
            }
            bf16x8 pf[4]; pf[0] = pack_p(p0, 0); pf[1] = pack_p(p0, 8); pf[2] = pack_p(p1, 0); pf[3] = pack_p(p1, 8);
            pv_tile(o0, o1, sm + buf + vrd, pf);
            if (t + 1 < ntile) { const int nb = ((t + 1) & 1) * BUF_R; *(LAS u32x4*)(sm + nb + koff) = kr; *(LAS u32x4*)(sm + nb + voff) = vr; }
            __syncthreads();
        }
#undef RET_TILE_ROW
#undef RET_TILE_POS
        float s1 = 0.f;
#pragma unroll
        for (int r = 0; r < 16; ++r) s1 += o0[r] + o1[r];
        s1 += __shfl_xor(s1, 32);
        const float mu = s1 * (1.f / 64);
        float s2 = 0.f;
#pragma unroll
        for (int r = 0; r < 16; ++r) { const float a = o0[r] - mu, c = o1[r] - mu; s2 += a * a + c * c; }
        s2 += __shfl_xor(s2, 32);
        const float rstd = rsqrtf(s2 * (1.f / 64) + EPS);
#pragma unroll
        for (int g = 0; g < 4; ++g)
#pragma unroll
            for (int blk = 0; blk < 2; ++blk) {
                const int d = blk * 32 + 8 * g + 4 * hi;
                const u32x2 gt = *(const u32x2*)(zq + C_RG + h * 64 + d);
                const f32x4 gw = *(const f32x4*)(gn_w + h * 64 + d);
                float y[4];
#pragma unroll
                for (int q = 0; q < 4; ++q) { const float ov = blk ? o1[4 * g + q] : o0[4 * g + q]; const unsigned gb = q < 2 ? gt.x : gt.y; const float gv = __uint_as_float((q & 1) ? (gb & 0xffff0000u) : (gb << 16));
                    y[q] = siluf_(gv) * ((ov - mu) * rstd * gw[q]); }
                u32x2 w; w.x = pk2(y[0], y[1]); w.y = pk2(y[2], y[3]);
                *(u32x2*)(zq + C_RQ + h * 64 + d) = w;
            }
    }
    __syncthreads();
}

struct SchedGrid {
    const char* A; const char* B; unsigned lda, ldb; int nt, nM, nN, G, c, kind, aux;
    __device__ __forceinline__ bool next(int i, pg8::Unit& u) const {
        int pm, pn; if (!pg8::static_tile(nM, nN, G, c, i, pm, pn)) return false;
        u.A = A + (size_t)pm * 256 * lda; u.B = B + (size_t)pn * 256 * ldb; u.lda = lda; u.ldb = ldb; u.nt = nt; u.pm = pm; u.pn = pn; u.kind = kind; u.aux = aux; return true; }
};
struct SchedP1 {
    const char* A; const char* B; int G, c, last;
    __device__ __forceinline__ bool next(int i, pg8::Unit& u) const {
        int pm, pn;
        if (!last) { if (!pg8::static_tile(RT / 256, 8, G, c, i, pm, pn)) return false; }
        else { if (!pg8::static_tile(RL / 256, 8, G, c, i, pm, pn)) { const int j = i * G + c - (RL / 256) * 8; if (j < 0 || j >= 32) return false; pm = RL / 256 + (j >> 2); pn = j & 3; } }
        u.A = A + (size_t)pm * 256 * 2048; u.B = B + (size_t)pn * 256 * 2048; u.lda = 2048; u.ldb = 2048; u.nt = 16; u.pm = pm; u.pn = pn; u.kind = 0; u.aux = 0; return true; }
};
struct SchedMerge {
    const char* Z; const char* XN; const char* WBR; const char* WING; int njobs, G, vcu;
    __device__ __forceinline__ bool next(int i, pg8::Unit& u) const {
        const int job = (i >> 3) * G + vcu; if (job >= njobs) return false;
        const int sub = i & 7, n = sub >> 1, pm = job >> 2, pn = job & 3;
        u.pm = pm; u.pn = pn; u.aux = n;
        if (!(sub & 1)) { const int bcol = n == 0 ? C_QC : (n == 1 ? C_FU : (n == 2 ? C_OC : C_RQ));
            u.A = Z + ((size_t)pm * 256 * ZW + bcol) * 2; u.lda = ZW * 2; u.B = WBR + ((size_t)n * 1024 + pn * 256) * 512; u.ldb = 512; u.nt = 4; u.kind = 0; }
        else { u.A = XN + (size_t)pm * 256 * 2048; u.lda = 2048; u.B = WING + ((size_t)n * 1024 + pn * 256) * 2048; u.ldb = 2048; u.nt = 16; u.kind = 1; }
        return true; }
};
#define EPI_FOREACH(...) _Pragma("unroll") for (int ai = 0; ai < 2; ++ai) _Pragma("unroll") for (int m = 0; m < 4; ++m) _Pragma("unroll") for (int bj = 0; bj < 2; ++bj) { \
        const int row = u.pm * 256 + ai * 128 + wr * 64 + m * 16 + fr, col = u.pn * 256 + bj * 128 + wc * 32 + 8 * fq; const f32x4 v0 = acc[ai][bj][m][0], v1 = acc[ai][bj][m][1]; (void)row; (void)col; __VA_ARGS__ }
struct EpiStore {
    bf16_t* O; int ld; int act;
    __device__ __forceinline__ void operator()(const f32x4 (&acc)[2][2][4][2], const pg8::Unit& u, int wr, int wc, int fr, int fq) const {
        EPI_FOREACH( f32x4 a = v0, b = v1; if (act == 1) { _Pragma("unroll") for (int q = 0; q < 4; ++q) { const float ra = fmaxf(a[q], 0.f), rb = fmaxf(b[q], 0.f); a[q] = ra * ra; b[q] = rb * rb; } }
            *(pg8::u32x4*)(O + (size_t)row * ld + col) = pack8(a, b); )
    }
};
struct EpiResid {
    const float* xlat; const float* xctx; float* olat; float* octx; const float* mod; int gch;
    __device__ __forceinline__ void operator()(const f32x4 (&acc)[2][2][4][2], const pg8::Unit& u, int wr, int wc, int fr, int fq) const {
        const bool lat = u.pm < 64; const float* xb = lat ? xlat : xctx - (size_t)RL * DM; float* ob = lat ? olat : octx - (size_t)RL * DM;
        const float* g = mod + (size_t)(lat ? (u.pm >> 3) : 8) * 6144 + gch * 1024;
        EPI_FOREACH( const f32x4 g0 = *(const f32x4*)(g + col), g1 = *(const f32x4*)(g + col + 4); const size_t o = (size_t)row * DM + col;
            const f32x4 x0 = *(const f32x4*)(xb + o), x1 = *(const f32x4*)(xb + o + 4); *(f32x4*)(ob + o) = x0 + g0 * v0; *(f32x4*)(ob + o + 4) = x1 + g1 * v1; if (bj) asm volatile("" ::: "memory"); )
    }
};
struct EpiMerge {
    pg8::u32x4* stash; bf16_t* MMp;
    __device__ __forceinline__ void operator()(const f32x4 (&acc)[2][2][4][2], const pg8::Unit& u, int wr, int wc, int fr, int fq) const {
        int tid = threadIdx.x; asm volatile("" : "+v"(tid));
        if (u.kind == 0) { EPI_FOREACH( stash[((ai * 4 + m) * 2 + bj) * NT + tid] = pack8(v0, v1); if (bj) asm volatile("" ::: "memory"); ) }
        else { EPI_FOREACH( f32x4 y0, y1; unpack8(stash[((ai * 4 + m) * 2 + bj) * NT + tid], y0, y1); f32x4 t0, t1;
                _Pragma("unroll") for (int q = 0; q < 4; ++q) { t0[q] = sigmoidf_(v0[q]) * y0[q]; t1[q] = sigmoidf_(v1[q]) * y1[q]; }
                pg8::u32x4* mp = (pg8::u32x4*)(MMp + (size_t)row * DM + col);
                if (u.aux != 0) { f32x4 p0, p1; unpack8(*mp, p0, p1); t0 += p0; t1 += p1; }
                *mp = pack8(t0, t1); asm volatile("" ::: "memory"); ) }
    }
};
__device__ __forceinline__ void transpose_item(const float* W, int K, int N, bf16_t* WT, int row_off, LAS float* scr, int item, int lane, const float* kscale = nullptr) {
    const int nblk = N / 32, kb = item / nblk, nb = item % nblk, k0 = 64 * kb, n0 = 32 * nb;
#pragma unroll 8
    for (int i = 0; i < 32; ++i) { const int kk = 2 * i + (lane >> 5); float wv = W[(size_t)(k0 + kk) * N + n0 + (lane & 31)]; if (kscale) wv *= kscale[k0 + kk]; scr[kk * 33 + (lane & 31)] = wv; }
    asm volatile("s_waitcnt lgkmcnt(0)" ::: "memory");
    const int c = lane & 7;
#pragma unroll
    for (int j = 0; j < 4; ++j) { const int n = (lane >> 3) + 8 * j; const LAS float* sp = scr + (8 * c) * 33 + n;
        pg8::u32x4 o; o.x = pg8::cvt_pk_bf16(sp[0 * 33], sp[1 * 33]); o.y = pg8::cvt_pk_bf16(sp[2 * 33], sp[3 * 33]); o.z = pg8::cvt_pk_bf16(sp[4 * 33], sp[5 * 33]); o.w = pg8::cvt_pk_bf16(sp[6 * 33], sp[7 * 33]);
        *(pg8::u32x4*)(WT + (size_t)(row_off + n0 + n) * K + k0 + 8 * c) = o; }
    asm volatile("s_waitcnt lgkmcnt(0)" ::: "memory");
}
__device__ __forceinline__ void ph_convert_weights(unsigned char* lds, int l, const float* w_in, const float* w1, const float* w2, const float* w_out, const float* w_br, const float* w_glu,
                                                   const float* w_uq, const float* q_norm, const float* w_ukv, const float* kv_norm, unsigned char* ws) { PH_IDS;
    const int wave = __builtin_amdgcn_readfirstlane(tid_ >> 6), lane = tid_ & 63;
    LAS float* scr = (LAS float*)((LAS unsigned char*)lds + wave * 16384);
    const int gw = bid_ * 8 + wave, NGW = G_ * 8;
    constexpr int I_IN = 16 * 189, I_1 = 16 * 128, I_2 = 64 * 32, I_O = 16 * 32, I_B = 4 * 32;
    constexpr int I_G = 4 * 16;
    constexpr int I_UQ = 4 * 12, I_UKV = 2 * 16;
    constexpr int NITEMS = I_IN + I_1 + I_2 + I_O + 4 * I_B + I_G + I_UQ + I_UKV;
    bf16_t* WIN_T = (bf16_t*)(ws + WS_WIN); bf16_t* W1_T = (bf16_t*)(ws + WS_W1); bf16_t* W2_T = (bf16_t*)(ws + WS_W2); bf16_t* WOUT_T = (bf16_t*)(ws + WS_WOUT); bf16_t* WBR_T = (bf16_t*)(ws + WS_WBR);
    for (int it = gw; it < NITEMS; it += NGW) {
        int r = it;
        if (r < I_IN) { const int nb = r % 189; transpose_item(w_in + (size_t)l * DM * INC, DM, INC, WIN_T, nb >= 61 ? 96 : 0, scr, r, lane); continue; } r -= I_IN;
        if (r < I_1) { transpose_item(w1 + (size_t)l * DM * DFF, DM, DFF, W1_T, 0, scr, r, lane); continue; } r -= I_1;
        if (r < I_2) { transpose_item(w2 + (size_t)l * DFF * DM, DFF, DM, W2_T, 0, scr, r, lane); continue; } r -= I_2;
        if (r < I_O) { transpose_item(w_out + (size_t)l * DM * DM, DM, DM, WOUT_T, 0, scr, r, lane); continue; } r -= I_O;
        if (r < 4 * I_B) { const int n = r / I_B; transpose_item(w_br + ((size_t)l * 4 + n) * 256 * DM, 256, DM, WBR_T + (size_t)n * 1024 * 256, 0, scr, r % I_B, lane); continue; } r -= 4 * I_B;
        { const int n0 = (r % 16) * 32; const int off = n0 < 128 ? 0 : (n0 < 256 ? 128 : (n0 < 384 ? -128 : 0));
          if (r < I_G) { transpose_item(w_glu + (size_t)l * 256 * 512, 256, 512, (bf16_t*)(ws + WS_WGLU), off, scr, r, lane); continue; } }
        r -= I_G;
        if (r < I_UQ) { transpose_item(w_uq + (size_t)l * 256 * 384, 256, 384, (bf16_t*)(ws + WS_WUQ), 0, scr, r, lane, q_norm + l * 256); continue; } r -= I_UQ;
        transpose_item(w_ukv + (size_t)l * 128 * 512, 128, 512, (bf16_t*)(ws + WS_WUKV), 0, scr, r, lane, kv_norm + l * 128);
    }
    GSTRIDE(gi, 96 * 1024 / 8) { *(pg8::u32x4*)(WIN_T + (size_t)1952 * 1024 + (size_t)gi * 8) = (pg8::u32x4){0u, 0u, 0u, 0u}; }
    __syncthreads();
}

struct EpiFourier {
    bf16_t* Zp; int rowbase, L; float scale;
    __device__ __forceinline__ void operator()(const f32x4 (&acc)[2][2][4][2], const pg8::Unit& u, int wr, int wc, int fr, int fq) const {
        EPI_FOREACH( *(pg8::u32x4*)(Zp + ((size_t)rowbase + (size_t)u.pn * L + row) * ZW + C_FU + (col - u.pn * 256)) = pack8(v0 * scale, v1 * scale); )
    }
};
struct EpiGlu {
    bf16_t* Zp;
    __device__ __forceinline__ void operator()(const f32x4 (&acc)[2][2][4][2], const pg8::Unit& u, int wr, int wc, int fr, int fq) const {
#pragma unroll
        for (int ai = 0; ai < 2; ++ai)
#pragma unroll
            for (int m = 0; m < 4; ++m) {
                const int row = u.pm * 256 + ai * 128 + wr * 64 + m * 16 + fr, col = u.pn * 128 + wc * 32 + 8 * fq;
                f32x4 a, b;
#pragma unroll
                for (int q = 0; q < 4; ++q) { a[q] = acc[ai][0][m][0][q] * sigmoidf_(acc[ai][1][m][0][q]); b[q] = acc[ai][0][m][1][q] * sigmoidf_(acc[ai][1][m][1][q]); }
                *(pg8::u32x4*)(Zp + (size_t)row * ZW + C_OC + col) = pack8(a, b);
            }
    }
};
__device__ __forceinline__ void ph_dft_gen(const float* trig, bf16_t* DL, bf16_t* DC) { PH_IDS;
    GSTRIDE(gi, 2048 * 4096 / 8) {
        const int k = gi >> 9, kk0 = (gi & 511) * 8; pg8::u32x4 w; unsigned pr[4];
#pragma unroll
        for (int q = 0; q < 4; ++q) { float v[2];
#pragma unroll
            for (int e = 0; e < 2; ++e) { const int kk = kk0 + 2 * q + e, part = kk >> 11, t = kk & 2047, idx = (k * t) & 2047; v[e] = part ? -trig[2048 + idx] : trig[idx]; }
            pr[q] = pg8::cvt_pk_bf16(v[0], v[1]); }
        w.x = pr[0]; w.y = pr[1]; w.z = pr[2]; w.w = pr[3];
        *(pg8::u32x4*)(DL + (size_t)k * 4096 + kk0) = w;
    }
    GSTRIDE(gi, 256 * 512 / 8) {
        const int k = gi >> 6, kk0 = (gi & 63) * 8; pg8::u32x4 w; unsigned pr[4];
#pragma unroll
        for (int q = 0; q < 4; ++q) { float v[2];
#pragma unroll
            for (int e = 0; e < 2; ++e) { const int kk = kk0 + 2 * q + e, part = kk >> 8, t = kk & 255, idx = ((k * t) & 255) * 8; v[e] = part ? -trig[2048 + idx] : trig[idx]; }
            pr[q] = pg8::cvt_pk_bf16(v[0], v[1]); }
        w.x = pr[0]; w.y = pr[1]; w.z = pr[2]; w.w = pr[3];
        *(pg8::u32x4*)(DC + (size_t)k * 512 + kk0) = w;
    }
}

constexpr size_t WS_BAR = 7 * MiB;
constexpr int LDS_BYTES = 147456;
struct Args { const float* in[30]; float* out; unsigned char* ws; };
typedef const __attribute__((address_space(4))) Args* CArgs;
__device__ __forceinline__ CArgs kargs() { CArgs p = (CArgs)__builtin_amdgcn_kernarg_segment_ptr(); asm volatile("" : "+s"(p)); return p; }
#define IN(i) (kargs()->in[i])
#define WSB(T, off) ((T*)(kargs()->ws + (off)))
#define OUTP (kargs()->out)
enum { I_X = 0, I_C, I_CTX, I_CCTX, I_ADAW, I_ADAB, I_NMIX, I_NFFN, I_WIN, I_QNORM, I_WUQ, I_KVNORM, I_WUKV, I_QKQ, I_QKK, I_LRE, I_LIM, I_LSTEP, I_BRE, I_BIM, I_CRE, I_CIM, I_S5D, I_WGLU, I_RDEC, I_RGN, I_WBR, I_WOUT, I_W1, I_W2 };
#define GRID_BAR() do { bar.bar = WSB(unsigned, WS_BAR); { unsigned x_ = bar.x; asm volatile("" : "+s"(x_)); bar.x = x_; } xcd_barrier(bar); } while (0)
template <int L> __device__ __forceinline__ void layer_body(unsigned char* lds, XcdBarrier& bar) {
    constexpr int l = L;
    constexpr bool LASTL = (L == DEPTH - 1);
    constexpr int NMT = LASTL ? RL / 256 : RT / 256;
    constexpr int WCTX = LASTL ? 0 : 1;

#define MODL (WSB(float, WS_MOD) + (size_t)l * 9 * 6144)
#define XLAT (l == 0 ? IN(I_X) : (const float*)OUTP)
#define XCTX (l == 0 ? IN(I_CTX) : (const float*)WSB(float, WS_XC))
#define WINL (IN(I_WIN) + (size_t)l * DM * INC)
#define ZP WSB(bf16_t, WS_Z)
#define XNP WSB(bf16_t, WS_XN)
#define QP WSB(bf16_t, WS_QKV)
#define KP (WSB(bf16_t, WS_QKV) + (size_t)32 * 2304 * 96)
#define VP (WSB(bf16_t, WS_QKV) + (size_t)2 * 32 * 2304 * 96)
#define F1LAT WSB(bf16_t, WS_F1)
#define F1CTX (WSB(bf16_t, WS_F1) + (size_t)8 * 256 * 2 * 2048)
#define QRAWP WSB(bf16_t, WS_RAW)
#define KVRAWP (WSB(bf16_t, WS_RAW) + (size_t)RT * 384)
        ph_s5_lp(l, IN(I_LRE), IN(I_LIM), IN(I_LSTEP), IN(I_BRE), IN(I_BIM), WSB(float2, WS_LP), WSB(float2, WS_BB), WSB(float, WS_LAMT));
        ph_adarms(XLAT, XCTX, IN(I_NMIX) + l * DM, MODL, 0, 1, XNP, RT);
        ph_convert_weights(lds, l, IN(I_WIN), IN(I_W1), IN(I_W2), IN(I_WOUT), IN(I_WBR), IN(I_WGLU), IN(I_WUQ), IN(I_QNORM), IN(I_WUKV), IN(I_KVNORM), kargs()->ws);
        if (l == 0) ph_dft_gen(WSB(float, WS_TRIG), WSB(bf16_t, WS_DFTL), WSB(bf16_t, WS_DFTC));
        GRID_BAR();
        ph_s5_tz(lds, l, WSB(float2, WS_LP), WSB(float2, WS_BB), IN(I_CRE), IN(I_CIM), WSB(float, WS_TZ));
        ph_s5_ms(WSB(float2, WS_LP), WSB(float2, WS_BB), WSB(bf16_t, WS_MS));
        ph_s5_qo(l, WSB(float2, WS_LP), IN(I_CRE), IN(I_CIM), WSB(bf16_t, WS_QO));
        { SchedP1 S; S.A = (const char*)XNP; S.B = (const char*)WSB(bf16_t, WS_WIN); S.G = l_grid(); S.c = l_bid(); S.last = LASTL ? 1 : 0;
          EpiStore E; E.O = ZP; E.ld = ZW; E.act = 0; pg8::gemm_phase((LAS unsigned char*)lds, S, E); }
        GRID_BAR();
        ph_prep(ZP, WSB(bf16_t, WS_WUQ), WSB(bf16_t, WS_WUKV), WSB(bf16_t, WS_D64), IN(I_QKQ) + l * 96, IN(I_QKK) + l * 96, QP, KP, VP, F1LAT, F1CTX);
        ph_s5_sloc(ZP, WSB(bf16_t, WS_MS), WSB(float, WS_SLOC));
        GRID_BAR();
        { SchedGrid S; S.A = (const char*)WSB(bf16_t, WS_DFTL); S.B = (const char*)F1LAT; S.lda = 8192; S.ldb = 8192; S.nt = 64; S.nM = 8; S.nN = 8; S.G = l_grid(); S.c = l_bid(); S.kind = 0; S.aux = 0;
          EpiFourier E; E.Zp = ZP; E.rowbase = 0; E.L = 2048; E.scale = 0.0027621358640099515f; pg8::gemm_phase((LAS unsigned char*)lds, S, E); }
        if (!LASTL) { SchedGrid S; S.A = (const char*)WSB(bf16_t, WS_DFTC); S.B = (const char*)F1CTX; S.lda = 1024; S.ldb = 1024; S.nt = 8; S.nM = 1; S.nN = 8; S.G = l_grid(); S.c = l_bid(); S.kind = 0; S.aux = 0;
          EpiFourier E; E.Zp = ZP; E.rowbase = RL; E.L = 256; E.scale = 0.0078125f; pg8::gemm_phase((LAS unsigned char*)lds, S, E); }
        ph_ret_mfma(lds, ZP, IN(I_RDEC) + l * 8, IN(I_RGN) + l * 256, WCTX);
        ph_attn_mfma(lds, QP, KP, VP, ZP, WCTX);
        ph_s5_out(lds, ZP, WSB(float, WS_TZ), IN(I_S5D) + l * 256, WSB(bf16_t, WS_QO), WSB(float, WS_SLOC), WSB(float, WS_LAMT), ZP, LASTL ? 16 : 18);
        GRID_BAR();
        { SchedGrid S; S.A = (const char*)(ZP + C_S5); S.B = (const char*)WSB(bf16_t, WS_WGLU); S.lda = ZW * 2; S.ldb = 512; S.nt = 4; S.nM = NMT; S.nN = 2; S.G = l_grid(); S.c = l_bid(); S.kind = 0; S.aux = 0;
          EpiGlu E; E.Zp = ZP; pg8::gemm_phase((LAS unsigned char*)lds, S, E); }
        GRID_BAR();
        { SchedMerge S; S.Z = (const char*)ZP; S.XN = (const char*)XNP; S.WBR = (const char*)WSB(bf16_t, WS_WBR); S.WING = (const char*)(WSB(bf16_t, WS_WIN) + (size_t)2048 * 1024);
          S.njobs = NMT * 4; S.G = l_grid(); { const int bx = l_bid(); S.vcu = (bx % 8) * (S.G / 8) + bx / 8; }
          EpiMerge E; E.stash = WSB(pg8::u32x4, WS_STASH) + (size_t)l_bid() * 8192; E.MMp = WSB(bf16_t, WS_MM); pg8::gemm_phase((LAS unsigned char*)lds, S, E); }
        GRID_BAR();
        { SchedGrid S; S.A = (const char*)WSB(bf16_t, WS_MM); S.B = (const char*)WSB(bf16_t, WS_WOUT); S.lda = 2048; S.ldb = 2048; S.nt = 16; S.nM = NMT; S.nN = 4; S.G = l_grid(); S.c = l_bid(); S.kind = 0; S.aux = 0;
          EpiResid E; E.xlat = XLAT; E.xctx = XCTX; E.olat = OUTP; E.octx = WSB(float, WS_XC); E.mod = MODL; E.gch = 2; pg8::gemm_phase((LAS unsigned char*)lds, S, E); }
        GRID_BAR();
        ph_adarms(OUTP, WSB(float, WS_XC), IN(I_NFFN) + l * DM, MODL, 3, 4, XNP, NMT * 256);
        GRID_BAR();
        { SchedGrid S; S.A = (const char*)XNP; S.B = (const char*)WSB(bf16_t, WS_W1); S.lda = 2048; S.ldb = 2048; S.nt = 16; S.nM = NMT; S.nN = 16; S.G = l_grid(); S.c = l_bid(); S.kind = 0; S.aux = 0;
          EpiStore E; E.O = WSB(bf16_t, WS_H); E.ld = DFF; E.act = 1; pg8::gemm_phase((LAS unsigned char*)lds, S, E); }
        GRID_BAR();
        { SchedGrid S; S.A = (const char*)WSB(bf16_t, WS_H); S.B = (const char*)WSB(bf16_t, WS_W2); S.lda = 8192; S.ldb = 8192; S.nt = 64; S.nM = NMT; S.nN = 4; S.G = l_grid(); S.c = l_bid(); S.kind = 0; S.aux = 0;
          EpiResid E; E.xlat = OUTP; E.xctx = WSB(float, WS_XC); E.olat = OUTP; E.octx = WSB(float, WS_XC); E.mod = MODL; E.gch = 5; pg8::gemm_phase((LAS unsigned char*)lds, S, E); }
        if (l + 1 < DEPTH) GRID_BAR();
}
__global__ void __launch_bounds__(NT, 2) mega(Args a_unused) {
    extern __shared__ __attribute__((aligned(16))) unsigned char lds[];
    volatile LAS unsigned* bst = (volatile LAS unsigned*)((LAS unsigned char*)lds + LDS_BYTES - 16);
    if (threadIdx.x < 4) bst[threadIdx.x] = 0u;
    __syncthreads();
    XcdBarrier bar = xcd_barrier_post(WSB(unsigned, WS_BAR), bst);

    ph_mod(lds, IN(I_C), IN(I_CCTX), IN(I_ADAW), IN(I_ADAB), WSB(float, WS_MOD));
    ph_trig(WSB(float, WS_TRIG), WSB(bf16_t, WS_D64));
    GRID_BAR();
    layer_body<0>(lds, bar);
    layer_body<1>(lds, bar);
}

extern "C" void kernel_launch(void* const* d_in, const int* in_sizes, int n_in, void* d_out, int out_size, void* d_ws, size_t ws_size, hipStream_t stream) {
    static int grid = 0;
    if (grid == 0) {
        if (n_in != 30 || ws_size < WS_END) { fprintf(stderr, "kernel_launch: unexpected n_in %d / ws_size %zu\n", n_in, ws_size); grid = -1; return; }
        int dev = 0, cus = 0, per_cu = 0;
        if (hipGetDevice(&dev) != hipSuccess || hipDeviceGetAttribute(&cus, hipDeviceAttributeMultiprocessorCount, dev) != hipSuccess) { grid = -1; return; }
        if (hipFuncSetAttribute((const void*)mega, hipFuncAttributeMaxDynamicSharedMemorySize, LDS_BYTES) != hipSuccess) { fprintf(stderr, "kernel_launch: hipFuncSetAttribute failed\n"); grid = -1; return; }
        if (hipOccupancyMaxActiveBlocksPerMultiprocessor(&per_cu, (const void*)mega, NT, LDS_BYTES) != hipSuccess || per_cu < 1) fprintf(stderr, "kernel_launch: occupancy query says %d\n", per_cu);
        (void)hipGetLastError();
        grid = cus;
    }
    if (grid < 0) return;
    (void)hipMemsetAsync((char*)d_ws + WS_BAR, 0, XCD_BAR_WORDS * 4, stream);
    Args a; memset((void*)&a, 0, sizeof(a));
    for (int i = 0; i < 30; ++i) a.in[i] = (const float*)d_in[i];
    a.out = (float*)d_out; a.ws = (unsigned char*)d_ws;
    hipLaunchKernelGGL(mega, dim3(grid), dim3(NT), LDS_BYTES, stream, a);
}
```

```cpp
#include <hip/hip_runtime.h>
#include <cstdint>
#include <cstring>
#include <cstdio>

typedef unsigned short bf16_t;
typedef short bf16x8 __attribute__((ext_vector_type(8)));
typedef float f32x4 __attribute__((ext_vector_type(4)));

constexpr int DM = 1024, NB = 8, SEQ = 2048, CTX = 256, DEPTH = 2;
constexpr int RL = NB * SEQ;
constexpr int RC = NB * CTX;
constexpr int RT = RL + RC;
constexpr int INC = 6048;
constexpr int ZW = 2048;
constexpr int C_KVC = 0, C_KR = 128, C_S5 = 160, C_RK = 416, C_RV = 672, C_QC = 928, C_FU = 1184, C_RQ = 1440, C_RG = 1696, C_GATE = 1952;
constexpr int C_OC = C_RK;
constexpr int DFF = 4096;
constexpr int TCH = 64;
constexpr int NCH = RT / TCH;
constexpr float EPS = 1e-6f;
#define PI_D 3.14159265358979323846

__device__ __forceinline__ float bf2f(bf16_t v) { return __uint_as_float(((unsigned)v) << 16); }
__device__ __forceinline__ bf16_t f2bf(float f) { unsigned u = __float_as_uint(f); return (bf16_t)((u + 0x7fffu + ((u >> 16) & 1u)) >> 16); }
__device__ __forceinline__ float sigmoidf_(float x) { return 1.f / (1.f + __expf(-x)); }
__device__ __forceinline__ float siluf_(float x) { return x * sigmoidf_(x); }
__device__ __forceinline__ float geluf_(float x) { return 0.5f * x * (1.f + tanhf(0.7978845608028654f * (x + 0.044715f * x * x * x))); }
__device__ __forceinline__ int row_batch(int row) { return row < RL ? (row >> 11) : ((row - RL) >> 8); }
__device__ __forceinline__ int row_modidx(int row) { return row < RL ? (row >> 11) : 8; }

constexpr size_t MiB = 1ull << 20;
constexpr size_t WS_MOD = 0;
constexpr size_t WS_RS = 1 * MiB;
constexpr size_t WS_TRIG = WS_RS + 256 * 1024;
constexpr size_t WS_LAMT = WS_TRIG + 32 * 1024;
constexpr size_t WS_LP = 2 * MiB;
constexpr size_t WS_BB = 5 * MiB;
constexpr size_t WS_W = 8 * MiB;
constexpr size_t WS_WIN = WS_W, WS_W1 = WS_W + 12 * MiB, WS_W2 = WS_W + 20 * MiB, WS_WOUT = WS_W + 28 * MiB, WS_WBR = WS_W + 30 * MiB;
constexpr size_t WS_XN = 40 * MiB;
constexpr size_t WS_RAW = WS_XN;
constexpr size_t WS_YG = WS_XN;
constexpr size_t WS_Z = 76 * MiB;
constexpr size_t WS_QKV = 148 * MiB;
constexpr size_t WS_F1 = 184 * MiB;
constexpr size_t WS_GL = WS_F1;
constexpr size_t WS_TZ = 202 * MiB;
constexpr size_t WS_MS = 204 * MiB;
constexpr size_t WS_QO = 212 * MiB;
constexpr size_t WS_SLOC = 220 * MiB;
constexpr size_t WS_XP = 225 * MiB;
constexpr size_t WS_XC = 230 * MiB;
constexpr size_t WS_MM = WS_QKV;
constexpr size_t WS_STASH = WS_F1;
constexpr size_t WS_H = WS_Z;
constexpr size_t WS_WUQ = 6 * MiB + 256 * 1024;
constexpr size_t WS_WUKV = 6 * MiB + 512 * 1024;
constexpr size_t WS_D64 = 6 * MiB + 768 * 1024;
constexpr size_t WS_WGLU = 6 * MiB;
constexpr size_t WS_DFTL = 238 * MiB;
constexpr size_t WS_DFTC = 254 * MiB;
constexpr size_t WS_END = 256 * MiB;


#define LAS __attribute__((address_space(3)))
#define NT 512
__device__ __forceinline__ int l_tid() { int t = threadIdx.x; asm volatile("" : "+v"(t)); return t; }
__device__ __forceinline__ int l_bid() { int b = blockIdx.x; asm volatile("" : "+s"(b)); return b; }
__device__ __forceinline__ int l_grid() { int g = gridDim.x; asm volatile("" : "+s"(g)); return g; }
#define PH_IDS const int tid_ = l_tid(), bid_ = l_bid(), G_ = l_grid(); (void)tid_; (void)bid_; (void)G_
template <class AF, class BF, class EF>
__device__ __forceinline__ void gemm_tile(const AF& A, const BF& B, const EF& E, bool valid, int b, int m0, int n0, int M, int N, int K, bf16_t (*sA)[40], bf16_t (*sB)[40], int ht) {
    f32x4 accm[2][2];
#pragma unroll
    for (int i = 0; i < 2; ++i)
#pragma unroll
        for (int j = 0; j < 2; ++j) accm[i][j] = (f32x4){0.f, 0.f, 0.f, 0.f};
    const int w = ht >> 6, lane = ht & 63, wm = (w >> 1) * 32, wn = (w & 1) * 32, fr = lane & 15, fq = lane >> 4;
    for (int k0 = 0; k0 < K; k0 += 32) {
        __syncthreads();
#pragma unroll
        for (int i = 0; i < 8; ++i) {
            const int e = ht + i * 256;
            { const int m = e >> 5, k = e & 31; float v = 0.f; if (valid && m0 + m < M && k0 + k < K) v = A(b, m0 + m, k0 + k); sA[m][k] = f2bf(v); }
            { const int k = e >> 6, n = e & 63; float v = 0.f; if (valid && n0 + n < N && k0 + k < K) v = B(b, k0 + k, n0 + n); sB[n][k] = f2bf(v); }
        }
        __syncthreads();
        bf16x8 af[2], bfr[2];
#pragma unroll
        for (int i = 0; i < 2; ++i) { af[i] = *(const bf16x8*)&sA[wm + i * 16 + fr][fq * 8]; bfr[i] = *(const bf16x8*)&sB[wn + i * 16 + fr][fq * 8]; }
#pragma unroll
        for (int i = 0; i < 2; ++i)
#pragma unroll
            for (int j = 0; j < 2; ++j) accm[i][j] = __builtin_amdgcn_mfma_f32_16x16x32_bf16(af[i], bfr[j], accm[i][j], 0, 0, 0);
    }
    if (valid) {
#pragma unroll
        for (int i = 0; i < 2; ++i)
#pragma unroll
            for (int j = 0; j < 2; ++j)
#pragma unroll
                for (int rr = 0; rr < 4; ++rr) {
                    const int m = m0 + wm + i * 16 + fq * 4 + rr, n = n0 + wn + j * 16 + fr;
                    if (m < M && n < N) E(b, m, n, accm[i][j][rr]);
                }
    }
}
template <class AF, class BF, class EF>
__device__ __forceinline__ void gemm_phase(unsigned char* lds, const AF& A, const BF& B, const EF& E, int nbatch, int M, int N, int K) {
    PH_IDS; const int tid = tid_, half = tid >> 8, ht = tid & 255;
    bf16_t (*sA)[40] = (bf16_t (*)[40])(lds + half * 10240);
    bf16_t (*sB)[40] = (bf16_t (*)[40])(lds + half * 10240 + 5120);
    const int tm = (M + 63) >> 6, tn = (N + 63) >> 6, total = nbatch * tm * tn;
    for (int it0 = bid_ * 2; it0 < total; it0 += G_ * 2) {
        const int it = it0 + half; const bool valid = it < total;
        const int itc = valid ? it : 0;
        const int b = itc / (tm * tn), r = itc % (tm * tn), m0 = (r / tn) * 64, n0 = (r % tn) * 64;
        gemm_tile(A, B, E, valid, b, m0, n0, M, N, K, sA, sB, ht);
    }
    __syncthreads();
}
template <class T> static T zeroed() { T t; memset((void*)&t, 0, sizeof(T)); return t; }

struct A_bf16 { const bf16_t* p; long long ld; long long coff;
    __device__ float operator()(int, int m, int k) const { return bf2f(p[(size_t)m * ld + coff + k]); } };
struct A_bf16_scaled { const bf16_t* p; long long ld; long long coff; const float* rs; long long rsi; const float* w;
    __device__ float operator()(int, int m, int k) const { return bf2f(p[(size_t)m * ld + coff + k]) * rs[(size_t)m * 2 + rsi] * w[k]; } };
struct B_f32 { const float* p; long long ld; long long coff;
    __device__ float operator()(int, int k, int n) const { return p[(size_t)k * ld + coff + n]; } };
struct E_bf16 { bf16_t* p; long long ld; long long coff;
    __device__ void operator()(int, int m, int n, float v) const { p[(size_t)m * ld + coff + n] = f2bf(v); } };

#define XB_TMO      128
#define XB_XCNT(j)  (256  + 64 * (j))
#define XB_XSUB(j)  (1280 + 64 * (j))
#define XB_XGEN(j)  (2304 + 64 * (j))
#define XB_TOP      3328
#define XB_TOPGEN   3392
#define XCD_BAR_WORDS 3456
#define XB_SPIN_CAP (1u << 18)
__device__ __forceinline__ unsigned xb_ld(unsigned* p)              { return __hip_atomic_load(p, __ATOMIC_RELAXED, __HIP_MEMORY_SCOPE_AGENT); }
__device__ __forceinline__ unsigned xb_add(unsigned* p, unsigned v) { return __hip_atomic_fetch_add(p, v, __ATOMIC_RELAXED, __HIP_MEMORY_SCOPE_AGENT); }
__device__ __forceinline__ unsigned xb_xcc_id() { return (unsigned)__builtin_amdgcn_s_getreg((3 << 11) | 20) & 0xFu; }
#define XB_SPIN(cond, bar) do { unsigned _sp = 0; while (cond) { __builtin_amdgcn_s_sleep(1); \
    if ((++_sp & 255u) == 0u) { if (xb_ld(&(bar)[XB_TMO])) break; if (_sp > XB_SPIN_CAP) { atomicAdd(&(bar)[XB_TMO], 1u); break; } } } } while (0)
struct XcdBarrier { unsigned* bar; unsigned x; volatile LAS unsigned* st; };
__device__ __forceinline__ XcdBarrier xcd_barrier_post(unsigned* bar, volatile LAS unsigned* st) {
    XcdBarrier b; b.bar = bar; b.x = xb_xcc_id(); b.st = st;
    if (threadIdx.x == 0) (void)xb_add(&bar[XB_XCNT(b.x)], 1u);
    return b;
}
__device__ __forceinline__ void xcd_barrier_complete(unsigned* bar, unsigned x, unsigned& nloc, unsigned& nx) {
    const unsigned G = gridDim.x * gridDim.y * gridDim.z;
    unsigned sum, cnt, mine, sp = 0u;
    for (;;) {
        sum = 0u; cnt = 0u; mine = 0u;
#pragma unroll
        for (unsigned j = 0; j < 16; ++j) { const unsigned c = xb_ld(&bar[XB_XCNT(j)]); sum += c; cnt += (c > 0u) ? 1u : 0u; mine = (j == x) ? c : mine; }
        if (sum == G) break;
        __builtin_amdgcn_s_sleep(1);
        if ((++sp & 255u) == 0u) { if (xb_ld(&bar[XB_TMO])) break; if (sp > XB_SPIN_CAP) { atomicAdd(&bar[XB_TMO], 1u); break; } }
    }
    nloc = mine > 0u ? mine : 1u; nx = cnt > 0u ? cnt : 1u;
}
__device__ __forceinline__ void xcd_barrier(const XcdBarrier& b) {
    asm volatile("s_waitcnt vmcnt(0)" ::: "memory");
    __syncthreads();
    if (threadIdx.x == 0) {
        unsigned* bar = b.bar;
        __builtin_amdgcn_s_waitcnt(0);
        unsigned nloc = b.st[0], nx = b.st[1];
        if (nloc == 0u) { xcd_barrier_complete(bar, b.x, nloc, nx); b.st[0] = nloc; b.st[1] = nx; }
        const unsigned old = xb_add(&bar[XB_XSUB(b.x)], 1u);
        const unsigned gen = old / nloc;
        if (old + 1u == (gen + 1u) * nloc) {
            __builtin_amdgcn_fence(__ATOMIC_RELEASE, "agent");
            asm volatile("s_waitcnt vmcnt(0)" ::: "memory");
            const unsigned og = xb_add(&bar[XB_TOP], 1u);
            const unsigned tg = og / nx;
            if (og + 1u == (tg + 1u) * nx) xb_add(&bar[XB_TOPGEN], 1u);
            else XB_SPIN(xb_ld(&bar[XB_TOPGEN]) == tg, bar);
            __builtin_amdgcn_fence(__ATOMIC_ACQUIRE, "agent");
            xb_add(&bar[XB_XGEN(b.x)], 1u);
            asm volatile("s_waitcnt vmcnt(0)" ::: "memory");
        } else {
            XB_SPIN(xb_ld(&bar[XB_XGEN(b.x)]) == gen, bar);
            __builtin_amdgcn_fence(__ATOMIC_ACQUIRE, "agent");
            asm volatile("s_waitcnt vmcnt(0)" ::: "memory");
        }
    }
    __syncthreads();
}

namespace pg8 {
typedef unsigned u32x4 __attribute__((ext_vector_type(4)));
constexpr int BM = 256, BK = 64, HALF = 128, HTB = HALF * BK * 2, STAGE_BYTES = 8 * HTB, NXCD = 8, WGM = 8;
__device__ __forceinline__ int lds_byte(int r, int c) { const int st = (r >> 4) * 2 + (c >> 5), rr = r & 15, cc = c & 31, ob = rr * 64 + cc * 2; return st * 1024 + (ob ^ (((ob >> 9) & 1) << 5)); }
__device__ __forceinline__ void stage_rc(int b, int& R, int& C) { const int st = b / 1024, sb = b % 1024, swz = sb ^ (((sb >> 9) & 1) << 5); R = (st >> 1) * 16 + swz / 64; C = (st & 1) * 32 + (swz % 64) / 2; }
__device__ __forceinline__ int perm32(int rho) { const int n = rho >> 4, i = rho & 15; return 8 * (i >> 2) + 4 * n + (i & 3); }
struct Unit { const char* A; const char* B; unsigned lda, ldb; int nt, pm, pn, kind, aux; };
__device__ __forceinline__ unsigned cvt_pk_bf16(float lo, float hi) { unsigned r; asm volatile("v_cvt_pk_bf16_f32 %0, %1, %2" : "=v"(r) : "v"(lo), "v"(hi)); return r; }
__device__ __forceinline__ bool static_tile(int nM, int nN, int G, int c, int i, int& pm, int& pn) {
    const int nwg = nM * nN; const long L = (long)i * G + c; if (L >= nwg) return false;
    int wgid = (int)L; { const int q = nwg / NXCD, r = nwg % NXCD, xcd = wgid % NXCD, off = wgid / NXCD; wgid = (xcd < r ? xcd * (q + 1) : r * (q + 1) + (xcd - r) * q) + off; }
    const int nig = WGM * nN, gid = wgid / nig, fm = gid * WGM, gsz = (nM - fm) < WGM ? (nM - fm) : WGM;
    pm = fm + ((wgid % nig) % gsz); pn = (wgid % nig) / gsz; return true;
}
template <class Epi, class Sched>
__device__ __forceinline__ void gemm_phase(LAS unsigned char* lds, const Sched& S, const Epi& E) {
    const int tid = l_tid(), wid = __builtin_amdgcn_readfirstlane(tid >> 6), lane = tid & 63, wr = wid >> 2, wc = wid & 3, fr = lane & 15, fq = lane >> 4;
    int sR[2], sRb[2], sC2[2];
#pragma unroll
    for (int i = 0; i < 2; ++i) { int R, C; stage_rc(tid * 16 + i * 8192, R, C); sR[i] = R; sRb[i] = (R & ~31) + perm32(R & 31); sC2[i] = C * 2; }
    const size_t kstep = (size_t)(BK * 2);
    const unsigned ldsw = (unsigned)wid * 1024u;
    const int aoff = lds_byte(wr * 64 + fr, fq * 8), boff = lds_byte(wc * 32 + fr, fq * 8);
#define PG8_SA(b, h) (((b) * 2 + (h)) * HTB)
#define PG8_SB(b, h) ((4 + (b) * 2 + (h)) * HTB)
#define PG8_STAGE_A(bufoff, gbase, ld) do { \
        __builtin_amdgcn_global_load_lds((const unsigned*)((const char*)(gbase) + (unsigned)(sR[0] * (ld) + sC2[0])), (LAS unsigned*)(lds + (bufoff) + ldsw), 16, 0, 0); \
        __builtin_amdgcn_global_load_lds((const unsigned*)((const char*)(gbase) + (unsigned)(sR[1] * (ld) + sC2[1])), (LAS unsigned*)(lds + (bufoff) + ldsw + 8192), 16, 0, 0); } while (0)
#define PG8_STAGE_B(bufoff, gbase, ld) do { \
        __builtin_amdgcn_global_load_lds((const unsigned*)((const char*)(gbase) + (unsigned)(sRb[0] * (ld) + sC2[0])), (LAS unsigned*)(lds + (bufoff) + ldsw), 16, 0, 0); \
        __builtin_amdgcn_global_load_lds((const unsigned*)((const char*)(gbase) + (unsigned)(sRb[1] * (ld) + sC2[1])), (LAS unsigned*)(lds + (bufoff) + ldsw + 8192), 16, 0, 0); } while (0)
#define PG8_LDA(dst, b, h) do { _Pragma("unroll") for (int m = 0; m < 4; ++m) _Pragma("unroll") for (int k = 0; k < 2; ++k) dst[m][k] = *(const LAS bf16x8*)(lds + PG8_SA(b, h) + aoff + m * 2048 + k * 1024); } while (0)
#define PG8_LDB(dst, b, h) do { _Pragma("unroll") for (int n = 0; n < 2; ++n) _Pragma("unroll") for (int k = 0; k < 2; ++k) dst[n][k] = *(const LAS bf16x8*)(lds + PG8_SB(b, h) + boff + n * 2048 + k * 1024); } while (0)
#define PG8_MMA(ai, bj, At, Bt) do { __builtin_amdgcn_s_setprio(1); _Pragma("unroll") for (int m = 0; m < 4; ++m) _Pragma("unroll") for (int n = 0; n < 2; ++n) _Pragma("unroll") for (int k = 0; k < 2; ++k) \
        acc[ai][bj][m][n] = __builtin_amdgcn_mfma_f32_16x16x32_bf16(Bt[n][k], At[m][k], acc[ai][bj][m][n], 0, 0, 0); __builtin_amdgcn_s_setprio(0); } while (0)
#define PG8_WAIT_V(n) asm volatile("s_waitcnt vmcnt(" #n ")" ::: "memory")
#define PG8_WAIT_L(n) asm volatile("s_waitcnt lgkmcnt(" #n ")" ::: "memory")
#define PG8_BAR __builtin_amdgcn_s_barrier()
#define PG8_SCHED __builtin_amdgcn_sched_barrier(0)
    Unit cur, nxt; int ui = 0;
    if (!S.next(0, cur)) return;
    f32x4 acc[2][2][4][2];
#pragma unroll
    for (int a = 0; a < 2; ++a)
#pragma unroll
        for (int b = 0; b < 2; ++b)
#pragma unroll
            for (int m = 0; m < 4; ++m)
#pragma unroll
                for (int n = 0; n < 2; ++n) acc[a][b][m][n] = (f32x4){0.f, 0.f, 0.f, 0.f};
    bf16x8 At[4][2], B0[2][2], B1[2][2];
    const char* cA = cur.A; const char* cB = cur.B;
    int clda = cur.lda, cldb = cur.ldb;
    PG8_STAGE_B(PG8_SB(0, 0), cB, cldb); PG8_STAGE_B(PG8_SB(0, 1), cB + (size_t)HALF * cldb, cldb); PG8_STAGE_A(PG8_SA(0, 0), cA, clda); PG8_STAGE_A(PG8_SA(0, 1), cA + (size_t)HALF * clda, clda);
    if (wr == 1) PG8_BAR;
    PG8_WAIT_V(2); PG8_BAR;
    PG8_STAGE_B(PG8_SB(1, 0), cB + kstep, cldb); PG8_STAGE_A(PG8_SA(1, 0), cA + kstep, clda); PG8_STAGE_B(PG8_SB(1, 1), cB + (size_t)HALF * cldb + kstep, cldb);
    PG8_WAIT_V(6); PG8_BAR;
    for (;;) {
        const bool has_next = S.next(ui + 1, nxt);
        const char* nA = has_next ? nxt.A : cA; const char* nB = has_next ? nxt.B : cB;
        const int nlda = has_next ? (int)nxt.lda : clda, nldb = has_next ? (int)nxt.ldb : cldb;
        const int nt = cur.nt;
        for (int t = 0; t < nt; t += 2) {
            const bool last = (t == nt - 2);
            const char* a1 = cA + (size_t)(t + 1) * kstep;
            const char* a2 = last ? nA : cA + (size_t)(t + 2) * kstep; const char* b2 = last ? nB : cB + (size_t)(t + 2) * kstep;
            const char* a3 = a2 + kstep; const char* b3 = b2 + kstep;
            const int lda2 = last ? nlda : clda, ldb2 = last ? nldb : cldb;
            PG8_LDB(B0, 0, 0); PG8_LDB(B1, 0, 1); PG8_SCHED; PG8_LDA(At, 0, 0); PG8_STAGE_A(PG8_SA(1, 1), a1 + (size_t)HALF * clda, clda);
            PG8_WAIT_V(8); PG8_WAIT_L(0); PG8_BAR; PG8_MMA(0, 0, At, B0); PG8_MMA(0, 1, At, B1); PG8_BAR; PG8_SCHED;
            PG8_LDA(At, 0, 1); PG8_STAGE_B(PG8_SB(0, 0), b2, ldb2); PG8_STAGE_B(PG8_SB(0, 1), b2 + (size_t)HALF * ldb2, ldb2); PG8_STAGE_A(PG8_SA(0, 0), a2, lda2);
            PG8_WAIT_V(8); PG8_WAIT_L(0); PG8_BAR; PG8_MMA(1, 0, At, B0); PG8_MMA(1, 1, At, B1); PG8_BAR; PG8_SCHED;
            PG8_LDB(B0, 1, 0); PG8_LDB(B1, 1, 1); PG8_SCHED; PG8_LDA(At, 1, 0); PG8_STAGE_A(PG8_SA(0, 1), a2 + (size_t)HALF * lda2, lda2);
            PG8_WAIT_V(8); PG8_WAIT_L(0); PG8_BAR; PG8_MMA(0, 0, At, B0); PG8_MMA(0, 1, At, B1); PG8_BAR; PG8_SCHED;
            PG8_LDA(At, 1, 1); PG8_STAGE_B(PG8_SB(1, 0), b3, ldb2); PG8_STAGE_B(PG8_SB(1, 1), b3 + (size_t)HALF * ldb2, ldb2); PG8_STAGE_A(PG8_SA(1, 0), a3, lda2);
            PG8_WAIT_V(8); PG8_WAIT_L(0); PG8_BAR; PG8_MMA(1, 0, At, B0); PG8_MMA(1, 1, At, B1); PG8_BAR; PG8_SCHED;
        }
        if (wr == 0) PG8_BAR;
        E(acc, cur, wr, wc, fr, fq);
        if (!has_next) break;
#pragma unroll
        for (int a = 0; a < 2; ++a)
#pragma unroll
            for (int b = 0; b < 2; ++b)
#pragma unroll
                for (int m = 0; m < 4; ++m)
#pragma unroll
                    for (int n = 0; n < 2; ++n) acc[a][b][m][n] = (f32x4){0.f, 0.f, 0.f, 0.f};
        cur = nxt; cA = nA; cB = nB; clda = nlda; cldb = nldb; ++ui;
        if (wr == 1) PG8_BAR;
    }
    PG8_WAIT_V(0);
    PG8_BAR;
#undef PG8_SA
#undef PG8_SB
#undef PG8_STAGE_A
#undef PG8_STAGE_B
#undef PG8_LDA
#undef PG8_LDB
#undef PG8_MMA
#undef PG8_WAIT_V
#undef PG8_WAIT_L
#undef PG8_BAR
#undef PG8_SCHED
}
}

__device__ __forceinline__ pg8::u32x4 pack8(const f32x4 a, const f32x4 b) { pg8::u32x4 w; w.x = pg8::cvt_pk_bf16(a[0], a[1]); w.y = pg8::cvt_pk_bf16(a[2], a[3]); w.z = pg8::cvt_pk_bf16(b[0], b[1]); w.w = pg8::cvt_pk_bf16(b[2], b[3]); return w; }
__device__ __forceinline__ void unpack8(const pg8::u32x4 w, f32x4& a, f32x4& b) {
    a[0] = __uint_as_float(w.x << 16); a[1] = __uint_as_float(w.x & 0xffff0000u); a[2] = __uint_as_float(w.y << 16); a[3] = __uint_as_float(w.y & 0xffff0000u);
    b[0] = __uint_as_float(w.z << 16); b[1] = __uint_as_float(w.z & 0xffff0000u); b[2] = __uint_as_float(w.w << 16); b[3] = __uint_as_float(w.w & 0xffff0000u); }
namespace fa {
typedef float f32x16 __attribute__((ext_vector_type(16)));
typedef short s16x4 __attribute__((ext_vector_type(4)));
typedef unsigned u32x4 __attribute__((ext_vector_type(4)));
typedef unsigned u32x2 __attribute__((ext_vector_type(2)));
__device__ __forceinline__ s16x4 vtr(const LAS char* p) { return __builtin_bit_cast(s16x4, __builtin_amdgcn_ds_read_tr16_b64_v4i16((LAS s16x4*)p)); }
__device__ __forceinline__ unsigned pk2(float lo, float hi) { unsigned r; asm volatile("v_cvt_pk_bf16_f32 %0, %1, %2" : "=v"(r) : "v"(lo), "v"(hi)); return r; }
__device__ __forceinline__ bf16x8 pack_p(const f32x16& p, int base) { u32x4 w; w.x = pk2(p[base], p[base + 1]); w.y = pk2(p[base + 2], p[base + 3]); w.z = pk2(p[base + 4], p[base + 5]); w.w = pk2(p[base + 6], p[base + 7]); return __builtin_bit_cast(bf16x8, w); }
__device__ __forceinline__ int crow(int r, int hi) { return (r & 3) + 8 * (r >> 2) + 4 * hi; }
__device__ __forceinline__ void pv_tile(f32x16& o0, f32x16& o1, const LAS char* vb, const bf16x8 (&pf)[4]) {
#pragma unroll
    for (int ks = 0; ks < 4; ++ks) {
        const s16x4 a0 = vtr(vb + ks * 1024), a1 = vtr(vb + ks * 1024 + 512), b0 = vtr(vb + 4096 + ks * 1024), b1 = vtr(vb + 4096 + ks * 1024 + 512);
        const bf16x8 v0 = (bf16x8){a0[0], a0[1], a0[2], a0[3], a1[0], a1[1], a1[2], a1[3]}, v1 = (bf16x8){b0[0], b0[1], b0[2], b0[3], b1[0], b1[1], b1[2], b1[3]};
        o0 = __builtin_amdgcn_mfma_f32_32x32x16_bf16(v0, pf[ks], o0, 0, 0, 0);
        o1 = __builtin_amdgcn_mfma_f32_32x32x16_bf16(v1, pf[ks], o1, 0, 0, 0);
    }
}
constexpr int KP_A = 208, KT_A = 64 * KP_A, VT = 8192, BUF_A = KT_A + VT;
constexpr int KP_R = 144, KT_R = 64 * KP_R, BUF_R = KT_R + VT;
}

#define GSTRIDE(gi, total) for (int gi = bid_ * NT + tid_; gi < (total); gi += G_ * NT)
__device__ __forceinline__ void ph_mod(unsigned char* lds, const float* c, const float* c_ctx, const float* ada_w, const float* ada_b, float* mod) { PH_IDS;
    float (*sl)[1024] = (float (*)[1024])lds;
    float* red = (float*)(lds + 9 * 1024 * 4);
    for (int e = tid_; e < 9 * 1024; e += NT) { const int j = e >> 10, k = e & 1023; const float v = j < 8 ? c[j * 1024 + k] : c_ctx[k]; sl[j][k] = siluf_(v); }
    __syncthreads();
    const int nn = tid_ & 63, ks = tid_ >> 6;
    for (int u = bid_; u < 2 * 96; u += G_) {
        const int l = u / 96, n = (u % 96) * 64 + nn;
        float acc[9];
#pragma unroll
        for (int j = 0; j < 9; ++j) acc[j] = 0.f;
        const float* w = ada_w + ((size_t)l * 1024 + ks * 128) * 6144 + n;
#pragma unroll 4
        for (int k = 0; k < 128; ++k) { const float wv = w[(size_t)k * 6144];
#pragma unroll
            for (int j = 0; j < 9; ++j) acc[j] += sl[j][ks * 128 + k] * wv; }
        __syncthreads();
#pragma unroll
        for (int j = 0; j < 9; ++j) red[(ks * 9 + j) * 64 + nn] = acc[j];
        __syncthreads();
        for (int e = tid_; e < 9 * 64; e += NT) { const int j = e >> 6, q = e & 63; float sum = 0.f;
#pragma unroll
            for (int r = 0; r < 8; ++r) sum += red[(r * 9 + j) * 64 + q];
            const int col = (u % 96) * 64 + q; mod[((size_t)l * 9 + j) * 6144 + col] = sum + ada_b[l * 6144 + col]; }
    }
    __syncthreads();
}
__device__ __forceinline__ void ph_trig(float* trig, bf16_t* d64) { PH_IDS; GSTRIDE(i, 2048) { const float xx = (float)i * (1.f / 1024.f); trig[i] = cospif(xx); trig[2048 + i] = sinpif(xx); }
    GSTRIDE(i, 128 * 64) { const int n = i >> 6, c = i & 63, m = n & 63; const float xx = (float)((m * c) & 63) * (1.f / 32.f); d64[i] = f2bf(n < 64 ? cospif(xx) : sinpif(xx)); } }
__device__ __forceinline__ double2 lam_pow(double re, double im, double dt, int k) {
    const double m = (double)__expf((float)(re * dt * k));
    double xx = im * dt * (double)k * 0.318309886183790671538;
    xx -= 2.0 * rint(xx * 0.5);
    const float xf = (float)xx;
    return make_double2(m * (double)cospif(xf), m * (double)sinpif(xf));
}
__device__ __forceinline__ void ph_s5_lp(int l, const float* lam_re, const float* lam_im, const float* log_step, const float* b_re, const float* b_im, float2* LP, float2* BB, float* lamT) { PH_IDS;
    GSTRIDE(it, 2 * 16 * 64 * 81) {
        const int i = it / 81, k = it % 81;
        const int d = i / 1024, g = (i / 64) % 16, p = i % 64;
        const size_t li = ((size_t)(l * 2 + d) * 16 + g) * 64 + p;
        const double re = lam_re[li], im = lam_im[li], dt = (double)expf(log_step[(l * 2 + d) * 16 + g]);
        if (k <= 64) {
            const double2 v = lam_pow(re, im, dt, k); LP[(size_t)i * 65 + k] = make_float2((float)v.x, (float)v.y);
            if (k == 64) { lamT[((size_t)(g * 2 + d) * 64 + p) * 2 + 0] = (float)v.x; lamT[((size_t)(g * 2 + d) * 64 + p) * 2 + 1] = (float)v.y; }
        } else {
            const int h = k - 65;
            const double2 l1 = lam_pow(re, im, dt, 1);
            const double nr = l1.x - 1.0, ni = l1.y, den = re * re + im * im;
            const double fr = (nr * re + ni * im) / den, fi = (ni * re - nr * im) / den;
            const double br = b_re[li * 16 + h], bi = b_im[li * 16 + h]; BB[(size_t)i * 16 + h] = make_float2((float)(fr * br - fi * bi), (float)(fr * bi + fi * br));
        }
    }
}
__device__ __forceinline__ void ph_s5_tz(unsigned char* lds_, int l, const float2* LP, const float2* BB, const float* c_re, const float* c_im, float* TZD) { PH_IDS;
    float2* sC = (float2*)lds_;
    float2* sL = sC + 16 * 64;
    float2* sB = sL + 64 * 65;
    for (int u = bid_; u < 32; u += G_) {
        const int g = u >> 1, d = u & 1;
        __syncthreads();
        for (int e = tid_; e < 16 * 64; e += NT) { const size_t ci = (((size_t)(l * 2 + d) * 16 + g) * 16) * 64 + e; sC[e] = make_float2(c_re[ci], c_im[ci]); }
        for (int e = tid_; e < 64 * 65; e += NT) sL[e] = LP[((size_t)d * 16 + g) * 64 * 65 + e];
        for (int e = tid_; e < 64 * 16; e += NT) sB[e] = BB[((size_t)d * 16 + g) * 64 * 16 + e];
        __syncthreads();
#pragma unroll 1
        for (int i = 0; i < 2; ++i) {
            const int r = tid_ + NT * i, tau = r >> 4, h = r & 15;
            float acc[16];
#pragma unroll
            for (int q = 0; q < 16; ++q) acc[q] = 0.f;
            for (int p = 0; p < 64; ++p) {
                const float2 c = sC[h * 64 + p], lp = sL[p * 65 + tau];
                const float er = c.x * lp.x - c.y * lp.y, ei = c.x * lp.y + c.y * lp.x;
#pragma unroll
                for (int q = 0; q < 16; ++q) { const float2 bb = sB[p * 16 + q]; acc[q] += er * bb.x - ei * bb.y; }
            }
            float* o = TZD + ((((size_t)d * 16 + g) * 64 + tau) * 16 + h) * 16;
#pragma unroll
            for (int q = 0; q < 4; ++q) *(f32x4*)(o + 4 * q) = (f32x4){acc[4 * q], acc[4 * q + 1], acc[4 * q + 2], acc[4 * q + 3]};
        }
    }
    __syncthreads();
}
__device__ __forceinline__ void ph_s5_ms(const float2* LP, const float2* BB, bf16_t* MST) { PH_IDS;
    GSTRIDE(i, 16 * 256 * 128) {
        const int g = i / (256 * 128), n = (i / 128) % 256, sh0 = (i % 128) * 8, d = n >> 7, p = n & 63, im = (n >> 6) & 1, s = sh0 >> 4, hp0 = sh0 & 15;
        const size_t gi = ((size_t)d * 16 + g) * 64 + p;
        const float2 lp = LP[gi * 65 + (d == 0 ? 63 - s : s)];
        float v[8];
#pragma unroll
        for (int q = 0; q < 8; ++q) { const float2 bb = BB[gi * 16 + hp0 + q]; v[q] = im ? lp.x * bb.y + lp.y * bb.x : lp.x * bb.x - lp.y * bb.y; }
        *(pg8::u32x4*)(MST + ((size_t)g * 256 + n) * 1024 + sh0) = pack8((f32x4){v[0], v[1], v[2], v[3]}, (f32x4){v[4], v[5], v[6], v[7]});
    }
}
__device__ __forceinline__ void ph_s5_qo(int l, const float2* LP, const float* c_re, const float* c_im, bf16_t* QOT) { PH_IDS;
    GSTRIDE(i, 16 * 1024 * 32) {
        const int g = i / (1024 * 32), th = (i / 32) % 1024, j0 = (i % 32) * 8, d = j0 >> 7, im = (j0 >> 6) & 1, p0 = j0 & 63, t = th >> 4, h = th & 15;
        const size_t ci = (((size_t)(l * 2 + d) * 16 + g) * 16 + h) * 64 + p0;
        const int e = d == 0 ? t + 1 : 64 - t;
        float v[8];
#pragma unroll
        for (int q = 0; q < 8; ++q) { const float cr = c_re[ci + q], cim = c_im[ci + q]; const float2 lp = LP[(((size_t)d * 16 + g) * 64 + p0 + q) * 65 + e]; v[q] = im ? -(cr * lp.y + cim * lp.x) : cr * lp.x - cim * lp.y; }
        *(pg8::u32x4*)(QOT + ((size_t)g * 1024 + th) * 256 + j0) = pack8((f32x4){v[0], v[1], v[2], v[3]}, (f32x4){v[4], v[5], v[6], v[7]});
    }
}
__device__ __forceinline__ void ph_adarms(const float* xlat, const float* xctx, const float* w, const float* mod, int sh_chunk, int sc_chunk, bf16_t* out, int nrows) { PH_IDS;
    const int wave = (bid_ * NT + tid_) >> 6, lane = tid_ & 63, nw = (G_ * NT) >> 6;
    for (int row = wave; row < nrows; row += nw) {
        const float* x = row < RL ? xlat + (size_t)row * DM : xctx + (size_t)(row - RL) * DM;
        f32x4 v[4]; float ss = 0.f;
#pragma unroll
        for (int j = 0; j < 4; ++j) { v[j] = *(const f32x4*)(x + j * 256 + lane * 4); ss += v[j][0] * v[j][0] + v[j][1] * v[j][1] + v[j][2] * v[j][2] + v[j][3] * v[j][3]; }
#pragma unroll
        for (int o = 1; o < 64; o <<= 1) ss += __shfl_xor(ss, o);
        const float rstd = rsqrtf(ss * (1.f / DM) + EPS);
        const float* mrow = mod + (size_t)row_modidx(row) * 6144;
#pragma unroll
        for (int j = 0; j < 4; ++j) { const int c0 = j * 256 + lane * 4;
            const f32x4 wv = *(const f32x4*)(w + c0), sc = *(const f32x4*)(mrow + sc_chunk * 1024 + c0), sh = *(const f32x4*)(mrow + sh_chunk * 1024 + c0);
            const f32x4 y = v[j] * rstd * wv * (sc + 1.f) + sh;
            fa::u32x2 o; o.x = fa::pk2(y[0], y[1]); o.y = fa::pk2(y[2], y[3]);
            *(fa::u32x2*)(out + (size_t)row * DM + c0) = o; }
    }
}
__device__ __forceinline__ void ph_mla_stats(const bf16_t* Z, float* rs) { PH_IDS;
    const int wave = (bid_ * NT + tid_) >> 6, lane = tid_ & 63, nw = (G_ * NT) >> 6;
    for (int row = wave; row < RT; row += nw) {
        const bf16_t* z = Z + (size_t)row * ZW; float sq = 0.f, sk = 0.f;
#pragma unroll
        for (int j = 0; j < 4; ++j) { const float v = bf2f(z[C_QC + j * 64 + lane]); sq += v * v; }
#pragma unroll
        for (int j = 0; j < 2; ++j) { const float v = bf2f(z[C_KVC + j * 64 + lane]); sk += v * v; }
#pragma unroll
        for (int o = 1; o < 64; o <<= 1) { sq += __shfl_xor(sq, o); sk += __shfl_xor(sk, o); }
        if (lane == 0) { rs[(size_t)row * 2] = rsqrtf(sq * (1.f / 256) + EPS); rs[(size_t)row * 2 + 1] = rsqrtf(sk * (1.f / 128) + EPS); }
    }
}
__device__ __forceinline__ void ph_mla_post(const bf16_t* Z, const bf16_t* qraw, const bf16_t* kvraw, const float* qkq, const float* qkk, bf16_t* Q, bf16_t* Kb, bf16_t* Vb) { PH_IDS;
    GSTRIDE(gi, RT * 8) {
        const int row = gi >> 3, h = (gi >> 1) & 3, isk = gi & 1;
        const bool lat = row < RL; const int b = row_batch(row), t = lat ? (row & 2047) : ((row - RL) & 255);
        const int qi = lat ? t : 2048 + t, ki = lat ? 256 + t : t;
        float v[96];
        float ss = 0.f;
        if (!isk) {
#pragma unroll
            for (int i = 0; i < 96; ++i) v[i] = bf2f(qraw[(size_t)row * 384 + h * 96 + i]);
        } else {
#pragma unroll
            for (int i = 0; i < 64; ++i) v[i] = bf2f(kvraw[(size_t)row * 512 + h * 128 + i]);
#pragma unroll
            for (int i = 0; i < 32; ++i) v[64 + i] = bf2f(Z[(size_t)row * ZW + C_KR + i]);
        }
#pragma unroll
        for (int i = 0; i < 96; ++i) ss += v[i] * v[i];
        const float rr = rsqrtf(ss * (1.f / 96) + EPS) * (isk ? 1.f : 0.14724727430627066f);
        const float* wv = isk ? qkk : qkq;
#pragma unroll
        for (int i = 0; i < 96; ++i) v[i] = v[i] * rr * wv[i];
        if (lat) {
            const float prow = (float)(t >> 6), pcol = (float)(t & 63);
#pragma unroll
            for (int part = 0; part < 2; ++part) { const float pos = part ? pcol : prow; const int base = 64 + part * 16;
#pragma unroll
                for (int j = 0; j < 8; ++j) { const float fr = exp2f(-(float)j * (13.287712379549449f / 8.f)), a = pos * fr, cs = __cosf(a), sn = __sinf(a);
                    const float x1 = v[base + j], x2 = v[base + 8 + j]; v[base + j] = x1 * cs - x2 * sn; v[base + 8 + j] = x1 * sn + x2 * cs; } }
        }
        bf16_t* o = isk ? Kb + ((size_t)(b * 4 + h) * 2304 + ki) * 96 : Q + ((size_t)(b * 4 + h) * 2304 + qi) * 96;
#pragma unroll
        for (int i = 0; i < 96; ++i) o[i] = f2bf(v[i]);
        if (isk) { bf16_t* vo = Vb + ((size_t)(b * 4 + h) * 2304 + ki) * 64; for (int i = 0; i < 64; ++i) vo[i] = kvraw[(size_t)row * 512 + h * 128 + 64 + i]; }
    }
}
__device__ __forceinline__ void ph_attn(unsigned char* lds, const bf16_t* Q, const bf16_t* Kb, const bf16_t* Vb, bf16_t* Z, int with_ctx) { PH_IDS;
    float (*sK)[96] = (float (*)[96])lds; float (*sV)[64] = (float (*)[64])(lds + 32 * 96 * 4);
    const int nunits = 32 * (8 + (with_ctx ? 1 : 0));
    const int qt = tid_ & 255, dh = (tid_ >> 8) * 32;
    for (int u = bid_; u < nunits; u += G_) {
        const int bh = u % 32, qb = u / 32;
        const bool lat = qb < 8;
        const int qi = qb * 256 + qt, nkeys = lat ? 2304 : 256;
        float q[96], o[32];
        const bf16_t* qp = Q + ((size_t)bh * 2304 + qi) * 96;
#pragma unroll
        for (int i = 0; i < 96; ++i) q[i] = bf2f(qp[i]) * 0.10206207261596577f;
#pragma unroll
        for (int i = 0; i < 32; ++i) o[i] = 0.f;
        float mx = -1e30f, l = 0.f;
        for (int k0 = 0; k0 < nkeys; k0 += 32) {
            __syncthreads();
            for (int e = tid_; e < 32 * 96; e += NT) sK[e / 96][e % 96] = bf2f(Kb[((size_t)bh * 2304 + k0) * 96 + e]);
            for (int e = tid_; e < 32 * 64; e += NT) sV[e / 64][e % 64] = bf2f(Vb[((size_t)bh * 2304 + k0) * 64 + e]);
            __syncthreads();
#pragma unroll 1
            for (int j = 0; j < 32; ++j) { float a = 0.f;
#pragma unroll
                for (int i = 0; i < 96; ++i) a += q[i] * sK[j][i];
                if (a > mx) { const float corr = __expf(mx - a); mx = a; l *= corr;
#pragma unroll
                    for (int i = 0; i < 32; ++i) o[i] *= corr; }
                const float p = __expf(a - mx); l += p;
#pragma unroll
                for (int i = 0; i < 32; ++i) o[i] += p * sV[j][dh + i]; }
        }
        const int b = bh >> 2, h = bh & 3;
        const int row = lat ? b * 2048 + qi : RL + b * 256 + (qi - 2048);
        const float inv = 1.f / l;
#pragma unroll
        for (int i = 0; i < 32; ++i) Z[(size_t)row * ZW + C_QC + h * 64 + dh + i] = f2bf(o[i] * inv);
    }
    __syncthreads();
}
__device__ __forceinline__ void ph_f1(const bf16_t* Z, const float* trig, bf16_t* F1lat, bf16_t* F1ctx) { PH_IDS;
    GSTRIDE(gi, RT * 256) {
        const int row = gi >> 8, gm = gi & 255, g = gm >> 6, m = gm & 63;
        float a = 0.f, bsum = 0.f;
        const bf16_t* u = Z + (size_t)row * ZW + C_FU + g * 64;
        for (int c = 0; c < 64; ++c) { const float v = bf2f(u[c]); const int idx = ((m * c) & 63) * 32; a += v * trig[idx]; bsum += v * trig[2048 + idx]; }
        if (row < RL) { const int b = row >> 11, t = row & 2047; bf16_t* o = F1lat + ((size_t)(b * 256 + gm) * 2) * 2048; o[t] = f2bf(a); o[2048 + t] = f2bf(bsum); }
        else { const int r = row - RL, b = r >> 8, t = r & 255; bf16_t* o = F1ctx + ((size_t)(b * 256 + gm) * 2) * 256; o[t] = f2bf(a); o[256 + t] = f2bf(bsum); }
    }
}
struct A_dft { const float* trig; long long L; long long mul;
    __device__ float operator()(int, int k, int kk) const { const int part = kk >= (int)L, t = part ? kk - (int)L : kk; const int idx = (int)(((long long)k * t) & (L - 1)) * (int)mul; return part ? -trig[2048 + idx] : trig[idx]; } };
struct B_f1t { const bf16_t* p; long long L;
    __device__ float operator()(int b, int kk, int n) const { return bf2f(p[((size_t)(b * 256 + n)) * 2 * L + kk]); } };
struct E_fourier { bf16_t* Z; long long rowbase; long long L; double scale;
    __device__ void operator()(int b, int m, int n, float v) const { Z[((size_t)rowbase + (size_t)b * L + m) * ZW + C_FU + n] = f2bf(v * (float)scale); } };

struct A_s5u { const bf16_t* Z;
    __device__ float operator()(int g, int rc, int k) const { return bf2f(Z[((size_t)rc * 64 + (k >> 4)) * ZW + C_S5 + g * 16 + (k & 15)]); } };
struct B_ms { const bf16_t* MS; __device__ float operator()(int g, int k, int n) const { return bf2f(MS[((size_t)g * 1024 + k) * 256 + n]); } };
struct E_sloc { float* S; __device__ void operator()(int g, int rc, int n, float v) const { S[((size_t)rc * 16 + g) * 256 + n] = v; } };
__device__ __forceinline__ void ph_s5_scan(const float* SLOC, const float* lamT, float* XP) { PH_IDS;
    GSTRIDE(i, 8 * 16 * 2 * 64) {
        const int b = i / 2048, g = (i / 128) % 16, d = (i / 64) % 2, p = i % 64;
        const float lr = lamT[((size_t)(g * 2 + d) * 64 + p) * 2], li = lamT[((size_t)(g * 2 + d) * 64 + p) * 2 + 1];
        float xr = 0.f, xi = 0.f;
        for (int step = 0; step < 36; ++step) {
            int rc;
            if (d == 0) rc = step < 4 ? 256 + b * 4 + step : b * 32 + (step - 4);
            else rc = step < 4 ? 256 + b * 4 + (3 - step) : b * 32 + (31 - (step - 4));
            const size_t o = ((size_t)rc * 16 + g) * 256 + d * 128;
            XP[o + p] = xr; XP[o + 64 + p] = xi;
            const float sr = SLOC[o + p], si = SLOC[o + 64 + p];
            const float nr = lr * xr - li * xi + sr, ni = lr * xi + li * xr + si; xr = nr; xi = ni;
        }
    }
}
struct A_s5out { const bf16_t* Z; const float* XP;
    __device__ float operator()(int g, int rc, int k) const { return k < 1024 ? bf2f(Z[((size_t)rc * 64 + (k >> 4)) * ZW + C_S5 + g * 16 + (k & 15)]) : XP[((size_t)rc * 16 + g) * 256 + (k - 1024)]; } };
struct B_s5out { const float* TZ; const bf16_t* QO;
    __device__ float operator()(int g, int k, int n) const { if (k < 1024) { const int s = k >> 4, hp = k & 15, t = n >> 4, h = n & 15; return TZ[(((size_t)g * 127 + (t - s + 63)) * 16 + hp) * 16 + h]; } return bf2f(QO[((size_t)g * 256 + (k - 1024)) * 1024 + n]); } };
struct E_s5out { bf16_t* YG; __device__ void operator()(int g, int rc, int n, float v) const { YG[((size_t)rc * 64 + (n >> 4)) * 256 + g * 16 + (n & 15)] = f2bf(geluf_(v)); } };
__device__ __forceinline__ void ph_glu(const bf16_t* GL, bf16_t* Z) { PH_IDS;
    GSTRIDE(gi, RT * 256) {
        const int row = gi >> 8, j = gi & 255;
        const float val = bf2f(GL[(size_t)row * 512 + j]), gate = bf2f(GL[(size_t)row * 512 + 256 + j]);
        Z[(size_t)row * ZW + C_S5 + j] = f2bf(val * sigmoidf_(gate));
    }
}
__device__ __forceinline__ void ph_ret_prep(bf16_t* Z) { PH_IDS;
    GSTRIDE(gi, RT * 4 * 32) {
        const int row = gi >> 7, h = (gi >> 5) & 3, j = gi & 31;
        bf16_t* z = Z + (size_t)row * ZW;
        if (row < RL) {
            const int t = row & 2047; const float fr = exp2f(-(float)j * (13.287712379549449f / 32.f)), a = (float)t * fr, cs = cosf(a), sn = sinf(a);
            { const float x1 = bf2f(z[C_RQ + h * 64 + j]), x2 = bf2f(z[C_RQ + h * 64 + 32 + j]); z[C_RQ + h * 64 + j] = f2bf(x1 * cs - x2 * sn); z[C_RQ + h * 64 + 32 + j] = f2bf(x1 * sn + x2 * cs); }
            { const float x1 = bf2f(z[C_RK + h * 64 + j]), x2 = bf2f(z[C_RK + h * 64 + 32 + j]); z[C_RK + h * 64 + j] = f2bf((x1 * cs - x2 * sn) * 0.125f); z[C_RK + h * 64 + 32 + j] = f2bf((x1 * sn + x2 * cs) * 0.125f); }
        } else {
            z[C_RK + h * 64 + j] = f2bf(bf2f(z[C_RK + h * 64 + j]) * 0.125f); z[C_RK + h * 64 + 32 + j] = f2bf(bf2f(z[C_RK + h * 64 + 32 + j]) * 0.125f);
        }
    }
}
__device__ __forceinline__ void ph_ret(unsigned char* lds, bf16_t* Z, const float* decay_logit, const float* gn_w, int with_ctx) { PH_IDS;
    float (*sK)[64] = (float (*)[64])lds; float (*sV)[64] = (float (*)[64])(lds + 32 * 64 * 4);
    float* sred = (float*)(lds + 2 * 32 * 64 * 4);
    const int nunits = 32 * (8 + (with_ctx ? 1 : 0));
    const int qt = tid_ & 255, hh = tid_ >> 8, dh = hh * 32;
    for (int u = bid_; u < nunits; u += G_) {
        const int bh = u % 32, qb = u / 32, b = bh >> 2, h = bh & 3;
        const bool lat = qb < 8;
        const int qpos = lat ? qb * 256 + qt : qt;
        const int qrow = lat ? b * 2048 + qpos : RL + b * 256 + qpos;
        const float lgf = -log1pf(__expf(-decay_logit[h])) * 1.4426950408889634f, lgb = -log1pf(__expf(-decay_logit[4 + h])) * 1.4426950408889634f;
        float q[64], o[32];
#pragma unroll
        for (int i = 0; i < 64; ++i) q[i] = bf2f(Z[(size_t)qrow * ZW + C_RQ + h * 64 + i]);
#pragma unroll
        for (int i = 0; i < 32; ++i) o[i] = 0.f;
        const int nkeys = lat ? 2560 : 256;
        for (int k0 = 0; k0 < nkeys; k0 += 32) {
            int krow0, kpos0;
            if (lat) { if (k0 < 256) { krow0 = RL + b * 256 + k0; kpos0 = k0 - 256; } else if (k0 < 2304) { krow0 = b * 2048 + (k0 - 256); kpos0 = k0 - 256; } else { krow0 = RL + b * 256 + (k0 - 2304); kpos0 = 2048 + (k0 - 2304); } }
            else { krow0 = RL + b * 256 + k0; kpos0 = k0; }
            __syncthreads();
            for (int e = tid_; e < 32 * 64; e += NT) { const int j = e >> 6, i = e & 63; sK[j][i] = bf2f(Z[(size_t)(krow0 + j) * ZW + C_RK + h * 64 + i]); sV[j][i] = bf2f(Z[(size_t)(krow0 + j) * ZW + C_RV + h * 64 + i]); }
            __syncthreads();
#pragma unroll 1
            for (int j = 0; j < 32; ++j) { float a = 0.f;
#pragma unroll
                for (int i = 0; i < 64; ++i) a += q[i] * sK[j][i];
                const int dpos = qpos - (kpos0 + j);
                const float dec = dpos > 0 ? exp2f(lgf * (float)dpos) : (dpos < 0 ? exp2f(lgb * (float)(-dpos)) : 2.f);
                a *= dec;
#pragma unroll
                for (int i = 0; i < 32; ++i) o[i] += a * sV[j][dh + i]; }
        }
        float s1 = 0.f;
#pragma unroll
        for (int i = 0; i < 32; ++i) s1 += o[i];
        __syncthreads();
        sred[hh * 256 + qt] = s1;
        __syncthreads();
        const float mu = (sred[qt] + sred[256 + qt]) * (1.f / 64);
        float s2 = 0.f;
#pragma unroll
        for (int i = 0; i < 32; ++i) { const float d = o[i] - mu; s2 += d * d; }
        __syncthreads();
        sred[hh * 256 + qt] = s2;
        __syncthreads();
        const float rstd = rsqrtf((sred[qt] + sred[256 + qt]) * (1.f / 64) + EPS);
#pragma unroll
        for (int i = 0; i < 32; ++i) { const float gte = bf2f(Z[(size_t)qrow * ZW + C_RG + h * 64 + dh + i]); const float y = (o[i] - mu) * rstd * gn_w[h * 64 + dh + i];
            Z[(size_t)qrow * ZW + C_RQ + h * 64 + dh + i] = f2bf(siluf_(gte) * y); }
    }
    __syncthreads();
}
struct E_merge { const bf16_t* stash; bf16_t* MMp; long long first;
    __device__ void operator()(int, int m, int n, float v) const { const size_t i = (size_t)m * DM + n; const float t = sigmoidf_(v) * bf2f(stash[i]); MMp[i] = f2bf(first ? t : bf2f(MMp[i]) + t); } };
struct E_resid { const float* xlat; const float* xctx; float* olat; float* octx; const float* mod; long long gchunk;
    __device__ void operator()(int, int m, int n, float v) const {
        const float g = mod[(size_t)row_modidx(m) * 6144 + gchunk * 1024 + n];
        if (m < RL) olat[(size_t)m * DM + n] = xlat[(size_t)m * DM + n] + g * v; else octx[(size_t)(m - RL) * DM + n] = xctx[(size_t)(m - RL) * DM + n] + g * v; } };
struct E_relu2 { bf16_t* H; __device__ void operator()(int, int m, int n, float v) const { const float r = fmaxf(v, 0.f); H[(size_t)m * DFF + n] = f2bf(r * r); } };


__device__ __forceinline__ void ph_s5_sloc(const bf16_t* Z, const bf16_t* MST, float* SLOC) { PH_IDS;
    const int lane = tid_ & 63, wid = __builtin_amdgcn_readfirstlane(tid_ >> 6), c16 = lane & 15, kq = lane >> 4;
    for (int u = bid_; u < 16 * 18; u += G_) {
        const int g = u / 18, rcbase = (u % 18) * 16;
        const bf16_t* up = Z + ((size_t)(rcbase + c16) * 64 + (kq >> 1)) * ZW + C_S5 + g * 16 + 8 * (kq & 1);
        const bf16_t* mp0 = MST + ((size_t)g * 256 + wid * 32 + c16) * 1024 + 8 * kq;
        f32x4 acc0 = (f32x4){0.f, 0.f, 0.f, 0.f}, acc1 = acc0;
#pragma unroll 8
        for (int ks = 0; ks < 32; ++ks) {
            const bf16x8 bfrag = *(const bf16x8*)(up + (size_t)(2 * ks) * ZW);
            const bf16x8 a0 = *(const bf16x8*)(mp0 + 32 * ks), a1 = *(const bf16x8*)(mp0 + 16 * 1024 + 32 * ks);
            acc0 = __builtin_amdgcn_mfma_f32_16x16x32_bf16(a0, bfrag, acc0, 0, 0, 0);
            acc1 = __builtin_amdgcn_mfma_f32_16x16x32_bf16(a1, bfrag, acc1, 0, 0, 0);
        }
        float* op = SLOC + ((size_t)(rcbase + c16) * 16 + g) * 256 + wid * 32 + 4 * kq;
        *(f32x4*)op = acc0; *(f32x4*)(op + 16) = acc1;
    }
}
__device__ __forceinline__ void ph_s5_out(unsigned char* lds_, const bf16_t* Z, const float* TZD, const float* s5d, const bf16_t* QOT, const float* SLOC, const float* lamT, bf16_t* YG, int nrct, int u0, int ustep) { PH_IDS;
    LAS char* sm = (LAS char*)lds_;
    constexpr int O_TZ = 0, O_XP = 65536, O_U = 73728, UP = 2064, O_SL = O_U + 16 * UP;
    const int lane = tid_ & 63, wid = __builtin_amdgcn_readfirstlane(tid_ >> 6), c16 = lane & 15, kq = lane >> 4;
    for (int u = u0; u < 16 * nrct; u += ustep) {
        const int g = u / nrct, rct = u % nrct, rcbase = rct * 16;
        const bool lat = rct < 16; const int b = rcbase >> 5, c0 = rcbase & 31;
        __syncthreads();
        for (int e = tid_; e < 127 * 64; e += NT) { const int dd = e >> 6, h = (e >> 2) & 15, q4 = (e & 3) * 4;
            const float* tf = TZD + ((((size_t)0 * 16 + g) * 64 + (dd >= 63 ? dd - 63 : 0)) * 16 + h) * 16 + q4; const float* tb = TZD + ((((size_t)1 * 16 + g) * 64 + (dd <= 63 ? 63 - dd : 0)) * 16 + h) * 16 + q4;
            f32x4 v = (f32x4){0.f, 0.f, 0.f, 0.f};
            if (dd >= 63) v += *(const f32x4*)tf;
            if (dd <= 63) v += *(const f32x4*)tb;
            if (dd == 63 && (h >> 2) == (q4 >> 2)) v[h & 3] += s5d[g * 16 + h];
            fa::u32x2 w; w.x = fa::pk2(v[0], v[1]); w.y = fa::pk2(v[2], v[3]);
            *(LAS fa::u32x2*)(sm + O_TZ + (dd * 16 + h) * 32 + q4 * 2) = w; }
        for (int e = tid_; e < 16 * 128; e += NT) { const int rc = e >> 7, s = (e >> 1) & 63, hh = e & 1;
            *(LAS fa::u32x4*)(sm + O_U + rc * UP + s * 32 + hh * 16) = *(const fa::u32x4*)(Z + ((size_t)(rcbase + rc) * 64 + s) * ZW + C_S5 + g * 16 + hh * 8); }
        const int nsl = lat ? 36 : 16;
        for (int e = tid_; e < nsl * 64; e += NT) { const int r = e >> 6, q4 = e & 63; const int rc = lat ? (r < 4 ? 256 + b * 4 + r : b * 32 + (r - 4)) : rcbase + r;
            *(LAS f32x4*)(sm + O_SL + r * 1024 + q4 * 16) = *(const f32x4*)(SLOC + ((size_t)rc * 16 + g) * 256 + q4 * 4); }
        __syncthreads();
        if (tid_ < 128) {
            const int d = tid_ >> 6, p = tid_ & 63;
            const float lr = lamT[((size_t)(g * 2 + d) * 64 + p) * 2], li = lamT[((size_t)(g * 2 + d) * 64 + p) * 2 + 1];
            const LAS float* sl = (const LAS float*)(sm + O_SL) + d * 128 + p;
            LAS bf16_t* xp = (LAS bf16_t*)(sm + O_XP) + d * 128 + p;
            float xr = 0.f, xi = 0.f;
#define S5_STEP(r) do { const float sr = sl[(r) * 256], si = sl[(r) * 256 + 64]; const float nr = lr * xr - li * xi + sr, ni = lr * xi + li * xr + si; xr = nr; xi = ni; } while (0)
            if (lat) {
                if (d == 0) { for (int r = 0; r < 4 + c0; ++r) S5_STEP(r);
                    for (int r = 0; r < 16; ++r) { xp[r * 256] = f2bf(xr); xp[r * 256 + 64] = f2bf(xi); S5_STEP(4 + c0 + r); } }
                else { for (int r = 3; r >= 0; --r) S5_STEP(r);
                    for (int c = 31; c >= c0 + 16; --c) S5_STEP(4 + c);
                    for (int r = 15; r >= 0; --r) { xp[r * 256] = f2bf(xr); xp[r * 256 + 64] = f2bf(xi); S5_STEP(4 + c0 + r); } }
            } else {
                if (d == 0) { for (int r = 0; r < 16; ++r) { if ((r & 3) == 0) { xr = 0.f; xi = 0.f; } xp[r * 256] = f2bf(xr); xp[r * 256 + 64] = f2bf(xi); S5_STEP(r); } }
                else { for (int r = 15; r >= 0; --r) { if ((r & 3) == 3) { xr = 0.f; xi = 0.f; } xp[r * 256] = f2bf(xr); xp[r * 256 + 64] = f2bf(xi); S5_STEP(r); } }
            }
#undef S5_STEP
        }
        __syncthreads();
        const LAS char* ub = sm + O_U + c16 * UP + kq * 16;
        const LAS char* xb = sm + O_XP + c16 * 512 + kq * 16;
#pragma unroll 1
        for (int i = 0; i < 8; ++i) {
            const int t = wid * 8 + i;
            f32x4 acc = (f32x4){0.f, 0.f, 0.f, 0.f};
            const LAS char* tz = sm + O_TZ + ((t + 63 - (kq >> 1)) * 16 + c16) * 32 + (kq & 1) * 16;
#pragma unroll 8
            for (int ks = 0; ks < 32; ++ks) {
                const bf16x8 a = *(const LAS bf16x8*)(tz - ks * 1024), bq = *(const LAS bf16x8*)(ub + ks * 64);
                acc = __builtin_amdgcn_mfma_f32_16x16x32_bf16(a, bq, acc, 0, 0, 0);
            }
            const bf16_t* qo = QOT + ((size_t)g * 1024 + t * 16 + c16) * 256 + 8 * kq;
#pragma unroll
            for (int ks = 0; ks < 8; ++ks) {
                const bf16x8 a = *(const bf16x8*)(qo + 32 * ks), bq = *(const LAS bf16x8*)(xb + ks * 64);
                acc = __builtin_amdgcn_mfma_f32_16x16x32_bf16(a, bq, acc, 0, 0, 0);
            }
            fa::u32x2 w; w.x = fa::pk2(geluf_(acc[0]), geluf_(acc[1])); w.y = fa::pk2(geluf_(acc[2]), geluf_(acc[3]));
            *(fa::u32x2*)(YG + ((size_t)(rcbase + c16) * 64 + t) * ZW + C_S5 + g * 16 + 4 * kq) = w;
        }
    }
    __syncthreads();
}
__device__ __forceinline__ void rope16(float (&v)[4], int kq, float pos, bool on) {
#pragma unroll
    for (int r = 0; r < 4; ++r) {
        const int j = (4 * kq + r) & 7;
        const float ang = pos * exp2f(-(float)j * (13.287712379549449f / 8.f)), cs = __cosf(ang), sn = __sinf(ang);
        const float other = __shfl_xor(v[r], 32);
        const float rot = kq < 2 ? v[r] * cs - other * sn : other * sn + v[r] * cs;
        v[r] = on ? rot : v[r];
    }
}
__device__ __forceinline__ void ph_prep(bf16_t* Z, const bf16_t* WUQ, const bf16_t* WUKV, const bf16_t* D64, const float* qkq, const float* qkk,
                                        bf16_t* Q, bf16_t* Kb, bf16_t* Vb, bf16_t* F1lat, bf16_t* F1ctx) { PH_IDS;
    const int lane = tid_ & 63, wid = __builtin_amdgcn_readfirstlane(tid_ >> 6), c16 = lane & 15, kq = lane >> 4;
    for (int blk = bid_; blk < RT / 72; blk += G_) {
        const int row0 = blk * 72;
#pragma unroll 1
      for (int pass3 = 0; pass3 < 2; ++pass3) {
        int rowc[3]; bool valid[3];
#pragma unroll
        for (int tt = 0; tt < 3; ++tt) { const int o = 16 * (3 * pass3 + tt) + c16; valid[tt] = o < 72; rowc[tt] = row0 + (valid[tt] ? o : 71); }
        if (wid < 4) {
            const int h = wid;
            f32x4 acc[6][3]; float ssq[3];
#pragma unroll
            for (int tt = 0; tt < 3; ++tt) { ssq[tt] = 0.f;
#pragma unroll
                for (int nt = 0; nt < 6; ++nt) acc[nt][tt] = (f32x4){0.f, 0.f, 0.f, 0.f}; }
#pragma unroll 1
            for (int ks = 0; ks < 8; ++ks) {
                bf16x8 bq[3], aw[6];
#pragma unroll
                for (int tt = 0; tt < 3; ++tt) { bq[tt] = *(const bf16x8*)(Z + (size_t)rowc[tt] * ZW + C_QC + 32 * ks + 8 * kq);
#pragma unroll
                    for (int e = 0; e < 8; ++e) { const float f = bf2f((bf16_t)bq[tt][e]); ssq[tt] += f * f; } }
#pragma unroll
                for (int nt = 0; nt < 6; ++nt) aw[nt] = *(const bf16x8*)(WUQ + (size_t)(h * 96 + 16 * nt + c16) * 256 + 32 * ks + 8 * kq);
#pragma unroll
                for (int nt = 0; nt < 6; ++nt)
#pragma unroll
                    for (int tt = 0; tt < 3; ++tt) acc[nt][tt] = __builtin_amdgcn_mfma_f32_16x16x32_bf16(aw[nt], bq[tt], acc[nt][tt], 0, 0, 0);
            }
#pragma unroll
            for (int tt = 0; tt < 3; ++tt) {
                float s1 = ssq[tt]; s1 += __shfl_xor(s1, 16); s1 += __shfl_xor(s1, 32);
                const float rstd = rsqrtf(s1 * (1.f / 256) + EPS);
                float ss = 0.f;
#pragma unroll
                for (int nt = 0; nt < 6; ++nt)
#pragma unroll
                    for (int r = 0; r < 4; ++r) ss += acc[nt][tt][r] * acc[nt][tt][r];
                ss += __shfl_xor(ss, 16); ss += __shfl_xor(ss, 32);
                const float fac = rstd * rsqrtf(rstd * rstd * ss * (1.f / 96) + EPS) * 0.14724727430627066f;
                const int row = rowc[tt]; const bool lat = row < RL; const int b = row_batch(row), t = lat ? (row & 2047) : ((row - RL) & 255), qi = lat ? t : 2048 + t;
                bf16_t* qo = Q + ((size_t)(b * 4 + h) * 2304 + qi) * 96 + 4 * kq;
#pragma unroll
                for (int nt = 0; nt < 6; ++nt) {
                    const f32x4 w = *(const f32x4*)(qkq + 16 * nt + 4 * kq);
                    float v[4];
#pragma unroll
                    for (int r = 0; r < 4; ++r) v[r] = acc[nt][tt][r] * fac * w[r];
                    if (nt >= 4) rope16(v, kq, nt == 4 ? (float)(t >> 6) : (float)(t & 63), lat);
                    fa::u32x2 o; o.x = fa::pk2(v[0], v[1]); o.y = fa::pk2(v[2], v[3]);
                    if (valid[tt]) *(fa::u32x2*)(qo + 16 * nt) = o;
                }
            }
        } else {
            const int h = wid - 4;
            float ssq[3], rstd[3];
#pragma unroll
            for (int tt = 0; tt < 3; ++tt) ssq[tt] = 0.f;
#pragma unroll 1
            for (int pass = 0; pass < 2; ++pass) {
                f32x4 acc[4][3];
#pragma unroll
                for (int tt = 0; tt < 3; ++tt)
#pragma unroll
                    for (int nt = 0; nt < 4; ++nt) acc[nt][tt] = (f32x4){0.f, 0.f, 0.f, 0.f};
#pragma unroll 1
                for (int ks = 0; ks < 4; ++ks) {
                    bf16x8 bq[3], aw[4];
#pragma unroll
                    for (int tt = 0; tt < 3; ++tt) { bq[tt] = *(const bf16x8*)(Z + (size_t)rowc[tt] * ZW + C_KVC + 32 * ks + 8 * kq);
                        if (pass == 0) {
#pragma unroll
                            for (int e = 0; e < 8; ++e) { const float f = bf2f((bf16_t)bq[tt][e]); ssq[tt] += f * f; } } }
#pragma unroll
                    for (int nt = 0; nt < 4; ++nt) aw[nt] = *(const bf16x8*)(WUKV + (size_t)(h * 128 + pass * 64 + 16 * nt + c16) * 128 + 32 * ks + 8 * kq);
#pragma unroll
                    for (int nt = 0; nt < 4; ++nt)
#pragma unroll
                        for (int tt = 0; tt < 3; ++tt) acc[nt][tt] = __builtin_amdgcn_mfma_f32_16x16x32_bf16(aw[nt], bq[tt], acc[nt][tt], 0, 0, 0);
                }
#pragma unroll
                for (int tt = 0; tt < 3; ++tt) {
                    const int row = rowc[tt]; const bool lat = row < RL; const int b = row_batch(row), t = lat ? (row & 2047) : ((row - RL) & 255), ki = lat ? 256 + t : t;
                    if (pass == 0) {
                        float s1 = ssq[tt]; s1 += __shfl_xor(s1, 16); s1 += __shfl_xor(s1, 32);
                        rstd[tt] = rsqrtf(s1 * (1.f / 128) + EPS);
                        float kr[2][4];
#pragma unroll
                        for (int e = 0; e < 2; ++e) { const fa::u32x2 w = *(const fa::u32x2*)(Z + (size_t)row * ZW + C_KR + 16 * e + 4 * kq);
                            kr[e][0] = __uint_as_float(w.x << 16); kr[e][1] = __uint_as_float(w.x & 0xffff0000u); kr[e][2] = __uint_as_float(w.y << 16); kr[e][3] = __uint_as_float(w.y & 0xffff0000u); }
                        float ss = 0.f;
#pragma unroll
                        for (int nt = 0; nt < 4; ++nt)
#pragma unroll
                            for (int r = 0; r < 4; ++r) { acc[nt][tt][r] *= rstd[tt]; ss += acc[nt][tt][r] * acc[nt][tt][r]; }
#pragma unroll
                        for (int e = 0; e < 2; ++e)
#pragma unroll
                            for (int r = 0; r < 4; ++r) ss += kr[e][r] * kr[e][r];
                        ss += __shfl_xor(ss, 16); ss += __shfl_xor(ss, 32);
                        const float fac = rsqrtf(ss * (1.f / 96) + EPS);
                        bf16_t* ko = Kb + ((size_t)(b * 4 + h) * 2304 + ki) * 96 + 4 * kq;
#pragma unroll
                        for (int nt = 0; nt < 6; ++nt) {
                            const f32x4 w = *(const f32x4*)(qkk + 16 * nt + 4 * kq);
                            float v[4];
#pragma unroll
                            for (int r = 0; r < 4; ++r) v[r] = (nt < 4 ? acc[nt < 4 ? nt : 0][tt][r] : kr[nt < 4 ? 0 : nt - 4][r]) * fac * w[r];
                            if (nt >= 4) rope16(v, kq, nt == 4 ? (float)(t >> 6) : (float)(t & 63), lat);
                            fa::u32x2 o; o.x = fa::pk2(v[0], v[1]); o.y = fa::pk2(v[2], v[3]);
                            if (valid[tt]) *(fa::u32x2*)(ko + 16 * nt) = o;
                        }
                    } else {
                        bf16_t* vo = Vb + ((size_t)(b * 4 + h) * 2304 + ki) * 64 + 4 * kq;
#pragma unroll
                        for (int nt = 0; nt < 4; ++nt) { fa::u32x2 o; o.x = fa::pk2(acc[nt][tt][0] * rstd[tt], acc[nt][tt][1] * rstd[tt]); o.y = fa::pk2(acc[nt][tt][2] * rstd[tt], acc[nt][tt][3] * rstd[tt]);
                            if (valid[tt]) *(fa::u32x2*)(vo + 16 * nt) = o; }
                    }
                }
            }
        }
        {
            const int g = wid >> 1, part = wid & 1;
            f32x4 acc[4][3];
#pragma unroll
            for (int tt = 0; tt < 3; ++tt)
#pragma unroll
                for (int nt = 0; nt < 4; ++nt) acc[nt][tt] = (f32x4){0.f, 0.f, 0.f, 0.f};
#pragma unroll
            for (int ks = 0; ks < 2; ++ks) {
                bf16x8 au[3], bd[4];
#pragma unroll
                for (int tt = 0; tt < 3; ++tt) au[tt] = *(const bf16x8*)(Z + (size_t)rowc[tt] * ZW + C_FU + g * 64 + 32 * ks + 8 * kq);
#pragma unroll
                for (int nt = 0; nt < 4; ++nt) bd[nt] = *(const bf16x8*)(D64 + (size_t)(part * 64 + 16 * nt + c16) * 64 + 32 * ks + 8 * kq);
#pragma unroll
                for (int nt = 0; nt < 4; ++nt)
#pragma unroll
                    for (int tt = 0; tt < 3; ++tt) acc[nt][tt] = __builtin_amdgcn_mfma_f32_16x16x32_bf16(au[tt], bd[nt], acc[nt][tt], 0, 0, 0);
            }
#pragma unroll
            for (int tt = 0; tt < 3; ++tt) {
                const int o4 = 16 * (3 * pass3 + tt) + 4 * kq; const int trow = row0 + o4;
                if (o4 < 72) {
                    const bool lat = trow < RL;
#pragma unroll
                    for (int nt = 0; nt < 4; ++nt) {
                        const int gm = g * 64 + 16 * nt + c16;
                        fa::u32x2 o; o.x = fa::pk2(acc[nt][tt][0], acc[nt][tt][1]); o.y = fa::pk2(acc[nt][tt][2], acc[nt][tt][3]);
                        if (lat) { const int b = trow >> 11, t0 = trow & 2047; *(fa::u32x2*)(F1lat + ((size_t)(b * 256 + gm) * 2 + part) * 2048 + t0) = o; }
                        else { const int rr = trow - RL, b = rr >> 8, t0 = rr & 255; *(fa::u32x2*)(F1ctx + ((size_t)(b * 256 + gm) * 2 + part) * 256 + t0) = o; }
                    }
                }
            }
        }
      }
#pragma unroll 1
        for (int it = tid_; it < 72 * 16; it += NT) {
            const int row = row0 + (it >> 4), h = (it >> 2) & 3, jg = it & 3;
            bf16_t* zq = Z + (size_t)row * ZW + C_RQ + h * 64 + 8 * jg; bf16_t* zk = Z + (size_t)row * ZW + C_RK + h * 64 + 8 * jg;
            const fa::u32x4 k1 = *(const fa::u32x4*)zk, k2 = *(const fa::u32x4*)(zk + 32);
            f32x4 ka, kb, kc, kd; unpack8(k1, ka, kb); unpack8(k2, kc, kd);
            if (row < RL) {
                const fa::u32x4 q1 = *(const fa::u32x4*)zq, q2 = *(const fa::u32x4*)(zq + 32);
                f32x4 qa, qb, qc, qd; unpack8(q1, qa, qb); unpack8(q2, qc, qd);
                const float tpos = (float)(row & 2047);
                float x1q[8] = {qa[0], qa[1], qa[2], qa[3], qb[0], qb[1], qb[2], qb[3]}, x2q[8] = {qc[0], qc[1], qc[2], qc[3], qd[0], qd[1], qd[2], qd[3]};
                float x1k[8] = {ka[0], ka[1], ka[2], ka[3], kb[0], kb[1], kb[2], kb[3]}, x2k[8] = {kc[0], kc[1], kc[2], kc[3], kd[0], kd[1], kd[2], kd[3]};
#pragma unroll
                for (int e = 0; e < 8; ++e) {
                    const float ang = tpos * exp2f(-(float)(8 * jg + e) * (13.287712379549449f / 32.f)), cs = cosf(ang), sn = sinf(ang);
                    const float a = x1q[e], c = x2q[e]; x1q[e] = a * cs - c * sn; x2q[e] = a * sn + c * cs;
                    const float a2 = x1k[e], c2 = x2k[e]; x1k[e] = (a2 * cs - c2 * sn) * 0.125f; x2k[e] = (a2 * sn + c2 * cs) * 0.125f;
                }
                *(fa::u32x4*)zq = pack8((f32x4){x1q[0], x1q[1], x1q[2], x1q[3]}, (f32x4){x1q[4], x1q[5], x1q[6], x1q[7]});
                *(fa::u32x4*)(zq + 32) = pack8((f32x4){x2q[0], x2q[1], x2q[2], x2q[3]}, (f32x4){x2q[4], x2q[5], x2q[6], x2q[7]});
                *(fa::u32x4*)zk = pack8((f32x4){x1k[0], x1k[1], x1k[2], x1k[3]}, (f32x4){x1k[4], x1k[5], x1k[6], x1k[7]});
                *(fa::u32x4*)(zk + 32) = pack8((f32x4){x2k[0], x2k[1], x2k[2], x2k[3]}, (f32x4){x2k[4], x2k[5], x2k[6], x2k[7]});
            } else {
                *(fa::u32x4*)zk = pack8(ka * 0.125f, kb * 0.125f); *(fa::u32x4*)(zk + 32) = pack8(kc * 0.125f, kd * 0.125f);
            }
        }
    }
}

__device__ __forceinline__ void ph_attn_mfma(unsigned char* lds_, const bf16_t* Q, const bf16_t* Kb, const bf16_t* Vb, bf16_t* Z, int with_ctx, int u0, int ustep) { PH_IDS;
    using namespace fa;
    LAS char* sm = (LAS char*)lds_;
    const int lane = tid_ & 63, wid = __builtin_amdgcn_readfirstlane(tid_ >> 6), r32 = lane & 31, hi = lane >> 5;
    const int nunits = 256 + (with_ctx ? 32 : 0);
    const int koff0 = (tid_ / 12) * KP_A + (tid_ % 12) * 16, koff1 = ((tid_ + 512) / 12) * KP_A + ((tid_ + 512) % 12) * 16;
    const int voff = KT_A + ((tid_ & 7) >> 2) * 4096 + (tid_ >> 3) * 64 + (tid_ & 3) * 16;
    const int vrd = KT_A + ((lane >> 4) & 1) * 32 + (lane & 3) * 8 + (4 * hi + ((lane & 15) >> 2)) * 64;
    for (int u = u0; u < nunits; u += ustep) {
        const bool lat = u < 256; const int bh = lat ? (u >> 3) : (u - 256), qb = lat ? (u & 7) : 8;
        const int ntile = lat ? 36 : 4;
        const char* Kg = (const char*)(Kb + (size_t)bh * 2304 * 96); const char* Vg = (const char*)(Vb + (size_t)bh * 2304 * 64);
        const bf16_t* Qg = Q + ((size_t)bh * 2304 + qb * 256 + wid * 32 + r32) * 96;
        bf16x8 qf[6];
#pragma unroll
        for (int st = 0; st < 6; ++st) qf[st] = *(const bf16x8*)(Qg + 16 * st + 8 * hi);
        f32x16 o0, o1;
#pragma unroll
        for (int r = 0; r < 16; ++r) { o0[r] = 0.f; o1[r] = 0.f; }
        float mrun = 0.f, lsum = 0.f;
        f32x16 negm;
#pragma unroll
        for (int r = 0; r < 16; ++r) negm[r] = 0.f;
        u32x4 kr0, kr1, vr;
        kr0 = *(const u32x4*)(Kg + tid_ * 16); kr1 = tid_ < 256 ? *(const u32x4*)(Kg + (tid_ + 512) * 16) : (u32x4){0u, 0u, 0u, 0u}; vr = *(const u32x4*)(Vg + tid_ * 16);
        __syncthreads();
        *(LAS u32x4*)(sm + koff0) = kr0; if (tid_ < 256) *(LAS u32x4*)(sm + koff1) = kr1; *(LAS u32x4*)(sm + voff) = vr;
        __syncthreads();
        for (int t = 0; t < ntile; ++t) {
            const int buf = (t & 1) * BUF_A;
            if (t + 1 < ntile) { const char* kg = Kg + (size_t)(t + 1) * 12288; const char* vg = Vg + (size_t)(t + 1) * 8192;
                kr0 = *(const u32x4*)(kg + tid_ * 16); if (tid_ < 256) kr1 = *(const u32x4*)(kg + (tid_ + 512) * 16); vr = *(const u32x4*)(vg + tid_ * 16); }
            const LAS char* kb = sm + buf + r32 * KP_A + 16 * hi;
            f32x16 p0 = negm, p1 = negm;
#pragma unroll
            for (int st = 0; st < 6; ++st) {
                const bf16x8 k0 = *(const LAS bf16x8*)(kb + 32 * st), k1 = *(const LAS bf16x8*)(kb + 32 * KP_A + 32 * st);
                p0 = __builtin_amdgcn_mfma_f32_32x32x16_bf16(k0, qf[st], p0, 0, 0, 0);
                p1 = __builtin_amdgcn_mfma_f32_32x32x16_bf16(k1, qf[st], p1, 0, 0, 0);
            }
            float ta = fmaxf(fmaxf(p0[0], p0[1]), p1[0]), tb = fmaxf(fmaxf(p0[2], p0[3]), p1[1]);
            ta = fmaxf(fmaxf(ta, p1[2]), p1[3]);
#pragma unroll
            for (int r = 4; r < 16; r += 4) { ta = fmaxf(fmaxf(ta, p0[r]), p0[r + 1]); tb = fmaxf(fmaxf(tb, p0[r + 2]), p0[r + 3]); ta = fmaxf(fmaxf(ta, p1[r]), p1[r + 1]); tb = fmaxf(fmaxf(tb, p1[r + 2]), p1[r + 3]); }
            float tm = fmaxf(ta, tb);
            tm = fmaxf(tm, __shfl_xor(tm, 32));
            if (t == 0 || __any(tm > 0.f)) {
                const float dl = t == 0 ? tm : fmaxf(tm, 0.f), alpha = t == 0 ? 1.f : __builtin_amdgcn_exp2f(-dl);
                mrun += dl; lsum *= alpha;
#pragma unroll
                for (int r = 0; r < 16; ++r) { p0[r] -= dl; p1[r] -= dl; o0[r] *= alpha; o1[r] *= alpha; negm[r] = -mrun; }
            }
            float ps = 0.f, ps2 = 0.f;
#pragma unroll
            for (int r = 0; r < 16; ++r) { p0[r] = __builtin_amdgcn_exp2f(p0[r]); p1[r] = __builtin_amdgcn_exp2f(p1[r]); ps += p0[r]; ps2 += p1[r]; }
            lsum += ps + ps2;
            bf16x8 pf[4]; pf[0] = pack_p(p0, 0); pf[1] = pack_p(p0, 8); pf[2] = pack_p(p1, 0); pf[3] = pack_p(p1, 8);
            pv_tile(o0, o1, sm + buf + vrd, pf);
            if (t + 1 < ntile) { const int nb = ((t + 1) & 1) * BUF_A; *(LAS u32x4*)(sm + nb + koff0) = kr0; if (tid_ < 256) *(LAS u32x4*)(sm + nb + koff1) = kr1; *(LAS u32x4*)(sm + nb + voff) = vr; }
            __syncthreads();
        }
        lsum += __shfl_xor(lsum, 32);
        const float inv = 1.f / lsum;
        const int b = bh >> 2, h = bh & 3;
        const int row = (lat ? b * 2048 + qb * 256 : RL + b * 256) + wid * 32 + r32;
        bf16_t* op = Z + (size_t)row * ZW + C_QC + h * 64 + 4 * hi;
#pragma unroll
        for (int g = 0; g < 4; ++g) {
            u32x2 w0, w1; w0.x = pk2(o0[4 * g] * inv, o0[4 * g + 1] * inv); w0.y = pk2(o0[4 * g + 2] * inv, o0[4 * g + 3] * inv);
            w1.x = pk2(o1[4 * g] * inv, o1[4 * g + 1] * inv); w1.y = pk2(o1[4 * g + 2] * inv, o1[4 * g + 3] * inv);
            *(u32x2*)(op + 8 * g) = w0; *(u32x2*)(op + 32 + 8 * g) = w1;
        }
    }
    __syncthreads();
}

__device__ __forceinline__ void ph_ret_mfma(unsigned char* lds_, bf16_t* Z, const float* decay_logit, const float* gn_w, int with_ctx, int u0, int ustep) { PH_IDS;
    using namespace fa;
    LAS char* sm = (LAS char*)lds_;
    const int lane = tid_ & 63, wid = __builtin_amdgcn_readfirstlane(tid_ >> 6), r32 = lane & 31, hi = lane >> 5;
    const int nunits = 256 + (with_ctx ? 32 : 0);
    const int prow = tid_ >> 3, pc = tid_ & 7;
    const int koff = prow * KP_R + pc * 16;
    const int voff = KT_R + (pc >> 2) * 4096 + prow * 64 + (pc & 3) * 16;
    const int vrd = KT_R + ((lane >> 4) & 1) * 32 + (lane & 3) * 8 + (4 * hi + ((lane & 15) >> 2)) * 64;
    for (int u = u0; u < nunits; u += ustep) {
        const bool lat = u < 256; const int bh = lat ? (u >> 3) : (u - 256), qb = lat ? (u & 7) : 0, b = bh >> 2, h = bh & 3;
        const int ntile = lat ? 40 : 4;
        const float lgf = -log1pf(__expf(-decay_logit[h])) * 1.4426950408889634f, lgb = -log1pf(__expf(-decay_logit[4 + h])) * 1.4426950408889634f;
        const int qw0 = qb * 256 + wid * 32, qpos = qw0 + r32;
        const int qrow = (lat ? b * 2048 : RL + b * 256) + qpos;
        float ckf[16], ckb[16];
#pragma unroll
        for (int r = 0; r < 16; ++r) { const float off = (float)crow(r, hi); ckf[r] = __builtin_amdgcn_exp2f(-lgf * off); ckb[r] = __builtin_amdgcn_exp2f(lgb * off); }
        const float cf32 = __builtin_amdgcn_exp2f(-lgf * 32.f), cb32 = __builtin_amdgcn_exp2f(lgb * 32.f);
        bf16_t* zq = Z + (size_t)qrow * ZW;
        bf16x8 qf[4];
#pragma unroll
        for (int st = 0; st < 4; ++st) qf[st] = *(const bf16x8*)(zq + C_RQ + h * 64 + 16 * st + 8 * hi);
        f32x16 o0, o1;
#pragma unroll
        for (int r = 0; r < 16; ++r) { o0[r] = 0.f; o1[r] = 0.f; }
        const int ctx0 = RL + b * 256, lat0 = b * 2048;
#define RET_TILE_ROW(t) (lat ? ((t) < 4 ? ctx0 + 64 * (t) : ((t) < 36 ? lat0 + 64 * ((t) - 4) : ctx0 + 64 * ((t) - 36))) : ctx0 + 64 * (t))
#define RET_TILE_POS(t) (lat ? 64 * (t) - 256 : 64 * (t))
        u32x4 kr, vr;
        { const bf16_t* zr = Z + (size_t)(RET_TILE_ROW(0) + prow) * ZW + h * 64 + pc * 8; kr = *(const u32x4*)(zr + C_RK); vr = *(const u32x4*)(zr + C_RV); }
        __syncthreads();
        *(LAS u32x4*)(sm + koff) = kr; *(LAS u32x4*)(sm + voff) = vr;
        __syncthreads();
        for (int t = 0; t < ntile; ++t) {
            const int buf = (t & 1) * BUF_R;
            if (t + 1 < ntile) { const bf16_t* zr = Z + (size_t)(RET_TILE_ROW(t + 1) + prow) * ZW + h * 64 + pc * 8; kr = *(const u32x4*)(zr + C_RK); vr = *(const u32x4*)(zr + C_RV); }
            const LAS char* kb = sm + buf + r32 * KP_R + 16 * hi;
            f32x16 p0, p1;
#pragma unroll
            for (int r = 0; r < 16; ++r) { p0[r] = 0.f; p1[r] = 0.f; }
#pragma unroll
            for (int st = 0; st < 4; ++st) {
                const bf16x8 k0 = *(const LAS bf16x8*)(kb + 32 * st), k1 = *(const LAS bf16x8*)(kb + 32 * KP_R + 32 * st);
                p0 = __builtin_amdgcn_mfma_f32_32x32x16_bf16(k0, qf[st], p0, 0, 0, 0);
                p1 = __builtin_amdgcn_mfma_f32_32x32x16_bf16(k1, qf[st], p1, 0, 0, 0);
            }
            const int kp0 = RET_TILE_POS(t);
            if (kp0 + 63 < qw0) {
                const float sq = __builtin_amdgcn_exp2f(lgf * (float)(qpos - kp0)), sq1 = sq * cf32;
#pragma unroll
                for (int r = 0; r < 16; ++r) { p0[r] = p0[r] * ckf[r] * sq; p1[r] = p1[r] * ckf[r] * sq1; }
            } else if (kp0 > qw0 + 31) {
                const float sq = __builtin_amdgcn_exp2f(lgb * (float)(kp0 - qpos)), sq1 = sq * cb32;
#pragma unroll
                for (int r = 0; r < 16; ++r) { p0[r] = p0[r] * ckb[r] * sq; p1[r] = p1[r] * ckb[r] * sq1; }
            } else {
                const int d0 = qpos - kp0 - 4 * hi;
#pragma unroll
                for (int r = 0; r < 16; ++r) {
                    const int dp0 = d0 - ((r & 3) + 8 * (r >> 2)), dp1 = dp0 - 32;
                    const float w0 = dp0 > 0 ? __builtin_amdgcn_exp2f(lgf * (float)dp0) : (dp0 < 0 ? __builtin_amdgcn_exp2f(-lgb * (float)dp0) : 2.f);
                    const float w1 = dp1 > 0 ? __builtin_amdgcn_exp2f(lgf * (float)dp1) : (dp1 < 0 ? __builtin_amdgcn_exp2f(-lgb * (float)dp1) : 2.f);
                    p0[r] *= w0; p1[r] *= w1;
                }
            }
            bf16x8 pf[4]; pf[0] = pack_p(p0, 0); pf[1] = pack_p(p0, 8); pf[2] = pack_p(p1, 0); pf[3] = pack_p(p1, 8);
            pv_tile(o0, o1, sm + buf + vrd, pf);
            if (t + 1 < ntile) { const int nb = ((t + 1) & 1) * BUF_R; *(LAS u32x4*)(sm + nb + koff) = kr; *(LAS u32x4*)(sm + nb + voff) = vr; }
            __syncthreads();
        }
#undef RET_TILE_ROW
#undef RET_TILE_POS
        float s1 = 0.f;
#pragma unroll
        for (int r = 0; r < 16; ++r) s1 += o0[r] + o1[r];
        s1 += __shfl_xor(s1, 32);
        const float mu = s1 * (1.f / 64);
        float s2 = 0.f;
#pragma unroll
        for (int r = 0; r < 16; ++r) { const float a = o0[r] - mu, c = o1[r] - mu; s2 += a * a + c * c; }
        s2 += __shfl_xor(s2, 32);
        const float rstd = rsqrtf(s2 * (1.f / 64) + EPS);
#pragma unroll
        for (int g = 0; g < 4; ++g)
#pragma unroll
            for (int blk = 0; blk < 2; ++blk) {
                const int d = blk * 32 + 8 * g + 4 * hi;
                const u32x2 gt = *(const u32x2*)(zq + C_RG + h * 64 + d);
                const f32x4 gw = *(const f32x4*)(gn_w + h * 64 + d);
                float y[4];
#pragma unroll
                for (int q = 0; q < 4; ++q) { const float ov = blk ? o1[4 * g + q] : o0[4 * g + q]; const unsigned gb = q < 2 ? gt.x : gt.y; const float gv = __uint_as_float((q & 1) ? (gb & 0xffff0000u) : (gb << 16));
                    y[q] = siluf_(gv) * ((ov - mu) * rstd * gw[q]); }
                u32x2 w; w.x = pk2(y[0], y[1]); w.y = pk2(y[2], y[3]);
                *(u32x2*)(zq + C_RQ + h * 64 + d) = w;
            }
    }
    __syncthreads();
}

struct SchedGrid {
    const char* A; const char* B; unsigned lda, ldb; int nt, nM, nN, G, c, kind, aux;
    __device__ __forceinline__ bool next(int i, pg8::Unit& u) const {
        int pm, pn; if (!pg8::static_tile(nM, nN, G, c, i, pm, pn)) return false;
        u.A = A + (size_t)pm * 256 * lda; u.B = B + (size_t)pn * 256 * ldb; u.lda = lda; u.ldb = ldb; u.nt = nt; u.pm = pm; u.pn = pn; u.kind = kind; u.aux = aux; return true; }
};
struct SchedP1 {
    const char* A; const char* B; int G, c, last;
    __device__ __forceinline__ bool next(int i, pg8::Unit& u) const {
        int pm, pn;
        if (!last) { if (!pg8::static_tile(RT / 256, 8, G, c, i, pm, pn)) return false; }
        else { if (!pg8::static_tile(RL / 256, 8, G, c, i, pm, pn)) { const int j = i * G + c - (RL / 256) * 8; if (j < 0 || j >= 32) return false; pm = RL / 256 + (j >> 2); pn = j & 3; } }
        u.A = A + (size_t)pm * 256 * 2048; u.B = B + (size_t)pn * 256 * 2048; u.lda = 2048; u.ldb = 2048; u.nt = 16; u.pm = pm; u.pn = pn; u.kind = 0; u.aux = 0; return true; }
};
struct SchedMerge {
    const char* Z; const char* XN; const char* WBR; const char* WING; int njobs, G, vcu;
    __device__ __forceinline__ bool next(int i, pg8::Unit& u) const {
        const int job = (i >> 3) * G + vcu; if (job >= njobs) return false;
        const int sub = i & 7, n = sub >> 1, pm = job >> 2, pn = job & 3;
        u.pm = pm; u.pn = pn; u.aux = n;
        if (!(sub & 1)) { const int bcol = n == 0 ? C_QC : (n == 1 ? C_FU : (n == 2 ? C_OC : C_RQ));
            u.A = Z + ((size_t)pm * 256 * ZW + bcol) * 2; u.lda = ZW * 2; u.B = WBR + ((size_t)n * 1024 + pn * 256) * 512; u.ldb = 512; u.nt = 4; u.kind = 0; }
        else { u.A = XN + (size_t)pm * 256 * 2048; u.lda = 2048; u.B = WING + ((size_t)n * 1024 + pn * 256) * 2048; u.ldb = 2048; u.nt = 16; u.kind = 1; }
        return true; }
};
#define EPI_FOREACH(...) _Pragma("unroll") for (int ai = 0; ai < 2; ++ai) _Pragma("unroll") for (int m = 0; m < 4; ++m) _Pragma("unroll") for (int bj = 0; bj < 2; ++bj) { \
        const int row = u.pm * 256 + ai * 128 + wr * 64 + m * 16 + fr, col = u.pn * 256 + bj * 128 + wc * 32 + 8 * fq; const f32x4 v0 = acc[ai][bj][m][0], v1 = acc[ai][bj][m][1]; (void)row; (void)col; __VA_ARGS__ }
struct EpiStore {
    bf16_t* O; int ld; int act;
    __device__ __forceinline__ void operator()(const f32x4 (&acc)[2][2][4][2], const pg8::Unit& u, int wr, int wc, int fr, int fq) const {
        EPI_FOREACH( f32x4 a = v0, b = v1; if (act == 1) { _Pragma("unroll") for (int q = 0; q < 4; ++q) { const float ra = fmaxf(a[q], 0.f), rb = fmaxf(b[q], 0.f); a[q] = ra * ra; b[q] = rb * rb; } }
            *(pg8::u32x4*)(O + (size_t)row * ld + col) = pack8(a, b); )
    }
};
struct EpiResid {
    const float* xlat; const float* xctx; float* olat; float* octx; const float* mod; int gch;
    __device__ __forceinline__ void operator()(const f32x4 (&acc)[2][2][4][2], const pg8::Unit& u, int wr, int wc, int fr, int fq) const {
        const bool lat = u.pm < 64; const float* xb = lat ? xlat : xctx - (size_t)RL * DM; float* ob = lat ? olat : octx - (size_t)RL * DM;
        const float* g = mod + (size_t)(lat ? (u.pm >> 3) : 8) * 6144 + gch * 1024;
        EPI_FOREACH( const f32x4 g0 = *(const f32x4*)(g + col), g1 = *(const f32x4*)(g + col + 4); const size_t o = (size_t)row * DM + col;
            const f32x4 x0 = *(const f32x4*)(xb + o), x1 = *(const f32x4*)(xb + o + 4); *(f32x4*)(ob + o) = x0 + g0 * v0; *(f32x4*)(ob + o + 4) = x1 + g1 * v1; if (bj) asm volatile("" ::: "memory"); )
    }
};
struct EpiMerge {
    pg8::u32x4* stash; bf16_t* MMp;
    __device__ __forceinline__ void operator()(const f32x4 (&acc)[2][2][4][2], const pg8::Unit& u, int wr, int wc, int fr, int fq) const {
        int tid = threadIdx.x; asm volatile("" : "+v"(tid));
        if (u.kind == 0) { EPI_FOREACH( stash[((ai * 4 + m) * 2 + bj) * NT + tid] = pack8(v0, v1); if (bj) asm volatile("" ::: "memory"); ) }
        else { EPI_FOREACH( f32x4 y0, y1; unpack8(stash[((ai * 4 + m) * 2 + bj) * NT + tid], y0, y1); f32x4 t0, t1;
                _Pragma("unroll") for (int q = 0; q < 4; ++q) { t0[q] = sigmoidf_(v0[q]) * y0[q]; t1[q] = sigmoidf_(v1[q]) * y1[q]; }
                pg8::u32x4* mp = (pg8::u32x4*)(MMp + (size_t)row * DM + col);
                if (u.aux != 0) { f32x4 p0, p1; unpack8(*mp, p0, p1); t0 += p0; t1 += p1; }
                *mp = pack8(t0, t1); asm volatile("" ::: "memory"); ) }
    }
};
__device__ __forceinline__ void transpose_item(const float* W, int K, int N, bf16_t* WT, int row_off, LAS float* scr, int item, int lane, const float* kscale = nullptr) {
    const int nblk = N / 32, kb = item / nblk, nb = item % nblk, k0 = 64 * kb, n0 = 32 * nb;
#pragma unroll 8
    for (int i = 0; i < 32; ++i) { const int kk = 2 * i + (lane >> 5); float wv = W[(size_t)(k0 + kk) * N + n0 + (lane & 31)]; if (kscale) wv *= kscale[k0 + kk]; scr[kk * 33 + (lane & 31)] = wv; }
    asm volatile("s_waitcnt lgkmcnt(0)" ::: "memory");
    const int c = lane & 7;
#pragma unroll
    for (int j = 0; j < 4; ++j) { const int n = (lane >> 3) + 8 * j; const LAS float* sp = scr + (8 * c) * 33 + n;
        pg8::u32x4 o; o.x = pg8::cvt_pk_bf16(sp[0 * 33], sp[1 * 33]); o.y = pg8::cvt_pk_bf16(sp[2 * 33], sp[3 * 33]); o.z = pg8::cvt_pk_bf16(sp[4 * 33], sp[5 * 33]); o.w = pg8::cvt_pk_bf16(sp[6 * 33], sp[7 * 33]);
        *(pg8::u32x4*)(WT + (size_t)(row_off + n0 + n) * K + k0 + 8 * c) = o; }
    asm volatile("s_waitcnt lgkmcnt(0)" ::: "memory");
}
__device__ __forceinline__ void ph_convert_weights(unsigned char* lds, int l, const float* w_in, const float* w1, const float* w2, const float* w_out, const float* w_br, const float* w_glu,
                                                   const float* w_uq, const float* q_norm, const float* w_ukv, const float* kv_norm, unsigned char* ws) { PH_IDS;
    const int wave = __builtin_amdgcn_readfirstlane(tid_ >> 6), lane = tid_ & 63;
    LAS float* scr = (LAS float*)((LAS unsigned char*)lds + wave * 16384);
    const int gw = bid_ * 8 + wave, NGW = G_ * 8;
    constexpr int I_IN = 16 * 189, I_1 = 16 * 128, I_2 = 64 * 32, I_O = 16 * 32, I_B = 4 * 32;
    constexpr int I_G = 4 * 16;
    constexpr int I_UQ = 4 * 12, I_UKV = 2 * 16;
    constexpr int NITEMS = I_IN + I_1 + I_2 + I_O + 4 * I_B + I_G + I_UQ + I_UKV;
    bf16_t* WIN_T = (bf16_t*)(ws + WS_WIN); bf16_t* W1_T = (bf16_t*)(ws + WS_W1); bf16_t* W2_T = (bf16_t*)(ws + WS_W2); bf16_t* WOUT_T = (bf16_t*)(ws + WS_WOUT); bf16_t* WBR_T = (bf16_t*)(ws + WS_WBR);
    for (int it = gw; it < NITEMS; it += NGW) {
        int r = it;
        if (r < I_IN) { const int nb = r % 189; transpose_item(w_in + (size_t)l * DM * INC, DM, INC, WIN_T, nb >= 61 ? 96 : 0, scr, r, lane); continue; } r -= I_IN;
        if (r < I_1) { transpose_item(w1 + (size_t)l * DM * DFF, DM, DFF, W1_T, 0, scr, r, lane); continue; } r -= I_1;
        if (r < I_2) { transpose_item(w2 + (size_t)l * DFF * DM, DFF, DM, W2_T, 0, scr, r, lane); continue; } r -= I_2;
        if (r < I_O) { transpose_item(w_out + (size_t)l * DM * DM, DM, DM, WOUT_T, 0, scr, r, lane); continue; } r -= I_O;
        if (r < 4 * I_B) { const int n = r / I_B; transpose_item(w_br + ((size_t)l * 4 + n) * 256 * DM, 256, DM, WBR_T + (size_t)n * 1024 * 256, 0, scr, r % I_B, lane); continue; } r -= 4 * I_B;
        { const int n0 = (r % 16) * 32; const int off = n0 < 128 ? 0 : (n0 < 256 ? 128 : (n0 < 384 ? -128 : 0));
          if (r < I_G) { transpose_item(w_glu + (size_t)l * 256 * 512, 256, 512, (bf16_t*)(ws + WS_WGLU), off, scr, r, lane); continue; } }
        r -= I_G;
        if (r < I_UQ) { transpose_item(w_uq + (size_t)l * 256 * 384, 256, 384, (bf16_t*)(ws + WS_WUQ), 0, scr, r, lane, q_norm + l * 256); continue; } r -= I_UQ;
        transpose_item(w_ukv + (size_t)l * 128 * 512, 128, 512, (bf16_t*)(ws + WS_WUKV), 0, scr, r, lane, kv_norm + l * 128);
    }
    GSTRIDE(gi, 96 * 1024 / 8) { *(pg8::u32x4*)(WIN_T + (size_t)1952 * 1024 + (size_t)gi * 8) = (pg8::u32x4){0u, 0u, 0u, 0u}; }
    __syncthreads();
}

struct EpiFourier {
    bf16_t* Zp; int rowbase, L; float scale;
    __device__ __forceinline__ void operator()(const f32x4 (&acc)[2][2][4][2], const pg8::Unit& u, int wr, int wc, int fr, int fq) const {
        EPI_FOREACH( *(pg8::u32x4*)(Zp + ((size_t)rowbase + (size_t)u.pn * L + row) * ZW + C_FU + (col - u.pn * 256)) = pack8(v0 * scale, v1 * scale); )
    }
};
struct EpiGlu {
    bf16_t* Zp;
    __device__ __forceinline__ void operator()(const f32x4 (&acc)[2][2][4][2], const pg8::Unit& u, int wr, int wc, int fr, int fq) const {
#pragma unroll
        for (int ai = 0; ai < 2; ++ai)
#pragma unroll
            for (int m = 0; m < 4; ++m) {
                const int row = u.pm * 256 + ai * 128 + wr * 64 + m * 16 + fr, col = u.pn * 128 + wc * 32 + 8 * fq;
                f32x4 a, b;
#pragma unroll
                for (int q = 0; q < 4; ++q) { a[q] = acc[ai][0][m][0][q] * sigmoidf_(acc[ai][1][m][0][q]); b[q] = acc[ai][0][m][1][q] * sigmoidf_(acc[ai][1][m][1][q]); }
                *(pg8::u32x4*)(Zp + (size_t)row * ZW + C_OC + col) = pack8(a, b);
            }
    }
};
__device__ __forceinline__ void ph_dft_gen(const float* trig, bf16_t* DL, bf16_t* DC) { PH_IDS;
    GSTRIDE(gi, 2048 * 4096 / 8) {
        const int k = gi >> 9, kk0 = (gi & 511) * 8; pg8::u32x4 w; unsigned pr[4];
#pragma unroll
        for (int q = 0; q < 4; ++q) { float v[2];
#pragma unroll
            for (int e = 0; e < 2; ++e) { const int kk = kk0 + 2 * q + e, part = kk >> 11, t = kk & 2047, idx = (k * t) & 2047; v[e] = part ? -trig[2048 + idx] : trig[idx]; }
            pr[q] = pg8::cvt_pk_bf16(v[0], v[1]); }
        w.x = pr[0]; w.y = pr[1]; w.z = pr[2]; w.w = pr[3];
        *(pg8::u32x4*)(DL + (size_t)k * 4096 + kk0) = w;
    }
    GSTRIDE(gi, 256 * 512 / 8) {
        const int k = gi >> 6, kk0 = (gi & 63) * 8; pg8::u32x4 w; unsigned pr[4];
#pragma unroll
        for (int q = 0; q < 4; ++q) { float v[2];
#pragma unroll
            for (int e = 0; e < 2; ++e) { const int kk = kk0 + 2 * q + e, part = kk >> 8, t = kk & 255, idx = ((k * t) & 255) * 8; v[e] = part ? -trig[2048 + idx] : trig[idx]; }
            pr[q] = pg8::cvt_pk_bf16(v[0], v[1]); }
        w.x = pr[0]; w.y = pr[1]; w.z = pr[2]; w.w = pr[3];
        *(pg8::u32x4*)(DC + (size_t)k * 512 + kk0) = w;
    }
}

constexpr size_t WS_BAR = 7 * MiB;
constexpr int LDS_BYTES = 147456;
struct Args { const float* in[30]; float* out; unsigned char* ws; };
typedef const __attribute__((address_space(4))) Args* CArgs;
__device__ __forceinline__ CArgs kargs() { CArgs p = (CArgs)__builtin_amdgcn_kernarg_segment_ptr(); asm volatile("" : "+s"(p)); return p; }
#define IN(i) (kargs()->in[i])
#define WSB(T, off) ((T*)(kargs()->ws + (off)))
#define OUTP (kargs()->out)
enum { I_X = 0, I_C, I_CTX, I_CCTX, I_ADAW, I_ADAB, I_NMIX, I_NFFN, I_WIN, I_QNORM, I_WUQ, I_KVNORM, I_WUKV, I_QKQ, I_QKK, I_LRE, I_LIM, I_LSTEP, I_BRE, I_BIM, I_CRE, I_CIM, I_S5D, I_WGLU, I_RDEC, I_RGN, I_WBR, I_WOUT, I_W1, I_W2 };
#define GRID_BAR() do { bar.bar = WSB(unsigned, WS_BAR); { unsigned x_ = bar.x; asm volatile("" : "+s"(x_)); bar.x = x_; } xcd_barrier(bar); } while (0)
template <int L> __device__ __forceinline__ void layer_body(unsigned char* lds, XcdBarrier& bar) {
    constexpr int l = L;
    constexpr bool LASTL = (L == DEPTH - 1);
    constexpr int NMT = LASTL ? RL / 256 : RT / 256;
    constexpr int WCTX = LASTL ? 0 : 1;

#define MODL (WSB(float, WS_MOD) + (size_t)l * 9 * 6144)
#define XLAT (l == 0 ? IN(I_X) : (const float*)OUTP)
#define XCTX (l == 0 ? IN(I_CTX) : (const float*)WSB(float, WS_XC))
#define WINL (IN(I_WIN) + (size_t)l * DM * INC)
#define ZP WSB(bf16_t, WS_Z)
#define XNP WSB(bf16_t, WS_XN)
#define QP WSB(bf16_t, WS_QKV)
#define KP (WSB(bf16_t, WS_QKV) + (size_t)32 * 2304 * 96)
#define VP (WSB(bf16_t, WS_QKV) + (size_t)2 * 32 * 2304 * 96)
#define F1LAT WSB(bf16_t, WS_F1)
#define F1CTX (WSB(bf16_t, WS_F1) + (size_t)8 * 256 * 2 * 2048)
#define QRAWP WSB(bf16_t, WS_RAW)
#define KVRAWP (WSB(bf16_t, WS_RAW) + (size_t)RT * 384)
        ph_s5_lp(l, IN(I_LRE), IN(I_LIM), IN(I_LSTEP), IN(I_BRE), IN(I_BIM), WSB(float2, WS_LP), WSB(float2, WS_BB), WSB(float, WS_LAMT));
        ph_adarms(XLAT, XCTX, IN(I_NMIX) + l * DM, MODL, 0, 1, XNP, RT);
        ph_convert_weights(lds, l, IN(I_WIN), IN(I_W1), IN(I_W2), IN(I_WOUT), IN(I_WBR), IN(I_WGLU), IN(I_WUQ), IN(I_QNORM), IN(I_WUKV), IN(I_KVNORM), kargs()->ws);
        if (l == 0) ph_dft_gen(WSB(float, WS_TRIG), WSB(bf16_t, WS_DFTL), WSB(bf16_t, WS_DFTC));
        GRID_BAR();
        ph_s5_tz(lds, l, WSB(float2, WS_LP), WSB(float2, WS_BB), IN(I_CRE), IN(I_CIM), WSB(float, WS_TZ));
        ph_s5_ms(WSB(float2, WS_LP), WSB(float2, WS_BB), WSB(bf16_t, WS_MS));
        ph_s5_qo(l, WSB(float2, WS_LP), IN(I_CRE), IN(I_CIM), WSB(bf16_t, WS_QO));
        { SchedP1 S; S.A = (const char*)XNP; S.B = (const char*)WSB(bf16_t, WS_WIN); S.G = l_grid(); S.c = l_bid(); S.last = LASTL ? 1 : 0;
          EpiStore E; E.O = ZP; E.ld = ZW; E.act = 0; pg8::gemm_phase((LAS unsigned char*)lds, S, E); }
        GRID_BAR();
        ph_prep(ZP, WSB(bf16_t, WS_WUQ), WSB(bf16_t, WS_WUKV), WSB(bf16_t, WS_D64), IN(I_QKQ) + l * 96, IN(I_QKK) + l * 96, QP, KP, VP, F1LAT, F1CTX);
        ph_s5_sloc(ZP, WSB(bf16_t, WS_MS), WSB(float, WS_SLOC));
        GRID_BAR();
        {
            const int bx = l_bid();
            if (bx < 64) { SchedGrid S; S.A = (const char*)WSB(bf16_t, WS_DFTL); S.B = (const char*)F1LAT; S.lda = 8192; S.ldb = 8192; S.nt = 64; S.nM = 8; S.nN = 8; S.G = 64; S.c = bx; S.kind = 0; S.aux = 0;
                EpiFourier E; E.Zp = ZP; E.rowbase = 0; E.L = 2048; E.scale = 0.0027621358640099515f; pg8::gemm_phase((LAS unsigned char*)lds, S, E); }
            constexpr int NS5 = 16 * (LASTL ? 16 : 18);
            constexpr int Q_RET = 0, Q_ATT = 256, Q_FC = 512, Q_RETC = Q_FC + (LASTL ? 0 : 8), Q_ATTC = Q_RETC + (LASTL ? 0 : 32), Q_S5 = Q_ATTC + (LASTL ? 0 : 32), Q_END = Q_S5 + NS5;
            volatile LAS int* qslot = (volatile LAS int*)((LAS unsigned char*)lds + LDS_BYTES - 32);
            for (;;) {
                __syncthreads();
                if (l_tid() == 0) qslot[0] = (int)atomicAdd(WSB(unsigned, WS_BAR) + XCD_BAR_WORDS + 64 * l, 1u);
                __syncthreads();
                const int q = __builtin_amdgcn_readfirstlane(qslot[0]);
                if (q >= Q_END) break;
                if (q < Q_ATT) ph_ret_mfma(lds, ZP, IN(I_RDEC) + l * 8, IN(I_RGN) + l * 256, WCTX, q - Q_RET, 1 << 20);
                else if (q < Q_FC) ph_attn_mfma(lds, QP, KP, VP, ZP, WCTX, q - Q_ATT, 1 << 20);
                else if (q < Q_RETC) { SchedGrid S; S.A = (const char*)WSB(bf16_t, WS_DFTC); S.B = (const char*)F1CTX; S.lda = 1024; S.ldb = 1024; S.nt = 8; S.nM = 1; S.nN = 8; S.G = 8; S.c = q - Q_FC; S.kind = 0; S.aux = 0;
                    EpiFourier E; E.Zp = ZP; E.rowbase = RL; E.L = 256; E.scale = 0.0078125f; pg8::gemm_phase((LAS unsigned char*)lds, S, E); }
                else if (q < Q_ATTC) ph_ret_mfma(lds, ZP, IN(I_RDEC) + l * 8, IN(I_RGN) + l * 256, WCTX, 256 + q - Q_RETC, 1 << 20);
                else if (q < Q_S5) ph_attn_mfma(lds, QP, KP, VP, ZP, WCTX, 256 + q - Q_ATTC, 1 << 20);
                else ph_s5_out(lds, ZP, WSB(float, WS_TZ), IN(I_S5D) + l * 256, WSB(bf16_t, WS_QO), WSB(float, WS_SLOC), WSB(float, WS_LAMT), ZP, LASTL ? 16 : 18, q - Q_S5, 1 << 20);
            }
        }
        GRID_BAR();
        { SchedGrid S; S.A = (const char*)(ZP + C_S5); S.B = (const char*)WSB(bf16_t, WS_WGLU); S.lda = ZW * 2; S.ldb = 512; S.nt = 4; S.nM = NMT; S.nN = 2; S.G = l_grid(); S.c = l_bid(); S.kind = 0; S.aux = 0;
          EpiGlu E; E.Zp = ZP; pg8::gemm_phase((LAS unsigned char*)lds, S, E); }
        GRID_BAR();
        { SchedMerge S; S.Z = (const char*)ZP; S.XN = (const char*)XNP; S.WBR = (const char*)WSB(bf16_t, WS_WBR); S.WING = (const char*)(WSB(bf16_t, WS_WIN) + (size_t)2048 * 1024);
          S.njobs = NMT * 4; S.G = l_grid(); { const int bx = l_bid(); S.vcu = (bx % 8) * (S.G / 8) + bx / 8; }
          EpiMerge E; E.stash = WSB(pg8::u32x4, WS_STASH) + (size_t)l_bid() * 8192; E.MMp = WSB(bf16_t, WS_MM); pg8::gemm_phase((LAS unsigned char*)lds, S, E); }
        GRID_BAR();
        { SchedGrid S; S.A = (const char*)WSB(bf16_t, WS_MM); S.B = (const char*)WSB(bf16_t, WS_WOUT); S.lda = 2048; S.ldb = 2048; S.nt = 16; S.nM = NMT; S.nN = 4; S.G = l_grid(); S.c = l_bid(); S.kind = 0; S.aux = 0;
          EpiResid E; E.xlat = XLAT; E.xctx = XCTX; E.olat = OUTP; E.octx = WSB(float, WS_XC); E.mod = MODL; E.gch = 2; pg8::gemm_phase((LAS unsigned char*)lds, S, E); }
        GRID_BAR();
        ph_adarms(OUTP, WSB(float, WS_XC), IN(I_NFFN) + l * DM, MODL, 3, 4, XNP, NMT * 256);
        GRID_BAR();
        { SchedGrid S; S.A = (const char*)XNP; S.B = (const char*)WSB(bf16_t, WS_W1); S.lda = 2048; S.ldb = 2048; S.nt = 16; S.nM = NMT; S.nN = 16; S.G = l_grid(); S.c = l_bid(); S.kind = 0; S.aux = 0;
          EpiStore E; E.O = WSB(bf16_t, WS_H); E.ld = DFF; E.act = 1; pg8::gemm_phase((LAS unsigned char*)lds, S, E); }
        GRID_BAR();
        { SchedGrid S; S.A = (const char*)WSB(bf16_t, WS_H); S.B = (const char*)WSB(bf16_t, WS_W2); S.lda = 8192; S.ldb = 8192; S.nt = 64; S.nM = NMT; S.nN = 4; S.G = l_grid(); S.c = l_bid(); S.kind = 0; S.aux = 0;
          EpiResid E; E.xlat = OUTP; E.xctx = WSB(float, WS_XC); E.olat = OUTP; E.octx = WSB(float, WS_XC); E.mod = MODL; E.gch = 5; pg8::gemm_phase((LAS unsigned char*)lds, S, E); }
        if (l + 1 < DEPTH) GRID_BAR();
}
__global__ void __launch_bounds__(NT, 2) mega(Args a_unused) {
    extern __shared__ __attribute__((aligned(16))) unsigned char lds[];
    volatile LAS unsigned* bst = (volatile LAS unsigned*)((LAS unsigned char*)lds + LDS_BYTES - 16);
    if (threadIdx.x < 4) bst[threadIdx.x] = 0u;
    __syncthreads();
    XcdBarrier bar = xcd_barrier_post(WSB(unsigned, WS_BAR), bst);

    ph_mod(lds, IN(I_C), IN(I_CCTX), IN(I_ADAW), IN(I_ADAB), WSB(float, WS_MOD));
    ph_trig(WSB(float, WS_TRIG), WSB(bf16_t, WS_D64));
    GRID_BAR();
    layer_body<0>(lds, bar);
    layer_body<1>(lds, bar);
}

extern "C" void kernel_launch(void* const* d_in, const int* in_sizes, int n_in, void* d_out, int out_size, void* d_ws, size_t ws_size, hipStream_t stream) {
    static int grid = 0;
    if (grid == 0) {
        if (n_in != 30 || ws_size < WS_END) { fprintf(stderr, "kernel_launch: unexpected n_in %d / ws_size %zu\n", n_in, ws_size); grid = -1; return; }
        int dev = 0, cus = 0, per_cu = 0;
        if (hipGetDevice(&dev) != hipSuccess || hipDeviceGetAttribute(&cus, hipDeviceAttributeMultiprocessorCount, dev) != hipSuccess) { grid = -1; return; }
        if (hipFuncSetAttribute((const void*)mega, hipFuncAttributeMaxDynamicSharedMemorySize, LDS_BYTES) != hipSuccess) { fprintf(stderr, "kernel_launch: hipFuncSetAttribute failed\n"); grid = -1; return; }
        if (hipOccupancyMaxActiveBlocksPerMultiprocessor(&per_cu, (const void*)mega, NT, LDS_BYTES) != hipSuccess || per_cu < 1) fprintf(stderr, "kernel_launch: occupancy query says %d\n", per_cu);
        (void)hipGetLastError();
        grid = cus;
    }
    if (grid < 0) return;
    (void)hipMemsetAsync((char*)d_ws + WS_BAR, 0, XCD_BAR_WORDS * 4 + 1024, stream);
    Args a; memset((void*)&a, 0, sizeof(a));
    for (int i = 0; i < 30; ++i) a.in[i] = (const float*)d_in[i];
    a.out = (float*)d_out; a.ws = (unsigned char*)d_ws;
    hipLaunchKernelGGL(mega, dim3(grid), dim3(NT), LDS_BYTES, stream, a);
}
```

```cpp
#include <hip/hip_runtime.h>
#include <cstdint>
#include <cstring>
#include <cstdio>

typedef unsigned short bf16_t;
typedef short bf16x8 __attribute__((ext_vector_type(8)));
typedef float f32x4 __attribute__((ext_vector_type(4)));

constexpr int DM = 1024, NB = 8, SEQ = 2048, CTX = 256, DEPTH = 2;
constexpr int RL = NB * SEQ;
constexpr int RC = NB * CTX;
constexpr int RT = RL + RC;
constexpr int INC = 6048;
constexpr int ZW = 2048;
constexpr int C_KVC = 0, C_KR = 128, C_S5 = 160, C_RK = 416, C_RV = 672, C_QC = 928, C_FU = 1184, C_RQ = 1440, C_RG = 1696, C_GATE = 1952;
constexpr int C_OC = C_RK;
constexpr int DFF = 4096;
constexpr int TCH = 64;
constexpr int NCH = RT / TCH;
constexpr float EPS = 1e-6f;
#define PI_D 3.14159265358979323846

__device__ __forceinline__ float bf2f(bf16_t v) { return __uint_as_float(((unsigned)v) << 16); }
__device__ __forceinline__ bf16_t f2bf(float f) { unsigned u = __float_as_uint(f); return (bf16_t)((u + 0x7fffu + ((u >> 16) & 1u)) >> 16); }
__device__ __forceinline__ float sigmoidf_(float x) { return 1.f / (1.f + __expf(-x)); }
__device__ __forceinline__ float siluf_(float x) { return x * sigmoidf_(x); }
__device__ __forceinline__ float geluf_(float x) { return 0.5f * x * (1.f + tanhf(0.7978845608028654f * (x + 0.044715f * x * x * x))); }
__device__ __forceinline__ int row_batch(int row) { return row < RL ? (row >> 11) : ((row - RL) >> 8); }
__device__ __forceinline__ int row_modidx(int row) { return row < RL ? (row >> 11) : 8; }

constexpr size_t MiB = 1ull << 20;
constexpr size_t WS_MOD = 0;
constexpr size_t WS_RS = 1 * MiB;
constexpr size_t WS_TRIG = WS_RS + 256 * 1024;
constexpr size_t WS_LAMT = WS_TRIG + 32 * 1024;
constexpr size_t WS_LP = 2 * MiB;
constexpr size_t WS_BB = 5 * MiB;
constexpr size_t WS_W = 8 * MiB;
constexpr size_t WS_WIN = WS_W, WS_W1 = WS_W + 12 * MiB, WS_W2 = WS_W + 20 * MiB, WS_WOUT = WS_W + 28 * MiB, WS_WBR = WS_W + 30 * MiB;
constexpr size_t WS_XN = 40 * MiB;
constexpr size_t WS_RAW = WS_XN;
constexpr size_t WS_YG = WS_XN;
constexpr size_t WS_Z = 76 * MiB;
constexpr size_t WS_QKV = 148 * MiB;
constexpr size_t WS_F1 = 184 * MiB;
constexpr size_t WS_GL = WS_F1;
constexpr size_t WS_TZ = 202 * MiB;
constexpr size_t WS_MS = 204 * MiB;
constexpr size_t WS_QO = 212 * MiB;
constexpr size_t WS_SLOC = 220 * MiB;
constexpr size_t WS_XP = 225 * MiB;
constexpr size_t WS_XC = 230 * MiB;
constexpr size_t WS_MM = WS_QKV;
constexpr size_t WS_STASH = WS_F1;
constexpr size_t WS_PM = 216 * MiB;
constexpr size_t WS_PD = WS_XN;
constexpr size_t WS_H = WS_Z;
constexpr size_t WS_WUQ = 6 * MiB + 256 * 1024;
constexpr size_t WS_WUKV = 6 * MiB + 512 * 1024;
constexpr size_t WS_D64 = 6 * MiB + 768 * 1024;
constexpr size_t WS_WGLU = 6 * MiB;
constexpr size_t WS_DFTL = 238 * MiB;
constexpr size_t WS_DFTC = 254 * MiB;
constexpr size_t WS_END = 256 * MiB;


#define LAS __attribute__((address_space(3)))
#define NT 512
__device__ __forceinline__ int l_tid() { int t = threadIdx.x; asm volatile("" : "+v"(t)); return t; }
__device__ __forceinline__ int l_bid() { int b = blockIdx.x; asm volatile("" : "+s"(b)); return b; }
__device__ __forceinline__ int l_grid() { int g = gridDim.x; asm volatile("" : "+s"(g)); return g; }
#define PH_IDS const int tid_ = l_tid(), bid_ = l_bid(), G_ = l_grid(); (void)tid_; (void)bid_; (void)G_
template <class AF, class BF, class EF>
__device__ __forceinline__ void gemm_tile(const AF& A, const BF& B, const EF& E, bool valid, int b, int m0, int n0, int M, int N, int K, bf16_t (*sA)[40], bf16_t (*sB)[40], int ht) {
    f32x4 accm[2][2];
#pragma unroll
    for (int i = 0; i < 2; ++i)
#pragma unroll
        for (int j = 0; j < 2; ++j) accm[i][j] = (f32x4){0.f, 0.f, 0.f, 0.f};
    const int w = ht >> 6, lane = ht & 63, wm = (w >> 1) * 32, wn = (w & 1) * 32, fr = lane & 15, fq = lane >> 4;
    for (int k0 = 0; k0 < K; k0 += 32) {
        __syncthreads();
#pragma unroll
        for (int i = 0; i < 8; ++i) {
            const int e = ht + i * 256;
            { const int m = e >> 5, k = e & 31; float v = 0.f; if (valid && m0 + m < M && k0 + k < K) v = A(b, m0 + m, k0 + k); sA[m][k] = f2bf(v); }
            { const int k = e >> 6, n = e & 63; float v = 0.f; if (valid && n0 + n < N && k0 + k < K) v = B(b, k0 + k, n0 + n); sB[n][k] = f2bf(v); }
        }
        __syncthreads();
        bf16x8 af[2], bfr[2];
#pragma unroll
        for (int i = 0; i < 2; ++i) { af[i] = *(const bf16x8*)&sA[wm + i * 16 + fr][fq * 8]; bfr[i] = *(const bf16x8*)&sB[wn + i * 16 + fr][fq * 8]; }
#pragma unroll
        for (int i = 0; i < 2; ++i)
#pragma unroll
            for (int j = 0; j < 2; ++j) accm[i][j] = __builtin_amdgcn_mfma_f32_16x16x32_bf16(af[i], bfr[j], accm[i][j], 0, 0, 0);
    }
    if (valid) {
#pragma unroll
        for (int i = 0; i < 2; ++i)
#pragma unroll
            for (int j = 0; j < 2; ++j)
#pragma unroll
                for (int rr = 0; rr < 4; ++rr) {
                    const int m = m0 + wm + i * 16 + fq * 4 + rr, n = n0 + wn + j * 16 + fr;
                    if (m < M && n < N) E(b, m, n, accm[i][j][rr]);
                }
    }
}
template <class AF, class BF, class EF>
__device__ __forceinline__ void gemm_phase(unsigned char* lds, const AF& A, const BF& B, const EF& E, int nbatch, int M, int N, int K) {
    PH_IDS; const int tid = tid_, half = tid >> 8, ht = tid & 255;
    bf16_t (*sA)[40] = (bf16_t (*)[40])(lds + half * 10240);
    bf16_t (*sB)[40] = (bf16_t (*)[40])(lds + half * 10240 + 5120);
    const int tm = (M + 63) >> 6, tn = (N + 63) >> 6, total = nbatch * tm * tn;
    for (int it0 = bid_ * 2; it0 < total; it0 += G_ * 2) {
        const int it = it0 + half; const bool valid = it < total;
        const int itc = valid ? it : 0;
        const int b = itc / (tm * tn), r = itc % (tm * tn), m0 = (r / tn) * 64, n0 = (r % tn) * 64;
        gemm_tile(A, B, E, valid, b, m0, n0, M, N, K, sA, sB, ht);
    }
    __syncthreads();
}
template <class T> static T zeroed() { T t; memset((void*)&t, 0, sizeof(T)); return t; }

struct A_bf16 { const bf16_t* p; long long ld; long long coff;
    __device__ float operator()(int, int m, int k) const { return bf2f(p[(size_t)m * ld + coff + k]); } };
struct A_bf16_scaled { const bf16_t* p; long long ld; long long coff; const float* rs; long long rsi; const float* w;
    __device__ float operator()(int, int m, int k) const { return bf2f(p[(size_t)m * ld + coff + k]) * rs[(size_t)m * 2 + rsi] * w[k]; } };
struct B_f32 { const float* p; long long ld; long long coff;
    __device__ float operator()(int, int k, int n) const { return p[(size_t)k * ld + coff + n]; } };
struct E_bf16 { bf16_t* p; long long ld; long long coff;
    __device__ void operator()(int, int m, int n, float v) const { p[(size_t)m * ld + coff + n] = f2bf(v); } };

#define XB_TMO      128
#define XB_XCNT(j)  (256  + 64 * (j))
#define XB_XSUB(j)  (1280 + 64 * (j))
#define XB_XGEN(j)  (2304 + 64 * (j))
#define XB_TOP      3328
#define XB_TOPGEN   3392
#define XCD_BAR_WORDS 3456
#define XB_SPIN_CAP (1u << 18)
__device__ __forceinline__ unsigned xb_ld(unsigned* p)              { return __hip_atomic_load(p, __ATOMIC_RELAXED, __HIP_MEMORY_SCOPE_AGENT); }
__device__ __forceinline__ unsigned xb_add(unsigned* p, unsigned v) { return __hip_atomic_fetch_add(p, v, __ATOMIC_RELAXED, __HIP_MEMORY_SCOPE_AGENT); }
__device__ __forceinline__ unsigned xb_xcc_id() { return (unsigned)__builtin_amdgcn_s_getreg((3 << 11) | 20) & 0xFu; }
#define XB_SPIN(cond, bar) do { unsigned _sp = 0; while (cond) { __builtin_amdgcn_s_sleep(1); \
    if ((++_sp & 255u) == 0u) { if (xb_ld(&(bar)[XB_TMO])) break; if (_sp > XB_SPIN_CAP) { atomicAdd(&(bar)[XB_TMO], 1u); break; } } } } while (0)
struct XcdBarrier { unsigned* bar; unsigned x; volatile LAS unsigned* st; };
__device__ __forceinline__ XcdBarrier xcd_barrier_post(unsigned* bar, volatile LAS unsigned* st) {
    XcdBarrier b; b.bar = bar; b.x = xb_xcc_id(); b.st = st;
    if (threadIdx.x == 0) (void)xb_add(&bar[XB_XCNT(b.x)], 1u);
    return b;
}
__device__ __forceinline__ void xcd_barrier_complete(unsigned* bar, unsigned x, unsigned& nloc, unsigned& nx) {
    const unsigned G = gridDim.x * gridDim.y * gridDim.z;
    unsigned sum, cnt, mine, sp = 0u;
    for (;;) {
        sum = 0u; cnt = 0u; mine = 0u;
#pragma unroll
        for (unsigned j = 0; j < 16; ++j) { const unsigned c = xb_ld(&bar[XB_XCNT(j)]); sum += c; cnt += (c > 0u) ? 1u : 0u; mine = (j == x) ? c : mine; }
        if (sum == G) break;
        __builtin_amdgcn_s_sleep(1);
        if ((++sp & 255u) == 0u) { if (xb_ld(&bar[XB_TMO])) break; if (sp > XB_SPIN_CAP) { atomicAdd(&bar[XB_TMO], 1u); break; } }
    }
    nloc = mine > 0u ? mine : 1u; nx = cnt > 0u ? cnt : 1u;
}
__device__ __forceinline__ void xcd_barrier(const XcdBarrier& b) {
    asm volatile("s_waitcnt vmcnt(0)" ::: "memory");
    __syncthreads();
    if (threadIdx.x == 0) {
        unsigned* bar = b.bar;
        __builtin_amdgcn_s_waitcnt(0);
        unsigned nloc = b.st[0], nx = b.st[1];
        if (nloc == 0u) { xcd_barrier_complete(bar, b.x, nloc, nx); b.st[0] = nloc; b.st[1] = nx; }
        const unsigned old = xb_add(&bar[XB_XSUB(b.x)], 1u);
        const unsigned gen = old / nloc;
        if (old + 1u == (gen + 1u) * nloc) {
            __builtin_amdgcn_fence(__ATOMIC_RELEASE, "agent");
            asm volatile("s_waitcnt vmcnt(0)" ::: "memory");
            const unsigned og = xb_add(&bar[XB_TOP], 1u);
            const unsigned tg = og / nx;
            if (og + 1u == (tg + 1u) * nx) xb_add(&bar[XB_TOPGEN], 1u);
            else XB_SPIN(xb_ld(&bar[XB_TOPGEN]) == tg, bar);
            __builtin_amdgcn_fence(__ATOMIC_ACQUIRE, "agent");
            xb_add(&bar[XB_XGEN(b.x)], 1u);
            asm volatile("s_waitcnt vmcnt(0)" ::: "memory");
        } else {
            XB_SPIN(xb_ld(&bar[XB_XGEN(b.x)]) == gen, bar);
            __builtin_amdgcn_fence(__ATOMIC_ACQUIRE, "agent");
            asm volatile("s_waitcnt vmcnt(0)" ::: "memory");
        }
    }
    __syncthreads();
}

namespace pg8 {
typedef unsigned u32x4 __attribute__((ext_vector_type(4)));
constexpr int BM = 256, BK = 64, HALF = 128, HTB = HALF * BK * 2, STAGE_BYTES = 8 * HTB, NXCD = 8, WGM = 8;
__device__ __forceinline__ int lds_byte(int r, int c) { const int st = (r >> 4) * 2 + (c >> 5), rr = r & 15, cc = c & 31, ob = rr * 64 + cc * 2; return st * 1024 + (ob ^ (((ob >> 9) & 1) << 5)); }
__device__ __forceinline__ void stage_rc(int b, int& R, int& C) { const int st = b / 1024, sb = b % 1024, swz = sb ^ (((sb >> 9) & 1) << 5); R = (st >> 1) * 16 + swz / 64; C = (st & 1) * 32 + (swz % 64) / 2; }
__device__ __forceinline__ int perm32(int rho) { const int n = rho >> 4, i = rho & 15; return 8 * (i >> 2) + 4 * n + (i & 3); }
struct Unit { const char* A; const char* B; unsigned lda, ldb; int nt, pm, pn, kind, aux; };
__device__ __forceinline__ unsigned cvt_pk_bf16(float lo, float hi) { unsigned r; asm volatile("v_cvt_pk_bf16_f32 %0, %1, %2" : "=v"(r) : "v"(lo), "v"(hi)); return r; }
__device__ __forceinline__ bool static_tile(int nM, int nN, int G, int c, int i, int& pm, int& pn) {
    const int nwg = nM * nN; const long L = (long)i * G + c; if (L >= nwg) return false;
    int wgid = (int)L; { const int q = nwg / NXCD, r = nwg % NXCD, xcd = wgid % NXCD, off = wgid / NXCD; wgid = (xcd < r ? xcd * (q + 1) : r * (q + 1) + (xcd - r) * q) + off; }
    const int nig = WGM * nN, gid = wgid / nig, fm = gid * WGM, gsz = (nM - fm) < WGM ? (nM - fm) : WGM;
    pm = fm + ((wgid % nig) % gsz); pn = (wgid % nig) / gsz; return true;
}
template <class Epi, class Sched>
__device__ __forceinline__ void gemm_phase(LAS unsigned char* lds, const Sched& S, const Epi& E) {
    const int tid = l_tid(), wid = __builtin_amdgcn_readfirstlane(tid >> 6), lane = tid & 63, wr = wid >> 2, wc = wid & 3, fr = lane & 15, fq = lane >> 4;
    int sR[2], sRb[2], sC2[2];
#pragma unroll
    for (int i = 0; i < 2; ++i) { int R, C; stage_rc(tid * 16 + i * 8192, R, C); sR[i] = R; sRb[i] = (R & ~31) + perm32(R & 31); sC2[i] = C * 2; }
    const size_t kstep = (size_t)(BK * 2);
    const unsigned ldsw = (unsigned)wid * 1024u;
    const int aoff = lds_byte(wr * 64 + fr, fq * 8), boff = lds_byte(wc * 32 + fr, fq * 8);
#define PG8_SA(b, h) (((b) * 2 + (h)) * HTB)
#define PG8_SB(b, h) ((4 + (b) * 2 + (h)) * HTB)
#define PG8_STAGE_A(bufoff, gbase, ld) do { \
        __builtin_amdgcn_global_load_lds((const unsigned*)((const char*)(gbase) + (unsigned)(sR[0] * (ld) + sC2[0])), (LAS unsigned*)(lds + (bufoff) + ldsw), 16, 0, 0); \
        __builtin_amdgcn_global_load_lds((const unsigned*)((const char*)(gbase) + (unsigned)(sR[1] * (ld) + sC2[1])), (LAS unsigned*)(lds + (bufoff) + ldsw + 8192), 16, 0, 0); } while (0)
#define PG8_STAGE_B(bufoff, gbase, ld) do { \
        __builtin_amdgcn_global_load_lds((const unsigned*)((const char*)(gbase) + (unsigned)(sRb[0] * (ld) + sC2[0])), (LAS unsigned*)(lds + (bufoff) + ldsw), 16, 0, 0); \
        __builtin_amdgcn_global_load_lds((const unsigned*)((const char*)(gbase) + (unsigned)(sRb[1] * (ld) + sC2[1])), (LAS unsigned*)(lds + (bufoff) + ldsw + 8192), 16, 0, 0); } while (0)
#define PG8_LDA(dst, b, h) do { _Pragma("unroll") for (int m = 0; m < 4; ++m) _Pragma("unroll") for (int k = 0; k < 2; ++k) dst[m][k] = *(const LAS bf16x8*)(lds + PG8_SA(b, h) + aoff + m * 2048 + k * 1024); } while (0)
#define PG8_LDB(dst, b, h) do { _Pragma("unroll") for (int n = 0; n < 2; ++n) _Pragma("unroll") for (int k = 0; k < 2; ++k) dst[n][k] = *(const LAS bf16x8*)(lds + PG8_SB(b, h) + boff + n * 2048 + k * 1024); } while (0)
#define PG8_MMA(ai, bj, At, Bt) do { __builtin_amdgcn_s_setprio(1); _Pragma("unroll") for (int m = 0; m < 4; ++m) _Pragma("unroll") for (int n = 0; n < 2; ++n) _Pragma("unroll") for (int k = 0; k < 2; ++k) \
        acc[ai][bj][m][n] = __builtin_amdgcn_mfma_f32_16x16x32_bf16(Bt[n][k], At[m][k], acc[ai][bj][m][n], 0, 0, 0); __builtin_amdgcn_s_setprio(0); } while (0)
#define PG8_WAIT_V(n) asm volatile("s_waitcnt vmcnt(" #n ")" ::: "memory")
#define PG8_WAIT_L(n) asm volatile("s_waitcnt lgkmcnt(" #n ")" ::: "memory")
#define PG8_BAR __builtin_amdgcn_s_barrier()
#define PG8_SCHED __builtin_amdgcn_sched_barrier(0)
    Unit cur, nxt; int ui = 0;
    if (!S.next(0, cur)) return;
    f32x4 acc[2][2][4][2];
#pragma unroll
    for (int a = 0; a < 2; ++a)
#pragma unroll
        for (int b = 0; b < 2; ++b)
#pragma unroll
            for (int m = 0; m < 4; ++m)
#pragma unroll
                for (int n = 0; n < 2; ++n) acc[a][b][m][n] = (f32x4){0.f, 0.f, 0.f, 0.f};
    bf16x8 At[4][2], B0[2][2], B1[2][2];
    const char* cA = cur.A; const char* cB = cur.B;
    int clda = cur.lda, cldb = cur.ldb;
    PG8_STAGE_B(PG8_SB(0, 0), cB, cldb); PG8_STAGE_B(PG8_SB(0, 1), cB + (size_t)HALF * cldb, cldb); PG8_STAGE_A(PG8_SA(0, 0), cA, clda); PG8_STAGE_A(PG8_SA(0, 1), cA + (size_t)HALF * clda, clda);
    if (wr == 1) PG8_BAR;
    PG8_WAIT_V(2); PG8_BAR;
    PG8_STAGE_B(PG8_SB(1, 0), cB + kstep, cldb); PG8_STAGE_A(PG8_SA(1, 0), cA + kstep, clda); PG8_STAGE_B(PG8_SB(1, 1), cB + (size_t)HALF * cldb + kstep, cldb);
    PG8_WAIT_V(6); PG8_BAR;
    for (;;) {
        const bool has_next = S.next(ui + 1, nxt);
        const char* nA = has_next ? nxt.A : cA; const char* nB = has_next ? nxt.B : cB;
        const int nlda = has_next ? (int)nxt.lda : clda, nldb = has_next ? (int)nxt.ldb : cldb;
        const int nt = cur.nt;
        for (int t = 0; t < nt; t += 2) {
            const bool last = (t == nt - 2);
            const char* a1 = cA + (size_t)(t + 1) * kstep;
            const char* a2 = last ? nA : cA + (size_t)(t + 2) * kstep; const char* b2 = last ? nB : cB + (size_t)(t + 2) * kstep;
            const char* a3 = a2 + kstep; const char* b3 = b2 + kstep;
            const int lda2 = last ? nlda : clda, ldb2 = last ? nldb : cldb;
            PG8_LDB(B0, 0, 0); PG8_LDB(B1, 0, 1); PG8_SCHED; PG8_LDA(At, 0, 0); PG8_STAGE_A(PG8_SA(1, 1), a1 + (size_t)HALF * clda, clda);
            PG8_WAIT_V(8); PG8_WAIT_L(0); PG8_BAR; PG8_MMA(0, 0, At, B0); PG8_MMA(0, 1, At, B1); PG8_BAR; PG8_SCHED;
            PG8_LDA(At, 0, 1); PG8_STAGE_B(PG8_SB(0, 0), b2, ldb2); PG8_STAGE_B(PG8_SB(0, 1), b2 + (size_t)HALF * ldb2, ldb2); PG8_STAGE_A(PG8_SA(0, 0), a2, lda2);
            PG8_WAIT_V(8); PG8_WAIT_L(0); PG8_BAR; PG8_MMA(1, 0, At, B0); PG8_MMA(1, 1, At, B1); PG8_BAR; PG8_SCHED;
            PG8_LDB(B0, 1, 0); PG8_LDB(B1, 1, 1); PG8_SCHED; PG8_LDA(At, 1, 0); PG8_STAGE_A(PG8_SA(0, 1), a2 + (size_t)HALF * lda2, lda2);
            PG8_WAIT_V(8); PG8_WAIT_L(0); PG8_BAR; PG8_MMA(0, 0, At, B0); PG8_MMA(0, 1, At, B1); PG8_BAR; PG8_SCHED;
            PG8_LDA(At, 1, 1); PG8_STAGE_B(PG8_SB(1, 0), b3, ldb2); PG8_STAGE_B(PG8_SB(1, 1), b3 + (size_t)HALF * ldb2, ldb2); PG8_STAGE_A(PG8_SA(1, 0), a3, lda2);
            PG8_WAIT_V(8); PG8_WAIT_L(0); PG8_BAR; PG8_MMA(1, 0, At, B0); PG8_MMA(1, 1, At, B1); PG8_BAR; PG8_SCHED;
        }
        if (wr == 0) PG8_BAR;
        E(acc, cur, wr, wc, fr, fq);
        if (!has_next) break;
#pragma unroll
        for (int a = 0; a < 2; ++a)
#pragma unroll
            for (int b = 0; b < 2; ++b)
#pragma unroll
                for (int m = 0; m < 4; ++m)
#pragma unroll
                    for (int n = 0; n < 2; ++n) acc[a][b][m][n] = (f32x4){0.f, 0.f, 0.f, 0.f};
        cur = nxt; cA = nA; cB = nB; clda = nlda; cldb = nldb; ++ui;
        if (wr == 1) PG8_BAR;
    }
    PG8_WAIT_V(0);
    PG8_BAR;
#undef PG8_SA
#undef PG8_SB
#undef PG8_STAGE_A
#undef PG8_STAGE_B
#undef PG8_LDA
#undef PG8_LDB
#undef PG8_MMA
#undef PG8_WAIT_V
#undef PG8_WAIT_L
#undef PG8_BAR
#undef PG8_SCHED
}
}

__device__ __forceinline__ pg8::u32x4 pack8(const f32x4 a, const f32x4 b) { pg8::u32x4 w; w.x = pg8::cvt_pk_bf16(a[0], a[1]); w.y = pg8::cvt_pk_bf16(a[2], a[3]); w.z = pg8::cvt_pk_bf16(b[0], b[1]); w.w = pg8::cvt_pk_bf16(b[2], b[3]); return w; }
__device__ __forceinline__ void unpack8(const pg8::u32x4 w, f32x4& a, f32x4& b) {
    a[0] = __uint_as_float(w.x << 16); a[1] = __uint_as_float(w.x & 0xffff0000u); a[2] = __uint_as_float(w.y << 16); a[3] = __uint_as_float(w.y & 0xffff0000u);
    b[0] = __uint_as_float(w.z << 16); b[1] = __uint_as_float(w.z & 0xffff0000u); b[2] = __uint_as_float(w.w << 16); b[3] = __uint_as_float(w.w & 0xffff0000u); }
namespace fa {
typedef float f32x16 __attribute__((ext_vector_type(16)));
typedef short s16x4 __attribute__((ext_vector_type(4)));
typedef unsigned u32x4 __attribute__((ext_vector_type(4)));
typedef unsigned u32x2 __attribute__((ext_vector_type(2)));
__device__ __forceinline__ s16x4 vtr(const LAS char* p) { return __builtin_bit_cast(s16x4, __builtin_amdgcn_ds_read_tr16_b64_v4i16((LAS s16x4*)p)); }
__device__ __forceinline__ unsigned pk2(float lo, float hi) { unsigned r; asm volatile("v_cvt_pk_bf16_f32 %0, %1, %2" : "=v"(r) : "v"(lo), "v"(hi)); return r; }
__device__ __forceinline__ bf16x8 pack_p(const f32x16& p, int base) { u32x4 w; w.x = pk2(p[base], p[base + 1]); w.y = pk2(p[base + 2], p[base + 3]); w.z = pk2(p[base + 4], p[base + 5]); w.w = pk2(p[base + 6], p[base + 7]); return __builtin_bit_cast(bf16x8, w); }
__device__ __forceinline__ int crow(int r, int hi) { return (r & 3) + 8 * (r >> 2) + 4 * hi; }
__device__ __forceinline__ void pv_tile(f32x16& o0, f32x16& o1, const LAS char* vb, const bf16x8 (&pf)[4]) {
#pragma unroll
    for (int ks = 0; ks < 4; ++ks) {
        const s16x4 a0 = vtr(vb + ks * 1024), a1 = vtr(vb + ks * 1024 + 512), b0 = vtr(vb + 4096 + ks * 1024), b1 = vtr(vb + 4096 + ks * 1024 + 512);
        const bf16x8 v0 = (bf16x8){a0[0], a0[1], a0[2], a0[3], a1[0], a1[1], a1[2], a1[3]}, v1 = (bf16x8){b0[0], b0[1], b0[2], b0[3], b1[0], b1[1], b1[2], b1[3]};
        o0 = __builtin_amdgcn_mfma_f32_32x32x16_bf16(v0, pf[ks], o0, 0, 0, 0);
        o1 = __builtin_amdgcn_mfma_f32_32x32x16_bf16(v1, pf[ks], o1, 0, 0, 0);
    }
}
constexpr int KP_A = 208, KT_A = 64 * KP_A, VT = 8192, BUF_A = KT_A + VT;
constexpr int KP_R = 144, KT_R = 64 * KP_R, BUF_R = KT_R + VT;
}

#define GSTRIDE(gi, total) for (int gi = bid_ * NT + tid_; gi < (total); gi += G_ * NT)
__device__ __forceinline__ void ph_mod(unsigned char* lds, const float* c, const float* c_ctx, const float* ada_w, const float* ada_b, float* mod) { PH_IDS;
    float (*sl)[1024] = (float (*)[1024])lds;
    float* red = (float*)(lds + 9 * 1024 * 4);
    for (int e = tid_; e < 9 * 1024; e += NT) { const int j = e >> 10, k = e & 1023; const float v = j < 8 ? c[j * 1024 + k] : c_ctx[k]; sl[j][k] = siluf_(v); }
    __syncthreads();
    const int nn = tid_ & 63, ks = tid_ >> 6;
    for (int u = bid_; u < 2 * 96; u += G_) {
        const int l = u / 96, n = (u % 96) * 64 + nn;
        float acc[9];
#pragma unroll
        for (int j = 0; j < 9; ++j) acc[j] = 0.f;
        const float* w = ada_w + ((size_t)l * 1024 + ks * 128) * 6144 + n;
#pragma unroll 4
        for (int k = 0; k < 128; ++k) { const float wv = w[(size_t)k * 6144];
#pragma unroll
            for (int j = 0; j < 9; ++j) acc[j] += sl[j][ks * 128 + k] * wv; }
        __syncthreads();
#pragma unroll
        for (int j = 0; j < 9; ++j) red[(ks * 9 + j) * 64 + nn] = acc[j];
        __syncthreads();
        for (int e = tid_; e < 9 * 64; e += NT) { const int j = e >> 6, q = e & 63; float sum = 0.f;
#pragma unroll
            for (int r = 0; r < 8; ++r) sum += red[(r * 9 + j) * 64 + q];
            const int col = (u % 96) * 64 + q; mod[((size_t)l * 9 + j) * 6144 + col] = sum + ada_b[l * 6144 + col]; }
    }
    __syncthreads();
}
__device__ __forceinline__ void ph_trig(float* trig, bf16_t* d64) { PH_IDS; GSTRIDE(i, 2048) { const float xx = (float)i * (1.f / 1024.f); trig[i] = cospif(xx); trig[2048 + i] = sinpif(xx); }
    GSTRIDE(i, 128 * 64) { const int n = i >> 6, c = i & 63, m = n & 63; const float xx = (float)((m * c) & 63) * (1.f / 32.f); d64[i] = f2bf(n < 64 ? cospif(xx) : sinpif(xx)); } }
__device__ __forceinline__ double2 lam_pow(double re, double im, double dt, int k) {
    const double m = (double)__expf((float)(re * dt * k));
    double xx = im * dt * (double)k * 0.318309886183790671538;
    xx -= 2.0 * rint(xx * 0.5);
    const float xf = (float)xx;
    return make_double2(m * (double)cospif(xf), m * (double)sinpif(xf));
}
__device__ __forceinline__ void ph_s5_lp(int l, const float* lam_re, const float* lam_im, const float* log_step, const float* b_re, const float* b_im, float2* LP, float2* BB, float* lamT) { PH_IDS;
    GSTRIDE(it, 2 * 16 * 64 * 81) {
        const int i = it / 81, k = it % 81;
        const int d = i / 1024, g = (i / 64) % 16, p = i % 64;
        const size_t li = ((size_t)(l * 2 + d) * 16 + g) * 64 + p;
        const double re = lam_re[li], im = lam_im[li], dt = (double)expf(log_step[(l * 2 + d) * 16 + g]);
        if (k <= 64) {
            const double2 v = lam_pow(re, im, dt, k); LP[(size_t)i * 65 + k] = make_float2((float)v.x, (float)v.y);
            if (k == 64) { lamT[((size_t)(g * 2 + d) * 64 + p) * 2 + 0] = (float)v.x; lamT[((size_t)(g * 2 + d) * 64 + p) * 2 + 1] = (float)v.y; }
        } else {
            const int h = k - 65;
            const double2 l1 = lam_pow(re, im, dt, 1);
            const double nr = l1.x - 1.0, ni = l1.y, den = re * re + im * im;
            const double fr = (nr * re + ni * im) / den, fi = (ni * re - nr * im) / den;
            const double br = b_re[li * 16 + h], bi = b_im[li * 16 + h]; BB[(size_t)i * 16 + h] = make_float2((float)(fr * br - fi * bi), (float)(fr * bi + fi * br));
        }
    }
}
__device__ __forceinline__ void ph_s5_tz(unsigned char* lds_, int l, const float2* LP, const float2* BB, const float* c_re, const float* c_im, float* TZD) { PH_IDS;
    float2* sC = (float2*)lds_;
    float2* sL = sC + 16 * 64;
    float2* sB = sL + 64 * 65;
    for (int u = bid_; u < 32; u += G_) {
        const int g = u >> 1, d = u & 1;
        __syncthreads();
        for (int e = tid_; e < 16 * 64; e += NT) { const size_t ci = (((size_t)(l * 2 + d) * 16 + g) * 16) * 64 + e; sC[e] = make_float2(c_re[ci], c_im[ci]); }
        for (int e = tid_; e < 64 * 65; e += NT) sL[e] = LP[((size_t)d * 16 + g) * 64 * 65 + e];
        for (int e = tid_; e < 64 * 16; e += NT) sB[e] = BB[((size_t)d * 16 + g) * 64 * 16 + e];
        __syncthreads();
#pragma unroll 1
        for (int i = 0; i < 2; ++i) {
            const int r = tid_ + NT * i, tau = r >> 4, h = r & 15;
            float acc[16];
#pragma unroll
            for (int q = 0; q < 16; ++q) acc[q] = 0.f;
            for (int p = 0; p < 64; ++p) {
                const float2 c = sC[h * 64 + p], lp = sL[p * 65 + tau];
                const float er = c.x * lp.x - c.y * lp.y, ei = c.x * lp.y + c.y * lp.x;
#pragma unroll
                for (int q = 0; q < 16; ++q) { const float2 bb = sB[p * 16 + q]; acc[q] += er * bb.x - ei * bb.y; }
            }
            float* o = TZD + ((((size_t)d * 16 + g) * 64 + tau) * 16 + h) * 16;
#pragma unroll
            for (int q = 0; q < 4; ++q) *(f32x4*)(o + 4 * q) = (f32x4){acc[4 * q], acc[4 * q + 1], acc[4 * q + 2], acc[4 * q + 3]};
        }
    }
    __syncthreads();
}
__device__ __forceinline__ void ph_s5_ms(const float2* LP, const float2* BB, bf16_t* MST) { PH_IDS;
    GSTRIDE(i, 16 * 256 * 128) {
        const int g = i / (256 * 128), n = (i / 128) % 256, sh0 = (i % 128) * 8, d = n >> 7, p = n & 63, im = (n >> 6) & 1, s = sh0 >> 4, hp0 = sh0 & 15;
        const size_t gi = ((size_t)d * 16 + g) * 64 + p;
        const float2 lp = LP[gi * 65 + (d == 0 ? 63 - s : s)];
        float v[8];
#pragma unroll
        for (int q = 0; q < 8; ++q) { const float2 bb = BB[gi * 16 + hp0 + q]; v[q] = im ? lp.x * bb.y + lp.y * bb.x : lp.x * bb.x - lp.y * bb.y; }
        *(pg8::u32x4*)(MST + ((size_t)g * 256 + n) * 1024 + sh0) = pack8((f32x4){v[0], v[1], v[2], v[3]}, (f32x4){v[4], v[5], v[6], v[7]});
    }
}
__device__ __forceinline__ void ph_s5_qo(int l, const float2* LP, const float* c_re, const float* c_im, bf16_t* QOT) { PH_IDS;
    GSTRIDE(i, 16 * 1024 * 32) {
        const int g = i / (1024 * 32), th = (i / 32) % 1024, j0 = (i % 32) * 8, d = j0 >> 7, im = (j0 >> 6) & 1, p0 = j0 & 63, t = th >> 4, h = th & 15;
        const size_t ci = (((size_t)(l * 2 + d) * 16 + g) * 16 + h) * 64 + p0;
        const int e = d == 0 ? t + 1 : 64 - t;
        float v[8];
#pragma unroll
        for (int q = 0; q < 8; ++q) { const float cr = c_re[ci + q], cim = c_im[ci + q]; const float2 lp = LP[(((size_t)d * 16 + g) * 64 + p0 + q) * 65 + e]; v[q] = im ? -(cr * lp.y + cim * lp.x) : cr * lp.x - cim * lp.y; }
        *(pg8::u32x4*)(QOT + ((size_t)g * 1024 + th) * 256 + j0) = pack8((f32x4){v[0], v[1], v[2], v[3]}, (f32x4){v[4], v[5], v[6], v[7]});
    }
}
__device__ __forceinline__ void ph_adarms(const float* xlat, const float* xctx, const float* w, const float* mod, int sh_chunk, int sc_chunk, bf16_t* out, int nrows) { PH_IDS;
    const int wave = (bid_ * NT + tid_) >> 6, lane = tid_ & 63, nw = (G_ * NT) >> 6;
    for (int row = wave; row < nrows; row += nw) {
        const float* x = row < RL ? xlat + (size_t)row * DM : xctx + (size_t)(row - RL) * DM;
        f32x4 v[4]; float ss = 0.f;
#pragma unroll
        for (int j = 0; j < 4; ++j) { v[j] = *(const f32x4*)(x + j * 256 + lane * 4); ss += v[j][0] * v[j][0] + v[j][1] * v[j][1] + v[j][2] * v[j][2] + v[j][3] * v[j][3]; }
#pragma unroll
        for (int o = 1; o < 64; o <<= 1) ss += __shfl_xor(ss, o);
        const float rstd = rsqrtf(ss * (1.f / DM) + EPS);
        const float* mrow = mod + (size_t)row_modidx(row) * 6144;
#pragma unroll
        for (int j = 0; j < 4; ++j) { const int c0 = j * 256 + lane * 4;
            const f32x4 wv = *(const f32x4*)(w + c0), sc = *(const f32x4*)(mrow + sc_chunk * 1024 + c0), sh = *(const f32x4*)(mrow + sh_chunk * 1024 + c0);
            const f32x4 y = v[j] * rstd * wv * (sc + 1.f) + sh;
            fa::u32x2 o; o.x = fa::pk2(y[0], y[1]); o.y = fa::pk2(y[2], y[3]);
            *(fa::u32x2*)(out + (size_t)row * DM + c0) = o; }
    }
}
__device__ __forceinline__ void ph_mla_stats(const bf16_t* Z, float* rs) { PH_IDS;
    const int wave = (bid_ * NT + tid_) >> 6, lane = tid_ & 63, nw = (G_ * NT) >> 6;
    for (int row = wave; row < RT; row += nw) {
        const bf16_t* z = Z + (size_t)row * ZW; float sq = 0.f, sk = 0.f;
#pragma unroll
        for (int j = 0; j < 4; ++j) { const float v = bf2f(z[C_QC + j * 64 + lane]); sq += v * v; }
#pragma unroll
        for (int j = 0; j < 2; ++j) { const float v = bf2f(z[C_KVC + j * 64 + lane]); sk += v * v; }
#pragma unroll
        for (int o = 1; o < 64; o <<= 1) { sq += __shfl_xor(sq, o); sk += __shfl_xor(sk, o); }
        if (lane == 0) { rs[(size_t)row * 2] = rsqrtf(sq * (1.f / 256) + EPS); rs[(size_t)row * 2 + 1] = rsqrtf(sk * (1.f / 128) + EPS); }
    }
}
__device__ __forceinline__ void ph_mla_post(const bf16_t* Z, const bf16_t* qraw, const bf16_t* kvraw, const float* qkq, const float* qkk, bf16_t* Q, bf16_t* Kb, bf16_t* Vb) { PH_IDS;
    GSTRIDE(gi, RT * 8) {
        const int row = gi >> 3, h = (gi >> 1) & 3, isk = gi & 1;
        const bool lat = row < RL; const int b = row_batch(row), t = lat ? (row & 2047) : ((row - RL) & 255);
        const int qi = lat ? t : 2048 + t, ki = lat ? 256 + t : t;
        float v[96];
        float ss = 0.f;
        if (!isk) {
#pragma unroll
            for (int i = 0; i < 96; ++i) v[i] = bf2f(qraw[(size_t)row * 384 + h * 96 + i]);
        } else {
#pragma unroll
            for (int i = 0; i < 64; ++i) v[i] = bf2f(kvraw[(size_t)row * 512 + h * 128 + i]);
#pragma unroll
            for (int i = 0; i < 32; ++i) v[64 + i] = bf2f(Z[(size_t)row * ZW + C_KR + i]);
        }
#pragma unroll
        for (int i = 0; i < 96; ++i) ss += v[i] * v[i];
        const float rr = rsqrtf(ss * (1.f / 96) + EPS) * (isk ? 1.f : 0.14724727430627066f);
        const float* wv = isk ? qkk : qkq;
#pragma unroll
        for (int i = 0; i < 96; ++i) v[i] = v[i] * rr * wv[i];
        if (lat) {
            const float prow = (float)(t >> 6), pcol = (float)(t & 63);
#pragma unroll
            for (int part = 0; part < 2; ++part) { const float pos = part ? pcol : prow; const int base = 64 + part * 16;
#pragma unroll
                for (int j = 0; j < 8; ++j) { const float fr = exp2f(-(float)j * (13.287712379549449f / 8.f)), a = pos * fr, cs = __cosf(a), sn = __sinf(a);
                    const float x1 = v[base + j], x2 = v[base + 8 + j]; v[base + j] = x1 * cs - x2 * sn; v[base + 8 + j] = x1 * sn + x2 * cs; } }
        }
        bf16_t* o = isk ? Kb + ((size_t)(b * 4 + h) * 2304 + ki) * 96 : Q + ((size_t)(b * 4 + h) * 2304 + qi) * 96;
#pragma unroll
        for (int i = 0; i < 96; ++i) o[i] = f2bf(v[i]);
        if (isk) { bf16_t* vo = Vb + ((size_t)(b * 4 + h) * 2304 + ki) * 64; for (int i = 0; i < 64; ++i) vo[i] = kvraw[(size_t)row * 512 + h * 128 + 64 + i]; }
    }
}
__device__ __forceinline__ void ph_attn(unsigned char* lds, const bf16_t* Q, const bf16_t* Kb, const bf16_t* Vb, bf16_t* Z, int with_ctx) { PH_IDS;
    float (*sK)[96] = (float (*)[96])lds; float (*sV)[64] = (float (*)[64])(lds + 32 * 96 * 4);
    const int nunits = 32 * (8 + (with_ctx ? 1 : 0));
    const int qt = tid_ & 255, dh = (tid_ >> 8) * 32;
    for (int u = bid_; u < nunits; u += G_) {
        const int bh = u % 32, qb = u / 32;
        const bool lat = qb < 8;
        const int qi = qb * 256 + qt, nkeys = lat ? 2304 : 256;
        float q[96], o[32];
        const bf16_t* qp = Q + ((size_t)bh * 2304 + qi) * 96;
#pragma unroll
        for (int i = 0; i < 96; ++i) q[i] = bf2f(qp[i]) * 0.10206207261596577f;
#pragma unroll
        for (int i = 0; i < 32; ++i) o[i] = 0.f;
        float mx = -1e30f, l = 0.f;
        for (int k0 = 0; k0 < nkeys; k0 += 32) {
            __syncthreads();
            for (int e = tid_; e < 32 * 96; e += NT) sK[e / 96][e % 96] = bf2f(Kb[((size_t)bh * 2304 + k0) * 96 + e]);
            for (int e = tid_; e < 32 * 64; e += NT) sV[e / 64][e % 64] = bf2f(Vb[((size_t)bh * 2304 + k0) * 64 + e]);
            __syncthreads();
#pragma unroll 1
            for (int j = 0; j < 32; ++j) { float a = 0.f;
#pragma unroll
                for (int i = 0; i < 96; ++i) a += q[i] * sK[j][i];
                if (a > mx) { const float corr = __expf(mx - a); mx = a; l *= corr;
#pragma unroll
                    for (int i = 0; i < 32; ++i) o[i] *= corr; }
                const float p = __expf(a - mx); l += p;
#pragma unroll
                for (int i = 0; i < 32; ++i) o[i] += p * sV[j][dh + i]; }
        }
        const int b = bh >> 2, h = bh & 3;
        const int row = lat ? b * 2048 + qi : RL + b * 256 + (qi - 2048);
        const float inv = 1.f / l;
#pragma unroll
        for (int i = 0; i < 32; ++i) Z[(size_t)row * ZW + C_QC + h * 64 + dh + i] = f2bf(o[i] * inv);
    }
    __syncthreads();
}
__device__ __forceinline__ void ph_f1(const bf16_t* Z, const float* trig, bf16_t* F1lat, bf16_t* F1ctx) { PH_IDS;
    GSTRIDE(gi, RT * 256) {
        const int row = gi >> 8, gm = gi & 255, g = gm >> 6, m = gm & 63;
        float a = 0.f, bsum = 0.f;
        const bf16_t* u = Z + (size_t)row * ZW + C_FU + g * 64;
        for (int c = 0; c < 64; ++c) { const float v = bf2f(u[c]); const int idx = ((m * c) & 63) * 32; a += v * trig[idx]; bsum += v * trig[2048 + idx]; }
        if (row < RL) { const int b = row >> 11, t = row & 2047; bf16_t* o = F1lat + ((size_t)(b * 256 + gm) * 2) * 2048; o[t] = f2bf(a); o[2048 + t] = f2bf(bsum); }
        else { const int r = row - RL, b = r >> 8, t = r & 255; bf16_t* o = F1ctx + ((size_t)(b * 256 + gm) * 2) * 256; o[t] = f2bf(a); o[256 + t] = f2bf(bsum); }
    }
}
struct A_dft { const float* trig; long long L; long long mul;
    __device__ float operator()(int, int k, int kk) const { const int part = kk >= (int)L, t = part ? kk - (int)L : kk; const int idx = (int)(((long long)k * t) & (L - 1)) * (int)mul; return part ? -trig[2048 + idx] : trig[idx]; } };
struct B_f1t { const bf16_t* p; long long L;
    __device__ float operator()(int b, int kk, int n) const { return bf2f(p[((size_t)(b * 256 + n)) * 2 * L + kk]); } };
struct E_fourier { bf16_t* Z; long long rowbase; long long L; double scale;
    __device__ void operator()(int b, int m, int n, float v) const { Z[((size_t)rowbase + (size_t)b * L + m) * ZW + C_FU + n] = f2bf(v * (float)scale); } };

struct A_s5u { const bf16_t* Z;
    __device__ float operator()(int g, int rc, int k) const { return bf2f(Z[((size_t)rc * 64 + (k >> 4)) * ZW + C_S5 + g * 16 + (k & 15)]); } };
struct B_ms { const bf16_t* MS; __device__ float operator()(int g, int k, int n) const { return bf2f(MS[((size_t)g * 1024 + k) * 256 + n]); } };
struct E_sloc { float* S; __device__ void operator()(int g, int rc, int n, float v) const { S[((size_t)rc * 16 + g) * 256 + n] = v; } };
__device__ __forceinline__ void ph_s5_scan(const float* SLOC, const float* lamT, float* XP) { PH_IDS;
    GSTRIDE(i, 8 * 16 * 2 * 64) {
        const int b = i / 2048, g = (i / 128) % 16, d = (i / 64) % 2, p = i % 64;
        const float lr = lamT[((size_t)(g * 2 + d) * 64 + p) * 2], li = lamT[((size_t)(g * 2 + d) * 64 + p) * 2 + 1];
        float xr = 0.f, xi = 0.f;
        for (int step = 0; step < 36; ++step) {
            int rc;
            if (d == 0) rc = step < 4 ? 256 + b * 4 + step : b * 32 + (step - 4);
            else rc = step < 4 ? 256 + b * 4 + (3 - step) : b * 32 + (31 - (step - 4));
            const size_t o = ((size_t)rc * 16 + g) * 256 + d * 128;
            XP[o + p] = xr; XP[o + 64 + p] = xi;
            const float sr = SLOC[o + p], si = SLOC[o + 64 + p];
            const float nr = lr * xr - li * xi + sr, ni = lr * xi + li * xr + si; xr = nr; xi = ni;
        }
    }
}
struct A_s5out { const bf16_t* Z; const float* XP;
    __device__ float operator()(int g, int rc, int k) const { return k < 1024 ? bf2f(Z[((size_t)rc * 64 + (k >> 4)) * ZW + C_S5 + g * 16 + (k & 15)]) : XP[((size_t)rc * 16 + g) * 256 + (k - 1024)]; } };
struct B_s5out { const float* TZ; const bf16_t* QO;
    __device__ float operator()(int g, int k, int n) const { if (k < 1024) { const int s = k >> 4, hp = k & 15, t = n >> 4, h = n & 15; return TZ[(((size_t)g * 127 + (t - s + 63)) * 16 + hp) * 16 + h]; } return bf2f(QO[((size_t)g * 256 + (k - 1024)) * 1024 + n]); } };
struct E_s5out { bf16_t* YG; __device__ void operator()(int g, int rc, int n, float v) const { YG[((size_t)rc * 64 + (n >> 4)) * 256 + g * 16 + (n & 15)] = f2bf(geluf_(v)); } };
__device__ __forceinline__ void ph_glu(const bf16_t* GL, bf16_t* Z) { PH_IDS;
    GSTRIDE(gi, RT * 256) {
        const int row = gi >> 8, j = gi & 255;
        const float val = bf2f(GL[(size_t)row * 512 + j]), gate = bf2f(GL[(size_t)row * 512 + 256 + j]);
        Z[(size_t)row * ZW + C_S5 + j] = f2bf(val * sigmoidf_(gate));
    }
}
__device__ __forceinline__ void ph_ret_prep(bf16_t* Z) { PH_IDS;
    GSTRIDE(gi, RT * 4 * 32) {
        const int row = gi >> 7, h = (gi >> 5) & 3, j = gi & 31;
        bf16_t* z = Z + (size_t)row * ZW;
        if (row < RL) {
            const int t = row & 2047; const float fr = exp2f(-(float)j * (13.287712379549449f / 32.f)), a = (float)t * fr, cs = cosf(a), sn = sinf(a);
            { const float x1 = bf2f(z[C_RQ + h * 64 + j]), x2 = bf2f(z[C_RQ + h * 64 + 32 + j]); z[C_RQ + h * 64 + j] = f2bf(x1 * cs - x2 * sn); z[C_RQ + h * 64 + 32 + j] = f2bf(x1 * sn + x2 * cs); }
            { const float x1 = bf2f(z[C_RK + h * 64 + j]), x2 = bf2f(z[C_RK + h * 64 + 32 + j]); z[C_RK + h * 64 + j] = f2bf((x1 * cs - x2 * sn) * 0.125f); z[C_RK + h * 64 + 32 + j] = f2bf((x1 * sn + x2 * cs) * 0.125f); }
        } else {
            z[C_RK + h * 64 + j] = f2bf(bf2f(z[C_RK + h * 64 + j]) * 0.125f); z[C_RK + h * 64 + 32 + j] = f2bf(bf2f(z[C_RK + h * 64 + 32 + j]) * 0.125f);
        }
    }
}
__device__ __forceinline__ void ph_ret(unsigned char* lds, bf16_t* Z, const float* decay_logit, const float* gn_w, int with_ctx) { PH_IDS;
    float (*sK)[64] = (float (*)[64])lds; float (*sV)[64] = (float (*)[64])(lds + 32 * 64 * 4);
    float* sred = (float*)(lds + 2 * 32 * 64 * 4);
    const int nunits = 32 * (8 + (with_ctx ? 1 : 0));
    const int qt = tid_ & 255, hh = tid_ >> 8, dh = hh * 32;
    for (int u = bid_; u < nunits; u += G_) {
        const int bh = u % 32, qb = u / 32, b = bh >> 2, h = bh & 3;
        const bool lat = qb < 8;
        const int qpos = lat ? qb * 256 + qt : qt;
        const int qrow = lat ? b * 2048 + qpos : RL + b * 256 + qpos;
        const float lgf = -log1pf(__expf(-decay_logit[h])) * 1.4426950408889634f, lgb = -log1pf(__expf(-decay_logit[4 + h])) * 1.4426950408889634f;
        float q[64], o[32];
#pragma unroll
        for (int i = 0; i < 64; ++i) q[i] = bf2f(Z[(size_t)qrow * ZW + C_RQ + h * 64 + i]);
#pragma unroll
        for (int i = 0; i < 32; ++i) o[i] = 0.f;
        const int nkeys = lat ? 2560 : 256;
        for (int k0 = 0; k0 < nkeys; k0 += 32) {
            int krow0, kpos0;
            if (lat) { if (k0 < 256) { krow0 = RL + b * 256 + k0; kpos0 = k0 - 256; } else if (k0 < 2304) { krow0 = b * 2048 + (k0 - 256); kpos0 = k0 - 256; } else { krow0 = RL + b * 256 + (k0 - 2304); kpos0 = 2048 + (k0 - 2304); } }
            else { krow0 = RL + b * 256 + k0; kpos0 = k0; }
            __syncthreads();
            for (int e = tid_; e < 32 * 64; e += NT) { const int j = e >> 6, i = e & 63; sK[j][i] = bf2f(Z[(size_t)(krow0 + j) * ZW + C_RK + h * 64 + i]); sV[j][i] = bf2f(Z[(size_t)(krow0 + j) * ZW + C_RV + h * 64 + i]); }
            __syncthreads();
#pragma unroll 1
            for (int j = 0; j < 32; ++j) { float a = 0.f;
#pragma unroll
                for (int i = 0; i < 64; ++i) a += q[i] * sK[j][i];
                const int dpos = qpos - (kpos0 + j);
                const float dec = dpos > 0 ? exp2f(lgf * (float)dpos) : (dpos < 0 ? exp2f(lgb * (float)(-dpos)) : 2.f);
                a *= dec;
#pragma unroll
                for (int i = 0; i < 32; ++i) o[i] += a * sV[j][dh + i]; }
        }
        float s1 = 0.f;
#pragma unroll
        for (int i = 0; i < 32; ++i) s1 += o[i];
        __syncthreads();
        sred[hh * 256 + qt] = s1;
        __syncthreads();
        const float mu = (sred[qt] + sred[256 + qt]) * (1.f / 64);
        float s2 = 0.f;
#pragma unroll
        for (int i = 0; i < 32; ++i) { const float d = o[i] - mu; s2 += d * d; }
        __syncthreads();
        sred[hh * 256 + qt] = s2;
        __syncthreads();
        const float rstd = rsqrtf((sred[qt] + sred[256 + qt]) * (1.f / 64) + EPS);
#pragma unroll
        for (int i = 0; i < 32; ++i) { const float gte = bf2f(Z[(size_t)qrow * ZW + C_RG + h * 64 + dh + i]); const float y = (o[i] - mu) * rstd * gn_w[h * 64 + dh + i];
            Z[(size_t)qrow * ZW + C_RQ + h * 64 + dh + i] = f2bf(siluf_(gte) * y); }
    }
    __syncthreads();
}
struct E_merge { const bf16_t* stash; bf16_t* MMp; long long first;
    __device__ void operator()(int, int m, int n, float v) const { const size_t i = (size_t)m * DM + n; const float t = sigmoidf_(v) * bf2f(stash[i]); MMp[i] = f2bf(first ? t : bf2f(MMp[i]) + t); } };
struct E_resid { const float* xlat; const float* xctx; float* olat; float* octx; const float* mod; long long gchunk;
    __device__ void operator()(int, int m, int n, float v) const {
        const float g = mod[(size_t)row_modidx(m) * 6144 + gchunk * 1024 + n];
        if (m < RL) olat[(size_t)m * DM + n] = xlat[(size_t)m * DM + n] + g * v; else octx[(size_t)(m - RL) * DM + n] = xctx[(size_t)(m - RL) * DM + n] + g * v; } };
struct E_relu2 { bf16_t* H; __device__ void operator()(int, int m, int n, float v) const { const float r = fmaxf(v, 0.f); H[(size_t)m * DFF + n] = f2bf(r * r); } };


__device__ __forceinline__ void ph_s5_sloc(const bf16_t* Z, const bf16_t* MST, float* SLOC) { PH_IDS;
    const int lane = tid_ & 63, wid = __builtin_amdgcn_readfirstlane(tid_ >> 6), c16 = lane & 15, kq = lane >> 4;
    for (int u = bid_; u < 16 * 18; u += G_) {
        const int g = u / 18, rcbase = (u % 18) * 16;
        const bf16_t* up = Z + ((size_t)(rcbase + c16) * 64 + (kq >> 1)) * ZW + C_S5 + g * 16 + 8 * (kq & 1);
        const bf16_t* mp0 = MST + ((size_t)g * 256 + wid * 32 + c16) * 1024 + 8 * kq;
        f32x4 acc0 = (f32x4){0.f, 0.f, 0.f, 0.f}, acc1 = acc0;
#pragma unroll 8
        for (int ks = 0; ks < 32; ++ks) {
            const bf16x8 bfrag = *(const bf16x8*)(up + (size_t)(2 * ks) * ZW);
            const bf16x8 a0 = *(const bf16x8*)(mp0 + 32 * ks), a1 = *(const bf16x8*)(mp0 + 16 * 1024 + 32 * ks);
            acc0 = __builtin_amdgcn_mfma_f32_16x16x32_bf16(a0, bfrag, acc0, 0, 0, 0);
            acc1 = __builtin_amdgcn_mfma_f32_16x16x32_bf16(a1, bfrag, acc1, 0, 0, 0);
        }
        float* op = SLOC + ((size_t)(rcbase + c16) * 16 + g) * 256 + wid * 32 + 4 * kq;
        *(f32x4*)op = acc0; *(f32x4*)(op + 16) = acc1;
    }
}
__device__ __forceinline__ void ph_s5_out(unsigned char* lds_, const bf16_t* Z, const float* TZD, const float* s5d, const bf16_t* QOT, const float* SLOC, const float* lamT, bf16_t* YG, int nrct, int u0, int ustep) { PH_IDS;
    LAS char* sm = (LAS char*)lds_;
    constexpr int O_TZ = 0, O_XP = 65536, O_U = 73728, UP = 2064, O_SL = O_U + 16 * UP;
    const int lane = tid_ & 63, wid = __builtin_amdgcn_readfirstlane(tid_ >> 6), c16 = lane & 15, kq = lane >> 4;
    for (int u = u0; u < 16 * nrct; u += ustep) {
        const int g = u / nrct, rct = u % nrct, rcbase = rct * 16;
        const bool lat = rct < 16; const int b = rcbase >> 5, c0 = rcbase & 31;
        __syncthreads();
        for (int e = tid_; e < 127 * 64; e += NT) { const int dd = e >> 6, h = (e >> 2) & 15, q4 = (e & 3) * 4;
            const float* tf = TZD + ((((size_t)0 * 16 + g) * 64 + (dd >= 63 ? dd - 63 : 0)) * 16 + h) * 16 + q4; const float* tb = TZD + ((((size_t)1 * 16 + g) * 64 + (dd <= 63 ? 63 - dd : 0)) * 16 + h) * 16 + q4;
            f32x4 v = (f32x4){0.f, 0.f, 0.f, 0.f};
            if (dd >= 63) v += *(const f32x4*)tf;
            if (dd <= 63) v += *(const f32x4*)tb;
            if (dd == 63 && (h >> 2) == (q4 >> 2)) v[h & 3] += s5d[g * 16 + h];
            fa::u32x2 w; w.x = fa::pk2(v[0], v[1]); w.y = fa::pk2(v[2], v[3]);
            *(LAS fa::u32x2*)(sm + O_TZ + (dd * 16 + h) * 32 + q4 * 2) = w; }
        for (int e = tid_; e < 16 * 128; e += NT) { const int rc = e >> 7, s = (e >> 1) & 63, hh = e & 1;
            *(LAS fa::u32x4*)(sm + O_U + rc * UP + s * 32 + hh * 16) = *(const fa::u32x4*)(Z + ((size_t)(rcbase + rc) * 64 + s) * ZW + C_S5 + g * 16 + hh * 8); }
        const int nsl = lat ? 36 : 16;
        for (int e = tid_; e < nsl * 64; e += NT) { const int r = e >> 6, q4 = e & 63; const int rc = lat ? (r < 4 ? 256 + b * 4 + r : b * 32 + (r - 4)) : rcbase + r;
            *(LAS f32x4*)(sm + O_SL + r * 1024 + q4 * 16) = *(const f32x4*)(SLOC + ((size_t)rc * 16 + g) * 256 + q4 * 4); }
        __syncthreads();
        if (tid_ < 128) {
            const int d = tid_ >> 6, p = tid_ & 63;
            const float lr = lamT[((size_t)(g * 2 + d) * 64 + p) * 2], li = lamT[((size_t)(g * 2 + d) * 64 + p) * 2 + 1];
            const LAS float* sl = (const LAS float*)(sm + O_SL) + d * 128 + p;
            LAS bf16_t* xp = (LAS bf16_t*)(sm + O_XP) + d * 128 + p;
            float xr = 0.f, xi = 0.f;
#define S5_STEP(r) do { const float sr = sl[(r) * 256], si = sl[(r) * 256 + 64]; const float nr = lr * xr - li * xi + sr, ni = lr * xi + li * xr + si; xr = nr; xi = ni; } while (0)
            if (lat) {
                if (d == 0) { for (int r = 0; r < 4 + c0; ++r) S5_STEP(r);
                    for (int r = 0; r < 16; ++r) { xp[r * 256] = f2bf(xr); xp[r * 256 + 64] = f2bf(xi); S5_STEP(4 + c0 + r); } }
                else { for (int r = 3; r >= 0; --r) S5_STEP(r);
                    for (int c = 31; c >= c0 + 16; --c) S5_STEP(4 + c);
                    for (int r = 15; r >= 0; --r) { xp[r * 256] = f2bf(xr); xp[r * 256 + 64] = f2bf(xi); S5_STEP(4 + c0 + r); } }
            } else {
                if (d == 0) { for (int r = 0; r < 16; ++r) { if ((r & 3) == 0) { xr = 0.f; xi = 0.f; } xp[r * 256] = f2bf(xr); xp[r * 256 + 64] = f2bf(xi); S5_STEP(r); } }
                else { for (int r = 15; r >= 0; --r) { if ((r & 3) == 3) { xr = 0.f; xi = 0.f; } xp[r * 256] = f2bf(xr); xp[r * 256 + 64] = f2bf(xi); S5_STEP(r); } }
            }
#undef S5_STEP
        }
        __syncthreads();
        const LAS char* ub = sm + O_U + c16 * UP + kq * 16;
        const LAS char* xb = sm + O_XP + c16 * 512 + kq * 16;
#pragma unroll 1
        for (int i = 0; i < 8; ++i) {
            const int t = wid * 8 + i;
            f32x4 acc = (f32x4){0.f, 0.f, 0.f, 0.f};
            const LAS char* tz = sm + O_TZ + ((t + 63 - (kq >> 1)) * 16 + c16) * 32 + (kq & 1) * 16;
#pragma unroll 8
            for (int ks = 0; ks < 32; ++ks) {
                const bf16x8 a = *(const LAS bf16x8*)(tz - ks * 1024), bq = *(const LAS bf16x8*)(ub + ks * 64);
                acc = __builtin_amdgcn_mfma_f32_16x16x32_bf16(a, bq, acc, 0, 0, 0);
            }
            const bf16_t* qo = QOT + ((size_t)g * 1024 + t * 16 + c16) * 256 + 8 * kq;
#pragma unroll
            for (int ks = 0; ks < 8; ++ks) {
                const bf16x8 a = *(const bf16x8*)(qo + 32 * ks), bq = *(const LAS bf16x8*)(xb + ks * 64);
                acc = __builtin_amdgcn_mfma_f32_16x16x32_bf16(a, bq, acc, 0, 0, 0);
            }
            fa::u32x2 w; w.x = fa::pk2(geluf_(acc[0]), geluf_(acc[1])); w.y = fa::pk2(geluf_(acc[2]), geluf_(acc[3]));
            *(fa::u32x2*)(YG + ((size_t)(rcbase + c16) * 64 + t) * ZW + C_S5 + g * 16 + 4 * kq) = w;
        }
    }
    __syncthreads();
}
__device__ __forceinline__ void rope16(float (&v)[4], int kq, float pos, bool on) {
#pragma unroll
    for (int r = 0; r < 4; ++r) {
        const int j = (4 * kq + r) & 7;
        const float ang = pos * exp2f(-(float)j * (13.287712379549449f / 8.f)), cs = __cosf(ang), sn = __sinf(ang);
        const float other = __shfl_xor(v[r], 32);
        const float rot = kq < 2 ? v[r] * cs - other * sn : other * sn + v[r] * cs;
        v[r] = on ? rot : v[r];
    }
}
__device__ __forceinline__ void ph_prep(bf16_t* Z, const bf16_t* WUQ, const bf16_t* WUKV, const bf16_t* D64, const float* qkq, const float* qkk,
                                        bf16_t* Q, bf16_t* Kb, bf16_t* Vb, bf16_t* F1lat, bf16_t* F1ctx) { PH_IDS;
    const int lane = tid_ & 63, wid = __builtin_amdgcn_readfirstlane(tid_ >> 6), c16 = lane & 15, kq = lane >> 4;
    for (int blk = bid_; blk < RT / 72; blk += G_) {
        const int row0 = blk * 72;
#pragma unroll 1
      for (int pass3 = 0; pass3 < 2; ++pass3) {
        int rowc[3]; bool valid[3];
#pragma unroll
        for (int tt = 0; tt < 3; ++tt) { const int o = 16 * (3 * pass3 + tt) + c16; valid[tt] = o < 72; rowc[tt] = row0 + (valid[tt] ? o : 71); }
        if (wid < 4) {
            const int h = wid;
            f32x4 acc[6][3]; float ssq[3];
#pragma unroll
            for (int tt = 0; tt < 3; ++tt) { ssq[tt] = 0.f;
#pragma unroll
                for (int nt = 0; nt < 6; ++nt) acc[nt][tt] = (f32x4){0.f, 0.f, 0.f, 0.f}; }
#pragma unroll 1
            for (int ks = 0; ks < 8; ++ks) {
                bf16x8 bq[3], aw[6];
#pragma unroll
                for (int tt = 0; tt < 3; ++tt) { bq[tt] = *(const bf16x8*)(Z + (size_t)rowc[tt] * ZW + C_QC + 32 * ks + 8 * kq);
#pragma unroll
                    for (int e = 0; e < 8; ++e) { const float f = bf2f((bf16_t)bq[tt][e]); ssq[tt] += f * f; } }
#pragma unroll
                for (int nt = 0; nt < 6; ++nt) aw[nt] = *(const bf16x8*)(WUQ + (size_t)(h * 96 + 16 * nt + c16) * 256 + 32 * ks + 8 * kq);
#pragma unroll
                for (int nt = 0; nt < 6; ++nt)
#pragma unroll
                    for (int tt = 0; tt < 3; ++tt) acc[nt][tt] = __builtin_amdgcn_mfma_f32_16x16x32_bf16(aw[nt], bq[tt], acc[nt][tt], 0, 0, 0);
            }
#pragma unroll
            for (int tt = 0; tt < 3; ++tt) {
                float s1 = ssq[tt]; s1 += __shfl_xor(s1, 16); s1 += __shfl_xor(s1, 32);
                const float rstd = rsqrtf(s1 * (1.f / 256) + EPS);
                float ss = 0.f;
#pragma unroll
                for (int nt = 0; nt < 6; ++nt)
#pragma unroll
                    for (int r = 0; r < 4; ++r) ss += acc[nt][tt][r] * acc[nt][tt][r];
                ss += __shfl_xor(ss, 16); ss += __shfl_xor(ss, 32);
                const float fac = rstd * rsqrtf(rstd * rstd * ss * (1.f / 96) + EPS) * 0.14724727430627066f;
                const int row = rowc[tt]; const bool lat = row < RL; const int b = row_batch(row), t = lat ? (row & 2047) : ((row - RL) & 255), qi = lat ? t : 2048 + t;
                bf16_t* qo = Q + ((size_t)(b * 4 + h) * 2304 + qi) * 96 + 4 * kq;
#pragma unroll
                for (int nt = 0; nt < 6; ++nt) {
                    const f32x4 w = *(const f32x4*)(qkq + 16 * nt + 4 * kq);
                    float v[4];
#pragma unroll
                    for (int r = 0; r < 4; ++r) v[r] = acc[nt][tt][r] * fac * w[r];
                    if (nt >= 4) rope16(v, kq, nt == 4 ? (float)(t >> 6) : (float)(t & 63), lat);
                    fa::u32x2 o; o.x = fa::pk2(v[0], v[1]); o.y = fa::pk2(v[2], v[3]);
                    if (valid[tt]) *(fa::u32x2*)(qo + 16 * nt) = o;
                }
            }
        } else {
            const int h = wid - 4;
            float ssq[3], rstd[3];
#pragma unroll
            for (int tt = 0; tt < 3; ++tt) ssq[tt] = 0.f;
#pragma unroll 1
            for (int pass = 0; pass < 2; ++pass) {
                f32x4 acc[4][3];
#pragma unroll
                for (int tt = 0; tt < 3; ++tt)
#pragma unroll
                    for (int nt = 0; nt < 4; ++nt) acc[nt][tt] = (f32x4){0.f, 0.f, 0.f, 0.f};
#pragma unroll 1
                for (int ks = 0; ks < 4; ++ks) {
                    bf16x8 bq[3], aw[4];
#pragma unroll
                    for (int tt = 0; tt < 3; ++tt) { bq[tt] = *(const bf16x8*)(Z + (size_t)rowc[tt] * ZW + C_KVC + 32 * ks + 8 * kq);
                        if (pass == 0) {
#pragma unroll
                            for (int e = 0; e < 8; ++e) { const float f = bf2f((bf16_t)bq[tt][e]); ssq[tt] += f * f; } } }
#pragma unroll
                    for (int nt = 0; nt < 4; ++nt) aw[nt] = *(const bf16x8*)(WUKV + (size_t)(h * 128 + pass * 64 + 16 * nt + c16) * 128 + 32 * ks + 8 * kq);
#pragma unroll
                    for (int nt = 0; nt < 4; ++nt)
#pragma unroll
                        for (int tt = 0; tt < 3; ++tt) acc[nt][tt] = __builtin_amdgcn_mfma_f32_16x16x32_bf16(aw[nt], bq[tt], acc[nt][tt], 0, 0, 0);
                }
#pragma unroll
                for (int tt = 0; tt < 3; ++tt) {
                    const int row = rowc[tt]; const bool lat = row < RL; const int b = row_batch(row), t = lat ? (row & 2047) : ((row - RL) & 255), ki = lat ? 256 + t : t;
                    if (pass == 0) {
                        float s1 = ssq[tt]; s1 += __shfl_xor(s1, 16); s1 += __shfl_xor(s1, 32);
                        rstd[tt] = rsqrtf(s1 * (1.f / 128) + EPS);
                        float kr[2][4];
#pragma unroll
                        for (int e = 0; e < 2; ++e) { const fa::u32x2 w = *(const fa::u32x2*)(Z + (size_t)row * ZW + C_KR + 16 * e + 4 * kq);
                            kr[e][0] = __uint_as_float(w.x << 16); kr[e][1] = __uint_as_float(w.x & 0xffff0000u); kr[e][2] = __uint_as_float(w.y << 16); kr[e][3] = __uint_as_float(w.y & 0xffff0000u); }
                        float ss = 0.f;
#pragma unroll
                        for (int nt = 0; nt < 4; ++nt)
#pragma unroll
                            for (int r = 0; r < 4; ++r) { acc[nt][tt][r] *= rstd[tt]; ss += acc[nt][tt][r] * acc[nt][tt][r]; }
#pragma unroll
                        for (int e = 0; e < 2; ++e)
#pragma unroll
                            for (int r = 0; r < 4; ++r) ss += kr[e][r] * kr[e][r];
                        ss += __shfl_xor(ss, 16); ss += __shfl_xor(ss, 32);
                        const float fac = rsqrtf(ss * (1.f / 96) + EPS);
                        bf16_t* ko = Kb + ((size_t)(b * 4 + h) * 2304 + ki) * 96 + 4 * kq;
#pragma unroll
                        for (int nt = 0; nt < 6; ++nt) {
                            const f32x4 w = *(const f32x4*)(qkk + 16 * nt + 4 * kq);
                            float v[4];
#pragma unroll
                            for (int r = 0; r < 4; ++r) v[r] = (nt < 4 ? acc[nt < 4 ? nt : 0][tt][r] : kr[nt < 4 ? 0 : nt - 4][r]) * fac * w[r];
                            if (nt >= 4) rope16(v, kq, nt == 4 ? (float)(t >> 6) : (float)(t & 63), lat);
                            fa::u32x2 o; o.x = fa::pk2(v[0], v[1]); o.y = fa::pk2(v[2], v[3]);
                            if (valid[tt]) *(fa::u32x2*)(ko + 16 * nt) = o;
                        }
                    } else {
                        bf16_t* vo = Vb + ((size_t)(b * 4 + h) * 2304 + ki) * 64 + 4 * kq;
#pragma unroll
                        for (int nt = 0; nt < 4; ++nt) { fa::u32x2 o; o.x = fa::pk2(acc[nt][tt][0] * rstd[tt], acc[nt][tt][1] * rstd[tt]); o.y = fa::pk2(acc[nt][tt][2] * rstd[tt], acc[nt][tt][3] * rstd[tt]);
                            if (valid[tt]) *(fa::u32x2*)(vo + 16 * nt) = o; }
                    }
                }
            }
        }
        {
            const int g = wid >> 1, part = wid & 1;
            f32x4 acc[4][3];
#pragma unroll
            for (int tt = 0; tt < 3; ++tt)
#pragma unroll
                for (int nt = 0; nt < 4; ++nt) acc[nt][tt] = (f32x4){0.f, 0.f, 0.f, 0.f};
#pragma unroll
            for (int ks = 0; ks < 2; ++ks) {
                bf16x8 au[3], bd[4];
#pragma unroll
                for (int tt = 0; tt < 3; ++tt) au[tt] = *(const bf16x8*)(Z + (size_t)rowc[tt] * ZW + C_FU + g * 64 + 32 * ks + 8 * kq);
#pragma unroll
                for (int nt = 0; nt < 4; ++nt) bd[nt] = *(const bf16x8*)(D64 + (size_t)(part * 64 + 16 * nt + c16) * 64 + 32 * ks + 8 * kq);
#pragma unroll
                for (int nt = 0; nt < 4; ++nt)
#pragma unroll
                    for (int tt = 0; tt < 3; ++tt) acc[nt][tt] = __builtin_amdgcn_mfma_f32_16x16x32_bf16(au[tt], bd[nt], acc[nt][tt], 0, 0, 0);
            }
#pragma unroll
            for (int tt = 0; tt < 3; ++tt) {
                const int o4 = 16 * (3 * pass3 + tt) + 4 * kq; const int trow = row0 + o4;
                if (o4 < 72) {
                    const bool lat = trow < RL;
#pragma unroll
                    for (int nt = 0; nt < 4; ++nt) {
                        const int gm = g * 64 + 16 * nt + c16;
                        fa::u32x2 o; o.x = fa::pk2(acc[nt][tt][0], acc[nt][tt][1]); o.y = fa::pk2(acc[nt][tt][2], acc[nt][tt][3]);
                        if (lat) { const int b = trow >> 11, t0 = trow & 2047; *(fa::u32x2*)(F1lat + ((size_t)(b * 256 + gm) * 2 + part) * 2048 + t0) = o; }
                        else { const int rr = trow - RL, b = rr >> 8, t0 = rr & 255; *(fa::u32x2*)(F1ctx + ((size_t)(b * 256 + gm) * 2 + part) * 256 + t0) = o; }
                    }
                }
            }
        }
      }
#pragma unroll 1
        for (int it = tid_; it < 72 * 16; it += NT) {
            const int row = row0 + (it >> 4), h = (it >> 2) & 3, jg = it & 3;
            bf16_t* zq = Z + (size_t)row * ZW + C_RQ + h * 64 + 8 * jg; bf16_t* zk = Z + (size_t)row * ZW + C_RK + h * 64 + 8 * jg;
            const fa::u32x4 k1 = *(const fa::u32x4*)zk, k2 = *(const fa::u32x4*)(zk + 32);
            f32x4 ka, kb, kc, kd; unpack8(k1, ka, kb); unpack8(k2, kc, kd);
            if (row < RL) {
                const fa::u32x4 q1 = *(const fa::u32x4*)zq, q2 = *(const fa::u32x4*)(zq + 32);
                f32x4 qa, qb, qc, qd; unpack8(q1, qa, qb); unpack8(q2, qc, qd);
                const float tpos = (float)(row & 2047);
                float x1q[8] = {qa[0], qa[1], qa[2], qa[3], qb[0], qb[1], qb[2], qb[3]}, x2q[8] = {qc[0], qc[1], qc[2], qc[3], qd[0], qd[1], qd[2], qd[3]};
                float x1k[8] = {ka[0], ka[1], ka[2], ka[3], kb[0], kb[1], kb[2], kb[3]}, x2k[8] = {kc[0], kc[1], kc[2], kc[3], kd[0], kd[1], kd[2], kd[3]};
#pragma unroll
                for (int e = 0; e < 8; ++e) {
                    const float ang = tpos * exp2f(-(float)(8 * jg + e) * (13.287712379549449f / 32.f)), cs = cosf(ang), sn = sinf(ang);
                    const float a = x1q[e], c = x2q[e]; x1q[e] = a * cs - c * sn; x2q[e] = a * sn + c * cs;
                    const float a2 = x1k[e], c2 = x2k[e]; x1k[e] = (a2 * cs - c2 * sn) * 0.125f; x2k[e] = (a2 * sn + c2 * cs) * 0.125f;
                }
                *(fa::u32x4*)zq = pack8((f32x4){x1q[0], x1q[1], x1q[2], x1q[3]}, (f32x4){x1q[4], x1q[5], x1q[6], x1q[7]});
                *(fa::u32x4*)(zq + 32) = pack8((f32x4){x2q[0], x2q[1], x2q[2], x2q[3]}, (f32x4){x2q[4], x2q[5], x2q[6], x2q[7]});
                *(fa::u32x4*)zk = pack8((f32x4){x1k[0], x1k[1], x1k[2], x1k[3]}, (f32x4){x1k[4], x1k[5], x1k[6], x1k[7]});
                *(fa::u32x4*)(zk + 32) = pack8((f32x4){x2k[0], x2k[1], x2k[2], x2k[3]}, (f32x4){x2k[4], x2k[5], x2k[6], x2k[7]});
            } else {
                *(fa::u32x4*)zk = pack8(ka * 0.125f, kb * 0.125f); *(fa::u32x4*)(zk + 32) = pack8(kc * 0.125f, kd * 0.125f);
            }
        }
    }
}

__device__ __forceinline__ void ph_attn_mfma(unsigned char* lds_, const bf16_t* Q, const bf16_t* Kb, const bf16_t* Vb, bf16_t* Z, int with_ctx, int u0, int ustep) { PH_IDS;
    using namespace fa;
    LAS char* sm = (LAS char*)lds_;
    const int lane = tid_ & 63, wid = __builtin_amdgcn_readfirstlane(tid_ >> 6), r32 = lane & 31, hi = lane >> 5;
    const int nunits = 256 + (with_ctx ? 32 : 0);
    const int koff0 = (tid_ / 12) * KP_A + (tid_ % 12) * 16, koff1 = ((tid_ + 512) / 12) * KP_A + ((tid_ + 512) % 12) * 16;
    const int voff = KT_A + ((tid_ & 7) >> 2) * 4096 + (tid_ >> 3) * 64 + (tid_ & 3) * 16;
    const int vrd = KT_A + ((lane >> 4) & 1) * 32 + (lane & 3) * 8 + (4 * hi + ((lane & 15) >> 2)) * 64;
    for (int u = u0; u < nunits; u += ustep) {
        const bool lat = u < 256; const int bh = lat ? (u >> 3) : (u - 256), qb = lat ? (u & 7) : 8;
        const int ntile = lat ? 36 : 4;
        const char* Kg = (const char*)(Kb + (size_t)bh * 2304 * 96); const char* Vg = (const char*)(Vb + (size_t)bh * 2304 * 64);
        const bf16_t* Qg = Q + ((size_t)bh * 2304 + qb * 256 + wid * 32 + r32) * 96;
        bf16x8 qf[6];
#pragma unroll
        for (int st = 0; st < 6; ++st) qf[st] = *(const bf16x8*)(Qg + 16 * st + 8 * hi);
        f32x16 o0, o1;
#pragma unroll
        for (int r = 0; r < 16; ++r) { o0[r] = 0.f; o1[r] = 0.f; }
        float mrun = 0.f, lsum = 0.f;
        f32x16 negm;
#pragma unroll
        for (int r = 0; r < 16; ++r) negm[r] = 0.f;
        u32x4 kr0, kr1, vr;
        kr0 = *(const u32x4*)(Kg + tid_ * 16); kr1 = tid_ < 256 ? *(const u32x4*)(Kg + (tid_ + 512) * 16) : (u32x4){0u, 0u, 0u, 0u}; vr = *(const u32x4*)(Vg + tid_ * 16);
        __syncthreads();
        *(LAS u32x4*)(sm + koff0) = kr0; if (tid_ < 256) *(LAS u32x4*)(sm + koff1) = kr1; *(LAS u32x4*)(sm + voff) = vr;
        __syncthreads();
        for (int t = 0; t < ntile; ++t) {
            const int buf = (t & 1) * BUF_A;
            if (t + 1 < ntile) { const char* kg = Kg + (size_t)(t + 1) * 12288; const char* vg = Vg + (size_t)(t + 1) * 8192;
                kr0 = *(const u32x4*)(kg + tid_ * 16); if (tid_ < 256) kr1 = *(const u32x4*)(kg + (tid_ + 512) * 16); vr = *(const u32x4*)(vg + tid_ * 16); }
            const LAS char* kb = sm + buf + r32 * KP_A + 16 * hi;
            f32x16 p0 = negm, p1 = negm;
#pragma unroll
            for (int st = 0; st < 6; ++st) {
                const bf16x8 k0 = *(const LAS bf16x8*)(kb + 32 * st), k1 = *(const LAS bf16x8*)(kb + 32 * KP_A + 32 * st);
                p0 = __builtin_amdgcn_mfma_f32_32x32x16_bf16(k0, qf[st], p0, 0, 0, 0);
                p1 = __builtin_amdgcn_mfma_f32_32x32x16_bf16(k1, qf[st], p1, 0, 0, 0);
            }
            float ta = fmaxf(fmaxf(p0[0], p0[1]), p1[0]), tb = fmaxf(fmaxf(p0[2], p0[3]), p1[1]);
            ta = fmaxf(fmaxf(ta, p1[2]), p1[3]);
#pragma unroll
            for (int r = 4; r < 16; r += 4) { ta = fmaxf(fmaxf(ta, p0[r]), p0[r + 1]); tb = fmaxf(fmaxf(tb, p0[r + 2]), p0[r + 3]); ta = fmaxf(fmaxf(ta, p1[r]), p1[r + 1]); tb = fmaxf(fmaxf(tb, p1[r + 2]), p1[r + 3]); }
            float tm = fmaxf(ta, tb);
            tm = fmaxf(tm, __shfl_xor(tm, 32));
            if (t == 0 || __any(tm > 0.f)) {
                const float dl = t == 0 ? tm : fmaxf(tm, 0.f), alpha = t == 0 ? 1.f : __builtin_amdgcn_exp2f(-dl);
                mrun += dl; lsum *= alpha;
#pragma unroll
                for (int r = 0; r < 16; ++r) { p0[r] -= dl; p1[r] -= dl; o0[r] *= alpha; o1[r] *= alpha; negm[r] = -mrun; }
            }
            float ps = 0.f, ps2 = 0.f;
#pragma unroll
            for (int r = 0; r < 16; ++r) { p0[r] = __builtin_amdgcn_exp2f(p0[r]); p1[r] = __builtin_amdgcn_exp2f(p1[r]); ps += p0[r]; ps2 += p1[r]; }
            lsum += ps + ps2;
            bf16x8 pf[4]; pf[0] = pack_p(p0, 0); pf[1] = pack_p(p0, 8); pf[2] = pack_p(p1, 0); pf[3] = pack_p(p1, 8);
            pv_tile(o0, o1, sm + buf + vrd, pf);
            if (t + 1 < ntile) { const int nb = ((t + 1) & 1) * BUF_A; *(LAS u32x4*)(sm + nb + koff0) = kr0; if (tid_ < 256) *(LAS u32x4*)(sm + nb + koff1) = kr1; *(LAS u32x4*)(sm + nb + voff) = vr; }
            __syncthreads();
        }
        lsum += __shfl_xor(lsum, 32);
        const float inv = 1.f / lsum;
        const int b = bh >> 2, h = bh & 3;
        const int row = (lat ? b * 2048 + qb * 256 : RL + b * 256) + wid * 32 + r32;
        bf16_t* op = Z + (size_t)row * ZW + C_QC + h * 64 + 4 * hi;
#pragma unroll
        for (int g = 0; g < 4; ++g) {
            u32x2 w0, w1; w0.x = pk2(o0[4 * g] * inv, o0[4 * g + 1] * inv); w0.y = pk2(o0[4 * g + 2] * inv, o0[4 * g + 3] * inv);
            w1.x = pk2(o1[4 * g] * inv, o1[4 * g + 1] * inv); w1.y = pk2(o1[4 * g + 2] * inv, o1[4 * g + 3] * inv);
            *(u32x2*)(op + 8 * g) = w0; *(u32x2*)(op + 32 + 8 * g) = w1;
        }
    }
    __syncthreads();
}

__device__ __forceinline__ void ph_ret_mfma(unsigned char* lds_, bf16_t* Z, const float* decay_logit, const float* gn_w, int with_ctx, int u0, int ustep) { PH_IDS;
    using namespace fa;
    LAS char* sm = (LAS char*)lds_;
    const int lane = tid_ & 63, wid = __builtin_amdgcn_readfirstlane(tid_ >> 6), r32 = lane & 31, hi = lane >> 5;
    const int nunits = 256 + (with_ctx ? 32 : 0);
    const int prow = tid_ >> 3, pc = tid_ & 7;
    const int koff = prow * KP_R + pc * 16;
    const int voff = KT_R + (pc >> 2) * 4096 + prow * 64 + (pc & 3) * 16;
    const int vrd = KT_R + ((lane >> 4) & 1) * 32 + (lane & 3) * 8 + (4 * hi + ((lane & 15) >> 2)) * 64;
    for (int u = u0; u < nunits; u += ustep) {
        const bool lat = u < 256; const int bh = lat ? (u >> 3) : (u - 256), qb = lat ? (u & 7) : 0, b = bh >> 2, h = bh & 3;
        const int ntile = lat ? 40 : 4;
        const float lgf = -log1pf(__expf(-decay_logit[h])) * 1.4426950408889634f, lgb = -log1pf(__expf(-decay_logit[4 + h])) * 1.4426950408889634f;
        const int qw0 = qb * 256 + wid * 32, qpos = qw0 + r32;
        const int qrow = (lat ? b * 2048 : RL + b * 256) + qpos;
        float ckf[16], ckb[16];
#pragma unroll
        for (int r = 0; r < 16; ++r) { const float off = (float)crow(r, hi); ckf[r] = __builtin_amdgcn_exp2f(-lgf * off); ckb[r] = __builtin_amdgcn_exp2f(lgb * off); }
        const float cf32 = __builtin_amdgcn_exp2f(-lgf * 32.f), cb32 = __builtin_amdgcn_exp2f(lgb * 32.f);
        bf16_t* zq = Z + (size_t)qrow * ZW;
        bf16x8 qf[4];
#pragma unroll
        for (int st = 0; st < 4; ++st) qf[st] = *(const bf16x8*)(zq + C_RQ + h * 64 + 16 * st + 8 * hi);
        f32x16 o0, o1;
#pragma unroll
        for (int r = 0; r < 16; ++r) { o0[r] = 0.f; o1[r] = 0.f; }
        const int ctx0 = RL + b * 256, lat0 = b * 2048;
#define RET_TILE_ROW(t) (lat ? ((t) < 4 ? ctx0 + 64 * (t) : ((t) < 36 ? lat0 + 64 * ((t) - 4) : ctx0 + 64 * ((t) - 36))) : ctx0 + 64 * (t))
#define RET_TILE_POS(t) (lat ? 64 * (t) - 256 : 64 * (t))
        u32x4 kr, vr;
        { const bf16_t* zr = Z + (size_t)(RET_TILE_ROW(0) + prow) * ZW + h * 64 + pc * 8; kr = *(const u32x4*)(zr + C_RK); vr = *(const u32x4*)(zr + C_RV); }
        __syncthreads();
        *(LAS u32x4*)(sm + koff) = kr; *(LAS u32x4*)(sm + voff) = vr;
        __syncthreads();
        for (int t = 0; t < ntile; ++t) {
            const int buf = (t & 1) * BUF_R;
            if (t + 1 < ntile) { const bf16_t* zr = Z + (size_t)(RET_TILE_ROW(t + 1) + prow) * ZW + h * 64 + pc * 8; kr = *(const u32x4*)(zr + C_RK); vr = *(const u32x4*)(zr + C_RV); }
            const LAS char* kb = sm + buf + r32 * KP_R + 16 * hi;
            f32x16 p0, p1;
#pragma unroll
            for (int r = 0; r < 16; ++r) { p0[r] = 0.f; p1[r] = 0.f; }
#pragma unroll
            for (int st = 0; st < 4; ++st) {
                const bf16x8 k0 = *(const LAS bf16x8*)(kb + 32 * st), k1 = *(const LAS bf16x8*)(kb + 32 * KP_R + 32 * st);
                p0 = __builtin_amdgcn_mfma_f32_32x32x16_bf16(k0, qf[st], p0, 0, 0, 0);
                p1 = __builtin_amdgcn_mfma_f32_32x32x16_bf16(k1, qf[st], p1, 0, 0, 0);
            }
            const int kp0 = RET_TILE_POS(t);
            if (kp0 + 63 < qw0) {
                const float sq = __builtin_amdgcn_exp2f(lgf * (float)(qpos - kp0)), sq1 = sq * cf32;
#pragma unroll
                for (int r = 0; r < 16; ++r) { p0[r] = p0[r] * ckf[r] * sq; p1[r] = p1[r] * ckf[r] * sq1; }
            } else if (kp0 > qw0 + 31) {
                const float sq = __builtin_amdgcn_exp2f(lgb * (float)(kp0 - qpos)), sq1 = sq * cb32;
#pragma unroll
                for (int r = 0; r < 16; ++r) { p0[r] = p0[r] * ckb[r] * sq; p1[r] = p1[r] * ckb[r] * sq1; }
            } else {
                const int d0 = qpos - kp0 - 4 * hi;
#pragma unroll
                for (int r = 0; r < 16; ++r) {
                    const int dp0 = d0 - ((r & 3) + 8 * (r >> 2)), dp1 = dp0 - 32;
                    const float w0 = dp0 > 0 ? __builtin_amdgcn_exp2f(lgf * (float)dp0) : (dp0 < 0 ? __builtin_amdgcn_exp2f(-lgb * (float)dp0) : 2.f);
                    const float w1 = dp1 > 0 ? __builtin_amdgcn_exp2f(lgf * (float)dp1) : (dp1 < 0 ? __builtin_amdgcn_exp2f(-lgb * (float)dp1) : 2.f);
                    p0[r] *= w0; p1[r] *= w1;
                }
            }
            bf16x8 pf[4]; pf[0] = pack_p(p0, 0); pf[1] = pack_p(p0, 8); pf[2] = pack_p(p1, 0); pf[3] = pack_p(p1, 8);
            pv_tile(o0, o1, sm + buf + vrd, pf);
            if (t + 1 < ntile) { const int nb = ((t + 1) & 1) * BUF_R; *(LAS u32x4*)(sm + nb + koff) = kr; *(LAS u32x4*)(sm + nb + voff) = vr; }
            __syncthreads();
        }
#undef RET_TILE_ROW
#undef RET_TILE_POS
        float s1 = 0.f;
#pragma unroll
        for (int r = 0; r < 16; ++r) s1 += o0[r] + o1[r];
        s1 += __shfl_xor(s1, 32);
        const float mu = s1 * (1.f / 64);
        float s2 = 0.f;
#pragma unroll
        for (int r = 0; r < 16; ++r) { const float a = o0[r] - mu, c = o1[r] - mu; s2 += a * a + c * c; }
        s2 += __shfl_xor(s2, 32);
        const float rstd = rsqrtf(s2 * (1.f / 64) + EPS);
#pragma unroll
        for (int g = 0; g < 4; ++g)
#pragma unroll
            for (int blk = 0; blk < 2; ++blk) {
                const int d = blk * 32 + 8 * g + 4 * hi;
                const u32x2 gt = *(const u32x2*)(zq + C_RG + h * 64 + d);
                const f32x4 gw = *(const f32x4*)(gn_w + h * 64 + d);
                float y[4];
#pragma unroll
                for (int q = 0; q < 4; ++q) { const float ov = blk ? o1[4 * g + q] : o0[4 * g + q]; const unsigned gb = q < 2 ? gt.x : gt.y; const float gv = __uint_as_float((q & 1) ? (gb & 0xffff0000u) : (gb << 16));
                    y[q] = siluf_(gv) * ((ov - mu) * rstd * gw[q]); }
                u32x2 w; w.x = pk2(y[0], y[1]); w.y = pk2(y[2], y[3]);
                *(u32x2*)(zq + C_RQ + h * 64 + d) = w;
            }
    }
    __syncthreads();
}

struct SchedGrid {
    const char* A; const char* B; unsigned lda, ldb; int nt, nM, nN, G, c, kind, aux;
    __device__ __forceinline__ bool next(int i, pg8::Unit& u) const {
        int pm, pn; if (!pg8::static_tile(nM, nN, G, c, i, pm, pn)) return false;
        u.A = A + (size_t)pm * 256 * lda; u.B = B + (size_t)pn * 256 * ldb; u.lda = lda; u.ldb = ldb; u.nt = nt; u.pm = pm; u.pn = pn; u.kind = kind; u.aux = aux; return true; }
};
struct SchedP1 {
    const char* A; const char* B; int G, c, last;
    __device__ __forceinline__ bool next(int i, pg8::Unit& u) const {
        int pm, pn;
        if (!last) { if (!pg8::static_tile(RT / 256, 8, G, c, i, pm, pn)) return false; }
        else { if (!pg8::static_tile(RL / 256, 8, G, c, i, pm, pn)) { const int j = i * G + c - (RL / 256) * 8; if (j < 0 || j >= 32) return false; pm = RL / 256 + (j >> 2); pn = j & 3; } }
        u.A = A + (size_t)pm * 256 * 2048; u.B = B + (size_t)pn * 256 * 2048; u.lda = 2048; u.ldb = 2048; u.nt = 16; u.pm = pm; u.pn = pn; u.kind = 0; u.aux = 0; return true; }
};
struct SchedMerge {
    const char* Z; const char* XN; const char* WBR; const char* WING; int njobs, G, vcu, nmini;
    __device__ __forceinline__ bool next(int i, pg8::Unit& u) const {
        int sub, n, pm, pn, part = 0;
        if (nmini > 0 && i >= 8) { if (i >= 10 || vcu >= nmini) return false; sub = i & 1; n = vcu & 3; pn = (vcu >> 2) & 3; pm = RL / 256 + (vcu >> 4); part = 1; }
        else { const int job = (i >> 3) * G + vcu; if (job >= njobs) return false; sub = i & 7; n = sub >> 1; pm = job >> 2; pn = job & 3; }
        u.pm = pm; u.pn = pn; u.aux = n;
        if (!(sub & 1)) { const int bcol = n == 0 ? C_QC : (n == 1 ? C_FU : (n == 2 ? C_OC : C_RQ));
            u.A = Z + ((size_t)pm * 256 * ZW + bcol) * 2; u.lda = ZW * 2; u.B = WBR + ((size_t)n * 1024 + pn * 256) * 512; u.ldb = 512; u.nt = 4; u.kind = 0; }
        else { u.A = XN + (size_t)pm * 256 * 2048; u.lda = 2048; u.B = WING + ((size_t)n * 1024 + pn * 256) * 2048; u.ldb = 2048; u.nt = 16; u.kind = part ? 2 : 1; }
        return true; }
};
struct SchedFfnDown {
    const char* H; const char* W2; int G, c, nctx;
    __device__ __forceinline__ bool next(int i, pg8::Unit& u) const {
        int pm, pn;
        if (pg8::static_tile(RL / 256, 4, G, c, i, pm, pn)) { u.A = H + (size_t)pm * 256 * 8192; u.B = W2 + (size_t)pn * 256 * 8192; u.lda = 8192; u.ldb = 8192; u.nt = 64; u.pm = pm; u.pn = pn; u.kind = 0; u.aux = 0; return true; }
        const int j = i * G + c - (RL / 256) * 4; if (j < 0 || j >= nctx) return false;
        pm = RL / 256 + (j >> 4); pn = (j >> 2) & 3; const int kq = j & 3;
        u.A = H + (size_t)pm * 256 * 8192 + kq * 2048; u.B = W2 + (size_t)pn * 256 * 8192 + kq * 2048; u.lda = 8192; u.ldb = 8192; u.nt = 16; u.pm = pm; u.pn = pn; u.kind = 3; u.aux = kq; return true; }
};
#define EPI_FOREACH(...) _Pragma("unroll") for (int ai = 0; ai < 2; ++ai) _Pragma("unroll") for (int m = 0; m < 4; ++m) _Pragma("unroll") for (int bj = 0; bj < 2; ++bj) { \
        const int row = u.pm * 256 + ai * 128 + wr * 64 + m * 16 + fr, col = u.pn * 256 + bj * 128 + wc * 32 + 8 * fq; const f32x4 v0 = acc[ai][bj][m][0], v1 = acc[ai][bj][m][1]; (void)row; (void)col; __VA_ARGS__ }
struct EpiStore {
    bf16_t* O; int ld; int act;
    __device__ __forceinline__ void operator()(const f32x4 (&acc)[2][2][4][2], const pg8::Unit& u, int wr, int wc, int fr, int fq) const {
        EPI_FOREACH( f32x4 a = v0, b = v1; if (act == 1) { _Pragma("unroll") for (int q = 0; q < 4; ++q) { const float ra = fmaxf(a[q], 0.f), rb = fmaxf(b[q], 0.f); a[q] = ra * ra; b[q] = rb * rb; } }
            *(pg8::u32x4*)(O + (size_t)row * ld + col) = pack8(a, b); )
    }
};
struct EpiResid {
    const float* xlat; const float* xctx; float* olat; float* octx; const float* mod; int gch; float* part;
    __device__ __forceinline__ void operator()(const f32x4 (&acc)[2][2][4][2], const pg8::Unit& u, int wr, int wc, int fr, int fq) const {
        if (u.kind == 3) { float* pb = part + (size_t)u.aux * RC * DM - (size_t)RL * DM;
            EPI_FOREACH( const size_t o = (size_t)row * DM + col; *(f32x4*)(pb + o) = v0; *(f32x4*)(pb + o + 4) = v1; if (bj) asm volatile("" ::: "memory"); )
            return; }
        const bool lat = u.pm < 64; const float* xb = lat ? xlat : xctx - (size_t)RL * DM; float* ob = lat ? olat : octx - (size_t)RL * DM;
        const float* g = mod + (size_t)(lat ? (u.pm >> 3) : 8) * 6144 + gch * 1024;
        EPI_FOREACH( const f32x4 g0 = *(const f32x4*)(g + col), g1 = *(const f32x4*)(g + col + 4); const size_t o = (size_t)row * DM + col;
            const f32x4 x0 = *(const f32x4*)(xb + o), x1 = *(const f32x4*)(xb + o + 4); *(f32x4*)(ob + o) = x0 + g0 * v0; *(f32x4*)(ob + o + 4) = x1 + g1 * v1; if (bj) asm volatile("" ::: "memory"); )
    }
};
struct EpiMerge {
    pg8::u32x4* stash; bf16_t* MMp; bf16_t* PMp;
    __device__ __forceinline__ void operator()(const f32x4 (&acc)[2][2][4][2], const pg8::Unit& u, int wr, int wc, int fr, int fq) const {
        int tid = threadIdx.x; asm volatile("" : "+v"(tid));
        if (u.kind == 0) { EPI_FOREACH( stash[((ai * 4 + m) * 2 + bj) * NT + tid] = pack8(v0, v1); if (bj) asm volatile("" ::: "memory"); ) }
        else { EPI_FOREACH( f32x4 y0, y1; unpack8(stash[((ai * 4 + m) * 2 + bj) * NT + tid], y0, y1); f32x4 t0, t1;
                _Pragma("unroll") for (int q = 0; q < 4; ++q) { t0[q] = sigmoidf_(v0[q]) * y0[q]; t1[q] = sigmoidf_(v1[q]) * y1[q]; }
                pg8::u32x4* mp = (pg8::u32x4*)((u.kind == 2 && u.aux != 0 ? PMp + (size_t)(u.aux - 1) * RC * DM - (size_t)RL * DM : MMp) + (size_t)row * DM + col);
                if (u.kind == 1 && u.aux != 0) { f32x4 p0, p1; unpack8(*mp, p0, p1); t0 += p0; t1 += p1; }
                *mp = pack8(t0, t1); asm volatile("" ::: "memory"); ) }
    }
};
__device__ __forceinline__ void transpose_item(const float* W, int K, int N, bf16_t* WT, int row_off, LAS float* scr, int item, int lane, const float* kscale = nullptr) {
    const int nblk = N / 32, kb = item / nblk, nb = item % nblk, k0 = 64 * kb, n0 = 32 * nb;
#pragma unroll 8
    for (int i = 0; i < 32; ++i) { const int kk = 2 * i + (lane >> 5); float wv = W[(size_t)(k0 + kk) * N + n0 + (lane & 31)]; if (kscale) wv *= kscale[k0 + kk]; scr[kk * 33 + (lane & 31)] = wv; }
    asm volatile("s_waitcnt lgkmcnt(0)" ::: "memory");
    const int c = lane & 7;
#pragma unroll
    for (int j = 0; j < 4; ++j) { const int n = (lane >> 3) + 8 * j; const LAS float* sp = scr + (8 * c) * 33 + n;
        pg8::u32x4 o; o.x = pg8::cvt_pk_bf16(sp[0 * 33], sp[1 * 33]); o.y = pg8::cvt_pk_bf16(sp[2 * 33], sp[3 * 33]); o.z = pg8::cvt_pk_bf16(sp[4 * 33], sp[5 * 33]); o.w = pg8::cvt_pk_bf16(sp[6 * 33], sp[7 * 33]);
        *(pg8::u32x4*)(WT + (size_t)(row_off + n0 + n) * K + k0 + 8 * c) = o; }
    asm volatile("s_waitcnt lgkmcnt(0)" ::: "memory");
}
__device__ __forceinline__ void ph_convert_weights(unsigned char* lds, int l, const float* w_in, const float* w1, const float* w2, const float* w_out, const float* w_br, const float* w_glu,
                                                   const float* w_uq, const float* q_norm, const float* w_ukv, const float* kv_norm, unsigned char* ws) { PH_IDS;
    const int wave = __builtin_amdgcn_readfirstlane(tid_ >> 6), lane = tid_ & 63;
    LAS float* scr = (LAS float*)((LAS unsigned char*)lds + wave * 16384);
    const int gw = bid_ * 8 + wave, NGW = G_ * 8;
    constexpr int I_IN = 16 * 189, I_1 = 16 * 128, I_2 = 64 * 32, I_O = 16 * 32, I_B = 4 * 32;
    constexpr int I_G = 4 * 16;
    constexpr int I_UQ = 4 * 12, I_UKV = 2 * 16;
    constexpr int NITEMS = I_IN + I_1 + I_2 + I_O + 4 * I_B + I_G + I_UQ + I_UKV;
    bf16_t* WIN_T = (bf16_t*)(ws + WS_WIN); bf16_t* W1_T = (bf16_t*)(ws + WS_W1); bf16_t* W2_T = (bf16_t*)(ws + WS_W2); bf16_t* WOUT_T = (bf16_t*)(ws + WS_WOUT); bf16_t* WBR_T = (bf16_t*)(ws + WS_WBR);
    for (int it = gw; it < NITEMS; it += NGW) {
        int r = it;
        if (r < I_IN) { const int nb = r % 189; transpose_item(w_in + (size_t)l * DM * INC, DM, INC, WIN_T, nb >= 61 ? 96 : 0, scr, r, lane); continue; } r -= I_IN;
        if (r < I_1) { transpose_item(w1 + (size_t)l * DM * DFF, DM, DFF, W1_T, 0, scr, r, lane); continue; } r -= I_1;
        if (r < I_2) { transpose_item(w2 + (size_t)l * DFF * DM, DFF, DM, W2_T, 0, scr, r, lane); continue; } r -= I_2;
        if (r < I_O) { transpose_item(w_out + (size_t)l * DM * DM, DM, DM, WOUT_T, 0, scr, r, lane); continue; } r -= I_O;
        if (r < 4 * I_B) { const int n = r / I_B; transpose_item(w_br + ((size_t)l * 4 + n) * 256 * DM, 256, DM, WBR_T + (size_t)n * 1024 * 256, 0, scr, r % I_B, lane); continue; } r -= 4 * I_B;
        { const int n0 = (r % 16) * 32; const int off = n0 < 128 ? 0 : (n0 < 256 ? 128 : (n0 < 384 ? -128 : 0));
          if (r < I_G) { transpose_item(w_glu + (size_t)l * 256 * 512, 256, 512, (bf16_t*)(ws + WS_WGLU), off, scr, r, lane); continue; } }
        r -= I_G;
        if (r < I_UQ) { transpose_item(w_uq + (size_t)l * 256 * 384, 256, 384, (bf16_t*)(ws + WS_WUQ), 0, scr, r, lane, q_norm + l * 256); continue; } r -= I_UQ;
        transpose_item(w_ukv + (size_t)l * 128 * 512, 128, 512, (bf16_t*)(ws + WS_WUKV), 0, scr, r, lane, kv_norm + l * 128);
    }
    GSTRIDE(gi, 96 * 1024 / 8) { *(pg8::u32x4*)(WIN_T + (size_t)1952 * 1024 + (size_t)gi * 8) = (pg8::u32x4){0u, 0u, 0u, 0u}; }
    __syncthreads();
}

struct EpiFourier {
    bf16_t* Zp; int rowbase, L; float scale;
    __device__ __forceinline__ void operator()(const f32x4 (&acc)[2][2][4][2], const pg8::Unit& u, int wr, int wc, int fr, int fq) const {
        EPI_FOREACH( *(pg8::u32x4*)(Zp + ((size_t)rowbase + (size_t)u.pn * L + row) * ZW + C_FU + (col - u.pn * 256)) = pack8(v0 * scale, v1 * scale); )
    }
};
struct EpiGlu {
    bf16_t* Zp;
    __device__ __forceinline__ void operator()(const f32x4 (&acc)[2][2][4][2], const pg8::Unit& u, int wr, int wc, int fr, int fq) const {
#pragma unroll
        for (int ai = 0; ai < 2; ++ai)
#pragma unroll
            for (int m = 0; m < 4; ++m) {
                const int row = u.pm * 256 + ai * 128 + wr * 64 + m * 16 + fr, col = u.pn * 128 + wc * 32 + 8 * fq;
                f32x4 a, b;
#pragma unroll
                for (int q = 0; q < 4; ++q) { a[q] = acc[ai][0][m][0][q] * sigmoidf_(acc[ai][1][m][0][q]); b[q] = acc[ai][0][m][1][q] * sigmoidf_(acc[ai][1][m][1][q]); }
                *(pg8::u32x4*)(Zp + (size_t)row * ZW + C_OC + col) = pack8(a, b);
            }
    }
};
__device__ __forceinline__ void ph_dft_gen(const float* trig, bf16_t* DL, bf16_t* DC) { PH_IDS;
    GSTRIDE(gi, 2048 * 4096 / 8) {
        const int k = gi >> 9, kk0 = (gi & 511) * 8; pg8::u32x4 w; unsigned pr[4];
#pragma unroll
        for (int q = 0; q < 4; ++q) { float v[2];
#pragma unroll
            for (int e = 0; e < 2; ++e) { const int kk = kk0 + 2 * q + e, part = kk >> 11, t = kk & 2047, idx = (k * t) & 2047; v[e] = part ? -trig[2048 + idx] : trig[idx]; }
            pr[q] = pg8::cvt_pk_bf16(v[0], v[1]); }
        w.x = pr[0]; w.y = pr[1]; w.z = pr[2]; w.w = pr[3];
        *(pg8::u32x4*)(DL + (size_t)k * 4096 + kk0) = w;
    }
    GSTRIDE(gi, 256 * 512 / 8) {
        const int k = gi >> 6, kk0 = (gi & 63) * 8; pg8::u32x4 w; unsigned pr[4];
#pragma unroll
        for (int q = 0; q < 4; ++q) { float v[2];
#pragma unroll
            for (int e = 0; e < 2; ++e) { const int kk = kk0 + 2 * q + e, part = kk >> 8, t = kk & 255, idx = ((k * t) & 255) * 8; v[e] = part ? -trig[2048 + idx] : trig[idx]; }
            pr[q] = pg8::cvt_pk_bf16(v[0], v[1]); }
        w.x = pr[0]; w.y = pr[1]; w.z = pr[2]; w.w = pr[3];
        *(pg8::u32x4*)(DC + (size_t)k * 512 + kk0) = w;
    }
}

__device__ __forceinline__ void ph_sum_mm(bf16_t* MMp, const bf16_t* PMp) { PH_IDS;
    GSTRIDE(gi, RC * DM / 8) {
        pg8::u32x4* mp = (pg8::u32x4*)(MMp + (size_t)RL * DM) + gi;
        f32x4 a, b; unpack8(*mp, a, b);
#pragma unroll
        for (int n = 0; n < 3; ++n) { f32x4 c, d; unpack8(*((const pg8::u32x4*)(PMp + (size_t)n * RC * DM) + gi), c, d); a += c; b += d; }
        *mp = pack8(a, b);
    }
}
__device__ __forceinline__ void ph_sum_ffn(float* XC, const float* PD, const float* mod) { PH_IDS;
    GSTRIDE(gi, RC * DM / 4) {
        const int col = (gi * 4) & (DM - 1);
        f32x4 a = *((const f32x4*)PD + gi);
#pragma unroll
        for (int n = 1; n < 4; ++n) a += *((const f32x4*)(PD + (size_t)n * RC * DM) + gi);
        const f32x4 g = *(const f32x4*)(mod + (size_t)8 * 6144 + 5 * 1024 + col);
        f32x4* xp = (f32x4*)XC + gi; *xp = *xp + g * a;
    }
}

constexpr size_t WS_BAR = 7 * MiB;
constexpr int LDS_BYTES = 147456;
struct Args { const float* in[30]; float* out; unsigned char* ws; };
typedef const __attribute__((address_space(4))) Args* CArgs;
__device__ __forceinline__ CArgs kargs() { CArgs p = (CArgs)__builtin_amdgcn_kernarg_segment_ptr(); asm volatile("" : "+s"(p)); return p; }
#define IN(i) (kargs()->in[i])
#define WSB(T, off) ((T*)(kargs()->ws + (off)))
#define OUTP (kargs()->out)
enum { I_X = 0, I_C, I_CTX, I_CCTX, I_ADAW, I_ADAB, I_NMIX, I_NFFN, I_WIN, I_QNORM, I_WUQ, I_KVNORM, I_WUKV, I_QKQ, I_QKK, I_LRE, I_LIM, I_LSTEP, I_BRE, I_BIM, I_CRE, I_CIM, I_S5D, I_WGLU, I_RDEC, I_RGN, I_WBR, I_WOUT, I_W1, I_W2 };
#define GRID_BAR() do { bar.bar = WSB(unsigned, WS_BAR); { unsigned x_ = bar.x; asm volatile("" : "+s"(x_)); bar.x = x_; } xcd_barrier(bar); } while (0)
template <int L> __device__ __forceinline__ void layer_body(unsigned char* lds, XcdBarrier& bar) {
    constexpr int l = L;
    constexpr bool LASTL = (L == DEPTH - 1);
    constexpr int NMT = LASTL ? RL / 256 : RT / 256;
    constexpr int WCTX = LASTL ? 0 : 1;

#define MODL (WSB(float, WS_MOD) + (size_t)l * 9 * 6144)
#define XLAT (l == 0 ? IN(I_X) : (const float*)OUTP)
#define XCTX (l == 0 ? IN(I_CTX) : (const float*)WSB(float, WS_XC))
#define WINL (IN(I_WIN) + (size_t)l * DM * INC)
#define ZP WSB(bf16_t, WS_Z)
#define XNP WSB(bf16_t, WS_XN)
#define QP WSB(bf16_t, WS_QKV)
#define KP (WSB(bf16_t, WS_QKV) + (size_t)32 * 2304 * 96)
#define VP (WSB(bf16_t, WS_QKV) + (size_t)2 * 32 * 2304 * 96)
#define F1LAT WSB(bf16_t, WS_F1)
#define F1CTX (WSB(bf16_t, WS_F1) + (size_t)8 * 256 * 2 * 2048)
#define QRAWP WSB(bf16_t, WS_RAW)
#define KVRAWP (WSB(bf16_t, WS_RAW) + (size_t)RT * 384)
        ph_s5_lp(l, IN(I_LRE), IN(I_LIM), IN(I_LSTEP), IN(I_BRE), IN(I_BIM), WSB(float2, WS_LP), WSB(float2, WS_BB), WSB(float, WS_LAMT));
        ph_adarms(XLAT, XCTX, IN(I_NMIX) + l * DM, MODL, 0, 1, XNP, RT);
        ph_convert_weights(lds, l, IN(I_WIN), IN(I_W1), IN(I_W2), IN(I_WOUT), IN(I_WBR), IN(I_WGLU), IN(I_WUQ), IN(I_QNORM), IN(I_WUKV), IN(I_KVNORM), kargs()->ws);
        if (l == 0) ph_dft_gen(WSB(float, WS_TRIG), WSB(bf16_t, WS_DFTL), WSB(bf16_t, WS_DFTC));
        GRID_BAR();
        ph_s5_tz(lds, l, WSB(float2, WS_LP), WSB(float2, WS_BB), IN(I_CRE), IN(I_CIM), WSB(float, WS_TZ));
        ph_s5_ms(WSB(float2, WS_LP), WSB(float2, WS_BB), WSB(bf16_t, WS_MS));
        ph_s5_qo(l, WSB(float2, WS_LP), IN(I_CRE), IN(I_CIM), WSB(bf16_t, WS_QO));
        { SchedP1 S; S.A = (const char*)XNP; S.B = (const char*)WSB(bf16_t, WS_WIN); S.G = l_grid(); S.c = l_bid(); S.last = LASTL ? 1 : 0;
          EpiStore E; E.O = ZP; E.ld = ZW; E.act = 0; pg8::gemm_phase((LAS unsigned char*)lds, S, E); }
        GRID_BAR();
        ph_prep(ZP, WSB(bf16_t, WS_WUQ), WSB(bf16_t, WS_WUKV), WSB(bf16_t, WS_D64), IN(I_QKQ) + l * 96, IN(I_QKK) + l * 96, QP, KP, VP, F1LAT, F1CTX);
        ph_s5_sloc(ZP, WSB(bf16_t, WS_MS), WSB(float, WS_SLOC));
        GRID_BAR();
        {
            const int bx = l_bid();
            if (bx < 64) { SchedGrid S; S.A = (const char*)WSB(bf16_t, WS_DFTL); S.B = (const char*)F1LAT; S.lda = 8192; S.ldb = 8192; S.nt = 64; S.nM = 8; S.nN = 8; S.G = 64; S.c = bx; S.kind = 0; S.aux = 0;
                EpiFourier E; E.Zp = ZP; E.rowbase = 0; E.L = 2048; E.scale = 0.0027621358640099515f; pg8::gemm_phase((LAS unsigned char*)lds, S, E); }
            constexpr int NS5 = 16 * (LASTL ? 16 : 18);
            constexpr int Q_RET = 0, Q_ATT = 256, Q_FC = 512, Q_RETC = Q_FC + (LASTL ? 0 : 8), Q_ATTC = Q_RETC + (LASTL ? 0 : 32), Q_S5 = Q_ATTC + (LASTL ? 0 : 32), Q_END = Q_S5 + NS5;
            volatile LAS int* qslot = (volatile LAS int*)((LAS unsigned char*)lds + LDS_BYTES - 32);
            for (;;) {
                __syncthreads();
                if (l_tid() == 0) qslot[0] = (int)atomicAdd(WSB(unsigned, WS_BAR) + XCD_BAR_WORDS + 64 * l, 1u);
                __syncthreads();
                const int q = __builtin_amdgcn_readfirstlane(qslot[0]);
                if (q >= Q_END) break;
                if (q < Q_ATT) ph_ret_mfma(lds, ZP, IN(I_RDEC) + l * 8, IN(I_RGN) + l * 256, WCTX, q - Q_RET, 1 << 20);
                else if (q < Q_FC) ph_attn_mfma(lds, QP, KP, VP, ZP, WCTX, q - Q_ATT, 1 << 20);
                else if (q < Q_RETC) { SchedGrid S; S.A = (const char*)WSB(bf16_t, WS_DFTC); S.B = (const char*)F1CTX; S.lda = 1024; S.ldb = 1024; S.nt = 8; S.nM = 1; S.nN = 8; S.G = 8; S.c = q - Q_FC; S.kind = 0; S.aux = 0;
                    EpiFourier E; E.Zp = ZP; E.rowbase = RL; E.L = 256; E.scale = 0.0078125f; pg8::gemm_phase((LAS unsigned char*)lds, S, E); }
                else if (q < Q_ATTC) ph_ret_mfma(lds, ZP, IN(I_RDEC) + l * 8, IN(I_RGN) + l * 256, WCTX, 256 + q - Q_RETC, 1 << 20);
                else if (q < Q_S5) ph_attn_mfma(lds, QP, KP, VP, ZP, WCTX, 256 + q - Q_ATTC, 1 << 20);
                else ph_s5_out(lds, ZP, WSB(float, WS_TZ), IN(I_S5D) + l * 256, WSB(bf16_t, WS_QO), WSB(float, WS_SLOC), WSB(float, WS_LAMT), ZP, LASTL ? 16 : 18, q - Q_S5, 1 << 20);
            }
        }
        GRID_BAR();
        { SchedGrid S; S.A = (const char*)(ZP + C_S5); S.B = (const char*)WSB(bf16_t, WS_WGLU); S.lda = ZW * 2; S.ldb = 512; S.nt = 4; S.nM = NMT; S.nN = 2; S.G = l_grid(); S.c = l_bid(); S.kind = 0; S.aux = 0;
          EpiGlu E; E.Zp = ZP; pg8::gemm_phase((LAS unsigned char*)lds, S, E); }
        GRID_BAR();
        { SchedMerge S; S.Z = (const char*)ZP; S.XN = (const char*)XNP; S.WBR = (const char*)WSB(bf16_t, WS_WBR); S.WING = (const char*)(WSB(bf16_t, WS_WIN) + (size_t)2048 * 1024);
          S.G = l_grid(); { const int bx = l_bid(); S.vcu = (bx % 8) * (S.G / 8) + bx / 8; }
          const bool mini = !LASTL && S.G == 256;
          S.njobs = mini ? RL / 256 * 4 : NMT * 4; S.nmini = mini ? 128 : 0;
          EpiMerge E; E.stash = WSB(pg8::u32x4, WS_STASH) + (size_t)l_bid() * 8192; E.MMp = WSB(bf16_t, WS_MM); E.PMp = WSB(bf16_t, WS_PM); pg8::gemm_phase((LAS unsigned char*)lds, S, E); }
        GRID_BAR();
        if (!LASTL && l_grid() == 256) { ph_sum_mm(WSB(bf16_t, WS_MM), WSB(bf16_t, WS_PM)); GRID_BAR(); }
        { SchedGrid S; S.A = (const char*)WSB(bf16_t, WS_MM); S.B = (const char*)WSB(bf16_t, WS_WOUT); S.lda = 2048; S.ldb = 2048; S.nt = 16; S.nM = NMT; S.nN = 4; S.G = l_grid(); S.c = l_bid(); S.kind = 0; S.aux = 0;
          EpiResid E; E.xlat = XLAT; E.xctx = XCTX; E.olat = OUTP; E.octx = WSB(float, WS_XC); E.mod = MODL; E.gch = 2; E.part = nullptr; pg8::gemm_phase((LAS unsigned char*)lds, S, E); }
        GRID_BAR();
        ph_adarms(OUTP, WSB(float, WS_XC), IN(I_NFFN) + l * DM, MODL, 3, 4, XNP, NMT * 256);
        GRID_BAR();
        { SchedGrid S; S.A = (const char*)XNP; S.B = (const char*)WSB(bf16_t, WS_W1); S.lda = 2048; S.ldb = 2048; S.nt = 16; S.nM = NMT; S.nN = 16; S.G = l_grid(); S.c = l_bid(); S.kind = 0; S.aux = 0;
          EpiStore E; E.O = WSB(bf16_t, WS_H); E.ld = DFF; E.act = 1; pg8::gemm_phase((LAS unsigned char*)lds, S, E); }
        GRID_BAR();
        { SchedFfnDown S; S.H = (const char*)WSB(bf16_t, WS_H); S.W2 = (const char*)WSB(bf16_t, WS_W2); S.G = l_grid(); S.c = l_bid(); S.nctx = (!LASTL && S.G == 256) ? 128 : 0;
          EpiResid E; E.xlat = OUTP; E.xctx = WSB(float, WS_XC); E.olat = OUTP; E.octx = WSB(float, WS_XC); E.mod = MODL; E.gch = 5; E.part = WSB(float, WS_PD);
          if (!LASTL && S.G != 256) { SchedGrid S2; S2.A = S.H; S2.B = S.W2; S2.lda = 8192; S2.ldb = 8192; S2.nt = 64; S2.nM = NMT; S2.nN = 4; S2.G = S.G; S2.c = S.c; S2.kind = 0; S2.aux = 0; pg8::gemm_phase((LAS unsigned char*)lds, S2, E); }
          else pg8::gemm_phase((LAS unsigned char*)lds, S, E); }
        if (!LASTL && l_grid() == 256) { GRID_BAR(); ph_sum_ffn(WSB(float, WS_XC), WSB(float, WS_PD), MODL); }
        if (l + 1 < DEPTH) GRID_BAR();
}
__global__ void __launch_bounds__(NT, 2) mega(Args a_unused) {
    extern __shared__ __attribute__((aligned(16))) unsigned char lds[];
    volatile LAS unsigned* bst = (volatile LAS unsigned*)((LAS unsigned char*)lds + LDS_BYTES - 16);
    if (threadIdx.x < 4) bst[threadIdx.x] = 0u;
    __syncthreads();
    XcdBarrier bar = xcd_barrier_post(WSB(unsigned, WS_BAR), bst);

    ph_mod(lds, IN(I_C), IN(I_CCTX), IN(I_ADAW), IN(I_ADAB), WSB(float, WS_MOD));
    ph_trig(WSB(float, WS_TRIG), WSB(bf16_t, WS_D64));
    GRID_BAR();
    layer_body<0>(lds, bar);
    layer_body<1>(lds, bar);
}

extern "C" void kernel_launch(void* const* d_in, const int* in_sizes, int n_in, void* d_out, int out_size, void* d_ws, size_t ws_size, hipStream_t stream) {
    static int grid = 0;
    if (grid == 0) {
        if (n_in != 30 || ws_size < WS_END) { fprintf(stderr, "kernel_launch: unexpected n_in %d / ws_size %zu\n", n_in, ws_size); grid = -1; return; }
        int dev = 0, cus = 0, per_cu = 0;
        if (hipGetDevice(&dev) != hipSuccess || hipDeviceGetAttribute(&cus, hipDeviceAttributeMultiprocessorCount, dev) != hipSuccess) { grid = -1; return; }
        if (hipFuncSetAttribute((const void*)mega, hipFuncAttributeMaxDynamicSharedMemorySize, LDS_BYTES) != hipSuccess) { fprintf(stderr, "kernel_launch: hipFuncSetAttribute failed\n"); grid = -1; return; }
        if (hipOccupancyMaxActiveBlocksPerMultiprocessor(&per_cu, (const void*)mega, NT, LDS_BYTES) != hipSuccess || per_cu < 1) fprintf(stderr, "kernel_launch: occupancy query says %d\n", per_cu);
        (void)hipGetLastError();
        grid = cus;
    }
    if (grid < 0) return;
    (void)hipMemsetAsync((char*)d_ws + WS_BAR, 0, XCD_BAR_WORDS * 4 + 1024, stream);
    Args a; memset((void*)&a, 0, sizeof(a));
    for (int i = 0; i < 30; ++i) a.in[i] = (const float*)d_in[i];
    a.out = (float*)d_out; a.ws = (unsigned char*)d_ws;
    hipLaunchKernelGGL(mega, dim3(grid), dim3(NT), LDS_BYTES, stream, a);
}
```

```cpp
#include <hip/hip_runtime.h>
#include <cstdint>
#include <cstring>
#include <cstdio>

typedef unsigned short bf16_t;
typedef short bf16x8 __attribute__((ext_vector_type(8)));
typedef float f32x4 __attribute__((ext_vector_type(4)));

constexpr int DM = 1024, NB = 8, SEQ = 2048, CTX = 256, DEPTH = 2;
constexpr int RL = NB * SEQ;
constexpr int RC = NB * CTX;
constexpr int RT = RL + RC;
constexpr int INC = 6048;
constexpr int ZW = 2048;
constexpr int C_KVC = 0, C_KR = 128, C_S5 = 160, C_RK = 416, C_RV = 672, C_QC = 928, C_FU = 1184, C_RQ = 1440, C_RG = 1696, C_GATE = 1952;
constexpr int C_OC = C_RK;
constexpr int DFF = 4096;
constexpr int TCH = 64;
constexpr int NCH = RT / TCH;
constexpr float EPS = 1e-6f;
#define PI_D 3.14159265358979323846

__device__ __forceinline__ float bf2f(bf16_t v) { return __uint_as_float(((unsigned)v) << 16); }
__device__ __forceinline__ bf16_t f2bf(float f) { unsigned u = __float_as_uint(f); return (bf16_t)((u + 0x7fffu + ((u >> 16) & 1u)) >> 16); }
__device__ __forceinline__ float sigmoidf_(float x) { return 1.f / (1.f + __expf(-x)); }
__device__ __forceinline__ float siluf_(float x) { return x * sigmoidf_(x); }
__device__ __forceinline__ float geluf_(float x) { return 0.5f * x * (1.f + tanhf(0.7978845608028654f * (x + 0.044715f * x * x * x))); }
__device__ __forceinline__ int row_batch(int row) { return row < RL ? (row >> 11) : ((row - RL) >> 8); }
__device__ __forceinline__ int row_modidx(int row) { return row < RL ? (row >> 11) : 8; }

constexpr size_t MiB = 1ull << 20;
constexpr size_t WS_MOD = 0;
constexpr size_t WS_RS = 512 * 1024;
constexpr size_t WS_TRIG = 512 * 1024;
constexpr size_t WS_LAMT = WS_TRIG + 32 * 1024;
constexpr size_t WS_LP = 1 * MiB;
constexpr size_t WS_BB = 2 * MiB + 128 * 1024;
constexpr size_t WS_W = 8 * MiB;
constexpr size_t WS_WIN = WS_W, WS_W1 = WS_W + 12 * MiB, WS_W2 = WS_W + 20 * MiB, WS_WOUT = WS_W + 28 * MiB, WS_WBR = WS_W + 30 * MiB;
constexpr size_t WS_XN = 40 * MiB;
constexpr size_t WS_RAW = WS_XN;
constexpr size_t WS_YG = WS_XN;
constexpr size_t WS_Z = 76 * MiB;
constexpr size_t WS_QKV = 148 * MiB;
constexpr size_t WS_F1 = 184 * MiB;
constexpr size_t WS_GL = WS_F1;
constexpr size_t WS_TZ = 202 * MiB;
constexpr size_t WS_MS = 204 * MiB;
constexpr size_t WS_QO = 212 * MiB;
constexpr size_t WS_MM = WS_QKV;
constexpr size_t WS_STASH = WS_F1;
constexpr size_t WS_KVF = 3 * MiB + 512 * 1024;
constexpr size_t WS_PD = WS_XN;
constexpr size_t WS_H = WS_Z;
constexpr size_t WS_WUQ = 2 * MiB + 768 * 1024;
constexpr size_t WS_WUKV = 3 * MiB;
constexpr size_t WS_D64 = 512 * 1024 + 64 * 1024;
constexpr size_t WS_WGLU = 2 * MiB + 512 * 1024;
constexpr size_t WS_CF = 3 * MiB + 128 * 1024;
constexpr size_t WS_WMF = 3 * MiB + 320 * 1024;
constexpr size_t WS_R = 220 * MiB;
constexpr size_t WS_XCB = 252 * MiB;
constexpr size_t OS_AT = 0;
constexpr size_t OS_BP = 1 * MiB;
constexpr size_t OS_DFTC = 53 * MiB;
constexpr size_t OS_SLOC = 17 * MiB;
constexpr size_t OS_KVB = 22 * MiB;
constexpr size_t OS_PM = 27 * MiB;
constexpr size_t OS_TZB = 41 * MiB;
constexpr size_t OS_CQ = 42 * MiB;
constexpr size_t OS_OC = 43 * MiB;
constexpr size_t OS_SS = 40 * MiB;
constexpr size_t WS_END = 256 * MiB;


#define LAS __attribute__((address_space(3)))
#define NT 512
__device__ __forceinline__ int l_tid() { int t = threadIdx.x; asm volatile("" : "+v"(t)); return t; }
__device__ __forceinline__ int l_bid() { int b = blockIdx.x; asm volatile("" : "+s"(b)); return b; }
__device__ __forceinline__ int l_grid() { int g = gridDim.x; asm volatile("" : "+s"(g)); return g; }
#define PH_IDS const int tid_ = l_tid(), bid_ = l_bid(), G_ = l_grid(); (void)tid_; (void)bid_; (void)G_
template <class AF, class BF, class EF>
__device__ __forceinline__ void gemm_tile(const AF& A, const BF& B, const EF& E, bool valid, int b, int m0, int n0, int M, int N, int K, bf16_t (*sA)[40], bf16_t (*sB)[40], int ht) {
    f32x4 accm[2][2];
#pragma unroll
    for (int i = 0; i < 2; ++i)
#pragma unroll
        for (int j = 0; j < 2; ++j) accm[i][j] = (f32x4){0.f, 0.f, 0.f, 0.f};
    const int w = ht >> 6, lane = ht & 63, wm = (w >> 1) * 32, wn = (w & 1) * 32, fr = lane & 15, fq = lane >> 4;
    for (int k0 = 0; k0 < K; k0 += 32) {
        __syncthreads();
#pragma unroll
        for (int i = 0; i < 8; ++i) {
            const int e = ht + i * 256;
            { const int m = e >> 5, k = e & 31; float v = 0.f; if (valid && m0 + m < M && k0 + k < K) v = A(b, m0 + m, k0 + k); sA[m][k] = f2bf(v); }
            { const int k = e >> 6, n = e & 63; float v = 0.f; if (valid && n0 + n < N && k0 + k < K) v = B(b, k0 + k, n0 + n); sB[n][k] = f2bf(v); }
        }
        __syncthreads();
        bf16x8 af[2], bfr[2];
#pragma unroll
        for (int i = 0; i < 2; ++i) { af[i] = *(const bf16x8*)&sA[wm + i * 16 + fr][fq * 8]; bfr[i] = *(const bf16x8*)&sB[wn + i * 16 + fr][fq * 8]; }
#pragma unroll
        for (int i = 0; i < 2; ++i)
#pragma unroll
            for (int j = 0; j < 2; ++j) accm[i][j] = __builtin_amdgcn_mfma_f32_16x16x32_bf16(af[i], bfr[j], accm[i][j], 0, 0, 0);
    }
    if (valid) {
#pragma unroll
        for (int i = 0; i < 2; ++i)
#pragma unroll
            for (int j = 0; j < 2; ++j)
#pragma unroll
                for (int rr = 0; rr < 4; ++rr) {
                    const int m = m0 + wm + i * 16 + fq * 4 + rr, n = n0 + wn + j * 16 + fr;
                    if (m < M && n < N) E(b, m, n, accm[i][j][rr]);
                }
    }
}
template <class AF, class BF, class EF>
__device__ __forceinline__ void gemm_phase(unsigned char* lds, const AF& A, const BF& B, const EF& E, int nbatch, int M, int N, int K) {
    PH_IDS; const int tid = tid_, half = tid >> 8, ht = tid & 255;
    bf16_t (*sA)[40] = (bf16_t (*)[40])(lds + half * 10240);
    bf16_t (*sB)[40] = (bf16_t (*)[40])(lds + half * 10240 + 5120);
    const int tm = (M + 63) >> 6, tn = (N + 63) >> 6, total = nbatch * tm * tn;
    for (int it0 = bid_ * 2; it0 < total; it0 += G_ * 2) {
        const int it = it0 + half; const bool valid = it < total;
        const int itc = valid ? it : 0;
        const int b = itc / (tm * tn), r = itc % (tm * tn), m0 = (r / tn) * 64, n0 = (r % tn) * 64;
        gemm_tile(A, B, E, valid, b, m0, n0, M, N, K, sA, sB, ht);
    }
    __syncthreads();
}
template <class T> static T zeroed() { T t; memset((void*)&t, 0, sizeof(T)); return t; }

struct A_bf16 { const bf16_t* p; long long ld; long long coff;
    __device__ float operator()(int, int m, int k) const { return bf2f(p[(size_t)m * ld + coff + k]); } };
struct A_bf16_scaled { const bf16_t* p; long long ld; long long coff; const float* rs; long long rsi; const float* w;
    __device__ float operator()(int, int m, int k) const { return bf2f(p[(size_t)m * ld + coff + k]) * rs[(size_t)m * 2 + rsi] * w[k]; } };
struct B_f32 { const float* p; long long ld; long long coff;
    __device__ float operator()(int, int k, int n) const { return p[(size_t)k * ld + coff + n]; } };
struct E_bf16 { bf16_t* p; long long ld; long long coff;
    __device__ void operator()(int, int m, int n, float v) const { p[(size_t)m * ld + coff + n] = f2bf(v); } };

#define XB_TMO      128
#define XB_XCNT(j)  (256  + 64 * (j))
#define XB_XSUB(j)  (1280 + 64 * (j))
#define XB_XGEN(j)  (2304 + 64 * (j))
#define XB_TOP      3328
#define XB_TOPGEN   3392
#define XCD_BAR_WORDS 3456
#define XB_SPIN_CAP (1u << 18)
__device__ __forceinline__ unsigned xb_ld(unsigned* p)              { return __hip_atomic_load(p, __ATOMIC_RELAXED, __HIP_MEMORY_SCOPE_AGENT); }
__device__ __forceinline__ unsigned xb_add(unsigned* p, unsigned v) { return __hip_atomic_fetch_add(p, v, __ATOMIC_RELAXED, __HIP_MEMORY_SCOPE_AGENT); }
__device__ __forceinline__ unsigned xb_xcc_id() { return (unsigned)__builtin_amdgcn_s_getreg((3 << 11) | 20) & 0xFu; }
#define XB_SPIN(cond, bar) do { unsigned _sp = 0; while (cond) { __builtin_amdgcn_s_sleep(1); \
    if ((++_sp & 255u) == 0u) { if (xb_ld(&(bar)[XB_TMO])) break; if (_sp > XB_SPIN_CAP) { atomicAdd(&(bar)[XB_TMO], 1u); break; } } } } while (0)
struct XcdBarrier { unsigned* bar; unsigned x; volatile LAS unsigned* st; };
__device__ __forceinline__ XcdBarrier xcd_barrier_post(unsigned* bar, volatile LAS unsigned* st) {
    XcdBarrier b; b.bar = bar; b.x = xb_xcc_id(); b.st = st;
    if (threadIdx.x == 0) (void)xb_add(&bar[XB_XCNT(b.x)], 1u);
    return b;
}
__device__ __forceinline__ void xcd_barrier_complete(unsigned* bar, unsigned x, unsigned& nloc, unsigned& nx) {
    const unsigned G = gridDim.x * gridDim.y * gridDim.z;
    unsigned sum, cnt, mine, sp = 0u;
    for (;;) {
        sum = 0u; cnt = 0u; mine = 0u;
#pragma unroll
        for (unsigned j = 0; j < 16; ++j) { const unsigned c = xb_ld(&bar[XB_XCNT(j)]); sum += c; cnt += (c > 0u) ? 1u : 0u; mine = (j == x) ? c : mine; }
        if (sum == G) break;
        __builtin_amdgcn_s_sleep(1);
        if ((++sp & 255u) == 0u) { if (xb_ld(&bar[XB_TMO])) break; if (sp > XB_SPIN_CAP) { atomicAdd(&bar[XB_TMO], 1u); break; } }
    }
    nloc = mine > 0u ? mine : 1u; nx = cnt > 0u ? cnt : 1u;
}
__device__ __forceinline__ void xcd_barrier(const XcdBarrier& b) {
    asm volatile("s_waitcnt vmcnt(0)" ::: "memory");
    __syncthreads();
    if (threadIdx.x == 0) {
        unsigned* bar = b.bar;
        __builtin_amdgcn_s_waitcnt(0);
        unsigned nloc = b.st[0], nx = b.st[1];
        if (nloc == 0u) { xcd_barrier_complete(bar, b.x, nloc, nx); b.st[0] = nloc; b.st[1] = nx; }
        const unsigned old = xb_add(&bar[XB_XSUB(b.x)], 1u);
        const unsigned gen = old / nloc;
        if (old + 1u == (gen + 1u) * nloc) {
            __builtin_amdgcn_fence(__ATOMIC_RELEASE, "agent");
            asm volatile("s_waitcnt vmcnt(0)" ::: "memory");
            const unsigned og = xb_add(&bar[XB_TOP], 1u);
            const unsigned tg = og / nx;
            if (og + 1u == (tg + 1u) * nx) xb_add(&bar[XB_TOPGEN], 1u);
            else XB_SPIN(xb_ld(&bar[XB_TOPGEN]) == tg, bar);
            __builtin_amdgcn_fence(__ATOMIC_ACQUIRE, "agent");
            xb_add(&bar[XB_XGEN(b.x)], 1u);
            asm volatile("s_waitcnt vmcnt(0)" ::: "memory");
        } else {
            XB_SPIN(xb_ld(&bar[XB_XGEN(b.x)]) == gen, bar);
            __builtin_amdgcn_fence(__ATOMIC_ACQUIRE, "agent");
            asm volatile("s_waitcnt vmcnt(0)" ::: "memory");
        }
    }
    __syncthreads();
}

__device__ __forceinline__ void dep_signal_x(unsigned* ctr, unsigned* sub, unsigned nloc) {
    asm volatile("s_waitcnt vmcnt(0)" ::: "memory");
    __syncthreads();
    if (threadIdx.x == 0) { const unsigned old = xb_add(sub, 1u);
        if (old + 1u == nloc) { __builtin_amdgcn_fence(__ATOMIC_RELEASE, "agent"); asm volatile("s_waitcnt vmcnt(0)" ::: "memory"); (void)xb_add(ctr, nloc); } }
}
__device__ __forceinline__ void dep_spin(unsigned* ctr, unsigned need, unsigned* bar) {
    XB_SPIN(xb_ld(ctr) < need, bar);
    __builtin_amdgcn_fence(__ATOMIC_ACQUIRE, "agent");
    asm volatile("s_waitcnt vmcnt(0)" ::: "memory");
}
namespace pg8 {
typedef unsigned u32x4 __attribute__((ext_vector_type(4)));
constexpr int BM = 256, BK = 64, HALF = 128, HTB = HALF * BK * 2, STAGE_BYTES = 8 * HTB, NXCD = 8, WGM = 8;
__device__ __forceinline__ int lds_byte(int r, int c) { const int st = (r >> 4) * 2 + (c >> 5), rr = r & 15, cc = c & 31, ob = rr * 64 + cc * 2; return st * 1024 + (ob ^ (((ob >> 9) & 1) << 5)); }
__device__ __forceinline__ void stage_rc(int b, int& R, int& C) { const int st = b / 1024, sb = b % 1024, swz = sb ^ (((sb >> 9) & 1) << 5); R = (st >> 1) * 16 + swz / 64; C = (st & 1) * 32 + (swz % 64) / 2; }
__device__ __forceinline__ int perm32(int rho) { const int n = rho >> 4, i = rho & 15; return 8 * (i >> 2) + 4 * n + (i & 3); }
struct Unit { const char* A; const char* B; unsigned lda, ldb; int nt, pm, pn, kind, aux; };
__device__ __forceinline__ unsigned cvt_pk_bf16(float lo, float hi) { unsigned r; asm volatile("v_cvt_pk_bf16_f32 %0, %1, %2" : "=v"(r) : "v"(lo), "v"(hi)); return r; }
__device__ __forceinline__ bool static_tile(int nM, int nN, int G, int c, int i, int& pm, int& pn) {
    const int nwg = nM * nN; const long L = (long)i * G + c; if (L >= nwg) return false;
    int wgid = (int)L; { const int q = nwg / NXCD, r = nwg % NXCD, xcd = wgid % NXCD, off = wgid / NXCD; wgid = (xcd < r ? xcd * (q + 1) : r * (q + 1) + (xcd - r) * q) + off; }
    const int nig = WGM * nN, gid = wgid / nig, fm = gid * WGM, gsz = (nM - fm) < WGM ? (nM - fm) : WGM;
    pm = fm + ((wgid % nig) % gsz); pn = (wgid % nig) / gsz; return true;
}
template <class Epi, class Sched>
__device__ __forceinline__ void gemm_phase(LAS unsigned char* lds, const Sched& S, const Epi& E) {
    const int tid = l_tid(), wid = __builtin_amdgcn_readfirstlane(tid >> 6), lane = tid & 63, wr = wid >> 2, wc = wid & 3, fr = lane & 15, fq = lane >> 4;
    int sR0, sC20;
    { int R, C; stage_rc(tid * 16, R, C); sR0 = R; sC20 = C * 2; }
#define PG8_R(i) (sR0 + 64 * (i))
#define PG8_RB(i) ((PG8_R(i) & ~31) + perm32(PG8_R(i) & 31))
    const size_t kstep = (size_t)(BK * 2);
    const unsigned ldsw = (unsigned)wid * 1024u;
    const int aoff = lds_byte(wr * 64 + fr, fq * 8), boff = lds_byte(wc * 32 + fr, fq * 8);
#define PG8_SA(b, h) (((b) * 2 + (h)) * HTB)
#define PG8_SB(b, h) ((4 + (b) * 2 + (h)) * HTB)
#define PG8_STAGE_A(bufoff, gbase, ld) do { \
        __builtin_amdgcn_global_load_lds((const unsigned*)((const char*)(gbase) + (unsigned)(PG8_R(0) * (ld) + sC20)), (LAS unsigned*)(lds + (bufoff) + ldsw), 16, 0, 0); \
        __builtin_amdgcn_global_load_lds((const unsigned*)((const char*)(gbase) + (unsigned)(PG8_R(1) * (ld) + sC20)), (LAS unsigned*)(lds + (bufoff) + ldsw + 8192), 16, 0, 0); } while (0)
#define PG8_STAGE_B(bufoff, gbase, ld) do { \
        __builtin_amdgcn_global_load_lds((const unsigned*)((const char*)(gbase) + (unsigned)(PG8_RB(0) * (ld) + sC20)), (LAS unsigned*)(lds + (bufoff) + ldsw), 16, 0, 0); \
        __builtin_amdgcn_global_load_lds((const unsigned*)((const char*)(gbase) + (unsigned)(PG8_RB(1) * (ld) + sC20)), (LAS unsigned*)(lds + (bufoff) + ldsw + 8192), 16, 0, 0); } while (0)
#define PG8_LDA(dst, b, h) do { _Pragma("unroll") for (int m = 0; m < 4; ++m) _Pragma("unroll") for (int k = 0; k < 2; ++k) dst[m][k] = *(const LAS bf16x8*)(lds + PG8_SA(b, h) + aoff + m * 2048 + k * 1024); } while (0)
#define PG8_LDB(dst, b, h) do { _Pragma("unroll") for (int n = 0; n < 2; ++n) _Pragma("unroll") for (int k = 0; k < 2; ++k) dst[n][k] = *(const LAS bf16x8*)(lds + PG8_SB(b, h) + boff + n * 2048 + k * 1024); } while (0)
#define PG8_MMA(ai, bj, At, Bt) do { __builtin_amdgcn_s_setprio(1); _Pragma("unroll") for (int m = 0; m < 4; ++m) _Pragma("unroll") for (int n = 0; n < 2; ++n) _Pragma("unroll") for (int k = 0; k < 2; ++k) \
        acc[ai][bj][m][n] = __builtin_amdgcn_mfma_f32_16x16x32_bf16(Bt[n][k], At[m][k], acc[ai][bj][m][n], 0, 0, 0); __builtin_amdgcn_s_setprio(0); } while (0)
#define PG8_WAIT_V(n) asm volatile("s_waitcnt vmcnt(" #n ")" ::: "memory")
#define PG8_WAIT_L(n) asm volatile("s_waitcnt lgkmcnt(" #n ")" ::: "memory")
#define PG8_BAR __builtin_amdgcn_s_barrier()
#define PG8_SCHED __builtin_amdgcn_sched_barrier(0)
    Unit cur, nxt; int ui = 0;
    if (!S.next(0, cur)) return;
    f32x4 prev_;
    if constexpr (Epi::PRE) { E.pre_issue(cur, tid, prev_); E.pre_commit(tid, 0, prev_); }
    f32x4 acc[2][2][4][2];
#pragma unroll
    for (int a = 0; a < 2; ++a)
#pragma unroll
        for (int b = 0; b < 2; ++b)
#pragma unroll
            for (int m = 0; m < 4; ++m)
#pragma unroll
                for (int n = 0; n < 2; ++n) acc[a][b][m][n] = (f32x4){0.f, 0.f, 0.f, 0.f};
    bf16x8 At[4][2], B0[2][2], B1[2][2];
    const char* cA = cur.A; const char* cB = cur.B;
    int clda = cur.lda, cldb = cur.ldb;
    PG8_STAGE_B(PG8_SB(0, 0), cB, cldb); PG8_STAGE_B(PG8_SB(0, 1), cB + (size_t)HALF * cldb, cldb); PG8_STAGE_A(PG8_SA(0, 0), cA, clda); PG8_STAGE_A(PG8_SA(0, 1), cA + (size_t)HALF * clda, clda);
    if (wr == 1) PG8_BAR;
    PG8_WAIT_V(2); PG8_BAR;
    PG8_STAGE_B(PG8_SB(1, 0), cB + kstep, cldb); PG8_STAGE_A(PG8_SA(1, 0), cA + kstep, clda); PG8_STAGE_B(PG8_SB(1, 1), cB + (size_t)HALF * cldb + kstep, cldb);
    PG8_WAIT_V(6); PG8_BAR;
    for (;;) {
        const bool has_next = S.next(ui + 1, nxt);
        const char* nA = has_next ? nxt.A : cA; const char* nB = has_next ? nxt.B : cB;
        const int nlda = has_next ? (int)nxt.lda : clda, nldb = has_next ? (int)nxt.ldb : cldb;
        const int nt = cur.nt;
        for (int t = 0; t < nt; t += 2) {
            const bool last = (t == nt - 2);
            const char* a1 = cA + (size_t)(t + 1) * kstep;
            const char* a2 = last ? nA : cA + (size_t)(t + 2) * kstep; const char* b2 = last ? nB : cB + (size_t)(t + 2) * kstep;
            const char* a3 = a2 + kstep; const char* b3 = b2 + kstep;
            const int lda2 = last ? nlda : clda, ldb2 = last ? nldb : cldb;
            PG8_LDB(B0, 0, 0); PG8_LDB(B1, 0, 1); PG8_SCHED; PG8_LDA(At, 0, 0); PG8_STAGE_A(PG8_SA(1, 1), a1 + (size_t)HALF * clda, clda);
            PG8_WAIT_V(8); PG8_WAIT_L(0); PG8_BAR; PG8_MMA(0, 0, At, B0); PG8_MMA(0, 1, At, B1); PG8_BAR; PG8_SCHED;
            PG8_LDA(At, 0, 1); PG8_STAGE_B(PG8_SB(0, 0), b2, ldb2); PG8_STAGE_B(PG8_SB(0, 1), b2 + (size_t)HALF * ldb2, ldb2); PG8_STAGE_A(PG8_SA(0, 0), a2, lda2);
            PG8_WAIT_V(8); PG8_WAIT_L(0); PG8_BAR; PG8_MMA(1, 0, At, B0); PG8_MMA(1, 1, At, B1); PG8_BAR; PG8_SCHED;
            PG8_LDB(B0, 1, 0); PG8_LDB(B1, 1, 1); PG8_SCHED; PG8_LDA(At, 1, 0); PG8_STAGE_A(PG8_SA(0, 1), a2 + (size_t)HALF * lda2, lda2);
            PG8_WAIT_V(8); PG8_WAIT_L(0); PG8_BAR; PG8_MMA(0, 0, At, B0); PG8_MMA(0, 1, At, B1); PG8_BAR; PG8_SCHED;
            PG8_LDA(At, 1, 1); PG8_STAGE_B(PG8_SB(1, 0), b3, ldb2); PG8_STAGE_B(PG8_SB(1, 1), b3 + (size_t)HALF * ldb2, ldb2); PG8_STAGE_A(PG8_SA(1, 0), a3, lda2);
            PG8_WAIT_V(8); PG8_WAIT_L(0); PG8_BAR; PG8_MMA(1, 0, At, B0); PG8_MMA(1, 1, At, B1); PG8_BAR; PG8_SCHED;
        }
        if (wr == 0) PG8_BAR;
        if constexpr (Epi::PRE) { if (has_next) E.pre_issue(nxt, tid, prev_); E(acc, cur, wr, wc, fr, fq, ui & 1); if (has_next) E.pre_commit(tid, (ui + 1) & 1, prev_); }
        else E(acc, cur, wr, wc, fr, fq);
        if (!has_next) break;
#pragma unroll
        for (int a = 0; a < 2; ++a)
#pragma unroll
            for (int b = 0; b < 2; ++b)
#pragma unroll
                for (int m = 0; m < 4; ++m)
#pragma unroll
                    for (int n = 0; n < 2; ++n) acc[a][b][m][n] = (f32x4){0.f, 0.f, 0.f, 0.f};
        cur = nxt; cA = nA; cB = nB; clda = nlda; cldb = nldb; ++ui;
        if (wr == 1) PG8_BAR;
    }
    PG8_WAIT_V(0);
    PG8_BAR;
#undef PG8_SA
#undef PG8_SB
#undef PG8_STAGE_A
#undef PG8_RB
#undef PG8_R
#undef PG8_STAGE_B
#undef PG8_LDA
#undef PG8_LDB
#undef PG8_MMA
#undef PG8_WAIT_V
#undef PG8_WAIT_L
#undef PG8_BAR
#undef PG8_SCHED
}
}

__device__ __forceinline__ pg8::u32x4 pack8(const f32x4 a, const f32x4 b) { pg8::u32x4 w; w.x = pg8::cvt_pk_bf16(a[0], a[1]); w.y = pg8::cvt_pk_bf16(a[2], a[3]); w.z = pg8::cvt_pk_bf16(b[0], b[1]); w.w = pg8::cvt_pk_bf16(b[2], b[3]); return w; }
__device__ __forceinline__ void unpack8(const pg8::u32x4 w, f32x4& a, f32x4& b) {
    a[0] = __uint_as_float(w.x << 16); a[1] = __uint_as_float(w.x & 0xffff0000u); a[2] = __uint_as_float(w.y << 16); a[3] = __uint_as_float(w.y & 0xffff0000u);
    b[0] = __uint_as_float(w.z << 16); b[1] = __uint_as_float(w.z & 0xffff0000u); b[2] = __uint_as_float(w.w << 16); b[3] = __uint_as_float(w.w & 0xffff0000u); }
namespace fa {
typedef float f32x16 __attribute__((ext_vector_type(16)));
typedef short s16x4 __attribute__((ext_vector_type(4)));
typedef unsigned u32x4 __attribute__((ext_vector_type(4)));
typedef unsigned u32x2 __attribute__((ext_vector_type(2)));
__device__ __forceinline__ s16x4 vtr(const LAS char* p) { return __builtin_bit_cast(s16x4, __builtin_amdgcn_ds_read_tr16_b64_v4i16((LAS s16x4*)p)); }
__device__ __forceinline__ unsigned pk2(float lo, float hi) { unsigned r; asm volatile("v_cvt_pk_bf16_f32 %0, %1, %2" : "=v"(r) : "v"(lo), "v"(hi)); return r; }
typedef __bf16 bf16v2_t __attribute__((ext_vector_type(2)));
typedef float f32v2_t __attribute__((ext_vector_type(2)));
__device__ __forceinline__ unsigned pk2n(float lo, float hi) { return __builtin_bit_cast(unsigned, __builtin_convertvector((f32v2_t){lo, hi}, bf16v2_t)); }
__device__ __forceinline__ bf16x8 pack_p(const f32x16& p, int base) { u32x4 w; w.x = pk2(p[base], p[base + 1]); w.y = pk2(p[base + 2], p[base + 3]); w.z = pk2(p[base + 4], p[base + 5]); w.w = pk2(p[base + 6], p[base + 7]); return __builtin_bit_cast(bf16x8, w); }
__device__ __forceinline__ int crow(int r, int hi) { return (r & 3) + 8 * (r >> 2) + 4 * hi; }
__device__ __forceinline__ void pv_tile(f32x16& o0, f32x16& o1, const LAS char* vb, const bf16x8 (&pf)[4]) {
#pragma unroll
    for (int ks = 0; ks < 4; ++ks) {
        const s16x4 a0 = vtr(vb + ks * 1024), a1 = vtr(vb + ks * 1024 + 512), b0 = vtr(vb + 4096 + ks * 1024), b1 = vtr(vb + 4096 + ks * 1024 + 512);
        const bf16x8 v0 = (bf16x8){a0[0], a0[1], a0[2], a0[3], a1[0], a1[1], a1[2], a1[3]}, v1 = (bf16x8){b0[0], b0[1], b0[2], b0[3], b1[0], b1[1], b1[2], b1[3]};
        o0 = __builtin_amdgcn_mfma_f32_32x32x16_bf16(v0, pf[ks], o0, 0, 0, 0);
        o1 = __builtin_amdgcn_mfma_f32_32x32x16_bf16(v1, pf[ks], o1, 0, 0, 0);
    }
}
constexpr int KP_A = 208, KT_A = 64 * KP_A, VT = 8192, BUF_A = KT_A + VT;
constexpr int KP_R = 144, KT_R = 64 * KP_R, BUF_R = KT_R + VT;
}

#define GSTRIDE(gi, total) for (int gi = bid_ * NT + tid_; gi < (total); gi += G_ * NT)
__device__ __forceinline__ void ph_mod(unsigned char* lds, const float* c, const float* c_ctx, const float* ada_w, const float* ada_b, float* mod) { PH_IDS;
    LAS float* sl = (LAS float*)lds;
    LAS float* red = sl + 9 * 1024;
    for (int e = tid_; e < 9 * 1024; e += NT) { const int j = e >> 10, k = e & 1023; const float v = j < 8 ? c[j * 1024 + k] : c_ctx[k]; sl[e] = siluf_(v); }
    __syncthreads();
    const int nn = tid_ & 63, ks = tid_ >> 6;
    for (int u = bid_; u < 2 * 96; u += G_) {
        const int l = u / 96, n = (u % 96) * 64 + nn;
        float acc[9];
#pragma unroll
        for (int j = 0; j < 9; ++j) acc[j] = 0.f;
        const float* w = ada_w + ((size_t)l * 1024 + ks * 128) * 6144 + n;
#pragma unroll 4
        for (int k4 = 0; k4 < 32; ++k4) {
            const float w0 = w[(size_t)(4 * k4) * 6144], w1 = w[(size_t)(4 * k4 + 1) * 6144], w2 = w[(size_t)(4 * k4 + 2) * 6144], w3 = w[(size_t)(4 * k4 + 3) * 6144];
#pragma unroll
            for (int j = 0; j < 9; ++j) { const f32x4 s4 = *(const LAS f32x4*)(sl + j * 1024 + ks * 128 + 4 * k4); acc[j] += s4[0] * w0 + s4[1] * w1 + s4[2] * w2 + s4[3] * w3; } }
        __syncthreads();
#pragma unroll
        for (int j = 0; j < 9; ++j) red[(ks * 9 + j) * 64 + nn] = acc[j];
        __syncthreads();
        for (int e = tid_; e < 9 * 64; e += NT) { const int j = e >> 6, q = e & 63; float sum = 0.f;
#pragma unroll
            for (int r = 0; r < 8; ++r) sum += red[(r * 9 + j) * 64 + q];
            const int col = (u % 96) * 64 + q; mod[((size_t)l * 9 + j) * 6144 + col] = sum + ada_b[l * 6144 + col]; }
    }
    __syncthreads();
}
__device__ __forceinline__ void ph_trig(float* trig, bf16_t* d64) { PH_IDS; GSTRIDE(i, 2048) { const float xx = (float)i * (1.f / 1024.f); trig[i] = cospif(xx); trig[2048 + i] = sinpif(xx); }
    GSTRIDE(i, 128 * 64) { const int n = i >> 6, c = i & 63, m = n & 63; const float xx = (float)((m * c) & 63) * (1.f / 32.f); d64[i] = f2bf(n < 64 ? cospif(xx) : sinpif(xx)); } }
__device__ __forceinline__ double2 lam_pow(double re, double im, double dt, int k) {
    const double m = (double)__expf((float)(re * dt * k));
    double xx = im * dt * (double)k * 0.318309886183790671538;
    xx -= 2.0 * rint(xx * 0.5);
    const float xf = (float)xx;
    return make_double2(m * (double)cospif(xf), m * (double)sinpif(xf));
}
__device__ __forceinline__ void ph_s5_lp(int l, const float* lam_re, const float* lam_im, const float* log_step, const float* b_re, const float* b_im, float2* LP, float2* BB, float* lamT) { PH_IDS;
    GSTRIDE(it, 2 * 16 * 64 * 81) {
        const int i = it / 81, k = it % 81;
        const int d = i / 1024, g = (i / 64) % 16, p = i % 64;
        const size_t li = ((size_t)(l * 2 + d) * 16 + g) * 64 + p;
        const double re = lam_re[li], im = lam_im[li], dt = (double)expf(log_step[(l * 2 + d) * 16 + g]);
        if (k <= 64) {
            const double2 v = lam_pow(re, im, dt, k); LP[(size_t)i * 65 + k] = make_float2((float)v.x, (float)v.y);
            if (k == 64) { lamT[((size_t)(g * 2 + d) * 64 + p) * 2 + 0] = (float)v.x; lamT[((size_t)(g * 2 + d) * 64 + p) * 2 + 1] = (float)v.y; }
        } else {
            const int h = k - 65;
            const double2 l1 = lam_pow(re, im, dt, 1);
            const double nr = l1.x - 1.0, ni = l1.y, den = re * re + im * im;
            const double fr = (nr * re + ni * im) / den, fi = (ni * re - nr * im) / den;
            const double br = b_re[li * 16 + h], bi = b_im[li * 16 + h]; BB[(size_t)i * 16 + h] = make_float2((float)(fr * br - fi * bi), (float)(fr * bi + fi * br));
        }
    }
}
__device__ __forceinline__ void ph_s5_tz(unsigned char* lds_, int l, const float2* LP, const float2* BB, const float* c_re, const float* c_im, float* TZD, int vb, int vg) { PH_IDS;
    typedef float f32x2_ __attribute__((ext_vector_type(2)));
    LAS f32x2_* sC = (LAS f32x2_*)lds_;
    LAS f32x2_* sL = sC + 16 * 64;
    LAS f32x2_* sB = sL + 64 * 8;
    for (int it = vb; it < 256; it += vg) {
        const int u = it >> 3, ts = it & 7, g = u >> 1, d = u & 1;
        const size_t cb = (((size_t)(l * 2 + d) * 16 + g) * 16) * 64, gb = (size_t)d * 16 + g;
        const float cr0 = c_re[cb + tid_], ci0 = c_im[cb + tid_], cr1 = c_re[cb + NT + tid_], ci1 = c_im[cb + NT + tid_];
        const float2 lpv = LP[gb * 64 * 65 + (size_t)(tid_ >> 3) * 65 + ts * 8 + (tid_ & 7)];
        const float2 bb0 = BB[gb * 64 * 16 + tid_], bb1 = BB[gb * 64 * 16 + NT + tid_];
        __syncthreads();
        sC[tid_] = (f32x2_){cr0, ci0}; sC[NT + tid_] = (f32x2_){cr1, ci1}; sL[tid_] = (f32x2_){lpv.x, lpv.y}; sB[tid_] = (f32x2_){bb0.x, bb0.y}; sB[NT + tid_] = (f32x2_){bb1.x, bb1.y};
        __syncthreads();
        const int pair = tid_ & 127, tl = pair >> 4, h = pair & 15, qg = tid_ >> 7;
        f32x4 acc = (f32x4){0.f, 0.f, 0.f, 0.f};
#pragma unroll 4
        for (int p = 0; p < 64; ++p) {
            const f32x2_ c = sC[h * 64 + p], lp = sL[p * 8 + tl];
            const float er = c.x * lp.x - c.y * lp.y, ei = c.x * lp.y + c.y * lp.x;
            const f32x4 b01 = *(const LAS f32x4*)&sB[p * 16 + 4 * qg], b23 = *(const LAS f32x4*)&sB[p * 16 + 4 * qg + 2];
            acc[0] += er * b01[0] - ei * b01[1]; acc[1] += er * b01[2] - ei * b01[3]; acc[2] += er * b23[0] - ei * b23[1]; acc[3] += er * b23[2] - ei * b23[3];
        }
        *(f32x4*)(TZD + (((gb * 64) + ts * 8 + tl) * 16 + h) * 16 + 4 * qg) = acc;
    }
    __syncthreads();
}
__device__ __forceinline__ void ph_s5_ms(const float2* LP, const float2* BB, bf16_t* MST, int vb, int vg) { PH_IDS;
    for (int i = vb * NT + tid_; i < 16 * 256 * 128; i += vg * NT) {
        const int g = i / (256 * 128), n = (i / 128) % 256, sh0 = (i % 128) * 8, d = n >> 7, p = n & 63, im = (n >> 6) & 1, s = sh0 >> 4, hp0 = sh0 & 15;
        const size_t gi = ((size_t)d * 16 + g) * 64 + p;
        const float2 lp = LP[gi * 65 + (d == 0 ? 63 - s : s)];
        float v[8];
#pragma unroll
        for (int q = 0; q < 8; ++q) { const float2 bb = BB[gi * 16 + hp0 + q]; v[q] = im ? lp.x * bb.y + lp.y * bb.x : lp.x * bb.x - lp.y * bb.y; }
        *(pg8::u32x4*)(MST + ((size_t)g * 256 + n) * 1024 + sh0) = pack8((f32x4){v[0], v[1], v[2], v[3]}, (f32x4){v[4], v[5], v[6], v[7]});
    }
}
__device__ __forceinline__ void ph_s5_qo(int l, const float2* LP, const float* c_re, const float* c_im, bf16_t* QOT, int vb, int vg) { PH_IDS;
    for (int i = vb * NT + tid_; i < 16 * 1024 * 32; i += vg * NT) {
        const int g = i / (1024 * 32), th = (i / 32) % 1024, j0 = (i % 32) * 8, d = j0 >> 7, im = (j0 >> 6) & 1, p0 = j0 & 63, t = th >> 4, h = th & 15;
        const size_t ci = (((size_t)(l * 2 + d) * 16 + g) * 16 + h) * 64 + p0;
        const int e = d == 0 ? t + 1 : 64 - t;
        float v[8];
#pragma unroll
        for (int q = 0; q < 8; ++q) { const float cr = c_re[ci + q], cim = c_im[ci + q]; const float2 lp = LP[(((size_t)d * 16 + g) * 64 + p0 + q) * 65 + e]; v[q] = im ? -(cr * lp.y + cim * lp.x) : cr * lp.x - cim * lp.y; }
        *(pg8::u32x4*)(QOT + ((size_t)g * 1024 + th) * 256 + j0) = pack8((f32x4){v[0], v[1], v[2], v[3]}, (f32x4){v[4], v[5], v[6], v[7]});
    }
}
__device__ __forceinline__ void ph_wmf(const float* w, const float* mod, float* wmf) { PH_IDS;
    GSTRIDE(i, 9 * 1024) { const int b = i >> 10, c = i & 1023; wmf[i] = w[c] * (1.f + mod[(size_t)b * 6144 + 4 * 1024 + c]); }
}
__device__ __forceinline__ void ph_cf_mfma(unsigned char* lds_, const bf16_t* W1T, const float* mod, float* cf, int vb, int vg) {
    const int tid = l_tid(), lane = tid & 63, kk = __builtin_amdgcn_readfirstlane(tid >> 6), i16 = lane & 15, kq = lane >> 4;
    LAS float* red = (LAS float*)lds_;
    for (int nt = vb; nt < 256; nt += vg) {
        f32x4 acc = (f32x4){0.f, 0.f, 0.f, 0.f};
#pragma unroll
        for (int s4 = 0; s4 < 4; ++s4) { const int k0 = kk * 128 + s4 * 32 + kq * 8;
            pg8::u32x4 aw = (pg8::u32x4){0u, 0u, 0u, 0u};
            if (i16 < 9) { const float* sp = mod + (size_t)i16 * 6144 + 3 * 1024 + k0; aw = pack8(*(const f32x4*)sp, *(const f32x4*)(sp + 4)); }
            const bf16x8 bw = *(const bf16x8*)(W1T + (size_t)(nt * 16 + i16) * 1024 + k0);
            acc = __builtin_amdgcn_mfma_f32_16x16x32_bf16(__builtin_bit_cast(bf16x8, aw), bw, acc, 0, 0, 0); }
        __syncthreads();
#pragma unroll
        for (int r = 0; r < 4; ++r) red[(kk * 16 + 4 * kq + r) * 16 + i16] = acc[r];
        __syncthreads();
        if (tid < 144) { float a = 0.f;
#pragma unroll
            for (int w = 0; w < 8; ++w) a += red[w * 256 + tid];
            cf[(size_t)(tid >> 4) * DFF + nt * 16 + (tid & 15)] = a; }
    }
    __syncthreads();
}
template <int XIN>
__device__ __forceinline__ void ph_adarms(const void* xlat, const void* xctx, const float* w, const float* mod, int sh_chunk, int sc_chunk, bf16_t* out, int nrows) { PH_IDS;
    const int wave = (bid_ * NT + tid_) >> 6, lane = tid_ & 63, nw = (G_ * NT) >> 6;
    f32x4 wv[4];
#pragma unroll
    for (int j = 0; j < 4; ++j) wv[j] = *(const f32x4*)(w + j * 256 + lane * 4);
    for (int row0 = wave; row0 < nrows; row0 += 3 * nw) {
        f32x4 v[3][4], sc[3][4], sh[3][4];
#pragma unroll
        for (int k = 0; k < 3; ++k) { const int row = row0 + k * nw;
            if (row < nrows) {
                if constexpr (XIN == 0) { const float* x = row < RL ? (const float*)xlat + (size_t)row * DM : (const float*)xctx + (size_t)(row - RL) * DM;
#pragma unroll
                    for (int j = 0; j < 4; ++j) v[k][j] = *(const f32x4*)(x + j * 256 + lane * 4); }
                else { const bf16_t* x = row < RL ? (const bf16_t*)xlat + (size_t)row * DM : (const bf16_t*)xctx + (size_t)(row - RL) * DM;
#pragma unroll
                    for (int j = 0; j < 4; ++j) { const fa::u32x2 r = *(const fa::u32x2*)(x + j * 256 + lane * 4); v[k][j] = (f32x4){__uint_as_float(r.x << 16), __uint_as_float(r.x & 0xffff0000u), __uint_as_float(r.y << 16), __uint_as_float(r.y & 0xffff0000u)}; } }
                const float* mrow = mod + (size_t)row_modidx(row) * 6144;
#pragma unroll
                for (int j = 0; j < 4; ++j) { const int c0 = j * 256 + lane * 4; sc[k][j] = *(const f32x4*)(mrow + sc_chunk * 1024 + c0); sh[k][j] = *(const f32x4*)(mrow + sh_chunk * 1024 + c0); }
            } }
#pragma unroll
        for (int k = 0; k < 3; ++k) { const int row = row0 + k * nw;
            if (row < nrows) {
                float ss = 0.f;
#pragma unroll
                for (int j = 0; j < 4; ++j) ss += v[k][j][0] * v[k][j][0] + v[k][j][1] * v[k][j][1] + v[k][j][2] * v[k][j][2] + v[k][j][3] * v[k][j][3];
#pragma unroll
                for (int o = 1; o < 64; o <<= 1) ss += __shfl_xor(ss, o);
                const float rstd = rsqrtf(ss * (1.f / DM) + EPS);
#pragma unroll
                for (int j = 0; j < 4; ++j) { const int c0 = j * 256 + lane * 4;
                    const f32x4 y = v[k][j] * rstd * wv[j] * (sc[k][j] + 1.f) + sh[k][j];
                    fa::u32x2 o; o.x = fa::pk2(y[0], y[1]); o.y = fa::pk2(y[2], y[3]);
                    *(fa::u32x2*)(out + (size_t)row * DM + c0) = o; }
            } }
    }
}
__device__ __forceinline__ void ph_mla_stats(const bf16_t* Z, float* rs) { PH_IDS;
    const int wave = (bid_ * NT + tid_) >> 6, lane = tid_ & 63, nw = (G_ * NT) >> 6;
    for (int row = wave; row < RT; row += nw) {
        const bf16_t* z = Z + (size_t)row * ZW; float sq = 0.f, sk = 0.f;
#pragma unroll
        for (int j = 0; j < 4; ++j) { const float v = bf2f(z[C_QC + j * 64 + lane]); sq += v * v; }
#pragma unroll
        for (int j = 0; j < 2; ++j) { const float v = bf2f(z[C_KVC + j * 64 + lane]); sk += v * v; }
#pragma unroll
        for (int o = 1; o < 64; o <<= 1) { sq += __shfl_xor(sq, o); sk += __shfl_xor(sk, o); }
        if (lane == 0) { rs[(size_t)row * 2] = rsqrtf(sq * (1.f / 256) + EPS); rs[(size_t)row * 2 + 1] = rsqrtf(sk * (1.f / 128) + EPS); }
    }
}
__device__ __forceinline__ void ph_mla_post(const bf16_t* Z, const bf16_t* qraw, const bf16_t* kvraw, const float* qkq, const float* qkk, bf16_t* Q, bf16_t* Kb, bf16_t* Vb) { PH_IDS;
    GSTRIDE(gi, RT * 8) {
        const int row = gi >> 3, h = (gi >> 1) & 3, isk = gi & 1;
        const bool lat = row < RL; const int b = row_batch(row), t = lat ? (row & 2047) : ((row - RL) & 255);
        const int qi = lat ? t : 2048 + t, ki = lat ? 256 + t : t;
        float v[96];
        float ss = 0.f;
        if (!isk) {
#pragma unroll
            for (int i = 0; i < 96; ++i) v[i] = bf2f(qraw[(size_t)row * 384 + h * 96 + i]);
        } else {
#pragma unroll
            for (int i = 0; i < 64; ++i) v[i] = bf2f(kvraw[(size_t)row * 512 + h * 128 + i]);
#pragma unroll
            for (int i = 0; i < 32; ++i) v[64 + i] = bf2f(Z[(size_t)row * ZW + C_KR + i]);
        }
#pragma unroll
        for (int i = 0; i < 96; ++i) ss += v[i] * v[i];
        const float rr = rsqrtf(ss * (1.f / 96) + EPS) * (isk ? 1.f : 0.14724727430627066f);
        const float* wv = isk ? qkk : qkq;
#pragma unroll
        for (int i = 0; i < 96; ++i) v[i] = v[i] * rr * wv[i];
        if (lat) {
            const float prow = (float)(t >> 6), pcol = (float)(t & 63);
#pragma unroll
            for (int part = 0; part < 2; ++part) { const float pos = part ? pcol : prow; const int base = 64 + part * 16;
#pragma unroll
                for (int j = 0; j < 8; ++j) { const float fr = exp2f(-(float)j * (13.287712379549449f / 8.f)), a = pos * fr, cs = __cosf(a), sn = __sinf(a);
                    const float x1 = v[base + j], x2 = v[base + 8 + j]; v[base + j] = x1 * cs - x2 * sn; v[base + 8 + j] = x1 * sn + x2 * cs; } }
        }
        bf16_t* o = isk ? Kb + ((size_t)(b * 4 + h) * 2304 + ki) * 96 : Q + ((size_t)(b * 4 + h) * 2304 + qi) * 96;
#pragma unroll
        for (int i = 0; i < 96; ++i) o[i] = f2bf(v[i]);
        if (isk) { bf16_t* vo = Vb + ((size_t)(b * 4 + h) * 2304 + ki) * 64; for (int i = 0; i < 64; ++i) vo[i] = kvraw[(size_t)row * 512 + h * 128 + 64 + i]; }
    }
}
__device__ __forceinline__ void ph_attn(unsigned char* lds, const bf16_t* Q, const bf16_t* Kb, const bf16_t* Vb, bf16_t* Z, int with_ctx) { PH_IDS;
    float (*sK)[96] = (float (*)[96])lds; float (*sV)[64] = (float (*)[64])(lds + 32 * 96 * 4);
    const int nunits = 32 * (8 + (with_ctx ? 1 : 0));
    const int qt = tid_ & 255, dh = (tid_ >> 8) * 32;
    for (int u = bid_; u < nunits; u += G_) {
        const int bh = u % 32, qb = u / 32;
        const bool lat = qb < 8;
        const int qi = qb * 256 + qt, nkeys = lat ? 2304 : 256;
        float q[96], o[32];
        const bf16_t* qp = Q + ((size_t)bh * 2304 + qi) * 96;
#pragma unroll
        for (int i = 0; i < 96; ++i) q[i] = bf2f(qp[i]) * 0.10206207261596577f;
#pragma unroll
        for (int i = 0; i < 32; ++i) o[i] = 0.f;
        float mx = -1e30f, l = 0.f;
        for (int k0 = 0; k0 < nkeys; k0 += 32) {
            __syncthreads();
            for (int e = tid_; e < 32 * 96; e += NT) sK[e / 96][e % 96] = bf2f(Kb[((size_t)bh * 2304 + k0) * 96 + e]);
            for (int e = tid_; e < 32 * 64; e += NT) sV[e / 64][e % 64] = bf2f(Vb[((size_t)bh * 2304 + k0) * 64 + e]);
            __syncthreads();
#pragma unroll 1
            for (int j = 0; j < 32; ++j) { float a = 0.f;
#pragma unroll
                for (int i = 0; i < 96; ++i) a += q[i] * sK[j][i];
                if (a > mx) { const float corr = __expf(mx - a); mx = a; l *= corr;
#pragma unroll
                    for (int i = 0; i < 32; ++i) o[i] *= corr; }
                const float p = __expf(a - mx); l += p;
#pragma unroll
                for (int i = 0; i < 32; ++i) o[i] += p * sV[j][dh + i]; }
        }
        const int b = bh >> 2, h = bh & 3;
        const int row = lat ? b * 2048 + qi : RL + b * 256 + (qi - 2048);
        const float inv = 1.f / l;
#pragma unroll
        for (int i = 0; i < 32; ++i) Z[(size_t)row * ZW + C_QC + h * 64 + dh + i] = f2bf(o[i] * inv);
    }
    __syncthreads();
}
__device__ __forceinline__ void ph_f1(const bf16_t* Z, const float* trig, bf16_t* F1lat, bf16_t* F1ctx) { PH_IDS;
    GSTRIDE(gi, RT * 256) {
        const int row = gi >> 8, gm = gi & 255, g = gm >> 6, m = gm & 63;
        float a = 0.f, bsum = 0.f;
        const bf16_t* u = Z + (size_t)row * ZW + C_FU + g * 64;
        for (int c = 0; c < 64; ++c) { const float v = bf2f(u[c]); const int idx = ((m * c) & 63) * 32; a += v * trig[idx]; bsum += v * trig[2048 + idx]; }
        if (row < RL) { const int b = row >> 11, t = row & 2047; bf16_t* o = F1lat + ((size_t)(b * 256 + gm) * 2) * 2048; o[t] = f2bf(a); o[2048 + t] = f2bf(bsum); }
        else { const int r = row - RL, b = r >> 8, t = r & 255; bf16_t* o = F1ctx + ((size_t)(b * 256 + gm) * 2) * 256; o[t] = f2bf(a); o[256 + t] = f2bf(bsum); }
    }
}
struct A_dft { const float* trig; long long L; long long mul;
    __device__ float operator()(int, int k, int kk) const { const int part = kk >= (int)L, t = part ? kk - (int)L : kk; const int idx = (int)(((long long)k * t) & (L - 1)) * (int)mul; return part ? -trig[2048 + idx] : trig[idx]; } };
struct B_f1t { const bf16_t* p; long long L;
    __device__ float operator()(int b, int kk, int n) const { return bf2f(p[((size_t)(b * 256 + n)) * 2 * L + kk]); } };
struct E_fourier { bf16_t* Z; long long rowbase; long long L; double scale;
    __device__ void operator()(int b, int m, int n, float v) const { Z[((size_t)rowbase + (size_t)b * L + m) * ZW + C_FU + n] = f2bf(v * (float)scale); } };

struct A_s5u { const bf16_t* Z;
    __device__ float operator()(int g, int rc, int k) const { return bf2f(Z[((size_t)rc * 64 + (k >> 4)) * ZW + C_S5 + g * 16 + (k & 15)]); } };
struct B_ms { const bf16_t* MS; __device__ float operator()(int g, int k, int n) const { return bf2f(MS[((size_t)g * 1024 + k) * 256 + n]); } };
struct E_sloc { float* S; __device__ void operator()(int g, int rc, int n, float v) const { S[((size_t)rc * 16 + g) * 256 + n] = v; } };
__device__ __forceinline__ void ph_s5_scan(const float* SLOC, const float* lamT, float* XP) { PH_IDS;
    GSTRIDE(i, 8 * 16 * 2 * 64) {
        const int b = i / 2048, g = (i / 128) % 16, d = (i / 64) % 2, p = i % 64;
        const float lr = lamT[((size_t)(g * 2 + d) * 64 + p) * 2], li = lamT[((size_t)(g * 2 + d) * 64 + p) * 2 + 1];
        float xr = 0.f, xi = 0.f;
        for (int step = 0; step < 36; ++step) {
            int rc;
            if (d == 0) rc = step < 4 ? 256 + b * 4 + step : b * 32 + (step - 4);
            else rc = step < 4 ? 256 + b * 4 + (3 - step) : b * 32 + (31 - (step - 4));
            const size_t o = ((size_t)rc * 16 + g) * 256 + d * 128;
            XP[o + p] = xr; XP[o + 64 + p] = xi;
            const float sr = SLOC[o + p], si = SLOC[o + 64 + p];
            const float nr = lr * xr - li * xi + sr, ni = lr * xi + li * xr + si; xr = nr; xi = ni;
        }
    }
}
struct A_s5out { const bf16_t* Z; const float* XP;
    __device__ float operator()(int g, int rc, int k) const { return k < 1024 ? bf2f(Z[((size_t)rc * 64 + (k >> 4)) * ZW + C_S5 + g * 16 + (k & 15)]) : XP[((size_t)rc * 16 + g) * 256 + (k - 1024)]; } };
struct B_s5out { const float* TZ; const bf16_t* QO;
    __device__ float operator()(int g, int k, int n) const { if (k < 1024) { const int s = k >> 4, hp = k & 15, t = n >> 4, h = n & 15; return TZ[(((size_t)g * 127 + (t - s + 63)) * 16 + hp) * 16 + h]; } return bf2f(QO[((size_t)g * 256 + (k - 1024)) * 1024 + n]); } };
struct E_s5out { bf16_t* YG; __device__ void operator()(int g, int rc, int n, float v) const { YG[((size_t)rc * 64 + (n >> 4)) * 256 + g * 16 + (n & 15)] = f2bf(geluf_(v)); } };
__device__ __forceinline__ void ph_glu(const bf16_t* GL, bf16_t* Z) { PH_IDS;
    GSTRIDE(gi, RT * 256) {
        const int row = gi >> 8, j = gi & 255;
        const float val = bf2f(GL[(size_t)row * 512 + j]), gate = bf2f(GL[(size_t)row * 512 + 256 + j]);
        Z[(size_t)row * ZW + C_S5 + j] = f2bf(val * sigmoidf_(gate));
    }
}
__device__ __forceinline__ void ph_ret_prep(bf16_t* Z) { PH_IDS;
    GSTRIDE(gi, RT * 4 * 32) {
        const int row = gi >> 7, h = (gi >> 5) & 3, j = gi & 31;
        bf16_t* z = Z + (size_t)row * ZW;
        if (row < RL) {
            const int t = row & 2047; const float fr = exp2f(-(float)j * (13.287712379549449f / 32.f)), a = (float)t * fr, cs = cosf(a), sn = sinf(a);
            { const float x1 = bf2f(z[C_RQ + h * 64 + j]), x2 = bf2f(z[C_RQ + h * 64 + 32 + j]); z[C_RQ + h * 64 + j] = f2bf(x1 * cs - x2 * sn); z[C_RQ + h * 64 + 32 + j] = f2bf(x1 * sn + x2 * cs); }
            { const float x1 = bf2f(z[C_RK + h * 64 + j]), x2 = bf2f(z[C_RK + h * 64 + 32 + j]); z[C_RK + h * 64 + j] = f2bf((x1 * cs - x2 * sn) * 0.125f); z[C_RK + h * 64 + 32 + j] = f2bf((x1 * sn + x2 * cs) * 0.125f); }
        } else {
            z[C_RK + h * 64 + j] = f2bf(bf2f(z[C_RK + h * 64 + j]) * 0.125f); z[C_RK + h * 64 + 32 + j] = f2bf(bf2f(z[C_RK + h * 64 + 32 + j]) * 0.125f);
        }
    }
}
__device__ __forceinline__ void ph_ret(unsigned char* lds, bf16_t* Z, const float* decay_logit, const float* gn_w, int with_ctx) { PH_IDS;
    float (*sK)[64] = (float (*)[64])lds; float (*sV)[64] = (float (*)[64])(lds + 32 * 64 * 4);
    float* sred = (float*)(lds + 2 * 32 * 64 * 4);
    const int nunits = 32 * (8 + (with_ctx ? 1 : 0));
    const int qt = tid_ & 255, hh = tid_ >> 8, dh = hh * 32;
    for (int u = bid_; u < nunits; u += G_) {
        const int bh = u % 32, qb = u / 32, b = bh >> 2, h = bh & 3;
        const bool lat = qb < 8;
        const int qpos = lat ? qb * 256 + qt : qt;
        const int qrow = lat ? b * 2048 + qpos : RL + b * 256 + qpos;
        const float lgf = -log1pf(__expf(-decay_logit[h])) * 1.4426950408889634f, lgb = -log1pf(__expf(-decay_logit[4 + h])) * 1.4426950408889634f;
        float q[64], o[32];
#pragma unroll
        for (int i = 0; i < 64; ++i) q[i] = bf2f(Z[(size_t)qrow * ZW + C_RQ + h * 64 + i]);
#pragma unroll
        for (int i = 0; i < 32; ++i) o[i] = 0.f;
        const int nkeys = lat ? 2560 : 256;
        for (int k0 = 0; k0 < nkeys; k0 += 32) {
            int krow0, kpos0;
            if (lat) { if (k0 < 256) { krow0 = RL + b * 256 + k0; kpos0 = k0 - 256; } else if (k0 < 2304) { krow0 = b * 2048 + (k0 - 256); kpos0 = k0 - 256; } else { krow0 = RL + b * 256 + (k0 - 2304); kpos0 = 2048 + (k0 - 2304); } }
            else { krow0 = RL + b * 256 + k0; kpos0 = k0; }
            __syncthreads();
            for (int e = tid_; e < 32 * 64; e += NT) { const int j = e >> 6, i = e & 63; sK[j][i] = bf2f(Z[(size_t)(krow0 + j) * ZW + C_RK + h * 64 + i]); sV[j][i] = bf2f(Z[(size_t)(krow0 + j) * ZW + C_RV + h * 64 + i]); }
            __syncthreads();
#pragma unroll 1
            for (int j = 0; j < 32; ++j) { float a = 0.f;
#pragma unroll
                for (int i = 0; i < 64; ++i) a += q[i] * sK[j][i];
                const int dpos = qpos - (kpos0 + j);
                const float dec = dpos > 0 ? exp2f(lgf * (float)dpos) : (dpos < 0 ? exp2f(lgb * (float)(-dpos)) : 2.f);
                a *= dec;
#pragma unroll
                for (int i = 0; i < 32; ++i) o[i] += a * sV[j][dh + i]; }
        }
        float s1 = 0.f;
#pragma unroll
        for (int i = 0; i < 32; ++i) s1 += o[i];
        __syncthreads();
        sred[hh * 256 + qt] = s1;
        __syncthreads();
        const float mu = (sred[qt] + sred[256 + qt]) * (1.f / 64);
        float s2 = 0.f;
#pragma unroll
        for (int i = 0; i < 32; ++i) { const float d = o[i] - mu; s2 += d * d; }
        __syncthreads();
        sred[hh * 256 + qt] = s2;
        __syncthreads();
        const float rstd = rsqrtf((sred[qt] + sred[256 + qt]) * (1.f / 64) + EPS);
#pragma unroll
        for (int i = 0; i < 32; ++i) { const float gte = bf2f(Z[(size_t)qrow * ZW + C_RG + h * 64 + dh + i]); const float y = (o[i] - mu) * rstd * gn_w[h * 64 + dh + i];
            Z[(size_t)qrow * ZW + C_RQ + h * 64 + dh + i] = f2bf(siluf_(gte) * y); }
    }
    __syncthreads();
}
struct E_merge { const bf16_t* stash; bf16_t* MMp; long long first;
    __device__ void operator()(int, int m, int n, float v) const { const size_t i = (size_t)m * DM + n; const float t = sigmoidf_(v) * bf2f(stash[i]); MMp[i] = f2bf(first ? t : bf2f(MMp[i]) + t); } };
struct E_resid { const float* xlat; const float* xctx; float* olat; float* octx; const float* mod; long long gchunk;
    __device__ void operator()(int, int m, int n, float v) const {
        const float g = mod[(size_t)row_modidx(m) * 6144 + gchunk * 1024 + n];
        if (m < RL) olat[(size_t)m * DM + n] = xlat[(size_t)m * DM + n] + g * v; else octx[(size_t)(m - RL) * DM + n] = xctx[(size_t)(m - RL) * DM + n] + g * v; } };
struct E_relu2 { bf16_t* H; __device__ void operator()(int, int m, int n, float v) const { const float r = fmaxf(v, 0.f); H[(size_t)m * DFF + n] = f2bf(r * r); } };


__device__ __forceinline__ void ph_s5_sloc(unsigned char* lds_, const bf16_t* Z, const bf16_t* MST, float* SLOC) { PH_IDS;
    const int lane = tid_ & 63, wid = __builtin_amdgcn_readfirstlane(tid_ >> 6), c16 = lane & 15, kq = lane >> 4;
    LAS char* sm = (LAS char*)lds_;
    constexpr int CP = 64 * 32 + 16;
    for (int u = bid_; u < 256; u += G_) {
        const int g = u >> 4, nh = (u >> 3) & 1, sl = u & 7;
        const bf16_t* mp0 = MST + ((size_t)g * 256 + nh * 128 + wid * 16 + c16) * 1024 + 8 * kq;
        bf16x8 a[32];
#pragma unroll
        for (int ks = 0; ks < 32; ++ks) a[ks] = *(const bf16x8*)(mp0 + 32 * ks);
        pg8::u32x4 st[4];
#define SLOC_ISSUE(blk_) do { _Pragma("unroll") for (int i = 0; i < 4; ++i) { const int p = tid_ + NT * i, r = p >> 1, hf = p & 1; \
            st[i] = *(const pg8::u32x4*)(Z + ((size_t)(blk_) * 1024 + r) * ZW + C_S5 + g * 16 + 8 * hf); } } while (0)
        SLOC_ISSUE(sl);
        for (int blk = sl; blk < 18; blk += 8) {
            const int rcbase = blk * 16;
            __syncthreads();
#pragma unroll
            for (int i = 0; i < 4; ++i) { const int p = tid_ + NT * i, r = p >> 1, hf = p & 1; *(LAS pg8::u32x4*)(sm + (r >> 6) * CP + (r & 63) * 32 + hf * 16) = st[i]; }
            if (blk + 8 < 18) SLOC_ISSUE(blk + 8);
            __syncthreads();
            const LAS char* bp = sm + c16 * CP + (kq >> 1) * 32 + (kq & 1) * 16;
            f32x4 acc0 = (f32x4){0.f, 0.f, 0.f, 0.f}, acc1 = acc0;
#pragma unroll
            for (int ks = 0; ks < 32; ks += 2) {
                const bf16x8 b0 = *(const LAS bf16x8*)(bp + ks * 64), b1 = *(const LAS bf16x8*)(bp + (ks + 1) * 64);
                acc0 = __builtin_amdgcn_mfma_f32_16x16x32_bf16(a[ks], b0, acc0, 0, 0, 0);
                acc1 = __builtin_amdgcn_mfma_f32_16x16x32_bf16(a[ks + 1], b1, acc1, 0, 0, 0);
            }
            *(f32x4*)(SLOC + ((size_t)(rcbase + c16) * 16 + g) * 256 + nh * 128 + wid * 16 + 4 * kq) = acc0 + acc1;
        }
#undef SLOC_ISSUE
    }
    __syncthreads();
}
__device__ __forceinline__ void ph_s5_tzb(int l, const float* TZD, const float* s5d, bf16_t* TZB, const float* c_re, const float* c_im, bf16_t* CQ) { PH_IDS;
    GSTRIDE(e, 16 * 16 * 256) { const int g = e >> 12, h = (e >> 8) & 15, n = e & 255, d = n >> 7, im = (n >> 6) & 1, p = n & 63;
        const size_t ci = ((((size_t)(l * 2 + d) * 16 + g) * 16 + h) * 64) + p; CQ[e] = f2bf(im ? -c_im[ci] : c_re[ci]); }
    GSTRIDE(e, 16 * 127 * 64) { const int g = e / (127 * 64), r = e % (127 * 64), dd = r >> 6, h = (r >> 2) & 15, q4 = (r & 3) * 4;
        f32x4 v = (f32x4){0.f, 0.f, 0.f, 0.f};
        if (dd >= 63) v += *(const f32x4*)(TZD + ((((size_t)0 * 16 + g) * 64 + (dd - 63)) * 16 + h) * 16 + q4);
        if (dd <= 63) v += *(const f32x4*)(TZD + ((((size_t)1 * 16 + g) * 64 + (63 - dd)) * 16 + h) * 16 + q4);
        if (dd == 63 && (h >> 2) == (q4 >> 2)) v[h & 3] += s5d[g * 16 + h];
        fa::u32x2 w; w.x = fa::pk2(v[0], v[1]); w.y = fa::pk2(v[2], v[3]);
        *(fa::u32x2*)(TZB + ((size_t)(g * 127 + dd) * 16 + h) * 16 + (((q4 >> 3) ^ (h >> 3)) * 8 + (q4 & 7))) = w; }
}
__device__ __forceinline__ void ph_s5_out(unsigned char* lds_, const bf16_t* Z, const bf16_t* TZB, const bf16_t* CQ, const float2* LP, const float* SLOC, const float* lamT, bf16_t* YG, int nrct, int u0, int ustep) { PH_IDS;
    LAS char* sm = (LAS char*)lds_;
    constexpr int O_TZ = 0, O_XP = 65536, O_U = 73728, UP = 2064, O_SL = O_U + 16 * UP;
    const int lane = tid_ & 63, wid = __builtin_amdgcn_readfirstlane(tid_ >> 6), c16 = lane & 15, kq = lane >> 4;
    for (int u = u0; u < 16 * nrct; u += ustep) {
        const int g = u / nrct, rct = u % nrct, rcbase = rct * 16;
        const bool lat = rct < 16; const int b = rcbase >> 5, c0 = rcbase & 31;
        const int nsl = lat ? 36 : 16;
        pg8::u32x4 sT[8], sU[4]; f32x4 sS[5];
        { const pg8::u32x4* tsrc = (const pg8::u32x4*)(TZB + (size_t)g * 127 * 256);
#pragma unroll
          for (int i_ = 0; i_ < 8; ++i_) { const int e = tid_ + NT * i_; if (e < 127 * 32) sT[i_] = tsrc[e]; }
#pragma unroll
          for (int i_ = 0; i_ < 4; ++i_) { const int e = tid_ + NT * i_, rc = e >> 7, s_ = (e >> 1) & 63, hh = e & 1; sU[i_] = *(const pg8::u32x4*)(Z + ((size_t)(rcbase + rc) * 64 + s_) * ZW + C_S5 + g * 16 + hh * 8); }
#pragma unroll
          for (int i_ = 0; i_ < 5; ++i_) { const int e = tid_ + NT * i_, r = e >> 6, q4 = e & 63; const int rc = lat ? (r < 4 ? 256 + b * 4 + r : b * 32 + (r - 4)) : rcbase + r;
              if (e < nsl * 64) sS[i_] = *(const f32x4*)(SLOC + ((size_t)rc * 16 + g) * 256 + q4 * 4); } }
        __syncthreads();
#pragma unroll
        for (int i_ = 0; i_ < 8; ++i_) { const int e = tid_ + NT * i_; if (e < 127 * 32) *(LAS pg8::u32x4*)(sm + O_TZ + e * 16) = sT[i_]; }
#pragma unroll
        for (int i_ = 0; i_ < 4; ++i_) { const int e = tid_ + NT * i_, rc = e >> 7, s_ = (e >> 1) & 63, hh = e & 1; *(LAS pg8::u32x4*)(sm + O_U + rc * UP + s_ * 32 + hh * 16) = sU[i_]; }
#pragma unroll
        for (int i_ = 0; i_ < 5; ++i_) { const int e = tid_ + NT * i_, r = e >> 6, q4 = e & 63; if (e < nsl * 64) *(LAS f32x4*)(sm + O_SL + r * 1024 + q4 * 16) = sS[i_]; }
        __syncthreads();
        if (tid_ < 128) {
            const int d = tid_ >> 6, p = tid_ & 63;
            const float lr = lamT[((size_t)(g * 2 + d) * 64 + p) * 2], li = lamT[((size_t)(g * 2 + d) * 64 + p) * 2 + 1];
            const LAS float* sl = (const LAS float*)(sm + O_SL) + d * 128 + p;
            LAS bf16_t* xp = (LAS bf16_t*)(sm + O_XP) + d * 128 + p;
            float xr = 0.f, xi = 0.f;
#define S5_STEP(r) do { const float sr = sl[(r) * 256], si = sl[(r) * 256 + 64]; const float nr = lr * xr - li * xi + sr, ni = lr * xi + li * xr + si; xr = nr; xi = ni; } while (0)
            if (lat) {
                if (d == 0) { for (int r = 0; r < 4 + c0; ++r) S5_STEP(r);
                    for (int r = 0; r < 16; ++r) { xp[r * 256] = f2bf(xr); xp[r * 256 + 64] = f2bf(xi); S5_STEP(4 + c0 + r); } }
                else { for (int r = 3; r >= 0; --r) S5_STEP(r);
                    for (int c = 31; c >= c0 + 16; --c) S5_STEP(4 + c);
                    for (int r = 15; r >= 0; --r) { xp[r * 256] = f2bf(xr); xp[r * 256 + 64] = f2bf(xi); S5_STEP(4 + c0 + r); } }
            } else {
                if (d == 0) { for (int r = 0; r < 16; ++r) { if ((r & 3) == 0) { xr = 0.f; xi = 0.f; } xp[r * 256] = f2bf(xr); xp[r * 256 + 64] = f2bf(xi); S5_STEP(r); } }
                else { for (int r = 15; r >= 0; --r) { if ((r & 3) == 3) { xr = 0.f; xi = 0.f; } xp[r * 256] = f2bf(xr); xp[r * 256 + 64] = f2bf(xi); S5_STEP(r); } }
            }
#undef S5_STEP
        }
        __syncthreads();
        const LAS char* ub = sm + O_U + c16 * UP + kq * 16;
        const LAS char* xb = sm + O_XP + c16 * 512 + kq * 16;
        f32x4 acc8[8];
#pragma unroll
        for (int i = 0; i < 8; ++i) acc8[i] = (f32x4){0.f, 0.f, 0.f, 0.f};
#pragma unroll
        for (int par = 0; par < 2; ++par) {
            const LAS char* fz = sm + O_TZ + ((wid * 8 + par + 63 - (kq >> 1)) * 16 + c16) * 32 + ((kq & 1) ^ (c16 >> 3)) * 16;
            bf16x8 uw[4];
            uw[0] = *(const LAS bf16x8*)(ub); uw[1] = *(const LAS bf16x8*)(ub + 64); uw[2] = *(const LAS bf16x8*)(ub + 128); uw[3] = uw[0];
#pragma unroll
            for (int m = -3; m < 32; ++m) {
                const bf16x8 f = *(const LAS bf16x8*)(fz - m * 1024);
                if (m + 3 < 32) uw[(m + 3) & 3] = *(const LAS bf16x8*)(ub + (m + 3) * 64);
#pragma unroll
                for (int j = 0; j < 4; ++j) { const int ks = m + j; if (ks >= 0 && ks < 32) acc8[par + 2 * j] = __builtin_amdgcn_mfma_f32_16x16x32_bf16(f, uw[ks & 3], acc8[par + 2 * j], 0, 0, 0); }
            }
        }
        {
#pragma unroll
            for (int d = 0; d < 2; ++d)
#pragma unroll 1
            for (int ph = 0; ph < 2; ++ph) {
                asm volatile("" ::: "memory");
                const bf16x8 cqr = *(const bf16x8*)(CQ + ((size_t)g * 16 + c16) * 256 + 32 * (4 * d + ph) + 8 * kq), cqi = *(const bf16x8*)(CQ + ((size_t)g * 16 + c16) * 256 + 32 * (4 * d + 2 + ph) + 8 * kq);
                const bf16x8 xre = *(const LAS bf16x8*)(xb + (4 * d + ph) * 64), xim = *(const LAS bf16x8*)(xb + (4 * d + 2 + ph) * 64);
                float yr[8], yi[8], lr[8], li[8];
                const int e0 = d == 0 ? 8 * wid + 1 : 57 - 8 * wid;
#pragma unroll
                for (int j = 0; j < 8; ++j) {
                    const float2* lp = LP + (((size_t)d * 16 + g) * 64 + 32 * ph + 8 * kq + j) * 65;
                    const float2 l1 = lp[1], ls = lp[e0];
                    const float xr = __uint_as_float((unsigned)(unsigned short)xre[j] << 16), xi = __uint_as_float((unsigned)(unsigned short)xim[j] << 16);
                    yr[j] = ls.x * xr - ls.y * xi; yi[j] = ls.x * xi + ls.y * xr; lr[j] = l1.x; li[j] = l1.y;
                }
#pragma unroll
                for (int s8 = 0; s8 < 8; ++s8) {
                    const int i = d == 0 ? s8 : 7 - s8;
                    const bf16x8 bre = __builtin_bit_cast(bf16x8, pack8((f32x4){yr[0], yr[1], yr[2], yr[3]}, (f32x4){yr[4], yr[5], yr[6], yr[7]}));
                    const bf16x8 bim = __builtin_bit_cast(bf16x8, pack8((f32x4){yi[0], yi[1], yi[2], yi[3]}, (f32x4){yi[4], yi[5], yi[6], yi[7]}));
                    acc8[i] = __builtin_amdgcn_mfma_f32_16x16x32_bf16(cqr, bre, acc8[i], 0, 0, 0);
                    acc8[i] = __builtin_amdgcn_mfma_f32_16x16x32_bf16(cqi, bim, acc8[i], 0, 0, 0);
                    if (s8 < 7) {
#pragma unroll
                        for (int j = 0; j < 8; ++j) { const float a = yr[j], c = yi[j]; yr[j] = lr[j] * a - li[j] * c; yi[j] = lr[j] * c + li[j] * a; }
                    }
                }
            }
        }
#pragma unroll
        for (int i = 0; i < 8; ++i) { const int t = wid * 8 + i;
            fa::u32x2 w; w.x = fa::pk2(geluf_(acc8[i][0]), geluf_(acc8[i][1])); w.y = fa::pk2(geluf_(acc8[i][2]), geluf_(acc8[i][3]));
            *(fa::u32x2*)(YG + ((size_t)(rcbase + c16) * 64 + t) * ZW + C_S5 + g * 16 + 4 * kq) = w; }
    }
    __syncthreads();
}
__device__ __forceinline__ void rope16(float (&v)[4], int kq, float pos, bool on) {
#pragma unroll
    for (int r = 0; r < 4; ++r) {
        const int j = (4 * kq + r) & 7;
        const float ang = pos * exp2f(-(float)j * (13.287712379549449f / 8.f)), cs = __cosf(ang), sn = __sinf(ang);
        const float other = __shfl_xor(v[r], 32);
        const float rot = kq < 2 ? v[r] * cs - other * sn : other * sn + v[r] * cs;
        v[r] = on ? rot : v[r];
    }
}
__device__ __forceinline__ void ph_prep(bf16_t* Z, const bf16_t* WUQ, const bf16_t* WUKV, const bf16_t* D64, const float* qkq, const float* qkk,
                                        bf16_t* Q, bf16_t* Kb, bf16_t* Vb, bf16_t* F1lat, bf16_t* F1ctx, unsigned char* lds_) { PH_IDS;
    const int lane = tid_ & 63, wid = __builtin_amdgcn_readfirstlane(tid_ >> 6), c16 = lane & 15, kq = lane >> 4;
    LAS char* sm = (LAS char*)lds_;
    constexpr int P_KV = 336, P_QC = 528, O_KV = 0, O_QC = 24576, O_FU = 63488;
    for (int blk = bid_; blk < RT / 72; blk += G_) {
        const int row0 = blk * 72;
        __syncthreads();
#pragma unroll 1
        for (int hf = 0; hf < 3; ++hf) { pg8::u32x4 st[4];
#pragma unroll
          for (int i = 0; i < 4; ++i) { const int e = tid_ + NT * (4 * hf + i);
              if (e < 1440) st[i] = *(const pg8::u32x4*)(Z + (size_t)(row0 + e / 20) * ZW + C_KVC + (e % 20) * 8);
              else if (e < 3744) st[i] = *(const pg8::u32x4*)(Z + (size_t)(row0 + ((e - 1440) >> 5)) * ZW + C_QC + ((e - 1440) & 31) * 8);
              else if (e < 6048) st[i] = *(const pg8::u32x4*)(Z + (size_t)(row0 + ((e - 3744) >> 5)) * ZW + C_FU + ((e - 3744) & 31) * 8); }
#pragma unroll
          for (int i = 0; i < 4; ++i) { const int e = tid_ + NT * (4 * hf + i);
              if (e < 1440) *(LAS pg8::u32x4*)(sm + O_KV + (e / 20) * P_KV + (e % 20) * 16) = st[i];
              else if (e < 3744) *(LAS pg8::u32x4*)(sm + O_QC + ((e - 1440) >> 5) * P_QC + ((e - 1440) & 31) * 16) = st[i];
              else if (e < 6048) *(LAS pg8::u32x4*)(sm + O_FU + ((e - 3744) >> 5) * P_QC + ((e - 3744) & 31) * 16) = st[i]; } }
        __syncthreads();
#pragma unroll 1
      for (int pass3 = 0; pass3 < 2; ++pass3) {
        int rowc[3], rl[3]; bool valid[3];
#pragma unroll
        for (int tt = 0; tt < 3; ++tt) { const int o = 16 * (3 * pass3 + tt) + c16; valid[tt] = o < 72; rl[tt] = valid[tt] ? o : 71; rowc[tt] = row0 + rl[tt]; }
        if (wid < 4) {
            const int h = wid;
            f32x4 acc[6][3]; float ssq[3];
#pragma unroll
            for (int tt = 0; tt < 3; ++tt) { ssq[tt] = 0.f;
#pragma unroll
                for (int nt = 0; nt < 6; ++nt) acc[nt][tt] = (f32x4){0.f, 0.f, 0.f, 0.f}; }
#pragma unroll 4
            for (int ks = 0; ks < 8; ++ks) {
                bf16x8 bq[3], aw[6];
#pragma unroll
                for (int tt = 0; tt < 3; ++tt) { bq[tt] = *(const LAS bf16x8*)(sm + O_QC + rl[tt] * P_QC + (32 * ks + 8 * kq) * 2);
#pragma unroll
                    for (int e = 0; e < 8; ++e) { const float f = bf2f((bf16_t)bq[tt][e]); ssq[tt] += f * f; } }
#pragma unroll
                for (int nt = 0; nt < 6; ++nt) aw[nt] = *(const bf16x8*)(WUQ + (size_t)(h * 96 + 16 * nt + c16) * 256 + 32 * ks + 8 * kq);
#pragma unroll
                for (int nt = 0; nt < 6; ++nt)
#pragma unroll
                    for (int tt = 0; tt < 3; ++tt) acc[nt][tt] = __builtin_amdgcn_mfma_f32_16x16x32_bf16(aw[nt], bq[tt], acc[nt][tt], 0, 0, 0);
            }
#pragma unroll
            for (int tt = 0; tt < 3; ++tt) {
                float s1 = ssq[tt]; s1 += __shfl_xor(s1, 16); s1 += __shfl_xor(s1, 32);
                const float rstd = rsqrtf(s1 * (1.f / 256) + EPS);
                float ss = 0.f;
#pragma unroll
                for (int nt = 0; nt < 6; ++nt)
#pragma unroll
                    for (int r = 0; r < 4; ++r) ss += acc[nt][tt][r] * acc[nt][tt][r];
                ss += __shfl_xor(ss, 16); ss += __shfl_xor(ss, 32);
                const float fac = rstd * rsqrtf(rstd * rstd * ss * (1.f / 96) + EPS) * 0.14724727430627066f;
                const int row = rowc[tt]; const bool lat = row < RL; const int b = row_batch(row), t = lat ? (row & 2047) : ((row - RL) & 255), qi = lat ? t : 2048 + t;
                bf16_t* qo = Q + ((size_t)(b * 4 + h) * 2304 + qi) * 96 + 4 * kq;
#pragma unroll
                for (int nt = 0; nt < 6; ++nt) {
                    const f32x4 w = *(const f32x4*)(qkq + 16 * nt + 4 * kq);
                    float v[4];
#pragma unroll
                    for (int r = 0; r < 4; ++r) v[r] = acc[nt][tt][r] * fac * w[r];
                    if (nt >= 4) rope16(v, kq, nt == 4 ? (float)(t >> 6) : (float)(t & 63), lat);
                    fa::u32x2 o; o.x = fa::pk2(v[0], v[1]); o.y = fa::pk2(v[2], v[3]);
                    if (valid[tt]) *(fa::u32x2*)(qo + 16 * nt) = o;
                }
            }
        } else {
            const int h = wid - 4;
            float ssq[3], rstd[3];
#pragma unroll
            for (int tt = 0; tt < 3; ++tt) ssq[tt] = 0.f;
#pragma unroll 1
            for (int pass = 0; pass < 2; ++pass) {
                f32x4 acc[4][3];
#pragma unroll
                for (int tt = 0; tt < 3; ++tt)
#pragma unroll
                    for (int nt = 0; nt < 4; ++nt) acc[nt][tt] = (f32x4){0.f, 0.f, 0.f, 0.f};
#pragma unroll
                for (int ks = 0; ks < 4; ++ks) {
                    bf16x8 bq[3], aw[4];
#pragma unroll
                    for (int tt = 0; tt < 3; ++tt) { bq[tt] = *(const LAS bf16x8*)(sm + O_KV + rl[tt] * P_KV + (32 * ks + 8 * kq) * 2);
                        if (pass == 0) {
#pragma unroll
                            for (int e = 0; e < 8; ++e) { const float f = bf2f((bf16_t)bq[tt][e]); ssq[tt] += f * f; } } }
#pragma unroll
                    for (int nt = 0; nt < 4; ++nt) aw[nt] = *(const bf16x8*)(WUKV + (size_t)(h * 128 + pass * 64 + 16 * nt + c16) * 128 + 32 * ks + 8 * kq);
#pragma unroll
                    for (int nt = 0; nt < 4; ++nt)
#pragma unroll
                        for (int tt = 0; tt < 3; ++tt) acc[nt][tt] = __builtin_amdgcn_mfma_f32_16x16x32_bf16(aw[nt], bq[tt], acc[nt][tt], 0, 0, 0);
                }
#pragma unroll
                for (int tt = 0; tt < 3; ++tt) {
                    const int row = rowc[tt]; const bool lat = row < RL; const int b = row_batch(row), t = lat ? (row & 2047) : ((row - RL) & 255), ki = lat ? 256 + t : t;
                    if (pass == 0) {
                        float s1 = ssq[tt]; s1 += __shfl_xor(s1, 16); s1 += __shfl_xor(s1, 32);
                        rstd[tt] = rsqrtf(s1 * (1.f / 128) + EPS);
                        float kr[2][4];
#pragma unroll
                        for (int e = 0; e < 2; ++e) { const fa::u32x2 w = *(const LAS fa::u32x2*)(sm + O_KV + rl[tt] * P_KV + (128 + 16 * e + 4 * kq) * 2);
                            kr[e][0] = __uint_as_float(w.x << 16); kr[e][1] = __uint_as_float(w.x & 0xffff0000u); kr[e][2] = __uint_as_float(w.y << 16); kr[e][3] = __uint_as_float(w.y & 0xffff0000u); }
                        float ss = 0.f;
#pragma unroll
                        for (int nt = 0; nt < 4; ++nt)
#pragma unroll
                            for (int r = 0; r < 4; ++r) { acc[nt][tt][r] *= rstd[tt]; ss += acc[nt][tt][r] * acc[nt][tt][r]; }
#pragma unroll
                        for (int e = 0; e < 2; ++e)
#pragma unroll
                            for (int r = 0; r < 4; ++r) ss += kr[e][r] * kr[e][r];
                        ss += __shfl_xor(ss, 16); ss += __shfl_xor(ss, 32);
                        const float fac = rsqrtf(ss * (1.f / 96) + EPS);
                        bf16_t* ko = Kb + ((size_t)(b * 4 + h) * 2304 + ki) * 96 + 4 * kq;
#pragma unroll
                        for (int nt = 0; nt < 6; ++nt) {
                            const f32x4 w = *(const f32x4*)(qkk + 16 * nt + 4 * kq);
                            float v[4];
#pragma unroll
                            for (int r = 0; r < 4; ++r) v[r] = (nt < 4 ? acc[nt < 4 ? nt : 0][tt][r] : kr[nt < 4 ? 0 : nt - 4][r]) * fac * w[r];
                            if (nt >= 4) rope16(v, kq, nt == 4 ? (float)(t >> 6) : (float)(t & 63), lat);
                            fa::u32x2 o; o.x = fa::pk2(v[0], v[1]); o.y = fa::pk2(v[2], v[3]);
                            if (valid[tt]) *(fa::u32x2*)(ko + 16 * nt) = o;
                        }
                    } else {
                        bf16_t* vo = Vb + ((size_t)(b * 4 + h) * 2304 + ki) * 64 + 4 * kq;
#pragma unroll
                        for (int nt = 0; nt < 4; ++nt) { fa::u32x2 o; o.x = fa::pk2(acc[nt][tt][0] * rstd[tt], acc[nt][tt][1] * rstd[tt]); o.y = fa::pk2(acc[nt][tt][2] * rstd[tt], acc[nt][tt][3] * rstd[tt]);
                            if (valid[tt]) *(fa::u32x2*)(vo + 16 * nt) = o; }
                    }
                }
            }
        }
        {
            const int g = wid >> 1, part = wid & 1;
            f32x4 acc[4][3];
#pragma unroll
            for (int tt = 0; tt < 3; ++tt)
#pragma unroll
                for (int nt = 0; nt < 4; ++nt) acc[nt][tt] = (f32x4){0.f, 0.f, 0.f, 0.f};
#pragma unroll
            for (int ks = 0; ks < 2; ++ks) {
                bf16x8 au[3], bd[4];
#pragma unroll
                for (int tt = 0; tt < 3; ++tt) au[tt] = *(const LAS bf16x8*)(sm + O_FU + rl[tt] * P_QC + (g * 64 + 32 * ks + 8 * kq) * 2);
#pragma unroll
                for (int nt = 0; nt < 4; ++nt) bd[nt] = *(const bf16x8*)(D64 + (size_t)(part * 64 + 16 * nt + c16) * 64 + 32 * ks + 8 * kq);
#pragma unroll
                for (int nt = 0; nt < 4; ++nt)
#pragma unroll
                    for (int tt = 0; tt < 3; ++tt) acc[nt][tt] = __builtin_amdgcn_mfma_f32_16x16x32_bf16(au[tt], bd[nt], acc[nt][tt], 0, 0, 0);
            }
#pragma unroll
            for (int tt = 0; tt < 3; ++tt) {
                const int o4 = 16 * (3 * pass3 + tt) + 4 * kq; const int trow = row0 + o4;
                if (o4 < 72) {
                    const bool lat = trow < RL;
#pragma unroll
                    for (int nt = 0; nt < 4; ++nt) {
                        const int gm = g * 64 + 16 * nt + c16;
                        fa::u32x2 o; o.x = fa::pk2(acc[nt][tt][0], acc[nt][tt][1]); o.y = fa::pk2(acc[nt][tt][2], acc[nt][tt][3]);
                        if (lat) { const int b = trow >> 11, t0 = trow & 2047; *(fa::u32x2*)(F1lat + ((size_t)(b * 256 + gm) * 2 + part) * 2048 + t0) = o; }
                        else { const int rr = trow - RL, b = rr >> 8, t0 = rr & 255; *(fa::u32x2*)(F1ctx + ((size_t)(b * 256 + gm) * 2 + part) * 256 + t0) = o; }
                    }
                }
            }
        }
      }
#pragma unroll 1
        for (int it = tid_; it < 72 * 16; it += NT) {
            const int row = row0 + (it >> 4), h = (it >> 2) & 3, jg = it & 3;
            bf16_t* zq = Z + (size_t)row * ZW + C_RQ + h * 64 + 8 * jg; bf16_t* zk = Z + (size_t)row * ZW + C_RK + h * 64 + 8 * jg;
            const fa::u32x4 k1 = *(const fa::u32x4*)zk, k2 = *(const fa::u32x4*)(zk + 32);
            f32x4 ka, kb, kc, kd; unpack8(k1, ka, kb); unpack8(k2, kc, kd);
            if (row < RL) {
                const fa::u32x4 q1 = *(const fa::u32x4*)zq, q2 = *(const fa::u32x4*)(zq + 32);
                f32x4 qa, qb, qc, qd; unpack8(q1, qa, qb); unpack8(q2, qc, qd);
                const float tpos = (float)(row & 2047);
                float x1q[8] = {qa[0], qa[1], qa[2], qa[3], qb[0], qb[1], qb[2], qb[3]}, x2q[8] = {qc[0], qc[1], qc[2], qc[3], qd[0], qd[1], qd[2], qd[3]};
                float x1k[8] = {ka[0], ka[1], ka[2], ka[3], kb[0], kb[1], kb[2], kb[3]}, x2k[8] = {kc[0], kc[1], kc[2], kc[3], kd[0], kd[1], kd[2], kd[3]};
#pragma unroll
                for (int e = 0; e < 8; ++e) {
                    float rev = tpos * (__builtin_amdgcn_exp2f(-(float)(8 * jg + e) * (13.287712379549449f / 32.f)) * 0.15915494309189535f); rev -= floorf(rev);
                    const float cs = __builtin_amdgcn_cosf(rev), sn = __builtin_amdgcn_sinf(rev);
                    const float a = x1q[e], c = x2q[e]; x1q[e] = a * cs - c * sn; x2q[e] = a * sn + c * cs;
                    const float a2 = x1k[e], c2 = x2k[e]; x1k[e] = (a2 * cs - c2 * sn) * 0.125f; x2k[e] = (a2 * sn + c2 * cs) * 0.125f;
                }
                *(fa::u32x4*)zq = pack8((f32x4){x1q[0], x1q[1], x1q[2], x1q[3]}, (f32x4){x1q[4], x1q[5], x1q[6], x1q[7]});
                *(fa::u32x4*)(zq + 32) = pack8((f32x4){x2q[0], x2q[1], x2q[2], x2q[3]}, (f32x4){x2q[4], x2q[5], x2q[6], x2q[7]});
                *(fa::u32x4*)zk = pack8((f32x4){x1k[0], x1k[1], x1k[2], x1k[3]}, (f32x4){x1k[4], x1k[5], x1k[6], x1k[7]});
                *(fa::u32x4*)(zk + 32) = pack8((f32x4){x2k[0], x2k[1], x2k[2], x2k[3]}, (f32x4){x2k[4], x2k[5], x2k[6], x2k[7]});
            } else {
                *(fa::u32x4*)zk = pack8(ka * 0.125f, kb * 0.125f); *(fa::u32x4*)(zk + 32) = pack8(kc * 0.125f, kd * 0.125f);
            }
        }
    }
}

__device__ __forceinline__ void attn_tile(const LAS char* sm, int r32, int hi, int vrd, int buf, bool first, const bf16x8 (&qf)[6], fa::f32x16& negm, float& mrun, float& lsum, fa::f32x16& o0, fa::f32x16& o1) {
    using namespace fa;
    const LAS char* kb = sm + buf + r32 * KP_A + 16 * hi;
    f32x16 p0 = negm, p1 = negm;
#pragma unroll
    for (int st = 0; st < 6; ++st) {
        const bf16x8 k0 = *(const LAS bf16x8*)(kb + 32 * st), k1 = *(const LAS bf16x8*)(kb + 32 * KP_A + 32 * st);
        p0 = __builtin_amdgcn_mfma_f32_32x32x16_bf16(k0, qf[st], p0, 0, 0, 0);
        p1 = __builtin_amdgcn_mfma_f32_32x32x16_bf16(k1, qf[st], p1, 0, 0, 0);
    }
    float ta = fmaxf(fmaxf(p0[0], p0[1]), p1[0]), tb = fmaxf(fmaxf(p0[2], p0[3]), p1[1]);
    ta = fmaxf(fmaxf(ta, p1[2]), p1[3]);
#pragma unroll
    for (int r = 4; r < 16; r += 4) { ta = fmaxf(fmaxf(ta, p0[r]), p0[r + 1]); tb = fmaxf(fmaxf(tb, p0[r + 2]), p0[r + 3]); ta = fmaxf(fmaxf(ta, p1[r]), p1[r + 1]); tb = fmaxf(fmaxf(tb, p1[r + 2]), p1[r + 3]); }
    float tm = fmaxf(ta, tb);
    tm = fmaxf(tm, __shfl_xor(tm, 32));
    if (first || __any(tm > 0.f)) {
        const float dl = first ? tm : fmaxf(tm, 0.f), alpha = first ? 1.f : __builtin_amdgcn_exp2f(-dl);
        mrun += dl; lsum *= alpha;
#pragma unroll
        for (int r = 0; r < 16; ++r) { p0[r] -= dl; p1[r] -= dl; o0[r] *= alpha; o1[r] *= alpha; negm[r] = -mrun; }
    }
    float ps = 0.f, ps2 = 0.f;
#pragma unroll
    for (int r = 0; r < 16; ++r) { p0[r] = __builtin_amdgcn_exp2f(p0[r]); p1[r] = __builtin_amdgcn_exp2f(p1[r]); ps += p0[r]; ps2 += p1[r]; }
    lsum += ps + ps2;
    bf16x8 pf[4]; pf[0] = pack_p(p0, 0); pf[1] = pack_p(p0, 8); pf[2] = pack_p(p1, 0); pf[3] = pack_p(p1, 8);
    pv_tile(o0, o1, sm + buf + vrd, pf);
}
__device__ __forceinline__ void attn_pair(const LAS char* sm, int r32, int hi, int vrd, int bufA, int bufB, bool first, const bf16x8 (&qf)[6], fa::f32x16& negm, float& mrun, float& lsum, fa::f32x16& o0, fa::f32x16& o1) {
    using namespace fa;
    const LAS char* ka = sm + bufA + r32 * KP_A + 16 * hi; const LAS char* kb = sm + bufB + r32 * KP_A + 16 * hi;
    f32x16 a0 = negm, a1 = negm, b0 = negm, b1 = negm;
#pragma unroll
    for (int st = 0; st < 6; ++st) {
        const bf16x8 k0 = *(const LAS bf16x8*)(ka + 32 * st), k1 = *(const LAS bf16x8*)(ka + 32 * KP_A + 32 * st);
        a0 = __builtin_amdgcn_mfma_f32_32x32x16_bf16(k0, qf[st], a0, 0, 0, 0);
        a1 = __builtin_amdgcn_mfma_f32_32x32x16_bf16(k1, qf[st], a1, 0, 0, 0);
    }
    float carry = 0.f;
    {
        float ta = fmaxf(fmaxf(a0[0], a0[1]), a1[0]), tb = fmaxf(fmaxf(a0[2], a0[3]), a1[1]);
        ta = fmaxf(fmaxf(ta, a1[2]), a1[3]);
#pragma unroll
        for (int r = 4; r < 16; r += 4) { ta = fmaxf(fmaxf(ta, a0[r]), a0[r + 1]); tb = fmaxf(fmaxf(tb, a0[r + 2]), a0[r + 3]); ta = fmaxf(fmaxf(ta, a1[r]), a1[r + 1]); tb = fmaxf(fmaxf(tb, a1[r + 2]), a1[r + 3]); }
        float tm = fmaxf(ta, tb);
        tm = fmaxf(tm, __shfl_xor(tm, 32));
        if (first || __any(tm > 0.f)) {
            const float dl = first ? tm : fmaxf(tm, 0.f), alpha = first ? 1.f : __builtin_amdgcn_exp2f(-dl);
            mrun += dl; lsum *= alpha; carry = dl;
#pragma unroll
            for (int r = 0; r < 16; ++r) { a0[r] -= dl; a1[r] -= dl; o0[r] *= alpha; o1[r] *= alpha; negm[r] = -mrun; }
        }
    }
#pragma unroll
    for (int st = 0; st < 6; ++st) {
        const bf16x8 k0 = *(const LAS bf16x8*)(kb + 32 * st), k1 = *(const LAS bf16x8*)(kb + 32 * KP_A + 32 * st);
        b0 = __builtin_amdgcn_mfma_f32_32x32x16_bf16(k0, qf[st], b0, 0, 0, 0);
        b1 = __builtin_amdgcn_mfma_f32_32x32x16_bf16(k1, qf[st], b1, 0, 0, 0);
    }
    float ps = 0.f, ps2 = 0.f;
#pragma unroll
    for (int r = 0; r < 16; ++r) { a0[r] = __builtin_amdgcn_exp2f(a0[r]); a1[r] = __builtin_amdgcn_exp2f(a1[r]); ps += a0[r]; ps2 += a1[r]; }
    lsum += ps + ps2;
    bf16x8 pf[4]; pf[0] = pack_p(a0, 0); pf[1] = pack_p(a0, 8); pf[2] = pack_p(a1, 0); pf[3] = pack_p(a1, 8);
    pv_tile(o0, o1, sm + bufA + vrd, pf);
    {
        float ta = fmaxf(fmaxf(b0[0], b0[1]), b1[0]), tb = fmaxf(fmaxf(b0[2], b0[3]), b1[1]);
        ta = fmaxf(fmaxf(ta, b1[2]), b1[3]);
#pragma unroll
        for (int r = 4; r < 16; r += 4) { ta = fmaxf(fmaxf(ta, b0[r]), b0[r + 1]); tb = fmaxf(fmaxf(tb, b0[r + 2]), b0[r + 3]); ta = fmaxf(fmaxf(ta, b1[r]), b1[r + 1]); tb = fmaxf(fmaxf(tb, b1[r + 2]), b1[r + 3]); }
        float tm = fmaxf(ta, tb) - carry;
        tm = fmaxf(tm, __shfl_xor(tm, 32));
        if (__any(tm > 0.f) || __any(carry != 0.f)) {
            const float dl = fmaxf(tm, 0.f), alpha = __builtin_amdgcn_exp2f(-dl), sh = carry + dl;
            mrun += dl; lsum *= alpha;
#pragma unroll
            for (int r = 0; r < 16; ++r) { b0[r] -= sh; b1[r] -= sh; o0[r] *= alpha; o1[r] *= alpha; negm[r] = -mrun; }
        }
    }
    ps = 0.f; ps2 = 0.f;
#pragma unroll
    for (int r = 0; r < 16; ++r) { b0[r] = __builtin_amdgcn_exp2f(b0[r]); b1[r] = __builtin_amdgcn_exp2f(b1[r]); ps += b0[r]; ps2 += b1[r]; }
    lsum += ps + ps2;
    pf[0] = pack_p(b0, 0); pf[1] = pack_p(b0, 8); pf[2] = pack_p(b1, 0); pf[3] = pack_p(b1, 8);
    pv_tile(o0, o1, sm + bufB + vrd, pf);
}
__device__ __forceinline__ float vadd1(float a, float b) { float r; asm("v_add_f32 %0, %1, %2" : "=v"(r) : "v"(a), "v"(b)); return r; }
__device__ __forceinline__ float att_max(const fa::f32x16& p0, const fa::f32x16& p1) {
    float ta = fmaxf(fmaxf(p0[0], p0[1]), p1[0]), tb = fmaxf(fmaxf(p0[2], p0[3]), p1[1]);
    ta = fmaxf(fmaxf(ta, p1[2]), p1[3]);
#pragma unroll
    for (int r = 4; r < 16; r += 4) { ta = fmaxf(fmaxf(ta, p0[r]), p0[r + 1]); tb = fmaxf(fmaxf(tb, p0[r + 2]), p0[r + 3]); ta = fmaxf(fmaxf(ta, p1[r]), p1[r + 1]); tb = fmaxf(fmaxf(tb, p1[r + 2]), p1[r + 3]); }
    return fmaxf(ta, tb);
}
__device__ __forceinline__ void att_shift(float tm, bool first, float& mrun, float& lsum, fa::f32x16& o0, fa::f32x16& o1) {
    tm = fmaxf(tm, __shfl_xor(tm, 32));
    if (first || __any(tm > mrun + 8.f)) {
        const float dl = first ? 0.f : fmaxf(tm - mrun, 0.f), alpha = __builtin_amdgcn_exp2f(-dl);
        mrun = first ? tm : mrun + dl; lsum *= alpha;
#pragma unroll
        for (int r = 0; r < 16; ++r) { o0[r] *= alpha; o1[r] *= alpha; }
    }
}
__device__ __forceinline__ void att_qk_exp(const LAS char* kb, const bf16x8 (&qf)[6], float nm, fa::f32x16& n0, fa::f32x16& n1, fa::f32x16& p0, fa::f32x16& p1, float& lsum, bf16x8 (&pf)[4]) {
    const fa::f32x16 zero = {0.f, 0.f, 0.f, 0.f, 0.f, 0.f, 0.f, 0.f, 0.f, 0.f, 0.f, 0.f, 0.f, 0.f, 0.f, 0.f};
    bf16x8 kc0 = *(const LAS bf16x8*)kb, kc1 = *(const LAS bf16x8*)(kb + 32 * fa::KP_A);
    float ps = 0.f, ps2 = 0.f;
#pragma unroll
    for (int st = 0; st < 6; ++st) {
        bf16x8 kn0 = kc0, kn1 = kc1;
        if (st < 5) { kn0 = *(const LAS bf16x8*)(kb + 32 * (st + 1)); kn1 = *(const LAS bf16x8*)(kb + 32 * fa::KP_A + 32 * (st + 1)); }
        n0 = __builtin_amdgcn_mfma_f32_32x32x16_bf16(kc0, qf[st], st == 0 ? zero : n0, 0, 0, 0);
        n1 = __builtin_amdgcn_mfma_f32_32x32x16_bf16(kc1, qf[st], st == 0 ? zero : n1, 0, 0, 0);
        constexpr int lo[7] = {0, 2, 6, 8, 10, 14, 16};
#pragma unroll
        for (int r = lo[st]; r < lo[st + 1]; ++r) {
            p0[r] = __builtin_amdgcn_exp2f(vadd1(p0[r], nm)); p1[r] = __builtin_amdgcn_exp2f(vadd1(p1[r], nm));
            ps += p0[r]; ps += p1[r]; }
        kc0 = kn0; kc1 = kn1;
        __builtin_amdgcn_sched_barrier(0);
    }
    lsum += ps + ps2;
    pf[0] = fa::pack_p(p0, 0); pf[1] = fa::pack_p(p0, 8); pf[2] = fa::pack_p(p1, 0); pf[3] = fa::pack_p(p1, 8);
}
__device__ __forceinline__ void att_exp_pack(fa::f32x16& p0, fa::f32x16& p1, float nm, float& lsum, bf16x8 (&pf)[4]) {
    float ps = 0.f, ps2 = 0.f;
#pragma unroll
    for (int r = 0; r < 16; ++r) { p0[r] = __builtin_amdgcn_exp2f(vadd1(p0[r], nm)); p1[r] = __builtin_amdgcn_exp2f(vadd1(p1[r], nm)); ps += p0[r]; ps += p1[r]; }
    lsum += ps + ps2;
    pf[0] = fa::pack_p(p0, 0); pf[1] = fa::pack_p(p0, 8); pf[2] = fa::pack_p(p1, 0); pf[3] = fa::pack_p(p1, 8);
}
__device__ __forceinline__ float att_pv_max(fa::f32x16& o0, fa::f32x16& o1, const LAS char* vb, const bf16x8 (&pf)[4], const fa::f32x16& n0, const fa::f32x16& n1) {
    using namespace fa;
    float ta = n0[0], tb = n1[0];
    s16x4 a0 = vtr(vb), a1 = vtr(vb + 512), b0 = vtr(vb + 4096), b1 = vtr(vb + 4096 + 512);
#pragma unroll
    for (int ks = 0; ks < 4; ++ks) {
        s16x4 na0 = a0, na1 = a1, nb0 = b0, nb1 = b1;
        if (ks < 3) { na0 = vtr(vb + (ks + 1) * 1024); na1 = vtr(vb + (ks + 1) * 1024 + 512); nb0 = vtr(vb + 4096 + (ks + 1) * 1024); nb1 = vtr(vb + 4096 + (ks + 1) * 1024 + 512); }
        const bf16x8 v0 = (bf16x8){a0[0], a0[1], a0[2], a0[3], a1[0], a1[1], a1[2], a1[3]}, v1 = (bf16x8){b0[0], b0[1], b0[2], b0[3], b1[0], b1[1], b1[2], b1[3]};
        o0 = __builtin_amdgcn_mfma_f32_32x32x16_bf16(v0, pf[ks], o0, 0, 0, 0);
        o1 = __builtin_amdgcn_mfma_f32_32x32x16_bf16(v1, pf[ks], o1, 0, 0, 0);
#pragma unroll
        for (int r = 4 * ks; r < 4 * ks + 4; ++r) { ta = fmaxf(ta, n0[r]); tb = fmaxf(tb, n1[r]); }
        a0 = na0; a1 = na1; b0 = nb0; b1 = nb1;
        __builtin_amdgcn_sched_barrier(0);
    }
    return fmaxf(ta, tb);
}
__device__ __forceinline__ void ph_attn_mfma(unsigned char* lds_, const bf16_t* Q, const bf16_t* Kb, const bf16_t* Vb, bf16_t* Z, int with_ctx, int u0, int ustep) { PH_IDS;
    using namespace fa;
    LAS char* sm = (LAS char*)lds_;
    const int lane = tid_ & 63, wid = __builtin_amdgcn_readfirstlane(tid_ >> 6), r32 = lane & 31, hi = lane >> 5;
    const int nunits = 256 + (with_ctx ? 32 : 0);
    const int koff0 = (tid_ / 12) * KP_A + (tid_ % 12) * 16, koff1 = ((tid_ + 512) / 12) * KP_A + ((tid_ + 512) % 12) * 16;
    const int voff = KT_A + ((tid_ & 7) >> 2) * 4096 + (tid_ >> 3) * 64 + (tid_ & 3) * 16;
    const int vrd = KT_A + ((lane >> 4) & 1) * 32 + (lane & 3) * 8 + (4 * hi + ((lane & 15) >> 2)) * 64;
    for (int u = u0; u < nunits; u += ustep) {
        const bool lat = u < 256; const int bh = lat ? (u >> 3) : (u - 256), qb = lat ? (u & 7) : 8;
        const int ntile = lat ? 36 : 4;
        const char* Kg = (const char*)(Kb + (size_t)bh * 2304 * 96); const char* Vg = (const char*)(Vb + (size_t)bh * 2304 * 64);
        const bf16_t* Qg = Q + ((size_t)bh * 2304 + qb * 256 + wid * 32 + r32) * 96;
        bf16x8 qf[6];
#pragma unroll
        for (int st = 0; st < 6; ++st) qf[st] = *(const bf16x8*)(Qg + 16 * st + 8 * hi);
        f32x16 o0, o1;
#pragma unroll
        for (int r = 0; r < 16; ++r) { o0[r] = 0.f; o1[r] = 0.f; }
        float mrun = 0.f, lsum = 0.f;
        f32x16 negm;
#pragma unroll
        for (int r = 0; r < 16; ++r) negm[r] = 0.f;
        u32x4 ka0, ka1, va, kb0, kb1, vb;
#define ATT_LOAD(k0_, k1_, v_, tt) do { const char* kg_ = Kg + (size_t)(tt) * 12288; const char* vg_ = Vg + (size_t)(tt) * 8192; \
            k0_ = *(const u32x4*)(kg_ + tid_ * 16); if (tid_ < 256) k1_ = *(const u32x4*)(kg_ + (tid_ + 512) * 16); v_ = *(const u32x4*)(vg_ + tid_ * 16); } while (0)
#define ATT_WRITE(k0_, k1_, v_, bo) do { *(LAS u32x4*)(sm + (bo) + koff0) = k0_; if (tid_ < 256) *(LAS u32x4*)(sm + (bo) + koff1) = k1_; *(LAS u32x4*)(sm + (bo) + voff) = v_; } while (0)
        ka1 = (u32x4){0u, 0u, 0u, 0u}; kb1 = ka1;
        const int npair = ntile >> 1;
        ATT_LOAD(ka0, ka1, va, 0); ATT_LOAD(kb0, kb1, vb, 1);
        __syncthreads();
        ATT_WRITE(ka0, ka1, va, 0); ATT_WRITE(kb0, kb1, vb, BUF_A);
        if (npair > 1) { ATT_LOAD(ka0, ka1, va, 2); ATT_LOAD(kb0, kb1, vb, 3); }
        __syncthreads();
        f32x16 a0, a1, b0, b1;
#pragma unroll
        for (int r = 0; r < 16; ++r) { a0[r] = 0.f; a1[r] = 0.f; }
        { const LAS char* kq0 = sm + r32 * KP_A + 16 * hi;
#pragma unroll
          for (int st = 0; st < 6; ++st) { const bf16x8 k0 = *(const LAS bf16x8*)(kq0 + 32 * st), k1 = *(const LAS bf16x8*)(kq0 + 32 * KP_A + 32 * st);
              a0 = __builtin_amdgcn_mfma_f32_32x32x16_bf16(k0, qf[st], a0, 0, 0, 0); a1 = __builtin_amdgcn_mfma_f32_32x32x16_bf16(k1, qf[st], a1, 0, 0, 0); } }
        float tmA = att_max(a0, a1);
        int cur = 0;
        for (int p = 0; p < npair; ++p) {
            const int nxt = cur == 4 * BUF_A ? 0 : cur + 2 * BUF_A;
            const bool more = p + 1 < npair;
            if (more) { ATT_WRITE(ka0, ka1, va, nxt); ATT_WRITE(kb0, kb1, vb, nxt + BUF_A); }
            if (p + 2 < npair) { ATT_LOAD(ka0, ka1, va, 2 * p + 4); ATT_LOAD(kb0, kb1, vb, 2 * p + 5); }
            bf16x8 pf[4];
            att_shift(tmA, p == 0, mrun, lsum, o0, o1);
            att_qk_exp(sm + cur + BUF_A + r32 * KP_A + 16 * hi, qf, -mrun, b0, b1, a0, a1, lsum, pf);
            const float tmB = att_pv_max(o0, o1, sm + cur + vrd, pf, b0, b1);
            att_shift(tmB, false, mrun, lsum, o0, o1);
            __syncthreads();
            if (more) {
                att_qk_exp(sm + nxt + r32 * KP_A + 16 * hi, qf, -mrun, a0, a1, b0, b1, lsum, pf);
                tmA = att_pv_max(o0, o1, sm + cur + BUF_A + vrd, pf, a0, a1);
            } else {
                att_exp_pack(b0, b1, -mrun, lsum, pf);
                pv_tile(o0, o1, sm + cur + BUF_A + vrd, pf);
            }
            cur = nxt;
        }
#undef ATT_LOAD
#undef ATT_WRITE
        lsum += __shfl_xor(lsum, 32);
        const float inv = 1.f / lsum;
        const int b = bh >> 2, h = bh & 3;
        const int row = (lat ? b * 2048 + qb * 256 : RL + b * 256) + wid * 32 + r32;
        bf16_t* op = Z + (size_t)row * ZW + C_QC + h * 64 + 4 * hi;
#pragma unroll
        for (int g = 0; g < 4; ++g) {
            u32x2 w0, w1; w0.x = pk2(o0[4 * g] * inv, o0[4 * g + 1] * inv); w0.y = pk2(o0[4 * g + 2] * inv, o0[4 * g + 3] * inv);
            w1.x = pk2(o1[4 * g] * inv, o1[4 * g + 1] * inv); w1.y = pk2(o1[4 * g + 2] * inv, o1[4 * g + 3] * inv);
            *(u32x2*)(op + 8 * g) = w0; *(u32x2*)(op + 32 + 8 * g) = w1;
        }
    }
    __syncthreads();
}

__device__ __forceinline__ void ret_tile(const LAS char* sm, int r32, int hi, int vrd, int buf, int kp0, int qw0, int qpos, float lgf, float lgb, float cf32, float cb32,
                                         const float (&ckf)[16], const float (&ckb)[16], const bf16x8 (&qf)[4], fa::f32x16& o0, fa::f32x16& o1) {
    using namespace fa;
    const LAS char* kb = sm + buf + r32 * KP_R + 16 * hi;
    f32x16 p0, p1;
#pragma unroll
    for (int r = 0; r < 16; ++r) { p0[r] = 0.f; p1[r] = 0.f; }
#pragma unroll
    for (int st = 0; st < 4; ++st) {
        const bf16x8 k0 = *(const LAS bf16x8*)(kb + 32 * st), k1 = *(const LAS bf16x8*)(kb + 32 * KP_R + 32 * st);
        p0 = __builtin_amdgcn_mfma_f32_32x32x16_bf16(k0, qf[st], p0, 0, 0, 0);
        p1 = __builtin_amdgcn_mfma_f32_32x32x16_bf16(k1, qf[st], p1, 0, 0, 0);
    }
    if (kp0 + 63 < qw0) {
        const float sq = __builtin_amdgcn_exp2f(lgf * (float)(qpos - kp0)), sq1 = sq * cf32;
#pragma unroll
        for (int r = 0; r < 16; ++r) { p0[r] = p0[r] * ckf[r] * sq; p1[r] = p1[r] * ckf[r] * sq1; }
    } else if (kp0 > qw0 + 31) {
        const float sq = __builtin_amdgcn_exp2f(lgb * (float)(kp0 - qpos)), sq1 = sq * cb32;
#pragma unroll
        for (int r = 0; r < 16; ++r) { p0[r] = p0[r] * ckb[r] * sq; p1[r] = p1[r] * ckb[r] * sq1; }
    } else {
        const int d0 = qpos - kp0 - 4 * hi;
#pragma unroll
        for (int r = 0; r < 16; ++r) {
            const float f0 = (float)(d0 - ((r & 3) + 8 * (r >> 2))), f1 = f0 - 32.f;
            const float w0 = __builtin_amdgcn_exp2f(lgf * fmaxf(f0, 0.f) + lgb * fmaxf(-f0, 0.f)) * (2.f - fminf(fabsf(f0), 1.f));
            const float w1 = __builtin_amdgcn_exp2f(lgf * fmaxf(f1, 0.f) + lgb * fmaxf(-f1, 0.f)) * (2.f - fminf(fabsf(f1), 1.f));
            p0[r] *= w0; p1[r] *= w1;
        }
    }
    bf16x8 pf[4]; pf[0] = pack_p(p0, 0); pf[1] = pack_p(p0, 8); pf[2] = pack_p(p1, 0); pf[3] = pack_p(p1, 8);
    pv_tile(o0, o1, sm + buf + vrd, pf);
}
__device__ __forceinline__ void ret_qk(const LAS char* sm, int r32, int hi, int buf, const bf16x8 (&qf)[4], fa::f32x16& p0, fa::f32x16& p1) {
    const LAS char* kb = sm + buf + r32 * fa::KP_R + 16 * hi;
#pragma unroll
    for (int r = 0; r < 16; ++r) { p0[r] = 0.f; p1[r] = 0.f; }
#pragma unroll
    for (int st = 0; st < 4; ++st) {
        const bf16x8 k0 = *(const LAS bf16x8*)(kb + 32 * st), k1 = *(const LAS bf16x8*)(kb + 32 * fa::KP_R + 32 * st);
        p0 = __builtin_amdgcn_mfma_f32_32x32x16_bf16(k0, qf[st], p0, 0, 0, 0);
        p1 = __builtin_amdgcn_mfma_f32_32x32x16_bf16(k1, qf[st], p1, 0, 0, 0);
    }
}
__device__ __forceinline__ void ret_tile_gen(const LAS char* sm, int r32, int hi, int vrd, int buf, int kp0, int qpos, float lgf, float lgb, const bf16x8 (&qf)[4], fa::f32x16& o0, fa::f32x16& o1) {
    using namespace fa;
    const LAS char* kb = sm + buf + r32 * KP_R + 16 * hi;
    f32x16 p0, p1;
#pragma unroll
    for (int r = 0; r < 16; ++r) { p0[r] = 0.f; p1[r] = 0.f; }
#pragma unroll
    for (int st = 0; st < 4; ++st) {
        const bf16x8 k0 = *(const LAS bf16x8*)(kb + 32 * st), k1 = *(const LAS bf16x8*)(kb + 32 * KP_R + 32 * st);
        p0 = __builtin_amdgcn_mfma_f32_32x32x16_bf16(k0, qf[st], p0, 0, 0, 0);
        p1 = __builtin_amdgcn_mfma_f32_32x32x16_bf16(k1, qf[st], p1, 0, 0, 0);
    }
    int d0 = qpos - kp0 - 4 * hi;
    asm volatile("" : "+v"(d0) : "v"(p0[15]), "v"(p1[15]));
#pragma unroll
    for (int r = 0; r < 16; ++r) {
        const float f0 = (float)(d0 - ((r & 3) + 8 * (r >> 2))), f1 = f0 - 32.f;
        const float w0 = __builtin_amdgcn_exp2f(lgf * fmaxf(f0, 0.f) + lgb * fmaxf(-f0, 0.f)) * (2.f - fminf(fabsf(f0), 1.f));
        const float w1 = __builtin_amdgcn_exp2f(lgf * fmaxf(f1, 0.f) + lgb * fmaxf(-f1, 0.f)) * (2.f - fminf(fabsf(f1), 1.f));
        p0[r] *= w0; p1[r] *= w1;
    }
    bf16x8 pf[4]; pf[0] = pack_p(p0, 0); pf[1] = pack_p(p0, 8); pf[2] = pack_p(p1, 0); pf[3] = pack_p(p1, 8);
    pv_tile(o0, o1, sm + buf + vrd, pf);
}
__device__ __forceinline__ void ph_ret_kv(unsigned char* lds_, const bf16_t* Z, const float* decay_logit, bf16_t* KVF, bf16_t* KVB, int vb, int vg) { PH_IDS;
    using namespace fa;
    LAS char* sm = (LAS char*)lds_;
    const int lane = tid_ & 63, wid = __builtin_amdgcn_readfirstlane(tid_ >> 6), r32 = lane & 31, hi = lane >> 5;
    const int vrd = ((lane >> 4) & 1) * 32 + (lane & 3) * 8 + (4 * hi + ((lane & 15) >> 2)) * 64;
    u32x4 pk[2], pv[2];
#define KV_ISSUE(uu) do { const int bh_ = (uu) / 18, ci_ = (uu) % 18, b_ = bh_ >> 2, h_ = bh_ & 3; const int r0_ = ci_ < 2 ? RL + b_ * 256 + 128 * ci_ : b_ * 2048 + 128 * (ci_ - 2); \
        _Pragma("unroll") for (int i = 0; i < 2; ++i) { const int p = tid_ + NT * i; const bf16_t* zr = Z + (size_t)(r0_ + (p >> 3)) * ZW + h_ * 64 + (p & 7) * 8; pk[i] = *(const u32x4*)(zr + C_RK); pv[i] = *(const u32x4*)(zr + C_RV); } } while (0)
    if (vb >= 0 && vb < 32 * 18) KV_ISSUE(vb);
    for (int u = vb >= 0 ? vb : 32 * 18; u < 32 * 18; u += vg) {
        const int bh = u / 18, h = bh & 3;
        const float lgf = -log1pf(__expf(-decay_logit[h])) * 1.4426950408889634f, lgb = -log1pf(__expf(-decay_logit[4 + h])) * 1.4426950408889634f;
        __syncthreads();
#pragma unroll
        for (int i = 0; i < 2; ++i) {
            const int p = tid_ + NT * i, row = p >> 3, c = p & 7, tile = row >> 6, key = row & 63;
            const int off = tile * 8192 + (c >> 2) * 4096 + key * 64 + (c & 3) * 16;
            *(LAS u32x4*)(sm + off) = pk[i];
            f32x4 va, vb; unpack8(pv[i], va, vb);
            const float wf = __builtin_amdgcn_exp2f(lgf * (float)(127 - row)), wb = __builtin_amdgcn_exp2f(lgb * (float)row);
            *(LAS u32x4*)(sm + 16384 + off) = pack8(va * wf, vb * wf);
            *(LAS u32x4*)(sm + 32768 + off) = pack8(va * wb, vb * wb);
        }
        if (u + vg < 32 * 18) KV_ISSUE(u + vg);
        __syncthreads();
        const int dir = wid >> 2, bd = (wid >> 1) & 1, be = wid & 1;
        f32x16 acc;
#pragma unroll
        for (int r = 0; r < 16; ++r) acc[r] = 0.f;
        const LAS char* ka = sm + bd * 4096 + vrd; const LAS char* vv = sm + 16384 + dir * 16384 + be * 4096 + vrd;
#pragma unroll
        for (int tile = 0; tile < 2; ++tile)
#pragma unroll
            for (int ks = 0; ks < 4; ++ks) {
                const s16x4 a0 = vtr(ka + tile * 8192 + ks * 1024), a1 = vtr(ka + tile * 8192 + ks * 1024 + 512), b0 = vtr(vv + tile * 8192 + ks * 1024), b1 = vtr(vv + tile * 8192 + ks * 1024 + 512);
                acc = __builtin_amdgcn_mfma_f32_32x32x16_bf16((bf16x8){a0[0], a0[1], a0[2], a0[3], a1[0], a1[1], a1[2], a1[3]}, (bf16x8){b0[0], b0[1], b0[2], b0[3], b1[0], b1[1], b1[2], b1[3]}, acc, 0, 0, 0);
            }
        bf16_t* o = (dir ? KVB : KVF) + ((size_t)u * 64 + be * 32 + r32) * 64 + bd * 32 + 4 * hi;
#pragma unroll
        for (int g = 0; g < 4; ++g) { u32x2 w; w.x = pk2n(acc[4 * g], acc[4 * g + 1]); w.y = pk2n(acc[4 * g + 2], acc[4 * g + 3]); *(u32x2*)(o + 8 * g) = w; }
    }
    __syncthreads();
}
#undef KV_ISSUE
__device__ __forceinline__ void ph_ret_chunk(unsigned char* lds_, bf16_t* Z, const bf16_t* KVF, const bf16_t* KVB, const float* decay_logit, const float* gn_w, int with_ctx, int u0, int ustep, unsigned* kvc, unsigned* barw) { PH_IDS;
    using namespace fa;
    LAS char* sm = (LAS char*)lds_;
    constexpr int ST_OFF = 4 * BUF_R, ST_SZ = 64 * KP_R;
    const int lane = tid_ & 63, wid = __builtin_amdgcn_readfirstlane(tid_ >> 6), r32 = lane & 31, hi = lane >> 5;
    const int nunits = 256 + (with_ctx ? 32 : 0);
    const int prow = tid_ >> 3, pc = tid_ & 7;
    const int koff = prow * KP_R + pc * 16;
    const int voff = KT_R + (pc >> 2) * 4096 + prow * 64 + (pc & 3) * 16;
    const int vrd = KT_R + ((lane >> 4) & 1) * 32 + (lane & 3) * 8 + (4 * hi + ((lane & 15) >> 2)) * 64;
    for (int u = u0; u < nunits; u += ustep) {
        const bool lat = u < 256; const int bh = lat ? (u >> 3) : (u - 256), qb = lat ? (u & 7) : 0, b = bh >> 2, h = bh & 3;
        const float lgf = -log1pf(__expf(-decay_logit[h])) * 1.4426950408889634f, lgb = -log1pf(__expf(-decay_logit[4 + h])) * 1.4426950408889634f;
        const int qw0 = qb * 256 + wid * 32, qpos = qw0 + r32;
        const int qrow = (lat ? b * 2048 : RL + b * 256) + qpos;
        bf16_t* zq = Z + (size_t)qrow * ZW;
        u32x4 sK[4], sV[4]; bf16x8 qf[4];
        { const size_t rb = (lat ? (size_t)b * 2048 + qb * 256 : (size_t)RL + b * 256);
#pragma unroll
          for (int j = 0; j < 4; ++j) { const bf16_t* zr = Z + (rb + 64 * j + prow) * ZW + h * 64 + pc * 8; sK[j] = *(const u32x4*)(zr + C_RK); sV[j] = *(const u32x4*)(zr + C_RV); } }
#pragma unroll
        for (int st = 0; st < 4; ++st) qf[st] = *(const bf16x8*)(zq + C_RQ + h * 64 + 16 * st + 8 * hi);
        if (kvc != nullptr && tid_ == 0) dep_spin(kvc, (unsigned)G_, barw);
        __syncthreads();
#pragma unroll
        for (int j = 0; j < 4; ++j) { *(LAS u32x4*)(sm + j * BUF_R + koff) = sK[j]; *(LAS u32x4*)(sm + j * BUF_R + voff) = sV[j]; }
        {
            const float g128f = __builtin_amdgcn_exp2f(lgf * 128.f), g128b = __builtin_amdgcn_exp2f(lgb * 128.f);
            const bf16_t* kf = KVF + (size_t)bh * 18 * 4096 + tid_ * 8; const bf16_t* kb = KVB + (size_t)bh * 18 * 4096 + tid_ * 8;
            LAS char* sto = sm + ST_OFF + (tid_ >> 3) * KP_R + (tid_ & 7) * 16;
            f32x4 sa = (f32x4){0.f, 0.f, 0.f, 0.f}, sb = sa, ta, tb;
#define ST_PUT(k) (*(LAS u32x4*)(sto + (k) * ST_SZ) = pack8(sa, sb))
#define ST_STEP(ptr, ci_, g_) do { unpack8(*(const u32x4*)((ptr) + (size_t)(ci_) * 4096), ta, tb); sa = sa * (g_) + ta; sb = sb * (g_) + tb; } while (0)
            if (lat) {
                const int cA = 2 * qb, n1 = 2 + cA, nb = 16 - cA;
                u32x4 Lq[9], Lr[9]; f32x4 sc = (f32x4){0.f, 0.f, 0.f, 0.f}, sd = sc;
#define ST_PUTB(k) (*(LAS u32x4*)(sto + (k) * ST_SZ) = pack8(sc, sd))
#pragma unroll
                for (int hf = 0; hf < 2; ++hf) {
#pragma unroll
                    for (int k = 0; k < 9; ++k) { const int kk = 9 * hf + k;
                        if (kk <= n1 && kk < 17) Lq[k] = *(const u32x4*)(kf + (size_t)kk * 4096);
                        if (kk <= nb && kk < 17) Lr[k] = *(const u32x4*)(kb + (size_t)(kk == 0 ? 1 : (kk == 1 ? 0 : 19 - kk)) * 4096); }
#pragma unroll
                    for (int k = 0; k < 9; ++k) { const int kk = 9 * hf + k;
                        if (kk == n1) ST_PUT(0); if (kk <= n1 && kk < 17) { unpack8(Lq[k], ta, tb); sa = sa * g128f + ta; sb = sb * g128f + tb; }
                        if (kk == nb) ST_PUTB(3); if (kk <= nb && kk < 17) { unpack8(Lr[k], ta, tb); sc = sc * g128b + ta; sd = sd * g128b + tb; } }
                    asm volatile("" ::: "memory"); }
                ST_PUT(1); ST_PUTB(2);
#undef ST_PUTB
            } else {
                ST_PUT(0); ST_PUT(3);
                ST_STEP(kf, 0, g128f); ST_PUT(1);
                sa = (f32x4){0.f, 0.f, 0.f, 0.f}; sb = sa; ST_STEP(kb, 1, g128b); ST_PUT(2);
            }
#undef ST_PUT
#undef ST_STEP
        }
        __syncthreads();
        u32x2 gtv[8]; f32x4 gwv[8];
#pragma unroll
        for (int g = 0; g < 4; ++g)
#pragma unroll
            for (int blk = 0; blk < 2; ++blk) { const int d = blk * 32 + 8 * g + 4 * hi; gtv[2 * g + blk] = *(const u32x2*)(zq + C_RG + h * 64 + d); gwv[2 * g + blk] = *(const f32x4*)(gn_w + h * 64 + d); }
        f32x16 o0, o1;
#pragma unroll
        for (int r = 0; r < 16; ++r) { o0[r] = 0.f; o1[r] = 0.f; }
        const int cl = wid >> 2, c0 = qb * 256 + 128 * cl;
        ret_tile_gen(sm, r32, hi, vrd, (2 * cl) * BUF_R, c0, qpos, lgf, lgb, qf, o0, o1);
        __builtin_amdgcn_sched_barrier(0);
        ret_tile_gen(sm, r32, hi, vrd, (2 * cl + 1) * BUF_R, c0 + 64, qpos, lgf, lgb, qf, o0, o1);
        __builtin_amdgcn_sched_barrier(0);
        { f32x16 p0, p1;
          ret_qk(sm, r32, hi, ST_OFF + cl * ST_SZ, qf, p0, p1);
          const float sf = __builtin_amdgcn_exp2f(lgf * (float)(qpos - c0 + 1));
#pragma unroll
          for (int r = 0; r < 16; ++r) { o0[r] += p0[r] * sf; o1[r] += p1[r] * sf; }
          ret_qk(sm, r32, hi, ST_OFF + (2 + cl) * ST_SZ, qf, p0, p1);
          const float sbk = __builtin_amdgcn_exp2f(lgb * (float)(c0 + 128 - qpos));
#pragma unroll
          for (int r = 0; r < 16; ++r) { o0[r] += p0[r] * sbk; o1[r] += p1[r] * sbk; } }
        float s1 = 0.f;
#pragma unroll
        for (int r = 0; r < 16; ++r) s1 += o0[r] + o1[r];
        s1 += __shfl_xor(s1, 32);
        const float mu = s1 * (1.f / 64);
        float s2 = 0.f;
#pragma unroll
        for (int r = 0; r < 16; ++r) { const float a = o0[r] - mu, c = o1[r] - mu; s2 += a * a + c * c; }
        s2 += __shfl_xor(s2, 32);
        const float rstd = rsqrtf(s2 * (1.f / 64) + EPS);
#pragma unroll
        for (int g = 0; g < 4; ++g)
#pragma unroll
            for (int blk = 0; blk < 2; ++blk) {
                const int d = blk * 32 + 8 * g + 4 * hi;
                const u32x2 gt = gtv[2 * g + blk];
                const f32x4 gw = gwv[2 * g + blk];
                float y[4];
#pragma unroll
                for (int q = 0; q < 4; ++q) { const float ov = blk ? o1[4 * g + q] : o0[4 * g + q]; const unsigned gb = q < 2 ? gt.x : gt.y; const float gv = __uint_as_float((q & 1) ? (gb & 0xffff0000u) : (gb << 16));
                    y[q] = siluf_(gv) * ((ov - mu) * rstd * gw[q]); }
                u32x2 w; w.x = pk2(y[0], y[1]); w.y = pk2(y[2], y[3]);
                *(u32x2*)(zq + C_RQ + h * 64 + d) = w;
            }
    }
    __syncthreads();
}

__device__ __forceinline__ void ph_ret_mfma(unsigned char* lds_, bf16_t* Z, const float* decay_logit, const float* gn_w, int with_ctx, int u0, int ustep) { PH_IDS;
    using namespace fa;
    LAS char* sm = (LAS char*)lds_;
    const int lane = tid_ & 63, wid = __builtin_amdgcn_readfirstlane(tid_ >> 6), r32 = lane & 31, hi = lane >> 5;
    const int nunits = 256 + (with_ctx ? 32 : 0);
    const int prow = tid_ >> 3, pc = tid_ & 7;
    const int koff = prow * KP_R + pc * 16;
    const int voff = KT_R + (pc >> 2) * 4096 + prow * 64 + (pc & 3) * 16;
    const int vrd = KT_R + ((lane >> 4) & 1) * 32 + (lane & 3) * 8 + (4 * hi + ((lane & 15) >> 2)) * 64;
    for (int u = u0; u < nunits; u += ustep) {
        const bool lat = u < 256; const int bh = lat ? (u >> 3) : (u - 256), qb = lat ? (u & 7) : 0, b = bh >> 2, h = bh & 3;
        const int ntile = lat ? 40 : 4;
        const float lgf = -log1pf(__expf(-decay_logit[h])) * 1.4426950408889634f, lgb = -log1pf(__expf(-decay_logit[4 + h])) * 1.4426950408889634f;
        const int qw0 = qb * 256 + wid * 32, qpos = qw0 + r32;
        const int qrow = (lat ? b * 2048 : RL + b * 256) + qpos;
        float ckf[16], ckb[16];
#pragma unroll
        for (int r = 0; r < 16; ++r) { const float off = (float)crow(r, hi); ckf[r] = __builtin_amdgcn_exp2f(-lgf * off); ckb[r] = __builtin_amdgcn_exp2f(lgb * off); }
        const float cf32 = __builtin_amdgcn_exp2f(-lgf * 32.f), cb32 = __builtin_amdgcn_exp2f(lgb * 32.f);
        bf16_t* zq = Z + (size_t)qrow * ZW;
        bf16x8 qf[4];
#pragma unroll
        for (int st = 0; st < 4; ++st) qf[st] = *(const bf16x8*)(zq + C_RQ + h * 64 + 16 * st + 8 * hi);
        f32x16 o0, o1;
#pragma unroll
        for (int r = 0; r < 16; ++r) { o0[r] = 0.f; o1[r] = 0.f; }
        const int ctx0 = RL + b * 256, lat0 = b * 2048;
#define RET_TILE_ROW(t) (lat ? ((t) < 4 ? ctx0 + 64 * (t) : ((t) < 36 ? lat0 + 64 * ((t) - 4) : ctx0 + 64 * ((t) - 36))) : ctx0 + 64 * (t))
#define RET_TILE_POS(t) (lat ? 64 * (t) - 256 : 64 * (t))
        u32x4 ka, va, kb2, vb2;
#define RET_LOAD(k_, v_, tt) do { const bf16_t* zr_ = Z + (size_t)(RET_TILE_ROW(tt) + prow) * ZW + h * 64 + pc * 8; k_ = *(const u32x4*)(zr_ + C_RK); v_ = *(const u32x4*)(zr_ + C_RV); } while (0)
#define RET_WRITE(k_, v_, bo) do { *(LAS u32x4*)(sm + (bo) + koff) = k_; *(LAS u32x4*)(sm + (bo) + voff) = v_; } while (0)
        RET_LOAD(ka, va, 0); RET_LOAD(kb2, vb2, 1);
        __syncthreads();
        RET_WRITE(ka, va, 0); RET_WRITE(kb2, vb2, BUF_R);
        __syncthreads();
        for (int t = 0; t < ntile; t += 2) {
            const int pb = (t & 2) * BUF_R, nb = 2 * BUF_R - pb;
            if (t + 2 < ntile) { RET_LOAD(ka, va, t + 2); RET_LOAD(kb2, vb2, t + 3); }
            ret_tile(sm, r32, hi, vrd, pb, RET_TILE_POS(t), qw0, qpos, lgf, lgb, cf32, cb32, ckf, ckb, qf, o0, o1);
            ret_tile(sm, r32, hi, vrd, pb + BUF_R, RET_TILE_POS(t + 1), qw0, qpos, lgf, lgb, cf32, cb32, ckf, ckb, qf, o0, o1);
            if (t + 2 < ntile) { RET_WRITE(ka, va, nb); RET_WRITE(kb2, vb2, nb + BUF_R); }
            __syncthreads();
        }
#undef RET_LOAD
#undef RET_WRITE
#undef RET_TILE_ROW
#undef RET_TILE_POS
        float s1 = 0.f;
#pragma unroll
        for (int r = 0; r < 16; ++r) s1 += o0[r] + o1[r];
        s1 += __shfl_xor(s1, 32);
        const float mu = s1 * (1.f / 64);
        float s2 = 0.f;
#pragma unroll
        for (int r = 0; r < 16; ++r) { const float a = o0[r] - mu, c = o1[r] - mu; s2 += a * a + c * c; }
        s2 += __shfl_xor(s2, 32);
        const float rstd = rsqrtf(s2 * (1.f / 64) + EPS);
#pragma unroll
        for (int g = 0; g < 4; ++g)
#pragma unroll
            for (int blk = 0; blk < 2; ++blk) {
                const int d = blk * 32 + 8 * g + 4 * hi;
                const u32x2 gt = *(const u32x2*)(zq + C_RG + h * 64 + d);
                const f32x4 gw = *(const f32x4*)(gn_w + h * 64 + d);
                float y[4];
#pragma unroll
                for (int q = 0; q < 4; ++q) { const float ov = blk ? o1[4 * g + q] : o0[4 * g + q]; const unsigned gb = q < 2 ? gt.x : gt.y; const float gv = __uint_as_float((q & 1) ? (gb & 0xffff0000u) : (gb << 16));
                    y[q] = siluf_(gv) * ((ov - mu) * rstd * gw[q]); }
                u32x2 w; w.x = pk2(y[0], y[1]); w.y = pk2(y[2], y[3]);
                *(u32x2*)(zq + C_RQ + h * 64 + d) = w;
            }
    }
    __syncthreads();
}

struct SchedGrid {
    const char* A; const char* B; unsigned lda, ldb; int nt, nM, nN, G, c, kind, aux;
    __device__ __forceinline__ bool next(int i, pg8::Unit& u) const {
        int pm, pn; if (!pg8::static_tile(nM, nN, G, c, i, pm, pn)) return false;
        u.A = A + (size_t)pm * 256 * lda; u.B = B + (size_t)pn * 256 * ldb; u.lda = lda; u.ldb = ldb; u.nt = nt; u.pm = pm; u.pn = pn; u.kind = kind; u.aux = aux; return true; }
};
struct SchedP1 {
    const char* A; const char* B; int G, c, last;
    __device__ __forceinline__ bool next(int i, pg8::Unit& u) const {
        int pm, pn;
        if (!last) { if (!pg8::static_tile(RT / 256, 8, G, c, i, pm, pn)) return false; }
        else { if (!pg8::static_tile(RL / 256, 8, G, c, i, pm, pn)) { const int j = i * G + c - (RL / 256) * 8; if (j < 0 || j >= 32) return false; pm = RL / 256 + (j >> 2); pn = j & 3; } }
        u.A = A + (size_t)pm * 256 * 2048; u.B = B + (size_t)pn * 256 * 2048; u.lda = 2048; u.ldb = 2048; u.nt = 16; u.pm = pm; u.pn = pn; u.kind = 0; u.aux = 0; return true; }
};
struct SchedMerge {
    const char* Z; const char* XN; const char* WBR; const char* WING; const char* OC; int njobs, G, vcu, nmini;
    __device__ __forceinline__ bool next(int i, pg8::Unit& u) const {
        int sub, n, pm, pn, part = 0;
        if (nmini > 0 && i >= 8) { if (i >= 10 || vcu >= nmini) return false; sub = i & 1; n = vcu & 3; pn = (vcu >> 2) & 3; pm = RL / 256 + (vcu >> 4); part = 1; }
        else { const int job = (i >> 3) * G + vcu; if (job >= njobs) return false; sub = i & 7; n = sub >> 1; pm = job >> 2; pn = job & 3; }
        u.pm = pm; u.pn = pn; u.aux = n;
        if (!(sub & 1)) { const int bcol = n == 0 ? C_QC : (n == 1 ? C_FU : C_RQ);
            if (n == 2) { u.A = OC + (size_t)pm * 256 * 512; u.lda = 512; } else { u.A = Z + ((size_t)pm * 256 * ZW + bcol) * 2; u.lda = ZW * 2; } u.B = WBR + ((size_t)n * 1024 + pn * 256) * 512; u.ldb = 512; u.nt = 4; u.kind = 0; }
        else { u.A = XN + (size_t)pm * 256 * 2048; u.lda = 2048; u.B = WING + ((size_t)n * 1024 + pn * 256) * 2048; u.ldb = 2048; u.nt = 16; u.kind = part ? 2 : 1; }
        return true; }
};
struct SchedFfnDown {
    const char* H; const char* W2; int G, c, nctx;
    __device__ __forceinline__ bool next(int i, pg8::Unit& u) const {
        int pm, pn;
        if (pg8::static_tile(RL / 256, 4, G, c, i, pm, pn)) { u.A = H + (size_t)pm * 256 * 8192; u.B = W2 + (size_t)pn * 256 * 8192; u.lda = 8192; u.ldb = 8192; u.nt = 64; u.pm = pm; u.pn = pn; u.kind = 0; u.aux = 0; return true; }
        const int j = i * G + c - (RL / 256) * 4; if (j < 0 || j >= nctx) return false;
        pm = RL / 256 + (j >> 4); pn = (j >> 2) & 3; const int kq = j & 3;
        u.A = H + (size_t)pm * 256 * 8192 + kq * 2048; u.B = W2 + (size_t)pn * 256 * 8192 + kq * 2048; u.lda = 8192; u.ldb = 8192; u.nt = 16; u.pm = pm; u.pn = pn; u.kind = 3; u.aux = kq; return true; }
};
#define EPI_FOREACH(...) _Pragma("unroll") for (int ai = 0; ai < 2; ++ai) _Pragma("unroll") for (int m = 0; m < 4; ++m) _Pragma("unroll") for (int bj = 0; bj < 2; ++bj) { \
        const int row = u.pm * 256 + ai * 128 + wr * 64 + m * 16 + fr, col = u.pn * 256 + bj * 128 + wc * 32 + 8 * fq; const f32x4 v0 = acc[ai][bj][m][0], v1 = acc[ai][bj][m][1]; (void)row; (void)col; __VA_ARGS__ }
struct EpiStore { static constexpr bool PRE = false;
    bf16_t* O; int ld; int act;
    __device__ __forceinline__ void operator()(const f32x4 (&acc)[2][2][4][2], const pg8::Unit& u, int wr, int wc, int fr, int fq) const {
        EPI_FOREACH( f32x4 a = v0, b = v1; if (act == 1) { _Pragma("unroll") for (int q = 0; q < 4; ++q) { const float ra = fmaxf(a[q], 0.f), rb = fmaxf(b[q], 0.f); a[q] = ra * ra; b[q] = rb * rb; } }
            *(pg8::u32x4*)(O + (size_t)row * ld + col) = pack8(a, b); )
    }
};
struct EpiFfnUp {
    static constexpr bool PRE = true;
    bf16_t* O; const float* ss; const float* cf; LAS float* red;
    __device__ __forceinline__ void pre_issue(const pg8::Unit& u, int tid, f32x4& v) const {
        if (tid < 256) v = *(const f32x4*)(ss + ((size_t)u.pm * 256 + tid) * 4);
        else v[0] = cf[(size_t)(u.pm < 64 ? (u.pm >> 3) : 8) * DFF + u.pn * 256 + (tid - 256)]; }
    __device__ __forceinline__ void pre_commit(int tid, int par, const f32x4& v) const {
        red[par * 512 + tid] = tid < 256 ? rsqrtf((v[0] + v[1] + v[2] + v[3]) * (1.f / DM) + EPS) : v[0]; }
    __device__ __forceinline__ void operator()(const f32x4 (&acc)[2][2][4][2], const pg8::Unit& u, int wr, int wc, int fr, int fq, int par) const {
        const LAS float* rp = red + par * 512 + wr * 64 + fr; const LAS float* cp = rp - (wr * 64 + fr) + 256 + wc * 32 + 8 * fq;
        EPI_FOREACH( const f32x4 c0 = *(const LAS f32x4*)(cp + bj * 128), c1 = *(const LAS f32x4*)(cp + bj * 128 + 4); const float r = rp[ai * 128 + m * 16]; f32x4 a, b;
            _Pragma("unroll") for (int q = 0; q < 4; ++q) { const float ra = fmaxf(v0[q] * r + c0[q], 0.f), rb = fmaxf(v1[q] * r + c1[q], 0.f); a[q] = ra * ra; b[q] = rb * rb; }
            *(pg8::u32x4*)(O + (size_t)row * DFF + col) = pack8(a, b); )
    }
};
template <int T> __device__ __forceinline__ void ld8(const void* base, size_t o, f32x4& a, f32x4& b) {
    if constexpr (T == 0) { const float* p = (const float*)base + o; a = *(const f32x4*)p; b = *(const f32x4*)(p + 4); } else unpack8(*(const pg8::u32x4*)((const bf16_t*)base + o), a, b); }
template <int T> __device__ __forceinline__ void st8(void* base, size_t o, const f32x4 a, const f32x4 b) {
    if constexpr (T == 0) { float* p = (float*)base + o; *(f32x4*)p = a; *(f32x4*)(p + 4) = b; } else *(pg8::u32x4*)((bf16_t*)base + o) = pack8(a, b); }
template <int XIN, int XOUT>
struct EpiResid { static constexpr bool PRE = false;
    const void* xlat; const void* xctx; void* olat; void* octx; const float* mod; int gch; float* part;
    bf16_t* an; const float* wmf; float* ss; LAS float* red;
    __device__ __forceinline__ void operator()(const f32x4 (&acc)[2][2][4][2], const pg8::Unit& u, int wr, int wc, int fr, int fq) const {
        if (u.kind == 3) { float* pb = part + (size_t)u.aux * RC * DM - (size_t)RL * DM;
            EPI_FOREACH( const size_t o = (size_t)row * DM + col; *(f32x4*)(pb + o) = v0; *(f32x4*)(pb + o + 4) = v1; if (bj) asm volatile("" ::: "memory"); )
            return; }
        const bool lat = u.pm < 64; const void* xb = lat ? xlat : xctx; void* ob = lat ? olat : octx; const size_t rb = lat ? 0 : (size_t)RL * DM;
        const float* g = mod + (size_t)(lat ? (u.pm >> 3) : 8) * 6144 + gch * 1024;
        if (an == nullptr) {
        EPI_FOREACH( const f32x4 g0 = *(const f32x4*)(g + col), g1 = *(const f32x4*)(g + col + 4); const size_t o = (size_t)row * DM + col - rb;
            f32x4 x0, x1; ld8<XIN>(xb, o, x0, x1); st8<XOUT>(ob, o, x0 + g0 * v0, x1 + g1 * v1); if (bj) asm volatile("" ::: "memory"); )
        return; }
        const float* wm = wmf + (size_t)(lat ? (u.pm >> 3) : 8) * 1024;
        float sq = 0.f;
        EPI_FOREACH( const f32x4 g0 = *(const f32x4*)(g + col), g1 = *(const f32x4*)(g + col + 4); const size_t o = (size_t)row * DM + col - rb;
            f32x4 x0, x1; ld8<XIN>(xb, o, x0, x1); const f32x4 y0 = x0 + g0 * v0, y1 = x1 + g1 * v1; st8<XOUT>(ob, o, y0, y1);
            const f32x4 w0 = *(const f32x4*)(wm + col), w1 = *(const f32x4*)(wm + col + 4);
            *(pg8::u32x4*)(an + (size_t)row * DM + col) = pack8(y0 * w0, y1 * w1);
            sq += y0[0] * y0[0] + y0[1] * y0[1] + y0[2] * y0[2] + y0[3] * y0[3] + y1[0] * y1[0] + y1[1] * y1[1] + y1[2] * y1[2] + y1[3] * y1[3];
            if (bj) { sq += __shfl_xor(sq, 16); sq += __shfl_xor(sq, 32); if (fq == 0) red[wc * 256 + ai * 128 + wr * 64 + m * 16 + fr] = sq; sq = 0.f; asm volatile("" ::: "memory"); } )
        __syncthreads();
        { int t = threadIdx.x; asm volatile("" : "+v"(t)); if (t < 256) ss[((size_t)u.pm * 256 + t) * 4 + u.pn] = red[t] + red[256 + t] + red[512 + t] + red[768 + t]; }
    }
};
struct EpiMerge { static constexpr bool PRE = false;
    pg8::u32x4* stash; bf16_t* MMp; bf16_t* PMp;
    __device__ __forceinline__ void operator()(const f32x4 (&acc)[2][2][4][2], const pg8::Unit& u, int wr, int wc, int fr, int fq) const {
        int tid = threadIdx.x; asm volatile("" : "+v"(tid));
        if (u.kind == 0) { EPI_FOREACH( stash[((ai * 4 + m) * 2 + bj) * NT + tid] = pack8(v0, v1); if (bj && (m & 1)) asm volatile("" ::: "memory"); ) }
        else { EPI_FOREACH( f32x4 y0, y1; unpack8(stash[((ai * 4 + m) * 2 + bj) * NT + tid], y0, y1); f32x4 t0, t1;
                _Pragma("unroll") for (int q = 0; q < 4; ++q) { t0[q] = sigmoidf_(v0[q]) * y0[q]; t1[q] = sigmoidf_(v1[q]) * y1[q]; }
                pg8::u32x4* mp = (pg8::u32x4*)((u.kind == 2 && u.aux != 0 ? PMp + (size_t)(u.aux - 1) * RC * DM - (size_t)RL * DM : MMp) + (size_t)row * DM + col);
                if (u.kind == 1 && u.aux != 0) { f32x4 p0, p1; unpack8(*mp, p0, p1); t0 += p0; t1 += p1; }
                *mp = pack8(t0, t1); if (bj && (m & 1)) asm volatile("" ::: "memory"); ) }
    }
};
struct TItem { const float* W; bf16_t* WT; const float* kscale; int K, N, row_off, item; };
__device__ __forceinline__ void titem_load(const TItem& t, int lane, f32x4 (&v)[8]) {
    const int nblk = t.N / 32, kb = t.item / nblk, nb = t.item % nblk;
    const float* p = t.W + (size_t)(64 * kb + (lane >> 3)) * t.N + 32 * nb + 4 * (lane & 7);
#pragma unroll
    for (int i = 0; i < 8; ++i) v[i] = *(const f32x4*)(p + (size_t)(8 * i) * t.N);
}
__device__ __forceinline__ void titem_store(const TItem& t, int lane, const f32x4 (&v)[8], LAS float* scr) {
    const int nblk = t.N / 32, kb = t.item / nblk, nb = t.item % nblk, k0 = 64 * kb, n0 = 32 * nb;
#pragma unroll
    for (int i = 0; i < 8; ++i) { const int kk = 8 * i + (lane >> 3); f32x4 w = v[i]; if (t.kscale) w *= t.kscale[k0 + kk];
        LAS float* sp = scr + kk * 33 + 4 * (lane & 7); sp[0] = w[0]; sp[1] = w[1]; sp[2] = w[2]; sp[3] = w[3]; }
    asm volatile("s_waitcnt lgkmcnt(0)" ::: "memory");
    const int c = lane & 7;
#pragma unroll
    for (int j = 0; j < 4; ++j) { const int n = (lane >> 3) + 8 * j; const LAS float* sp = scr + (8 * c) * 33 + n;
        pg8::u32x4 o; o.x = pg8::cvt_pk_bf16(sp[0 * 33], sp[1 * 33]); o.y = pg8::cvt_pk_bf16(sp[2 * 33], sp[3 * 33]); o.z = pg8::cvt_pk_bf16(sp[4 * 33], sp[5 * 33]); o.w = pg8::cvt_pk_bf16(sp[6 * 33], sp[7 * 33]);
        *(pg8::u32x4*)(t.WT + (size_t)(t.row_off + n0 + n) * t.K + k0 + 8 * c) = o; }
    asm volatile("s_waitcnt lgkmcnt(0)" ::: "memory");
}
__device__ __forceinline__ void ph_convert_weights(unsigned char* lds, int l, const float* w_in, const float* w1, const float* w2, const float* w_out, const float* w_br, const float* w_glu,
                                                   const float* w_uq, const float* q_norm, const float* w_ukv, const float* kv_norm, unsigned char* ws) { PH_IDS;
    const int wave = __builtin_amdgcn_readfirstlane(tid_ >> 6), lane = tid_ & 63;
    LAS float* scr = (LAS float*)((LAS unsigned char*)lds + wave * 16384);
    const int gw = bid_ * 8 + wave, NGW = G_ * 8;
    constexpr int I_IN = 16 * 189, I_1 = 16 * 128, I_2 = 64 * 32, I_O = 16 * 32, I_B = 4 * 32;
    constexpr int I_G = 4 * 16;
    constexpr int I_UQ = 4 * 12, I_UKV = 2 * 16;
    constexpr int NITEMS = I_IN + I_1 + I_2 + I_O + 4 * I_B + I_G + I_UQ + I_UKV;
    bf16_t* WIN_T = (bf16_t*)(ws + WS_WIN); bf16_t* W1_T = (bf16_t*)(ws + WS_W1); bf16_t* W2_T = (bf16_t*)(ws + WS_W2); bf16_t* WOUT_T = (bf16_t*)(ws + WS_WOUT); bf16_t* WBR_T = (bf16_t*)(ws + WS_WBR);
    auto decode = [&](int it) -> TItem {
        TItem t; t.kscale = nullptr; t.row_off = 0; int r = it;
        if (r < I_IN) { t.W = w_in + (size_t)l * DM * INC; t.K = DM; t.N = INC; t.WT = WIN_T; t.row_off = (r % 189) >= 61 ? 96 : 0; t.item = r; return t; } r -= I_IN;
        if (r < I_1) { t.W = w1 + (size_t)l * DM * DFF; t.K = DM; t.N = DFF; t.WT = W1_T; t.item = r; return t; } r -= I_1;
        if (r < I_2) { t.W = w2 + (size_t)l * DFF * DM; t.K = DFF; t.N = DM; t.WT = W2_T; t.item = r; return t; } r -= I_2;
        if (r < I_O) { t.W = w_out + (size_t)l * DM * DM; t.K = DM; t.N = DM; t.WT = WOUT_T; t.item = r; return t; } r -= I_O;
        if (r < 4 * I_B) { const int n = r / I_B; t.W = w_br + ((size_t)l * 4 + n) * 256 * DM; t.K = 256; t.N = DM; t.WT = WBR_T + (size_t)n * 1024 * 256; t.item = r % I_B; return t; } r -= 4 * I_B;
        if (r < I_G) { const int n0 = (r % 16) * 32;
            t.W = w_glu + (size_t)l * 256 * 512; t.K = 256; t.N = 512; t.WT = (bf16_t*)(ws + WS_WGLU); t.row_off = n0 < 128 ? 0 : (n0 < 256 ? 128 : (n0 < 384 ? -128 : 0)); t.item = r; return t; } r -= I_G;
        if (r < I_UQ) { t.W = w_uq + (size_t)l * 256 * 384; t.K = 256; t.N = 384; t.WT = (bf16_t*)(ws + WS_WUQ); t.kscale = q_norm + l * 256; t.item = r; return t; } r -= I_UQ;
        t.W = w_ukv + (size_t)l * 128 * 512; t.K = 128; t.N = 512; t.WT = (bf16_t*)(ws + WS_WUKV); t.kscale = kv_norm + l * 128; t.item = r; return t;
    };
    if (gw < NITEMS) {
        TItem cur = decode(gw); f32x4 v[8]; titem_load(cur, lane, v);
        for (int it = gw; it < NITEMS; it += NGW) {
            const bool more = it + NGW < NITEMS;
            TItem nxt = cur; f32x4 vn[8];
            if (more) { nxt = decode(it + NGW); titem_load(nxt, lane, vn); }
            titem_store(cur, lane, v, scr);
            if (more) { cur = nxt;
#pragma unroll
                for (int i = 0; i < 8; ++i) v[i] = vn[i]; }
        }
    }
    GSTRIDE(gi, 96 * 1024 / 8) { *(pg8::u32x4*)(WIN_T + (size_t)1952 * 1024 + (size_t)gi * 8) = (pg8::u32x4){0u, 0u, 0u, 0u}; }
    __syncthreads();
}

struct EpiFourier { static constexpr bool PRE = false;
    bf16_t* Zp; int rowbase, L; float scale;
    __device__ __forceinline__ void operator()(const f32x4 (&acc)[2][2][4][2], const pg8::Unit& u, int wr, int wc, int fr, int fq) const {
        EPI_FOREACH( *(pg8::u32x4*)(Zp + ((size_t)rowbase + (size_t)u.pn * L + row) * ZW + C_FU + (col - u.pn * 256)) = pack8(v0 * scale, v1 * scale); )
    }
};
__device__ __forceinline__ void ph_f2a(unsigned char* lds_, const bf16_t* F1, const float* trig, bf16_t* BP) { PH_IDS;
    const int lane = tid_ & 63, wid = __builtin_amdgcn_readfirstlane(tid_ >> 6), c16 = lane & 15, kq = lane >> 4;
    LAS char* wi = (LAS char*)lds_ + wid * 16384;
    LAS char* wo = wi + 8192;
    bf16x8 are, aim;
#pragma unroll
    for (int j = 0; j < 8; ++j) { const int t2 = 8 * (kq & 1) + j, idx = ((c16 * t2) & 15) * 128; const float cs = trig[idx], sn = trig[2048 + idx];
        are[j] = (short)f2bf((kq >> 1) ? -sn : cs); aim[j] = (short)f2bf((kq >> 1) ? cs : sn); }
    for (int col = bid_ * 8 + wid; col < NB * 256; col += G_ * 8) {
        const pg8::u32x4* src = (const pg8::u32x4*)(F1 + (size_t)col * 4096);
        pg8::u32x4 st[8];
#pragma unroll
        for (int i = 0; i < 8; ++i) st[i] = src[lane + 64 * i];
#pragma unroll
        for (int i = 0; i < 8; ++i) *(LAS pg8::u32x4*)(wi + (lane + 64 * i) * 16) = st[i];
        asm volatile("s_waitcnt lgkmcnt(0)" ::: "memory");
#pragma unroll 2
        for (int nb = 0; nb < 8; ++nb) {
            const int t1 = 16 * nb + c16;
            bf16x8 bf;
#pragma unroll
            for (int j = 0; j < 8; ++j) bf[j] = *(const LAS short*)(wi + ((kq >> 1) * 2048 + t1 + 128 * (8 * (kq & 1) + j)) * 2);
            const f32x4 z4 = (f32x4){0.f, 0.f, 0.f, 0.f};
            const f32x4 re = __builtin_amdgcn_mfma_f32_16x16x32_bf16(are, bf, z4, 0, 0, 0), im = __builtin_amdgcn_mfma_f32_16x16x32_bf16(aim, bf, z4, 0, 0, 0);
#pragma unroll
            for (int r = 0; r < 4; ++r) { const int k2 = 4 * kq + r, idx = k2 * t1; const float cs = trig[idx], sn = trig[2048 + idx];
                *(LAS bf16_t*)(wo + ((k2 * 2 + 0) * 128 + t1) * 2) = f2bf(re[r] * cs - im[r] * sn);
                *(LAS bf16_t*)(wo + ((k2 * 2 + 1) * 128 + t1) * 2) = f2bf(re[r] * sn + im[r] * cs); }
        }
        asm volatile("s_waitcnt lgkmcnt(0)" ::: "memory");
        pg8::u32x4* dst = (pg8::u32x4*)(BP + (size_t)col * 4096);
#pragma unroll
        for (int i = 0; i < 8; ++i) dst[lane + 64 * i] = *(const LAS pg8::u32x4*)(wo + (lane + 64 * i) * 16);
        asm volatile("s_waitcnt lgkmcnt(0)" ::: "memory");
    }
    __syncthreads();
}
struct SchedFourier2 { static constexpr bool DEP = false;
    const char* AT; const char* BP; int c;
    __device__ __forceinline__ bool next(int i, pg8::Unit& u) const {
        if (i != 0) return false;
        const int j = c & 7, b = c >> 3;
        u.A = AT; u.lda = 1024; u.B = BP + ((size_t)b * 256 * 4096 + (size_t)j * 512) * 2; u.ldb = 8192; u.nt = 8; u.pm = j; u.pn = b; u.kind = 0; u.aux = 0; return true; }
};
struct EpiFourier2 { static constexpr bool PRE = false;
    bf16_t* Zp; float scale;
    __device__ __forceinline__ void operator()(const f32x4 (&acc)[2][2][4][2], const pg8::Unit& u, int wr, int wc, int fr, int fq) const {
#pragma unroll
        for (int ai = 0; ai < 2; ++ai)
#pragma unroll
            for (int m = 0; m < 4; ++m)
#pragma unroll
                for (int bj = 0; bj < 2; ++bj) {
                    const int k1 = wr * 64 + m * 16 + fr, k = 16 * k1 + 2 * u.pm + ai, gm = bj * 128 + wc * 32 + 8 * fq;
                    *(pg8::u32x4*)(Zp + ((size_t)u.pn * 2048 + k) * ZW + C_FU + gm) = pack8(acc[ai][bj][m][0] * scale, acc[ai][bj][m][1] * scale);
                }
    }
};
struct EpiGlu { static constexpr bool PRE = false;
    bf16_t* OCp;
    __device__ __forceinline__ void operator()(const f32x4 (&acc)[2][2][4][2], const pg8::Unit& u, int wr, int wc, int fr, int fq) const {
#pragma unroll
        for (int ai = 0; ai < 2; ++ai)
#pragma unroll
            for (int m = 0; m < 4; ++m) {
                const int row = u.pm * 256 + ai * 128 + wr * 64 + m * 16 + fr, col = u.pn * 128 + wc * 32 + 8 * fq;
                f32x4 a, b;
#pragma unroll
                for (int q = 0; q < 4; ++q) { a[q] = acc[ai][0][m][0][q] * sigmoidf_(acc[ai][1][m][0][q]); b[q] = acc[ai][0][m][1][q] * sigmoidf_(acc[ai][1][m][1][q]); }
                *(pg8::u32x4*)(OCp + (size_t)row * 256 + col) = pack8(a, b);
            }
    }
};
__device__ __forceinline__ void ph_dft_gen(const float* trig, bf16_t* AT, bf16_t* DC) { PH_IDS;
    GSTRIDE(gi, 256 * 512) {
        const int r = gi >> 9, c = gi & 511, h = r >> 7, k1 = r & 127, hh = c >> 8, part = (c >> 7) & 1, t1 = c & 127, idx = ((k1 * t1) & 127) * 16;
        AT[gi] = f2bf(h != hh ? 0.f : (part ? -trig[2048 + idx] : trig[idx]));
    }
    GSTRIDE(gi, 256 * 512 / 8) {
        const int k = gi >> 6, kk0 = (gi & 63) * 8; pg8::u32x4 w; unsigned pr[4];
#pragma unroll
        for (int q = 0; q < 4; ++q) { float v[2];
#pragma unroll
            for (int e = 0; e < 2; ++e) { const int kk = kk0 + 2 * q + e, part = kk >> 8, t = kk & 255, idx = ((k * t) & 255) * 8; v[e] = part ? -trig[2048 + idx] : trig[idx]; }
            pr[q] = pg8::cvt_pk_bf16(v[0], v[1]); }
        w.x = pr[0]; w.y = pr[1]; w.z = pr[2]; w.w = pr[3];
        *(pg8::u32x4*)(DC + (size_t)k * 512 + kk0) = w;
    }
}

__device__ __forceinline__ void ph_sum_mm(bf16_t* MMp, const bf16_t* PMp) { PH_IDS;
    GSTRIDE(gi, RC * DM / 8) {
        pg8::u32x4* mp = (pg8::u32x4*)(MMp + (size_t)RL * DM) + gi;
        f32x4 a, b; unpack8(*mp, a, b);
#pragma unroll
        for (int n = 0; n < 3; ++n) { f32x4 c, d; unpack8(*((const pg8::u32x4*)(PMp + (size_t)n * RC * DM) + gi), c, d); a += c; b += d; }
        *mp = pack8(a, b);
    }
}
__device__ __forceinline__ void ph_sum_ffn(bf16_t* XC, const float* PD, const float* mod) { PH_IDS;
    GSTRIDE(gi, RC * DM / 8) {
        const int col = (gi * 8) & (DM - 1);
        f32x4 a0 = *((const f32x4*)PD + 2 * gi), a1 = *((const f32x4*)PD + 2 * gi + 1);
#pragma unroll
        for (int n = 1; n < 4; ++n) { a0 += *((const f32x4*)(PD + (size_t)n * RC * DM) + 2 * gi); a1 += *((const f32x4*)(PD + (size_t)n * RC * DM) + 2 * gi + 1); }
        const f32x4 g0 = *(const f32x4*)(mod + (size_t)8 * 6144 + 5 * 1024 + col), g1 = *(const f32x4*)(mod + (size_t)8 * 6144 + 5 * 1024 + col + 4);
        f32x4 x0, x1; ld8<1>(XC, (size_t)gi * 8, x0, x1); st8<1>(XC, (size_t)gi * 8, x0 + g0 * a0, x1 + g1 * a1);
    }
}

constexpr size_t WS_BAR = 768 * 1024;
constexpr int LDS_BYTES = 147456;
struct Args { const float* in[30]; float* out; unsigned char* ws; };
typedef const __attribute__((address_space(4))) Args* CArgs;
__device__ __forceinline__ CArgs kargs() { CArgs p = (CArgs)__builtin_amdgcn_kernarg_segment_ptr(); asm volatile("" : "+s"(p)); return p; }
#define IN(i) (kargs()->in[i])
#define WSB(T, off) ((T*)(kargs()->ws + (off)))
#define OSB(T, off) ((T*)((unsigned char*)kargs()->out + (off)))
#define OUTP (kargs()->out)
enum { I_X = 0, I_C, I_CTX, I_CCTX, I_ADAW, I_ADAB, I_NMIX, I_NFFN, I_WIN, I_QNORM, I_WUQ, I_KVNORM, I_WUKV, I_QKQ, I_QKK, I_LRE, I_LIM, I_LSTEP, I_BRE, I_BIM, I_CRE, I_CIM, I_S5D, I_WGLU, I_RDEC, I_RGN, I_WBR, I_WOUT, I_W1, I_W2 };
#define GRID_BAR() do { bar.bar = WSB(unsigned, WS_BAR); { unsigned x_ = bar.x; asm volatile("" : "+s"(x_)); bar.x = x_; } xcd_barrier(bar); } while (0)
template <int L> __device__ __forceinline__ void layer_body(unsigned char* lds, XcdBarrier& bar) {
    constexpr int l = L;
    constexpr bool LASTL = (L == DEPTH - 1);
    constexpr int NMT = LASTL ? RL / 256 : RT / 256;
    constexpr int WCTX = LASTL ? 0 : 1;

#define MODL (WSB(float, WS_MOD) + (size_t)l * 9 * 6144)
#define XLAT (l == 0 ? (const void*)IN(I_X) : (const void*)WSB(bf16_t, WS_R))
#define XCTX (l == 0 ? (const void*)IN(I_CTX) : (const void*)WSB(bf16_t, WS_XCB))
    constexpr int XIN = (L == 0) ? 0 : 1;
#define WINL (IN(I_WIN) + (size_t)l * DM * INC)
#define ZP WSB(bf16_t, WS_Z)
#define XNP WSB(bf16_t, WS_XN)
#define QP WSB(bf16_t, WS_QKV)
#define KP (WSB(bf16_t, WS_QKV) + (size_t)32 * 2304 * 96)
#define VP (WSB(bf16_t, WS_QKV) + (size_t)2 * 32 * 2304 * 96)
#define F1LAT WSB(bf16_t, WS_F1)
#define F1CTX (WSB(bf16_t, WS_F1) + (size_t)8 * 256 * 2 * 2048)
#define QRAWP WSB(bf16_t, WS_RAW)
#define KVRAWP (WSB(bf16_t, WS_RAW) + (size_t)RT * 384)
        ph_s5_lp(l, IN(I_LRE), IN(I_LIM), IN(I_LSTEP), IN(I_BRE), IN(I_BIM), WSB(float2, WS_LP), WSB(float2, WS_BB), WSB(float, WS_LAMT));
        ph_adarms<XIN>(XLAT, XCTX, IN(I_NMIX) + l * DM, MODL, 0, 1, XNP, RT);
        ph_convert_weights(lds, l, IN(I_WIN), IN(I_W1), IN(I_W2), IN(I_WOUT), IN(I_WBR), IN(I_WGLU), IN(I_WUQ), IN(I_QNORM), IN(I_WUKV), IN(I_KVNORM), kargs()->ws);
        if (l == 0) ph_dft_gen(WSB(float, WS_TRIG), OSB(bf16_t, OS_AT), OSB(bf16_t, OS_DFTC));
        ph_wmf(IN(I_NFFN) + l * DM, MODL, WSB(float, WS_WMF));
        GRID_BAR();
        { SchedP1 S; S.A = (const char*)XNP; S.B = (const char*)WSB(bf16_t, WS_WIN); S.G = l_grid(); S.c = l_bid(); S.last = LASTL ? 1 : 0;
          EpiStore E; E.O = ZP; E.ld = ZW; E.act = 0; pg8::gemm_phase((LAS unsigned char*)lds, S, E); }
        { const int G = l_grid(), bx = l_bid(), n3 = G == 256 ? (LASTL ? 32 : 64) : 0;
          if (bx >= n3) { const int vb = bx - n3, vg = G - n3;
            ph_s5_tz(lds, l, WSB(float2, WS_LP), WSB(float2, WS_BB), IN(I_CRE), IN(I_CIM), WSB(float, WS_TZ), vb, vg);
            ph_s5_ms(WSB(float2, WS_LP), WSB(float2, WS_BB), WSB(bf16_t, WS_MS), vb, vg);
            ph_cf_mfma(lds, WSB(bf16_t, WS_W1), MODL, WSB(float, WS_CF), vb, vg); } }
        GRID_BAR();
        ph_s5_tzb(l, WSB(float, WS_TZ), IN(I_S5D) + l * 256, OSB(bf16_t, OS_TZB), IN(I_CRE), IN(I_CIM), OSB(bf16_t, OS_CQ));
        ph_prep(ZP, WSB(bf16_t, WS_WUQ), WSB(bf16_t, WS_WUKV), WSB(bf16_t, WS_D64), IN(I_QKQ) + l * 96, IN(I_QKK) + l * 96, QP, KP, VP, F1LAT, F1CTX, lds);
        ph_s5_sloc(lds, ZP, WSB(bf16_t, WS_MS), OSB(float, OS_SLOC));
        GRID_BAR();
        unsigned* kvc_ = WSB(unsigned, WS_BAR) + XCD_BAR_WORDS + 128 + 1024 * l;
        unsigned* f2c_ = kvc_ + 640;
        ph_f2a(lds, F1LAT, WSB(float, WS_TRIG), OSB(bf16_t, OS_BP));
        dep_signal_x(f2c_, f2c_ + 32 + 16 * bar.x, bar.st[0]);
        { const int G = l_grid(), bx = l_bid(), nf = G == 256 ? (LASTL ? 64 : 72) : 0;
          ph_ret_kv(lds, ZP, IN(I_RDEC) + l * 8, WSB(bf16_t, WS_KVF), OSB(bf16_t, OS_KVB), bx - nf, G - nf);
          dep_signal_x(kvc_, kvc_ + 32 + 16 * bar.x, bar.st[0]); }
        {
            const int bx = l_bid();
            if (bx < 64) { if (l_tid() == 0) dep_spin(f2c_, (unsigned)l_grid(), WSB(unsigned, WS_BAR)); __syncthreads();
                SchedFourier2 S; S.AT = (const char*)OSB(bf16_t, OS_AT); S.BP = (const char*)OSB(bf16_t, OS_BP); S.c = bx;
                EpiFourier2 E; E.Zp = ZP; E.scale = 0.0027621358640099515f; pg8::gemm_phase((LAS unsigned char*)lds, S, E); }
            else if (!LASTL && bx < 72) { SchedGrid S; S.A = (const char*)OSB(bf16_t, OS_DFTC); S.B = (const char*)F1CTX; S.lda = 1024; S.ldb = 1024; S.nt = 8; S.nM = 1; S.nN = 8; S.G = 8; S.c = bx - 64; S.kind = 0; S.aux = 0;
                EpiFourier E; E.Zp = ZP; E.rowbase = RL; E.L = 256; E.scale = 0.0078125f; pg8::gemm_phase((LAS unsigned char*)lds, S, E); }
            constexpr int NS5 = 16 * (LASTL ? 16 : 18);
            constexpr int NC = LASTL ? 0 : 32;
            constexpr int Q_ATT = 0, Q_ATTC = 256, Q_S5 = Q_ATTC + NC, Q_RET = Q_S5 + NS5, Q_RETC = Q_RET + 256, Q_END = Q_RETC + NC;
            volatile LAS int* qslot = (volatile LAS int*)((LAS unsigned char*)lds + LDS_BYTES - 32);
            unsigned* s5c_ = kvc_ + 320; bool s5sig_ = false;
            for (;;) {
                __syncthreads();
                if (l_tid() == 0) qslot[0] = (int)atomicAdd(WSB(unsigned, WS_BAR) + XCD_BAR_WORDS + 64 * l, 1u);
                __syncthreads();
                const int q = __builtin_amdgcn_readfirstlane(qslot[0]);
                if (!s5sig_ && q >= Q_RET) { dep_signal_x(s5c_, s5c_ + 32 + 16 * bar.x, bar.st[0]); s5sig_ = true; }
                if (q >= Q_END) break;
                if (q < Q_ATTC) ph_attn_mfma(lds, QP, KP, VP, ZP, WCTX, q - Q_ATT, 1 << 20);
                else if (q < Q_S5) ph_attn_mfma(lds, QP, KP, VP, ZP, WCTX, 256 + q - Q_ATTC, 1 << 20);
                else if (q < Q_RET) ph_s5_out(lds, ZP, OSB(bf16_t, OS_TZB), OSB(bf16_t, OS_CQ), WSB(float2, WS_LP), OSB(float, OS_SLOC), WSB(float, WS_LAMT), ZP, LASTL ? 16 : 18, q - Q_S5, 1 << 20);
                else if (q < Q_RETC) ph_ret_chunk(lds, ZP, WSB(bf16_t, WS_KVF), OSB(bf16_t, OS_KVB), IN(I_RDEC) + l * 8, IN(I_RGN) + l * 256, WCTX, q - Q_RET, 1 << 20, kvc_, WSB(unsigned, WS_BAR));
                else ph_ret_chunk(lds, ZP, WSB(bf16_t, WS_KVF), OSB(bf16_t, OS_KVB), IN(I_RDEC) + l * 8, IN(I_RGN) + l * 256, WCTX, 256 + q - Q_RETC, 1 << 20, kvc_, WSB(unsigned, WS_BAR));
            }
        }
        if (l_tid() == 0) dep_spin(kvc_ + 320, (unsigned)l_grid(), WSB(unsigned, WS_BAR));
        __syncthreads();
        { SchedGrid S; S.A = (const char*)(ZP + C_S5); S.B = (const char*)WSB(bf16_t, WS_WGLU); S.lda = ZW * 2; S.ldb = 512; S.nt = 4; S.nM = NMT; S.nN = 2; S.G = l_grid(); S.c = l_bid(); S.kind = 0; S.aux = 0;
          EpiGlu E; E.OCp = OSB(bf16_t, OS_OC); pg8::gemm_phase((LAS unsigned char*)lds, S, E); }
        GRID_BAR();
        { SchedMerge S; S.Z = (const char*)ZP; S.XN = (const char*)XNP; S.WBR = (const char*)WSB(bf16_t, WS_WBR); S.WING = (const char*)(WSB(bf16_t, WS_WIN) + (size_t)2048 * 1024); S.OC = (const char*)OSB(bf16_t, OS_OC);
          S.G = l_grid(); { const int bx = l_bid(); S.vcu = (bx % 8) * (S.G / 8) + bx / 8; }
          const bool mini = !LASTL && S.G == 256;
          S.njobs = mini ? RL / 256 * 4 : NMT * 4; S.nmini = mini ? 128 : 0;
          EpiMerge E; E.stash = WSB(pg8::u32x4, WS_STASH) + (size_t)l_bid() * 8192; E.MMp = WSB(bf16_t, WS_MM); E.PMp = OSB(bf16_t, OS_PM); pg8::gemm_phase((LAS unsigned char*)lds, S, E); }
        GRID_BAR();
        if (!LASTL && l_grid() == 256) { ph_sum_mm(WSB(bf16_t, WS_MM), OSB(bf16_t, OS_PM)); GRID_BAR(); }
        { SchedGrid S; S.A = (const char*)WSB(bf16_t, WS_MM); S.B = (const char*)WSB(bf16_t, WS_WOUT); S.lda = 2048; S.ldb = 2048; S.nt = 16; S.nM = NMT; S.nN = 4; S.G = l_grid(); S.c = l_bid(); S.kind = 0; S.aux = 0;
          EpiResid<XIN, 1> E; E.xlat = XLAT; E.xctx = XCTX; E.olat = WSB(bf16_t, WS_R); E.octx = WSB(bf16_t, WS_XCB); E.mod = MODL; E.gch = 2; E.part = nullptr; E.an = XNP; E.wmf = WSB(float, WS_WMF); E.ss = OSB(float, OS_SS); E.red = (LAS float*)((LAS unsigned char*)lds + 131072); pg8::gemm_phase((LAS unsigned char*)lds, S, E); }
        GRID_BAR();
        { SchedGrid S; S.A = (const char*)XNP; S.B = (const char*)WSB(bf16_t, WS_W1); S.lda = 2048; S.ldb = 2048; S.nt = 16; S.nM = NMT; S.nN = 16; S.G = l_grid(); S.c = l_bid(); S.kind = 0; S.aux = 0;
          EpiFfnUp E; E.O = WSB(bf16_t, WS_H); E.ss = OSB(float, OS_SS); E.cf = WSB(float, WS_CF); E.red = (LAS float*)((LAS unsigned char*)lds + 131072); pg8::gemm_phase((LAS unsigned char*)lds, S, E); }
        GRID_BAR();
        { SchedFfnDown S; S.H = (const char*)WSB(bf16_t, WS_H); S.W2 = (const char*)WSB(bf16_t, WS_W2); S.G = l_grid(); S.c = l_bid(); S.nctx = (!LASTL && S.G == 256) ? 128 : 0;
          EpiResid<1, LASTL ? 0 : 1> E; E.xlat = WSB(bf16_t, WS_R); E.xctx = WSB(bf16_t, WS_XCB); E.olat = LASTL ? (void*)OUTP : (void*)WSB(bf16_t, WS_R); E.octx = WSB(bf16_t, WS_XCB); E.mod = MODL; E.gch = 5; E.part = WSB(float, WS_PD); E.an = nullptr; E.wmf = nullptr; E.ss = nullptr; E.red = nullptr;
          if (!LASTL && S.G != 256) { SchedGrid S2; S2.A = S.H; S2.B = S.W2; S2.lda = 8192; S2.ldb = 8192; S2.nt = 64; S2.nM = NMT; S2.nN = 4; S2.G = S.G; S2.c = S.c; S2.kind = 0; S2.aux = 0; pg8::gemm_phase((LAS unsigned char*)lds, S2, E); }
          else pg8::gemm_phase((LAS unsigned char*)lds, S, E); }
        if (!LASTL && l_grid() == 256) { GRID_BAR(); ph_sum_ffn(WSB(bf16_t, WS_XCB), WSB(float, WS_PD), MODL); }
        if (l + 1 < DEPTH) GRID_BAR();
}
__global__ void __launch_bounds__(NT, 2) mega(Args a_unused) {
    extern __shared__ __attribute__((aligned(16))) unsigned char lds[];
    volatile LAS unsigned* bst = (volatile LAS unsigned*)((LAS unsigned char*)lds + LDS_BYTES - 16);
    if (threadIdx.x < 4) bst[threadIdx.x] = 0u;
    __syncthreads();
    XcdBarrier bar = xcd_barrier_post(WSB(unsigned, WS_BAR), bst);

    ph_mod(lds, IN(I_C), IN(I_CCTX), IN(I_ADAW), IN(I_ADAB), WSB(float, WS_MOD));
    ph_trig(WSB(float, WS_TRIG), WSB(bf16_t, WS_D64));
    GRID_BAR();
    layer_body<0>(lds, bar);
    layer_body<1>(lds, bar);
}

extern "C" void kernel_launch(void* const* d_in, const int* in_sizes, int n_in, void* d_out, int out_size, void* d_ws, size_t ws_size, hipStream_t stream) {
    static int grid = 0;
    if (grid == 0) {
        if (n_in != 30 || ws_size < WS_END) { fprintf(stderr, "kernel_launch: unexpected n_in %d / ws_size %zu\n", n_in, ws_size); grid = -1; return; }
        int dev = 0, cus = 0, per_cu = 0;
        if (hipGetDevice(&dev) != hipSuccess || hipDeviceGetAttribute(&cus, hipDeviceAttributeMultiprocessorCount, dev) != hipSuccess) { grid = -1; return; }
        if (hipFuncSetAttribute((const void*)mega, hipFuncAttributeMaxDynamicSharedMemorySize, LDS_BYTES) != hipSuccess) { fprintf(stderr, "kernel_launch: hipFuncSetAttribute failed\n"); grid = -1; return; }
        if (hipOccupancyMaxActiveBlocksPerMultiprocessor(&per_cu, (const void*)mega, NT, LDS_BYTES) != hipSuccess || per_cu < 1) fprintf(stderr, "kernel_launch: occupancy query says %d\n", per_cu);
        (void)hipGetLastError();
        grid = cus;
    }
    if (grid < 0) return;
    (void)hipMemsetAsync((char*)d_ws + WS_BAR, 0, (XCD_BAR_WORDS + 128 + 2048) * 4, stream);
    Args a; memset((void*)&a, 0, sizeof(a));
    for (int i = 0; i < 30; ++i) a.in[i] = (const float*)d_in[i];
    a.out = (float*)d_out; a.ws = (unsigned char*)d_ws;
    hipLaunchKernelGGL(mega, dim3(grid), dim3(NT), LDS_BYTES, stream, a);
}
```

```cpp
#include <hip/hip_runtime.h>
#include <cstdint>
#include <cstring>
#include <cstdio>

typedef unsigned short bf16_t;
typedef short bf16x8 __attribute__((ext_vector_type(8)));
typedef float f32x4 __attribute__((ext_vector_type(4)));

constexpr int DM = 1024, NB = 8, SEQ = 2048, CTX = 256, DEPTH = 2;
constexpr int RL = NB * SEQ;
constexpr int RC = NB * CTX;
constexpr int RT = RL + RC;
constexpr int INC = 6048;
constexpr int ZW = 2048;
constexpr int C_KVC = 0, C_KR = 128, C_S5 = 160, C_RK = 416, C_RV = 672, C_QC = 928, C_FU = 1184, C_RQ = 1440, C_RG = 1696, C_GATE = 1952;
constexpr int C_OC = C_RK;
constexpr int DFF = 4096;
constexpr int TCH = 64;
constexpr int NCH = RT / TCH;
constexpr float EPS = 1e-6f;
#define PI_D 3.14159265358979323846

__device__ __forceinline__ float bf2f(bf16_t v) { return __uint_as_float(((unsigned)v) << 16); }
__device__ __forceinline__ bf16_t f2bf(float f) { unsigned u = __float_as_uint(f); return (bf16_t)((u + 0x7fffu + ((u >> 16) & 1u)) >> 16); }
__device__ __forceinline__ float sigmoidf_(float x) { return 1.f / (1.f + __expf(-x)); }
__device__ __forceinline__ float siluf_(float x) { return x * sigmoidf_(x); }
__device__ __forceinline__ float geluf_(float x) { return 0.5f * x * (1.f + tanhf(0.7978845608028654f * (x + 0.044715f * x * x * x))); }
__device__ __forceinline__ int row_batch(int row) { return row < RL ? (row >> 11) : ((row - RL) >> 8); }
__device__ __forceinline__ int row_modidx(int row) { return row < RL ? (row >> 11) : 8; }

constexpr size_t MiB = 1ull << 20;
constexpr size_t WS_MOD = 0;
constexpr size_t WS_RS = 512 * 1024;
constexpr size_t WS_TRIG = 512 * 1024;
constexpr size_t WS_LAMT = WS_TRIG + 32 * 1024;
constexpr size_t WS_LP = 1 * MiB;
constexpr size_t WS_BB = 2 * MiB + 128 * 1024;
constexpr size_t WS_W = 8 * MiB;
constexpr size_t WS_WIN = WS_W, WS_W1 = WS_W + 12 * MiB, WS_W2 = WS_W + 20 * MiB, WS_WOUT = WS_W + 28 * MiB, WS_WBR = WS_W + 30 * MiB;
constexpr size_t WS_XN = 40 * MiB;
constexpr size_t WS_RAW = WS_XN;
constexpr size_t WS_YG = WS_XN;
constexpr size_t WS_Z = 76 * MiB;
constexpr size_t WS_QKV = 148 * MiB;
constexpr size_t WS_F1 = 184 * MiB;
constexpr size_t WS_GL = WS_F1;
constexpr size_t WS_TZ = 202 * MiB;
constexpr size_t WS_MS = 204 * MiB;
constexpr size_t WS_QO = 212 * MiB;
constexpr size_t WS_MM = WS_QKV;
constexpr size_t WS_STASH = WS_F1;
constexpr size_t WS_KVF = 3 * MiB + 512 * 1024;
constexpr size_t WS_PD = WS_XN;
constexpr size_t WS_H = WS_Z;
constexpr size_t WS_WUQ = 2 * MiB + 768 * 1024;
constexpr size_t WS_WUKV = 3 * MiB;
constexpr size_t WS_D64 = 512 * 1024 + 64 * 1024;
constexpr size_t WS_WGLU = 2 * MiB + 512 * 1024;
constexpr size_t WS_CF = 3 * MiB + 128 * 1024;
constexpr size_t WS_WMF = 3 * MiB + 320 * 1024;
constexpr size_t WS_R = 220 * MiB;
constexpr size_t WS_XCB = 252 * MiB;
constexpr size_t OS_AT = 0;
constexpr size_t OS_BP = 1 * MiB;
constexpr size_t OS_DFTC = 53 * MiB;
constexpr size_t OS_SLOC = 17 * MiB;
constexpr size_t OS_KVB = 22 * MiB;
constexpr size_t OS_PM = 27 * MiB;
constexpr size_t OS_TZB = 41 * MiB;
constexpr size_t OS_CQ = 42 * MiB;
constexpr size_t OS_OC = 43 * MiB;
constexpr size_t OS_SS = 40 * MiB;
constexpr size_t WS_END = 256 * MiB;


#define LAS __attribute__((address_space(3)))
#define NT 512
__device__ __forceinline__ int l_tid() { int t = threadIdx.x; asm volatile("" : "+v"(t)); return t; }
__device__ __forceinline__ int l_bid() { int b = blockIdx.x; asm volatile("" : "+s"(b)); return b; }
__device__ __forceinline__ int l_grid() { int g = gridDim.x; asm volatile("" : "+s"(g)); return g; }
#define PH_IDS const int tid_ = l_tid(), bid_ = l_bid(), G_ = l_grid(); (void)tid_; (void)bid_; (void)G_
template <class AF, class BF, class EF>
__device__ __forceinline__ void gemm_tile(const AF& A, const BF& B, const EF& E, bool valid, int b, int m0, int n0, int M, int N, int K, bf16_t (*sA)[40], bf16_t (*sB)[40], int ht) {
    f32x4 accm[2][2];
#pragma unroll
    for (int i = 0; i < 2; ++i)
#pragma unroll
        for (int j = 0; j < 2; ++j) accm[i][j] = (f32x4){0.f, 0.f, 0.f, 0.f};
    const int w = ht >> 6, lane = ht & 63, wm = (w >> 1) * 32, wn = (w & 1) * 32, fr = lane & 15, fq = lane >> 4;
    for (int k0 = 0; k0 < K; k0 += 32) {
        __syncthreads();
#pragma unroll
        for (int i = 0; i < 8; ++i) {
            const int e = ht + i * 256;
            { const int m = e >> 5, k = e & 31; float v = 0.f; if (valid && m0 + m < M && k0 + k < K) v = A(b, m0 + m, k0 + k); sA[m][k] = f2bf(v); }
            { const int k = e >> 6, n = e & 63; float v = 0.f; if (valid && n0 + n < N && k0 + k < K) v = B(b, k0 + k, n0 + n); sB[n][k] = f2bf(v); }
        }
        __syncthreads();
        bf16x8 af[2], bfr[2];
#pragma unroll
        for (int i = 0; i < 2; ++i) { af[i] = *(const bf16x8*)&sA[wm + i * 16 + fr][fq * 8]; bfr[i] = *(const bf16x8*)&sB[wn + i * 16 + fr][fq * 8]; }
#pragma unroll
        for (int i = 0; i < 2; ++i)
#pragma unroll
            for (int j = 0; j < 2; ++j) accm[i][j] = __builtin_amdgcn_mfma_f32_16x16x32_bf16(af[i], bfr[j], accm[i][j], 0, 0, 0);
    }
    if (valid) {
#pragma unroll
        for (int i = 0; i < 2; ++i)
#pragma unroll
            for (int j = 0; j < 2; ++j)
#pragma unroll
                for (int rr = 0; rr < 4; ++rr) {
                    const int m = m0 + wm + i * 16 + fq * 4 + rr, n = n0 + wn + j * 16 + fr;
                    if (m < M && n < N) E(b, m, n, accm[i][j][rr]);
                }
    }
}
template <class AF, class BF, class EF>
__device__ __forceinline__ void gemm_phase(unsigned char* lds, const AF& A, const BF& B, const EF& E, int nbatch, int M, int N, int K) {
    PH_IDS; const int tid = tid_, half = tid >> 8, ht = tid & 255;
    bf16_t (*sA)[40] = (bf16_t (*)[40])(lds + half * 10240);
    bf16_t (*sB)[40] = (bf16_t (*)[40])(lds + half * 10240 + 5120);
    const int tm = (M + 63) >> 6, tn = (N + 63) >> 6, total = nbatch * tm * tn;
    for (int it0 = bid_ * 2; it0 < total; it0 += G_ * 2) {
        const int it = it0 + half; const bool valid = it < total;
        const int itc = valid ? it : 0;
        const int b = itc / (tm * tn), r = itc % (tm * tn), m0 = (r / tn) * 64, n0 = (r % tn) * 64;
        gemm_tile(A, B, E, valid, b, m0, n0, M, N, K, sA, sB, ht);
    }
    __syncthreads();
}
template <class T> static T zeroed() { T t; memset((void*)&t, 0, sizeof(T)); return t; }

struct A_bf16 { const bf16_t* p; long long ld; long long coff;
    __device__ float operator()(int, int m, int k) const { return bf2f(p[(size_t)m * ld + coff + k]); } };
struct A_bf16_scaled { const bf16_t* p; long long ld; long long coff; const float* rs; long long rsi; const float* w;
    __device__ float operator()(int, int m, int k) const { return bf2f(p[(size_t)m * ld + coff + k]) * rs[(size_t)m * 2 + rsi] * w[k]; } };
struct B_f32 { const float* p; long long ld; long long coff;
    __device__ float operator()(int, int k, int n) const { return p[(size_t)k * ld + coff + n]; } };
struct E_bf16 { bf16_t* p; long long ld; long long coff;
    __device__ void operator()(int, int m, int n, float v) const { p[(size_t)m * ld + coff + n] = f2bf(v); } };

#define XB_TMO      128
#define XB_XCNT(j)  (256  + 64 * (j))
#define XB_XSUB(j)  (1280 + 64 * (j))
#define XB_XGEN(j)  (2304 + 64 * (j))
#define XB_TOP      3328
#define XB_TOPGEN   3392
#define XCD_BAR_WORDS 3456
#define XB_SPIN_CAP (1u << 18)
__device__ __forceinline__ unsigned xb_ld(unsigned* p)              { return __hip_atomic_load(p, __ATOMIC_RELAXED, __HIP_MEMORY_SCOPE_AGENT); }
__device__ __forceinline__ unsigned xb_add(unsigned* p, unsigned v) { return __hip_atomic_fetch_add(p, v, __ATOMIC_RELAXED, __HIP_MEMORY_SCOPE_AGENT); }
__device__ __forceinline__ unsigned xb_xcc_id() { return (unsigned)__builtin_amdgcn_s_getreg((3 << 11) | 20) & 0xFu; }
#define XB_SPIN(cond, bar) do { unsigned _sp = 0; while (cond) { __builtin_amdgcn_s_sleep(1); \
    if ((++_sp & 255u) == 0u) { if (xb_ld(&(bar)[XB_TMO])) break; if (_sp > XB_SPIN_CAP) { atomicAdd(&(bar)[XB_TMO], 1u); break; } } } } while (0)
struct XcdBarrier { unsigned* bar; unsigned x; volatile LAS unsigned* st; };
__device__ __forceinline__ XcdBarrier xcd_barrier_post(unsigned* bar, volatile LAS unsigned* st) {
    XcdBarrier b; b.bar = bar; b.x = xb_xcc_id(); b.st = st;
    if (threadIdx.x == 0) (void)xb_add(&bar[XB_XCNT(b.x)], 1u);
    return b;
}
__device__ __forceinline__ void xcd_barrier_complete(unsigned* bar, unsigned x, unsigned& nloc, unsigned& nx) {
    const unsigned G = gridDim.x * gridDim.y * gridDim.z;
    unsigned sum, cnt, mine, sp = 0u;
    for (;;) {
        sum = 0u; cnt = 0u; mine = 0u;
#pragma unroll
        for (unsigned j = 0; j < 16; ++j) { const unsigned c = xb_ld(&bar[XB_XCNT(j)]); sum += c; cnt += (c > 0u) ? 1u : 0u; mine = (j == x) ? c : mine; }
        if (sum == G) break;
        __builtin_amdgcn_s_sleep(1);
        if ((++sp & 255u) == 0u) { if (xb_ld(&bar[XB_TMO])) break; if (sp > XB_SPIN_CAP) { atomicAdd(&bar[XB_TMO], 1u); break; } }
    }
    nloc = mine > 0u ? mine : 1u; nx = cnt > 0u ? cnt : 1u;
}
__device__ __forceinline__ void xcd_barrier(const XcdBarrier& b) {
    asm volatile("s_waitcnt vmcnt(0)" ::: "memory");
    __syncthreads();
    if (threadIdx.x == 0) {
        unsigned* bar = b.bar;
        __builtin_amdgcn_s_waitcnt(0);
        unsigned nloc = b.st[0], nx = b.st[1];
        if (nloc == 0u) { xcd_barrier_complete(bar, b.x, nloc, nx); b.st[0] = nloc; b.st[1] = nx; }
        const unsigned old = xb_add(&bar[XB_XSUB(b.x)], 1u);
        const unsigned gen = old / nloc;
        if (old + 1u == (gen + 1u) * nloc) {
            __builtin_amdgcn_fence(__ATOMIC_RELEASE, "agent");
            asm volatile("s_waitcnt vmcnt(0)" ::: "memory");
            const unsigned og = xb_add(&bar[XB_TOP], 1u);
            const unsigned tg = og / nx;
            if (og + 1u == (tg + 1u) * nx) xb_add(&bar[XB_TOPGEN], 1u);
            else XB_SPIN(xb_ld(&bar[XB_TOPGEN]) == tg, bar);
            __builtin_amdgcn_fence(__ATOMIC_ACQUIRE, "agent");
            xb_add(&bar[XB_XGEN(b.x)], 1u);
            asm volatile("s_waitcnt vmcnt(0)" ::: "memory");
        } else {
            XB_SPIN(xb_ld(&bar[XB_XGEN(b.x)]) == gen, bar);
            __builtin_amdgcn_fence(__ATOMIC_ACQUIRE, "agent");
            asm volatile("s_waitcnt vmcnt(0)" ::: "memory");
        }
    }
    __syncthreads();
}

__device__ __forceinline__ void dep_signal_x(unsigned* ctr, unsigned* sub, unsigned nloc) {
    asm volatile("s_waitcnt vmcnt(0)" ::: "memory");
    __syncthreads();
    if (threadIdx.x == 0) { const unsigned old = xb_add(sub, 1u);
        if (old + 1u == nloc) { __builtin_amdgcn_fence(__ATOMIC_RELEASE, "agent"); asm volatile("s_waitcnt vmcnt(0)" ::: "memory"); (void)xb_add(ctr, nloc); } }
}
__device__ __forceinline__ void dep_spin(unsigned* ctr, unsigned need, unsigned* bar) {
    XB_SPIN(xb_ld(ctr) < need, bar);
    __builtin_amdgcn_fence(__ATOMIC_ACQUIRE, "agent");
    asm volatile("s_waitcnt vmcnt(0)" ::: "memory");
}
namespace pg8 {
typedef unsigned u32x4 __attribute__((ext_vector_type(4)));
constexpr int BM = 256, BK = 64, HALF = 128, HTB = HALF * BK * 2, STAGE_BYTES = 8 * HTB, NXCD = 8, WGM = 8;
__device__ __forceinline__ int lds_byte(int r, int c) { const int st = (r >> 4) * 2 + (c >> 5), rr = r & 15, cc = c & 31, ob = rr * 64 + cc * 2; return st * 1024 + (ob ^ (((ob >> 9) & 1) << 5)); }
__device__ __forceinline__ void stage_rc(int b, int& R, int& C) { const int st = b / 1024, sb = b % 1024, swz = sb ^ (((sb >> 9) & 1) << 5); R = (st >> 1) * 16 + swz / 64; C = (st & 1) * 32 + (swz % 64) / 2; }
__device__ __forceinline__ int perm32(int rho) { const int n = rho >> 4, i = rho & 15; return 8 * (i >> 2) + 4 * n + (i & 3); }
struct Unit { const char* A; const char* B; unsigned lda, ldb; int nt, pm, pn, kind, aux; };
__device__ __forceinline__ unsigned cvt_pk_bf16(float lo, float hi) { unsigned r; asm volatile("v_cvt_pk_bf16_f32 %0, %1, %2" : "=v"(r) : "v"(lo), "v"(hi)); return r; }
__device__ __forceinline__ bool static_tile(int nM, int nN, int G, int c, int i, int& pm, int& pn) {
    const int nwg = nM * nN; const long L = (long)i * G + c; if (L >= nwg) return false;
    int wgid = (int)L; { const int q = nwg / NXCD, r = nwg % NXCD, xcd = wgid % NXCD, off = wgid / NXCD; wgid = (xcd < r ? xcd * (q + 1) : r * (q + 1) + (xcd - r) * q) + off; }
    const int nig = WGM * nN, gid = wgid / nig, fm = gid * WGM, gsz = (nM - fm) < WGM ? (nM - fm) : WGM;
    pm = fm + ((wgid % nig) % gsz); pn = (wgid % nig) / gsz; return true;
}
template <class Epi, class Sched>
__device__ __forceinline__ void gemm_phase(LAS unsigned char* lds, const Sched& S, const Epi& E) {
    const int tid = l_tid(), wid = __builtin_amdgcn_readfirstlane(tid >> 6), lane = tid & 63, wr = wid >> 2, wc = wid & 3, fr = lane & 15, fq = lane >> 4;
    int sR0, sC20;
    { int R, C; stage_rc(tid * 16, R, C); sR0 = R; sC20 = C * 2; }
#define PG8_R(i) (sR0 + 64 * (i))
#define PG8_RB(i) ((PG8_R(i) & ~31) + perm32(PG8_R(i) & 31))
    const size_t kstep = (size_t)(BK * 2);
    const unsigned ldsw = (unsigned)wid * 1024u;
    const int aoff = lds_byte(wr * 64 + fr, fq * 8), boff = lds_byte(wc * 32 + fr, fq * 8);
#define PG8_SA(b, h) (((b) * 2 + (h)) * HTB)
#define PG8_SB(b, h) ((4 + (b) * 2 + (h)) * HTB)
#define PG8_STAGE_A(bufoff, gbase, ld) do { \
        __builtin_amdgcn_global_load_lds((const unsigned*)((const char*)(gbase) + (unsigned)(PG8_R(0) * (ld) + sC20)), (LAS unsigned*)(lds + (bufoff) + ldsw), 16, 0, 0); \
        __builtin_amdgcn_global_load_lds((const unsigned*)((const char*)(gbase) + (unsigned)(PG8_R(1) * (ld) + sC20)), (LAS unsigned*)(lds + (bufoff) + ldsw + 8192), 16, 0, 0); } while (0)
#define PG8_STAGE_B(bufoff, gbase, ld) do { \
        __builtin_amdgcn_global_load_lds((const unsigned*)((const char*)(gbase) + (unsigned)(PG8_RB(0) * (ld) + sC20)), (LAS unsigned*)(lds + (bufoff) + ldsw), 16, 0, 0); \
        __builtin_amdgcn_global_load_lds((const unsigned*)((const char*)(gbase) + (unsigned)(PG8_RB(1) * (ld) + sC20)), (LAS unsigned*)(lds + (bufoff) + ldsw + 8192), 16, 0, 0); } while (0)
#define PG8_LDA(dst, b, h) do { _Pragma("unroll") for (int m = 0; m < 4; ++m) _Pragma("unroll") for (int k = 0; k < 2; ++k) dst[m][k] = *(const LAS bf16x8*)(lds + PG8_SA(b, h) + aoff + m * 2048 + k * 1024); } while (0)
#define PG8_LDB(dst, b, h) do { _Pragma("unroll") for (int n = 0; n < 2; ++n) _Pragma("unroll") for (int k = 0; k < 2; ++k) dst[n][k] = *(const LAS bf16x8*)(lds + PG8_SB(b, h) + boff + n * 2048 + k * 1024); } while (0)
#define PG8_MMA(ai, bj, At, Bt) do { __builtin_amdgcn_s_setprio(1); _Pragma("unroll") for (int m = 0; m < 4; ++m) _Pragma("unroll") for (int n = 0; n < 2; ++n) _Pragma("unroll") for (int k = 0; k < 2; ++k) \
        acc[ai][bj][m][n] = __builtin_amdgcn_mfma_f32_16x16x32_bf16(Bt[n][k], At[m][k], acc[ai][bj][m][n], 0, 0, 0); __builtin_amdgcn_s_setprio(0); } while (0)
#define PG8_WAIT_V(n) asm volatile("s_waitcnt vmcnt(" #n ")" ::: "memory")
#define PG8_WAIT_L(n) asm volatile("s_waitcnt lgkmcnt(" #n ")" ::: "memory")
#define PG8_BAR __builtin_amdgcn_s_barrier()
#define PG8_SCHED __builtin_amdgcn_sched_barrier(0)
    Unit cur, nxt; int ui = 0;
    if (!S.next(0, cur)) return;
    f32x4 prev_;
    if constexpr (Epi::PRE) { E.pre_issue(cur, tid, prev_); E.pre_commit(tid, 0, prev_); }
    f32x4 acc[2][2][4][2];
#pragma unroll
    for (int a = 0; a < 2; ++a)
#pragma unroll
        for (int b = 0; b < 2; ++b)
#pragma unroll
            for (int m = 0; m < 4; ++m)
#pragma unroll
                for (int n = 0; n < 2; ++n) acc[a][b][m][n] = (f32x4){0.f, 0.f, 0.f, 0.f};
    bf16x8 At[4][2], B0[2][2], B1[2][2];
    const char* cA = cur.A; const char* cB = cur.B;
    int clda = cur.lda, cldb = cur.ldb;
    PG8_STAGE_B(PG8_SB(0, 0), cB, cldb); PG8_STAGE_B(PG8_SB(0, 1), cB + (size_t)HALF * cldb, cldb); PG8_STAGE_A(PG8_SA(0, 0), cA, clda); PG8_STAGE_A(PG8_SA(0, 1), cA + (size_t)HALF * clda, clda);
    if (wr == 1) PG8_BAR;
    PG8_WAIT_V(2); PG8_BAR;
    PG8_STAGE_B(PG8_SB(1, 0), cB + kstep, cldb); PG8_STAGE_A(PG8_SA(1, 0), cA + kstep, clda); PG8_STAGE_B(PG8_SB(1, 1), cB + (size_t)HALF * cldb + kstep, cldb);
    PG8_WAIT_V(6); PG8_BAR;
    for (;;) {
        const bool has_next = S.next(ui + 1, nxt);
        const char* nA = has_next ? nxt.A : cA; const char* nB = has_next ? nxt.B : cB;
        const int nlda = has_next ? (int)nxt.lda : clda, nldb = has_next ? (int)nxt.ldb : cldb;
        const int nt = cur.nt;
        for (int t = 0; t < nt; t += 2) {
            const bool last = (t == nt - 2);
            const char* a1 = cA + (size_t)(t + 1) * kstep;
            const char* a2 = last ? nA : cA + (size_t)(t + 2) * kstep; const char* b2 = last ? nB : cB + (size_t)(t + 2) * kstep;
            const char* a3 = a2 + kstep; const char* b3 = b2 + kstep;
            const int lda2 = last ? nlda : clda, ldb2 = last ? nldb : cldb;
            PG8_LDB(B0, 0, 0); PG8_LDB(B1, 0, 1); PG8_SCHED; PG8_LDA(At, 0, 0); PG8_STAGE_A(PG8_SA(1, 1), a1 + (size_t)HALF * clda, clda);
            PG8_WAIT_V(8); PG8_WAIT_L(0); PG8_BAR; PG8_MMA(0, 0, At, B0); PG8_MMA(0, 1, At, B1); PG8_BAR; PG8_SCHED;
            PG8_LDA(At, 0, 1); PG8_STAGE_B(PG8_SB(0, 0), b2, ldb2); PG8_STAGE_B(PG8_SB(0, 1), b2 + (size_t)HALF * ldb2, ldb2); PG8_STAGE_A(PG8_SA(0, 0), a2, lda2);
            PG8_WAIT_V(8); PG8_WAIT_L(0); PG8_BAR; PG8_MMA(1, 0, At, B0); PG8_MMA(1, 1, At, B1); PG8_BAR; PG8_SCHED;
            PG8_LDB(B0, 1, 0); PG8_LDB(B1, 1, 1); PG8_SCHED; PG8_LDA(At, 1, 0); PG8_STAGE_A(PG8_SA(0, 1), a2 + (size_t)HALF * lda2, lda2);
            PG8_WAIT_V(8); PG8_WAIT_L(0); PG8_BAR; PG8_MMA(0, 0, At, B0); PG8_MMA(0, 1, At, B1); PG8_BAR; PG8_SCHED;
            PG8_LDA(At, 1, 1); PG8_STAGE_B(PG8_SB(1, 0), b3, ldb2); PG8_STAGE_B(PG8_SB(1, 1), b3 + (size_t)HALF * ldb2, ldb2); PG8_STAGE_A(PG8_SA(1, 0), a3, lda2);
            PG8_WAIT_V(8); PG8_WAIT_L(0); PG8_BAR; PG8_MMA(1, 0, At, B0); PG8_MMA(1, 1, At, B1); PG8_BAR; PG8_SCHED;
        }
        if (wr == 0) PG8_BAR;
        if constexpr (Epi::PRE) { if (has_next) E.pre_issue(nxt, tid, prev_); E(acc, cur, wr, wc, fr, fq, ui & 1); if (has_next) E.pre_commit(tid, (ui + 1) & 1, prev_); }
        else E(acc, cur, wr, wc, fr, fq);
        if (!has_next) break;
#pragma unroll
        for (int a = 0; a < 2; ++a)
#pragma unroll
            for (int b = 0; b < 2; ++b)
#pragma unroll
                for (int m = 0; m < 4; ++m)
#pragma unroll
                    for (int n = 0; n < 2; ++n) acc[a][b][m][n] = (f32x4){0.f, 0.f, 0.f, 0.f};
        cur = nxt; cA = nA; cB = nB; clda = nlda; cldb = nldb; ++ui;
        if (wr == 1) PG8_BAR;
    }
    PG8_WAIT_V(0);
    PG8_BAR;
#undef PG8_SA
#undef PG8_SB
#undef PG8_STAGE_A
#undef PG8_RB
#undef PG8_R
#undef PG8_STAGE_B
#undef PG8_LDA
#undef PG8_LDB
#undef PG8_MMA
#undef PG8_WAIT_V
#undef PG8_WAIT_L
#undef PG8_BAR
#undef PG8_SCHED
}
}

__device__ __forceinline__ pg8::u32x4 pack8(const f32x4 a, const f32x4 b) { pg8::u32x4 w; w.x = pg8::cvt_pk_bf16(a[0], a[1]); w.y = pg8::cvt_pk_bf16(a[2], a[3]); w.z = pg8::cvt_pk_bf16(b[0], b[1]); w.w = pg8::cvt_pk_bf16(b[2], b[3]); return w; }
__device__ __forceinline__ void unpack8(const pg8::u32x4 w, f32x4& a, f32x4& b) {
    a[0] = __uint_as_float(w.x << 16); a[1] = __uint_as_float(w.x & 0xffff0000u); a[2] = __uint_as_float(w.y << 16); a[3] = __uint_as_float(w.y & 0xffff0000u);
    b[0] = __uint_as_float(w.z << 16); b[1] = __uint_as_float(w.z & 0xffff0000u); b[2] = __uint_as_float(w.w << 16); b[3] = __uint_as_float(w.w & 0xffff0000u); }
namespace fa {
typedef float f32x16 __attribute__((ext_vector_type(16)));
typedef short s16x4 __attribute__((ext_vector_type(4)));
typedef unsigned u32x4 __attribute__((ext_vector_type(4)));
typedef unsigned u32x2 __attribute__((ext_vector_type(2)));
__device__ __forceinline__ s16x4 vtr(const LAS char* p) { return __builtin_bit_cast(s16x4, __builtin_amdgcn_ds_read_tr16_b64_v4i16((LAS s16x4*)p)); }
__device__ __forceinline__ unsigned pk2(float lo, float hi) { unsigned r; asm volatile("v_cvt_pk_bf16_f32 %0, %1, %2" : "=v"(r) : "v"(lo), "v"(hi)); return r; }
typedef __bf16 bf16v2_t __attribute__((ext_vector_type(2)));
typedef float f32v2_t __attribute__((ext_vector_type(2)));
__device__ __forceinline__ unsigned pk2n(float lo, float hi) { return __builtin_bit_cast(unsigned, __builtin_convertvector((f32v2_t){lo, hi}, bf16v2_t)); }
__device__ __forceinline__ bf16x8 pack_p(const f32x16& p, int base) { u32x4 w; w.x = pk2(p[base], p[base + 1]); w.y = pk2(p[base + 2], p[base + 3]); w.z = pk2(p[base + 4], p[base + 5]); w.w = pk2(p[base + 6], p[base + 7]); return __builtin_bit_cast(bf16x8, w); }
__device__ __forceinline__ int crow(int r, int hi) { return (r & 3) + 8 * (r >> 2) + 4 * hi; }
__device__ __forceinline__ void pv_tile(f32x16& o0, f32x16& o1, const LAS char* vb, const bf16x8 (&pf)[4]) {
#pragma unroll
    for (int ks = 0; ks < 4; ++ks) {
        const s16x4 a0 = vtr(vb + ks * 1024), a1 = vtr(vb + ks * 1024 + 512), b0 = vtr(vb + 4096 + ks * 1024), b1 = vtr(vb + 4096 + ks * 1024 + 512);
        const bf16x8 v0 = (bf16x8){a0[0], a0[1], a0[2], a0[3], a1[0], a1[1], a1[2], a1[3]}, v1 = (bf16x8){b0[0], b0[1], b0[2], b0[3], b1[0], b1[1], b1[2], b1[3]};
        o0 = __builtin_amdgcn_mfma_f32_32x32x16_bf16(v0, pf[ks], o0, 0, 0, 0);
        o1 = __builtin_amdgcn_mfma_f32_32x32x16_bf16(v1, pf[ks], o1, 0, 0, 0);
    }
}
constexpr int KP_A = 208, KT_A = 64 * KP_A, VT = 8192, BUF_A = KT_A + VT;
constexpr int KP_R = 144, KT_R = 64 * KP_R, BUF_R = KT_R + VT;
}

#define GSTRIDE(gi, total) for (int gi = bid_ * NT + tid_; gi < (total); gi += G_ * NT)
__device__ __forceinline__ void ph_mod(unsigned char* lds, const float* c, const float* c_ctx, const float* ada_w, const float* ada_b, float* mod) { PH_IDS;
    LAS float* sl = (LAS float*)lds;
    LAS float* red = sl + 9 * 1024;
    for (int e = tid_; e < 9 * 1024; e += NT) { const int j = e >> 10, k = e & 1023; const float v = j < 8 ? c[j * 1024 + k] : c_ctx[k]; sl[e] = siluf_(v); }
    __syncthreads();
    const int nn = tid_ & 63, ks = tid_ >> 6;
    for (int u = bid_; u < 2 * 96; u += G_) {
        const int l = u / 96, n = (u % 96) * 64 + nn;
        float acc[9];
#pragma unroll
        for (int j = 0; j < 9; ++j) acc[j] = 0.f;
        const float* w = ada_w + ((size_t)l * 1024 + ks * 128) * 6144 + n;
#pragma unroll 4
        for (int k4 = 0; k4 < 32; ++k4) {
            const float w0 = w[(size_t)(4 * k4) * 6144], w1 = w[(size_t)(4 * k4 + 1) * 6144], w2 = w[(size_t)(4 * k4 + 2) * 6144], w3 = w[(size_t)(4 * k4 + 3) * 6144];
#pragma unroll
            for (int j = 0; j < 9; ++j) { const f32x4 s4 = *(const LAS f32x4*)(sl + j * 1024 + ks * 128 + 4 * k4); acc[j] += s4[0] * w0 + s4[1] * w1 + s4[2] * w2 + s4[3] * w3; } }
        __syncthreads();
#pragma unroll
        for (int j = 0; j < 9; ++j) red[(ks * 9 + j) * 64 + nn] = acc[j];
        __syncthreads();
        for (int e = tid_; e < 9 * 64; e += NT) { const int j = e >> 6, q = e & 63; float sum = 0.f;
#pragma unroll
            for (int r = 0; r < 8; ++r) sum += red[(r * 9 + j) * 64 + q];
            const int col = (u % 96) * 64 + q; mod[((size_t)l * 9 + j) * 6144 + col] = sum + ada_b[l * 6144 + col]; }
    }
    __syncthreads();
}
__device__ __forceinline__ void ph_trig(float* trig, bf16_t* d64) { PH_IDS; GSTRIDE(i, 2048) { const float xx = (float)i * (1.f / 1024.f); trig[i] = cospif(xx); trig[2048 + i] = sinpif(xx); }
    GSTRIDE(i, 128 * 64) { const int n = i >> 6, c = i & 63, m = n & 63; const float xx = (float)((m * c) & 63) * (1.f / 32.f); d64[i] = f2bf(n < 64 ? cospif(xx) : sinpif(xx)); } }
__device__ __forceinline__ double2 lam_pow(double re, double im, double dt, int k) {
    const double m = (double)__expf((float)(re * dt * k));
    double xx = im * dt * (double)k * 0.318309886183790671538;
    xx -= 2.0 * rint(xx * 0.5);
    const float xf = (float)xx;
    return make_double2(m * (double)cospif(xf), m * (double)sinpif(xf));
}
__device__ __forceinline__ void ph_s5_lp(int l, const float* lam_re, const float* lam_im, const float* log_step, const float* b_re, const float* b_im, float2* LP, float2* BB, float* lamT) { PH_IDS;
    GSTRIDE(it, 2 * 16 * 64 * 81) {
        const int i = it / 81, k = it % 81;
        const int d = i / 1024, g = (i / 64) % 16, p = i % 64;
        const size_t li = ((size_t)(l * 2 + d) * 16 + g) * 64 + p;
        const double re = lam_re[li], im = lam_im[li], dt = (double)expf(log_step[(l * 2 + d) * 16 + g]);
        if (k <= 64) {
            const double2 v = lam_pow(re, im, dt, k); LP[(size_t)i * 65 + k] = make_float2((float)v.x, (float)v.y);
            if (k == 64) { lamT[((size_t)(g * 2 + d) * 64 + p) * 2 + 0] = (float)v.x; lamT[((size_t)(g * 2 + d) * 64 + p) * 2 + 1] = (float)v.y; }
        } else {
            const int h = k - 65;
            const double2 l1 = lam_pow(re, im, dt, 1);
            const double nr = l1.x - 1.0, ni = l1.y, den = re * re + im * im;
            const double fr = (nr * re + ni * im) / den, fi = (ni * re - nr * im) / den;
            const double br = b_re[li * 16 + h], bi = b_im[li * 16 + h]; BB[(size_t)i * 16 + h] = make_float2((float)(fr * br - fi * bi), (float)(fr * bi + fi * br));
        }
    }
}
__device__ __forceinline__ void ph_s5_tz(unsigned char* lds_, int l, const float2* LP, const float2* BB, const float* c_re, const float* c_im, float* TZD, int vb, int vg) { PH_IDS;
    typedef float f32x2_ __attribute__((ext_vector_type(2)));
    LAS f32x2_* sC = (LAS f32x2_*)lds_;
    LAS f32x2_* sL = sC + 16 * 64;
    LAS f32x2_* sB = sL + 64 * 8;
    for (int it = vb; it < 256; it += vg) {
        const int u = it >> 3, ts = it & 7, g = u >> 1, d = u & 1;
        const size_t cb = (((size_t)(l * 2 + d) * 16 + g) * 16) * 64, gb = (size_t)d * 16 + g;
        const float cr0 = c_re[cb + tid_], ci0 = c_im[cb + tid_], cr1 = c_re[cb + NT + tid_], ci1 = c_im[cb + NT + tid_];
        const float2 lpv = LP[gb * 64 * 65 + (size_t)(tid_ >> 3) * 65 + ts * 8 + (tid_ & 7)];
        const float2 bb0 = BB[gb * 64 * 16 + tid_], bb1 = BB[gb * 64 * 16 + NT + tid_];
        __syncthreads();
        sC[tid_] = (f32x2_){cr0, ci0}; sC[NT + tid_] = (f32x2_){cr1, ci1}; sL[tid_] = (f32x2_){lpv.x, lpv.y}; sB[tid_] = (f32x2_){bb0.x, bb0.y}; sB[NT + tid_] = (f32x2_){bb1.x, bb1.y};
        __syncthreads();
        const int pair = tid_ & 127, tl = pair >> 4, h = pair & 15, qg = tid_ >> 7;
        f32x4 acc = (f32x4){0.f, 0.f, 0.f, 0.f};
#pragma unroll 4
        for (int p = 0; p < 64; ++p) {
            const f32x2_ c = sC[h * 64 + p], lp = sL[p * 8 + tl];
            const float er = c.x * lp.x - c.y * lp.y, ei = c.x * lp.y + c.y * lp.x;
            const f32x4 b01 = *(const LAS f32x4*)&sB[p * 16 + 4 * qg], b23 = *(const LAS f32x4*)&sB[p * 16 + 4 * qg + 2];
            acc[0] += er * b01[0] - ei * b01[1]; acc[1] += er * b01[2] - ei * b01[3]; acc[2] += er * b23[0] - ei * b23[1]; acc[3] += er * b23[2] - ei * b23[3];
        }
        *(f32x4*)(TZD + (((gb * 64) + ts * 8 + tl) * 16 + h) * 16 + 4 * qg) = acc;
    }
    __syncthreads();
}
__device__ __forceinline__ void ph_s5_ms(const float2* LP, const float2* BB, bf16_t* MST, int vb, int vg) { PH_IDS;
    for (int i0 = vb * NT + tid_; i0 < 16 * 256 * 128; i0 += 3 * vg * NT) {
        float2 lp[3]; f32x4 bb[3][4];
#pragma unroll
        for (int k = 0; k < 3; ++k) { const int i = i0 + k * vg * NT;
            if (i < 16 * 256 * 128) { const int g = i / (256 * 128), n = (i / 128) % 256, sh0 = (i % 128) * 8, d = n >> 7, p = n & 63, s = sh0 >> 4, hp0 = sh0 & 15;
                const size_t gi = ((size_t)d * 16 + g) * 64 + p;
                lp[k] = LP[gi * 65 + (d == 0 ? 63 - s : s)];
#pragma unroll
                for (int q = 0; q < 4; ++q) bb[k][q] = *(const f32x4*)(BB + gi * 16 + hp0 + 2 * q); } }
#pragma unroll
        for (int k = 0; k < 3; ++k) { const int i = i0 + k * vg * NT;
            if (i < 16 * 256 * 128) { const int g = i / (256 * 128), n = (i / 128) % 256, sh0 = (i % 128) * 8, im = (n >> 6) & 1;
                float v[8];
#pragma unroll
                for (int q = 0; q < 4; ++q) { v[2 * q] = im ? lp[k].x * bb[k][q][1] + lp[k].y * bb[k][q][0] : lp[k].x * bb[k][q][0] - lp[k].y * bb[k][q][1];
                    v[2 * q + 1] = im ? lp[k].x * bb[k][q][3] + lp[k].y * bb[k][q][2] : lp[k].x * bb[k][q][2] - lp[k].y * bb[k][q][3]; }
                *(pg8::u32x4*)(MST + ((size_t)g * 256 + n) * 1024 + sh0) = pack8((f32x4){v[0], v[1], v[2], v[3]}, (f32x4){v[4], v[5], v[6], v[7]}); } }
    }
}
__device__ __forceinline__ void ph_s5_qo(int l, const float2* LP, const float* c_re, const float* c_im, bf16_t* QOT, int vb, int vg) { PH_IDS;
    for (int i = vb * NT + tid_; i < 16 * 1024 * 32; i += vg * NT) {
        const int g = i / (1024 * 32), th = (i / 32) % 1024, j0 = (i % 32) * 8, d = j0 >> 7, im = (j0 >> 6) & 1, p0 = j0 & 63, t = th >> 4, h = th & 15;
        const size_t ci = (((size_t)(l * 2 + d) * 16 + g) * 16 + h) * 64 + p0;
        const int e = d == 0 ? t + 1 : 64 - t;
        float v[8];
#pragma unroll
        for (int q = 0; q < 8; ++q) { const float cr = c_re[ci + q], cim = c_im[ci + q]; const float2 lp = LP[(((size_t)d * 16 + g) * 64 + p0 + q) * 65 + e]; v[q] = im ? -(cr * lp.y + cim * lp.x) : cr * lp.x - cim * lp.y; }
        *(pg8::u32x4*)(QOT + ((size_t)g * 1024 + th) * 256 + j0) = pack8((f32x4){v[0], v[1], v[2], v[3]}, (f32x4){v[4], v[5], v[6], v[7]});
    }
}
__device__ __forceinline__ void ph_wmf(const float* w, const float* mod, float* wmf) { PH_IDS;
    GSTRIDE(i, 9 * 1024) { const int b = i >> 10, c = i & 1023; wmf[i] = w[c] * (1.f + mod[(size_t)b * 6144 + 4 * 1024 + c]); }
}
__device__ __forceinline__ void ph_cf_mfma(unsigned char* lds_, const bf16_t* W1T, const float* mod, float* cf, int vb, int vg) {
    const int tid = l_tid(), lane = tid & 63, kk = __builtin_amdgcn_readfirstlane(tid >> 6), i16 = lane & 15, kq = lane >> 4;
    LAS float* red = (LAS float*)lds_;
    for (int nt = vb; nt < 256; nt += vg) {
        f32x4 acc = (f32x4){0.f, 0.f, 0.f, 0.f};
#pragma unroll
        for (int s4 = 0; s4 < 4; ++s4) { const int k0 = kk * 128 + s4 * 32 + kq * 8;
            pg8::u32x4 aw = (pg8::u32x4){0u, 0u, 0u, 0u};
            if (i16 < 9) { const float* sp = mod + (size_t)i16 * 6144 + 3 * 1024 + k0; aw = pack8(*(const f32x4*)sp, *(const f32x4*)(sp + 4)); }
            const bf16x8 bw = *(const bf16x8*)(W1T + (size_t)(nt * 16 + i16) * 1024 + k0);
            acc = __builtin_amdgcn_mfma_f32_16x16x32_bf16(__builtin_bit_cast(bf16x8, aw), bw, acc, 0, 0, 0); }
        __syncthreads();
#pragma unroll
        for (int r = 0; r < 4; ++r) red[(kk * 16 + 4 * kq + r) * 16 + i16] = acc[r];
        __syncthreads();
        if (tid < 144) { float a = 0.f;
#pragma unroll
            for (int w = 0; w < 8; ++w) a += red[w * 256 + tid];
            cf[(size_t)(tid >> 4) * DFF + nt * 16 + (tid & 15)] = a; }
    }
    __syncthreads();
}
template <int XIN>
__device__ __forceinline__ void ph_adarms(const void* xlat, const void* xctx, const float* w, const float* mod, int sh_chunk, int sc_chunk, bf16_t* out, int nrows) { PH_IDS;
    const int wave = (bid_ * NT + tid_) >> 6, lane = tid_ & 63, nw = (G_ * NT) >> 6;
    f32x4 wv[4];
#pragma unroll
    for (int j = 0; j < 4; ++j) wv[j] = *(const f32x4*)(w + j * 256 + lane * 4);
    for (int row0 = wave; row0 < nrows; row0 += 3 * nw) {
        f32x4 v[3][4], sc[3][4], sh[3][4];
#pragma unroll
        for (int k = 0; k < 3; ++k) { const int row = row0 + k * nw;
            if (row < nrows) {
                if constexpr (XIN == 0) { const float* x = row < RL ? (const float*)xlat + (size_t)row * DM : (const float*)xctx + (size_t)(row - RL) * DM;
#pragma unroll
                    for (int j = 0; j < 4; ++j) v[k][j] = *(const f32x4*)(x + j * 256 + lane * 4); }
                else { const bf16_t* x = row < RL ? (const bf16_t*)xlat + (size_t)row * DM : (const bf16_t*)xctx + (size_t)(row - RL) * DM;
#pragma unroll
                    for (int j = 0; j < 4; ++j) { const fa::u32x2 r = *(const fa::u32x2*)(x + j * 256 + lane * 4); v[k][j] = (f32x4){__uint_as_float(r.x << 16), __uint_as_float(r.x & 0xffff0000u), __uint_as_float(r.y << 16), __uint_as_float(r.y & 0xffff0000u)}; } }
                const float* mrow = mod + (size_t)row_modidx(row) * 6144;
#pragma unroll
                for (int j = 0; j < 4; ++j) { const int c0 = j * 256 + lane * 4; sc[k][j] = *(const f32x4*)(mrow + sc_chunk * 1024 + c0); sh[k][j] = *(const f32x4*)(mrow + sh_chunk * 1024 + c0); }
            } }
#pragma unroll
        for (int k = 0; k < 3; ++k) { const int row = row0 + k * nw;
            if (row < nrows) {
                float ss = 0.f;
#pragma unroll
                for (int j = 0; j < 4; ++j) ss += v[k][j][0] * v[k][j][0] + v[k][j][1] * v[k][j][1] + v[k][j][2] * v[k][j][2] + v[k][j][3] * v[k][j][3];
#pragma unroll
                for (int o = 1; o < 64; o <<= 1) ss += __shfl_xor(ss, o);
                const float rstd = rsqrtf(ss * (1.f / DM) + EPS);
#pragma unroll
                for (int j = 0; j < 4; ++j) { const int c0 = j * 256 + lane * 4;
                    const f32x4 y = v[k][j] * rstd * wv[j] * (sc[k][j] + 1.f) + sh[k][j];
                    fa::u32x2 o; o.x = fa::pk2(y[0], y[1]); o.y = fa::pk2(y[2], y[3]);
                    *(fa::u32x2*)(out + (size_t)row * DM + c0) = o; }
            } }
    }
}
__device__ __forceinline__ void ph_mla_stats(const bf16_t* Z, float* rs) { PH_IDS;
    const int wave = (bid_ * NT + tid_) >> 6, lane = tid_ & 63, nw = (G_ * NT) >> 6;
    for (int row = wave; row < RT; row += nw) {
        const bf16_t* z = Z + (size_t)row * ZW; float sq = 0.f, sk = 0.f;
#pragma unroll
        for (int j = 0; j < 4; ++j) { const float v = bf2f(z[C_QC + j * 64 + lane]); sq += v * v; }
#pragma unroll
        for (int j = 0; j < 2; ++j) { const float v = bf2f(z[C_KVC + j * 64 + lane]); sk += v * v; }
#pragma unroll
        for (int o = 1; o < 64; o <<= 1) { sq += __shfl_xor(sq, o); sk += __shfl_xor(sk, o); }
        if (lane == 0) { rs[(size_t)row * 2] = rsqrtf(sq * (1.f / 256) + EPS); rs[(size_t)row * 2 + 1] = rsqrtf(sk * (1.f / 128) + EPS); }
    }
}
__device__ __forceinline__ void ph_mla_post(const bf16_t* Z, const bf16_t* qraw, const bf16_t* kvraw, const float* qkq, const float* qkk, bf16_t* Q, bf16_t* Kb, bf16_t* Vb) { PH_IDS;
    GSTRIDE(gi, RT * 8) {
        const int row = gi >> 3, h = (gi >> 1) & 3, isk = gi & 1;
        const bool lat = row < RL; const int b = row_batch(row), t = lat ? (row & 2047) : ((row - RL) & 255);
        const int qi = lat ? t : 2048 + t, ki = lat ? 256 + t : t;
        float v[96];
        float ss = 0.f;
        if (!isk) {
#pragma unroll
            for (int i = 0; i < 96; ++i) v[i] = bf2f(qraw[(size_t)row * 384 + h * 96 + i]);
        } else {
#pragma unroll
            for (int i = 0; i < 64; ++i) v[i] = bf2f(kvraw[(size_t)row * 512 + h * 128 + i]);
#pragma unroll
            for (int i = 0; i < 32; ++i) v[64 + i] = bf2f(Z[(size_t)row * ZW + C_KR + i]);
        }
#pragma unroll
        for (int i = 0; i < 96; ++i) ss += v[i] * v[i];
        const float rr = rsqrtf(ss * (1.f / 96) + EPS) * (isk ? 1.f : 0.14724727430627066f);
        const float* wv = isk ? qkk : qkq;
#pragma unroll
        for (int i = 0; i < 96; ++i) v[i] = v[i] * rr * wv[i];
        if (lat) {
            const float prow = (float)(t >> 6), pcol = (float)(t & 63);
#pragma unroll
            for (int part = 0; part < 2; ++part) { const float pos = part ? pcol : prow; const int base = 64 + part * 16;
#pragma unroll
                for (int j = 0; j < 8; ++j) { const float fr = exp2f(-(float)j * (13.287712379549449f / 8.f)), a = pos * fr, cs = __cosf(a), sn = __sinf(a);
                    const float x1 = v[base + j], x2 = v[base + 8 + j]; v[base + j] = x1 * cs - x2 * sn; v[base + 8 + j] = x1 * sn + x2 * cs; } }
        }
        bf16_t* o = isk ? Kb + ((size_t)(b * 4 + h) * 2304 + ki) * 96 : Q + ((size_t)(b * 4 + h) * 2304 + qi) * 96;
#pragma unroll
        for (int i = 0; i < 96; ++i) o[i] = f2bf(v[i]);
        if (isk) { bf16_t* vo = Vb + ((size_t)(b * 4 + h) * 2304 + ki) * 64; for (int i = 0; i < 64; ++i) vo[i] = kvraw[(size_t)row * 512 + h * 128 + 64 + i]; }
    }
}
__device__ __forceinline__ void ph_attn(unsigned char* lds, const bf16_t* Q, const bf16_t* Kb, const bf16_t* Vb, bf16_t* Z, int with_ctx) { PH_IDS;
    float (*sK)[96] = (float (*)[96])lds; float (*sV)[64] = (float (*)[64])(lds + 32 * 96 * 4);
    const int nunits = 32 * (8 + (with_ctx ? 1 : 0));
    const int qt = tid_ & 255, dh = (tid_ >> 8) * 32;
    for (int u = bid_; u < nunits; u += G_) {
        const int bh = u % 32, qb = u / 32;
        const bool lat = qb < 8;
        const int qi = qb * 256 + qt, nkeys = lat ? 2304 : 256;
        float q[96], o[32];
        const bf16_t* qp = Q + ((size_t)bh * 2304 + qi) * 96;
#pragma unroll
        for (int i = 0; i < 96; ++i) q[i] = bf2f(qp[i]) * 0.10206207261596577f;
#pragma unroll
        for (int i = 0; i < 32; ++i) o[i] = 0.f;
        float mx = -1e30f, l = 0.f;
        for (int k0 = 0; k0 < nkeys; k0 += 32) {
            __syncthreads();
            for (int e = tid_; e < 32 * 96; e += NT) sK[e / 96][e % 96] = bf2f(Kb[((size_t)bh * 2304 + k0) * 96 + e]);
            for (int e = tid_; e < 32 * 64; e += NT) sV[e / 64][e % 64] = bf2f(Vb[((size_t)bh * 2304 + k0) * 64 + e]);
            __syncthreads();
#pragma unroll 1
            for (int j = 0; j < 32; ++j) { float a = 0.f;
#pragma unroll
                for (int i = 0; i < 96; ++i) a += q[i] * sK[j][i];
                if (a > mx) { const float corr = __expf(mx - a); mx = a; l *= corr;
#pragma unroll
                    for (int i = 0; i < 32; ++i) o[i] *= corr; }
                const float p = __expf(a - mx); l += p;
#pragma unroll
                for (int i = 0; i < 32; ++i) o[i] += p * sV[j][dh + i]; }
        }
        const int b = bh >> 2, h = bh & 3;
        const int row = lat ? b * 2048 + qi : RL + b * 256 + (qi - 2048);
        const float inv = 1.f / l;
#pragma unroll
        for (int i = 0; i < 32; ++i) Z[(size_t)row * ZW + C_QC + h * 64 + dh + i] = f2bf(o[i] * inv);
    }
    __syncthreads();
}
__device__ __forceinline__ void ph_f1(const bf16_t* Z, const float* trig, bf16_t* F1lat, bf16_t* F1ctx) { PH_IDS;
    GSTRIDE(gi, RT * 256) {
        const int row = gi >> 8, gm = gi & 255, g = gm >> 6, m = gm & 63;
        float a = 0.f, bsum = 0.f;
        const bf16_t* u = Z + (size_t)row * ZW + C_FU + g * 64;
        for (int c = 0; c < 64; ++c) { const float v = bf2f(u[c]); const int idx = ((m * c) & 63) * 32; a += v * trig[idx]; bsum += v * trig[2048 + idx]; }
        if (row < RL) { const int b = row >> 11, t = row & 2047; bf16_t* o = F1lat + ((size_t)(b * 256 + gm) * 2) * 2048; o[t] = f2bf(a); o[2048 + t] = f2bf(bsum); }
        else { const int r = row - RL, b = r >> 8, t = r & 255; bf16_t* o = F1ctx + ((size_t)(b * 256 + gm) * 2) * 256; o[t] = f2bf(a); o[256 + t] = f2bf(bsum); }
    }
}
struct A_dft { const float* trig; long long L; long long mul;
    __device__ float operator()(int, int k, int kk) const { const int part = kk >= (int)L, t = part ? kk - (int)L : kk; const int idx = (int)(((long long)k * t) & (L - 1)) * (int)mul; return part ? -trig[2048 + idx] : trig[idx]; } };
struct B_f1t { const bf16_t* p; long long L;
    __device__ float operator()(int b, int kk, int n) const { return bf2f(p[((size_t)(b * 256 + n)) * 2 * L + kk]); } };
struct E_fourier { bf16_t* Z; long long rowbase; long long L; double scale;
    __device__ void operator()(int b, int m, int n, float v) const { Z[((size_t)rowbase + (size_t)b * L + m) * ZW + C_FU + n] = f2bf(v * (float)scale); } };

struct A_s5u { const bf16_t* Z;
    __device__ float operator()(int g, int rc, int k) const { return bf2f(Z[((size_t)rc * 64 + (k >> 4)) * ZW + C_S5 + g * 16 + (k & 15)]); } };
struct B_ms { const bf16_t* MS; __device__ float operator()(int g, int k, int n) const { return bf2f(MS[((size_t)g * 1024 + k) * 256 + n]); } };
struct E_sloc { float* S; __device__ void operator()(int g, int rc, int n, float v) const { S[((size_t)rc * 16 + g) * 256 + n] = v; } };
__device__ __forceinline__ void ph_s5_scan(const float* SLOC, const float* lamT, float* XP) { PH_IDS;
    GSTRIDE(i, 8 * 16 * 2 * 64) {
        const int b = i / 2048, g = (i / 128) % 16, d = (i / 64) % 2, p = i % 64;
        const float lr = lamT[((size_t)(g * 2 + d) * 64 + p) * 2], li = lamT[((size_t)(g * 2 + d) * 64 + p) * 2 + 1];
        float xr = 0.f, xi = 0.f;
        for (int step = 0; step < 36; ++step) {
            int rc;
            if (d == 0) rc = step < 4 ? 256 + b * 4 + step : b * 32 + (step - 4);
            else rc = step < 4 ? 256 + b * 4 + (3 - step) : b * 32 + (31 - (step - 4));
            const size_t o = ((size_t)rc * 16 + g) * 256 + d * 128;
            XP[o + p] = xr; XP[o + 64 + p] = xi;
            const float sr = SLOC[o + p], si = SLOC[o + 64 + p];
            const float nr = lr * xr - li * xi + sr, ni = lr * xi + li * xr + si; xr = nr; xi = ni;
        }
    }
}
struct A_s5out { const bf16_t* Z; const float* XP;
    __device__ float operator()(int g, int rc, int k) const { return k < 1024 ? bf2f(Z[((size_t)rc * 64 + (k >> 4)) * ZW + C_S5 + g * 16 + (k & 15)]) : XP[((size_t)rc * 16 + g) * 256 + (k - 1024)]; } };
struct B_s5out { const float* TZ; const bf16_t* QO;
    __device__ float operator()(int g, int k, int n) const { if (k < 1024) { const int s = k >> 4, hp = k & 15, t = n >> 4, h = n & 15; return TZ[(((size_t)g * 127 + (t - s + 63)) * 16 + hp) * 16 + h]; } return bf2f(QO[((size_t)g * 256 + (k - 1024)) * 1024 + n]); } };
struct E_s5out { bf16_t* YG; __device__ void operator()(int g, int rc, int n, float v) const { YG[((size_t)rc * 64 + (n >> 4)) * 256 + g * 16 + (n & 15)] = f2bf(geluf_(v)); } };
__device__ __forceinline__ void ph_glu(const bf16_t* GL, bf16_t* Z) { PH_IDS;
    GSTRIDE(gi, RT * 256) {
        const int row = gi >> 8, j = gi & 255;
        const float val = bf2f(GL[(size_t)row * 512 + j]), gate = bf2f(GL[(size_t)row * 512 + 256 + j]);
        Z[(size_t)row * ZW + C_S5 + j] = f2bf(val * sigmoidf_(gate));
    }
}
__device__ __forceinline__ void ph_ret_prep(bf16_t* Z) { PH_IDS;
    GSTRIDE(gi, RT * 4 * 32) {
        const int row = gi >> 7, h = (gi >> 5) & 3, j = gi & 31;
        bf16_t* z = Z + (size_t)row * ZW;
        if (row < RL) {
            const int t = row & 2047; const float fr = exp2f(-(float)j * (13.287712379549449f / 32.f)), a = (float)t * fr, cs = cosf(a), sn = sinf(a);
            { const float x1 = bf2f(z[C_RQ + h * 64 + j]), x2 = bf2f(z[C_RQ + h * 64 + 32 + j]); z[C_RQ + h * 64 + j] = f2bf(x1 * cs - x2 * sn); z[C_RQ + h * 64 + 32 + j] = f2bf(x1 * sn + x2 * cs); }
            { const float x1 = bf2f(z[C_RK + h * 64 + j]), x2 = bf2f(z[C_RK + h * 64 + 32 + j]); z[C_RK + h * 64 + j] = f2bf((x1 * cs - x2 * sn) * 0.125f); z[C_RK + h * 64 + 32 + j] = f2bf((x1 * sn + x2 * cs) * 0.125f); }
        } else {
            z[C_RK + h * 64 + j] = f2bf(bf2f(z[C_RK + h * 64 + j]) * 0.125f); z[C_RK + h * 64 + 32 + j] = f2bf(bf2f(z[C_RK + h * 64 + 32 + j]) * 0.125f);
        }
    }
}
__device__ __forceinline__ void ph_ret(unsigned char* lds, bf16_t* Z, const float* decay_logit, const float* gn_w, int with_ctx) { PH_IDS;
    float (*sK)[64] = (float (*)[64])lds; float (*sV)[64] = (float (*)[64])(lds + 32 * 64 * 4);
    float* sred = (float*)(lds + 2 * 32 * 64 * 4);
    const int nunits = 32 * (8 + (with_ctx ? 1 : 0));
    const int qt = tid_ & 255, hh = tid_ >> 8, dh = hh * 32;
    for (int u = bid_; u < nunits; u += G_) {
        const int bh = u % 32, qb = u / 32, b = bh >> 2, h = bh & 3;
        const bool lat = qb < 8;
        const int qpos = lat ? qb * 256 + qt : qt;
        const int qrow = lat ? b * 2048 + qpos : RL + b * 256 + qpos;
        const float lgf = -log1pf(__expf(-decay_logit[h])) * 1.4426950408889634f, lgb = -log1pf(__expf(-decay_logit[4 + h])) * 1.4426950408889634f;
        float q[64], o[32];
#pragma unroll
        for (int i = 0; i < 64; ++i) q[i] = bf2f(Z[(size_t)qrow * ZW + C_RQ + h * 64 + i]);
#pragma unroll
        for (int i = 0; i < 32; ++i) o[i] = 0.f;
        const int nkeys = lat ? 2560 : 256;
        for (int k0 = 0; k0 < nkeys; k0 += 32) {
            int krow0, kpos0;
            if (lat) { if (k0 < 256) { krow0 = RL + b * 256 + k0; kpos0 = k0 - 256; } else if (k0 < 2304) { krow0 = b * 2048 + (k0 - 256); kpos0 = k0 - 256; } else { krow0 = RL + b * 256 + (k0 - 2304); kpos0 = 2048 + (k0 - 2304); } }
            else { krow0 = RL + b * 256 + k0; kpos0 = k0; }
            __syncthreads();
            for (int e = tid_; e < 32 * 64; e += NT) { const int j = e >> 6, i = e & 63; sK[j][i] = bf2f(Z[(size_t)(krow0 + j) * ZW + C_RK + h * 64 + i]); sV[j][i] = bf2f(Z[(size_t)(krow0 + j) * ZW + C_RV + h * 64 + i]); }
            __syncthreads();
#pragma unroll 1
            for (int j = 0; j < 32; ++j) { float a = 0.f;
#pragma unroll
                for (int i = 0; i < 64; ++i) a += q[i] * sK[j][i];
                const int dpos = qpos - (kpos0 + j);
                const float dec = dpos > 0 ? exp2f(lgf * (float)dpos) : (dpos < 0 ? exp2f(lgb * (float)(-dpos)) : 2.f);
                a *= dec;
#pragma unroll
                for (int i = 0; i < 32; ++i) o[i] += a * sV[j][dh + i]; }
        }
        float s1 = 0.f;
#pragma unroll
        for (int i = 0; i < 32; ++i) s1 += o[i];
        __syncthreads();
        sred[hh * 256 + qt] = s1;
        __syncthreads();
        const float mu = (sred[qt] + sred[256 + qt]) * (1.f / 64);
        float s2 = 0.f;
#pragma unroll
        for (int i = 0; i < 32; ++i) { const float d = o[i] - mu; s2 += d * d; }
        __syncthreads();
        sred[hh * 256 + qt] = s2;
        __syncthreads();
        const float rstd = rsqrtf((sred[qt] + sred[256 + qt]) * (1.f / 64) + EPS);
#pragma unroll
        for (int i = 0; i < 32; ++i) { const float gte = bf2f(Z[(size_t)qrow * ZW + C_RG + h * 64 + dh + i]); const float y = (o[i] - mu) * rstd * gn_w[h * 64 + dh + i];
            Z[(size_t)qrow * ZW + C_RQ + h * 64 + dh + i] = f2bf(siluf_(gte) * y); }
    }
    __syncthreads();
}
struct E_merge { const bf16_t* stash; bf16_t* MMp; long long first;
    __device__ void operator()(int, int m, int n, float v) const { const size_t i = (size_t)m * DM + n; const float t = sigmoidf_(v) * bf2f(stash[i]); MMp[i] = f2bf(first ? t : bf2f(MMp[i]) + t); } };
struct E_resid { const float* xlat; const float* xctx; float* olat; float* octx; const float* mod; long long gchunk;
    __device__ void operator()(int, int m, int n, float v) const {
        const float g = mod[(size_t)row_modidx(m) * 6144 + gchunk * 1024 + n];
        if (m < RL) olat[(size_t)m * DM + n] = xlat[(size_t)m * DM + n] + g * v; else octx[(size_t)(m - RL) * DM + n] = xctx[(size_t)(m - RL) * DM + n] + g * v; } };
struct E_relu2 { bf16_t* H; __device__ void operator()(int, int m, int n, float v) const { const float r = fmaxf(v, 0.f); H[(size_t)m * DFF + n] = f2bf(r * r); } };


__device__ __forceinline__ void ph_s5_sloc(unsigned char* lds_, const bf16_t* Z, const bf16_t* MST, float* SLOC) { PH_IDS;
    const int lane = tid_ & 63, wid = __builtin_amdgcn_readfirstlane(tid_ >> 6), c16 = lane & 15, kq = lane >> 4;
    LAS char* sm = (LAS char*)lds_;
    constexpr int CP = 64 * 32 + 16;
    for (int u = bid_; u < 256; u += G_) {
        const int g = u >> 4, nh = (u >> 3) & 1, sl = u & 7;
        const bf16_t* mp0 = MST + ((size_t)g * 256 + nh * 128 + wid * 16 + c16) * 1024 + 8 * kq;
        bf16x8 a[32];
#pragma unroll
        for (int ks = 0; ks < 32; ++ks) a[ks] = *(const bf16x8*)(mp0 + 32 * ks);
        pg8::u32x4 st[4];
#define SLOC_ISSUE(blk_) do { _Pragma("unroll") for (int i = 0; i < 4; ++i) { const int p = tid_ + NT * i, r = p >> 1, hf = p & 1; \
            st[i] = *(const pg8::u32x4*)(Z + ((size_t)(blk_) * 1024 + r) * ZW + C_S5 + g * 16 + 8 * hf); } } while (0)
        SLOC_ISSUE(sl);
        for (int blk = sl; blk < 18; blk += 8) {
            const int rcbase = blk * 16;
            __syncthreads();
#pragma unroll
            for (int i = 0; i < 4; ++i) { const int p = tid_ + NT * i, r = p >> 1, hf = p & 1; *(LAS pg8::u32x4*)(sm + (r >> 6) * CP + (r & 63) * 32 + hf * 16) = st[i]; }
            if (blk + 8 < 18) SLOC_ISSUE(blk + 8);
            __syncthreads();
            const LAS char* bp = sm + c16 * CP + (kq >> 1) * 32 + (kq & 1) * 16;
            f32x4 acc0 = (f32x4){0.f, 0.f, 0.f, 0.f}, acc1 = acc0;
#pragma unroll
            for (int ks = 0; ks < 32; ks += 2) {
                const bf16x8 b0 = *(const LAS bf16x8*)(bp + ks * 64), b1 = *(const LAS bf16x8*)(bp + (ks + 1) * 64);
                acc0 = __builtin_amdgcn_mfma_f32_16x16x32_bf16(a[ks], b0, acc0, 0, 0, 0);
                acc1 = __builtin_amdgcn_mfma_f32_16x16x32_bf16(a[ks + 1], b1, acc1, 0, 0, 0);
            }
            *(f32x4*)(SLOC + ((size_t)(rcbase + c16) * 16 + g) * 256 + nh * 128 + wid * 16 + 4 * kq) = acc0 + acc1;
        }
#undef SLOC_ISSUE
    }
    __syncthreads();
}
__device__ __forceinline__ void ph_s5_tzb(int l, const float* TZD, const float* s5d, bf16_t* TZB, const float* c_re, const float* c_im, bf16_t* CQ) { PH_IDS;
    GSTRIDE(e, 16 * 16 * 256) { const int g = e >> 12, h = (e >> 8) & 15, n = e & 255, d = n >> 7, im = (n >> 6) & 1, p = n & 63;
        const size_t ci = ((((size_t)(l * 2 + d) * 16 + g) * 16 + h) * 64) + p; CQ[e] = f2bf(im ? -c_im[ci] : c_re[ci]); }
    GSTRIDE(e, 16 * 127 * 64) { const int g = e / (127 * 64), r = e % (127 * 64), dd = r >> 6, h = (r >> 2) & 15, q4 = (r & 3) * 4;
        f32x4 v = (f32x4){0.f, 0.f, 0.f, 0.f};
        if (dd >= 63) v += *(const f32x4*)(TZD + ((((size_t)0 * 16 + g) * 64 + (dd - 63)) * 16 + h) * 16 + q4);
        if (dd <= 63) v += *(const f32x4*)(TZD + ((((size_t)1 * 16 + g) * 64 + (63 - dd)) * 16 + h) * 16 + q4);
        if (dd == 63 && (h >> 2) == (q4 >> 2)) v[h & 3] += s5d[g * 16 + h];
        fa::u32x2 w; w.x = fa::pk2(v[0], v[1]); w.y = fa::pk2(v[2], v[3]);
        *(fa::u32x2*)(TZB + ((size_t)(g * 127 + dd) * 16 + h) * 16 + (((q4 >> 3) ^ (h >> 3)) * 8 + (q4 & 7))) = w; }
}
__device__ __forceinline__ void ph_s5_out(unsigned char* lds_, const bf16_t* Z, const bf16_t* TZB, const bf16_t* CQ, const float2* LP, const float* SLOC, const float* lamT, bf16_t* YG, int nrct, int u0, int ustep) { PH_IDS;
    LAS char* sm = (LAS char*)lds_;
    constexpr int O_TZ = 0, O_XP = 65536, O_U = 73728, UP = 2064, O_SL = O_U + 16 * UP;
    const int lane = tid_ & 63, wid = __builtin_amdgcn_readfirstlane(tid_ >> 6), c16 = lane & 15, kq = lane >> 4;
    for (int u = u0; u < 16 * nrct; u += ustep) {
        const int g = u / nrct, rct = u % nrct, rcbase = rct * 16;
        const bool lat = rct < 16; const int b = rcbase >> 5, c0 = rcbase & 31;
        const int nsl = lat ? 36 : 16;
        pg8::u32x4 sT[8], sU[4]; f32x4 sS[5];
        { const pg8::u32x4* tsrc = (const pg8::u32x4*)(TZB + (size_t)g * 127 * 256);
#pragma unroll
          for (int i_ = 0; i_ < 8; ++i_) { const int e = tid_ + NT * i_; if (e < 127 * 32) sT[i_] = tsrc[e]; }
#pragma unroll
          for (int i_ = 0; i_ < 4; ++i_) { const int e = tid_ + NT * i_, rc = e >> 7, s_ = (e >> 1) & 63, hh = e & 1; sU[i_] = *(const pg8::u32x4*)(Z + ((size_t)(rcbase + rc) * 64 + s_) * ZW + C_S5 + g * 16 + hh * 8); }
#pragma unroll
          for (int i_ = 0; i_ < 5; ++i_) { const int e = tid_ + NT * i_, r = e >> 6, q4 = e & 63; const int rc = lat ? (r < 4 ? 256 + b * 4 + r : b * 32 + (r - 4)) : rcbase + r;
              if (e < nsl * 64) sS[i_] = *(const f32x4*)(SLOC + ((size_t)rc * 16 + g) * 256 + q4 * 4); } }
        __syncthreads();
#pragma unroll
        for (int i_ = 0; i_ < 8; ++i_) { const int e = tid_ + NT * i_; if (e < 127 * 32) *(LAS pg8::u32x4*)(sm + O_TZ + e * 16) = sT[i_]; }
#pragma unroll
        for (int i_ = 0; i_ < 4; ++i_) { const int e = tid_ + NT * i_, rc = e >> 7, s_ = (e >> 1) & 63, hh = e & 1; *(LAS pg8::u32x4*)(sm + O_U + rc * UP + s_ * 32 + hh * 16) = sU[i_]; }
#pragma unroll
        for (int i_ = 0; i_ < 5; ++i_) { const int e = tid_ + NT * i_, r = e >> 6, q4 = e & 63; if (e < nsl * 64) *(LAS f32x4*)(sm + O_SL + r * 1024 + q4 * 16) = sS[i_]; }
        __syncthreads();
        if (tid_ < 128) {
            const int d = tid_ >> 6, p = tid_ & 63;
            const float lr = lamT[((size_t)(g * 2 + d) * 64 + p) * 2], li = lamT[((size_t)(g * 2 + d) * 64 + p) * 2 + 1];
            const LAS float* sl = (const LAS float*)(sm + O_SL) + d * 128 + p;
            LAS bf16_t* xp = (LAS bf16_t*)(sm + O_XP) + d * 128 + p;
            float xr = 0.f, xi = 0.f;
#define S5_STEP(r) do { const float sr = sl[(r) * 256], si = sl[(r) * 256 + 64]; const float nr = lr * xr - li * xi + sr, ni = lr * xi + li * xr + si; xr = nr; xi = ni; } while (0)
            if (lat) {
                if (d == 0) { for (int r = 0; r < 4 + c0; ++r) S5_STEP(r);
                    for (int r = 0; r < 16; ++r) { xp[r * 256] = f2bf(xr); xp[r * 256 + 64] = f2bf(xi); S5_STEP(4 + c0 + r); } }
                else { for (int r = 3; r >= 0; --r) S5_STEP(r);
                    for (int c = 31; c >= c0 + 16; --c) S5_STEP(4 + c);
                    for (int r = 15; r >= 0; --r) { xp[r * 256] = f2bf(xr); xp[r * 256 + 64] = f2bf(xi); S5_STEP(4 + c0 + r); } }
            } else {
                if (d == 0) { for (int r = 0; r < 16; ++r) { if ((r & 3) == 0) { xr = 0.f; xi = 0.f; } xp[r * 256] = f2bf(xr); xp[r * 256 + 64] = f2bf(xi); S5_STEP(r); } }
                else { for (int r = 15; r >= 0; --r) { if ((r & 3) == 3) { xr = 0.f; xi = 0.f; } xp[r * 256] = f2bf(xr); xp[r * 256 + 64] = f2bf(xi); S5_STEP(r); } }
            }
#undef S5_STEP
        }
        __syncthreads();
        const LAS char* ub = sm + O_U + c16 * UP + kq * 16;
        const LAS char* xb = sm + O_XP + c16 * 512 + kq * 16;
        f32x4 acc8[8];
#pragma unroll
        for (int i = 0; i < 8; ++i) acc8[i] = (f32x4){0.f, 0.f, 0.f, 0.f};
#pragma unroll
        for (int par = 0; par < 2; ++par) {
            const LAS char* fz = sm + O_TZ + ((wid * 8 + par + 63 - (kq >> 1)) * 16 + c16) * 32 + ((kq & 1) ^ (c16 >> 3)) * 16;
            bf16x8 uw[4];
            uw[0] = *(const LAS bf16x8*)(ub); uw[1] = *(const LAS bf16x8*)(ub + 64); uw[2] = *(const LAS bf16x8*)(ub + 128); uw[3] = uw[0];
#pragma unroll
            for (int m = -3; m < 32; ++m) {
                const bf16x8 f = *(const LAS bf16x8*)(fz - m * 1024);
                if (m + 3 < 32) uw[(m + 3) & 3] = *(const LAS bf16x8*)(ub + (m + 3) * 64);
#pragma unroll
                for (int j = 0; j < 4; ++j) { const int ks = m + j; if (ks >= 0 && ks < 32) acc8[par + 2 * j] = __builtin_amdgcn_mfma_f32_16x16x32_bf16(f, uw[ks & 3], acc8[par + 2 * j], 0, 0, 0); }
            }
        }
        {
#pragma unroll
            for (int d = 0; d < 2; ++d)
#pragma unroll 1
            for (int ph = 0; ph < 2; ++ph) {
                asm volatile("" ::: "memory");
                const bf16x8 cqr = *(const bf16x8*)(CQ + ((size_t)g * 16 + c16) * 256 + 32 * (4 * d + ph) + 8 * kq), cqi = *(const bf16x8*)(CQ + ((size_t)g * 16 + c16) * 256 + 32 * (4 * d + 2 + ph) + 8 * kq);
                const bf16x8 xre = *(const LAS bf16x8*)(xb + (4 * d + ph) * 64), xim = *(const LAS bf16x8*)(xb + (4 * d + 2 + ph) * 64);
                float yr[8], yi[8], lr[8], li[8];
                const int e0 = d == 0 ? 8 * wid + 1 : 57 - 8 * wid;
#pragma unroll
                for (int j = 0; j < 8; ++j) {
                    const float2* lp = LP + (((size_t)d * 16 + g) * 64 + 32 * ph + 8 * kq + j) * 65;
                    const float2 l1 = lp[1], ls = lp[e0];
                    const float xr = __uint_as_float((unsigned)(unsigned short)xre[j] << 16), xi = __uint_as_float((unsigned)(unsigned short)xim[j] << 16);
                    yr[j] = ls.x * xr - ls.y * xi; yi[j] = ls.x * xi + ls.y * xr; lr[j] = l1.x; li[j] = l1.y;
                }
#pragma unroll
                for (int s8 = 0; s8 < 8; ++s8) {
                    const int i = d == 0 ? s8 : 7 - s8;
                    const bf16x8 bre = __builtin_bit_cast(bf16x8, pack8((f32x4){yr[0], yr[1], yr[2], yr[3]}, (f32x4){yr[4], yr[5], yr[6], yr[7]}));
                    const bf16x8 bim = __builtin_bit_cast(bf16x8, pack8((f32x4){yi[0], yi[1], yi[2], yi[3]}, (f32x4){yi[4], yi[5], yi[6], yi[7]}));
                    acc8[i] = __builtin_amdgcn_mfma_f32_16x16x32_bf16(cqr, bre, acc8[i], 0, 0, 0);
                    acc8[i] = __builtin_amdgcn_mfma_f32_16x16x32_bf16(cqi, bim, acc8[i], 0, 0, 0);
                    if (s8 < 7) {
#pragma unroll
                        for (int j = 0; j < 8; ++j) { const float a = yr[j], c = yi[j]; yr[j] = lr[j] * a - li[j] * c; yi[j] = lr[j] * c + li[j] * a; }
                    }
                }
            }
        }
#pragma unroll
        for (int i = 0; i < 8; ++i) { const int t = wid * 8 + i;
            fa::u32x2 w; w.x = fa::pk2(geluf_(acc8[i][0]), geluf_(acc8[i][1])); w.y = fa::pk2(geluf_(acc8[i][2]), geluf_(acc8[i][3]));
            *(fa::u32x2*)(YG + ((size_t)(rcbase + c16) * 64 + t) * ZW + C_S5 + g * 16 + 4 * kq) = w; }
    }
    __syncthreads();
}
__device__ __forceinline__ void rope16(float (&v)[4], int kq, float pos, bool on) {
#pragma unroll
    for (int r = 0; r < 4; ++r) {
        const int j = (4 * kq + r) & 7;
        const float ang = pos * exp2f(-(float)j * (13.287712379549449f / 8.f)), cs = __cosf(ang), sn = __sinf(ang);
        const float other = __shfl_xor(v[r], 32);
        const float rot = kq < 2 ? v[r] * cs - other * sn : other * sn + v[r] * cs;
        v[r] = on ? rot : v[r];
    }
}
__device__ __forceinline__ void ph_prep(bf16_t* Z, const bf16_t* WUQ, const bf16_t* WUKV, const bf16_t* D64, const float* qkq, const float* qkk,
                                        bf16_t* Q, bf16_t* Kb, bf16_t* Vb, bf16_t* F1lat, bf16_t* F1ctx, unsigned char* lds_) { PH_IDS;
    const int lane = tid_ & 63, wid = __builtin_amdgcn_readfirstlane(tid_ >> 6), c16 = lane & 15, kq = lane >> 4;
    LAS char* sm = (LAS char*)lds_;
    constexpr int P_KV = 336, P_QC = 528, O_KV = 0, O_QC = 24576, O_FU = 63488;
    for (int blk = bid_; blk < RT / 72; blk += G_) {
        const int row0 = blk * 72;
        __syncthreads();
#pragma unroll 1
        for (int hf = 0; hf < 3; ++hf) { pg8::u32x4 st[4];
#pragma unroll
          for (int i = 0; i < 4; ++i) { const int e = tid_ + NT * (4 * hf + i);
              if (e < 1440) st[i] = *(const pg8::u32x4*)(Z + (size_t)(row0 + e / 20) * ZW + C_KVC + (e % 20) * 8);
              else if (e < 3744) st[i] = *(const pg8::u32x4*)(Z + (size_t)(row0 + ((e - 1440) >> 5)) * ZW + C_QC + ((e - 1440) & 31) * 8);
              else if (e < 6048) st[i] = *(const pg8::u32x4*)(Z + (size_t)(row0 + ((e - 3744) >> 5)) * ZW + C_FU + ((e - 3744) & 31) * 8); }
#pragma unroll
          for (int i = 0; i < 4; ++i) { const int e = tid_ + NT * (4 * hf + i);
              if (e < 1440) *(LAS pg8::u32x4*)(sm + O_KV + (e / 20) * P_KV + (e % 20) * 16) = st[i];
              else if (e < 3744) *(LAS pg8::u32x4*)(sm + O_QC + ((e - 1440) >> 5) * P_QC + ((e - 1440) & 31) * 16) = st[i];
              else if (e < 6048) *(LAS pg8::u32x4*)(sm + O_FU + ((e - 3744) >> 5) * P_QC + ((e - 3744) & 31) * 16) = st[i]; } }
        __syncthreads();
#pragma unroll 1
      for (int pass3 = 0; pass3 < 2; ++pass3) {
        int rowc[3], rl[3]; bool valid[3];
#pragma unroll
        for (int tt = 0; tt < 3; ++tt) { const int o = 16 * (3 * pass3 + tt) + c16; valid[tt] = o < 72; rl[tt] = valid[tt] ? o : 71; rowc[tt] = row0 + rl[tt]; }
        if (wid < 4) {
            const int h = wid;
            f32x4 acc[6][3]; float ssq[3];
#pragma unroll
            for (int tt = 0; tt < 3; ++tt) { ssq[tt] = 0.f;
#pragma unroll
                for (int nt = 0; nt < 6; ++nt) acc[nt][tt] = (f32x4){0.f, 0.f, 0.f, 0.f}; }
#pragma unroll 4
            for (int ks = 0; ks < 8; ++ks) {
                bf16x8 bq[3], aw[6];
#pragma unroll
                for (int tt = 0; tt < 3; ++tt) { bq[tt] = *(const LAS bf16x8*)(sm + O_QC + rl[tt] * P_QC + (32 * ks + 8 * kq) * 2);
#pragma unroll
                    for (int e = 0; e < 8; ++e) { const float f = bf2f((bf16_t)bq[tt][e]); ssq[tt] += f * f; } }
#pragma unroll
                for (int nt = 0; nt < 6; ++nt) aw[nt] = *(const bf16x8*)(WUQ + (size_t)(h * 96 + 16 * nt + c16) * 256 + 32 * ks + 8 * kq);
#pragma unroll
                for (int nt = 0; nt < 6; ++nt)
#pragma unroll
                    for (int tt = 0; tt < 3; ++tt) acc[nt][tt] = __builtin_amdgcn_mfma_f32_16x16x32_bf16(aw[nt], bq[tt], acc[nt][tt], 0, 0, 0);
            }
#pragma unroll
            for (int tt = 0; tt < 3; ++tt) {
                float s1 = ssq[tt]; s1 += __shfl_xor(s1, 16); s1 += __shfl_xor(s1, 32);
                const float rstd = rsqrtf(s1 * (1.f / 256) + EPS);
                float ss = 0.f;
#pragma unroll
                for (int nt = 0; nt < 6; ++nt)
#pragma unroll
                    for (int r = 0; r < 4; ++r) ss += acc[nt][tt][r] * acc[nt][tt][r];
                ss += __shfl_xor(ss, 16); ss += __shfl_xor(ss, 32);
                const float fac = rstd * rsqrtf(rstd * rstd * ss * (1.f / 96) + EPS) * 0.14724727430627066f;
                const int row = rowc[tt]; const bool lat = row < RL; const int b = row_batch(row), t = lat ? (row & 2047) : ((row - RL) & 255), qi = lat ? t : 2048 + t;
                bf16_t* qo = Q + ((size_t)(b * 4 + h) * 2304 + qi) * 96 + 4 * kq;
#pragma unroll
                for (int nt = 0; nt < 6; ++nt) {
                    const f32x4 w = *(const f32x4*)(qkq + 16 * nt + 4 * kq);
                    float v[4];
#pragma unroll
                    for (int r = 0; r < 4; ++r) v[r] = acc[nt][tt][r] * fac * w[r];
                    if (nt >= 4) rope16(v, kq, nt == 4 ? (float)(t >> 6) : (float)(t & 63), lat);
                    fa::u32x2 o; o.x = fa::pk2(v[0], v[1]); o.y = fa::pk2(v[2], v[3]);
                    if (valid[tt]) *(fa::u32x2*)(qo + 16 * nt) = o;
                }
            }
        } else {
            const int h = wid - 4;
            float ssq[3], rstd[3];
#pragma unroll
            for (int tt = 0; tt < 3; ++tt) ssq[tt] = 0.f;
#pragma unroll 1
            for (int pass = 0; pass < 2; ++pass) {
                f32x4 acc[4][3];
#pragma unroll
                for (int tt = 0; tt < 3; ++tt)
#pragma unroll
                    for (int nt = 0; nt < 4; ++nt) acc[nt][tt] = (f32x4){0.f, 0.f, 0.f, 0.f};
#pragma unroll
                for (int ks = 0; ks < 4; ++ks) {
                    bf16x8 bq[3], aw[4];
#pragma unroll
                    for (int tt = 0; tt < 3; ++tt) { bq[tt] = *(const LAS bf16x8*)(sm + O_KV + rl[tt] * P_KV + (32 * ks + 8 * kq) * 2);
                        if (pass == 0) {
#pragma unroll
                            for (int e = 0; e < 8; ++e) { const float f = bf2f((bf16_t)bq[tt][e]); ssq[tt] += f * f; } } }
#pragma unroll
                    for (int nt = 0; nt < 4; ++nt) aw[nt] = *(const bf16x8*)(WUKV + (size_t)(h * 128 + pass * 64 + 16 * nt + c16) * 128 + 32 * ks + 8 * kq);
#pragma unroll
                    for (int nt = 0; nt < 4; ++nt)
#pragma unroll
                        for (int tt = 0; tt < 3; ++tt) acc[nt][tt] = __builtin_amdgcn_mfma_f32_16x16x32_bf16(aw[nt], bq[tt], acc[nt][tt], 0, 0, 0);
                }
#pragma unroll
                for (int tt = 0; tt < 3; ++tt) {
                    const int row = rowc[tt]; const bool lat = row < RL; const int b = row_batch(row), t = lat ? (row & 2047) : ((row - RL) & 255), ki = lat ? 256 + t : t;
                    if (pass == 0) {
                        float s1 = ssq[tt]; s1 += __shfl_xor(s1, 16); s1 += __shfl_xor(s1, 32);
                        rstd[tt] = rsqrtf(s1 * (1.f / 128) + EPS);
                        float kr[2][4];
#pragma unroll
                        for (int e = 0; e < 2; ++e) { const fa::u32x2 w = *(const LAS fa::u32x2*)(sm + O_KV + rl[tt] * P_KV + (128 + 16 * e + 4 * kq) * 2);
                            kr[e][0] = __uint_as_float(w.x << 16); kr[e][1] = __uint_as_float(w.x & 0xffff0000u); kr[e][2] = __uint_as_float(w.y << 16); kr[e][3] = __uint_as_float(w.y & 0xffff0000u); }
                        float ss = 0.f;
#pragma unroll
                        for (int nt = 0; nt < 4; ++nt)
#pragma unroll
                            for (int r = 0; r < 4; ++r) { acc[nt][tt][r] *= rstd[tt]; ss += acc[nt][tt][r] * acc[nt][tt][r]; }
#pragma unroll
                        for (int e = 0; e < 2; ++e)
#pragma unroll
                            for (int r = 0; r < 4; ++r) ss += kr[e][r] * kr[e][r];
                        ss += __shfl_xor(ss, 16); ss += __shfl_xor(ss, 32);
                        const float fac = rsqrtf(ss * (1.f / 96) + EPS);
                        bf16_t* ko = Kb + ((size_t)(b * 4 + h) * 2304 + ki) * 96 + 4 * kq;
#pragma unroll
                        for (int nt = 0; nt < 6; ++nt) {
                            const f32x4 w = *(const f32x4*)(qkk + 16 * nt + 4 * kq);
                            float v[4];
#pragma unroll
                            for (int r = 0; r < 4; ++r) v[r] = (nt < 4 ? acc[nt < 4 ? nt : 0][tt][r] : kr[nt < 4 ? 0 : nt - 4][r]) * fac * w[r];
                            if (nt >= 4) rope16(v, kq, nt == 4 ? (float)(t >> 6) : (float)(t & 63), lat);
                            fa::u32x2 o; o.x = fa::pk2(v[0], v[1]); o.y = fa::pk2(v[2], v[3]);
                            if (valid[tt]) *(fa::u32x2*)(ko + 16 * nt) = o;
                        }
                    } else {
                        bf16_t* vo = Vb + ((size_t)(b * 4 + h) * 2304 + ki) * 64 + 4 * kq;
#pragma unroll
                        for (int nt = 0; nt < 4; ++nt) { fa::u32x2 o; o.x = fa::pk2(acc[nt][tt][0] * rstd[tt], acc[nt][tt][1] * rstd[tt]); o.y = fa::pk2(acc[nt][tt][2] * rstd[tt], acc[nt][tt][3] * rstd[tt]);
                            if (valid[tt]) *(fa::u32x2*)(vo + 16 * nt) = o; }
                    }
                }
            }
        }
        {
            const int g = wid >> 1, part = wid & 1;
            f32x4 acc[4][3];
#pragma unroll
            for (int tt = 0; tt < 3; ++tt)
#pragma unroll
                for (int nt = 0; nt < 4; ++nt) acc[nt][tt] = (f32x4){0.f, 0.f, 0.f, 0.f};
#pragma unroll
            for (int ks = 0; ks < 2; ++ks) {
                bf16x8 au[3], bd[4];
#pragma unroll
                for (int tt = 0; tt < 3; ++tt) au[tt] = *(const LAS bf16x8*)(sm + O_FU + rl[tt] * P_QC + (g * 64 + 32 * ks + 8 * kq) * 2);
#pragma unroll
                for (int nt = 0; nt < 4; ++nt) bd[nt] = *(const bf16x8*)(D64 + (size_t)(part * 64 + 16 * nt + c16) * 64 + 32 * ks + 8 * kq);
#pragma unroll
                for (int nt = 0; nt < 4; ++nt)
#pragma unroll
                    for (int tt = 0; tt < 3; ++tt) acc[nt][tt] = __builtin_amdgcn_mfma_f32_16x16x32_bf16(au[tt], bd[nt], acc[nt][tt], 0, 0, 0);
            }
#pragma unroll
            for (int tt = 0; tt < 3; ++tt) {
                const int o4 = 16 * (3 * pass3 + tt) + 4 * kq; const int trow = row0 + o4;
                if (o4 < 72) {
                    const bool lat = trow < RL;
#pragma unroll
                    for (int nt = 0; nt < 4; ++nt) {
                        const int gm = g * 64 + 16 * nt + c16;
                        fa::u32x2 o; o.x = fa::pk2(acc[nt][tt][0], acc[nt][tt][1]); o.y = fa::pk2(acc[nt][tt][2], acc[nt][tt][3]);
                        if (lat) { const int b = trow >> 11, t0 = trow & 2047; *(fa::u32x2*)(F1lat + ((size_t)(b * 256 + gm) * 2 + part) * 2048 + t0) = o; }
                        else { const int rr = trow - RL, b = rr >> 8, t0 = rr & 255; *(fa::u32x2*)(F1ctx + ((size_t)(b * 256 + gm) * 2 + part) * 256 + t0) = o; }
                    }
                }
            }
        }
      }
#pragma unroll 1
        for (int it = tid_; it < 72 * 16; it += NT) {
            const int row = row0 + (it >> 4), h = (it >> 2) & 3, jg = it & 3;
            bf16_t* zq = Z + (size_t)row * ZW + C_RQ + h * 64 + 8 * jg; bf16_t* zk = Z + (size_t)row * ZW + C_RK + h * 64 + 8 * jg;
            const fa::u32x4 k1 = *(const fa::u32x4*)zk, k2 = *(const fa::u32x4*)(zk + 32);
            f32x4 ka, kb, kc, kd; unpack8(k1, ka, kb); unpack8(k2, kc, kd);
            if (row < RL) {
                const fa::u32x4 q1 = *(const fa::u32x4*)zq, q2 = *(const fa::u32x4*)(zq + 32);
                f32x4 qa, qb, qc, qd; unpack8(q1, qa, qb); unpack8(q2, qc, qd);
                const float tpos = (float)(row & 2047);
                float x1q[8] = {qa[0], qa[1], qa[2], qa[3], qb[0], qb[1], qb[2], qb[3]}, x2q[8] = {qc[0], qc[1], qc[2], qc[3], qd[0], qd[1], qd[2], qd[3]};
                float x1k[8] = {ka[0], ka[1], ka[2], ka[3], kb[0], kb[1], kb[2], kb[3]}, x2k[8] = {kc[0], kc[1], kc[2], kc[3], kd[0], kd[1], kd[2], kd[3]};
#pragma unroll
                for (int e = 0; e < 8; ++e) {
                    float rev = tpos * (__builtin_amdgcn_exp2f(-(float)(8 * jg + e) * (13.287712379549449f / 32.f)) * 0.15915494309189535f); rev -= floorf(rev);
                    const float cs = __builtin_amdgcn_cosf(rev), sn = __builtin_amdgcn_sinf(rev);
                    const float a = x1q[e], c = x2q[e]; x1q[e] = a * cs - c * sn; x2q[e] = a * sn + c * cs;
                    const float a2 = x1k[e], c2 = x2k[e]; x1k[e] = (a2 * cs - c2 * sn) * 0.125f; x2k[e] = (a2 * sn + c2 * cs) * 0.125f;
                }
                *(fa::u32x4*)zq = pack8((f32x4){x1q[0], x1q[1], x1q[2], x1q[3]}, (f32x4){x1q[4], x1q[5], x1q[6], x1q[7]});
                *(fa::u32x4*)(zq + 32) = pack8((f32x4){x2q[0], x2q[1], x2q[2], x2q[3]}, (f32x4){x2q[4], x2q[5], x2q[6], x2q[7]});
                *(fa::u32x4*)zk = pack8((f32x4){x1k[0], x1k[1], x1k[2], x1k[3]}, (f32x4){x1k[4], x1k[5], x1k[6], x1k[7]});
                *(fa::u32x4*)(zk + 32) = pack8((f32x4){x2k[0], x2k[1], x2k[2], x2k[3]}, (f32x4){x2k[4], x2k[5], x2k[6], x2k[7]});
            } else {
                *(fa::u32x4*)zk = pack8(ka * 0.125f, kb * 0.125f); *(fa::u32x4*)(zk + 32) = pack8(kc * 0.125f, kd * 0.125f);
            }
        }
    }
}

__device__ __forceinline__ void attn_tile(const LAS char* sm, int r32, int hi, int vrd, int buf, bool first, const bf16x8 (&qf)[6], fa::f32x16& negm, float& mrun, float& lsum, fa::f32x16& o0, fa::f32x16& o1) {
    using namespace fa;
    const LAS char* kb = sm + buf + r32 * KP_A + 16 * hi;
    f32x16 p0 = negm, p1 = negm;
#pragma unroll
    for (int st = 0; st < 6; ++st) {
        const bf16x8 k0 = *(const LAS bf16x8*)(kb + 32 * st), k1 = *(const LAS bf16x8*)(kb + 32 * KP_A + 32 * st);
        p0 = __builtin_amdgcn_mfma_f32_32x32x16_bf16(k0, qf[st], p0, 0, 0, 0);
        p1 = __builtin_amdgcn_mfma_f32_32x32x16_bf16(k1, qf[st], p1, 0, 0, 0);
    }
    float ta = fmaxf(fmaxf(p0[0], p0[1]), p1[0]), tb = fmaxf(fmaxf(p0[2], p0[3]), p1[1]);
    ta = fmaxf(fmaxf(ta, p1[2]), p1[3]);
#pragma unroll
    for (int r = 4; r < 16; r += 4) { ta = fmaxf(fmaxf(ta, p0[r]), p0[r + 1]); tb = fmaxf(fmaxf(tb, p0[r + 2]), p0[r + 3]); ta = fmaxf(fmaxf(ta, p1[r]), p1[r + 1]); tb = fmaxf(fmaxf(tb, p1[r + 2]), p1[r + 3]); }
    float tm = fmaxf(ta, tb);
    tm = fmaxf(tm, __shfl_xor(tm, 32));
    if (first || __any(tm > 0.f)) {
        const float dl = first ? tm : fmaxf(tm, 0.f), alpha = first ? 1.f : __builtin_amdgcn_exp2f(-dl);
        mrun += dl; lsum *= alpha;
#pragma unroll
        for (int r = 0; r < 16; ++r) { p0[r] -= dl; p1[r] -= dl; o0[r] *= alpha; o1[r] *= alpha; negm[r] = -mrun; }
    }
    float ps = 0.f, ps2 = 0.f;
#pragma unroll
    for (int r = 0; r < 16; ++r) { p0[r] = __builtin_amdgcn_exp2f(p0[r]); p1[r] = __builtin_amdgcn_exp2f(p1[r]); ps += p0[r]; ps2 += p1[r]; }
    lsum += ps + ps2;
    bf16x8 pf[4]; pf[0] = pack_p(p0, 0); pf[1] = pack_p(p0, 8); pf[2] = pack_p(p1, 0); pf[3] = pack_p(p1, 8);
    pv_tile(o0, o1, sm + buf + vrd, pf);
}
__device__ __forceinline__ void attn_pair(const LAS char* sm, int r32, int hi, int vrd, int bufA, int bufB, bool first, const bf16x8 (&qf)[6], fa::f32x16& negm, float& mrun, float& lsum, fa::f32x16& o0, fa::f32x16& o1) {
    using namespace fa;
    const LAS char* ka = sm + bufA + r32 * KP_A + 16 * hi; const LAS char* kb = sm + bufB + r32 * KP_A + 16 * hi;
    f32x16 a0 = negm, a1 = negm, b0 = negm, b1 = negm;
#pragma unroll
    for (int st = 0; st < 6; ++st) {
        const bf16x8 k0 = *(const LAS bf16x8*)(ka + 32 * st), k1 = *(const LAS bf16x8*)(ka + 32 * KP_A + 32 * st);
        a0 = __builtin_amdgcn_mfma_f32_32x32x16_bf16(k0, qf[st], a0, 0, 0, 0);
        a1 = __builtin_amdgcn_mfma_f32_32x32x16_bf16(k1, qf[st], a1, 0, 0, 0);
    }
    float carry = 0.f;
    {
        float ta = fmaxf(fmaxf(a0[0], a0[1]), a1[0]), tb = fmaxf(fmaxf(a0[2], a0[3]), a1[1]);
        ta = fmaxf(fmaxf(ta, a1[2]), a1[3]);
#pragma unroll
        for (int r = 4; r < 16; r += 4) { ta = fmaxf(fmaxf(ta, a0[r]), a0[r + 1]); tb = fmaxf(fmaxf(tb, a0[r + 2]), a0[r + 3]); ta = fmaxf(fmaxf(ta, a1[r]), a1[r + 1]); tb = fmaxf(fmaxf(tb, a1[r + 2]), a1[r + 3]); }
        float tm = fmaxf(ta, tb);
        tm = fmaxf(tm, __shfl_xor(tm, 32));
        if (first || __any(tm > 0.f)) {
            const float dl = first ? tm : fmaxf(tm, 0.f), alpha = first ? 1.f : __builtin_amdgcn_exp2f(-dl);
            mrun += dl; lsum *= alpha; carry = dl;
#pragma unroll
            for (int r = 0; r < 16; ++r) { a0[r] -= dl; a1[r] -= dl; o0[r] *= alpha; o1[r] *= alpha; negm[r] = -mrun; }
        }
    }
#pragma unroll
    for (int st = 0; st < 6; ++st) {
        const bf16x8 k0 = *(const LAS bf16x8*)(kb + 32 * st), k1 = *(const LAS bf16x8*)(kb + 32 * KP_A + 32 * st);
        b0 = __builtin_amdgcn_mfma_f32_32x32x16_bf16(k0, qf[st], b0, 0, 0, 0);
        b1 = __builtin_amdgcn_mfma_f32_32x32x16_bf16(k1, qf[st], b1, 0, 0, 0);
    }
    float ps = 0.f, ps2 = 0.f;
#pragma unroll
    for (int r = 0; r < 16; ++r) { a0[r] = __builtin_amdgcn_exp2f(a0[r]); a1[r] = __builtin_amdgcn_exp2f(a1[r]); ps += a0[r]; ps2 += a1[r]; }
    lsum += ps + ps2;
    bf16x8 pf[4]; pf[0] = pack_p(a0, 0); pf[1] = pack_p(a0, 8); pf[2] = pack_p(a1, 0); pf[3] = pack_p(a1, 8);
    pv_tile(o0, o1, sm + bufA + vrd, pf);
    {
        float ta = fmaxf(fmaxf(b0[0], b0[1]), b1[0]), tb = fmaxf(fmaxf(b0[2], b0[3]), b1[1]);
        ta = fmaxf(fmaxf(ta, b1[2]), b1[3]);
#pragma unroll
        for (int r = 4; r < 16; r += 4) { ta = fmaxf(fmaxf(ta, b0[r]), b0[r + 1]); tb = fmaxf(fmaxf(tb, b0[r + 2]), b0[r + 3]); ta = fmaxf(fmaxf(ta, b1[r]), b1[r + 1]); tb = fmaxf(fmaxf(tb, b1[r + 2]), b1[r + 3]); }
        float tm = fmaxf(ta, tb) - carry;
        tm = fmaxf(tm, __shfl_xor(tm, 32));
        if (__any(tm > 0.f) || __any(carry != 0.f)) {
            const float dl = fmaxf(tm, 0.f), alpha = __builtin_amdgcn_exp2f(-dl), sh = carry + dl;
            mrun += dl; lsum *= alpha;
#pragma unroll
            for (int r = 0; r < 16; ++r) { b0[r] -= sh; b1[r] -= sh; o0[r] *= alpha; o1[r] *= alpha; negm[r] = -mrun; }
        }
    }
    ps = 0.f; ps2 = 0.f;
#pragma unroll
    for (int r = 0; r < 16; ++r) { b0[r] = __builtin_amdgcn_exp2f(b0[r]); b1[r] = __builtin_amdgcn_exp2f(b1[r]); ps += b0[r]; ps2 += b1[r]; }
    lsum += ps + ps2;
    pf[0] = pack_p(b0, 0); pf[1] = pack_p(b0, 8); pf[2] = pack_p(b1, 0); pf[3] = pack_p(b1, 8);
    pv_tile(o0, o1, sm + bufB + vrd, pf);
}
__device__ __forceinline__ float vadd1(float a, float b) { float r; asm("v_add_f32 %0, %1, %2" : "=v"(r) : "v"(a), "v"(b)); return r; }
__device__ __forceinline__ float att_max(const fa::f32x16& p0, const fa::f32x16& p1) {
    float ta = fmaxf(fmaxf(p0[0], p0[1]), p1[0]), tb = fmaxf(fmaxf(p0[2], p0[3]), p1[1]);
    ta = fmaxf(fmaxf(ta, p1[2]), p1[3]);
#pragma unroll
    for (int r = 4; r < 16; r += 4) { ta = fmaxf(fmaxf(ta, p0[r]), p0[r + 1]); tb = fmaxf(fmaxf(tb, p0[r + 2]), p0[r + 3]); ta = fmaxf(fmaxf(ta, p1[r]), p1[r + 1]); tb = fmaxf(fmaxf(tb, p1[r + 2]), p1[r + 3]); }
    return fmaxf(ta, tb);
}
__device__ __forceinline__ void att_shift(float tm, bool first, float& mrun, float& lsum, fa::f32x16& o0, fa::f32x16& o1) {
    tm = fmaxf(tm, __shfl_xor(tm, 32));
    if (first || __any(tm > mrun + 8.f)) {
        const float dl = first ? 0.f : fmaxf(tm - mrun, 0.f), alpha = __builtin_amdgcn_exp2f(-dl);
        mrun = first ? tm : mrun + dl; lsum *= alpha;
#pragma unroll
        for (int r = 0; r < 16; ++r) { o0[r] *= alpha; o1[r] *= alpha; }
    }
}
__device__ __forceinline__ void att_qk_exp(const LAS char* kb, const bf16x8 (&qf)[6], float nm, fa::f32x16& n0, fa::f32x16& n1, fa::f32x16& p0, fa::f32x16& p1, float& lsum, bf16x8 (&pf)[4]) {
    const fa::f32x16 zero = {0.f, 0.f, 0.f, 0.f, 0.f, 0.f, 0.f, 0.f, 0.f, 0.f, 0.f, 0.f, 0.f, 0.f, 0.f, 0.f};
    bf16x8 kc0 = *(const LAS bf16x8*)kb, kc1 = *(const LAS bf16x8*)(kb + 32 * fa::KP_A);
    float ps = 0.f, ps2 = 0.f;
#pragma unroll
    for (int st = 0; st < 6; ++st) {
        bf16x8 kn0 = kc0, kn1 = kc1;
        if (st < 5) { kn0 = *(const LAS bf16x8*)(kb + 32 * (st + 1)); kn1 = *(const LAS bf16x8*)(kb + 32 * fa::KP_A + 32 * (st + 1)); }
        n0 = __builtin_amdgcn_mfma_f32_32x32x16_bf16(kc0, qf[st], st == 0 ? zero : n0, 0, 0, 0);
        n1 = __builtin_amdgcn_mfma_f32_32x32x16_bf16(kc1, qf[st], st == 0 ? zero : n1, 0, 0, 0);
        constexpr int lo[7] = {0, 2, 6, 8, 10, 14, 16};
#pragma unroll
        for (int r = lo[st]; r < lo[st + 1]; ++r) {
            p0[r] = __builtin_amdgcn_exp2f(vadd1(p0[r], nm)); p1[r] = __builtin_amdgcn_exp2f(vadd1(p1[r], nm));
            ps += p0[r]; ps += p1[r]; }
        kc0 = kn0; kc1 = kn1;
        __builtin_amdgcn_sched_barrier(0);
    }
    lsum += ps + ps2;
    pf[0] = fa::pack_p(p0, 0); pf[1] = fa::pack_p(p0, 8); pf[2] = fa::pack_p(p1, 0); pf[3] = fa::pack_p(p1, 8);
}
__device__ __forceinline__ void att_exp_pack(fa::f32x16& p0, fa::f32x16& p1, float nm, float& lsum, bf16x8 (&pf)[4]) {
    float ps = 0.f, ps2 = 0.f;
#pragma unroll
    for (int r = 0; r < 16; ++r) { p0[r] = __builtin_amdgcn_exp2f(vadd1(p0[r], nm)); p1[r] = __builtin_amdgcn_exp2f(vadd1(p1[r], nm)); ps += p0[r]; ps += p1[r]; }
    lsum += ps + ps2;
    pf[0] = fa::pack_p(p0, 0); pf[1] = fa::pack_p(p0, 8); pf[2] = fa::pack_p(p1, 0); pf[3] = fa::pack_p(p1, 8);
}
__device__ __forceinline__ float att_pv_max(fa::f32x16& o0, fa::f32x16& o1, const LAS char* vb, const bf16x8 (&pf)[4], const fa::f32x16& n0, const fa::f32x16& n1) {
    using namespace fa;
    float ta = n0[0], tb = n1[0];
    s16x4 a0 = vtr(vb), a1 = vtr(vb + 512), b0 = vtr(vb + 4096), b1 = vtr(vb + 4096 + 512);
#pragma unroll
    for (int ks = 0; ks < 4; ++ks) {
        s16x4 na0 = a0, na1 = a1, nb0 = b0, nb1 = b1;
        if (ks < 3) { na0 = vtr(vb + (ks + 1) * 1024); na1 = vtr(vb + (ks + 1) * 1024 + 512); nb0 = vtr(vb + 4096 + (ks + 1) * 1024); nb1 = vtr(vb + 4096 + (ks + 1) * 1024 + 512); }
        const bf16x8 v0 = (bf16x8){a0[0], a0[1], a0[2], a0[3], a1[0], a1[1], a1[2], a1[3]}, v1 = (bf16x8){b0[0], b0[1], b0[2], b0[3], b1[0], b1[1], b1[2], b1[3]};
        o0 = __builtin_amdgcn_mfma_f32_32x32x16_bf16(v0, pf[ks], o0, 0, 0, 0);
        o1 = __builtin_amdgcn_mfma_f32_32x32x16_bf16(v1, pf[ks], o1, 0, 0, 0);
#pragma unroll
        for (int r = 4 * ks; r < 4 * ks + 4; ++r) { ta = fmaxf(ta, n0[r]); tb = fmaxf(tb, n1[r]); }
        a0 = na0; a1 = na1; b0 = nb0; b1 = nb1;
        __builtin_amdgcn_sched_barrier(0);
    }
    return fmaxf(ta, tb);
}
__device__ __forceinline__ void ph_attn_mfma(unsigned char* lds_, const bf16_t* Q, const bf16_t* Kb, const bf16_t* Vb, bf16_t* Z, int with_ctx, int u0, int ustep) { PH_IDS;
    using namespace fa;
    LAS char* sm = (LAS char*)lds_;
    const int lane = tid_ & 63, wid = __builtin_amdgcn_readfirstlane(tid_ >> 6), r32 = lane & 31, hi = lane >> 5;
    const int nunits = 256 + (with_ctx ? 32 : 0);
    const int koff0 = (tid_ / 12) * KP_A + (tid_ % 12) * 16, koff1 = ((tid_ + 512) / 12) * KP_A + ((tid_ + 512) % 12) * 16;
    const int voff = KT_A + ((tid_ & 7) >> 2) * 4096 + (tid_ >> 3) * 64 + (tid_ & 3) * 16;
    const int vrd = KT_A + ((lane >> 4) & 1) * 32 + (lane & 3) * 8 + (4 * hi + ((lane & 15) >> 2)) * 64;
    for (int u = u0; u < nunits; u += ustep) {
        const bool lat = u < 256; const int bh = lat ? (u >> 3) : (u - 256), qb = lat ? (u & 7) : 8;
        const int ntile = lat ? 36 : 4;
        const char* Kg = (const char*)(Kb + (size_t)bh * 2304 * 96); const char* Vg = (const char*)(Vb + (size_t)bh * 2304 * 64);
        const bf16_t* Qg = Q + ((size_t)bh * 2304 + qb * 256 + wid * 32 + r32) * 96;
        bf16x8 qf[6];
#pragma unroll
        for (int st = 0; st < 6; ++st) qf[st] = *(const bf16x8*)(Qg + 16 * st + 8 * hi);
        f32x16 o0, o1;
#pragma unroll
        for (int r = 0; r < 16; ++r) { o0[r] = 0.f; o1[r] = 0.f; }
        float mrun = 0.f, lsum = 0.f;
        f32x16 negm;
#pragma unroll
        for (int r = 0; r < 16; ++r) negm[r] = 0.f;
        u32x4 ka0, ka1, va, kb0, kb1, vb;
#define ATT_LOAD(k0_, k1_, v_, tt) do { const char* kg_ = Kg + (size_t)(tt) * 12288; const char* vg_ = Vg + (size_t)(tt) * 8192; \
            k0_ = *(const u32x4*)(kg_ + tid_ * 16); if (tid_ < 256) k1_ = *(const u32x4*)(kg_ + (tid_ + 512) * 16); v_ = *(const u32x4*)(vg_ + tid_ * 16); } while (0)
#define ATT_WRITE(k0_, k1_, v_, bo) do { *(LAS u32x4*)(sm + (bo) + koff0) = k0_; if (tid_ < 256) *(LAS u32x4*)(sm + (bo) + koff1) = k1_; *(LAS u32x4*)(sm + (bo) + voff) = v_; } while (0)
        ka1 = (u32x4){0u, 0u, 0u, 0u}; kb1 = ka1;
        const int npair = ntile >> 1;
        ATT_LOAD(ka0, ka1, va, 0); ATT_LOAD(kb0, kb1, vb, 1);
        __syncthreads();
        ATT_WRITE(ka0, ka1, va, 0); ATT_WRITE(kb0, kb1, vb, BUF_A);
        if (npair > 1) { ATT_LOAD(ka0, ka1, va, 2); ATT_LOAD(kb0, kb1, vb, 3); }
        __syncthreads();
        f32x16 a0, a1, b0, b1;
#pragma unroll
        for (int r = 0; r < 16; ++r) { a0[r] = 0.f; a1[r] = 0.f; }
        { const LAS char* kq0 = sm + r32 * KP_A + 16 * hi;
#pragma unroll
          for (int st = 0; st < 6; ++st) { const bf16x8 k0 = *(const LAS bf16x8*)(kq0 + 32 * st), k1 = *(const LAS bf16x8*)(kq0 + 32 * KP_A + 32 * st);
              a0 = __builtin_amdgcn_mfma_f32_32x32x16_bf16(k0, qf[st], a0, 0, 0, 0); a1 = __builtin_amdgcn_mfma_f32_32x32x16_bf16(k1, qf[st], a1, 0, 0, 0); } }
        float tmA = att_max(a0, a1);
        int cur = 0;
        for (int p = 0; p < npair; ++p) {
            const int nxt = cur == 4 * BUF_A ? 0 : cur + 2 * BUF_A;
            const bool more = p + 1 < npair;
            if (more) { ATT_WRITE(ka0, ka1, va, nxt); ATT_WRITE(kb0, kb1, vb, nxt + BUF_A); }
            if (p + 2 < npair) { ATT_LOAD(ka0, ka1, va, 2 * p + 4); ATT_LOAD(kb0, kb1, vb, 2 * p + 5); }
            bf16x8 pf[4];
            att_shift(tmA, p == 0, mrun, lsum, o0, o1);
            att_qk_exp(sm + cur + BUF_A + r32 * KP_A + 16 * hi, qf, -mrun, b0, b1, a0, a1, lsum, pf);
            const float tmB = att_pv_max(o0, o1, sm + cur + vrd, pf, b0, b1);
            att_shift(tmB, false, mrun, lsum, o0, o1);
            __syncthreads();
            if (more) {
                att_qk_exp(sm + nxt + r32 * KP_A + 16 * hi, qf, -mrun, a0, a1, b0, b1, lsum, pf);
                tmA = att_pv_max(o0, o1, sm + cur + BUF_A + vrd, pf, a0, a1);
            } else {
                att_exp_pack(b0, b1, -mrun, lsum, pf);
                pv_tile(o0, o1, sm + cur + BUF_A + vrd, pf);
            }
            cur = nxt;
        }
#undef ATT_LOAD
#undef ATT_WRITE
        lsum += __shfl_xor(lsum, 32);
        const float inv = 1.f / lsum;
        const int b = bh >> 2, h = bh & 3;
        const int row = (lat ? b * 2048 + qb * 256 : RL + b * 256) + wid * 32 + r32;
        bf16_t* op = Z + (size_t)row * ZW + C_QC + h * 64 + 4 * hi;
#pragma unroll
        for (int g = 0; g < 4; ++g) {
            u32x2 w0, w1; w0.x = pk2(o0[4 * g] * inv, o0[4 * g + 1] * inv); w0.y = pk2(o0[4 * g + 2] * inv, o0[4 * g + 3] * inv);
            w1.x = pk2(o1[4 * g] * inv, o1[4 * g + 1] * inv); w1.y = pk2(o1[4 * g + 2] * inv, o1[4 * g + 3] * inv);
            *(u32x2*)(op + 8 * g) = w0; *(u32x2*)(op + 32 + 8 * g) = w1;
        }
    }
    __syncthreads();
}

__device__ __forceinline__ void ret_tile(const LAS char* sm, int r32, int hi, int vrd, int buf, int kp0, int qw0, int qpos, float lgf, float lgb, float cf32, float cb32,
                                         const float (&ckf)[16], const float (&ckb)[16], const bf16x8 (&qf)[4], fa::f32x16& o0, fa::f32x16& o1) {
    using namespace fa;
    const LAS char* kb = sm + buf + r32 * KP_R + 16 * hi;
    f32x16 p0, p1;
#pragma unroll
    for (int r = 0; r < 16; ++r) { p0[r] = 0.f; p1[r] = 0.f; }
#pragma unroll
    for (int st = 0; st < 4; ++st) {
        const bf16x8 k0 = *(const LAS bf16x8*)(kb + 32 * st), k1 = *(const LAS bf16x8*)(kb + 32 * KP_R + 32 * st);
        p0 = __builtin_amdgcn_mfma_f32_32x32x16_bf16(k0, qf[st], p0, 0, 0, 0);
        p1 = __builtin_amdgcn_mfma_f32_32x32x16_bf16(k1, qf[st], p1, 0, 0, 0);
    }
    if (kp0 + 63 < qw0) {
        const float sq = __builtin_amdgcn_exp2f(lgf * (float)(qpos - kp0)), sq1 = sq * cf32;
#pragma unroll
        for (int r = 0; r < 16; ++r) { p0[r] = p0[r] * ckf[r] * sq; p1[r] = p1[r] * ckf[r] * sq1; }
    } else if (kp0 > qw0 + 31) {
        const float sq = __builtin_amdgcn_exp2f(lgb * (float)(kp0 - qpos)), sq1 = sq * cb32;
#pragma unroll
        for (int r = 0; r < 16; ++r) { p0[r] = p0[r] * ckb[r] * sq; p1[r] = p1[r] * ckb[r] * sq1; }
    } else {
        const int d0 = qpos - kp0 - 4 * hi;
#pragma unroll
        for (int r = 0; r < 16; ++r) {
            const float f0 = (float)(d0 - ((r & 3) + 8 * (r >> 2))), f1 = f0 - 32.f;
            const float w0 = __builtin_amdgcn_exp2f(lgf * fmaxf(f0, 0.f) + lgb * fmaxf(-f0, 0.f)) * (2.f - fminf(fabsf(f0), 1.f));
            const float w1 = __builtin_amdgcn_exp2f(lgf * fmaxf(f1, 0.f) + lgb * fmaxf(-f1, 0.f)) * (2.f - fminf(fabsf(f1), 1.f));
            p0[r] *= w0; p1[r] *= w1;
        }
    }
    bf16x8 pf[4]; pf[0] = pack_p(p0, 0); pf[1] = pack_p(p0, 8); pf[2] = pack_p(p1, 0); pf[3] = pack_p(p1, 8);
    pv_tile(o0, o1, sm + buf + vrd, pf);
}
__device__ __forceinline__ void ret_qk(const LAS char* sm, int r32, int hi, int buf, const bf16x8 (&qf)[4], fa::f32x16& p0, fa::f32x16& p1) {
    const LAS char* kb = sm + buf + r32 * fa::KP_R + 16 * hi;
#pragma unroll
    for (int r = 0; r < 16; ++r) { p0[r] = 0.f; p1[r] = 0.f; }
#pragma unroll
    for (int st = 0; st < 4; ++st) {
        const bf16x8 k0 = *(const LAS bf16x8*)(kb + 32 * st), k1 = *(const LAS bf16x8*)(kb + 32 * fa::KP_R + 32 * st);
        p0 = __builtin_amdgcn_mfma_f32_32x32x16_bf16(k0, qf[st], p0, 0, 0, 0);
        p1 = __builtin_amdgcn_mfma_f32_32x32x16_bf16(k1, qf[st], p1, 0, 0, 0);
    }
}
__device__ __forceinline__ void ret_tile_gen(const LAS char* sm, int r32, int hi, int vrd, int buf, int kp0, int qpos, float lgf, float lgb, const bf16x8 (&qf)[4], fa::f32x16& o0, fa::f32x16& o1) {
    using namespace fa;
    const LAS char* kb = sm + buf + r32 * KP_R + 16 * hi;
    f32x16 p0, p1;
#pragma unroll
    for (int r = 0; r < 16; ++r) { p0[r] = 0.f; p1[r] = 0.f; }
#pragma unroll
    for (int st = 0; st < 4; ++st) {
        const bf16x8 k0 = *(const LAS bf16x8*)(kb + 32 * st), k1 = *(const LAS bf16x8*)(kb + 32 * KP_R + 32 * st);
        p0 = __builtin_amdgcn_mfma_f32_32x32x16_bf16(k0, qf[st], p0, 0, 0, 0);
        p1 = __builtin_amdgcn_mfma_f32_32x32x16_bf16(k1, qf[st], p1, 0, 0, 0);
    }
    int d0 = qpos - kp0 - 4 * hi;
    asm volatile("" : "+v"(d0) : "v"(p0[15]), "v"(p1[15]));
#pragma unroll
    for (int r = 0; r < 16; ++r) {
        const float f0 = (float)(d0 - ((r & 3) + 8 * (r >> 2))), f1 = f0 - 32.f;
        const float w0 = __builtin_amdgcn_exp2f(lgf * fmaxf(f0, 0.f) + lgb * fmaxf(-f0, 0.f)) * (2.f - fminf(fabsf(f0), 1.f));
        const float w1 = __builtin_amdgcn_exp2f(lgf * fmaxf(f1, 0.f) + lgb * fmaxf(-f1, 0.f)) * (2.f - fminf(fabsf(f1), 1.f));
        p0[r] *= w0; p1[r] *= w1;
    }
    bf16x8 pf[4]; pf[0] = pack_p(p0, 0); pf[1] = pack_p(p0, 8); pf[2] = pack_p(p1, 0); pf[3] = pack_p(p1, 8);
    pv_tile(o0, o1, sm + buf + vrd, pf);
}
__device__ __forceinline__ void ph_ret_kv(unsigned char* lds_, const bf16_t* Z, const float* decay_logit, bf16_t* KVF, bf16_t* KVB, int vb, int vg) { PH_IDS;
    using namespace fa;
    LAS char* sm = (LAS char*)lds_;
    const int lane = tid_ & 63, wid = __builtin_amdgcn_readfirstlane(tid_ >> 6), r32 = lane & 31, hi = lane >> 5;
    const int vrd = ((lane >> 4) & 1) * 32 + (lane & 3) * 8 + (4 * hi + ((lane & 15) >> 2)) * 64;
    u32x4 pk[2], pv[2];
#define KV_ISSUE(uu) do { const int bh_ = (uu) / 18, ci_ = (uu) % 18, b_ = bh_ >> 2, h_ = bh_ & 3; const int r0_ = ci_ < 2 ? RL + b_ * 256 + 128 * ci_ : b_ * 2048 + 128 * (ci_ - 2); \
        _Pragma("unroll") for (int i = 0; i < 2; ++i) { const int p = tid_ + NT * i; const bf16_t* zr = Z + (size_t)(r0_ + (p >> 3)) * ZW + h_ * 64 + (p & 7) * 8; pk[i] = *(const u32x4*)(zr + C_RK); pv[i] = *(const u32x4*)(zr + C_RV); } } while (0)
    if (vb >= 0 && vb < 32 * 18) KV_ISSUE(vb);
    for (int u = vb >= 0 ? vb : 32 * 18; u < 32 * 18; u += vg) {
        const int bh = u / 18, h = bh & 3;
        const float lgf = -log1pf(__expf(-decay_logit[h])) * 1.4426950408889634f, lgb = -log1pf(__expf(-decay_logit[4 + h])) * 1.4426950408889634f;
        __syncthreads();
#pragma unroll
        for (int i = 0; i < 2; ++i) {
            const int p = tid_ + NT * i, row = p >> 3, c = p & 7, tile = row >> 6, key = row & 63;
            const int off = tile * 8192 + (c >> 2) * 4096 + key * 64 + (c & 3) * 16;
            *(LAS u32x4*)(sm + off) = pk[i];
            f32x4 va, vb; unpack8(pv[i], va, vb);
            const float wf = __builtin_amdgcn_exp2f(lgf * (float)(127 - row)), wb = __builtin_amdgcn_exp2f(lgb * (float)row);
            *(LAS u32x4*)(sm + 16384 + off) = pack8(va * wf, vb * wf);
            *(LAS u32x4*)(sm + 32768 + off) = pack8(va * wb, vb * wb);
        }
        if (u + vg < 32 * 18) KV_ISSUE(u + vg);
        __syncthreads();
        const int dir = wid >> 2, bd = (wid >> 1) & 1, be = wid & 1;
        f32x16 acc;
#pragma unroll
        for (int r = 0; r < 16; ++r) acc[r] = 0.f;
        const LAS char* ka = sm + bd * 4096 + vrd; const LAS char* vv = sm + 16384 + dir * 16384 + be * 4096 + vrd;
#pragma unroll
        for (int tile = 0; tile < 2; ++tile)
#pragma unroll
            for (int ks = 0; ks < 4; ++ks) {
                const s16x4 a0 = vtr(ka + tile * 8192 + ks * 1024), a1 = vtr(ka + tile * 8192 + ks * 1024 + 512), b0 = vtr(vv + tile * 8192 + ks * 1024), b1 = vtr(vv + tile * 8192 + ks * 1024 + 512);
                acc = __builtin_amdgcn_mfma_f32_32x32x16_bf16((bf16x8){a0[0], a0[1], a0[2], a0[3], a1[0], a1[1], a1[2], a1[3]}, (bf16x8){b0[0], b0[1], b0[2], b0[3], b1[0], b1[1], b1[2], b1[3]}, acc, 0, 0, 0);
            }
        bf16_t* o = (dir ? KVB : KVF) + ((size_t)u * 64 + be * 32 + r32) * 64 + bd * 32 + 4 * hi;
#pragma unroll
        for (int g = 0; g < 4; ++g) { u32x2 w; w.x = pk2n(acc[4 * g], acc[4 * g + 1]); w.y = pk2n(acc[4 * g + 2], acc[4 * g + 3]); *(u32x2*)(o + 8 * g) = w; }
    }
    __syncthreads();
}
#undef KV_ISSUE
__device__ __forceinline__ void ph_ret_chunk(unsigned char* lds_, bf16_t* Z, const bf16_t* KVF, const bf16_t* KVB, const float* decay_logit, const float* gn_w, int with_ctx, int u0, int ustep, unsigned* kvc, unsigned* barw) { PH_IDS;
    using namespace fa;
    LAS char* sm = (LAS char*)lds_;
    constexpr int ST_OFF = 4 * BUF_R, ST_SZ = 64 * KP_R;
    const int lane = tid_ & 63, wid = __builtin_amdgcn_readfirstlane(tid_ >> 6), r32 = lane & 31, hi = lane >> 5;
    const int nunits = 256 + (with_ctx ? 32 : 0);
    const int prow = tid_ >> 3, pc = tid_ & 7;
    const int koff = prow * KP_R + pc * 16;
    const int voff = KT_R + (pc >> 2) * 4096 + prow * 64 + (pc & 3) * 16;
    const int vrd = KT_R + ((lane >> 4) & 1) * 32 + (lane & 3) * 8 + (4 * hi + ((lane & 15) >> 2)) * 64;
    for (int u = u0; u < nunits; u += ustep) {
        const bool lat = u < 256; const int bh = lat ? (u >> 3) : (u - 256), qb = lat ? (u & 7) : 0, b = bh >> 2, h = bh & 3;
        const float lgf = -log1pf(__expf(-decay_logit[h])) * 1.4426950408889634f, lgb = -log1pf(__expf(-decay_logit[4 + h])) * 1.4426950408889634f;
        const int qw0 = qb * 256 + wid * 32, qpos = qw0 + r32;
        const int qrow = (lat ? b * 2048 : RL + b * 256) + qpos;
        bf16_t* zq = Z + (size_t)qrow * ZW;
        u32x4 sK[4], sV[4]; bf16x8 qf[4];
        { const size_t rb = (lat ? (size_t)b * 2048 + qb * 256 : (size_t)RL + b * 256);
#pragma unroll
          for (int j = 0; j < 4; ++j) { const bf16_t* zr = Z + (rb + 64 * j + prow) * ZW + h * 64 + pc * 8; sK[j] = *(const u32x4*)(zr + C_RK); sV[j] = *(const u32x4*)(zr + C_RV); } }
#pragma unroll
        for (int st = 0; st < 4; ++st) qf[st] = *(const bf16x8*)(zq + C_RQ + h * 64 + 16 * st + 8 * hi);
        if (kvc != nullptr && tid_ == 0) dep_spin(kvc, (unsigned)G_, barw);
        __syncthreads();
#pragma unroll
        for (int j = 0; j < 4; ++j) { *(LAS u32x4*)(sm + j * BUF_R + koff) = sK[j]; *(LAS u32x4*)(sm + j * BUF_R + voff) = sV[j]; }
        {
            const float g128f = __builtin_amdgcn_exp2f(lgf * 128.f), g128b = __builtin_amdgcn_exp2f(lgb * 128.f);
            const bf16_t* kf = KVF + (size_t)bh * 18 * 4096 + tid_ * 8; const bf16_t* kb = KVB + (size_t)bh * 18 * 4096 + tid_ * 8;
            LAS char* sto = sm + ST_OFF + (tid_ >> 3) * KP_R + (tid_ & 7) * 16;
            f32x4 sa = (f32x4){0.f, 0.f, 0.f, 0.f}, sb = sa, ta, tb;
#define ST_PUT(k) (*(LAS u32x4*)(sto + (k) * ST_SZ) = pack8(sa, sb))
#define ST_STEP(ptr, ci_, g_) do { unpack8(*(const u32x4*)((ptr) + (size_t)(ci_) * 4096), ta, tb); sa = sa * (g_) + ta; sb = sb * (g_) + tb; } while (0)
            if (lat) {
                const int cA = 2 * qb, n1 = 2 + cA, nb = 16 - cA;
                u32x4 Lq[9], Lr[9]; f32x4 sc = (f32x4){0.f, 0.f, 0.f, 0.f}, sd = sc;
#define ST_PUTB(k) (*(LAS u32x4*)(sto + (k) * ST_SZ) = pack8(sc, sd))
#pragma unroll
                for (int hf = 0; hf < 2; ++hf) {
#pragma unroll
                    for (int k = 0; k < 9; ++k) { const int kk = 9 * hf + k;
                        if (kk <= n1 && kk < 17) Lq[k] = *(const u32x4*)(kf + (size_t)kk * 4096);
                        if (kk <= nb && kk < 17) Lr[k] = *(const u32x4*)(kb + (size_t)(kk == 0 ? 1 : (kk == 1 ? 0 : 19 - kk)) * 4096); }
#pragma unroll
                    for (int k = 0; k < 9; ++k) { const int kk = 9 * hf + k;
                        if (kk == n1) ST_PUT(0); if (kk <= n1 && kk < 17) { unpack8(Lq[k], ta, tb); sa = sa * g128f + ta; sb = sb * g128f + tb; }
                        if (kk == nb) ST_PUTB(3); if (kk <= nb && kk < 17) { unpack8(Lr[k], ta, tb); sc = sc * g128b + ta; sd = sd * g128b + tb; } }
                    asm volatile("" ::: "memory"); }
                ST_PUT(1); ST_PUTB(2);
#undef ST_PUTB
            } else {
                ST_PUT(0); ST_PUT(3);
                ST_STEP(kf, 0, g128f); ST_PUT(1);
                sa = (f32x4){0.f, 0.f, 0.f, 0.f}; sb = sa; ST_STEP(kb, 1, g128b); ST_PUT(2);
            }
#undef ST_PUT
#undef ST_STEP
        }
        __syncthreads();
        u32x2 gtv[8]; f32x4 gwv[8];
#pragma unroll
        for (int g = 0; g < 4; ++g)
#pragma unroll
            for (int blk = 0; blk < 2; ++blk) { const int d = blk * 32 + 8 * g + 4 * hi; gtv[2 * g + blk] = *(const u32x2*)(zq + C_RG + h * 64 + d); gwv[2 * g + blk] = *(const f32x4*)(gn_w + h * 64 + d); }
        f32x16 o0, o1;
#pragma unroll
        for (int r = 0; r < 16; ++r) { o0[r] = 0.f; o1[r] = 0.f; }
        const int cl = wid >> 2, c0 = qb * 256 + 128 * cl;
        ret_tile_gen(sm, r32, hi, vrd, (2 * cl) * BUF_R, c0, qpos, lgf, lgb, qf, o0, o1);
        __builtin_amdgcn_sched_barrier(0);
        ret_tile_gen(sm, r32, hi, vrd, (2 * cl + 1) * BUF_R, c0 + 64, qpos, lgf, lgb, qf, o0, o1);
        __builtin_amdgcn_sched_barrier(0);
        { f32x16 p0, p1;
          ret_qk(sm, r32, hi, ST_OFF + cl * ST_SZ, qf, p0, p1);
          const float sf = __builtin_amdgcn_exp2f(lgf * (float)(qpos - c0 + 1));
#pragma unroll
          for (int r = 0; r < 16; ++r) { o0[r] += p0[r] * sf; o1[r] += p1[r] * sf; }
          ret_qk(sm, r32, hi, ST_OFF + (2 + cl) * ST_SZ, qf, p0, p1);
          const float sbk = __builtin_amdgcn_exp2f(lgb * (float)(c0 + 128 - qpos));
#pragma unroll
          for (int r = 0; r < 16; ++r) { o0[r] += p0[r] * sbk; o1[r] += p1[r] * sbk; } }
        float s1 = 0.f;
#pragma unroll
        for (int r = 0; r < 16; ++r) s1 += o0[r] + o1[r];
        s1 += __shfl_xor(s1, 32);
        const float mu = s1 * (1.f / 64);
        float s2 = 0.f;
#pragma unroll
        for (int r = 0; r < 16; ++r) { const float a = o0[r] - mu, c = o1[r] - mu; s2 += a * a + c * c; }
        s2 += __shfl_xor(s2, 32);
        const float rstd = rsqrtf(s2 * (1.f / 64) + EPS);
#pragma unroll
        for (int g = 0; g < 4; ++g)
#pragma unroll
            for (int blk = 0; blk < 2; ++blk) {
                const int d = blk * 32 + 8 * g + 4 * hi;
                const u32x2 gt = gtv[2 * g + blk];
                const f32x4 gw = gwv[2 * g + blk];
                float y[4];
#pragma unroll
                for (int q = 0; q < 4; ++q) { const float ov = blk ? o1[4 * g + q] : o0[4 * g + q]; const unsigned gb = q < 2 ? gt.x : gt.y; const float gv = __uint_as_float((q & 1) ? (gb & 0xffff0000u) : (gb << 16));
                    y[q] = siluf_(gv) * ((ov - mu) * rstd * gw[q]); }
                u32x2 w; w.x = pk2(y[0], y[1]); w.y = pk2(y[2], y[3]);
                *(u32x2*)(zq + C_RQ + h * 64 + d) = w;
            }
    }
    __syncthreads();
}

__device__ __forceinline__ void ph_ret_mfma(unsigned char* lds_, bf16_t* Z, const float* decay_logit, const float* gn_w, int with_ctx, int u0, int ustep) { PH_IDS;
    using namespace fa;
    LAS char* sm = (LAS char*)lds_;
    const int lane = tid_ & 63, wid = __builtin_amdgcn_readfirstlane(tid_ >> 6), r32 = lane & 31, hi = lane >> 5;
    const int nunits = 256 + (with_ctx ? 32 : 0);
    const int prow = tid_ >> 3, pc = tid_ & 7;
    const int koff = prow * KP_R + pc * 16;
    const int voff = KT_R + (pc >> 2) * 4096 + prow * 64 + (pc & 3) * 16;
    const int vrd = KT_R + ((lane >> 4) & 1) * 32 + (lane & 3) * 8 + (4 * hi + ((lane & 15) >> 2)) * 64;
    for (int u = u0; u < nunits; u += ustep) {
        const bool lat = u < 256; const int bh = lat ? (u >> 3) : (u - 256), qb = lat ? (u & 7) : 0, b = bh >> 2, h = bh & 3;
        const int ntile = lat ? 40 : 4;
        const float lgf = -log1pf(__expf(-decay_logit[h])) * 1.4426950408889634f, lgb = -log1pf(__expf(-decay_logit[4 + h])) * 1.4426950408889634f;
        const int qw0 = qb * 256 + wid * 32, qpos = qw0 + r32;
        const int qrow = (lat ? b * 2048 : RL + b * 256) + qpos;
        float ckf[16], ckb[16];
#pragma unroll
        for (int r = 0; r < 16; ++r) { const float off = (float)crow(r, hi); ckf[r] = __builtin_amdgcn_exp2f(-lgf * off); ckb[r] = __builtin_amdgcn_exp2f(lgb * off); }
        const float cf32 = __builtin_amdgcn_exp2f(-lgf * 32.f), cb32 = __builtin_amdgcn_exp2f(lgb * 32.f);
        bf16_t* zq = Z + (size_t)qrow * ZW;
        bf16x8 qf[4];
#pragma unroll
        for (int st = 0; st < 4; ++st) qf[st] = *(const bf16x8*)(zq + C_RQ + h * 64 + 16 * st + 8 * hi);
        f32x16 o0, o1;
#pragma unroll
        for (int r = 0; r < 16; ++r) { o0[r] = 0.f; o1[r] = 0.f; }
        const int ctx0 = RL + b * 256, lat0 = b * 2048;
#define RET_TILE_ROW(t) (lat ? ((t) < 4 ? ctx0 + 64 * (t) : ((t) < 36 ? lat0 + 64 * ((t) - 4) : ctx0 + 64 * ((t) - 36))) : ctx0 + 64 * (t))
#define RET_TILE_POS(t) (lat ? 64 * (t) - 256 : 64 * (t))
        u32x4 ka, va, kb2, vb2;
#define RET_LOAD(k_, v_, tt) do { const bf16_t* zr_ = Z + (size_t)(RET_TILE_ROW(tt) + prow) * ZW + h * 64 + pc * 8; k_ = *(const u32x4*)(zr_ + C_RK); v_ = *(const u32x4*)(zr_ + C_RV); } while (0)
#define RET_WRITE(k_, v_, bo) do { *(LAS u32x4*)(sm + (bo) + koff) = k_; *(LAS u32x4*)(sm + (bo) + voff) = v_; } while (0)
        RET_LOAD(ka, va, 0); RET_LOAD(kb2, vb2, 1);
        __syncthreads();
        RET_WRITE(ka, va, 0); RET_WRITE(kb2, vb2, BUF_R);
        __syncthreads();
        for (int t = 0; t < ntile; t += 2) {
            const int pb = (t & 2) * BUF_R, nb = 2 * BUF_R - pb;
            if (t + 2 < ntile) { RET_LOAD(ka, va, t + 2); RET_LOAD(kb2, vb2, t + 3); }
            ret_tile(sm, r32, hi, vrd, pb, RET_TILE_POS(t), qw0, qpos, lgf, lgb, cf32, cb32, ckf, ckb, qf, o0, o1);
            ret_tile(sm, r32, hi, vrd, pb + BUF_R, RET_TILE_POS(t + 1), qw0, qpos, lgf, lgb, cf32, cb32, ckf, ckb, qf, o0, o1);
            if (t + 2 < ntile) { RET_WRITE(ka, va, nb); RET_WRITE(kb2, vb2, nb + BUF_R); }
            __syncthreads();
        }
#undef RET_LOAD
#undef RET_WRITE
#undef RET_TILE_ROW
#undef RET_TILE_POS
        float s1 = 0.f;
#pragma unroll
        for (int r = 0; r < 16; ++r) s1 += o0[r] + o1[r];
        s1 += __shfl_xor(s1, 32);
        const float mu = s1 * (1.f / 64);
        float s2 = 0.f;
#pragma unroll
        for (int r = 0; r < 16; ++r) { const float a = o0[r] - mu, c = o1[r] - mu; s2 += a * a + c * c; }
        s2 += __shfl_xor(s2, 32);
        const float rstd = rsqrtf(s2 * (1.f / 64) + EPS);
#pragma unroll
        for (int g = 0; g < 4; ++g)
#pragma unroll
            for (int blk = 0; blk < 2; ++blk) {
                const int d = blk * 32 + 8 * g + 4 * hi;
                const u32x2 gt = *(const u32x2*)(zq + C_RG + h * 64 + d);
                const f32x4 gw = *(const f32x4*)(gn_w + h * 64 + d);
                float y[4];
#pragma unroll
                for (int q = 0; q < 4; ++q) { const float ov = blk ? o1[4 * g + q] : o0[4 * g + q]; const unsigned gb = q < 2 ? gt.x : gt.y; const float gv = __uint_as_float((q & 1) ? (gb & 0xffff0000u) : (gb << 16));
                    y[q] = siluf_(gv) * ((ov - mu) * rstd * gw[q]); }
                u32x2 w; w.x = pk2(y[0], y[1]); w.y = pk2(y[2], y[3]);
                *(u32x2*)(zq + C_RQ + h * 64 + d) = w;
            }
    }
    __syncthreads();
}

struct SchedGrid {
    const char* A; const char* B; unsigned lda, ldb; int nt, nM, nN, G, c, kind, aux;
    __device__ __forceinline__ bool next(int i, pg8::Unit& u) const {
        int pm, pn; if (!pg8::static_tile(nM, nN, G, c, i, pm, pn)) return false;
        u.A = A + (size_t)pm * 256 * lda; u.B = B + (size_t)pn * 256 * ldb; u.lda = lda; u.ldb = ldb; u.nt = nt; u.pm = pm; u.pn = pn; u.kind = kind; u.aux = aux; return true; }
};
struct SchedP1 {
    const char* A; const char* B; int G, c, last;
    __device__ __forceinline__ bool next(int i, pg8::Unit& u) const {
        int pm, pn;
        if (!last) { if (!pg8::static_tile(RT / 256, 8, G, c, i, pm, pn)) return false; }
        else { if (!pg8::static_tile(RL / 256, 8, G, c, i, pm, pn)) { const int j = i * G + c - (RL / 256) * 8; if (j < 0 || j >= 32) return false; pm = RL / 256 + (j >> 2); pn = j & 3; } }
        u.A = A + (size_t)pm * 256 * 2048; u.B = B + (size_t)pn * 256 * 2048; u.lda = 2048; u.ldb = 2048; u.nt = 16; u.pm = pm; u.pn = pn; u.kind = 0; u.aux = 0; return true; }
};
struct SchedMerge {
    const char* Z; const char* XN; const char* WBR; const char* WING; const char* OC; int njobs, G, vcu, nmini;
    __device__ __forceinline__ bool next(int i, pg8::Unit& u) const {
        int sub, n, pm, pn, part = 0;
        if (nmini > 0 && i >= 8) { if (i >= 10 || vcu >= nmini) return false; sub = i & 1; n = vcu & 3; pn = (vcu >> 2) & 3; pm = RL / 256 + (vcu >> 4); part = 1; }
        else { const int job = (i >> 3) * G + vcu; if (job >= njobs) return false; sub = i & 7; n = sub >> 1; pm = job >> 2; pn = job & 3; }
        u.pm = pm; u.pn = pn; u.aux = n;
        if (!(sub & 1)) { const int bcol = n == 0 ? C_QC : (n == 1 ? C_FU : C_RQ);
            if (n == 2) { u.A = OC + (size_t)pm * 256 * 512; u.lda = 512; } else { u.A = Z + ((size_t)pm * 256 * ZW + bcol) * 2; u.lda = ZW * 2; } u.B = WBR + ((size_t)n * 1024 + pn * 256) * 512; u.ldb = 512; u.nt = 4; u.kind = 0; }
        else { u.A = XN + (size_t)pm * 256 * 2048; u.lda = 2048; u.B = WING + ((size_t)n * 1024 + pn * 256) * 2048; u.ldb = 2048; u.nt = 16; u.kind = part ? 2 : 1; }
        return true; }
};
struct SchedFfnDown {
    const char* H; const char* W2; int G, c, nctx;
    __device__ __forceinline__ bool next(int i, pg8::Unit& u) const {
        int pm, pn;
        if (pg8::static_tile(RL / 256, 4, G, c, i, pm, pn)) { u.A = H + (size_t)pm * 256 * 8192; u.B = W2 + (size_t)pn * 256 * 8192; u.lda = 8192; u.ldb = 8192; u.nt = 64; u.pm = pm; u.pn = pn; u.kind = 0; u.aux = 0; return true; }
        const int j = i * G + c - (RL / 256) * 4; if (j < 0 || j >= nctx) return false;
        pm = RL / 256 + (j >> 4); pn = (j >> 2) & 3; const int kq = j & 3;
        u.A = H + (size_t)pm * 256 * 8192 + kq * 2048; u.B = W2 + (size_t)pn * 256 * 8192 + kq * 2048; u.lda = 8192; u.ldb = 8192; u.nt = 16; u.pm = pm; u.pn = pn; u.kind = 3; u.aux = kq; return true; }
};
#define EPI_FOREACH(...) _Pragma("unroll") for (int ai = 0; ai < 2; ++ai) _Pragma("unroll") for (int m = 0; m < 4; ++m) _Pragma("unroll") for (int bj = 0; bj < 2; ++bj) { \
        const int row = u.pm * 256 + ai * 128 + wr * 64 + m * 16 + fr, col = u.pn * 256 + bj * 128 + wc * 32 + 8 * fq; const f32x4 v0 = acc[ai][bj][m][0], v1 = acc[ai][bj][m][1]; (void)row; (void)col; __VA_ARGS__ }
struct EpiStore { static constexpr bool PRE = false;
    bf16_t* O; int ld; int act;
    __device__ __forceinline__ void operator()(const f32x4 (&acc)[2][2][4][2], const pg8::Unit& u, int wr, int wc, int fr, int fq) const {
        EPI_FOREACH( f32x4 a = v0, b = v1; if (act == 1) { _Pragma("unroll") for (int q = 0; q < 4; ++q) { const float ra = fmaxf(a[q], 0.f), rb = fmaxf(b[q], 0.f); a[q] = ra * ra; b[q] = rb * rb; } }
            *(pg8::u32x4*)(O + (size_t)row * ld + col) = pack8(a, b); )
    }
};
struct EpiFfnUp {
    static constexpr bool PRE = true;
    bf16_t* O; const float* ss; const float* cf; LAS float* red;
    __device__ __forceinline__ void pre_issue(const pg8::Unit& u, int tid, f32x4& v) const {
        if (tid < 256) v = *(const f32x4*)(ss + ((size_t)u.pm * 256 + tid) * 4);
        else v[0] = cf[(size_t)(u.pm < 64 ? (u.pm >> 3) : 8) * DFF + u.pn * 256 + (tid - 256)]; }
    __device__ __forceinline__ void pre_commit(int tid, int par, const f32x4& v) const {
        red[par * 512 + tid] = tid < 256 ? rsqrtf((v[0] + v[1] + v[2] + v[3]) * (1.f / DM) + EPS) : v[0]; }
    __device__ __forceinline__ void operator()(const f32x4 (&acc)[2][2][4][2], const pg8::Unit& u, int wr, int wc, int fr, int fq, int par) const {
        const LAS float* rp = red + par * 512 + wr * 64 + fr; const LAS float* cp = rp - (wr * 64 + fr) + 256 + wc * 32 + 8 * fq;
        EPI_FOREACH( const f32x4 c0 = *(const LAS f32x4*)(cp + bj * 128), c1 = *(const LAS f32x4*)(cp + bj * 128 + 4); const float r = rp[ai * 128 + m * 16]; f32x4 a, b;
            _Pragma("unroll") for (int q = 0; q < 4; ++q) { const float ra = fmaxf(v0[q] * r + c0[q], 0.f), rb = fmaxf(v1[q] * r + c1[q], 0.f); a[q] = ra * ra; b[q] = rb * rb; }
            *(pg8::u32x4*)(O + (size_t)row * DFF + col) = pack8(a, b); )
    }
};
template <int T> __device__ __forceinline__ void ld8(const void* base, size_t o, f32x4& a, f32x4& b) {
    if constexpr (T == 0) { const float* p = (const float*)base + o; a = *(const f32x4*)p; b = *(const f32x4*)(p + 4); } else unpack8(*(const pg8::u32x4*)((const bf16_t*)base + o), a, b); }
template <int T> __device__ __forceinline__ void st8(void* base, size_t o, const f32x4 a, const f32x4 b) {
    if constexpr (T == 0) { float* p = (float*)base + o; *(f32x4*)p = a; *(f32x4*)(p + 4) = b; } else *(pg8::u32x4*)((bf16_t*)base + o) = pack8(a, b); }
template <int XIN, int XOUT>
struct EpiResid { static constexpr bool PRE = false;
    const void* xlat; const void* xctx; void* olat; void* octx; const float* mod; int gch; float* part;
    bf16_t* an; const float* wmf; float* ss; LAS float* red;
    __device__ __forceinline__ void operator()(const f32x4 (&acc)[2][2][4][2], const pg8::Unit& u, int wr, int wc, int fr, int fq) const {
        if (u.kind == 3) { float* pb = part + (size_t)u.aux * RC * DM - (size_t)RL * DM;
            EPI_FOREACH( const size_t o = (size_t)row * DM + col; *(f32x4*)(pb + o) = v0; *(f32x4*)(pb + o + 4) = v1; if (bj) asm volatile("" ::: "memory"); )
            return; }
        const bool lat = u.pm < 64; const void* xb = lat ? xlat : xctx; void* ob = lat ? olat : octx; const size_t rb = lat ? 0 : (size_t)RL * DM;
        const float* g = mod + (size_t)(lat ? (u.pm >> 3) : 8) * 6144 + gch * 1024;
        if (an == nullptr) {
        EPI_FOREACH( const f32x4 g0 = *(const f32x4*)(g + col), g1 = *(const f32x4*)(g + col + 4); const size_t o = (size_t)row * DM + col - rb;
            f32x4 x0, x1; ld8<XIN>(xb, o, x0, x1); st8<XOUT>(ob, o, x0 + g0 * v0, x1 + g1 * v1); if (bj) asm volatile("" ::: "memory"); )
        return; }
        const float* wm = wmf + (size_t)(lat ? (u.pm >> 3) : 8) * 1024;
        float sq = 0.f;
        EPI_FOREACH( const f32x4 g0 = *(const f32x4*)(g + col), g1 = *(const f32x4*)(g + col + 4); const size_t o = (size_t)row * DM + col - rb;
            f32x4 x0, x1; ld8<XIN>(xb, o, x0, x1); const f32x4 y0 = x0 + g0 * v0, y1 = x1 + g1 * v1; st8<XOUT>(ob, o, y0, y1);
            const f32x4 w0 = *(const f32x4*)(wm + col), w1 = *(const f32x4*)(wm + col + 4);
            *(pg8::u32x4*)(an + (size_t)row * DM + col) = pack8(y0 * w0, y1 * w1);
            sq += y0[0] * y0[0] + y0[1] * y0[1] + y0[2] * y0[2] + y0[3] * y0[3] + y1[0] * y1[0] + y1[1] * y1[1] + y1[2] * y1[2] + y1[3] * y1[3];
            if (bj) { sq += __shfl_xor(sq, 16); sq += __shfl_xor(sq, 32); if (fq == 0) red[wc * 256 + ai * 128 + wr * 64 + m * 16 + fr] = sq; sq = 0.f; asm volatile("" ::: "memory"); } )
        __syncthreads();
        { int t = threadIdx.x; asm volatile("" : "+v"(t)); if (t < 256) ss[((size_t)u.pm * 256 + t) * 4 + u.pn] = red[t] + red[256 + t] + red[512 + t] + red[768 + t]; }
    }
};
struct EpiMerge { static constexpr bool PRE = false;
    pg8::u32x4* stash; bf16_t* MMp; bf16_t* PMp;
    __device__ __forceinline__ void operator()(const f32x4 (&acc)[2][2][4][2], const pg8::Unit& u, int wr, int wc, int fr, int fq) const {
        int tid = threadIdx.x; asm volatile("" : "+v"(tid));
        if (u.kind == 0) { EPI_FOREACH( stash[((ai * 4 + m) * 2 + bj) * NT + tid] = pack8(v0, v1); if (bj && (m & 1)) asm volatile("" ::: "memory"); ) }
        else { EPI_FOREACH( f32x4 y0, y1; unpack8(stash[((ai * 4 + m) * 2 + bj) * NT + tid], y0, y1); f32x4 t0, t1;
                _Pragma("unroll") for (int q = 0; q < 4; ++q) { t0[q] = sigmoidf_(v0[q]) * y0[q]; t1[q] = sigmoidf_(v1[q]) * y1[q]; }
                pg8::u32x4* mp = (pg8::u32x4*)((u.kind == 2 && u.aux != 0 ? PMp + (size_t)(u.aux - 1) * RC * DM - (size_t)RL * DM : MMp) + (size_t)row * DM + col);
                if (u.kind == 1 && u.aux != 0) { f32x4 p0, p1; unpack8(*mp, p0, p1); t0 += p0; t1 += p1; }
                *mp = pack8(t0, t1); if (bj && (m & 1)) asm volatile("" ::: "memory"); ) }
    }
};
struct TItem { const float* W; bf16_t* WT; const float* kscale; int K, N, row_off, item; };
__device__ __forceinline__ void titem_load(const TItem& t, int lane, f32x4 (&v)[8]) {
    const int nblk = t.N / 32, kb = t.item / nblk, nb = t.item % nblk;
    const float* p = t.W + (size_t)(64 * kb + (lane >> 3)) * t.N + 32 * nb + 4 * (lane & 7);
#pragma unroll
    for (int i = 0; i < 8; ++i) v[i] = *(const f32x4*)(p + (size_t)(8 * i) * t.N);
}
__device__ __forceinline__ void titem_store(const TItem& t, int lane, const f32x4 (&v)[8], LAS float* scr) {
    const int nblk = t.N / 32, kb = t.item / nblk, nb = t.item % nblk, k0 = 64 * kb, n0 = 32 * nb;
#pragma unroll
    for (int i = 0; i < 8; ++i) { const int kk = 8 * i + (lane >> 3); f32x4 w = v[i]; if (t.kscale) w *= t.kscale[k0 + kk];
        LAS float* sp = scr + kk * 33 + 4 * (lane & 7); sp[0] = w[0]; sp[1] = w[1]; sp[2] = w[2]; sp[3] = w[3]; }
    asm volatile("s_waitcnt lgkmcnt(0)" ::: "memory");
    const int c = lane & 7;
#pragma unroll
    for (int j = 0; j < 4; ++j) { const int n = (lane >> 3) + 8 * j; const LAS float* sp = scr + (8 * c) * 33 + n;
        pg8::u32x4 o; o.x = pg8::cvt_pk_bf16(sp[0 * 33], sp[1 * 33]); o.y = pg8::cvt_pk_bf16(sp[2 * 33], sp[3 * 33]); o.z = pg8::cvt_pk_bf16(sp[4 * 33], sp[5 * 33]); o.w = pg8::cvt_pk_bf16(sp[6 * 33], sp[7 * 33]);
        *(pg8::u32x4*)(t.WT + (size_t)(t.row_off + n0 + n) * t.K + k0 + 8 * c) = o; }
    asm volatile("s_waitcnt lgkmcnt(0)" ::: "memory");
}
__device__ __forceinline__ void ph_convert_weights(unsigned char* lds, int l, const float* w_in, const float* w1, const float* w2, const float* w_out, const float* w_br, const float* w_glu,
                                                   const float* w_uq, const float* q_norm, const float* w_ukv, const float* kv_norm, unsigned char* ws) { PH_IDS;
    const int wave = __builtin_amdgcn_readfirstlane(tid_ >> 6), lane = tid_ & 63;
    LAS float* scr = (LAS float*)((LAS unsigned char*)lds + wave * 16384);
    const int gw = bid_ * 8 + wave, NGW = G_ * 8;
    constexpr int I_IN = 16 * 189, I_1 = 16 * 128, I_2 = 64 * 32, I_O = 16 * 32, I_B = 4 * 32;
    constexpr int I_G = 4 * 16;
    constexpr int I_UQ = 4 * 12, I_UKV = 2 * 16;
    constexpr int NITEMS = I_IN + I_1 + I_2 + I_O + 4 * I_B + I_G + I_UQ + I_UKV;
    bf16_t* WIN_T = (bf16_t*)(ws + WS_WIN); bf16_t* W1_T = (bf16_t*)(ws + WS_W1); bf16_t* W2_T = (bf16_t*)(ws + WS_W2); bf16_t* WOUT_T = (bf16_t*)(ws + WS_WOUT); bf16_t* WBR_T = (bf16_t*)(ws + WS_WBR);
    auto decode = [&](int it) -> TItem {
        TItem t; t.kscale = nullptr; t.row_off = 0; int r = it;
        if (r < I_IN) { t.W = w_in + (size_t)l * DM * INC; t.K = DM; t.N = INC; t.WT = WIN_T; t.row_off = (r % 189) >= 61 ? 96 : 0; t.item = r; return t; } r -= I_IN;
        if (r < I_1) { t.W = w1 + (size_t)l * DM * DFF; t.K = DM; t.N = DFF; t.WT = W1_T; t.item = r; return t; } r -= I_1;
        if (r < I_2) { t.W = w2 + (size_t)l * DFF * DM; t.K = DFF; t.N = DM; t.WT = W2_T; t.item = r; return t; } r -= I_2;
        if (r < I_O) { t.W = w_out + (size_t)l * DM * DM; t.K = DM; t.N = DM; t.WT = WOUT_T; t.item = r; return t; } r -= I_O;
        if (r < 4 * I_B) { const int n = r / I_B; t.W = w_br + ((size_t)l * 4 + n) * 256 * DM; t.K = 256; t.N = DM; t.WT = WBR_T + (size_t)n * 1024 * 256; t.item = r % I_B; return t; } r -= 4 * I_B;
        if (r < I_G) { const int n0 = (r % 16) * 32;
            t.W = w_glu + (size_t)l * 256 * 512; t.K = 256; t.N = 512; t.WT = (bf16_t*)(ws + WS_WGLU); t.row_off = n0 < 128 ? 0 : (n0 < 256 ? 128 : (n0 < 384 ? -128 : 0)); t.item = r; return t; } r -= I_G;
        if (r < I_UQ) { t.W = w_uq + (size_t)l * 256 * 384; t.K = 256; t.N = 384; t.WT = (bf16_t*)(ws + WS_WUQ); t.kscale = q_norm + l * 256; t.item = r; return t; } r -= I_UQ;
        t.W = w_ukv + (size_t)l * 128 * 512; t.K = 128; t.N = 512; t.WT = (bf16_t*)(ws + WS_WUKV); t.kscale = kv_norm + l * 128; t.item = r; return t;
    };
    if (gw < NITEMS) {
        TItem cur = decode(gw); f32x4 v[8]; titem_load(cur, lane, v);
        for (int it = gw; it < NITEMS; it += NGW) {
            const bool more = it + NGW < NITEMS;
            TItem nxt = cur; f32x4 vn[8];
            if (more) { nxt = decode(it + NGW); titem_load(nxt, lane, vn); }
            titem_store(cur, lane, v, scr);
            if (more) { cur = nxt;
#pragma unroll
                for (int i = 0; i < 8; ++i) v[i] = vn[i]; }
        }
    }
    GSTRIDE(gi, 96 * 1024 / 8) { *(pg8::u32x4*)(WIN_T + (size_t)1952 * 1024 + (size_t)gi * 8) = (pg8::u32x4){0u, 0u, 0u, 0u}; }
    __syncthreads();
}

struct EpiFourier { static constexpr bool PRE = false;
    bf16_t* Zp; int rowbase, L; float scale;
    __device__ __forceinline__ void operator()(const f32x4 (&acc)[2][2][4][2], const pg8::Unit& u, int wr, int wc, int fr, int fq) const {
        EPI_FOREACH( *(pg8::u32x4*)(Zp + ((size_t)rowbase + (size_t)u.pn * L + row) * ZW + C_FU + (col - u.pn * 256)) = pack8(v0 * scale, v1 * scale); )
    }
};
__device__ __forceinline__ void ph_f2a(unsigned char* lds_, const bf16_t* F1, const float* trig, bf16_t* BP) { PH_IDS;
    const int lane = tid_ & 63, wid = __builtin_amdgcn_readfirstlane(tid_ >> 6), c16 = lane & 15, kq = lane >> 4;
    LAS char* wi = (LAS char*)lds_ + wid * 16384;
    LAS char* wo = wi + 8192;
    bf16x8 are, aim;
#pragma unroll
    for (int j = 0; j < 8; ++j) { const int t2 = 8 * (kq & 1) + j, idx = ((c16 * t2) & 15) * 128; const float cs = trig[idx], sn = trig[2048 + idx];
        are[j] = (short)f2bf((kq >> 1) ? -sn : cs); aim[j] = (short)f2bf((kq >> 1) ? cs : sn); }
    for (int col = bid_ * 8 + wid; col < NB * 256; col += G_ * 8) {
        const pg8::u32x4* src = (const pg8::u32x4*)(F1 + (size_t)col * 4096);
        pg8::u32x4 st[8];
#pragma unroll
        for (int i = 0; i < 8; ++i) st[i] = src[lane + 64 * i];
#pragma unroll
        for (int i = 0; i < 8; ++i) *(LAS pg8::u32x4*)(wi + (lane + 64 * i) * 16) = st[i];
        asm volatile("s_waitcnt lgkmcnt(0)" ::: "memory");
#pragma unroll 2
        for (int nb = 0; nb < 8; ++nb) {
            const int t1 = 16 * nb + c16;
            bf16x8 bf;
#pragma unroll
            for (int j = 0; j < 8; ++j) bf[j] = *(const LAS short*)(wi + ((kq >> 1) * 2048 + t1 + 128 * (8 * (kq & 1) + j)) * 2);
            const f32x4 z4 = (f32x4){0.f, 0.f, 0.f, 0.f};
            const f32x4 re = __builtin_amdgcn_mfma_f32_16x16x32_bf16(are, bf, z4, 0, 0, 0), im = __builtin_amdgcn_mfma_f32_16x16x32_bf16(aim, bf, z4, 0, 0, 0);
#pragma unroll
            for (int r = 0; r < 4; ++r) { const int k2 = 4 * kq + r, idx = k2 * t1; const float cs = trig[idx], sn = trig[2048 + idx];
                *(LAS bf16_t*)(wo + ((k2 * 2 + 0) * 128 + t1) * 2) = f2bf(re[r] * cs - im[r] * sn);
                *(LAS bf16_t*)(wo + ((k2 * 2 + 1) * 128 + t1) * 2) = f2bf(re[r] * sn + im[r] * cs); }
        }
        asm volatile("s_waitcnt lgkmcnt(0)" ::: "memory");
        pg8::u32x4* dst = (pg8::u32x4*)(BP + (size_t)col * 4096);
#pragma unroll
        for (int i = 0; i < 8; ++i) dst[lane + 64 * i] = *(const LAS pg8::u32x4*)(wo + (lane + 64 * i) * 16);
        asm volatile("s_waitcnt lgkmcnt(0)" ::: "memory");
    }
    __syncthreads();
}
struct SchedFourier2 { static constexpr bool DEP = false;
    const char* AT; const char* BP; int c;
    __device__ __forceinline__ bool next(int i, pg8::Unit& u) const {
        if (i != 0) return false;
        const int j = c & 7, b = c >> 3;
        u.A = AT; u.lda = 1024; u.B = BP + ((size_t)b * 256 * 4096 + (size_t)j * 512) * 2; u.ldb = 8192; u.nt = 8; u.pm = j; u.pn = b; u.kind = 0; u.aux = 0; return true; }
};
struct EpiFourier2 { static constexpr bool PRE = false;
    bf16_t* Zp; float scale;
    __device__ __forceinline__ void operator()(const f32x4 (&acc)[2][2][4][2], const pg8::Unit& u, int wr, int wc, int fr, int fq) const {
#pragma unroll
        for (int ai = 0; ai < 2; ++ai)
#pragma unroll
            for (int m = 0; m < 4; ++m)
#pragma unroll
                for (int bj = 0; bj < 2; ++bj) {
                    const int k1 = wr * 64 + m * 16 + fr, k = 16 * k1 + 2 * u.pm + ai, gm = bj * 128 + wc * 32 + 8 * fq;
                    *(pg8::u32x4*)(Zp + ((size_t)u.pn * 2048 + k) * ZW + C_FU + gm) = pack8(acc[ai][bj][m][0] * scale, acc[ai][bj][m][1] * scale);
                }
    }
};
struct EpiGlu { static constexpr bool PRE = false;
    bf16_t* OCp;
    __device__ __forceinline__ void operator()(const f32x4 (&acc)[2][2][4][2], const pg8::Unit& u, int wr, int wc, int fr, int fq) const {
#pragma unroll
        for (int ai = 0; ai < 2; ++ai)
#pragma unroll
            for (int m = 0; m < 4; ++m) {
                const int row = u.pm * 256 + ai * 128 + wr * 64 + m * 16 + fr, col = u.pn * 128 + wc * 32 + 8 * fq;
                f32x4 a, b;
#pragma unroll
                for (int q = 0; q < 4; ++q) { a[q] = acc[ai][0][m][0][q] * sigmoidf_(acc[ai][1][m][0][q]); b[q] = acc[ai][0][m][1][q] * sigmoidf_(acc[ai][1][m][1][q]); }
                *(pg8::u32x4*)(OCp + (size_t)row * 256 + col) = pack8(a, b);
            }
    }
};
__device__ __forceinline__ void ph_dft_gen(const float* trig, bf16_t* AT, bf16_t* DC) { PH_IDS;
    GSTRIDE(gi, 256 * 512) {
        const int r = gi >> 9, c = gi & 511, h = r >> 7, k1 = r & 127, hh = c >> 8, part = (c >> 7) & 1, t1 = c & 127, idx = ((k1 * t1) & 127) * 16;
        AT[gi] = f2bf(h != hh ? 0.f : (part ? -trig[2048 + idx] : trig[idx]));
    }
    GSTRIDE(gi, 256 * 512 / 8) {
        const int k = gi >> 6, kk0 = (gi & 63) * 8; pg8::u32x4 w; unsigned pr[4];
#pragma unroll
        for (int q = 0; q < 4; ++q) { float v[2];
#pragma unroll
            for (int e = 0; e < 2; ++e) { const int kk = kk0 + 2 * q + e, part = kk >> 8, t = kk & 255, idx = ((k * t) & 255) * 8; v[e] = part ? -trig[2048 + idx] : trig[idx]; }
            pr[q] = pg8::cvt_pk_bf16(v[0], v[1]); }
        w.x = pr[0]; w.y = pr[1]; w.z = pr[2]; w.w = pr[3];
        *(pg8::u32x4*)(DC + (size_t)k * 512 + kk0) = w;
    }
}

__device__ __forceinline__ void ph_sum_mm(bf16_t* MMp, const bf16_t* PMp) { PH_IDS;
    GSTRIDE(gi, RC * DM / 8) {
        pg8::u32x4* mp = (pg8::u32x4*)(MMp + (size_t)RL * DM) + gi;
        f32x4 a, b; unpack8(*mp, a, b);
#pragma unroll
        for (int n = 0; n < 3; ++n) { f32x4 c, d; unpack8(*((const pg8::u32x4*)(PMp + (size_t)n * RC * DM) + gi), c, d); a += c; b += d; }
        *mp = pack8(a, b);
    }
}
__device__ __forceinline__ void ph_sum_ffn(bf16_t* XC, const float* PD, const float* mod) { PH_IDS;
    GSTRIDE(gi, RC * DM / 8) {
        const int col = (gi * 8) & (DM - 1);
        f32x4 a0 = *((const f32x4*)PD + 2 * gi), a1 = *((const f32x4*)PD + 2 * gi + 1);
#pragma unroll
        for (int n = 1; n < 4; ++n) { a0 += *((const f32x4*)(PD + (size_t)n * RC * DM) + 2 * gi); a1 += *((const f32x4*)(PD + (size_t)n * RC * DM) + 2 * gi + 1); }
        const f32x4 g0 = *(const f32x4*)(mod + (size_t)8 * 6144 + 5 * 1024 + col), g1 = *(const f32x4*)(mod + (size_t)8 * 6144 + 5 * 1024 + col + 4);
        f32x4 x0, x1; ld8<1>(XC, (size_t)gi * 8, x0, x1); st8<1>(XC, (size_t)gi * 8, x0 + g0 * a0, x1 + g1 * a1);
    }
}

constexpr size_t WS_BAR = 768 * 1024;
constexpr int LDS_BYTES = 147456;
struct Args { const float* in[30]; float* out; unsigned char* ws; };
typedef const __attribute__((address_space(4))) Args* CArgs;
__device__ __forceinline__ CArgs kargs() { CArgs p = (CArgs)__builtin_amdgcn_kernarg_segment_ptr(); asm volatile("" : "+s"(p)); return p; }
#define IN(i) (kargs()->in[i])
#define WSB(T, off) ((T*)(kargs()->ws + (off)))
#define OSB(T, off) ((T*)((unsigned char*)kargs()->out + (off)))
#define OUTP (kargs()->out)
enum { I_X = 0, I_C, I_CTX, I_CCTX, I_ADAW, I_ADAB, I_NMIX, I_NFFN, I_WIN, I_QNORM, I_WUQ, I_KVNORM, I_WUKV, I_QKQ, I_QKK, I_LRE, I_LIM, I_LSTEP, I_BRE, I_BIM, I_CRE, I_CIM, I_S5D, I_WGLU, I_RDEC, I_RGN, I_WBR, I_WOUT, I_W1, I_W2 };
#define GRID_BAR() do { bar.bar = WSB(unsigned, WS_BAR); { unsigned x_ = bar.x; asm volatile("" : "+s"(x_)); bar.x = x_; } xcd_barrier(bar); } while (0)
template <int L> __device__ __forceinline__ void layer_body(unsigned char* lds, XcdBarrier& bar) {
    constexpr int l = L;
    constexpr bool LASTL = (L == DEPTH - 1);
    constexpr int NMT = LASTL ? RL / 256 : RT / 256;
    constexpr int WCTX = LASTL ? 0 : 1;

#define MODL (WSB(float, WS_MOD) + (size_t)l * 9 * 6144)
#define XLAT (l == 0 ? (const void*)IN(I_X) : (const void*)WSB(bf16_t, WS_R))
#define XCTX (l == 0 ? (const void*)IN(I_CTX) : (const void*)WSB(bf16_t, WS_XCB))
    constexpr int XIN = (L == 0) ? 0 : 1;
#define WINL (IN(I_WIN) + (size_t)l * DM * INC)
#define ZP WSB(bf16_t, WS_Z)
#define XNP WSB(bf16_t, WS_XN)
#define QP WSB(bf16_t, WS_QKV)
#define KP (WSB(bf16_t, WS_QKV) + (size_t)32 * 2304 * 96)
#define VP (WSB(bf16_t, WS_QKV) + (size_t)2 * 32 * 2304 * 96)
#define F1LAT WSB(bf16_t, WS_F1)
#define F1CTX (WSB(bf16_t, WS_F1) + (size_t)8 * 256 * 2 * 2048)
#define QRAWP WSB(bf16_t, WS_RAW)
#define KVRAWP (WSB(bf16_t, WS_RAW) + (size_t)RT * 384)
        ph_s5_lp(l, IN(I_LRE), IN(I_LIM), IN(I_LSTEP), IN(I_BRE), IN(I_BIM), WSB(float2, WS_LP), WSB(float2, WS_BB), WSB(float, WS_LAMT));
        ph_adarms<XIN>(XLAT, XCTX, IN(I_NMIX) + l * DM, MODL, 0, 1, XNP, RT);
        ph_convert_weights(lds, l, IN(I_WIN), IN(I_W1), IN(I_W2), IN(I_WOUT), IN(I_WBR), IN(I_WGLU), IN(I_WUQ), IN(I_QNORM), IN(I_WUKV), IN(I_KVNORM), kargs()->ws);
        if (l == 0) ph_dft_gen(WSB(float, WS_TRIG), OSB(bf16_t, OS_AT), OSB(bf16_t, OS_DFTC));
        ph_wmf(IN(I_NFFN) + l * DM, MODL, WSB(float, WS_WMF));
        GRID_BAR();
        { SchedP1 S; S.A = (const char*)XNP; S.B = (const char*)WSB(bf16_t, WS_WIN); S.G = l_grid(); S.c = l_bid(); S.last = LASTL ? 1 : 0;
          EpiStore E; E.O = ZP; E.ld = ZW; E.act = 0; pg8::gemm_phase((LAS unsigned char*)lds, S, E); }
        { const int G = l_grid(), bx = l_bid(), n3 = G == 256 ? (LASTL ? 32 : 64) : 0;
          if (bx >= n3) { const int vb = bx - n3, vg = G - n3;
            ph_s5_tz(lds, l, WSB(float2, WS_LP), WSB(float2, WS_BB), IN(I_CRE), IN(I_CIM), WSB(float, WS_TZ), vb, vg);
            ph_s5_ms(WSB(float2, WS_LP), WSB(float2, WS_BB), WSB(bf16_t, WS_MS), vb, vg);
            ph_cf_mfma(lds, WSB(bf16_t, WS_W1), MODL, WSB(float, WS_CF), vb, vg); } }
        GRID_BAR();
        ph_s5_tzb(l, WSB(float, WS_TZ), IN(I_S5D) + l * 256, OSB(bf16_t, OS_TZB), IN(I_CRE), IN(I_CIM), OSB(bf16_t, OS_CQ));
        ph_prep(ZP, WSB(bf16_t, WS_WUQ), WSB(bf16_t, WS_WUKV), WSB(bf16_t, WS_D64), IN(I_QKQ) + l * 96, IN(I_QKK) + l * 96, QP, KP, VP, F1LAT, F1CTX, lds);
        ph_s5_sloc(lds, ZP, WSB(bf16_t, WS_MS), OSB(float, OS_SLOC));
        GRID_BAR();
        unsigned* kvc_ = WSB(unsigned, WS_BAR) + XCD_BAR_WORDS + 128 + 1024 * l;
        unsigned* f2c_ = kvc_ + 640;
        ph_f2a(lds, F1LAT, WSB(float, WS_TRIG), OSB(bf16_t, OS_BP));
        dep_signal_x(f2c_, f2c_ + 32 + 16 * bar.x, bar.st[0]);
        { const int G = l_grid(), bx = l_bid(), nf = G == 256 ? (LASTL ? 64 : 72) : 0;
          ph_ret_kv(lds, ZP, IN(I_RDEC) + l * 8, WSB(bf16_t, WS_KVF), OSB(bf16_t, OS_KVB), bx - nf, G - nf);
          dep_signal_x(kvc_, kvc_ + 32 + 16 * bar.x, bar.st[0]); }
        {
            const int bx = l_bid();
            if (bx < 64) { if (l_tid() == 0) dep_spin(f2c_, (unsigned)l_grid(), WSB(unsigned, WS_BAR)); __syncthreads();
                SchedFourier2 S; S.AT = (const char*)OSB(bf16_t, OS_AT); S.BP = (const char*)OSB(bf16_t, OS_BP); S.c = bx;
                EpiFourier2 E; E.Zp = ZP; E.scale = 0.0027621358640099515f; pg8::gemm_phase((LAS unsigned char*)lds, S, E); }
            else if (!LASTL && bx < 72) { SchedGrid S; S.A = (const char*)OSB(bf16_t, OS_DFTC); S.B = (const char*)F1CTX; S.lda = 1024; S.ldb = 1024; S.nt = 8; S.nM = 1; S.nN = 8; S.G = 8; S.c = bx - 64; S.kind = 0; S.aux = 0;
                EpiFourier E; E.Zp = ZP; E.rowbase = RL; E.L = 256; E.scale = 0.0078125f; pg8::gemm_phase((LAS unsigned char*)lds, S, E); }
            constexpr int NS5 = 16 * (LASTL ? 16 : 18);
            constexpr int NC = LASTL ? 0 : 32;
            constexpr int Q_ATT = 0, Q_ATTC = 256, Q_S5 = Q_ATTC + NC, Q_RET = Q_S5 + NS5, Q_RETC = Q_RET + 256, Q_END = Q_RETC + NC;
            volatile LAS int* qslot = (volatile LAS int*)((LAS unsigned char*)lds + LDS_BYTES - 32);
            unsigned* s5c_ = kvc_ + 320; bool s5sig_ = false;
            for (;;) {
                __syncthreads();
                if (l_tid() == 0) qslot[0] = (int)atomicAdd(WSB(unsigned, WS_BAR) + XCD_BAR_WORDS + 64 * l, 1u);
                __syncthreads();
                const int q = __builtin_amdgcn_readfirstlane(qslot[0]);
                if (!s5sig_ && q >= Q_RET) { dep_signal_x(s5c_, s5c_ + 32 + 16 * bar.x, bar.st[0]); s5sig_ = true; }
                if (q >= Q_END) break;
                if (q < Q_ATTC) ph_attn_mfma(lds, QP, KP, VP, ZP, WCTX, q - Q_ATT, 1 << 20);
                else if (q < Q_S5) ph_attn_mfma(lds, QP, KP, VP, ZP, WCTX, 256 + q - Q_ATTC, 1 << 20);
                else if (q < Q_RET) ph_s5_out(lds, ZP, OSB(bf16_t, OS_TZB), OSB(bf16_t, OS_CQ), WSB(float2, WS_LP), OSB(float, OS_SLOC), WSB(float, WS_LAMT), ZP, LASTL ? 16 : 18, q - Q_S5, 1 << 20);
                else if (q < Q_RETC) ph_ret_chunk(lds, ZP, WSB(bf16_t, WS_KVF), OSB(bf16_t, OS_KVB), IN(I_RDEC) + l * 8, IN(I_RGN) + l * 256, WCTX, q - Q_RET, 1 << 20, kvc_, WSB(unsigned, WS_BAR));
                else ph_ret_chunk(lds, ZP, WSB(bf16_t, WS_KVF), OSB(bf16_t, OS_KVB), IN(I_RDEC) + l * 8, IN(I_RGN) + l * 256, WCTX, 256 + q - Q_RETC, 1 << 20, kvc_, WSB(unsigned, WS_BAR));
            }
        }
        if (l_tid() == 0) dep_spin(kvc_ + 320, (unsigned)l_grid(), WSB(unsigned, WS_BAR));
        __syncthreads();
        { SchedGrid S; S.A = (const char*)(ZP + C_S5); S.B = (const char*)WSB(bf16_t, WS_WGLU); S.lda = ZW * 2; S.ldb = 512; S.nt = 4; S.nM = NMT; S.nN = 2; S.G = l_grid(); S.c = l_bid(); S.kind = 0; S.aux = 0;
          EpiGlu E; E.OCp = OSB(bf16_t, OS_OC); pg8::gemm_phase((LAS unsigned char*)lds, S, E); }
        GRID_BAR();
        { SchedMerge S; S.Z = (const char*)ZP; S.XN = (const char*)XNP; S.WBR = (const char*)WSB(bf16_t, WS_WBR); S.WING = (const char*)(WSB(bf16_t, WS_WIN) + (size_t)2048 * 1024); S.OC = (const char*)OSB(bf16_t, OS_OC);
          S.G = l_grid(); { const int bx = l_bid(); S.vcu = (bx % 8) * (S.G / 8) + bx / 8; }
          const bool mini = !LASTL && S.G == 256;
          S.njobs = mini ? RL / 256 * 4 : NMT * 4; S.nmini = mini ? 128 : 0;
          EpiMerge E; E.stash = WSB(pg8::u32x4, WS_STASH) + (size_t)l_bid() * 8192; E.MMp = WSB(bf16_t, WS_MM); E.PMp = OSB(bf16_t, OS_PM); pg8::gemm_phase((LAS unsigned char*)lds, S, E); }
        GRID_BAR();
        if (!LASTL && l_grid() == 256) { ph_sum_mm(WSB(bf16_t, WS_MM), OSB(bf16_t, OS_PM)); GRID_BAR(); }
        { SchedGrid S; S.A = (const char*)WSB(bf16_t, WS_MM); S.B = (const char*)WSB(bf16_t, WS_WOUT); S.lda = 2048; S.ldb = 2048; S.nt = 16; S.nM = NMT; S.nN = 4; S.G = l_grid(); S.c = l_bid(); S.kind = 0; S.aux = 0;
          EpiResid<XIN, 1> E; E.xlat = XLAT; E.xctx = XCTX; E.olat = WSB(bf16_t, WS_R); E.octx = WSB(bf16_t, WS_XCB); E.mod = MODL; E.gch = 2; E.part = nullptr; E.an = XNP; E.wmf = WSB(float, WS_WMF); E.ss = OSB(float, OS_SS); E.red = (LAS float*)((LAS unsigned char*)lds + 131072); pg8::gemm_phase((LAS unsigned char*)lds, S, E); }
        GRID_BAR();
        { SchedGrid S; S.A = (const char*)XNP; S.B = (const char*)WSB(bf16_t, WS_W1); S.lda = 2048; S.ldb = 2048; S.nt = 16; S.nM = NMT; S.nN = 16; S.G = l_grid(); S.c = l_bid(); S.kind = 0; S.aux = 0;
          EpiFfnUp E; E.O = WSB(bf16_t, WS_H); E.ss = OSB(float, OS_SS); E.cf = WSB(float, WS_CF); E.red = (LAS float*)((LAS unsigned char*)lds + 131072); pg8::gemm_phase((LAS unsigned char*)lds, S, E); }
        GRID_BAR();
        { SchedFfnDown S; S.H = (const char*)WSB(bf16_t, WS_H); S.W2 = (const char*)WSB(bf16_t, WS_W2); S.G = l_grid(); S.c = l_bid(); S.nctx = (!LASTL && S.G == 256) ? 128 : 0;
          EpiResid<1, LASTL ? 0 : 1> E; E.xlat = WSB(bf16_t, WS_R); E.xctx = WSB(bf16_t, WS_XCB); E.olat = LASTL ? (void*)OUTP : (void*)WSB(bf16_t, WS_R); E.octx = WSB(bf16_t, WS_XCB); E.mod = MODL; E.gch = 5; E.part = WSB(float, WS_PD); E.an = nullptr; E.wmf = nullptr; E.ss = nullptr; E.red = nullptr;
          if (!LASTL && S.G != 256) { SchedGrid S2; S2.A = S.H; S2.B = S.W2; S2.lda = 8192; S2.ldb = 8192; S2.nt = 64; S2.nM = NMT; S2.nN = 4; S2.G = S.G; S2.c = S.c; S2.kind = 0; S2.aux = 0; pg8::gemm_phase((LAS unsigned char*)lds, S2, E); }
          else pg8::gemm_phase((LAS unsigned char*)lds, S, E); }
        if (!LASTL && l_grid() == 256) { GRID_BAR(); ph_sum_ffn(WSB(bf16_t, WS_XCB), WSB(float, WS_PD), MODL); }
        if (l + 1 < DEPTH) GRID_BAR();
}
__global__ void __launch_bounds__(NT, 2) mega(Args a_unused) {
    extern __shared__ __attribute__((aligned(16))) unsigned char lds[];
    volatile LAS unsigned* bst = (volatile LAS unsigned*)((LAS unsigned char*)lds + LDS_BYTES - 16);
    if (threadIdx.x < 4) bst[threadIdx.x] = 0u;
    __syncthreads();
    XcdBarrier bar = xcd_barrier_post(WSB(unsigned, WS_BAR), bst);

    ph_mod(lds, IN(I_C), IN(I_CCTX), IN(I_ADAW), IN(I_ADAB), WSB(float, WS_MOD));
    ph_trig(WSB(float, WS_TRIG), WSB(bf16_t, WS_D64));
    GRID_BAR();
    layer_body<0>(lds, bar);
    layer_body<1>(lds, bar);
}

extern "C" void kernel_launch(void* const* d_in, const int* in_sizes, int n_in, void* d_out, int out_size, void* d_ws, size_t ws_size, hipStream_t stream) {
    static int grid = 0;
    if (grid == 0) {
        if (n_in != 30 || ws_size < WS_END) { fprintf(stderr, "kernel_launch: unexpected n_in %d / ws_size %zu\n", n_in, ws_size); grid = -1; return; }
        int dev = 0, cus = 0, per_cu = 0;
        if (hipGetDevice(&dev) != hipSuccess || hipDeviceGetAttribute(&cus, hipDeviceAttributeMultiprocessorCount, dev) != hipSuccess) { grid = -1; return; }
        if (hipFuncSetAttribute((const void*)mega, hipFuncAttributeMaxDynamicSharedMemorySize, LDS_BYTES) != hipSuccess) { fprintf(stderr, "kernel_launch: hipFuncSetAttribute failed\n"); grid = -1; return; }
        if (hipOccupancyMaxActiveBlocksPerMultiprocessor(&per_cu, (const void*)mega, NT, LDS_BYTES) != hipSuccess || per_cu < 1) fprintf(stderr, "kernel_launch: occupancy query says %d\n", per_cu);
        (void)hipGetLastError();
        grid = cus;
    }
    if (grid < 0) return;
    (void)hipMemsetAsync((char*)d_ws + WS_BAR, 0, (XCD_BAR_WORDS + 128 + 2048) * 4, stream);
    Args a; memset((void*)&a, 0, sizeof(a));
    for (int i = 0; i < 30; ++i) a.in[i] = (const float*)d_in[i];
    a.out = (float*)d_out; a.ws = (unsigned char*)d_ws;
    hipLaunchKernelGGL(mega, dim3(grid), dim3(NT), LDS_BYTES, stream, a);
}
```

```cpp
#include <hip/hip_runtime.h>
#include <cstdint>
#include <cstring>
#include <cstdio>

typedef unsigned short bf16_t;
typedef short bf16x8 __attribute__((ext_vector_type(8)));
typedef float f32x4 __attribute__((ext_vector_type(4)));

constexpr int DM = 1024, NB = 8, SEQ = 2048, CTX = 256, DEPTH = 2;
constexpr int RL = NB * SEQ;
constexpr int RC = NB * CTX;
constexpr int RT = RL + RC;
constexpr int INC = 6048;
constexpr int ZW = 2048;
constexpr int C_KVC = 0, C_KR = 128, C_S5 = 160, C_RK = 416, C_RV = 672, C_QC = 928, C_FU = 1184, C_RQ = 1440, C_RG = 1696, C_GATE = 1952;
constexpr int C_OC = C_RK;
constexpr int DFF = 4096;
constexpr int TCH = 64;
constexpr int NCH = RT / TCH;
constexpr float EPS = 1e-6f;
#define PI_D 3.14159265358979323846

__device__ __forceinline__ float bf2f(bf16_t v) { return __uint_as_float(((unsigned)v) << 16); }
__device__ __forceinline__ bf16_t f2bf(float f) { unsigned u = __float_as_uint(f); return (bf16_t)((u + 0x7fffu + ((u >> 16) & 1u)) >> 16); }
__device__ __forceinline__ float sigmoidf_(float x) { return 1.f / (1.f + __expf(-x)); }
__device__ __forceinline__ float siluf_(float x) { return x * sigmoidf_(x); }
__device__ __forceinline__ float geluf_(float x) { return 0.5f * x * (1.f + tanhf(0.7978845608028654f * (x + 0.044715f * x * x * x))); }
__device__ __forceinline__ int row_batch(int row) { return row < RL ? (row >> 11) : ((row - RL) >> 8); }
__device__ __forceinline__ int row_modidx(int row) { return row < RL ? (row >> 11) : 8; }

constexpr size_t MiB = 1ull << 20;
constexpr size_t WS_MOD = 0;
constexpr size_t WS_RS = 512 * 1024;
constexpr size_t WS_TRIG = 512 * 1024;
constexpr size_t WS_LAMT = WS_TRIG + 32 * 1024;
constexpr size_t WS_LP = 1 * MiB;
constexpr size_t WS_BB = 2 * MiB + 128 * 1024;
constexpr size_t WS_W = 8 * MiB;
constexpr size_t WS_WIN = WS_W, WS_W1 = WS_W + 12 * MiB, WS_W2 = WS_W + 20 * MiB, WS_WOUT = WS_W + 28 * MiB, WS_WBR = WS_W + 30 * MiB;
constexpr size_t WS_XN = 40 * MiB;
constexpr size_t WS_RAW = WS_XN;
constexpr size_t WS_YG = WS_XN;
constexpr size_t WS_Z = 76 * MiB;
constexpr size_t WS_QKV = 148 * MiB;
constexpr size_t WS_F1 = 184 * MiB;
constexpr size_t WS_GL = WS_F1;
constexpr size_t WS_TZ = 202 * MiB;
constexpr size_t WS_MS = 204 * MiB;
constexpr size_t WS_QO = 212 * MiB;
constexpr size_t WS_MM = WS_QKV;
constexpr size_t WS_STASH = WS_F1;
constexpr size_t WS_KVF = 3 * MiB + 512 * 1024;
constexpr size_t WS_PD = WS_XN;
constexpr size_t WS_H = WS_Z;
constexpr size_t WS_WUQ = 2 * MiB + 768 * 1024;
constexpr size_t WS_WUKV = 3 * MiB;
constexpr size_t WS_D64 = 512 * 1024 + 64 * 1024;
constexpr size_t WS_WGLU = 2 * MiB + 512 * 1024;
constexpr size_t WS_CF = 3 * MiB + 128 * 1024;
constexpr size_t WS_WMF = 3 * MiB + 320 * 1024;
constexpr size_t WS_R = 220 * MiB;
constexpr size_t WS_XCB = 252 * MiB;
constexpr size_t OS_AT = 0;
constexpr size_t OS_BP = 1 * MiB;
constexpr size_t OS_DFTC = 53 * MiB;
constexpr size_t OS_SLOC = 17 * MiB;
constexpr size_t OS_KVB = 22 * MiB;
constexpr size_t OS_PM = 27 * MiB;
constexpr size_t OS_TZB = 41 * MiB;
constexpr size_t OS_CQ = 42 * MiB;
constexpr size_t OS_OC = 43 * MiB;
constexpr size_t OS_SS = 40 * MiB;
constexpr size_t WS_END = 256 * MiB;


#define LAS __attribute__((address_space(3)))
#define NT 512
__device__ __forceinline__ int l_tid() { int t = threadIdx.x; asm volatile("" : "+v"(t)); return t; }
__device__ __forceinline__ int l_bid() { int b = blockIdx.x; asm volatile("" : "+s"(b)); return b; }
__device__ __forceinline__ int l_grid() { int g = gridDim.x; asm volatile("" : "+s"(g)); return g; }
#define PH_IDS const int tid_ = l_tid(), bid_ = l_bid(), G_ = l_grid(); (void)tid_; (void)bid_; (void)G_
template <class AF, class BF, class EF>
__device__ __forceinline__ void gemm_tile(const AF& A, const BF& B, const EF& E, bool valid, int b, int m0, int n0, int M, int N, int K, bf16_t (*sA)[40], bf16_t (*sB)[40], int ht) {
    f32x4 accm[2][2];
#pragma unroll
    for (int i = 0; i < 2; ++i)
#pragma unroll
        for (int j = 0; j < 2; ++j) accm[i][j] = (f32x4){0.f, 0.f, 0.f, 0.f};
    const int w = ht >> 6, lane = ht & 63, wm = (w >> 1) * 32, wn = (w & 1) * 32, fr = lane & 15, fq = lane >> 4;
    for (int k0 = 0; k0 < K; k0 += 32) {
        __syncthreads();
#pragma unroll
        for (int i = 0; i < 8; ++i) {
            const int e = ht + i * 256;
            { const int m = e >> 5, k = e & 31; float v = 0.f; if (valid && m0 + m < M && k0 + k < K) v = A(b, m0 + m, k0 + k); sA[m][k] = f2bf(v); }
            { const int k = e >> 6, n = e & 63; float v = 0.f; if (valid && n0 + n < N && k0 + k < K) v = B(b, k0 + k, n0 + n); sB[n][k] = f2bf(v); }
        }
        __syncthreads();
        bf16x8 af[2], bfr[2];
#pragma unroll
        for (int i = 0; i < 2; ++i) { af[i] = *(const bf16x8*)&sA[wm + i * 16 + fr][fq * 8]; bfr[i] = *(const bf16x8*)&sB[wn + i * 16 + fr][fq * 8]; }
#pragma unroll
        for (int i = 0; i < 2; ++i)
#pragma unroll
            for (int j = 0; j < 2; ++j) accm[i][j] = __builtin_amdgcn_mfma_f32_16x16x32_bf16(af[i], bfr[j], accm[i][j], 0, 0, 0);
    }
    if (valid) {
#pragma unroll
        for (int i = 0; i < 2; ++i)
#pragma unroll
            for (int j = 0; j < 2; ++j)
#pragma unroll
                for (int rr = 0; rr < 4; ++rr) {
                    const int m = m0 + wm + i * 16 + fq * 4 + rr, n = n0 + wn + j * 16 + fr;
                    if (m < M && n < N) E(b, m, n, accm[i][j][rr]);
                }
    }
}
template <class AF, class BF, class EF>
__device__ __forceinline__ void gemm_phase(unsigned char* lds, const AF& A, const BF& B, const EF& E, int nbatch, int M, int N, int K) {
    PH_IDS; const int tid = tid_, half = tid >> 8, ht = tid & 255;
    bf16_t (*sA)[40] = (bf16_t (*)[40])(lds + half * 10240);
    bf16_t (*sB)[40] = (bf16_t (*)[40])(lds + half * 10240 + 5120);
    const int tm = (M + 63) >> 6, tn = (N + 63) >> 6, total = nbatch * tm * tn;
    for (int it0 = bid_ * 2; it0 < total; it0 += G_ * 2) {
        const int it = it0 + half; const bool valid = it < total;
        const int itc = valid ? it : 0;
        const int b = itc / (tm * tn), r = itc % (tm * tn), m0 = (r / tn) * 64, n0 = (r % tn) * 64;
        gemm_tile(A, B, E, valid, b, m0, n0, M, N, K, sA, sB, ht);
    }
    __syncthreads();
}
template <class T> static T zeroed() { T t; memset((void*)&t, 0, sizeof(T)); return t; }

struct A_bf16 { const bf16_t* p; long long ld; long long coff;
    __device__ float operator()(int, int m, int k) const { return bf2f(p[(size_t)m * ld + coff + k]); } };
struct A_bf16_scaled { const bf16_t* p; long long ld; long long coff; const float* rs; long long rsi; const float* w;
    __device__ float operator()(int, int m, int k) const { return bf2f(p[(size_t)m * ld + coff + k]) * rs[(size_t)m * 2 + rsi] * w[k]; } };
struct B_f32 { const float* p; long long ld; long long coff;
    __device__ float operator()(int, int k, int n) const { return p[(size_t)k * ld + coff + n]; } };
struct E_bf16 { bf16_t* p; long long ld; long long coff;
    __device__ void operator()(int, int m, int n, float v) const { p[(size_t)m * ld + coff + n] = f2bf(v); } };

#define XB_TMO      128
#define XB_XCNT(j)  (256  + 64 * (j))
#define XB_XSUB(j)  (1280 + 64 * (j))
#define XB_XGEN(j)  (2304 + 64 * (j))
#define XB_TOP      3328
#define XB_TOPGEN   3392
#define XCD_BAR_WORDS 3456
#define XB_SPIN_CAP (1u << 18)
__device__ __forceinline__ unsigned xb_ld(unsigned* p)              { return __hip_atomic_load(p, __ATOMIC_RELAXED, __HIP_MEMORY_SCOPE_AGENT); }
__device__ __forceinline__ unsigned xb_add(unsigned* p, unsigned v) { return __hip_atomic_fetch_add(p, v, __ATOMIC_RELAXED, __HIP_MEMORY_SCOPE_AGENT); }
__device__ __forceinline__ unsigned xb_xcc_id() { return (unsigned)__builtin_amdgcn_s_getreg((3 << 11) | 20) & 0xFu; }
#define XB_SPIN(cond, bar) do { unsigned _sp = 0; while (cond) { __builtin_amdgcn_s_sleep(1); \
    if ((++_sp & 255u) == 0u) { if (xb_ld(&(bar)[XB_TMO])) break; if (_sp > XB_SPIN_CAP) { atomicAdd(&(bar)[XB_TMO], 1u); break; } } } } while (0)
struct XcdBarrier { unsigned* bar; unsigned x; volatile LAS unsigned* st; };
__device__ __forceinline__ XcdBarrier xcd_barrier_post(unsigned* bar, volatile LAS unsigned* st) {
    XcdBarrier b; b.bar = bar; b.x = xb_xcc_id(); b.st = st;
    if (threadIdx.x == 0) (void)xb_add(&bar[XB_XCNT(b.x)], 1u);
    return b;
}
__device__ __forceinline__ void xcd_barrier_complete(unsigned* bar, unsigned x, unsigned& nloc, unsigned& nx) {
    const unsigned G = gridDim.x * gridDim.y * gridDim.z;
    unsigned sum, cnt, mine, sp = 0u;
    for (;;) {
        sum = 0u; cnt = 0u; mine = 0u;
#pragma unroll
        for (unsigned j = 0; j < 16; ++j) { const unsigned c = xb_ld(&bar[XB_XCNT(j)]); sum += c; cnt += (c > 0u) ? 1u : 0u; mine = (j == x) ? c : mine; }
        if (sum == G) break;
        __builtin_amdgcn_s_sleep(1);
        if ((++sp & 255u) == 0u) { if (xb_ld(&bar[XB_TMO])) break; if (sp > XB_SPIN_CAP) { atomicAdd(&bar[XB_TMO], 1u); break; } }
    }
    nloc = mine > 0u ? mine : 1u; nx = cnt > 0u ? cnt : 1u;
}
__device__ __forceinline__ void xcd_barrier(const XcdBarrier& b) {
    asm volatile("s_waitcnt vmcnt(0)" ::: "memory");
    __syncthreads();
    if (threadIdx.x == 0) {
        unsigned* bar = b.bar;
        __builtin_amdgcn_s_waitcnt(0);
        unsigned nloc = b.st[0], nx = b.st[1];
        if (nloc == 0u) { xcd_barrier_complete(bar, b.x, nloc, nx); b.st[0] = nloc; b.st[1] = nx; }
        const unsigned old = xb_add(&bar[XB_XSUB(b.x)], 1u);
        const unsigned gen = old / nloc;
        if (old + 1u == (gen + 1u) * nloc) {
            __builtin_amdgcn_fence(__ATOMIC_RELEASE, "agent");
            asm volatile("s_waitcnt vmcnt(0)" ::: "memory");
            const unsigned og = xb_add(&bar[XB_TOP], 1u);
            const unsigned tg = og / nx;
            if (og + 1u == (tg + 1u) * nx) xb_add(&bar[XB_TOPGEN], 1u);
            else XB_SPIN(xb_ld(&bar[XB_TOPGEN]) == tg, bar);
            __builtin_amdgcn_fence(__ATOMIC_ACQUIRE, "agent");
            xb_add(&bar[XB_XGEN(b.x)], 1u);
            asm volatile("s_waitcnt vmcnt(0)" ::: "memory");
        } else {
            XB_SPIN(xb_ld(&bar[XB_XGEN(b.x)]) == gen, bar);
            __builtin_amdgcn_fence(__ATOMIC_ACQUIRE, "agent");
            asm volatile("s_waitcnt vmcnt(0)" ::: "memory");
        }
    }
    __syncthreads();
}

__device__ __forceinline__ void dep_signal_x(unsigned* ctr, unsigned* sub, unsigned nloc) {
    asm volatile("s_waitcnt vmcnt(0)" ::: "memory");
    __syncthreads();
    if (threadIdx.x == 0) { const unsigned old = xb_add(sub, 1u);
        if (old + 1u == nloc) { __builtin_amdgcn_fence(__ATOMIC_RELEASE, "agent"); asm volatile("s_waitcnt vmcnt(0)" ::: "memory"); (void)xb_add(ctr, nloc); } }
}
__device__ __forceinline__ void dep_spin(unsigned* ctr, unsigned need, unsigned* bar) {
    XB_SPIN(xb_ld(ctr) < need, bar);
    __builtin_amdgcn_fence(__ATOMIC_ACQUIRE, "agent");
    asm volatile("s_waitcnt vmcnt(0)" ::: "memory");
}
namespace pg8 {
typedef unsigned u32x4 __attribute__((ext_vector_type(4)));
constexpr int BM = 256, BK = 64, HALF = 128, HTB = HALF * BK * 2, STAGE_BYTES = 8 * HTB, NXCD = 8, WGM = 8;
__device__ __forceinline__ int lds_byte(int r, int c) { const int st = (r >> 4) * 2 + (c >> 5), rr = r & 15, cc = c & 31, ob = rr * 64 + cc * 2; return st * 1024 + (ob ^ (((ob >> 9) & 1) << 5)); }
__device__ __forceinline__ void stage_rc(int b, int& R, int& C) { const int st = b / 1024, sb = b % 1024, swz = sb ^ (((sb >> 9) & 1) << 5); R = (st >> 1) * 16 + swz / 64; C = (st & 1) * 32 + (swz % 64) / 2; }
__device__ __forceinline__ int perm32(int rho) { const int n = rho >> 4, i = rho & 15; return 8 * (i >> 2) + 4 * n + (i & 3); }
struct Unit { const char* A; const char* B; unsigned lda, ldb; int nt, pm, pn, kind, aux; };
__device__ __forceinline__ unsigned cvt_pk_bf16(float lo, float hi) { unsigned r; asm volatile("v_cvt_pk_bf16_f32 %0, %1, %2" : "=v"(r) : "v"(lo), "v"(hi)); return r; }
__device__ __forceinline__ bool static_tile(int nM, int nN, int G, int c, int i, int& pm, int& pn) {
    const int nwg = nM * nN; const long L = (long)i * G + c; if (L >= nwg) return false;
    int wgid = (int)L; { const int q = nwg / NXCD, r = nwg % NXCD, xcd = wgid % NXCD, off = wgid / NXCD; wgid = (xcd < r ? xcd * (q + 1) : r * (q + 1) + (xcd - r) * q) + off; }
    const int nig = WGM * nN, gid = wgid / nig, fm = gid * WGM, gsz = (nM - fm) < WGM ? (nM - fm) : WGM;
    pm = fm + ((wgid % nig) % gsz); pn = (wgid % nig) / gsz; return true;
}
template <class Epi, class Sched>
__device__ __forceinline__ void gemm_phase(LAS unsigned char* lds, const Sched& S, const Epi& E) {
    const int tid = l_tid(), wid = __builtin_amdgcn_readfirstlane(tid >> 6), lane = tid & 63, wr = wid >> 2, wc = wid & 3, fr = lane & 15, fq = lane >> 4;
    int sR0, sC20;
    { int R, C; stage_rc(tid * 16, R, C); sR0 = R; sC20 = C * 2; }
#define PG8_R(i) (sR0 + 64 * (i))
#define PG8_RB(i) ((PG8_R(i) & ~31) + perm32(PG8_R(i) & 31))
    const size_t kstep = (size_t)(BK * 2);
    const unsigned ldsw = (unsigned)wid * 1024u;
    const int aoff = lds_byte(wr * 64 + fr, fq * 8), boff = lds_byte(wc * 32 + fr, fq * 8);
#define PG8_SA(b, h) (((b) * 2 + (h)) * HTB)
#define PG8_SB(b, h) ((4 + (b) * 2 + (h)) * HTB)
#define PG8_STAGE_A(bufoff, gbase, ld) do { \
        __builtin_amdgcn_global_load_lds((const unsigned*)((const char*)(gbase) + (unsigned)(PG8_R(0) * (ld) + sC20)), (LAS unsigned*)(lds + (bufoff) + ldsw), 16, 0, 0); \
        __builtin_amdgcn_global_load_lds((const unsigned*)((const char*)(gbase) + (unsigned)(PG8_R(1) * (ld) + sC20)), (LAS unsigned*)(lds + (bufoff) + ldsw + 8192), 16, 0, 0); } while (0)
#define PG8_STAGE_B(bufoff, gbase, ld) do { \
        __builtin_amdgcn_global_load_lds((const unsigned*)((const char*)(gbase) + (unsigned)(PG8_RB(0) * (ld) + sC20)), (LAS unsigned*)(lds + (bufoff) + ldsw), 16, 0, 0); \
        __builtin_amdgcn_global_load_lds((const unsigned*)((const char*)(gbase) + (unsigned)(PG8_RB(1) * (ld) + sC20)), (LAS unsigned*)(lds + (bufoff) + ldsw + 8192), 16, 0, 0); } while (0)
#define PG8_LDA(dst, b, h) do { _Pragma("unroll") for (int m = 0; m < 4; ++m) _Pragma("unroll") for (int k = 0; k < 2; ++k) dst[m][k] = *(const LAS bf16x8*)(lds + PG8_SA(b, h) + aoff + m * 2048 + k * 1024); } while (0)
#define PG8_LDB(dst, b, h) do { _Pragma("unroll") for (int n = 0; n < 2; ++n) _Pragma("unroll") for (int k = 0; k < 2; ++k) dst[n][k] = *(const LAS bf16x8*)(lds + PG8_SB(b, h) + boff + n * 2048 + k * 1024); } while (0)
#define PG8_MMA(ai, bj, At, Bt) do { __builtin_amdgcn_s_setprio(1); _Pragma("unroll") for (int m = 0; m < 4; ++m) _Pragma("unroll") for (int n = 0; n < 2; ++n) _Pragma("unroll") for (int k = 0; k < 2; ++k) \
        acc[ai][bj][m][n] = __builtin_amdgcn_mfma_f32_16x16x32_bf16(Bt[n][k], At[m][k], acc[ai][bj][m][n], 0, 0, 0); __builtin_amdgcn_s_setprio(0); } while (0)
#define PG8_WAIT_V(n) asm volatile("s_waitcnt vmcnt(" #n ")" ::: "memory")
#define PG8_WAIT_L(n) asm volatile("s_waitcnt lgkmcnt(" #n ")" ::: "memory")
#define PG8_BAR __builtin_amdgcn_s_barrier()
#define PG8_SCHED __builtin_amdgcn_sched_barrier(0)
    Unit cur, nxt; int ui = 0;
    if (!S.next(0, cur)) return;
    f32x4 prev_;
    if constexpr (Epi::PRE) { E.pre_issue(cur, tid, prev_); E.pre_commit(tid, 0, prev_); }
    f32x4 acc[2][2][4][2];
#pragma unroll
    for (int a = 0; a < 2; ++a)
#pragma unroll
        for (int b = 0; b < 2; ++b)
#pragma unroll
            for (int m = 0; m < 4; ++m)
#pragma unroll
                for (int n = 0; n < 2; ++n) acc[a][b][m][n] = (f32x4){0.f, 0.f, 0.f, 0.f};
    bf16x8 At[4][2], B0[2][2], B1[2][2];
    const char* cA = cur.A; const char* cB = cur.B;
    int clda = cur.lda, cldb = cur.ldb;
    PG8_STAGE_B(PG8_SB(0, 0), cB, cldb); PG8_STAGE_B(PG8_SB(0, 1), cB + (size_t)HALF * cldb, cldb); PG8_STAGE_A(PG8_SA(0, 0), cA, clda); PG8_STAGE_A(PG8_SA(0, 1), cA + (size_t)HALF * clda, clda);
    if (wr == 1) PG8_BAR;
    PG8_WAIT_V(2); PG8_BAR;
    PG8_STAGE_B(PG8_SB(1, 0), cB + kstep, cldb); PG8_STAGE_A(PG8_SA(1, 0), cA + kstep, clda); PG8_STAGE_B(PG8_SB(1, 1), cB + (size_t)HALF * cldb + kstep, cldb);
    PG8_WAIT_V(6); PG8_BAR;
    for (;;) {
        const bool has_next = S.next(ui + 1, nxt);
        const char* nA = has_next ? nxt.A : cA; const char* nB = has_next ? nxt.B : cB;
        const int nlda = has_next ? (int)nxt.lda : clda, nldb = has_next ? (int)nxt.ldb : cldb;
        const int nt = cur.nt;
        for (int t = 0; t < nt; t += 2) {
            const bool last = (t == nt - 2);
            const char* a1 = cA + (size_t)(t + 1) * kstep;
            const char* a2 = last ? nA : cA + (size_t)(t + 2) * kstep; const char* b2 = last ? nB : cB + (size_t)(t + 2) * kstep;
            const char* a3 = a2 + kstep; const char* b3 = b2 + kstep;
            const int lda2 = last ? nlda : clda, ldb2 = last ? nldb : cldb;
            PG8_LDB(B0, 0, 0); PG8_LDB(B1, 0, 1); PG8_SCHED; PG8_LDA(At, 0, 0); PG8_STAGE_A(PG8_SA(1, 1), a1 + (size_t)HALF * clda, clda);
            PG8_WAIT_V(8); PG8_WAIT_L(0); PG8_BAR; PG8_MMA(0, 0, At, B0); PG8_MMA(0, 1, At, B1); PG8_BAR; PG8_SCHED;
            PG8_LDA(At, 0, 1); PG8_STAGE_B(PG8_SB(0, 0), b2, ldb2); PG8_STAGE_B(PG8_SB(0, 1), b2 + (size_t)HALF * ldb2, ldb2); PG8_STAGE_A(PG8_SA(0, 0), a2, lda2);
            PG8_WAIT_V(8); PG8_WAIT_L(0); PG8_BAR; PG8_MMA(1, 0, At, B0); PG8_MMA(1, 1, At, B1); PG8_BAR; PG8_SCHED;
            PG8_LDB(B0, 1, 0); PG8_LDB(B1, 1, 1); PG8_SCHED; PG8_LDA(At, 1, 0); PG8_STAGE_A(PG8_SA(0, 1), a2 + (size_t)HALF * lda2, lda2);
            PG8_WAIT_V(8); PG8_WAIT_L(0); PG8_BAR; PG8_MMA(0, 0, At, B0); PG8_MMA(0, 1, At, B1); PG8_BAR; PG8_SCHED;
            PG8_LDA(At, 1, 1); PG8_STAGE_B(PG8_SB(1, 0), b3, ldb2); PG8_STAGE_B(PG8_SB(1, 1), b3 + (size_t)HALF * ldb2, ldb2); PG8_STAGE_A(PG8_SA(1, 0), a3, lda2);
            PG8_WAIT_V(8); PG8_WAIT_L(0); PG8_BAR; PG8_MMA(1, 0, At, B0); PG8_MMA(1, 1, At, B1); PG8_BAR; PG8_SCHED;
        }
        if (wr == 0) PG8_BAR;
        if constexpr (Epi::PRE) { if (has_next) E.pre_issue(nxt, tid, prev_); E(acc, cur, wr, wc, fr, fq, ui & 1); if (has_next) E.pre_commit(tid, (ui + 1) & 1, prev_); }
        else E(acc, cur, wr, wc, fr, fq);
        if (!has_next) break;
#pragma unroll
        for (int a = 0; a < 2; ++a)
#pragma unroll
            for (int b = 0; b < 2; ++b)
#pragma unroll
                for (int m = 0; m < 4; ++m)
#pragma unroll
                    for (int n = 0; n < 2; ++n) acc[a][b][m][n] = (f32x4){0.f, 0.f, 0.f, 0.f};
        cur = nxt; cA = nA; cB = nB; clda = nlda; cldb = nldb; ++ui;
        if (wr == 1) PG8_BAR;
    }
    PG8_WAIT_V(0);
    PG8_BAR;
#undef PG8_SA
#undef PG8_SB
#undef PG8_STAGE_A
#undef PG8_RB
#undef PG8_R
#undef PG8_STAGE_B
#undef PG8_LDA
#undef PG8_LDB
#undef PG8_MMA
#undef PG8_WAIT_V
#undef PG8_WAIT_L
#undef PG8_BAR
#undef PG8_SCHED
}
}

__device__ __forceinline__ pg8::u32x4 pack8(const f32x4 a, const f32x4 b) { pg8::u32x4 w; w.x = pg8::cvt_pk_bf16(a[0], a[1]); w.y = pg8::cvt_pk_bf16(a[2], a[3]); w.z = pg8::cvt_pk_bf16(b[0], b[1]); w.w = pg8::cvt_pk_bf16(b[2], b[3]); return w; }
__device__ __forceinline__ void unpack8(const pg8::u32x4 w, f32x4& a, f32x4& b) {
    a[0] = __uint_as_float(w.x << 16); a[1] = __uint_as_float(w.x & 0xffff0000u); a[2] = __uint_as_float(w.y << 16); a[3] = __uint_as_float(w.y & 0xffff0000u);
    b[0] = __uint_as_float(w.z << 16); b[1] = __uint_as_float(w.z & 0xffff0000u); b[2] = __uint_as_float(w.w << 16); b[3] = __uint_as_float(w.w & 0xffff0000u); }
namespace fa {
typedef float f32x16 __attribute__((ext_vector_type(16)));
typedef short s16x4 __attribute__((ext_vector_type(4)));
typedef unsigned u32x4 __attribute__((ext_vector_type(4)));
typedef unsigned u32x2 __attribute__((ext_vector_type(2)));
__device__ __forceinline__ s16x4 vtr(const LAS char* p) { return __builtin_bit_cast(s16x4, __builtin_amdgcn_ds_read_tr16_b64_v4i16((LAS s16x4*)p)); }
__device__ __forceinline__ unsigned pk2(float lo, float hi) { unsigned r; asm volatile("v_cvt_pk_bf16_f32 %0, %1, %2" : "=v"(r) : "v"(lo), "v"(hi)); return r; }
typedef __bf16 bf16v2_t __attribute__((ext_vector_type(2)));
typedef float f32v2_t __attribute__((ext_vector_type(2)));
__device__ __forceinline__ unsigned pk2n(float lo, float hi) { return __builtin_bit_cast(unsigned, __builtin_convertvector((f32v2_t){lo, hi}, bf16v2_t)); }
__device__ __forceinline__ bf16x8 pack_p(const f32x16& p, int base) { u32x4 w; w.x = pk2(p[base], p[base + 1]); w.y = pk2(p[base + 2], p[base + 3]); w.z = pk2(p[base + 4], p[base + 5]); w.w = pk2(p[base + 6], p[base + 7]); return __builtin_bit_cast(bf16x8, w); }
__device__ __forceinline__ int crow(int r, int hi) { return (r & 3) + 8 * (r >> 2) + 4 * hi; }
__device__ __forceinline__ void pv_tile(f32x16& o0, f32x16& o1, const LAS char* vb, const bf16x8 (&pf)[4]) {
#pragma unroll
    for (int ks = 0; ks < 4; ++ks) {
        const s16x4 a0 = vtr(vb + ks * 1024), a1 = vtr(vb + ks * 1024 + 512), b0 = vtr(vb + 4096 + ks * 1024), b1 = vtr(vb + 4096 + ks * 1024 + 512);
        const bf16x8 v0 = (bf16x8){a0[0], a0[1], a0[2], a0[3], a1[0], a1[1], a1[2], a1[3]}, v1 = (bf16x8){b0[0], b0[1], b0[2], b0[3], b1[0], b1[1], b1[2], b1[3]};
        o0 = __builtin_amdgcn_mfma_f32_32x32x16_bf16(v0, pf[ks], o0, 0, 0, 0);
        o1 = __builtin_amdgcn_mfma_f32_32x32x16_bf16(v1, pf[ks], o1, 0, 0, 0);
    }
}
constexpr int KP_A = 208, KT_A = 64 * KP_A, VT = 8192, BUF_A = KT_A + VT;
constexpr int KP_R = 144, KT_R = 64 * KP_R, BUF_R = KT_R + VT;
}

#define GSTRIDE(gi, total) for (int gi = bid_ * NT + tid_; gi < (total); gi += G_ * NT)
__device__ __forceinline__ void ph_mod(unsigned char* lds, const float* c, const float* c_ctx, const float* ada_w, const float* ada_b, float* mod) { PH_IDS;
    LAS float* sl = (LAS float*)lds;
    LAS float* red = sl + 9 * 1024;
    for (int e = tid_; e < 9 * 1024; e += NT) { const int j = e >> 10, k = e & 1023; const float v = j < 8 ? c[j * 1024 + k] : c_ctx[k]; sl[e] = siluf_(v); }
    __syncthreads();
    const int nn = tid_ & 63, ks = tid_ >> 6;
    for (int u = bid_; u < 2 * 96; u += G_) {
        const int l = u / 96, n = (u % 96) * 64 + nn;
        float acc[9];
#pragma unroll
        for (int j = 0; j < 9; ++j) acc[j] = 0.f;
        const float* w = ada_w + ((size_t)l * 1024 + ks * 128) * 6144 + n;
#pragma unroll 4
        for (int k4 = 0; k4 < 32; ++k4) {
            const float w0 = w[(size_t)(4 * k4) * 6144], w1 = w[(size_t)(4 * k4 + 1) * 6144], w2 = w[(size_t)(4 * k4 + 2) * 6144], w3 = w[(size_t)(4 * k4 + 3) * 6144];
#pragma unroll
            for (int j = 0; j < 9; ++j) { const f32x4 s4 = *(const LAS f32x4*)(sl + j * 1024 + ks * 128 + 4 * k4); acc[j] += s4[0] * w0 + s4[1] * w1 + s4[2] * w2 + s4[3] * w3; } }
        __syncthreads();
#pragma unroll
        for (int j = 0; j < 9; ++j) red[(ks * 9 + j) * 64 + nn] = acc[j];
        __syncthreads();
        for (int e = tid_; e < 9 * 64; e += NT) { const int j = e >> 6, q = e & 63; float sum = 0.f;
#pragma unroll
            for (int r = 0; r < 8; ++r) sum += red[(r * 9 + j) * 64 + q];
            const int col = (u % 96) * 64 + q; mod[((size_t)l * 9 + j) * 6144 + col] = sum + ada_b[l * 6144 + col]; }
    }
    __syncthreads();
}
__device__ __forceinline__ void ph_trig(float* trig, bf16_t* d64) { PH_IDS; GSTRIDE(i, 2048) { const float xx = (float)i * (1.f / 1024.f); trig[i] = cospif(xx); trig[2048 + i] = sinpif(xx); }
    GSTRIDE(i, 128 * 64) { const int n = i >> 6, c = i & 63, m = n & 63; const float xx = (float)((m * c) & 63) * (1.f / 32.f); d64[i] = f2bf(n < 64 ? cospif(xx) : sinpif(xx)); } }
__device__ __forceinline__ double2 lam_pow(double re, double im, double dt, int k) {
    const double m = (double)__expf((float)(re * dt * k));
    double xx = im * dt * (double)k * 0.318309886183790671538;
    xx -= 2.0 * rint(xx * 0.5);
    const float xf = (float)xx;
    return make_double2(m * (double)cospif(xf), m * (double)sinpif(xf));
}
__device__ __forceinline__ void ph_s5_lp(int l, const float* lam_re, const float* lam_im, const float* log_step, const float* b_re, const float* b_im, float2* LP, float2* BB, float* lamT) { PH_IDS;
    GSTRIDE(it, 2 * 16 * 64 * 81) {
        const int i = it / 81, k = it % 81;
        const int d = i / 1024, g = (i / 64) % 16, p = i % 64;
        const size_t li = ((size_t)(l * 2 + d) * 16 + g) * 64 + p;
        const double re = lam_re[li], im = lam_im[li], dt = (double)expf(log_step[(l * 2 + d) * 16 + g]);
        if (k <= 64) {
            const double2 v = lam_pow(re, im, dt, k); LP[(size_t)i * 65 + k] = make_float2((float)v.x, (float)v.y);
            if (k == 64) { lamT[((size_t)(g * 2 + d) * 64 + p) * 2 + 0] = (float)v.x; lamT[((size_t)(g * 2 + d) * 64 + p) * 2 + 1] = (float)v.y; }
        } else {
            const int h = k - 65;
            const double2 l1 = lam_pow(re, im, dt, 1);
            const double nr = l1.x - 1.0, ni = l1.y, den = re * re + im * im;
            const double fr = (nr * re + ni * im) / den, fi = (ni * re - nr * im) / den;
            const double br = b_re[li * 16 + h], bi = b_im[li * 16 + h]; BB[(size_t)i * 16 + h] = make_float2((float)(fr * br - fi * bi), (float)(fr * bi + fi * br));
        }
    }
}
__device__ __forceinline__ void ph_s5_tz(unsigned char* lds_, int l, const float2* LP, const float2* BB, const float* c_re, const float* c_im, float* TZD, int vb, int vg) { PH_IDS;
    typedef float f32x2_ __attribute__((ext_vector_type(2)));
    LAS f32x2_* sC = (LAS f32x2_*)lds_;
    LAS f32x2_* sL = sC + 16 * 64;
    LAS f32x2_* sB = sL + 64 * 8;
    for (int it = vb; it < 256; it += vg) {
        const int u = it >> 3, ts = it & 7, g = u >> 1, d = u & 1;
        const size_t cb = (((size_t)(l * 2 + d) * 16 + g) * 16) * 64, gb = (size_t)d * 16 + g;
        const float cr0 = c_re[cb + tid_], ci0 = c_im[cb + tid_], cr1 = c_re[cb + NT + tid_], ci1 = c_im[cb + NT + tid_];
        const float2 lpv = LP[gb * 64 * 65 + (size_t)(tid_ >> 3) * 65 + ts * 8 + (tid_ & 7)];
        const float2 bb0 = BB[gb * 64 * 16 + tid_], bb1 = BB[gb * 64 * 16 + NT + tid_];
        __syncthreads();
        sC[tid_] = (f32x2_){cr0, ci0}; sC[NT + tid_] = (f32x2_){cr1, ci1}; sL[tid_] = (f32x2_){lpv.x, lpv.y}; sB[tid_] = (f32x2_){bb0.x, bb0.y}; sB[NT + tid_] = (f32x2_){bb1.x, bb1.y};
        __syncthreads();
        const int pair = tid_ & 127, tl = pair >> 4, h = pair & 15, qg = tid_ >> 7;
        f32x4 acc = (f32x4){0.f, 0.f, 0.f, 0.f};
#pragma unroll 4
        for (int p = 0; p < 64; ++p) {
            const f32x2_ c = sC[h * 64 + p], lp = sL[p * 8 + tl];
            const float er = c.x * lp.x - c.y * lp.y, ei = c.x * lp.y + c.y * lp.x;
            const f32x4 b01 = *(const LAS f32x4*)&sB[p * 16 + 4 * qg], b23 = *(const LAS f32x4*)&sB[p * 16 + 4 * qg + 2];
            acc[0] += er * b01[0] - ei * b01[1]; acc[1] += er * b01[2] - ei * b01[3]; acc[2] += er * b23[0] - ei * b23[1]; acc[3] += er * b23[2] - ei * b23[3];
        }
        *(f32x4*)(TZD + (((gb * 64) + ts * 8 + tl) * 16 + h) * 16 + 4 * qg) = acc;
    }
    __syncthreads();
}
__device__ __forceinline__ void ph_s5_ms(const float2* LP, const float2* BB, bf16_t* MST, int vb, int vg) { PH_IDS;
    for (int i0 = vb * NT + tid_; i0 < 16 * 256 * 128; i0 += 3 * vg * NT) {
        float2 lp[3]; f32x4 bb[3][4];
#pragma unroll
        for (int k = 0; k < 3; ++k) { const int i = i0 + k * vg * NT;
            if (i < 16 * 256 * 128) { const int g = i / (256 * 128), n = (i / 128) % 256, sh0 = (i % 128) * 8, d = n >> 7, p = n & 63, s = sh0 >> 4, hp0 = sh0 & 15;
                const size_t gi = ((size_t)d * 16 + g) * 64 + p;
                lp[k] = LP[gi * 65 + (d == 0 ? 63 - s : s)];
#pragma unroll
                for (int q = 0; q < 4; ++q) bb[k][q] = *(const f32x4*)(BB + gi * 16 + hp0 + 2 * q); } }
#pragma unroll
        for (int k = 0; k < 3; ++k) { const int i = i0 + k * vg * NT;
            if (i < 16 * 256 * 128) { const int g = i / (256 * 128), n = (i / 128) % 256, sh0 = (i % 128) * 8, im = (n >> 6) & 1;
                float v[8];
#pragma unroll
                for (int q = 0; q < 4; ++q) { v[2 * q] = im ? lp[k].x * bb[k][q][1] + lp[k].y * bb[k][q][0] : lp[k].x * bb[k][q][0] - lp[k].y * bb[k][q][1];
                    v[2 * q + 1] = im ? lp[k].x * bb[k][q][3] + lp[k].y * bb[k][q][2] : lp[k].x * bb[k][q][2] - lp[k].y * bb[k][q][3]; }
                *(pg8::u32x4*)(MST + ((size_t)g * 256 + n) * 1024 + sh0) = pack8((f32x4){v[0], v[1], v[2], v[3]}, (f32x4){v[4], v[5], v[6], v[7]}); } }
    }
}
__device__ __forceinline__ void ph_s5_qo(int l, const float2* LP, const float* c_re, const float* c_im, bf16_t* QOT, int vb, int vg) { PH_IDS;
    for (int i = vb * NT + tid_; i < 16 * 1024 * 32; i += vg * NT) {
        const int g = i / (1024 * 32), th = (i / 32) % 1024, j0 = (i % 32) * 8, d = j0 >> 7, im = (j0 >> 6) & 1, p0 = j0 & 63, t = th >> 4, h = th & 15;
        const size_t ci = (((size_t)(l * 2 + d) * 16 + g) * 16 + h) * 64 + p0;
        const int e = d == 0 ? t + 1 : 64 - t;
        float v[8];
#pragma unroll
        for (int q = 0; q < 8; ++q) { const float cr = c_re[ci + q], cim = c_im[ci + q]; const float2 lp = LP[(((size_t)d * 16 + g) * 64 + p0 + q) * 65 + e]; v[q] = im ? -(cr * lp.y + cim * lp.x) : cr * lp.x - cim * lp.y; }
        *(pg8::u32x4*)(QOT + ((size_t)g * 1024 + th) * 256 + j0) = pack8((f32x4){v[0], v[1], v[2], v[3]}, (f32x4){v[4], v[5], v[6], v[7]});
    }
}
__device__ __forceinline__ void ph_wmf(const float* w, const float* mod, float* wmf) { PH_IDS;
    GSTRIDE(i, 9 * 1024) { const int b = i >> 10, c = i & 1023; wmf[i] = w[c] * (1.f + mod[(size_t)b * 6144 + 4 * 1024 + c]); }
}
__device__ __forceinline__ void ph_cf_mfma(unsigned char* lds_, const bf16_t* W1T, const float* mod, float* cf, int vb, int vg) {
    const int tid = l_tid(), lane = tid & 63, kk = __builtin_amdgcn_readfirstlane(tid >> 6), i16 = lane & 15, kq = lane >> 4;
    LAS float* red = (LAS float*)lds_;
    for (int nt = vb; nt < 256; nt += vg) {
        f32x4 acc = (f32x4){0.f, 0.f, 0.f, 0.f};
#pragma unroll
        for (int s4 = 0; s4 < 4; ++s4) { const int k0 = kk * 128 + s4 * 32 + kq * 8;
            pg8::u32x4 aw = (pg8::u32x4){0u, 0u, 0u, 0u};
            if (i16 < 9) { const float* sp = mod + (size_t)i16 * 6144 + 3 * 1024 + k0; aw = pack8(*(const f32x4*)sp, *(const f32x4*)(sp + 4)); }
            const bf16x8 bw = *(const bf16x8*)(W1T + (size_t)(nt * 16 + i16) * 1024 + k0);
            acc = __builtin_amdgcn_mfma_f32_16x16x32_bf16(__builtin_bit_cast(bf16x8, aw), bw, acc, 0, 0, 0); }
        __syncthreads();
#pragma unroll
        for (int r = 0; r < 4; ++r) red[(kk * 16 + 4 * kq + r) * 16 + i16] = acc[r];
        __syncthreads();
        if (tid < 144) { float a = 0.f;
#pragma unroll
            for (int w = 0; w < 8; ++w) a += red[w * 256 + tid];
            cf[(size_t)(tid >> 4) * DFF + nt * 16 + (tid & 15)] = a; }
    }
    __syncthreads();
}
template <int XIN>
__device__ __forceinline__ void ph_adarms(const void* xlat, const void* xctx, const float* w, const float* mod, int sh_chunk, int sc_chunk, bf16_t* out, int nrows) { PH_IDS;
    const int wave = (bid_ * NT + tid_) >> 6, lane = tid_ & 63, nw = (G_ * NT) >> 6;
    f32x4 wv[4];
#pragma unroll
    for (int j = 0; j < 4; ++j) wv[j] = *(const f32x4*)(w + j * 256 + lane * 4);
    for (int row0 = wave; row0 < nrows; row0 += 3 * nw) {
        f32x4 v[3][4], sc[3][4], sh[3][4];
#pragma unroll
        for (int k = 0; k < 3; ++k) { const int row = row0 + k * nw;
            if (row < nrows) {
                if constexpr (XIN == 0) { const float* x = row < RL ? (const float*)xlat + (size_t)row * DM : (const float*)xctx + (size_t)(row - RL) * DM;
#pragma unroll
                    for (int j = 0; j < 4; ++j) v[k][j] = *(const f32x4*)(x + j * 256 + lane * 4); }
                else { const bf16_t* x = row < RL ? (const bf16_t*)xlat + (size_t)row * DM : (const bf16_t*)xctx + (size_t)(row - RL) * DM;
#pragma unroll
                    for (int j = 0; j < 4; ++j) { const fa::u32x2 r = *(const fa::u32x2*)(x + j * 256 + lane * 4); v[k][j] = (f32x4){__uint_as_float(r.x << 16), __uint_as_float(r.x & 0xffff0000u), __uint_as_float(r.y << 16), __uint_as_float(r.y & 0xffff0000u)}; } }
                const float* mrow = mod + (size_t)row_modidx(row) * 6144;
#pragma unroll
                for (int j = 0; j < 4; ++j) { const int c0 = j * 256 + lane * 4; sc[k][j] = *(const f32x4*)(mrow + sc_chunk * 1024 + c0); sh[k][j] = *(const f32x4*)(mrow + sh_chunk * 1024 + c0); }
            } }
#pragma unroll
        for (int k = 0; k < 3; ++k) { const int row = row0 + k * nw;
            if (row < nrows) {
                float ss = 0.f;
#pragma unroll
                for (int j = 0; j < 4; ++j) ss += v[k][j][0] * v[k][j][0] + v[k][j][1] * v[k][j][1] + v[k][j][2] * v[k][j][2] + v[k][j][3] * v[k][j][3];
#pragma unroll
                for (int o = 1; o < 64; o <<= 1) ss += __shfl_xor(ss, o);
                const float rstd = rsqrtf(ss * (1.f / DM) + EPS);
#pragma unroll
                for (int j = 0; j < 4; ++j) { const int c0 = j * 256 + lane * 4;
                    const f32x4 y = v[k][j] * rstd * wv[j] * (sc[k][j] + 1.f) + sh[k][j];
                    fa::u32x2 o; o.x = fa::pk2(y[0], y[1]); o.y = fa::pk2(y[2], y[3]);
                    *(fa::u32x2*)(out + (size_t)row * DM + c0) = o; }
            } }
    }
}
__device__ __forceinline__ void ph_mla_stats(const bf16_t* Z, float* rs) { PH_IDS;
    const int wave = (bid_ * NT + tid_) >> 6, lane = tid_ & 63, nw = (G_ * NT) >> 6;
    for (int row = wave; row < RT; row += nw) {
        const bf16_t* z = Z + (size_t)row * ZW; float sq = 0.f, sk = 0.f;
#pragma unroll
        for (int j = 0; j < 4; ++j) { const float v = bf2f(z[C_QC + j * 64 + lane]); sq += v * v; }
#pragma unroll
        for (int j = 0; j < 2; ++j) { const float v = bf2f(z[C_KVC + j * 64 + lane]); sk += v * v; }
#pragma unroll
        for (int o = 1; o < 64; o <<= 1) { sq += __shfl_xor(sq, o); sk += __shfl_xor(sk, o); }
        if (lane == 0) { rs[(size_t)row * 2] = rsqrtf(sq * (1.f / 256) + EPS); rs[(size_t)row * 2 + 1] = rsqrtf(sk * (1.f / 128) + EPS); }
    }
}
__device__ __forceinline__ void ph_mla_post(const bf16_t* Z, const bf16_t* qraw, const bf16_t* kvraw, const float* qkq, const float* qkk, bf16_t* Q, bf16_t* Kb, bf16_t* Vb) { PH_IDS;
    GSTRIDE(gi, RT * 8) {
        const int row = gi >> 3, h = (gi >> 1) & 3, isk = gi & 1;
        const bool lat = row < RL; const int b = row_batch(row), t = lat ? (row & 2047) : ((row - RL) & 255);
        const int qi = lat ? t : 2048 + t, ki = lat ? 256 + t : t;
        float v[96];
        float ss = 0.f;
        if (!isk) {
#pragma unroll
            for (int i = 0; i < 96; ++i) v[i] = bf2f(qraw[(size_t)row * 384 + h * 96 + i]);
        } else {
#pragma unroll
            for (int i = 0; i < 64; ++i) v[i] = bf2f(kvraw[(size_t)row * 512 + h * 128 + i]);
#pragma unroll
            for (int i = 0; i < 32; ++i) v[64 + i] = bf2f(Z[(size_t)row * ZW + C_KR + i]);
        }
#pragma unroll
        for (int i = 0; i < 96; ++i) ss += v[i] * v[i];
        const float rr = rsqrtf(ss * (1.f / 96) + EPS) * (isk ? 1.f : 0.14724727430627066f);
        const float* wv = isk ? qkk : qkq;
#pragma unroll
        for (int i = 0; i < 96; ++i) v[i] = v[i] * rr * wv[i];
        if (lat) {
            const float prow = (float)(t >> 6), pcol = (float)(t & 63);
#pragma unroll
            for (int part = 0; part < 2; ++part) { const float pos = part ? pcol : prow; const int base = 64 + part * 16;
#pragma unroll
                for (int j = 0; j < 8; ++j) { const float fr = exp2f(-(float)j * (13.287712379549449f / 8.f)), a = pos * fr, cs = __cosf(a), sn = __sinf(a);
                    const float x1 = v[base + j], x2 = v[base + 8 + j]; v[base + j] = x1 * cs - x2 * sn; v[base + 8 + j] = x1 * sn + x2 * cs; } }
        }
        bf16_t* o = isk ? Kb + ((size_t)(b * 4 + h) * 2304 + ki) * 96 : Q + ((size_t)(b * 4 + h) * 2304 + qi) * 96;
#pragma unroll
        for (int i = 0; i < 96; ++i) o[i] = f2bf(v[i]);
        if (isk) { bf16_t* vo = Vb + ((size_t)(b * 4 + h) * 2304 + ki) * 64; for (int i = 0; i < 64; ++i) vo[i] = kvraw[(size_t)row * 512 + h * 128 + 64 + i]; }
    }
}
__device__ __forceinline__ void ph_attn(unsigned char* lds, const bf16_t* Q, const bf16_t* Kb, const bf16_t* Vb, bf16_t* Z, int with_ctx) { PH_IDS;
    float (*sK)[96] = (float (*)[96])lds; float (*sV)[64] = (float (*)[64])(lds + 32 * 96 * 4);
    const int nunits = 32 * (8 + (with_ctx ? 1 : 0));
    const int qt = tid_ & 255, dh = (tid_ >> 8) * 32;
    for (int u = bid_; u < nunits; u += G_) {
        const int bh = u % 32, qb = u / 32;
        const bool lat = qb < 8;
        const int qi = qb * 256 + qt, nkeys = lat ? 2304 : 256;
        float q[96], o[32];
        const bf16_t* qp = Q + ((size_t)bh * 2304 + qi) * 96;
#pragma unroll
        for (int i = 0; i < 96; ++i) q[i] = bf2f(qp[i]) * 0.10206207261596577f;
#pragma unroll
        for (int i = 0; i < 32; ++i) o[i] = 0.f;
        float mx = -1e30f, l = 0.f;
        for (int k0 = 0; k0 < nkeys; k0 += 32) {
            __syncthreads();
            for (int e = tid_; e < 32 * 96; e += NT) sK[e / 96][e % 96] = bf2f(Kb[((size_t)bh * 2304 + k0) * 96 + e]);
            for (int e = tid_; e < 32 * 64; e += NT) sV[e / 64][e % 64] = bf2f(Vb[((size_t)bh * 2304 + k0) * 64 + e]);
            __syncthreads();
#pragma unroll 1
            for (int j = 0; j < 32; ++j) { float a = 0.f;
#pragma unroll
                for (int i = 0; i < 96; ++i) a += q[i] * sK[j][i];
                if (a > mx) { const float corr = __expf(mx - a); mx = a; l *= corr;
#pragma unroll
                    for (int i = 0; i < 32; ++i) o[i] *= corr; }
                const float p = __expf(a - mx); l += p;
#pragma unroll
                for (int i = 0; i < 32; ++i) o[i] += p * sV[j][dh + i]; }
        }
        const int b = bh >> 2, h = bh & 3;
        const int row = lat ? b * 2048 + qi : RL + b * 256 + (qi - 2048);
        const float inv = 1.f / l;
#pragma unroll
        for (int i = 0; i < 32; ++i) Z[(size_t)row * ZW + C_QC + h * 64 + dh + i] = f2bf(o[i] * inv);
    }
    __syncthreads();
}
__device__ __forceinline__ void ph_f1(const bf16_t* Z, const float* trig, bf16_t* F1lat, bf16_t* F1ctx) { PH_IDS;
    GSTRIDE(gi, RT * 256) {
        const int row = gi >> 8, gm = gi & 255, g = gm >> 6, m = gm & 63;
        float a = 0.f, bsum = 0.f;
        const bf16_t* u = Z + (size_t)row * ZW + C_FU + g * 64;
        for (int c = 0; c < 64; ++c) { const float v = bf2f(u[c]); const int idx = ((m * c) & 63) * 32; a += v * trig[idx]; bsum += v * trig[2048 + idx]; }
        if (row < RL) { const int b = row >> 11, t = row & 2047; bf16_t* o = F1lat + ((size_t)(b * 256 + gm) * 2) * 2048; o[t] = f2bf(a); o[2048 + t] = f2bf(bsum); }
        else { const int r = row - RL, b = r >> 8, t = r & 255; bf16_t* o = F1ctx + ((size_t)(b * 256 + gm) * 2) * 256; o[t] = f2bf(a); o[256 + t] = f2bf(bsum); }
    }
}
struct A_dft { const float* trig; long long L; long long mul;
    __device__ float operator()(int, int k, int kk) const { const int part = kk >= (int)L, t = part ? kk - (int)L : kk; const int idx = (int)(((long long)k * t) & (L - 1)) * (int)mul; return part ? -trig[2048 + idx] : trig[idx]; } };
struct B_f1t { const bf16_t* p; long long L;
    __device__ float operator()(int b, int kk, int n) const { return bf2f(p[((size_t)(b * 256 + n)) * 2 * L + kk]); } };
struct E_fourier { bf16_t* Z; long long rowbase; long long L; double scale;
    __device__ void operator()(int b, int m, int n, float v) const { Z[((size_t)rowbase + (size_t)b * L + m) * ZW + C_FU + n] = f2bf(v * (float)scale); } };

struct A_s5u { const bf16_t* Z;
    __device__ float operator()(int g, int rc, int k) const { return bf2f(Z[((size_t)rc * 64 + (k >> 4)) * ZW + C_S5 + g * 16 + (k & 15)]); } };
struct B_ms { const bf16_t* MS; __device__ float operator()(int g, int k, int n) const { return bf2f(MS[((size_t)g * 1024 + k) * 256 + n]); } };
struct E_sloc { float* S; __device__ void operator()(int g, int rc, int n, float v) const { S[((size_t)rc * 16 + g) * 256 + n] = v; } };
__device__ __forceinline__ void ph_s5_scan(const float* SLOC, const float* lamT, float* XP) { PH_IDS;
    GSTRIDE(i, 8 * 16 * 2 * 64) {
        const int b = i / 2048, g = (i / 128) % 16, d = (i / 64) % 2, p = i % 64;
        const float lr = lamT[((size_t)(g * 2 + d) * 64 + p) * 2], li = lamT[((size_t)(g * 2 + d) * 64 + p) * 2 + 1];
        float xr = 0.f, xi = 0.f;
        for (int step = 0; step < 36; ++step) {
            int rc;
            if (d == 0) rc = step < 4 ? 256 + b * 4 + step : b * 32 + (step - 4);
            else rc = step < 4 ? 256 + b * 4 + (3 - step) : b * 32 + (31 - (step - 4));
            const size_t o = ((size_t)rc * 16 + g) * 256 + d * 128;
            XP[o + p] = xr; XP[o + 64 + p] = xi;
            const float sr = SLOC[o + p], si = SLOC[o + 64 + p];
            const float nr = lr * xr - li * xi + sr, ni = lr * xi + li * xr + si; xr = nr; xi = ni;
        }
    }
}
struct A_s5out { const bf16_t* Z; const float* XP;
    __device__ float operator()(int g, int rc, int k) const { return k < 1024 ? bf2f(Z[((size_t)rc * 64 + (k >> 4)) * ZW + C_S5 + g * 16 + (k & 15)]) : XP[((size_t)rc * 16 + g) * 256 + (k - 1024)]; } };
struct B_s5out { const float* TZ; const bf16_t* QO;
    __device__ float operator()(int g, int k, int n) const { if (k < 1024) { const int s = k >> 4, hp = k & 15, t = n >> 4, h = n & 15; return TZ[(((size_t)g * 127 + (t - s + 63)) * 16 + hp) * 16 + h]; } return bf2f(QO[((size_t)g * 256 + (k - 1024)) * 1024 + n]); } };
struct E_s5out { bf16_t* YG; __device__ void operator()(int g, int rc, int n, float v) const { YG[((size_t)rc * 64 + (n >> 4)) * 256 + g * 16 + (n & 15)] = f2bf(geluf_(v)); } };
__device__ __forceinline__ void ph_glu(const bf16_t* GL, bf16_t* Z) { PH_IDS;
    GSTRIDE(gi, RT * 256) {
        const int row = gi >> 8, j = gi & 255;
        const float val = bf2f(GL[(size_t)row * 512 + j]), gate = bf2f(GL[(size_t)row * 512 + 256 + j]);
        Z[(size_t)row * ZW + C_S5 + j] = f2bf(val * sigmoidf_(gate));
    }
}
__device__ __forceinline__ void ph_ret_prep(bf16_t* Z) { PH_IDS;
    GSTRIDE(gi, RT * 4 * 32) {
        const int row = gi >> 7, h = (gi >> 5) & 3, j = gi & 31;
        bf16_t* z = Z + (size_t)row * ZW;
        if (row < RL) {
            const int t = row & 2047; const float fr = exp2f(-(float)j * (13.287712379549449f / 32.f)), a = (float)t * fr, cs = cosf(a), sn = sinf(a);
            { const float x1 = bf2f(z[C_RQ + h * 64 + j]), x2 = bf2f(z[C_RQ + h * 64 + 32 + j]); z[C_RQ + h * 64 + j] = f2bf(x1 * cs - x2 * sn); z[C_RQ + h * 64 + 32 + j] = f2bf(x1 * sn + x2 * cs); }
            { const float x1 = bf2f(z[C_RK + h * 64 + j]), x2 = bf2f(z[C_RK + h * 64 + 32 + j]); z[C_RK + h * 64 + j] = f2bf((x1 * cs - x2 * sn) * 0.125f); z[C_RK + h * 64 + 32 + j] = f2bf((x1 * sn + x2 * cs) * 0.125f); }
        } else {
            z[C_RK + h * 64 + j] = f2bf(bf2f(z[C_RK + h * 64 + j]) * 0.125f); z[C_RK + h * 64 + 32 + j] = f2bf(bf2f(z[C_RK + h * 64 + 32 + j]) * 0.125f);
        }
    }
}
__device__ __forceinline__ void ph_ret(unsigned char* lds, bf16_t* Z, const float* decay_logit, const float* gn_w, int with_ctx) { PH_IDS;
    float (*sK)[64] = (float (*)[64])lds; float (*sV)[64] = (float (*)[64])(lds + 32 * 64 * 4);
    float* sred = (float*)(lds + 2 * 32 * 64 * 4);
    const int nunits = 32 * (8 + (with_ctx ? 1 : 0));
    const int qt = tid_ & 255, hh = tid_ >> 8, dh = hh * 32;
    for (int u = bid_; u < nunits; u += G_) {
        const int bh = u % 32, qb = u / 32, b = bh >> 2, h = bh & 3;
        const bool lat = qb < 8;
        const int qpos = lat ? qb * 256 + qt : qt;
        const int qrow = lat ? b * 2048 + qpos : RL + b * 256 + qpos;
        const float lgf = -log1pf(__expf(-decay_logit[h])) * 1.4426950408889634f, lgb = -log1pf(__expf(-decay_logit[4 + h])) * 1.4426950408889634f;
        float q[64], o[32];
#pragma unroll
        for (int i = 0; i < 64; ++i) q[i] = bf2f(Z[(size_t)qrow * ZW + C_RQ + h * 64 + i]);
#pragma unroll
        for (int i = 0; i < 32; ++i) o[i] = 0.f;
        const int nkeys = lat ? 2560 : 256;
        for (int k0 = 0; k0 < nkeys; k0 += 32) {
            int krow0, kpos0;
            if (lat) { if (k0 < 256) { krow0 = RL + b * 256 + k0; kpos0 = k0 - 256; } else if (k0 < 2304) { krow0 = b * 2048 + (k0 - 256); kpos0 = k0 - 256; } else { krow0 = RL + b * 256 + (k0 - 2304); kpos0 = 2048 + (k0 - 2304); } }
            else { krow0 = RL + b * 256 + k0; kpos0 = k0; }
            __syncthreads();
            for (int e = tid_; e < 32 * 64; e += NT) { const int j = e >> 6, i = e & 63; sK[j][i] = bf2f(Z[(size_t)(krow0 + j) * ZW + C_RK + h * 64 + i]); sV[j][i] = bf2f(Z[(size_t)(krow0 + j) * ZW + C_RV + h * 64 + i]); }
            __syncthreads();
#pragma unroll 1
            for (int j = 0; j < 32; ++j) { float a = 0.f;
#pragma unroll
                for (int i = 0; i < 64; ++i) a += q[i] * sK[j][i];
                const int dpos = qpos - (kpos0 + j);
                const float dec = dpos > 0 ? exp2f(lgf * (float)dpos) : (dpos < 0 ? exp2f(lgb * (float)(-dpos)) : 2.f);
                a *= dec;
#pragma unroll
                for (int i = 0; i < 32; ++i) o[i] += a * sV[j][dh + i]; }
        }
        float s1 = 0.f;
#pragma unroll
        for (int i = 0; i < 32; ++i) s1 += o[i];
        __syncthreads();
        sred[hh * 256 + qt] = s1;
        __syncthreads();
        const float mu = (sred[qt] + sred[256 + qt]) * (1.f / 64);
        float s2 = 0.f;
#pragma unroll
        for (int i = 0; i < 32; ++i) { const float d = o[i] - mu; s2 += d * d; }
        __syncthreads();
        sred[hh * 256 + qt] = s2;
        __syncthreads();
        const float rstd = rsqrtf((sred[qt] + sred[256 + qt]) * (1.f / 64) + EPS);
#pragma unroll
        for (int i = 0; i < 32; ++i) { const float gte = bf2f(Z[(size_t)qrow * ZW + C_RG + h * 64 + dh + i]); const float y = (o[i] - mu) * rstd * gn_w[h * 64 + dh + i];
            Z[(size_t)qrow * ZW + C_RQ + h * 64 + dh + i] = f2bf(siluf_(gte) * y); }
    }
    __syncthreads();
}
struct E_merge { const bf16_t* stash; bf16_t* MMp; long long first;
    __device__ void operator()(int, int m, int n, float v) const { const size_t i = (size_t)m * DM + n; const float t = sigmoidf_(v) * bf2f(stash[i]); MMp[i] = f2bf(first ? t : bf2f(MMp[i]) + t); } };
struct E_resid { const float* xlat; const float* xctx; float* olat; float* octx; const float* mod; long long gchunk;
    __device__ void operator()(int, int m, int n, float v) const {
        const float g = mod[(size_t)row_modidx(m) * 6144 + gchunk * 1024 + n];
        if (m < RL) olat[(size_t)m * DM + n] = xlat[(size_t)m * DM + n] + g * v; else octx[(size_t)(m - RL) * DM + n] = xctx[(size_t)(m - RL) * DM + n] + g * v; } };
struct E_relu2 { bf16_t* H; __device__ void operator()(int, int m, int n, float v) const { const float r = fmaxf(v, 0.f); H[(size_t)m * DFF + n] = f2bf(r * r); } };


__device__ __forceinline__ void ph_s5_sloc(unsigned char* lds_, const bf16_t* Z, const bf16_t* MST, float* SLOC) { PH_IDS;
    const int lane = tid_ & 63, wid = __builtin_amdgcn_readfirstlane(tid_ >> 6), c16 = lane & 15, kq = lane >> 4;
    LAS char* sm = (LAS char*)lds_;
    constexpr int CP = 64 * 32 + 16;
    for (int u = bid_; u < 256; u += G_) {
        const int g = u >> 4, nh = (u >> 3) & 1, sl = u & 7;
        const bf16_t* mp0 = MST + ((size_t)g * 256 + nh * 128 + wid * 16 + c16) * 1024 + 8 * kq;
        bf16x8 a[32];
#pragma unroll
        for (int ks = 0; ks < 32; ++ks) a[ks] = *(const bf16x8*)(mp0 + 32 * ks);
        pg8::u32x4 st[4];
#define SLOC_ISSUE(blk_) do { _Pragma("unroll") for (int i = 0; i < 4; ++i) { const int p = tid_ + NT * i, r = p >> 1, hf = p & 1; \
            st[i] = *(const pg8::u32x4*)(Z + ((size_t)(blk_) * 1024 + r) * ZW + C_S5 + g * 16 + 8 * hf); } } while (0)
        SLOC_ISSUE(sl);
        for (int blk = sl; blk < 18; blk += 8) {
            const int rcbase = blk * 16;
            __syncthreads();
#pragma unroll
            for (int i = 0; i < 4; ++i) { const int p = tid_ + NT * i, r = p >> 1, hf = p & 1; *(LAS pg8::u32x4*)(sm + (r >> 6) * CP + (r & 63) * 32 + hf * 16) = st[i]; }
            if (blk + 8 < 18) SLOC_ISSUE(blk + 8);
            __syncthreads();
            const LAS char* bp = sm + c16 * CP + (kq >> 1) * 32 + (kq & 1) * 16;
            f32x4 acc0 = (f32x4){0.f, 0.f, 0.f, 0.f}, acc1 = acc0;
#pragma unroll
            for (int ks = 0; ks < 32; ks += 2) {
                const bf16x8 b0 = *(const LAS bf16x8*)(bp + ks * 64), b1 = *(const LAS bf16x8*)(bp + (ks + 1) * 64);
                acc0 = __builtin_amdgcn_mfma_f32_16x16x32_bf16(a[ks], b0, acc0, 0, 0, 0);
                acc1 = __builtin_amdgcn_mfma_f32_16x16x32_bf16(a[ks + 1], b1, acc1, 0, 0, 0);
            }
            *(f32x4*)(SLOC + ((size_t)(rcbase + c16) * 16 + g) * 256 + nh * 128 + wid * 16 + 4 * kq) = acc0 + acc1;
        }
#undef SLOC_ISSUE
    }
    __syncthreads();
}
__device__ __forceinline__ void ph_s5_tzb(int l, const float* TZD, const float* s5d, bf16_t* TZB, const float* c_re, const float* c_im, bf16_t* CQ) { PH_IDS;
    GSTRIDE(e, 16 * 16 * 256) { const int g = e >> 12, h = (e >> 8) & 15, n = e & 255, d = n >> 7, im = (n >> 6) & 1, p = n & 63;
        const size_t ci = ((((size_t)(l * 2 + d) * 16 + g) * 16 + h) * 64) + p; CQ[e] = f2bf(im ? -c_im[ci] : c_re[ci]); }
    GSTRIDE(e, 16 * 127 * 64) { const int g = e / (127 * 64), r = e % (127 * 64), dd = r >> 6, h = (r >> 2) & 15, q4 = (r & 3) * 4;
        f32x4 v = (f32x4){0.f, 0.f, 0.f, 0.f};
        if (dd >= 63) v += *(const f32x4*)(TZD + ((((size_t)0 * 16 + g) * 64 + (dd - 63)) * 16 + h) * 16 + q4);
        if (dd <= 63) v += *(const f32x4*)(TZD + ((((size_t)1 * 16 + g) * 64 + (63 - dd)) * 16 + h) * 16 + q4);
        if (dd == 63 && (h >> 2) == (q4 >> 2)) v[h & 3] += s5d[g * 16 + h];
        fa::u32x2 w; w.x = fa::pk2(v[0], v[1]); w.y = fa::pk2(v[2], v[3]);
        *(fa::u32x2*)(TZB + ((size_t)(g * 127 + dd) * 16 + h) * 16 + (((q4 >> 3) ^ (h >> 3)) * 8 + (q4 & 7))) = w; }
}
__device__ __forceinline__ void ph_s5_out(unsigned char* lds_, const bf16_t* Z, const bf16_t* TZB, const bf16_t* CQ, const float2* LP, const float* SLOC, const float* lamT, bf16_t* YG, int nrct, int u0, int ustep) { PH_IDS;
    LAS char* sm = (LAS char*)lds_;
    constexpr int O_TZ = 0, O_XP = 65536, O_U = 73728, UP = 2064, O_SL = O_U + 16 * UP;
    const int lane = tid_ & 63, wid = __builtin_amdgcn_readfirstlane(tid_ >> 6), c16 = lane & 15, kq = lane >> 4;
    for (int u = u0; u < 16 * nrct; u += ustep) {
        const int g = u / nrct, rct = u % nrct, rcbase = rct * 16;
        const bool lat = rct < 16; const int b = rcbase >> 5, c0 = rcbase & 31;
        const int nsl = lat ? 36 : 16;
        pg8::u32x4 sT[8], sU[4]; f32x4 sS[5];
        { const pg8::u32x4* tsrc = (const pg8::u32x4*)(TZB + (size_t)g * 127 * 256);
#pragma unroll
          for (int i_ = 0; i_ < 8; ++i_) { const int e = tid_ + NT * i_; if (e < 127 * 32) sT[i_] = tsrc[e]; }
#pragma unroll
          for (int i_ = 0; i_ < 4; ++i_) { const int e = tid_ + NT * i_, rc = e >> 7, s_ = (e >> 1) & 63, hh = e & 1; sU[i_] = *(const pg8::u32x4*)(Z + ((size_t)(rcbase + rc) * 64 + s_) * ZW + C_S5 + g * 16 + hh * 8); }
#pragma unroll
          for (int i_ = 0; i_ < 5; ++i_) { const int e = tid_ + NT * i_, r = e >> 6, q4 = e & 63; const int rc = lat ? (r < 4 ? 256 + b * 4 + r : b * 32 + (r - 4)) : rcbase + r;
              if (e < nsl * 64) sS[i_] = *(const f32x4*)(SLOC + ((size_t)rc * 16 + g) * 256 + q4 * 4); } }
        typedef float f32x2v __attribute__((ext_vector_type(2)));
        f32x2v sLq[3]; pg8::u32x4 sCq = *(const pg8::u32x4*)(CQ + (size_t)g * 4096 + tid_ * 8);
#pragma unroll
        for (int i_ = 0; i_ < 3; ++i_) { const int e = tid_ + NT * i_;
            if (e < 1152) { const int e2 = e - 128, d_ = e < 128 ? (e >> 6) : ((e2 >> 6) & 1), p_ = e & 63, w_ = e2 >> 7, k_ = e < 128 ? 1 : (d_ == 0 ? 8 * w_ + 1 : 57 - 8 * w_);
                const float2 t_ = LP[(((size_t)d_ * 16 + g) * 64 + p_) * 65 + k_]; sLq[i_] = (f32x2v){t_.x, t_.y}; } }
        __syncthreads();
#pragma unroll
        for (int i_ = 0; i_ < 8; ++i_) { const int e = tid_ + NT * i_; if (e < 127 * 32) *(LAS pg8::u32x4*)(sm + O_TZ + e * 16) = sT[i_]; }
#pragma unroll
        for (int i_ = 0; i_ < 4; ++i_) { const int e = tid_ + NT * i_, rc = e >> 7, s_ = (e >> 1) & 63, hh = e & 1; *(LAS pg8::u32x4*)(sm + O_U + rc * UP + s_ * 32 + hh * 16) = sU[i_]; }
#pragma unroll
        for (int i_ = 0; i_ < 5; ++i_) { const int e = tid_ + NT * i_, r = e >> 6, q4 = e & 63; if (e < nsl * 64) *(LAS f32x4*)(sm + O_SL + r * 1024 + q4 * 16) = sS[i_]; }
        __syncthreads();
        if (tid_ < 128) {
            const int d = tid_ >> 6, p = tid_ & 63;
            const float lr = lamT[((size_t)(g * 2 + d) * 64 + p) * 2], li = lamT[((size_t)(g * 2 + d) * 64 + p) * 2 + 1];
            const LAS float* sl = (const LAS float*)(sm + O_SL) + d * 128 + p;
            LAS bf16_t* xp = (LAS bf16_t*)(sm + O_XP) + d * 128 + p;
            float xr = 0.f, xi = 0.f;
#define S5_STEP(r) do { const float sr = sl[(r) * 256], si = sl[(r) * 256 + 64]; const float nr = lr * xr - li * xi + sr, ni = lr * xi + li * xr + si; xr = nr; xi = ni; } while (0)
            if (lat) {
                if (d == 0) { for (int r = 0; r < 4 + c0; ++r) S5_STEP(r);
                    for (int r = 0; r < 16; ++r) { xp[r * 256] = f2bf(xr); xp[r * 256 + 64] = f2bf(xi); S5_STEP(4 + c0 + r); } }
                else { for (int r = 3; r >= 0; --r) S5_STEP(r);
                    for (int c = 31; c >= c0 + 16; --c) S5_STEP(4 + c);
                    for (int r = 15; r >= 0; --r) { xp[r * 256] = f2bf(xr); xp[r * 256 + 64] = f2bf(xi); S5_STEP(4 + c0 + r); } }
            } else {
                if (d == 0) { for (int r = 0; r < 16; ++r) { if ((r & 3) == 0) { xr = 0.f; xi = 0.f; } xp[r * 256] = f2bf(xr); xp[r * 256 + 64] = f2bf(xi); S5_STEP(r); } }
                else { for (int r = 15; r >= 0; --r) { if ((r & 3) == 3) { xr = 0.f; xi = 0.f; } xp[r * 256] = f2bf(xr); xp[r * 256 + 64] = f2bf(xi); S5_STEP(r); } }
            }
#undef S5_STEP
        }
        __syncthreads();
#pragma unroll
        for (int i_ = 0; i_ < 3; ++i_) { const int e = tid_ + NT * i_; if (e < 1152) *(LAS f32x2v*)(sm + O_SL + e * 8) = sLq[i_]; }
        *(LAS pg8::u32x4*)(sm + O_SL + 9216 + tid_ * 16) = sCq;
        const LAS char* ub = sm + O_U + c16 * UP + kq * 16;
        const LAS char* xb = sm + O_XP + c16 * 512 + kq * 16;
        f32x4 acc8[8];
#pragma unroll
        for (int i = 0; i < 8; ++i) acc8[i] = (f32x4){0.f, 0.f, 0.f, 0.f};
#pragma unroll
        for (int par = 0; par < 2; ++par) {
            const LAS char* fz = sm + O_TZ + ((wid * 8 + par + 63 - (kq >> 1)) * 16 + c16) * 32 + ((kq & 1) ^ (c16 >> 3)) * 16;
            bf16x8 uw[4];
            uw[0] = *(const LAS bf16x8*)(ub); uw[1] = *(const LAS bf16x8*)(ub + 64); uw[2] = *(const LAS bf16x8*)(ub + 128); uw[3] = uw[0];
#pragma unroll
            for (int m = -3; m < 32; ++m) {
                const bf16x8 f = *(const LAS bf16x8*)(fz - m * 1024);
                if (m + 3 < 32) uw[(m + 3) & 3] = *(const LAS bf16x8*)(ub + (m + 3) * 64);
#pragma unroll
                for (int j = 0; j < 4; ++j) { const int ks = m + j; if (ks >= 0 && ks < 32) acc8[par + 2 * j] = __builtin_amdgcn_mfma_f32_16x16x32_bf16(f, uw[ks & 3], acc8[par + 2 * j], 0, 0, 0); }
            }
        }
        __syncthreads();
        {
#pragma unroll
            for (int d = 0; d < 2; ++d)
#pragma unroll 1
            for (int ph = 0; ph < 2; ++ph) {
                asm volatile("" ::: "memory");
                const bf16x8 cqr = *(const LAS bf16x8*)(sm + O_SL + 9216 + (c16 * 256 + 32 * (4 * d + ph) + 8 * kq) * 2), cqi = *(const LAS bf16x8*)(sm + O_SL + 9216 + (c16 * 256 + 32 * (4 * d + 2 + ph) + 8 * kq) * 2);
                const bf16x8 xre = *(const LAS bf16x8*)(xb + (4 * d + ph) * 64), xim = *(const LAS bf16x8*)(xb + (4 * d + 2 + ph) * 64);
                float yr[8], yi[8], lr[8], li[8];
#pragma unroll
                for (int j = 0; j < 8; ++j) {
                    const int p_ = 32 * ph + 8 * kq + j;
                    const f32x2v l1 = *(const LAS f32x2v*)(sm + O_SL + (d * 64 + p_) * 8), ls = *(const LAS f32x2v*)(sm + O_SL + (128 + (wid * 2 + d) * 64 + p_) * 8);
                    const float xr = __uint_as_float((unsigned)(unsigned short)xre[j] << 16), xi = __uint_as_float((unsigned)(unsigned short)xim[j] << 16);
                    yr[j] = ls.x * xr - ls.y * xi; yi[j] = ls.x * xi + ls.y * xr; lr[j] = l1.x; li[j] = l1.y;
                }
#pragma unroll
                for (int s8 = 0; s8 < 8; ++s8) {
                    const int i = d == 0 ? s8 : 7 - s8;
                    const bf16x8 bre = __builtin_bit_cast(bf16x8, pack8((f32x4){yr[0], yr[1], yr[2], yr[3]}, (f32x4){yr[4], yr[5], yr[6], yr[7]}));
                    const bf16x8 bim = __builtin_bit_cast(bf16x8, pack8((f32x4){yi[0], yi[1], yi[2], yi[3]}, (f32x4){yi[4], yi[5], yi[6], yi[7]}));
                    acc8[i] = __builtin_amdgcn_mfma_f32_16x16x32_bf16(cqr, bre, acc8[i], 0, 0, 0);
                    acc8[i] = __builtin_amdgcn_mfma_f32_16x16x32_bf16(cqi, bim, acc8[i], 0, 0, 0);
                    if (s8 < 7) {
#pragma unroll
                        for (int j = 0; j < 8; ++j) { const float a = yr[j], c = yi[j]; yr[j] = lr[j] * a - li[j] * c; yi[j] = lr[j] * c + li[j] * a; }
                    }
                }
            }
        }
#pragma unroll
        for (int i = 0; i < 8; ++i) { const int t = wid * 8 + i;
            fa::u32x2 w; w.x = fa::pk2(geluf_(acc8[i][0]), geluf_(acc8[i][1])); w.y = fa::pk2(geluf_(acc8[i][2]), geluf_(acc8[i][3]));
            *(fa::u32x2*)(YG + ((size_t)(rcbase + c16) * 64 + t) * ZW + C_S5 + g * 16 + 4 * kq) = w; }
    }
    __syncthreads();
}
__device__ __forceinline__ void rope16(float (&v)[4], int kq, float pos, bool on) {
#pragma unroll
    for (int r = 0; r < 4; ++r) {
        const int j = (4 * kq + r) & 7;
        const float ang = pos * exp2f(-(float)j * (13.287712379549449f / 8.f)), cs = __cosf(ang), sn = __sinf(ang);
        const float other = __shfl_xor(v[r], 32);
        const float rot = kq < 2 ? v[r] * cs - other * sn : other * sn + v[r] * cs;
        v[r] = on ? rot : v[r];
    }
}
__device__ __forceinline__ void ph_prep(bf16_t* Z, const bf16_t* WUQ, const bf16_t* WUKV, const bf16_t* D64, const float* qkq, const float* qkk,
                                        bf16_t* Q, bf16_t* Kb, bf16_t* Vb, bf16_t* F1lat, bf16_t* F1ctx, unsigned char* lds_) { PH_IDS;
    const int lane = tid_ & 63, wid = __builtin_amdgcn_readfirstlane(tid_ >> 6), c16 = lane & 15, kq = lane >> 4;
    LAS char* sm = (LAS char*)lds_;
    constexpr int P_KV = 336, P_QC = 528, O_KV = 0, O_QC = 24576, O_FU = 63488;
    for (int blk = bid_; blk < RT / 72; blk += G_) {
        const int row0 = blk * 72;
        __syncthreads();
#pragma unroll 1
        for (int hf = 0; hf < 3; ++hf) { pg8::u32x4 st[4];
#pragma unroll
          for (int i = 0; i < 4; ++i) { const int e = tid_ + NT * (4 * hf + i);
              if (e < 1440) st[i] = *(const pg8::u32x4*)(Z + (size_t)(row0 + e / 20) * ZW + C_KVC + (e % 20) * 8);
              else if (e < 3744) st[i] = *(const pg8::u32x4*)(Z + (size_t)(row0 + ((e - 1440) >> 5)) * ZW + C_QC + ((e - 1440) & 31) * 8);
              else if (e < 6048) st[i] = *(const pg8::u32x4*)(Z + (size_t)(row0 + ((e - 3744) >> 5)) * ZW + C_FU + ((e - 3744) & 31) * 8); }
#pragma unroll
          for (int i = 0; i < 4; ++i) { const int e = tid_ + NT * (4 * hf + i);
              if (e < 1440) *(LAS pg8::u32x4*)(sm + O_KV + (e / 20) * P_KV + (e % 20) * 16) = st[i];
              else if (e < 3744) *(LAS pg8::u32x4*)(sm + O_QC + ((e - 1440) >> 5) * P_QC + ((e - 1440) & 31) * 16) = st[i];
              else if (e < 6048) *(LAS pg8::u32x4*)(sm + O_FU + ((e - 3744) >> 5) * P_QC + ((e - 3744) & 31) * 16) = st[i]; } }
        __syncthreads();
#pragma unroll 1
      for (int pass3 = 0; pass3 < 2; ++pass3) {
        int rowc[3], rl[3]; bool valid[3];
#pragma unroll
        for (int tt = 0; tt < 3; ++tt) { const int o = 16 * (3 * pass3 + tt) + c16; valid[tt] = o < 72; rl[tt] = valid[tt] ? o : 71; rowc[tt] = row0 + rl[tt]; }
        if (wid < 4) {
            const int h = wid;
            f32x4 acc[6][3]; float ssq[3];
#pragma unroll
            for (int tt = 0; tt < 3; ++tt) { ssq[tt] = 0.f;
#pragma unroll
                for (int nt = 0; nt < 6; ++nt) acc[nt][tt] = (f32x4){0.f, 0.f, 0.f, 0.f}; }
#pragma unroll 4
            for (int ks = 0; ks < 8; ++ks) {
                bf16x8 bq[3], aw[6];
#pragma unroll
                for (int tt = 0; tt < 3; ++tt) { bq[tt] = *(const LAS bf16x8*)(sm + O_QC + rl[tt] * P_QC + (32 * ks + 8 * kq) * 2);
#pragma unroll
                    for (int e = 0; e < 8; ++e) { const float f = bf2f((bf16_t)bq[tt][e]); ssq[tt] += f * f; } }
#pragma unroll
                for (int nt = 0; nt < 6; ++nt) aw[nt] = *(const bf16x8*)(WUQ + (size_t)(h * 96 + 16 * nt + c16) * 256 + 32 * ks + 8 * kq);
#pragma unroll
                for (int nt = 0; nt < 6; ++nt)
#pragma unroll
                    for (int tt = 0; tt < 3; ++tt) acc[nt][tt] = __builtin_amdgcn_mfma_f32_16x16x32_bf16(aw[nt], bq[tt], acc[nt][tt], 0, 0, 0);
            }
#pragma unroll
            for (int tt = 0; tt < 3; ++tt) {
                float s1 = ssq[tt]; s1 += __shfl_xor(s1, 16); s1 += __shfl_xor(s1, 32);
                const float rstd = rsqrtf(s1 * (1.f / 256) + EPS);
                float ss = 0.f;
#pragma unroll
                for (int nt = 0; nt < 6; ++nt)
#pragma unroll
                    for (int r = 0; r < 4; ++r) ss += acc[nt][tt][r] * acc[nt][tt][r];
                ss += __shfl_xor(ss, 16); ss += __shfl_xor(ss, 32);
                const float fac = rstd * rsqrtf(rstd * rstd * ss * (1.f / 96) + EPS) * 0.14724727430627066f;
                const int row = rowc[tt]; const bool lat = row < RL; const int b = row_batch(row), t = lat ? (row & 2047) : ((row - RL) & 255), qi = lat ? t : 2048 + t;
                bf16_t* qo = Q + ((size_t)(b * 4 + h) * 2304 + qi) * 96 + 4 * kq;
#pragma unroll
                for (int nt = 0; nt < 6; ++nt) {
                    const f32x4 w = *(const f32x4*)(qkq + 16 * nt + 4 * kq);
                    float v[4];
#pragma unroll
                    for (int r = 0; r < 4; ++r) v[r] = acc[nt][tt][r] * fac * w[r];
                    if (nt >= 4) rope16(v, kq, nt == 4 ? (float)(t >> 6) : (float)(t & 63), lat);
                    fa::u32x2 o; o.x = fa::pk2(v[0], v[1]); o.y = fa::pk2(v[2], v[3]);
                    if (valid[tt]) *(fa::u32x2*)(qo + 16 * nt) = o;
                }
            }
        } else {
            const int h = wid - 4;
            float ssq[3], rstd[3];
#pragma unroll
            for (int tt = 0; tt < 3; ++tt) ssq[tt] = 0.f;
#pragma unroll 1
            for (int pass = 0; pass < 2; ++pass) {
                f32x4 acc[4][3];
#pragma unroll
                for (int tt = 0; tt < 3; ++tt)
#pragma unroll
                    for (int nt = 0; nt < 4; ++nt) acc[nt][tt] = (f32x4){0.f, 0.f, 0.f, 0.f};
#pragma unroll
                for (int ks = 0; ks < 4; ++ks) {
                    bf16x8 bq[3], aw[4];
#pragma unroll
                    for (int tt = 0; tt < 3; ++tt) { bq[tt] = *(const LAS bf16x8*)(sm + O_KV + rl[tt] * P_KV + (32 * ks + 8 * kq) * 2);
                        if (pass == 0) {
#pragma unroll
                            for (int e = 0; e < 8; ++e) { const float f = bf2f((bf16_t)bq[tt][e]); ssq[tt] += f * f; } } }
#pragma unroll
                    for (int nt = 0; nt < 4; ++nt) aw[nt] = *(const bf16x8*)(WUKV + (size_t)(h * 128 + pass * 64 + 16 * nt + c16) * 128 + 32 * ks + 8 * kq);
#pragma unroll
                    for (int nt = 0; nt < 4; ++nt)
#pragma unroll
                        for (int tt = 0; tt < 3; ++tt) acc[nt][tt] = __builtin_amdgcn_mfma_f32_16x16x32_bf16(aw[nt], bq[tt], acc[nt][tt], 0, 0, 0);
                }
#pragma unroll
                for (int tt = 0; tt < 3; ++tt) {
                    const int row = rowc[tt]; const bool lat = row < RL; const int b = row_batch(row), t = lat ? (row & 2047) : ((row - RL) & 255), ki = lat ? 256 + t : t;
                    if (pass == 0) {
                        float s1 = ssq[tt]; s1 += __shfl_xor(s1, 16); s1 += __shfl_xor(s1, 32);
                        rstd[tt] = rsqrtf(s1 * (1.f / 128) + EPS);
                        float kr[2][4];
#pragma unroll
                        for (int e = 0; e < 2; ++e) { const fa::u32x2 w = *(const LAS fa::u32x2*)(sm + O_KV + rl[tt] * P_KV + (128 + 16 * e + 4 * kq) * 2);
                            kr[e][0] = __uint_as_float(w.x << 16); kr[e][1] = __uint_as_float(w.x & 0xffff0000u); kr[e][2] = __uint_as_float(w.y << 16); kr[e][3] = __uint_as_float(w.y & 0xffff0000u); }
                        float ss = 0.f;
#pragma unroll
                        for (int nt = 0; nt < 4; ++nt)
#pragma unroll
                            for (int r = 0; r < 4; ++r) { acc[nt][tt][r] *= rstd[tt]; ss += acc[nt][tt][r] * acc[nt][tt][r]; }
#pragma unroll
                        for (int e = 0; e < 2; ++e)
#pragma unroll
                            for (int r = 0; r < 4; ++r) ss += kr[e][r] * kr[e][r];
                        ss += __shfl_xor(ss, 16); ss += __shfl_xor(ss, 32);
                        const float fac = rsqrtf(ss * (1.f / 96) + EPS);
                        bf16_t* ko = Kb + ((size_t)(b * 4 + h) * 2304 + ki) * 96 + 4 * kq;
#pragma unroll
                        for (int nt = 0; nt < 6; ++nt) {
                            const f32x4 w = *(const f32x4*)(qkk + 16 * nt + 4 * kq);
                            float v[4];
#pragma unroll
                            for (int r = 0; r < 4; ++r) v[r] = (nt < 4 ? acc[nt < 4 ? nt : 0][tt][r] : kr[nt < 4 ? 0 : nt - 4][r]) * fac * w[r];
                            if (nt >= 4) rope16(v, kq, nt == 4 ? (float)(t >> 6) : (float)(t & 63), lat);
                            fa::u32x2 o; o.x = fa::pk2(v[0], v[1]); o.y = fa::pk2(v[2], v[3]);
                            if (valid[tt]) *(fa::u32x2*)(ko + 16 * nt) = o;
                        }
                    } else {
                        bf16_t* vo = Vb + ((size_t)(b * 4 + h) * 2304 + ki) * 64 + 4 * kq;
#pragma unroll
                        for (int nt = 0; nt < 4; ++nt) { fa::u32x2 o; o.x = fa::pk2(acc[nt][tt][0] * rstd[tt], acc[nt][tt][1] * rstd[tt]); o.y = fa::pk2(acc[nt][tt][2] * rstd[tt], acc[nt][tt][3] * rstd[tt]);
                            if (valid[tt]) *(fa::u32x2*)(vo + 16 * nt) = o; }
                    }
                }
            }
        }
        {
            const int g = wid >> 1, part = wid & 1;
            f32x4 acc[4][3];
#pragma unroll
            for (int tt = 0; tt < 3; ++tt)
#pragma unroll
                for (int nt = 0; nt < 4; ++nt) acc[nt][tt] = (f32x4){0.f, 0.f, 0.f, 0.f};
#pragma unroll
            for (int ks = 0; ks < 2; ++ks) {
                bf16x8 au[3], bd[4];
#pragma unroll
                for (int tt = 0; tt < 3; ++tt) au[tt] = *(const LAS bf16x8*)(sm + O_FU + rl[tt] * P_QC + (g * 64 + 32 * ks + 8 * kq) * 2);
#pragma unroll
                for (int nt = 0; nt < 4; ++nt) bd[nt] = *(const bf16x8*)(D64 + (size_t)(part * 64 + 16 * nt + c16) * 64 + 32 * ks + 8 * kq);
#pragma unroll
                for (int nt = 0; nt < 4; ++nt)
#pragma unroll
                    for (int tt = 0; tt < 3; ++tt) acc[nt][tt] = __builtin_amdgcn_mfma_f32_16x16x32_bf16(au[tt], bd[nt], acc[nt][tt], 0, 0, 0);
            }
#pragma unroll
            for (int tt = 0; tt < 3; ++tt) {
                const int o4 = 16 * (3 * pass3 + tt) + 4 * kq; const int trow = row0 + o4;
                if (o4 < 72) {
                    const bool lat = trow < RL;
#pragma unroll
                    for (int nt = 0; nt < 4; ++nt) {
                        const int gm = g * 64 + 16 * nt + c16;
                        fa::u32x2 o; o.x = fa::pk2(acc[nt][tt][0], acc[nt][tt][1]); o.y = fa::pk2(acc[nt][tt][2], acc[nt][tt][3]);
                        if (lat) { const int b = trow >> 11, t0 = trow & 2047; *(fa::u32x2*)(F1lat + ((size_t)(b * 256 + gm) * 2 + part) * 2048 + t0) = o; }
                        else { const int rr = trow - RL, b = rr >> 8, t0 = rr & 255; *(fa::u32x2*)(F1ctx + ((size_t)(b * 256 + gm) * 2 + part) * 256 + t0) = o; }
                    }
                }
            }
        }
      }
#pragma unroll 1
        for (int it = tid_; it < 72 * 16; it += NT) {
            const int row = row0 + (it >> 4), h = (it >> 2) & 3, jg = it & 3;
            bf16_t* zq = Z + (size_t)row * ZW + C_RQ + h * 64 + 8 * jg; bf16_t* zk = Z + (size_t)row * ZW + C_RK + h * 64 + 8 * jg;
            const fa::u32x4 k1 = *(const fa::u32x4*)zk, k2 = *(const fa::u32x4*)(zk + 32);
            f32x4 ka, kb, kc, kd; unpack8(k1, ka, kb); unpack8(k2, kc, kd);
            if (row < RL) {
                const fa::u32x4 q1 = *(const fa::u32x4*)zq, q2 = *(const fa::u32x4*)(zq + 32);
                f32x4 qa, qb, qc, qd; unpack8(q1, qa, qb); unpack8(q2, qc, qd);
                const float tpos = (float)(row & 2047);
                float x1q[8] = {qa[0], qa[1], qa[2], qa[3], qb[0], qb[1], qb[2], qb[3]}, x2q[8] = {qc[0], qc[1], qc[2], qc[3], qd[0], qd[1], qd[2], qd[3]};
                float x1k[8] = {ka[0], ka[1], ka[2], ka[3], kb[0], kb[1], kb[2], kb[3]}, x2k[8] = {kc[0], kc[1], kc[2], kc[3], kd[0], kd[1], kd[2], kd[3]};
#pragma unroll
                for (int e = 0; e < 8; ++e) {
                    float rev = tpos * (__builtin_amdgcn_exp2f(-(float)(8 * jg + e) * (13.287712379549449f / 32.f)) * 0.15915494309189535f); rev -= floorf(rev);
                    const float cs = __builtin_amdgcn_cosf(rev), sn = __builtin_amdgcn_sinf(rev);
                    const float a = x1q[e], c = x2q[e]; x1q[e] = a * cs - c * sn; x2q[e] = a * sn + c * cs;
                    const float a2 = x1k[e], c2 = x2k[e]; x1k[e] = (a2 * cs - c2 * sn) * 0.125f; x2k[e] = (a2 * sn + c2 * cs) * 0.125f;
                }
                *(fa::u32x4*)zq = pack8((f32x4){x1q[0], x1q[1], x1q[2], x1q[3]}, (f32x4){x1q[4], x1q[5], x1q[6], x1q[7]});
                *(fa::u32x4*)(zq + 32) = pack8((f32x4){x2q[0], x2q[1], x2q[2], x2q[3]}, (f32x4){x2q[4], x2q[5], x2q[6], x2q[7]});
                *(fa::u32x4*)zk = pack8((f32x4){x1k[0], x1k[1], x1k[2], x1k[3]}, (f32x4){x1k[4], x1k[5], x1k[6], x1k[7]});
                *(fa::u32x4*)(zk + 32) = pack8((f32x4){x2k[0], x2k[1], x2k[2], x2k[3]}, (f32x4){x2k[4], x2k[5], x2k[6], x2k[7]});
            } else {
                *(fa::u32x4*)zk = pack8(ka * 0.125f, kb * 0.125f); *(fa::u32x4*)(zk + 32) = pack8(kc * 0.125f, kd * 0.125f);
            }
        }
    }
}

__device__ __forceinline__ void attn_tile(const LAS char* sm, int r32, int hi, int vrd, int buf, bool first, const bf16x8 (&qf)[6], fa::f32x16& negm, float& mrun, float& lsum, fa::f32x16& o0, fa::f32x16& o1) {
    using namespace fa;
    const LAS char* kb = sm + buf + r32 * KP_A + 16 * hi;
    f32x16 p0 = negm, p1 = negm;
#pragma unroll
    for (int st = 0; st < 6; ++st) {
        const bf16x8 k0 = *(const LAS bf16x8*)(kb + 32 * st), k1 = *(const LAS bf16x8*)(kb + 32 * KP_A + 32 * st);
        p0 = __builtin_amdgcn_mfma_f32_32x32x16_bf16(k0, qf[st], p0, 0, 0, 0);
        p1 = __builtin_amdgcn_mfma_f32_32x32x16_bf16(k1, qf[st], p1, 0, 0, 0);
    }
    float ta = fmaxf(fmaxf(p0[0], p0[1]), p1[0]), tb = fmaxf(fmaxf(p0[2], p0[3]), p1[1]);
    ta = fmaxf(fmaxf(ta, p1[2]), p1[3]);
#pragma unroll
    for (int r = 4; r < 16; r += 4) { ta = fmaxf(fmaxf(ta, p0[r]), p0[r + 1]); tb = fmaxf(fmaxf(tb, p0[r + 2]), p0[r + 3]); ta = fmaxf(fmaxf(ta, p1[r]), p1[r + 1]); tb = fmaxf(fmaxf(tb, p1[r + 2]), p1[r + 3]); }
    float tm = fmaxf(ta, tb);
    tm = fmaxf(tm, __shfl_xor(tm, 32));
    if (first || __any(tm > 0.f)) {
        const float dl = first ? tm : fmaxf(tm, 0.f), alpha = first ? 1.f : __builtin_amdgcn_exp2f(-dl);
        mrun += dl; lsum *= alpha;
#pragma unroll
        for (int r = 0; r < 16; ++r) { p0[r] -= dl; p1[r] -= dl; o0[r] *= alpha; o1[r] *= alpha; negm[r] = -mrun; }
    }
    float ps = 0.f, ps2 = 0.f;
#pragma unroll
    for (int r = 0; r < 16; ++r) { p0[r] = __builtin_amdgcn_exp2f(p0[r]); p1[r] = __builtin_amdgcn_exp2f(p1[r]); ps += p0[r]; ps2 += p1[r]; }
    lsum += ps + ps2;
    bf16x8 pf[4]; pf[0] = pack_p(p0, 0); pf[1] = pack_p(p0, 8); pf[2] = pack_p(p1, 0); pf[3] = pack_p(p1, 8);
    pv_tile(o0, o1, sm + buf + vrd, pf);
}
__device__ __forceinline__ void attn_pair(const LAS char* sm, int r32, int hi, int vrd, int bufA, int bufB, bool first, const bf16x8 (&qf)[6], fa::f32x16& negm, float& mrun, float& lsum, fa::f32x16& o0, fa::f32x16& o1) {
    using namespace fa;
    const LAS char* ka = sm + bufA + r32 * KP_A + 16 * hi; const LAS char* kb = sm + bufB + r32 * KP_A + 16 * hi;
    f32x16 a0 = negm, a1 = negm, b0 = negm, b1 = negm;
#pragma unroll
    for (int st = 0; st < 6; ++st) {
        const bf16x8 k0 = *(const LAS bf16x8*)(ka + 32 * st), k1 = *(const LAS bf16x8*)(ka + 32 * KP_A + 32 * st);
        a0 = __builtin_amdgcn_mfma_f32_32x32x16_bf16(k0, qf[st], a0, 0, 0, 0);
        a1 = __builtin_amdgcn_mfma_f32_32x32x16_bf16(k1, qf[st], a1, 0, 0, 0);
    }
    float carry = 0.f;
    {
        float ta = fmaxf(fmaxf(a0[0], a0[1]), a1[0]), tb = fmaxf(fmaxf(a0[2], a0[3]), a1[1]);
        ta = fmaxf(fmaxf(ta, a1[2]), a1[3]);
#pragma unroll
        for (int r = 4; r < 16; r += 4) { ta = fmaxf(fmaxf(ta, a0[r]), a0[r + 1]); tb = fmaxf(fmaxf(tb, a0[r + 2]), a0[r + 3]); ta = fmaxf(fmaxf(ta, a1[r]), a1[r + 1]); tb = fmaxf(fmaxf(tb, a1[r + 2]), a1[r + 3]); }
        float tm = fmaxf(ta, tb);
        tm = fmaxf(tm, __shfl_xor(tm, 32));
        if (first || __any(tm > 0.f)) {
            const float dl = first ? tm : fmaxf(tm, 0.f), alpha = first ? 1.f : __builtin_amdgcn_exp2f(-dl);
            mrun += dl; lsum *= alpha; carry = dl;
#pragma unroll
            for (int r = 0; r < 16; ++r) { a0[r] -= dl; a1[r] -= dl; o0[r] *= alpha; o1[r] *= alpha; negm[r] = -mrun; }
        }
    }
#pragma unroll
    for (int st = 0; st < 6; ++st) {
        const bf16x8 k0 = *(const LAS bf16x8*)(kb + 32 * st), k1 = *(const LAS bf16x8*)(kb + 32 * KP_A + 32 * st);
        b0 = __builtin_amdgcn_mfma_f32_32x32x16_bf16(k0, qf[st], b0, 0, 0, 0);
        b1 = __builtin_amdgcn_mfma_f32_32x32x16_bf16(k1, qf[st], b1, 0, 0, 0);
    }
    float ps = 0.f, ps2 = 0.f;
#pragma unroll
    for (int r = 0; r < 16; ++r) { a0[r] = __builtin_amdgcn_exp2f(a0[r]); a1[r] = __builtin_amdgcn_exp2f(a1[r]); ps += a0[r]; ps2 += a1[r]; }
    lsum += ps + ps2;
    bf16x8 pf[4]; pf[0] = pack_p(a0, 0); pf[1] = pack_p(a0, 8); pf[2] = pack_p(a1, 0); pf[3] = pack_p(a1, 8);
    pv_tile(o0, o1, sm + bufA + vrd, pf);
    {
        float ta = fmaxf(fmaxf(b0[0], b0[1]), b1[0]), tb = fmaxf(fmaxf(b0[2], b0[3]), b1[1]);
        ta = fmaxf(fmaxf(ta, b1[2]), b1[3]);
#pragma unroll
        for (int r = 4; r < 16; r += 4) { ta = fmaxf(fmaxf(ta, b0[r]), b0[r + 1]); tb = fmaxf(fmaxf(tb, b0[r + 2]), b0[r + 3]); ta = fmaxf(fmaxf(ta, b1[r]), b1[r + 1]); tb = fmaxf(fmaxf(tb, b1[r + 2]), b1[r + 3]); }
        float tm = fmaxf(ta, tb) - carry;
        tm = fmaxf(tm, __shfl_xor(tm, 32));
        if (__any(tm > 0.f) || __any(carry != 0.f)) {
            const float dl = fmaxf(tm, 0.f), alpha = __builtin_amdgcn_exp2f(-dl), sh = carry + dl;
            mrun += dl; lsum *= alpha;
#pragma unroll
            for (int r = 0; r < 16; ++r) { b0[r] -= sh; b1[r] -= sh; o0[r] *= alpha; o1[r] *= alpha; negm[r] = -mrun; }
        }
    }
    ps = 0.f; ps2 = 0.f;
#pragma unroll
    for (int r = 0; r < 16; ++r) { b0[r] = __builtin_amdgcn_exp2f(b0[r]); b1[r] = __builtin_amdgcn_exp2f(b1[r]); ps += b0[r]; ps2 += b1[r]; }
    lsum += ps + ps2;
    pf[0] = pack_p(b0, 0); pf[1] = pack_p(b0, 8); pf[2] = pack_p(b1, 0); pf[3] = pack_p(b1, 8);
    pv_tile(o0, o1, sm + bufB + vrd, pf);
}
__device__ __forceinline__ float vadd1(float a, float b) { float r; asm("v_add_f32 %0, %1, %2" : "=v"(r) : "v"(a), "v"(b)); return r; }
__device__ __forceinline__ float att_max(const fa::f32x16& p0, const fa::f32x16& p1) {
    float ta = fmaxf(fmaxf(p0[0], p0[1]), p1[0]), tb = fmaxf(fmaxf(p0[2], p0[3]), p1[1]);
    ta = fmaxf(fmaxf(ta, p1[2]), p1[3]);
#pragma unroll
    for (int r = 4; r < 16; r += 4) { ta = fmaxf(fmaxf(ta, p0[r]), p0[r + 1]); tb = fmaxf(fmaxf(tb, p0[r + 2]), p0[r + 3]); ta = fmaxf(fmaxf(ta, p1[r]), p1[r + 1]); tb = fmaxf(fmaxf(tb, p1[r + 2]), p1[r + 3]); }
    return fmaxf(ta, tb);
}
__device__ __forceinline__ void att_shift(float tm, bool first, float& mrun, float& lsum, fa::f32x16& o0, fa::f32x16& o1) {
    tm = fmaxf(tm, __shfl_xor(tm, 32));
    if (first || __any(tm > mrun + 8.f)) {
        const float dl = first ? 0.f : fmaxf(tm - mrun, 0.f), alpha = __builtin_amdgcn_exp2f(-dl);
        mrun = first ? tm : mrun + dl; lsum *= alpha;
#pragma unroll
        for (int r = 0; r < 16; ++r) { o0[r] *= alpha; o1[r] *= alpha; }
    }
}
__device__ __forceinline__ void att_qk_exp(const LAS char* kb, const bf16x8 (&qf)[6], float nm, fa::f32x16& n0, fa::f32x16& n1, fa::f32x16& p0, fa::f32x16& p1, float& lsum, bf16x8 (&pf)[4]) {
    const fa::f32x16 zero = {0.f, 0.f, 0.f, 0.f, 0.f, 0.f, 0.f, 0.f, 0.f, 0.f, 0.f, 0.f, 0.f, 0.f, 0.f, 0.f};
    bf16x8 kc0 = *(const LAS bf16x8*)kb, kc1 = *(const LAS bf16x8*)(kb + 32 * fa::KP_A);
    float ps = 0.f, ps2 = 0.f;
#pragma unroll
    for (int st = 0; st < 6; ++st) {
        bf16x8 kn0 = kc0, kn1 = kc1;
        if (st < 5) { kn0 = *(const LAS bf16x8*)(kb + 32 * (st + 1)); kn1 = *(const LAS bf16x8*)(kb + 32 * fa::KP_A + 32 * (st + 1)); }
        n0 = __builtin_amdgcn_mfma_f32_32x32x16_bf16(kc0, qf[st], st == 0 ? zero : n0, 0, 0, 0);
        n1 = __builtin_amdgcn_mfma_f32_32x32x16_bf16(kc1, qf[st], st == 0 ? zero : n1, 0, 0, 0);
        constexpr int lo[7] = {0, 2, 6, 8, 10, 14, 16};
#pragma unroll
        for (int r = lo[st]; r < lo[st + 1]; ++r) {
            p0[r] = __builtin_amdgcn_exp2f(vadd1(p0[r], nm)); p1[r] = __builtin_amdgcn_exp2f(vadd1(p1[r], nm));
            ps += p0[r]; ps += p1[r]; }
        kc0 = kn0; kc1 = kn1;
        __builtin_amdgcn_sched_barrier(0);
    }
    lsum += ps + ps2;
    pf[0] = fa::pack_p(p0, 0); pf[1] = fa::pack_p(p0, 8); pf[2] = fa::pack_p(p1, 0); pf[3] = fa::pack_p(p1, 8);
}
__device__ __forceinline__ void att_exp_pack(fa::f32x16& p0, fa::f32x16& p1, float nm, float& lsum, bf16x8 (&pf)[4]) {
    float ps = 0.f, ps2 = 0.f;
#pragma unroll
    for (int r = 0; r < 16; ++r) { p0[r] = __builtin_amdgcn_exp2f(vadd1(p0[r], nm)); p1[r] = __builtin_amdgcn_exp2f(vadd1(p1[r], nm)); ps += p0[r]; ps += p1[r]; }
    lsum += ps + ps2;
    pf[0] = fa::pack_p(p0, 0); pf[1] = fa::pack_p(p0, 8); pf[2] = fa::pack_p(p1, 0); pf[3] = fa::pack_p(p1, 8);
}
__device__ __forceinline__ float att_pv_max(fa::f32x16& o0, fa::f32x16& o1, const LAS char* vb, const bf16x8 (&pf)[4], const fa::f32x16& n0, const fa::f32x16& n1) {
    using namespace fa;
    float ta = n0[0], tb = n1[0];
    s16x4 a0 = vtr(vb), a1 = vtr(vb + 512), b0 = vtr(vb + 4096), b1 = vtr(vb + 4096 + 512);
#pragma unroll
    for (int ks = 0; ks < 4; ++ks) {
        s16x4 na0 = a0, na1 = a1, nb0 = b0, nb1 = b1;
        if (ks < 3) { na0 = vtr(vb + (ks + 1) * 1024); na1 = vtr(vb + (ks + 1) * 1024 + 512); nb0 = vtr(vb + 4096 + (ks + 1) * 1024); nb1 = vtr(vb + 4096 + (ks + 1) * 1024 + 512); }
        const bf16x8 v0 = (bf16x8){a0[0], a0[1], a0[2], a0[3], a1[0], a1[1], a1[2], a1[3]}, v1 = (bf16x8){b0[0], b0[1], b0[2], b0[3], b1[0], b1[1], b1[2], b1[3]};
        o0 = __builtin_amdgcn_mfma_f32_32x32x16_bf16(v0, pf[ks], o0, 0, 0, 0);
        o1 = __builtin_amdgcn_mfma_f32_32x32x16_bf16(v1, pf[ks], o1, 0, 0, 0);
#pragma unroll
        for (int r = 4 * ks; r < 4 * ks + 4; ++r) { ta = fmaxf(ta, n0[r]); tb = fmaxf(tb, n1[r]); }
        a0 = na0; a1 = na1; b0 = nb0; b1 = nb1;
        __builtin_amdgcn_sched_barrier(0);
    }
    return fmaxf(ta, tb);
}
__device__ __forceinline__ void ph_attn_mfma(unsigned char* lds_, const bf16_t* Q, const bf16_t* Kb, const bf16_t* Vb, bf16_t* Z, int with_ctx, int u0, int ustep) { PH_IDS;
    using namespace fa;
    LAS char* sm = (LAS char*)lds_;
    const int lane = tid_ & 63, wid = __builtin_amdgcn_readfirstlane(tid_ >> 6), r32 = lane & 31, hi = lane >> 5;
    const int nunits = 256 + (with_ctx ? 32 : 0);
    const int koff0 = (tid_ / 12) * KP_A + (tid_ % 12) * 16, koff1 = ((tid_ + 512) / 12) * KP_A + ((tid_ + 512) % 12) * 16;
    const int voff = KT_A + ((tid_ & 7) >> 2) * 4096 + (tid_ >> 3) * 64 + (tid_ & 3) * 16;
    const int vrd = KT_A + ((lane >> 4) & 1) * 32 + (lane & 3) * 8 + (4 * hi + ((lane & 15) >> 2)) * 64;
    for (int u = u0; u < nunits; u += ustep) {
        const bool lat = u < 256; const int bh = lat ? (u >> 3) : (u - 256), qb = lat ? (u & 7) : 8;
        const int ntile = lat ? 36 : 4;
        const char* Kg = (const char*)(Kb + (size_t)bh * 2304 * 96); const char* Vg = (const char*)(Vb + (size_t)bh * 2304 * 64);
        const bf16_t* Qg = Q + ((size_t)bh * 2304 + qb * 256 + wid * 32 + r32) * 96;
        bf16x8 qf[6];
#pragma unroll
        for (int st = 0; st < 6; ++st) qf[st] = *(const bf16x8*)(Qg + 16 * st + 8 * hi);
        f32x16 o0, o1;
#pragma unroll
        for (int r = 0; r < 16; ++r) { o0[r] = 0.f; o1[r] = 0.f; }
        float mrun = 0.f, lsum = 0.f;
        f32x16 negm;
#pragma unroll
        for (int r = 0; r < 16; ++r) negm[r] = 0.f;
        u32x4 ka0, ka1, va, kb0, kb1, vb;
#define ATT_LOAD(k0_, k1_, v_, tt) do { const char* kg_ = Kg + (size_t)(tt) * 12288; const char* vg_ = Vg + (size_t)(tt) * 8192; \
            k0_ = *(const u32x4*)(kg_ + tid_ * 16); if (tid_ < 256) k1_ = *(const u32x4*)(kg_ + (tid_ + 512) * 16); v_ = *(const u32x4*)(vg_ + tid_ * 16); } while (0)
#define ATT_WRITE(k0_, k1_, v_, bo) do { *(LAS u32x4*)(sm + (bo) + koff0) = k0_; if (tid_ < 256) *(LAS u32x4*)(sm + (bo) + koff1) = k1_; *(LAS u32x4*)(sm + (bo) + voff) = v_; } while (0)
        ka1 = (u32x4){0u, 0u, 0u, 0u}; kb1 = ka1;
        const int npair = ntile >> 1;
        ATT_LOAD(ka0, ka1, va, 0); ATT_LOAD(kb0, kb1, vb, 1);
        __syncthreads();
        ATT_WRITE(ka0, ka1, va, 0); ATT_WRITE(kb0, kb1, vb, BUF_A);
        if (npair > 1) { ATT_LOAD(ka0, ka1, va, 2); ATT_LOAD(kb0, kb1, vb, 3); }
        __syncthreads();
        f32x16 a0, a1, b0, b1;
#pragma unroll
        for (int r = 0; r < 16; ++r) { a0[r] = 0.f; a1[r] = 0.f; }
        { const LAS char* kq0 = sm + r32 * KP_A + 16 * hi;
#pragma unroll
          for (int st = 0; st < 6; ++st) { const bf16x8 k0 = *(const LAS bf16x8*)(kq0 + 32 * st), k1 = *(const LAS bf16x8*)(kq0 + 32 * KP_A + 32 * st);
              a0 = __builtin_amdgcn_mfma_f32_32x32x16_bf16(k0, qf[st], a0, 0, 0, 0); a1 = __builtin_amdgcn_mfma_f32_32x32x16_bf16(k1, qf[st], a1, 0, 0, 0); } }
        float tmA = att_max(a0, a1);
        int cur = 0;
        for (int p = 0; p < npair; ++p) {
            const int nxt = cur == 4 * BUF_A ? 0 : cur + 2 * BUF_A;
            const bool more = p + 1 < npair;
            if (more) { ATT_WRITE(ka0, ka1, va, nxt); ATT_WRITE(kb0, kb1, vb, nxt + BUF_A); }
            if (p + 2 < npair) { ATT_LOAD(ka0, ka1, va, 2 * p + 4); ATT_LOAD(kb0, kb1, vb, 2 * p + 5); }
            bf16x8 pf[4];
            att_shift(tmA, p == 0, mrun, lsum, o0, o1);
            att_qk_exp(sm + cur + BUF_A + r32 * KP_A + 16 * hi, qf, -mrun, b0, b1, a0, a1, lsum, pf);
            const float tmB = att_pv_max(o0, o1, sm + cur + vrd, pf, b0, b1);
            att_shift(tmB, false, mrun, lsum, o0, o1);
            __syncthreads();
            if (more) {
                att_qk_exp(sm + nxt + r32 * KP_A + 16 * hi, qf, -mrun, a0, a1, b0, b1, lsum, pf);
                tmA = att_pv_max(o0, o1, sm + cur + BUF_A + vrd, pf, a0, a1);
            } else {
                att_exp_pack(b0, b1, -mrun, lsum, pf);
                pv_tile(o0, o1, sm + cur + BUF_A + vrd, pf);
            }
            cur = nxt;
        }
#undef ATT_LOAD
#undef ATT_WRITE
        lsum += __shfl_xor(lsum, 32);
        const float inv = 1.f / lsum;
        const int b = bh >> 2, h = bh & 3;
        const int row = (lat ? b * 2048 + qb * 256 : RL + b * 256) + wid * 32 + r32;
        bf16_t* op = Z + (size_t)row * ZW + C_QC + h * 64 + 4 * hi;
#pragma unroll
        for (int g = 0; g < 4; ++g) {
            u32x2 w0, w1; w0.x = pk2(o0[4 * g] * inv, o0[4 * g + 1] * inv); w0.y = pk2(o0[4 * g + 2] * inv, o0[4 * g + 3] * inv);
            w1.x = pk2(o1[4 * g] * inv, o1[4 * g + 1] * inv); w1.y = pk2(o1[4 * g + 2] * inv, o1[4 * g + 3] * inv);
            *(u32x2*)(op + 8 * g) = w0; *(u32x2*)(op + 32 + 8 * g) = w1;
        }
    }
    __syncthreads();
}

__device__ __forceinline__ void ret_tile(const LAS char* sm, int r32, int hi, int vrd, int buf, int kp0, int qw0, int qpos, float lgf, float lgb, float cf32, float cb32,
                                         const float (&ckf)[16], const float (&ckb)[16], const bf16x8 (&qf)[4], fa::f32x16& o0, fa::f32x16& o1) {
    using namespace fa;
    const LAS char* kb = sm + buf + r32 * KP_R + 16 * hi;
    f32x16 p0, p1;
#pragma unroll
    for (int r = 0; r < 16; ++r) { p0[r] = 0.f; p1[r] = 0.f; }
#pragma unroll
    for (int st = 0; st < 4; ++st) {
        const bf16x8 k0 = *(const LAS bf16x8*)(kb + 32 * st), k1 = *(const LAS bf16x8*)(kb + 32 * KP_R + 32 * st);
        p0 = __builtin_amdgcn_mfma_f32_32x32x16_bf16(k0, qf[st], p0, 0, 0, 0);
        p1 = __builtin_amdgcn_mfma_f32_32x32x16_bf16(k1, qf[st], p1, 0, 0, 0);
    }
    if (kp0 + 63 < qw0) {
        const float sq = __builtin_amdgcn_exp2f(lgf * (float)(qpos - kp0)), sq1 = sq * cf32;
#pragma unroll
        for (int r = 0; r < 16; ++r) { p0[r] = p0[r] * ckf[r] * sq; p1[r] = p1[r] * ckf[r] * sq1; }
    } else if (kp0 > qw0 + 31) {
        const float sq = __builtin_amdgcn_exp2f(lgb * (float)(kp0 - qpos)), sq1 = sq * cb32;
#pragma unroll
        for (int r = 0; r < 16; ++r) { p0[r] = p0[r] * ckb[r] * sq; p1[r] = p1[r] * ckb[r] * sq1; }
    } else {
        const int d0 = qpos - kp0 - 4 * hi;
#pragma unroll
        for (int r = 0; r < 16; ++r) {
            const float f0 = (float)(d0 - ((r & 3) + 8 * (r >> 2))), f1 = f0 - 32.f;
            const float w0 = __builtin_amdgcn_exp2f(lgf * fmaxf(f0, 0.f) + lgb * fmaxf(-f0, 0.f)) * (2.f - fminf(fabsf(f0), 1.f));
            const float w1 = __builtin_amdgcn_exp2f(lgf * fmaxf(f1, 0.f) + lgb * fmaxf(-f1, 0.f)) * (2.f - fminf(fabsf(f1), 1.f));
            p0[r] *= w0; p1[r] *= w1;
        }
    }
    bf16x8 pf[4]; pf[0] = pack_p(p0, 0); pf[1] = pack_p(p0, 8); pf[2] = pack_p(p1, 0); pf[3] = pack_p(p1, 8);
    pv_tile(o0, o1, sm + buf + vrd, pf);
}
__device__ __forceinline__ void ret_qk(const LAS char* sm, int r32, int hi, int buf, const bf16x8 (&qf)[4], fa::f32x16& p0, fa::f32x16& p1) {
    const LAS char* kb = sm + buf + r32 * fa::KP_R + 16 * hi;
#pragma unroll
    for (int r = 0; r < 16; ++r) { p0[r] = 0.f; p1[r] = 0.f; }
#pragma unroll
    for (int st = 0; st < 4; ++st) {
        const bf16x8 k0 = *(const LAS bf16x8*)(kb + 32 * st), k1 = *(const LAS bf16x8*)(kb + 32 * fa::KP_R + 32 * st);
        p0 = __builtin_amdgcn_mfma_f32_32x32x16_bf16(k0, qf[st], p0, 0, 0, 0);
        p1 = __builtin_amdgcn_mfma_f32_32x32x16_bf16(k1, qf[st], p1, 0, 0, 0);
    }
}
__device__ __forceinline__ void ret_tile_gen(const LAS char* sm, int r32, int hi, int vrd, int buf, int kp0, int qpos, float lgf, float lgb, const bf16x8 (&qf)[4], fa::f32x16& o0, fa::f32x16& o1) {
    using namespace fa;
    const LAS char* kb = sm + buf + r32 * KP_R + 16 * hi;
    f32x16 p0, p1;
#pragma unroll
    for (int r = 0; r < 16; ++r) { p0[r] = 0.f; p1[r] = 0.f; }
#pragma unroll
    for (int st = 0; st < 4; ++st) {
        const bf16x8 k0 = *(const LAS bf16x8*)(kb + 32 * st), k1 = *(const LAS bf16x8*)(kb + 32 * KP_R + 32 * st);
        p0 = __builtin_amdgcn_mfma_f32_32x32x16_bf16(k0, qf[st], p0, 0, 0, 0);
        p1 = __builtin_amdgcn_mfma_f32_32x32x16_bf16(k1, qf[st], p1, 0, 0, 0);
    }
    int d0 = qpos - kp0 - 4 * hi;
    asm volatile("" : "+v"(d0) : "v"(p0[15]), "v"(p1[15]));
#pragma unroll
    for (int r = 0; r < 16; ++r) {
        const float f0 = (float)(d0 - ((r & 3) + 8 * (r >> 2))), f1 = f0 - 32.f;
        const float w0 = __builtin_amdgcn_exp2f(lgf * fmaxf(f0, 0.f) + lgb * fmaxf(-f0, 0.f)) * (2.f - fminf(fabsf(f0), 1.f));
        const float w1 = __builtin_amdgcn_exp2f(lgf * fmaxf(f1, 0.f) + lgb * fmaxf(-f1, 0.f)) * (2.f - fminf(fabsf(f1), 1.f));
        p0[r] *= w0; p1[r] *= w1;
    }
    bf16x8 pf[4]; pf[0] = pack_p(p0, 0); pf[1] = pack_p(p0, 8); pf[2] = pack_p(p1, 0); pf[3] = pack_p(p1, 8);
    pv_tile(o0, o1, sm + buf + vrd, pf);
}
__device__ __forceinline__ void ph_ret_kv(unsigned char* lds_, const bf16_t* Z, const float* decay_logit, bf16_t* KVF, bf16_t* KVB, int vb, int vg) { PH_IDS;
    using namespace fa;
    LAS char* sm = (LAS char*)lds_;
    const int lane = tid_ & 63, wid = __builtin_amdgcn_readfirstlane(tid_ >> 6), r32 = lane & 31, hi = lane >> 5;
    const int vrd = ((lane >> 4) & 1) * 32 + (lane & 3) * 8 + (4 * hi + ((lane & 15) >> 2)) * 64;
    u32x4 pk[2], pv[2];
#define KV_ISSUE(uu) do { const int bh_ = (uu) / 18, ci_ = (uu) % 18, b_ = bh_ >> 2, h_ = bh_ & 3; const int r0_ = ci_ < 2 ? RL + b_ * 256 + 128 * ci_ : b_ * 2048 + 128 * (ci_ - 2); \
        _Pragma("unroll") for (int i = 0; i < 2; ++i) { const int p = tid_ + NT * i; const bf16_t* zr = Z + (size_t)(r0_ + (p >> 3)) * ZW + h_ * 64 + (p & 7) * 8; pk[i] = *(const u32x4*)(zr + C_RK); pv[i] = *(const u32x4*)(zr + C_RV); } } while (0)
    if (vb >= 0 && vb < 32 * 18) KV_ISSUE(vb);
    for (int u = vb >= 0 ? vb : 32 * 18; u < 32 * 18; u += vg) {
        const int bh = u / 18, h = bh & 3;
        const float lgf = -log1pf(__expf(-decay_logit[h])) * 1.4426950408889634f, lgb = -log1pf(__expf(-decay_logit[4 + h])) * 1.4426950408889634f;
        __syncthreads();
#pragma unroll
        for (int i = 0; i < 2; ++i) {
            const int p = tid_ + NT * i, row = p >> 3, c = p & 7, tile = row >> 6, key = row & 63;
            const int off = tile * 8192 + (c >> 2) * 4096 + key * 64 + (c & 3) * 16;
            *(LAS u32x4*)(sm + off) = pk[i];
            f32x4 va, vb; unpack8(pv[i], va, vb);
            const float wf = __builtin_amdgcn_exp2f(lgf * (float)(127 - row)), wb = __builtin_amdgcn_exp2f(lgb * (float)row);
            *(LAS u32x4*)(sm + 16384 + off) = pack8(va * wf, vb * wf);
            *(LAS u32x4*)(sm + 32768 + off) = pack8(va * wb, vb * wb);
        }
        if (u + vg < 32 * 18) KV_ISSUE(u + vg);
        __syncthreads();
        const int dir = wid >> 2, bd = (wid >> 1) & 1, be = wid & 1;
        f32x16 acc;
#pragma unroll
        for (int r = 0; r < 16; ++r) acc[r] = 0.f;
        const LAS char* ka = sm + bd * 4096 + vrd; const LAS char* vv = sm + 16384 + dir * 16384 + be * 4096 + vrd;
#pragma unroll
        for (int tile = 0; tile < 2; ++tile)
#pragma unroll
            for (int ks = 0; ks < 4; ++ks) {
                const s16x4 a0 = vtr(ka + tile * 8192 + ks * 1024), a1 = vtr(ka + tile * 8192 + ks * 1024 + 512), b0 = vtr(vv + tile * 8192 + ks * 1024), b1 = vtr(vv + tile * 8192 + ks * 1024 + 512);
                acc = __builtin_amdgcn_mfma_f32_32x32x16_bf16((bf16x8){a0[0], a0[1], a0[2], a0[3], a1[0], a1[1], a1[2], a1[3]}, (bf16x8){b0[0], b0[1], b0[2], b0[3], b1[0], b1[1], b1[2], b1[3]}, acc, 0, 0, 0);
            }
        bf16_t* o = (dir ? KVB : KVF) + ((size_t)u * 64 + be * 32 + r32) * 64 + bd * 32 + 4 * hi;
#pragma unroll
        for (int g = 0; g < 4; ++g) { u32x2 w; w.x = pk2n(acc[4 * g], acc[4 * g + 1]); w.y = pk2n(acc[4 * g + 2], acc[4 * g + 3]); *(u32x2*)(o + 8 * g) = w; }
    }
    __syncthreads();
}
#undef KV_ISSUE
__device__ __forceinline__ void ph_ret_chunk(unsigned char* lds_, bf16_t* Z, const bf16_t* KVF, const bf16_t* KVB, const float* decay_logit, const float* gn_w, int with_ctx, int u0, int ustep, unsigned* kvc, unsigned* barw) { PH_IDS;
    using namespace fa;
    LAS char* sm = (LAS char*)lds_;
    constexpr int ST_OFF = 4 * BUF_R, ST_SZ = 64 * KP_R;
    const int lane = tid_ & 63, wid = __builtin_amdgcn_readfirstlane(tid_ >> 6), r32 = lane & 31, hi = lane >> 5;
    const int nunits = 256 + (with_ctx ? 32 : 0);
    const int prow = tid_ >> 3, pc = tid_ & 7;
    const int koff = prow * KP_R + pc * 16;
    const int voff = KT_R + (pc >> 2) * 4096 + prow * 64 + (pc & 3) * 16;
    const int vrd = KT_R + ((lane >> 4) & 1) * 32 + (lane & 3) * 8 + (4 * hi + ((lane & 15) >> 2)) * 64;
    for (int u = u0; u < nunits; u += ustep) {
        const bool lat = u < 256; const int bh = lat ? (u >> 3) : (u - 256), qb = lat ? (u & 7) : 0, b = bh >> 2, h = bh & 3;
        const float lgf = -log1pf(__expf(-decay_logit[h])) * 1.4426950408889634f, lgb = -log1pf(__expf(-decay_logit[4 + h])) * 1.4426950408889634f;
        const int qw0 = qb * 256 + wid * 32, qpos = qw0 + r32;
        const int qrow = (lat ? b * 2048 : RL + b * 256) + qpos;
        bf16_t* zq = Z + (size_t)qrow * ZW;
        u32x4 sK[4], sV[4]; bf16x8 qf[4];
        { const size_t rb = (lat ? (size_t)b * 2048 + qb * 256 : (size_t)RL + b * 256);
#pragma unroll
          for (int j = 0; j < 4; ++j) { const bf16_t* zr = Z + (rb + 64 * j + prow) * ZW + h * 64 + pc * 8; sK[j] = *(const u32x4*)(zr + C_RK); sV[j] = *(const u32x4*)(zr + C_RV); } }
#pragma unroll
        for (int st = 0; st < 4; ++st) qf[st] = *(const bf16x8*)(zq + C_RQ + h * 64 + 16 * st + 8 * hi);
        if (kvc != nullptr && tid_ == 0) dep_spin(kvc, (unsigned)G_, barw);
        __syncthreads();
#pragma unroll
        for (int j = 0; j < 4; ++j) { *(LAS u32x4*)(sm + j * BUF_R + koff) = sK[j]; *(LAS u32x4*)(sm + j * BUF_R + voff) = sV[j]; }
        {
            const float g128f = __builtin_amdgcn_exp2f(lgf * 128.f), g128b = __builtin_amdgcn_exp2f(lgb * 128.f);
            const bf16_t* kf = KVF + (size_t)bh * 18 * 4096 + tid_ * 8; const bf16_t* kb = KVB + (size_t)bh * 18 * 4096 + tid_ * 8;
            LAS char* sto = sm + ST_OFF + (tid_ >> 3) * KP_R + (tid_ & 7) * 16;
            f32x4 sa = (f32x4){0.f, 0.f, 0.f, 0.f}, sb = sa, ta, tb;
#define ST_PUT(k) (*(LAS u32x4*)(sto + (k) * ST_SZ) = pack8(sa, sb))
#define ST_STEP(ptr, ci_, g_) do { unpack8(*(const u32x4*)((ptr) + (size_t)(ci_) * 4096), ta, tb); sa = sa * (g_) + ta; sb = sb * (g_) + tb; } while (0)
            if (lat) {
                const int cA = 2 * qb, n1 = 2 + cA, nb = 16 - cA;
                u32x4 Lq[9], Lr[9]; f32x4 sc = (f32x4){0.f, 0.f, 0.f, 0.f}, sd = sc;
#define ST_PUTB(k) (*(LAS u32x4*)(sto + (k) * ST_SZ) = pack8(sc, sd))
#pragma unroll
                for (int hf = 0; hf < 2; ++hf) {
#pragma unroll
                    for (int k = 0; k < 9; ++k) { const int kk = 9 * hf + k;
                        if (kk <= n1 && kk < 17) Lq[k] = *(const u32x4*)(kf + (size_t)kk * 4096);
                        if (kk <= nb && kk < 17) Lr[k] = *(const u32x4*)(kb + (size_t)(kk == 0 ? 1 : (kk == 1 ? 0 : 19 - kk)) * 4096); }
#pragma unroll
                    for (int k = 0; k < 9; ++k) { const int kk = 9 * hf + k;
                        if (kk == n1) ST_PUT(0); if (kk <= n1 && kk < 17) { unpack8(Lq[k], ta, tb); sa = sa * g128f + ta; sb = sb * g128f + tb; }
                        if (kk == nb) ST_PUTB(3); if (kk <= nb && kk < 17) { unpack8(Lr[k], ta, tb); sc = sc * g128b + ta; sd = sd * g128b + tb; } }
                    asm volatile("" ::: "memory"); }
                ST_PUT(1); ST_PUTB(2);
#undef ST_PUTB
            } else {
                ST_PUT(0); ST_PUT(3);
                ST_STEP(kf, 0, g128f); ST_PUT(1);
                sa = (f32x4){0.f, 0.f, 0.f, 0.f}; sb = sa; ST_STEP(kb, 1, g128b); ST_PUT(2);
            }
#undef ST_PUT
#undef ST_STEP
        }
        __syncthreads();
        u32x2 gtv[8]; f32x4 gwv[8];
#pragma unroll
        for (int g = 0; g < 4; ++g)
#pragma unroll
            for (int blk = 0; blk < 2; ++blk) { const int d = blk * 32 + 8 * g + 4 * hi; gtv[2 * g + blk] = *(const u32x2*)(zq + C_RG + h * 64 + d); gwv[2 * g + blk] = *(const f32x4*)(gn_w + h * 64 + d); }
        f32x16 o0, o1;
#pragma unroll
        for (int r = 0; r < 16; ++r) { o0[r] = 0.f; o1[r] = 0.f; }
        const int cl = wid >> 2, c0 = qb * 256 + 128 * cl;
        ret_tile_gen(sm, r32, hi, vrd, (2 * cl) * BUF_R, c0, qpos, lgf, lgb, qf, o0, o1);
        __builtin_amdgcn_sched_barrier(0);
        ret_tile_gen(sm, r32, hi, vrd, (2 * cl + 1) * BUF_R, c0 + 64, qpos, lgf, lgb, qf, o0, o1);
        __builtin_amdgcn_sched_barrier(0);
        { f32x16 p0, p1;
          ret_qk(sm, r32, hi, ST_OFF + cl * ST_SZ, qf, p0, p1);
          const float sf = __builtin_amdgcn_exp2f(lgf * (float)(qpos - c0 + 1));
#pragma unroll
          for (int r = 0; r < 16; ++r) { o0[r] += p0[r] * sf; o1[r] += p1[r] * sf; }
          ret_qk(sm, r32, hi, ST_OFF + (2 + cl) * ST_SZ, qf, p0, p1);
          const float sbk = __builtin_amdgcn_exp2f(lgb * (float)(c0 + 128 - qpos));
#pragma unroll
          for (int r = 0; r < 16; ++r) { o0[r] += p0[r] * sbk; o1[r] += p1[r] * sbk; } }
        float s1 = 0.f;
#pragma unroll
        for (int r = 0; r < 16; ++r) s1 += o0[r] + o1[r];
        s1 += __shfl_xor(s1, 32);
        const float mu = s1 * (1.f / 64);
        float s2 = 0.f;
#pragma unroll
        for (int r = 0; r < 16; ++r) { const float a = o0[r] - mu, c = o1[r] - mu; s2 += a * a + c * c; }
        s2 += __shfl_xor(s2, 32);
        const float rstd = rsqrtf(s2 * (1.f / 64) + EPS);
#pragma unroll
        for (int g = 0; g < 4; ++g)
#pragma unroll
            for (int blk = 0; blk < 2; ++blk) {
                const int d = blk * 32 + 8 * g + 4 * hi;
                const u32x2 gt = gtv[2 * g + blk];
                const f32x4 gw = gwv[2 * g + blk];
                float y[4];
#pragma unroll
                for (int q = 0; q < 4; ++q) { const float ov = blk ? o1[4 * g + q] : o0[4 * g + q]; const unsigned gb = q < 2 ? gt.x : gt.y; const float gv = __uint_as_float((q & 1) ? (gb & 0xffff0000u) : (gb << 16));
                    y[q] = siluf_(gv) * ((ov - mu) * rstd * gw[q]); }
                u32x2 w; w.x = pk2(y[0], y[1]); w.y = pk2(y[2], y[3]);
                *(u32x2*)(zq + C_RQ + h * 64 + d) = w;
            }
    }
    __syncthreads();
}

__device__ __forceinline__ void ph_ret_mfma(unsigned char* lds_, bf16_t* Z, const float* decay_logit, const float* gn_w, int with_ctx, int u0, int ustep) { PH_IDS;
    using namespace fa;
    LAS char* sm = (LAS char*)lds_;
    const int lane = tid_ & 63, wid = __builtin_amdgcn_readfirstlane(tid_ >> 6), r32 = lane & 31, hi = lane >> 5;
    const int nunits = 256 + (with_ctx ? 32 : 0);
    const int prow = tid_ >> 3, pc = tid_ & 7;
    const int koff = prow * KP_R + pc * 16;
    const int voff = KT_R + (pc >> 2) * 4096 + prow * 64 + (pc & 3) * 16;
    const int vrd = KT_R + ((lane >> 4) & 1) * 32 + (lane & 3) * 8 + (4 * hi + ((lane & 15) >> 2)) * 64;
    for (int u = u0; u < nunits; u += ustep) {
        const bool lat = u < 256; const int bh = lat ? (u >> 3) : (u - 256), qb = lat ? (u & 7) : 0, b = bh >> 2, h = bh & 3;
        const int ntile = lat ? 40 : 4;
        const float lgf = -log1pf(__expf(-decay_logit[h])) * 1.4426950408889634f, lgb = -log1pf(__expf(-decay_logit[4 + h])) * 1.4426950408889634f;
        const int qw0 = qb * 256 + wid * 32, qpos = qw0 + r32;
        const int qrow = (lat ? b * 2048 : RL + b * 256) + qpos;
        float ckf[16], ckb[16];
#pragma unroll
        for (int r = 0; r < 16; ++r) { const float off = (float)crow(r, hi); ckf[r] = __builtin_amdgcn_exp2f(-lgf * off); ckb[r] = __builtin_amdgcn_exp2f(lgb * off); }
        const float cf32 = __builtin_amdgcn_exp2f(-lgf * 32.f), cb32 = __builtin_amdgcn_exp2f(lgb * 32.f);
        bf16_t* zq = Z + (size_t)qrow * ZW;
        bf16x8 qf[4];
#pragma unroll
        for (int st = 0; st < 4; ++st) qf[st] = *(const bf16x8*)(zq + C_RQ + h * 64 + 16 * st + 8 * hi);
        f32x16 o0, o1;
#pragma unroll
        for (int r = 0; r < 16; ++r) { o0[r] = 0.f; o1[r] = 0.f; }
        const int ctx0 = RL + b * 256, lat0 = b * 2048;
#define RET_TILE_ROW(t) (lat ? ((t) < 4 ? ctx0 + 64 * (t) : ((t) < 36 ? lat0 + 64 * ((t) - 4) : ctx0 + 64 * ((t) - 36))) : ctx0 + 64 * (t))
#define RET_TILE_POS(t) (lat ? 64 * (t) - 256 : 64 * (t))
        u32x4 ka, va, kb2, vb2;
#define RET_LOAD(k_, v_, tt) do { const bf16_t* zr_ = Z + (size_t)(RET_TILE_ROW(tt) + prow) * ZW + h * 64 + pc * 8; k_ = *(const u32x4*)(zr_ + C_RK); v_ = *(const u32x4*)(zr_ + C_RV); } while (0)
#define RET_WRITE(k_, v_, bo) do { *(LAS u32x4*)(sm + (bo) + koff) = k_; *(LAS u32x4*)(sm + (bo) + voff) = v_; } while (0)
        RET_LOAD(ka, va, 0); RET_LOAD(kb2, vb2, 1);
        __syncthreads();
        RET_WRITE(ka, va, 0); RET_WRITE(kb2, vb2, BUF_R);
        __syncthreads();
        for (int t = 0; t < ntile; t += 2) {
            const int pb = (t & 2) * BUF_R, nb = 2 * BUF_R - pb;
            if (t + 2 < ntile) { RET_LOAD(ka, va, t + 2); RET_LOAD(kb2, vb2, t + 3); }
            ret_tile(sm, r32, hi, vrd, pb, RET_TILE_POS(t), qw0, qpos, lgf, lgb, cf32, cb32, ckf, ckb, qf, o0, o1);
            ret_tile(sm, r32, hi, vrd, pb + BUF_R, RET_TILE_POS(t + 1), qw0, qpos, lgf, lgb, cf32, cb32, ckf, ckb, qf, o0, o1);
            if (t + 2 < ntile) { RET_WRITE(ka, va, nb); RET_WRITE(kb2, vb2, nb + BUF_R); }
            __syncthreads();
        }
#undef RET_LOAD
#undef RET_WRITE
#undef RET_TILE_ROW
#undef RET_TILE_POS
        float s1 = 0.f;
#pragma unroll
        for (int r = 0; r < 16; ++r) s1 += o0[r] + o1[r];
        s1 += __shfl_xor(s1, 32);
        const float mu = s1 * (1.f / 64);
        float s2 = 0.f;
#pragma unroll
        for (int r = 0; r < 16; ++r) { const float a = o0[r] - mu, c = o1[r] - mu; s2 += a * a + c * c; }
        s2 += __shfl_xor(s2, 32);
        const float rstd = rsqrtf(s2 * (1.f / 64) + EPS);
#pragma unroll
        for (int g = 0; g < 4; ++g)
#pragma unroll
            for (int blk = 0; blk < 2; ++blk) {
                const int d = blk * 32 + 8 * g + 4 * hi;
                const u32x2 gt = *(const u32x2*)(zq + C_RG + h * 64 + d);
                const f32x4 gw = *(const f32x4*)(gn_w + h * 64 + d);
                float y[4];
#pragma unroll
                for (int q = 0; q < 4; ++q) { const float ov = blk ? o1[4 * g + q] : o0[4 * g + q]; const unsigned gb = q < 2 ? gt.x : gt.y; const float gv = __uint_as_float((q & 1) ? (gb & 0xffff0000u) : (gb << 16));
                    y[q] = siluf_(gv) * ((ov - mu) * rstd * gw[q]); }
                u32x2 w; w.x = pk2(y[0], y[1]); w.y = pk2(y[2], y[3]);
                *(u32x2*)(zq + C_RQ + h * 64 + d) = w;
            }
    }
    __syncthreads();
}

struct SchedGrid {
    const char* A; const char* B; unsigned lda, ldb; int nt, nM, nN, G, c, kind, aux;
    __device__ __forceinline__ bool next(int i, pg8::Unit& u) const {
        int pm, pn; if (!pg8::static_tile(nM, nN, G, c, i, pm, pn)) return false;
        u.A = A + (size_t)pm * 256 * lda; u.B = B + (size_t)pn * 256 * ldb; u.lda = lda; u.ldb = ldb; u.nt = nt; u.pm = pm; u.pn = pn; u.kind = kind; u.aux = aux; return true; }
};
struct SchedP1 {
    const char* A; const char* B; int G, c, last;
    __device__ __forceinline__ bool next(int i, pg8::Unit& u) const {
        int pm, pn;
        if (!last) { if (!pg8::static_tile(RT / 256, 8, G, c, i, pm, pn)) return false; }
        else { if (!pg8::static_tile(RL / 256, 8, G, c, i, pm, pn)) { const int j = i * G + c - (RL / 256) * 8; if (j < 0 || j >= 32) return false; pm = RL / 256 + (j >> 2); pn = j & 3; } }
        u.A = A + (size_t)pm * 256 * 2048; u.B = B + (size_t)pn * 256 * 2048; u.lda = 2048; u.ldb = 2048; u.nt = 16; u.pm = pm; u.pn = pn; u.kind = 0; u.aux = 0; return true; }
};
struct SchedMerge {
    const char* Z; const char* XN; const char* WBR; const char* WING; const char* OC; int njobs, G, vcu, nmini;
    __device__ __forceinline__ bool next(int i, pg8::Unit& u) const {
        int sub, n, pm, pn, part = 0;
        if (nmini > 0 && i >= 8) { if (i >= 10 || vcu >= nmini) return false; sub = i & 1; n = vcu & 3; pn = (vcu >> 2) & 3; pm = RL / 256 + (vcu >> 4); part = 1; }
        else { const int job = (i >> 3) * G + vcu; if (job >= njobs) return false; sub = i & 7; n = sub >> 1; pm = job >> 2; pn = job & 3; }
        u.pm = pm; u.pn = pn; u.aux = n;
        if (!(sub & 1)) { const int bcol = n == 0 ? C_QC : (n == 1 ? C_FU : C_RQ);
            if (n == 2) { u.A = OC + (size_t)pm * 256 * 512; u.lda = 512; } else { u.A = Z + ((size_t)pm * 256 * ZW + bcol) * 2; u.lda = ZW * 2; } u.B = WBR + ((size_t)n * 1024 + pn * 256) * 512; u.ldb = 512; u.nt = 4; u.kind = 0; }
        else { u.A = XN + (size_t)pm * 256 * 2048; u.lda = 2048; u.B = WING + ((size_t)n * 1024 + pn * 256) * 2048; u.ldb = 2048; u.nt = 16; u.kind = part ? 2 : 1; }
        return true; }
};
struct SchedFfnDown {
    const char* H; const char* W2; int G, c, nctx;
    __device__ __forceinline__ bool next(int i, pg8::Unit& u) const {
        int pm, pn;
        if (pg8::static_tile(RL / 256, 4, G, c, i, pm, pn)) { u.A = H + (size_t)pm * 256 * 8192; u.B = W2 + (size_t)pn * 256 * 8192; u.lda = 8192; u.ldb = 8192; u.nt = 64; u.pm = pm; u.pn = pn; u.kind = 0; u.aux = 0; return true; }
        const int j = i * G + c - (RL / 256) * 4; if (j < 0 || j >= nctx) return false;
        pm = RL / 256 + (j >> 4); pn = (j >> 2) & 3; const int kq = j & 3;
        u.A = H + (size_t)pm * 256 * 8192 + kq * 2048; u.B = W2 + (size_t)pn * 256 * 8192 + kq * 2048; u.lda = 8192; u.ldb = 8192; u.nt = 16; u.pm = pm; u.pn = pn; u.kind = 3; u.aux = kq; return true; }
};
#define EPI_FOREACH(...) _Pragma("unroll") for (int ai = 0; ai < 2; ++ai) _Pragma("unroll") for (int m = 0; m < 4; ++m) _Pragma("unroll") for (int bj = 0; bj < 2; ++bj) { \
        const int row = u.pm * 256 + ai * 128 + wr * 64 + m * 16 + fr, col = u.pn * 256 + bj * 128 + wc * 32 + 8 * fq; const f32x4 v0 = acc[ai][bj][m][0], v1 = acc[ai][bj][m][1]; (void)row; (void)col; __VA_ARGS__ }
struct EpiStore { static constexpr bool PRE = false;
    bf16_t* O; int ld; int act;
    __device__ __forceinline__ void operator()(const f32x4 (&acc)[2][2][4][2], const pg8::Unit& u, int wr, int wc, int fr, int fq) const {
        EPI_FOREACH( f32x4 a = v0, b = v1; if (act == 1) { _Pragma("unroll") for (int q = 0; q < 4; ++q) { const float ra = fmaxf(a[q], 0.f), rb = fmaxf(b[q], 0.f); a[q] = ra * ra; b[q] = rb * rb; } }
            *(pg8::u32x4*)(O + (size_t)row * ld + col) = pack8(a, b); )
    }
};
struct EpiFfnUp {
    static constexpr bool PRE = true;
    bf16_t* O; const float* ss; const float* cf; LAS float* red;
    __device__ __forceinline__ void pre_issue(const pg8::Unit& u, int tid, f32x4& v) const {
        if (tid < 256) v = *(const f32x4*)(ss + ((size_t)u.pm * 256 + tid) * 4);
        else v[0] = cf[(size_t)(u.pm < 64 ? (u.pm >> 3) : 8) * DFF + u.pn * 256 + (tid - 256)]; }
    __device__ __forceinline__ void pre_commit(int tid, int par, const f32x4& v) const {
        red[par * 512 + tid] = tid < 256 ? rsqrtf((v[0] + v[1] + v[2] + v[3]) * (1.f / DM) + EPS) : v[0]; }
    __device__ __forceinline__ void operator()(const f32x4 (&acc)[2][2][4][2], const pg8::Unit& u, int wr, int wc, int fr, int fq, int par) const {
        const LAS float* rp = red + par * 512 + wr * 64 + fr; const LAS float* cp = rp - (wr * 64 + fr) + 256 + wc * 32 + 8 * fq;
        EPI_FOREACH( const f32x4 c0 = *(const LAS f32x4*)(cp + bj * 128), c1 = *(const LAS f32x4*)(cp + bj * 128 + 4); const float r = rp[ai * 128 + m * 16]; f32x4 a, b;
            _Pragma("unroll") for (int q = 0; q < 4; ++q) { const float ra = fmaxf(v0[q] * r + c0[q], 0.f), rb = fmaxf(v1[q] * r + c1[q], 0.f); a[q] = ra * ra; b[q] = rb * rb; }
            *(pg8::u32x4*)(O + (size_t)row * DFF + col) = pack8(a, b); )
    }
};
template <int T> __device__ __forceinline__ void ld8(const void* base, size_t o, f32x4& a, f32x4& b) {
    if constexpr (T == 0) { const float* p = (const float*)base + o; a = *(const f32x4*)p; b = *(const f32x4*)(p + 4); } else unpack8(*(const pg8::u32x4*)((const bf16_t*)base + o), a, b); }
template <int T> __device__ __forceinline__ void st8(void* base, size_t o, const f32x4 a, const f32x4 b) {
    if constexpr (T == 0) { float* p = (float*)base + o; *(f32x4*)p = a; *(f32x4*)(p + 4) = b; } else *(pg8::u32x4*)((bf16_t*)base + o) = pack8(a, b); }
template <int XIN, int XOUT>
struct EpiResid { static constexpr bool PRE = false;
    const void* xlat; const void* xctx; void* olat; void* octx; const float* mod; int gch; float* part;
    bf16_t* an; const float* wmf; float* ss; LAS float* red;
    __device__ __forceinline__ void operator()(const f32x4 (&acc)[2][2][4][2], const pg8::Unit& u, int wr, int wc, int fr, int fq) const {
        if (u.kind == 3) { float* pb = part + (size_t)u.aux * RC * DM - (size_t)RL * DM;
            EPI_FOREACH( const size_t o = (size_t)row * DM + col; *(f32x4*)(pb + o) = v0; *(f32x4*)(pb + o + 4) = v1; if (bj) asm volatile("" ::: "memory"); )
            return; }
        const bool lat = u.pm < 64; const void* xb = lat ? xlat : xctx; void* ob = lat ? olat : octx; const size_t rb = lat ? 0 : (size_t)RL * DM;
        const float* g = mod + (size_t)(lat ? (u.pm >> 3) : 8) * 6144 + gch * 1024;
        if (an == nullptr) {
        EPI_FOREACH( const f32x4 g0 = *(const f32x4*)(g + col), g1 = *(const f32x4*)(g + col + 4); const size_t o = (size_t)row * DM + col - rb;
            f32x4 x0, x1; ld8<XIN>(xb, o, x0, x1); st8<XOUT>(ob, o, x0 + g0 * v0, x1 + g1 * v1); if (bj) asm volatile("" ::: "memory"); )
        return; }
        const float* wm = wmf + (size_t)(lat ? (u.pm >> 3) : 8) * 1024;
        float sq = 0.f;
        EPI_FOREACH( const f32x4 g0 = *(const f32x4*)(g + col), g1 = *(const f32x4*)(g + col + 4); const size_t o = (size_t)row * DM + col - rb;
            f32x4 x0, x1; ld8<XIN>(xb, o, x0, x1); const f32x4 y0 = x0 + g0 * v0, y1 = x1 + g1 * v1; st8<XOUT>(ob, o, y0, y1);
            const f32x4 w0 = *(const f32x4*)(wm + col), w1 = *(const f32x4*)(wm + col + 4);
            *(pg8::u32x4*)(an + (size_t)row * DM + col) = pack8(y0 * w0, y1 * w1);
            sq += y0[0] * y0[0] + y0[1] * y0[1] + y0[2] * y0[2] + y0[3] * y0[3] + y1[0] * y1[0] + y1[1] * y1[1] + y1[2] * y1[2] + y1[3] * y1[3];
            if (bj) { sq += __shfl_xor(sq, 16); sq += __shfl_xor(sq, 32); if (fq == 0) red[wc * 256 + ai * 128 + wr * 64 + m * 16 + fr] = sq; sq = 0.f; asm volatile("" ::: "memory"); } )
        __syncthreads();
        { int t = threadIdx.x; asm volatile("" : "+v"(t)); if (t < 256) ss[((size_t)u.pm * 256 + t) * 4 + u.pn] = red[t] + red[256 + t] + red[512 + t] + red[768 + t]; }
    }
};
struct EpiMerge { static constexpr bool PRE = false;
    pg8::u32x4* stash; bf16_t* MMp; bf16_t* PMp;
    __device__ __forceinline__ void operator()(const f32x4 (&acc)[2][2][4][2], const pg8::Unit& u, int wr, int wc, int fr, int fq) const {
        int tid = threadIdx.x; asm volatile("" : "+v"(tid));
        if (u.kind == 0) { EPI_FOREACH( stash[((ai * 4 + m) * 2 + bj) * NT + tid] = pack8(v0, v1); if (bj && (m & 1)) asm volatile("" ::: "memory"); ) }
        else { EPI_FOREACH( f32x4 y0, y1; unpack8(stash[((ai * 4 + m) * 2 + bj) * NT + tid], y0, y1); f32x4 t0, t1;
                _Pragma("unroll") for (int q = 0; q < 4; ++q) { t0[q] = sigmoidf_(v0[q]) * y0[q]; t1[q] = sigmoidf_(v1[q]) * y1[q]; }
                pg8::u32x4* mp = (pg8::u32x4*)((u.kind == 2 && u.aux != 0 ? PMp + (size_t)(u.aux - 1) * RC * DM - (size_t)RL * DM : MMp) + (size_t)row * DM + col);
                if (u.kind == 1 && u.aux != 0) { f32x4 p0, p1; unpack8(*mp, p0, p1); t0 += p0; t1 += p1; }
                *mp = pack8(t0, t1); if (bj && (m & 1)) asm volatile("" ::: "memory"); ) }
    }
};
struct TItem { const float* W; bf16_t* WT; const float* kscale; int K, N, row_off, item; };
__device__ __forceinline__ void titem_load(const TItem& t, int lane, f32x4 (&v)[8]) {
    const int nblk = t.N / 32, kb = t.item / nblk, nb = t.item % nblk;
    const float* p = t.W + (size_t)(64 * kb + (lane >> 3)) * t.N + 32 * nb + 4 * (lane & 7);
#pragma unroll
    for (int i = 0; i < 8; ++i) v[i] = *(const f32x4*)(p + (size_t)(8 * i) * t.N);
}
__device__ __forceinline__ void titem_store(const TItem& t, int lane, const f32x4 (&v)[8], LAS float* scr) {
    const int nblk = t.N / 32, kb = t.item / nblk, nb = t.item % nblk, k0 = 64 * kb, n0 = 32 * nb;
#pragma unroll
    for (int i = 0; i < 8; ++i) { const int kk = 8 * i + (lane >> 3); f32x4 w = v[i]; if (t.kscale) w *= t.kscale[k0 + kk];
        LAS float* sp = scr + kk * 33 + 4 * (lane & 7); sp[0] = w[0]; sp[1] = w[1]; sp[2] = w[2]; sp[3] = w[3]; }
    asm volatile("s_waitcnt lgkmcnt(0)" ::: "memory");
    const int c = lane & 7;
#pragma unroll
    for (int j = 0; j < 4; ++j) { const int n = (lane >> 3) + 8 * j; const LAS float* sp = scr + (8 * c) * 33 + n;
        pg8::u32x4 o; o.x = pg8::cvt_pk_bf16(sp[0 * 33], sp[1 * 33]); o.y = pg8::cvt_pk_bf16(sp[2 * 33], sp[3 * 33]); o.z = pg8::cvt_pk_bf16(sp[4 * 33], sp[5 * 33]); o.w = pg8::cvt_pk_bf16(sp[6 * 33], sp[7 * 33]);
        *(pg8::u32x4*)(t.WT + (size_t)(t.row_off + n0 + n) * t.K + k0 + 8 * c) = o; }
    asm volatile("s_waitcnt lgkmcnt(0)" ::: "memory");
}
__device__ __forceinline__ void ph_convert_weights(unsigned char* lds, int l, const float* w_in, const float* w1, const float* w2, const float* w_out, const float* w_br, const float* w_glu,
                                                   const float* w_uq, const float* q_norm, const float* w_ukv, const float* kv_norm, unsigned char* ws) { PH_IDS;
    const int wave = __builtin_amdgcn_readfirstlane(tid_ >> 6), lane = tid_ & 63;
    LAS float* scr = (LAS float*)((LAS unsigned char*)lds + wave * 16384);
    const int gw = bid_ * 8 + wave, NGW = G_ * 8;
    constexpr int I_IN = 16 * 189, I_1 = 16 * 128, I_2 = 64 * 32, I_O = 16 * 32, I_B = 4 * 32;
    constexpr int I_G = 4 * 16;
    constexpr int I_UQ = 4 * 12, I_UKV = 2 * 16;
    constexpr int NITEMS = I_IN + I_1 + I_2 + I_O + 4 * I_B + I_G + I_UQ + I_UKV;
    bf16_t* WIN_T = (bf16_t*)(ws + WS_WIN); bf16_t* W1_T = (bf16_t*)(ws + WS_W1); bf16_t* W2_T = (bf16_t*)(ws + WS_W2); bf16_t* WOUT_T = (bf16_t*)(ws + WS_WOUT); bf16_t* WBR_T = (bf16_t*)(ws + WS_WBR);
    auto decode = [&](int it) -> TItem {
        TItem t; t.kscale = nullptr; t.row_off = 0; int r = it;
        if (r < I_IN) { t.W = w_in + (size_t)l * DM * INC; t.K = DM; t.N = INC; t.WT = WIN_T; t.row_off = (r % 189) >= 61 ? 96 : 0; t.item = r; return t; } r -= I_IN;
        if (r < I_1) { t.W = w1 + (size_t)l * DM * DFF; t.K = DM; t.N = DFF; t.WT = W1_T; t.item = r; return t; } r -= I_1;
        if (r < I_2) { t.W = w2 + (size_t)l * DFF * DM; t.K = DFF; t.N = DM; t.WT = W2_T; t.item = r; return t; } r -= I_2;
        if (r < I_O) { t.W = w_out + (size_t)l * DM * DM; t.K = DM; t.N = DM; t.WT = WOUT_T; t.item = r; return t; } r -= I_O;
        if (r < 4 * I_B) { const int n = r / I_B; t.W = w_br + ((size_t)l * 4 + n) * 256 * DM; t.K = 256; t.N = DM; t.WT = WBR_T + (size_t)n * 1024 * 256; t.item = r % I_B; return t; } r -= 4 * I_B;
        if (r < I_G) { const int n0 = (r % 16) * 32;
            t.W = w_glu + (size_t)l * 256 * 512; t.K = 256; t.N = 512; t.WT = (bf16_t*)(ws + WS_WGLU); t.row_off = n0 < 128 ? 0 : (n0 < 256 ? 128 : (n0 < 384 ? -128 : 0)); t.item = r; return t; } r -= I_G;
        if (r < I_UQ) { t.W = w_uq + (size_t)l * 256 * 384; t.K = 256; t.N = 384; t.WT = (bf16_t*)(ws + WS_WUQ); t.kscale = q_norm + l * 256; t.item = r; return t; } r -= I_UQ;
        t.W = w_ukv + (size_t)l * 128 * 512; t.K = 128; t.N = 512; t.WT = (bf16_t*)(ws + WS_WUKV); t.kscale = kv_norm + l * 128; t.item = r; return t;
    };
    if (gw < NITEMS) {
        TItem cur = decode(gw); f32x4 v[8]; titem_load(cur, lane, v);
        for (int it = gw; it < NITEMS; it += NGW) {
            const bool more = it + NGW < NITEMS;
            TItem nxt = cur; f32x4 vn[8];
            if (more) { nxt = decode(it + NGW); titem_load(nxt, lane, vn); }
            titem_store(cur, lane, v, scr);
            if (more) { cur = nxt;
#pragma unroll
                for (int i = 0; i < 8; ++i) v[i] = vn[i]; }
        }
    }
    GSTRIDE(gi, 96 * 1024 / 8) { *(pg8::u32x4*)(WIN_T + (size_t)1952 * 1024 + (size_t)gi * 8) = (pg8::u32x4){0u, 0u, 0u, 0u}; }
    __syncthreads();
}

struct EpiFourier { static constexpr bool PRE = false;
    bf16_t* Zp; int rowbase, L; float scale;
    __device__ __forceinline__ void operator()(const f32x4 (&acc)[2][2][4][2], const pg8::Unit& u, int wr, int wc, int fr, int fq) const {
        EPI_FOREACH( *(pg8::u32x4*)(Zp + ((size_t)rowbase + (size_t)u.pn * L + row) * ZW + C_FU + (col - u.pn * 256)) = pack8(v0 * scale, v1 * scale); )
    }
};
__device__ __forceinline__ void ph_f2a(unsigned char* lds_, const bf16_t* F1, const float* trig, bf16_t* BP) { PH_IDS;
    const int lane = tid_ & 63, wid = __builtin_amdgcn_readfirstlane(tid_ >> 6), c16 = lane & 15, kq = lane >> 4;
    LAS char* wi = (LAS char*)lds_ + wid * 16384;
    LAS char* wo = wi + 8192;
    bf16x8 are, aim;
#pragma unroll
    for (int j = 0; j < 8; ++j) { const int t2 = 8 * (kq & 1) + j, idx = ((c16 * t2) & 15) * 128; const float cs = trig[idx], sn = trig[2048 + idx];
        are[j] = (short)f2bf((kq >> 1) ? -sn : cs); aim[j] = (short)f2bf((kq >> 1) ? cs : sn); }
    for (int col = bid_ * 8 + wid; col < NB * 256; col += G_ * 8) {
        const pg8::u32x4* src = (const pg8::u32x4*)(F1 + (size_t)col * 4096);
        pg8::u32x4 st[8];
#pragma unroll
        for (int i = 0; i < 8; ++i) st[i] = src[lane + 64 * i];
#pragma unroll
        for (int i = 0; i < 8; ++i) *(LAS pg8::u32x4*)(wi + (lane + 64 * i) * 16) = st[i];
        asm volatile("s_waitcnt lgkmcnt(0)" ::: "memory");
#pragma unroll 2
        for (int nb = 0; nb < 8; ++nb) {
            const int t1 = 16 * nb + c16;
            bf16x8 bf;
#pragma unroll
            for (int j = 0; j < 8; ++j) bf[j] = *(const LAS short*)(wi + ((kq >> 1) * 2048 + t1 + 128 * (8 * (kq & 1) + j)) * 2);
            const f32x4 z4 = (f32x4){0.f, 0.f, 0.f, 0.f};
            const f32x4 re = __builtin_amdgcn_mfma_f32_16x16x32_bf16(are, bf, z4, 0, 0, 0), im = __builtin_amdgcn_mfma_f32_16x16x32_bf16(aim, bf, z4, 0, 0, 0);
#pragma unroll
            for (int r = 0; r < 4; ++r) { const int k2 = 4 * kq + r, idx = k2 * t1; const float cs = trig[idx], sn = trig[2048 + idx];
                *(LAS bf16_t*)(wo + ((k2 * 2 + 0) * 128 + t1) * 2) = f2bf(re[r] * cs - im[r] * sn);
                *(LAS bf16_t*)(wo + ((k2 * 2 + 1) * 128 + t1) * 2) = f2bf(re[r] * sn + im[r] * cs); }
        }
        asm volatile("s_waitcnt lgkmcnt(0)" ::: "memory");
        pg8::u32x4* dst = (pg8::u32x4*)(BP + (size_t)col * 4096);
#pragma unroll
        for (int i = 0; i < 8; ++i) dst[lane + 64 * i] = *(const LAS pg8::u32x4*)(wo + (lane + 64 * i) * 16);
        asm volatile("s_waitcnt lgkmcnt(0)" ::: "memory");
    }
    __syncthreads();
}
struct SchedFourier2 { static constexpr bool DEP = false;
    const char* AT; const char* BP; int c;
    __device__ __forceinline__ bool next(int i, pg8::Unit& u) const {
        if (i != 0) return false;
        const int j = c & 7, b = c >> 3;
        u.A = AT; u.lda = 1024; u.B = BP + ((size_t)b * 256 * 4096 + (size_t)j * 512) * 2; u.ldb = 8192; u.nt = 8; u.pm = j; u.pn = b; u.kind = 0; u.aux = 0; return true; }
};
struct EpiFourier2 { static constexpr bool PRE = false;
    bf16_t* Zp; float scale;
    __device__ __forceinline__ void operator()(const f32x4 (&acc)[2][2][4][2], const pg8::Unit& u, int wr, int wc, int fr, int fq) const {
#pragma unroll
        for (int ai = 0; ai < 2; ++ai)
#pragma unroll
            for (int m = 0; m < 4; ++m)
#pragma unroll
                for (int bj = 0; bj < 2; ++bj) {
                    const int k1 = wr * 64 + m * 16 + fr, k = 16 * k1 + 2 * u.pm + ai, gm = bj * 128 + wc * 32 + 8 * fq;
                    *(pg8::u32x4*)(Zp + ((size_t)u.pn * 2048 + k) * ZW + C_FU + gm) = pack8(acc[ai][bj][m][0] * scale, acc[ai][bj][m][1] * scale);
                }
    }
};
struct EpiGlu { static constexpr bool PRE = false;
    bf16_t* OCp;
    __device__ __forceinline__ void operator()(const f32x4 (&acc)[2][2][4][2], const pg8::Unit& u, int wr, int wc, int fr, int fq) const {
#pragma unroll
        for (int ai = 0; ai < 2; ++ai)
#pragma unroll
            for (int m = 0; m < 4; ++m) {
                const int row = u.pm * 256 + ai * 128 + wr * 64 + m * 16 + fr, col = u.pn * 128 + wc * 32 + 8 * fq;
                f32x4 a, b;
#pragma unroll
                for (int q = 0; q < 4; ++q) { a[q] = acc[ai][0][m][0][q] * sigmoidf_(acc[ai][1][m][0][q]); b[q] = acc[ai][0][m][1][q] * sigmoidf_(acc[ai][1][m][1][q]); }
                *(pg8::u32x4*)(OCp + (size_t)row * 256 + col) = pack8(a, b);
            }
    }
};
__device__ __forceinline__ void ph_dft_gen(const float* trig, bf16_t* AT, bf16_t* DC) { PH_IDS;
    GSTRIDE(gi, 256 * 512) {
        const int r = gi >> 9, c = gi & 511, h = r >> 7, k1 = r & 127, hh = c >> 8, part = (c >> 7) & 1, t1 = c & 127, idx = ((k1 * t1) & 127) * 16;
        AT[gi] = f2bf(h != hh ? 0.f : (part ? -trig[2048 + idx] : trig[idx]));
    }
    GSTRIDE(gi, 256 * 512 / 8) {
        const int k = gi >> 6, kk0 = (gi & 63) * 8; pg8::u32x4 w; unsigned pr[4];
#pragma unroll
        for (int q = 0; q < 4; ++q) { float v[2];
#pragma unroll
            for (int e = 0; e < 2; ++e) { const int kk = kk0 + 2 * q + e, part = kk >> 8, t = kk & 255, idx = ((k * t) & 255) * 8; v[e] = part ? -trig[2048 + idx] : trig[idx]; }
            pr[q] = pg8::cvt_pk_bf16(v[0], v[1]); }
        w.x = pr[0]; w.y = pr[1]; w.z = pr[2]; w.w = pr[3];
        *(pg8::u32x4*)(DC + (size_t)k * 512 + kk0) = w;
    }
}

__device__ __forceinline__ void ph_sum_mm(bf16_t* MMp, const bf16_t* PMp) { PH_IDS;
    GSTRIDE(gi, RC * DM / 8) {
        pg8::u32x4* mp = (pg8::u32x4*)(MMp + (size_t)RL * DM) + gi;
        f32x4 a, b; unpack8(*mp, a, b);
#pragma unroll
        for (int n = 0; n < 3; ++n) { f32x4 c, d; unpack8(*((const pg8::u32x4*)(PMp + (size_t)n * RC * DM) + gi), c, d); a += c; b += d; }
        *mp = pack8(a, b);
    }
}
__device__ __forceinline__ void ph_sum_ffn(bf16_t* XC, const float* PD, const float* mod) { PH_IDS;
    GSTRIDE(gi, RC * DM / 8) {
        const int col = (gi * 8) & (DM - 1);
        f32x4 a0 = *((const f32x4*)PD + 2 * gi), a1 = *((const f32x4*)PD + 2 * gi + 1);
#pragma unroll
        for (int n = 1; n < 4; ++n) { a0 += *((const f32x4*)(PD + (size_t)n * RC * DM) + 2 * gi); a1 += *((const f32x4*)(PD + (size_t)n * RC * DM) + 2 * gi + 1); }
        const f32x4 g0 = *(const f32x4*)(mod + (size_t)8 * 6144 + 5 * 1024 + col), g1 = *(const f32x4*)(mod + (size_t)8 * 6144 + 5 * 1024 + col + 4);
        f32x4 x0, x1; ld8<1>(XC, (size_t)gi * 8, x0, x1); st8<1>(XC, (size_t)gi * 8, x0 + g0 * a0, x1 + g1 * a1);
    }
}

constexpr size_t WS_BAR = 768 * 1024;
constexpr int LDS_BYTES = 147456;
struct Args { const float* in[30]; float* out; unsigned char* ws; };
typedef const __attribute__((address_space(4))) Args* CArgs;
__device__ __forceinline__ CArgs kargs() { CArgs p = (CArgs)__builtin_amdgcn_kernarg_segment_ptr(); asm volatile("" : "+s"(p)); return p; }
#define IN(i) (kargs()->in[i])
#define WSB(T, off) ((T*)(kargs()->ws + (off)))
#define OSB(T, off) ((T*)((unsigned char*)kargs()->out + (off)))
#define OUTP (kargs()->out)
enum { I_X = 0, I_C, I_CTX, I_CCTX, I_ADAW, I_ADAB, I_NMIX, I_NFFN, I_WIN, I_QNORM, I_WUQ, I_KVNORM, I_WUKV, I_QKQ, I_QKK, I_LRE, I_LIM, I_LSTEP, I_BRE, I_BIM, I_CRE, I_CIM, I_S5D, I_WGLU, I_RDEC, I_RGN, I_WBR, I_WOUT, I_W1, I_W2 };
#define GRID_BAR() do { bar.bar = WSB(unsigned, WS_BAR); { unsigned x_ = bar.x; asm volatile("" : "+s"(x_)); bar.x = x_; } xcd_barrier(bar); } while (0)
template <int L> __device__ __forceinline__ void layer_body(unsigned char* lds, XcdBarrier& bar) {
    constexpr int l = L;
    constexpr bool LASTL = (L == DEPTH - 1);
    constexpr int NMT = LASTL ? RL / 256 : RT / 256;
    constexpr int WCTX = LASTL ? 0 : 1;

#define MODL (WSB(float, WS_MOD) + (size_t)l * 9 * 6144)
#define XLAT (l == 0 ? (const void*)IN(I_X) : (const void*)WSB(bf16_t, WS_R))
#define XCTX (l == 0 ? (const void*)IN(I_CTX) : (const void*)WSB(bf16_t, WS_XCB))
    constexpr int XIN = (L == 0) ? 0 : 1;
#define WINL (IN(I_WIN) + (size_t)l * DM * INC)
#define ZP WSB(bf16_t, WS_Z)
#define XNP WSB(bf16_t, WS_XN)
#define QP WSB(bf16_t, WS_QKV)
#define KP (WSB(bf16_t, WS_QKV) + (size_t)32 * 2304 * 96)
#define VP (WSB(bf16_t, WS_QKV) + (size_t)2 * 32 * 2304 * 96)
#define F1LAT WSB(bf16_t, WS_F1)
#define F1CTX (WSB(bf16_t, WS_F1) + (size_t)8 * 256 * 2 * 2048)
#define QRAWP WSB(bf16_t, WS_RAW)
#define KVRAWP (WSB(bf16_t, WS_RAW) + (size_t)RT * 384)
        ph_s5_lp(l, IN(I_LRE), IN(I_LIM), IN(I_LSTEP), IN(I_BRE), IN(I_BIM), WSB(float2, WS_LP), WSB(float2, WS_BB), WSB(float, WS_LAMT));
        ph_adarms<XIN>(XLAT, XCTX, IN(I_NMIX) + l * DM, MODL, 0, 1, XNP, RT);
        ph_convert_weights(lds, l, IN(I_WIN), IN(I_W1), IN(I_W2), IN(I_WOUT), IN(I_WBR), IN(I_WGLU), IN(I_WUQ), IN(I_QNORM), IN(I_WUKV), IN(I_KVNORM), kargs()->ws);
        if (l == 0) ph_dft_gen(WSB(float, WS_TRIG), OSB(bf16_t, OS_AT), OSB(bf16_t, OS_DFTC));
        ph_wmf(IN(I_NFFN) + l * DM, MODL, WSB(float, WS_WMF));
        GRID_BAR();
        { SchedP1 S; S.A = (const char*)XNP; S.B = (const char*)WSB(bf16_t, WS_WIN); S.G = l_grid(); S.c = l_bid(); S.last = LASTL ? 1 : 0;
          EpiStore E; E.O = ZP; E.ld = ZW; E.act = 0; pg8::gemm_phase((LAS unsigned char*)lds, S, E); }
        { const int G = l_grid(), bx = l_bid(), n3 = G == 256 ? (LASTL ? 32 : 64) : 0;
          if (bx >= n3) { const int vb = bx - n3, vg = G - n3;
            ph_s5_tz(lds, l, WSB(float2, WS_LP), WSB(float2, WS_BB), IN(I_CRE), IN(I_CIM), WSB(float, WS_TZ), vb, vg);
            ph_s5_ms(WSB(float2, WS_LP), WSB(float2, WS_BB), WSB(bf16_t, WS_MS), vb, vg);
            ph_cf_mfma(lds, WSB(bf16_t, WS_W1), MODL, WSB(float, WS_CF), vb, vg); } }
        GRID_BAR();
        ph_s5_tzb(l, WSB(float, WS_TZ), IN(I_S5D) + l * 256, OSB(bf16_t, OS_TZB), IN(I_CRE), IN(I_CIM), OSB(bf16_t, OS_CQ));
        ph_prep(ZP, WSB(bf16_t, WS_WUQ), WSB(bf16_t, WS_WUKV), WSB(bf16_t, WS_D64), IN(I_QKQ) + l * 96, IN(I_QKK) + l * 96, QP, KP, VP, F1LAT, F1CTX, lds);
        ph_s5_sloc(lds, ZP, WSB(bf16_t, WS_MS), OSB(float, OS_SLOC));
        GRID_BAR();
        unsigned* kvc_ = WSB(unsigned, WS_BAR) + XCD_BAR_WORDS + 128 + 1024 * l;
        unsigned* f2c_ = kvc_ + 640;
        ph_f2a(lds, F1LAT, WSB(float, WS_TRIG), OSB(bf16_t, OS_BP));
        dep_signal_x(f2c_, f2c_ + 32 + 16 * bar.x, bar.st[0]);
        { const int G = l_grid(), bx = l_bid(), nf = G == 256 ? (LASTL ? 64 : 72) : 0;
          ph_ret_kv(lds, ZP, IN(I_RDEC) + l * 8, WSB(bf16_t, WS_KVF), OSB(bf16_t, OS_KVB), bx - nf, G - nf);
          dep_signal_x(kvc_, kvc_ + 32 + 16 * bar.x, bar.st[0]); }
        {
            const int bx = l_bid();
            if (bx < 64) { if (l_tid() == 0) dep_spin(f2c_, (unsigned)l_grid(), WSB(unsigned, WS_BAR)); __syncthreads();
                SchedFourier2 S; S.AT = (const char*)OSB(bf16_t, OS_AT); S.BP = (const char*)OSB(bf16_t, OS_BP); S.c = bx;
                EpiFourier2 E; E.Zp = ZP; E.scale = 0.0027621358640099515f; pg8::gemm_phase((LAS unsigned char*)lds, S, E); }
            else if (!LASTL && bx < 72) { SchedGrid S; S.A = (const char*)OSB(bf16_t, OS_DFTC); S.B = (const char*)F1CTX; S.lda = 1024; S.ldb = 1024; S.nt = 8; S.nM = 1; S.nN = 8; S.G = 8; S.c = bx - 64; S.kind = 0; S.aux = 0;
                EpiFourier E; E.Zp = ZP; E.rowbase = RL; E.L = 256; E.scale = 0.0078125f; pg8::gemm_phase((LAS unsigned char*)lds, S, E); }
            constexpr int NS5 = 16 * (LASTL ? 16 : 18);
            constexpr int NC = LASTL ? 0 : 32;
            constexpr int Q_ATT = 0, Q_ATTC = 256, Q_S5 = Q_ATTC + NC, Q_RET = Q_S5 + NS5, Q_RETC = Q_RET + 256, Q_END = Q_RETC + NC;
            volatile LAS int* qslot = (volatile LAS int*)((LAS unsigned char*)lds + LDS_BYTES - 32);
            unsigned* s5c_ = kvc_ + 320; bool s5sig_ = false;
            for (;;) {
                __syncthreads();
                if (l_tid() == 0) qslot[0] = (int)atomicAdd(WSB(unsigned, WS_BAR) + XCD_BAR_WORDS + 64 * l, 1u);
                __syncthreads();
                const int q = __builtin_amdgcn_readfirstlane(qslot[0]);
                if (!s5sig_ && q >= Q_RET) { dep_signal_x(s5c_, s5c_ + 32 + 16 * bar.x, bar.st[0]); s5sig_ = true; }
                if (q >= Q_END) break;
                if (q < Q_ATTC) ph_attn_mfma(lds, QP, KP, VP, ZP, WCTX, q - Q_ATT, 1 << 20);
                else if (q < Q_S5) ph_attn_mfma(lds, QP, KP, VP, ZP, WCTX, 256 + q - Q_ATTC, 1 << 20);
                else if (q < Q_RET) ph_s5_out(lds, ZP, OSB(bf16_t, OS_TZB), OSB(bf16_t, OS_CQ), WSB(float2, WS_LP), OSB(float, OS_SLOC), WSB(float, WS_LAMT), ZP, LASTL ? 16 : 18, q - Q_S5, 1 << 20);
                else if (q < Q_RETC) ph_ret_chunk(lds, ZP, WSB(bf16_t, WS_KVF), OSB(bf16_t, OS_KVB), IN(I_RDEC) + l * 8, IN(I_RGN) + l * 256, WCTX, q - Q_RET, 1 << 20, kvc_, WSB(unsigned, WS_BAR));
                else ph_ret_chunk(lds, ZP, WSB(bf16_t, WS_KVF), OSB(bf16_t, OS_KVB), IN(I_RDEC) + l * 8, IN(I_RGN) + l * 256, WCTX, 256 + q - Q_RETC, 1 << 20, kvc_, WSB(unsigned, WS_BAR));
            }
        }
        if (l_tid() == 0) dep_spin(kvc_ + 320, (unsigned)l_grid(), WSB(unsigned, WS_BAR));
        __syncthreads();
        { SchedGrid S; S.A = (const char*)(ZP + C_S5); S.B = (const char*)WSB(bf16_t, WS_WGLU); S.lda = ZW * 2; S.ldb = 512; S.nt = 4; S.nM = NMT; S.nN = 2; S.G = l_grid(); S.c = l_bid(); S.kind = 0; S.aux = 0;
          EpiGlu E; E.OCp = OSB(bf16_t, OS_OC); pg8::gemm_phase((LAS unsigned char*)lds, S, E); }
        GRID_BAR();
        { SchedMerge S; S.Z = (const char*)ZP; S.XN = (const char*)XNP; S.WBR = (const char*)WSB(bf16_t, WS_WBR); S.WING = (const char*)(WSB(bf16_t, WS_WIN) + (size_t)2048 * 1024); S.OC = (const char*)OSB(bf16_t, OS_OC);
          S.G = l_grid(); { const int bx = l_bid(); S.vcu = (bx % 8) * (S.G / 8) + bx / 8; }
          const bool mini = !LASTL && S.G == 256;
          S.njobs = mini ? RL / 256 * 4 : NMT * 4; S.nmini = mini ? 128 : 0;
          EpiMerge E; E.stash = WSB(pg8::u32x4, WS_STASH) + (size_t)l_bid() * 8192; E.MMp = WSB(bf16_t, WS_MM); E.PMp = OSB(bf16_t, OS_PM); pg8::gemm_phase((LAS unsigned char*)lds, S, E); }
        GRID_BAR();
        if (!LASTL && l_grid() == 256) { ph_sum_mm(WSB(bf16_t, WS_MM), OSB(bf16_t, OS_PM)); GRID_BAR(); }
        { SchedGrid S; S.A = (const char*)WSB(bf16_t, WS_MM); S.B = (const char*)WSB(bf16_t, WS_WOUT); S.lda = 2048; S.ldb = 2048; S.nt = 16; S.nM = NMT; S.nN = 4; S.G = l_grid(); S.c = l_bid(); S.kind = 0; S.aux = 0;
          EpiResid<XIN, 1> E; E.xlat = XLAT; E.xctx = XCTX; E.olat = WSB(bf16_t, WS_R); E.octx = WSB(bf16_t, WS_XCB); E.mod = MODL; E.gch = 2; E.part = nullptr; E.an = XNP; E.wmf = WSB(float, WS_WMF); E.ss = OSB(float, OS_SS); E.red = (LAS float*)((LAS unsigned char*)lds + 131072); pg8::gemm_phase((LAS unsigned char*)lds, S, E); }
        GRID_BAR();
        { SchedGrid S; S.A = (const char*)XNP; S.B = (const char*)WSB(bf16_t, WS_W1); S.lda = 2048; S.ldb = 2048; S.nt = 16; S.nM = NMT; S.nN = 16; S.G = l_grid(); S.c = l_bid(); S.kind = 0; S.aux = 0;
          EpiFfnUp E; E.O = WSB(bf16_t, WS_H); E.ss = OSB(float, OS_SS); E.cf = WSB(float, WS_CF); E.red = (LAS float*)((LAS unsigned char*)lds + 131072); pg8::gemm_phase((LAS unsigned char*)lds, S, E); }
        GRID_BAR();
        { SchedFfnDown S; S.H = (const char*)WSB(bf16_t, WS_H); S.W2 = (const char*)WSB(bf16_t, WS_W2); S.G = l_grid(); S.c = l_bid(); S.nctx = (!LASTL && S.G == 256) ? 128 : 0;
          EpiResid<1, LASTL ? 0 : 1> E; E.xlat = WSB(bf16_t, WS_R); E.xctx = WSB(bf16_t, WS_XCB); E.olat = LASTL ? (void*)OUTP : (void*)WSB(bf16_t, WS_R); E.octx = WSB(bf16_t, WS_XCB); E.mod = MODL; E.gch = 5; E.part = WSB(float, WS_PD); E.an = nullptr; E.wmf = nullptr; E.ss = nullptr; E.red = nullptr;
          if (!LASTL && S.G != 256) { SchedGrid S2; S2.A = S.H; S2.B = S.W2; S2.lda = 8192; S2.ldb = 8192; S2.nt = 64; S2.nM = NMT; S2.nN = 4; S2.G = S.G; S2.c = S.c; S2.kind = 0; S2.aux = 0; pg8::gemm_phase((LAS unsigned char*)lds, S2, E); }
          else pg8::gemm_phase((LAS unsigned char*)lds, S, E); }
        if (!LASTL && l_grid() == 256) { GRID_BAR(); ph_sum_ffn(WSB(bf16_t, WS_XCB), WSB(float, WS_PD), MODL); }
        if (l + 1 < DEPTH) GRID_BAR();
}
__global__ void __launch_bounds__(NT, 2) mega(Args a_unused) {
    extern __shared__ __attribute__((aligned(16))) unsigned char lds[];
    volatile LAS unsigned* bst = (volatile LAS unsigned*)((LAS unsigned char*)lds + LDS_BYTES - 16);
    if (threadIdx.x < 4) bst[threadIdx.x] = 0u;
    __syncthreads();
    XcdBarrier bar = xcd_barrier_post(WSB(unsigned, WS_BAR), bst);

    ph_mod(lds, IN(I_C), IN(I_CCTX), IN(I_ADAW), IN(I_ADAB), WSB(float, WS_MOD));
    ph_trig(WSB(float, WS_TRIG), WSB(bf16_t, WS_D64));
    GRID_BAR();
    layer_body<0>(lds, bar);
    layer_body<1>(lds, bar);
}

extern "C" void kernel_launch(void* const* d_in, const int* in_sizes, int n_in, void* d_out, int out_size, void* d_ws, size_t ws_size, hipStream_t stream) {
    static int grid = 0;
    if (grid == 0) {
        if (n_in != 30 || ws_size < WS_END) { fprintf(stderr, "kernel_launch: unexpected n_in %d / ws_size %zu\n", n_in, ws_size); grid = -1; return; }
        int dev = 0, cus = 0, per_cu = 0;
        if (hipGetDevice(&dev) != hipSuccess || hipDeviceGetAttribute(&cus, hipDeviceAttributeMultiprocessorCount, dev) != hipSuccess) { grid = -1; return; }
        if (hipFuncSetAttribute((const void*)mega, hipFuncAttributeMaxDynamicSharedMemorySize, LDS_BYTES) != hipSuccess) { fprintf(stderr, "kernel_launch: hipFuncSetAttribute failed\n"); grid = -1; return; }
        if (hipOccupancyMaxActiveBlocksPerMultiprocessor(&per_cu, (const void*)mega, NT, LDS_BYTES) != hipSuccess || per_cu < 1) fprintf(stderr, "kernel_launch: occupancy query says %d\n", per_cu);
        (void)hipGetLastError();
        grid = cus;
    }
    if (grid < 0) return;
    (void)hipMemsetAsync((char*)d_ws + WS_BAR, 0, (XCD_BAR_WORDS + 128 + 2048) * 4, stream);
    Args a; memset((void*)&a, 0, sizeof(a));
    for (int i = 0; i < 30; ++i) a.in[i] = (const float*)d_in[i];
    a.out = (float*)d_out; a.ws = (unsigned char*)d_ws;
    hipLaunchKernelGGL(mega, dim3(grid), dim3(NT), LDS_BYTES, stream, a);
}
```

```cpp
#include <hip/hip_runtime.h>
#include <cstdint>
#include <cstring>
#include <cstdio>

typedef unsigned short bf16_t;
typedef short bf16x8 __attribute__((ext_vector_type(8)));
typedef float f32x4 __attribute__((ext_vector_type(4)));

constexpr int DM = 1024, NB = 8, SEQ = 2048, CTX = 256, DEPTH = 2;
constexpr int RL = NB * SEQ;
constexpr int RC = NB * CTX;
constexpr int RT = RL + RC;
constexpr int INC = 6048;
constexpr int ZW = 2048;
constexpr int C_KVC = 0, C_KR = 128, C_S5 = 160, C_RK = 416, C_RV = 672, C_QC = 928, C_FU = 1184, C_RQ = 1440, C_RG = 1696, C_GATE = 1952;
constexpr int C_OC = C_RK;
constexpr int DFF = 4096;
constexpr int TCH = 64;
constexpr int NCH = RT / TCH;
constexpr float EPS = 1e-6f;
#define PI_D 3.14159265358979323846

__device__ __forceinline__ float bf2f(bf16_t v) { return __uint_as_float(((unsigned)v) << 16); }
__device__ __forceinline__ bf16_t f2bf(float f) { unsigned u = __float_as_uint(f); return (bf16_t)((u + 0x7fffu + ((u >> 16) & 1u)) >> 16); }
__device__ __forceinline__ float sigmoidf_(float x) { return 1.f / (1.f + __expf(-x)); }
__device__ __forceinline__ float siluf_(float x) { return x * sigmoidf_(x); }
__device__ __forceinline__ float geluf_(float x) { return 0.5f * x * (1.f + tanhf(0.7978845608028654f * (x + 0.044715f * x * x * x))); }
__device__ __forceinline__ int row_batch(int row) { return row < RL ? (row >> 11) : ((row - RL) >> 8); }
__device__ __forceinline__ int row_modidx(int row) { return row < RL ? (row >> 11) : 8; }

constexpr size_t MiB = 1ull << 20;
constexpr size_t WS_MOD = 0;
constexpr size_t WS_RS = 512 * 1024;
constexpr size_t WS_TRIG = 512 * 1024;
constexpr size_t WS_LAMT = WS_TRIG + 32 * 1024;
constexpr size_t WS_LP = 1 * MiB;
constexpr size_t WS_BB = 2 * MiB + 128 * 1024;
constexpr size_t WS_W = 8 * MiB;
constexpr size_t WS_WIN = WS_W, WS_W1 = WS_W + 12 * MiB, WS_W2 = WS_W + 20 * MiB, WS_WOUT = WS_W + 28 * MiB, WS_WBR = WS_W + 30 * MiB;
constexpr size_t WS_XN = 40 * MiB;
constexpr size_t WS_RAW = WS_XN;
constexpr size_t WS_YG = WS_XN;
constexpr size_t WS_Z = 76 * MiB;
constexpr size_t WS_QKV = 148 * MiB;
constexpr size_t WS_F1 = 184 * MiB;
constexpr size_t WS_GL = WS_F1;
constexpr size_t WS_TZ = 202 * MiB;
constexpr size_t WS_MS = 204 * MiB;
constexpr size_t WS_QO = 212 * MiB;
constexpr size_t WS_MM = WS_QKV;
constexpr size_t WS_STASH = WS_F1;
constexpr size_t WS_KVF = 3 * MiB + 512 * 1024;
constexpr size_t WS_PD = WS_XN;
constexpr size_t WS_H = WS_Z;
constexpr size_t WS_WUQ = 2 * MiB + 768 * 1024;
constexpr size_t WS_WUKV = 3 * MiB;
constexpr size_t WS_D64 = 512 * 1024 + 64 * 1024;
constexpr size_t WS_WGLU = 2 * MiB + 512 * 1024;
constexpr size_t WS_CF = 3 * MiB + 128 * 1024;
constexpr size_t WS_WMF = 3 * MiB + 320 * 1024;
constexpr size_t WS_R = 220 * MiB;
constexpr size_t WS_XCB = 252 * MiB;
constexpr size_t OS_AT = 0;
constexpr size_t OS_BP = 1 * MiB;
constexpr size_t OS_DFTC = 53 * MiB;
constexpr size_t OS_SLOC = 17 * MiB;
constexpr size_t OS_KVB = 22 * MiB;
constexpr size_t OS_PM = 27 * MiB;
constexpr size_t OS_TZB = 41 * MiB;
constexpr size_t OS_CQ = 42 * MiB;
constexpr size_t OS_OC = 43 * MiB;
constexpr size_t OS_SS = 40 * MiB;
constexpr size_t WS_END = 256 * MiB;


#define LAS __attribute__((address_space(3)))
#define NT 512
__device__ __forceinline__ int l_tid() { int t = threadIdx.x; asm volatile("" : "+v"(t)); return t; }
__device__ __forceinline__ int l_bid() { int b = blockIdx.x; asm volatile("" : "+s"(b)); return b; }
__device__ __forceinline__ int l_grid() { int g = gridDim.x; asm volatile("" : "+s"(g)); return g; }
#define PH_IDS const int tid_ = l_tid(), bid_ = l_bid(), G_ = l_grid(); (void)tid_; (void)bid_; (void)G_
template <class AF, class BF, class EF>
__device__ __forceinline__ void gemm_tile(const AF& A, const BF& B, const EF& E, bool valid, int b, int m0, int n0, int M, int N, int K, bf16_t (*sA)[40], bf16_t (*sB)[40], int ht) {
    f32x4 accm[2][2];
#pragma unroll
    for (int i = 0; i < 2; ++i)
#pragma unroll
        for (int j = 0; j < 2; ++j) accm[i][j] = (f32x4){0.f, 0.f, 0.f, 0.f};
    const int w = ht >> 6, lane = ht & 63, wm = (w >> 1) * 32, wn = (w & 1) * 32, fr = lane & 15, fq = lane >> 4;
    for (int k0 = 0; k0 < K; k0 += 32) {
        __syncthreads();
#pragma unroll
        for (int i = 0; i < 8; ++i) {
            const int e = ht + i * 256;
            { const int m = e >> 5, k = e & 31; float v = 0.f; if (valid && m0 + m < M && k0 + k < K) v = A(b, m0 + m, k0 + k); sA[m][k] = f2bf(v); }
            { const int k = e >> 6, n = e & 63; float v = 0.f; if (valid && n0 + n < N && k0 + k < K) v = B(b, k0 + k, n0 + n); sB[n][k] = f2bf(v); }
        }
        __syncthreads();
        bf16x8 af[2], bfr[2];
#pragma unroll
        for (int i = 0; i < 2; ++i) { af[i] = *(const bf16x8*)&sA[wm + i * 16 + fr][fq * 8]; bfr[i] = *(const bf16x8*)&sB[wn + i * 16 + fr][fq * 8]; }
#pragma unroll
        for (int i = 0; i < 2; ++i)
#pragma unroll
            for (int j = 0; j < 2; ++j) accm[i][j] = __builtin_amdgcn_mfma_f32_16x16x32_bf16(af[i], bfr[j], accm[i][j], 0, 0, 0);
    }
    if (valid) {
#pragma unroll
        for (int i = 0; i < 2; ++i)
#pragma unroll
            for (int j = 0; j < 2; ++j)
#pragma unroll
                for (int rr = 0; rr < 4; ++rr) {
                    const int m = m0 + wm + i * 16 + fq * 4 + rr, n = n0 + wn + j * 16 + fr;
                    if (m < M && n < N) E(b, m, n, accm[i][j][rr]);
                }
    }
}
template <class AF, class BF, class EF>
__device__ __forceinline__ void gemm_phase(unsigned char* lds, const AF& A, const BF& B, const EF& E, int nbatch, int M, int N, int K) {
    PH_IDS; const int tid = tid_, half = tid >> 8, ht = tid & 255;
    bf16_t (*sA)[40] = (bf16_t (*)[40])(lds + half * 10240);
    bf16_t (*sB)[40] = (bf16_t (*)[40])(lds + half * 10240 + 5120);
    const int tm = (M + 63) >> 6, tn = (N + 63) >> 6, total = nbatch * tm * tn;
    for (int it0 = bid_ * 2; it0 < total; it0 += G_ * 2) {
        const int it = it0 + half; const bool valid = it < total;
        const int itc = valid ? it : 0;
        const int b = itc / (tm * tn), r = itc % (tm * tn), m0 = (r / tn) * 64, n0 = (r % tn) * 64;
        gemm_tile(A, B, E, valid, b, m0, n0, M, N, K, sA, sB, ht);
    }
    __syncthreads();
}
template <class T> static T zeroed() { T t; memset((void*)&t, 0, sizeof(T)); return t; }

struct A_bf16 { const bf16_t* p; long long ld; long long coff;
    __device__ float operator()(int, int m, int k) const { return bf2f(p[(size_t)m * ld + coff + k]); } };
struct A_bf16_scaled { const bf16_t* p; long long ld; long long coff; const float* rs; long long rsi; const float* w;
    __device__ float operator()(int, int m, int k) const { return bf2f(p[(size_t)m * ld + coff + k]) * rs[(size_t)m * 2 + rsi] * w[k]; } };
struct B_f32 { const float* p; long long ld; long long coff;
    __device__ float operator()(int, int k, int n) const { return p[(size_t)k * ld + coff + n]; } };
struct E_bf16 { bf16_t* p; long long ld; long long coff;
    __device__ void operator()(int, int m, int n, float v) const { p[(size_t)m * ld + coff + n] = f2bf(v); } };

#define XB_TMO      128
#define XB_XCNT(j)  (256  + 64 * (j))
#define XB_XSUB(j)  (1280 + 64 * (j))
#define XB_XGEN(j)  (2304 + 64 * (j))
#define XB_TOP      3328
#define XB_TOPGEN   3392
#define XCD_BAR_WORDS 3456
#define XB_SPIN_CAP (1u << 18)
__device__ __forceinline__ unsigned xb_ld(unsigned* p)              { return __hip_atomic_load(p, __ATOMIC_RELAXED, __HIP_MEMORY_SCOPE_AGENT); }
__device__ __forceinline__ unsigned xb_add(unsigned* p, unsigned v) { return __hip_atomic_fetch_add(p, v, __ATOMIC_RELAXED, __HIP_MEMORY_SCOPE_AGENT); }
__device__ __forceinline__ unsigned xb_xcc_id() { return (unsigned)__builtin_amdgcn_s_getreg((3 << 11) | 20) & 0xFu; }
#define XB_SPIN(cond, bar) do { unsigned _sp = 0; while (cond) { __builtin_amdgcn_s_sleep(1); \
    if ((++_sp & 255u) == 0u) { if (xb_ld(&(bar)[XB_TMO])) break; if (_sp > XB_SPIN_CAP) { atomicAdd(&(bar)[XB_TMO], 1u); break; } } } } while (0)
struct XcdBarrier { unsigned* bar; unsigned x; volatile LAS unsigned* st; };
__device__ __forceinline__ XcdBarrier xcd_barrier_post(unsigned* bar, volatile LAS unsigned* st) {
    XcdBarrier b; b.bar = bar; b.x = xb_xcc_id(); b.st = st;
    if (threadIdx.x == 0) (void)xb_add(&bar[XB_XCNT(b.x)], 1u);
    return b;
}
__device__ __forceinline__ void xcd_barrier_complete(unsigned* bar, unsigned x, unsigned& nloc, unsigned& nx) {
    const unsigned G = gridDim.x * gridDim.y * gridDim.z;
    unsigned sum, cnt, mine, sp = 0u;
    for (;;) {
        sum = 0u; cnt = 0u; mine = 0u;
#pragma unroll
        for (unsigned j = 0; j < 16; ++j) { const unsigned c = xb_ld(&bar[XB_XCNT(j)]); sum += c; cnt += (c > 0u) ? 1u : 0u; mine = (j == x) ? c : mine; }
        if (sum == G) break;
        __builtin_amdgcn_s_sleep(1);
        if ((++sp & 255u) == 0u) { if (xb_ld(&bar[XB_TMO])) break; if (sp > XB_SPIN_CAP) { atomicAdd(&bar[XB_TMO], 1u); break; } }
    }
    nloc = mine > 0u ? mine : 1u; nx = cnt > 0u ? cnt : 1u;
}
__device__ __forceinline__ void xcd_barrier(const XcdBarrier& b) {
    asm volatile("s_waitcnt vmcnt(0)" ::: "memory");
    __syncthreads();
    if (threadIdx.x == 0) {
        unsigned* bar = b.bar;
        __builtin_amdgcn_s_waitcnt(0);
        unsigned nloc = b.st[0], nx = b.st[1];
        if (nloc == 0u) { xcd_barrier_complete(bar, b.x, nloc, nx); b.st[0] = nloc; b.st[1] = nx; }
        const unsigned old = xb_add(&bar[XB_XSUB(b.x)], 1u);
        const unsigned gen = old / nloc;
        if (old + 1u == (gen + 1u) * nloc) {
            __builtin_amdgcn_fence(__ATOMIC_RELEASE, "agent");
            asm volatile("s_waitcnt vmcnt(0)" ::: "memory");
            const unsigned og = xb_add(&bar[XB_TOP], 1u);
            const unsigned tg = og / nx;
            if (og + 1u == (tg + 1u) * nx) xb_add(&bar[XB_TOPGEN], 1u);
            else XB_SPIN(xb_ld(&bar[XB_TOPGEN]) == tg, bar);
            __builtin_amdgcn_fence(__ATOMIC_ACQUIRE, "agent");
            xb_add(&bar[XB_XGEN(b.x)], 1u);
            asm volatile("s_waitcnt vmcnt(0)" ::: "memory");
        } else {
            XB_SPIN(xb_ld(&bar[XB_XGEN(b.x)]) == gen, bar);
            __builtin_amdgcn_fence(__ATOMIC_ACQUIRE, "agent");
            asm volatile("s_waitcnt vmcnt(0)" ::: "memory");
        }
    }
    __syncthreads();
}

__device__ __forceinline__ void dep_signal_x(unsigned* ctr, unsigned* sub, unsigned nloc) {
    asm volatile("s_waitcnt vmcnt(0)" ::: "memory");
    __syncthreads();
    if (threadIdx.x == 0) { const unsigned old = xb_add(sub, 1u);
        if (old + 1u == nloc) { __builtin_amdgcn_fence(__ATOMIC_RELEASE, "agent"); asm volatile("s_waitcnt vmcnt(0)" ::: "memory"); (void)xb_add(ctr, nloc); } }
}
__device__ __forceinline__ void dep_spin(unsigned* ctr, unsigned need, unsigned* bar) {
    XB_SPIN(xb_ld(ctr) < need, bar);
    __builtin_amdgcn_fence(__ATOMIC_ACQUIRE, "agent");
    asm volatile("s_waitcnt vmcnt(0)" ::: "memory");
}
namespace pg8 {
typedef unsigned u32x4 __attribute__((ext_vector_type(4)));
constexpr int BM = 256, BK = 64, HALF = 128, HTB = HALF * BK * 2, STAGE_BYTES = 8 * HTB, NXCD = 8, WGM = 8;
__device__ __forceinline__ int lds_byte(int r, int c) { const int st = (r >> 4) * 2 + (c >> 5), rr = r & 15, cc = c & 31, ob = rr * 64 + cc * 2; return st * 1024 + (ob ^ (((ob >> 9) & 1) << 5)); }
__device__ __forceinline__ void stage_rc(int b, int& R, int& C) { const int st = b / 1024, sb = b % 1024, swz = sb ^ (((sb >> 9) & 1) << 5); R = (st >> 1) * 16 + swz / 64; C = (st & 1) * 32 + (swz % 64) / 2; }
__device__ __forceinline__ int perm32(int rho) { const int n = rho >> 4, i = rho & 15; return 8 * (i >> 2) + 4 * n + (i & 3); }
struct Unit { const char* A; const char* B; unsigned lda, ldb; int nt, pm, pn, kind, aux; };
__device__ __forceinline__ unsigned cvt_pk_bf16(float lo, float hi) { unsigned r; asm volatile("v_cvt_pk_bf16_f32 %0, %1, %2" : "=v"(r) : "v"(lo), "v"(hi)); return r; }
__device__ __forceinline__ bool static_tile(int nM, int nN, int G, int c, int i, int& pm, int& pn) {
    const int nwg = nM * nN; const long L = (long)i * G + c; if (L >= nwg) return false;
    int wgid = (int)L; { const int q = nwg / NXCD, r = nwg % NXCD, xcd = wgid % NXCD, off = wgid / NXCD; wgid = (xcd < r ? xcd * (q + 1) : r * (q + 1) + (xcd - r) * q) + off; }
    const int nig = WGM * nN, gid = wgid / nig, fm = gid * WGM, gsz = (nM - fm) < WGM ? (nM - fm) : WGM;
    pm = fm + ((wgid % nig) % gsz); pn = (wgid % nig) / gsz; return true;
}
template <class Epi, class Sched>
__device__ __forceinline__ void gemm_phase(LAS unsigned char* lds, const Sched& S, const Epi& E) {
    const int tid = l_tid(), wid = __builtin_amdgcn_readfirstlane(tid >> 6), lane = tid & 63, wr = wid >> 2, wc = wid & 3, fr = lane & 15, fq = lane >> 4;
    int sR0, sC20;
    { int R, C; stage_rc(tid * 16, R, C); sR0 = R; sC20 = C * 2; }
#define PG8_R(i) (sR0 + 64 * (i))
#define PG8_RB(i) ((PG8_R(i) & ~31) + perm32(PG8_R(i) & 31))
    const size_t kstep = (size_t)(BK * 2);
    const unsigned ldsw = (unsigned)wid * 1024u;
    const int aoff = lds_byte(wr * 64 + fr, fq * 8), boff = lds_byte(wc * 32 + fr, fq * 8);
#define PG8_SA(b, h) (((b) * 2 + (h)) * HTB)
#define PG8_SB(b, h) ((4 + (b) * 2 + (h)) * HTB)
#define PG8_STAGE_A(bufoff, gbase, ld) do { \
        __builtin_amdgcn_global_load_lds((const unsigned*)((const char*)(gbase) + (unsigned)(PG8_R(0) * (ld) + sC20)), (LAS unsigned*)(lds + (bufoff) + ldsw), 16, 0, 0); \
        __builtin_amdgcn_global_load_lds((const unsigned*)((const char*)(gbase) + (unsigned)(PG8_R(1) * (ld) + sC20)), (LAS unsigned*)(lds + (bufoff) + ldsw + 8192), 16, 0, 0); } while (0)
#define PG8_STAGE_B(bufoff, gbase, ld) do { \
        __builtin_amdgcn_global_load_lds((const unsigned*)((const char*)(gbase) + (unsigned)(PG8_RB(0) * (ld) + sC20)), (LAS unsigned*)(lds + (bufoff) + ldsw), 16, 0, 0); \
        __builtin_amdgcn_global_load_lds((const unsigned*)((const char*)(gbase) + (unsigned)(PG8_RB(1) * (ld) + sC20)), (LAS unsigned*)(lds + (bufoff) + ldsw + 8192), 16, 0, 0); } while (0)
#define PG8_LDA(dst, b, h) do { _Pragma("unroll") for (int m = 0; m < 4; ++m) _Pragma("unroll") for (int k = 0; k < 2; ++k) dst[m][k] = *(const LAS bf16x8*)(lds + PG8_SA(b, h) + aoff + m * 2048 + k * 1024); } while (0)
#define PG8_LDB(dst, b, h) do { _Pragma("unroll") for (int n = 0; n < 2; ++n) _Pragma("unroll") for (int k = 0; k < 2; ++k) dst[n][k] = *(const LAS bf16x8*)(lds + PG8_SB(b, h) + boff + n * 2048 + k * 1024); } while (0)
#define PG8_MMA(ai, bj, At, Bt) do { __builtin_amdgcn_s_setprio(1); _Pragma("unroll") for (int m = 0; m < 4; ++m) _Pragma("unroll") for (int n = 0; n < 2; ++n) _Pragma("unroll") for (int k = 0; k < 2; ++k) \
        acc[ai][bj][m][n] = __builtin_amdgcn_mfma_f32_16x16x32_bf16(Bt[n][k], At[m][k], acc[ai][bj][m][n], 0, 0, 0); __builtin_amdgcn_s_setprio(0); } while (0)
#define PG8_WAIT_V(n) asm volatile("s_waitcnt vmcnt(" #n ")" ::: "memory")
#define PG8_WAIT_L(n) asm volatile("s_waitcnt lgkmcnt(" #n ")" ::: "memory")
#define PG8_BAR __builtin_amdgcn_s_barrier()
#define PG8_SCHED __builtin_amdgcn_sched_barrier(0)
    Unit cur, nxt; int ui = 0;
    if (!S.next(0, cur)) return;
    f32x4 prev_;
    if constexpr (Epi::PRE) { E.pre_issue(cur, tid, prev_); E.pre_commit(tid, 0, prev_); }
    f32x4 acc[2][2][4][2];
#pragma unroll
    for (int a = 0; a < 2; ++a)
#pragma unroll
        for (int b = 0; b < 2; ++b)
#pragma unroll
            for (int m = 0; m < 4; ++m)
#pragma unroll
                for (int n = 0; n < 2; ++n) acc[a][b][m][n] = (f32x4){0.f, 0.f, 0.f, 0.f};
    bf16x8 At[4][2], B0[2][2], B1[2][2];
    const char* cA = cur.A; const char* cB = cur.B;
    int clda = cur.lda, cldb = cur.ldb;
    PG8_STAGE_B(PG8_SB(0, 0), cB, cldb); PG8_STAGE_B(PG8_SB(0, 1), cB + (size_t)HALF * cldb, cldb); PG8_STAGE_A(PG8_SA(0, 0), cA, clda); PG8_STAGE_A(PG8_SA(0, 1), cA + (size_t)HALF * clda, clda);
    if (wr == 1) PG8_BAR;
    PG8_WAIT_V(2); PG8_BAR;
    PG8_STAGE_B(PG8_SB(1, 0), cB + kstep, cldb); PG8_STAGE_A(PG8_SA(1, 0), cA + kstep, clda); PG8_STAGE_B(PG8_SB(1, 1), cB + (size_t)HALF * cldb + kstep, cldb);
    PG8_WAIT_V(6); PG8_BAR;
    for (;;) {
        const bool has_next = S.next(ui + 1, nxt);
        const char* nA = has_next ? nxt.A : cA; const char* nB = has_next ? nxt.B : cB;
        const int nlda = has_next ? (int)nxt.lda : clda, nldb = has_next ? (int)nxt.ldb : cldb;
        const int nt = cur.nt;
        for (int t = 0; t < nt; t += 2) {
            const bool last = (t == nt - 2);
            const char* a1 = cA + (size_t)(t + 1) * kstep;
            const char* a2 = last ? nA : cA + (size_t)(t + 2) * kstep; const char* b2 = last ? nB : cB + (size_t)(t + 2) * kstep;
            const char* a3 = a2 + kstep; const char* b3 = b2 + kstep;
            const int lda2 = last ? nlda : clda, ldb2 = last ? nldb : cldb;
            PG8_LDB(B0, 0, 0); PG8_LDB(B1, 0, 1); PG8_SCHED; PG8_LDA(At, 0, 0); PG8_STAGE_A(PG8_SA(1, 1), a1 + (size_t)HALF * clda, clda);
            PG8_WAIT_V(8); PG8_WAIT_L(0); PG8_BAR; PG8_MMA(0, 0, At, B0); PG8_MMA(0, 1, At, B1); PG8_BAR; PG8_SCHED;
            PG8_LDA(At, 0, 1); PG8_STAGE_B(PG8_SB(0, 0), b2, ldb2); PG8_STAGE_B(PG8_SB(0, 1), b2 + (size_t)HALF * ldb2, ldb2); PG8_STAGE_A(PG8_SA(0, 0), a2, lda2);
            PG8_WAIT_V(8); PG8_WAIT_L(0); PG8_BAR; PG8_MMA(1, 0, At, B0); PG8_MMA(1, 1, At, B1); PG8_BAR; PG8_SCHED;
            PG8_LDB(B0, 1, 0); PG8_LDB(B1, 1, 1); PG8_SCHED; PG8_LDA(At, 1, 0); PG8_STAGE_A(PG8_SA(0, 1), a2 + (size_t)HALF * lda2, lda2);
            PG8_WAIT_V(8); PG8_WAIT_L(0); PG8_BAR; PG8_MMA(0, 0, At, B0); PG8_MMA(0, 1, At, B1); PG8_BAR; PG8_SCHED;
            PG8_LDA(At, 1, 1); PG8_STAGE_B(PG8_SB(1, 0), b3, ldb2); PG8_STAGE_B(PG8_SB(1, 1), b3 + (size_t)HALF * ldb2, ldb2); PG8_STAGE_A(PG8_SA(1, 0), a3, lda2);
            PG8_WAIT_V(8); PG8_WAIT_L(0); PG8_BAR; PG8_MMA(1, 0, At, B0); PG8_MMA(1, 1, At, B1); PG8_BAR; PG8_SCHED;
        }
        if (wr == 0) PG8_BAR;
        if constexpr (Epi::PRE) { if (has_next) E.pre_issue(nxt, tid, prev_); E(acc, cur, wr, wc, fr, fq, ui & 1); if (has_next) E.pre_commit(tid, (ui + 1) & 1, prev_); }
        else E(acc, cur, wr, wc, fr, fq);
        if (!has_next) break;
#pragma unroll
        for (int a = 0; a < 2; ++a)
#pragma unroll
            for (int b = 0; b < 2; ++b)
#pragma unroll
                for (int m = 0; m < 4; ++m)
#pragma unroll
                    for (int n = 0; n < 2; ++n) acc[a][b][m][n] = (f32x4){0.f, 0.f, 0.f, 0.f};
        cur = nxt; cA = nA; cB = nB; clda = nlda; cldb = nldb; ++ui;
        if (wr == 1) PG8_BAR;
    }
    PG8_WAIT_V(0);
    PG8_BAR;
#undef PG8_SA
#undef PG8_SB
#undef PG8_STAGE_A
#undef PG8_RB
#undef PG8_R
#undef PG8_STAGE_B
#undef PG8_LDA
#undef PG8_LDB
#undef PG8_MMA
#undef PG8_WAIT_V
#undef PG8_WAIT_L
#undef PG8_BAR
#undef PG8_SCHED
}
}

__device__ __forceinline__ pg8::u32x4 pack8(const f32x4 a, const f32x4 b) { pg8::u32x4 w; w.x = pg8::cvt_pk_bf16(a[0], a[1]); w.y = pg8::cvt_pk_bf16(a[2], a[3]); w.z = pg8::cvt_pk_bf16(b[0], b[1]); w.w = pg8::cvt_pk_bf16(b[2], b[3]); return w; }
__device__ __forceinline__ void unpack8(const pg8::u32x4 w, f32x4& a, f32x4& b) {
    a[0] = __uint_as_float(w.x << 16); a[1] = __uint_as_float(w.x & 0xffff0000u); a[2] = __uint_as_float(w.y << 16); a[3] = __uint_as_float(w.y & 0xffff0000u);
    b[0] = __uint_as_float(w.z << 16); b[1] = __uint_as_float(w.z & 0xffff0000u); b[2] = __uint_as_float(w.w << 16); b[3] = __uint_as_float(w.w & 0xffff0000u); }
namespace fa {
typedef float f32x16 __attribute__((ext_vector_type(16)));
typedef short s16x4 __attribute__((ext_vector_type(4)));
typedef unsigned u32x4 __attribute__((ext_vector_type(4)));
typedef unsigned u32x2 __attribute__((ext_vector_type(2)));
__device__ __forceinline__ s16x4 vtr(const LAS char* p) { return __builtin_bit_cast(s16x4, __builtin_amdgcn_ds_read_tr16_b64_v4i16((LAS s16x4*)p)); }
__device__ __forceinline__ unsigned pk2(float lo, float hi) { unsigned r; asm volatile("v_cvt_pk_bf16_f32 %0, %1, %2" : "=v"(r) : "v"(lo), "v"(hi)); return r; }
typedef __bf16 bf16v2_t __attribute__((ext_vector_type(2)));
typedef float f32v2_t __attribute__((ext_vector_type(2)));
__device__ __forceinline__ unsigned pk2n(float lo, float hi) { return __builtin_bit_cast(unsigned, __builtin_convertvector((f32v2_t){lo, hi}, bf16v2_t)); }
__device__ __forceinline__ bf16x8 pack_p(const f32x16& p, int base) { u32x4 w; w.x = pk2(p[base], p[base + 1]); w.y = pk2(p[base + 2], p[base + 3]); w.z = pk2(p[base + 4], p[base + 5]); w.w = pk2(p[base + 6], p[base + 7]); return __builtin_bit_cast(bf16x8, w); }
__device__ __forceinline__ int crow(int r, int hi) { return (r & 3) + 8 * (r >> 2) + 4 * hi; }
__device__ __forceinline__ void pv_tile(f32x16& o0, f32x16& o1, const LAS char* vb, const bf16x8 (&pf)[4]) {
#pragma unroll
    for (int ks = 0; ks < 4; ++ks) {
        const s16x4 a0 = vtr(vb + ks * 1024), a1 = vtr(vb + ks * 1024 + 512), b0 = vtr(vb + 4096 + ks * 1024), b1 = vtr(vb + 4096 + ks * 1024 + 512);
        const bf16x8 v0 = (bf16x8){a0[0], a0[1], a0[2], a0[3], a1[0], a1[1], a1[2], a1[3]}, v1 = (bf16x8){b0[0], b0[1], b0[2], b0[3], b1[0], b1[1], b1[2], b1[3]};
        o0 = __builtin_amdgcn_mfma_f32_32x32x16_bf16(v0, pf[ks], o0, 0, 0, 0);
        o1 = __builtin_amdgcn_mfma_f32_32x32x16_bf16(v1, pf[ks], o1, 0, 0, 0);
    }
}
constexpr int KP_A = 208, KT_A = 64 * KP_A, VT = 8192, BUF_A = KT_A + VT;
constexpr int KP_R = 144, KT_R = 64 * KP_R, BUF_R = KT_R + VT;
}

#define GSTRIDE(gi, total) for (int gi = bid_ * NT + tid_; gi < (total); gi += G_ * NT)
__device__ __forceinline__ void ph_mod(unsigned char* lds, const float* c, const float* c_ctx, const float* ada_w, const float* ada_b, float* mod) { PH_IDS;
    LAS float* sl = (LAS float*)lds;
    LAS float* red = sl + 9 * 1024;
    for (int e = tid_; e < 9 * 1024; e += NT) { const int j = e >> 10, k = e & 1023; const float v = j < 8 ? c[j * 1024 + k] : c_ctx[k]; sl[e] = siluf_(v); }
    __syncthreads();
    const int nn = tid_ & 63, ks = tid_ >> 6;
    for (int u = bid_; u < 2 * 96; u += G_) {
        const int l = u / 96, n = (u % 96) * 64 + nn;
        float acc[9];
#pragma unroll
        for (int j = 0; j < 9; ++j) acc[j] = 0.f;
        const float* w = ada_w + ((size_t)l * 1024 + ks * 128) * 6144 + n;
#pragma unroll 4
        for (int k4 = 0; k4 < 32; ++k4) {
            const float w0 = w[(size_t)(4 * k4) * 6144], w1 = w[(size_t)(4 * k4 + 1) * 6144], w2 = w[(size_t)(4 * k4 + 2) * 6144], w3 = w[(size_t)(4 * k4 + 3) * 6144];
#pragma unroll
            for (int j = 0; j < 9; ++j) { const f32x4 s4 = *(const LAS f32x4*)(sl + j * 1024 + ks * 128 + 4 * k4); acc[j] += s4[0] * w0 + s4[1] * w1 + s4[2] * w2 + s4[3] * w3; } }
        __syncthreads();
#pragma unroll
        for (int j = 0; j < 9; ++j) red[(ks * 9 + j) * 64 + nn] = acc[j];
        __syncthreads();
        for (int e = tid_; e < 9 * 64; e += NT) { const int j = e >> 6, q = e & 63; float sum = 0.f;
#pragma unroll
            for (int r = 0; r < 8; ++r) sum += red[(r * 9 + j) * 64 + q];
            const int col = (u % 96) * 64 + q; mod[((size_t)l * 9 + j) * 6144 + col] = sum + ada_b[l * 6144 + col]; }
    }
    __syncthreads();
}
__device__ __forceinline__ void ph_trig(float* trig, bf16_t* d64) { PH_IDS; GSTRIDE(i, 2048) { const float xx = (float)i * (1.f / 1024.f); trig[i] = cospif(xx); trig[2048 + i] = sinpif(xx); }
    GSTRIDE(i, 128 * 64) { const int n = i >> 6, c = i & 63, m = n & 63; const float xx = (float)((m * c) & 63) * (1.f / 32.f); d64[i] = f2bf(n < 64 ? cospif(xx) : sinpif(xx)); } }
__device__ __forceinline__ double2 lam_pow(double re, double im, double dt, int k) {
    const double m = (double)__expf((float)(re * dt * k));
    double xx = im * dt * (double)k * 0.318309886183790671538;
    xx -= 2.0 * rint(xx * 0.5);
    const float xf = (float)xx;
    return make_double2(m * (double)cospif(xf), m * (double)sinpif(xf));
}
__device__ __forceinline__ void ph_s5_lp(int l, const float* lam_re, const float* lam_im, const float* log_step, const float* b_re, const float* b_im, float2* LP, float2* BB, float* lamT) { PH_IDS;
    GSTRIDE(it, 2 * 16 * 64 * 81) {
        const int i = it / 81, k = it % 81;
        const int d = i / 1024, g = (i / 64) % 16, p = i % 64;
        const size_t li = ((size_t)(l * 2 + d) * 16 + g) * 64 + p;
        const double re = lam_re[li], im = lam_im[li], dt = (double)expf(log_step[(l * 2 + d) * 16 + g]);
        if (k <= 64) {
            const double2 v = lam_pow(re, im, dt, k); LP[(size_t)i * 65 + k] = make_float2((float)v.x, (float)v.y);
            if (k == 64) { lamT[((size_t)(g * 2 + d) * 64 + p) * 2 + 0] = (float)v.x; lamT[((size_t)(g * 2 + d) * 64 + p) * 2 + 1] = (float)v.y; }
        } else {
            const int h = k - 65;
            const double2 l1 = lam_pow(re, im, dt, 1);
            const double nr = l1.x - 1.0, ni = l1.y, den = re * re + im * im;
            const double fr = (nr * re + ni * im) / den, fi = (ni * re - nr * im) / den;
            const double br = b_re[li * 16 + h], bi = b_im[li * 16 + h]; BB[(size_t)i * 16 + h] = make_float2((float)(fr * br - fi * bi), (float)(fr * bi + fi * br));
        }
    }
}
__device__ __forceinline__ void ph_s5_tz(unsigned char* lds_, int l, const float2* LP, const float2* BB, const float* c_re, const float* c_im, float* TZD, int vb, int vg) { PH_IDS;
    typedef float f32x2_ __attribute__((ext_vector_type(2)));
    LAS f32x2_* sC = (LAS f32x2_*)lds_;
    LAS f32x2_* sL = sC + 16 * 64;
    LAS f32x2_* sB = sL + 64 * 8;
    for (int it = vb; it < 256; it += vg) {
        const int u = it >> 3, ts = it & 7, g = u >> 1, d = u & 1;
        const size_t cb = (((size_t)(l * 2 + d) * 16 + g) * 16) * 64, gb = (size_t)d * 16 + g;
        const float cr0 = c_re[cb + tid_], ci0 = c_im[cb + tid_], cr1 = c_re[cb + NT + tid_], ci1 = c_im[cb + NT + tid_];
        const float2 lpv = LP[gb * 64 * 65 + (size_t)(tid_ >> 3) * 65 + ts * 8 + (tid_ & 7)];
        const float2 bb0 = BB[gb * 64 * 16 + tid_], bb1 = BB[gb * 64 * 16 + NT + tid_];
        __syncthreads();
        sC[tid_] = (f32x2_){cr0, ci0}; sC[NT + tid_] = (f32x2_){cr1, ci1}; sL[tid_] = (f32x2_){lpv.x, lpv.y}; sB[tid_] = (f32x2_){bb0.x, bb0.y}; sB[NT + tid_] = (f32x2_){bb1.x, bb1.y};
        __syncthreads();
        const int pair = tid_ & 127, tl = pair >> 4, h = pair & 15, qg = tid_ >> 7;
        f32x4 acc = (f32x4){0.f, 0.f, 0.f, 0.f};
#pragma unroll 4
        for (int p = 0; p < 64; ++p) {
            const f32x2_ c = sC[h * 64 + p], lp = sL[p * 8 + tl];
            const float er = c.x * lp.x - c.y * lp.y, ei = c.x * lp.y + c.y * lp.x;
            const f32x4 b01 = *(const LAS f32x4*)&sB[p * 16 + 4 * qg], b23 = *(const LAS f32x4*)&sB[p * 16 + 4 * qg + 2];
            acc[0] += er * b01[0] - ei * b01[1]; acc[1] += er * b01[2] - ei * b01[3]; acc[2] += er * b23[0] - ei * b23[1]; acc[3] += er * b23[2] - ei * b23[3];
        }
        *(f32x4*)(TZD + (((gb * 64) + ts * 8 + tl) * 16 + h) * 16 + 4 * qg) = acc;
    }
    __syncthreads();
}
__device__ __forceinline__ void ph_s5_ms(const float2* LP, const float2* BB, bf16_t* MST, int vb, int vg) { PH_IDS;
    for (int i0 = vb * NT + tid_; i0 < 16 * 256 * 128; i0 += 3 * vg * NT) {
        float2 lp[3]; f32x4 bb[3][4];
#pragma unroll
        for (int k = 0; k < 3; ++k) { const int i = i0 + k * vg * NT;
            if (i < 16 * 256 * 128) { const int g = i / (256 * 128), n = (i / 128) % 256, sh0 = (i % 128) * 8, d = n >> 7, p = n & 63, s = sh0 >> 4, hp0 = sh0 & 15;
                const size_t gi = ((size_t)d * 16 + g) * 64 + p;
                lp[k] = LP[gi * 65 + (d == 0 ? 63 - s : s)];
#pragma unroll
                for (int q = 0; q < 4; ++q) bb[k][q] = *(const f32x4*)(BB + gi * 16 + hp0 + 2 * q); } }
#pragma unroll
        for (int k = 0; k < 3; ++k) { const int i = i0 + k * vg * NT;
            if (i < 16 * 256 * 128) { const int g = i / (256 * 128), n = (i / 128) % 256, sh0 = (i % 128) * 8, im = (n >> 6) & 1;
                float v[8];
#pragma unroll
                for (int q = 0; q < 4; ++q) { v[2 * q] = im ? lp[k].x * bb[k][q][1] + lp[k].y * bb[k][q][0] : lp[k].x * bb[k][q][0] - lp[k].y * bb[k][q][1];
                    v[2 * q + 1] = im ? lp[k].x * bb[k][q][3] + lp[k].y * bb[k][q][2] : lp[k].x * bb[k][q][2] - lp[k].y * bb[k][q][3]; }
                *(pg8::u32x4*)(MST + ((size_t)g * 256 + n) * 1024 + sh0) = pack8((f32x4){v[0], v[1], v[2], v[3]}, (f32x4){v[4], v[5], v[6], v[7]}); } }
    }
}
__device__ __forceinline__ void ph_s5_qo(int l, const float2* LP, const float* c_re, const float* c_im, bf16_t* QOT, int vb, int vg) { PH_IDS;
    for (int i = vb * NT + tid_; i < 16 * 1024 * 32; i += vg * NT) {
        const int g = i / (1024 * 32), th = (i / 32) % 1024, j0 = (i % 32) * 8, d = j0 >> 7, im = (j0 >> 6) & 1, p0 = j0 & 63, t = th >> 4, h = th & 15;
        const size_t ci = (((size_t)(l * 2 + d) * 16 + g) * 16 + h) * 64 + p0;
        const int e = d == 0 ? t + 1 : 64 - t;
        float v[8];
#pragma unroll
        for (int q = 0; q < 8; ++q) { const float cr = c_re[ci + q], cim = c_im[ci + q]; const float2 lp = LP[(((size_t)d * 16 + g) * 64 + p0 + q) * 65 + e]; v[q] = im ? -(cr * lp.y + cim * lp.x) : cr * lp.x - cim * lp.y; }
        *(pg8::u32x4*)(QOT + ((size_t)g * 1024 + th) * 256 + j0) = pack8((f32x4){v[0], v[1], v[2], v[3]}, (f32x4){v[4], v[5], v[6], v[7]});
    }
}
__device__ __forceinline__ void ph_wmf(const float* w, const float* mod, float* wmf) { PH_IDS;
    GSTRIDE(i, 9 * 1024) { const int b = i >> 10, c = i & 1023; wmf[i] = w[c] * (1.f + mod[(size_t)b * 6144 + 4 * 1024 + c]); }
}
__device__ __forceinline__ void ph_cf_mfma(unsigned char* lds_, const bf16_t* W1T, const float* mod, float* cf, int vb, int vg) {
    const int tid = l_tid(), lane = tid & 63, kk = __builtin_amdgcn_readfirstlane(tid >> 6), i16 = lane & 15, kq = lane >> 4;
    LAS float* red = (LAS float*)lds_;
    for (int nt = vb; nt < 256; nt += vg) {
        f32x4 acc = (f32x4){0.f, 0.f, 0.f, 0.f};
#pragma unroll
        for (int s4 = 0; s4 < 4; ++s4) { const int k0 = kk * 128 + s4 * 32 + kq * 8;
            pg8::u32x4 aw = (pg8::u32x4){0u, 0u, 0u, 0u};
            if (i16 < 9) { const float* sp = mod + (size_t)i16 * 6144 + 3 * 1024 + k0; aw = pack8(*(const f32x4*)sp, *(const f32x4*)(sp + 4)); }
            const bf16x8 bw = *(const bf16x8*)(W1T + (size_t)(nt * 16 + i16) * 1024 + k0);
            acc = __builtin_amdgcn_mfma_f32_16x16x32_bf16(__builtin_bit_cast(bf16x8, aw), bw, acc, 0, 0, 0); }
        __syncthreads();
#pragma unroll
        for (int r = 0; r < 4; ++r) red[(kk * 16 + 4 * kq + r) * 16 + i16] = acc[r];
        __syncthreads();
        if (tid < 144) { float a = 0.f;
#pragma unroll
            for (int w = 0; w < 8; ++w) a += red[w * 256 + tid];
            cf[(size_t)(tid >> 4) * DFF + nt * 16 + (tid & 15)] = a; }
    }
    __syncthreads();
}
template <int XIN>
__device__ __forceinline__ void ph_adarms(const void* xlat, const void* xctx, const float* w, const float* mod, int sh_chunk, int sc_chunk, bf16_t* out, int nrows) { PH_IDS;
    const int wave = (bid_ * NT + tid_) >> 6, lane = tid_ & 63, nw = (G_ * NT) >> 6;
    f32x4 wv[4];
#pragma unroll
    for (int j = 0; j < 4; ++j) wv[j] = *(const f32x4*)(w + j * 256 + lane * 4);
    for (int row0 = wave; row0 < nrows; row0 += 3 * nw) {
        f32x4 v[3][4], sc[3][4], sh[3][4];
#pragma unroll
        for (int k = 0; k < 3; ++k) { const int row = row0 + k * nw;
            if (row < nrows) {
                if constexpr (XIN == 0) { const float* x = row < RL ? (const float*)xlat + (size_t)row * DM : (const float*)xctx + (size_t)(row - RL) * DM;
#pragma unroll
                    for (int j = 0; j < 4; ++j) v[k][j] = *(const f32x4*)(x + j * 256 + lane * 4); }
                else { const bf16_t* x = row < RL ? (const bf16_t*)xlat + (size_t)row * DM : (const bf16_t*)xctx + (size_t)(row - RL) * DM;
#pragma unroll
                    for (int j = 0; j < 4; ++j) { const fa::u32x2 r = *(const fa::u32x2*)(x + j * 256 + lane * 4); v[k][j] = (f32x4){__uint_as_float(r.x << 16), __uint_as_float(r.x & 0xffff0000u), __uint_as_float(r.y << 16), __uint_as_float(r.y & 0xffff0000u)}; } }
                const float* mrow = mod + (size_t)row_modidx(row) * 6144;
#pragma unroll
                for (int j = 0; j < 4; ++j) { const int c0 = j * 256 + lane * 4; sc[k][j] = *(const f32x4*)(mrow + sc_chunk * 1024 + c0); sh[k][j] = *(const f32x4*)(mrow + sh_chunk * 1024 + c0); }
            } }
#pragma unroll
        for (int k = 0; k < 3; ++k) { const int row = row0 + k * nw;
            if (row < nrows) {
                float ss = 0.f;
#pragma unroll
                for (int j = 0; j < 4; ++j) ss += v[k][j][0] * v[k][j][0] + v[k][j][1] * v[k][j][1] + v[k][j][2] * v[k][j][2] + v[k][j][3] * v[k][j][3];
#pragma unroll
                for (int o = 1; o < 64; o <<= 1) ss += __shfl_xor(ss, o);
                const float rstd = rsqrtf(ss * (1.f / DM) + EPS);
#pragma unroll
                for (int j = 0; j < 4; ++j) { const int c0 = j * 256 + lane * 4;
                    const f32x4 y = v[k][j] * rstd * wv[j] * (sc[k][j] + 1.f) + sh[k][j];
                    fa::u32x2 o; o.x = fa::pk2(y[0], y[1]); o.y = fa::pk2(y[2], y[3]);
                    *(fa::u32x2*)(out + (size_t)row * DM + c0) = o; }
            } }
    }
}
__device__ __forceinline__ void ph_mla_stats(const bf16_t* Z, float* rs) { PH_IDS;
    const int wave = (bid_ * NT + tid_) >> 6, lane = tid_ & 63, nw = (G_ * NT) >> 6;
    for (int row = wave; row < RT; row += nw) {
        const bf16_t* z = Z + (size_t)row * ZW; float sq = 0.f, sk = 0.f;
#pragma unroll
        for (int j = 0; j < 4; ++j) { const float v = bf2f(z[C_QC + j * 64 + lane]); sq += v * v; }
#pragma unroll
        for (int j = 0; j < 2; ++j) { const float v = bf2f(z[C_KVC + j * 64 + lane]); sk += v * v; }
#pragma unroll
        for (int o = 1; o < 64; o <<= 1) { sq += __shfl_xor(sq, o); sk += __shfl_xor(sk, o); }
        if (lane == 0) { rs[(size_t)row * 2] = rsqrtf(sq * (1.f / 256) + EPS); rs[(size_t)row * 2 + 1] = rsqrtf(sk * (1.f / 128) + EPS); }
    }
}
__device__ __forceinline__ void ph_mla_post(const bf16_t* Z, const bf16_t* qraw, const bf16_t* kvraw, const float* qkq, const float* qkk, bf16_t* Q, bf16_t* Kb, bf16_t* Vb) { PH_IDS;
    GSTRIDE(gi, RT * 8) {
        const int row = gi >> 3, h = (gi >> 1) & 3, isk = gi & 1;
        const bool lat = row < RL; const int b = row_batch(row), t = lat ? (row & 2047) : ((row - RL) & 255);
        const int qi = lat ? t : 2048 + t, ki = lat ? 256 + t : t;
        float v[96];
        float ss = 0.f;
        if (!isk) {
#pragma unroll
            for (int i = 0; i < 96; ++i) v[i] = bf2f(qraw[(size_t)row * 384 + h * 96 + i]);
        } else {
#pragma unroll
            for (int i = 0; i < 64; ++i) v[i] = bf2f(kvraw[(size_t)row * 512 + h * 128 + i]);
#pragma unroll
            for (int i = 0; i < 32; ++i) v[64 + i] = bf2f(Z[(size_t)row * ZW + C_KR + i]);
        }
#pragma unroll
        for (int i = 0; i < 96; ++i) ss += v[i] * v[i];
        const float rr = rsqrtf(ss * (1.f / 96) + EPS) * (isk ? 1.f : 0.14724727430627066f);
        const float* wv = isk ? qkk : qkq;
#pragma unroll
        for (int i = 0; i < 96; ++i) v[i] = v[i] * rr * wv[i];
        if (lat) {
            const float prow = (float)(t >> 6), pcol = (float)(t & 63);
#pragma unroll
            for (int part = 0; part < 2; ++part) { const float pos = part ? pcol : prow; const int base = 64 + part * 16;
#pragma unroll
                for (int j = 0; j < 8; ++j) { const float fr = exp2f(-(float)j * (13.287712379549449f / 8.f)), a = pos * fr, cs = __cosf(a), sn = __sinf(a);
                    const float x1 = v[base + j], x2 = v[base + 8 + j]; v[base + j] = x1 * cs - x2 * sn; v[base + 8 + j] = x1 * sn + x2 * cs; } }
        }
        bf16_t* o = isk ? Kb + ((size_t)(b * 4 + h) * 2304 + ki) * 96 : Q + ((size_t)(b * 4 + h) * 2304 + qi) * 96;
#pragma unroll
        for (int i = 0; i < 96; ++i) o[i] = f2bf(v[i]);
        if (isk) { bf16_t* vo = Vb + ((size_t)(b * 4 + h) * 2304 + ki) * 64; for (int i = 0; i < 64; ++i) vo[i] = kvraw[(size_t)row * 512 + h * 128 + 64 + i]; }
    }
}
__device__ __forceinline__ void ph_attn(unsigned char* lds, const bf16_t* Q, const bf16_t* Kb, const bf16_t* Vb, bf16_t* Z, int with_ctx) { PH_IDS;
    float (*sK)[96] = (float (*)[96])lds; float (*sV)[64] = (float (*)[64])(lds + 32 * 96 * 4);
    const int nunits = 32 * (8 + (with_ctx ? 1 : 0));
    const int qt = tid_ & 255, dh = (tid_ >> 8) * 32;
    for (int u = bid_; u < nunits; u += G_) {
        const int bh = u % 32, qb = u / 32;
        const bool lat = qb < 8;
        const int qi = qb * 256 + qt, nkeys = lat ? 2304 : 256;
        float q[96], o[32];
        const bf16_t* qp = Q + ((size_t)bh * 2304 + qi) * 96;
#pragma unroll
        for (int i = 0; i < 96; ++i) q[i] = bf2f(qp[i]) * 0.10206207261596577f;
#pragma unroll
        for (int i = 0; i < 32; ++i) o[i] = 0.f;
        float mx = -1e30f, l = 0.f;
        for (int k0 = 0; k0 < nkeys; k0 += 32) {
            __syncthreads();
            for (int e = tid_; e < 32 * 96; e += NT) sK[e / 96][e % 96] = bf2f(Kb[((size_t)bh * 2304 + k0) * 96 + e]);
            for (int e = tid_; e < 32 * 64; e += NT) sV[e / 64][e % 64] = bf2f(Vb[((size_t)bh * 2304 + k0) * 64 + e]);
            __syncthreads();
#pragma unroll 1
            for (int j = 0; j < 32; ++j) { float a = 0.f;
#pragma unroll
                for (int i = 0; i < 96; ++i) a += q[i] * sK[j][i];
                if (a > mx) { const float corr = __expf(mx - a); mx = a; l *= corr;
#pragma unroll
                    for (int i = 0; i < 32; ++i) o[i] *= corr; }
                const float p = __expf(a - mx); l += p;
#pragma unroll
                for (int i = 0; i < 32; ++i) o[i] += p * sV[j][dh + i]; }
        }
        const int b = bh >> 2, h = bh & 3;
        const int row = lat ? b * 2048 + qi : RL + b * 256 + (qi - 2048);
        const float inv = 1.f / l;
#pragma unroll
        for (int i = 0; i < 32; ++i) Z[(size_t)row * ZW + C_QC + h * 64 + dh + i] = f2bf(o[i] * inv);
    }
    __syncthreads();
}
__device__ __forceinline__ void ph_f1(const bf16_t* Z, const float* trig, bf16_t* F1lat, bf16_t* F1ctx) { PH_IDS;
    GSTRIDE(gi, RT * 256) {
        const int row = gi >> 8, gm = gi & 255, g = gm >> 6, m = gm & 63;
        float a = 0.f, bsum = 0.f;
        const bf16_t* u = Z + (size_t)row * ZW + C_FU + g * 64;
        for (int c = 0; c < 64; ++c) { const float v = bf2f(u[c]); const int idx = ((m * c) & 63) * 32; a += v * trig[idx]; bsum += v * trig[2048 + idx]; }
        if (row < RL) { const int b = row >> 11, t = row & 2047; bf16_t* o = F1lat + ((size_t)(b * 256 + gm) * 2) * 2048; o[t] = f2bf(a); o[2048 + t] = f2bf(bsum); }
        else { const int r = row - RL, b = r >> 8, t = r & 255; bf16_t* o = F1ctx + ((size_t)(b * 256 + gm) * 2) * 256; o[t] = f2bf(a); o[256 + t] = f2bf(bsum); }
    }
}
struct A_dft { const float* trig; long long L; long long mul;
    __device__ float operator()(int, int k, int kk) const { const int part = kk >= (int)L, t = part ? kk - (int)L : kk; const int idx = (int)(((long long)k * t) & (L - 1)) * (int)mul; return part ? -trig[2048 + idx] : trig[idx]; } };
struct B_f1t { const bf16_t* p; long long L;
    __device__ float operator()(int b, int kk, int n) const { return bf2f(p[((size_t)(b * 256 + n)) * 2 * L + kk]); } };
struct E_fourier { bf16_t* Z; long long rowbase; long long L; double scale;
    __device__ void operator()(int b, int m, int n, float v) const { Z[((size_t)rowbase + (size_t)b * L + m) * ZW + C_FU + n] = f2bf(v * (float)scale); } };

struct A_s5u { const bf16_t* Z;
    __device__ float operator()(int g, int rc, int k) const { return bf2f(Z[((size_t)rc * 64 + (k >> 4)) * ZW + C_S5 + g * 16 + (k & 15)]); } };
struct B_ms { const bf16_t* MS; __device__ float operator()(int g, int k, int n) const { return bf2f(MS[((size_t)g * 1024 + k) * 256 + n]); } };
struct E_sloc { float* S; __device__ void operator()(int g, int rc, int n, float v) const { S[((size_t)rc * 16 + g) * 256 + n] = v; } };
__device__ __forceinline__ void ph_s5_scan(const float* SLOC, const float* lamT, float* XP) { PH_IDS;
    GSTRIDE(i, 8 * 16 * 2 * 64) {
        const int b = i / 2048, g = (i / 128) % 16, d = (i / 64) % 2, p = i % 64;
        const float lr = lamT[((size_t)(g * 2 + d) * 64 + p) * 2], li = lamT[((size_t)(g * 2 + d) * 64 + p) * 2 + 1];
        float xr = 0.f, xi = 0.f;
        for (int step = 0; step < 36; ++step) {
            int rc;
            if (d == 0) rc = step < 4 ? 256 + b * 4 + step : b * 32 + (step - 4);
            else rc = step < 4 ? 256 + b * 4 + (3 - step) : b * 32 + (31 - (step - 4));
            const size_t o = ((size_t)rc * 16 + g) * 256 + d * 128;
            XP[o + p] = xr; XP[o + 64 + p] = xi;
            const float sr = SLOC[o + p], si = SLOC[o + 64 + p];
            const float nr = lr * xr - li * xi + sr, ni = lr * xi + li * xr + si; xr = nr; xi = ni;
        }
    }
}
struct A_s5out { const bf16_t* Z; const float* XP;
    __device__ float operator()(int g, int rc, int k) const { return k < 1024 ? bf2f(Z[((size_t)rc * 64 + (k >> 4)) * ZW + C_S5 + g * 16 + (k & 15)]) : XP[((size_t)rc * 16 + g) * 256 + (k - 1024)]; } };
struct B_s5out { const float* TZ; const bf16_t* QO;
    __device__ float operator()(int g, int k, int n) const { if (k < 1024) { const int s = k >> 4, hp = k & 15, t = n >> 4, h = n & 15; return TZ[(((size_t)g * 127 + (t - s + 63)) * 16 + hp) * 16 + h]; } return bf2f(QO[((size_t)g * 256 + (k - 1024)) * 1024 + n]); } };
struct E_s5out { bf16_t* YG; __device__ void operator()(int g, int rc, int n, float v) const { YG[((size_t)rc * 64 + (n >> 4)) * 256 + g * 16 + (n & 15)] = f2bf(geluf_(v)); } };
__device__ __forceinline__ void ph_glu(const bf16_t* GL, bf16_t* Z) { PH_IDS;
    GSTRIDE(gi, RT * 256) {
        const int row = gi >> 8, j = gi & 255;
        const float val = bf2f(GL[(size_t)row * 512 + j]), gate = bf2f(GL[(size_t)row * 512 + 256 + j]);
        Z[(size_t)row * ZW + C_S5 + j] = f2bf(val * sigmoidf_(gate));
    }
}
__device__ __forceinline__ void ph_ret_prep(bf16_t* Z) { PH_IDS;
    GSTRIDE(gi, RT * 4 * 32) {
        const int row = gi >> 7, h = (gi >> 5) & 3, j = gi & 31;
        bf16_t* z = Z + (size_t)row * ZW;
        if (row < RL) {
            const int t = row & 2047; const float fr = exp2f(-(float)j * (13.287712379549449f / 32.f)), a = (float)t * fr, cs = cosf(a), sn = sinf(a);
            { const float x1 = bf2f(z[C_RQ + h * 64 + j]), x2 = bf2f(z[C_RQ + h * 64 + 32 + j]); z[C_RQ + h * 64 + j] = f2bf(x1 * cs - x2 * sn); z[C_RQ + h * 64 + 32 + j] = f2bf(x1 * sn + x2 * cs); }
            { const float x1 = bf2f(z[C_RK + h * 64 + j]), x2 = bf2f(z[C_RK + h * 64 + 32 + j]); z[C_RK + h * 64 + j] = f2bf((x1 * cs - x2 * sn) * 0.125f); z[C_RK + h * 64 + 32 + j] = f2bf((x1 * sn + x2 * cs) * 0.125f); }
        } else {
            z[C_RK + h * 64 + j] = f2bf(bf2f(z[C_RK + h * 64 + j]) * 0.125f); z[C_RK + h * 64 + 32 + j] = f2bf(bf2f(z[C_RK + h * 64 + 32 + j]) * 0.125f);
        }
    }
}
__device__ __forceinline__ void ph_ret(unsigned char* lds, bf16_t* Z, const float* decay_logit, const float* gn_w, int with_ctx) { PH_IDS;
    float (*sK)[64] = (float (*)[64])lds; float (*sV)[64] = (float (*)[64])(lds + 32 * 64 * 4);
    float* sred = (float*)(lds + 2 * 32 * 64 * 4);
    const int nunits = 32 * (8 + (with_ctx ? 1 : 0));
    const int qt = tid_ & 255, hh = tid_ >> 8, dh = hh * 32;
    for (int u = bid_; u < nunits; u += G_) {
        const int bh = u % 32, qb = u / 32, b = bh >> 2, h = bh & 3;
        const bool lat = qb < 8;
        const int qpos = lat ? qb * 256 + qt : qt;
        const int qrow = lat ? b * 2048 + qpos : RL + b * 256 + qpos;
        const float lgf = -log1pf(__expf(-decay_logit[h])) * 1.4426950408889634f, lgb = -log1pf(__expf(-decay_logit[4 + h])) * 1.4426950408889634f;
        float q[64], o[32];
#pragma unroll
        for (int i = 0; i < 64; ++i) q[i] = bf2f(Z[(size_t)qrow * ZW + C_RQ + h * 64 + i]);
#pragma unroll
        for (int i = 0; i < 32; ++i) o[i] = 0.f;
        const int nkeys = lat ? 2560 : 256;
        for (int k0 = 0; k0 < nkeys; k0 += 32) {
            int krow0, kpos0;
            if (lat) { if (k0 < 256) { krow0 = RL + b * 256 + k0; kpos0 = k0 - 256; } else if (k0 < 2304) { krow0 = b * 2048 + (k0 - 256); kpos0 = k0 - 256; } else { krow0 = RL + b * 256 + (k0 - 2304); kpos0 = 2048 + (k0 - 2304); } }
            else { krow0 = RL + b * 256 + k0; kpos0 = k0; }
            __syncthreads();
            for (int e = tid_; e < 32 * 64; e += NT) { const int j = e >> 6, i = e & 63; sK[j][i] = bf2f(Z[(size_t)(krow0 + j) * ZW + C_RK + h * 64 + i]); sV[j][i] = bf2f(Z[(size_t)(krow0 + j) * ZW + C_RV + h * 64 + i]); }
            __syncthreads();
#pragma unroll 1
            for (int j = 0; j < 32; ++j) { float a = 0.f;
#pragma unroll
                for (int i = 0; i < 64; ++i) a += q[i] * sK[j][i];
                const int dpos = qpos - (kpos0 + j);
                const float dec = dpos > 0 ? exp2f(lgf * (float)dpos) : (dpos < 0 ? exp2f(lgb * (float)(-dpos)) : 2.f);
                a *= dec;
#pragma unroll
                for (int i = 0; i < 32; ++i) o[i] += a * sV[j][dh + i]; }
        }
        float s1 = 0.f;
#pragma unroll
        for (int i = 0; i < 32; ++i) s1 += o[i];
        __syncthreads();
        sred[hh * 256 + qt] = s1;
        __syncthreads();
        const float mu = (sred[qt] + sred[256 + qt]) * (1.f / 64);
        float s2 = 0.f;
#pragma unroll
        for (int i = 0; i < 32; ++i) { const float d = o[i] - mu; s2 += d * d; }
        __syncthreads();
        sred[hh * 256 + qt] = s2;
        __syncthreads();
        const float rstd = rsqrtf((sred[qt] + sred[256 + qt]) * (1.f / 64) + EPS);
#pragma unroll
        for (int i = 0; i < 32; ++i) { const float gte = bf2f(Z[(size_t)qrow * ZW + C_RG + h * 64 + dh + i]); const float y = (o[i] - mu) * rstd * gn_w[h * 64 + dh + i];
            Z[(size_t)qrow * ZW + C_RQ + h * 64 + dh + i] = f2bf(siluf_(gte) * y); }
    }
    __syncthreads();
}
struct E_merge { const bf16_t* stash; bf16_t* MMp; long long first;
    __device__ void operator()(int, int m, int n, float v) const { const size_t i = (size_t)m * DM + n; const float t = sigmoidf_(v) * bf2f(stash[i]); MMp[i] = f2bf(first ? t : bf2f(MMp[i]) + t); } };
struct E_resid { const float* xlat; const float* xctx; float* olat; float* octx; const float* mod; long long gchunk;
    __device__ void operator()(int, int m, int n, float v) const {
        const float g = mod[(size_t)row_modidx(m) * 6144 + gchunk * 1024 + n];
        if (m < RL) olat[(size_t)m * DM + n] = xlat[(size_t)m * DM + n] + g * v; else octx[(size_t)(m - RL) * DM + n] = xctx[(size_t)(m - RL) * DM + n] + g * v; } };
struct E_relu2 { bf16_t* H; __device__ void operator()(int, int m, int n, float v) const { const float r = fmaxf(v, 0.f); H[(size_t)m * DFF + n] = f2bf(r * r); } };


__device__ __forceinline__ void ph_s5_sloc(unsigned char* lds_, const bf16_t* Z, const bf16_t* MST, float* SLOC) { PH_IDS;
    const int lane = tid_ & 63, wid = __builtin_amdgcn_readfirstlane(tid_ >> 6), c16 = lane & 15, kq = lane >> 4;
    LAS char* sm = (LAS char*)lds_;
    constexpr int CP = 64 * 32 + 16;
    for (int u = bid_; u < 256; u += G_) {
        const int g = u >> 4, nh = (u >> 3) & 1, sl = u & 7;
        const bf16_t* mp0 = MST + ((size_t)g * 256 + nh * 128 + wid * 16 + c16) * 1024 + 8 * kq;
        bf16x8 a[32];
#pragma unroll
        for (int ks = 0; ks < 32; ++ks) a[ks] = *(const bf16x8*)(mp0 + 32 * ks);
        pg8::u32x4 st[4];
#define SLOC_ISSUE(blk_) do { _Pragma("unroll") for (int i = 0; i < 4; ++i) { const int p = tid_ + NT * i, r = p >> 1, hf = p & 1; \
            st[i] = *(const pg8::u32x4*)(Z + ((size_t)(blk_) * 1024 + r) * ZW + C_S5 + g * 16 + 8 * hf); } } while (0)
        SLOC_ISSUE(sl);
        for (int blk = sl; blk < 18; blk += 8) {
            const int rcbase = blk * 16;
            __syncthreads();
#pragma unroll
            for (int i = 0; i < 4; ++i) { const int p = tid_ + NT * i, r = p >> 1, hf = p & 1; *(LAS pg8::u32x4*)(sm + (r >> 6) * CP + (r & 63) * 32 + hf * 16) = st[i]; }
            if (blk + 8 < 18) SLOC_ISSUE(blk + 8);
            __syncthreads();
            const LAS char* bp = sm + c16 * CP + (kq >> 1) * 32 + (kq & 1) * 16;
            f32x4 acc0 = (f32x4){0.f, 0.f, 0.f, 0.f}, acc1 = acc0;
#pragma unroll
            for (int ks = 0; ks < 32; ks += 2) {
                const bf16x8 b0 = *(const LAS bf16x8*)(bp + ks * 64), b1 = *(const LAS bf16x8*)(bp + (ks + 1) * 64);
                acc0 = __builtin_amdgcn_mfma_f32_16x16x32_bf16(a[ks], b0, acc0, 0, 0, 0);
                acc1 = __builtin_amdgcn_mfma_f32_16x16x32_bf16(a[ks + 1], b1, acc1, 0, 0, 0);
            }
            *(f32x4*)(SLOC + ((size_t)(rcbase + c16) * 16 + g) * 256 + nh * 128 + wid * 16 + 4 * kq) = acc0 + acc1;
        }
#undef SLOC_ISSUE
    }
    __syncthreads();
}
__device__ __forceinline__ void ph_s5_tzb(int l, const float* TZD, const float* s5d, bf16_t* TZB, const float* c_re, const float* c_im, bf16_t* CQ) { PH_IDS;
    GSTRIDE(e, 16 * 16 * 256) { const int g = e >> 12, h = (e >> 8) & 15, n = e & 255, d = n >> 7, im = (n >> 6) & 1, p = n & 63;
        const size_t ci = ((((size_t)(l * 2 + d) * 16 + g) * 16 + h) * 64) + p; CQ[e] = f2bf(im ? -c_im[ci] : c_re[ci]); }
    GSTRIDE(e, 16 * 127 * 64) { const int g = e / (127 * 64), r = e % (127 * 64), dd = r >> 6, h = (r >> 2) & 15, q4 = (r & 3) * 4;
        f32x4 v = (f32x4){0.f, 0.f, 0.f, 0.f};
        if (dd >= 63) v += *(const f32x4*)(TZD + ((((size_t)0 * 16 + g) * 64 + (dd - 63)) * 16 + h) * 16 + q4);
        if (dd <= 63) v += *(const f32x4*)(TZD + ((((size_t)1 * 16 + g) * 64 + (63 - dd)) * 16 + h) * 16 + q4);
        if (dd == 63 && (h >> 2) == (q4 >> 2)) v[h & 3] += s5d[g * 16 + h];
        fa::u32x2 w; w.x = fa::pk2(v[0], v[1]); w.y = fa::pk2(v[2], v[3]);
        *(fa::u32x2*)(TZB + ((size_t)(g * 127 + dd) * 16 + h) * 16 + (((q4 >> 3) ^ (h >> 3)) * 8 + (q4 & 7))) = w; }
}
__device__ __forceinline__ void ph_s5_out(unsigned char* lds_, const bf16_t* Z, const bf16_t* TZB, const bf16_t* CQ, const float2* LP, const float* SLOC, const float* lamT, bf16_t* YG, int nrct, int u0, int ustep) { PH_IDS;
    LAS char* sm = (LAS char*)lds_;
    constexpr int O_TZ = 0, O_XP = 65536, O_U = 73728, UP = 2064, O_SL = O_U + 16 * UP;
    const int lane = tid_ & 63, wid = __builtin_amdgcn_readfirstlane(tid_ >> 6), c16 = lane & 15, kq = lane >> 4;
    for (int u = u0; u < 16 * nrct; u += ustep) {
        const int g = u / nrct, rct = u % nrct, rcbase = rct * 16;
        const bool lat = rct < 16; const int b = rcbase >> 5, c0 = rcbase & 31;
        const int nsl = lat ? 36 : 16;
        pg8::u32x4 sT[8], sU[4]; f32x4 sS[5];
        { const pg8::u32x4* tsrc = (const pg8::u32x4*)(TZB + (size_t)g * 127 * 256);
#pragma unroll
          for (int i_ = 0; i_ < 8; ++i_) { const int e = tid_ + NT * i_; if (e < 127 * 32) sT[i_] = tsrc[e]; }
#pragma unroll
          for (int i_ = 0; i_ < 4; ++i_) { const int e = tid_ + NT * i_, rc = e >> 7, s_ = (e >> 1) & 63, hh = e & 1; sU[i_] = *(const pg8::u32x4*)(Z + ((size_t)(rcbase + rc) * 64 + s_) * ZW + C_S5 + g * 16 + hh * 8); }
#pragma unroll
          for (int i_ = 0; i_ < 5; ++i_) { const int e = tid_ + NT * i_, r = e >> 6, q4 = e & 63; const int rc = lat ? (r < 4 ? 256 + b * 4 + r : b * 32 + (r - 4)) : rcbase + r;
              if (e < nsl * 64) sS[i_] = *(const f32x4*)(SLOC + ((size_t)rc * 16 + g) * 256 + q4 * 4); } }
        typedef float f32x2v __attribute__((ext_vector_type(2)));
        f32x2v sLq[3]; pg8::u32x4 sCq = *(const pg8::u32x4*)(CQ + (size_t)g * 4096 + tid_ * 8);
#pragma unroll
        for (int i_ = 0; i_ < 3; ++i_) { const int e = tid_ + NT * i_;
            if (e < 1152) { const int e2 = e - 128, d_ = e < 128 ? (e >> 6) : ((e2 >> 6) & 1), p_ = e & 63, w_ = e2 >> 7, k_ = e < 128 ? 1 : (d_ == 0 ? 8 * w_ + 1 : 57 - 8 * w_);
                const float2 t_ = LP[(((size_t)d_ * 16 + g) * 64 + p_) * 65 + k_]; sLq[i_] = (f32x2v){t_.x, t_.y}; } }
        __syncthreads();
#pragma unroll
        for (int i_ = 0; i_ < 8; ++i_) { const int e = tid_ + NT * i_; if (e < 127 * 32) *(LAS pg8::u32x4*)(sm + O_TZ + e * 16) = sT[i_]; }
#pragma unroll
        for (int i_ = 0; i_ < 4; ++i_) { const int e = tid_ + NT * i_, rc = e >> 7, s_ = (e >> 1) & 63, hh = e & 1; *(LAS pg8::u32x4*)(sm + O_U + rc * UP + s_ * 32 + hh * 16) = sU[i_]; }
#pragma unroll
        for (int i_ = 0; i_ < 5; ++i_) { const int e = tid_ + NT * i_, r = e >> 6, q4 = e & 63; if (e < nsl * 64) *(LAS f32x4*)(sm + O_SL + r * 1024 + q4 * 16) = sS[i_]; }
        __syncthreads();
        if (tid_ < 128) {
            const int d = tid_ >> 6, p = tid_ & 63;
            const float lr = lamT[((size_t)(g * 2 + d) * 64 + p) * 2], li = lamT[((size_t)(g * 2 + d) * 64 + p) * 2 + 1];
            const LAS float* sl = (const LAS float*)(sm + O_SL) + d * 128 + p;
            LAS bf16_t* xp = (LAS bf16_t*)(sm + O_XP) + d * 128 + p;
            float xr = 0.f, xi = 0.f;
#define S5_STEP(r) do { const float sr = sl[(r) * 256], si = sl[(r) * 256 + 64]; const float nr = lr * xr - li * xi + sr, ni = lr * xi + li * xr + si; xr = nr; xi = ni; } while (0)
            if (lat) {
                if (d == 0) { for (int r = 0; r < 4 + c0; ++r) S5_STEP(r);
                    for (int r = 0; r < 16; ++r) { xp[r * 256] = f2bf(xr); xp[r * 256 + 64] = f2bf(xi); S5_STEP(4 + c0 + r); } }
                else { for (int r = 3; r >= 0; --r) S5_STEP(r);
                    for (int c = 31; c >= c0 + 16; --c) S5_STEP(4 + c);
                    for (int r = 15; r >= 0; --r) { xp[r * 256] = f2bf(xr); xp[r * 256 + 64] = f2bf(xi); S5_STEP(4 + c0 + r); } }
            } else {
                if (d == 0) { for (int r = 0; r < 16; ++r) { if ((r & 3) == 0) { xr = 0.f; xi = 0.f; } xp[r * 256] = f2bf(xr); xp[r * 256 + 64] = f2bf(xi); S5_STEP(r); } }
                else { for (int r = 15; r >= 0; --r) { if ((r & 3) == 3) { xr = 0.f; xi = 0.f; } xp[r * 256] = f2bf(xr); xp[r * 256 + 64] = f2bf(xi); S5_STEP(r); } }
            }
#undef S5_STEP
        }
        __syncthreads();
#pragma unroll
        for (int i_ = 0; i_ < 3; ++i_) { const int e = tid_ + NT * i_; if (e < 1152) *(LAS f32x2v*)(sm + O_SL + e * 8) = sLq[i_]; }
        *(LAS pg8::u32x4*)(sm + O_SL + 9216 + tid_ * 16) = sCq;
        const LAS char* ub = sm + O_U + c16 * UP + kq * 16;
        const LAS char* xb = sm + O_XP + c16 * 512 + kq * 16;
        f32x4 acc8[8];
#pragma unroll
        for (int i = 0; i < 8; ++i) acc8[i] = (f32x4){0.f, 0.f, 0.f, 0.f};
#pragma unroll
        for (int par = 0; par < 2; ++par) {
            const LAS char* fz = sm + O_TZ + ((wid * 8 + par + 63 - (kq >> 1)) * 16 + c16) * 32 + ((kq & 1) ^ (c16 >> 3)) * 16;
            bf16x8 uw[4];
            uw[0] = *(const LAS bf16x8*)(ub); uw[1] = *(const LAS bf16x8*)(ub + 64); uw[2] = *(const LAS bf16x8*)(ub + 128); uw[3] = uw[0];
#pragma unroll
            for (int m = -3; m < 32; ++m) {
                const bf16x8 f = *(const LAS bf16x8*)(fz - m * 1024);
                if (m + 3 < 32) uw[(m + 3) & 3] = *(const LAS bf16x8*)(ub + (m + 3) * 64);
#pragma unroll
                for (int j = 0; j < 4; ++j) { const int ks = m + j; if (ks >= 0 && ks < 32) acc8[par + 2 * j] = __builtin_amdgcn_mfma_f32_16x16x32_bf16(f, uw[ks & 3], acc8[par + 2 * j], 0, 0, 0); }
            }
        }
        __syncthreads();
        {
#pragma unroll
            for (int d = 0; d < 2; ++d)
#pragma unroll 1
            for (int ph = 0; ph < 2; ++ph) {
                asm volatile("" ::: "memory");
                const bf16x8 cqr = *(const LAS bf16x8*)(sm + O_SL + 9216 + (c16 * 256 + 32 * (4 * d + ph) + 8 * kq) * 2), cqi = *(const LAS bf16x8*)(sm + O_SL + 9216 + (c16 * 256 + 32 * (4 * d + 2 + ph) + 8 * kq) * 2);
                const bf16x8 xre = *(const LAS bf16x8*)(xb + (4 * d + ph) * 64), xim = *(const LAS bf16x8*)(xb + (4 * d + 2 + ph) * 64);
                float yr[8], yi[8], lr[8], li[8];
#pragma unroll
                for (int j = 0; j < 8; ++j) {
                    const int p_ = 32 * ph + 8 * kq + j;
                    const f32x2v l1 = *(const LAS f32x2v*)(sm + O_SL + (d * 64 + p_) * 8), ls = *(const LAS f32x2v*)(sm + O_SL + (128 + (wid * 2 + d) * 64 + p_) * 8);
                    const float xr = __uint_as_float((unsigned)(unsigned short)xre[j] << 16), xi = __uint_as_float((unsigned)(unsigned short)xim[j] << 16);
                    yr[j] = ls.x * xr - ls.y * xi; yi[j] = ls.x * xi + ls.y * xr; lr[j] = l1.x; li[j] = l1.y;
                }
#pragma unroll
                for (int s8 = 0; s8 < 8; ++s8) {
                    const int i = d == 0 ? s8 : 7 - s8;
                    const bf16x8 bre = __builtin_bit_cast(bf16x8, pack8((f32x4){yr[0], yr[1], yr[2], yr[3]}, (f32x4){yr[4], yr[5], yr[6], yr[7]}));
                    const bf16x8 bim = __builtin_bit_cast(bf16x8, pack8((f32x4){yi[0], yi[1], yi[2], yi[3]}, (f32x4){yi[4], yi[5], yi[6], yi[7]}));
                    acc8[i] = __builtin_amdgcn_mfma_f32_16x16x32_bf16(cqr, bre, acc8[i], 0, 0, 0);
                    acc8[i] = __builtin_amdgcn_mfma_f32_16x16x32_bf16(cqi, bim, acc8[i], 0, 0, 0);
                    if (s8 < 7) {
#pragma unroll
                        for (int j = 0; j < 8; ++j) { const float a = yr[j], c = yi[j]; yr[j] = lr[j] * a - li[j] * c; yi[j] = lr[j] * c + li[j] * a; }
                    }
                }
            }
        }
#pragma unroll
        for (int i = 0; i < 8; ++i) { const int t = wid * 8 + i;
            fa::u32x2 w; w.x = fa::pk2(geluf_(acc8[i][0]), geluf_(acc8[i][1])); w.y = fa::pk2(geluf_(acc8[i][2]), geluf_(acc8[i][3]));
            *(fa::u32x2*)(YG + ((size_t)(rcbase + c16) * 64 + t) * ZW + C_S5 + g * 16 + 4 * kq) = w; }
    }
    __syncthreads();
}
__device__ __forceinline__ void rope16(float (&v)[4], int kq, float pos, bool on) {
#pragma unroll
    for (int r = 0; r < 4; ++r) {
        const int j = (4 * kq + r) & 7;
        const float ang = pos * exp2f(-(float)j * (13.287712379549449f / 8.f)), cs = __cosf(ang), sn = __sinf(ang);
        const float other = __shfl_xor(v[r], 32);
        const float rot = kq < 2 ? v[r] * cs - other * sn : other * sn + v[r] * cs;
        v[r] = on ? rot : v[r];
    }
}
__device__ __forceinline__ void ph_prep(bf16_t* Z, const bf16_t* WUQ, const bf16_t* WUKV, const bf16_t* D64, const float* qkq, const float* qkk,
                                        bf16_t* Q, bf16_t* Kb, bf16_t* Vb, bf16_t* F1lat, bf16_t* F1ctx, unsigned char* lds_) { PH_IDS;
    const int lane = tid_ & 63, wid = __builtin_amdgcn_readfirstlane(tid_ >> 6), c16 = lane & 15, kq = lane >> 4;
    LAS char* sm = (LAS char*)lds_;
    constexpr int P_KV = 336, P_QC = 528, O_KV = 0, O_QC = 24576, O_FU = 63488;
    for (int blk = bid_; blk < RT / 72; blk += G_) {
        const int row0 = blk * 72;
        __syncthreads();
#pragma unroll 1
        for (int hf = 0; hf < 3; ++hf) { pg8::u32x4 st[4];
#pragma unroll
          for (int i = 0; i < 4; ++i) { const int e = tid_ + NT * (4 * hf + i);
              if (e < 1440) st[i] = *(const pg8::u32x4*)(Z + (size_t)(row0 + e / 20) * ZW + C_KVC + (e % 20) * 8);
              else if (e < 3744) st[i] = *(const pg8::u32x4*)(Z + (size_t)(row0 + ((e - 1440) >> 5)) * ZW + C_QC + ((e - 1440) & 31) * 8);
              else if (e < 6048) st[i] = *(const pg8::u32x4*)(Z + (size_t)(row0 + ((e - 3744) >> 5)) * ZW + C_FU + ((e - 3744) & 31) * 8); }
#pragma unroll
          for (int i = 0; i < 4; ++i) { const int e = tid_ + NT * (4 * hf + i);
              if (e < 1440) *(LAS pg8::u32x4*)(sm + O_KV + (e / 20) * P_KV + (e % 20) * 16) = st[i];
              else if (e < 3744) *(LAS pg8::u32x4*)(sm + O_QC + ((e - 1440) >> 5) * P_QC + ((e - 1440) & 31) * 16) = st[i];
              else if (e < 6048) *(LAS pg8::u32x4*)(sm + O_FU + ((e - 3744) >> 5) * P_QC + ((e - 3744) & 31) * 16) = st[i]; } }
        __syncthreads();
#pragma unroll 1
      for (int pass3 = 0; pass3 < 2; ++pass3) {
        int rowc[3], rl[3]; bool valid[3];
#pragma unroll
        for (int tt = 0; tt < 3; ++tt) { const int o = 16 * (3 * pass3 + tt) + c16; valid[tt] = o < 72; rl[tt] = valid[tt] ? o : 71; rowc[tt] = row0 + rl[tt]; }
        if (wid < 4) {
            const int h = wid;
            f32x4 acc[6][3]; float ssq[3];
#pragma unroll
            for (int tt = 0; tt < 3; ++tt) { ssq[tt] = 0.f;
#pragma unroll
                for (int nt = 0; nt < 6; ++nt) acc[nt][tt] = (f32x4){0.f, 0.f, 0.f, 0.f}; }
#pragma unroll 4
            for (int ks = 0; ks < 8; ++ks) {
                bf16x8 bq[3], aw[6];
#pragma unroll
                for (int tt = 0; tt < 3; ++tt) { bq[tt] = *(const LAS bf16x8*)(sm + O_QC + rl[tt] * P_QC + (32 * ks + 8 * kq) * 2);
#pragma unroll
                    for (int e = 0; e < 8; ++e) { const float f = bf2f((bf16_t)bq[tt][e]); ssq[tt] += f * f; } }
#pragma unroll
                for (int nt = 0; nt < 6; ++nt) aw[nt] = *(const bf16x8*)(WUQ + (size_t)(h * 96 + 16 * nt + c16) * 256 + 32 * ks + 8 * kq);
#pragma unroll
                for (int nt = 0; nt < 6; ++nt)
#pragma unroll
                    for (int tt = 0; tt < 3; ++tt) acc[nt][tt] = __builtin_amdgcn_mfma_f32_16x16x32_bf16(aw[nt], bq[tt], acc[nt][tt], 0, 0, 0);
            }
#pragma unroll
            for (int tt = 0; tt < 3; ++tt) {
                float s1 = ssq[tt]; s1 += __shfl_xor(s1, 16); s1 += __shfl_xor(s1, 32);
                const float rstd = rsqrtf(s1 * (1.f / 256) + EPS);
                float ss = 0.f;
#pragma unroll
                for (int nt = 0; nt < 6; ++nt)
#pragma unroll
                    for (int r = 0; r < 4; ++r) ss += acc[nt][tt][r] * acc[nt][tt][r];
                ss += __shfl_xor(ss, 16); ss += __shfl_xor(ss, 32);
                const float fac = rstd * rsqrtf(rstd * rstd * ss * (1.f / 96) + EPS) * 0.14724727430627066f;
                const int row = rowc[tt]; const bool lat = row < RL; const int b = row_batch(row), t = lat ? (row & 2047) : ((row - RL) & 255), qi = lat ? t : 2048 + t;
                bf16_t* qo = Q + ((size_t)(b * 4 + h) * 2304 + qi) * 96 + 4 * kq;
#pragma unroll
                for (int nt = 0; nt < 6; ++nt) {
                    const f32x4 w = *(const f32x4*)(qkq + 16 * nt + 4 * kq);
                    float v[4];
#pragma unroll
                    for (int r = 0; r < 4; ++r) v[r] = acc[nt][tt][r] * fac * w[r];
                    if (nt >= 4) rope16(v, kq, nt == 4 ? (float)(t >> 6) : (float)(t & 63), lat);
                    fa::u32x2 o; o.x = fa::pk2(v[0], v[1]); o.y = fa::pk2(v[2], v[3]);
                    if (valid[tt]) *(fa::u32x2*)(qo + 16 * nt) = o;
                }
            }
        } else {
            const int h = wid - 4;
            float ssq[3], rstd[3];
#pragma unroll
            for (int tt = 0; tt < 3; ++tt) ssq[tt] = 0.f;
#pragma unroll 1
            for (int pass = 0; pass < 2; ++pass) {
                f32x4 acc[4][3];
#pragma unroll
                for (int tt = 0; tt < 3; ++tt)
#pragma unroll
                    for (int nt = 0; nt < 4; ++nt) acc[nt][tt] = (f32x4){0.f, 0.f, 0.f, 0.f};
#pragma unroll
                for (int ks = 0; ks < 4; ++ks) {
                    bf16x8 bq[3], aw[4];
#pragma unroll
                    for (int tt = 0; tt < 3; ++tt) { bq[tt] = *(const LAS bf16x8*)(sm + O_KV + rl[tt] * P_KV + (32 * ks + 8 * kq) * 2);
                        if (pass == 0) {
#pragma unroll
                            for (int e = 0; e < 8; ++e) { const float f = bf2f((bf16_t)bq[tt][e]); ssq[tt] += f * f; } } }
#pragma unroll
                    for (int nt = 0; nt < 4; ++nt) aw[nt] = *(const bf16x8*)(WUKV + (size_t)(h * 128 + pass * 64 + 16 * nt + c16) * 128 + 32 * ks + 8 * kq);
#pragma unroll
                    for (int nt = 0; nt < 4; ++nt)
#pragma unroll
                        for (int tt = 0; tt < 3; ++tt) acc[nt][tt] = __builtin_amdgcn_mfma_f32_16x16x32_bf16(aw[nt], bq[tt], acc[nt][tt], 0, 0, 0);
                }
#pragma unroll
                for (int tt = 0; tt < 3; ++tt) {
                    const int row = rowc[tt]; const bool lat = row < RL; const int b = row_batch(row), t = lat ? (row & 2047) : ((row - RL) & 255), ki = lat ? 256 + t : t;
                    if (pass == 0) {
                        float s1 = ssq[tt]; s1 += __shfl_xor(s1, 16); s1 += __shfl_xor(s1, 32);
                        rstd[tt] = rsqrtf(s1 * (1.f / 128) + EPS);
                        float kr[2][4];
#pragma unroll
                        for (int e = 0; e < 2; ++e) { const fa::u32x2 w = *(const LAS fa::u32x2*)(sm + O_KV + rl[tt] * P_KV + (128 + 16 * e + 4 * kq) * 2);
                            kr[e][0] = __uint_as_float(w.x << 16); kr[e][1] = __uint_as_float(w.x & 0xffff0000u); kr[e][2] = __uint_as_float(w.y << 16); kr[e][3] = __uint_as_float(w.y & 0xffff0000u); }
                        float ss = 0.f;
#pragma unroll
                        for (int nt = 0; nt < 4; ++nt)
#pragma unroll
                            for (int r = 0; r < 4; ++r) { acc[nt][tt][r] *= rstd[tt]; ss += acc[nt][tt][r] * acc[nt][tt][r]; }
#pragma unroll
                        for (int e = 0; e < 2; ++e)
#pragma unroll
                            for (int r = 0; r < 4; ++r) ss += kr[e][r] * kr[e][r];
                        ss += __shfl_xor(ss, 16); ss += __shfl_xor(ss, 32);
                        const float fac = rsqrtf(ss * (1.f / 96) + EPS);
                        bf16_t* ko = Kb + ((size_t)(b * 4 + h) * 2304 + ki) * 96 + 4 * kq;
#pragma unroll
                        for (int nt = 0; nt < 6; ++nt) {
                            const f32x4 w = *(const f32x4*)(qkk + 16 * nt + 4 * kq);
                            float v[4];
#pragma unroll
                            for (int r = 0; r < 4; ++r) v[r] = (nt < 4 ? acc[nt < 4 ? nt : 0][tt][r] : kr[nt < 4 ? 0 : nt - 4][r]) * fac * w[r];
                            if (nt >= 4) rope16(v, kq, nt == 4 ? (float)(t >> 6) : (float)(t & 63), lat);
                            fa::u32x2 o; o.x = fa::pk2(v[0], v[1]); o.y = fa::pk2(v[2], v[3]);
                            if (valid[tt]) *(fa::u32x2*)(ko + 16 * nt) = o;
                        }
                    } else {
                        bf16_t* vo = Vb + ((size_t)(b * 4 + h) * 2304 + ki) * 64 + 4 * kq;
#pragma unroll
                        for (int nt = 0; nt < 4; ++nt) { fa::u32x2 o; o.x = fa::pk2(acc[nt][tt][0] * rstd[tt], acc[nt][tt][1] * rstd[tt]); o.y = fa::pk2(acc[nt][tt][2] * rstd[tt], acc[nt][tt][3] * rstd[tt]);
                            if (valid[tt]) *(fa::u32x2*)(vo + 16 * nt) = o; }
                    }
                }
            }
        }
        {
            const int g = wid >> 1, part = wid & 1;
            f32x4 acc[4][3];
#pragma unroll
            for (int tt = 0; tt < 3; ++tt)
#pragma unroll
                for (int nt = 0; nt < 4; ++nt) acc[nt][tt] = (f32x4){0.f, 0.f, 0.f, 0.f};
#pragma unroll
            for (int ks = 0; ks < 2; ++ks) {
                bf16x8 au[3], bd[4];
#pragma unroll
                for (int tt = 0; tt < 3; ++tt) au[tt] = *(const LAS bf16x8*)(sm + O_FU + rl[tt] * P_QC + (g * 64 + 32 * ks + 8 * kq) * 2);
#pragma unroll
                for (int nt = 0; nt < 4; ++nt) bd[nt] = *(const bf16x8*)(D64 + (size_t)(part * 64 + 16 * nt + c16) * 64 + 32 * ks + 8 * kq);
#pragma unroll
                for (int nt = 0; nt < 4; ++nt)
#pragma unroll
                    for (int tt = 0; tt < 3; ++tt) acc[nt][tt] = __builtin_amdgcn_mfma_f32_16x16x32_bf16(au[tt], bd[nt], acc[nt][tt], 0, 0, 0);
            }
#pragma unroll
            for (int tt = 0; tt < 3; ++tt) {
                const int o4 = 16 * (3 * pass3 + tt) + 4 * kq; const int trow = row0 + o4;
                if (o4 < 72) {
                    const bool lat = trow < RL;
#pragma unroll
                    for (int nt = 0; nt < 4; ++nt) {
                        const int gm = g * 64 + 16 * nt + c16;
                        fa::u32x2 o; o.x = fa::pk2(acc[nt][tt][0], acc[nt][tt][1]); o.y = fa::pk2(acc[nt][tt][2], acc[nt][tt][3]);
                        if (lat) { const int b = trow >> 11, t0 = trow & 2047; *(fa::u32x2*)(F1lat + ((size_t)(b * 256 + gm) * 2 + part) * 2048 + t0) = o; }
                        else { const int rr = trow - RL, b = rr >> 8, t0 = rr & 255; *(fa::u32x2*)(F1ctx + ((size_t)(b * 256 + gm) * 2 + part) * 256 + t0) = o; }
                    }
                }
            }
        }
      }
#pragma unroll 1
        for (int it = tid_; it < 72 * 16; it += NT) {
            const int row = row0 + (it >> 4), h = (it >> 2) & 3, jg = it & 3;
            bf16_t* zq = Z + (size_t)row * ZW + C_RQ + h * 64 + 8 * jg; bf16_t* zk = Z + (size_t)row * ZW + C_RK + h * 64 + 8 * jg;
            const fa::u32x4 k1 = *(const fa::u32x4*)zk, k2 = *(const fa::u32x4*)(zk + 32);
            f32x4 ka, kb, kc, kd; unpack8(k1, ka, kb); unpack8(k2, kc, kd);
            if (row < RL) {
                const fa::u32x4 q1 = *(const fa::u32x4*)zq, q2 = *(const fa::u32x4*)(zq + 32);
                f32x4 qa, qb, qc, qd; unpack8(q1, qa, qb); unpack8(q2, qc, qd);
                const float tpos = (float)(row & 2047);
                float x1q[8] = {qa[0], qa[1], qa[2], qa[3], qb[0], qb[1], qb[2], qb[3]}, x2q[8] = {qc[0], qc[1], qc[2], qc[3], qd[0], qd[1], qd[2], qd[3]};
                float x1k[8] = {ka[0], ka[1], ka[2], ka[3], kb[0], kb[1], kb[2], kb[3]}, x2k[8] = {kc[0], kc[1], kc[2], kc[3], kd[0], kd[1], kd[2], kd[3]};
#pragma unroll
                for (int e = 0; e < 8; ++e) {
                    float rev = tpos * (__builtin_amdgcn_exp2f(-(float)(8 * jg + e) * (13.287712379549449f / 32.f)) * 0.15915494309189535f); rev -= floorf(rev);
                    const float cs = __builtin_amdgcn_cosf(rev), sn = __builtin_amdgcn_sinf(rev);
                    const float a = x1q[e], c = x2q[e]; x1q[e] = a * cs - c * sn; x2q[e] = a * sn + c * cs;
                    const float a2 = x1k[e], c2 = x2k[e]; x1k[e] = (a2 * cs - c2 * sn) * 0.125f; x2k[e] = (a2 * sn + c2 * cs) * 0.125f;
                }
                *(fa::u32x4*)zq = pack8((f32x4){x1q[0], x1q[1], x1q[2], x1q[3]}, (f32x4){x1q[4], x1q[5], x1q[6], x1q[7]});
                *(fa::u32x4*)(zq + 32) = pack8((f32x4){x2q[0], x2q[1], x2q[2], x2q[3]}, (f32x4){x2q[4], x2q[5], x2q[6], x2q[7]});
                *(fa::u32x4*)zk = pack8((f32x4){x1k[0], x1k[1], x1k[2], x1k[3]}, (f32x4){x1k[4], x1k[5], x1k[6], x1k[7]});
                *(fa::u32x4*)(zk + 32) = pack8((f32x4){x2k[0], x2k[1], x2k[2], x2k[3]}, (f32x4){x2k[4], x2k[5], x2k[6], x2k[7]});
            } else {
                *(fa::u32x4*)zk = pack8(ka * 0.125f, kb * 0.125f); *(fa::u32x4*)(zk + 32) = pack8(kc * 0.125f, kd * 0.125f);
            }
        }
    }
}

__device__ __forceinline__ void attn_tile(const LAS char* sm, int r32, int hi, int vrd, int buf, bool first, const bf16x8 (&qf)[6], fa::f32x16& negm, float& mrun, float& lsum, fa::f32x16& o0, fa::f32x16& o1) {
    using namespace fa;
    const LAS char* kb = sm + buf + r32 * KP_A + 16 * hi;
    f32x16 p0 = negm, p1 = negm;
#pragma unroll
    for (int st = 0; st < 6; ++st) {
        const bf16x8 k0 = *(const LAS bf16x8*)(kb + 32 * st), k1 = *(const LAS bf16x8*)(kb + 32 * KP_A + 32 * st);
        p0 = __builtin_amdgcn_mfma_f32_32x32x16_bf16(k0, qf[st], p0, 0, 0, 0);
        p1 = __builtin_amdgcn_mfma_f32_32x32x16_bf16(k1, qf[st], p1, 0, 0, 0);
    }
    float ta = fmaxf(fmaxf(p0[0], p0[1]), p1[0]), tb = fmaxf(fmaxf(p0[2], p0[3]), p1[1]);
    ta = fmaxf(fmaxf(ta, p1[2]), p1[3]);
#pragma unroll
    for (int r = 4; r < 16; r += 4) { ta = fmaxf(fmaxf(ta, p0[r]), p0[r + 1]); tb = fmaxf(fmaxf(tb, p0[r + 2]), p0[r + 3]); ta = fmaxf(fmaxf(ta, p1[r]), p1[r + 1]); tb = fmaxf(fmaxf(tb, p1[r + 2]), p1[r + 3]); }
    float tm = fmaxf(ta, tb);
    tm = fmaxf(tm, __shfl_xor(tm, 32));
    if (first || __any(tm > 0.f)) {
        const float dl = first ? tm : fmaxf(tm, 0.f), alpha = first ? 1.f : __builtin_amdgcn_exp2f(-dl);
        mrun += dl; lsum *= alpha;
#pragma unroll
        for (int r = 0; r < 16; ++r) { p0[r] -= dl; p1[r] -= dl; o0[r] *= alpha; o1[r] *= alpha; negm[r] = -mrun; }
    }
    float ps = 0.f, ps2 = 0.f;
#pragma unroll
    for (int r = 0; r < 16; ++r) { p0[r] = __builtin_amdgcn_exp2f(p0[r]); p1[r] = __builtin_amdgcn_exp2f(p1[r]); ps += p0[r]; ps2 += p1[r]; }
    lsum += ps + ps2;
    bf16x8 pf[4]; pf[0] = pack_p(p0, 0); pf[1] = pack_p(p0, 8); pf[2] = pack_p(p1, 0); pf[3] = pack_p(p1, 8);
    pv_tile(o0, o1, sm + buf + vrd, pf);
}
__device__ __forceinline__ void attn_pair(const LAS char* sm, int r32, int hi, int vrd, int bufA, int bufB, bool first, const bf16x8 (&qf)[6], fa::f32x16& negm, float& mrun, float& lsum, fa::f32x16& o0, fa::f32x16& o1) {
    using namespace fa;
    const LAS char* ka = sm + bufA + r32 * KP_A + 16 * hi; const LAS char* kb = sm + bufB + r32 * KP_A + 16 * hi;
    f32x16 a0 = negm, a1 = negm, b0 = negm, b1 = negm;
#pragma unroll
    for (int st = 0; st < 6; ++st) {
        const bf16x8 k0 = *(const LAS bf16x8*)(ka + 32 * st), k1 = *(const LAS bf16x8*)(ka + 32 * KP_A + 32 * st);
        a0 = __builtin_amdgcn_mfma_f32_32x32x16_bf16(k0, qf[st], a0, 0, 0, 0);
        a1 = __builtin_amdgcn_mfma_f32_32x32x16_bf16(k1, qf[st], a1, 0, 0, 0);
    }
    float carry = 0.f;
    {
        float ta = fmaxf(fmaxf(a0[0], a0[1]), a1[0]), tb = fmaxf(fmaxf(a0[2], a0[3]), a1[1]);
        ta = fmaxf(fmaxf(ta, a1[2]), a1[3]);
#pragma unroll
        for (int r = 4; r < 16; r += 4) { ta = fmaxf(fmaxf(ta, a0[r]), a0[r + 1]); tb = fmaxf(fmaxf(tb, a0[r + 2]), a0[r + 3]); ta = fmaxf(fmaxf(ta, a1[r]), a1[r + 1]); tb = fmaxf(fmaxf(tb, a1[r + 2]), a1[r + 3]); }
        float tm = fmaxf(ta, tb);
        tm = fmaxf(tm, __shfl_xor(tm, 32));
        if (first || __any(tm > 0.f)) {
            const float dl = first ? tm : fmaxf(tm, 0.f), alpha = first ? 1.f : __builtin_amdgcn_exp2f(-dl);
            mrun += dl; lsum *= alpha; carry = dl;
#pragma unroll
            for (int r = 0; r < 16; ++r) { a0[r] -= dl; a1[r] -= dl; o0[r] *= alpha; o1[r] *= alpha; negm[r] = -mrun; }
        }
    }
#pragma unroll
    for (int st = 0; st < 6; ++st) {
        const bf16x8 k0 = *(const LAS bf16x8*)(kb + 32 * st), k1 = *(const LAS bf16x8*)(kb + 32 * KP_A + 32 * st);
        b0 = __builtin_amdgcn_mfma_f32_32x32x16_bf16(k0, qf[st], b0, 0, 0, 0);
        b1 = __builtin_amdgcn_mfma_f32_32x32x16_bf16(k1, qf[st], b1, 0, 0, 0);
    }
    float ps = 0.f, ps2 = 0.f;
#pragma unroll
    for (int r = 0; r < 16; ++r) { a0[r] = __builtin_amdgcn_exp2f(a0[r]); a1[r] = __builtin_amdgcn_exp2f(a1[r]); ps += a0[r]; ps2 += a1[r]; }
    lsum += ps + ps2;
    bf16x8 pf[4]; pf[0] = pack_p(a0, 0); pf[1] = pack_p(a0, 8); pf[2] = pack_p(a1, 0); pf[3] = pack_p(a1, 8);
    pv_tile(o0, o1, sm + bufA + vrd, pf);
    {
        float ta = fmaxf(fmaxf(b0[0], b0[1]), b1[0]), tb = fmaxf(fmaxf(b0[2], b0[3]), b1[1]);
        ta = fmaxf(fmaxf(ta, b1[2]), b1[3]);
#pragma unroll
        for (int r = 4; r < 16; r += 4) { ta = fmaxf(fmaxf(ta, b0[r]), b0[r + 1]); tb = fmaxf(fmaxf(tb, b0[r + 2]), b0[r + 3]); ta = fmaxf(fmaxf(ta, b1[r]), b1[r + 1]); tb = fmaxf(fmaxf(tb, b1[r + 2]), b1[r + 3]); }
        float tm = fmaxf(ta, tb) - carry;
        tm = fmaxf(tm, __shfl_xor(tm, 32));
        if (__any(tm > 0.f) || __any(carry != 0.f)) {
            const float dl = fmaxf(tm, 0.f), alpha = __builtin_amdgcn_exp2f(-dl), sh = carry + dl;
            mrun += dl; lsum *= alpha;
#pragma unroll
            for (int r = 0; r < 16; ++r) { b0[r] -= sh; b1[r] -= sh; o0[r] *= alpha; o1[r] *= alpha; negm[r] = -mrun; }
        }
    }
    ps = 0.f; ps2 = 0.f;
#pragma unroll
    for (int r = 0; r < 16; ++r) { b0[r] = __builtin_amdgcn_exp2f(b0[r]); b1[r] = __builtin_amdgcn_exp2f(b1[r]); ps += b0[r]; ps2 += b1[r]; }
    lsum += ps + ps2;
    pf[0] = pack_p(b0, 0); pf[1] = pack_p(b0, 8); pf[2] = pack_p(b1, 0); pf[3] = pack_p(b1, 8);
    pv_tile(o0, o1, sm + bufB + vrd, pf);
}
__device__ __forceinline__ float vadd1(float a, float b) { float r; asm("v_add_f32 %0, %1, %2" : "=v"(r) : "v"(a), "v"(b)); return r; }
__device__ __forceinline__ float att_max(const fa::f32x16& p0, const fa::f32x16& p1) {
    float ta = fmaxf(fmaxf(p0[0], p0[1]), p1[0]), tb = fmaxf(fmaxf(p0[2], p0[3]), p1[1]);
    ta = fmaxf(fmaxf(ta, p1[2]), p1[3]);
#pragma unroll
    for (int r = 4; r < 16; r += 4) { ta = fmaxf(fmaxf(ta, p0[r]), p0[r + 1]); tb = fmaxf(fmaxf(tb, p0[r + 2]), p0[r + 3]); ta = fmaxf(fmaxf(ta, p1[r]), p1[r + 1]); tb = fmaxf(fmaxf(tb, p1[r + 2]), p1[r + 3]); }
    return fmaxf(ta, tb);
}
__device__ __forceinline__ void att_shift(float tm, bool first, float& mrun, float& lsum, fa::f32x16& o0, fa::f32x16& o1) {
    tm = fmaxf(tm, __shfl_xor(tm, 32));
    if (first || __any(tm > mrun + 8.f)) {
        const float dl = first ? 0.f : fmaxf(tm - mrun, 0.f), alpha = __builtin_amdgcn_exp2f(-dl);
        mrun = first ? tm : mrun + dl; lsum *= alpha;
#pragma unroll
        for (int r = 0; r < 16; ++r) { o0[r] *= alpha; o1[r] *= alpha; }
    }
}
__device__ __forceinline__ void att_qk_exp(const LAS char* kb, const bf16x8 (&qf)[6], float nm, fa::f32x16& n0, fa::f32x16& n1, fa::f32x16& p0, fa::f32x16& p1, float& lsum, bf16x8 (&pf)[4]) {
    const fa::f32x16 zero = {0.f, 0.f, 0.f, 0.f, 0.f, 0.f, 0.f, 0.f, 0.f, 0.f, 0.f, 0.f, 0.f, 0.f, 0.f, 0.f};
    bf16x8 kc0 = *(const LAS bf16x8*)kb, kc1 = *(const LAS bf16x8*)(kb + 32 * fa::KP_A);
    float ps = 0.f, ps2 = 0.f;
#pragma unroll
    for (int st = 0; st < 6; ++st) {
        bf16x8 kn0 = kc0, kn1 = kc1;
        if (st < 5) { kn0 = *(const LAS bf16x8*)(kb + 32 * (st + 1)); kn1 = *(const LAS bf16x8*)(kb + 32 * fa::KP_A + 32 * (st + 1)); }
        n0 = __builtin_amdgcn_mfma_f32_32x32x16_bf16(kc0, qf[st], st == 0 ? zero : n0, 0, 0, 0);
        n1 = __builtin_amdgcn_mfma_f32_32x32x16_bf16(kc1, qf[st], st == 0 ? zero : n1, 0, 0, 0);
        constexpr int lo[7] = {0, 2, 6, 8, 10, 14, 16};
#pragma unroll
        for (int r = lo[st]; r < lo[st + 1]; ++r) {
            p0[r] = __builtin_amdgcn_exp2f(vadd1(p0[r], nm)); p1[r] = __builtin_amdgcn_exp2f(vadd1(p1[r], nm));
            ps += p0[r]; ps += p1[r]; }
        kc0 = kn0; kc1 = kn1;
        __builtin_amdgcn_sched_barrier(0);
    }
    lsum += ps + ps2;
    pf[0] = fa::pack_p(p0, 0); pf[1] = fa::pack_p(p0, 8); pf[2] = fa::pack_p(p1, 0); pf[3] = fa::pack_p(p1, 8);
}
__device__ __forceinline__ void att_exp_pack(fa::f32x16& p0, fa::f32x16& p1, float nm, float& lsum, bf16x8 (&pf)[4]) {
    float ps = 0.f, ps2 = 0.f;
#pragma unroll
    for (int r = 0; r < 16; ++r) { p0[r] = __builtin_amdgcn_exp2f(vadd1(p0[r], nm)); p1[r] = __builtin_amdgcn_exp2f(vadd1(p1[r], nm)); ps += p0[r]; ps += p1[r]; }
    lsum += ps + ps2;
    pf[0] = fa::pack_p(p0, 0); pf[1] = fa::pack_p(p0, 8); pf[2] = fa::pack_p(p1, 0); pf[3] = fa::pack_p(p1, 8);
}
__device__ __forceinline__ float att_pv_max(fa::f32x16& o0, fa::f32x16& o1, const LAS char* vb, const bf16x8 (&pf)[4], const fa::f32x16& n0, const fa::f32x16& n1) {
    using namespace fa;
    float ta = n0[0], tb = n1[0];
    s16x4 a0 = vtr(vb), a1 = vtr(vb + 512), b0 = vtr(vb + 4096), b1 = vtr(vb + 4096 + 512);
#pragma unroll
    for (int ks = 0; ks < 4; ++ks) {
        s16x4 na0 = a0, na1 = a1, nb0 = b0, nb1 = b1;
        if (ks < 3) { na0 = vtr(vb + (ks + 1) * 1024); na1 = vtr(vb + (ks + 1) * 1024 + 512); nb0 = vtr(vb + 4096 + (ks + 1) * 1024); nb1 = vtr(vb + 4096 + (ks + 1) * 1024 + 512); }
        const bf16x8 v0 = (bf16x8){a0[0], a0[1], a0[2], a0[3], a1[0], a1[1], a1[2], a1[3]}, v1 = (bf16x8){b0[0], b0[1], b0[2], b0[3], b1[0], b1[1], b1[2], b1[3]};
        o0 = __builtin_amdgcn_mfma_f32_32x32x16_bf16(v0, pf[ks], o0, 0, 0, 0);
        o1 = __builtin_amdgcn_mfma_f32_32x32x16_bf16(v1, pf[ks], o1, 0, 0, 0);
#pragma unroll
        for (int r = 4 * ks; r < 4 * ks + 4; ++r) { ta = fmaxf(ta, n0[r]); tb = fmaxf(tb, n1[r]); }
        a0 = na0; a1 = na1; b0 = nb0; b1 = nb1;
        __builtin_amdgcn_sched_barrier(0);
    }
    return fmaxf(ta, tb);
}
__device__ __forceinline__ void ph_attn_mfma(unsigned char* lds_, const bf16_t* Q, const bf16_t* Kb, const bf16_t* Vb, bf16_t* Z, int with_ctx, int u0, int ustep) { PH_IDS;
    using namespace fa;
    LAS char* sm = (LAS char*)lds_;
    const int lane = tid_ & 63, wid = __builtin_amdgcn_readfirstlane(tid_ >> 6), r32 = lane & 31, hi = lane >> 5;
    const int nunits = 256 + (with_ctx ? 32 : 0);
    const int koff0 = (tid_ / 12) * KP_A + (tid_ % 12) * 16, koff1 = ((tid_ + 512) / 12) * KP_A + ((tid_ + 512) % 12) * 16;
    const int voff = KT_A + ((tid_ & 7) >> 2) * 4096 + (tid_ >> 3) * 64 + (tid_ & 3) * 16;
    const int vrd = KT_A + ((lane >> 4) & 1) * 32 + (lane & 3) * 8 + (4 * hi + ((lane & 15) >> 2)) * 64;
    for (int u = u0; u < nunits; u += ustep) {
        const bool lat = u < 256; const int bh = lat ? (u >> 3) : (u - 256), qb = lat ? (u & 7) : 8;
        const int ntile = lat ? 36 : 4;
        const char* Kg = (const char*)(Kb + (size_t)bh * 2304 * 96); const char* Vg = (const char*)(Vb + (size_t)bh * 2304 * 64);
        const bf16_t* Qg = Q + ((size_t)bh * 2304 + qb * 256 + wid * 32 + r32) * 96;
        bf16x8 qf[6];
#pragma unroll
        for (int st = 0; st < 6; ++st) qf[st] = *(const bf16x8*)(Qg + 16 * st + 8 * hi);
        f32x16 o0, o1;
#pragma unroll
        for (int r = 0; r < 16; ++r) { o0[r] = 0.f; o1[r] = 0.f; }
        float mrun = 0.f, lsum = 0.f;
        f32x16 negm;
#pragma unroll
        for (int r = 0; r < 16; ++r) negm[r] = 0.f;
        u32x4 ka0, ka1, va, kb0, kb1, vb;
#define ATT_LOAD(k0_, k1_, v_, tt) do { const char* kg_ = Kg + (size_t)(tt) * 12288; const char* vg_ = Vg + (size_t)(tt) * 8192; \
            k0_ = *(const u32x4*)(kg_ + tid_ * 16); if (tid_ < 256) k1_ = *(const u32x4*)(kg_ + (tid_ + 512) * 16); v_ = *(const u32x4*)(vg_ + tid_ * 16); } while (0)
#define ATT_WRITE(k0_, k1_, v_, bo) do { *(LAS u32x4*)(sm + (bo) + koff0) = k0_; if (tid_ < 256) *(LAS u32x4*)(sm + (bo) + koff1) = k1_; *(LAS u32x4*)(sm + (bo) + voff) = v_; } while (0)
        ka1 = (u32x4){0u, 0u, 0u, 0u}; kb1 = ka1;
        const int npair = ntile >> 1;
        ATT_LOAD(ka0, ka1, va, 0); ATT_LOAD(kb0, kb1, vb, 1);
        __syncthreads();
        ATT_WRITE(ka0, ka1, va, 0); ATT_WRITE(kb0, kb1, vb, BUF_A);
        if (npair > 1) { ATT_LOAD(ka0, ka1, va, 2); ATT_LOAD(kb0, kb1, vb, 3); }
        __syncthreads();
        f32x16 a0, a1, b0, b1;
#pragma unroll
        for (int r = 0; r < 16; ++r) { a0[r] = 0.f; a1[r] = 0.f; }
        { const LAS char* kq0 = sm + r32 * KP_A + 16 * hi;
#pragma unroll
          for (int st = 0; st < 6; ++st) { const bf16x8 k0 = *(const LAS bf16x8*)(kq0 + 32 * st), k1 = *(const LAS bf16x8*)(kq0 + 32 * KP_A + 32 * st);
              a0 = __builtin_amdgcn_mfma_f32_32x32x16_bf16(k0, qf[st], a0, 0, 0, 0); a1 = __builtin_amdgcn_mfma_f32_32x32x16_bf16(k1, qf[st], a1, 0, 0, 0); } }
        float tmA = att_max(a0, a1);
        int cur = 0;
        for (int p = 0; p < npair; ++p) {
            const int nxt = cur == 4 * BUF_A ? 0 : cur + 2 * BUF_A;
            const bool more = p + 1 < npair;
            if (more) { ATT_WRITE(ka0, ka1, va, nxt); ATT_WRITE(kb0, kb1, vb, nxt + BUF_A); }
            if (p + 2 < npair) { ATT_LOAD(ka0, ka1, va, 2 * p + 4); ATT_LOAD(kb0, kb1, vb, 2 * p + 5); }
            bf16x8 pf[4];
            att_shift(tmA, p == 0, mrun, lsum, o0, o1);
            att_qk_exp(sm + cur + BUF_A + r32 * KP_A + 16 * hi, qf, -mrun, b0, b1, a0, a1, lsum, pf);
            const float tmB = att_pv_max(o0, o1, sm + cur + vrd, pf, b0, b1);
            att_shift(tmB, false, mrun, lsum, o0, o1);
            __syncthreads();
            if (more) {
                att_qk_exp(sm + nxt + r32 * KP_A + 16 * hi, qf, -mrun, a0, a1, b0, b1, lsum, pf);
                tmA = att_pv_max(o0, o1, sm + cur + BUF_A + vrd, pf, a0, a1);
            } else {
                att_exp_pack(b0, b1, -mrun, lsum, pf);
                pv_tile(o0, o1, sm + cur + BUF_A + vrd, pf);
            }
            cur = nxt;
        }
#undef ATT_LOAD
#undef ATT_WRITE
        lsum += __shfl_xor(lsum, 32);
        const float inv = 1.f / lsum;
        const int b = bh >> 2, h = bh & 3;
        const int row = (lat ? b * 2048 + qb * 256 : RL + b * 256) + wid * 32 + r32;
        bf16_t* op = Z + (size_t)row * ZW + C_QC + h * 64 + 4 * hi;
#pragma unroll
        for (int g = 0; g < 4; ++g) {
            u32x2 w0, w1; w0.x = pk2(o0[4 * g] * inv, o0[4 * g + 1] * inv); w0.y = pk2(o0[4 * g + 2] * inv, o0[4 * g + 3] * inv);
            w1.x = pk2(o1[4 * g] * inv, o1[4 * g + 1] * inv); w1.y = pk2(o1[4 * g + 2] * inv, o1[4 * g + 3] * inv);
            *(u32x2*)(op + 8 * g) = w0; *(u32x2*)(op + 32 + 8 * g) = w1;
        }
    }
    __syncthreads();
}

__device__ __forceinline__ void ret_tile(const LAS char* sm, int r32, int hi, int vrd, int buf, int kp0, int qw0, int qpos, float lgf, float lgb, float cf32, float cb32,
                                         const float (&ckf)[16], const float (&ckb)[16], const bf16x8 (&qf)[4], fa::f32x16& o0, fa::f32x16& o1) {
    using namespace fa;
    const LAS char* kb = sm + buf + r32 * KP_R + 16 * hi;
    f32x16 p0, p1;
#pragma unroll
    for (int r = 0; r < 16; ++r) { p0[r] = 0.f; p1[r] = 0.f; }
#pragma unroll
    for (int st = 0; st < 4; ++st) {
        const bf16x8 k0 = *(const LAS bf16x8*)(kb + 32 * st), k1 = *(const LAS bf16x8*)(kb + 32 * KP_R + 32 * st);
        p0 = __builtin_amdgcn_mfma_f32_32x32x16_bf16(k0, qf[st], p0, 0, 0, 0);
        p1 = __builtin_amdgcn_mfma_f32_32x32x16_bf16(k1, qf[st], p1, 0, 0, 0);
    }
    if (kp0 + 63 < qw0) {
        const float sq = __builtin_amdgcn_exp2f(lgf * (float)(qpos - kp0)), sq1 = sq * cf32;
#pragma unroll
        for (int r = 0; r < 16; ++r) { p0[r] = p0[r] * ckf[r] * sq; p1[r] = p1[r] * ckf[r] * sq1; }
    } else if (kp0 > qw0 + 31) {
        const float sq = __builtin_amdgcn_exp2f(lgb * (float)(kp0 - qpos)), sq1 = sq * cb32;
#pragma unroll
        for (int r = 0; r < 16; ++r) { p0[r] = p0[r] * ckb[r] * sq; p1[r] = p1[r] * ckb[r] * sq1; }
    } else {
        const int d0 = qpos - kp0 - 4 * hi;
#pragma unroll
        for (int r = 0; r < 16; ++r) {
            const float f0 = (float)(d0 - ((r & 3) + 8 * (r >> 2))), f1 = f0 - 32.f;
            const float w0 = __builtin_amdgcn_exp2f(lgf * fmaxf(f0, 0.f) + lgb * fmaxf(-f0, 0.f)) * (2.f - fminf(fabsf(f0), 1.f));
            const float w1 = __builtin_amdgcn_exp2f(lgf * fmaxf(f1, 0.f) + lgb * fmaxf(-f1, 0.f)) * (2.f - fminf(fabsf(f1), 1.f));
            p0[r] *= w0; p1[r] *= w1;
        }
    }
    bf16x8 pf[4]; pf[0] = pack_p(p0, 0); pf[1] = pack_p(p0, 8); pf[2] = pack_p(p1, 0); pf[3] = pack_p(p1, 8);
    pv_tile(o0, o1, sm + buf + vrd, pf);
}
__device__ __forceinline__ void ret_qk(const LAS char* sm, int r32, int hi, int buf, const bf16x8 (&qf)[4], fa::f32x16& p0, fa::f32x16& p1) {
    const LAS char* kb = sm + buf + r32 * fa::KP_R + 16 * hi;
#pragma unroll
    for (int r = 0; r < 16; ++r) { p0[r] = 0.f; p1[r] = 0.f; }
#pragma unroll
    for (int st = 0; st < 4; ++st) {
        const bf16x8 k0 = *(const LAS bf16x8*)(kb + 32 * st), k1 = *(const LAS bf16x8*)(kb + 32 * fa::KP_R + 32 * st);
        p0 = __builtin_amdgcn_mfma_f32_32x32x16_bf16(k0, qf[st], p0, 0, 0, 0);
        p1 = __builtin_amdgcn_mfma_f32_32x32x16_bf16(k1, qf[st], p1, 0, 0, 0);
    }
}
__device__ __forceinline__ void ret_tile_gen(const LAS char* sm, int r32, int hi, int vrd, int buf, int kp0, int qpos, float lgf, float lgb, const bf16x8 (&qf)[4], fa::f32x16& o0, fa::f32x16& o1) {
    using namespace fa;
    const LAS char* kb = sm + buf + r32 * KP_R + 16 * hi;
    f32x16 p0, p1;
#pragma unroll
    for (int r = 0; r < 16; ++r) { p0[r] = 0.f; p1[r] = 0.f; }
#pragma unroll
    for (int st = 0; st < 4; ++st) {
        const bf16x8 k0 = *(const LAS bf16x8*)(kb + 32 * st), k1 = *(const LAS bf16x8*)(kb + 32 * KP_R + 32 * st);
        p0 = __builtin_amdgcn_mfma_f32_32x32x16_bf16(k0, qf[st], p0, 0, 0, 0);
        p1 = __builtin_amdgcn_mfma_f32_32x32x16_bf16(k1, qf[st], p1, 0, 0, 0);
    }
    int d0 = qpos - kp0 - 4 * hi;
    asm volatile("" : "+v"(d0) : "v"(p0[15]), "v"(p1[15]));
#pragma unroll
    for (int r = 0; r < 16; ++r) {
        const float f0 = (float)(d0 - ((r & 3) + 8 * (r >> 2))), f1 = f0 - 32.f;
        const float w0 = __builtin_amdgcn_exp2f(lgf * fmaxf(f0, 0.f) + lgb * fmaxf(-f0, 0.f)) * (2.f - fminf(fabsf(f0), 1.f));
        const float w1 = __builtin_amdgcn_exp2f(lgf * fmaxf(f1, 0.f) + lgb * fmaxf(-f1, 0.f)) * (2.f - fminf(fabsf(f1), 1.f));
        p0[r] *= w0; p1[r] *= w1;
    }
    bf16x8 pf[4]; pf[0] = pack_p(p0, 0); pf[1] = pack_p(p0, 8); pf[2] = pack_p(p1, 0); pf[3] = pack_p(p1, 8);
    pv_tile(o0, o1, sm + buf + vrd, pf);
}
__device__ __forceinline__ void ph_ret_kv(unsigned char* lds_, const bf16_t* Z, const float* decay_logit, bf16_t* KVF, bf16_t* KVB, int vb, int vg) { PH_IDS;
    using namespace fa;
    LAS char* sm = (LAS char*)lds_;
    const int lane = tid_ & 63, wid = __builtin_amdgcn_readfirstlane(tid_ >> 6), r32 = lane & 31, hi = lane >> 5;
    const int vrd = ((lane >> 4) & 1) * 32 + (lane & 3) * 8 + (4 * hi + ((lane & 15) >> 2)) * 64;
    u32x4 pk[2], pv[2];
#define KV_ISSUE(uu) do { const int bh_ = (uu) / 18, ci_ = (uu) % 18, b_ = bh_ >> 2, h_ = bh_ & 3; const int r0_ = ci_ < 2 ? RL + b_ * 256 + 128 * ci_ : b_ * 2048 + 128 * (ci_ - 2); \
        _Pragma("unroll") for (int i = 0; i < 2; ++i) { const int p = tid_ + NT * i; const bf16_t* zr = Z + (size_t)(r0_ + (p >> 3)) * ZW + h_ * 64 + (p & 7) * 8; pk[i] = *(const u32x4*)(zr + C_RK); pv[i] = *(const u32x4*)(zr + C_RV); } } while (0)
    if (vb >= 0 && vb < 32 * 18) KV_ISSUE(vb);
    for (int u = vb >= 0 ? vb : 32 * 18; u < 32 * 18; u += vg) {
        const int bh = u / 18, h = bh & 3;
        const float lgf = -log1pf(__expf(-decay_logit[h])) * 1.4426950408889634f, lgb = -log1pf(__expf(-decay_logit[4 + h])) * 1.4426950408889634f;
        __syncthreads();
#pragma unroll
        for (int i = 0; i < 2; ++i) {
            const int p = tid_ + NT * i, row = p >> 3, c = p & 7, tile = row >> 6, key = row & 63;
            const int off = tile * 8192 + (c >> 2) * 4096 + key * 64 + (c & 3) * 16;
            *(LAS u32x4*)(sm + off) = pk[i];
            f32x4 va, vb; unpack8(pv[i], va, vb);
            const float wf = __builtin_amdgcn_exp2f(lgf * (float)(127 - row)), wb = __builtin_amdgcn_exp2f(lgb * (float)row);
            *(LAS u32x4*)(sm + 16384 + off) = pack8(va * wf, vb * wf);
            *(LAS u32x4*)(sm + 32768 + off) = pack8(va * wb, vb * wb);
        }
        if (u + vg < 32 * 18) KV_ISSUE(u + vg);
        __syncthreads();
        const int dir = wid >> 2, bd = (wid >> 1) & 1, be = wid & 1;
        f32x16 acc;
#pragma unroll
        for (int r = 0; r < 16; ++r) acc[r] = 0.f;
        const LAS char* ka = sm + bd * 4096 + vrd; const LAS char* vv = sm + 16384 + dir * 16384 + be * 4096 + vrd;
#pragma unroll
        for (int tile = 0; tile < 2; ++tile)
#pragma unroll
            for (int ks = 0; ks < 4; ++ks) {
                const s16x4 a0 = vtr(ka + tile * 8192 + ks * 1024), a1 = vtr(ka + tile * 8192 + ks * 1024 + 512), b0 = vtr(vv + tile * 8192 + ks * 1024), b1 = vtr(vv + tile * 8192 + ks * 1024 + 512);
                acc = __builtin_amdgcn_mfma_f32_32x32x16_bf16((bf16x8){a0[0], a0[1], a0[2], a0[3], a1[0], a1[1], a1[2], a1[3]}, (bf16x8){b0[0], b0[1], b0[2], b0[3], b1[0], b1[1], b1[2], b1[3]}, acc, 0, 0, 0);
            }
        bf16_t* o = (dir ? KVB : KVF) + ((size_t)u * 64 + be * 32 + r32) * 64 + bd * 32 + 4 * hi;
#pragma unroll
        for (int g = 0; g < 4; ++g) { u32x2 w; w.x = pk2n(acc[4 * g], acc[4 * g + 1]); w.y = pk2n(acc[4 * g + 2], acc[4 * g + 3]); *(u32x2*)(o + 8 * g) = w; }
    }
    __syncthreads();
}
#undef KV_ISSUE
__device__ __forceinline__ void ph_ret_chunk(unsigned char* lds_, bf16_t* Z, const bf16_t* KVF, const bf16_t* KVB, const float* decay_logit, const float* gn_w, int with_ctx, int u0, int ustep, unsigned* kvc, unsigned* barw) { PH_IDS;
    using namespace fa;
    LAS char* sm = (LAS char*)lds_;
    constexpr int ST_OFF = 4 * BUF_R, ST_SZ = 64 * KP_R;
    const int lane = tid_ & 63, wid = __builtin_amdgcn_readfirstlane(tid_ >> 6), r32 = lane & 31, hi = lane >> 5;
    const int nunits = 256 + (with_ctx ? 32 : 0);
    const int prow = tid_ >> 3, pc = tid_ & 7;
    const int koff = prow * KP_R + pc * 16;
    const int voff = KT_R + (pc >> 2) * 4096 + prow * 64 + (pc & 3) * 16;
    const int vrd = KT_R + ((lane >> 4) & 1) * 32 + (lane & 3) * 8 + (4 * hi + ((lane & 15) >> 2)) * 64;
    for (int u = u0; u < nunits; u += ustep) {
        const bool lat = u < 256; const int bh = lat ? (u >> 3) : (u - 256), qb = lat ? (u & 7) : 0, b = bh >> 2, h = bh & 3;
        const float lgf = -log1pf(__expf(-decay_logit[h])) * 1.4426950408889634f, lgb = -log1pf(__expf(-decay_logit[4 + h])) * 1.4426950408889634f;
        const int qw0 = qb * 256 + wid * 32, qpos = qw0 + r32;
        const int qrow = (lat ? b * 2048 : RL + b * 256) + qpos;
        bf16_t* zq = Z + (size_t)qrow * ZW;
        u32x4 sK[4], sV[4]; bf16x8 qf[4];
        { const size_t rb = (lat ? (size_t)b * 2048 + qb * 256 : (size_t)RL + b * 256);
#pragma unroll
          for (int j = 0; j < 4; ++j) { const bf16_t* zr = Z + (rb + 64 * j + prow) * ZW + h * 64 + pc * 8; sK[j] = *(const u32x4*)(zr + C_RK); sV[j] = *(const u32x4*)(zr + C_RV); } }
#pragma unroll
        for (int st = 0; st < 4; ++st) qf[st] = *(const bf16x8*)(zq + C_RQ + h * 64 + 16 * st + 8 * hi);
        if (kvc != nullptr && tid_ == 0) dep_spin(kvc, (unsigned)G_, barw);
        __syncthreads();
#pragma unroll
        for (int j = 0; j < 4; ++j) { *(LAS u32x4*)(sm + j * BUF_R + koff) = sK[j]; *(LAS u32x4*)(sm + j * BUF_R + voff) = sV[j]; }
        {
            const float g128f = __builtin_amdgcn_exp2f(lgf * 128.f), g128b = __builtin_amdgcn_exp2f(lgb * 128.f);
            const bf16_t* kf = KVF + (size_t)bh * 18 * 4096 + tid_ * 8; const bf16_t* kb = KVB + (size_t)bh * 18 * 4096 + tid_ * 8;
            LAS char* sto = sm + ST_OFF + (tid_ >> 3) * KP_R + (tid_ & 7) * 16;
            f32x4 sa = (f32x4){0.f, 0.f, 0.f, 0.f}, sb = sa, ta, tb;
#define ST_PUT(k) (*(LAS u32x4*)(sto + (k) * ST_SZ) = pack8(sa, sb))
#define ST_STEP(ptr, ci_, g_) do { unpack8(*(const u32x4*)((ptr) + (size_t)(ci_) * 4096), ta, tb); sa = sa * (g_) + ta; sb = sb * (g_) + tb; } while (0)
            if (lat) {
                const int cA = 2 * qb, n1 = 2 + cA, nb = 16 - cA;
                u32x4 Lq[9], Lr[9]; f32x4 sc = (f32x4){0.f, 0.f, 0.f, 0.f}, sd = sc;
#define ST_PUTB(k) (*(LAS u32x4*)(sto + (k) * ST_SZ) = pack8(sc, sd))
#pragma unroll
                for (int hf = 0; hf < 2; ++hf) {
#pragma unroll
                    for (int k = 0; k < 9; ++k) { const int kk = 9 * hf + k;
                        if (kk <= n1 && kk < 17) Lq[k] = *(const u32x4*)(kf + (size_t)kk * 4096);
                        if (kk <= nb && kk < 17) Lr[k] = *(const u32x4*)(kb + (size_t)(kk == 0 ? 1 : (kk == 1 ? 0 : 19 - kk)) * 4096); }
#pragma unroll
                    for (int k = 0; k < 9; ++k) { const int kk = 9 * hf + k;
                        if (kk == n1) ST_PUT(0); if (kk <= n1 && kk < 17) { unpack8(Lq[k], ta, tb); sa = sa * g128f + ta; sb = sb * g128f + tb; }
                        if (kk == nb) ST_PUTB(3); if (kk <= nb && kk < 17) { unpack8(Lr[k], ta, tb); sc = sc * g128b + ta; sd = sd * g128b + tb; } }
                    asm volatile("" ::: "memory"); }
                ST_PUT(1); ST_PUTB(2);
#undef ST_PUTB
            } else {
                ST_PUT(0); ST_PUT(3);
                ST_STEP(kf, 0, g128f); ST_PUT(1);
                sa = (f32x4){0.f, 0.f, 0.f, 0.f}; sb = sa; ST_STEP(kb, 1, g128b); ST_PUT(2);
            }
#undef ST_PUT
#undef ST_STEP
        }
        __syncthreads();
        u32x2 gtv[8]; f32x4 gwv[8];
#pragma unroll
        for (int g = 0; g < 4; ++g)
#pragma unroll
            for (int blk = 0; blk < 2; ++blk) { const int d = blk * 32 + 8 * g + 4 * hi; gtv[2 * g + blk] = *(const u32x2*)(zq + C_RG + h * 64 + d); gwv[2 * g + blk] = *(const f32x4*)(gn_w + h * 64 + d); }
        f32x16 o0, o1;
#pragma unroll
        for (int r = 0; r < 16; ++r) { o0[r] = 0.f; o1[r] = 0.f; }
        const int cl = wid >> 2, c0 = qb * 256 + 128 * cl;
        ret_tile_gen(sm, r32, hi, vrd, (2 * cl) * BUF_R, c0, qpos, lgf, lgb, qf, o0, o1);
        __builtin_amdgcn_sched_barrier(0);
        ret_tile_gen(sm, r32, hi, vrd, (2 * cl + 1) * BUF_R, c0 + 64, qpos, lgf, lgb, qf, o0, o1);
        __builtin_amdgcn_sched_barrier(0);
        { f32x16 p0, p1;
          ret_qk(sm, r32, hi, ST_OFF + cl * ST_SZ, qf, p0, p1);
          const float sf = __builtin_amdgcn_exp2f(lgf * (float)(qpos - c0 + 1));
#pragma unroll
          for (int r = 0; r < 16; ++r) { o0[r] += p0[r] * sf; o1[r] += p1[r] * sf; }
          ret_qk(sm, r32, hi, ST_OFF + (2 + cl) * ST_SZ, qf, p0, p1);
          const float sbk = __builtin_amdgcn_exp2f(lgb * (float)(c0 + 128 - qpos));
#pragma unroll
          for (int r = 0; r < 16; ++r) { o0[r] += p0[r] * sbk; o1[r] += p1[r] * sbk; } }
        float s1 = 0.f;
#pragma unroll
        for (int r = 0; r < 16; ++r) s1 += o0[r] + o1[r];
        s1 += __shfl_xor(s1, 32);
        const float mu = s1 * (1.f / 64);
        float s2 = 0.f;
#pragma unroll
        for (int r = 0; r < 16; ++r) { const float a = o0[r] - mu, c = o1[r] - mu; s2 += a * a + c * c; }
        s2 += __shfl_xor(s2, 32);
        const float rstd = rsqrtf(s2 * (1.f / 64) + EPS);
#pragma unroll
        for (int g = 0; g < 4; ++g)
#pragma unroll
            for (int blk = 0; blk < 2; ++blk) {
                const int d = blk * 32 + 8 * g + 4 * hi;
                const u32x2 gt = gtv[2 * g + blk];
                const f32x4 gw = gwv[2 * g + blk];
                float y[4];
#pragma unroll
                for (int q = 0; q < 4; ++q) { const float ov = blk ? o1[4 * g + q] : o0[4 * g + q]; const unsigned gb = q < 2 ? gt.x : gt.y; const float gv = __uint_as_float((q & 1) ? (gb & 0xffff0000u) : (gb << 16));
                    y[q] = siluf_(gv) * ((ov - mu) * rstd * gw[q]); }
                u32x2 w; w.x = pk2(y[0], y[1]); w.y = pk2(y[2], y[3]);
                *(u32x2*)(zq + C_RQ + h * 64 + d) = w;
            }
    }
    __syncthreads();
}

__device__ __forceinline__ void ph_ret_mfma(unsigned char* lds_, bf16_t* Z, const float* decay_logit, const float* gn_w, int with_ctx, int u0, int ustep) { PH_IDS;
    using namespace fa;
    LAS char* sm = (LAS char*)lds_;
    const int lane = tid_ & 63, wid = __builtin_amdgcn_readfirstlane(tid_ >> 6), r32 = lane & 31, hi = lane >> 5;
    const int nunits = 256 + (with_ctx ? 32 : 0);
    const int prow = tid_ >> 3, pc = tid_ & 7;
    const int koff = prow * KP_R + pc * 16;
    const int voff = KT_R + (pc >> 2) * 4096 + prow * 64 + (pc & 3) * 16;
    const int vrd = KT_R + ((lane >> 4) & 1) * 32 + (lane & 3) * 8 + (4 * hi + ((lane & 15) >> 2)) * 64;
    for (int u = u0; u < nunits; u += ustep) {
        const bool lat = u < 256; const int bh = lat ? (u >> 3) : (u - 256), qb = lat ? (u & 7) : 0, b = bh >> 2, h = bh & 3;
        const int ntile = lat ? 40 : 4;
        const float lgf = -log1pf(__expf(-decay_logit[h])) * 1.4426950408889634f, lgb = -log1pf(__expf(-decay_logit[4 + h])) * 1.4426950408889634f;
        const int qw0 = qb * 256 + wid * 32, qpos = qw0 + r32;
        const int qrow = (lat ? b * 2048 : RL + b * 256) + qpos;
        float ckf[16], ckb[16];
#pragma unroll
        for (int r = 0; r < 16; ++r) { const float off = (float)crow(r, hi); ckf[r] = __builtin_amdgcn_exp2f(-lgf * off); ckb[r] = __builtin_amdgcn_exp2f(lgb * off); }
        const float cf32 = __builtin_amdgcn_exp2f(-lgf * 32.f), cb32 = __builtin_amdgcn_exp2f(lgb * 32.f);
        bf16_t* zq = Z + (size_t)qrow * ZW;
        bf16x8 qf[4];
#pragma unroll
        for (int st = 0; st < 4; ++st) qf[st] = *(const bf16x8*)(zq + C_RQ + h * 64 + 16 * st + 8 * hi);
        f32x16 o0, o1;
#pragma unroll
        for (int r = 0; r < 16; ++r) { o0[r] = 0.f; o1[r] = 0.f; }
        const int ctx0 = RL + b * 256, lat0 = b * 2048;
#define RET_TILE_ROW(t) (lat ? ((t) < 4 ? ctx0 + 64 * (t) : ((t) < 36 ? lat0 + 64 * ((t) - 4) : ctx0 + 64 * ((t) - 36))) : ctx0 + 64 * (t))
#define RET_TILE_POS(t) (lat ? 64 * (t) - 256 : 64 * (t))
        u32x4 ka, va, kb2, vb2;
#define RET_LOAD(k_, v_, tt) do { const bf16_t* zr_ = Z + (size_t)(RET_TILE_ROW(tt) + prow) * ZW + h * 64 + pc * 8; k_ = *(const u32x4*)(zr_ + C_RK); v_ = *(const u32x4*)(zr_ + C_RV); } while (0)
#define RET_WRITE(k_, v_, bo) do { *(LAS u32x4*)(sm + (bo) + koff) = k_; *(LAS u32x4*)(sm + (bo) + voff) = v_; } while (0)
        RET_LOAD(ka, va, 0); RET_LOAD(kb2, vb2, 1);
        __syncthreads();
        RET_WRITE(ka, va, 0); RET_WRITE(kb2, vb2, BUF_R);
        __syncthreads();
        for (int t = 0; t < ntile; t += 2) {
            const int pb = (t & 2) * BUF_R, nb = 2 * BUF_R - pb;
            if (t + 2 < ntile) { RET_LOAD(ka, va, t + 2); RET_LOAD(kb2, vb2, t + 3); }
            ret_tile(sm, r32, hi, vrd, pb, RET_TILE_POS(t), qw0, qpos, lgf, lgb, cf32, cb32, ckf, ckb, qf, o0, o1);
            ret_tile(sm, r32, hi, vrd, pb + BUF_R, RET_TILE_POS(t + 1), qw0, qpos, lgf, lgb, cf32, cb32, ckf, ckb, qf, o0, o1);
            if (t + 2 < ntile) { RET_WRITE(ka, va, nb); RET_WRITE(kb2, vb2, nb + BUF_R); }
            __syncthreads();
        }
#undef RET_LOAD
#undef RET_WRITE
#undef RET_TILE_ROW
#undef RET_TILE_POS
        float s1 = 0.f;
#pragma unroll
        for (int r = 0; r < 16; ++r) s1 += o0[r] + o1[r];
        s1 += __shfl_xor(s1, 32);
        const float mu = s1 * (1.f / 64);
        float s2 = 0.f;
#pragma unroll
        for (int r = 0; r < 16; ++r) { const float a = o0[r] - mu, c = o1[r] - mu; s2 += a * a + c * c; }
        s2 += __shfl_xor(s2, 32);
        const float rstd = rsqrtf(s2 * (1.f / 64) + EPS);
#pragma unroll
        for (int g = 0; g < 4; ++g)
#pragma unroll
            for (int blk = 0; blk < 2; ++blk) {
                const int d = blk * 32 + 8 * g + 4 * hi;
                const u32x2 gt = *(const u32x2*)(zq + C_RG + h * 64 + d);
                const f32x4 gw = *(const f32x4*)(gn_w + h * 64 + d);
                float y[4];
#pragma unroll
                for (int q = 0; q < 4; ++q) { const float ov = blk ? o1[4 * g + q] : o0[4 * g + q]; const unsigned gb = q < 2 ? gt.x : gt.y; const float gv = __uint_as_float((q & 1) ? (gb & 0xffff0000u) : (gb << 16));
                    y[q] = siluf_(gv) * ((ov - mu) * rstd * gw[q]); }
                u32x2 w; w.x = pk2(y[0], y[1]); w.y = pk2(y[2], y[3]);
                *(u32x2*)(zq + C_RQ + h * 64 + d) = w;
            }
    }
    __syncthreads();
}

struct SchedGrid {
    const char* A; const char* B; unsigned lda, ldb; int nt, nM, nN, G, c, kind, aux;
    __device__ __forceinline__ bool next(int i, pg8::Unit& u) const {
        int pm, pn; if (!pg8::static_tile(nM, nN, G, c, i, pm, pn)) return false;
        u.A = A + (size_t)pm * 256 * lda; u.B = B + (size_t)pn * 256 * ldb; u.lda = lda; u.ldb = ldb; u.nt = nt; u.pm = pm; u.pn = pn; u.kind = kind; u.aux = aux; return true; }
};
struct SchedGluDyn { static constexpr bool DEP = false;
    const char* A; const char* B; unsigned* ctr; volatile LAS int* slot; int nunits;
    __device__ __forceinline__ bool next(int, pg8::Unit& u) const {
        if (threadIdx.x == 0) slot[0] = (int)atomicAdd(ctr, 1u);
        __syncthreads();
        const int q = __builtin_amdgcn_readfirstlane(slot[0]);
        if (q >= nunits) return false;
        const int pm = q >> 1, pn = q & 1;
        u.A = A + (size_t)pm * 256 * (ZW * 2); u.B = B + (size_t)pn * 256 * 512; u.lda = ZW * 2; u.ldb = 512; u.nt = 4; u.pm = pm; u.pn = pn; u.kind = 0; u.aux = 0; return true; }
};
struct SchedP1 {
    const char* A; const char* B; int G, c, last;
    __device__ __forceinline__ bool next(int i, pg8::Unit& u) const {
        int pm, pn;
        if (!last) { if (!pg8::static_tile(RT / 256, 8, G, c, i, pm, pn)) return false; }
        else { if (!pg8::static_tile(RL / 256, 8, G, c, i, pm, pn)) { const int j = i * G + c - (RL / 256) * 8; if (j < 0 || j >= 32) return false; pm = RL / 256 + (j >> 2); pn = j & 3; } }
        u.A = A + (size_t)pm * 256 * 2048; u.B = B + (size_t)pn * 256 * 2048; u.lda = 2048; u.ldb = 2048; u.nt = 16; u.pm = pm; u.pn = pn; u.kind = 0; u.aux = 0; return true; }
};
struct SchedMerge {
    const char* Z; const char* XN; const char* WBR; const char* WING; const char* OC; int njobs, G, vcu, nmini;
    __device__ __forceinline__ bool next(int i, pg8::Unit& u) const {
        int sub, n, pm, pn, part = 0;
        if (nmini > 0 && i >= 8) { if (i >= 10 || vcu >= nmini) return false; sub = i & 1; n = vcu & 3; pn = (vcu >> 2) & 3; pm = RL / 256 + (vcu >> 4); part = 1; }
        else { const int job = (i >> 3) * G + vcu; if (job >= njobs) return false; sub = i & 7; n = sub >> 1; pm = job >> 2; pn = job & 3; }
        u.pm = pm; u.pn = pn; u.aux = n;
        if (!(sub & 1)) { const int bcol = n == 0 ? C_QC : (n == 1 ? C_FU : C_RQ);
            if (n == 2) { u.A = OC + (size_t)pm * 256 * 512; u.lda = 512; } else { u.A = Z + ((size_t)pm * 256 * ZW + bcol) * 2; u.lda = ZW * 2; } u.B = WBR + ((size_t)n * 1024 + pn * 256) * 512; u.ldb = 512; u.nt = 4; u.kind = 0; }
        else { u.A = XN + (size_t)pm * 256 * 2048; u.lda = 2048; u.B = WING + ((size_t)n * 1024 + pn * 256) * 2048; u.ldb = 2048; u.nt = 16; u.kind = part ? 2 : 1; }
        return true; }
};
struct SchedFfnDown {
    const char* H; const char* W2; int G, c, nctx;
    __device__ __forceinline__ bool next(int i, pg8::Unit& u) const {
        int pm, pn;
        if (pg8::static_tile(RL / 256, 4, G, c, i, pm, pn)) { u.A = H + (size_t)pm * 256 * 8192; u.B = W2 + (size_t)pn * 256 * 8192; u.lda = 8192; u.ldb = 8192; u.nt = 64; u.pm = pm; u.pn = pn; u.kind = 0; u.aux = 0; return true; }
        const int j = i * G + c - (RL / 256) * 4; if (j < 0 || j >= nctx) return false;
        pm = RL / 256 + (j >> 4); pn = (j >> 2) & 3; const int kq = j & 3;
        u.A = H + (size_t)pm * 256 * 8192 + kq * 2048; u.B = W2 + (size_t)pn * 256 * 8192 + kq * 2048; u.lda = 8192; u.ldb = 8192; u.nt = 16; u.pm = pm; u.pn = pn; u.kind = 3; u.aux = kq; return true; }
};
#define EPI_FOREACH(...) _Pragma("unroll") for (int ai = 0; ai < 2; ++ai) _Pragma("unroll") for (int m = 0; m < 4; ++m) _Pragma("unroll") for (int bj = 0; bj < 2; ++bj) { \
        const int row = u.pm * 256 + ai * 128 + wr * 64 + m * 16 + fr, col = u.pn * 256 + bj * 128 + wc * 32 + 8 * fq; const f32x4 v0 = acc[ai][bj][m][0], v1 = acc[ai][bj][m][1]; (void)row; (void)col; __VA_ARGS__ }
struct EpiStore { static constexpr bool PRE = false;
    bf16_t* O; int ld; int act;
    __device__ __forceinline__ void operator()(const f32x4 (&acc)[2][2][4][2], const pg8::Unit& u, int wr, int wc, int fr, int fq) const {
        EPI_FOREACH( f32x4 a = v0, b = v1; if (act == 1) { _Pragma("unroll") for (int q = 0; q < 4; ++q) { const float ra = fmaxf(a[q], 0.f), rb = fmaxf(b[q], 0.f); a[q] = ra * ra; b[q] = rb * rb; } }
            *(pg8::u32x4*)(O + (size_t)row * ld + col) = pack8(a, b); )
    }
};
struct EpiFfnUp {
    static constexpr bool PRE = true;
    bf16_t* O; const float* ss; const float* cf; LAS float* red;
    __device__ __forceinline__ void pre_issue(const pg8::Unit& u, int tid, f32x4& v) const {
        if (tid < 256) v = *(const f32x4*)(ss + ((size_t)u.pm * 256 + tid) * 4);
        else v[0] = cf[(size_t)(u.pm < 64 ? (u.pm >> 3) : 8) * DFF + u.pn * 256 + (tid - 256)]; }
    __device__ __forceinline__ void pre_commit(int tid, int par, const f32x4& v) const {
        red[par * 512 + tid] = tid < 256 ? rsqrtf((v[0] + v[1] + v[2] + v[3]) * (1.f / DM) + EPS) : v[0]; }
    __device__ __forceinline__ void operator()(const f32x4 (&acc)[2][2][4][2], const pg8::Unit& u, int wr, int wc, int fr, int fq, int par) const {
        const LAS float* rp = red + par * 512 + wr * 64 + fr; const LAS float* cp = rp - (wr * 64 + fr) + 256 + wc * 32 + 8 * fq;
        EPI_FOREACH( const f32x4 c0 = *(const LAS f32x4*)(cp + bj * 128), c1 = *(const LAS f32x4*)(cp + bj * 128 + 4); const float r = rp[ai * 128 + m * 16]; f32x4 a, b;
            _Pragma("unroll") for (int q = 0; q < 4; ++q) { const float ra = fmaxf(v0[q] * r + c0[q], 0.f), rb = fmaxf(v1[q] * r + c1[q], 0.f); a[q] = ra * ra; b[q] = rb * rb; }
            *(pg8::u32x4*)(O + (size_t)row * DFF + col) = pack8(a, b); )
    }
};
template <int T> __device__ __forceinline__ void ld8(const void* base, size_t o, f32x4& a, f32x4& b) {
    if constexpr (T == 0) { const float* p = (const float*)base + o; a = *(const f32x4*)p; b = *(const f32x4*)(p + 4); } else unpack8(*(const pg8::u32x4*)((const bf16_t*)base + o), a, b); }
template <int T> __device__ __forceinline__ void st8(void* base, size_t o, const f32x4 a, const f32x4 b) {
    if constexpr (T == 0) { float* p = (float*)base + o; *(f32x4*)p = a; *(f32x4*)(p + 4) = b; } else *(pg8::u32x4*)((bf16_t*)base + o) = pack8(a, b); }
template <int XIN, int XOUT>
struct EpiResid { static constexpr bool PRE = false;
    const void* xlat; const void* xctx; void* olat; void* octx; const float* mod; int gch; float* part;
    bf16_t* an; const float* wmf; float* ss; LAS float* red;
    __device__ __forceinline__ void operator()(const f32x4 (&acc)[2][2][4][2], const pg8::Unit& u, int wr, int wc, int fr, int fq) const {
        if (u.kind == 3) { float* pb = part + (size_t)u.aux * RC * DM - (size_t)RL * DM;
            EPI_FOREACH( const size_t o = (size_t)row * DM + col; *(f32x4*)(pb + o) = v0; *(f32x4*)(pb + o + 4) = v1; if (bj) asm volatile("" ::: "memory"); )
            return; }
        const bool lat = u.pm < 64; const void* xb = lat ? xlat : xctx; void* ob = lat ? olat : octx; const size_t rb = lat ? 0 : (size_t)RL * DM;
        const float* g = mod + (size_t)(lat ? (u.pm >> 3) : 8) * 6144 + gch * 1024;
        if (an == nullptr) {
        EPI_FOREACH( const f32x4 g0 = *(const f32x4*)(g + col), g1 = *(const f32x4*)(g + col + 4); const size_t o = (size_t)row * DM + col - rb;
            f32x4 x0, x1; ld8<XIN>(xb, o, x0, x1); st8<XOUT>(ob, o, x0 + g0 * v0, x1 + g1 * v1); if (bj) asm volatile("" ::: "memory"); )
        return; }
        const float* wm = wmf + (size_t)(lat ? (u.pm >> 3) : 8) * 1024;
        float sq = 0.f;
        EPI_FOREACH( const f32x4 g0 = *(const f32x4*)(g + col), g1 = *(const f32x4*)(g + col + 4); const size_t o = (size_t)row * DM + col - rb;
            f32x4 x0, x1; ld8<XIN>(xb, o, x0, x1); const f32x4 y0 = x0 + g0 * v0, y1 = x1 + g1 * v1; st8<XOUT>(ob, o, y0, y1);
            const f32x4 w0 = *(const f32x4*)(wm + col), w1 = *(const f32x4*)(wm + col + 4);
            *(pg8::u32x4*)(an + (size_t)row * DM + col) = pack8(y0 * w0, y1 * w1);
            sq += y0[0] * y0[0] + y0[1] * y0[1] + y0[2] * y0[2] + y0[3] * y0[3] + y1[0] * y1[0] + y1[1] * y1[1] + y1[2] * y1[2] + y1[3] * y1[3];
            if (bj) { sq += __shfl_xor(sq, 16); sq += __shfl_xor(sq, 32); if (fq == 0) red[wc * 256 + ai * 128 + wr * 64 + m * 16 + fr] = sq; sq = 0.f; asm volatile("" ::: "memory"); } )
        __syncthreads();
        { int t = threadIdx.x; asm volatile("" : "+v"(t)); if (t < 256) ss[((size_t)u.pm * 256 + t) * 4 + u.pn] = red[t] + red[256 + t] + red[512 + t] + red[768 + t]; }
    }
};
struct EpiMerge { static constexpr bool PRE = false;
    pg8::u32x4* stash; bf16_t* MMp; bf16_t* PMp;
    __device__ __forceinline__ void operator()(const f32x4 (&acc)[2][2][4][2], const pg8::Unit& u, int wr, int wc, int fr, int fq) const {
        int tid = threadIdx.x; asm volatile("" : "+v"(tid));
        if (u.kind == 0) { EPI_FOREACH( stash[((ai * 4 + m) * 2 + bj) * NT + tid] = pack8(v0, v1); if (bj && (m & 1)) asm volatile("" ::: "memory"); ) }
        else { EPI_FOREACH( f32x4 y0, y1; unpack8(stash[((ai * 4 + m) * 2 + bj) * NT + tid], y0, y1); f32x4 t0, t1;
                _Pragma("unroll") for (int q = 0; q < 4; ++q) { t0[q] = sigmoidf_(v0[q]) * y0[q]; t1[q] = sigmoidf_(v1[q]) * y1[q]; }
                pg8::u32x4* mp = (pg8::u32x4*)((u.kind == 2 && u.aux != 0 ? PMp + (size_t)(u.aux - 1) * RC * DM - (size_t)RL * DM : MMp) + (size_t)row * DM + col);
                if (u.kind == 1 && u.aux != 0) { f32x4 p0, p1; unpack8(*mp, p0, p1); t0 += p0; t1 += p1; }
                *mp = pack8(t0, t1); if (bj && (m & 1)) asm volatile("" ::: "memory"); ) }
    }
};
struct TItem { const float* W; bf16_t* WT; const float* kscale; int K, N, row_off, item; };
__device__ __forceinline__ void titem_load(const TItem& t, int lane, f32x4 (&v)[8]) {
    const int nblk = t.N / 32, kb = t.item / nblk, nb = t.item % nblk;
    const float* p = t.W + (size_t)(64 * kb + (lane >> 3)) * t.N + 32 * nb + 4 * (lane & 7);
#pragma unroll
    for (int i = 0; i < 8; ++i) v[i] = *(const f32x4*)(p + (size_t)(8 * i) * t.N);
}
__device__ __forceinline__ void titem_store(const TItem& t, int lane, const f32x4 (&v)[8], LAS float* scr) {
    const int nblk = t.N / 32, kb = t.item / nblk, nb = t.item % nblk, k0 = 64 * kb, n0 = 32 * nb;
#pragma unroll
    for (int i = 0; i < 8; ++i) { const int kk = 8 * i + (lane >> 3); f32x4 w = v[i]; if (t.kscale) w *= t.kscale[k0 + kk];
        LAS float* sp = scr + kk * 33 + 4 * (lane & 7); sp[0] = w[0]; sp[1] = w[1]; sp[2] = w[2]; sp[3] = w[3]; }
    asm volatile("s_waitcnt lgkmcnt(0)" ::: "memory");
    const int c = lane & 7;
#pragma unroll
    for (int j = 0; j < 4; ++j) { const int n = (lane >> 3) + 8 * j; const LAS float* sp = scr + (8 * c) * 33 + n;
        pg8::u32x4 o; o.x = pg8::cvt_pk_bf16(sp[0 * 33], sp[1 * 33]); o.y = pg8::cvt_pk_bf16(sp[2 * 33], sp[3 * 33]); o.z = pg8::cvt_pk_bf16(sp[4 * 33], sp[5 * 33]); o.w = pg8::cvt_pk_bf16(sp[6 * 33], sp[7 * 33]);
        *(pg8::u32x4*)(t.WT + (size_t)(t.row_off + n0 + n) * t.K + k0 + 8 * c) = o; }
    asm volatile("s_waitcnt lgkmcnt(0)" ::: "memory");
}
__device__ __forceinline__ void ph_convert_weights(unsigned char* lds, int l, const float* w_in, const float* w1, const float* w2, const float* w_out, const float* w_br, const float* w_glu,
                                                   const float* w_uq, const float* q_norm, const float* w_ukv, const float* kv_norm, unsigned char* ws) { PH_IDS;
    const int wave = __builtin_amdgcn_readfirstlane(tid_ >> 6), lane = tid_ & 63;
    LAS float* scr = (LAS float*)((LAS unsigned char*)lds + wave * 16384);
    const int gw = bid_ * 8 + wave, NGW = G_ * 8;
    constexpr int I_IN = 16 * 189, I_1 = 16 * 128, I_2 = 64 * 32, I_O = 16 * 32, I_B = 4 * 32;
    constexpr int I_G = 4 * 16;
    constexpr int I_UQ = 4 * 12, I_UKV = 2 * 16;
    constexpr int NITEMS = I_IN + I_1 + I_2 + I_O + 4 * I_B + I_G + I_UQ + I_UKV;
    bf16_t* WIN_T = (bf16_t*)(ws + WS_WIN); bf16_t* W1_T = (bf16_t*)(ws + WS_W1); bf16_t* W2_T = (bf16_t*)(ws + WS_W2); bf16_t* WOUT_T = (bf16_t*)(ws + WS_WOUT); bf16_t* WBR_T = (bf16_t*)(ws + WS_WBR);
    auto decode = [&](int it) -> TItem {
        TItem t; t.kscale = nullptr; t.row_off = 0; int r = it;
        if (r < I_IN) { t.W = w_in + (size_t)l * DM * INC; t.K = DM; t.N = INC; t.WT = WIN_T; t.row_off = (r % 189) >= 61 ? 96 : 0; t.item = r; return t; } r -= I_IN;
        if (r < I_1) { t.W = w1 + (size_t)l * DM * DFF; t.K = DM; t.N = DFF; t.WT = W1_T; t.item = r; return t; } r -= I_1;
        if (r < I_2) { t.W = w2 + (size_t)l * DFF * DM; t.K = DFF; t.N = DM; t.WT = W2_T; t.item = r; return t; } r -= I_2;
        if (r < I_O) { t.W = w_out + (size_t)l * DM * DM; t.K = DM; t.N = DM; t.WT = WOUT_T; t.item = r; return t; } r -= I_O;
        if (r < 4 * I_B) { const int n = r / I_B; t.W = w_br + ((size_t)l * 4 + n) * 256 * DM; t.K = 256; t.N = DM; t.WT = WBR_T + (size_t)n * 1024 * 256; t.item = r % I_B; return t; } r -= 4 * I_B;
        if (r < I_G) { const int n0 = (r % 16) * 32;
            t.W = w_glu + (size_t)l * 256 * 512; t.K = 256; t.N = 512; t.WT = (bf16_t*)(ws + WS_WGLU); t.row_off = n0 < 128 ? 0 : (n0 < 256 ? 128 : (n0 < 384 ? -128 : 0)); t.item = r; return t; } r -= I_G;
        if (r < I_UQ) { t.W = w_uq + (size_t)l * 256 * 384; t.K = 256; t.N = 384; t.WT = (bf16_t*)(ws + WS_WUQ); t.kscale = q_norm + l * 256; t.item = r; return t; } r -= I_UQ;
        t.W = w_ukv + (size_t)l * 128 * 512; t.K = 128; t.N = 512; t.WT = (bf16_t*)(ws + WS_WUKV); t.kscale = kv_norm + l * 128; t.item = r; return t;
    };
    if (gw < NITEMS) {
        TItem cur = decode(gw); f32x4 v[8]; titem_load(cur, lane, v);
        for (int it = gw; it < NITEMS; it += NGW) {
            const bool more = it + NGW < NITEMS;
            TItem nxt = cur; f32x4 vn[8];
            if (more) { nxt = decode(it + NGW); titem_load(nxt, lane, vn); }
            titem_store(cur, lane, v, scr);
            if (more) { cur = nxt;
#pragma unroll
                for (int i = 0; i < 8; ++i) v[i] = vn[i]; }
        }
    }
    GSTRIDE(gi, 96 * 1024 / 8) { *(pg8::u32x4*)(WIN_T + (size_t)1952 * 1024 + (size_t)gi * 8) = (pg8::u32x4){0u, 0u, 0u, 0u}; }
    __syncthreads();
}

struct EpiFourier { static constexpr bool PRE = false;
    bf16_t* Zp; int rowbase, L; float scale;
    __device__ __forceinline__ void operator()(const f32x4 (&acc)[2][2][4][2], const pg8::Unit& u, int wr, int wc, int fr, int fq) const {
        EPI_FOREACH( *(pg8::u32x4*)(Zp + ((size_t)rowbase + (size_t)u.pn * L + row) * ZW + C_FU + (col - u.pn * 256)) = pack8(v0 * scale, v1 * scale); )
    }
};
__device__ __forceinline__ void ph_f2a(unsigned char* lds_, const bf16_t* F1, const float* trig, bf16_t* BP) { PH_IDS;
    const int lane = tid_ & 63, wid = __builtin_amdgcn_readfirstlane(tid_ >> 6), c16 = lane & 15, kq = lane >> 4;
    LAS char* wi = (LAS char*)lds_ + wid * 16384;
    LAS char* wo = wi + 8192;
    bf16x8 are, aim;
#pragma unroll
    for (int j = 0; j < 8; ++j) { const int t2 = 8 * (kq & 1) + j, idx = ((c16 * t2) & 15) * 128; const float cs = trig[idx], sn = trig[2048 + idx];
        are[j] = (short)f2bf((kq >> 1) ? -sn : cs); aim[j] = (short)f2bf((kq >> 1) ? cs : sn); }
    for (int col = bid_ * 8 + wid; col < NB * 256; col += G_ * 8) {
        const pg8::u32x4* src = (const pg8::u32x4*)(F1 + (size_t)col * 4096);
        pg8::u32x4 st[8];
#pragma unroll
        for (int i = 0; i < 8; ++i) st[i] = src[lane + 64 * i];
#pragma unroll
        for (int i = 0; i < 8; ++i) *(LAS pg8::u32x4*)(wi + (lane + 64 * i) * 16) = st[i];
        asm volatile("s_waitcnt lgkmcnt(0)" ::: "memory");
#pragma unroll 2
        for (int nb = 0; nb < 8; ++nb) {
            const int t1 = 16 * nb + c16;
            bf16x8 bf;
#pragma unroll
            for (int j = 0; j < 8; ++j) bf[j] = *(const LAS short*)(wi + ((kq >> 1) * 2048 + t1 + 128 * (8 * (kq & 1) + j)) * 2);
            const f32x4 z4 = (f32x4){0.f, 0.f, 0.f, 0.f};
            const f32x4 re = __builtin_amdgcn_mfma_f32_16x16x32_bf16(are, bf, z4, 0, 0, 0), im = __builtin_amdgcn_mfma_f32_16x16x32_bf16(aim, bf, z4, 0, 0, 0);
#pragma unroll
            for (int r = 0; r < 4; ++r) { const int k2 = 4 * kq + r, idx = k2 * t1; const float cs = trig[idx], sn = trig[2048 + idx];
                *(LAS bf16_t*)(wo + ((k2 * 2 + 0) * 128 + t1) * 2) = f2bf(re[r] * cs - im[r] * sn);
                *(LAS bf16_t*)(wo + ((k2 * 2 + 1) * 128 + t1) * 2) = f2bf(re[r] * sn + im[r] * cs); }
        }
        asm volatile("s_waitcnt lgkmcnt(0)" ::: "memory");
        pg8::u32x4* dst = (pg8::u32x4*)(BP + (size_t)col * 4096);
#pragma unroll
        for (int i = 0; i < 8; ++i) dst[lane + 64 * i] = *(const LAS pg8::u32x4*)(wo + (lane + 64 * i) * 16);
        asm volatile("s_waitcnt lgkmcnt(0)" ::: "memory");
    }
    __syncthreads();
}
struct SchedFourier2 { static constexpr bool DEP = false;
    const char* AT; const char* BP; int c;
    __device__ __forceinline__ bool next(int i, pg8::Unit& u) const {
        if (i != 0) return false;
        const int j = c & 7, b = c >> 3;
        u.A = AT; u.lda = 1024; u.B = BP + ((size_t)b * 256 * 4096 + (size_t)j * 512) * 2; u.ldb = 8192; u.nt = 8; u.pm = j; u.pn = b; u.kind = 0; u.aux = 0; return true; }
};
struct EpiFourier2 { static constexpr bool PRE = false;
    bf16_t* Zp; float scale;
    __device__ __forceinline__ void operator()(const f32x4 (&acc)[2][2][4][2], const pg8::Unit& u, int wr, int wc, int fr, int fq) const {
#pragma unroll
        for (int ai = 0; ai < 2; ++ai)
#pragma unroll
            for (int m = 0; m < 4; ++m)
#pragma unroll
                for (int bj = 0; bj < 2; ++bj) {
                    const int k1 = wr * 64 + m * 16 + fr, k = 16 * k1 + 2 * u.pm + ai, gm = bj * 128 + wc * 32 + 8 * fq;
                    *(pg8::u32x4*)(Zp + ((size_t)u.pn * 2048 + k) * ZW + C_FU + gm) = pack8(acc[ai][bj][m][0] * scale, acc[ai][bj][m][1] * scale);
                }
    }
};
struct EpiGlu { static constexpr bool PRE = false;
    bf16_t* OCp;
    __device__ __forceinline__ void operator()(const f32x4 (&acc)[2][2][4][2], const pg8::Unit& u, int wr, int wc, int fr, int fq) const {
#pragma unroll
        for (int ai = 0; ai < 2; ++ai)
#pragma unroll
            for (int m = 0; m < 4; ++m) {
                const int row = u.pm * 256 + ai * 128 + wr * 64 + m * 16 + fr, col = u.pn * 128 + wc * 32 + 8 * fq;
                f32x4 a, b;
#pragma unroll
                for (int q = 0; q < 4; ++q) { a[q] = acc[ai][0][m][0][q] * sigmoidf_(acc[ai][1][m][0][q]); b[q] = acc[ai][0][m][1][q] * sigmoidf_(acc[ai][1][m][1][q]); }
                *(pg8::u32x4*)(OCp + (size_t)row * 256 + col) = pack8(a, b);
            }
    }
};
__device__ __forceinline__ void ph_dft_gen(const float* trig, bf16_t* AT, bf16_t* DC) { PH_IDS;
    GSTRIDE(gi, 256 * 512) {
        const int r = gi >> 9, c = gi & 511, h = r >> 7, k1 = r & 127, hh = c >> 8, part = (c >> 7) & 1, t1 = c & 127, idx = ((k1 * t1) & 127) * 16;
        AT[gi] = f2bf(h != hh ? 0.f : (part ? -trig[2048 + idx] : trig[idx]));
    }
    GSTRIDE(gi, 256 * 512 / 8) {
        const int k = gi >> 6, kk0 = (gi & 63) * 8; pg8::u32x4 w; unsigned pr[4];
#pragma unroll
        for (int q = 0; q < 4; ++q) { float v[2];
#pragma unroll
            for (int e = 0; e < 2; ++e) { const int kk = kk0 + 2 * q + e, part = kk >> 8, t = kk & 255, idx = ((k * t) & 255) * 8; v[e] = part ? -trig[2048 + idx] : trig[idx]; }
            pr[q] = pg8::cvt_pk_bf16(v[0], v[1]); }
        w.x = pr[0]; w.y = pr[1]; w.z = pr[2]; w.w = pr[3];
        *(pg8::u32x4*)(DC + (size_t)k * 512 + kk0) = w;
    }
}

__device__ __forceinline__ void ph_sum_mm(bf16_t* MMp, const bf16_t* PMp) { PH_IDS;
    GSTRIDE(gi, RC * DM / 8) {
        pg8::u32x4* mp = (pg8::u32x4*)(MMp + (size_t)RL * DM) + gi;
        f32x4 a, b; unpack8(*mp, a, b);
#pragma unroll
        for (int n = 0; n < 3; ++n) { f32x4 c, d; unpack8(*((const pg8::u32x4*)(PMp + (size_t)n * RC * DM) + gi), c, d); a += c; b += d; }
        *mp = pack8(a, b);
    }
}
__device__ __forceinline__ void ph_sum_ffn(bf16_t* XC, const float* PD, const float* mod) { PH_IDS;
    GSTRIDE(gi, RC * DM / 8) {
        const int col = (gi * 8) & (DM - 1);
        f32x4 a0 = *((const f32x4*)PD + 2 * gi), a1 = *((const f32x4*)PD + 2 * gi + 1);
#pragma unroll
        for (int n = 1; n < 4; ++n) { a0 += *((const f32x4*)(PD + (size_t)n * RC * DM) + 2 * gi); a1 += *((const f32x4*)(PD + (size_t)n * RC * DM) + 2 * gi + 1); }
        const f32x4 g0 = *(const f32x4*)(mod + (size_t)8 * 6144 + 5 * 1024 + col), g1 = *(const f32x4*)(mod + (size_t)8 * 6144 + 5 * 1024 + col + 4);
        f32x4 x0, x1; ld8<1>(XC, (size_t)gi * 8, x0, x1); st8<1>(XC, (size_t)gi * 8, x0 + g0 * a0, x1 + g1 * a1);
    }
}

constexpr size_t WS_BAR = 768 * 1024;
constexpr int LDS_BYTES = 147456;
struct Args { const float* in[30]; float* out; unsigned char* ws; };
typedef const __attribute__((address_space(4))) Args* CArgs;
__device__ __forceinline__ CArgs kargs() { CArgs p = (CArgs)__builtin_amdgcn_kernarg_segment_ptr(); asm volatile("" : "+s"(p)); return p; }
#define IN(i) (kargs()->in[i])
#define WSB(T, off) ((T*)(kargs()->ws + (off)))
#define OSB(T, off) ((T*)((unsigned char*)kargs()->out + (off)))
#define OUTP (kargs()->out)
enum { I_X = 0, I_C, I_CTX, I_CCTX, I_ADAW, I_ADAB, I_NMIX, I_NFFN, I_WIN, I_QNORM, I_WUQ, I_KVNORM, I_WUKV, I_QKQ, I_QKK, I_LRE, I_LIM, I_LSTEP, I_BRE, I_BIM, I_CRE, I_CIM, I_S5D, I_WGLU, I_RDEC, I_RGN, I_WBR, I_WOUT, I_W1, I_W2 };
#define GRID_BAR() do { bar.bar = WSB(unsigned, WS_BAR); { unsigned x_ = bar.x; asm volatile("" : "+s"(x_)); bar.x = x_; } xcd_barrier(bar); } while (0)
template <int L> __device__ __forceinline__ void layer_body(unsigned char* lds, XcdBarrier& bar) {
    constexpr int l = L;
    constexpr bool LASTL = (L == DEPTH - 1);
    constexpr int NMT = LASTL ? RL / 256 : RT / 256;
    constexpr int WCTX = LASTL ? 0 : 1;

#define MODL (WSB(float, WS_MOD) + (size_t)l * 9 * 6144)
#define XLAT (l == 0 ? (const void*)IN(I_X) : (const void*)WSB(bf16_t, WS_R))
#define XCTX (l == 0 ? (const void*)IN(I_CTX) : (const void*)WSB(bf16_t, WS_XCB))
    constexpr int XIN = (L == 0) ? 0 : 1;
#define WINL (IN(I_WIN) + (size_t)l * DM * INC)
#define ZP WSB(bf16_t, WS_Z)
#define XNP WSB(bf16_t, WS_XN)
#define QP WSB(bf16_t, WS_QKV)
#define KP (WSB(bf16_t, WS_QKV) + (size_t)32 * 2304 * 96)
#define VP (WSB(bf16_t, WS_QKV) + (size_t)2 * 32 * 2304 * 96)
#define F1LAT WSB(bf16_t, WS_F1)
#define F1CTX (WSB(bf16_t, WS_F1) + (size_t)8 * 256 * 2 * 2048)
#define QRAWP WSB(bf16_t, WS_RAW)
#define KVRAWP (WSB(bf16_t, WS_RAW) + (size_t)RT * 384)
        ph_s5_lp(l, IN(I_LRE), IN(I_LIM), IN(I_LSTEP), IN(I_BRE), IN(I_BIM), WSB(float2, WS_LP), WSB(float2, WS_BB), WSB(float, WS_LAMT));
        ph_adarms<XIN>(XLAT, XCTX, IN(I_NMIX) + l * DM, MODL, 0, 1, XNP, RT);
        ph_convert_weights(lds, l, IN(I_WIN), IN(I_W1), IN(I_W2), IN(I_WOUT), IN(I_WBR), IN(I_WGLU), IN(I_WUQ), IN(I_QNORM), IN(I_WUKV), IN(I_KVNORM), kargs()->ws);
        if (l == 0) ph_dft_gen(WSB(float, WS_TRIG), OSB(bf16_t, OS_AT), OSB(bf16_t, OS_DFTC));
        ph_wmf(IN(I_NFFN) + l * DM, MODL, WSB(float, WS_WMF));
        GRID_BAR();
        { SchedP1 S; S.A = (const char*)XNP; S.B = (const char*)WSB(bf16_t, WS_WIN); S.G = l_grid(); S.c = l_bid(); S.last = LASTL ? 1 : 0;
          EpiStore E; E.O = ZP; E.ld = ZW; E.act = 0; pg8::gemm_phase((LAS unsigned char*)lds, S, E); }
        { const int G = l_grid(), bx = l_bid(), n3 = G == 256 ? (LASTL ? 32 : 64) : 0;
          if (bx >= n3) { const int vb = bx - n3, vg = G - n3;
            ph_s5_tz(lds, l, WSB(float2, WS_LP), WSB(float2, WS_BB), IN(I_CRE), IN(I_CIM), WSB(float, WS_TZ), vb, vg);
            ph_s5_ms(WSB(float2, WS_LP), WSB(float2, WS_BB), WSB(bf16_t, WS_MS), vb, vg);
            ph_cf_mfma(lds, WSB(bf16_t, WS_W1), MODL, WSB(float, WS_CF), vb, vg); } }
        GRID_BAR();
        ph_s5_tzb(l, WSB(float, WS_TZ), IN(I_S5D) + l * 256, OSB(bf16_t, OS_TZB), IN(I_CRE), IN(I_CIM), OSB(bf16_t, OS_CQ));
        ph_prep(ZP, WSB(bf16_t, WS_WUQ), WSB(bf16_t, WS_WUKV), WSB(bf16_t, WS_D64), IN(I_QKQ) + l * 96, IN(I_QKK) + l * 96, QP, KP, VP, F1LAT, F1CTX, lds);
        ph_s5_sloc(lds, ZP, WSB(bf16_t, WS_MS), OSB(float, OS_SLOC));
        GRID_BAR();
        unsigned* kvc_ = WSB(unsigned, WS_BAR) + XCD_BAR_WORDS + 128 + 1024 * l;
        unsigned* f2c_ = kvc_ + 640;
        ph_f2a(lds, F1LAT, WSB(float, WS_TRIG), OSB(bf16_t, OS_BP));
        dep_signal_x(f2c_, f2c_ + 32 + 16 * bar.x, bar.st[0]);
        { const int G = l_grid(), bx = l_bid(), nf = G == 256 ? (LASTL ? 64 : 72) : 0;
          ph_ret_kv(lds, ZP, IN(I_RDEC) + l * 8, WSB(bf16_t, WS_KVF), OSB(bf16_t, OS_KVB), bx - nf, G - nf);
          dep_signal_x(kvc_, kvc_ + 32 + 16 * bar.x, bar.st[0]); }
        {
            const int bx = l_bid();
            if (bx < 64) { if (l_tid() == 0) dep_spin(f2c_, (unsigned)l_grid(), WSB(unsigned, WS_BAR)); __syncthreads();
                SchedFourier2 S; S.AT = (const char*)OSB(bf16_t, OS_AT); S.BP = (const char*)OSB(bf16_t, OS_BP); S.c = bx;
                EpiFourier2 E; E.Zp = ZP; E.scale = 0.0027621358640099515f; pg8::gemm_phase((LAS unsigned char*)lds, S, E); }
            else if (!LASTL && bx < 72) { SchedGrid S; S.A = (const char*)OSB(bf16_t, OS_DFTC); S.B = (const char*)F1CTX; S.lda = 1024; S.ldb = 1024; S.nt = 8; S.nM = 1; S.nN = 8; S.G = 8; S.c = bx - 64; S.kind = 0; S.aux = 0;
                EpiFourier E; E.Zp = ZP; E.rowbase = RL; E.L = 256; E.scale = 0.0078125f; pg8::gemm_phase((LAS unsigned char*)lds, S, E); }
            constexpr int NS5 = 16 * (LASTL ? 16 : 18);
            constexpr int NC = LASTL ? 0 : 32;
            constexpr int Q_ATT = 0, Q_ATTC = 256, Q_S5 = Q_ATTC + NC, Q_RET = Q_S5 + NS5, Q_RETC = Q_RET + 256, Q_END = Q_RETC + NC;
            volatile LAS int* qslot = (volatile LAS int*)((LAS unsigned char*)lds + LDS_BYTES - 32);
            unsigned* s5c_ = kvc_ + 320; bool s5sig_ = false;
            for (;;) {
                __syncthreads();
                if (l_tid() == 0) qslot[0] = (int)atomicAdd(WSB(unsigned, WS_BAR) + XCD_BAR_WORDS + 64 * l, 1u);
                __syncthreads();
                const int q = __builtin_amdgcn_readfirstlane(qslot[0]);
                if (!s5sig_ && q >= Q_RET) { dep_signal_x(s5c_, s5c_ + 32 + 16 * bar.x, bar.st[0]); s5sig_ = true; }
                if (q >= Q_END) break;
                if (q < Q_ATTC) ph_attn_mfma(lds, QP, KP, VP, ZP, WCTX, q - Q_ATT, 1 << 20);
                else if (q < Q_S5) ph_attn_mfma(lds, QP, KP, VP, ZP, WCTX, 256 + q - Q_ATTC, 1 << 20);
                else if (q < Q_RET) ph_s5_out(lds, ZP, OSB(bf16_t, OS_TZB), OSB(bf16_t, OS_CQ), WSB(float2, WS_LP), OSB(float, OS_SLOC), WSB(float, WS_LAMT), ZP, LASTL ? 16 : 18, q - Q_S5, 1 << 20);
                else if (q < Q_RETC) ph_ret_chunk(lds, ZP, WSB(bf16_t, WS_KVF), OSB(bf16_t, OS_KVB), IN(I_RDEC) + l * 8, IN(I_RGN) + l * 256, WCTX, q - Q_RET, 1 << 20, kvc_, WSB(unsigned, WS_BAR));
                else ph_ret_chunk(lds, ZP, WSB(bf16_t, WS_KVF), OSB(bf16_t, OS_KVB), IN(I_RDEC) + l * 8, IN(I_RGN) + l * 256, WCTX, 256 + q - Q_RETC, 1 << 20, kvc_, WSB(unsigned, WS_BAR));
            }
        }
        if (l_tid() == 0) dep_spin(kvc_ + 320, (unsigned)l_grid(), WSB(unsigned, WS_BAR));
        __syncthreads();
        { SchedGluDyn S; S.A = (const char*)(ZP + C_S5); S.B = (const char*)WSB(bf16_t, WS_WGLU); S.ctr = kvc_ + 960; S.slot = (volatile LAS int*)((LAS unsigned char*)lds + LDS_BYTES - 32); S.nunits = NMT * 2;
          EpiGlu E; E.OCp = OSB(bf16_t, OS_OC); pg8::gemm_phase((LAS unsigned char*)lds, S, E); }
        GRID_BAR();
        { SchedMerge S; S.Z = (const char*)ZP; S.XN = (const char*)XNP; S.WBR = (const char*)WSB(bf16_t, WS_WBR); S.WING = (const char*)(WSB(bf16_t, WS_WIN) + (size_t)2048 * 1024); S.OC = (const char*)OSB(bf16_t, OS_OC);
          S.G = l_grid(); { const int bx = l_bid(); S.vcu = (bx % 8) * (S.G / 8) + bx / 8; }
          const bool mini = !LASTL && S.G == 256;
          S.njobs = mini ? RL / 256 * 4 : NMT * 4; S.nmini = mini ? 128 : 0;
          EpiMerge E; E.stash = WSB(pg8::u32x4, WS_STASH) + (size_t)l_bid() * 8192; E.MMp = WSB(bf16_t, WS_MM); E.PMp = OSB(bf16_t, OS_PM); pg8::gemm_phase((LAS unsigned char*)lds, S, E); }
        GRID_BAR();
        if (!LASTL && l_grid() == 256) { ph_sum_mm(WSB(bf16_t, WS_MM), OSB(bf16_t, OS_PM)); GRID_BAR(); }
        { SchedGrid S; S.A = (const char*)WSB(bf16_t, WS_MM); S.B = (const char*)WSB(bf16_t, WS_WOUT); S.lda = 2048; S.ldb = 2048; S.nt = 16; S.nM = NMT; S.nN = 4; S.G = l_grid(); S.c = l_bid(); S.kind = 0; S.aux = 0;
          EpiResid<XIN, 1> E; E.xlat = XLAT; E.xctx = XCTX; E.olat = WSB(bf16_t, WS_R); E.octx = WSB(bf16_t, WS_XCB); E.mod = MODL; E.gch = 2; E.part = nullptr; E.an = XNP; E.wmf = WSB(float, WS_WMF); E.ss = OSB(float, OS_SS); E.red = (LAS float*)((LAS unsigned char*)lds + 131072); pg8::gemm_phase((LAS unsigned char*)lds, S, E); }
        GRID_BAR();
        { SchedGrid S; S.A = (const char*)XNP; S.B = (const char*)WSB(bf16_t, WS_W1); S.lda = 2048; S.ldb = 2048; S.nt = 16; S.nM = NMT; S.nN = 16; S.G = l_grid(); S.c = l_bid(); S.kind = 0; S.aux = 0;
          EpiFfnUp E; E.O = WSB(bf16_t, WS_H); E.ss = OSB(float, OS_SS); E.cf = WSB(float, WS_CF); E.red = (LAS float*)((LAS unsigned char*)lds + 131072); pg8::gemm_phase((LAS unsigned char*)lds, S, E); }
        GRID_BAR();
        { SchedFfnDown S; S.H = (const char*)WSB(bf16_t, WS_H); S.W2 = (const char*)WSB(bf16_t, WS_W2); S.G = l_grid(); S.c = l_bid(); S.nctx = (!LASTL && S.G == 256) ? 128 : 0;
          EpiResid<1, LASTL ? 0 : 1> E; E.xlat = WSB(bf16_t, WS_R); E.xctx = WSB(bf16_t, WS_XCB); E.olat = LASTL ? (void*)OUTP : (void*)WSB(bf16_t, WS_R); E.octx = WSB(bf16_t, WS_XCB); E.mod = MODL; E.gch = 5; E.part = WSB(float, WS_PD); E.an = nullptr; E.wmf = nullptr; E.ss = nullptr; E.red = nullptr;
          if (!LASTL && S.G != 256) { SchedGrid S2; S2.A = S.H; S2.B = S.W2; S2.lda = 8192; S2.ldb = 8192; S2.nt = 64; S2.nM = NMT; S2.nN = 4; S2.G = S.G; S2.c = S.c; S2.kind = 0; S2.aux = 0; pg8::gemm_phase((LAS unsigned char*)lds, S2, E); }
          else pg8::gemm_phase((LAS unsigned char*)lds, S, E); }
        if (!LASTL && l_grid() == 256) { GRID_BAR(); ph_sum_ffn(WSB(bf16_t, WS_XCB), WSB(float, WS_PD), MODL); }
        if (l + 1 < DEPTH) GRID_BAR();
}
__global__ void __launch_bounds__(NT, 2) mega(Args a_unused) {
    extern __shared__ __attribute__((aligned(16))) unsigned char lds[];
    volatile LAS unsigned* bst = (volatile LAS unsigned*)((LAS unsigned char*)lds + LDS_BYTES - 16);
    if (threadIdx.x < 4) bst[threadIdx.x] = 0u;
    __syncthreads();
    XcdBarrier bar = xcd_barrier_post(WSB(unsigned, WS_BAR), bst);

    ph_mod(lds, IN(I_C), IN(I_CCTX), IN(I_ADAW), IN(I_ADAB), WSB(float, WS_MOD));
    ph_trig(WSB(float, WS_TRIG), WSB(bf16_t, WS_D64));
    GRID_BAR();
    layer_body<0>(lds, bar);
    layer_body<1>(lds, bar);
}

extern "C" void kernel_launch(void* const* d_in, const int* in_sizes, int n_in, void* d_out, int out_size, void* d_ws, size_t ws_size, hipStream_t stream) {
    static int grid = 0;
    if (grid == 0) {
        if (n_in != 30 || ws_size < WS_END) { fprintf(stderr, "kernel_launch: unexpected n_in %d / ws_size %zu\n", n_in, ws_size); grid = -1; return; }
        int dev = 0, cus = 0, per_cu = 0;
        if (hipGetDevice(&dev) != hipSuccess || hipDeviceGetAttribute(&cus, hipDeviceAttributeMultiprocessorCount, dev) != hipSuccess) { grid = -1; return; }
        if (hipFuncSetAttribute((const void*)mega, hipFuncAttributeMaxDynamicSharedMemorySize, LDS_BYTES) != hipSuccess) { fprintf(stderr, "kernel_launch: hipFuncSetAttribute failed\n"); grid = -1; return; }
        if (hipOccupancyMaxActiveBlocksPerMultiprocessor(&per_cu, (const void*)mega, NT, LDS_BYTES) != hipSuccess || per_cu < 1) fprintf(stderr, "kernel_launch: occupancy query says %d\n", per_cu);
        (void)hipGetLastError();
        grid = cus;
    }
    if (grid < 0) return;
    (void)hipMemsetAsync((char*)d_ws + WS_BAR, 0, (XCD_BAR_WORDS + 128 + 2048) * 4, stream);
    Args a; memset((void*)&a, 0, sizeof(a));
    for (int i = 0; i < 30; ++i) a.in[i] = (const float*)d_in[i];
    a.out = (float*)d_out; a.ws = (unsigned char*)d_ws;
    hipLaunchKernelGGL(mega, dim3(grid), dim3(NT), LDS_BYTES, stream, a);
}
```

```cpp
#include <hip/hip_runtime.h>
#include <cstdint>
#include <cstring>
#include <cstdio>

typedef unsigned short bf16_t;
typedef short bf16x8 __attribute__((ext_vector_type(8)));
typedef float f32x4 __attribute__((ext_vector_type(4)));

constexpr int DM = 1024, NB = 8, SEQ = 2048, CTX = 256, DEPTH = 2;
constexpr int RL = NB * SEQ;
constexpr int RC = NB * CTX;
constexpr int RT = RL + RC;
constexpr int INC = 6048;
constexpr int ZW = 2048;
constexpr int C_KVC = 0, C_KR = 128, C_S5 = 160, C_RK = 416, C_RV = 672, C_QC = 928, C_FU = 1184, C_RQ = 1440, C_RG = 1696, C_GATE = 1952;
constexpr int C_OC = C_RK;
constexpr int DFF = 4096;
constexpr int TCH = 64;
constexpr int NCH = RT / TCH;
constexpr float EPS = 1e-6f;
#define PI_D 3.14159265358979323846

__device__ __forceinline__ float bf2f(bf16_t v) { return __uint_as_float(((unsigned)v) << 16); }
__device__ __forceinline__ bf16_t f2bf(float f) { unsigned u = __float_as_uint(f); return (bf16_t)((u + 0x7fffu + ((u >> 16) & 1u)) >> 16); }
__device__ __forceinline__ float sigmoidf_(float x) { return 1.f / (1.f + __expf(-x)); }
__device__ __forceinline__ float siluf_(float x) { return x * sigmoidf_(x); }
__device__ __forceinline__ float geluf_(float x) { return 0.5f * x * (1.f + tanhf(0.7978845608028654f * (x + 0.044715f * x * x * x))); }
__device__ __forceinline__ int row_batch(int row) { return row < RL ? (row >> 11) : ((row - RL) >> 8); }
__device__ __forceinline__ int row_modidx(int row) { return row < RL ? (row >> 11) : 8; }

constexpr size_t MiB = 1ull << 20;
constexpr size_t WS_MOD = 0;
constexpr size_t WS_RS = 512 * 1024;
constexpr size_t WS_TRIG = 512 * 1024;
constexpr size_t WS_LAMT = WS_TRIG + 32 * 1024;
constexpr size_t WS_LP = 1 * MiB;
constexpr size_t WS_BB = 2 * MiB + 128 * 1024;
constexpr size_t WS_W = 8 * MiB;
constexpr size_t WS_WIN = WS_W, WS_W1 = WS_W + 12 * MiB, WS_W2 = WS_W + 20 * MiB, WS_WOUT = WS_W + 28 * MiB, WS_WBR = WS_W + 30 * MiB;
constexpr size_t WS_XN = 40 * MiB;
constexpr size_t WS_RAW = WS_XN;
constexpr size_t WS_YG = WS_XN;
constexpr size_t WS_Z = 76 * MiB;
constexpr size_t WS_QKV = 148 * MiB;
constexpr size_t WS_F1 = 184 * MiB;
constexpr size_t WS_GL = WS_F1;
constexpr size_t WS_TZ = 202 * MiB;
constexpr size_t WS_MS = 204 * MiB;
constexpr size_t WS_QO = 212 * MiB;
constexpr size_t WS_MM = WS_QKV;
constexpr size_t WS_STASH = WS_F1;
constexpr size_t WS_KVF = 3 * MiB + 512 * 1024;
constexpr size_t WS_PD = WS_XN;
constexpr size_t WS_H = WS_Z;
constexpr size_t WS_WUQ = 2 * MiB + 768 * 1024;
constexpr size_t WS_WUKV = 3 * MiB;
constexpr size_t WS_D64 = 512 * 1024 + 64 * 1024;
constexpr size_t WS_WGLU = 2 * MiB + 512 * 1024;
constexpr size_t WS_CF = 3 * MiB + 128 * 1024;
constexpr size_t WS_WMF = 3 * MiB + 320 * 1024;
constexpr size_t WS_R = 220 * MiB;
constexpr size_t WS_XCB = 252 * MiB;
constexpr size_t OS_AT = 0;
constexpr size_t OS_BP = 1 * MiB;
constexpr size_t OS_DFTC = 53 * MiB;
constexpr size_t OS_SLOC = 17 * MiB;
constexpr size_t OS_KVB = 22 * MiB;
constexpr size_t OS_PM = 27 * MiB;
constexpr size_t OS_TZB = 41 * MiB;
constexpr size_t OS_CQ = 42 * MiB;
constexpr size_t OS_OC = 43 * MiB;
constexpr size_t OS_SS = 40 * MiB;
constexpr size_t WS_END = 256 * MiB;


#define LAS __attribute__((address_space(3)))
#define NT 512
__device__ __forceinline__ int l_tid() { int t = threadIdx.x; asm volatile("" : "+v"(t)); return t; }
__device__ __forceinline__ int l_bid() { int b = blockIdx.x; asm volatile("" : "+s"(b)); return b; }
__device__ __forceinline__ int l_grid() { int g = gridDim.x; asm volatile("" : "+s"(g)); return g; }
#define PH_IDS const int tid_ = l_tid(), bid_ = l_bid(), G_ = l_grid(); (void)tid_; (void)bid_; (void)G_
template <class AF, class BF, class EF>
__device__ __forceinline__ void gemm_tile(const AF& A, const BF& B, const EF& E, bool valid, int b, int m0, int n0, int M, int N, int K, bf16_t (*sA)[40], bf16_t (*sB)[40], int ht) {
    f32x4 accm[2][2];
#pragma unroll
    for (int i = 0; i < 2; ++i)
#pragma unroll
        for (int j = 0; j < 2; ++j) accm[i][j] = (f32x4){0.f, 0.f, 0.f, 0.f};
    const int w = ht >> 6, lane = ht & 63, wm = (w >> 1) * 32, wn = (w & 1) * 32, fr = lane & 15, fq = lane >> 4;
    for (int k0 = 0; k0 < K; k0 += 32) {
        __syncthreads();
#pragma unroll
        for (int i = 0; i < 8; ++i) {
            const int e = ht + i * 256;
            { const int m = e >> 5, k = e & 31; float v = 0.f; if (valid && m0 + m < M && k0 + k < K) v = A(b, m0 + m, k0 + k); sA[m][k] = f2bf(v); }
            { const int k = e >> 6, n = e & 63; float v = 0.f; if (valid && n0 + n < N && k0 + k < K) v = B(b, k0 + k, n0 + n); sB[n][k] = f2bf(v); }
        }
        __syncthreads();
        bf16x8 af[2], bfr[2];
#pragma unroll
        for (int i = 0; i < 2; ++i) { af[i] = *(const bf16x8*)&sA[wm + i * 16 + fr][fq * 8]; bfr[i] = *(const bf16x8*)&sB[wn + i * 16 + fr][fq * 8]; }
#pragma unroll
        for (int i = 0; i < 2; ++i)
#pragma unroll
            for (int j = 0; j < 2; ++j) accm[i][j] = __builtin_amdgcn_mfma_f32_16x16x32_bf16(af[i], bfr[j], accm[i][j], 0, 0, 0);
    }
    if (valid) {
#pragma unroll
        for (int i = 0; i < 2; ++i)
#pragma unroll
            for (int j = 0; j < 2; ++j)
#pragma unroll
                for (int rr = 0; rr < 4; ++rr) {
                    const int m = m0 + wm + i * 16 + fq * 4 + rr, n = n0 + wn + j * 16 + fr;
                    if (m < M && n < N) E(b, m, n, accm[i][j][rr]);
                }
    }
}
template <class AF, class BF, class EF>
__device__ __forceinline__ void gemm_phase(unsigned char* lds, const AF& A, const BF& B, const EF& E, int nbatch, int M, int N, int K) {
    PH_IDS; const int tid = tid_, half = tid >> 8, ht = tid & 255;
    bf16_t (*sA)[40] = (bf16_t (*)[40])(lds + half * 10240);
    bf16_t (*sB)[40] = (bf16_t (*)[40])(lds + half * 10240 + 5120);
    const int tm = (M + 63) >> 6, tn = (N + 63) >> 6, total = nbatch * tm * tn;
    for (int it0 = bid_ * 2; it0 < total; it0 += G_ * 2) {
        const int it = it0 + half; const bool valid = it < total;
        const int itc = valid ? it : 0;
        const int b = itc / (tm * tn), r = itc % (tm * tn), m0 = (r / tn) * 64, n0 = (r % tn) * 64;
        gemm_tile(A, B, E, valid, b, m0, n0, M, N, K, sA, sB, ht);
    }
    __syncthreads();
}
template <class T> static T zeroed() { T t; memset((void*)&t, 0, sizeof(T)); return t; }

struct A_bf16 { const bf16_t* p; long long ld; long long coff;
    __device__ float operator()(int, int m, int k) const { return bf2f(p[(size_t)m * ld + coff + k]); } };
struct A_bf16_scaled { const bf16_t* p; long long ld; long long coff; const float* rs; long long rsi; const float* w;
    __device__ float operator()(int, int m, int k) const { return bf2f(p[(size_t)m * ld + coff + k]) * rs[(size_t)m * 2 + rsi] * w[k]; } };
struct B_f32 { const float* p; long long ld; long long coff;
    __device__ float operator()(int, int k, int n) const { return p[(size_t)k * ld + coff + n]; } };
struct E_bf16 { bf16_t* p; long long ld; long long coff;
    __device__ void operator()(int, int m, int n, float v) const { p[(size_t)m * ld + coff + n] = f2bf(v); } };

#define XB_TMO      128
#define XB_XCNT(j)  (256  + 64 * (j))
#define XB_XSUB(j)  (1280 + 64 * (j))
#define XB_XGEN(j)  (2304 + 64 * (j))
#define XB_TOP      3328
#define XB_TOPGEN   3392
#define XCD_BAR_WORDS 3456
#define XB_SPIN_CAP (1u << 18)
__device__ __forceinline__ unsigned xb_ld(unsigned* p)              { return __hip_atomic_load(p, __ATOMIC_RELAXED, __HIP_MEMORY_SCOPE_AGENT); }
__device__ __forceinline__ unsigned xb_add(unsigned* p, unsigned v) { return __hip_atomic_fetch_add(p, v, __ATOMIC_RELAXED, __HIP_MEMORY_SCOPE_AGENT); }
__device__ __forceinline__ unsigned xb_xcc_id() { return (unsigned)__builtin_amdgcn_s_getreg((3 << 11) | 20) & 0xFu; }
#define XB_SPIN(cond, bar) do { unsigned _sp = 0; while (cond) { __builtin_amdgcn_s_sleep(1); \
    if ((++_sp & 255u) == 0u) { if (xb_ld(&(bar)[XB_TMO])) break; if (_sp > XB_SPIN_CAP) { atomicAdd(&(bar)[XB_TMO], 1u); break; } } } } while (0)
struct XcdBarrier { unsigned* bar; unsigned x; volatile LAS unsigned* st; };
__device__ __forceinline__ XcdBarrier xcd_barrier_post(unsigned* bar, volatile LAS unsigned* st) {
    XcdBarrier b; b.bar = bar; b.x = xb_xcc_id(); b.st = st;
    if (threadIdx.x == 0) (void)xb_add(&bar[XB_XCNT(b.x)], 1u);
    return b;
}
__device__ __forceinline__ void xcd_barrier_complete(unsigned* bar, unsigned x, unsigned& nloc, unsigned& nx) {
    const unsigned G = gridDim.x * gridDim.y * gridDim.z;
    unsigned sum, cnt, mine, sp = 0u;
    for (;;) {
        sum = 0u; cnt = 0u; mine = 0u;
#pragma unroll
        for (unsigned j = 0; j < 16; ++j) { const unsigned c = xb_ld(&bar[XB_XCNT(j)]); sum += c; cnt += (c > 0u) ? 1u : 0u; mine = (j == x) ? c : mine; }
        if (sum == G) break;
        __builtin_amdgcn_s_sleep(1);
        if ((++sp & 255u) == 0u) { if (xb_ld(&bar[XB_TMO])) break; if (sp > XB_SPIN_CAP) { atomicAdd(&bar[XB_TMO], 1u); break; } }
    }
    nloc = mine > 0u ? mine : 1u; nx = cnt > 0u ? cnt : 1u;
}
__device__ __forceinline__ void xcd_barrier(const XcdBarrier& b) {
    asm volatile("s_waitcnt vmcnt(0)" ::: "memory");
    __syncthreads();
    if (threadIdx.x == 0) {
        unsigned* bar = b.bar;
        __builtin_amdgcn_s_waitcnt(0);
        unsigned nloc = b.st[0], nx = b.st[1];
        if (nloc == 0u) { xcd_barrier_complete(bar, b.x, nloc, nx); b.st[0] = nloc; b.st[1] = nx; }
        const unsigned old = xb_add(&bar[XB_XSUB(b.x)], 1u);
        const unsigned gen = old / nloc;
        if (old + 1u == (gen + 1u) * nloc) {
            __builtin_amdgcn_fence(__ATOMIC_RELEASE, "agent");
            asm volatile("s_waitcnt vmcnt(0)" ::: "memory");
            const unsigned og = xb_add(&bar[XB_TOP], 1u);
            const unsigned tg = og / nx;
            if (og + 1u == (tg + 1u) * nx) xb_add(&bar[XB_TOPGEN], 1u);
            else XB_SPIN(xb_ld(&bar[XB_TOPGEN]) == tg, bar);
            __builtin_amdgcn_fence(__ATOMIC_ACQUIRE, "agent");
            xb_add(&bar[XB_XGEN(b.x)], 1u);
            asm volatile("s_waitcnt vmcnt(0)" ::: "memory");
        } else {
            XB_SPIN(xb_ld(&bar[XB_XGEN(b.x)]) == gen, bar);
            __builtin_amdgcn_fence(__ATOMIC_ACQUIRE, "agent");
            asm volatile("s_waitcnt vmcnt(0)" ::: "memory");
        }
    }
    __syncthreads();
}

__device__ __forceinline__ void dep_signal_x(unsigned* ctr, unsigned* sub, unsigned nloc) {
    asm volatile("s_waitcnt vmcnt(0)" ::: "memory");
    __syncthreads();
    if (threadIdx.x == 0) { const unsigned old = xb_add(sub, 1u);
        if (old + 1u == nloc) { __builtin_amdgcn_fence(__ATOMIC_RELEASE, "agent"); asm volatile("s_waitcnt vmcnt(0)" ::: "memory"); (void)xb_add(ctr, nloc); } }
}
__device__ __forceinline__ void dep_spin(unsigned* ctr, unsigned need, unsigned* bar) {
    XB_SPIN(xb_ld(ctr) < need, bar);
    __builtin_amdgcn_fence(__ATOMIC_ACQUIRE, "agent");
    asm volatile("s_waitcnt vmcnt(0)" ::: "memory");
}
namespace pg8 {
typedef unsigned u32x4 __attribute__((ext_vector_type(4)));
constexpr int BM = 256, BK = 64, HALF = 128, HTB = HALF * BK * 2, STAGE_BYTES = 8 * HTB, NXCD = 8, WGM = 8;
__device__ __forceinline__ int lds_byte(int r, int c) { const int st = (r >> 4) * 2 + (c >> 5), rr = r & 15, cc = c & 31, ob = rr * 64 + cc * 2; return st * 1024 + (ob ^ (((ob >> 9) & 1) << 5)); }
__device__ __forceinline__ void stage_rc(int b, int& R, int& C) { const int st = b / 1024, sb = b % 1024, swz = sb ^ (((sb >> 9) & 1) << 5); R = (st >> 1) * 16 + swz / 64; C = (st & 1) * 32 + (swz % 64) / 2; }
__device__ __forceinline__ int perm32(int rho) { const int n = rho >> 4, i = rho & 15; return 8 * (i >> 2) + 4 * n + (i & 3); }
struct Unit { const char* A; const char* B; unsigned lda, ldb; int nt, pm, pn, kind, aux; };
__device__ __forceinline__ unsigned cvt_pk_bf16(float lo, float hi) { unsigned r; asm volatile("v_cvt_pk_bf16_f32 %0, %1, %2" : "=v"(r) : "v"(lo), "v"(hi)); return r; }
__device__ __forceinline__ bool static_tile(int nM, int nN, int G, int c, int i, int& pm, int& pn) {
    const int nwg = nM * nN; const long L = (long)i * G + c; if (L >= nwg) return false;
    int wgid = (int)L; { const int q = nwg / NXCD, r = nwg % NXCD, xcd = wgid % NXCD, off = wgid / NXCD; wgid = (xcd < r ? xcd * (q + 1) : r * (q + 1) + (xcd - r) * q) + off; }
    const int nig = WGM * nN, gid = wgid / nig, fm = gid * WGM, gsz = (nM - fm) < WGM ? (nM - fm) : WGM;
    pm = fm + ((wgid % nig) % gsz); pn = (wgid % nig) / gsz; return true;
}
template <class Epi, class Sched>
__device__ __forceinline__ void gemm_phase(LAS unsigned char* lds, const Sched& S, const Epi& E) {
    const int tid = l_tid(), wid = __builtin_amdgcn_readfirstlane(tid >> 6), lane = tid & 63, wr = wid >> 2, wc = wid & 3, fr = lane & 15, fq = lane >> 4;
    int sR0, sC20;
    { int R, C; stage_rc(tid * 16, R, C); sR0 = R; sC20 = C * 2; }
#define PG8_R(i) (sR0 + 64 * (i))
#define PG8_RB(i) ((PG8_R(i) & ~31) + perm32(PG8_R(i) & 31))
    const size_t kstep = (size_t)(BK * 2);
    const unsigned ldsw = (unsigned)wid * 1024u;
    const int aoff = lds_byte(wr * 64 + fr, fq * 8), boff = lds_byte(wc * 32 + fr, fq * 8);
#define PG8_SA(b, h) (((b) * 2 + (h)) * HTB)
#define PG8_SB(b, h) ((4 + (b) * 2 + (h)) * HTB)
#define PG8_STAGE_A(bufoff, gbase, ld) do { \
        __builtin_amdgcn_global_load_lds((const unsigned*)((const char*)(gbase) + (unsigned)(PG8_R(0) * (ld) + sC20)), (LAS unsigned*)(lds + (bufoff) + ldsw), 16, 0, 0); \
        __builtin_amdgcn_global_load_lds((const unsigned*)((const char*)(gbase) + (unsigned)(PG8_R(1) * (ld) + sC20)), (LAS unsigned*)(lds + (bufoff) + ldsw + 8192), 16, 0, 0); } while (0)
#define PG8_STAGE_B(bufoff, gbase, ld) do { \
        __builtin_amdgcn_global_load_lds((const unsigned*)((const char*)(gbase) + (unsigned)(PG8_RB(0) * (ld) + sC20)), (LAS unsigned*)(lds + (bufoff) + ldsw), 16, 0, 0); \
        __builtin_amdgcn_global_load_lds((const unsigned*)((const char*)(gbase) + (unsigned)(PG8_RB(1) * (ld) + sC20)), (LAS unsigned*)(lds + (bufoff) + ldsw + 8192), 16, 0, 0); } while (0)
#define PG8_LDA(dst, b, h) do { _Pragma("unroll") for (int m = 0; m < 4; ++m) _Pragma("unroll") for (int k = 0; k < 2; ++k) dst[m][k] = *(const LAS bf16x8*)(lds + PG8_SA(b, h) + aoff + m * 2048 + k * 1024); } while (0)
#define PG8_LDB(dst, b, h) do { _Pragma("unroll") for (int n = 0; n < 2; ++n) _Pragma("unroll") for (int k = 0; k < 2; ++k) dst[n][k] = *(const LAS bf16x8*)(lds + PG8_SB(b, h) + boff + n * 2048 + k * 1024); } while (0)
#define PG8_MMA(ai, bj, At, Bt) do { __builtin_amdgcn_s_setprio(1); _Pragma("unroll") for (int m = 0; m < 4; ++m) _Pragma("unroll") for (int n = 0; n < 2; ++n) _Pragma("unroll") for (int k = 0; k < 2; ++k) \
        acc[ai][bj][m][n] = __builtin_amdgcn_mfma_f32_16x16x32_bf16(Bt[n][k], At[m][k], acc[ai][bj][m][n], 0, 0, 0); __builtin_amdgcn_s_setprio(0); } while (0)
#define PG8_WAIT_V(n) asm volatile("s_waitcnt vmcnt(" #n ")" ::: "memory")
#define PG8_WAIT_L(n) asm volatile("s_waitcnt lgkmcnt(" #n ")" ::: "memory")
#define PG8_BAR __builtin_amdgcn_s_barrier()
#define PG8_SCHED __builtin_amdgcn_sched_barrier(0)
    Unit cur, nxt; int ui = 0;
    if (!S.next(0, cur)) return;
    f32x4 prev_;
    if constexpr (Epi::PRE) { E.pre_issue(cur, tid, prev_); E.pre_commit(tid, 0, prev_); }
    f32x4 acc[2][2][4][2];
#pragma unroll
    for (int a = 0; a < 2; ++a)
#pragma unroll
        for (int b = 0; b < 2; ++b)
#pragma unroll
            for (int m = 0; m < 4; ++m)
#pragma unroll
                for (int n = 0; n < 2; ++n) acc[a][b][m][n] = (f32x4){0.f, 0.f, 0.f, 0.f};
    bf16x8 At[4][2], B0[2][2], B1[2][2];
    const char* cA = cur.A; const char* cB = cur.B;
    int clda = cur.lda, cldb = cur.ldb;
    PG8_STAGE_B(PG8_SB(0, 0), cB, cldb); PG8_STAGE_B(PG8_SB(0, 1), cB + (size_t)HALF * cldb, cldb); PG8_STAGE_A(PG8_SA(0, 0), cA, clda); PG8_STAGE_A(PG8_SA(0, 1), cA + (size_t)HALF * clda, clda);
    if (wr == 1) PG8_BAR;
    PG8_WAIT_V(2); PG8_BAR;
    PG8_STAGE_B(PG8_SB(1, 0), cB + kstep, cldb); PG8_STAGE_A(PG8_SA(1, 0), cA + kstep, clda); PG8_STAGE_B(PG8_SB(1, 1), cB + (size_t)HALF * cldb + kstep, cldb);
    PG8_WAIT_V(6); PG8_BAR;
    for (;;) {
        const bool has_next = S.next(ui + 1, nxt);
        const char* nA = has_next ? nxt.A : cA; const char* nB = has_next ? nxt.B : cB;
        const int nlda = has_next ? (int)nxt.lda : clda, nldb = has_next ? (int)nxt.ldb : cldb;
        const int nt = cur.nt;
        for (int t = 0; t < nt; t += 2) {
            const bool last = (t == nt - 2);
            const char* a1 = cA + (size_t)(t + 1) * kstep;
            const char* a2 = last ? nA : cA + (size_t)(t + 2) * kstep; const char* b2 = last ? nB : cB + (size_t)(t + 2) * kstep;
            const char* a3 = a2 + kstep; const char* b3 = b2 + kstep;
            const int lda2 = last ? nlda : clda, ldb2 = last ? nldb : cldb;
            PG8_LDB(B0, 0, 0); PG8_LDB(B1, 0, 1); PG8_SCHED; PG8_LDA(At, 0, 0); PG8_STAGE_A(PG8_SA(1, 1), a1 + (size_t)HALF * clda, clda);
            PG8_WAIT_V(8); PG8_WAIT_L(0); PG8_BAR; PG8_MMA(0, 0, At, B0); PG8_MMA(0, 1, At, B1); PG8_BAR; PG8_SCHED;
            PG8_LDA(At, 0, 1); PG8_STAGE_B(PG8_SB(0, 0), b2, ldb2); PG8_STAGE_B(PG8_SB(0, 1), b2 + (size_t)HALF * ldb2, ldb2); PG8_STAGE_A(PG8_SA(0, 0), a2, lda2);
            PG8_WAIT_V(8); PG8_WAIT_L(0); PG8_BAR; PG8_MMA(1, 0, At, B0); PG8_MMA(1, 1, At, B1); PG8_BAR; PG8_SCHED;
            PG8_LDB(B0, 1, 0); PG8_LDB(B1, 1, 1); PG8_SCHED; PG8_LDA(At, 1, 0); PG8_STAGE_A(PG8_SA(0, 1), a2 + (size_t)HALF * lda2, lda2);
            PG8_WAIT_V(8); PG8_WAIT_L(0); PG8_BAR; PG8_MMA(0, 0, At, B0); PG8_MMA(0, 1, At, B1); PG8_BAR; PG8_SCHED;
            PG8_LDA(At, 1, 1); PG8_STAGE_B(PG8_SB(1, 0), b3, ldb2); PG8_STAGE_B(PG8_SB(1, 1), b3 + (size_t)HALF * ldb2, ldb2); PG8_STAGE_A(PG8_SA(1, 0), a3, lda2);
            PG8_WAIT_V(8); PG8_WAIT_L(0); PG8_BAR; PG8_MMA(1, 0, At, B0); PG8_MMA(1, 1, At, B1); PG8_BAR; PG8_SCHED;
        }
        if (wr == 0) PG8_BAR;
        if constexpr (Epi::PRE) { if (has_next) E.pre_issue(nxt, tid, prev_); E(acc, cur, wr, wc, fr, fq, ui & 1); if (has_next) E.pre_commit(tid, (ui + 1) & 1, prev_); }
        else E(acc, cur, wr, wc, fr, fq);
        if (!has_next) break;
#pragma unroll
        for (int a = 0; a < 2; ++a)
#pragma unroll
            for (int b = 0; b < 2; ++b)
#pragma unroll
                for (int m = 0; m < 4; ++m)
#pragma unroll
                    for (int n = 0; n < 2; ++n) acc[a][b][m][n] = (f32x4){0.f, 0.f, 0.f, 0.f};
        cur = nxt; cA = nA; cB = nB; clda = nlda; cldb = nldb; ++ui;
        if (wr == 1) PG8_BAR;
    }
    PG8_WAIT_V(0);
    PG8_BAR;
#undef PG8_SA
#undef PG8_SB
#undef PG8_STAGE_A
#undef PG8_RB
#undef PG8_R
#undef PG8_STAGE_B
#undef PG8_LDA
#undef PG8_LDB
#undef PG8_MMA
#undef PG8_WAIT_V
#undef PG8_WAIT_L
#undef PG8_BAR
#undef PG8_SCHED
}
}

__device__ __forceinline__ pg8::u32x4 pack8(const f32x4 a, const f32x4 b) { pg8::u32x4 w; w.x = pg8::cvt_pk_bf16(a[0], a[1]); w.y = pg8::cvt_pk_bf16(a[2], a[3]); w.z = pg8::cvt_pk_bf16(b[0], b[1]); w.w = pg8::cvt_pk_bf16(b[2], b[3]); return w; }
__device__ __forceinline__ void unpack8(const pg8::u32x4 w, f32x4& a, f32x4& b) {
    a[0] = __uint_as_float(w.x << 16); a[1] = __uint_as_float(w.x & 0xffff0000u); a[2] = __uint_as_float(w.y << 16); a[3] = __uint_as_float(w.y & 0xffff0000u);
    b[0] = __uint_as_float(w.z << 16); b[1] = __uint_as_float(w.z & 0xffff0000u); b[2] = __uint_as_float(w.w << 16); b[3] = __uint_as_float(w.w & 0xffff0000u); }
namespace fa {
typedef float f32x16 __attribute__((ext_vector_type(16)));
typedef short s16x4 __attribute__((ext_vector_type(4)));
typedef unsigned u32x4 __attribute__((ext_vector_type(4)));
typedef unsigned u32x2 __attribute__((ext_vector_type(2)));
__device__ __forceinline__ s16x4 vtr(const LAS char* p) { return __builtin_bit_cast(s16x4, __builtin_amdgcn_ds_read_tr16_b64_v4i16((LAS s16x4*)p)); }
__device__ __forceinline__ unsigned pk2(float lo, float hi) { unsigned r; asm volatile("v_cvt_pk_bf16_f32 %0, %1, %2" : "=v"(r) : "v"(lo), "v"(hi)); return r; }
typedef __bf16 bf16v2_t __attribute__((ext_vector_type(2)));
typedef float f32v2_t __attribute__((ext_vector_type(2)));
__device__ __forceinline__ unsigned pk2n(float lo, float hi) { return __builtin_bit_cast(unsigned, __builtin_convertvector((f32v2_t){lo, hi}, bf16v2_t)); }
__device__ __forceinline__ bf16x8 pack_p(const f32x16& p, int base) { u32x4 w; w.x = pk2(p[base], p[base + 1]); w.y = pk2(p[base + 2], p[base + 3]); w.z = pk2(p[base + 4], p[base + 5]); w.w = pk2(p[base + 6], p[base + 7]); return __builtin_bit_cast(bf16x8, w); }
__device__ __forceinline__ int crow(int r, int hi) { return (r & 3) + 8 * (r >> 2) + 4 * hi; }
__device__ __forceinline__ void pv_tile(f32x16& o0, f32x16& o1, const LAS char* vb, const bf16x8 (&pf)[4]) {
#pragma unroll
    for (int ks = 0; ks < 4; ++ks) {
        const s16x4 a0 = vtr(vb + ks * 1024), a1 = vtr(vb + ks * 1024 + 512), b0 = vtr(vb + 4096 + ks * 1024), b1 = vtr(vb + 4096 + ks * 1024 + 512);
        const bf16x8 v0 = (bf16x8){a0[0], a0[1], a0[2], a0[3], a1[0], a1[1], a1[2], a1[3]}, v1 = (bf16x8){b0[0], b0[1], b0[2], b0[3], b1[0], b1[1], b1[2], b1[3]};
        o0 = __builtin_amdgcn_mfma_f32_32x32x16_bf16(v0, pf[ks], o0, 0, 0, 0);
        o1 = __builtin_amdgcn_mfma_f32_32x32x16_bf16(v1, pf[ks], o1, 0, 0, 0);
    }
}
constexpr int KP_A = 208, KT_A = 64 * KP_A, VT = 8192, BUF_A = KT_A + VT;
constexpr int KP_R = 144, KT_R = 64 * KP_R, BUF_R = KT_R + VT;
}

#define GSTRIDE(gi, total) for (int gi = bid_ * NT + tid_; gi < (total); gi += G_ * NT)
__device__ __forceinline__ void ph_mod(unsigned char* lds, const float* c, const float* c_ctx, const float* ada_w, const float* ada_b, float* mod) { PH_IDS;
    LAS float* sl = (LAS float*)lds;
    LAS float* red = sl + 9 * 1024;
    for (int e = tid_; e < 9 * 1024; e += NT) { const int j = e >> 10, k = e & 1023; const float v = j < 8 ? c[j * 1024 + k] : c_ctx[k]; sl[e] = siluf_(v); }
    __syncthreads();
    const int nn = tid_ & 63, ks = tid_ >> 6;
    for (int u = bid_; u < 2 * 96; u += G_) {
        const int l = u / 96, n = (u % 96) * 64 + nn;
        float acc[9];
#pragma unroll
        for (int j = 0; j < 9; ++j) acc[j] = 0.f;
        const float* w = ada_w + ((size_t)l * 1024 + ks * 128) * 6144 + n;
#pragma unroll 4
        for (int k4 = 0; k4 < 32; ++k4) {
            const float w0 = w[(size_t)(4 * k4) * 6144], w1 = w[(size_t)(4 * k4 + 1) * 6144], w2 = w[(size_t)(4 * k4 + 2) * 6144], w3 = w[(size_t)(4 * k4 + 3) * 6144];
#pragma unroll
            for (int j = 0; j < 9; ++j) { const f32x4 s4 = *(const LAS f32x4*)(sl + j * 1024 + ks * 128 + 4 * k4); acc[j] += s4[0] * w0 + s4[1] * w1 + s4[2] * w2 + s4[3] * w3; } }
        __syncthreads();
#pragma unroll
        for (int j = 0; j < 9; ++j) red[(ks * 9 + j) * 64 + nn] = acc[j];
        __syncthreads();
        for (int e = tid_; e < 9 * 64; e += NT) { const int j = e >> 6, q = e & 63; float sum = 0.f;
#pragma unroll
            for (int r = 0; r < 8; ++r) sum += red[(r * 9 + j) * 64 + q];
            const int col = (u % 96) * 64 + q; mod[((size_t)l * 9 + j) * 6144 + col] = sum + ada_b[l * 6144 + col]; }
    }
    __syncthreads();
}
__device__ __forceinline__ void ph_trig(float* trig, bf16_t* d64) { PH_IDS; GSTRIDE(i, 2048) { const float xx = (float)i * (1.f / 1024.f); trig[i] = cospif(xx); trig[2048 + i] = sinpif(xx); }
    GSTRIDE(i, 128 * 64) { const int n = i >> 6, c = i & 63, m = n & 63; const float xx = (float)((m * c) & 63) * (1.f / 32.f); d64[i] = f2bf(n < 64 ? cospif(xx) : sinpif(xx)); } }
__device__ __forceinline__ double2 lam_pow(double re, double im, double dt, int k) {
    const double m = (double)__expf((float)(re * dt * k));
    double xx = im * dt * (double)k * 0.318309886183790671538;
    xx -= 2.0 * rint(xx * 0.5);
    const float xf = (float)xx;
    return make_double2(m * (double)cospif(xf), m * (double)sinpif(xf));
}
__device__ __forceinline__ void ph_s5_lp(int l, const float* lam_re, const float* lam_im, const float* log_step, const float* b_re, const float* b_im, float2* LP, float2* BB, float* lamT) { PH_IDS;
    GSTRIDE(it, 2 * 16 * 64 * 81) {
        const int i = it / 81, k = it % 81;
        const int d = i / 1024, g = (i / 64) % 16, p = i % 64;
        const size_t li = ((size_t)(l * 2 + d) * 16 + g) * 64 + p;
        const double re = lam_re[li], im = lam_im[li], dt = (double)expf(log_step[(l * 2 + d) * 16 + g]);
        if (k <= 64) {
            const double2 v = lam_pow(re, im, dt, k); LP[(size_t)i * 65 + k] = make_float2((float)v.x, (float)v.y);
            if (k == 64) { lamT[((size_t)(g * 2 + d) * 64 + p) * 2 + 0] = (float)v.x; lamT[((size_t)(g * 2 + d) * 64 + p) * 2 + 1] = (float)v.y; }
        } else {
            const int h = k - 65;
            const double2 l1 = lam_pow(re, im, dt, 1);
            const double nr = l1.x - 1.0, ni = l1.y, den = re * re + im * im;
            const double fr = (nr * re + ni * im) / den, fi = (ni * re - nr * im) / den;
            const double br = b_re[li * 16 + h], bi = b_im[li * 16 + h]; BB[(size_t)i * 16 + h] = make_float2((float)(fr * br - fi * bi), (float)(fr * bi + fi * br));
        }
    }
}
__device__ __forceinline__ void ph_s5_tz(unsigned char* lds_, int l, const float2* LP, const float2* BB, const float* c_re, const float* c_im, float* TZD, int vb, int vg) { PH_IDS;
    typedef float f32x2_ __attribute__((ext_vector_type(2)));
    LAS f32x2_* sC = (LAS f32x2_*)lds_;
    LAS f32x2_* sL = sC + 16 * 64;
    LAS f32x2_* sB = sL + 64 * 8;
    for (int it = vb; it < 256; it += vg) {
        const int u = it >> 3, ts = it & 7, g = u >> 1, d = u & 1;
        const size_t cb = (((size_t)(l * 2 + d) * 16 + g) * 16) * 64, gb = (size_t)d * 16 + g;
        const float cr0 = c_re[cb + tid_], ci0 = c_im[cb + tid_], cr1 = c_re[cb + NT + tid_], ci1 = c_im[cb + NT + tid_];
        const float2 lpv = LP[gb * 64 * 65 + (size_t)(tid_ >> 3) * 65 + ts * 8 + (tid_ & 7)];
        const float2 bb0 = BB[gb * 64 * 16 + tid_], bb1 = BB[gb * 64 * 16 + NT + tid_];
        __syncthreads();
        sC[tid_] = (f32x2_){cr0, ci0}; sC[NT + tid_] = (f32x2_){cr1, ci1}; sL[tid_] = (f32x2_){lpv.x, lpv.y}; sB[tid_] = (f32x2_){bb0.x, bb0.y}; sB[NT + tid_] = (f32x2_){bb1.x, bb1.y};
        __syncthreads();
        const int pair = tid_ & 127, tl = pair >> 4, h = pair & 15, qg = tid_ >> 7;
        f32x4 acc = (f32x4){0.f, 0.f, 0.f, 0.f};
#pragma unroll 4
        for (int p = 0; p < 64; ++p) {
            const f32x2_ c = sC[h * 64 + p], lp = sL[p * 8 + tl];
            const float er = c.x * lp.x - c.y * lp.y, ei = c.x * lp.y + c.y * lp.x;
            const f32x4 b01 = *(const LAS f32x4*)&sB[p * 16 + 4 * qg], b23 = *(const LAS f32x4*)&sB[p * 16 + 4 * qg + 2];
            acc[0] += er * b01[0] - ei * b01[1]; acc[1] += er * b01[2] - ei * b01[3]; acc[2] += er * b23[0] - ei * b23[1]; acc[3] += er * b23[2] - ei * b23[3];
        }
        *(f32x4*)(TZD + (((gb * 64) + ts * 8 + tl) * 16 + h) * 16 + 4 * qg) = acc;
    }
    __syncthreads();
}
__device__ __forceinline__ void ph_s5_ms(const float2* LP, const float2* BB, bf16_t* MST, int vb, int vg) { PH_IDS;
    for (int i0 = vb * NT + tid_; i0 < 16 * 256 * 128; i0 += 3 * vg * NT) {
        float2 lp[3]; f32x4 bb[3][4];
#pragma unroll
        for (int k = 0; k < 3; ++k) { const int i = i0 + k * vg * NT;
            if (i < 16 * 256 * 128) { const int g = i / (256 * 128), n = (i / 128) % 256, sh0 = (i % 128) * 8, d = n >> 7, p = n & 63, s = sh0 >> 4, hp0 = sh0 & 15;
                const size_t gi = ((size_t)d * 16 + g) * 64 + p;
                lp[k] = LP[gi * 65 + (d == 0 ? 63 - s : s)];
#pragma unroll
                for (int q = 0; q < 4; ++q) bb[k][q] = *(const f32x4*)(BB + gi * 16 + hp0 + 2 * q); } }
#pragma unroll
        for (int k = 0; k < 3; ++k) { const int i = i0 + k * vg * NT;
            if (i < 16 * 256 * 128) { const int g = i / (256 * 128), n = (i / 128) % 256, sh0 = (i % 128) * 8, im = (n >> 6) & 1;
                float v[8];
#pragma unroll
                for (int q = 0; q < 4; ++q) { v[2 * q] = im ? lp[k].x * bb[k][q][1] + lp[k].y * bb[k][q][0] : lp[k].x * bb[k][q][0] - lp[k].y * bb[k][q][1];
                    v[2 * q + 1] = im ? lp[k].x * bb[k][q][3] + lp[k].y * bb[k][q][2] : lp[k].x * bb[k][q][2] - lp[k].y * bb[k][q][3]; }
                *(pg8::u32x4*)(MST + ((size_t)g * 256 + n) * 1024 + sh0) = pack8((f32x4){v[0], v[1], v[2], v[3]}, (f32x4){v[4], v[5], v[6], v[7]}); } }
    }
}
__device__ __forceinline__ void ph_s5_qo(int l, const float2* LP, const float* c_re, const float* c_im, bf16_t* QOT, int vb, int vg) { PH_IDS;
    for (int i = vb * NT + tid_; i < 16 * 1024 * 32; i += vg * NT) {
        const int g = i / (1024 * 32), th = (i / 32) % 1024, j0 = (i % 32) * 8, d = j0 >> 7, im = (j0 >> 6) & 1, p0 = j0 & 63, t = th >> 4, h = th & 15;
        const size_t ci = (((size_t)(l * 2 + d) * 16 + g) * 16 + h) * 64 + p0;
        const int e = d == 0 ? t + 1 : 64 - t;
        float v[8];
#pragma unroll
        for (int q = 0; q < 8; ++q) { const float cr = c_re[ci + q], cim = c_im[ci + q]; const float2 lp = LP[(((size_t)d * 16 + g) * 64 + p0 + q) * 65 + e]; v[q] = im ? -(cr * lp.y + cim * lp.x) : cr * lp.x - cim * lp.y; }
        *(pg8::u32x4*)(QOT + ((size_t)g * 1024 + th) * 256 + j0) = pack8((f32x4){v[0], v[1], v[2], v[3]}, (f32x4){v[4], v[5], v[6], v[7]});
    }
}
__device__ __forceinline__ void ph_wmf(const float* w, const float* mod, float* wmf) { PH_IDS;
    GSTRIDE(i, 9 * 1024) { const int b = i >> 10, c = i & 1023; wmf[i] = w[c] * (1.f + mod[(size_t)b * 6144 + 4 * 1024 + c]); }
}
__device__ __forceinline__ void ph_cf_mfma(unsigned char* lds_, const bf16_t* W1T, const float* mod, float* cf, int vb, int vg) {
    const int tid = l_tid(), lane = tid & 63, kk = __builtin_amdgcn_readfirstlane(tid >> 6), i16 = lane & 15, kq = lane >> 4;
    LAS float* red = (LAS float*)lds_;
    for (int nt = vb; nt < 256; nt += vg) {
        f32x4 acc = (f32x4){0.f, 0.f, 0.f, 0.f};
#pragma unroll
        for (int s4 = 0; s4 < 4; ++s4) { const int k0 = kk * 128 + s4 * 32 + kq * 8;
            pg8::u32x4 aw = (pg8::u32x4){0u, 0u, 0u, 0u};
            if (i16 < 9) { const float* sp = mod + (size_t)i16 * 6144 + 3 * 1024 + k0; aw = pack8(*(const f32x4*)sp, *(const f32x4*)(sp + 4)); }
            const bf16x8 bw = *(const bf16x8*)(W1T + (size_t)(nt * 16 + i16) * 1024 + k0);
            acc = __builtin_amdgcn_mfma_f32_16x16x32_bf16(__builtin_bit_cast(bf16x8, aw), bw, acc, 0, 0, 0); }
        __syncthreads();
#pragma unroll
        for (int r = 0; r < 4; ++r) red[(kk * 16 + 4 * kq + r) * 16 + i16] = acc[r];
        __syncthreads();
        if (tid < 144) { float a = 0.f;
#pragma unroll
            for (int w = 0; w < 8; ++w) a += red[w * 256 + tid];
            cf[(size_t)(tid >> 4) * DFF + nt * 16 + (tid & 15)] = a; }
    }
    __syncthreads();
}
template <int XIN>
__device__ __forceinline__ void ph_adarms(const void* xlat, const void* xctx, const float* w, const float* mod, int sh_chunk, int sc_chunk, bf16_t* out, int nrows) { PH_IDS;
    const int wave = (bid_ * NT + tid_) >> 6, lane = tid_ & 63, nw = (G_ * NT) >> 6;
    f32x4 wv[4];
#pragma unroll
    for (int j = 0; j < 4; ++j) wv[j] = *(const f32x4*)(w + j * 256 + lane * 4);
    for (int row0 = wave; row0 < nrows; row0 += 3 * nw) {
        f32x4 v[3][4], sc[3][4], sh[3][4];
#pragma unroll
        for (int k = 0; k < 3; ++k) { const int row = row0 + k * nw;
            if (row < nrows) {
                if constexpr (XIN == 0) { const float* x = row < RL ? (const float*)xlat + (size_t)row * DM : (const float*)xctx + (size_t)(row - RL) * DM;
#pragma unroll
                    for (int j = 0; j < 4; ++j) v[k][j] = *(const f32x4*)(x + j * 256 + lane * 4); }
                else { const bf16_t* x = row < RL ? (const bf16_t*)xlat + (size_t)row * DM : (const bf16_t*)xctx + (size_t)(row - RL) * DM;
#pragma unroll
                    for (int j = 0; j < 4; ++j) { const fa::u32x2 r = *(const fa::u32x2*)(x + j * 256 + lane * 4); v[k][j] = (f32x4){__uint_as_float(r.x << 16), __uint_as_float(r.x & 0xffff0000u), __uint_as_float(r.y << 16), __uint_as_float(r.y & 0xffff0000u)}; } }
                const float* mrow = mod + (size_t)row_modidx(row) * 6144;
#pragma unroll
                for (int j = 0; j < 4; ++j) { const int c0 = j * 256 + lane * 4; sc[k][j] = *(const f32x4*)(mrow + sc_chunk * 1024 + c0); sh[k][j] = *(const f32x4*)(mrow + sh_chunk * 1024 + c0); }
            } }
#pragma unroll
        for (int k = 0; k < 3; ++k) { const int row = row0 + k * nw;
            if (row < nrows) {
                float ss = 0.f;
#pragma unroll
                for (int j = 0; j < 4; ++j) ss += v[k][j][0] * v[k][j][0] + v[k][j][1] * v[k][j][1] + v[k][j][2] * v[k][j][2] + v[k][j][3] * v[k][j][3];
#pragma unroll
                for (int o = 1; o < 64; o <<= 1) ss += __shfl_xor(ss, o);
                const float rstd = rsqrtf(ss * (1.f / DM) + EPS);
#pragma unroll
                for (int j = 0; j < 4; ++j) { const int c0 = j * 256 + lane * 4;
                    const f32x4 y = v[k][j] * rstd * wv[j] * (sc[k][j] + 1.f) + sh[k][j];
                    fa::u32x2 o; o.x = fa::pk2(y[0], y[1]); o.y = fa::pk2(y[2], y[3]);
                    *(fa::u32x2*)(out + (size_t)row * DM + c0) = o; }
            } }
    }
}
__device__ __forceinline__ void ph_mla_stats(const bf16_t* Z, float* rs) { PH_IDS;
    const int wave = (bid_ * NT + tid_) >> 6, lane = tid_ & 63, nw = (G_ * NT) >> 6;
    for (int row = wave; row < RT; row += nw) {
        const bf16_t* z = Z + (size_t)row * ZW; float sq = 0.f, sk = 0.f;
#pragma unroll
        for (int j = 0; j < 4; ++j) { const float v = bf2f(z[C_QC + j * 64 + lane]); sq += v * v; }
#pragma unroll
        for (int j = 0; j < 2; ++j) { const float v = bf2f(z[C_KVC + j * 64 + lane]); sk += v * v; }
#pragma unroll
        for (int o = 1; o < 64; o <<= 1) { sq += __shfl_xor(sq, o); sk += __shfl_xor(sk, o); }
        if (lane == 0) { rs[(size_t)row * 2] = rsqrtf(sq * (1.f / 256) + EPS); rs[(size_t)row * 2 + 1] = rsqrtf(sk * (1.f / 128) + EPS); }
    }
}
__device__ __forceinline__ void ph_mla_post(const bf16_t* Z, const bf16_t* qraw, const bf16_t* kvraw, const float* qkq, const float* qkk, bf16_t* Q, bf16_t* Kb, bf16_t* Vb) { PH_IDS;
    GSTRIDE(gi, RT * 8) {
        const int row = gi >> 3, h = (gi >> 1) & 3, isk = gi & 1;
        const bool lat = row < RL; const int b = row_batch(row), t = lat ? (row & 2047) : ((row - RL) & 255);
        const int qi = lat ? t : 2048 + t, ki = lat ? 256 + t : t;
        float v[96];
        float ss = 0.f;
        if (!isk) {
#pragma unroll
            for (int i = 0; i < 96; ++i) v[i] = bf2f(qraw[(size_t)row * 384 + h * 96 + i]);
        } else {
#pragma unroll
            for (int i = 0; i < 64; ++i) v[i] = bf2f(kvraw[(size_t)row * 512 + h * 128 + i]);
#pragma unroll
            for (int i = 0; i < 32; ++i) v[64 + i] = bf2f(Z[(size_t)row * ZW + C_KR + i]);
        }
#pragma unroll
        for (int i = 0; i < 96; ++i) ss += v[i] * v[i];
        const float rr = rsqrtf(ss * (1.f / 96) + EPS) * (isk ? 1.f : 0.14724727430627066f);
        const float* wv = isk ? qkk : qkq;
#pragma unroll
        for (int i = 0; i < 96; ++i) v[i] = v[i] * rr * wv[i];
        if (lat) {
            const float prow = (float)(t >> 6), pcol = (float)(t & 63);
#pragma unroll
            for (int part = 0; part < 2; ++part) { const float pos = part ? pcol : prow; const int base = 64 + part * 16;
#pragma unroll
                for (int j = 0; j < 8; ++j) { const float fr = exp2f(-(float)j * (13.287712379549449f / 8.f)), a = pos * fr, cs = __cosf(a), sn = __sinf(a);
                    const float x1 = v[base + j], x2 = v[base + 8 + j]; v[base + j] = x1 * cs - x2 * sn; v[base + 8 + j] = x1 * sn + x2 * cs; } }
        }
        bf16_t* o = isk ? Kb + ((size_t)(b * 4 + h) * 2304 + ki) * 96 : Q + ((size_t)(b * 4 + h) * 2304 + qi) * 96;
#pragma unroll
        for (int i = 0; i < 96; ++i) o[i] = f2bf(v[i]);
        if (isk) { bf16_t* vo = Vb + ((size_t)(b * 4 + h) * 2304 + ki) * 64; for (int i = 0; i < 64; ++i) vo[i] = kvraw[(size_t)row * 512 + h * 128 + 64 + i]; }
    }
}
__device__ __forceinline__ void ph_attn(unsigned char* lds, const bf16_t* Q, const bf16_t* Kb, const bf16_t* Vb, bf16_t* Z, int with_ctx) { PH_IDS;
    float (*sK)[96] = (float (*)[96])lds; float (*sV)[64] = (float (*)[64])(lds + 32 * 96 * 4);
    const int nunits = 32 * (8 + (with_ctx ? 1 : 0));
    const int qt = tid_ & 255, dh = (tid_ >> 8) * 32;
    for (int u = bid_; u < nunits; u += G_) {
        const int bh = u % 32, qb = u / 32;
        const bool lat = qb < 8;
        const int qi = qb * 256 + qt, nkeys = lat ? 2304 : 256;
        float q[96], o[32];
        const bf16_t* qp = Q + ((size_t)bh * 2304 + qi) * 96;
#pragma unroll
        for (int i = 0; i < 96; ++i) q[i] = bf2f(qp[i]) * 0.10206207261596577f;
#pragma unroll
        for (int i = 0; i < 32; ++i) o[i] = 0.f;
        float mx = -1e30f, l = 0.f;
        for (int k0 = 0; k0 < nkeys; k0 += 32) {
            __syncthreads();
            for (int e = tid_; e < 32 * 96; e += NT) sK[e / 96][e % 96] = bf2f(Kb[((size_t)bh * 2304 + k0) * 96 + e]);
            for (int e = tid_; e < 32 * 64; e += NT) sV[e / 64][e % 64] = bf2f(Vb[((size_t)bh * 2304 + k0) * 64 + e]);
            __syncthreads();
#pragma unroll 1
            for (int j = 0; j < 32; ++j) { float a = 0.f;
#pragma unroll
                for (int i = 0; i < 96; ++i) a += q[i] * sK[j][i];
                if (a > mx) { const float corr = __expf(mx - a); mx = a; l *= corr;
#pragma unroll
                    for (int i = 0; i < 32; ++i) o[i] *= corr; }
                const float p = __expf(a - mx); l += p;
#pragma unroll
                for (int i = 0; i < 32; ++i) o[i] += p * sV[j][dh + i]; }
        }
        const int b = bh >> 2, h = bh & 3;
        const int row = lat ? b * 2048 + qi : RL + b * 256 + (qi - 2048);
        const float inv = 1.f / l;
#pragma unroll
        for (int i = 0; i < 32; ++i) Z[(size_t)row * ZW + C_QC + h * 64 + dh + i] = f2bf(o[i] * inv);
    }
    __syncthreads();
}
__device__ __forceinline__ void ph_f1(const bf16_t* Z, const float* trig, bf16_t* F1lat, bf16_t* F1ctx) { PH_IDS;
    GSTRIDE(gi, RT * 256) {
        const int row = gi >> 8, gm = gi & 255, g = gm >> 6, m = gm & 63;
        float a = 0.f, bsum = 0.f;
        const bf16_t* u = Z + (size_t)row * ZW + C_FU + g * 64;
        for (int c = 0; c < 64; ++c) { const float v = bf2f(u[c]); const int idx = ((m * c) & 63) * 32; a += v * trig[idx]; bsum += v * trig[2048 + idx]; }
        if (row < RL) { const int b = row >> 11, t = row & 2047; bf16_t* o = F1lat + ((size_t)(b * 256 + gm) * 2) * 2048; o[t] = f2bf(a); o[2048 + t] = f2bf(bsum); }
        else { const int r = row - RL, b = r >> 8, t = r & 255; bf16_t* o = F1ctx + ((size_t)(b * 256 + gm) * 2) * 256; o[t] = f2bf(a); o[256 + t] = f2bf(bsum); }
    }
}
struct A_dft { const float* trig; long long L; long long mul;
    __device__ float operator()(int, int k, int kk) const { const int part = kk >= (int)L, t = part ? kk - (int)L : kk; const int idx = (int)(((long long)k * t) & (L - 1)) * (int)mul; return part ? -trig[2048 + idx] : trig[idx]; } };
struct B_f1t { const bf16_t* p; long long L;
    __device__ float operator()(int b, int kk, int n) const { return bf2f(p[((size_t)(b * 256 + n)) * 2 * L + kk]); } };
struct E_fourier { bf16_t* Z; long long rowbase; long long L; double scale;
    __device__ void operator()(int b, int m, int n, float v) const { Z[((size_t)rowbase + (size_t)b * L + m) * ZW + C_FU + n] = f2bf(v * (float)scale); } };

struct A_s5u { const bf16_t* Z;
    __device__ float operator()(int g, int rc, int k) const { return bf2f(Z[((size_t)rc * 64 + (k >> 4)) * ZW + C_S5 + g * 16 + (k & 15)]); } };
struct B_ms { const bf16_t* MS; __device__ float operator()(int g, int k, int n) const { return bf2f(MS[((size_t)g * 1024 + k) * 256 + n]); } };
struct E_sloc { float* S; __device__ void operator()(int g, int rc, int n, float v) const { S[((size_t)rc * 16 + g) * 256 + n] = v; } };
__device__ __forceinline__ void ph_s5_scan(const float* SLOC, const float* lamT, float* XP) { PH_IDS;
    GSTRIDE(i, 8 * 16 * 2 * 64) {
        const int b = i / 2048, g = (i / 128) % 16, d = (i / 64) % 2, p = i % 64;
        const float lr = lamT[((size_t)(g * 2 + d) * 64 + p) * 2], li = lamT[((size_t)(g * 2 + d) * 64 + p) * 2 + 1];
        float xr = 0.f, xi = 0.f;
        for (int step = 0; step < 36; ++step) {
            int rc;
            if (d == 0) rc = step < 4 ? 256 + b * 4 + step : b * 32 + (step - 4);
            else rc = step < 4 ? 256 + b * 4 + (3 - step) : b * 32 + (31 - (step - 4));
            const size_t o = ((size_t)rc * 16 + g) * 256 + d * 128;
            XP[o + p] = xr; XP[o + 64 + p] = xi;
            const float sr = SLOC[o + p], si = SLOC[o + 64 + p];
            const float nr = lr * xr - li * xi + sr, ni = lr * xi + li * xr + si; xr = nr; xi = ni;
        }
    }
}
struct A_s5out { const bf16_t* Z; const float* XP;
    __device__ float operator()(int g, int rc, int k) const { return k < 1024 ? bf2f(Z[((size_t)rc * 64 + (k >> 4)) * ZW + C_S5 + g * 16 + (k & 15)]) : XP[((size_t)rc * 16 + g) * 256 + (k - 1024)]; } };
struct B_s5out { const float* TZ; const bf16_t* QO;
    __device__ float operator()(int g, int k, int n) const { if (k < 1024) { const int s = k >> 4, hp = k & 15, t = n >> 4, h = n & 15; return TZ[(((size_t)g * 127 + (t - s + 63)) * 16 + hp) * 16 + h]; } return bf2f(QO[((size_t)g * 256 + (k - 1024)) * 1024 + n]); } };
struct E_s5out { bf16_t* YG; __device__ void operator()(int g, int rc, int n, float v) const { YG[((size_t)rc * 64 + (n >> 4)) * 256 + g * 16 + (n & 15)] = f2bf(geluf_(v)); } };
__device__ __forceinline__ void ph_glu(const bf16_t* GL, bf16_t* Z) { PH_IDS;
    GSTRIDE(gi, RT * 256) {
        const int row = gi >> 8, j = gi & 255;
        const float val = bf2f(GL[(size_t)row * 512 + j]), gate = bf2f(GL[(size_t)row * 512 + 256 + j]);
        Z[(size_t)row * ZW + C_S5 + j] = f2bf(val * sigmoidf_(gate));
    }
}
__device__ __forceinline__ void ph_ret_prep(bf16_t* Z) { PH_IDS;
    GSTRIDE(gi, RT * 4 * 32) {
        const int row = gi >> 7, h = (gi >> 5) & 3, j = gi & 31;
        bf16_t* z = Z + (size_t)row * ZW;
        if (row < RL) {
            const int t = row & 2047; const float fr = exp2f(-(float)j * (13.287712379549449f / 32.f)), a = (float)t * fr, cs = cosf(a), sn = sinf(a);
            { const float x1 = bf2f(z[C_RQ + h * 64 + j]), x2 = bf2f(z[C_RQ + h * 64 + 32 + j]); z[C_RQ + h * 64 + j] = f2bf(x1 * cs - x2 * sn); z[C_RQ + h * 64 + 32 + j] = f2bf(x1 * sn + x2 * cs); }
            { const float x1 = bf2f(z[C_RK + h * 64 + j]), x2 = bf2f(z[C_RK + h * 64 + 32 + j]); z[C_RK + h * 64 + j] = f2bf((x1 * cs - x2 * sn) * 0.125f); z[C_RK + h * 64 + 32 + j] = f2bf((x1 * sn + x2 * cs) * 0.125f); }
        } else {
            z[C_RK + h * 64 + j] = f2bf(bf2f(z[C_RK + h * 64 + j]) * 0.125f); z[C_RK + h * 64 + 32 + j] = f2bf(bf2f(z[C_RK + h * 64 + 32 + j]) * 0.125f);
        }
    }
}
__device__ __forceinline__ void ph_ret(unsigned char* lds, bf16_t* Z, const float* decay_logit, const float* gn_w, int with_ctx) { PH_IDS;
    float (*sK)[64] = (float (*)[64])lds; float (*sV)[64] = (float (*)[64])(lds + 32 * 64 * 4);
    float* sred = (float*)(lds + 2 * 32 * 64 * 4);
    const int nunits = 32 * (8 + (with_ctx ? 1 : 0));
    const int qt = tid_ & 255, hh = tid_ >> 8, dh = hh * 32;
    for (int u = bid_; u < nunits; u += G_) {
        const int bh = u % 32, qb = u / 32, b = bh >> 2, h = bh & 3;
        const bool lat = qb < 8;
        const int qpos = lat ? qb * 256 + qt : qt;
        const int qrow = lat ? b * 2048 + qpos : RL + b * 256 + qpos;
        const float lgf = -log1pf(__expf(-decay_logit[h])) * 1.4426950408889634f, lgb = -log1pf(__expf(-decay_logit[4 + h])) * 1.4426950408889634f;
        float q[64], o[32];
#pragma unroll
        for (int i = 0; i < 64; ++i) q[i] = bf2f(Z[(size_t)qrow * ZW + C_RQ + h * 64 + i]);
#pragma unroll
        for (int i = 0; i < 32; ++i) o[i] = 0.f;
        const int nkeys = lat ? 2560 : 256;
        for (int k0 = 0; k0 < nkeys; k0 += 32) {
            int krow0, kpos0;
            if (lat) { if (k0 < 256) { krow0 = RL + b * 256 + k0; kpos0 = k0 - 256; } else if (k0 < 2304) { krow0 = b * 2048 + (k0 - 256); kpos0 = k0 - 256; } else { krow0 = RL + b * 256 + (k0 - 2304); kpos0 = 2048 + (k0 - 2304); } }
            else { krow0 = RL + b * 256 + k0; kpos0 = k0; }
            __syncthreads();
            for (int e = tid_; e < 32 * 64; e += NT) { const int j = e >> 6, i = e & 63; sK[j][i] = bf2f(Z[(size_t)(krow0 + j) * ZW + C_RK + h * 64 + i]); sV[j][i] = bf2f(Z[(size_t)(krow0 + j) * ZW + C_RV + h * 64 + i]); }
            __syncthreads();
#pragma unroll 1
            for (int j = 0; j < 32; ++j) { float a = 0.f;
#pragma unroll
                for (int i = 0; i < 64; ++i) a += q[i] * sK[j][i];
                const int dpos = qpos - (kpos0 + j);
                const float dec = dpos > 0 ? exp2f(lgf * (float)dpos) : (dpos < 0 ? exp2f(lgb * (float)(-dpos)) : 2.f);
                a *= dec;
#pragma unroll
                for (int i = 0; i < 32; ++i) o[i] += a * sV[j][dh + i]; }
        }
        float s1 = 0.f;
#pragma unroll
        for (int i = 0; i < 32; ++i) s1 += o[i];
        __syncthreads();
        sred[hh * 256 + qt] = s1;
        __syncthreads();
        const float mu = (sred[qt] + sred[256 + qt]) * (1.f / 64);
        float s2 = 0.f;
#pragma unroll
        for (int i = 0; i < 32; ++i) { const float d = o[i] - mu; s2 += d * d; }
        __syncthreads();
        sred[hh * 256 + qt] = s2;
        __syncthreads();
        const float rstd = rsqrtf((sred[qt] + sred[256 + qt]) * (1.f / 64) + EPS);
#pragma unroll
        for (int i = 0; i < 32; ++i) { const float gte = bf2f(Z[(size_t)qrow * ZW + C_RG + h * 64 + dh + i]); const float y = (o[i] - mu) * rstd * gn_w[h * 64 + dh + i];
            Z[(size_t)qrow * ZW + C_RQ + h * 64 + dh + i] = f2bf(siluf_(gte) * y); }
    }
    __syncthreads();
}
struct E_merge { const bf16_t* stash; bf16_t* MMp; long long first;
    __device__ void operator()(int, int m, int n, float v) const { const size_t i = (size_t)m * DM + n; const float t = sigmoidf_(v) * bf2f(stash[i]); MMp[i] = f2bf(first ? t : bf2f(MMp[i]) + t); } };
struct E_resid { const float* xlat; const float* xctx; float* olat; float* octx; const float* mod; long long gchunk;
    __device__ void operator()(int, int m, int n, float v) const {
        const float g = mod[(size_t)row_modidx(m) * 6144 + gchunk * 1024 + n];
        if (m < RL) olat[(size_t)m * DM + n] = xlat[(size_t)m * DM + n] + g * v; else octx[(size_t)(m - RL) * DM + n] = xctx[(size_t)(m - RL) * DM + n] + g * v; } };
struct E_relu2 { bf16_t* H; __device__ void operator()(int, int m, int n, float v) const { const float r = fmaxf(v, 0.f); H[(size_t)m * DFF + n] = f2bf(r * r); } };


__device__ __forceinline__ void ph_s5_sloc(unsigned char* lds_, const bf16_t* Z, const bf16_t* MST, float* SLOC) { PH_IDS;
    const int lane = tid_ & 63, wid = __builtin_amdgcn_readfirstlane(tid_ >> 6), c16 = lane & 15, kq = lane >> 4;
    LAS char* sm = (LAS char*)lds_;
    constexpr int CP = 64 * 32 + 16;
    for (int u = bid_; u < 256; u += G_) {
        const int g = u >> 4, nh = (u >> 3) & 1, sl = u & 7;
        const bf16_t* mp0 = MST + ((size_t)g * 256 + nh * 128 + wid * 16 + c16) * 1024 + 8 * kq;
        bf16x8 a[32];
#pragma unroll
        for (int ks = 0; ks < 32; ++ks) a[ks] = *(const bf16x8*)(mp0 + 32 * ks);
        pg8::u32x4 st[4];
#define SLOC_ISSUE(blk_) do { _Pragma("unroll") for (int i = 0; i < 4; ++i) { const int p = tid_ + NT * i, r = p >> 1, hf = p & 1; \
            st[i] = *(const pg8::u32x4*)(Z + ((size_t)(blk_) * 1024 + r) * ZW + C_S5 + g * 16 + 8 * hf); } } while (0)
        SLOC_ISSUE(sl);
        for (int blk = sl; blk < 18; blk += 8) {
            const int rcbase = blk * 16;
            __syncthreads();
#pragma unroll
            for (int i = 0; i < 4; ++i) { const int p = tid_ + NT * i, r = p >> 1, hf = p & 1; *(LAS pg8::u32x4*)(sm + (r >> 6) * CP + (r & 63) * 32 + hf * 16) = st[i]; }
            if (blk + 8 < 18) SLOC_ISSUE(blk + 8);
            __syncthreads();
            const LAS char* bp = sm + c16 * CP + (kq >> 1) * 32 + (kq & 1) * 16;
            f32x4 acc0 = (f32x4){0.f, 0.f, 0.f, 0.f}, acc1 = acc0;
#pragma unroll
            for (int ks = 0; ks < 32; ks += 2) {
                const bf16x8 b0 = *(const LAS bf16x8*)(bp + ks * 64), b1 = *(const LAS bf16x8*)(bp + (ks + 1) * 64);
                acc0 = __builtin_amdgcn_mfma_f32_16x16x32_bf16(a[ks], b0, acc0, 0, 0, 0);
                acc1 = __builtin_amdgcn_mfma_f32_16x16x32_bf16(a[ks + 1], b1, acc1, 0, 0, 0);
            }
            *(f32x4*)(SLOC + ((size_t)(rcbase + c16) * 16 + g) * 256 + nh * 128 + wid * 16 + 4 * kq) = acc0 + acc1;
        }
#undef SLOC_ISSUE
    }
    __syncthreads();
}
__device__ __forceinline__ void ph_s5_tzb(int l, const float* TZD, const float* s5d, bf16_t* TZB, const float* c_re, const float* c_im, bf16_t* CQ) { PH_IDS;
    GSTRIDE(e, 16 * 16 * 256) { const int g = e >> 12, h = (e >> 8) & 15, n = e & 255, d = n >> 7, im = (n >> 6) & 1, p = n & 63;
        const size_t ci = ((((size_t)(l * 2 + d) * 16 + g) * 16 + h) * 64) + p; CQ[e] = f2bf(im ? -c_im[ci] : c_re[ci]); }
    GSTRIDE(e, 16 * 127 * 64) { const int g = e / (127 * 64), r = e % (127 * 64), dd = r >> 6, h = (r >> 2) & 15, q4 = (r & 3) * 4;
        f32x4 v = (f32x4){0.f, 0.f, 0.f, 0.f};
        if (dd >= 63) v += *(const f32x4*)(TZD + ((((size_t)0 * 16 + g) * 64 + (dd - 63)) * 16 + h) * 16 + q4);
        if (dd <= 63) v += *(const f32x4*)(TZD + ((((size_t)1 * 16 + g) * 64 + (63 - dd)) * 16 + h) * 16 + q4);
        if (dd == 63 && (h >> 2) == (q4 >> 2)) v[h & 3] += s5d[g * 16 + h];
        fa::u32x2 w; w.x = fa::pk2(v[0], v[1]); w.y = fa::pk2(v[2], v[3]);
        *(fa::u32x2*)(TZB + ((size_t)(g * 127 + dd) * 16 + h) * 16 + (((q4 >> 3) ^ (h >> 3)) * 8 + (q4 & 7))) = w; }
}
__device__ __forceinline__ void ph_s5_out(unsigned char* lds_, const bf16_t* Z, const bf16_t* TZB, const bf16_t* CQ, const float2* LP, const float* SLOC, const float* lamT, bf16_t* YG, int nrct, int u0, int ustep) { PH_IDS;
    LAS char* sm = (LAS char*)lds_;
    constexpr int O_TZ = 0, O_XP = 65536, O_U = 73728, UP = 2064, O_SL = O_U + 16 * UP;
    const int lane = tid_ & 63, wid = __builtin_amdgcn_readfirstlane(tid_ >> 6), c16 = lane & 15, kq = lane >> 4;
    for (int u = u0; u < 16 * nrct; u += ustep) {
        const int g = u / nrct, rct = u % nrct, rcbase = rct * 16;
        const bool lat = rct < 16; const int b = rcbase >> 5, c0 = rcbase & 31;
        const int nsl = lat ? 36 : 16;
        pg8::u32x4 sT[8], sU[4]; f32x4 sS[5];
        { const pg8::u32x4* tsrc = (const pg8::u32x4*)(TZB + (size_t)g * 127 * 256);
#pragma unroll
          for (int i_ = 0; i_ < 8; ++i_) { const int e = tid_ + NT * i_; if (e < 127 * 32) sT[i_] = tsrc[e]; }
#pragma unroll
          for (int i_ = 0; i_ < 4; ++i_) { const int e = tid_ + NT * i_, rc = e >> 7, s_ = (e >> 1) & 63, hh = e & 1; sU[i_] = *(const pg8::u32x4*)(Z + ((size_t)(rcbase + rc) * 64 + s_) * ZW + C_S5 + g * 16 + hh * 8); }
#pragma unroll
          for (int i_ = 0; i_ < 5; ++i_) { const int e = tid_ + NT * i_, r = e >> 6, q4 = e & 63; const int rc = lat ? (r < 4 ? 256 + b * 4 + r : b * 32 + (r - 4)) : rcbase + r;
              if (e < nsl * 64) sS[i_] = *(const f32x4*)(SLOC + ((size_t)rc * 16 + g) * 256 + q4 * 4); } }
        typedef float f32x2v __attribute__((ext_vector_type(2)));
        f32x2v sLq[3]; pg8::u32x4 sCq = *(const pg8::u32x4*)(CQ + (size_t)g * 4096 + tid_ * 8);
#pragma unroll
        for (int i_ = 0; i_ < 3; ++i_) { const int e = tid_ + NT * i_;
            if (e < 1152) { const int e2 = e - 128, d_ = e < 128 ? (e >> 6) : ((e2 >> 6) & 1), p_ = e & 63, w_ = e2 >> 7, k_ = e < 128 ? 1 : (d_ == 0 ? 8 * w_ + 1 : 57 - 8 * w_);
                const float2 t_ = LP[(((size_t)d_ * 16 + g) * 64 + p_) * 65 + k_]; sLq[i_] = (f32x2v){t_.x, t_.y}; } }
        __syncthreads();
#pragma unroll
        for (int i_ = 0; i_ < 8; ++i_) { const int e = tid_ + NT * i_; if (e < 127 * 32) *(LAS pg8::u32x4*)(sm + O_TZ + e * 16) = sT[i_]; }
#pragma unroll
        for (int i_ = 0; i_ < 4; ++i_) { const int e = tid_ + NT * i_, rc = e >> 7, s_ = (e >> 1) & 63, hh = e & 1; *(LAS pg8::u32x4*)(sm + O_U + rc * UP + s_ * 32 + hh * 16) = sU[i_]; }
#pragma unroll
        for (int i_ = 0; i_ < 5; ++i_) { const int e = tid_ + NT * i_, r = e >> 6, q4 = e & 63; if (e < nsl * 64) *(LAS f32x4*)(sm + O_SL + r * 1024 + q4 * 16) = sS[i_]; }
        __syncthreads();
        if (tid_ < 128) {
            const int d = tid_ >> 6, p = tid_ & 63;
            const float lr = lamT[((size_t)(g * 2 + d) * 64 + p) * 2], li = lamT[((size_t)(g * 2 + d) * 64 + p) * 2 + 1];
            const LAS float* sl = (const LAS float*)(sm + O_SL) + d * 128 + p;
            LAS bf16_t* xp = (LAS bf16_t*)(sm + O_XP) + d * 128 + p;
            float xr = 0.f, xi = 0.f;
#define S5_STEP(r) do { const float sr = sl[(r) * 256], si = sl[(r) * 256 + 64]; const float nr = lr * xr - li * xi + sr, ni = lr * xi + li * xr + si; xr = nr; xi = ni; } while (0)
            if (lat) {
                if (d == 0) { for (int r = 0; r < 4 + c0; ++r) S5_STEP(r);
                    for (int r = 0; r < 16; ++r) { xp[r * 256] = f2bf(xr); xp[r * 256 + 64] = f2bf(xi); S5_STEP(4 + c0 + r); } }
                else { for (int r = 3; r >= 0; --r) S5_STEP(r);
                    for (int c = 31; c >= c0 + 16; --c) S5_STEP(4 + c);
                    for (int r = 15; r >= 0; --r) { xp[r * 256] = f2bf(xr); xp[r * 256 + 64] = f2bf(xi); S5_STEP(4 + c0 + r); } }
            } else {
                if (d == 0) { for (int r = 0; r < 16; ++r) { if ((r & 3) == 0) { xr = 0.f; xi = 0.f; } xp[r * 256] = f2bf(xr); xp[r * 256 + 64] = f2bf(xi); S5_STEP(r); } }
                else { for (int r = 15; r >= 0; --r) { if ((r & 3) == 3) { xr = 0.f; xi = 0.f; } xp[r * 256] = f2bf(xr); xp[r * 256 + 64] = f2bf(xi); S5_STEP(r); } }
            }
#undef S5_STEP
        }
        __syncthreads();
#pragma unroll
        for (int i_ = 0; i_ < 3; ++i_) { const int e = tid_ + NT * i_; if (e < 1152) *(LAS f32x2v*)(sm + O_SL + e * 8) = sLq[i_]; }
        *(LAS pg8::u32x4*)(sm + O_SL + 9216 + tid_ * 16) = sCq;
        const LAS char* ub = sm + O_U + c16 * UP + kq * 16;
        const LAS char* xb = sm + O_XP + c16 * 512 + kq * 16;
        f32x4 acc8[8];
#pragma unroll
        for (int i = 0; i < 8; ++i) acc8[i] = (f32x4){0.f, 0.f, 0.f, 0.f};
#pragma unroll
        for (int par = 0; par < 2; ++par) {
            const LAS char* fz = sm + O_TZ + ((wid * 8 + par + 63 - (kq >> 1)) * 16 + c16) * 32 + ((kq & 1) ^ (c16 >> 3)) * 16;
            bf16x8 uw[4];
            uw[0] = *(const LAS bf16x8*)(ub); uw[1] = *(const LAS bf16x8*)(ub + 64); uw[2] = *(const LAS bf16x8*)(ub + 128); uw[3] = uw[0];
#pragma unroll
            for (int m = -3; m < 32; ++m) {
                const bf16x8 f = *(const LAS bf16x8*)(fz - m * 1024);
                if (m + 3 < 32) uw[(m + 3) & 3] = *(const LAS bf16x8*)(ub + (m + 3) * 64);
#pragma unroll
                for (int j = 0; j < 4; ++j) { const int ks = m + j; if (ks >= 0 && ks < 32) acc8[par + 2 * j] = __builtin_amdgcn_mfma_f32_16x16x32_bf16(f, uw[ks & 3], acc8[par + 2 * j], 0, 0, 0); }
            }
        }
        __syncthreads();
        {
#pragma unroll
            for (int d = 0; d < 2; ++d)
#pragma unroll 1
            for (int ph = 0; ph < 2; ++ph) {
                asm volatile("" ::: "memory");
                const bf16x8 cqr = *(const LAS bf16x8*)(sm + O_SL + 9216 + (c16 * 256 + 32 * (4 * d + ph) + 8 * kq) * 2), cqi = *(const LAS bf16x8*)(sm + O_SL + 9216 + (c16 * 256 + 32 * (4 * d + 2 + ph) + 8 * kq) * 2);
                const bf16x8 xre = *(const LAS bf16x8*)(xb + (4 * d + ph) * 64), xim = *(const LAS bf16x8*)(xb + (4 * d + 2 + ph) * 64);
                float yr[8], yi[8], lr[8], li[8];
#pragma unroll
                for (int j = 0; j < 8; ++j) {
                    const int p_ = 32 * ph + 8 * kq + j;
                    const f32x2v l1 = *(const LAS f32x2v*)(sm + O_SL + (d * 64 + p_) * 8), ls = *(const LAS f32x2v*)(sm + O_SL + (128 + (wid * 2 + d) * 64 + p_) * 8);
                    const float xr = __uint_as_float((unsigned)(unsigned short)xre[j] << 16), xi = __uint_as_float((unsigned)(unsigned short)xim[j] << 16);
                    yr[j] = ls.x * xr - ls.y * xi; yi[j] = ls.x * xi + ls.y * xr; lr[j] = l1.x; li[j] = l1.y;
                }
#pragma unroll
                for (int s8 = 0; s8 < 8; ++s8) {
                    const int i = d == 0 ? s8 : 7 - s8;
                    const bf16x8 bre = __builtin_bit_cast(bf16x8, pack8((f32x4){yr[0], yr[1], yr[2], yr[3]}, (f32x4){yr[4], yr[5], yr[6], yr[7]}));
                    const bf16x8 bim = __builtin_bit_cast(bf16x8, pack8((f32x4){yi[0], yi[1], yi[2], yi[3]}, (f32x4){yi[4], yi[5], yi[6], yi[7]}));
                    acc8[i] = __builtin_amdgcn_mfma_f32_16x16x32_bf16(cqr, bre, acc8[i], 0, 0, 0);
                    acc8[i] = __builtin_amdgcn_mfma_f32_16x16x32_bf16(cqi, bim, acc8[i], 0, 0, 0);
                    if (s8 < 7) {
#pragma unroll
                        for (int j = 0; j < 8; ++j) { const float a = yr[j], c = yi[j]; yr[j] = lr[j] * a - li[j] * c; yi[j] = lr[j] * c + li[j] * a; }
                    }
                }
            }
        }
#pragma unroll
        for (int i = 0; i < 8; ++i) { const int t = wid * 8 + i;
            fa::u32x2 w; w.x = fa::pk2(geluf_(acc8[i][0]), geluf_(acc8[i][1])); w.y = fa::pk2(geluf_(acc8[i][2]), geluf_(acc8[i][3]));
            *(fa::u32x2*)(YG + ((size_t)(rcbase + c16) * 64 + t) * ZW + C_S5 + g * 16 + 4 * kq) = w; }
    }
    __syncthreads();
}
__device__ __forceinline__ void rope16(float (&v)[4], int kq, float pos, bool on) {
#pragma unroll
    for (int r = 0; r < 4; ++r) {
        const int j = (4 * kq + r) & 7;
        const float ang = pos * exp2f(-(float)j * (13.287712379549449f / 8.f)), cs = __cosf(ang), sn = __sinf(ang);
        const float other = __shfl_xor(v[r], 32);
        const float rot = kq < 2 ? v[r] * cs - other * sn : other * sn + v[r] * cs;
        v[r] = on ? rot : v[r];
    }
}
__device__ __forceinline__ void ph_prep(bf16_t* Z, const bf16_t* WUQ, const bf16_t* WUKV, const bf16_t* D64, const float* qkq, const float* qkk,
                                        bf16_t* Q, bf16_t* Kb, bf16_t* Vb, bf16_t* F1lat, bf16_t* F1ctx, unsigned char* lds_) { PH_IDS;
    const int lane = tid_ & 63, wid = __builtin_amdgcn_readfirstlane(tid_ >> 6), c16 = lane & 15, kq = lane >> 4;
    LAS char* sm = (LAS char*)lds_;
    constexpr int P_KV = 336, P_QC = 528, O_KV = 0, O_QC = 24576, O_FU = 63488;
    for (int blk = bid_; blk < RT / 72; blk += G_) {
        const int row0 = blk * 72;
        __syncthreads();
#pragma unroll 1
        for (int hf = 0; hf < 3; ++hf) { pg8::u32x4 st[4];
#pragma unroll
          for (int i = 0; i < 4; ++i) { const int e = tid_ + NT * (4 * hf + i);
              if (e < 1440) st[i] = *(const pg8::u32x4*)(Z + (size_t)(row0 + e / 20) * ZW + C_KVC + (e % 20) * 8);
              else if (e < 3744) st[i] = *(const pg8::u32x4*)(Z + (size_t)(row0 + ((e - 1440) >> 5)) * ZW + C_QC + ((e - 1440) & 31) * 8);
              else if (e < 6048) st[i] = *(const pg8::u32x4*)(Z + (size_t)(row0 + ((e - 3744) >> 5)) * ZW + C_FU + ((e - 3744) & 31) * 8); }
#pragma unroll
          for (int i = 0; i < 4; ++i) { const int e = tid_ + NT * (4 * hf + i);
              if (e < 1440) *(LAS pg8::u32x4*)(sm + O_KV + (e / 20) * P_KV + (e % 20) * 16) = st[i];
              else if (e < 3744) *(LAS pg8::u32x4*)(sm + O_QC + ((e - 1440) >> 5) * P_QC + ((e - 1440) & 31) * 16) = st[i];
              else if (e < 6048) *(LAS pg8::u32x4*)(sm + O_FU + ((e - 3744) >> 5) * P_QC + ((e - 3744) & 31) * 16) = st[i]; } }
        __syncthreads();
#pragma unroll 1
      for (int pass3 = 0; pass3 < 2; ++pass3) {
        int rowc[3], rl[3]; bool valid[3];
#pragma unroll
        for (int tt = 0; tt < 3; ++tt) { const int o = 16 * (3 * pass3 + tt) + c16; valid[tt] = o < 72; rl[tt] = valid[tt] ? o : 71; rowc[tt] = row0 + rl[tt]; }
        if (wid < 4) {
            const int h = wid;
            f32x4 acc[6][3]; float ssq[3];
#pragma unroll
            for (int tt = 0; tt < 3; ++tt) { ssq[tt] = 0.f;
#pragma unroll
                for (int nt = 0; nt < 6; ++nt) acc[nt][tt] = (f32x4){0.f, 0.f, 0.f, 0.f}; }
#pragma unroll 4
            for (int ks = 0; ks < 8; ++ks) {
                bf16x8 bq[3], aw[6];
#pragma unroll
                for (int tt = 0; tt < 3; ++tt) { bq[tt] = *(const LAS bf16x8*)(sm + O_QC + rl[tt] * P_QC + (32 * ks + 8 * kq) * 2);
#pragma unroll
                    for (int e = 0; e < 8; ++e) { const float f = bf2f((bf16_t)bq[tt][e]); ssq[tt] += f * f; } }
#pragma unroll
                for (int nt = 0; nt < 6; ++nt) aw[nt] = *(const bf16x8*)(WUQ + (size_t)(h * 96 + 16 * nt + c16) * 256 + 32 * ks + 8 * kq);
#pragma unroll
                for (int nt = 0; nt < 6; ++nt)
#pragma unroll
                    for (int tt = 0; tt < 3; ++tt) acc[nt][tt] = __builtin_amdgcn_mfma_f32_16x16x32_bf16(aw[nt], bq[tt], acc[nt][tt], 0, 0, 0);
            }
#pragma unroll
            for (int tt = 0; tt < 3; ++tt) {
                float s1 = ssq[tt]; s1 += __shfl_xor(s1, 16); s1 += __shfl_xor(s1, 32);
                const float rstd = rsqrtf(s1 * (1.f / 256) + EPS);
                float ss = 0.f;
#pragma unroll
                for (int nt = 0; nt < 6; ++nt)
#pragma unroll
                    for (int r = 0; r < 4; ++r) ss += acc[nt][tt][r] * acc[nt][tt][r];
                ss += __shfl_xor(ss, 16); ss += __shfl_xor(ss, 32);
                const float fac = rstd * rsqrtf(rstd * rstd * ss * (1.f / 96) + EPS) * 0.14724727430627066f;
                const int row = rowc[tt]; const bool lat = row < RL; const int b = row_batch(row), t = lat ? (row & 2047) : ((row - RL) & 255), qi = lat ? t : 2048 + t;
                bf16_t* qo = Q + ((size_t)(b * 4 + h) * 2304 + qi) * 96 + 4 * kq;
#pragma unroll
                for (int nt = 0; nt < 6; ++nt) {
                    const f32x4 w = *(const f32x4*)(qkq + 16 * nt + 4 * kq);
                    float v[4];
#pragma unroll
                    for (int r = 0; r < 4; ++r) v[r] = acc[nt][tt][r] * fac * w[r];
                    if (nt >= 4) rope16(v, kq, nt == 4 ? (float)(t >> 6) : (float)(t & 63), lat);
                    fa::u32x2 o; o.x = fa::pk2(v[0], v[1]); o.y = fa::pk2(v[2], v[3]);
                    if (valid[tt]) *(fa::u32x2*)(qo + 16 * nt) = o;
                }
            }
        } else {
            const int h = wid - 4;
            float ssq[3], rstd[3];
#pragma unroll
            for (int tt = 0; tt < 3; ++tt) ssq[tt] = 0.f;
#pragma unroll 1
            for (int pass = 0; pass < 2; ++pass) {
                f32x4 acc[4][3];
#pragma unroll
                for (int tt = 0; tt < 3; ++tt)
#pragma unroll
                    for (int nt = 0; nt < 4; ++nt) acc[nt][tt] = (f32x4){0.f, 0.f, 0.f, 0.f};
#pragma unroll
                for (int ks = 0; ks < 4; ++ks) {
                    bf16x8 bq[3], aw[4];
#pragma unroll
                    for (int tt = 0; tt < 3; ++tt) { bq[tt] = *(const LAS bf16x8*)(sm + O_KV + rl[tt] * P_KV + (32 * ks + 8 * kq) * 2);
                        if (pass == 0) {
#pragma unroll
                            for (int e = 0; e < 8; ++e) { const float f = bf2f((bf16_t)bq[tt][e]); ssq[tt] += f * f; } } }
#pragma unroll
                    for (int nt = 0; nt < 4; ++nt) aw[nt] = *(const bf16x8*)(WUKV + (size_t)(h * 128 + pass * 64 + 16 * nt + c16) * 128 + 32 * ks + 8 * kq);
#pragma unroll
                    for (int nt = 0; nt < 4; ++nt)
#pragma unroll
                        for (int tt = 0; tt < 3; ++tt) acc[nt][tt] = __builtin_amdgcn_mfma_f32_16x16x32_bf16(aw[nt], bq[tt], acc[nt][tt], 0, 0, 0);
                }
#pragma unroll
                for (int tt = 0; tt < 3; ++tt) {
                    const int row = rowc[tt]; const bool lat = row < RL; const int b = row_batch(row), t = lat ? (row & 2047) : ((row - RL) & 255), ki = lat ? 256 + t : t;
                    if (pass == 0) {
                        float s1 = ssq[tt]; s1 += __shfl_xor(s1, 16); s1 += __shfl_xor(s1, 32);
                        rstd[tt] = rsqrtf(s1 * (1.f / 128) + EPS);
                        float kr[2][4];
#pragma unroll
                        for (int e = 0; e < 2; ++e) { const fa::u32x2 w = *(const LAS fa::u32x2*)(sm + O_KV + rl[tt] * P_KV + (128 + 16 * e + 4 * kq) * 2);
                            kr[e][0] = __uint_as_float(w.x << 16); kr[e][1] = __uint_as_float(w.x & 0xffff0000u); kr[e][2] = __uint_as_float(w.y << 16); kr[e][3] = __uint_as_float(w.y & 0xffff0000u); }
                        float ss = 0.f;
#pragma unroll
                        for (int nt = 0; nt < 4; ++nt)
#pragma unroll
                            for (int r = 0; r < 4; ++r) { acc[nt][tt][r] *= rstd[tt]; ss += acc[nt][tt][r] * acc[nt][tt][r]; }
#pragma unroll
                        for (int e = 0; e < 2; ++e)
#pragma unroll
                            for (int r = 0; r < 4; ++r) ss += kr[e][r] * kr[e][r];
                        ss += __shfl_xor(ss, 16); ss += __shfl_xor(ss, 32);
                        const float fac = rsqrtf(ss * (1.f / 96) + EPS);
                        bf16_t* ko = Kb + ((size_t)(b * 4 + h) * 2304 + ki) * 96 + 4 * kq;
#pragma unroll
                        for (int nt = 0; nt < 6; ++nt) {
                            const f32x4 w = *(const f32x4*)(qkk + 16 * nt + 4 * kq);
                            float v[4];
#pragma unroll
                            for (int r = 0; r < 4; ++r) v[r] = (nt < 4 ? acc[nt < 4 ? nt : 0][tt][r] : kr[nt < 4 ? 0 : nt - 4][r]) * fac * w[r];
                            if (nt >= 4) rope16(v, kq, nt == 4 ? (float)(t >> 6) : (float)(t & 63), lat);
                            fa::u32x2 o; o.x = fa::pk2(v[0], v[1]); o.y = fa::pk2(v[2], v[3]);
                            if (valid[tt]) *(fa::u32x2*)(ko + 16 * nt) = o;
                        }
                    } else {
                        bf16_t* vo = Vb + ((size_t)(b * 4 + h) * 2304 + ki) * 64 + 4 * kq;
#pragma unroll
                        for (int nt = 0; nt < 4; ++nt) { fa::u32x2 o; o.x = fa::pk2(acc[nt][tt][0] * rstd[tt], acc[nt][tt][1] * rstd[tt]); o.y = fa::pk2(acc[nt][tt][2] * rstd[tt], acc[nt][tt][3] * rstd[tt]);
                            if (valid[tt]) *(fa::u32x2*)(vo + 16 * nt) = o; }
                    }
                }
            }
        }
        {
            const int g = wid >> 1, part = wid & 1;
            f32x4 acc[4][3];
#pragma unroll
            for (int tt = 0; tt < 3; ++tt)
#pragma unroll
                for (int nt = 0; nt < 4; ++nt) acc[nt][tt] = (f32x4){0.f, 0.f, 0.f, 0.f};
#pragma unroll
            for (int ks = 0; ks < 2; ++ks) {
                bf16x8 au[3], bd[4];
#pragma unroll
                for (int tt = 0; tt < 3; ++tt) au[tt] = *(const LAS bf16x8*)(sm + O_FU + rl[tt] * P_QC + (g * 64 + 32 * ks + 8 * kq) * 2);
#pragma unroll
                for (int nt = 0; nt < 4; ++nt) bd[nt] = *(const bf16x8*)(D64 + (size_t)(part * 64 + 16 * nt + c16) * 64 + 32 * ks + 8 * kq);
#pragma unroll
                for (int nt = 0; nt < 4; ++nt)
#pragma unroll
                    for (int tt = 0; tt < 3; ++tt) acc[nt][tt] = __builtin_amdgcn_mfma_f32_16x16x32_bf16(au[tt], bd[nt], acc[nt][tt], 0, 0, 0);
            }
#pragma unroll
            for (int tt = 0; tt < 3; ++tt) {
                const int o4 = 16 * (3 * pass3 + tt) + 4 * kq; const int trow = row0 + o4;
                if (o4 < 72) {
                    const bool lat = trow < RL;
#pragma unroll
                    for (int nt = 0; nt < 4; ++nt) {
                        const int gm = g * 64 + 16 * nt + c16;
                        fa::u32x2 o; o.x = fa::pk2(acc[nt][tt][0], acc[nt][tt][1]); o.y = fa::pk2(acc[nt][tt][2], acc[nt][tt][3]);
                        if (lat) { const int b = trow >> 11, t0 = trow & 2047; *(fa::u32x2*)(F1lat + ((size_t)(b * 256 + gm) * 2 + part) * 2048 + t0) = o; }
                        else { const int rr = trow - RL, b = rr >> 8, t0 = rr & 255; *(fa::u32x2*)(F1ctx + ((size_t)(b * 256 + gm) * 2 + part) * 256 + t0) = o; }
                    }
                }
            }
        }
      }
#pragma unroll 1
        for (int it = tid_; it < 72 * 16; it += NT) {
            const int row = row0 + (it >> 4), h = (it >> 2) & 3, jg = it & 3;
            bf16_t* zq = Z + (size_t)row * ZW + C_RQ + h * 64 + 8 * jg; bf16_t* zk = Z + (size_t)row * ZW + C_RK + h * 64 + 8 * jg;
            const fa::u32x4 k1 = *(const fa::u32x4*)zk, k2 = *(const fa::u32x4*)(zk + 32);
            f32x4 ka, kb, kc, kd; unpack8(k1, ka, kb); unpack8(k2, kc, kd);
            if (row < RL) {
                const fa::u32x4 q1 = *(const fa::u32x4*)zq, q2 = *(const fa::u32x4*)(zq + 32);
                f32x4 qa, qb, qc, qd; unpack8(q1, qa, qb); unpack8(q2, qc, qd);
                const float tpos = (float)(row & 2047);
                float x1q[8] = {qa[0], qa[1], qa[2], qa[3], qb[0], qb[1], qb[2], qb[3]}, x2q[8] = {qc[0], qc[1], qc[2], qc[3], qd[0], qd[1], qd[2], qd[3]};
                float x1k[8] = {ka[0], ka[1], ka[2], ka[3], kb[0], kb[1], kb[2], kb[3]}, x2k[8] = {kc[0], kc[1], kc[2], kc[3], kd[0], kd[1], kd[2], kd[3]};
#pragma unroll
                for (int e = 0; e < 8; ++e) {
                    float rev = tpos * (__builtin_amdgcn_exp2f(-(float)(8 * jg + e) * (13.287712379549449f / 32.f)) * 0.15915494309189535f); rev -= floorf(rev);
                    const float cs = __builtin_amdgcn_cosf(rev), sn = __builtin_amdgcn_sinf(rev);
                    const float a = x1q[e], c = x2q[e]; x1q[e] = a * cs - c * sn; x2q[e] = a * sn + c * cs;
                    const float a2 = x1k[e], c2 = x2k[e]; x1k[e] = (a2 * cs - c2 * sn) * 0.125f; x2k[e] = (a2 * sn + c2 * cs) * 0.125f;
                }
                *(fa::u32x4*)zq = pack8((f32x4){x1q[0], x1q[1], x1q[2], x1q[3]}, (f32x4){x1q[4], x1q[5], x1q[6], x1q[7]});
                *(fa::u32x4*)(zq + 32) = pack8((f32x4){x2q[0], x2q[1], x2q[2], x2q[3]}, (f32x4){x2q[4], x2q[5], x2q[6], x2q[7]});
                *(fa::u32x4*)zk = pack8((f32x4){x1k[0], x1k[1], x1k[2], x1k[3]}, (f32x4){x1k[4], x1k[5], x1k[6], x1k[7]});
                *(fa::u32x4*)(zk + 32) = pack8((f32x4){x2k[0], x2k[1], x2k[2], x2k[3]}, (f32x4){x2k[4], x2k[5], x2k[6], x2k[7]});
            } else {
                *(fa::u32x4*)zk = pack8(ka * 0.125f, kb * 0.125f); *(fa::u32x4*)(zk + 32) = pack8(kc * 0.125f, kd * 0.125f);
            }
        }
    }
}

__device__ __forceinline__ void attn_tile(const LAS char* sm, int r32, int hi, int vrd, int buf, bool first, const bf16x8 (&qf)[6], fa::f32x16& negm, float& mrun, float& lsum, fa::f32x16& o0, fa::f32x16& o1) {
    using namespace fa;
    const LAS char* kb = sm + buf + r32 * KP_A + 16 * hi;
    f32x16 p0 = negm, p1 = negm;
#pragma unroll
    for (int st = 0; st < 6; ++st) {
        const bf16x8 k0 = *(const LAS bf16x8*)(kb + 32 * st), k1 = *(const LAS bf16x8*)(kb + 32 * KP_A + 32 * st);
        p0 = __builtin_amdgcn_mfma_f32_32x32x16_bf16(k0, qf[st], p0, 0, 0, 0);
        p1 = __builtin_amdgcn_mfma_f32_32x32x16_bf16(k1, qf[st], p1, 0, 0, 0);
    }
    float ta = fmaxf(fmaxf(p0[0], p0[1]), p1[0]), tb = fmaxf(fmaxf(p0[2], p0[3]), p1[1]);
    ta = fmaxf(fmaxf(ta, p1[2]), p1[3]);
#pragma unroll
    for (int r = 4; r < 16; r += 4) { ta = fmaxf(fmaxf(ta, p0[r]), p0[r + 1]); tb = fmaxf(fmaxf(tb, p0[r + 2]), p0[r + 3]); ta = fmaxf(fmaxf(ta, p1[r]), p1[r + 1]); tb = fmaxf(fmaxf(tb, p1[r + 2]), p1[r + 3]); }
    float tm = fmaxf(ta, tb);
    tm = fmaxf(tm, __shfl_xor(tm, 32));
    if (first || __any(tm > 0.f)) {
        const float dl = first ? tm : fmaxf(tm, 0.f), alpha = first ? 1.f : __builtin_amdgcn_exp2f(-dl);
        mrun += dl; lsum *= alpha;
#pragma unroll
        for (int r = 0; r < 16; ++r) { p0[r] -= dl; p1[r] -= dl; o0[r] *= alpha; o1[r] *= alpha; negm[r] = -mrun; }
    }
    float ps = 0.f, ps2 = 0.f;
#pragma unroll
    for (int r = 0; r < 16; ++r) { p0[r] = __builtin_amdgcn_exp2f(p0[r]); p1[r] = __builtin_amdgcn_exp2f(p1[r]); ps += p0[r]; ps2 += p1[r]; }
    lsum += ps + ps2;
    bf16x8 pf[4]; pf[0] = pack_p(p0, 0); pf[1] = pack_p(p0, 8); pf[2] = pack_p(p1, 0); pf[3] = pack_p(p1, 8);
    pv_tile(o0, o1, sm + buf + vrd, pf);
}
__device__ __forceinline__ void attn_pair(const LAS char* sm, int r32, int hi, int vrd, int bufA, int bufB, bool first, const bf16x8 (&qf)[6], fa::f32x16& negm, float& mrun, float& lsum, fa::f32x16& o0, fa::f32x16& o1) {
    using namespace fa;
    const LAS char* ka = sm + bufA + r32 * KP_A + 16 * hi; const LAS char* kb = sm + bufB + r32 * KP_A + 16 * hi;
    f32x16 a0 = negm, a1 = negm, b0 = negm, b1 = negm;
#pragma unroll
    for (int st = 0; st < 6; ++st) {
        const bf16x8 k0 = *(const LAS bf16x8*)(ka + 32 * st), k1 = *(const LAS bf16x8*)(ka + 32 * KP_A + 32 * st);
        a0 = __builtin_amdgcn_mfma_f32_32x32x16_bf16(k0, qf[st], a0, 0, 0, 0);
        a1 = __builtin_amdgcn_mfma_f32_32x32x16_bf16(k1, qf[st], a1, 0, 0, 0);
    }
    float carry = 0.f;
    {
        float ta = fmaxf(fmaxf(a0[0], a0[1]), a1[0]), tb = fmaxf(fmaxf(a0[2], a0[3]), a1[1]);
        ta = fmaxf(fmaxf(ta, a1[2]), a1[3]);
#pragma unroll
        for (int r = 4; r < 16; r += 4) { ta = fmaxf(fmaxf(ta, a0[r]), a0[r + 1]); tb = fmaxf(fmaxf(tb, a0[r + 2]), a0[r + 3]); ta = fmaxf(fmaxf(ta, a1[r]), a1[r + 1]); tb = fmaxf(fmaxf(tb, a1[r + 2]), a1[r + 3]); }
        float tm = fmaxf(ta, tb);
        tm = fmaxf(tm, __shfl_xor(tm, 32));
        if (first || __any(tm > 0.f)) {
            const float dl = first ? tm : fmaxf(tm, 0.f), alpha = first ? 1.f : __builtin_amdgcn_exp2f(-dl);
            mrun += dl; lsum *= alpha; carry = dl;
#pragma unroll
            for (int r = 0; r < 16; ++r) { a0[r] -= dl; a1[r] -= dl; o0[r] *= alpha; o1[r] *= alpha; negm[r] = -mrun; }
        }
    }
#pragma unroll
    for (int st = 0; st < 6; ++st) {
        const bf16x8 k0 = *(const LAS bf16x8*)(kb + 32 * st), k1 = *(const LAS bf16x8*)(kb + 32 * KP_A + 32 * st);
        b0 = __builtin_amdgcn_mfma_f32_32x32x16_bf16(k0, qf[st], b0, 0, 0, 0);
        b1 = __builtin_amdgcn_mfma_f32_32x32x16_bf16(k1, qf[st], b1, 0, 0, 0);
    }
    float ps = 0.f, ps2 = 0.f;
#pragma unroll
    for (int r = 0; r < 16; ++r) { a0[r] = __builtin_amdgcn_exp2f(a0[r]); a1[r] = __builtin_amdgcn_exp2f(a1[r]); ps += a0[r]; ps2 += a1[r]; }
    lsum += ps + ps2;
    bf16x8 pf[4]; pf[0] = pack_p(a0, 0); pf[1] = pack_p(a0, 8); pf[2] = pack_p(a1, 0); pf[3] = pack_p(a1, 8);
    pv_tile(o0, o1, sm + bufA + vrd, pf);
    {
        float ta = fmaxf(fmaxf(b0[0], b0[1]), b1[0]), tb = fmaxf(fmaxf(b0[2], b0[3]), b1[1]);
        ta = fmaxf(fmaxf(ta, b1[2]), b1[3]);
#pragma unroll
        for (int r = 4; r < 16; r += 4) { ta = fmaxf(fmaxf(ta, b0[r]), b0[r + 1]); tb = fmaxf(fmaxf(tb, b0[r + 2]), b0[r + 3]); ta = fmaxf(fmaxf(ta, b1[r]), b1[r + 1]); tb = fmaxf(fmaxf(tb, b1[r + 2]), b1[r + 3]); }
        float tm = fmaxf(ta, tb) - carry;
        tm = fmaxf(tm, __shfl_xor(tm, 32));
        if (__any(tm > 0.f) || __any(carry != 0.f)) {
            const float dl = fmaxf(tm, 0.f), alpha = __builtin_amdgcn_exp2f(-dl), sh = carry + dl;
            mrun += dl; lsum *= alpha;
#pragma unroll
            for (int r = 0; r < 16; ++r) { b0[r] -= sh; b1[r] -= sh; o0[r] *= alpha; o1[r] *= alpha; negm[r] = -mrun; }
        }
    }
    ps = 0.f; ps2 = 0.f;
#pragma unroll
    for (int r = 0; r < 16; ++r) { b0[r] = __builtin_amdgcn_exp2f(b0[r]); b1[r] = __builtin_amdgcn_exp2f(b1[r]); ps += b0[r]; ps2 += b1[r]; }
    lsum += ps + ps2;
    pf[0] = pack_p(b0, 0); pf[1] = pack_p(b0, 8); pf[2] = pack_p(b1, 0); pf[3] = pack_p(b1, 8);
    pv_tile(o0, o1, sm + bufB + vrd, pf);
}
__device__ __forceinline__ float vadd1(float a, float b) { float r; asm("v_add_f32 %0, %1, %2" : "=v"(r) : "v"(a), "v"(b)); return r; }
__device__ __forceinline__ float att_max(const fa::f32x16& p0, const fa::f32x16& p1) {
    float ta = fmaxf(fmaxf(p0[0], p0[1]), p1[0]), tb = fmaxf(fmaxf(p0[2], p0[3]), p1[1]);
    ta = fmaxf(fmaxf(ta, p1[2]), p1[3]);
#pragma unroll
    for (int r = 4; r < 16; r += 4) { ta = fmaxf(fmaxf(ta, p0[r]), p0[r + 1]); tb = fmaxf(fmaxf(tb, p0[r + 2]), p0[r + 3]); ta = fmaxf(fmaxf(ta, p1[r]), p1[r + 1]); tb = fmaxf(fmaxf(tb, p1[r + 2]), p1[r + 3]); }
    return fmaxf(ta, tb);
}
__device__ __forceinline__ void att_shift(float tm, bool first, float& mrun, float& lsum, fa::f32x16& o0, fa::f32x16& o1) {
    tm = fmaxf(tm, __shfl_xor(tm, 32));
    if (first || __any(tm > mrun + 8.f)) {
        const float dl = first ? 0.f : fmaxf(tm - mrun, 0.f), alpha = __builtin_amdgcn_exp2f(-dl);
        mrun = first ? tm : mrun + dl; lsum *= alpha;
#pragma unroll
        for (int r = 0; r < 16; ++r) { o0[r] *= alpha; o1[r] *= alpha; }
    }
}
__device__ __forceinline__ void att_qk_exp(const LAS char* kb, const bf16x8 (&qf)[6], float nm, fa::f32x16& n0, fa::f32x16& n1, fa::f32x16& p0, fa::f32x16& p1, float& lsum, bf16x8 (&pf)[4]) {
    const fa::f32x16 zero = {0.f, 0.f, 0.f, 0.f, 0.f, 0.f, 0.f, 0.f, 0.f, 0.f, 0.f, 0.f, 0.f, 0.f, 0.f, 0.f};
    bf16x8 kc0 = *(const LAS bf16x8*)kb, kc1 = *(const LAS bf16x8*)(kb + 32 * fa::KP_A);
    float ps = 0.f, ps2 = 0.f;
#pragma unroll
    for (int st = 0; st < 6; ++st) {
        bf16x8 kn0 = kc0, kn1 = kc1;
        if (st < 5) { kn0 = *(const LAS bf16x8*)(kb + 32 * (st + 1)); kn1 = *(const LAS bf16x8*)(kb + 32 * fa::KP_A + 32 * (st + 1)); }
        n0 = __builtin_amdgcn_mfma_f32_32x32x16_bf16(kc0, qf[st], st == 0 ? zero : n0, 0, 0, 0);
        n1 = __builtin_amdgcn_mfma_f32_32x32x16_bf16(kc1, qf[st], st == 0 ? zero : n1, 0, 0, 0);
        constexpr int lo[7] = {0, 2, 6, 8, 10, 14, 16};
#pragma unroll
        for (int r = lo[st]; r < lo[st + 1]; ++r) {
            p0[r] = __builtin_amdgcn_exp2f(vadd1(p0[r], nm)); p1[r] = __builtin_amdgcn_exp2f(vadd1(p1[r], nm));
            ps += p0[r]; ps += p1[r]; }
        kc0 = kn0; kc1 = kn1;
        __builtin_amdgcn_sched_barrier(0);
    }
    lsum += ps + ps2;
    pf[0] = fa::pack_p(p0, 0); pf[1] = fa::pack_p(p0, 8); pf[2] = fa::pack_p(p1, 0); pf[3] = fa::pack_p(p1, 8);
}
__device__ __forceinline__ void att_exp_pack(fa::f32x16& p0, fa::f32x16& p1, float nm, float& lsum, bf16x8 (&pf)[4]) {
    float ps = 0.f, ps2 = 0.f;
#pragma unroll
    for (int r = 0; r < 16; ++r) { p0[r] = __builtin_amdgcn_exp2f(vadd1(p0[r], nm)); p1[r] = __builtin_amdgcn_exp2f(vadd1(p1[r], nm)); ps += p0[r]; ps += p1[r]; }
    lsum += ps + ps2;
    pf[0] = fa::pack_p(p0, 0); pf[1] = fa::pack_p(p0, 8); pf[2] = fa::pack_p(p1, 0); pf[3] = fa::pack_p(p1, 8);
}
__device__ __forceinline__ float att_pv_max(fa::f32x16& o0, fa::f32x16& o1, const LAS char* vb, const bf16x8 (&pf)[4], const fa::f32x16& n0, const fa::f32x16& n1) {
    using namespace fa;
    float ta = n0[0], tb = n1[0];
    s16x4 a0 = vtr(vb), a1 = vtr(vb + 512), b0 = vtr(vb + 4096), b1 = vtr(vb + 4096 + 512);
#pragma unroll
    for (int ks = 0; ks < 4; ++ks) {
        s16x4 na0 = a0, na1 = a1, nb0 = b0, nb1 = b1;
        if (ks < 3) { na0 = vtr(vb + (ks + 1) * 1024); na1 = vtr(vb + (ks + 1) * 1024 + 512); nb0 = vtr(vb + 4096 + (ks + 1) * 1024); nb1 = vtr(vb + 4096 + (ks + 1) * 1024 + 512); }
        const bf16x8 v0 = (bf16x8){a0[0], a0[1], a0[2], a0[3], a1[0], a1[1], a1[2], a1[3]}, v1 = (bf16x8){b0[0], b0[1], b0[2], b0[3], b1[0], b1[1], b1[2], b1[3]};
        o0 = __builtin_amdgcn_mfma_f32_32x32x16_bf16(v0, pf[ks], o0, 0, 0, 0);
        o1 = __builtin_amdgcn_mfma_f32_32x32x16_bf16(v1, pf[ks], o1, 0, 0, 0);
#pragma unroll
        for (int r = 4 * ks; r < 4 * ks + 4; ++r) { ta = fmaxf(ta, n0[r]); tb = fmaxf(tb, n1[r]); }
        a0 = na0; a1 = na1; b0 = nb0; b1 = nb1;
        __builtin_amdgcn_sched_barrier(0);
    }
    return fmaxf(ta, tb);
}
__device__ __forceinline__ void ph_attn_mfma(unsigned char* lds_, const bf16_t* Q, const bf16_t* Kb, const bf16_t* Vb, bf16_t* Z, int with_ctx, int u0, int ustep) { PH_IDS;
    using namespace fa;
    LAS char* sm = (LAS char*)lds_;
    const int lane = tid_ & 63, wid = __builtin_amdgcn_readfirstlane(tid_ >> 6), r32 = lane & 31, hi = lane >> 5;
    const int nunits = 256 + (with_ctx ? 32 : 0);
    const int koff0 = (tid_ / 12) * KP_A + (tid_ % 12) * 16, koff1 = ((tid_ + 512) / 12) * KP_A + ((tid_ + 512) % 12) * 16;
    const int voff = KT_A + ((tid_ & 7) >> 2) * 4096 + (tid_ >> 3) * 64 + (tid_ & 3) * 16;
    const int vrd = KT_A + ((lane >> 4) & 1) * 32 + (lane & 3) * 8 + (4 * hi + ((lane & 15) >> 2)) * 64;
    for (int u = u0; u < nunits; u += ustep) {
        const bool lat = u < 256; const int bh = lat ? (u >> 3) : (u - 256), qb = lat ? (u & 7) : 8;
        const int ntile = lat ? 36 : 4;
        const char* Kg = (const char*)(Kb + (size_t)bh * 2304 * 96); const char* Vg = (const char*)(Vb + (size_t)bh * 2304 * 64);
        const bf16_t* Qg = Q + ((size_t)bh * 2304 + qb * 256 + wid * 32 + r32) * 96;
        bf16x8 qf[6];
#pragma unroll
        for (int st = 0; st < 6; ++st) qf[st] = *(const bf16x8*)(Qg + 16 * st + 8 * hi);
        f32x16 o0, o1;
#pragma unroll
        for (int r = 0; r < 16; ++r) { o0[r] = 0.f; o1[r] = 0.f; }
        float mrun = 0.f, lsum = 0.f;
        f32x16 negm;
#pragma unroll
        for (int r = 0; r < 16; ++r) negm[r] = 0.f;
        u32x4 ka0, ka1, va, kb0, kb1, vb;
#define ATT_LOAD(k0_, k1_, v_, tt) do { const char* kg_ = Kg + (size_t)(tt) * 12288; const char* vg_ = Vg + (size_t)(tt) * 8192; \
            k0_ = *(const u32x4*)(kg_ + tid_ * 16); if (tid_ < 256) k1_ = *(const u32x4*)(kg_ + (tid_ + 512) * 16); v_ = *(const u32x4*)(vg_ + tid_ * 16); } while (0)
#define ATT_WRITE(k0_, k1_, v_, bo) do { *(LAS u32x4*)(sm + (bo) + koff0) = k0_; if (tid_ < 256) *(LAS u32x4*)(sm + (bo) + koff1) = k1_; *(LAS u32x4*)(sm + (bo) + voff) = v_; } while (0)
        ka1 = (u32x4){0u, 0u, 0u, 0u}; kb1 = ka1;
        const int npair = ntile >> 1;
        ATT_LOAD(ka0, ka1, va, 0); ATT_LOAD(kb0, kb1, vb, 1);
        __syncthreads();
        ATT_WRITE(ka0, ka1, va, 0); ATT_WRITE(kb0, kb1, vb, BUF_A);
        if (npair > 1) { ATT_LOAD(ka0, ka1, va, 2); ATT_LOAD(kb0, kb1, vb, 3); }
        __syncthreads();
        f32x16 a0, a1, b0, b1;
#pragma unroll
        for (int r = 0; r < 16; ++r) { a0[r] = 0.f; a1[r] = 0.f; }
        { const LAS char* kq0 = sm + r32 * KP_A + 16 * hi;
#pragma unroll
          for (int st = 0; st < 6; ++st) { const bf16x8 k0 = *(const LAS bf16x8*)(kq0 + 32 * st), k1 = *(const LAS bf16x8*)(kq0 + 32 * KP_A + 32 * st);
              a0 = __builtin_amdgcn_mfma_f32_32x32x16_bf16(k0, qf[st], a0, 0, 0, 0); a1 = __builtin_amdgcn_mfma_f32_32x32x16_bf16(k1, qf[st], a1, 0, 0, 0); } }
        float tmA = att_max(a0, a1);
        int cur = 0;
        for (int p = 0; p < npair; ++p) {
            const int nxt = cur == 4 * BUF_A ? 0 : cur + 2 * BUF_A;
            const bool more = p + 1 < npair;
            if (more) { ATT_WRITE(ka0, ka1, va, nxt); ATT_WRITE(kb0, kb1, vb, nxt + BUF_A); }
            if (p + 2 < npair) { ATT_LOAD(ka0, ka1, va, 2 * p + 4); ATT_LOAD(kb0, kb1, vb, 2 * p + 5); }
            bf16x8 pf[4];
            att_shift(tmA, p == 0, mrun, lsum, o0, o1);
            att_qk_exp(sm + cur + BUF_A + r32 * KP_A + 16 * hi, qf, -mrun, b0, b1, a0, a1, lsum, pf);
            const float tmB = att_pv_max(o0, o1, sm + cur + vrd, pf, b0, b1);
            att_shift(tmB, false, mrun, lsum, o0, o1);
            __syncthreads();
            if (more) {
                att_qk_exp(sm + nxt + r32 * KP_A + 16 * hi, qf, -mrun, a0, a1, b0, b1, lsum, pf);
                tmA = att_pv_max(o0, o1, sm + cur + BUF_A + vrd, pf, a0, a1);
            } else {
                att_exp_pack(b0, b1, -mrun, lsum, pf);
                pv_tile(o0, o1, sm + cur + BUF_A + vrd, pf);
            }
            cur = nxt;
        }
#undef ATT_LOAD
#undef ATT_WRITE
        lsum += __shfl_xor(lsum, 32);
        const float inv = 1.f / lsum;
        const int b = bh >> 2, h = bh & 3;
        const int row = (lat ? b * 2048 + qb * 256 : RL + b * 256) + wid * 32 + r32;
        bf16_t* op = Z + (size_t)row * ZW + C_QC + h * 64 + 4 * hi;
#pragma unroll
        for (int g = 0; g < 4; ++g) {
            u32x2 w0, w1; w0.x = pk2(o0[4 * g] * inv, o0[4 * g + 1] * inv); w0.y = pk2(o0[4 * g + 2] * inv, o0[4 * g + 3] * inv);
            w1.x = pk2(o1[4 * g] * inv, o1[4 * g + 1] * inv); w1.y = pk2(o1[4 * g + 2] * inv, o1[4 * g + 3] * inv);
            *(u32x2*)(op + 8 * g) = w0; *(u32x2*)(op + 32 + 8 * g) = w1;
        }
    }
    __syncthreads();
}

__device__ __forceinline__ void ret_tile(const LAS char* sm, int r32, int hi, int vrd, int buf, int kp0, int qw0, int qpos, float lgf, float lgb, float cf32, float cb32,
                                         const float (&ckf)[16], const float (&ckb)[16], const bf16x8 (&qf)[4], fa::f32x16& o0, fa::f32x16& o1) {
    using namespace fa;
    const LAS char* kb = sm + buf + r32 * KP_R + 16 * hi;
    f32x16 p0, p1;
#pragma unroll
    for (int r = 0; r < 16; ++r) { p0[r] = 0.f; p1[r] = 0.f; }
#pragma unroll
    for (int st = 0; st < 4; ++st) {
        const bf16x8 k0 = *(const LAS bf16x8*)(kb + 32 * st), k1 = *(const LAS bf16x8*)(kb + 32 * KP_R + 32 * st);
        p0 = __builtin_amdgcn_mfma_f32_32x32x16_bf16(k0, qf[st], p0, 0, 0, 0);
        p1 = __builtin_amdgcn_mfma_f32_32x32x16_bf16(k1, qf[st], p1, 0, 0, 0);
    }
    if (kp0 + 63 < qw0) {
        const float sq = __builtin_amdgcn_exp2f(lgf * (float)(qpos - kp0)), sq1 = sq * cf32;
#pragma unroll
        for (int r = 0; r < 16; ++r) { p0[r] = p0[r] * ckf[r] * sq; p1[r] = p1[r] * ckf[r] * sq1; }
    } else if (kp0 > qw0 + 31) {
        const float sq = __builtin_amdgcn_exp2f(lgb * (float)(kp0 - qpos)), sq1 = sq * cb32;
#pragma unroll
        for (int r = 0; r < 16; ++r) { p0[r] = p0[r] * ckb[r] * sq; p1[r] = p1[r] * ckb[r] * sq1; }
    } else {
        const int d0 = qpos - kp0 - 4 * hi;
#pragma unroll
        for (int r = 0; r < 16; ++r) {
            const float f0 = (float)(d0 - ((r & 3) + 8 * (r >> 2))), f1 = f0 - 32.f;
            const float w0 = __builtin_amdgcn_exp2f(lgf * fmaxf(f0, 0.f) + lgb * fmaxf(-f0, 0.f)) * (2.f - fminf(fabsf(f0), 1.f));
            const float w1 = __builtin_amdgcn_exp2f(lgf * fmaxf(f1, 0.f) + lgb * fmaxf(-f1, 0.f)) * (2.f - fminf(fabsf(f1), 1.f));
            p0[r] *= w0; p1[r] *= w1;
        }
    }
    bf16x8 pf[4]; pf[0] = pack_p(p0, 0); pf[1] = pack_p(p0, 8); pf[2] = pack_p(p1, 0); pf[3] = pack_p(p1, 8);
    pv_tile(o0, o1, sm + buf + vrd, pf);
}
__device__ __forceinline__ void ret_qk(const LAS char* sm, int r32, int hi, int buf, const bf16x8 (&qf)[4], fa::f32x16& p0, fa::f32x16& p1) {
    const LAS char* kb = sm + buf + r32 * fa::KP_R + 16 * hi;
#pragma unroll
    for (int r = 0; r < 16; ++r) { p0[r] = 0.f; p1[r] = 0.f; }
#pragma unroll
    for (int st = 0; st < 4; ++st) {
        const bf16x8 k0 = *(const LAS bf16x8*)(kb + 32 * st), k1 = *(const LAS bf16x8*)(kb + 32 * fa::KP_R + 32 * st);
        p0 = __builtin_amdgcn_mfma_f32_32x32x16_bf16(k0, qf[st], p0, 0, 0, 0);
        p1 = __builtin_amdgcn_mfma_f32_32x32x16_bf16(k1, qf[st], p1, 0, 0, 0);
    }
}
__device__ __forceinline__ void ret_tile_gen(const LAS char* sm, int r32, int hi, int vrd, int buf, int kp0, int qpos, float lgf, float lgb, const bf16x8 (&qf)[4], fa::f32x16& o0, fa::f32x16& o1) {
    using namespace fa;
    const LAS char* kb = sm + buf + r32 * KP_R + 16 * hi;
    f32x16 p0, p1;
#pragma unroll
    for (int r = 0; r < 16; ++r) { p0[r] = 0.f; p1[r] = 0.f; }
#pragma unroll
    for (int st = 0; st < 4; ++st) {
        const bf16x8 k0 = *(const LAS bf16x8*)(kb + 32 * st), k1 = *(const LAS bf16x8*)(kb + 32 * KP_R + 32 * st);
        p0 = __builtin_amdgcn_mfma_f32_32x32x16_bf16(k0, qf[st], p0, 0, 0, 0);
        p1 = __builtin_amdgcn_mfma_f32_32x32x16_bf16(k1, qf[st], p1, 0, 0, 0);
    }
    int d0 = qpos - kp0 - 4 * hi;
    asm volatile("" : "+v"(d0) : "v"(p0[15]), "v"(p1[15]));
#pragma unroll
    for (int r = 0; r < 16; ++r) {
        const float f0 = (float)(d0 - ((r & 3) + 8 * (r >> 2))), f1 = f0 - 32.f;
        const float w0 = __builtin_amdgcn_exp2f(lgf * fmaxf(f0, 0.f) + lgb * fmaxf(-f0, 0.f)) * (2.f - fminf(fabsf(f0), 1.f));
        const float w1 = __builtin_amdgcn_exp2f(lgf * fmaxf(f1, 0.f) + lgb * fmaxf(-f1, 0.f)) * (2.f - fminf(fabsf(f1), 1.f));
        p0[r] *= w0; p1[r] *= w1;
    }
    bf16x8 pf[4]; pf[0] = pack_p(p0, 0); pf[1] = pack_p(p0, 8); pf[2] = pack_p(p1, 0); pf[3] = pack_p(p1, 8);
    pv_tile(o0, o1, sm + buf + vrd, pf);
}
__device__ __forceinline__ void ph_ret_kv(unsigned char* lds_, const bf16_t* Z, const float* decay_logit, bf16_t* KVF, bf16_t* KVB, int vb, int vg) { PH_IDS;
    using namespace fa;
    LAS char* sm = (LAS char*)lds_;
    const int lane = tid_ & 63, wid = __builtin_amdgcn_readfirstlane(tid_ >> 6), r32 = lane & 31, hi = lane >> 5;
    const int vrd = ((lane >> 4) & 1) * 32 + (lane & 3) * 8 + (4 * hi + ((lane & 15) >> 2)) * 64;
    u32x4 pk[2], pv[2];
#define KV_ISSUE(uu) do { const int bh_ = (uu) / 18, ci_ = (uu) % 18, b_ = bh_ >> 2, h_ = bh_ & 3; const int r0_ = ci_ < 2 ? RL + b_ * 256 + 128 * ci_ : b_ * 2048 + 128 * (ci_ - 2); \
        _Pragma("unroll") for (int i = 0; i < 2; ++i) { const int p = tid_ + NT * i; const bf16_t* zr = Z + (size_t)(r0_ + (p >> 3)) * ZW + h_ * 64 + (p & 7) * 8; pk[i] = *(const u32x4*)(zr + C_RK); pv[i] = *(const u32x4*)(zr + C_RV); } } while (0)
    if (vb >= 0 && vb < 32 * 18) KV_ISSUE(vb);
    for (int u = vb >= 0 ? vb : 32 * 18; u < 32 * 18; u += vg) {
        const int bh = u / 18, h = bh & 3;
        const float lgf = -log1pf(__expf(-decay_logit[h])) * 1.4426950408889634f, lgb = -log1pf(__expf(-decay_logit[4 + h])) * 1.4426950408889634f;
        __syncthreads();
#pragma unroll
        for (int i = 0; i < 2; ++i) {
            const int p = tid_ + NT * i, row = p >> 3, c = p & 7, tile = row >> 6, key = row & 63;
            const int off = tile * 8192 + (c >> 2) * 4096 + key * 64 + (c & 3) * 16;
            *(LAS u32x4*)(sm + off) = pk[i];
            f32x4 va, vb; unpack8(pv[i], va, vb);
            const float wf = __builtin_amdgcn_exp2f(lgf * (float)(127 - row)), wb = __builtin_amdgcn_exp2f(lgb * (float)row);
            *(LAS u32x4*)(sm + 16384 + off) = pack8(va * wf, vb * wf);
            *(LAS u32x4*)(sm + 32768 + off) = pack8(va * wb, vb * wb);
        }
        if (u + vg < 32 * 18) KV_ISSUE(u + vg);
        __syncthreads();
        const int dir = wid >> 2, bd = (wid >> 1) & 1, be = wid & 1;
        f32x16 acc;
#pragma unroll
        for (int r = 0; r < 16; ++r) acc[r] = 0.f;
        const LAS char* ka = sm + bd * 4096 + vrd; const LAS char* vv = sm + 16384 + dir * 16384 + be * 4096 + vrd;
#pragma unroll
        for (int tile = 0; tile < 2; ++tile)
#pragma unroll
            for (int ks = 0; ks < 4; ++ks) {
                const s16x4 a0 = vtr(ka + tile * 8192 + ks * 1024), a1 = vtr(ka + tile * 8192 + ks * 1024 + 512), b0 = vtr(vv + tile * 8192 + ks * 1024), b1 = vtr(vv + tile * 8192 + ks * 1024 + 512);
                acc = __builtin_amdgcn_mfma_f32_32x32x16_bf16((bf16x8){a0[0], a0[1], a0[2], a0[3], a1[0], a1[1], a1[2], a1[3]}, (bf16x8){b0[0], b0[1], b0[2], b0[3], b1[0], b1[1], b1[2], b1[3]}, acc, 0, 0, 0);
            }
        bf16_t* o = (dir ? KVB : KVF) + ((size_t)u * 64 + be * 32 + r32) * 64 + bd * 32 + 4 * hi;
#pragma unroll
        for (int g = 0; g < 4; ++g) { u32x2 w; w.x = pk2n(acc[4 * g], acc[4 * g + 1]); w.y = pk2n(acc[4 * g + 2], acc[4 * g + 3]); *(u32x2*)(o + 8 * g) = w; }
    }
    __syncthreads();
}
#undef KV_ISSUE
__device__ __forceinline__ void ph_ret_chunk(unsigned char* lds_, bf16_t* Z, const bf16_t* KVF, const bf16_t* KVB, const float* decay_logit, const float* gn_w, int with_ctx, int u0, int ustep, unsigned* kvc, unsigned* barw) { PH_IDS;
    using namespace fa;
    LAS char* sm = (LAS char*)lds_;
    constexpr int ST_OFF = 4 * BUF_R, ST_SZ = 64 * KP_R;
    const int lane = tid_ & 63, wid = __builtin_amdgcn_readfirstlane(tid_ >> 6), r32 = lane & 31, hi = lane >> 5;
    const int nunits = 256 + (with_ctx ? 32 : 0);
    const int prow = tid_ >> 3, pc = tid_ & 7;
    const int koff = prow * KP_R + pc * 16;
    const int voff = KT_R + (pc >> 2) * 4096 + prow * 64 + (pc & 3) * 16;
    const int vrd = KT_R + ((lane >> 4) & 1) * 32 + (lane & 3) * 8 + (4 * hi + ((lane & 15) >> 2)) * 64;
    for (int u = u0; u < nunits; u += ustep) {
        const bool lat = u < 256; const int bh = lat ? (u >> 3) : (u - 256), qb = lat ? (u & 7) : 0, b = bh >> 2, h = bh & 3;
        const float lgf = -log1pf(__expf(-decay_logit[h])) * 1.4426950408889634f, lgb = -log1pf(__expf(-decay_logit[4 + h])) * 1.4426950408889634f;
        const int qw0 = qb * 256 + wid * 32, qpos = qw0 + r32;
        const int qrow = (lat ? b * 2048 : RL + b * 256) + qpos;
        bf16_t* zq = Z + (size_t)qrow * ZW;
        u32x4 sK[4], sV[4]; bf16x8 qf[4];
        { const size_t rb = (lat ? (size_t)b * 2048 + qb * 256 : (size_t)RL + b * 256);
#pragma unroll
          for (int j = 0; j < 4; ++j) { const bf16_t* zr = Z + (rb + 64 * j + prow) * ZW + h * 64 + pc * 8; sK[j] = *(const u32x4*)(zr + C_RK); sV[j] = *(const u32x4*)(zr + C_RV); } }
#pragma unroll
        for (int st = 0; st < 4; ++st) qf[st] = *(const bf16x8*)(zq + C_RQ + h * 64 + 16 * st + 8 * hi);
        if (kvc != nullptr && tid_ == 0) dep_spin(kvc, (unsigned)G_, barw);
        __syncthreads();
#pragma unroll
        for (int j = 0; j < 4; ++j) { *(LAS u32x4*)(sm + j * BUF_R + koff) = sK[j]; *(LAS u32x4*)(sm + j * BUF_R + voff) = sV[j]; }
        {
            const float g128f = __builtin_amdgcn_exp2f(lgf * 128.f), g128b = __builtin_amdgcn_exp2f(lgb * 128.f);
            const bf16_t* kf = KVF + (size_t)bh * 18 * 4096 + tid_ * 8; const bf16_t* kb = KVB + (size_t)bh * 18 * 4096 + tid_ * 8;
            LAS char* sto = sm + ST_OFF + (tid_ >> 3) * KP_R + (tid_ & 7) * 16;
            f32x4 sa = (f32x4){0.f, 0.f, 0.f, 0.f}, sb = sa, ta, tb;
#define ST_PUT(k) (*(LAS u32x4*)(sto + (k) * ST_SZ) = pack8(sa, sb))
#define ST_STEP(ptr, ci_, g_) do { unpack8(*(const u32x4*)((ptr) + (size_t)(ci_) * 4096), ta, tb); sa = sa * (g_) + ta; sb = sb * (g_) + tb; } while (0)
            if (lat) {
                const int cA = 2 * qb, n1 = 2 + cA, nb = 16 - cA;
                u32x4 Lq[9], Lr[9]; f32x4 sc = (f32x4){0.f, 0.f, 0.f, 0.f}, sd = sc;
#define ST_PUTB(k) (*(LAS u32x4*)(sto + (k) * ST_SZ) = pack8(sc, sd))
#pragma unroll
                for (int hf = 0; hf < 2; ++hf) {
#pragma unroll
                    for (int k = 0; k < 9; ++k) { const int kk = 9 * hf + k;
                        if (kk <= n1 && kk < 17) Lq[k] = *(const u32x4*)(kf + (size_t)kk * 4096);
                        if (kk <= nb && kk < 17) Lr[k] = *(const u32x4*)(kb + (size_t)(kk == 0 ? 1 : (kk == 1 ? 0 : 19 - kk)) * 4096); }
#pragma unroll
                    for (int k = 0; k < 9; ++k) { const int kk = 9 * hf + k;
                        if (kk == n1) ST_PUT(0); if (kk <= n1 && kk < 17) { unpack8(Lq[k], ta, tb); sa = sa * g128f + ta; sb = sb * g128f + tb; }
                        if (kk == nb) ST_PUTB(3); if (kk <= nb && kk < 17) { unpack8(Lr[k], ta, tb); sc = sc * g128b + ta; sd = sd * g128b + tb; } }
                    asm volatile("" ::: "memory"); }
                ST_PUT(1); ST_PUTB(2);
#undef ST_PUTB
            } else {
                ST_PUT(0); ST_PUT(3);
                ST_STEP(kf, 0, g128f); ST_PUT(1);
                sa = (f32x4){0.f, 0.f, 0.f, 0.f}; sb = sa; ST_STEP(kb, 1, g128b); ST_PUT(2);
            }
#undef ST_PUT
#undef ST_STEP
        }
        __syncthreads();
        u32x2 gtv[8]; f32x4 gwv[8];
#pragma unroll
        for (int g = 0; g < 4; ++g)
#pragma unroll
            for (int blk = 0; blk < 2; ++blk) { const int d = blk * 32 + 8 * g + 4 * hi; gtv[2 * g + blk] = *(const u32x2*)(zq + C_RG + h * 64 + d); gwv[2 * g + blk] = *(const f32x4*)(gn_w + h * 64 + d); }
        f32x16 o0, o1;
#pragma unroll
        for (int r = 0; r < 16; ++r) { o0[r] = 0.f; o1[r] = 0.f; }
        const int cl = wid >> 2, c0 = qb * 256 + 128 * cl;
        ret_tile_gen(sm, r32, hi, vrd, (2 * cl) * BUF_R, c0, qpos, lgf, lgb, qf, o0, o1);
        __builtin_amdgcn_sched_barrier(0);
        ret_tile_gen(sm, r32, hi, vrd, (2 * cl + 1) * BUF_R, c0 + 64, qpos, lgf, lgb, qf, o0, o1);
        __builtin_amdgcn_sched_barrier(0);
        { f32x16 p0, p1;
          ret_qk(sm, r32, hi, ST_OFF + cl * ST_SZ, qf, p0, p1);
          const float sf = __builtin_amdgcn_exp2f(lgf * (float)(qpos - c0 + 1));
#pragma unroll
          for (int r = 0; r < 16; ++r) { o0[r] += p0[r] * sf; o1[r] += p1[r] * sf; }
          ret_qk(sm, r32, hi, ST_OFF + (2 + cl) * ST_SZ, qf, p0, p1);
          const float sbk = __builtin_amdgcn_exp2f(lgb * (float)(c0 + 128 - qpos));
#pragma unroll
          for (int r = 0; r < 16; ++r) { o0[r] += p0[r] * sbk; o1[r] += p1[r] * sbk; } }
        float s1 = 0.f;
#pragma unroll
        for (int r = 0; r < 16; ++r) s1 += o0[r] + o1[r];
        s1 += __shfl_xor(s1, 32);
        const float mu = s1 * (1.f / 64);
        float s2 = 0.f;
#pragma unroll
        for (int r = 0; r < 16; ++r) { const float a = o0[r] - mu, c = o1[r] - mu; s2 += a * a + c * c; }
        s2 += __shfl_xor(s2, 32);
        const float rstd = rsqrtf(s2 * (1.f / 64) + EPS);
#pragma unroll
        for (int g = 0; g < 4; ++g)
#pragma unroll
            for (int blk = 0; blk < 2; ++blk) {
                const int d = blk * 32 + 8 * g + 4 * hi;
                const u32x2 gt = gtv[2 * g + blk];
                const f32x4 gw = gwv[2 * g + blk];
                float y[4];
#pragma unroll
                for (int q = 0; q < 4; ++q) { const float ov = blk ? o1[4 * g + q] : o0[4 * g + q]; const unsigned gb = q < 2 ? gt.x : gt.y; const float gv = __uint_as_float((q & 1) ? (gb & 0xffff0000u) : (gb << 16));
                    y[q] = siluf_(gv) * ((ov - mu) * rstd * gw[q]); }
                u32x2 w; w.x = pk2(y[0], y[1]); w.y = pk2(y[2], y[3]);
                *(u32x2*)(zq + C_RQ + h * 64 + d) = w;
            }
    }
    __syncthreads();
}

__device__ __forceinline__ void ph_ret_mfma(unsigned char* lds_, bf16_t* Z, const float* decay_logit, const float* gn_w, int with_ctx, int u0, int ustep) { PH_IDS;
    using namespace fa;
    LAS char* sm = (LAS char*)lds_;
    const int lane = tid_ & 63, wid = __builtin_amdgcn_readfirstlane(tid_ >> 6), r32 = lane & 31, hi = lane >> 5;
    const int nunits = 256 + (with_ctx ? 32 : 0);
    const int prow = tid_ >> 3, pc = tid_ & 7;
    const int koff = prow * KP_R + pc * 16;
    const int voff = KT_R + (pc >> 2) * 4096 + prow * 64 + (pc & 3) * 16;
    const int vrd = KT_R + ((lane >> 4) & 1) * 32 + (lane & 3) * 8 + (4 * hi + ((lane & 15) >> 2)) * 64;
    for (int u = u0; u < nunits; u += ustep) {
        const bool lat = u < 256; const int bh = lat ? (u >> 3) : (u - 256), qb = lat ? (u & 7) : 0, b = bh >> 2, h = bh & 3;
        const int ntile = lat ? 40 : 4;
        const float lgf = -log1pf(__expf(-decay_logit[h])) * 1.4426950408889634f, lgb = -log1pf(__expf(-decay_logit[4 + h])) * 1.4426950408889634f;
        const int qw0 = qb * 256 + wid * 32, qpos = qw0 + r32;
        const int qrow = (lat ? b * 2048 : RL + b * 256) + qpos;
        float ckf[16], ckb[16];
#pragma unroll
        for (int r = 0; r < 16; ++r) { const float off = (float)crow(r, hi); ckf[r] = __builtin_amdgcn_exp2f(-lgf * off); ckb[r] = __builtin_amdgcn_exp2f(lgb * off); }
        const float cf32 = __builtin_amdgcn_exp2f(-lgf * 32.f), cb32 = __builtin_amdgcn_exp2f(lgb * 32.f);
        bf16_t* zq = Z + (size_t)qrow * ZW;
        bf16x8 qf[4];
#pragma unroll
        for (int st = 0; st < 4; ++st) qf[st] = *(const bf16x8*)(zq + C_RQ + h * 64 + 16 * st + 8 * hi);
        f32x16 o0, o1;
#pragma unroll
        for (int r = 0; r < 16; ++r) { o0[r] = 0.f; o1[r] = 0.f; }
        const int ctx0 = RL + b * 256, lat0 = b * 2048;
#define RET_TILE_ROW(t) (lat ? ((t) < 4 ? ctx0 + 64 * (t) : ((t) < 36 ? lat0 + 64 * ((t) - 4) : ctx0 + 64 * ((t) - 36))) : ctx0 + 64 * (t))
#define RET_TILE_POS(t) (lat ? 64 * (t) - 256 : 64 * (t))
        u32x4 ka, va, kb2, vb2;
#define RET_LOAD(k_, v_, tt) do { const bf16_t* zr_ = Z + (size_t)(RET_TILE_ROW(tt) + prow) * ZW + h * 64 + pc * 8; k_ = *(const u32x4*)(zr_ + C_RK); v_ = *(const u32x4*)(zr_ + C_RV); } while (0)
#define RET_WRITE(k_, v_, bo) do { *(LAS u32x4*)(sm + (bo) + koff) = k_; *(LAS u32x4*)(sm + (bo) + voff) = v_; } while (0)
        RET_LOAD(ka, va, 0); RET_LOAD(kb2, vb2, 1);
        __syncthreads();
        RET_WRITE(ka, va, 0); RET_WRITE(kb2, vb2, BUF_R);
        __syncthreads();
        for (int t = 0; t < ntile; t += 2) {
            const int pb = (t & 2) * BUF_R, nb = 2 * BUF_R - pb;
            if (t + 2 < ntile) { RET_LOAD(ka, va, t + 2); RET_LOAD(kb2, vb2, t + 3); }
            ret_tile(sm, r32, hi, vrd, pb, RET_TILE_POS(t), qw0, qpos, lgf, lgb, cf32, cb32, ckf, ckb, qf, o0, o1);
            ret_tile(sm, r32, hi, vrd, pb + BUF_R, RET_TILE_POS(t + 1), qw0, qpos, lgf, lgb, cf32, cb32, ckf, ckb, qf, o0, o1);
            if (t + 2 < ntile) { RET_WRITE(ka, va, nb); RET_WRITE(kb2, vb2, nb + BUF_R); }
            __syncthreads();
        }
#undef RET_LOAD
#undef RET_WRITE
#undef RET_TILE_ROW
#undef RET_TILE_POS
        float s1 = 0.f;
#pragma unroll
        for (int r = 0; r < 16; ++r) s1 += o0[r] + o1[r];
        s1 += __shfl_xor(s1, 32);
        const float mu = s1 * (1.f / 64);
        float s2 = 0.f;
#pragma unroll
        for (int r = 0; r < 16; ++r) { const float a = o0[r] - mu, c = o1[r] - mu; s2 += a * a + c * c; }
        s2 += __shfl_xor(s2, 32);
        const float rstd = rsqrtf(s2 * (1.f / 64) + EPS);
#pragma unroll
        for (int g = 0; g < 4; ++g)
#pragma unroll
            for (int blk = 0; blk < 2; ++blk) {
                const int d = blk * 32 + 8 * g + 4 * hi;
                const u32x2 gt = *(const u32x2*)(zq + C_RG + h * 64 + d);
                const f32x4 gw = *(const f32x4*)(gn_w + h * 64 + d);
                float y[4];
#pragma unroll
                for (int q = 0; q < 4; ++q) { const float ov = blk ? o1[4 * g + q] : o0[4 * g + q]; const unsigned gb = q < 2 ? gt.x : gt.y; const float gv = __uint_as_float((q & 1) ? (gb & 0xffff0000u) : (gb << 16));
                    y[q] = siluf_(gv) * ((ov - mu) * rstd * gw[q]); }
                u32x2 w; w.x = pk2(y[0], y[1]); w.y = pk2(y[2], y[3]);
                *(u32x2*)(zq + C_RQ + h * 64 + d) = w;
            }
    }
    __syncthreads();
}

struct SchedGrid {
    const char* A; const char* B; unsigned lda, ldb; int nt, nM, nN, G, c, kind, aux;
    __device__ __forceinline__ bool next(int i, pg8::Unit& u) const {
        int pm, pn; if (!pg8::static_tile(nM, nN, G, c, i, pm, pn)) return false;
        u.A = A + (size_t)pm * 256 * lda; u.B = B + (size_t)pn * 256 * ldb; u.lda = lda; u.ldb = ldb; u.nt = nt; u.pm = pm; u.pn = pn; u.kind = kind; u.aux = aux; return true; }
};
struct SchedGluDyn { static constexpr bool DEP = false;
    const char* A; const char* B; unsigned* ctr; volatile LAS int* slot; int nunits;
    __device__ __forceinline__ bool next(int, pg8::Unit& u) const {
        if (threadIdx.x == 0) slot[0] = (int)atomicAdd(ctr, 1u);
        __syncthreads();
        const int q = __builtin_amdgcn_readfirstlane(slot[0]);
        if (q >= nunits) return false;
        const int pm = q >> 1, pn = q & 1;
        u.A = A + (size_t)pm * 256 * (ZW * 2); u.B = B + (size_t)pn * 256 * 512; u.lda = ZW * 2; u.ldb = 512; u.nt = 4; u.pm = pm; u.pn = pn; u.kind = 0; u.aux = 0; return true; }
};
struct SchedP1 {
    const char* A; const char* B; int G, c, last;
    __device__ __forceinline__ bool next(int i, pg8::Unit& u) const {
        int pm, pn;
        if (!last) { if (!pg8::static_tile(RT / 256, 8, G, c, i, pm, pn)) return false; }
        else { if (!pg8::static_tile(RL / 256, 8, G, c, i, pm, pn)) { const int j = i * G + c - (RL / 256) * 8; if (j < 0 || j >= 32) return false; pm = RL / 256 + (j >> 2); pn = j & 3; } }
        u.A = A + (size_t)pm * 256 * 2048; u.B = B + (size_t)pn * 256 * 2048; u.lda = 2048; u.ldb = 2048; u.nt = 16; u.pm = pm; u.pn = pn; u.kind = 0; u.aux = 0; return true; }
};
struct SchedMerge {
    const char* Z; const char* XN; const char* WBR; const char* WING; const char* OC; int njobs, G, vcu, nmini;
    __device__ __forceinline__ bool next(int i, pg8::Unit& u) const {
        int sub, n, pm, pn, part = 0;
        if (nmini > 0 && i >= 8) { if (i >= 10 || vcu >= nmini) return false; sub = i & 1; n = vcu & 3; pn = (vcu >> 2) & 3; pm = RL / 256 + (vcu >> 4); part = 1; }
        else { const int job = (i >> 3) * G + vcu; if (job >= njobs) return false; sub = i & 7; n = sub >> 1; pm = job >> 2; pn = job & 3; }
        u.pm = pm; u.pn = pn; u.aux = n;
        if (!(sub & 1)) { const int bcol = n == 0 ? C_QC : (n == 1 ? C_FU : C_RQ);
            if (n == 2) { u.A = OC + (size_t)pm * 256 * 512; u.lda = 512; } else { u.A = Z + ((size_t)pm * 256 * ZW + bcol) * 2; u.lda = ZW * 2; } u.B = WBR + ((size_t)n * 1024 + pn * 256) * 512; u.ldb = 512; u.nt = 4; u.kind = 0; }
        else { u.A = XN + (size_t)pm * 256 * 2048; u.lda = 2048; u.B = WING + ((size_t)n * 1024 + pn * 256) * 2048; u.ldb = 2048; u.nt = 16; u.kind = part ? 2 : 1; }
        return true; }
};
struct SchedFfnDown {
    const char* H; const char* W2; int G, c, nctx;
    __device__ __forceinline__ bool next(int i, pg8::Unit& u) const {
        int pm, pn;
        if (pg8::static_tile(RL / 256, 4, G, c, i, pm, pn)) { u.A = H + (size_t)pm * 256 * 8192; u.B = W2 + (size_t)pn * 256 * 8192; u.lda = 8192; u.ldb = 8192; u.nt = 64; u.pm = pm; u.pn = pn; u.kind = 0; u.aux = 0; return true; }
        const int j = i * G + c - (RL / 256) * 4; if (j < 0 || j >= nctx) return false;
        pm = RL / 256 + (j >> 4); pn = (j >> 2) & 3; const int kq = j & 3;
        u.A = H + (size_t)pm * 256 * 8192 + kq * 2048; u.B = W2 + (size_t)pn * 256 * 8192 + kq * 2048; u.lda = 8192; u.ldb = 8192; u.nt = 16; u.pm = pm; u.pn = pn; u.kind = 3; u.aux = kq; return true; }
};
#define EPI_FOREACH(...) _Pragma("unroll") for (int ai = 0; ai < 2; ++ai) _Pragma("unroll") for (int m = 0; m < 4; ++m) _Pragma("unroll") for (int bj = 0; bj < 2; ++bj) { \
        const int row = u.pm * 256 + ai * 128 + wr * 64 + m * 16 + fr, col = u.pn * 256 + bj * 128 + wc * 32 + 8 * fq; const f32x4 v0 = acc[ai][bj][m][0], v1 = acc[ai][bj][m][1]; (void)row; (void)col; __VA_ARGS__ }
struct EpiStore { static constexpr bool PRE = false;
    bf16_t* O; int ld; int act;
    __device__ __forceinline__ void operator()(const f32x4 (&acc)[2][2][4][2], const pg8::Unit& u, int wr, int wc, int fr, int fq) const {
        EPI_FOREACH( f32x4 a = v0, b = v1; if (act == 1) { _Pragma("unroll") for (int q = 0; q < 4; ++q) { const float ra = fmaxf(a[q], 0.f), rb = fmaxf(b[q], 0.f); a[q] = ra * ra; b[q] = rb * rb; } }
            *(pg8::u32x4*)(O + (size_t)row * ld + col) = pack8(a, b); )
    }
};
struct EpiFfnUp {
    static constexpr bool PRE = true;
    bf16_t* O; const float* ss; const float* cf; LAS float* red;
    __device__ __forceinline__ void pre_issue(const pg8::Unit& u, int tid, f32x4& v) const {
        if (tid < 256) v = *(const f32x4*)(ss + ((size_t)u.pm * 256 + tid) * 4);
        else v[0] = cf[(size_t)(u.pm < 64 ? (u.pm >> 3) : 8) * DFF + u.pn * 256 + (tid - 256)]; }
    __device__ __forceinline__ void pre_commit(int tid, int par, const f32x4& v) const {
        red[par * 512 + tid] = tid < 256 ? rsqrtf((v[0] + v[1] + v[2] + v[3]) * (1.f / DM) + EPS) : v[0]; }
    __device__ __forceinline__ void operator()(const f32x4 (&acc)[2][2][4][2], const pg8::Unit& u, int wr, int wc, int fr, int fq, int par) const {
        const LAS float* rp = red + par * 512 + wr * 64 + fr; const LAS float* cp = rp - (wr * 64 + fr) + 256 + wc * 32 + 8 * fq;
        EPI_FOREACH( const f32x4 c0 = *(const LAS f32x4*)(cp + bj * 128), c1 = *(const LAS f32x4*)(cp + bj * 128 + 4); const float r = rp[ai * 128 + m * 16]; f32x4 a, b;
            _Pragma("unroll") for (int q = 0; q < 4; ++q) { const float ra = fmaxf(v0[q] * r + c0[q], 0.f), rb = fmaxf(v1[q] * r + c1[q], 0.f); a[q] = ra * ra; b[q] = rb * rb; }
            *(pg8::u32x4*)(O + (size_t)row * DFF + col) = pack8(a, b); )
    }
};
template <int T> __device__ __forceinline__ void ld8(const void* base, size_t o, f32x4& a, f32x4& b) {
    if constexpr (T == 0) { const float* p = (const float*)base + o; a = *(const f32x4*)p; b = *(const f32x4*)(p + 4); } else unpack8(*(const pg8::u32x4*)((const bf16_t*)base + o), a, b); }
template <int T> __device__ __forceinline__ void st8(void* base, size_t o, const f32x4 a, const f32x4 b) {
    if constexpr (T == 0) { float* p = (float*)base + o; *(f32x4*)p = a; *(f32x4*)(p + 4) = b; } else *(pg8::u32x4*)((bf16_t*)base + o) = pack8(a, b); }
template <int XIN, int XOUT>
struct EpiResid { static constexpr bool PRE = false;
    const void* xlat; const void* xctx; void* olat; void* octx; const float* mod; int gch; float* part;
    bf16_t* an; const float* wmf; float* ss; LAS float* red;
    __device__ __forceinline__ void operator()(const f32x4 (&acc)[2][2][4][2], const pg8::Unit& u, int wr, int wc, int fr, int fq) const {
        if (u.kind == 3) { float* pb = part + (size_t)u.aux * RC * DM - (size_t)RL * DM;
            EPI_FOREACH( const size_t o = (size_t)row * DM + col; *(f32x4*)(pb + o) = v0; *(f32x4*)(pb + o + 4) = v1; if (bj) asm volatile("" ::: "memory"); )
            return; }
        const bool lat = u.pm < 64; const void* xb = lat ? xlat : xctx; void* ob = lat ? olat : octx; const size_t rb = lat ? 0 : (size_t)RL * DM;
        const float* g = mod + (size_t)(lat ? (u.pm >> 3) : 8) * 6144 + gch * 1024;
        if (an == nullptr) {
        EPI_FOREACH( const f32x4 g0 = *(const f32x4*)(g + col), g1 = *(const f32x4*)(g + col + 4); const size_t o = (size_t)row * DM + col - rb;
            f32x4 x0, x1; ld8<XIN>(xb, o, x0, x1); st8<XOUT>(ob, o, x0 + g0 * v0, x1 + g1 * v1); if (bj) asm volatile("" ::: "memory"); )
        return; }
        const float* wm = wmf + (size_t)(lat ? (u.pm >> 3) : 8) * 1024;
        float sq = 0.f;
        EPI_FOREACH( const f32x4 g0 = *(const f32x4*)(g + col), g1 = *(const f32x4*)(g + col + 4); const size_t o = (size_t)row * DM + col - rb;
            f32x4 x0, x1; ld8<XIN>(xb, o, x0, x1); const f32x4 y0 = x0 + g0 * v0, y1 = x1 + g1 * v1; st8<XOUT>(ob, o, y0, y1);
            const f32x4 w0 = *(const f32x4*)(wm + col), w1 = *(const f32x4*)(wm + col + 4);
            *(pg8::u32x4*)(an + (size_t)row * DM + col) = pack8(y0 * w0, y1 * w1);
            sq += y0[0] * y0[0] + y0[1] * y0[1] + y0[2] * y0[2] + y0[3] * y0[3] + y1[0] * y1[0] + y1[1] * y1[1] + y1[2] * y1[2] + y1[3] * y1[3];
            if (bj) { sq += __shfl_xor(sq, 16); sq += __shfl_xor(sq, 32); if (fq == 0) red[wc * 256 + ai * 128 + wr * 64 + m * 16 + fr] = sq; sq = 0.f; asm volatile("" ::: "memory"); } )
        __syncthreads();
        { int t = threadIdx.x; asm volatile("" : "+v"(t)); if (t < 256) ss[((size_t)u.pm * 256 + t) * 4 + u.pn] = red[t] + red[256 + t] + red[512 + t] + red[768 + t]; }
    }
};
struct EpiMerge { static constexpr bool PRE = false;
    pg8::u32x4* stash; bf16_t* MMp; bf16_t* PMp;
    __device__ __forceinline__ void operator()(const f32x4 (&acc)[2][2][4][2], const pg8::Unit& u, int wr, int wc, int fr, int fq) const {
        int tid = threadIdx.x; asm volatile("" : "+v"(tid));
        if (u.kind == 0) { EPI_FOREACH( stash[((ai * 4 + m) * 2 + bj) * NT + tid] = pack8(v0, v1); if (bj && (m & 1)) asm volatile("" ::: "memory"); ) }
        else { EPI_FOREACH( f32x4 y0, y1; unpack8(stash[((ai * 4 + m) * 2 + bj) * NT + tid], y0, y1); f32x4 t0, t1;
                _Pragma("unroll") for (int q = 0; q < 4; ++q) { t0[q] = sigmoidf_(v0[q]) * y0[q]; t1[q] = sigmoidf_(v1[q]) * y1[q]; }
                pg8::u32x4* mp = (pg8::u32x4*)((u.kind == 2 && u.aux != 0 ? PMp + (size_t)(u.aux - 1) * RC * DM - (size_t)RL * DM : MMp) + (size_t)row * DM + col);
                if (u.kind == 1 && u.aux != 0) { f32x4 p0, p1; unpack8(*mp, p0, p1); t0 += p0; t1 += p1; }
                *mp = pack8(t0, t1); if (bj && (m & 1)) asm volatile("" ::: "memory"); ) }
    }
};
struct TItem { const float* W; bf16_t* WT; const float* kscale; int K, N, row_off, item; };
__device__ __forceinline__ void titem_load(const TItem& t, int lane, f32x4 (&v)[8]) {
    const int nblk = t.N / 32, kb = t.item / nblk, nb = t.item % nblk;
    const float* p = t.W + (size_t)(64 * kb + (lane >> 3)) * t.N + 32 * nb + 4 * (lane & 7);
#pragma unroll
    for (int i = 0; i < 8; ++i) v[i] = *(const f32x4*)(p + (size_t)(8 * i) * t.N);
}
__device__ __forceinline__ void titem_store(const TItem& t, int lane, const f32x4 (&v)[8], LAS float* scr) {
    const int nblk = t.N / 32, kb = t.item / nblk, nb = t.item % nblk, k0 = 64 * kb, n0 = 32 * nb;
#pragma unroll
    for (int i = 0; i < 8; ++i) { const int kk = 8 * i + (lane >> 3); f32x4 w = v[i]; if (t.kscale) w *= t.kscale[k0 + kk];
        LAS float* sp = scr + kk * 33 + 4 * (lane & 7); sp[0] = w[0]; sp[1] = w[1]; sp[2] = w[2]; sp[3] = w[3]; }
    asm volatile("s_waitcnt lgkmcnt(0)" ::: "memory");
    const int c = lane & 7;
#pragma unroll
    for (int j = 0; j < 4; ++j) { const int n = (lane >> 3) + 8 * j; const LAS float* sp = scr + (8 * c) * 33 + n;
        pg8::u32x4 o; o.x = pg8::cvt_pk_bf16(sp[0 * 33], sp[1 * 33]); o.y = pg8::cvt_pk_bf16(sp[2 * 33], sp[3 * 33]); o.z = pg8::cvt_pk_bf16(sp[4 * 33], sp[5 * 33]); o.w = pg8::cvt_pk_bf16(sp[6 * 33], sp[7 * 33]);
        *(pg8::u32x4*)(t.WT + (size_t)(t.row_off + n0 + n) * t.K + k0 + 8 * c) = o; }
    asm volatile("s_waitcnt lgkmcnt(0)" ::: "memory");
}
__device__ __forceinline__ void ph_convert_weights(unsigned char* lds, int l, const float* w_in, const float* w1, const float* w2, const float* w_out, const float* w_br, const float* w_glu,
                                                   const float* w_uq, const float* q_norm, const float* w_ukv, const float* kv_norm, unsigned char* ws) { PH_IDS;
    const int wave = __builtin_amdgcn_readfirstlane(tid_ >> 6), lane = tid_ & 63;
    LAS float* scr = (LAS float*)((LAS unsigned char*)lds + wave * 16384);
    const int gw = bid_ * 8 + wave, NGW = G_ * 8;
    constexpr int I_IN = 16 * 189, I_1 = 16 * 128, I_2 = 64 * 32, I_O = 16 * 32, I_B = 4 * 32;
    constexpr int I_G = 4 * 16;
    constexpr int I_UQ = 4 * 12, I_UKV = 2 * 16;
    constexpr int NITEMS = I_IN + I_1 + I_2 + I_O + 4 * I_B + I_G + I_UQ + I_UKV;
    bf16_t* WIN_T = (bf16_t*)(ws + WS_WIN); bf16_t* W1_T = (bf16_t*)(ws + WS_W1); bf16_t* W2_T = (bf16_t*)(ws + WS_W2); bf16_t* WOUT_T = (bf16_t*)(ws + WS_WOUT); bf16_t* WBR_T = (bf16_t*)(ws + WS_WBR);
    auto decode = [&](int it) -> TItem {
        TItem t; t.kscale = nullptr; t.row_off = 0; int r = it;
        if (r < I_IN) { t.W = w_in + (size_t)l * DM * INC; t.K = DM; t.N = INC; t.WT = WIN_T; t.row_off = (r % 189) >= 61 ? 96 : 0; t.item = r; return t; } r -= I_IN;
        if (r < I_1) { t.W = w1 + (size_t)l * DM * DFF; t.K = DM; t.N = DFF; t.WT = W1_T; t.item = r; return t; } r -= I_1;
        if (r < I_2) { t.W = w2 + (size_t)l * DFF * DM; t.K = DFF; t.N = DM; t.WT = W2_T; t.item = r; return t; } r -= I_2;
        if (r < I_O) { t.W = w_out + (size_t)l * DM * DM; t.K = DM; t.N = DM; t.WT = WOUT_T; t.item = r; return t; } r -= I_O;
        if (r < 4 * I_B) { const int n = r / I_B; t.W = w_br + ((size_t)l * 4 + n) * 256 * DM; t.K = 256; t.N = DM; t.WT = WBR_T + (size_t)n * 1024 * 256; t.item = r % I_B; return t; } r -= 4 * I_B;
        if (r < I_G) { const int n0 = (r % 16) * 32;
            t.W = w_glu + (size_t)l * 256 * 512; t.K = 256; t.N = 512; t.WT = (bf16_t*)(ws + WS_WGLU); t.row_off = n0 < 128 ? 0 : (n0 < 256 ? 128 : (n0 < 384 ? -128 : 0)); t.item = r; return t; } r -= I_G;
        if (r < I_UQ) { t.W = w_uq + (size_t)l * 256 * 384; t.K = 256; t.N = 384; t.WT = (bf16_t*)(ws + WS_WUQ); t.kscale = q_norm + l * 256; t.item = r; return t; } r -= I_UQ;
        t.W = w_ukv + (size_t)l * 128 * 512; t.K = 128; t.N = 512; t.WT = (bf16_t*)(ws + WS_WUKV); t.kscale = kv_norm + l * 128; t.item = r; return t;
    };
    if (gw < NITEMS) {
        TItem cur = decode(gw); f32x4 v[8]; titem_load(cur, lane, v);
        for (int it = gw; it < NITEMS; it += NGW) {
            const bool more = it + NGW < NITEMS;
            TItem nxt = cur; f32x4 vn[8];
            if (more) { nxt = decode(it + NGW); titem_load(nxt, lane, vn); }
            titem_store(cur, lane, v, scr);
            if (more) { cur = nxt;
#pragma unroll
                for (int i = 0; i < 8; ++i) v[i] = vn[i]; }
        }
    }
    GSTRIDE(gi, 96 * 1024 / 8) { *(pg8::u32x4*)(WIN_T + (size_t)1952 * 1024 + (size_t)gi * 8) = (pg8::u32x4){0u, 0u, 0u, 0u}; }
    __syncthreads();
}

struct EpiFourier { static constexpr bool PRE = false;
    bf16_t* Zp; int rowbase, L; float scale;
    __device__ __forceinline__ void operator()(const f32x4 (&acc)[2][2][4][2], const pg8::Unit& u, int wr, int wc, int fr, int fq) const {
        EPI_FOREACH( *(pg8::u32x4*)(Zp + ((size_t)rowbase + (size_t)u.pn * L + row) * ZW + C_FU + (col - u.pn * 256)) = pack8(v0 * scale, v1 * scale); )
    }
};
__device__ __forceinline__ void ph_f2a(unsigned char* lds_, const bf16_t* F1, const float* trig, bf16_t* BP) { PH_IDS;
    const int lane = tid_ & 63, wid = __builtin_amdgcn_readfirstlane(tid_ >> 6), c16 = lane & 15, kq = lane >> 4;
    LAS char* wi = (LAS char*)lds_ + wid * 16384;
    LAS char* wo = wi + 8192;
    bf16x8 are, aim;
#pragma unroll
    for (int j = 0; j < 8; ++j) { const int t2 = 8 * (kq & 1) + j, idx = ((c16 * t2) & 15) * 128; const float cs = trig[idx], sn = trig[2048 + idx];
        are[j] = (short)f2bf((kq >> 1) ? -sn : cs); aim[j] = (short)f2bf((kq >> 1) ? cs : sn); }
    for (int col = bid_ * 8 + wid; col < NB * 256; col += G_ * 8) {
        const pg8::u32x4* src = (const pg8::u32x4*)(F1 + (size_t)col * 4096);
        pg8::u32x4 st[8];
#pragma unroll
        for (int i = 0; i < 8; ++i) st[i] = src[lane + 64 * i];
#pragma unroll
        for (int i = 0; i < 8; ++i) *(LAS pg8::u32x4*)(wi + (lane + 64 * i) * 16) = st[i];
        asm volatile("s_waitcnt lgkmcnt(0)" ::: "memory");
#pragma unroll 2
        for (int nb = 0; nb < 8; ++nb) {
            const int t1 = 16 * nb + c16;
            bf16x8 bf;
#pragma unroll
            for (int j = 0; j < 8; ++j) bf[j] = *(const LAS short*)(wi + ((kq >> 1) * 2048 + t1 + 128 * (8 * (kq & 1) + j)) * 2);
            const f32x4 z4 = (f32x4){0.f, 0.f, 0.f, 0.f};
            const f32x4 re = __builtin_amdgcn_mfma_f32_16x16x32_bf16(are, bf, z4, 0, 0, 0), im = __builtin_amdgcn_mfma_f32_16x16x32_bf16(aim, bf, z4, 0, 0, 0);
#pragma unroll
            for (int r = 0; r < 4; ++r) { const int k2 = 4 * kq + r, idx = k2 * t1; const float cs = trig[idx], sn = trig[2048 + idx];
                *(LAS bf16_t*)(wo + ((k2 * 2 + 0) * 128 + t1) * 2) = f2bf(re[r] * cs - im[r] * sn);
                *(LAS bf16_t*)(wo + ((k2 * 2 + 1) * 128 + t1) * 2) = f2bf(re[r] * sn + im[r] * cs); }
        }
        asm volatile("s_waitcnt lgkmcnt(0)" ::: "memory");
        pg8::u32x4* dst = (pg8::u32x4*)(BP + (size_t)col * 4096);
#pragma unroll
        for (int i = 0; i < 8; ++i) dst[lane + 64 * i] = *(const LAS pg8::u32x4*)(wo + (lane + 64 * i) * 16);
        asm volatile("s_waitcnt lgkmcnt(0)" ::: "memory");
    }
    __syncthreads();
}
struct SchedFourier2 { static constexpr bool DEP = false;
    const char* AT; const char* BP; int c;
    __device__ __forceinline__ bool next(int i, pg8::Unit& u) const {
        if (i != 0) return false;
        const int j = c & 7, b = c >> 3;
        u.A = AT; u.lda = 1024; u.B = BP + ((size_t)b * 256 * 4096 + (size_t)j * 512) * 2; u.ldb = 8192; u.nt = 8; u.pm = j; u.pn = b; u.kind = 0; u.aux = 0; return true; }
};
struct EpiFourier2 { static constexpr bool PRE = false;
    bf16_t* Zp; float scale;
    __device__ __forceinline__ void operator()(const f32x4 (&acc)[2][2][4][2], const pg8::Unit& u, int wr, int wc, int fr, int fq) const {
#pragma unroll
        for (int ai = 0; ai < 2; ++ai)
#pragma unroll
            for (int m = 0; m < 4; ++m)
#pragma unroll
                for (int bj = 0; bj < 2; ++bj) {
                    const int k1 = wr * 64 + m * 16 + fr, k = 16 * k1 + 2 * u.pm + ai, gm = bj * 128 + wc * 32 + 8 * fq;
                    *(pg8::u32x4*)(Zp + ((size_t)u.pn * 2048 + k) * ZW + C_FU + gm) = pack8(acc[ai][bj][m][0] * scale, acc[ai][bj][m][1] * scale);
                }
    }
};
struct EpiGlu { static constexpr bool PRE = false;
    bf16_t* OCp;
    __device__ __forceinline__ void operator()(const f32x4 (&acc)[2][2][4][2], const pg8::Unit& u, int wr, int wc, int fr, int fq) const {
#pragma unroll
        for (int ai = 0; ai < 2; ++ai)
#pragma unroll
            for (int m = 0; m < 4; ++m) {
                const int row = u.pm * 256 + ai * 128 + wr * 64 + m * 16 + fr, col = u.pn * 128 + wc * 32 + 8 * fq;
                f32x4 a, b;
#pragma unroll
                for (int q = 0; q < 4; ++q) { a[q] = acc[ai][0][m][0][q] * sigmoidf_(acc[ai][1][m][0][q]); b[q] = acc[ai][0][m][1][q] * sigmoidf_(acc[ai][1][m][1][q]); }
                *(pg8::u32x4*)(OCp + (size_t)row * 256 + col) = pack8(a, b);
            }
    }
};
__device__ __forceinline__ void ph_dft_gen(const float* trig, bf16_t* AT, bf16_t* DC) { PH_IDS;
    GSTRIDE(gi, 256 * 512) {
        const int r = gi >> 9, c = gi & 511, h = r >> 7, k1 = r & 127, hh = c >> 8, part = (c >> 7) & 1, t1 = c & 127, idx = ((k1 * t1) & 127) * 16;
        AT[gi] = f2bf(h != hh ? 0.f : (part ? -trig[2048 + idx] : trig[idx]));
    }
    GSTRIDE(gi, 256 * 512 / 8) {
        const int k = gi >> 6, kk0 = (gi & 63) * 8; pg8::u32x4 w; unsigned pr[4];
#pragma unroll
        for (int q = 0; q < 4; ++q) { float v[2];
#pragma unroll
            for (int e = 0; e < 2; ++e) { const int kk = kk0 + 2 * q + e, part = kk >> 8, t = kk & 255, idx = ((k * t) & 255) * 8; v[e] = part ? -trig[2048 + idx] : trig[idx]; }
            pr[q] = pg8::cvt_pk_bf16(v[0], v[1]); }
        w.x = pr[0]; w.y = pr[1]; w.z = pr[2]; w.w = pr[3];
        *(pg8::u32x4*)(DC + (size_t)k * 512 + kk0) = w;
    }
}

__device__ __forceinline__ void ph_sum_mm(bf16_t* MMp, const bf16_t* PMp) { PH_IDS;
    GSTRIDE(gi, RC * DM / 8) {
        pg8::u32x4* mp = (pg8::u32x4*)(MMp + (size_t)RL * DM) + gi;
        f32x4 a, b; unpack8(*mp, a, b);
#pragma unroll
        for (int n = 0; n < 3; ++n) { f32x4 c, d; unpack8(*((const pg8::u32x4*)(PMp + (size_t)n * RC * DM) + gi), c, d); a += c; b += d; }
        *mp = pack8(a, b);
    }
}
__device__ __forceinline__ void ph_sum_ffn(bf16_t* XC, const float* PD, const float* mod) { PH_IDS;
    GSTRIDE(gi, RC * DM / 8) {
        const int col = (gi * 8) & (DM - 1);
        f32x4 a0 = *((const f32x4*)PD + 2 * gi), a1 = *((const f32x4*)PD + 2 * gi + 1);
#pragma unroll
        for (int n = 1; n < 4; ++n) { a0 += *((const f32x4*)(PD + (size_t)n * RC * DM) + 2 * gi); a1 += *((const f32x4*)(PD + (size_t)n * RC * DM) + 2 * gi + 1); }
        const f32x4 g0 = *(const f32x4*)(mod + (size_t)8 * 6144 + 5 * 1024 + col), g1 = *(const f32x4*)(mod + (size_t)8 * 6144 + 5 * 1024 + col + 4);
        f32x4 x0, x1; ld8<1>(XC, (size_t)gi * 8, x0, x1); st8<1>(XC, (size_t)gi * 8, x0 + g0 * a0, x1 + g1 * a1);
    }
}

constexpr size_t WS_BAR = 768 * 1024;
constexpr int LDS_BYTES = 147456;
struct Args { const float* in[30]; float* out; unsigned char* ws; };
typedef const __attribute__((address_space(4))) Args* CArgs;
__device__ __forceinline__ CArgs kargs() { CArgs p = (CArgs)__builtin_amdgcn_kernarg_segment_ptr(); asm volatile("" : "+s"(p)); return p; }
#define IN(i) (kargs()->in[i])
#define WSB(T, off) ((T*)(kargs()->ws + (off)))
#define OSB(T, off) ((T*)((unsigned char*)kargs()->out + (off)))
#define OUTP (kargs()->out)
enum { I_X = 0, I_C, I_CTX, I_CCTX, I_ADAW, I_ADAB, I_NMIX, I_NFFN, I_WIN, I_QNORM, I_WUQ, I_KVNORM, I_WUKV, I_QKQ, I_QKK, I_LRE, I_LIM, I_LSTEP, I_BRE, I_BIM, I_CRE, I_CIM, I_S5D, I_WGLU, I_RDEC, I_RGN, I_WBR, I_WOUT, I_W1, I_W2 };
#define GRID_BAR() do { bar.bar = WSB(unsigned, WS_BAR); { unsigned x_ = bar.x; asm volatile("" : "+s"(x_)); bar.x = x_; } xcd_barrier(bar); } while (0)
template <int L> __device__ __forceinline__ void layer_body(unsigned char* lds, XcdBarrier& bar) {
    constexpr int l = L;
    constexpr bool LASTL = (L == DEPTH - 1);
    constexpr int NMT = LASTL ? RL / 256 : RT / 256;
    constexpr int WCTX = LASTL ? 0 : 1;

#define MODL (WSB(float, WS_MOD) + (size_t)l * 9 * 6144)
#define XLAT (l == 0 ? (const void*)IN(I_X) : (const void*)WSB(bf16_t, WS_R))
#define XCTX (l == 0 ? (const void*)IN(I_CTX) : (const void*)WSB(bf16_t, WS_XCB))
    constexpr int XIN = (L == 0) ? 0 : 1;
#define WINL (IN(I_WIN) + (size_t)l * DM * INC)
#define ZP WSB(bf16_t, WS_Z)
#define XNP WSB(bf16_t, WS_XN)
#define QP WSB(bf16_t, WS_QKV)
#define KP (WSB(bf16_t, WS_QKV) + (size_t)32 * 2304 * 96)
#define VP (WSB(bf16_t, WS_QKV) + (size_t)2 * 32 * 2304 * 96)
#define F1LAT WSB(bf16_t, WS_F1)
#define F1CTX (WSB(bf16_t, WS_F1) + (size_t)8 * 256 * 2 * 2048)
#define QRAWP WSB(bf16_t, WS_RAW)
#define KVRAWP (WSB(bf16_t, WS_RAW) + (size_t)RT * 384)
        if (l != 0) ph_s5_lp(l, IN(I_LRE), IN(I_LIM), IN(I_LSTEP), IN(I_BRE), IN(I_BIM), WSB(float2, WS_LP), WSB(float2, WS_BB), WSB(float, WS_LAMT));
        ph_adarms<XIN>(XLAT, XCTX, IN(I_NMIX) + l * DM, MODL, 0, 1, XNP, RT);
        if (l != 0) ph_convert_weights(lds, l, IN(I_WIN), IN(I_W1), IN(I_W2), IN(I_WOUT), IN(I_WBR), IN(I_WGLU), IN(I_WUQ), IN(I_QNORM), IN(I_WUKV), IN(I_KVNORM), kargs()->ws);
        if (l == 0) ph_dft_gen(WSB(float, WS_TRIG), OSB(bf16_t, OS_AT), OSB(bf16_t, OS_DFTC));
        ph_wmf(IN(I_NFFN) + l * DM, MODL, WSB(float, WS_WMF));
        GRID_BAR();
        { SchedP1 S; S.A = (const char*)XNP; S.B = (const char*)WSB(bf16_t, WS_WIN); S.G = l_grid(); S.c = l_bid(); S.last = LASTL ? 1 : 0;
          EpiStore E; E.O = ZP; E.ld = ZW; E.act = 0; pg8::gemm_phase((LAS unsigned char*)lds, S, E); }
        { const int G = l_grid(), bx = l_bid(), n3 = G == 256 ? (LASTL ? 32 : 64) : 0;
          if (bx >= n3) { const int vb = bx - n3, vg = G - n3;
            ph_s5_tz(lds, l, WSB(float2, WS_LP), WSB(float2, WS_BB), IN(I_CRE), IN(I_CIM), WSB(float, WS_TZ), vb, vg);
            ph_s5_ms(WSB(float2, WS_LP), WSB(float2, WS_BB), WSB(bf16_t, WS_MS), vb, vg);
            ph_cf_mfma(lds, WSB(bf16_t, WS_W1), MODL, WSB(float, WS_CF), vb, vg); } }
        GRID_BAR();
        ph_s5_tzb(l, WSB(float, WS_TZ), IN(I_S5D) + l * 256, OSB(bf16_t, OS_TZB), IN(I_CRE), IN(I_CIM), OSB(bf16_t, OS_CQ));
        ph_prep(ZP, WSB(bf16_t, WS_WUQ), WSB(bf16_t, WS_WUKV), WSB(bf16_t, WS_D64), IN(I_QKQ) + l * 96, IN(I_QKK) + l * 96, QP, KP, VP, F1LAT, F1CTX, lds);
        ph_s5_sloc(lds, ZP, WSB(bf16_t, WS_MS), OSB(float, OS_SLOC));
        GRID_BAR();
        unsigned* kvc_ = WSB(unsigned, WS_BAR) + XCD_BAR_WORDS + 128 + 1024 * l;
        unsigned* f2c_ = kvc_ + 640;
        ph_f2a(lds, F1LAT, WSB(float, WS_TRIG), OSB(bf16_t, OS_BP));
        dep_signal_x(f2c_, f2c_ + 32 + 16 * bar.x, bar.st[0]);
        { const int G = l_grid(), bx = l_bid(), nf = G == 256 ? (LASTL ? 64 : 72) : 0;
          ph_ret_kv(lds, ZP, IN(I_RDEC) + l * 8, WSB(bf16_t, WS_KVF), OSB(bf16_t, OS_KVB), bx - nf, G - nf);
          dep_signal_x(kvc_, kvc_ + 32 + 16 * bar.x, bar.st[0]); }
        {
            const int bx = l_bid();
            if (bx < 64) { if (l_tid() == 0) dep_spin(f2c_, (unsigned)l_grid(), WSB(unsigned, WS_BAR)); __syncthreads();
                SchedFourier2 S; S.AT = (const char*)OSB(bf16_t, OS_AT); S.BP = (const char*)OSB(bf16_t, OS_BP); S.c = bx;
                EpiFourier2 E; E.Zp = ZP; E.scale = 0.0027621358640099515f; pg8::gemm_phase((LAS unsigned char*)lds, S, E); }
            else if (!LASTL && bx < 72) { SchedGrid S; S.A = (const char*)OSB(bf16_t, OS_DFTC); S.B = (const char*)F1CTX; S.lda = 1024; S.ldb = 1024; S.nt = 8; S.nM = 1; S.nN = 8; S.G = 8; S.c = bx - 64; S.kind = 0; S.aux = 0;
                EpiFourier E; E.Zp = ZP; E.rowbase = RL; E.L = 256; E.scale = 0.0078125f; pg8::gemm_phase((LAS unsigned char*)lds, S, E); }
            constexpr int NS5 = 16 * (LASTL ? 16 : 18);
            constexpr int NC = LASTL ? 0 : 32;
            constexpr int Q_ATT = 0, Q_ATTC = 256, Q_S5 = Q_ATTC + NC, Q_RET = Q_S5 + NS5, Q_RETC = Q_RET + 256, Q_END = Q_RETC + NC;
            volatile LAS int* qslot = (volatile LAS int*)((LAS unsigned char*)lds + LDS_BYTES - 32);
            unsigned* s5c_ = kvc_ + 320; bool s5sig_ = false;
            for (;;) {
                __syncthreads();
                if (l_tid() == 0) qslot[0] = (int)atomicAdd(WSB(unsigned, WS_BAR) + XCD_BAR_WORDS + 64 * l, 1u);
                __syncthreads();
                const int q = __builtin_amdgcn_readfirstlane(qslot[0]);
                if (!s5sig_ && q >= Q_RET) { dep_signal_x(s5c_, s5c_ + 32 + 16 * bar.x, bar.st[0]); s5sig_ = true; }
                if (q >= Q_END) break;
                if (q < Q_ATTC) ph_attn_mfma(lds, QP, KP, VP, ZP, WCTX, q - Q_ATT, 1 << 20);
                else if (q < Q_S5) ph_attn_mfma(lds, QP, KP, VP, ZP, WCTX, 256 + q - Q_ATTC, 1 << 20);
                else if (q < Q_RET) ph_s5_out(lds, ZP, OSB(bf16_t, OS_TZB), OSB(bf16_t, OS_CQ), WSB(float2, WS_LP), OSB(float, OS_SLOC), WSB(float, WS_LAMT), ZP, LASTL ? 16 : 18, q - Q_S5, 1 << 20);
                else if (q < Q_RETC) ph_ret_chunk(lds, ZP, WSB(bf16_t, WS_KVF), OSB(bf16_t, OS_KVB), IN(I_RDEC) + l * 8, IN(I_RGN) + l * 256, WCTX, q - Q_RET, 1 << 20, kvc_, WSB(unsigned, WS_BAR));
                else ph_ret_chunk(lds, ZP, WSB(bf16_t, WS_KVF), OSB(bf16_t, OS_KVB), IN(I_RDEC) + l * 8, IN(I_RGN) + l * 256, WCTX, 256 + q - Q_RETC, 1 << 20, kvc_, WSB(unsigned, WS_BAR));
            }
        }
        if (l_tid() == 0) dep_spin(kvc_ + 320, (unsigned)l_grid(), WSB(unsigned, WS_BAR));
        __syncthreads();
        { SchedGluDyn S; S.A = (const char*)(ZP + C_S5); S.B = (const char*)WSB(bf16_t, WS_WGLU); S.ctr = kvc_ + 960; S.slot = (volatile LAS int*)((LAS unsigned char*)lds + LDS_BYTES - 32); S.nunits = NMT * 2;
          EpiGlu E; E.OCp = OSB(bf16_t, OS_OC); pg8::gemm_phase((LAS unsigned char*)lds, S, E); }
        GRID_BAR();
        { SchedMerge S; S.Z = (const char*)ZP; S.XN = (const char*)XNP; S.WBR = (const char*)WSB(bf16_t, WS_WBR); S.WING = (const char*)(WSB(bf16_t, WS_WIN) + (size_t)2048 * 1024); S.OC = (const char*)OSB(bf16_t, OS_OC);
          S.G = l_grid(); { const int bx = l_bid(); S.vcu = (bx % 8) * (S.G / 8) + bx / 8; }
          const bool mini = !LASTL && S.G == 256;
          S.njobs = mini ? RL / 256 * 4 : NMT * 4; S.nmini = mini ? 128 : 0;
          EpiMerge E; E.stash = WSB(pg8::u32x4, WS_STASH) + (size_t)l_bid() * 8192; E.MMp = WSB(bf16_t, WS_MM); E.PMp = OSB(bf16_t, OS_PM); pg8::gemm_phase((LAS unsigned char*)lds, S, E); }
        GRID_BAR();
        if (!LASTL && l_grid() == 256) { ph_sum_mm(WSB(bf16_t, WS_MM), OSB(bf16_t, OS_PM)); GRID_BAR(); }
        { SchedGrid S; S.A = (const char*)WSB(bf16_t, WS_MM); S.B = (const char*)WSB(bf16_t, WS_WOUT); S.lda = 2048; S.ldb = 2048; S.nt = 16; S.nM = NMT; S.nN = 4; S.G = l_grid(); S.c = l_bid(); S.kind = 0; S.aux = 0;
          EpiResid<XIN, 1> E; E.xlat = XLAT; E.xctx = XCTX; E.olat = WSB(bf16_t, WS_R); E.octx = WSB(bf16_t, WS_XCB); E.mod = MODL; E.gch = 2; E.part = nullptr; E.an = XNP; E.wmf = WSB(float, WS_WMF); E.ss = OSB(float, OS_SS); E.red = (LAS float*)((LAS unsigned char*)lds + 131072); pg8::gemm_phase((LAS unsigned char*)lds, S, E); }
        GRID_BAR();
        { SchedGrid S; S.A = (const char*)XNP; S.B = (const char*)WSB(bf16_t, WS_W1); S.lda = 2048; S.ldb = 2048; S.nt = 16; S.nM = NMT; S.nN = 16; S.G = l_grid(); S.c = l_bid(); S.kind = 0; S.aux = 0;
          EpiFfnUp E; E.O = WSB(bf16_t, WS_H); E.ss = OSB(float, OS_SS); E.cf = WSB(float, WS_CF); E.red = (LAS float*)((LAS unsigned char*)lds + 131072); pg8::gemm_phase((LAS unsigned char*)lds, S, E); }
        GRID_BAR();
        { SchedFfnDown S; S.H = (const char*)WSB(bf16_t, WS_H); S.W2 = (const char*)WSB(bf16_t, WS_W2); S.G = l_grid(); S.c = l_bid(); S.nctx = (!LASTL && S.G == 256) ? 128 : 0;
          EpiResid<1, LASTL ? 0 : 1> E; E.xlat = WSB(bf16_t, WS_R); E.xctx = WSB(bf16_t, WS_XCB); E.olat = LASTL ? (void*)OUTP : (void*)WSB(bf16_t, WS_R); E.octx = WSB(bf16_t, WS_XCB); E.mod = MODL; E.gch = 5; E.part = WSB(float, WS_PD); E.an = nullptr; E.wmf = nullptr; E.ss = nullptr; E.red = nullptr;
          if (!LASTL && S.G != 256) { SchedGrid S2; S2.A = S.H; S2.B = S.W2; S2.lda = 8192; S2.ldb = 8192; S2.nt = 64; S2.nM = NMT; S2.nN = 4; S2.G = S.G; S2.c = S.c; S2.kind = 0; S2.aux = 0; pg8::gemm_phase((LAS unsigned char*)lds, S2, E); }
          else pg8::gemm_phase((LAS unsigned char*)lds, S, E); }
        if (!LASTL && l_grid() == 256) { GRID_BAR(); ph_sum_ffn(WSB(bf16_t, WS_XCB), WSB(float, WS_PD), MODL); }
        if (l + 1 < DEPTH) GRID_BAR();
}
__global__ void __launch_bounds__(NT, 2) mega(Args a_unused) {
    extern __shared__ __attribute__((aligned(16))) unsigned char lds[];
    volatile LAS unsigned* bst = (volatile LAS unsigned*)((LAS unsigned char*)lds + LDS_BYTES - 16);
    if (threadIdx.x < 4) bst[threadIdx.x] = 0u;
    __syncthreads();
    XcdBarrier bar = xcd_barrier_post(WSB(unsigned, WS_BAR), bst);

    ph_mod(lds, IN(I_C), IN(I_CCTX), IN(I_ADAW), IN(I_ADAB), WSB(float, WS_MOD));
    ph_trig(WSB(float, WS_TRIG), WSB(bf16_t, WS_D64));
    ph_s5_lp(0, IN(I_LRE), IN(I_LIM), IN(I_LSTEP), IN(I_BRE), IN(I_BIM), WSB(float2, WS_LP), WSB(float2, WS_BB), WSB(float, WS_LAMT));
    ph_convert_weights(lds, 0, IN(I_WIN), IN(I_W1), IN(I_W2), IN(I_WOUT), IN(I_WBR), IN(I_WGLU), IN(I_WUQ), IN(I_QNORM), IN(I_WUKV), IN(I_KVNORM), kargs()->ws);
    GRID_BAR();
    layer_body<0>(lds, bar);
    layer_body<1>(lds, bar);
}

extern "C" void kernel_launch(void* const* d_in, const int* in_sizes, int n_in, void* d_out, int out_size, void* d_ws, size_t ws_size, hipStream_t stream) {
    static int grid = 0;
    if (grid == 0) {
        if (n_in != 30 || ws_size < WS_END) { fprintf(stderr, "kernel_launch: unexpected n_in %d / ws_size %zu\n", n_in, ws_size); grid = -1; return; }
        int dev = 0, cus = 0, per_cu = 0;
        if (hipGetDevice(&dev) != hipSuccess || hipDeviceGetAttribute(&cus, hipDeviceAttributeMultiprocessorCount, dev) != hipSuccess) { grid = -1; return; }
        if (hipFuncSetAttribute((const void*)mega, hipFuncAttributeMaxDynamicSharedMemorySize, LDS_BYTES) != hipSuccess) { fprintf(stderr, "kernel_launch: hipFuncSetAttribute failed\n"); grid = -1; return; }
        if (hipOccupancyMaxActiveBlocksPerMultiprocessor(&per_cu, (const void*)mega, NT, LDS_BYTES) != hipSuccess || per_cu < 1) fprintf(stderr, "kernel_launch: occupancy query says %d\n", per_cu);
        (void)hipGetLastError();
        grid = cus;
    }
    if (grid < 0) return;
    (void)hipMemsetAsync((char*)d_ws + WS_BAR, 0, (XCD_BAR_WORDS + 128 + 2048) * 4, stream);
    Args a; memset((void*)&a, 0, sizeof(a));
    for (int i = 0; i < 30; ++i) a.in[i] = (const float*)d_in[i];
    a.out = (float*)d_out; a.ws = (unsigned char*)d_ws;
    hipLaunchKernelGGL(mega, dim3(grid), dim3(NT), LDS_BYTES, stream, a);
}
```

```cpp
#include <hip/hip_runtime.h>
#include <cstdint>
#include <cstring>
#include <cstdio>

typedef unsigned short bf16_t;
typedef short bf16x8 __attribute__((ext_vector_type(8)));
typedef float f32x4 __attribute__((ext_vector_type(4)));

constexpr int DM = 1024, NB = 8, SEQ = 2048, CTX = 256, DEPTH = 2;
constexpr int RL = NB * SEQ;
constexpr int RC = NB * CTX;
constexpr int RT = RL + RC;
constexpr int INC = 6048;
constexpr int ZW = 2048;
constexpr int C_KVC = 0, C_KR = 128, C_S5 = 160, C_RK = 416, C_RV = 672, C_QC = 928, C_FU = 1184, C_RQ = 1440, C_RG = 1696, C_GATE = 1952;
constexpr int C_OC = C_RK;
constexpr int DFF = 4096;
constexpr int TCH = 64;
constexpr int NCH = RT / TCH;
constexpr float EPS = 1e-6f;
#define PI_D 3.14159265358979323846

__device__ __forceinline__ float bf2f(bf16_t v) { return __uint_as_float(((unsigned)v) << 16); }
__device__ __forceinline__ bf16_t f2bf(float f) { unsigned u = __float_as_uint(f); return (bf16_t)((u + 0x7fffu + ((u >> 16) & 1u)) >> 16); }
__device__ __forceinline__ float sigmoidf_(float x) { return 1.f / (1.f + __expf(-x)); }
__device__ __forceinline__ float siluf_(float x) { return x * sigmoidf_(x); }
__device__ __forceinline__ float geluf_(float x) { return 0.5f * x * (1.f + tanhf(0.7978845608028654f * (x + 0.044715f * x * x * x))); }
__device__ __forceinline__ int row_batch(int row) { return row < RL ? (row >> 11) : ((row - RL) >> 8); }
__device__ __forceinline__ int row_modidx(int row) { return row < RL ? (row >> 11) : 8; }

constexpr size_t MiB = 1ull << 20;
constexpr size_t WS_MOD = 0;
constexpr size_t WS_RS = 512 * 1024;
constexpr size_t WS_TRIG = 512 * 1024;
constexpr size_t WS_LAMT = WS_TRIG + 32 * 1024;
constexpr size_t WS_LP = 1 * MiB;
constexpr size_t WS_BB = 2 * MiB + 128 * 1024;
constexpr size_t WS_W = 8 * MiB;
constexpr size_t WS_WIN = WS_W, WS_W1 = WS_W + 12 * MiB, WS_W2 = WS_W + 20 * MiB, WS_WOUT = WS_W + 28 * MiB, WS_WBR = WS_W + 30 * MiB;
constexpr size_t WS_XN = 40 * MiB;
constexpr size_t WS_RAW = WS_XN;
constexpr size_t WS_YG = WS_XN;
constexpr size_t WS_Z = 76 * MiB;
constexpr size_t WS_QKV = 148 * MiB;
constexpr size_t WS_F1 = 184 * MiB;
constexpr size_t WS_GL = WS_F1;
constexpr size_t WS_TZ = 202 * MiB;
constexpr size_t WS_MS = 204 * MiB;
constexpr size_t WS_QO = 212 * MiB;
constexpr size_t WS_MM = WS_QKV;
constexpr size_t WS_STASH = WS_F1;
constexpr size_t WS_KVF = 3 * MiB + 512 * 1024;
constexpr size_t WS_PD = WS_XN;
constexpr size_t WS_H = WS_Z;
constexpr size_t WS_WUQ = 2 * MiB + 768 * 1024;
constexpr size_t WS_WUKV = 3 * MiB;
constexpr size_t WS_D64 = 512 * 1024 + 64 * 1024;
constexpr size_t WS_WGLU = 2 * MiB + 512 * 1024;
constexpr size_t WS_CF = 3 * MiB + 128 * 1024;
constexpr size_t WS_WMF = 3 * MiB + 320 * 1024;
constexpr size_t WS_R = 220 * MiB;
constexpr size_t WS_XCB = 252 * MiB;
constexpr size_t OS_AT = 0;
constexpr size_t OS_BP = 1 * MiB;
constexpr size_t OS_DFTC = 53 * MiB;
constexpr size_t OS_SLOC = 17 * MiB;
constexpr size_t OS_KVB = 22 * MiB;
constexpr size_t OS_PM = 27 * MiB;
constexpr size_t OS_TZB = 41 * MiB;
constexpr size_t OS_CQ = 42 * MiB;
constexpr size_t OS_OC = 43 * MiB;
constexpr size_t OS_SS = 40 * MiB;
constexpr size_t WS_END = 256 * MiB;


#define LAS __attribute__((address_space(3)))
#define NT 512
__device__ __forceinline__ int l_tid() { int t = threadIdx.x; asm volatile("" : "+v"(t)); return t; }
__device__ __forceinline__ int l_bid() { int b = blockIdx.x; asm volatile("" : "+s"(b)); return b; }
__device__ __forceinline__ int l_grid() { int g = gridDim.x; asm volatile("" : "+s"(g)); return g; }
#define PH_IDS const int tid_ = l_tid(), bid_ = l_bid(), G_ = l_grid(); (void)tid_; (void)bid_; (void)G_
template <class AF, class BF, class EF>
__device__ __forceinline__ void gemm_tile(const AF& A, const BF& B, const EF& E, bool valid, int b, int m0, int n0, int M, int N, int K, bf16_t (*sA)[40], bf16_t (*sB)[40], int ht) {
    f32x4 accm[2][2];
#pragma unroll
    for (int i = 0; i < 2; ++i)
#pragma unroll
        for (int j = 0; j < 2; ++j) accm[i][j] = (f32x4){0.f, 0.f, 0.f, 0.f};
    const int w = ht >> 6, lane = ht & 63, wm = (w >> 1) * 32, wn = (w & 1) * 32, fr = lane & 15, fq = lane >> 4;
    for (int k0 = 0; k0 < K; k0 += 32) {
        __syncthreads();
#pragma unroll
        for (int i = 0; i < 8; ++i) {
            const int e = ht + i * 256;
            { const int m = e >> 5, k = e & 31; float v = 0.f; if (valid && m0 + m < M && k0 + k < K) v = A(b, m0 + m, k0 + k); sA[m][k] = f2bf(v); }
            { const int k = e >> 6, n = e & 63; float v = 0.f; if (valid && n0 + n < N && k0 + k < K) v = B(b, k0 + k, n0 + n); sB[n][k] = f2bf(v); }
        }
        __syncthreads();
        bf16x8 af[2], bfr[2];
#pragma unroll
        for (int i = 0; i < 2; ++i) { af[i] = *(const bf16x8*)&sA[wm + i * 16 + fr][fq * 8]; bfr[i] = *(const bf16x8*)&sB[wn + i * 16 + fr][fq * 8]; }
#pragma unroll
        for (int i = 0; i < 2; ++i)
#pragma unroll
            for (int j = 0; j < 2; ++j) accm[i][j] = __builtin_amdgcn_mfma_f32_16x16x32_bf16(af[i], bfr[j], accm[i][j], 0, 0, 0);
    }
    if (valid) {
#pragma unroll
        for (int i = 0; i < 2; ++i)
#pragma unroll
            for (int j = 0; j < 2; ++j)
#pragma unroll
                for (int rr = 0; rr < 4; ++rr) {
                    const int m = m0 + wm + i * 16 + fq * 4 + rr, n = n0 + wn + j * 16 + fr;
                    if (m < M && n < N) E(b, m, n, accm[i][j][rr]);
                }
    }
}
template <class AF, class BF, class EF>
__device__ __forceinline__ void gemm_phase(unsigned char* lds, const AF& A, const BF& B, const EF& E, int nbatch, int M, int N, int K) {
    PH_IDS; const int tid = tid_, half = tid >> 8, ht = tid & 255;
    bf16_t (*sA)[40] = (bf16_t (*)[40])(lds + half * 10240);
    bf16_t (*sB)[40] = (bf16_t (*)[40])(lds + half * 10240 + 5120);
    const int tm = (M + 63) >> 6, tn = (N + 63) >> 6, total = nbatch * tm * tn;
    for (int it0 = bid_ * 2; it0 < total; it0 += G_ * 2) {
        const int it = it0 + half; const bool valid = it < total;
        const int itc = valid ? it : 0;
        const int b = itc / (tm * tn), r = itc % (tm * tn), m0 = (r / tn) * 64, n0 = (r % tn) * 64;
        gemm_tile(A, B, E, valid, b, m0, n0, M, N, K, sA, sB, ht);
    }
    __syncthreads();
}
template <class T> static T zeroed() { T t; memset((void*)&t, 0, sizeof(T)); return t; }

struct A_bf16 { const bf16_t* p; long long ld; long long coff;
    __device__ float operator()(int, int m, int k) const { return bf2f(p[(size_t)m * ld + coff + k]); } };
struct A_bf16_scaled { const bf16_t* p; long long ld; long long coff; const float* rs; long long rsi; const float* w;
    __device__ float operator()(int, int m, int k) const { return bf2f(p[(size_t)m * ld + coff + k]) * rs[(size_t)m * 2 + rsi] * w[k]; } };
struct B_f32 { const float* p; long long ld; long long coff;
    __device__ float operator()(int, int k, int n) const { return p[(size_t)k * ld + coff + n]; } };
struct E_bf16 { bf16_t* p; long long ld; long long coff;
    __device__ void operator()(int, int m, int n, float v) const { p[(size_t)m * ld + coff + n] = f2bf(v); } };

#define XB_TMO      128
#define XB_XCNT(j)  (256  + 64 * (j))
#define XB_XSUB(j)  (1280 + 64 * (j))
#define XB_XGEN(j)  (2304 + 64 * (j))
#define XB_TOP      3328
#define XB_TOPGEN   3392
#define XCD_BAR_WORDS 3456
#define XB_SPIN_CAP (1u << 18)
__device__ __forceinline__ unsigned xb_ld(unsigned* p)              { return __hip_atomic_load(p, __ATOMIC_RELAXED, __HIP_MEMORY_SCOPE_AGENT); }
__device__ __forceinline__ unsigned xb_add(unsigned* p, unsigned v) { return __hip_atomic_fetch_add(p, v, __ATOMIC_RELAXED, __HIP_MEMORY_SCOPE_AGENT); }
__device__ __forceinline__ unsigned xb_xcc_id() { return (unsigned)__builtin_amdgcn_s_getreg((3 << 11) | 20) & 0xFu; }
#define XB_SPIN(cond, bar) do { unsigned _sp = 0; while (cond) { __builtin_amdgcn_s_sleep(1); \
    if ((++_sp & 255u) == 0u) { if (xb_ld(&(bar)[XB_TMO])) break; if (_sp > XB_SPIN_CAP) { atomicAdd(&(bar)[XB_TMO], 1u); break; } } } } while (0)
struct XcdBarrier { unsigned* bar; unsigned x; volatile LAS unsigned* st; };
__device__ __forceinline__ XcdBarrier xcd_barrier_post(unsigned* bar, volatile LAS unsigned* st) {
    XcdBarrier b; b.bar = bar; b.x = xb_xcc_id(); b.st = st;
    if (threadIdx.x == 0) (void)xb_add(&bar[XB_XCNT(b.x)], 1u);
    return b;
}
__device__ __forceinline__ void xcd_barrier_complete(unsigned* bar, unsigned x, unsigned& nloc, unsigned& nx) {
    const unsigned G = gridDim.x * gridDim.y * gridDim.z;
    unsigned sum, cnt, mine, sp = 0u;
    for (;;) {
        sum = 0u; cnt = 0u; mine = 0u;
#pragma unroll
        for (unsigned j = 0; j < 16; ++j) { const unsigned c = xb_ld(&bar[XB_XCNT(j)]); sum += c; cnt += (c > 0u) ? 1u : 0u; mine = (j == x) ? c : mine; }
        if (sum == G) break;
        __builtin_amdgcn_s_sleep(1);
        if ((++sp & 255u) == 0u) { if (xb_ld(&bar[XB_TMO])) break; if (sp > XB_SPIN_CAP) { atomicAdd(&bar[XB_TMO], 1u); break; } }
    }
    nloc = mine > 0u ? mine : 1u; nx = cnt > 0u ? cnt : 1u;
}
__device__ __forceinline__ void xcd_barrier(const XcdBarrier& b) {
    asm volatile("s_waitcnt vmcnt(0)" ::: "memory");
    __syncthreads();
    if (threadIdx.x == 0) {
        unsigned* bar = b.bar;
        __builtin_amdgcn_s_waitcnt(0);
        unsigned nloc = b.st[0], nx = b.st[1];
        if (nloc == 0u) { xcd_barrier_complete(bar, b.x, nloc, nx); b.st[0] = nloc; b.st[1] = nx; }
        const unsigned old = xb_add(&bar[XB_XSUB(b.x)], 1u);
        const unsigned gen = old / nloc;
        if (old + 1u == (gen + 1u) * nloc) {
            __builtin_amdgcn_fence(__ATOMIC_RELEASE, "agent");
            asm volatile("s_waitcnt vmcnt(0)" ::: "memory");
            const unsigned og = xb_add(&bar[XB_TOP], 1u);
            const unsigned tg = og / nx;
            if (og + 1u == (tg + 1u) * nx) xb_add(&bar[XB_TOPGEN], 1u);
            else XB_SPIN(xb_ld(&bar[XB_TOPGEN]) == tg, bar);
            __builtin_amdgcn_fence(__ATOMIC_ACQUIRE, "agent");
            xb_add(&bar[XB_XGEN(b.x)], 1u);
            asm volatile("s_waitcnt vmcnt(0)" ::: "memory");
        } else {
            XB_SPIN(xb_ld(&bar[XB_XGEN(b.x)]) == gen, bar);
            __builtin_amdgcn_fence(__ATOMIC_ACQUIRE, "agent");
            asm volatile("s_waitcnt vmcnt(0)" ::: "memory");
        }
    }
    __syncthreads();
}

__device__ __forceinline__ void dep_signal_x(unsigned* ctr, unsigned* sub, unsigned nloc) {
    asm volatile("s_waitcnt vmcnt(0)" ::: "memory");
    __syncthreads();
    if (threadIdx.x == 0) { const unsigned old = xb_add(sub, 1u);
        if (old + 1u == nloc) { __builtin_amdgcn_fence(__ATOMIC_RELEASE, "agent"); asm volatile("s_waitcnt vmcnt(0)" ::: "memory"); (void)xb_add(ctr, nloc); } }
}
__device__ __forceinline__ void dep_spin(unsigned* ctr, unsigned need, unsigned* bar) {
    XB_SPIN(xb_ld(ctr) < need, bar);
    __builtin_amdgcn_fence(__ATOMIC_ACQUIRE, "agent");
    asm volatile("s_waitcnt vmcnt(0)" ::: "memory");
}
namespace pg8 {
typedef unsigned u32x4 __attribute__((ext_vector_type(4)));
constexpr int BM = 256, BK = 64, HALF = 128, HTB = HALF * BK * 2, STAGE_BYTES = 8 * HTB, NXCD = 8, WGM = 8;
__device__ __forceinline__ int lds_byte(int r, int c) { const int st = (r >> 4) * 2 + (c >> 5), rr = r & 15, cc = c & 31, ob = rr * 64 + cc * 2; return st * 1024 + (ob ^ (((ob >> 9) & 1) << 5)); }
__device__ __forceinline__ void stage_rc(int b, int& R, int& C) { const int st = b / 1024, sb = b % 1024, swz = sb ^ (((sb >> 9) & 1) << 5); R = (st >> 1) * 16 + swz / 64; C = (st & 1) * 32 + (swz % 64) / 2; }
__device__ __forceinline__ int perm32(int rho) { const int n = rho >> 4, i = rho & 15; return 8 * (i >> 2) + 4 * n + (i & 3); }
struct Unit { const char* A; const char* B; unsigned lda, ldb; int nt, pm, pn, kind, aux; };
__device__ __forceinline__ unsigned cvt_pk_bf16(float lo, float hi) { unsigned r; asm volatile("v_cvt_pk_bf16_f32 %0, %1, %2" : "=v"(r) : "v"(lo), "v"(hi)); return r; }
__device__ __forceinline__ bool static_tile(int nM, int nN, int G, int c, int i, int& pm, int& pn) {
    const int nwg = nM * nN; const long L = (long)i * G + c; if (L >= nwg) return false;
    int wgid = (int)L; { const int q = nwg / NXCD, r = nwg % NXCD, xcd = wgid % NXCD, off = wgid / NXCD; wgid = (xcd < r ? xcd * (q + 1) : r * (q + 1) + (xcd - r) * q) + off; }
    const int nig = WGM * nN, gid = wgid / nig, fm = gid * WGM, gsz = (nM - fm) < WGM ? (nM - fm) : WGM;
    pm = fm + ((wgid % nig) % gsz); pn = (wgid % nig) / gsz; return true;
}
template <class Epi, class Sched>
__device__ __forceinline__ void gemm_phase(LAS unsigned char* lds, const Sched& S, const Epi& E) {
    const int tid = l_tid(), wid = __builtin_amdgcn_readfirstlane(tid >> 6), lane = tid & 63, wr = wid >> 2, wc = wid & 3, fr = lane & 15, fq = lane >> 4;
    int sR0, sC20;
    { int R, C; stage_rc(tid * 16, R, C); sR0 = R; sC20 = C * 2; }
#define PG8_R(i) (sR0 + 64 * (i))
#define PG8_RB(i) ((PG8_R(i) & ~31) + perm32(PG8_R(i) & 31))
    const size_t kstep = (size_t)(BK * 2);
    const unsigned ldsw = (unsigned)wid * 1024u;
    const int aoff = lds_byte(wr * 64 + fr, fq * 8), boff = lds_byte(wc * 32 + fr, fq * 8);
#define PG8_SA(b, h) (((b) * 2 + (h)) * HTB)
#define PG8_SB(b, h) ((4 + (b) * 2 + (h)) * HTB)
#define PG8_STAGE_A(bufoff, gbase, ld) do { \
        __builtin_amdgcn_global_load_lds((const unsigned*)((const char*)(gbase) + (unsigned)(PG8_R(0) * (ld) + sC20)), (LAS unsigned*)(lds + (bufoff) + ldsw), 16, 0, 0); \
        __builtin_amdgcn_global_load_lds((const unsigned*)((const char*)(gbase) + (unsigned)(PG8_R(1) * (ld) + sC20)), (LAS unsigned*)(lds + (bufoff) + ldsw + 8192), 16, 0, 0); } while (0)
#define PG8_STAGE_B(bufoff, gbase, ld) do { \
        __builtin_amdgcn_global_load_lds((const unsigned*)((const char*)(gbase) + (unsigned)(PG8_RB(0) * (ld) + sC20)), (LAS unsigned*)(lds + (bufoff) + ldsw), 16, 0, 0); \
        __builtin_amdgcn_global_load_lds((const unsigned*)((const char*)(gbase) + (unsigned)(PG8_RB(1) * (ld) + sC20)), (LAS unsigned*)(lds + (bufoff) + ldsw + 8192), 16, 0, 0); } while (0)
#define PG8_LDA(dst, b, h) do { _Pragma("unroll") for (int m = 0; m < 4; ++m) _Pragma("unroll") for (int k = 0; k < 2; ++k) dst[m][k] = *(const LAS bf16x8*)(lds + PG8_SA(b, h) + aoff + m * 2048 + k * 1024); } while (0)
#define PG8_LDB(dst, b, h) do { _Pragma("unroll") for (int n = 0; n < 2; ++n) _Pragma("unroll") for (int k = 0; k < 2; ++k) dst[n][k] = *(const LAS bf16x8*)(lds + PG8_SB(b, h) + boff + n * 2048 + k * 1024); } while (0)
#define PG8_MMA(ai, bj, At, Bt) do { __builtin_amdgcn_s_setprio(1); _Pragma("unroll") for (int m = 0; m < 4; ++m) _Pragma("unroll") for (int n = 0; n < 2; ++n) _Pragma("unroll") for (int k = 0; k < 2; ++k) \
        acc[ai][bj][m][n] = __builtin_amdgcn_mfma_f32_16x16x32_bf16(Bt[n][k], At[m][k], acc[ai][bj][m][n], 0, 0, 0); __builtin_amdgcn_s_setprio(0); } while (0)
#define PG8_WAIT_V(n) asm volatile("s_waitcnt vmcnt(" #n ")" ::: "memory")
#define PG8_WAIT_L(n) asm volatile("s_waitcnt lgkmcnt(" #n ")" ::: "memory")
#define PG8_BAR __builtin_amdgcn_s_barrier()
#define PG8_SCHED __builtin_amdgcn_sched_barrier(0)
    Unit cur, nxt; int ui = 0;
    if (!S.next(0, cur)) return;
    f32x4 prev_;
    if constexpr (Epi::PRE) { E.pre_issue(cur, tid, prev_); E.pre_commit(tid, 0, prev_); }
    f32x4 acc[2][2][4][2];
#pragma unroll
    for (int a = 0; a < 2; ++a)
#pragma unroll
        for (int b = 0; b < 2; ++b)
#pragma unroll
            for (int m = 0; m < 4; ++m)
#pragma unroll
                for (int n = 0; n < 2; ++n) acc[a][b][m][n] = (f32x4){0.f, 0.f, 0.f, 0.f};
    bf16x8 At[4][2], B0[2][2], B1[2][2];
    const char* cA = cur.A; const char* cB = cur.B;
    int clda = cur.lda, cldb = cur.ldb;
    PG8_STAGE_B(PG8_SB(0, 0), cB, cldb); PG8_STAGE_B(PG8_SB(0, 1), cB + (size_t)HALF * cldb, cldb); PG8_STAGE_A(PG8_SA(0, 0), cA, clda); PG8_STAGE_A(PG8_SA(0, 1), cA + (size_t)HALF * clda, clda);
    if (wr == 1) PG8_BAR;
    PG8_WAIT_V(2); PG8_BAR;
    PG8_STAGE_B(PG8_SB(1, 0), cB + kstep, cldb); PG8_STAGE_A(PG8_SA(1, 0), cA + kstep, clda); PG8_STAGE_B(PG8_SB(1, 1), cB + (size_t)HALF * cldb + kstep, cldb);
    PG8_WAIT_V(6); PG8_BAR;
    for (;;) {
        const bool has_next = S.next(ui + 1, nxt);
        const char* nA = has_next ? nxt.A : cA; const char* nB = has_next ? nxt.B : cB;
        const int nlda = has_next ? (int)nxt.lda : clda, nldb = has_next ? (int)nxt.ldb : cldb;
        const int nt = cur.nt;
        for (int t = 0; t < nt; t += 2) {
            const bool last = (t == nt - 2);
            const char* a1 = cA + (size_t)(t + 1) * kstep;
            const char* a2 = last ? nA : cA + (size_t)(t + 2) * kstep; const char* b2 = last ? nB : cB + (size_t)(t + 2) * kstep;
            const char* a3 = a2 + kstep; const char* b3 = b2 + kstep;
            const int lda2 = last ? nlda : clda, ldb2 = last ? nldb : cldb;
            PG8_LDB(B0, 0, 0); PG8_LDB(B1, 0, 1); PG8_SCHED; PG8_LDA(At, 0, 0); PG8_STAGE_A(PG8_SA(1, 1), a1 + (size_t)HALF * clda, clda);
            PG8_WAIT_V(8); PG8_WAIT_L(0); PG8_BAR; PG8_MMA(0, 0, At, B0); PG8_MMA(0, 1, At, B1); PG8_BAR; PG8_SCHED;
            PG8_LDA(At, 0, 1); PG8_STAGE_B(PG8_SB(0, 0), b2, ldb2); PG8_STAGE_B(PG8_SB(0, 1), b2 + (size_t)HALF * ldb2, ldb2); PG8_STAGE_A(PG8_SA(0, 0), a2, lda2);
            PG8_WAIT_V(8); PG8_WAIT_L(0); PG8_BAR; PG8_MMA(1, 0, At, B0); PG8_MMA(1, 1, At, B1); PG8_BAR; PG8_SCHED;
            PG8_LDB(B0, 1, 0); PG8_LDB(B1, 1, 1); PG8_SCHED; PG8_LDA(At, 1, 0); PG8_STAGE_A(PG8_SA(0, 1), a2 + (size_t)HALF * lda2, lda2);
            PG8_WAIT_V(8); PG8_WAIT_L(0); PG8_BAR; PG8_MMA(0, 0, At, B0); PG8_MMA(0, 1, At, B1); PG8_BAR; PG8_SCHED;
            PG8_LDA(At, 1, 1); PG8_STAGE_B(PG8_SB(1, 0), b3, ldb2); PG8_STAGE_B(PG8_SB(1, 1), b3 + (size_t)HALF * ldb2, ldb2); PG8_STAGE_A(PG8_SA(1, 0), a3, lda2);
            PG8_WAIT_V(8); PG8_WAIT_L(0); PG8_BAR; PG8_MMA(1, 0, At, B0); PG8_MMA(1, 1, At, B1); PG8_BAR; PG8_SCHED;
        }
        if (wr == 0) PG8_BAR;
        if constexpr (Epi::PRE) { if (has_next) E.pre_issue(nxt, tid, prev_); E(acc, cur, wr, wc, fr, fq, ui & 1); if (has_next) E.pre_commit(tid, (ui + 1) & 1, prev_); }
        else E(acc, cur, wr, wc, fr, fq);
        if (!has_next) break;
#pragma unroll
        for (int a = 0; a < 2; ++a)
#pragma unroll
            for (int b = 0; b < 2; ++b)
#pragma unroll
                for (int m = 0; m < 4; ++m)
#pragma unroll
                    for (int n = 0; n < 2; ++n) acc[a][b][m][n] = (f32x4){0.f, 0.f, 0.f, 0.f};
        cur = nxt; cA = nA; cB = nB; clda = nlda; cldb = nldb; ++ui;
        if (wr == 1) PG8_BAR;
    }
    PG8_WAIT_V(0);
    PG8_BAR;
#undef PG8_SA
#undef PG8_SB
#undef PG8_STAGE_A
#undef PG8_RB
#undef PG8_R
#undef PG8_STAGE_B
#undef PG8_LDA
#undef PG8_LDB
#undef PG8_MMA
#undef PG8_WAIT_V
#undef PG8_WAIT_L
#undef PG8_BAR
#undef PG8_SCHED
}
}

__device__ __forceinline__ pg8::u32x4 pack8(const f32x4 a, const f32x4 b) { pg8::u32x4 w; w.x = pg8::cvt_pk_bf16(a[0], a[1]); w.y = pg8::cvt_pk_bf16(a[2], a[3]); w.z = pg8::cvt_pk_bf16(b[0], b[1]); w.w = pg8::cvt_pk_bf16(b[2], b[3]); return w; }
__device__ __forceinline__ void unpack8(const pg8::u32x4 w, f32x4& a, f32x4& b) {
    a[0] = __uint_as_float(w.x << 16); a[1] = __uint_as_float(w.x & 0xffff0000u); a[2] = __uint_as_float(w.y << 16); a[3] = __uint_as_float(w.y & 0xffff0000u);
    b[0] = __uint_as_float(w.z << 16); b[1] = __uint_as_float(w.z & 0xffff0000u); b[2] = __uint_as_float(w.w << 16); b[3] = __uint_as_float(w.w & 0xffff0000u); }
namespace fa {
typedef float f32x16 __attribute__((ext_vector_type(16)));
typedef short s16x4 __attribute__((ext_vector_type(4)));
typedef unsigned u32x4 __attribute__((ext_vector_type(4)));
typedef unsigned u32x2 __attribute__((ext_vector_type(2)));
__device__ __forceinline__ s16x4 vtr(const LAS char* p) { return __builtin_bit_cast(s16x4, __builtin_amdgcn_ds_read_tr16_b64_v4i16((LAS s16x4*)p)); }
__device__ __forceinline__ unsigned pk2(float lo, float hi) { unsigned r; asm volatile("v_cvt_pk_bf16_f32 %0, %1, %2" : "=v"(r) : "v"(lo), "v"(hi)); return r; }
typedef __bf16 bf16v2_t __attribute__((ext_vector_type(2)));
typedef float f32v2_t __attribute__((ext_vector_type(2)));
__device__ __forceinline__ unsigned pk2n(float lo, float hi) { return __builtin_bit_cast(unsigned, __builtin_convertvector((f32v2_t){lo, hi}, bf16v2_t)); }
__device__ __forceinline__ bf16x8 pack_p(const f32x16& p, int base) { u32x4 w; w.x = pk2(p[base], p[base + 1]); w.y = pk2(p[base + 2], p[base + 3]); w.z = pk2(p[base + 4], p[base + 5]); w.w = pk2(p[base + 6], p[base + 7]); return __builtin_bit_cast(bf16x8, w); }
__device__ __forceinline__ int crow(int r, int hi) { return (r & 3) + 8 * (r >> 2) + 4 * hi; }
__device__ __forceinline__ void pv_tile(f32x16& o0, f32x16& o1, const LAS char* vb, const bf16x8 (&pf)[4]) {
#pragma unroll
    for (int ks = 0; ks < 4; ++ks) {
        const s16x4 a0 = vtr(vb + ks * 1024), a1 = vtr(vb + ks * 1024 + 512), b0 = vtr(vb + 4096 + ks * 1024), b1 = vtr(vb + 4096 + ks * 1024 + 512);
        const bf16x8 v0 = (bf16x8){a0[0], a0[1], a0[2], a0[3], a1[0], a1[1], a1[2], a1[3]}, v1 = (bf16x8){b0[0], b0[1], b0[2], b0[3], b1[0], b1[1], b1[2], b1[3]};
        o0 = __builtin_amdgcn_mfma_f32_32x32x16_bf16(v0, pf[ks], o0, 0, 0, 0);
        o1 = __builtin_amdgcn_mfma_f32_32x32x16_bf16(v1, pf[ks], o1, 0, 0, 0);
    }
}
constexpr int KP_A = 208, KT_A = 64 * KP_A, VT = 8192, BUF_A = KT_A + VT;
constexpr int KP_R = 144, KT_R = 64 * KP_R, BUF_R = KT_R + VT;
}

#define GSTRIDE(gi, total) for (int gi = bid_ * NT + tid_; gi < (total); gi += G_ * NT)
__device__ __forceinline__ void ph_mod(unsigned char* lds, const float* c, const float* c_ctx, const float* ada_w, const float* ada_b, float* mod) { PH_IDS;
    LAS float* sl = (LAS float*)lds;
    LAS float* red = sl + 9 * 1024;
    for (int e = tid_; e < 9 * 1024; e += NT) { const int j = e >> 10, k = e & 1023; const float v = j < 8 ? c[j * 1024 + k] : c_ctx[k]; sl[e] = siluf_(v); }
    __syncthreads();
    const int nn = tid_ & 63, ks = tid_ >> 6;
    for (int u = bid_; u < 2 * 96; u += G_) {
        const int l = u / 96, n = (u % 96) * 64 + nn;
        float acc[9];
#pragma unroll
        for (int j = 0; j < 9; ++j) acc[j] = 0.f;
        const float* w = ada_w + ((size_t)l * 1024 + ks * 128) * 6144 + n;
#pragma unroll 4
        for (int k4 = 0; k4 < 32; ++k4) {
            const float w0 = w[(size_t)(4 * k4) * 6144], w1 = w[(size_t)(4 * k4 + 1) * 6144], w2 = w[(size_t)(4 * k4 + 2) * 6144], w3 = w[(size_t)(4 * k4 + 3) * 6144];
#pragma unroll
            for (int j = 0; j < 9; ++j) { const f32x4 s4 = *(const LAS f32x4*)(sl + j * 1024 + ks * 128 + 4 * k4); acc[j] += s4[0] * w0 + s4[1] * w1 + s4[2] * w2 + s4[3] * w3; } }
        __syncthreads();
#pragma unroll
        for (int j = 0; j < 9; ++j) red[(ks * 9 + j) * 64 + nn] = acc[j];
        __syncthreads();
        for (int e = tid_; e < 9 * 64; e += NT) { const int j = e >> 6, q = e & 63; float sum = 0.f;
#pragma unroll
            for (int r = 0; r < 8; ++r) sum += red[(r * 9 + j) * 64 + q];
            const int col = (u % 96) * 64 + q; mod[((size_t)l * 9 + j) * 6144 + col] = sum + ada_b[l * 6144 + col]; }
    }
    __syncthreads();
}
__device__ __forceinline__ void ph_trig(float* trig, bf16_t* d64) { PH_IDS; GSTRIDE(i, 2048) { const float xx = (float)i * (1.f / 1024.f); trig[i] = cospif(xx); trig[2048 + i] = sinpif(xx); }
    GSTRIDE(i, 128 * 64) { const int n = i >> 6, c = i & 63, m = n & 63; const float xx = (float)((m * c) & 63) * (1.f / 32.f); d64[i] = f2bf(n < 64 ? cospif(xx) : sinpif(xx)); } }
__device__ __forceinline__ double2 lam_pow(double re, double im, double dt, int k) {
    const double m = (double)__expf((float)(re * dt * k));
    double xx = im * dt * (double)k * 0.318309886183790671538;
    xx -= 2.0 * rint(xx * 0.5);
    const float xf = (float)xx;
    return make_double2(m * (double)cospif(xf), m * (double)sinpif(xf));
}
__device__ __forceinline__ void ph_s5_lp(int l, const float* lam_re, const float* lam_im, const float* log_step, const float* b_re, const float* b_im, float2* LP, float2* BB, float* lamT, int vb, int vg) { PH_IDS;
    for (int it = vb * NT + tid_; it < 2 * 16 * 64 * 81; it += vg * NT) {
        const int i = it / 81, k = it % 81;
        const int d = i / 1024, g = (i / 64) % 16, p = i % 64;
        const size_t li = ((size_t)(l * 2 + d) * 16 + g) * 64 + p;
        const double re = lam_re[li], im = lam_im[li], dt = (double)expf(log_step[(l * 2 + d) * 16 + g]);
        if (k <= 64) {
            const double2 v = lam_pow(re, im, dt, k); LP[(size_t)i * 65 + k] = make_float2((float)v.x, (float)v.y);
            if (k == 64) { lamT[((size_t)(g * 2 + d) * 64 + p) * 2 + 0] = (float)v.x; lamT[((size_t)(g * 2 + d) * 64 + p) * 2 + 1] = (float)v.y; }
        } else {
            const int h = k - 65;
            const double2 l1 = lam_pow(re, im, dt, 1);
            const double nr = l1.x - 1.0, ni = l1.y, den = re * re + im * im;
            const double fr = (nr * re + ni * im) / den, fi = (ni * re - nr * im) / den;
            const double br = b_re[li * 16 + h], bi = b_im[li * 16 + h]; BB[(size_t)i * 16 + h] = make_float2((float)(fr * br - fi * bi), (float)(fr * bi + fi * br));
        }
    }
}
__device__ __forceinline__ void ph_s5_tz(unsigned char* lds_, int l, const float2* LP, const float2* BB, const float* c_re, const float* c_im, float* TZD, int vb, int vg) { PH_IDS;
    typedef float f32x2_ __attribute__((ext_vector_type(2)));
    LAS f32x2_* sC = (LAS f32x2_*)lds_;
    LAS f32x2_* sL = sC + 16 * 64;
    LAS f32x2_* sB = sL + 64 * 8;
    for (int it = vb; it < 256; it += vg) {
        const int u = it >> 3, ts = it & 7, g = u >> 1, d = u & 1;
        const size_t cb = (((size_t)(l * 2 + d) * 16 + g) * 16) * 64, gb = (size_t)d * 16 + g;
        const float cr0 = c_re[cb + tid_], ci0 = c_im[cb + tid_], cr1 = c_re[cb + NT + tid_], ci1 = c_im[cb + NT + tid_];
        const float2 lpv = LP[gb * 64 * 65 + (size_t)(tid_ >> 3) * 65 + ts * 8 + (tid_ & 7)];
        const float2 bb0 = BB[gb * 64 * 16 + tid_], bb1 = BB[gb * 64 * 16 + NT + tid_];
        __syncthreads();
        sC[tid_] = (f32x2_){cr0, ci0}; sC[NT + tid_] = (f32x2_){cr1, ci1}; sL[tid_] = (f32x2_){lpv.x, lpv.y}; sB[tid_] = (f32x2_){bb0.x, bb0.y}; sB[NT + tid_] = (f32x2_){bb1.x, bb1.y};
        __syncthreads();
        const int pair = tid_ & 127, tl = pair >> 4, h = pair & 15, qg = tid_ >> 7;
        f32x4 acc = (f32x4){0.f, 0.f, 0.f, 0.f};
#pragma unroll 4
        for (int p = 0; p < 64; ++p) {
            const f32x2_ c = sC[h * 64 + p], lp = sL[p * 8 + tl];
            const float er = c.x * lp.x - c.y * lp.y, ei = c.x * lp.y + c.y * lp.x;
            const f32x4 b01 = *(const LAS f32x4*)&sB[p * 16 + 4 * qg], b23 = *(const LAS f32x4*)&sB[p * 16 + 4 * qg + 2];
            acc[0] += er * b01[0] - ei * b01[1]; acc[1] += er * b01[2] - ei * b01[3]; acc[2] += er * b23[0] - ei * b23[1]; acc[3] += er * b23[2] - ei * b23[3];
        }
        *(f32x4*)(TZD + (((gb * 64) + ts * 8 + tl) * 16 + h) * 16 + 4 * qg) = acc;
    }
    __syncthreads();
}
__device__ __forceinline__ void ph_s5_ms(const float2* LP, const float2* BB, bf16_t* MST, int vb, int vg) { PH_IDS;
    for (int i0 = vb * NT + tid_; i0 < 16 * 256 * 128; i0 += 3 * vg * NT) {
        float2 lp[3]; f32x4 bb[3][4];
#pragma unroll
        for (int k = 0; k < 3; ++k) { const int i = i0 + k * vg * NT;
            if (i < 16 * 256 * 128) { const int g = i / (256 * 128), n = (i / 128) % 256, sh0 = (i % 128) * 8, d = n >> 7, p = n & 63, s = sh0 >> 4, hp0 = sh0 & 15;
                const size_t gi = ((size_t)d * 16 + g) * 64 + p;
                lp[k] = LP[gi * 65 + (d == 0 ? 63 - s : s)];
#pragma unroll
                for (int q = 0; q < 4; ++q) bb[k][q] = *(const f32x4*)(BB + gi * 16 + hp0 + 2 * q); } }
#pragma unroll
        for (int k = 0; k < 3; ++k) { const int i = i0 + k * vg * NT;
            if (i < 16 * 256 * 128) { const int g = i / (256 * 128), n = (i / 128) % 256, sh0 = (i % 128) * 8, im = (n >> 6) & 1;
                float v[8];
#pragma unroll
                for (int q = 0; q < 4; ++q) { v[2 * q] = im ? lp[k].x * bb[k][q][1] + lp[k].y * bb[k][q][0] : lp[k].x * bb[k][q][0] - lp[k].y * bb[k][q][1];
                    v[2 * q + 1] = im ? lp[k].x * bb[k][q][3] + lp[k].y * bb[k][q][2] : lp[k].x * bb[k][q][2] - lp[k].y * bb[k][q][3]; }
                *(pg8::u32x4*)(MST + ((size_t)g * 256 + n) * 1024 + sh0) = pack8((f32x4){v[0], v[1], v[2], v[3]}, (f32x4){v[4], v[5], v[6], v[7]}); } }
    }
}
__device__ __forceinline__ void ph_s5_qo(int l, const float2* LP, const float* c_re, const float* c_im, bf16_t* QOT, int vb, int vg) { PH_IDS;
    for (int i = vb * NT + tid_; i < 16 * 1024 * 32; i += vg * NT) {
        const int g = i / (1024 * 32), th = (i / 32) % 1024, j0 = (i % 32) * 8, d = j0 >> 7, im = (j0 >> 6) & 1, p0 = j0 & 63, t = th >> 4, h = th & 15;
        const size_t ci = (((size_t)(l * 2 + d) * 16 + g) * 16 + h) * 64 + p0;
        const int e = d == 0 ? t + 1 : 64 - t;
        float v[8];
#pragma unroll
        for (int q = 0; q < 8; ++q) { const float cr = c_re[ci + q], cim = c_im[ci + q]; const float2 lp = LP[(((size_t)d * 16 + g) * 64 + p0 + q) * 65 + e]; v[q] = im ? -(cr * lp.y + cim * lp.x) : cr * lp.x - cim * lp.y; }
        *(pg8::u32x4*)(QOT + ((size_t)g * 1024 + th) * 256 + j0) = pack8((f32x4){v[0], v[1], v[2], v[3]}, (f32x4){v[4], v[5], v[6], v[7]});
    }
}
__device__ __forceinline__ void ph_wmf(const float* w, const float* mod, float* wmf) { PH_IDS;
    GSTRIDE(i, 9 * 1024) { const int b = i >> 10, c = i & 1023; wmf[i] = w[c] * (1.f + mod[(size_t)b * 6144 + 4 * 1024 + c]); }
}
__device__ __forceinline__ void ph_cf_mfma(unsigned char* lds_, const bf16_t* W1T, const float* mod, float* cf, int vb, int vg) {
    const int tid = l_tid(), lane = tid & 63, kk = __builtin_amdgcn_readfirstlane(tid >> 6), i16 = lane & 15, kq = lane >> 4;
    LAS float* red = (LAS float*)lds_;
    for (int nt = vb; nt < 256; nt += vg) {
        f32x4 acc = (f32x4){0.f, 0.f, 0.f, 0.f};
#pragma unroll
        for (int s4 = 0; s4 < 4; ++s4) { const int k0 = kk * 128 + s4 * 32 + kq * 8;
            pg8::u32x4 aw = (pg8::u32x4){0u, 0u, 0u, 0u};
            if (i16 < 9) { const float* sp = mod + (size_t)i16 * 6144 + 3 * 1024 + k0; aw = pack8(*(const f32x4*)sp, *(const f32x4*)(sp + 4)); }
            const bf16x8 bw = *(const bf16x8*)(W1T + (size_t)(nt * 16 + i16) * 1024 + k0);
            acc = __builtin_amdgcn_mfma_f32_16x16x32_bf16(__builtin_bit_cast(bf16x8, aw), bw, acc, 0, 0, 0); }
        __syncthreads();
#pragma unroll
        for (int r = 0; r < 4; ++r) red[(kk * 16 + 4 * kq + r) * 16 + i16] = acc[r];
        __syncthreads();
        if (tid < 144) { float a = 0.f;
#pragma unroll
            for (int w = 0; w < 8; ++w) a += red[w * 256 + tid];
            cf[(size_t)(tid >> 4) * DFF + nt * 16 + (tid & 15)] = a; }
    }
    __syncthreads();
}
template <int XIN>
__device__ __forceinline__ void ph_adarms(const void* xlat, const void* xctx, const float* w, const float* mod, int sh_chunk, int sc_chunk, bf16_t* out, int nrows, const float* pd, const float* pg) { PH_IDS;
    const int wave = (bid_ * NT + tid_) >> 6, lane = tid_ & 63, nw = (G_ * NT) >> 6;
    f32x4 wv[4];
#pragma unroll
    for (int j = 0; j < 4; ++j) wv[j] = *(const f32x4*)(w + j * 256 + lane * 4);
    for (int row0 = wave; row0 < nrows; row0 += 3 * nw) {
        f32x4 v[3][4], sc[3][4], sh[3][4];
#pragma unroll
        for (int k = 0; k < 3; ++k) { const int row = row0 + k * nw;
            if (row < nrows) {
                if constexpr (XIN == 0) { const float* x = row < RL ? (const float*)xlat + (size_t)row * DM : (const float*)xctx + (size_t)(row - RL) * DM;
#pragma unroll
                    for (int j = 0; j < 4; ++j) v[k][j] = *(const f32x4*)(x + j * 256 + lane * 4); }
                else { const bf16_t* x = row < RL ? (const bf16_t*)xlat + (size_t)row * DM : (const bf16_t*)xctx + (size_t)(row - RL) * DM;
#pragma unroll
                    for (int j = 0; j < 4; ++j) { const fa::u32x2 r = *(const fa::u32x2*)(x + j * 256 + lane * 4); v[k][j] = (f32x4){__uint_as_float(r.x << 16), __uint_as_float(r.x & 0xffff0000u), __uint_as_float(r.y << 16), __uint_as_float(r.y & 0xffff0000u)}; }
                    if (pd != nullptr && row >= RL) { const float* p = pd + (size_t)(row - RL) * DM;
#pragma unroll
                        for (int j = 0; j < 4; ++j) { const int c0 = j * 256 + lane * 4; f32x4 a = *(const f32x4*)(p + c0);
#pragma unroll
                            for (int n = 1; n < 4; ++n) a += *(const f32x4*)(p + (size_t)n * RC * DM + c0);
                            v[k][j] += *(const f32x4*)(pg + c0) * a; } } }
                const float* mrow = mod + (size_t)row_modidx(row) * 6144;
#pragma unroll
                for (int j = 0; j < 4; ++j) { const int c0 = j * 256 + lane * 4; sc[k][j] = *(const f32x4*)(mrow + sc_chunk * 1024 + c0); sh[k][j] = *(const f32x4*)(mrow + sh_chunk * 1024 + c0); }
            } }
#pragma unroll
        for (int k = 0; k < 3; ++k) { const int row = row0 + k * nw;
            if (row < nrows) {
                float ss = 0.f;
#pragma unroll
                for (int j = 0; j < 4; ++j) ss += v[k][j][0] * v[k][j][0] + v[k][j][1] * v[k][j][1] + v[k][j][2] * v[k][j][2] + v[k][j][3] * v[k][j][3];
#pragma unroll
                for (int o = 1; o < 64; o <<= 1) ss += __shfl_xor(ss, o);
                const float rstd = rsqrtf(ss * (1.f / DM) + EPS);
#pragma unroll
                for (int j = 0; j < 4; ++j) { const int c0 = j * 256 + lane * 4;
                    const f32x4 y = v[k][j] * rstd * wv[j] * (sc[k][j] + 1.f) + sh[k][j];
                    fa::u32x2 o; o.x = fa::pk2(y[0], y[1]); o.y = fa::pk2(y[2], y[3]);
                    *(fa::u32x2*)(out + (size_t)row * DM + c0) = o; }
            } }
    }
}
__device__ __forceinline__ void ph_mla_stats(const bf16_t* Z, float* rs) { PH_IDS;
    const int wave = (bid_ * NT + tid_) >> 6, lane = tid_ & 63, nw = (G_ * NT) >> 6;
    for (int row = wave; row < RT; row += nw) {
        const bf16_t* z = Z + (size_t)row * ZW; float sq = 0.f, sk = 0.f;
#pragma unroll
        for (int j = 0; j < 4; ++j) { const float v = bf2f(z[C_QC + j * 64 + lane]); sq += v * v; }
#pragma unroll
        for (int j = 0; j < 2; ++j) { const float v = bf2f(z[C_KVC + j * 64 + lane]); sk += v * v; }
#pragma unroll
        for (int o = 1; o < 64; o <<= 1) { sq += __shfl_xor(sq, o); sk += __shfl_xor(sk, o); }
        if (lane == 0) { rs[(size_t)row * 2] = rsqrtf(sq * (1.f / 256) + EPS); rs[(size_t)row * 2 + 1] = rsqrtf(sk * (1.f / 128) + EPS); }
    }
}
__device__ __forceinline__ void ph_mla_post(const bf16_t* Z, const bf16_t* qraw, const bf16_t* kvraw, const float* qkq, const float* qkk, bf16_t* Q, bf16_t* Kb, bf16_t* Vb) { PH_IDS;
    GSTRIDE(gi, RT * 8) {
        const int row = gi >> 3, h = (gi >> 1) & 3, isk = gi & 1;
        const bool lat = row < RL; const int b = row_batch(row), t = lat ? (row & 2047) : ((row - RL) & 255);
        const int qi = lat ? t : 2048 + t, ki = lat ? 256 + t : t;
        float v[96];
        float ss = 0.f;
        if (!isk) {
#pragma unroll
            for (int i = 0; i < 96; ++i) v[i] = bf2f(qraw[(size_t)row * 384 + h * 96 + i]);
        } else {
#pragma unroll
            for (int i = 0; i < 64; ++i) v[i] = bf2f(kvraw[(size_t)row * 512 + h * 128 + i]);
#pragma unroll
            for (int i = 0; i < 32; ++i) v[64 + i] = bf2f(Z[(size_t)row * ZW + C_KR + i]);
        }
#pragma unroll
        for (int i = 0; i < 96; ++i) ss += v[i] * v[i];
        const float rr = rsqrtf(ss * (1.f / 96) + EPS) * (isk ? 1.f : 0.14724727430627066f);
        const float* wv = isk ? qkk : qkq;
#pragma unroll
        for (int i = 0; i < 96; ++i) v[i] = v[i] * rr * wv[i];
        if (lat) {
            const float prow = (float)(t >> 6), pcol = (float)(t & 63);
#pragma unroll
            for (int part = 0; part < 2; ++part) { const float pos = part ? pcol : prow; const int base = 64 + part * 16;
#pragma unroll
                for (int j = 0; j < 8; ++j) { const float fr = exp2f(-(float)j * (13.287712379549449f / 8.f)), a = pos * fr, cs = __cosf(a), sn = __sinf(a);
                    const float x1 = v[base + j], x2 = v[base + 8 + j]; v[base + j] = x1 * cs - x2 * sn; v[base + 8 + j] = x1 * sn + x2 * cs; } }
        }
        bf16_t* o = isk ? Kb + ((size_t)(b * 4 + h) * 2304 + ki) * 96 : Q + ((size_t)(b * 4 + h) * 2304 + qi) * 96;
#pragma unroll
        for (int i = 0; i < 96; ++i) o[i] = f2bf(v[i]);
        if (isk) { bf16_t* vo = Vb + ((size_t)(b * 4 + h) * 2304 + ki) * 64; for (int i = 0; i < 64; ++i) vo[i] = kvraw[(size_t)row * 512 + h * 128 + 64 + i]; }
    }
}
__device__ __forceinline__ void ph_attn(unsigned char* lds, const bf16_t* Q, const bf16_t* Kb, const bf16_t* Vb, bf16_t* Z, int with_ctx) { PH_IDS;
    float (*sK)[96] = (float (*)[96])lds; float (*sV)[64] = (float (*)[64])(lds + 32 * 96 * 4);
    const int nunits = 32 * (8 + (with_ctx ? 1 : 0));
    const int qt = tid_ & 255, dh = (tid_ >> 8) * 32;
    for (int u = bid_; u < nunits; u += G_) {
        const int bh = u % 32, qb = u / 32;
        const bool lat = qb < 8;
        const int qi = qb * 256 + qt, nkeys = lat ? 2304 : 256;
        float q[96], o[32];
        const bf16_t* qp = Q + ((size_t)bh * 2304 + qi) * 96;
#pragma unroll
        for (int i = 0; i < 96; ++i) q[i] = bf2f(qp[i]) * 0.10206207261596577f;
#pragma unroll
        for (int i = 0; i < 32; ++i) o[i] = 0.f;
        float mx = -1e30f, l = 0.f;
        for (int k0 = 0; k0 < nkeys; k0 += 32) {
            __syncthreads();
            for (int e = tid_; e < 32 * 96; e += NT) sK[e / 96][e % 96] = bf2f(Kb[((size_t)bh * 2304 + k0) * 96 + e]);
            for (int e = tid_; e < 32 * 64; e += NT) sV[e / 64][e % 64] = bf2f(Vb[((size_t)bh * 2304 + k0) * 64 + e]);
            __syncthreads();
#pragma unroll 1
            for (int j = 0; j < 32; ++j) { float a = 0.f;
#pragma unroll
                for (int i = 0; i < 96; ++i) a += q[i] * sK[j][i];
                if (a > mx) { const float corr = __expf(mx - a); mx = a; l *= corr;
#pragma unroll
                    for (int i = 0; i < 32; ++i) o[i] *= corr; }
                const float p = __expf(a - mx); l += p;
#pragma unroll
                for (int i = 0; i < 32; ++i) o[i] += p * sV[j][dh + i]; }
        }
        const int b = bh >> 2, h = bh & 3;
        const int row = lat ? b * 2048 + qi : RL + b * 256 + (qi - 2048);
        const float inv = 1.f / l;
#pragma unroll
        for (int i = 0; i < 32; ++i) Z[(size_t)row * ZW + C_QC + h * 64 + dh + i] = f2bf(o[i] * inv);
    }
    __syncthreads();
}
__device__ __forceinline__ void ph_f1(const bf16_t* Z, const float* trig, bf16_t* F1lat, bf16_t* F1ctx) { PH_IDS;
    GSTRIDE(gi, RT * 256) {
        const int row = gi >> 8, gm = gi & 255, g = gm >> 6, m = gm & 63;
        float a = 0.f, bsum = 0.f;
        const bf16_t* u = Z + (size_t)row * ZW + C_FU + g * 64;
        for (int c = 0; c < 64; ++c) { const float v = bf2f(u[c]); const int idx = ((m * c) & 63) * 32; a += v * trig[idx]; bsum += v * trig[2048 + idx]; }
        if (row < RL) { const int b = row >> 11, t = row & 2047; bf16_t* o = F1lat + ((size_t)(b * 256 + gm) * 2) * 2048; o[t] = f2bf(a); o[2048 + t] = f2bf(bsum); }
        else { const int r = row - RL, b = r >> 8, t = r & 255; bf16_t* o = F1ctx + ((size_t)(b * 256 + gm) * 2) * 256; o[t] = f2bf(a); o[256 + t] = f2bf(bsum); }
    }
}
struct A_dft { const float* trig; long long L; long long mul;
    __device__ float operator()(int, int k, int kk) const { const int part = kk >= (int)L, t = part ? kk - (int)L : kk; const int idx = (int)(((long long)k * t) & (L - 1)) * (int)mul; return part ? -trig[2048 + idx] : trig[idx]; } };
struct B_f1t { const bf16_t* p; long long L;
    __device__ float operator()(int b, int kk, int n) const { return bf2f(p[((size_t)(b * 256 + n)) * 2 * L + kk]); } };
struct E_fourier { bf16_t* Z; long long rowbase; long long L; double scale;
    __device__ void operator()(int b, int m, int n, float v) const { Z[((size_t)rowbase + (size_t)b * L + m) * ZW + C_FU + n] = f2bf(v * (float)scale); } };

struct A_s5u { const bf16_t* Z;
    __device__ float operator()(int g, int rc, int k) const { return bf2f(Z[((size_t)rc * 64 + (k >> 4)) * ZW + C_S5 + g * 16 + (k & 15)]); } };
struct B_ms { const bf16_t* MS; __device__ float operator()(int g, int k, int n) const { return bf2f(MS[((size_t)g * 1024 + k) * 256 + n]); } };
struct E_sloc { float* S; __device__ void operator()(int g, int rc, int n, float v) const { S[((size_t)rc * 16 + g) * 256 + n] = v; } };
__device__ __forceinline__ void ph_s5_scan(const float* SLOC, const float* lamT, float* XP) { PH_IDS;
    GSTRIDE(i, 8 * 16 * 2 * 64) {
        const int b = i / 2048, g = (i / 128) % 16, d = (i / 64) % 2, p = i % 64;
        const float lr = lamT[((size_t)(g * 2 + d) * 64 + p) * 2], li = lamT[((size_t)(g * 2 + d) * 64 + p) * 2 + 1];
        float xr = 0.f, xi = 0.f;
        for (int step = 0; step < 36; ++step) {
            int rc;
            if (d == 0) rc = step < 4 ? 256 + b * 4 + step : b * 32 + (step - 4);
            else rc = step < 4 ? 256 + b * 4 + (3 - step) : b * 32 + (31 - (step - 4));
            const size_t o = ((size_t)rc * 16 + g) * 256 + d * 128;
            XP[o + p] = xr; XP[o + 64 + p] = xi;
            const float sr = SLOC[o + p], si = SLOC[o + 64 + p];
            const float nr = lr * xr - li * xi + sr, ni = lr * xi + li * xr + si; xr = nr; xi = ni;
        }
    }
}
struct A_s5out { const bf16_t* Z; const float* XP;
    __device__ float operator()(int g, int rc, int k) const { return k < 1024 ? bf2f(Z[((size_t)rc * 64 + (k >> 4)) * ZW + C_S5 + g * 16 + (k & 15)]) : XP[((size_t)rc * 16 + g) * 256 + (k - 1024)]; } };
struct B_s5out { const float* TZ; const bf16_t* QO;
    __device__ float operator()(int g, int k, int n) const { if (k < 1024) { const int s = k >> 4, hp = k & 15, t = n >> 4, h = n & 15; return TZ[(((size_t)g * 127 + (t - s + 63)) * 16 + hp) * 16 + h]; } return bf2f(QO[((size_t)g * 256 + (k - 1024)) * 1024 + n]); } };
struct E_s5out { bf16_t* YG; __device__ void operator()(int g, int rc, int n, float v) const { YG[((size_t)rc * 64 + (n >> 4)) * 256 + g * 16 + (n & 15)] = f2bf(geluf_(v)); } };
__device__ __forceinline__ void ph_glu(const bf16_t* GL, bf16_t* Z) { PH_IDS;
    GSTRIDE(gi, RT * 256) {
        const int row = gi >> 8, j = gi & 255;
        const float val = bf2f(GL[(size_t)row * 512 + j]), gate = bf2f(GL[(size_t)row * 512 + 256 + j]);
        Z[(size_t)row * ZW + C_S5 + j] = f2bf(val * sigmoidf_(gate));
    }
}
__device__ __forceinline__ void ph_ret_prep(bf16_t* Z) { PH_IDS;
    GSTRIDE(gi, RT * 4 * 32) {
        const int row = gi >> 7, h = (gi >> 5) & 3, j = gi & 31;
        bf16_t* z = Z + (size_t)row * ZW;
        if (row < RL) {
            const int t = row & 2047; const float fr = exp2f(-(float)j * (13.287712379549449f / 32.f)), a = (float)t * fr, cs = cosf(a), sn = sinf(a);
            { const float x1 = bf2f(z[C_RQ + h * 64 + j]), x2 = bf2f(z[C_RQ + h * 64 + 32 + j]); z[C_RQ + h * 64 + j] = f2bf(x1 * cs - x2 * sn); z[C_RQ + h * 64 + 32 + j] = f2bf(x1 * sn + x2 * cs); }
            { const float x1 = bf2f(z[C_RK + h * 64 + j]), x2 = bf2f(z[C_RK + h * 64 + 32 + j]); z[C_RK + h * 64 + j] = f2bf((x1 * cs - x2 * sn) * 0.125f); z[C_RK + h * 64 + 32 + j] = f2bf((x1 * sn + x2 * cs) * 0.125f); }
        } else {
            z[C_RK + h * 64 + j] = f2bf(bf2f(z[C_RK + h * 64 + j]) * 0.125f); z[C_RK + h * 64 + 32 + j] = f2bf(bf2f(z[C_RK + h * 64 + 32 + j]) * 0.125f);
        }
    }
}
__device__ __forceinline__ void ph_ret(unsigned char* lds, bf16_t* Z, const float* decay_logit, const float* gn_w, int with_ctx) { PH_IDS;
    float (*sK)[64] = (float (*)[64])lds; float (*sV)[64] = (float (*)[64])(lds + 32 * 64 * 4);
    float* sred = (float*)(lds + 2 * 32 * 64 * 4);
    const int nunits = 32 * (8 + (with_ctx ? 1 : 0));
    const int qt = tid_ & 255, hh = tid_ >> 8, dh = hh * 32;
    for (int u = bid_; u < nunits; u += G_) {
        const int bh = u % 32, qb = u / 32, b = bh >> 2, h = bh & 3;
        const bool lat = qb < 8;
        const int qpos = lat ? qb * 256 + qt : qt;
        const int qrow = lat ? b * 2048 + qpos : RL + b * 256 + qpos;
        const float lgf = -log1pf(__expf(-decay_logit[h])) * 1.4426950408889634f, lgb = -log1pf(__expf(-decay_logit[4 + h])) * 1.4426950408889634f;
        float q[64], o[32];
#pragma unroll
        for (int i = 0; i < 64; ++i) q[i] = bf2f(Z[(size_t)qrow * ZW + C_RQ + h * 64 + i]);
#pragma unroll
        for (int i = 0; i < 32; ++i) o[i] = 0.f;
        const int nkeys = lat ? 2560 : 256;
        for (int k0 = 0; k0 < nkeys; k0 += 32) {
            int krow0, kpos0;
            if (lat) { if (k0 < 256) { krow0 = RL + b * 256 + k0; kpos0 = k0 - 256; } else if (k0 < 2304) { krow0 = b * 2048 + (k0 - 256); kpos0 = k0 - 256; } else { krow0 = RL + b * 256 + (k0 - 2304); kpos0 = 2048 + (k0 - 2304); } }
            else { krow0 = RL + b * 256 + k0; kpos0 = k0; }
            __syncthreads();
            for (int e = tid_; e < 32 * 64; e += NT) { const int j = e >> 6, i = e & 63; sK[j][i] = bf2f(Z[(size_t)(krow0 + j) * ZW + C_RK + h * 64 + i]); sV[j][i] = bf2f(Z[(size_t)(krow0 + j) * ZW + C_RV + h * 64 + i]); }
            __syncthreads();
#pragma unroll 1
            for (int j = 0; j < 32; ++j) { float a = 0.f;
#pragma unroll
                for (int i = 0; i < 64; ++i) a += q[i] * sK[j][i];
                const int dpos = qpos - (kpos0 + j);
                const float dec = dpos > 0 ? exp2f(lgf * (float)dpos) : (dpos < 0 ? exp2f(lgb * (float)(-dpos)) : 2.f);
                a *= dec;
#pragma unroll
                for (int i = 0; i < 32; ++i) o[i] += a * sV[j][dh + i]; }
        }
        float s1 = 0.f;
#pragma unroll
        for (int i = 0; i < 32; ++i) s1 += o[i];
        __syncthreads();
        sred[hh * 256 + qt] = s1;
        __syncthreads();
        const float mu = (sred[qt] + sred[256 + qt]) * (1.f / 64);
        float s2 = 0.f;
#pragma unroll
        for (int i = 0; i < 32; ++i) { const float d = o[i] - mu; s2 += d * d; }
        __syncthreads();
        sred[hh * 256 + qt] = s2;
        __syncthreads();
        const float rstd = rsqrtf((sred[qt] + sred[256 + qt]) * (1.f / 64) + EPS);
#pragma unroll
        for (int i = 0; i < 32; ++i) { const float gte = bf2f(Z[(size_t)qrow * ZW + C_RG + h * 64 + dh + i]); const float y = (o[i] - mu) * rstd * gn_w[h * 64 + dh + i];
            Z[(size_t)qrow * ZW + C_RQ + h * 64 + dh + i] = f2bf(siluf_(gte) * y); }
    }
    __syncthreads();
}
struct E_merge { const bf16_t* stash; bf16_t* MMp; long long first;
    __device__ void operator()(int, int m, int n, float v) const { const size_t i = (size_t)m * DM + n; const float t = sigmoidf_(v) * bf2f(stash[i]); MMp[i] = f2bf(first ? t : bf2f(MMp[i]) + t); } };
struct E_resid { const float* xlat; const float* xctx; float* olat; float* octx; const float* mod; long long gchunk;
    __device__ void operator()(int, int m, int n, float v) const {
        const float g = mod[(size_t)row_modidx(m) * 6144 + gchunk * 1024 + n];
        if (m < RL) olat[(size_t)m * DM + n] = xlat[(size_t)m * DM + n] + g * v; else octx[(size_t)(m - RL) * DM + n] = xctx[(size_t)(m - RL) * DM + n] + g * v; } };
struct E_relu2 { bf16_t* H; __device__ void operator()(int, int m, int n, float v) const { const float r = fmaxf(v, 0.f); H[(size_t)m * DFF + n] = f2bf(r * r); } };


__device__ __forceinline__ void ph_s5_sloc(unsigned char* lds_, const bf16_t* Z, const bf16_t* MST, float* SLOC) { PH_IDS;
    const int lane = tid_ & 63, wid = __builtin_amdgcn_readfirstlane(tid_ >> 6), c16 = lane & 15, kq = lane >> 4;
    LAS char* sm = (LAS char*)lds_;
    constexpr int CP = 64 * 32 + 16;
    for (int u = bid_; u < 256; u += G_) {
        const int g = u >> 4, nh = (u >> 3) & 1, sl = u & 7;
        const bf16_t* mp0 = MST + ((size_t)g * 256 + nh * 128 + wid * 16 + c16) * 1024 + 8 * kq;
        bf16x8 a[32];
#pragma unroll
        for (int ks = 0; ks < 32; ++ks) a[ks] = *(const bf16x8*)(mp0 + 32 * ks);
        pg8::u32x4 st[4];
#define SLOC_ISSUE(blk_) do { _Pragma("unroll") for (int i = 0; i < 4; ++i) { const int p = tid_ + NT * i, r = p >> 1, hf = p & 1; \
            st[i] = *(const pg8::u32x4*)(Z + ((size_t)(blk_) * 1024 + r) * ZW + C_S5 + g * 16 + 8 * hf); } } while (0)
        SLOC_ISSUE(sl);
        for (int blk = sl; blk < 18; blk += 8) {
            const int rcbase = blk * 16;
            __syncthreads();
#pragma unroll
            for (int i = 0; i < 4; ++i) { const int p = tid_ + NT * i, r = p >> 1, hf = p & 1; *(LAS pg8::u32x4*)(sm + (r >> 6) * CP + (r & 63) * 32 + hf * 16) = st[i]; }
            if (blk + 8 < 18) SLOC_ISSUE(blk + 8);
            __syncthreads();
            const LAS char* bp = sm + c16 * CP + (kq >> 1) * 32 + (kq & 1) * 16;
            f32x4 acc0 = (f32x4){0.f, 0.f, 0.f, 0.f}, acc1 = acc0;
#pragma unroll
            for (int ks = 0; ks < 32; ks += 2) {
                const bf16x8 b0 = *(const LAS bf16x8*)(bp + ks * 64), b1 = *(const LAS bf16x8*)(bp + (ks + 1) * 64);
                acc0 = __builtin_amdgcn_mfma_f32_16x16x32_bf16(a[ks], b0, acc0, 0, 0, 0);
                acc1 = __builtin_amdgcn_mfma_f32_16x16x32_bf16(a[ks + 1], b1, acc1, 0, 0, 0);
            }
            *(f32x4*)(SLOC + ((size_t)(rcbase + c16) * 16 + g) * 256 + nh * 128 + wid * 16 + 4 * kq) = acc0 + acc1;
        }
#undef SLOC_ISSUE
    }
    __syncthreads();
}
__device__ __forceinline__ void ph_s5_tzb(int l, const float* TZD, const float* s5d, bf16_t* TZB, const float* c_re, const float* c_im, bf16_t* CQ) { PH_IDS;
    GSTRIDE(e, 16 * 16 * 256) { const int g = e >> 12, h = (e >> 8) & 15, n = e & 255, d = n >> 7, im = (n >> 6) & 1, p = n & 63;
        const size_t ci = ((((size_t)(l * 2 + d) * 16 + g) * 16 + h) * 64) + p; CQ[e] = f2bf(im ? -c_im[ci] : c_re[ci]); }
    GSTRIDE(e, 16 * 127 * 64) { const int g = e / (127 * 64), r = e % (127 * 64), dd = r >> 6, h = (r >> 2) & 15, q4 = (r & 3) * 4;
        f32x4 v = (f32x4){0.f, 0.f, 0.f, 0.f};
        if (dd >= 63) v += *(const f32x4*)(TZD + ((((size_t)0 * 16 + g) * 64 + (dd - 63)) * 16 + h) * 16 + q4);
        if (dd <= 63) v += *(const f32x4*)(TZD + ((((size_t)1 * 16 + g) * 64 + (63 - dd)) * 16 + h) * 16 + q4);
        if (dd == 63 && (h >> 2) == (q4 >> 2)) v[h & 3] += s5d[g * 16 + h];
        fa::u32x2 w; w.x = fa::pk2(v[0], v[1]); w.y = fa::pk2(v[2], v[3]);
        *(fa::u32x2*)(TZB + ((size_t)(g * 127 + dd) * 16 + h) * 16 + (((q4 >> 3) ^ (h >> 3)) * 8 + (q4 & 7))) = w; }
}
__device__ __forceinline__ void ph_s5_out(unsigned char* lds_, const bf16_t* Z, const bf16_t* TZB, const bf16_t* CQ, const float2* LP, const float* SLOC, const float* lamT, bf16_t* YG, int nrct, int u0, int ustep) { PH_IDS;
    LAS char* sm = (LAS char*)lds_;
    constexpr int O_TZ = 0, O_XP = 65536, O_U = 73728, UP = 2064, O_SL = O_U + 16 * UP;
    const int lane = tid_ & 63, wid = __builtin_amdgcn_readfirstlane(tid_ >> 6), c16 = lane & 15, kq = lane >> 4;
    for (int u = u0; u < 16 * nrct; u += ustep) {
        const int g = u / nrct, rct = u % nrct, rcbase = rct * 16;
        const bool lat = rct < 16; const int b = rcbase >> 5, c0 = rcbase & 31;
        const int nsl = lat ? 36 : 16;
        pg8::u32x4 sT[8], sU[4]; f32x4 sS[5];
        { const pg8::u32x4* tsrc = (const pg8::u32x4*)(TZB + (size_t)g * 127 * 256);
#pragma unroll
          for (int i_ = 0; i_ < 8; ++i_) { const int e = tid_ + NT * i_; if (e < 127 * 32) sT[i_] = tsrc[e]; }
#pragma unroll
          for (int i_ = 0; i_ < 4; ++i_) { const int e = tid_ + NT * i_, rc = e >> 7, s_ = (e >> 1) & 63, hh = e & 1; sU[i_] = *(const pg8::u32x4*)(Z + ((size_t)(rcbase + rc) * 64 + s_) * ZW + C_S5 + g * 16 + hh * 8); }
#pragma unroll
          for (int i_ = 0; i_ < 5; ++i_) { const int e = tid_ + NT * i_, r = e >> 6, q4 = e & 63; const int rc = lat ? (r < 4 ? 256 + b * 4 + r : b * 32 + (r - 4)) : rcbase + r;
              if (e < nsl * 64) sS[i_] = *(const f32x4*)(SLOC + ((size_t)rc * 16 + g) * 256 + q4 * 4); } }
        typedef float f32x2v __attribute__((ext_vector_type(2)));
        f32x2v sLq[3]; pg8::u32x4 sCq = *(const pg8::u32x4*)(CQ + (size_t)g * 4096 + tid_ * 8);
#pragma unroll
        for (int i_ = 0; i_ < 3; ++i_) { const int e = tid_ + NT * i_;
            if (e < 1152) { const int e2 = e - 128, d_ = e < 128 ? (e >> 6) : ((e2 >> 6) & 1), p_ = e & 63, w_ = e2 >> 7, k_ = e < 128 ? 1 : (d_ == 0 ? 8 * w_ + 1 : 57 - 8 * w_);
                const float2 t_ = LP[(((size_t)d_ * 16 + g) * 64 + p_) * 65 + k_]; sLq[i_] = (f32x2v){t_.x, t_.y}; } }
        __syncthreads();
#pragma unroll
        for (int i_ = 0; i_ < 8; ++i_) { const int e = tid_ + NT * i_; if (e < 127 * 32) *(LAS pg8::u32x4*)(sm + O_TZ + e * 16) = sT[i_]; }
#pragma unroll
        for (int i_ = 0; i_ < 4; ++i_) { const int e = tid_ + NT * i_, rc = e >> 7, s_ = (e >> 1) & 63, hh = e & 1; *(LAS pg8::u32x4*)(sm + O_U + rc * UP + s_ * 32 + hh * 16) = sU[i_]; }
#pragma unroll
        for (int i_ = 0; i_ < 5; ++i_) { const int e = tid_ + NT * i_, r = e >> 6, q4 = e & 63; if (e < nsl * 64) *(LAS f32x4*)(sm + O_SL + r * 1024 + q4 * 16) = sS[i_]; }
        __syncthreads();
        if (tid_ < 128) {
            const int d = tid_ >> 6, p = tid_ & 63;
            const float lr = lamT[((size_t)(g * 2 + d) * 64 + p) * 2], li = lamT[((size_t)(g * 2 + d) * 64 + p) * 2 + 1];
            const LAS float* sl = (const LAS float*)(sm + O_SL) + d * 128 + p;
            LAS bf16_t* xp = (LAS bf16_t*)(sm + O_XP) + d * 128 + p;
            float xr = 0.f, xi = 0.f;
#define S5_STEP(r) do { const float sr = sl[(r) * 256], si = sl[(r) * 256 + 64]; const float nr = lr * xr - li * xi + sr, ni = lr * xi + li * xr + si; xr = nr; xi = ni; } while (0)
            if (lat) {
                if (d == 0) { for (int r = 0; r < 4 + c0; ++r) S5_STEP(r);
                    for (int r = 0; r < 16; ++r) { xp[r * 256] = f2bf(xr); xp[r * 256 + 64] = f2bf(xi); S5_STEP(4 + c0 + r); } }
                else { for (int r = 3; r >= 0; --r) S5_STEP(r);
                    for (int c = 31; c >= c0 + 16; --c) S5_STEP(4 + c);
                    for (int r = 15; r >= 0; --r) { xp[r * 256] = f2bf(xr); xp[r * 256 + 64] = f2bf(xi); S5_STEP(4 + c0 + r); } }
            } else {
                if (d == 0) { for (int r = 0; r < 16; ++r) { if ((r & 3) == 0) { xr = 0.f; xi = 0.f; } xp[r * 256] = f2bf(xr); xp[r * 256 + 64] = f2bf(xi); S5_STEP(r); } }
                else { for (int r = 15; r >= 0; --r) { if ((r & 3) == 3) { xr = 0.f; xi = 0.f; } xp[r * 256] = f2bf(xr); xp[r * 256 + 64] = f2bf(xi); S5_STEP(r); } }
            }
#undef S5_STEP
        }
        __syncthreads();
#pragma unroll
        for (int i_ = 0; i_ < 3; ++i_) { const int e = tid_ + NT * i_; if (e < 1152) *(LAS f32x2v*)(sm + O_SL + e * 8) = sLq[i_]; }
        *(LAS pg8::u32x4*)(sm + O_SL + 9216 + tid_ * 16) = sCq;
        const LAS char* ub = sm + O_U + c16 * UP + kq * 16;
        const LAS char* xb = sm + O_XP + c16 * 512 + kq * 16;
        f32x4 acc8[8];
#pragma unroll
        for (int i = 0; i < 8; ++i) acc8[i] = (f32x4){0.f, 0.f, 0.f, 0.f};
#pragma unroll
        for (int par = 0; par < 2; ++par) {
            const LAS char* fz = sm + O_TZ + ((wid * 8 + par + 63 - (kq >> 1)) * 16 + c16) * 32 + ((kq & 1) ^ (c16 >> 3)) * 16;
            bf16x8 uw[4];
            uw[0] = *(const LAS bf16x8*)(ub); uw[1] = *(const LAS bf16x8*)(ub + 64); uw[2] = *(const LAS bf16x8*)(ub + 128); uw[3] = uw[0];
#pragma unroll
            for (int m = -3; m < 32; ++m) {
                const bf16x8 f = *(const LAS bf16x8*)(fz - m * 1024);
                if (m + 3 < 32) uw[(m + 3) & 3] = *(const LAS bf16x8*)(ub + (m + 3) * 64);
#pragma unroll
                for (int j = 0; j < 4; ++j) { const int ks = m + j; if (ks >= 0 && ks < 32) acc8[par + 2 * j] = __builtin_amdgcn_mfma_f32_16x16x32_bf16(f, uw[ks & 3], acc8[par + 2 * j], 0, 0, 0); }
            }
        }
        __syncthreads();
        {
#pragma unroll
            for (int d = 0; d < 2; ++d)
#pragma unroll 1
            for (int ph = 0; ph < 2; ++ph) {
                asm volatile("" ::: "memory");
                const bf16x8 cqr = *(const LAS bf16x8*)(sm + O_SL + 9216 + (c16 * 256 + 32 * (4 * d + ph) + 8 * kq) * 2), cqi = *(const LAS bf16x8*)(sm + O_SL + 9216 + (c16 * 256 + 32 * (4 * d + 2 + ph) + 8 * kq) * 2);
                const bf16x8 xre = *(const LAS bf16x8*)(xb + (4 * d + ph) * 64), xim = *(const LAS bf16x8*)(xb + (4 * d + 2 + ph) * 64);
                float yr[8], yi[8], lr[8], li[8];
#pragma unroll
                for (int j = 0; j < 8; ++j) {
                    const int p_ = 32 * ph + 8 * kq + j;
                    const f32x2v l1 = *(const LAS f32x2v*)(sm + O_SL + (d * 64 + p_) * 8), ls = *(const LAS f32x2v*)(sm + O_SL + (128 + (wid * 2 + d) * 64 + p_) * 8);
                    const float xr = __uint_as_float((unsigned)(unsigned short)xre[j] << 16), xi = __uint_as_float((unsigned)(unsigned short)xim[j] << 16);
                    yr[j] = ls.x * xr - ls.y * xi; yi[j] = ls.x * xi + ls.y * xr; lr[j] = l1.x; li[j] = l1.y;
                }
#pragma unroll
                for (int s8 = 0; s8 < 8; ++s8) {
                    const int i = d == 0 ? s8 : 7 - s8;
                    const bf16x8 bre = __builtin_bit_cast(bf16x8, pack8((f32x4){yr[0], yr[1], yr[2], yr[3]}, (f32x4){yr[4], yr[5], yr[6], yr[7]}));
                    const bf16x8 bim = __builtin_bit_cast(bf16x8, pack8((f32x4){yi[0], yi[1], yi[2], yi[3]}, (f32x4){yi[4], yi[5], yi[6], yi[7]}));
                    acc8[i] = __builtin_amdgcn_mfma_f32_16x16x32_bf16(cqr, bre, acc8[i], 0, 0, 0);
                    acc8[i] = __builtin_amdgcn_mfma_f32_16x16x32_bf16(cqi, bim, acc8[i], 0, 0, 0);
                    if (s8 < 7) {
#pragma unroll
                        for (int j = 0; j < 8; ++j) { const float a = yr[j], c = yi[j]; yr[j] = lr[j] * a - li[j] * c; yi[j] = lr[j] * c + li[j] * a; }
                    }
                }
            }
        }
#pragma unroll
        for (int i = 0; i < 8; ++i) { const int t = wid * 8 + i;
            fa::u32x2 w; w.x = fa::pk2(geluf_(acc8[i][0]), geluf_(acc8[i][1])); w.y = fa::pk2(geluf_(acc8[i][2]), geluf_(acc8[i][3]));
            *(fa::u32x2*)(YG + ((size_t)(rcbase + c16) * 64 + t) * ZW + C_S5 + g * 16 + 4 * kq) = w; }
    }
    __syncthreads();
}
__device__ __forceinline__ void rope16(float (&v)[4], int kq, float pos, bool on) {
#pragma unroll
    for (int r = 0; r < 4; ++r) {
        const int j = (4 * kq + r) & 7;
        const float ang = pos * exp2f(-(float)j * (13.287712379549449f / 8.f)), cs = __cosf(ang), sn = __sinf(ang);
        const float other = __shfl_xor(v[r], 32);
        const float rot = kq < 2 ? v[r] * cs - other * sn : other * sn + v[r] * cs;
        v[r] = on ? rot : v[r];
    }
}
__device__ __forceinline__ void ph_prep(bf16_t* Z, const bf16_t* WUQ, const bf16_t* WUKV, const bf16_t* D64, const float* qkq, const float* qkk,
                                        bf16_t* Q, bf16_t* Kb, bf16_t* Vb, bf16_t* F1lat, bf16_t* F1ctx, unsigned char* lds_) { PH_IDS;
    const int lane = tid_ & 63, wid = __builtin_amdgcn_readfirstlane(tid_ >> 6), c16 = lane & 15, kq = lane >> 4;
    LAS char* sm = (LAS char*)lds_;
    constexpr int P_KV = 336, P_QC = 528, O_KV = 0, O_QC = 24576, O_FU = 63488;
    for (int blk = bid_; blk < RT / 72; blk += G_) {
        const int row0 = blk * 72;
        __syncthreads();
#pragma unroll 1
        for (int hf = 0; hf < 3; ++hf) { pg8::u32x4 st[4];
#pragma unroll
          for (int i = 0; i < 4; ++i) { const int e = tid_ + NT * (4 * hf + i);
              if (e < 1440) st[i] = *(const pg8::u32x4*)(Z + (size_t)(row0 + e / 20) * ZW + C_KVC + (e % 20) * 8);
              else if (e < 3744) st[i] = *(const pg8::u32x4*)(Z + (size_t)(row0 + ((e - 1440) >> 5)) * ZW + C_QC + ((e - 1440) & 31) * 8);
              else if (e < 6048) st[i] = *(const pg8::u32x4*)(Z + (size_t)(row0 + ((e - 3744) >> 5)) * ZW + C_FU + ((e - 3744) & 31) * 8); }
#pragma unroll
          for (int i = 0; i < 4; ++i) { const int e = tid_ + NT * (4 * hf + i);
              if (e < 1440) *(LAS pg8::u32x4*)(sm + O_KV + (e / 20) * P_KV + (e % 20) * 16) = st[i];
              else if (e < 3744) *(LAS pg8::u32x4*)(sm + O_QC + ((e - 1440) >> 5) * P_QC + ((e - 1440) & 31) * 16) = st[i];
              else if (e < 6048) *(LAS pg8::u32x4*)(sm + O_FU + ((e - 3744) >> 5) * P_QC + ((e - 3744) & 31) * 16) = st[i]; } }
        __syncthreads();
#pragma unroll 1
      for (int pass3 = 0; pass3 < 2; ++pass3) {
        int rowc[3], rl[3]; bool valid[3];
#pragma unroll
        for (int tt = 0; tt < 3; ++tt) { const int o = 16 * (3 * pass3 + tt) + c16; valid[tt] = o < 72; rl[tt] = valid[tt] ? o : 71; rowc[tt] = row0 + rl[tt]; }
        if (wid < 4) {
            const int h = wid;
            f32x4 acc[6][3]; float ssq[3];
#pragma unroll
            for (int tt = 0; tt < 3; ++tt) { ssq[tt] = 0.f;
#pragma unroll
                for (int nt = 0; nt < 6; ++nt) acc[nt][tt] = (f32x4){0.f, 0.f, 0.f, 0.f}; }
#pragma unroll 4
            for (int ks = 0; ks < 8; ++ks) {
                bf16x8 bq[3], aw[6];
#pragma unroll
                for (int tt = 0; tt < 3; ++tt) { bq[tt] = *(const LAS bf16x8*)(sm + O_QC + rl[tt] * P_QC + (32 * ks + 8 * kq) * 2);
#pragma unroll
                    for (int e = 0; e < 8; ++e) { const float f = bf2f((bf16_t)bq[tt][e]); ssq[tt] += f * f; } }
#pragma unroll
                for (int nt = 0; nt < 6; ++nt) aw[nt] = *(const bf16x8*)(WUQ + (size_t)(h * 96 + 16 * nt + c16) * 256 + 32 * ks + 8 * kq);
#pragma unroll
                for (int nt = 0; nt < 6; ++nt)
#pragma unroll
                    for (int tt = 0; tt < 3; ++tt) acc[nt][tt] = __builtin_amdgcn_mfma_f32_16x16x32_bf16(aw[nt], bq[tt], acc[nt][tt], 0, 0, 0);
            }
#pragma unroll
            for (int tt = 0; tt < 3; ++tt) {
                float s1 = ssq[tt]; s1 += __shfl_xor(s1, 16); s1 += __shfl_xor(s1, 32);
                const float rstd = rsqrtf(s1 * (1.f / 256) + EPS);
                float ss = 0.f;
#pragma unroll
                for (int nt = 0; nt < 6; ++nt)
#pragma unroll
                    for (int r = 0; r < 4; ++r) ss += acc[nt][tt][r] * acc[nt][tt][r];
                ss += __shfl_xor(ss, 16); ss += __shfl_xor(ss, 32);
                const float fac = rstd * rsqrtf(rstd * rstd * ss * (1.f / 96) + EPS) * 0.14724727430627066f;
                const int row = rowc[tt]; const bool lat = row < RL; const int b = row_batch(row), t = lat ? (row & 2047) : ((row - RL) & 255), qi = lat ? t : 2048 + t;
                bf16_t* qo = Q + ((size_t)(b * 4 + h) * 2304 + qi) * 96 + 4 * kq;
#pragma unroll
                for (int nt = 0; nt < 6; ++nt) {
                    const f32x4 w = *(const f32x4*)(qkq + 16 * nt + 4 * kq);
                    float v[4];
#pragma unroll
                    for (int r = 0; r < 4; ++r) v[r] = acc[nt][tt][r] * fac * w[r];
                    if (nt >= 4) rope16(v, kq, nt == 4 ? (float)(t >> 6) : (float)(t & 63), lat);
                    fa::u32x2 o; o.x = fa::pk2(v[0], v[1]); o.y = fa::pk2(v[2], v[3]);
                    if (valid[tt]) *(fa::u32x2*)(qo + 16 * nt) = o;
                }
            }
        } else {
            const int h = wid - 4;
            float ssq[3], rstd[3];
#pragma unroll
            for (int tt = 0; tt < 3; ++tt) ssq[tt] = 0.f;
#pragma unroll 1
            for (int pass = 0; pass < 2; ++pass) {
                f32x4 acc[4][3];
#pragma unroll
                for (int tt = 0; tt < 3; ++tt)
#pragma unroll
                    for (int nt = 0; nt < 4; ++nt) acc[nt][tt] = (f32x4){0.f, 0.f, 0.f, 0.f};
#pragma unroll
                for (int ks = 0; ks < 4; ++ks) {
                    bf16x8 bq[3], aw[4];
#pragma unroll
                    for (int tt = 0; tt < 3; ++tt) { bq[tt] = *(const LAS bf16x8*)(sm + O_KV + rl[tt] * P_KV + (32 * ks + 8 * kq) * 2);
                        if (pass == 0) {
#pragma unroll
                            for (int e = 0; e < 8; ++e) { const float f = bf2f((bf16_t)bq[tt][e]); ssq[tt] += f * f; } } }
#pragma unroll
                    for (int nt = 0; nt < 4; ++nt) aw[nt] = *(const bf16x8*)(WUKV + (size_t)(h * 128 + pass * 64 + 16 * nt + c16) * 128 + 32 * ks + 8 * kq);
#pragma unroll
                    for (int nt = 0; nt < 4; ++nt)
#pragma unroll
                        for (int tt = 0; tt < 3; ++tt) acc[nt][tt] = __builtin_amdgcn_mfma_f32_16x16x32_bf16(aw[nt], bq[tt], acc[nt][tt], 0, 0, 0);
                }
#pragma unroll
                for (int tt = 0; tt < 3; ++tt) {
                    const int row = rowc[tt]; const bool lat = row < RL; const int b = row_batch(row), t = lat ? (row & 2047) : ((row - RL) & 255), ki = lat ? 256 + t : t;
                    if (pass == 0) {
                        float s1 = ssq[tt]; s1 += __shfl_xor(s1, 16); s1 += __shfl_xor(s1, 32);
                        rstd[tt] = rsqrtf(s1 * (1.f / 128) + EPS);
                        float kr[2][4];
#pragma unroll
                        for (int e = 0; e < 2; ++e) { const fa::u32x2 w = *(const LAS fa::u32x2*)(sm + O_KV + rl[tt] * P_KV + (128 + 16 * e + 4 * kq) * 2);
                            kr[e][0] = __uint_as_float(w.x << 16); kr[e][1] = __uint_as_float(w.x & 0xffff0000u); kr[e][2] = __uint_as_float(w.y << 16); kr[e][3] = __uint_as_float(w.y & 0xffff0000u); }
                        float ss = 0.f;
#pragma unroll
                        for (int nt = 0; nt < 4; ++nt)
#pragma unroll
                            for (int r = 0; r < 4; ++r) { acc[nt][tt][r] *= rstd[tt]; ss += acc[nt][tt][r] * acc[nt][tt][r]; }
#pragma unroll
                        for (int e = 0; e < 2; ++e)
#pragma unroll
                            for (int r = 0; r < 4; ++r) ss += kr[e][r] * kr[e][r];
                        ss += __shfl_xor(ss, 16); ss += __shfl_xor(ss, 32);
                        const float fac = rsqrtf(ss * (1.f / 96) + EPS);
                        bf16_t* ko = Kb + ((size_t)(b * 4 + h) * 2304 + ki) * 96 + 4 * kq;
#pragma unroll
                        for (int nt = 0; nt < 6; ++nt) {
                            const f32x4 w = *(const f32x4*)(qkk + 16 * nt + 4 * kq);
                            float v[4];
#pragma unroll
                            for (int r = 0; r < 4; ++r) v[r] = (nt < 4 ? acc[nt < 4 ? nt : 0][tt][r] : kr[nt < 4 ? 0 : nt - 4][r]) * fac * w[r];
                            if (nt >= 4) rope16(v, kq, nt == 4 ? (float)(t >> 6) : (float)(t & 63), lat);
                            fa::u32x2 o; o.x = fa::pk2(v[0], v[1]); o.y = fa::pk2(v[2], v[3]);
                            if (valid[tt]) *(fa::u32x2*)(ko + 16 * nt) = o;
                        }
                    } else {
                        bf16_t* vo = Vb + ((size_t)(b * 4 + h) * 2304 + ki) * 64 + 4 * kq;
#pragma unroll
                        for (int nt = 0; nt < 4; ++nt) { fa::u32x2 o; o.x = fa::pk2(acc[nt][tt][0] * rstd[tt], acc[nt][tt][1] * rstd[tt]); o.y = fa::pk2(acc[nt][tt][2] * rstd[tt], acc[nt][tt][3] * rstd[tt]);
                            if (valid[tt]) *(fa::u32x2*)(vo + 16 * nt) = o; }
                    }
                }
            }
        }
        {
            const int g = wid >> 1, part = wid & 1;
            f32x4 acc[4][3];
#pragma unroll
            for (int tt = 0; tt < 3; ++tt)
#pragma unroll
                for (int nt = 0; nt < 4; ++nt) acc[nt][tt] = (f32x4){0.f, 0.f, 0.f, 0.f};
#pragma unroll
            for (int ks = 0; ks < 2; ++ks) {
                bf16x8 au[3], bd[4];
#pragma unroll
                for (int tt = 0; tt < 3; ++tt) au[tt] = *(const LAS bf16x8*)(sm + O_FU + rl[tt] * P_QC + (g * 64 + 32 * ks + 8 * kq) * 2);
#pragma unroll
                for (int nt = 0; nt < 4; ++nt) bd[nt] = *(const bf16x8*)(D64 + (size_t)(part * 64 + 16 * nt + c16) * 64 + 32 * ks + 8 * kq);
#pragma unroll
                for (int nt = 0; nt < 4; ++nt)
#pragma unroll
                    for (int tt = 0; tt < 3; ++tt) acc[nt][tt] = __builtin_amdgcn_mfma_f32_16x16x32_bf16(au[tt], bd[nt], acc[nt][tt], 0, 0, 0);
            }
#pragma unroll
            for (int tt = 0; tt < 3; ++tt) {
                const int o4 = 16 * (3 * pass3 + tt) + 4 * kq; const int trow = row0 + o4;
                if (o4 < 72) {
                    const bool lat = trow < RL;
#pragma unroll
                    for (int nt = 0; nt < 4; ++nt) {
                        const int gm = g * 64 + 16 * nt + c16;
                        fa::u32x2 o; o.x = fa::pk2(acc[nt][tt][0], acc[nt][tt][1]); o.y = fa::pk2(acc[nt][tt][2], acc[nt][tt][3]);
                        if (lat) { const int b = trow >> 11, t0 = trow & 2047; *(fa::u32x2*)(F1lat + ((size_t)(b * 256 + gm) * 2 + part) * 2048 + t0) = o; }
                        else { const int rr = trow - RL, b = rr >> 8, t0 = rr & 255; *(fa::u32x2*)(F1ctx + ((size_t)(b * 256 + gm) * 2 + part) * 256 + t0) = o; }
                    }
                }
            }
        }
      }
#pragma unroll 1
        for (int it = tid_; it < 72 * 16; it += NT) {
            const int row = row0 + (it >> 4), h = (it >> 2) & 3, jg = it & 3;
            bf16_t* zq = Z + (size_t)row * ZW + C_RQ + h * 64 + 8 * jg; bf16_t* zk = Z + (size_t)row * ZW + C_RK + h * 64 + 8 * jg;
            const fa::u32x4 k1 = *(const fa::u32x4*)zk, k2 = *(const fa::u32x4*)(zk + 32);
            f32x4 ka, kb, kc, kd; unpack8(k1, ka, kb); unpack8(k2, kc, kd);
            if (row < RL) {
                const fa::u32x4 q1 = *(const fa::u32x4*)zq, q2 = *(const fa::u32x4*)(zq + 32);
                f32x4 qa, qb, qc, qd; unpack8(q1, qa, qb); unpack8(q2, qc, qd);
                const float tpos = (float)(row & 2047);
                float x1q[8] = {qa[0], qa[1], qa[2], qa[3], qb[0], qb[1], qb[2], qb[3]}, x2q[8] = {qc[0], qc[1], qc[2], qc[3], qd[0], qd[1], qd[2], qd[3]};
                float x1k[8] = {ka[0], ka[1], ka[2], ka[3], kb[0], kb[1], kb[2], kb[3]}, x2k[8] = {kc[0], kc[1], kc[2], kc[3], kd[0], kd[1], kd[2], kd[3]};
#pragma unroll
                for (int e = 0; e < 8; ++e) {
                    float rev = tpos * (__builtin_amdgcn_exp2f(-(float)(8 * jg + e) * (13.287712379549449f / 32.f)) * 0.15915494309189535f); rev -= floorf(rev);
                    const float cs = __builtin_amdgcn_cosf(rev), sn = __builtin_amdgcn_sinf(rev);
                    const float a = x1q[e], c = x2q[e]; x1q[e] = a * cs - c * sn; x2q[e] = a * sn + c * cs;
                    const float a2 = x1k[e], c2 = x2k[e]; x1k[e] = (a2 * cs - c2 * sn) * 0.125f; x2k[e] = (a2 * sn + c2 * cs) * 0.125f;
                }
                *(fa::u32x4*)zq = pack8((f32x4){x1q[0], x1q[1], x1q[2], x1q[3]}, (f32x4){x1q[4], x1q[5], x1q[6], x1q[7]});
                *(fa::u32x4*)(zq + 32) = pack8((f32x4){x2q[0], x2q[1], x2q[2], x2q[3]}, (f32x4){x2q[4], x2q[5], x2q[6], x2q[7]});
                *(fa::u32x4*)zk = pack8((f32x4){x1k[0], x1k[1], x1k[2], x1k[3]}, (f32x4){x1k[4], x1k[5], x1k[6], x1k[7]});
                *(fa::u32x4*)(zk + 32) = pack8((f32x4){x2k[0], x2k[1], x2k[2], x2k[3]}, (f32x4){x2k[4], x2k[5], x2k[6], x2k[7]});
            } else {
                *(fa::u32x4*)zk = pack8(ka * 0.125f, kb * 0.125f); *(fa::u32x4*)(zk + 32) = pack8(kc * 0.125f, kd * 0.125f);
            }
        }
    }
}

__device__ __forceinline__ void attn_tile(const LAS char* sm, int r32, int hi, int vrd, int buf, bool first, const bf16x8 (&qf)[6], fa::f32x16& negm, float& mrun, float& lsum, fa::f32x16& o0, fa::f32x16& o1) {
    using namespace fa;
    const LAS char* kb = sm + buf + r32 * KP_A + 16 * hi;
    f32x16 p0 = negm, p1 = negm;
#pragma unroll
    for (int st = 0; st < 6; ++st) {
        const bf16x8 k0 = *(const LAS bf16x8*)(kb + 32 * st), k1 = *(const LAS bf16x8*)(kb + 32 * KP_A + 32 * st);
        p0 = __builtin_amdgcn_mfma_f32_32x32x16_bf16(k0, qf[st], p0, 0, 0, 0);
        p1 = __builtin_amdgcn_mfma_f32_32x32x16_bf16(k1, qf[st], p1, 0, 0, 0);
    }
    float ta = fmaxf(fmaxf(p0[0], p0[1]), p1[0]), tb = fmaxf(fmaxf(p0[2], p0[3]), p1[1]);
    ta = fmaxf(fmaxf(ta, p1[2]), p1[3]);
#pragma unroll
    for (int r = 4; r < 16; r += 4) { ta = fmaxf(fmaxf(ta, p0[r]), p0[r + 1]); tb = fmaxf(fmaxf(tb, p0[r + 2]), p0[r + 3]); ta = fmaxf(fmaxf(ta, p1[r]), p1[r + 1]); tb = fmaxf(fmaxf(tb, p1[r + 2]), p1[r + 3]); }
    float tm = fmaxf(ta, tb);
    tm = fmaxf(tm, __shfl_xor(tm, 32));
    if (first || __any(tm > 0.f)) {
        const float dl = first ? tm : fmaxf(tm, 0.f), alpha = first ? 1.f : __builtin_amdgcn_exp2f(-dl);
        mrun += dl; lsum *= alpha;
#pragma unroll
        for (int r = 0; r < 16; ++r) { p0[r] -= dl; p1[r] -= dl; o0[r] *= alpha; o1[r] *= alpha; negm[r] = -mrun; }
    }
    float ps = 0.f, ps2 = 0.f;
#pragma unroll
    for (int r = 0; r < 16; ++r) { p0[r] = __builtin_amdgcn_exp2f(p0[r]); p1[r] = __builtin_amdgcn_exp2f(p1[r]); ps += p0[r]; ps2 += p1[r]; }
    lsum += ps + ps2;
    bf16x8 pf[4]; pf[0] = pack_p(p0, 0); pf[1] = pack_p(p0, 8); pf[2] = pack_p(p1, 0); pf[3] = pack_p(p1, 8);
    pv_tile(o0, o1, sm + buf + vrd, pf);
}
__device__ __forceinline__ void attn_pair(const LAS char* sm, int r32, int hi, int vrd, int bufA, int bufB, bool first, const bf16x8 (&qf)[6], fa::f32x16& negm, float& mrun, float& lsum, fa::f32x16& o0, fa::f32x16& o1) {
    using namespace fa;
    const LAS char* ka = sm + bufA + r32 * KP_A + 16 * hi; const LAS char* kb = sm + bufB + r32 * KP_A + 16 * hi;
    f32x16 a0 = negm, a1 = negm, b0 = negm, b1 = negm;
#pragma unroll
    for (int st = 0; st < 6; ++st) {
        const bf16x8 k0 = *(const LAS bf16x8*)(ka + 32 * st), k1 = *(const LAS bf16x8*)(ka + 32 * KP_A + 32 * st);
        a0 = __builtin_amdgcn_mfma_f32_32x32x16_bf16(k0, qf[st], a0, 0, 0, 0);
        a1 = __builtin_amdgcn_mfma_f32_32x32x16_bf16(k1, qf[st], a1, 0, 0, 0);
    }
    float carry = 0.f;
    {
        float ta = fmaxf(fmaxf(a0[0], a0[1]), a1[0]), tb = fmaxf(fmaxf(a0[2], a0[3]), a1[1]);
        ta = fmaxf(fmaxf(ta, a1[2]), a1[3]);
#pragma unroll
        for (int r = 4; r < 16; r += 4) { ta = fmaxf(fmaxf(ta, a0[r]), a0[r + 1]); tb = fmaxf(fmaxf(tb, a0[r + 2]), a0[r + 3]); ta = fmaxf(fmaxf(ta, a1[r]), a1[r + 1]); tb = fmaxf(fmaxf(tb, a1[r + 2]), a1[r + 3]); }
        float tm = fmaxf(ta, tb);
        tm = fmaxf(tm, __shfl_xor(tm, 32));
        if (first || __any(tm > 0.f)) {
            const float dl = first ? tm : fmaxf(tm, 0.f), alpha = first ? 1.f : __builtin_amdgcn_exp2f(-dl);
            mrun += dl; lsum *= alpha; carry = dl;
#pragma unroll
            for (int r = 0; r < 16; ++r) { a0[r] -= dl; a1[r] -= dl; o0[r] *= alpha; o1[r] *= alpha; negm[r] = -mrun; }
        }
    }
#pragma unroll
    for (int st = 0; st < 6; ++st) {
        const bf16x8 k0 = *(const LAS bf16x8*)(kb + 32 * st), k1 = *(const LAS bf16x8*)(kb + 32 * KP_A + 32 * st);
        b0 = __builtin_amdgcn_mfma_f32_32x32x16_bf16(k0, qf[st], b0, 0, 0, 0);
        b1 = __builtin_amdgcn_mfma_f32_32x32x16_bf16(k1, qf[st], b1, 0, 0, 0);
    }
    float ps = 0.f, ps2 = 0.f;
#pragma unroll
    for (int r = 0; r < 16; ++r) { a0[r] = __builtin_amdgcn_exp2f(a0[r]); a1[r] = __builtin_amdgcn_exp2f(a1[r]); ps += a0[r]; ps2 += a1[r]; }
    lsum += ps + ps2;
    bf16x8 pf[4]; pf[0] = pack_p(a0, 0); pf[1] = pack_p(a0, 8); pf[2] = pack_p(a1, 0); pf[3] = pack_p(a1, 8);
    pv_tile(o0, o1, sm + bufA + vrd, pf);
    {
        float ta = fmaxf(fmaxf(b0[0], b0[1]), b1[0]), tb = fmaxf(fmaxf(b0[2], b0[3]), b1[1]);
        ta = fmaxf(fmaxf(ta, b1[2]), b1[3]);
#pragma unroll
        for (int r = 4; r < 16; r += 4) { ta = fmaxf(fmaxf(ta, b0[r]), b0[r + 1]); tb = fmaxf(fmaxf(tb, b0[r + 2]), b0[r + 3]); ta = fmaxf(fmaxf(ta, b1[r]), b1[r + 1]); tb = fmaxf(fmaxf(tb, b1[r + 2]), b1[r + 3]); }
        float tm = fmaxf(ta, tb) - carry;
        tm = fmaxf(tm, __shfl_xor(tm, 32));
        if (__any(tm > 0.f) || __any(carry != 0.f)) {
            const float dl = fmaxf(tm, 0.f), alpha = __builtin_amdgcn_exp2f(-dl), sh = carry + dl;
            mrun += dl; lsum *= alpha;
#pragma unroll
            for (int r = 0; r < 16; ++r) { b0[r] -= sh; b1[r] -= sh; o0[r] *= alpha; o1[r] *= alpha; negm[r] = -mrun; }
        }
    }
    ps = 0.f; ps2 = 0.f;
#pragma unroll
    for (int r = 0; r < 16; ++r) { b0[r] = __builtin_amdgcn_exp2f(b0[r]); b1[r] = __builtin_amdgcn_exp2f(b1[r]); ps += b0[r]; ps2 += b1[r]; }
    lsum += ps + ps2;
    pf[0] = pack_p(b0, 0); pf[1] = pack_p(b0, 8); pf[2] = pack_p(b1, 0); pf[3] = pack_p(b1, 8);
    pv_tile(o0, o1, sm + bufB + vrd, pf);
}
__device__ __forceinline__ float vadd1(float a, float b) { float r; asm("v_add_f32 %0, %1, %2" : "=v"(r) : "v"(a), "v"(b)); return r; }
__device__ __forceinline__ float att_max(const fa::f32x16& p0, const fa::f32x16& p1) {
    float ta = fmaxf(fmaxf(p0[0], p0[1]), p1[0]), tb = fmaxf(fmaxf(p0[2], p0[3]), p1[1]);
    ta = fmaxf(fmaxf(ta, p1[2]), p1[3]);
#pragma unroll
    for (int r = 4; r < 16; r += 4) { ta = fmaxf(fmaxf(ta, p0[r]), p0[r + 1]); tb = fmaxf(fmaxf(tb, p0[r + 2]), p0[r + 3]); ta = fmaxf(fmaxf(ta, p1[r]), p1[r + 1]); tb = fmaxf(fmaxf(tb, p1[r + 2]), p1[r + 3]); }
    return fmaxf(ta, tb);
}
__device__ __forceinline__ void att_shift(float tm, bool first, float& mrun, float& lsum, fa::f32x16& o0, fa::f32x16& o1) {
    if (first || __any(tm > mrun + 8.f)) {
        tm = fmaxf(tm, __shfl_xor(tm, 32));
        const float dl = first ? 0.f : fmaxf(tm - mrun, 0.f), alpha = __builtin_amdgcn_exp2f(-dl);
        mrun = first ? tm : mrun + dl; lsum *= alpha;
#pragma unroll
        for (int r = 0; r < 16; ++r) { o0[r] *= alpha; o1[r] *= alpha; }
    }
}
__device__ __forceinline__ void att_qk_exp(const LAS char* kb, const bf16x8 (&qf)[6], float nm, fa::f32x16& n0, fa::f32x16& n1, fa::f32x16& p0, fa::f32x16& p1, float& lsum, bf16x8 (&pf)[4]) {
    const fa::f32x16 zero = {0.f, 0.f, 0.f, 0.f, 0.f, 0.f, 0.f, 0.f, 0.f, 0.f, 0.f, 0.f, 0.f, 0.f, 0.f, 0.f};
    bf16x8 kc0 = *(const LAS bf16x8*)kb, kc1 = *(const LAS bf16x8*)(kb + 32 * fa::KP_A);
    float ps = 0.f, ps2 = 0.f;
#pragma unroll
    for (int st = 0; st < 6; ++st) {
        bf16x8 kn0 = kc0, kn1 = kc1;
        if (st < 5) { kn0 = *(const LAS bf16x8*)(kb + 32 * (st + 1)); kn1 = *(const LAS bf16x8*)(kb + 32 * fa::KP_A + 32 * (st + 1)); }
        n0 = __builtin_amdgcn_mfma_f32_32x32x16_bf16(kc0, qf[st], st == 0 ? zero : n0, 0, 0, 0);
        n1 = __builtin_amdgcn_mfma_f32_32x32x16_bf16(kc1, qf[st], st == 0 ? zero : n1, 0, 0, 0);
        constexpr int lo[7] = {0, 2, 6, 8, 10, 14, 16};
#pragma unroll
        for (int r = lo[st]; r < lo[st + 1]; ++r) {
            p0[r] = __builtin_amdgcn_exp2f(vadd1(p0[r], nm)); p1[r] = __builtin_amdgcn_exp2f(vadd1(p1[r], nm));
            ps += p0[r]; ps += p1[r]; }
        kc0 = kn0; kc1 = kn1;
        __builtin_amdgcn_sched_barrier(0);
    }
    lsum += ps + ps2;
    pf[0] = fa::pack_p(p0, 0); pf[1] = fa::pack_p(p0, 8); pf[2] = fa::pack_p(p1, 0); pf[3] = fa::pack_p(p1, 8);
}
__device__ __forceinline__ void att_exp_pack(fa::f32x16& p0, fa::f32x16& p1, float nm, float& lsum, bf16x8 (&pf)[4]) {
    float ps = 0.f, ps2 = 0.f;
#pragma unroll
    for (int r = 0; r < 16; ++r) { p0[r] = __builtin_amdgcn_exp2f(vadd1(p0[r], nm)); p1[r] = __builtin_amdgcn_exp2f(vadd1(p1[r], nm)); ps += p0[r]; ps += p1[r]; }
    lsum += ps + ps2;
    pf[0] = fa::pack_p(p0, 0); pf[1] = fa::pack_p(p0, 8); pf[2] = fa::pack_p(p1, 0); pf[3] = fa::pack_p(p1, 8);
}
__device__ __forceinline__ float att_pv_max(fa::f32x16& o0, fa::f32x16& o1, const LAS char* vb, const bf16x8 (&pf)[4], const fa::f32x16& n0, const fa::f32x16& n1) {
    using namespace fa;
    float ta = n0[0], tb = n1[0];
    s16x4 a0 = vtr(vb), a1 = vtr(vb + 512), b0 = vtr(vb + 4096), b1 = vtr(vb + 4096 + 512);
#pragma unroll
    for (int ks = 0; ks < 4; ++ks) {
        s16x4 na0 = a0, na1 = a1, nb0 = b0, nb1 = b1;
        if (ks < 3) { na0 = vtr(vb + (ks + 1) * 1024); na1 = vtr(vb + (ks + 1) * 1024 + 512); nb0 = vtr(vb + 4096 + (ks + 1) * 1024); nb1 = vtr(vb + 4096 + (ks + 1) * 1024 + 512); }
        const bf16x8 v0 = (bf16x8){a0[0], a0[1], a0[2], a0[3], a1[0], a1[1], a1[2], a1[3]}, v1 = (bf16x8){b0[0], b0[1], b0[2], b0[3], b1[0], b1[1], b1[2], b1[3]};
        o0 = __builtin_amdgcn_mfma_f32_32x32x16_bf16(v0, pf[ks], o0, 0, 0, 0);
        o1 = __builtin_amdgcn_mfma_f32_32x32x16_bf16(v1, pf[ks], o1, 0, 0, 0);
#pragma unroll
        for (int r = 4 * ks; r < 4 * ks + 4; ++r) { ta = fmaxf(ta, n0[r]); tb = fmaxf(tb, n1[r]); }
        a0 = na0; a1 = na1; b0 = nb0; b1 = nb1;
        __builtin_amdgcn_sched_barrier(0);
    }
    return fmaxf(ta, tb);
}
__device__ __forceinline__ void ph_attn_mfma(unsigned char* lds_, const bf16_t* Q, const bf16_t* Kb, const bf16_t* Vb, bf16_t* Z, int with_ctx, int u0, int ustep) { PH_IDS;
    using namespace fa;
    LAS char* sm = (LAS char*)lds_;
    const int lane = tid_ & 63, wid = __builtin_amdgcn_readfirstlane(tid_ >> 6), r32 = lane & 31, hi = lane >> 5;
    const int nunits = 256 + (with_ctx ? 32 : 0);
    const int koff0 = (tid_ / 12) * KP_A + (tid_ % 12) * 16, koff1 = ((tid_ + 512) / 12) * KP_A + ((tid_ + 512) % 12) * 16;
    const int voff = KT_A + ((tid_ & 7) >> 2) * 4096 + (tid_ >> 3) * 64 + (tid_ & 3) * 16;
    const int vrd = KT_A + ((lane >> 4) & 1) * 32 + (lane & 3) * 8 + (4 * hi + ((lane & 15) >> 2)) * 64;
    for (int u = u0; u < nunits; u += ustep) {
        const bool lat = u < 256; const int bh = lat ? (u >> 3) : (u - 256), qb = lat ? (u & 7) : 8;
        const int ntile = lat ? 36 : 4;
        const char* Kg = (const char*)(Kb + (size_t)bh * 2304 * 96); const char* Vg = (const char*)(Vb + (size_t)bh * 2304 * 64);
        const bf16_t* Qg = Q + ((size_t)bh * 2304 + qb * 256 + wid * 32 + r32) * 96;
        bf16x8 qf[6];
#pragma unroll
        for (int st = 0; st < 6; ++st) qf[st] = *(const bf16x8*)(Qg + 16 * st + 8 * hi);
        f32x16 o0, o1;
#pragma unroll
        for (int r = 0; r < 16; ++r) { o0[r] = 0.f; o1[r] = 0.f; }
        float mrun = 0.f, lsum = 0.f;
        f32x16 negm;
#pragma unroll
        for (int r = 0; r < 16; ++r) negm[r] = 0.f;
        u32x4 ka0, ka1, va, kb0, kb1, vb;
#define ATT_LOAD(k0_, k1_, v_, tt) do { const char* kg_ = Kg + (size_t)(tt) * 12288; const char* vg_ = Vg + (size_t)(tt) * 8192; \
            k0_ = *(const u32x4*)(kg_ + tid_ * 16); if (tid_ < 256) k1_ = *(const u32x4*)(kg_ + (tid_ + 512) * 16); v_ = *(const u32x4*)(vg_ + tid_ * 16); } while (0)
#define ATT_WRITE(k0_, k1_, v_, bo) do { *(LAS u32x4*)(sm + (bo) + koff0) = k0_; if (tid_ < 256) *(LAS u32x4*)(sm + (bo) + koff1) = k1_; *(LAS u32x4*)(sm + (bo) + voff) = v_; } while (0)
        ka1 = (u32x4){0u, 0u, 0u, 0u}; kb1 = ka1;
        const int npair = ntile >> 1;
        ATT_LOAD(ka0, ka1, va, 0); ATT_LOAD(kb0, kb1, vb, 1);
        __syncthreads();
        ATT_WRITE(ka0, ka1, va, 0); ATT_WRITE(kb0, kb1, vb, BUF_A);
        if (npair > 1) { ATT_LOAD(ka0, ka1, va, 2); ATT_LOAD(kb0, kb1, vb, 3); }
        __syncthreads();
        f32x16 a0, a1, b0, b1;
#pragma unroll
        for (int r = 0; r < 16; ++r) { a0[r] = 0.f; a1[r] = 0.f; }
        { const LAS char* kq0 = sm + r32 * KP_A + 16 * hi;
#pragma unroll
          for (int st = 0; st < 6; ++st) { const bf16x8 k0 = *(const LAS bf16x8*)(kq0 + 32 * st), k1 = *(const LAS bf16x8*)(kq0 + 32 * KP_A + 32 * st);
              a0 = __builtin_amdgcn_mfma_f32_32x32x16_bf16(k0, qf[st], a0, 0, 0, 0); a1 = __builtin_amdgcn_mfma_f32_32x32x16_bf16(k1, qf[st], a1, 0, 0, 0); } }
        float tmA = att_max(a0, a1);
        int cur = 0;
        for (int p = 0; p < npair; ++p) {
            const int nxt = cur == 4 * BUF_A ? 0 : cur + 2 * BUF_A;
            const bool more = p + 1 < npair;
            if (more) { ATT_WRITE(ka0, ka1, va, nxt); ATT_WRITE(kb0, kb1, vb, nxt + BUF_A); }
            if (p + 2 < npair) { ATT_LOAD(ka0, ka1, va, 2 * p + 4); ATT_LOAD(kb0, kb1, vb, 2 * p + 5); }
            bf16x8 pf[4];
            att_shift(tmA, p == 0, mrun, lsum, o0, o1);
            att_qk_exp(sm + cur + BUF_A + r32 * KP_A + 16 * hi, qf, -mrun, b0, b1, a0, a1, lsum, pf);
            const float tmB = att_pv_max(o0, o1, sm + cur + vrd, pf, b0, b1);
            att_shift(tmB, false, mrun, lsum, o0, o1);
            __syncthreads();
            if (more) {
                att_qk_exp(sm + nxt + r32 * KP_A + 16 * hi, qf, -mrun, a0, a1, b0, b1, lsum, pf);
                tmA = att_pv_max(o0, o1, sm + cur + BUF_A + vrd, pf, a0, a1);
            } else {
                att_exp_pack(b0, b1, -mrun, lsum, pf);
                pv_tile(o0, o1, sm + cur + BUF_A + vrd, pf);
            }
            cur = nxt;
        }
#undef ATT_LOAD
#undef ATT_WRITE
        lsum += __shfl_xor(lsum, 32);
        const float inv = 1.f / lsum;
        const int b = bh >> 2, h = bh & 3;
        const int row = (lat ? b * 2048 + qb * 256 : RL + b * 256) + wid * 32 + r32;
        bf16_t* op = Z + (size_t)row * ZW + C_QC + h * 64 + 8 * hi;
        u32x2 w0[4], w1[4];
#pragma unroll
        for (int g = 0; g < 4; ++g) {
            w0[g].x = pk2n(o0[4 * g] * inv, o0[4 * g + 1] * inv); w0[g].y = pk2n(o0[4 * g + 2] * inv, o0[4 * g + 3] * inv);
            w1[g].x = pk2n(o1[4 * g] * inv, o1[4 * g + 1] * inv); w1[g].y = pk2n(o1[4 * g + 2] * inv, o1[4 * g + 3] * inv); }
#pragma unroll
        for (int g = 0; g < 4; g += 2) {
            auto rx = __builtin_amdgcn_permlane32_swap(w0[g].x, w0[g + 1].x, false, false), ry = __builtin_amdgcn_permlane32_swap(w0[g].y, w0[g + 1].y, false, false);
            *(u32x4*)(op + 8 * g) = (u32x4){(unsigned)rx[0], (unsigned)ry[0], (unsigned)rx[1], (unsigned)ry[1]};
            auto sx = __builtin_amdgcn_permlane32_swap(w1[g].x, w1[g + 1].x, false, false), sy = __builtin_amdgcn_permlane32_swap(w1[g].y, w1[g + 1].y, false, false);
            *(u32x4*)(op + 32 + 8 * g) = (u32x4){(unsigned)sx[0], (unsigned)sy[0], (unsigned)sx[1], (unsigned)sy[1]};
        }
    }
    __syncthreads();
}

__device__ __forceinline__ void ret_tile(const LAS char* sm, int r32, int hi, int vrd, int buf, int kp0, int qw0, int qpos, float lgf, float lgb, float cf32, float cb32,
                                         const float (&ckf)[16], const float (&ckb)[16], const bf16x8 (&qf)[4], fa::f32x16& o0, fa::f32x16& o1) {
    using namespace fa;
    const LAS char* kb = sm + buf + r32 * KP_R + 16 * hi;
    f32x16 p0, p1;
#pragma unroll
    for (int r = 0; r < 16; ++r) { p0[r] = 0.f; p1[r] = 0.f; }
#pragma unroll
    for (int st = 0; st < 4; ++st) {
        const bf16x8 k0 = *(const LAS bf16x8*)(kb + 32 * st), k1 = *(const LAS bf16x8*)(kb + 32 * KP_R + 32 * st);
        p0 = __builtin_amdgcn_mfma_f32_32x32x16_bf16(k0, qf[st], p0, 0, 0, 0);
        p1 = __builtin_amdgcn_mfma_f32_32x32x16_bf16(k1, qf[st], p1, 0, 0, 0);
    }
    if (kp0 + 63 < qw0) {
        const float sq = __builtin_amdgcn_exp2f(lgf * (float)(qpos - kp0)), sq1 = sq * cf32;
#pragma unroll
        for (int r = 0; r < 16; ++r) { p0[r] = p0[r] * ckf[r] * sq; p1[r] = p1[r] * ckf[r] * sq1; }
    } else if (kp0 > qw0 + 31) {
        const float sq = __builtin_amdgcn_exp2f(lgb * (float)(kp0 - qpos)), sq1 = sq * cb32;
#pragma unroll
        for (int r = 0; r < 16; ++r) { p0[r] = p0[r] * ckb[r] * sq; p1[r] = p1[r] * ckb[r] * sq1; }
    } else {
        const int d0 = qpos - kp0 - 4 * hi;
#pragma unroll
        for (int r = 0; r < 16; ++r) {
            const float f0 = (float)(d0 - ((r & 3) + 8 * (r >> 2))), f1 = f0 - 32.f;
            const float w0 = __builtin_amdgcn_exp2f(lgf * fmaxf(f0, 0.f) + lgb * fmaxf(-f0, 0.f)) * (2.f - fminf(fabsf(f0), 1.f));
            const float w1 = __builtin_amdgcn_exp2f(lgf * fmaxf(f1, 0.f) + lgb * fmaxf(-f1, 0.f)) * (2.f - fminf(fabsf(f1), 1.f));
            p0[r] *= w0; p1[r] *= w1;
        }
    }
    bf16x8 pf[4]; pf[0] = pack_p(p0, 0); pf[1] = pack_p(p0, 8); pf[2] = pack_p(p1, 0); pf[3] = pack_p(p1, 8);
    pv_tile(o0, o1, sm + buf + vrd, pf);
}
__device__ __forceinline__ void ret_qk(const LAS char* sm, int r32, int hi, int buf, const bf16x8 (&qf)[4], fa::f32x16& p0, fa::f32x16& p1) {
    const LAS char* kb = sm + buf + r32 * fa::KP_R + 16 * hi;
#pragma unroll
    for (int r = 0; r < 16; ++r) { p0[r] = 0.f; p1[r] = 0.f; }
#pragma unroll
    for (int st = 0; st < 4; ++st) {
        const bf16x8 k0 = *(const LAS bf16x8*)(kb + 32 * st), k1 = *(const LAS bf16x8*)(kb + 32 * fa::KP_R + 32 * st);
        p0 = __builtin_amdgcn_mfma_f32_32x32x16_bf16(k0, qf[st], p0, 0, 0, 0);
        p1 = __builtin_amdgcn_mfma_f32_32x32x16_bf16(k1, qf[st], p1, 0, 0, 0);
    }
}
__device__ __forceinline__ void ret_tile_gen(const LAS char* sm, int r32, int hi, int vrd, int buf, int kp0, int qpos, float lgf, float lgb, const bf16x8 (&qf)[4], fa::f32x16& o0, fa::f32x16& o1) {
    using namespace fa;
    const LAS char* kb = sm + buf + r32 * KP_R + 16 * hi;
    f32x16 p0, p1;
#pragma unroll
    for (int r = 0; r < 16; ++r) { p0[r] = 0.f; p1[r] = 0.f; }
#pragma unroll
    for (int st = 0; st < 4; ++st) {
        const bf16x8 k0 = *(const LAS bf16x8*)(kb + 32 * st), k1 = *(const LAS bf16x8*)(kb + 32 * KP_R + 32 * st);
        p0 = __builtin_amdgcn_mfma_f32_32x32x16_bf16(k0, qf[st], p0, 0, 0, 0);
        p1 = __builtin_amdgcn_mfma_f32_32x32x16_bf16(k1, qf[st], p1, 0, 0, 0);
    }
    int d0 = qpos - kp0 - 4 * hi;
    asm volatile("" : "+v"(d0) : "v"(p0[15]), "v"(p1[15]));
#pragma unroll
    for (int r = 0; r < 16; ++r) {
        const float f0 = (float)(d0 - ((r & 3) + 8 * (r >> 2))), f1 = f0 - 32.f;
        const float w0 = __builtin_amdgcn_exp2f(lgf * fmaxf(f0, 0.f) + lgb * fmaxf(-f0, 0.f)) * (2.f - fminf(fabsf(f0), 1.f));
        const float w1 = __builtin_amdgcn_exp2f(lgf * fmaxf(f1, 0.f) + lgb * fmaxf(-f1, 0.f)) * (2.f - fminf(fabsf(f1), 1.f));
        p0[r] *= w0; p1[r] *= w1;
    }
    bf16x8 pf[4]; pf[0] = pack_p(p0, 0); pf[1] = pack_p(p0, 8); pf[2] = pack_p(p1, 0); pf[3] = pack_p(p1, 8);
    pv_tile(o0, o1, sm + buf + vrd, pf);
}
__device__ __forceinline__ void ph_ret_kv(unsigned char* lds_, const bf16_t* Z, const float* decay_logit, bf16_t* KVF, bf16_t* KVB, int vb, int vg) { PH_IDS;
    using namespace fa;
    LAS char* sm = (LAS char*)lds_;
    const int lane = tid_ & 63, wid = __builtin_amdgcn_readfirstlane(tid_ >> 6), r32 = lane & 31, hi = lane >> 5;
    const int vrd = ((lane >> 4) & 1) * 32 + (lane & 3) * 8 + (4 * hi + ((lane & 15) >> 2)) * 64;
    u32x4 pk[2], pv[2];
#define KV_ISSUE(uu) do { const int bh_ = (uu) / 18, ci_ = (uu) % 18, b_ = bh_ >> 2, h_ = bh_ & 3; const int r0_ = ci_ < 2 ? RL + b_ * 256 + 128 * ci_ : b_ * 2048 + 128 * (ci_ - 2); \
        _Pragma("unroll") for (int i = 0; i < 2; ++i) { const int p = tid_ + NT * i; const bf16_t* zr = Z + (size_t)(r0_ + (p >> 3)) * ZW + h_ * 64 + (p & 7) * 8; pk[i] = *(const u32x4*)(zr + C_RK); pv[i] = *(const u32x4*)(zr + C_RV); } } while (0)
    if (vb >= 0 && vb < 32 * 18) KV_ISSUE(vb);
    for (int u = vb >= 0 ? vb : 32 * 18; u < 32 * 18; u += vg) {
        const int bh = u / 18, h = bh & 3;
        const float lgf = -log1pf(__expf(-decay_logit[h])) * 1.4426950408889634f, lgb = -log1pf(__expf(-decay_logit[4 + h])) * 1.4426950408889634f;
        __syncthreads();
#pragma unroll
        for (int i = 0; i < 2; ++i) {
            const int p = tid_ + NT * i, row = p >> 3, c = p & 7, tile = row >> 6, key = row & 63;
            const int off = tile * 8192 + (c >> 2) * 4096 + key * 64 + (c & 3) * 16;
            *(LAS u32x4*)(sm + off) = pk[i];
            f32x4 va, vb; unpack8(pv[i], va, vb);
            const float wf = __builtin_amdgcn_exp2f(lgf * (float)(127 - row)), wb = __builtin_amdgcn_exp2f(lgb * (float)row);
            *(LAS u32x4*)(sm + 16384 + off) = pack8(va * wf, vb * wf);
            *(LAS u32x4*)(sm + 32768 + off) = pack8(va * wb, vb * wb);
        }
        if (u + vg < 32 * 18) KV_ISSUE(u + vg);
        __syncthreads();
        const int dir = wid >> 2, bd = (wid >> 1) & 1, be = wid & 1;
        f32x16 acc;
#pragma unroll
        for (int r = 0; r < 16; ++r) acc[r] = 0.f;
        const LAS char* ka = sm + bd * 4096 + vrd; const LAS char* vv = sm + 16384 + dir * 16384 + be * 4096 + vrd;
#pragma unroll
        for (int tile = 0; tile < 2; ++tile)
#pragma unroll
            for (int ks = 0; ks < 4; ++ks) {
                const s16x4 a0 = vtr(ka + tile * 8192 + ks * 1024), a1 = vtr(ka + tile * 8192 + ks * 1024 + 512), b0 = vtr(vv + tile * 8192 + ks * 1024), b1 = vtr(vv + tile * 8192 + ks * 1024 + 512);
                acc = __builtin_amdgcn_mfma_f32_32x32x16_bf16((bf16x8){a0[0], a0[1], a0[2], a0[3], a1[0], a1[1], a1[2], a1[3]}, (bf16x8){b0[0], b0[1], b0[2], b0[3], b1[0], b1[1], b1[2], b1[3]}, acc, 0, 0, 0);
            }
        bf16_t* o = (dir ? KVB : KVF) + ((size_t)u * 64 + be * 32 + r32) * 64 + bd * 32 + 4 * hi;
#pragma unroll
        for (int g = 0; g < 4; ++g) { u32x2 w; w.x = pk2n(acc[4 * g], acc[4 * g + 1]); w.y = pk2n(acc[4 * g + 2], acc[4 * g + 3]); *(u32x2*)(o + 8 * g) = w; }
    }
    __syncthreads();
}
#undef KV_ISSUE
__device__ __forceinline__ void ph_ret_chunk(unsigned char* lds_, bf16_t* Z, const bf16_t* KVF, const bf16_t* KVB, const float* decay_logit, const float* gn_w, int with_ctx, int u0, int ustep, unsigned* kvc, unsigned* barw) { PH_IDS;
    using namespace fa;
    LAS char* sm = (LAS char*)lds_;
    constexpr int ST_OFF = 4 * BUF_R, ST_SZ = 64 * KP_R;
    const int lane = tid_ & 63, wid = __builtin_amdgcn_readfirstlane(tid_ >> 6), r32 = lane & 31, hi = lane >> 5;
    const int nunits = 256 + (with_ctx ? 32 : 0);
    const int prow = tid_ >> 3, pc = tid_ & 7;
    const int koff = prow * KP_R + pc * 16;
    const int voff = KT_R + (pc >> 2) * 4096 + prow * 64 + (pc & 3) * 16;
    const int vrd = KT_R + ((lane >> 4) & 1) * 32 + (lane & 3) * 8 + (4 * hi + ((lane & 15) >> 2)) * 64;
    for (int u = u0; u < nunits; u += ustep) {
        const bool lat = u < 256; const int bh = lat ? (u >> 3) : (u - 256), qb = lat ? (u & 7) : 0, b = bh >> 2, h = bh & 3;
        const float lgf = -log1pf(__expf(-decay_logit[h])) * 1.4426950408889634f, lgb = -log1pf(__expf(-decay_logit[4 + h])) * 1.4426950408889634f;
        const int qw0 = qb * 256 + wid * 32, qpos = qw0 + r32;
        const int qrow = (lat ? b * 2048 : RL + b * 256) + qpos;
        bf16_t* zq = Z + (size_t)qrow * ZW;
        u32x4 sK[4], sV[4]; bf16x8 qf[4];
        { const size_t rb = (lat ? (size_t)b * 2048 + qb * 256 : (size_t)RL + b * 256);
#pragma unroll
          for (int j = 0; j < 4; ++j) { const bf16_t* zr = Z + (rb + 64 * j + prow) * ZW + h * 64 + pc * 8; sK[j] = *(const u32x4*)(zr + C_RK); sV[j] = *(const u32x4*)(zr + C_RV); } }
#pragma unroll
        for (int st = 0; st < 4; ++st) qf[st] = *(const bf16x8*)(zq + C_RQ + h * 64 + 16 * st + 8 * hi);
        if (kvc != nullptr && tid_ == 0) dep_spin(kvc, (unsigned)G_, barw);
        __syncthreads();
#pragma unroll
        for (int j = 0; j < 4; ++j) { *(LAS u32x4*)(sm + j * BUF_R + koff) = sK[j]; *(LAS u32x4*)(sm + j * BUF_R + voff) = sV[j]; }
        {
            const float g128f = __builtin_amdgcn_exp2f(lgf * 128.f), g128b = __builtin_amdgcn_exp2f(lgb * 128.f);
            const bf16_t* kf = KVF + (size_t)bh * 18 * 4096 + tid_ * 8; const bf16_t* kb = KVB + (size_t)bh * 18 * 4096 + tid_ * 8;
            LAS char* sto = sm + ST_OFF + (tid_ >> 3) * KP_R + (tid_ & 7) * 16;
            f32x4 sa = (f32x4){0.f, 0.f, 0.f, 0.f}, sb = sa, ta, tb;
#define ST_PUT(k) (*(LAS u32x4*)(sto + (k) * ST_SZ) = pack8(sa, sb))
#define ST_STEP(ptr, ci_, g_) do { unpack8(*(const u32x4*)((ptr) + (size_t)(ci_) * 4096), ta, tb); sa = sa * (g_) + ta; sb = sb * (g_) + tb; } while (0)
            if (lat) {
                const int cA = 2 * qb, n1 = 2 + cA, nb = 16 - cA;
                u32x4 Lq[9], Lr[9]; f32x4 sc = (f32x4){0.f, 0.f, 0.f, 0.f}, sd = sc;
#define ST_PUTB(k) (*(LAS u32x4*)(sto + (k) * ST_SZ) = pack8(sc, sd))
#pragma unroll
                for (int hf = 0; hf < 2; ++hf) {
#pragma unroll
                    for (int k = 0; k < 9; ++k) { const int kk = 9 * hf + k;
                        if (kk <= n1 && kk < 17) Lq[k] = *(const u32x4*)(kf + (size_t)kk * 4096);
                        if (kk <= nb && kk < 17) Lr[k] = *(const u32x4*)(kb + (size_t)(kk == 0 ? 1 : (kk == 1 ? 0 : 19 - kk)) * 4096); }
#pragma unroll
                    for (int k = 0; k < 9; ++k) { const int kk = 9 * hf + k;
                        if (kk == n1) ST_PUT(0); if (kk <= n1 && kk < 17) { unpack8(Lq[k], ta, tb); sa = sa * g128f + ta; sb = sb * g128f + tb; }
                        if (kk == nb) ST_PUTB(3); if (kk <= nb && kk < 17) { unpack8(Lr[k], ta, tb); sc = sc * g128b + ta; sd = sd * g128b + tb; } }
                    asm volatile("" ::: "memory"); }
                ST_PUT(1); ST_PUTB(2);
#undef ST_PUTB
            } else {
                ST_PUT(0); ST_PUT(3);
                ST_STEP(kf, 0, g128f); ST_PUT(1);
                sa = (f32x4){0.f, 0.f, 0.f, 0.f}; sb = sa; ST_STEP(kb, 1, g128b); ST_PUT(2);
            }
#undef ST_PUT
#undef ST_STEP
        }
        __syncthreads();
        u32x2 gtv[8]; f32x4 gwv[8];
#pragma unroll
        for (int g = 0; g < 4; ++g)
#pragma unroll
            for (int blk = 0; blk < 2; ++blk) { const int d = blk * 32 + 8 * g + 4 * hi; gtv[2 * g + blk] = *(const u32x2*)(zq + C_RG + h * 64 + d); gwv[2 * g + blk] = *(const f32x4*)(gn_w + h * 64 + d); }
        f32x16 o0, o1;
#pragma unroll
        for (int r = 0; r < 16; ++r) { o0[r] = 0.f; o1[r] = 0.f; }
        const int cl = wid >> 2, c0 = qb * 256 + 128 * cl;
        ret_tile_gen(sm, r32, hi, vrd, (2 * cl) * BUF_R, c0, qpos, lgf, lgb, qf, o0, o1);
        __builtin_amdgcn_sched_barrier(0);
        ret_tile_gen(sm, r32, hi, vrd, (2 * cl + 1) * BUF_R, c0 + 64, qpos, lgf, lgb, qf, o0, o1);
        __builtin_amdgcn_sched_barrier(0);
        { f32x16 p0, p1;
          ret_qk(sm, r32, hi, ST_OFF + cl * ST_SZ, qf, p0, p1);
          const float sf = __builtin_amdgcn_exp2f(lgf * (float)(qpos - c0 + 1));
#pragma unroll
          for (int r = 0; r < 16; ++r) { o0[r] += p0[r] * sf; o1[r] += p1[r] * sf; }
          ret_qk(sm, r32, hi, ST_OFF + (2 + cl) * ST_SZ, qf, p0, p1);
          const float sbk = __builtin_amdgcn_exp2f(lgb * (float)(c0 + 128 - qpos));
#pragma unroll
          for (int r = 0; r < 16; ++r) { o0[r] += p0[r] * sbk; o1[r] += p1[r] * sbk; } }
        float s1 = 0.f;
#pragma unroll
        for (int r = 0; r < 16; ++r) s1 += o0[r] + o1[r];
        s1 += __shfl_xor(s1, 32);
        const float mu = s1 * (1.f / 64);
        float s2 = 0.f;
#pragma unroll
        for (int r = 0; r < 16; ++r) { const float a = o0[r] - mu, c = o1[r] - mu; s2 += a * a + c * c; }
        s2 += __shfl_xor(s2, 32);
        const float rstd = rsqrtf(s2 * (1.f / 64) + EPS);
        u32x2 wv[2][4];
#pragma unroll
        for (int g = 0; g < 4; ++g)
#pragma unroll
            for (int blk = 0; blk < 2; ++blk) {
                const int d = blk * 32 + 8 * g + 4 * hi;
                const u32x2 gt = gtv[2 * g + blk];
                const f32x4 gw = gwv[2 * g + blk];
                float y[4];
#pragma unroll
                for (int q = 0; q < 4; ++q) { const float ov = blk ? o1[4 * g + q] : o0[4 * g + q]; const unsigned gb = q < 2 ? gt.x : gt.y; const float gv = __uint_as_float((q & 1) ? (gb & 0xffff0000u) : (gb << 16));
                    y[q] = siluf_(gv) * ((ov - mu) * rstd * gw[q]); }
                wv[blk][g].x = pk2n(y[0], y[1]); wv[blk][g].y = pk2n(y[2], y[3]);
            }
#pragma unroll
        for (int blk = 0; blk < 2; ++blk)
#pragma unroll
            for (int g = 0; g < 4; g += 2) {
                auto rx = __builtin_amdgcn_permlane32_swap(wv[blk][g].x, wv[blk][g + 1].x, false, false), ry = __builtin_amdgcn_permlane32_swap(wv[blk][g].y, wv[blk][g + 1].y, false, false);
                *(u32x4*)(zq + C_RQ + h * 64 + blk * 32 + 8 * g + 8 * hi) = (u32x4){(unsigned)rx[0], (unsigned)ry[0], (unsigned)rx[1], (unsigned)ry[1]};
            }
    }
    __syncthreads();
}

__device__ __forceinline__ void ph_ret_mfma(unsigned char* lds_, bf16_t* Z, const float* decay_logit, const float* gn_w, int with_ctx, int u0, int ustep) { PH_IDS;
    using namespace fa;
    LAS char* sm = (LAS char*)lds_;
    const int lane = tid_ & 63, wid = __builtin_amdgcn_readfirstlane(tid_ >> 6), r32 = lane & 31, hi = lane >> 5;
    const int nunits = 256 + (with_ctx ? 32 : 0);
    const int prow = tid_ >> 3, pc = tid_ & 7;
    const int koff = prow * KP_R + pc * 16;
    const int voff = KT_R + (pc >> 2) * 4096 + prow * 64 + (pc & 3) * 16;
    const int vrd = KT_R + ((lane >> 4) & 1) * 32 + (lane & 3) * 8 + (4 * hi + ((lane & 15) >> 2)) * 64;
    for (int u = u0; u < nunits; u += ustep) {
        const bool lat = u < 256; const int bh = lat ? (u >> 3) : (u - 256), qb = lat ? (u & 7) : 0, b = bh >> 2, h = bh & 3;
        const int ntile = lat ? 40 : 4;
        const float lgf = -log1pf(__expf(-decay_logit[h])) * 1.4426950408889634f, lgb = -log1pf(__expf(-decay_logit[4 + h])) * 1.4426950408889634f;
        const int qw0 = qb * 256 + wid * 32, qpos = qw0 + r32;
        const int qrow = (lat ? b * 2048 : RL + b * 256) + qpos;
        float ckf[16], ckb[16];
#pragma unroll
        for (int r = 0; r < 16; ++r) { const float off = (float)crow(r, hi); ckf[r] = __builtin_amdgcn_exp2f(-lgf * off); ckb[r] = __builtin_amdgcn_exp2f(lgb * off); }
        const float cf32 = __builtin_amdgcn_exp2f(-lgf * 32.f), cb32 = __builtin_amdgcn_exp2f(lgb * 32.f);
        bf16_t* zq = Z + (size_t)qrow * ZW;
        bf16x8 qf[4];
#pragma unroll
        for (int st = 0; st < 4; ++st) qf[st] = *(const bf16x8*)(zq + C_RQ + h * 64 + 16 * st + 8 * hi);
        f32x16 o0, o1;
#pragma unroll
        for (int r = 0; r < 16; ++r) { o0[r] = 0.f; o1[r] = 0.f; }
        const int ctx0 = RL + b * 256, lat0 = b * 2048;
#define RET_TILE_ROW(t) (lat ? ((t) < 4 ? ctx0 + 64 * (t) : ((t) < 36 ? lat0 + 64 * ((t) - 4) : ctx0 + 64 * ((t) - 36))) : ctx0 + 64 * (t))
#define RET_TILE_POS(t) (lat ? 64 * (t) - 256 : 64 * (t))
        u32x4 ka, va, kb2, vb2;
#define RET_LOAD(k_, v_, tt) do { const bf16_t* zr_ = Z + (size_t)(RET_TILE_ROW(tt) + prow) * ZW + h * 64 + pc * 8; k_ = *(const u32x4*)(zr_ + C_RK); v_ = *(const u32x4*)(zr_ + C_RV); } while (0)
#define RET_WRITE(k_, v_, bo) do { *(LAS u32x4*)(sm + (bo) + koff) = k_; *(LAS u32x4*)(sm + (bo) + voff) = v_; } while (0)
        RET_LOAD(ka, va, 0); RET_LOAD(kb2, vb2, 1);
        __syncthreads();
        RET_WRITE(ka, va, 0); RET_WRITE(kb2, vb2, BUF_R);
        __syncthreads();
        for (int t = 0; t < ntile; t += 2) {
            const int pb = (t & 2) * BUF_R, nb = 2 * BUF_R - pb;
            if (t + 2 < ntile) { RET_LOAD(ka, va, t + 2); RET_LOAD(kb2, vb2, t + 3); }
            ret_tile(sm, r32, hi, vrd, pb, RET_TILE_POS(t), qw0, qpos, lgf, lgb, cf32, cb32, ckf, ckb, qf, o0, o1);
            ret_tile(sm, r32, hi, vrd, pb + BUF_R, RET_TILE_POS(t + 1), qw0, qpos, lgf, lgb, cf32, cb32, ckf, ckb, qf, o0, o1);
            if (t + 2 < ntile) { RET_WRITE(ka, va, nb); RET_WRITE(kb2, vb2, nb + BUF_R); }
            __syncthreads();
        }
#undef RET_LOAD
#undef RET_WRITE
#undef RET_TILE_ROW
#undef RET_TILE_POS
        float s1 = 0.f;
#pragma unroll
        for (int r = 0; r < 16; ++r) s1 += o0[r] + o1[r];
        s1 += __shfl_xor(s1, 32);
        const float mu = s1 * (1.f / 64);
        float s2 = 0.f;
#pragma unroll
        for (int r = 0; r < 16; ++r) { const float a = o0[r] - mu, c = o1[r] - mu; s2 += a * a + c * c; }
        s2 += __shfl_xor(s2, 32);
        const float rstd = rsqrtf(s2 * (1.f / 64) + EPS);
#pragma unroll
        for (int g = 0; g < 4; ++g)
#pragma unroll
            for (int blk = 0; blk < 2; ++blk) {
                const int d = blk * 32 + 8 * g + 4 * hi;
                const u32x2 gt = *(const u32x2*)(zq + C_RG + h * 64 + d);
                const f32x4 gw = *(const f32x4*)(gn_w + h * 64 + d);
                float y[4];
#pragma unroll
                for (int q = 0; q < 4; ++q) { const float ov = blk ? o1[4 * g + q] : o0[4 * g + q]; const unsigned gb = q < 2 ? gt.x : gt.y; const float gv = __uint_as_float((q & 1) ? (gb & 0xffff0000u) : (gb << 16));
                    y[q] = siluf_(gv) * ((ov - mu) * rstd * gw[q]); }
                u32x2 w; w.x = pk2(y[0], y[1]); w.y = pk2(y[2], y[3]);
                *(u32x2*)(zq + C_RQ + h * 64 + d) = w;
            }
    }
    __syncthreads();
}

struct SchedGrid {
    const char* A; const char* B; unsigned lda, ldb; int nt, nM, nN, G, c, kind, aux;
    __device__ __forceinline__ bool next(int i, pg8::Unit& u) const {
        int pm, pn; if (!pg8::static_tile(nM, nN, G, c, i, pm, pn)) return false;
        u.A = A + (size_t)pm * 256 * lda; u.B = B + (size_t)pn * 256 * ldb; u.lda = lda; u.ldb = ldb; u.nt = nt; u.pm = pm; u.pn = pn; u.kind = kind; u.aux = aux; return true; }
};
struct SchedDep {
    const char* A; const char* B; unsigned lda, ldb; int nt, nM, nN, G, c, mode; unsigned* dep; unsigned* barw; mutable int okpm;
    __device__ __forceinline__ bool next(int i, pg8::Unit& u) const {
        int pm, pn;
        if (mode == 0) { if (!pg8::static_tile(nM, nN, G, c, i, pm, pn)) return false; }
        else { const int x = c & 7, j = c >> 3;
            if (mode == 1) { if (i > 1 || (i == 1 && j >= 4)) return false; const int o = 32 * i + j; pm = 9 * x + (o >> 2); pn = o & 3; }
            else { if (i < 4) { pm = 9 * x + (j & 7); pn = 4 * i + (j >> 3); } else if (i == 4 && j >= 4 && j < 20) { pm = 9 * x + 8; pn = j - 4; } else return false;
                if (pm != okpm) { if (threadIdx.x == 0) dep_spin(dep + pm, 4u, barw); __syncthreads(); okpm = pm; } } }
        u.A = A + (size_t)pm * 256 * lda; u.B = B + (size_t)pn * 256 * ldb; u.lda = lda; u.ldb = ldb; u.nt = nt; u.pm = pm; u.pn = pn; u.kind = 0; u.aux = 0; return true; }
};
struct SchedGluDyn { static constexpr bool DEP = false;
    const char* A; const char* B; unsigned* ctr; volatile LAS int* slot; int nunits;
    __device__ __forceinline__ bool next(int, pg8::Unit& u) const {
        if (threadIdx.x == 0) slot[0] = (int)atomicAdd(ctr, 1u);
        __syncthreads();
        const int q = __builtin_amdgcn_readfirstlane(slot[0]);
        if (q >= nunits) return false;
        const int pm = q >> 1, pn = q & 1;
        u.A = A + (size_t)pm * 256 * (ZW * 2); u.B = B + (size_t)pn * 256 * 512; u.lda = ZW * 2; u.ldb = 512; u.nt = 4; u.pm = pm; u.pn = pn; u.kind = 0; u.aux = 0; return true; }
};
struct SchedP1 {
    const char* A; const char* B; int G, c, last;
    __device__ __forceinline__ bool next(int i, pg8::Unit& u) const {
        int pm, pn;
        if (!last) { if (!pg8::static_tile(RT / 256, 8, G, c, i, pm, pn)) return false; }
        else { if (!pg8::static_tile(RL / 256, 8, G, c, i, pm, pn)) { const int j = i * G + c - (RL / 256) * 8; if (j < 0 || j >= 32) return false; pm = RL / 256 + (j >> 2); pn = j & 3; } }
        u.A = A + (size_t)pm * 256 * 2048; u.B = B + (size_t)pn * 256 * 2048; u.lda = 2048; u.ldb = 2048; u.nt = 16; u.pm = pm; u.pn = pn; u.kind = 0; u.aux = 0; return true; }
};
struct SchedMerge {
    const char* Z; const char* XN; const char* WBR; const char* WING; const char* OC; int njobs, G, vcu, nmini;
    __device__ __forceinline__ bool next(int i, pg8::Unit& u) const {
        int sub, n, pm, pn, part = 0;
        if (nmini > 0 && i >= 8) { if (i >= 10 || vcu >= nmini) return false; sub = i & 1; n = vcu & 3; pn = (vcu >> 2) & 3; pm = RL / 256 + (vcu >> 4); part = 1; }
        else { const int job = (i >> 3) * G + vcu; if (job >= njobs) return false; sub = i & 7; n = sub >> 1; pm = job >> 2; pn = job & 3; }
        u.pm = pm; u.pn = pn; u.aux = n;
        if (!(sub & 1)) { const int bcol = n == 0 ? C_QC : (n == 1 ? C_FU : C_RQ);
            if (n == 2) { u.A = OC + (size_t)pm * 256 * 512; u.lda = 512; } else { u.A = Z + ((size_t)pm * 256 * ZW + bcol) * 2; u.lda = ZW * 2; } u.B = WBR + ((size_t)n * 1024 + pn * 256) * 512; u.ldb = 512; u.nt = 4; u.kind = 0; }
        else { u.A = XN + (size_t)pm * 256 * 2048; u.lda = 2048; u.B = WING + ((size_t)n * 1024 + pn * 256) * 2048; u.ldb = 2048; u.nt = 16; u.kind = part ? 2 : 1; }
        return true; }
};
struct SchedFfnDown {
    const char* H; const char* W2; int G, c, nctx;
    __device__ __forceinline__ bool next(int i, pg8::Unit& u) const {
        int pm, pn;
        if (pg8::static_tile(RL / 256, 4, G, c, i, pm, pn)) { u.A = H + (size_t)pm * 256 * 8192; u.B = W2 + (size_t)pn * 256 * 8192; u.lda = 8192; u.ldb = 8192; u.nt = 64; u.pm = pm; u.pn = pn; u.kind = 0; u.aux = 0; return true; }
        const int j = i * G + c - (RL / 256) * 4; if (j < 0 || j >= nctx) return false;
        pm = RL / 256 + (j >> 4); pn = (j >> 2) & 3; const int kq = j & 3;
        u.A = H + (size_t)pm * 256 * 8192 + kq * 2048; u.B = W2 + (size_t)pn * 256 * 8192 + kq * 2048; u.lda = 8192; u.ldb = 8192; u.nt = 16; u.pm = pm; u.pn = pn; u.kind = 3; u.aux = kq; return true; }
};
#define EPI_FOREACH(...) _Pragma("unroll") for (int ai = 0; ai < 2; ++ai) _Pragma("unroll") for (int m = 0; m < 4; ++m) _Pragma("unroll") for (int bj = 0; bj < 2; ++bj) { \
        const int row = u.pm * 256 + ai * 128 + wr * 64 + m * 16 + fr, col = u.pn * 256 + bj * 128 + wc * 32 + 8 * fq; const f32x4 v0 = acc[ai][bj][m][0], v1 = acc[ai][bj][m][1]; (void)row; (void)col; __VA_ARGS__ }
struct EpiStore { static constexpr bool PRE = false;
    bf16_t* O; int ld; int act;
    __device__ __forceinline__ void operator()(const f32x4 (&acc)[2][2][4][2], const pg8::Unit& u, int wr, int wc, int fr, int fq) const {
        EPI_FOREACH( f32x4 a = v0, b = v1; if (act == 1) { _Pragma("unroll") for (int q = 0; q < 4; ++q) { const float ra = fmaxf(a[q], 0.f), rb = fmaxf(b[q], 0.f); a[q] = ra * ra; b[q] = rb * rb; } }
            *(pg8::u32x4*)(O + (size_t)row * ld + col) = pack8(a, b); )
    }
};
struct EpiFfnUp {
    static constexpr bool PRE = true;
    bf16_t* O; const float* ss; const float* cf; LAS float* red;
    __device__ __forceinline__ void pre_issue(const pg8::Unit& u, int tid, f32x4& v) const {
        if (tid < 256) v = *(const f32x4*)(ss + ((size_t)u.pm * 256 + tid) * 4);
        else v[0] = cf[(size_t)(u.pm < 64 ? (u.pm >> 3) : 8) * DFF + u.pn * 256 + (tid - 256)]; }
    __device__ __forceinline__ void pre_commit(int tid, int par, const f32x4& v) const {
        red[par * 512 + tid] = tid < 256 ? rsqrtf((v[0] + v[1] + v[2] + v[3]) * (1.f / DM) + EPS) : v[0]; }
    __device__ __forceinline__ void operator()(const f32x4 (&acc)[2][2][4][2], const pg8::Unit& u, int wr, int wc, int fr, int fq, int par) const {
        const LAS float* rp = red + par * 512 + wr * 64 + fr; const LAS float* cp = rp - (wr * 64 + fr) + 256 + wc * 32 + 8 * fq;
        EPI_FOREACH( const f32x4 c0 = *(const LAS f32x4*)(cp + bj * 128), c1 = *(const LAS f32x4*)(cp + bj * 128 + 4); const float r = rp[ai * 128 + m * 16]; f32x4 a, b;
            _Pragma("unroll") for (int q = 0; q < 4; ++q) { const float ra = fmaxf(v0[q] * r + c0[q], 0.f), rb = fmaxf(v1[q] * r + c1[q], 0.f); a[q] = ra * ra; b[q] = rb * rb; }
            *(pg8::u32x4*)(O + (size_t)row * DFF + col) = pack8(a, b); )
    }
};
template <int T> __device__ __forceinline__ void ld8(const void* base, size_t o, f32x4& a, f32x4& b) {
    if constexpr (T == 0) { const float* p = (const float*)base + o; a = *(const f32x4*)p; b = *(const f32x4*)(p + 4); } else unpack8(*(const pg8::u32x4*)((const bf16_t*)base + o), a, b); }
template <int T> __device__ __forceinline__ void st8(void* base, size_t o, const f32x4 a, const f32x4 b) {
    if constexpr (T == 0) { float* p = (float*)base + o; *(f32x4*)p = a; *(f32x4*)(p + 4) = b; } else *(pg8::u32x4*)((bf16_t*)base + o) = pack8(a, b); }
template <int XIN, int XOUT>
struct EpiResid { static constexpr bool PRE = false;
    const void* xlat; const void* xctx; void* olat; void* octx; const float* mod; int gch; float* part;
    unsigned* dep;
    bf16_t* an; const float* wmf; float* ss; LAS float* red;
    __device__ __forceinline__ void operator()(const f32x4 (&acc)[2][2][4][2], const pg8::Unit& u, int wr, int wc, int fr, int fq) const {
        if (u.kind == 3) { float* pb = part + (size_t)u.aux * RC * DM - (size_t)RL * DM;
            EPI_FOREACH( const size_t o = (size_t)row * DM + col; *(f32x4*)(pb + o) = v0; *(f32x4*)(pb + o + 4) = v1; if (bj) asm volatile("" ::: "memory"); )
            return; }
        const bool lat = u.pm < 64; const void* xb = lat ? xlat : xctx; void* ob = lat ? olat : octx; const size_t rb = lat ? 0 : (size_t)RL * DM;
        const float* g = mod + (size_t)(lat ? (u.pm >> 3) : 8) * 6144 + gch * 1024;
        if constexpr (XIN == 1) {
            f32x4 G0[2], G1[2];
#pragma unroll
            for (int bj = 0; bj < 2; ++bj) { const int cb = u.pn * 256 + bj * 128 + wc * 32 + 8 * fq; G0[bj] = *(const f32x4*)(g + cb); G1[bj] = *(const f32x4*)(g + cb + 4); }
            if (an == nullptr) {
                pg8::u32x4 xr[16];
                EPI_FOREACH( xr[(ai * 4 + m) * 2 + bj] = *(const pg8::u32x4*)((const bf16_t*)xb + ((size_t)row * DM + col - rb)); )
                EPI_FOREACH( const size_t o = (size_t)row * DM + col - rb; f32x4 x0, x1; unpack8(xr[(ai * 4 + m) * 2 + bj], x0, x1); st8<XOUT>(ob, o, x0 + G0[bj] * v0, x1 + G1[bj] * v1); )
                return; }
            const float* wm = wmf + (size_t)(lat ? (u.pm >> 3) : 8) * 1024;
            f32x4 W0[2], W1[2];
#pragma unroll
            for (int bj = 0; bj < 2; ++bj) { const int cb = u.pn * 256 + bj * 128 + wc * 32 + 8 * fq; W0[bj] = *(const f32x4*)(wm + cb); W1[bj] = *(const f32x4*)(wm + cb + 4); }
#pragma unroll
            for (int ai = 0; ai < 2; ++ai) {
                pg8::u32x4 xr[8];
#pragma unroll
                for (int m = 0; m < 4; ++m)
#pragma unroll
                    for (int bj = 0; bj < 2; ++bj) { const int row = u.pm * 256 + ai * 128 + wr * 64 + m * 16 + fr, col = u.pn * 256 + bj * 128 + wc * 32 + 8 * fq; xr[m * 2 + bj] = *(const pg8::u32x4*)((const bf16_t*)xb + ((size_t)row * DM + col - rb)); }
                float sq = 0.f;
#pragma unroll
                for (int m = 0; m < 4; ++m)
#pragma unroll
                    for (int bj = 0; bj < 2; ++bj) {
                        const int row = u.pm * 256 + ai * 128 + wr * 64 + m * 16 + fr, col = u.pn * 256 + bj * 128 + wc * 32 + 8 * fq; const size_t o = (size_t)row * DM + col - rb;
                        const f32x4 v0 = acc[ai][bj][m][0], v1 = acc[ai][bj][m][1];
                        f32x4 x0, x1; unpack8(xr[m * 2 + bj], x0, x1); const f32x4 y0 = x0 + G0[bj] * v0, y1 = x1 + G1[bj] * v1; st8<XOUT>(ob, o, y0, y1);
                        *(pg8::u32x4*)(an + (size_t)row * DM + col) = pack8(y0 * W0[bj], y1 * W1[bj]);
                        sq += y0[0] * y0[0] + y0[1] * y0[1] + y0[2] * y0[2] + y0[3] * y0[3] + y1[0] * y1[0] + y1[1] * y1[1] + y1[2] * y1[2] + y1[3] * y1[3];
                        if (bj) { sq += __shfl_xor(sq, 16); sq += __shfl_xor(sq, 32); if (fq == 0) red[wc * 256 + ai * 128 + wr * 64 + m * 16 + fr] = sq; sq = 0.f; }
                    }
            }
            __syncthreads();
            { int t = threadIdx.x; asm volatile("" : "+v"(t)); if (t < 256) ss[((size_t)u.pm * 256 + t) * 4 + u.pn] = red[t] + red[256 + t] + red[512 + t] + red[768 + t]; }
            if (dep != nullptr) { asm volatile("s_waitcnt vmcnt(0)" ::: "memory"); __syncthreads();
                if (threadIdx.x == 0) { __builtin_amdgcn_fence(__ATOMIC_RELEASE, "agent"); asm volatile("s_waitcnt vmcnt(0)" ::: "memory"); (void)xb_add(dep + u.pm, 1u); } }
            return;
        }
        if (an == nullptr) {
        EPI_FOREACH( const f32x4 g0 = *(const f32x4*)(g + col), g1 = *(const f32x4*)(g + col + 4); const size_t o = (size_t)row * DM + col - rb;
            f32x4 x0, x1; ld8<XIN>(xb, o, x0, x1); st8<XOUT>(ob, o, x0 + g0 * v0, x1 + g1 * v1); if (bj) asm volatile("" ::: "memory"); )
        return; }
        const float* wm = wmf + (size_t)(lat ? (u.pm >> 3) : 8) * 1024;
        {
            f32x4 G0[2], G1[2], W0[2], W1[2];
#pragma unroll
            for (int bj = 0; bj < 2; ++bj) { const int cb = u.pn * 256 + bj * 128 + wc * 32 + 8 * fq; G0[bj] = *(const f32x4*)(g + cb); G1[bj] = *(const f32x4*)(g + cb + 4); W0[bj] = *(const f32x4*)(wm + cb); W1[bj] = *(const f32x4*)(wm + cb + 4); }
#pragma unroll
            for (int am = 0; am < 4; ++am) { const int ai = am >> 1, mh = am & 1;
                f32x4 xa[4], xc[4];
#pragma unroll
                for (int m2 = 0; m2 < 2; ++m2)
#pragma unroll
                    for (int bj = 0; bj < 2; ++bj) { const int m = 2 * mh + m2; const int row = u.pm * 256 + ai * 128 + wr * 64 + m * 16 + fr, col = u.pn * 256 + bj * 128 + wc * 32 + 8 * fq; ld8<XIN>(xb, (size_t)row * DM + col - rb, xa[m2 * 2 + bj], xc[m2 * 2 + bj]); }
                float sq = 0.f;
#pragma unroll
                for (int m2 = 0; m2 < 2; ++m2)
#pragma unroll
                    for (int bj = 0; bj < 2; ++bj) { const int m = 2 * mh + m2;
                        const int row = u.pm * 256 + ai * 128 + wr * 64 + m * 16 + fr, col = u.pn * 256 + bj * 128 + wc * 32 + 8 * fq; const size_t o = (size_t)row * DM + col - rb;
                        const f32x4 v0 = acc[ai][bj][m][0], v1 = acc[ai][bj][m][1];
                        const f32x4 y0 = xa[m2 * 2 + bj] + G0[bj] * v0, y1 = xc[m2 * 2 + bj] + G1[bj] * v1; st8<XOUT>(ob, o, y0, y1);
                        *(pg8::u32x4*)(an + (size_t)row * DM + col) = pack8(y0 * W0[bj], y1 * W1[bj]);
                        sq += y0[0] * y0[0] + y0[1] * y0[1] + y0[2] * y0[2] + y0[3] * y0[3] + y1[0] * y1[0] + y1[1] * y1[1] + y1[2] * y1[2] + y1[3] * y1[3];
                        if (bj) { sq += __shfl_xor(sq, 16); sq += __shfl_xor(sq, 32); if (fq == 0) red[wc * 256 + ai * 128 + wr * 64 + m * 16 + fr] = sq; sq = 0.f; }
                    }
            }
        }
        __syncthreads();
        { int t = threadIdx.x; asm volatile("" : "+v"(t)); if (t < 256) ss[((size_t)u.pm * 256 + t) * 4 + u.pn] = red[t] + red[256 + t] + red[512 + t] + red[768 + t]; }
        if (dep != nullptr) { asm volatile("s_waitcnt vmcnt(0)" ::: "memory"); __syncthreads();
            if (threadIdx.x == 0) { __builtin_amdgcn_fence(__ATOMIC_RELEASE, "agent"); asm volatile("s_waitcnt vmcnt(0)" ::: "memory"); (void)xb_add(dep + u.pm, 1u); } }
    }
};
struct EpiMerge { static constexpr bool PRE = false;
    pg8::u32x4* stash; bf16_t* MMp; bf16_t* PMp;
    __device__ __forceinline__ void operator()(const f32x4 (&acc)[2][2][4][2], const pg8::Unit& u, int wr, int wc, int fr, int fq) const {
        int tid = threadIdx.x; asm volatile("" : "+v"(tid));
        if (u.kind == 0) { EPI_FOREACH( stash[((ai * 4 + m) * 2 + bj) * NT + tid] = pack8(v0, v1); if (bj && (m & 1)) asm volatile("" ::: "memory"); ) }
        else { EPI_FOREACH( f32x4 y0, y1; unpack8(stash[((ai * 4 + m) * 2 + bj) * NT + tid], y0, y1); f32x4 t0, t1;
                _Pragma("unroll") for (int q = 0; q < 4; ++q) { t0[q] = sigmoidf_(v0[q]) * y0[q]; t1[q] = sigmoidf_(v1[q]) * y1[q]; }
                pg8::u32x4* mp = (pg8::u32x4*)((u.kind == 2 && u.aux != 0 ? PMp + (size_t)(u.aux - 1) * RC * DM - (size_t)RL * DM : MMp) + (size_t)row * DM + col);
                if (u.kind == 1 && u.aux != 0) { f32x4 p0, p1; unpack8(*mp, p0, p1); t0 += p0; t1 += p1; }
                *mp = pack8(t0, t1); ) }
    }
};
struct TItem { const float* W; bf16_t* WT; const float* kscale; int K, N, row_off, item; };
__device__ __forceinline__ void titem_load(const TItem& t, int lane, f32x4 (&v)[8]) {
    const int nblk = t.N / 32, kb = t.item / nblk, nb = t.item % nblk;
    const float* p = t.W + (size_t)(64 * kb + (lane >> 3)) * t.N + 32 * nb + 4 * (lane & 7);
#pragma unroll
    for (int i = 0; i < 8; ++i) v[i] = *(const f32x4*)(p + (size_t)(8 * i) * t.N);
}
__device__ __forceinline__ void titem_store(const TItem& t, int lane, const f32x4 (&v)[8], LAS float* scr) {
    const int nblk = t.N / 32, kb = t.item / nblk, nb = t.item % nblk, k0 = 64 * kb, n0 = 32 * nb;
#pragma unroll
    for (int i = 0; i < 8; ++i) { const int kk = 8 * i + (lane >> 3); f32x4 w = v[i]; if (t.kscale) w *= t.kscale[k0 + kk];
        LAS float* sp = scr + kk * 33 + 4 * (lane & 7); sp[0] = w[0]; sp[1] = w[1]; sp[2] = w[2]; sp[3] = w[3]; }
    asm volatile("s_waitcnt lgkmcnt(0)" ::: "memory");
    const int c = lane & 7;
#pragma unroll
    for (int j = 0; j < 4; ++j) { const int n = (lane >> 3) + 8 * j; const LAS float* sp = scr + (8 * c) * 33 + n;
        pg8::u32x4 o; o.x = pg8::cvt_pk_bf16(sp[0 * 33], sp[1 * 33]); o.y = pg8::cvt_pk_bf16(sp[2 * 33], sp[3 * 33]); o.z = pg8::cvt_pk_bf16(sp[4 * 33], sp[5 * 33]); o.w = pg8::cvt_pk_bf16(sp[6 * 33], sp[7 * 33]);
        *(pg8::u32x4*)(t.WT + (size_t)(t.row_off + n0 + n) * t.K + k0 + 8 * c) = o; }
    asm volatile("s_waitcnt lgkmcnt(0)" ::: "memory");
}
__device__ __forceinline__ void ph_convert_weights(unsigned char* lds, int l, const float* w_in, const float* w1, const float* w2, const float* w_out, const float* w_br, const float* w_glu,
                                                   const float* w_uq, const float* q_norm, const float* w_ukv, const float* kv_norm, unsigned char* ws, int it_lo, int it_hi, int vb, int vg, int sk_lo, int sk_len, int heavy_from) { PH_IDS;
    const int wave = __builtin_amdgcn_readfirstlane(tid_ >> 6), lane = tid_ & 63;
    LAS float* scr = (LAS float*)((LAS unsigned char*)lds + wave * 16384);
    const int hf_ = heavy_from < vg ? heavy_from : vg;
    const int NGW = hf_ * 8 + (vg - hf_) * 24, npass_ = vb >= hf_ ? 3 : 1;
    constexpr int I_IN = 16 * 189, I_1 = 16 * 128, I_2 = 64 * 32, I_O = 16 * 32, I_B = 4 * 32;
    constexpr int I_G = 4 * 16;
    constexpr int I_UQ = 4 * 12, I_UKV = 2 * 16;
    constexpr int NITEMS = I_IN + I_1 + I_2 + I_O + 4 * I_B + I_G + I_UQ + I_UKV;
    bf16_t* WIN_T = (bf16_t*)(ws + WS_WIN); bf16_t* W1_T = (bf16_t*)(ws + WS_W1); bf16_t* W2_T = (bf16_t*)(ws + WS_W2); bf16_t* WOUT_T = (bf16_t*)(ws + WS_WOUT); bf16_t* WBR_T = (bf16_t*)(ws + WS_WBR);
    auto decode = [&](int it) -> TItem {
        TItem t; t.kscale = nullptr; t.row_off = 0; int r = it; if (r >= sk_lo) r += sk_len;
        if (r < I_IN) { t.W = w_in + (size_t)l * DM * INC; t.K = DM; t.N = INC; t.WT = WIN_T; t.row_off = (r % 189) >= 61 ? 96 : 0; t.item = r; return t; } r -= I_IN;
        if (r < I_1) { t.W = w1 + (size_t)l * DM * DFF; t.K = DM; t.N = DFF; t.WT = W1_T; t.item = r; return t; } r -= I_1;
        if (r < I_2) { t.W = w2 + (size_t)l * DFF * DM; t.K = DFF; t.N = DM; t.WT = W2_T; t.item = r; return t; } r -= I_2;
        if (r < I_O) { t.W = w_out + (size_t)l * DM * DM; t.K = DM; t.N = DM; t.WT = WOUT_T; t.item = r; return t; } r -= I_O;
        if (r < 4 * I_B) { const int n = r / I_B; t.W = w_br + ((size_t)l * 4 + n) * 256 * DM; t.K = 256; t.N = DM; t.WT = WBR_T + (size_t)n * 1024 * 256; t.item = r % I_B; return t; } r -= 4 * I_B;
        if (r < I_G) { const int n0 = (r % 16) * 32;
            t.W = w_glu + (size_t)l * 256 * 512; t.K = 256; t.N = 512; t.WT = (bf16_t*)(ws + WS_WGLU); t.row_off = n0 < 128 ? 0 : (n0 < 256 ? 128 : (n0 < 384 ? -128 : 0)); t.item = r; return t; } r -= I_G;
        if (r < I_UQ) { t.W = w_uq + (size_t)l * 256 * 384; t.K = 256; t.N = 384; t.WT = (bf16_t*)(ws + WS_WUQ); t.kscale = q_norm + l * 256; t.item = r; return t; } r -= I_UQ;
        t.W = w_ukv + (size_t)l * 128 * 512; t.K = 128; t.N = 512; t.WT = (bf16_t*)(ws + WS_WUKV); t.kscale = kv_norm + l * 128; t.item = r; return t;
    };
    const int IT_HI = it_hi < 0 ? NITEMS - sk_len : it_hi;
#pragma unroll 1
    for (int ps_ = 0; ps_ < npass_; ++ps_) {
    const int gw = vb < hf_ ? vb * 8 + wave : hf_ * 8 + (vb - hf_) * 24 + ps_ * 8 + wave;
    if (it_lo + gw < IT_HI) {
        TItem cur = decode(it_lo + gw); f32x4 v[8]; titem_load(cur, lane, v);
        for (int it = it_lo + gw; it < IT_HI; it += NGW) {
            const bool more = it + NGW < IT_HI;
            TItem nxt = cur; f32x4 vn[8];
            if (more) { nxt = decode(it + NGW); titem_load(nxt, lane, vn); }
            titem_store(cur, lane, v, scr);
            if (more) { cur = nxt;
#pragma unroll
                for (int i = 0; i < 8; ++i) v[i] = vn[i]; }
        }
    }
    }
    if (it_hi < 0) { GSTRIDE(gi, 96 * 1024 / 8) { *(pg8::u32x4*)(WIN_T + (size_t)1952 * 1024 + (size_t)gi * 8) = (pg8::u32x4){0u, 0u, 0u, 0u}; } }
    __syncthreads();
}
constexpr int CV_E3 = 16 * 189 + 16 * 128 + 64 * 32;
constexpr int CV_E1 = 2400, CV_E2 = 16 * 189 + 16 * 128;

struct EpiFourier { static constexpr bool PRE = false;
    bf16_t* Zp; int rowbase, L; float scale;
    __device__ __forceinline__ void operator()(const f32x4 (&acc)[2][2][4][2], const pg8::Unit& u, int wr, int wc, int fr, int fq) const {
        EPI_FOREACH( *(pg8::u32x4*)(Zp + ((size_t)rowbase + (size_t)u.pn * L + row) * ZW + C_FU + (col - u.pn * 256)) = pack8(v0 * scale, v1 * scale); )
    }
};
__device__ __forceinline__ void ph_f2a(unsigned char* lds_, const bf16_t* F1, const float* trig, bf16_t* BP) { PH_IDS;
    const int lane = tid_ & 63, wid = __builtin_amdgcn_readfirstlane(tid_ >> 6), c16 = lane & 15, kq = lane >> 4;
    LAS char* wi = (LAS char*)lds_ + wid * 16384;
    LAS char* wo = wi + 8192;
    bf16x8 are, aim;
#pragma unroll
    for (int j = 0; j < 8; ++j) { const int t2 = 8 * (kq & 1) + j, idx = ((c16 * t2) & 15) * 128; const float cs = trig[idx], sn = trig[2048 + idx];
        are[j] = (short)f2bf((kq >> 1) ? -sn : cs); aim[j] = (short)f2bf((kq >> 1) ? cs : sn); }
    for (int col = bid_ * 8 + wid; col < NB * 256; col += G_ * 8) {
        const pg8::u32x4* src = (const pg8::u32x4*)(F1 + (size_t)col * 4096);
        pg8::u32x4 st[8];
#pragma unroll
        for (int i = 0; i < 8; ++i) st[i] = src[lane + 64 * i];
#pragma unroll
        for (int i = 0; i < 8; ++i) *(LAS pg8::u32x4*)(wi + (lane + 64 * i) * 16) = st[i];
        asm volatile("s_waitcnt lgkmcnt(0)" ::: "memory");
#pragma unroll 2
        for (int nb = 0; nb < 8; ++nb) {
            const int t1 = 16 * nb + c16;
            bf16x8 bf;
#pragma unroll
            for (int j = 0; j < 8; ++j) bf[j] = *(const LAS short*)(wi + ((kq >> 1) * 2048 + t1 + 128 * (8 * (kq & 1) + j)) * 2);
            const f32x4 z4 = (f32x4){0.f, 0.f, 0.f, 0.f};
            const f32x4 re = __builtin_amdgcn_mfma_f32_16x16x32_bf16(are, bf, z4, 0, 0, 0), im = __builtin_amdgcn_mfma_f32_16x16x32_bf16(aim, bf, z4, 0, 0, 0);
#pragma unroll
            for (int r = 0; r < 4; ++r) { const int k2 = 4 * kq + r, idx = k2 * t1; const float cs = trig[idx], sn = trig[2048 + idx];
                *(LAS bf16_t*)(wo + ((k2 * 2 + 0) * 128 + t1) * 2) = f2bf(re[r] * cs - im[r] * sn);
                *(LAS bf16_t*)(wo + ((k2 * 2 + 1) * 128 + t1) * 2) = f2bf(re[r] * sn + im[r] * cs); }
        }
        asm volatile("s_waitcnt lgkmcnt(0)" ::: "memory");
        pg8::u32x4* dst = (pg8::u32x4*)(BP + (size_t)col * 4096);
#pragma unroll
        for (int i = 0; i < 8; ++i) dst[lane + 64 * i] = *(const LAS pg8::u32x4*)(wo + (lane + 64 * i) * 16);
        asm volatile("s_waitcnt lgkmcnt(0)" ::: "memory");
    }
    __syncthreads();
}
struct SchedFourier2 { static constexpr bool DEP = false;
    const char* AT; const char* BP; int c;
    __device__ __forceinline__ bool next(int i, pg8::Unit& u) const {
        if (i != 0) return false;
        const int j = c & 7, b = c >> 3;
        u.A = AT; u.lda = 1024; u.B = BP + ((size_t)b * 256 * 4096 + (size_t)j * 512) * 2; u.ldb = 8192; u.nt = 8; u.pm = j; u.pn = b; u.kind = 0; u.aux = 0; return true; }
};
struct EpiFourier2 { static constexpr bool PRE = false;
    bf16_t* Zp; float scale;
    __device__ __forceinline__ void operator()(const f32x4 (&acc)[2][2][4][2], const pg8::Unit& u, int wr, int wc, int fr, int fq) const {
#pragma unroll
        for (int ai = 0; ai < 2; ++ai)
#pragma unroll
            for (int m = 0; m < 4; ++m)
#pragma unroll
                for (int bj = 0; bj < 2; ++bj) {
                    const int k1 = wr * 64 + m * 16 + fr, k = 16 * k1 + 2 * u.pm + ai, gm = bj * 128 + wc * 32 + 8 * fq;
                    *(pg8::u32x4*)(Zp + ((size_t)u.pn * 2048 + k) * ZW + C_FU + gm) = pack8(acc[ai][bj][m][0] * scale, acc[ai][bj][m][1] * scale);
                }
    }
};
struct EpiGlu { static constexpr bool PRE = false;
    bf16_t* OCp;
    __device__ __forceinline__ void operator()(const f32x4 (&acc)[2][2][4][2], const pg8::Unit& u, int wr, int wc, int fr, int fq) const {
#pragma unroll
        for (int ai = 0; ai < 2; ++ai)
#pragma unroll
            for (int m = 0; m < 4; ++m) {
                const int row = u.pm * 256 + ai * 128 + wr * 64 + m * 16 + fr, col = u.pn * 128 + wc * 32 + 8 * fq;
                f32x4 a, b;
#pragma unroll
                for (int q = 0; q < 4; ++q) { a[q] = acc[ai][0][m][0][q] * sigmoidf_(acc[ai][1][m][0][q]); b[q] = acc[ai][0][m][1][q] * sigmoidf_(acc[ai][1][m][1][q]); }
                *(pg8::u32x4*)(OCp + (size_t)row * 256 + col) = pack8(a, b);
            }
    }
};
__device__ __forceinline__ void ph_dft_gen(const float* trig, bf16_t* AT, bf16_t* DC) { PH_IDS;
    GSTRIDE(gi, 256 * 512) {
        const int r = gi >> 9, c = gi & 511, h = r >> 7, k1 = r & 127, hh = c >> 8, part = (c >> 7) & 1, t1 = c & 127, idx = ((k1 * t1) & 127) * 16;
        AT[gi] = f2bf(h != hh ? 0.f : (part ? -trig[2048 + idx] : trig[idx]));
    }
    GSTRIDE(gi, 256 * 512 / 8) {
        const int k = gi >> 6, kk0 = (gi & 63) * 8; pg8::u32x4 w; unsigned pr[4];
#pragma unroll
        for (int q = 0; q < 4; ++q) { float v[2];
#pragma unroll
            for (int e = 0; e < 2; ++e) { const int kk = kk0 + 2 * q + e, part = kk >> 8, t = kk & 255, idx = ((k * t) & 255) * 8; v[e] = part ? -trig[2048 + idx] : trig[idx]; }
            pr[q] = pg8::cvt_pk_bf16(v[0], v[1]); }
        w.x = pr[0]; w.y = pr[1]; w.z = pr[2]; w.w = pr[3];
        *(pg8::u32x4*)(DC + (size_t)k * 512 + kk0) = w;
    }
}

__device__ __forceinline__ void ph_sum_mm(bf16_t* MMp, const bf16_t* PMp) { PH_IDS;
    GSTRIDE(gi, RC * DM / 8) {
        pg8::u32x4* mp = (pg8::u32x4*)(MMp + (size_t)RL * DM) + gi;
        f32x4 a, b; unpack8(*mp, a, b);
#pragma unroll
        for (int n = 0; n < 3; ++n) { f32x4 c, d; unpack8(*((const pg8::u32x4*)(PMp + (size_t)n * RC * DM) + gi), c, d); a += c; b += d; }
        *mp = pack8(a, b);
    }
}
__device__ __forceinline__ void ph_sum_ffn(bf16_t* XC, const float* PD, const float* mod) { PH_IDS;
    GSTRIDE(gi, RC * DM / 8) {
        const int col = (gi * 8) & (DM - 1);
        f32x4 a0 = *((const f32x4*)PD + 2 * gi), a1 = *((const f32x4*)PD + 2 * gi + 1);
#pragma unroll
        for (int n = 1; n < 4; ++n) { a0 += *((const f32x4*)(PD + (size_t)n * RC * DM) + 2 * gi); a1 += *((const f32x4*)(PD + (size_t)n * RC * DM) + 2 * gi + 1); }
        const f32x4 g0 = *(const f32x4*)(mod + (size_t)8 * 6144 + 5 * 1024 + col), g1 = *(const f32x4*)(mod + (size_t)8 * 6144 + 5 * 1024 + col + 4);
        f32x4 x0, x1; ld8<1>(XC, (size_t)gi * 8, x0, x1); st8<1>(XC, (size_t)gi * 8, x0 + g0 * a0, x1 + g1 * a1);
    }
}

constexpr size_t WS_BAR = 768 * 1024;
constexpr int LDS_BYTES = 147456;
struct Args { const float* in[30]; float* out; unsigned char* ws; };
typedef const __attribute__((address_space(4))) Args* CArgs;
__device__ __forceinline__ CArgs kargs() { CArgs p = (CArgs)__builtin_amdgcn_kernarg_segment_ptr(); asm volatile("" : "+s"(p)); return p; }
#define IN(i) (kargs()->in[i])
#define WSB(T, off) ((T*)(kargs()->ws + (off)))
#define OSB(T, off) ((T*)((unsigned char*)kargs()->out + (off)))
#define OUTP (kargs()->out)
enum { I_X = 0, I_C, I_CTX, I_CCTX, I_ADAW, I_ADAB, I_NMIX, I_NFFN, I_WIN, I_QNORM, I_WUQ, I_KVNORM, I_WUKV, I_QKQ, I_QKK, I_LRE, I_LIM, I_LSTEP, I_BRE, I_BIM, I_CRE, I_CIM, I_S5D, I_WGLU, I_RDEC, I_RGN, I_WBR, I_WOUT, I_W1, I_W2 };
#define GRID_BAR() do { bar.bar = WSB(unsigned, WS_BAR); { unsigned x_ = bar.x; asm volatile("" : "+s"(x_)); bar.x = x_; } xcd_barrier(bar); } while (0)
template <int L> __device__ __forceinline__ void layer_body(unsigned char* lds, XcdBarrier& bar) {
    constexpr int l = L;
    constexpr bool LASTL = (L == DEPTH - 1);
    constexpr int NMT = LASTL ? RL / 256 : RT / 256;
    constexpr int WCTX = LASTL ? 0 : 1;

#define MODL (WSB(float, WS_MOD) + (size_t)l * 9 * 6144)
#define XLAT (l == 0 ? (const void*)IN(I_X) : (const void*)WSB(bf16_t, WS_R))
#define XCTX (l == 0 ? (const void*)IN(I_CTX) : (const void*)WSB(bf16_t, WS_XCB))
    constexpr int XIN = (L == 0) ? 0 : 1;
#define WINL (IN(I_WIN) + (size_t)l * DM * INC)
#define ZP WSB(bf16_t, WS_Z)
#define XNP WSB(bf16_t, WS_XN)
#define QP WSB(bf16_t, WS_QKV)
#define KP (WSB(bf16_t, WS_QKV) + (size_t)32 * 2304 * 96)
#define VP (WSB(bf16_t, WS_QKV) + (size_t)2 * 32 * 2304 * 96)
#define F1LAT WSB(bf16_t, WS_F1)
#define F1CTX (WSB(bf16_t, WS_F1) + (size_t)8 * 256 * 2 * 2048)
#define QRAWP WSB(bf16_t, WS_RAW)
#define KVRAWP (WSB(bf16_t, WS_RAW) + (size_t)RT * 384)
        if (l != 0 && l_grid() != 256) ph_s5_lp(l, IN(I_LRE), IN(I_LIM), IN(I_LSTEP), IN(I_BRE), IN(I_BIM), WSB(float2, WS_LP), WSB(float2, WS_BB), WSB(float, WS_LAMT), l_bid(), l_grid());
        ph_adarms<XIN>(XLAT, XCTX, IN(I_NMIX) + l * DM, MODL, 0, 1, XNP, RT, (l != 0 && l_grid() == 256) ? OSB(float, 1 * MiB) : nullptr, WSB(float, WS_MOD) + (size_t)(l > 0 ? l - 1 : 0) * 9 * 6144 + (size_t)8 * 6144 + 5 * 1024);
        if (l != 0) ph_convert_weights(lds, l, IN(I_WIN), IN(I_W1), IN(I_W2), IN(I_WOUT), IN(I_WBR), IN(I_WGLU), IN(I_WUQ), IN(I_QNORM), IN(I_WUKV), IN(I_KVNORM), kargs()->ws, l_grid() == 256 ? CV_E2 : 0, -1, l_bid(), l_grid(), 1 << 30, 0, 1 << 30);
        if (l == 0) ph_dft_gen(WSB(float, WS_TRIG), OSB(bf16_t, OS_AT), OSB(bf16_t, OS_DFTC));
        ph_wmf(IN(I_NFFN) + l * DM, MODL, WSB(float, WS_WMF));
        GRID_BAR();
        { SchedP1 S; S.A = (const char*)XNP; S.B = (const char*)WSB(bf16_t, WS_WIN); S.G = l_grid(); S.c = l_bid(); S.last = LASTL ? 1 : 0;
          EpiStore E; E.O = ZP; E.ld = ZW; E.act = 0; pg8::gemm_phase((LAS unsigned char*)lds, S, E); }
        { const int G = l_grid(), bx = l_bid(), n3 = G == 256 ? (LASTL ? 32 : 64) : 0;
          if (bx >= n3) { const int vb = bx - n3, vg = G - n3;
            ph_s5_tz(lds, l, WSB(float2, WS_LP), WSB(float2, WS_BB), IN(I_CRE), IN(I_CIM), WSB(float, WS_TZ), vb, vg);
            ph_s5_ms(WSB(float2, WS_LP), WSB(float2, WS_BB), WSB(bf16_t, WS_MS), vb, vg);
            ph_cf_mfma(lds, WSB(bf16_t, WS_W1), MODL, WSB(float, WS_CF), vb, vg); } }
        GRID_BAR();
        ph_s5_tzb(l, WSB(float, WS_TZ), IN(I_S5D) + l * 256, OSB(bf16_t, OS_TZB), IN(I_CRE), IN(I_CIM), OSB(bf16_t, OS_CQ));
        ph_prep(ZP, WSB(bf16_t, WS_WUQ), WSB(bf16_t, WS_WUKV), WSB(bf16_t, WS_D64), IN(I_QKQ) + l * 96, IN(I_QKK) + l * 96, QP, KP, VP, F1LAT, F1CTX, lds);
        ph_s5_sloc(lds, ZP, WSB(bf16_t, WS_MS), OSB(float, OS_SLOC));
        GRID_BAR();
        unsigned* kvc_ = WSB(unsigned, WS_BAR) + XCD_BAR_WORDS + 128 + 1024 * l;
        bf16_t* MMP_ = l == 0 ? OSB(bf16_t, 1 * MiB) : WSB(bf16_t, WS_MM);
        bf16_t* PMP_ = l == 0 ? WSB(bf16_t, WS_QKV) : OSB(bf16_t, OS_PM);
        unsigned* f2c_ = kvc_ + 640;
        ph_f2a(lds, F1LAT, WSB(float, WS_TRIG), OSB(bf16_t, OS_BP));
        dep_signal_x(f2c_, f2c_ + 32 + 16 * bar.x, bar.st[0]);
        { const int G = l_grid(), bx = l_bid(), nf = G == 256 ? (LASTL ? 64 : 72) : 0;
          ph_ret_kv(lds, ZP, IN(I_RDEC) + l * 8, WSB(bf16_t, WS_KVF), OSB(bf16_t, OS_KVB), bx - nf, G - nf);
          dep_signal_x(kvc_, kvc_ + 32 + 16 * bar.x, bar.st[0]); }
        {
            const int bx = l_bid();
            if (bx < 64) { if (l_tid() == 0) dep_spin(f2c_, (unsigned)l_grid(), WSB(unsigned, WS_BAR)); __syncthreads();
                SchedFourier2 S; S.AT = (const char*)OSB(bf16_t, OS_AT); S.BP = (const char*)OSB(bf16_t, OS_BP); S.c = bx;
                EpiFourier2 E; E.Zp = ZP; E.scale = 0.0027621358640099515f; pg8::gemm_phase((LAS unsigned char*)lds, S, E); }
            else if (!LASTL && bx < 72) { SchedGrid S; S.A = (const char*)OSB(bf16_t, OS_DFTC); S.B = (const char*)F1CTX; S.lda = 1024; S.ldb = 1024; S.nt = 8; S.nM = 1; S.nN = 8; S.G = 8; S.c = bx - 64; S.kind = 0; S.aux = 0;
                EpiFourier E; E.Zp = ZP; E.rowbase = RL; E.L = 256; E.scale = 0.0078125f; pg8::gemm_phase((LAS unsigned char*)lds, S, E); }
            constexpr int NS5 = 16 * (LASTL ? 16 : 18);
            constexpr int NC = LASTL ? 0 : 32;
            constexpr int Q_ATT = 0, Q_ATTC = 256, Q_S5 = Q_ATTC + NC, Q_RET = Q_S5 + NS5, Q_RETC = Q_RET + 256, Q_END = Q_RETC + NC;
            volatile LAS int* qslot = (volatile LAS int*)((LAS unsigned char*)lds + LDS_BYTES - 32);
            unsigned* s5c_ = kvc_ + 320; bool s5sig_ = false;
            for (;;) {
                __syncthreads();
                if (l_tid() == 0) qslot[0] = (int)atomicAdd(WSB(unsigned, WS_BAR) + XCD_BAR_WORDS + 64 * l, 1u);
                __syncthreads();
                const int q = __builtin_amdgcn_readfirstlane(qslot[0]);
                if (!s5sig_ && q >= Q_RET) { dep_signal_x(s5c_, s5c_ + 32 + 16 * bar.x, bar.st[0]); s5sig_ = true; }
                if (q >= Q_END) break;
                if (q < Q_ATTC) ph_attn_mfma(lds, QP, KP, VP, ZP, WCTX, q - Q_ATT, 1 << 20);
                else if (q < Q_S5) ph_attn_mfma(lds, QP, KP, VP, ZP, WCTX, 256 + q - Q_ATTC, 1 << 20);
                else if (q < Q_RET) ph_s5_out(lds, ZP, OSB(bf16_t, OS_TZB), OSB(bf16_t, OS_CQ), WSB(float2, WS_LP), OSB(float, OS_SLOC), WSB(float, WS_LAMT), ZP, LASTL ? 16 : 18, q - Q_S5, 1 << 20);
                else if (q < Q_RETC) ph_ret_chunk(lds, ZP, WSB(bf16_t, WS_KVF), OSB(bf16_t, OS_KVB), IN(I_RDEC) + l * 8, IN(I_RGN) + l * 256, WCTX, q - Q_RET, 1 << 20, kvc_, WSB(unsigned, WS_BAR));
                else ph_ret_chunk(lds, ZP, WSB(bf16_t, WS_KVF), OSB(bf16_t, OS_KVB), IN(I_RDEC) + l * 8, IN(I_RGN) + l * 256, WCTX, 256 + q - Q_RETC, 1 << 20, kvc_, WSB(unsigned, WS_BAR));
            }
        }
        if (l_tid() == 0) dep_spin(kvc_ + 320, (unsigned)l_grid(), WSB(unsigned, WS_BAR));
        __syncthreads();
        { SchedGluDyn S; S.A = (const char*)(ZP + C_S5); S.B = (const char*)WSB(bf16_t, WS_WGLU); S.ctr = kvc_ + 960; S.slot = (volatile LAS int*)((LAS unsigned char*)lds + LDS_BYTES - 32); S.nunits = NMT * 2;
          EpiGlu E; E.OCp = OSB(bf16_t, OS_OC); pg8::gemm_phase((LAS unsigned char*)lds, S, E); }
        GRID_BAR();
        { SchedMerge S; S.Z = (const char*)ZP; S.XN = (const char*)XNP; S.WBR = (const char*)WSB(bf16_t, WS_WBR); S.WING = (const char*)(WSB(bf16_t, WS_WIN) + (size_t)2048 * 1024); S.OC = (const char*)OSB(bf16_t, OS_OC);
          S.G = l_grid(); { const int bx = l_bid(); S.vcu = (bx % 8) * (S.G / 8) + bx / 8; }
          const bool mini = !LASTL && S.G == 256;
          S.njobs = mini ? RL / 256 * 4 : NMT * 4; S.nmini = mini ? 128 : 0;
          EpiMerge E; E.stash = WSB(pg8::u32x4, WS_STASH) + (size_t)l_bid() * 8192; E.MMp = MMP_; E.PMp = PMP_; pg8::gemm_phase((LAS unsigned char*)lds, S, E);
          if (mini && S.vcu >= 128) { ph_s5_lp(l + 1, IN(I_LRE), IN(I_LIM), IN(I_LSTEP), IN(I_BRE), IN(I_BIM), WSB(float2, WS_LP), WSB(float2, WS_BB), WSB(float, WS_LAMT), S.vcu - 128, 128);
              if (l == 0) ph_convert_weights(lds, l, IN(I_WIN), IN(I_W1), IN(I_W2), IN(I_WOUT), IN(I_WBR), IN(I_WGLU), IN(I_WUQ), IN(I_QNORM), IN(I_WUKV), IN(I_KVNORM), kargs()->ws, CV_E2, CV_E3, S.vcu - 128, 128, 1 << 30, 0, 1 << 30); } }
        GRID_BAR();
        if (!LASTL && l_grid() == 256) { ph_sum_mm(MMP_, PMP_); GRID_BAR(); }
        const bool fuse_ = !LASTL && l_grid() == 256;
        unsigned* jlc_ = kvc_ + 480;
        { SchedDep S; S.A = (const char*)MMP_; S.B = (const char*)WSB(bf16_t, WS_WOUT); S.lda = 2048; S.ldb = 2048; S.nt = 16; S.nM = NMT; S.nN = 4; S.G = l_grid(); S.c = l_bid(); S.mode = fuse_ ? 1 : 0; S.dep = nullptr; S.barw = nullptr; S.okpm = -1;
          EpiResid<XIN, 1> E; E.xlat = XLAT; E.xctx = XCTX; E.olat = WSB(bf16_t, WS_R); E.octx = WSB(bf16_t, WS_XCB); E.mod = MODL; E.gch = 2; E.part = nullptr; E.dep = fuse_ ? jlc_ : nullptr; E.an = XNP; E.wmf = WSB(float, WS_WMF); E.ss = OSB(float, OS_SS); E.red = (LAS float*)((LAS unsigned char*)lds + 131072); pg8::gemm_phase((LAS unsigned char*)lds, S, E); }
        if (!fuse_) GRID_BAR();
        { SchedDep S; S.A = (const char*)XNP; S.B = (const char*)WSB(bf16_t, WS_W1); S.lda = 2048; S.ldb = 2048; S.nt = 16; S.nM = NMT; S.nN = 16; S.G = l_grid(); S.c = l_bid(); S.mode = fuse_ ? 2 : 0; S.dep = jlc_; S.barw = WSB(unsigned, WS_BAR); S.okpm = -1;
          EpiFfnUp E; E.O = WSB(bf16_t, WS_H); E.ss = OSB(float, OS_SS); E.cf = WSB(float, WS_CF); E.red = (LAS float*)((LAS unsigned char*)lds + 131072); pg8::gemm_phase((LAS unsigned char*)lds, S, E); }
        if (fuse_ && (l_bid() >> 3) >= 20)
            ph_convert_weights(lds, l + 1, IN(I_WIN), IN(I_W1), IN(I_W2), IN(I_WOUT), IN(I_WBR), IN(I_WGLU), IN(I_WUQ), IN(I_QNORM), IN(I_WUKV), IN(I_KVNORM), kargs()->ws, 0, CV_E1, (l_bid() & 7) * 12 + (l_bid() >> 3) - 20, 96, 1 << 30, 0, 1 << 30);
        GRID_BAR();
        { SchedFfnDown S; S.H = (const char*)WSB(bf16_t, WS_H); S.W2 = (const char*)WSB(bf16_t, WS_W2); S.G = l_grid(); S.c = l_bid(); S.nctx = (!LASTL && S.G == 256) ? 128 : 0;
          EpiResid<1, LASTL ? 0 : 1> E; E.xlat = WSB(bf16_t, WS_R); E.xctx = WSB(bf16_t, WS_XCB); E.olat = LASTL ? (void*)OUTP : (void*)WSB(bf16_t, WS_R); E.octx = WSB(bf16_t, WS_XCB); E.mod = MODL; E.gch = 5; E.part = OSB(float, 1 * MiB); E.dep = nullptr; E.an = nullptr; E.wmf = nullptr; E.ss = nullptr; E.red = nullptr;
          if (!LASTL && S.G != 256) { SchedGrid S2; S2.A = S.H; S2.B = S.W2; S2.lda = 8192; S2.ldb = 8192; S2.nt = 64; S2.nM = NMT; S2.nN = 4; S2.G = S.G; S2.c = S.c; S2.kind = 0; S2.aux = 0; pg8::gemm_phase((LAS unsigned char*)lds, S2, E); }
          else pg8::gemm_phase((LAS unsigned char*)lds, S, E); }
        if (!LASTL && l_grid() == 256 && l_bid() >= 128)
            ph_convert_weights(lds, l + 1, IN(I_WIN), IN(I_W1), IN(I_W2), IN(I_WOUT), IN(I_WBR), IN(I_WGLU), IN(I_WUQ), IN(I_QNORM), IN(I_WUKV), IN(I_KVNORM), kargs()->ws, CV_E1, CV_E2, l_bid() - 128, 128, 1 << 30, 0, 1 << 30);
        if (l + 1 < DEPTH) GRID_BAR();
}
__global__ void __launch_bounds__(NT, 2) mega(Args a_unused) {
    extern __shared__ __attribute__((aligned(16))) unsigned char lds[];
    volatile LAS unsigned* bst = (volatile LAS unsigned*)((LAS unsigned char*)lds + LDS_BYTES - 16);
    if (threadIdx.x < 4) bst[threadIdx.x] = 0u;
    __syncthreads();
    XcdBarrier bar = xcd_barrier_post(WSB(unsigned, WS_BAR), bst);

    ph_mod(lds, IN(I_C), IN(I_CCTX), IN(I_ADAW), IN(I_ADAB), WSB(float, WS_MOD));
    ph_trig(WSB(float, WS_TRIG), WSB(bf16_t, WS_D64));
    ph_s5_lp(0, IN(I_LRE), IN(I_LIM), IN(I_LSTEP), IN(I_BRE), IN(I_BIM), WSB(float2, WS_LP), WSB(float2, WS_BB), WSB(float, WS_LAMT), l_bid(), l_grid());
    ph_convert_weights(lds, 0, IN(I_WIN), IN(I_W1), IN(I_W2), IN(I_WOUT), IN(I_WBR), IN(I_WGLU), IN(I_WUQ), IN(I_QNORM), IN(I_WUKV), IN(I_KVNORM), kargs()->ws, 0, -1, l_bid(), l_grid(), l_grid() == 256 ? CV_E2 : (1 << 30), l_grid() == 256 ? CV_E3 - CV_E2 : 0, 192);
    GRID_BAR();
    layer_body<0>(lds, bar);
    layer_body<1>(lds, bar);
}

extern "C" void kernel_launch(void* const* d_in, const int* in_sizes, int n_in, void* d_out, int out_size, void* d_ws, size_t ws_size, hipStream_t stream) {
    static int grid = 0;
    if (grid == 0) {
        if (n_in != 30 || ws_size < WS_END) { fprintf(stderr, "kernel_launch: unexpected n_in %d / ws_size %zu\n", n_in, ws_size); grid = -1; return; }
        int dev = 0, cus = 0, per_cu = 0;
        if (hipGetDevice(&dev) != hipSuccess || hipDeviceGetAttribute(&cus, hipDeviceAttributeMultiprocessorCount, dev) != hipSuccess) { grid = -1; return; }
        if (hipFuncSetAttribute((const void*)mega, hipFuncAttributeMaxDynamicSharedMemorySize, LDS_BYTES) != hipSuccess) { fprintf(stderr, "kernel_launch: hipFuncSetAttribute failed\n"); grid = -1; return; }
        if (hipOccupancyMaxActiveBlocksPerMultiprocessor(&per_cu, (const void*)mega, NT, LDS_BYTES) != hipSuccess || per_cu < 1) fprintf(stderr, "kernel_launch: occupancy query says %d\n", per_cu);
        (void)hipGetLastError();
        grid = cus;
    }
    if (grid < 0) return;
    (void)hipMemsetAsync((char*)d_ws + WS_BAR, 0, (XCD_BAR_WORDS + 128 + 2048) * 4, stream);
    Args a; memset((void*)&a, 0, sizeof(a));
    for (int i = 0; i < 30; ++i) a.in[i] = (const float*)d_in[i];
    a.out = (float*)d_out; a.ws = (unsigned char*)d_ws;
    hipLaunchKernelGGL(mega, dim3(grid), dim3(NT), LDS_BYTES, stream, a);
}
```
